# Optimizing an MI355X kernel written in HIP

```python
import math
import jax
import jax.numpy as jnp
from jax import lax
import numpy as np


D_MODEL = 1024
BATCH = 2
SEQ = 8192
DEPTH = 1

HEAD_DIM = 64
HEADS_PER_GROUP = 4
DILATION_GROUPS = ((128, 1), (512, 4), (2048, 16))
N_GROUPS = len(DILATION_GROUPS)
ATTN_WIDTH = N_GROUPS * HEADS_PER_GROUP * HEAD_DIM
ATTN_OUT = HEADS_PER_GROUP * HEAD_DIM
ROPE_THETA = 500000.0
ROPE_DIM = HEAD_DIM // 4
NEG_BIG = -1e30

HYENA_WIDTH = D_MODEL // 2
HYENA_ORDER = 2
HYENA_EMB = 33
HYENA_BANDS = (HYENA_EMB - 1) // 2
HYENA_FILTER_HIDDEN = 64
HYENA_SHORT = 3
HYENA_DECAY_SHORT_PCT = 0.3
HYENA_DECAY_LONG_PCT = 1.5
HYENA_DECAY_TARGET = 1e-2
HYENA_FILTER_INIT = 0.05

PEER_HEADS = 8
PEER_NKEYS = 128
PEER_EXPERTS = PEER_NKEYS * PEER_NKEYS
PEER_KEY_DIM = 128
PEER_TOPK = 16
PEER_CHUNK = 128

N_BRANCH = 2
IN_WIDTH = (HYENA_ORDER + 1) * HYENA_WIDTH + 3 * ATTN_WIDTH + N_BRANCH * D_MODEL
DN_ALPHA = (2.0 * DEPTH) ** 0.25
DN_BETA = (8.0 * DEPTH) ** -0.25
ADA_INIT = 0.2
LN_EPS = 1e-5

kernel_name = 'hybrid_hyena_dilated_attn_peer_encoder'


def layer_norm(x, g, b):
    xf = x.astype(jnp.float32)
    mu = jnp.mean(xf, axis=-1, keepdims=True)
    var = jnp.mean(jnp.square(xf - mu), axis=-1, keepdims=True)
    y = (xf - mu) * lax.rsqrt(var + LN_EPS) * g.astype(jnp.float32) + b.astype(jnp.float32)
    return y.astype(x.dtype)


def short_conv(z, w, b):
    zp = jnp.pad(z, ((0, 0), (1, 1), (0, 0)))
    return zp[:, :-2] * w[0] + zp[:, 1:-1] * w[1] + zp[:, 2:] * w[2] + b


def hyena_filters(L, f1_w, f1_b, f1_freq, f2_w, f2_b, f2_freq, f3_w):
    f32 = jnp.float32
    t = jnp.linspace(0.0, 1.0, L, dtype=f32)[:, None]
    w = 2.0 * math.pi * jnp.arange(L, dtype=f32)[:, None] / L
    f = jnp.linspace(1e-4, HYENA_BANDS - 1, HYENA_BANDS, dtype=f32)[None, :]
    z = jnp.concatenate([t, jnp.cos(f * w), -jnp.sin(f * w)], axis=-1)
    h = jnp.sin(f1_freq.astype(f32) * (z @ f1_w.astype(f32) + f1_b.astype(f32)))
    h = jnp.sin(f2_freq.astype(f32) * (h @ f2_w.astype(f32) + f2_b.astype(f32)))
    h = (h @ f3_w.astype(f32)).reshape(L, 2, HYENA_ORDER, HYENA_WIDTH)
    max_decay = math.log(HYENA_DECAY_TARGET) / HYENA_DECAY_SHORT_PCT
    min_decay = math.log(HYENA_DECAY_TARGET) / HYENA_DECAY_LONG_PCT
    deltas = jnp.linspace(min_decay, max_decay, HYENA_WIDTH, dtype=f32)
    decay = jnp.exp(-t * jnp.abs(deltas)[None, :])
    h = h * decay[:, None, None, :]
    fwd, bwd = h[:, 0], h[:, 1]
    k2 = jnp.concatenate([fwd, jnp.zeros((1, HYENA_ORDER, HYENA_WIDTH), f32), bwd[:0:-1]], axis=0)
    return jnp.fft.rfft(k2, axis=0)


def long_conv(z, kf, bias):
    L = z.shape[1]
    zf = jnp.fft.rfft(z.astype(jnp.float32), n=2 * L, axis=1)
    y = jnp.fft.irfft(zf * kf[None], n=2 * L, axis=1)[:, :L]
    return (y + z.astype(jnp.float32) * bias.astype(jnp.float32)).astype(z.dtype)


def hyena_mixer(p_h, conv_w, conv_b, f1_w, f1_b, f1_freq, f2_w, f2_b, f2_freq, f3_w, bias):
    zc = short_conv(p_h, conv_w, conv_b)
    v, x1, x2 = jnp.split(zc, 3, axis=-1)
    K = hyena_filters(p_h.shape[1], f1_w, f1_b, f1_freq, f2_w, f2_b, f2_freq, f3_w)
    z = v
    for o, gate in enumerate((x1, x2)):
        z = gate * long_conv(z, K[:, o], bias[o])
    return z


def rotary(t, positions):
    f32 = jnp.float32
    inv = ROPE_THETA ** (-jnp.arange(0, ROPE_DIM, 2, dtype=f32) / ROPE_DIM)
    ang = positions.astype(f32)[..., None] * inv
    cos = jnp.cos(ang)[:, :, None, :]
    sin = jnp.sin(ang)[:, :, None, :]
    half = ROPE_DIM // 2
    t1 = t[..., :half].astype(f32)
    t2 = t[..., half:ROPE_DIM].astype(f32)
    out = jnp.concatenate([t1 * cos - t2 * sin, t2 * cos + t1 * sin, t[..., ROPE_DIM:].astype(f32)], axis=-1)
    return out.astype(t.dtype)


def dilated_window_attention(q, k, v, dilation, half):
    B, S, H, E = q.shape
    n = S // dilation
    blk = half
    nb = -(-n // blk)
    n_pad = nb * blk
    f32 = jnp.float32

    def to_blocks(t):
        t = t.reshape(B, n, dilation, H, E).transpose(0, 2, 1, 3, 4)
        t = jnp.pad(t, ((0, 0), (0, 0), (0, n_pad - n), (0, 0), (0, 0)))
        return t.reshape(B, dilation, nb, blk, H, E)

    def windows(t):
        tp = jnp.pad(t, ((0, 0), (0, 0), (1, 1), (0, 0), (0, 0), (0, 0)))
        return jnp.concatenate([tp[:, :, :-2], tp[:, :, 1:-1], tp[:, :, 2:]], axis=3)

    def from_blocks(t):
        t = t.reshape((B, dilation, n_pad) + t.shape[4:])[:, :, :n]
        t = jnp.swapaxes(t, 1, 2)
        return t.reshape((B, S) + t.shape[3:])

    qb = to_blocks(q).astype(f32) * (E ** -0.5)
    kw = windows(to_blocks(k)).astype(f32)
    vw = windows(to_blocks(v)).astype(f32)
    s = jnp.einsum('brnqhe,brnkhe->brnhqk', qb, kw)
    qi = jnp.arange(nb)[:, None] * blk + jnp.arange(blk)[None, :]
    kj = (jnp.arange(nb)[:, None] - 1) * blk + jnp.arange(3 * blk)[None, :]
    mask = (jnp.abs(qi[:, :, None] - kj[:, None, :]) <= half) & (kj[:, None, :] >= 0) & (kj[:, None, :] < n)
    mask = mask[None, None, :, None]
    s = jnp.where(mask, s, NEG_BIG)
    m = jnp.max(s, axis=-1)
    p = jnp.where(mask, jnp.exp(s - m[..., None]), 0.0)
    l = jnp.sum(p, axis=-1)
    acc = jnp.einsum('brnhqk,brnkhe->brnqhe', p, vw)
    acc = from_blocks(acc)
    m = from_blocks(jnp.swapaxes(m, 3, 4))
    l = from_blocks(jnp.swapaxes(l, 3, 4))
    return acc, m, l


def attention_mixer(qkv, positions):
    B, S, _ = qkv.shape
    qkv = qkv.reshape(B, S, 3, N_GROUPS * HEADS_PER_GROUP, HEAD_DIM)
    q = rotary(qkv[:, :, 0], positions)
    k = rotary(qkv[:, :, 1], positions)
    v = qkv[:, :, 2]
    accs, ms, ls = [], [], []
    for g, (window, dilation) in enumerate(DILATION_GROUPS):
        hs = slice(g * HEADS_PER_GROUP, (g + 1) * HEADS_PER_GROUP)
        a, m, l = dilated_window_attention(q[:, :, hs], k[:, :, hs], v[:, :, hs], dilation, window // (2 * dilation))
        accs.append(a)
        ms.append(m)
        ls.append(l)
    ms = jnp.stack(ms)
    wts = jnp.exp(ms - jnp.max(ms, axis=0, keepdims=True))
    num = jnp.sum(wts[..., None] * jnp.stack(accs), axis=0)
    den = jnp.sum(wts * jnp.stack(ls), axis=0)
    out = num / den[..., None]
    return out.reshape(B, S, ATTN_OUT).astype(qkv.dtype)


def peer(u, wq, keys, utab, vtab):
    B, S, D = u.shape
    T = B * S
    xt = u.reshape(T, D)
    q = (xt @ wq).reshape(T, PEER_HEADS, 2, PEER_KEY_DIM)
    s = jnp.einsum('thpe,hpke->thpk', q.astype(jnp.float32), keys.astype(jnp.float32))
    sv, si = lax.top_k(s, PEER_TOPK)
    cand = (sv[:, :, 0, :, None] + sv[:, :, 1, None, :]).reshape(T, PEER_HEADS, PEER_TOPK * PEER_TOPK)
    cidx = (si[:, :, 0, :, None] * PEER_NKEYS + si[:, :, 1, None, :]).reshape(T, PEER_HEADS, PEER_TOPK * PEER_TOPK)
    tv, ti = lax.top_k(cand, PEER_TOPK)
    eidx = jnp.take_along_axis(cidx, ti, axis=-1)
    g = jax.nn.softmax(tv, axis=-1)
    nc = T // PEER_CHUNK
    eidx = eidx.reshape(nc, PEER_CHUNK, PEER_HEADS * PEER_TOPK)
    g = g.reshape(nc, PEER_CHUNK, PEER_HEADS * PEER_TOPK)
    xc = xt.reshape(nc, PEER_CHUNK, D)

    def chunk(args):
        xb, ib, gb = args
        a = jnp.einsum('cd,ced->ce', xb, utab[ib]).astype(jnp.float32)
        coef = (gb * jax.nn.gelu(a, approximate=False)).astype(xb.dtype)
        return jnp.einsum('ce,ced->cd', coef, vtab[ib])

    return lax.map(chunk, (xc, eidx, g)).reshape(B, S, D)


def setup_inputs(seed: int = 0) -> dict:
    key = jax.random.key(seed)
    ks = jax.random.split(key, 32)
    f32 = jnp.float32

    def nrm(k, shape, scale):
        return jax.random.normal(k, shape, f32) * scale

    L, D, HW, HFH = DEPTH, D_MODEL, HYENA_WIDTH, HYENA_FILTER_HIDDEN
    return {
        'x': nrm(ks[0], (BATCH, SEQ, D), 1.0),
        'c': nrm(ks[1], (BATCH, D), 1.0),
        'positions': jnp.broadcast_to(jnp.arange(SEQ, dtype=jnp.int32)[None, :], (BATCH, SEQ)),
        'w_ada': nrm(ks[2], (L, D, 6 * D), ADA_INIT * D ** -0.5),
        'b_ada': nrm(ks[3], (L, 6 * D), 0.02),
        'w_in': nrm(ks[4], (L, D, IN_WIDTH), D ** -0.5),
        'hy_conv_w': nrm(ks[5], (L, HYENA_SHORT, 3 * HW), HYENA_SHORT ** -0.5),
        'hy_conv_b': nrm(ks[6], (L, 3 * HW), 0.02),
        'hy_f1_w': nrm(ks[7], (L, HYENA_EMB, HFH), HYENA_EMB ** -0.5),
        'hy_f1_b': nrm(ks[8], (L, HFH), 0.1),
        'hy_f1_freq': 1.0 + nrm(ks[9], (L, HFH), 0.01),
        'hy_f2_w': nrm(ks[10], (L, HFH, HFH), HFH ** -0.5),
        'hy_f2_b': nrm(ks[11], (L, HFH), 0.1),
        'hy_f2_freq': 1.0 + nrm(ks[12], (L, HFH), 0.01),
        'hy_f3_w': nrm(ks[13], (L, HFH, 2 * HYENA_ORDER * HW), HYENA_FILTER_INIT * HFH ** -0.5),
        'hy_bias': nrm(ks[14], (L, HYENA_ORDER, HW), 1.0),
        'w_branch_hyena': nrm(ks[15], (L, HW, D), HW ** -0.5),
        'w_branch_attn': nrm(ks[16], (L, ATTN_OUT, D), ATTN_OUT ** -0.5),
        'w_out': nrm(ks[17], (L, D, D), DN_BETA * D ** -0.5),
        'ln1_g': 1.0 + nrm(ks[18], (L, D), 0.01),
        'ln1_b': nrm(ks[19], (L, D), 0.01),
        'peer_wq': nrm(ks[20], (L, D, PEER_HEADS * 2 * PEER_KEY_DIM), D ** -0.5),
        'peer_keys': nrm(ks[21], (L, PEER_HEADS, 2, PEER_NKEYS, PEER_KEY_DIM), PEER_KEY_DIM ** -0.5),
        'peer_u': nrm(ks[22], (L, PEER_EXPERTS, D), D ** -0.5),
        'peer_v': nrm(ks[23], (L, PEER_EXPERTS, D), DN_BETA),
        'ln2_g': 1.0 + nrm(ks[24], (L, D), 0.01),
        'ln2_b': nrm(ks[25], (L, D), 0.01),
    }


def reference(x, c, positions, w_ada, b_ada, w_in, hy_conv_w, hy_conv_b, hy_f1_w, hy_f1_b, hy_f1_freq,
              hy_f2_w, hy_f2_b, hy_f2_freq, hy_f3_w, hy_bias, w_branch_hyena, w_branch_attn, w_out,
              ln1_g, ln1_b, peer_wq, peer_keys, peer_u, peer_v, ln2_g, ln2_b):
    hy_cols = (HYENA_ORDER + 1) * HYENA_WIDTH
    attn_cols = 3 * ATTN_WIDTH
    for l in range(DEPTH):
        ada = jax.nn.silu(c) @ w_ada[l] + b_ada[l]
        sh1, sc1, g1, sh2, sc2, g2 = jnp.split(ada[:, None, :], 6, axis=-1)

        u = x * (1.0 + sc1) + sh1
        proj = u @ w_in[l]
        p_h, p_qkv, p_gate = jnp.split(proj, [hy_cols, hy_cols + attn_cols], axis=-1)
        y_h = hyena_mixer(p_h, hy_conv_w[l], hy_conv_b[l], hy_f1_w[l], hy_f1_b[l], hy_f1_freq[l],
                          hy_f2_w[l], hy_f2_b[l], hy_f2_freq[l], hy_f3_w[l], hy_bias[l])
        y_a = attention_mixer(p_qkv, positions)
        gate_h, gate_a = jnp.split(jax.nn.sigmoid(p_gate), 2, axis=-1)
        merged = gate_h * (y_h @ w_branch_hyena[l]) + gate_a * (y_a @ w_branch_attn[l])
        x = layer_norm(DN_ALPHA * x + (1.0 + g1) * (merged @ w_out[l]), ln1_g[l], ln1_b[l])

        u2 = x * (1.0 + sc2) + sh2
        f = peer(u2, peer_wq[l], peer_keys[l], peer_u[l], peer_v[l])
        x = layer_norm(DN_ALPHA * x + (1.0 + g2) * f, ln2_g[l], ln2_b[l])
    return x
```

```cpp
#include <hip/hip_runtime.h>
#include <hip/hip_cooperative_groups.h>
#include <cstdio>
#include <cstdint>

#define DI __device__ __forceinline__
typedef unsigned short ushort_t;
typedef __attribute__((ext_vector_type(8))) short bf16x8;
typedef __attribute__((ext_vector_type(16))) float f32x16;
typedef __attribute__((ext_vector_type(4))) float f32x4;
typedef __attribute__((ext_vector_type(4))) unsigned u32x4;

constexpr int T_ = 16384, S_ = 8192, NB = 2, D_ = 1024;
constexpr int HW_ = 512, HYC = 1536, QKVC = 2304, GATEC = 2048, INW = 5888;
constexpr int NT = 512;
constexpr float DN_ALPHA = 1.189207115002721f;
constexpr float LN_EPS = 1e-5f;

constexpr size_t OFF_ADA   = 0;
constexpr size_t OFF_WIN_T = 65536;
constexpr size_t OFF_WQ_T  = OFF_WIN_T + (size_t)INW * 1024 * 2;
constexpr size_t OFF_WOUT_T= OFF_WQ_T + (size_t)2048 * 1024 * 2;
constexpr size_t OFF_WBH_T = OFF_WOUT_T + (size_t)1024 * 1024 * 2;
constexpr size_t OFF_WBA_T = OFF_WBH_T + (size_t)1024 * 512 * 2;
constexpr size_t OFF_PH    = OFF_WBA_T + (size_t)1024 * 256 * 2;
constexpr size_t OFF_QKV   = OFF_PH + (size_t)T_ * HYC * 2;
constexpr size_t OFF_GATE  = OFF_QKV + (size_t)T_ * QKVC * 2;
constexpr size_t OFF_YH    = OFF_GATE + (size_t)T_ * GATEC * 2;
constexpr size_t OFF_YA    = OFF_YH + (size_t)T_ * HW_ * 2;
constexpr size_t OFF_END   = OFF_YA + (size_t)T_ * 256 * 2;
constexpr size_t OFF_MERGED= OFF_PH;
constexpr size_t OFF_Q32   = OFF_QKV;
constexpr size_t OFF_IDX   = OFF_YH;
constexpr size_t OFF_GV    = OFF_YH + (size_t)T_ * 128 * 4;
static_assert(OFF_END <= 268435456ull, "ws overflow");

struct P {
  const float *x, *c; const int* pos;
  const float *w_ada, *b_ada, *w_in, *hy_conv_w, *hy_conv_b, *f1_w, *f1_b, *f1_freq, *f2_w, *f2_b, *f2_freq, *f3_w,
      *hy_bias, *w_bh, *w_ba, *w_out, *ln1_g, *ln1_b, *wq, *keys, *pu, *pv, *ln2_g, *ln2_b;
  float* out; char* ws;
};

DI ushort_t f2bf(float x) { unsigned u = __float_as_uint(x); u += 0x7fffu + ((u >> 16) & 1u); return (ushort_t)(u >> 16); }
DI float bf2f(ushort_t h) { return __uint_as_float(((unsigned)h) << 16); }
DI unsigned pack2(float a, float b) { return (unsigned)f2bf(a) | ((unsigned)f2bf(b) << 16); }
DI float wave_sum(float v) {
#pragma unroll
  for (int o = 32; o > 0; o >>= 1) v += __shfl_xor(v, o);
  return v;
}

__global__ void __launch_bounds__(256) k_ada(P p) {
  __shared__ float red[2][4][64];
  const int tid = threadIdx.x, cl = tid & 63, kq = tid >> 6;
  const int col = blockIdx.x * 64 + cl;
  float a0 = 0.f, a1 = 0.f;
  for (int k = kq * 256; k < kq * 256 + 256; ++k) {
    float w = p.w_ada[(size_t)k * 6144 + col];
    float c0 = p.c[k], c1 = p.c[1024 + k];
    a0 += (c0 / (1.f + __expf(-c0))) * w;
    a1 += (c1 / (1.f + __expf(-c1))) * w;
  }
  red[0][kq][cl] = a0; red[1][kq][cl] = a1;
  __syncthreads();
  if (tid < 128) {
    int b = tid >> 6;
    float s = red[b][0][cl] + red[b][1][cl] + red[b][2][cl] + red[b][3][cl] + p.b_ada[col];
    ((float*)(p.ws + OFF_ADA))[b * 6144 + col] = s;
  }
}

__global__ void __launch_bounds__(256) k_transpose(const float* __restrict__ W, ushort_t* __restrict__ Wt, int K, int N) {
  __shared__ float tile[32][33];
  const int tx = threadIdx.x & 31, ty = threadIdx.x >> 5;
  const int n0 = blockIdx.x * 32, k0 = blockIdx.y * 32;
  for (int i = ty; i < 32; i += 8) tile[i][tx] = W[(size_t)(k0 + i) * N + n0 + tx];
  __syncthreads();
  for (int i = ty; i < 32; i += 8) Wt[(size_t)(n0 + i) * K + k0 + tx] = f2bf(tile[tx][i]);
}

__global__ void __launch_bounds__(256) k_filter(P p) {
  __shared__ float zf[32][33];
  __shared__ float h1[32][64];
  __shared__ __attribute__((aligned(16))) float h2T[64][32];
  const int tid = threadIdx.x, t0 = blockIdx.x * 32;
  for (int idx = tid; idx < 32 * 33; idx += 256) {
    int tt = idx / 33, e = idx % 33, t = t0 + tt;
    float tl = (float)t * (1.0f / 8191.0f);
    float w = 6.283185307179586f * (float)t / 8192.0f;
    float val;
    if (e == 0) val = tl;
    else {
      int i = (e - 1) & 15;
      float f = 1e-4f + (float)i * ((15.0f - 1e-4f) / 15.0f);
      val = (e <= 16) ? cosf(f * w) : -sinf(f * w);
    }
    zf[tt][e] = val;
  }
  __syncthreads();
  for (int idx = tid; idx < 32 * 64; idx += 256) {
    int tt = idx >> 6, j = idx & 63;
    float a = p.f1_b[j];
    for (int e = 0; e < 33; ++e) a += zf[tt][e] * p.f1_w[e * 64 + j];
    h1[tt][j] = sinf(p.f1_freq[j] * a);
  }
  __syncthreads();
  for (int idx = tid; idx < 32 * 64; idx += 256) {
    int tt = idx >> 6, j = idx & 63;
    float a = p.f2_b[j];
    for (int e = 0; e < 64; ++e) a += h1[tt][e] * p.f2_w[e * 64 + j];
    h2T[j][tt] = sinf(p.f2_freq[j] * a);
  }
  __syncthreads();
  float* filt = p.out;
  const float min_decay = -3.0701134573253945f, max_decay = -15.350567286626973f;
  for (int col = tid; col < 2048; col += 256) {
    float acc[32];
#pragma unroll
    for (int i = 0; i < 32; ++i) acc[i] = 0.f;
    for (int j = 0; j < 64; ++j) {
      float w = p.f3_w[j * 2048 + col];
#pragma unroll
      for (int q = 0; q < 8; ++q) {
        f32x4 h = *(const f32x4*)&h2T[j][q * 4];
        acc[q * 4 + 0] += h[0] * w; acc[q * 4 + 1] += h[1] * w; acc[q * 4 + 2] += h[2] * w; acc[q * 4 + 3] += h[3] * w;
      }
    }
    int c = col & 511;
    float delta = fabsf(min_decay + (float)c * ((max_decay - min_decay) / 511.0f));
    float* dst = filt + (size_t)col * 8192 + t0;
#pragma unroll
    for (int q = 0; q < 8; ++q) {
      f32x4 o;
#pragma unroll
      for (int r = 0; r < 4; ++r) {
        float tl = (float)(t0 + q * 4 + r) * (1.0f / 8191.0f);
        o[r] = acc[q * 4 + r] * __expf(-tl * delta);
      }
      *(f32x4*)(dst + q * 4) = o;
    }
  }
}

constexpr int BM = 256, BN = 128, BK = 64;
constexpr int LDS_A = BM * BK * 2, LDS_B = BN * BK * 2, LDS_STAGE = LDS_A + LDS_B;
constexpr int GEMM_LDS = 2 * LDS_STAGE + 8192;

DI int swz(int row, int ch) { return row * 128 + ((ch ^ (row & 7)) << 4); }

struct ALoadBf16 {
  const ushort_t* A; int lda;
  struct Raw { u32x4 v; };
  DI Raw fetch(int row, int k) const { Raw r; r.v = *(const u32x4*)(A + (size_t)row * lda + k); return r; }
  DI u32x4 cvt(const Raw& r, int k) const { return r.v; }
};
struct ALoadF32Mod {
  const float* A; const float* mod;
  struct Raw { f32x4 a, b; };
  DI Raw fetch(int row, int k) const { Raw r; const float* s = A + (size_t)row * 1024 + k; r.a = *(const f32x4*)s; r.b = *(const f32x4*)(s + 4); return r; }
  DI u32x4 cvt(const Raw& r, int k) const {
    f32x4 s0 = *(const f32x4*)(mod + k), s1 = *(const f32x4*)(mod + k + 4);
    f32x4 h0 = *(const f32x4*)(mod + 1024 + k), h1 = *(const f32x4*)(mod + 1024 + k + 4);
    u32x4 o;
    o[0] = pack2(r.a[0] * s0[0] + h0[0], r.a[1] * s0[1] + h0[1]);
    o[1] = pack2(r.a[2] * s0[2] + h0[2], r.a[3] * s0[3] + h0[3]);
    o[2] = pack2(r.b[0] * s1[0] + h1[0], r.b[1] * s1[1] + h1[1]);
    o[3] = pack2(r.b[2] * s1[2] + h1[2], r.b[3] * s1[3] + h1[3]);
    return o;
  }
};

template <class AL>
DI void gemm_mainloop(f32x16 (&acc)[2][2], const AL& al, int m0, const ushort_t* __restrict__ Bt, int ldb, int n0, int K, char* smem) {
  const int tid = threadIdx.x, lane = tid & 63, wave = tid >> 6;
  const int wm = wave >> 1, wn = wave & 1;
  const int lr = tid >> 3, lc = tid & 7;
  typename AL::Raw ra[4]; u32x4 rb[2];
  const int nk = K / BK;
#pragma unroll
  for (int i = 0; i < 4; ++i) ra[i] = al.fetch(m0 + lr + 64 * i, lc * 8);
#pragma unroll
  for (int i = 0; i < 2; ++i) rb[i] = *(const u32x4*)(Bt + (size_t)(n0 + lr + 64 * i) * ldb + lc * 8);
  __syncthreads();
#pragma unroll
  for (int i = 0; i < 4; ++i) *(u32x4*)(smem + swz(lr + 64 * i, lc)) = al.cvt(ra[i], lc * 8);
#pragma unroll
  for (int i = 0; i < 2; ++i) *(u32x4*)(smem + LDS_A + swz(lr + 64 * i, lc)) = rb[i];
  __syncthreads();
  for (int kt = 0; kt < nk; ++kt) {
    char* cur = smem + (kt & 1) * LDS_STAGE;
    char* nxt = smem + ((kt + 1) & 1) * LDS_STAGE;
    const bool more = (kt + 1 < nk);
    const int kn = (kt + 1) * BK + lc * 8;
    if (more) {
#pragma unroll
      for (int i = 0; i < 4; ++i) ra[i] = al.fetch(m0 + lr + 64 * i, kn);
#pragma unroll
      for (int i = 0; i < 2; ++i) rb[i] = *(const u32x4*)(Bt + (size_t)(n0 + lr + 64 * i) * ldb + kn);
    }
#pragma unroll
    for (int s = 0; s < 4; ++s) {
      const int ch = 2 * s + (lane >> 5);
      bf16x8 af[2], bfr[2];
#pragma unroll
      for (int mi = 0; mi < 2; ++mi) af[mi] = *(const bf16x8*)(cur + swz(wm * 64 + mi * 32 + (lane & 31), ch));
#pragma unroll
      for (int ni = 0; ni < 2; ++ni) bfr[ni] = *(const bf16x8*)(cur + LDS_A + swz(wn * 64 + ni * 32 + (lane & 31), ch));
#pragma unroll
      for (int mi = 0; mi < 2; ++mi)
#pragma unroll
        for (int ni = 0; ni < 2; ++ni) acc[mi][ni] = __builtin_amdgcn_mfma_f32_32x32x16_bf16(af[mi], bfr[ni], acc[mi][ni], 0, 0, 0);
    }
    if (more) {
#pragma unroll
      for (int i = 0; i < 4; ++i) *(u32x4*)(nxt + swz(lr + 64 * i, lc)) = al.cvt(ra[i], kn);
#pragma unroll
      for (int i = 0; i < 2; ++i) *(u32x4*)(nxt + LDS_A + swz(lr + 64 * i, lc)) = rb[i];
    }
    __syncthreads();
  }
}
DI void acc_zero(f32x16 (&acc)[2][2]) {
#pragma unroll
  for (int a = 0; a < 2; ++a)
#pragma unroll
    for (int b = 0; b < 2; ++b)
#pragma unroll
      for (int r = 0; r < 16; ++r) acc[a][b][r] = 0.f;
}
#define ACC_ROW(mi, r) (wm * 64 + (mi) * 32 + ((r) & 3) + 8 * ((r) >> 2) + 4 * (lane >> 5))
#define ACC_COL(ni) (wn * 64 + (ni) * 32 + (lane & 31))

DI void stage_mod(float* mod, const float* ada, int b, int sc_chunk, int sh_chunk) {
  for (int i = threadIdx.x; i < 1024; i += NT) {
    mod[i] = 1.f + ada[b * 6144 + sc_chunk * 1024 + i];
    mod[1024 + i] = ada[b * 6144 + sh_chunk * 1024 + i];
  }
}

__global__ void __launch_bounds__(NT) k_inproj(P p) {
  __shared__ __attribute__((aligned(16))) char smem[GEMM_LDS];
  const float* ada = (const float*)(p.ws + OFF_ADA);
  float* mod = (float*)(smem + 2 * LDS_STAGE);
  const ushort_t* wt = (const ushort_t*)(p.ws + OFF_WIN_T);
  ushort_t* ph = (ushort_t*)(p.ws + OFF_PH);
  ushort_t* qkv = (ushort_t*)(p.ws + OFF_QKV);
  ushort_t* gate = (ushort_t*)(p.ws + OFF_GATE);
  const int tid = threadIdx.x, lane = tid & 63, wave = tid >> 6, wm = wave >> 1, wn = wave & 1;
  constexpr int NTN = INW / BN;
  constexpr int NTM = T_ / BM;
  for (int tile = blockIdx.x; tile < NTM * NTN; tile += gridDim.x) {
    const int tm = tile / NTN, tn = tile % NTN;
    const int m0 = tm * BM, n0 = tn * BN, b = m0 / S_;
    __syncthreads();
    stage_mod(mod, ada, b, 1, 0);
    __syncthreads();
    f32x16 acc[2][2]; acc_zero(acc);
    ALoadF32Mod al{p.x, mod};
    gemm_mainloop(acc, al, m0, wt, 1024, n0, 1024, smem);
#pragma unroll
    for (int ni = 0; ni < 2; ++ni) {
      const int col = n0 + ACC_COL(ni);
#pragma unroll
      for (int mi = 0; mi < 2; ++mi) {
        if (col < HYC) {
#pragma unroll
          for (int r = 0; r < 16; ++r) ph[(size_t)(m0 + ACC_ROW(mi, r)) * HYC + col] = f2bf(acc[mi][ni][r]);
        } else if (col < HYC + QKVC) {
          const int cq = col - HYC;
          const bool rot = (cq < 1536) && ((cq & 63) < 16);
          const float qs = (cq < 768) ? 0.125f : 1.0f;
          const float inv = expf(-13.122363377404328f * (float)(cq & 7) * 0.125f);
#pragma unroll
          for (int r = 0; r < 16; ++r) {
            const int row = m0 + ACC_ROW(mi, r);
            float v = acc[mi][ni][r];
            float o = __shfl_xor(v, 8);
            if (rot) {
              float ang = (float)p.pos[row] * inv;
              float sn, cs; sincosf(ang, &sn, &cs);
              v = ((cq & 15) < 8) ? (v * cs - o * sn) : (v * cs + o * sn);
            }
            qkv[(size_t)row * QKVC + cq] = f2bf(v * qs);
          }
        } else {
          const int cg = col - HYC - QKVC;
#pragma unroll
          for (int r = 0; r < 16; ++r) {
            float v = acc[mi][ni][r];
            gate[(size_t)(m0 + ACC_ROW(mi, r)) * GATEC + cg] = f2bf(1.f / (1.f + __expf(-v)));
          }
        }
      }
    }
  }
}

DI float sconv(const ushort_t* ph, int b, int t, int ch, float w0, float w1, float w2, float cb) {
  const ushort_t* base = ph + (size_t)(b * S_) * HYC + ch;
  float v = cb + w1 * bf2f(base[(size_t)t * HYC]);
  if (t > 0) v += w0 * bf2f(base[(size_t)(t - 1) * HYC]);
  if (t < S_ - 1) v += w2 * bf2f(base[(size_t)(t + 1) * HYC]);
  return v;
}
__global__ void __launch_bounds__(NT) k_hyena(P p) {
  __shared__ __attribute__((aligned(16))) float z[2][S_];
  __shared__ __attribute__((aligned(16))) float kk[2 * S_];
  const ushort_t* ph = (const ushort_t*)(p.ws + OFF_PH);
  ushort_t* yh = (ushort_t*)(p.ws + OFF_YH);
  const float* filt = p.out;
  const int tid = threadIdx.x;
  for (int c = blockIdx.x; c < HW_; c += gridDim.x) {
    __syncthreads();
    {
      const float w0 = p.hy_conv_w[c], w1 = p.hy_conv_w[HYC + c], w2 = p.hy_conv_w[2 * HYC + c], cb = p.hy_conv_b[c];
      for (int i = tid; i < 2 * S_; i += NT) { int b = i >> 13, t = i & (S_ - 1); z[b][t] = sconv(ph, b, t, c, w0, w1, w2, cb); }
    }
    for (int o = 0; o < 2; ++o) {
      const float* fw = filt + (size_t)(0 * 1024 + o * 512 + c) * S_;
      const float* bw = filt + (size_t)(1 * 1024 + o * 512 + c) * S_;
      for (int m = tid; m < S_; m += NT) { kk[S_ + m] = fw[m]; if (m > 0) kk[S_ - m] = bw[m]; }
      if (tid == 0) kk[0] = 0.f;
      __syncthreads();
      float a0[16], a1[16];
#pragma unroll
      for (int i = 0; i < 16; ++i) { a0[i] = 0.f; a1[i] = 0.f; }
      for (int s = 0; s < S_; s += 4) {
        f32x4 z0 = *(const f32x4*)&z[0][s], z1 = *(const f32x4*)&z[1][s];
#pragma unroll
        for (int u = 0; u < 4; ++u) {
          const float* kp = kk + (S_ + tid - s - u);
#pragma unroll
          for (int i = 0; i < 16; ++i) { float kv = kp[512 * i]; a0[i] += z0[u] * kv; a1[i] += z1[u] * kv; }
        }
      }
      const int gch = (o + 1) * 512 + c;
      const float w0 = p.hy_conv_w[gch], w1 = p.hy_conv_w[HYC + gch], w2 = p.hy_conv_w[2 * HYC + gch], cb = p.hy_conv_b[gch];
      const float bias = p.hy_bias[o * 512 + c];
      __syncthreads();
#pragma unroll
      for (int i = 0; i < 16; ++i) {
        const int t = tid + 512 * i;
        const float r0 = sconv(ph, 0, t, gch, w0, w1, w2, cb) * (a0[i] + bias * z[0][t]);
        const float r1 = sconv(ph, 1, t, gch, w0, w1, w2, cb) * (a1[i] + bias * z[1][t]);
        if (o == 0) { z[0][t] = r0; z[1][t] = r1; }
        else { yh[(size_t)t * HW_ + c] = f2bf(r0); yh[(size_t)(S_ + t) * HW_ + c] = f2bf(r1); }
      }
      __syncthreads();
    }
  }
}

__global__ void __launch_bounds__(NT) k_attn(P p) {
  const ushort_t* qkv = (const ushort_t*)(p.ws + OFF_QKV);
  ushort_t* ya = (ushort_t*)(p.ws + OFF_YA);
  for (int item = blockIdx.x * NT + threadIdx.x; item < T_ * 4; item += gridDim.x * NT) {
    const int hs = item / T_;
    const int tok = item % T_;
    const int b = tok / S_, t = tok % S_;
    float acc[64];
#pragma unroll
    for (int e = 0; e < 64; ++e) acc[e] = 0.f;
    float m = -1e30f, l = 0.f;
    for (int g = 0; g < 3; ++g) {
      const int dil = (g == 0) ? 1 : (g == 1 ? 4 : 16);
      const int head = g * 4 + hs;
      float q[64];
      {
        const ushort_t* qp = qkv + (size_t)tok * QKVC + head * 64;
#pragma unroll
        for (int e8 = 0; e8 < 8; ++e8) {
          u32x4 v = *(const u32x4*)(qp + e8 * 8);
#pragma unroll
          for (int w = 0; w < 4; ++w) { q[e8 * 8 + 2 * w] = __uint_as_float(v[w] << 16); q[e8 * 8 + 2 * w + 1] = __uint_as_float(v[w] & 0xffff0000u); }
        }
      }
      for (int j = -64; j <= 64; ++j) {
        const int tk = t + dil * j;
        if (tk < 0 || tk >= S_) continue;
        const ushort_t* kp = qkv + (size_t)(b * S_ + tk) * QKVC + 768 + head * 64;
        float s = 0.f;
#pragma unroll
        for (int e8 = 0; e8 < 8; ++e8) {
          u32x4 v = *(const u32x4*)(kp + e8 * 8);
#pragma unroll
          for (int w = 0; w < 4; ++w) { s += q[e8 * 8 + 2 * w] * __uint_as_float(v[w] << 16); s += q[e8 * 8 + 2 * w + 1] * __uint_as_float(v[w] & 0xffff0000u); }
        }
        const float mn = fmaxf(m, s);
        const float corr = __expf(m - mn), pe = __expf(s - mn);
        l = l * corr + pe; m = mn;
        const ushort_t* vp = kp + 768;
#pragma unroll
        for (int e8 = 0; e8 < 8; ++e8) {
          u32x4 v = *(const u32x4*)(vp + e8 * 8);
#pragma unroll
          for (int w = 0; w < 4; ++w) {
            acc[e8 * 8 + 2 * w] = acc[e8 * 8 + 2 * w] * corr + pe * __uint_as_float(v[w] << 16);
            acc[e8 * 8 + 2 * w + 1] = acc[e8 * 8 + 2 * w + 1] * corr + pe * __uint_as_float(v[w] & 0xffff0000u);
          }
        }
      }
    }
    const float il = 1.f / l;
    ushort_t* op = ya + (size_t)tok * 256 + hs * 64;
#pragma unroll
    for (int e8 = 0; e8 < 8; ++e8) {
      u32x4 o;
#pragma unroll
      for (int w = 0; w < 4; ++w) o[w] = pack2(acc[e8 * 8 + 2 * w] * il, acc[e8 * 8 + 2 * w + 1] * il);
      *(u32x4*)(op + e8 * 8) = o;
    }
  }
}

__global__ void __launch_bounds__(NT) k_merge(P p) {
  __shared__ __attribute__((aligned(16))) char smem[GEMM_LDS];
  const ushort_t* yh = (const ushort_t*)(p.ws + OFF_YH);
  const ushort_t* ya = (const ushort_t*)(p.ws + OFF_YA);
  const ushort_t* gate = (const ushort_t*)(p.ws + OFF_GATE);
  ushort_t* merged = (ushort_t*)(p.ws + OFF_MERGED);
  const int tid = threadIdx.x, lane = tid & 63, wave = tid >> 6, wm = wave >> 1, wn = wave & 1;
  constexpr int NTN = 1024 / BN, NTM = T_ / BM;
  for (int tile = blockIdx.x; tile < NTM * NTN; tile += gridDim.x) {
    const int m0 = (tile / NTN) * BM, n0 = (tile % NTN) * BN;
    f32x16 a1[2][2], a2[2][2]; acc_zero(a1); acc_zero(a2);
    ALoadBf16 l1{yh, HW_};
    gemm_mainloop(a1, l1, m0, (const ushort_t*)(p.ws + OFF_WBH_T), 512, n0, 512, smem);
    ALoadBf16 l2{ya, 256};
    gemm_mainloop(a2, l2, m0, (const ushort_t*)(p.ws + OFF_WBA_T), 256, n0, 256, smem);
#pragma unroll
    for (int mi = 0; mi < 2; ++mi)
#pragma unroll
      for (int ni = 0; ni < 2; ++ni)
#pragma unroll
        for (int r = 0; r < 16; ++r) {
          const int row = m0 + ACC_ROW(mi, r), col = n0 + ACC_COL(ni);
          float gh = bf2f(gate[(size_t)row * GATEC + col]), ga = bf2f(gate[(size_t)row * GATEC + 1024 + col]);
          merged[(size_t)row * 1024 + col] = f2bf(gh * a1[mi][ni][r] + ga * a2[mi][ni][r]);
        }
  }
}

__global__ void __launch_bounds__(NT) k_outproj(P p) {
  __shared__ __attribute__((aligned(16))) char smem[GEMM_LDS];
  const float* ada = (const float*)(p.ws + OFF_ADA);
  const ushort_t* merged = (const ushort_t*)(p.ws + OFF_MERGED);
  const int tid = threadIdx.x, lane = tid & 63, wave = tid >> 6, wm = wave >> 1, wn = wave & 1;
  constexpr int NTN = 1024 / BN, NTM = T_ / BM;
  for (int tile = blockIdx.x; tile < NTM * NTN; tile += gridDim.x) {
    const int m0 = (tile / NTN) * BM, n0 = (tile % NTN) * BN, b = m0 / S_;
    f32x16 acc[2][2]; acc_zero(acc);
    ALoadBf16 l1{merged, 1024};
    gemm_mainloop(acc, l1, m0, (const ushort_t*)(p.ws + OFF_WOUT_T), 1024, n0, 1024, smem);
#pragma unroll
    for (int ni = 0; ni < 2; ++ni) {
      const int col = n0 + ACC_COL(ni);
      const float g1 = 1.f + ada[b * 6144 + 2 * 1024 + col];
#pragma unroll
      for (int mi = 0; mi < 2; ++mi)
#pragma unroll
        for (int r = 0; r < 16; ++r) {
          const size_t o = (size_t)(m0 + ACC_ROW(mi, r)) * 1024 + col;
          p.out[o] = DN_ALPHA * p.x[o] + g1 * acc[mi][ni][r];
        }
    }
  }
}

__global__ void __launch_bounds__(NT) k_ln(float* __restrict__ xio, const float* __restrict__ g, const float* __restrict__ bta) {
  const int lane = threadIdx.x & 63, wave = threadIdx.x >> 6;
  for (int row = blockIdx.x * 8 + wave; row < T_; row += gridDim.x * 8) {
    float* rp = xio + (size_t)row * 1024;
    f32x4 v[4];
    float s = 0.f;
#pragma unroll
    for (int i = 0; i < 4; ++i) { v[i] = *(const f32x4*)(rp + i * 256 + lane * 4); s += v[i][0] + v[i][1] + v[i][2] + v[i][3]; }
    const float mu = wave_sum(s) * (1.f / 1024.f);
    float q = 0.f;
#pragma unroll
    for (int i = 0; i < 4; ++i)
#pragma unroll
      for (int j = 0; j < 4; ++j) { float d = v[i][j] - mu; q += d * d; }
    const float rs = rsqrtf(wave_sum(q) * (1.f / 1024.f) + LN_EPS);
#pragma unroll
    for (int i = 0; i < 4; ++i) {
      f32x4 gg = *(const f32x4*)(g + i * 256 + lane * 4), bb = *(const f32x4*)(bta + i * 256 + lane * 4), o;
#pragma unroll
      for (int j = 0; j < 4; ++j) o[j] = (v[i][j] - mu) * rs * gg[j] + bb[j];
      *(f32x4*)(rp + i * 256 + lane * 4) = o;
    }
  }
}

__global__ void __launch_bounds__(NT) k_peerq(P p) {
  __shared__ __attribute__((aligned(16))) char smem[GEMM_LDS];
  const float* ada = (const float*)(p.ws + OFF_ADA);
  float* mod = (float*)(smem + 2 * LDS_STAGE);
  float* q32 = (float*)(p.ws + OFF_Q32);
  const int tid = threadIdx.x, lane = tid & 63, wave = tid >> 6, wm = wave >> 1, wn = wave & 1;
  constexpr int NTN = 2048 / BN, NTM = T_ / BM;
  for (int tile = blockIdx.x; tile < NTM * NTN; tile += gridDim.x) {
    const int m0 = (tile / NTN) * BM, n0 = (tile % NTN) * BN, b = m0 / S_;
    __syncthreads();
    stage_mod(mod, ada, b, 4, 3);
    __syncthreads();
    f32x16 acc[2][2]; acc_zero(acc);
    ALoadF32Mod al{p.out, mod};
    gemm_mainloop(acc, al, m0, (const ushort_t*)(p.ws + OFF_WQ_T), 1024, n0, 1024, smem);
#pragma unroll
    for (int mi = 0; mi < 2; ++mi)
#pragma unroll
      for (int ni = 0; ni < 2; ++ni)
#pragma unroll
        for (int r = 0; r < 16; ++r) q32[(size_t)(m0 + ACC_ROW(mi, r)) * 2048 + n0 + ACC_COL(ni)] = acc[mi][ni][r];
  }
}

__global__ void __launch_bounds__(NT) k_topk(P p) {
  __shared__ __attribute__((aligned(16))) float sq[8][256];
  __shared__ __attribute__((aligned(16))) float ssc[8][2][128];
  __shared__ __attribute__((aligned(16))) float scand[8][256];
  __shared__ float ssv[8][2][16];
  __shared__ int ssi[8][2][16];
  const float* q32 = (const float*)(p.ws + OFF_Q32);
  int* idx = (int*)(p.ws + OFF_IDX);
  float* gv = (float*)(p.ws + OFF_GV);
  const int lane = threadIdx.x & 63, h = threadIdx.x >> 6;
  for (int tok = blockIdx.x; tok < T_; tok += gridDim.x) {
    __syncthreads();
    {
      const float* qp = q32 + (size_t)tok * 2048 + h * 256;
      *(f32x4*)&sq[h][lane * 4] = *(const f32x4*)(qp + lane * 4);
    }
    __syncthreads();
#pragma unroll
    for (int pp = 0; pp < 2; ++pp)
#pragma unroll
      for (int half = 0; half < 2; ++half) {
        const int k = lane + 64 * half;
        const float* kp = p.keys + ((size_t)((h * 2 + pp) * 128 + k)) * 128;
        float s = 0.f;
#pragma unroll 8
        for (int e4 = 0; e4 < 32; ++e4) {
          f32x4 kv = *(const f32x4*)(kp + e4 * 4);
          f32x4 qv = *(const f32x4*)&sq[h][pp * 128 + e4 * 4];
          s += kv[0] * qv[0] + kv[1] * qv[1] + kv[2] * qv[2] + kv[3] * qv[3];
        }
        ssc[h][pp][k] = s;
      }
    __syncthreads();
#pragma unroll
    for (int pp = 0; pp < 2; ++pp) {
      const float va = ssc[h][pp][lane], vb = ssc[h][pp][lane + 64];
      int ra = 0, rb = 0;
      for (int j4 = 0; j4 < 32; ++j4) {
        f32x4 o = *(const f32x4*)&ssc[h][pp][j4 * 4];
#pragma unroll
        for (int u = 0; u < 4; ++u) {
          const int j = j4 * 4 + u;
          ra += (o[u] > va || (o[u] == va && j < lane)) ? 1 : 0;
          rb += (o[u] > vb || (o[u] == vb && j < lane + 64)) ? 1 : 0;
        }
      }
      if (ra < 16) { ssv[h][pp][ra] = va; ssi[h][pp][ra] = lane; }
      if (rb < 16) { ssv[h][pp][rb] = vb; ssi[h][pp][rb] = lane + 64; }
    }
    __syncthreads();
    float cv[4];
#pragma unroll
    for (int u = 0; u < 4; ++u) { const int ci = lane + 64 * u; cv[u] = ssv[h][0][ci >> 4] + ssv[h][1][ci & 15]; scand[h][ci] = cv[u]; }
    __syncthreads();
    int rk[4] = {0, 0, 0, 0};
    for (int j4 = 0; j4 < 64; ++j4) {
      f32x4 o = *(const f32x4*)&scand[h][j4 * 4];
#pragma unroll
      for (int w = 0; w < 4; ++w) {
        const int j = j4 * 4 + w;
#pragma unroll
        for (int u = 0; u < 4; ++u) rk[u] += (o[w] > cv[u] || (o[w] == cv[u] && j < lane + 64 * u)) ? 1 : 0;
      }
    }
    __syncthreads();
#pragma unroll
    for (int u = 0; u < 4; ++u)
      if (rk[u] < 16) {
        const int ci = lane + 64 * u;
        ssc[h][0][rk[u]] = cv[u];
        ssc[h][1][rk[u]] = __int_as_float(ssi[h][0][ci >> 4] * 128 + ssi[h][1][ci & 15]);
      }
    __syncthreads();
    {
      const float v = ssc[h][0][lane & 15];
      const float mx = ssc[h][0][0];
      float e = __expf(v - mx);
      float s = e;
#pragma unroll
      for (int o = 8; o > 0; o >>= 1) s += __shfl_xor(s, o);
      if (lane < 16) {
        idx[(size_t)tok * 128 + h * 16 + lane] = __float_as_int(ssc[h][1][lane]);
        gv[(size_t)tok * 128 + h * 16 + lane] = e / s;
      }
    }
  }
}

__global__ void __launch_bounds__(NT) k_peer(P p) {
  const float* ada = (const float*)(p.ws + OFF_ADA);
  const int* idx = (const int*)(p.ws + OFF_IDX);
  const float* gv = (const float*)(p.ws + OFF_GV);
  const int lane = threadIdx.x & 63, wave = threadIdx.x >> 6;
  for (int tok = blockIdx.x * 8 + wave; tok < T_; tok += gridDim.x * 8) {
    const int b = tok / S_;
    float* rp = p.out + (size_t)tok * 1024;
    f32x4 x1[4], u2[4], acc[4];
#pragma unroll
    for (int i = 0; i < 4; ++i) {
      const int col = i * 256 + lane * 4;
      x1[i] = *(const f32x4*)(rp + col);
      f32x4 sc = *(const f32x4*)(ada + b * 6144 + 4 * 1024 + col), sh = *(const f32x4*)(ada + b * 6144 + 3 * 1024 + col);
#pragma unroll
      for (int j = 0; j < 4; ++j) { u2[i][j] = x1[i][j] * (1.f + sc[j]) + sh[j]; acc[i][j] = 0.f; }
    }
    for (int s = 0; s < 128; ++s) {
      const int e = __builtin_amdgcn_readfirstlane(idx[(size_t)tok * 128 + s]);
      const float g = gv[(size_t)tok * 128 + s];
      const float* ur = p.pu + (size_t)e * 1024;
      const float* vr = p.pv + (size_t)e * 1024;
      float d = 0.f;
#pragma unroll
      for (int i = 0; i < 4; ++i) {
        f32x4 u = *(const f32x4*)(ur + i * 256 + lane * 4);
        d += u[0] * u2[i][0] + u[1] * u2[i][1] + u[2] * u2[i][2] + u[3] * u2[i][3];
      }
      const float a = wave_sum(d);
      const float coef = g * 0.5f * a * (1.f + erff(a * 0.7071067811865475f));
#pragma unroll
      for (int i = 0; i < 4; ++i) {
        f32x4 v = *(const f32x4*)(vr + i * 256 + lane * 4);
#pragma unroll
        for (int j = 0; j < 4; ++j) acc[i][j] += coef * v[j];
      }
    }
    float sm = 0.f;
#pragma unroll
    for (int i = 0; i < 4; ++i) {
      const int col = i * 256 + lane * 4;
      f32x4 g2 = *(const f32x4*)(ada + b * 6144 + 5 * 1024 + col);
#pragma unroll
      for (int j = 0; j < 4; ++j) { acc[i][j] = DN_ALPHA * x1[i][j] + (1.f + g2[j]) * acc[i][j]; sm += acc[i][j]; }
    }
    const float mu = wave_sum(sm) * (1.f / 1024.f);
    float q = 0.f;
#pragma unroll
    for (int i = 0; i < 4; ++i)
#pragma unroll
      for (int j = 0; j < 4; ++j) { float d = acc[i][j] - mu; q += d * d; }
    const float rs = rsqrtf(wave_sum(q) * (1.f / 1024.f) + LN_EPS);
#pragma unroll
    for (int i = 0; i < 4; ++i) {
      const int col = i * 256 + lane * 4;
      f32x4 gg = *(const f32x4*)(p.ln2_g + col), bb = *(const f32x4*)(p.ln2_b + col), o;
#pragma unroll
      for (int j = 0; j < 4; ++j) o[j] = (acc[i][j] - mu) * rs * gg[j] + bb[j];
      *(f32x4*)(rp + col) = o;
    }
  }
}

extern "C" void kernel_launch(void* const* d_in, const int* in_sizes, int n_in, void* d_out, int out_size, void* d_ws, size_t ws_size,
                              hipStream_t stream) {
  P p{};
  p.x = (const float*)d_in[0]; p.c = (const float*)d_in[1]; p.pos = (const int*)d_in[2];
  p.w_ada = (const float*)d_in[3]; p.b_ada = (const float*)d_in[4]; p.w_in = (const float*)d_in[5];
  p.hy_conv_w = (const float*)d_in[6]; p.hy_conv_b = (const float*)d_in[7];
  p.f1_w = (const float*)d_in[8]; p.f1_b = (const float*)d_in[9]; p.f1_freq = (const float*)d_in[10];
  p.f2_w = (const float*)d_in[11]; p.f2_b = (const float*)d_in[12]; p.f2_freq = (const float*)d_in[13];
  p.f3_w = (const float*)d_in[14]; p.hy_bias = (const float*)d_in[15];
  p.w_bh = (const float*)d_in[16]; p.w_ba = (const float*)d_in[17]; p.w_out = (const float*)d_in[18];
  p.ln1_g = (const float*)d_in[19]; p.ln1_b = (const float*)d_in[20];
  p.wq = (const float*)d_in[21]; p.keys = (const float*)d_in[22]; p.pu = (const float*)d_in[23]; p.pv = (const float*)d_in[24];
  p.ln2_g = (const float*)d_in[25]; p.ln2_b = (const float*)d_in[26];
  p.out = (float*)d_out; p.ws = (char*)d_ws;
  char* ws = (char*)d_ws;

  k_ada<<<96, 256, 0, stream>>>(p);
  k_transpose<<<dim3(INW / 32, 1024 / 32), 256, 0, stream>>>(p.w_in, (ushort_t*)(ws + OFF_WIN_T), 1024, INW);
  k_transpose<<<dim3(2048 / 32, 1024 / 32), 256, 0, stream>>>(p.wq, (ushort_t*)(ws + OFF_WQ_T), 1024, 2048);
  k_transpose<<<dim3(1024 / 32, 1024 / 32), 256, 0, stream>>>(p.w_out, (ushort_t*)(ws + OFF_WOUT_T), 1024, 1024);
  k_transpose<<<dim3(1024 / 32, 512 / 32), 256, 0, stream>>>(p.w_bh, (ushort_t*)(ws + OFF_WBH_T), 512, 1024);
  k_transpose<<<dim3(1024 / 32, 256 / 32), 256, 0, stream>>>(p.w_ba, (ushort_t*)(ws + OFF_WBA_T), 256, 1024);
  k_filter<<<256, 256, 0, stream>>>(p);
  k_inproj<<<1024, NT, 0, stream>>>(p);
  k_hyena<<<512, NT, 0, stream>>>(p);
  k_attn<<<128, NT, 0, stream>>>(p);
  k_merge<<<512, NT, 0, stream>>>(p);
  k_outproj<<<512, NT, 0, stream>>>(p);
  k_ln<<<2048, NT, 0, stream>>>(p.out, p.ln1_g, p.ln1_b);
  k_peerq<<<1024, NT, 0, stream>>>(p);
  k_topk<<<4096, NT, 0, stream>>>(p);
  k_peer<<<2048, NT, 0, stream>>>(p);
}
```

```cpp
#include <hip/hip_runtime.h>
#include <hip/hip_cooperative_groups.h>
#include <cstdio>
#include <cstdint>

#define DI __device__ __forceinline__
typedef unsigned short ushort_t;
typedef __attribute__((ext_vector_type(8))) short bf16x8;
typedef __attribute__((ext_vector_type(16))) float f32x16;
typedef __attribute__((ext_vector_type(4))) float f32x4;
typedef __attribute__((ext_vector_type(4))) unsigned u32x4;

constexpr int T_ = 16384, S_ = 8192, NB = 2, D_ = 1024;
constexpr int HW_ = 512, HYC = 1536, QKVC = 2304, GATEC = 2048, INW = 5888;
constexpr int NT = 512;
constexpr float DN_ALPHA = 1.189207115002721f;
constexpr float LN_EPS = 1e-5f;

constexpr size_t OFF_ADA   = 0;
constexpr size_t OFF_WIN_T = 65536;
constexpr size_t OFF_WQ_T  = OFF_WIN_T + (size_t)INW * 1024 * 2;
constexpr size_t OFF_WOUT_T= OFF_WQ_T + (size_t)2048 * 1024 * 2;
constexpr size_t OFF_WBH_T = OFF_WOUT_T + (size_t)1024 * 1024 * 2;
constexpr size_t OFF_WBA_T = OFF_WBH_T + (size_t)1024 * 512 * 2;
constexpr size_t OFF_PH    = OFF_WBA_T + (size_t)1024 * 256 * 2;
constexpr size_t OFF_QKV   = OFF_PH + (size_t)T_ * HYC * 2;
constexpr size_t OFF_GATE  = OFF_QKV + (size_t)T_ * QKVC * 2;
constexpr size_t OFF_YH    = OFF_GATE + (size_t)T_ * GATEC * 2;
constexpr size_t OFF_YA    = OFF_YH + (size_t)T_ * HW_ * 2;
constexpr size_t OFF_END   = OFF_YA + (size_t)T_ * 256 * 2;
constexpr size_t OFF_MERGED= OFF_PH;
constexpr size_t OFF_Q32   = OFF_QKV;
constexpr size_t OFF_IDX   = OFF_YH;
constexpr size_t OFF_GV    = OFF_YH + (size_t)T_ * 128 * 4;
static_assert(OFF_END <= 268435456ull, "ws overflow");

struct P {
  const float *x, *c; const int* pos;
  const float *w_ada, *b_ada, *w_in, *hy_conv_w, *hy_conv_b, *f1_w, *f1_b, *f1_freq, *f2_w, *f2_b, *f2_freq, *f3_w,
      *hy_bias, *w_bh, *w_ba, *w_out, *ln1_g, *ln1_b, *wq, *keys, *pu, *pv, *ln2_g, *ln2_b;
  float* out; char* ws;
};

DI ushort_t f2bf(float x) { unsigned u = __float_as_uint(x); u += 0x7fffu + ((u >> 16) & 1u); return (ushort_t)(u >> 16); }
DI float bf2f(ushort_t h) { return __uint_as_float(((unsigned)h) << 16); }
DI unsigned pack2(float a, float b) { return (unsigned)f2bf(a) | ((unsigned)f2bf(b) << 16); }
DI int tid_opaque() { int t = threadIdx.x; asm volatile("" : "+v"(t)); return t; }
DI float wave_sum(float v) {
#pragma unroll
  for (int o = 32; o > 0; o >>= 1) v += __shfl_xor(v, o);
  return v;
}

DI void phase_ada(const P& p, char* smem) {
  float (*red)[8][64] = (float (*)[8][64])smem;
  const int tid = tid_opaque(), cl = tid & 63, kq = tid >> 6;
  for (int item = blockIdx.x; item < 96; item += gridDim.x) {
    const int col = item * 64 + cl;
    float a0 = 0.f, a1 = 0.f;
    for (int k = kq * 128; k < kq * 128 + 128; ++k) {
      float w = p.w_ada[(size_t)k * 6144 + col];
      float c0 = p.c[k], c1 = p.c[1024 + k];
      a0 += (c0 / (1.f + __expf(-c0))) * w;
      a1 += (c1 / (1.f + __expf(-c1))) * w;
    }
    __syncthreads();
    red[0][kq][cl] = a0; red[1][kq][cl] = a1;
    __syncthreads();
    if (tid < 128) {
      int b = tid >> 6;
      float s = p.b_ada[col];
#pragma unroll
      for (int q = 0; q < 8; ++q) s += red[b][q][cl];
      ((float*)(p.ws + OFF_ADA))[b * 6144 + col] = s;
    }
  }
}

DI void transpose_tile(const float* __restrict__ W, ushort_t* __restrict__ Wt, int K, int N, int item, char* smem) {
  float (*tile)[65] = (float (*)[65])smem;
  const int ntn = N / 64;
  const int n0 = (item % ntn) * 64, k0 = (item / ntn) * 32;
  const int tid = tid_opaque();
  __syncthreads();
  {
    const int tx = tid & 63, ty = tid >> 6;
#pragma unroll
    for (int i = 0; i < 4; ++i) tile[ty + 8 * i][tx] = W[(size_t)(k0 + ty + 8 * i) * N + n0 + tx];
  }
  __syncthreads();
  {
    const int kk = tid & 31, nn0 = tid >> 5;
#pragma unroll
    for (int i = 0; i < 4; ++i) Wt[(size_t)(n0 + nn0 + 16 * i) * K + k0 + kk] = f2bf(tile[kk][nn0 + 16 * i]);
  }
}
DI void phase_transposes(const P& p, char* smem) {
  constexpr int I0 = (INW / 64) * 32, I1 = I0 + 32 * 32, I2 = I1 + 16 * 32, I3 = I2 + 16 * 16, I4 = I3 + 16 * 8;
  for (int item = blockIdx.x; item < I4; item += gridDim.x) {
    if (item < I0) transpose_tile(p.w_in, (ushort_t*)(p.ws + OFF_WIN_T), 1024, INW, item, smem);
    else if (item < I1) transpose_tile(p.wq, (ushort_t*)(p.ws + OFF_WQ_T), 1024, 2048, item - I0, smem);
    else if (item < I2) transpose_tile(p.w_out, (ushort_t*)(p.ws + OFF_WOUT_T), 1024, 1024, item - I1, smem);
    else if (item < I3) transpose_tile(p.w_bh, (ushort_t*)(p.ws + OFF_WBH_T), 512, 1024, item - I2, smem);
    else transpose_tile(p.w_ba, (ushort_t*)(p.ws + OFF_WBA_T), 256, 1024, item - I3, smem);
  }
}

DI void phase_filter(const P& p, char* smem) {
  float (*zf)[33] = (float (*)[33])smem;
  float (*h1)[64] = (float (*)[64])(smem + 4352);
  float (*h2T)[32] = (float (*)[32])(smem + 4352 + 8192);
  const int tid = tid_opaque();
  for (int item = blockIdx.x; item < 256; item += gridDim.x) {
  const int t0 = item * 32;
  __syncthreads();
  for (int idx = tid; idx < 32 * 33; idx += NT) {
    int tt = idx / 33, e = idx % 33, t = t0 + tt;
    float tl = (float)t * (1.0f / 8191.0f);
    float w = 6.283185307179586f * (float)t / 8192.0f;
    float val;
    if (e == 0) val = tl;
    else {
      int i = (e - 1) & 15;
      float f = 1e-4f + (float)i * ((15.0f - 1e-4f) / 15.0f);
      val = (e <= 16) ? cosf(f * w) : -sinf(f * w);
    }
    zf[tt][e] = val;
  }
  __syncthreads();
  for (int idx = tid; idx < 32 * 64; idx += NT) {
    int tt = idx >> 6, j = idx & 63;
    float a = p.f1_b[j];
    for (int e = 0; e < 33; ++e) a += zf[tt][e] * p.f1_w[e * 64 + j];
    h1[tt][j] = sinf(p.f1_freq[j] * a);
  }
  __syncthreads();
  for (int idx = tid; idx < 32 * 64; idx += NT) {
    int tt = idx >> 6, j = idx & 63;
    float a = p.f2_b[j];
    for (int e = 0; e < 64; ++e) a += h1[tt][e] * p.f2_w[e * 64 + j];
    h2T[j][tt] = sinf(p.f2_freq[j] * a);
  }
  __syncthreads();
  float* filt = p.out;
  const float min_decay = -3.0701134573253945f, max_decay = -15.350567286626973f;
  for (int col = tid; col < 2048; col += NT) {
    float acc[32];
#pragma unroll
    for (int i = 0; i < 32; ++i) acc[i] = 0.f;
    for (int j = 0; j < 64; ++j) {
      float w = p.f3_w[j * 2048 + col];
#pragma unroll
      for (int q = 0; q < 8; ++q) {
        f32x4 h = *(const f32x4*)&h2T[j][q * 4];
        acc[q * 4 + 0] += h[0] * w; acc[q * 4 + 1] += h[1] * w; acc[q * 4 + 2] += h[2] * w; acc[q * 4 + 3] += h[3] * w;
      }
    }
    int c = col & 511;
    float delta = fabsf(min_decay + (float)c * ((max_decay - min_decay) / 511.0f));
    float* dst = filt + (size_t)col * 8192 + t0;
#pragma unroll
    for (int q = 0; q < 8; ++q) {
      f32x4 o;
#pragma unroll
      for (int r = 0; r < 4; ++r) {
        float tl = (float)(t0 + q * 4 + r) * (1.0f / 8191.0f);
        o[r] = acc[q * 4 + r] * __expf(-tl * delta);
      }
      *(f32x4*)(dst + q * 4) = o;
    }
  }
  }
}

constexpr int BM = 256, BN = 128, BK = 64;
constexpr int LDS_A = BM * BK * 2, LDS_B = BN * BK * 2, LDS_STAGE = LDS_A + LDS_B;
constexpr int GEMM_LDS = 2 * LDS_STAGE + 8192;

DI int swz(int row, int ch) { return row * 128 + ((ch ^ (row & 7)) << 4); }

struct ALoadBf16 {
  const ushort_t* A; int lda;
  struct Raw { u32x4 v; };
  DI Raw fetch(int row, int k) const { Raw r; r.v = *(const u32x4*)(A + (size_t)row * lda + k); return r; }
  DI u32x4 cvt(const Raw& r, int k) const { return r.v; }
};
struct ALoadF32Mod {
  const float* A; const float* mod;
  struct Raw { f32x4 a, b; };
  DI Raw fetch(int row, int k) const { Raw r; const float* s = A + (size_t)row * 1024 + k; r.a = *(const f32x4*)s; r.b = *(const f32x4*)(s + 4); return r; }
  DI u32x4 cvt(const Raw& r, int k) const {
    f32x4 s0 = *(const f32x4*)(mod + k), s1 = *(const f32x4*)(mod + k + 4);
    f32x4 h0 = *(const f32x4*)(mod + 1024 + k), h1 = *(const f32x4*)(mod + 1024 + k + 4);
    u32x4 o;
    o[0] = pack2(r.a[0] * s0[0] + h0[0], r.a[1] * s0[1] + h0[1]);
    o[1] = pack2(r.a[2] * s0[2] + h0[2], r.a[3] * s0[3] + h0[3]);
    o[2] = pack2(r.b[0] * s1[0] + h1[0], r.b[1] * s1[1] + h1[1]);
    o[3] = pack2(r.b[2] * s1[2] + h1[2], r.b[3] * s1[3] + h1[3]);
    return o;
  }
};

template <class AL>
DI void gemm_mainloop(f32x16 (&acc)[2][2], const AL& al, int m0, const ushort_t* __restrict__ Bt, int ldb, int n0, int K, char* smem) {
  const int tid = tid_opaque(), lane = tid & 63, wave = tid >> 6;
  const int wm = wave >> 1, wn = wave & 1;
  const int lr = tid >> 3, lc = tid & 7;
  typename AL::Raw ra[4]; u32x4 rb[2];
  const int nk = K / BK;
#pragma unroll
  for (int i = 0; i < 4; ++i) ra[i] = al.fetch(m0 + lr + 64 * i, lc * 8);
#pragma unroll
  for (int i = 0; i < 2; ++i) rb[i] = *(const u32x4*)(Bt + (size_t)(n0 + lr + 64 * i) * ldb + lc * 8);
  __syncthreads();
#pragma unroll
  for (int i = 0; i < 4; ++i) *(u32x4*)(smem + swz(lr + 64 * i, lc)) = al.cvt(ra[i], lc * 8);
#pragma unroll
  for (int i = 0; i < 2; ++i) *(u32x4*)(smem + LDS_A + swz(lr + 64 * i, lc)) = rb[i];
  __syncthreads();
  for (int kt = 0; kt < nk; ++kt) {
    char* cur = smem + (kt & 1) * LDS_STAGE;
    char* nxt = smem + ((kt + 1) & 1) * LDS_STAGE;
    const bool more = (kt + 1 < nk);
    const int kn = (kt + 1) * BK + lc * 8;
    if (more) {
#pragma unroll
      for (int i = 0; i < 4; ++i) ra[i] = al.fetch(m0 + lr + 64 * i, kn);
#pragma unroll
      for (int i = 0; i < 2; ++i) rb[i] = *(const u32x4*)(Bt + (size_t)(n0 + lr + 64 * i) * ldb + kn);
    }
#pragma unroll
    for (int s = 0; s < 4; ++s) {
      const int ch = 2 * s + (lane >> 5);
      bf16x8 af[2], bfr[2];
#pragma unroll
      for (int mi = 0; mi < 2; ++mi) af[mi] = *(const bf16x8*)(cur + swz(wm * 64 + mi * 32 + (lane & 31), ch));
#pragma unroll
      for (int ni = 0; ni < 2; ++ni) bfr[ni] = *(const bf16x8*)(cur + LDS_A + swz(wn * 64 + ni * 32 + (lane & 31), ch));
#pragma unroll
      for (int mi = 0; mi < 2; ++mi)
#pragma unroll
        for (int ni = 0; ni < 2; ++ni) acc[mi][ni] = __builtin_amdgcn_mfma_f32_32x32x16_bf16(af[mi], bfr[ni], acc[mi][ni], 0, 0, 0);
    }
    if (more) {
#pragma unroll
      for (int i = 0; i < 4; ++i) *(u32x4*)(nxt + swz(lr + 64 * i, lc)) = al.cvt(ra[i], kn);
#pragma unroll
      for (int i = 0; i < 2; ++i) *(u32x4*)(nxt + LDS_A + swz(lr + 64 * i, lc)) = rb[i];
    }
    __syncthreads();
  }
}
DI void acc_zero(f32x16 (&acc)[2][2]) {
#pragma unroll
  for (int a = 0; a < 2; ++a)
#pragma unroll
    for (int b = 0; b < 2; ++b)
#pragma unroll
      for (int r = 0; r < 16; ++r) acc[a][b][r] = 0.f;
}
#define ACC_ROW(mi, r) (wm * 64 + (mi) * 32 + ((r) & 3) + 8 * ((r) >> 2) + 4 * (lane >> 5))
#define ACC_COL(ni) (wn * 64 + (ni) * 32 + (lane & 31))

DI void stage_mod(float* mod, const float* ada, int b, int sc_chunk, int sh_chunk) {
  for (int i = tid_opaque(); i < 1024; i += NT) {
    mod[i] = 1.f + ada[b * 6144 + sc_chunk * 1024 + i];
    mod[1024 + i] = ada[b * 6144 + sh_chunk * 1024 + i];
  }
}

DI void phase_inproj(const P& p, char* smem) {
  const float* ada = (const float*)(p.ws + OFF_ADA);
  float* mod = (float*)(smem + 2 * LDS_STAGE);
  const ushort_t* wt = (const ushort_t*)(p.ws + OFF_WIN_T);
  ushort_t* ph = (ushort_t*)(p.ws + OFF_PH);
  ushort_t* qkv = (ushort_t*)(p.ws + OFF_QKV);
  ushort_t* gate = (ushort_t*)(p.ws + OFF_GATE);
  const int tid = tid_opaque(), lane = tid & 63, wave = tid >> 6, wm = wave >> 1, wn = wave & 1;
  constexpr int NTN = INW / BN;
  constexpr int NTM = T_ / BM;
  for (int tile = blockIdx.x; tile < NTM * NTN; tile += gridDim.x) {
    const int tm = tile / NTN, tn = tile % NTN;
    const int m0 = tm * BM, n0 = tn * BN, b = m0 / S_;
    __syncthreads();
    stage_mod(mod, ada, b, 1, 0);
    __syncthreads();
    f32x16 acc[2][2]; acc_zero(acc);
    ALoadF32Mod al{p.x, mod};
    gemm_mainloop(acc, al, m0, wt, 1024, n0, 1024, smem);
#pragma unroll
    for (int ni = 0; ni < 2; ++ni) {
      const int col = n0 + ACC_COL(ni);
#pragma unroll
      for (int mi = 0; mi < 2; ++mi) {
        if (col < HYC) {
#pragma unroll
          for (int r = 0; r < 16; ++r) ph[(size_t)(m0 + ACC_ROW(mi, r)) * HYC + col] = f2bf(acc[mi][ni][r]);
        } else if (col < HYC + QKVC) {
          const int cq = col - HYC;
          const bool rot = (cq < 1536) && ((cq & 63) < 16);
          const float qs = (cq < 768) ? 0.125f : 1.0f;
          const float inv = expf(-13.122363377404328f * (float)(cq & 7) * 0.125f);
#pragma unroll
          for (int r = 0; r < 16; ++r) {
            const int row = m0 + ACC_ROW(mi, r);
            float v = acc[mi][ni][r];
            float o = __shfl_xor(v, 8);
            if (rot) {
              float ang = (float)p.pos[row] * inv;
              float sn, cs; sincosf(ang, &sn, &cs);
              v = ((cq & 15) < 8) ? (v * cs - o * sn) : (v * cs + o * sn);
            }
            qkv[(size_t)row * QKVC + cq] = f2bf(v * qs);
          }
        } else {
          const int cg = col - HYC - QKVC;
#pragma unroll
          for (int r = 0; r < 16; ++r) {
            float v = acc[mi][ni][r];
            gate[(size_t)(m0 + ACC_ROW(mi, r)) * GATEC + cg] = f2bf(1.f / (1.f + __expf(-v)));
          }
        }
      }
    }
  }
}

DI float sconv(const ushort_t* ph, int b, int t, int ch, float w0, float w1, float w2, float cb) {
  const ushort_t* base = ph + (size_t)(b * S_) * HYC + ch;
  float v = cb + w1 * bf2f(base[(size_t)t * HYC]);
  if (t > 0) v += w0 * bf2f(base[(size_t)(t - 1) * HYC]);
  if (t < S_ - 1) v += w2 * bf2f(base[(size_t)(t + 1) * HYC]);
  return v;
}
DI void hyena_item(const P& p, char* smem, int c) {
  float (*z)[S_] = (float (*)[S_])smem;
  float* kk = (float*)(smem + 65536);
  const ushort_t* ph = (const ushort_t*)(p.ws + OFF_PH);
  ushort_t* yh = (ushort_t*)(p.ws + OFF_YH);
  const float* filt = p.out;
  int tid = threadIdx.x;
  asm volatile("" : "+v"(tid));
  {
    __syncthreads();
    {
      const float w0 = p.hy_conv_w[c], w1 = p.hy_conv_w[HYC + c], w2 = p.hy_conv_w[2 * HYC + c], cb = p.hy_conv_b[c];
      for (int i = tid; i < 2 * S_; i += NT) { int b = i >> 13, t = i & (S_ - 1); z[b][t] = sconv(ph, b, t, c, w0, w1, w2, cb); }
    }
    for (int o = 0; o < 2; ++o) {
      const float* fw = filt + (size_t)(0 * 1024 + o * 512 + c) * S_;
      const float* bw = filt + (size_t)(1 * 1024 + o * 512 + c) * S_;
      for (int m = tid; m < S_; m += NT) { kk[S_ + m] = fw[m]; if (m > 0) kk[S_ - m] = bw[m]; }
      if (tid == 0) kk[0] = 0.f;
      __syncthreads();
      float a0[16], a1[16];
#pragma unroll
      for (int i = 0; i < 16; ++i) { a0[i] = 0.f; a1[i] = 0.f; }
#pragma unroll 1
      for (int s = 0; s < S_; s += 2) {
        const float z0[2] = {z[0][s], z[0][s + 1]}, z1[2] = {z[1][s], z[1][s + 1]};
#pragma unroll
        for (int u = 0; u < 2; ++u) {
          const float* kp = kk + (S_ + tid - s - u);
#pragma unroll
          for (int i = 0; i < 16; ++i) { float kv = kp[512 * i]; a0[i] += z0[u] * kv; a1[i] += z1[u] * kv; }
        }
      }
      const int gch = (o + 1) * 512 + c;
      const float w0 = p.hy_conv_w[gch], w1 = p.hy_conv_w[HYC + gch], w2 = p.hy_conv_w[2 * HYC + gch], cb = p.hy_conv_b[gch];
      const float bias = p.hy_bias[o * 512 + c];
      __syncthreads();
      int tg = tid;
      asm volatile("" : "+v"(tg));
#pragma unroll
      for (int i = 0; i < 16; ++i) {
        const int t = tg + 512 * i;
        const float r0 = sconv(ph, 0, t, gch, w0, w1, w2, cb) * (a0[i] + bias * z[0][t]);
        const float r1 = sconv(ph, 1, t, gch, w0, w1, w2, cb) * (a1[i] + bias * z[1][t]);
        if (o == 0) { z[0][t] = r0; z[1][t] = r1; }
        else { yh[(size_t)t * HW_ + c] = f2bf(r0); yh[(size_t)(S_ + t) * HW_ + c] = f2bf(r1); }
        asm volatile("" ::: "memory");
      }
      __syncthreads();
    }
  }
}

DI void attn_item(const P& p, int item) {
  const ushort_t* qkv = (const ushort_t*)(p.ws + OFF_QKV);
  ushort_t* ya = (ushort_t*)(p.ws + OFF_YA);
  {
    int tx = threadIdx.x;
    asm volatile("" : "+v"(tx));
    const int hs = tx >> 7;
    const int tok = item * 128 + (tx & 127);
    const int b = tok / S_, t = tok % S_;
    float acc[64];
#pragma unroll
    for (int e = 0; e < 64; ++e) acc[e] = 0.f;
    float m = -1e30f, l = 0.f;
    for (int g = 0; g < 3; ++g) {
      const int dil = (g == 0) ? 1 : (g == 1 ? 4 : 16);
      const int head = g * 4 + hs;
      float q[64];
      {
        const ushort_t* qp = qkv + (size_t)tok * QKVC + head * 64;
#pragma unroll
        for (int e8 = 0; e8 < 8; ++e8) {
          u32x4 v = *(const u32x4*)(qp + e8 * 8);
#pragma unroll
          for (int w = 0; w < 4; ++w) { q[e8 * 8 + 2 * w] = __uint_as_float(v[w] << 16); q[e8 * 8 + 2 * w + 1] = __uint_as_float(v[w] & 0xffff0000u); }
        }
      }
      for (int j = -64; j <= 64; ++j) {
        const int tk = t + dil * j;
        if (tk < 0 || tk >= S_) continue;
        const ushort_t* kp = qkv + (size_t)(b * S_ + tk) * QKVC + 768 + head * 64;
        float s = 0.f;
#pragma unroll
        for (int e8 = 0; e8 < 8; ++e8) {
          u32x4 v = *(const u32x4*)(kp + e8 * 8);
#pragma unroll
          for (int w = 0; w < 4; ++w) { s += q[e8 * 8 + 2 * w] * __uint_as_float(v[w] << 16); s += q[e8 * 8 + 2 * w + 1] * __uint_as_float(v[w] & 0xffff0000u); }
        }
        const float mn = fmaxf(m, s);
        const float corr = __expf(m - mn), pe = __expf(s - mn);
        l = l * corr + pe; m = mn;
        const ushort_t* vp = kp + 768;
#pragma unroll
        for (int e8 = 0; e8 < 8; ++e8) {
          u32x4 v = *(const u32x4*)(vp + e8 * 8);
#pragma unroll
          for (int w = 0; w < 4; ++w) {
            acc[e8 * 8 + 2 * w] = acc[e8 * 8 + 2 * w] * corr + pe * __uint_as_float(v[w] << 16);
            acc[e8 * 8 + 2 * w + 1] = acc[e8 * 8 + 2 * w + 1] * corr + pe * __uint_as_float(v[w] & 0xffff0000u);
          }
        }
      }
    }
    const float il = 1.f / l;
    ushort_t* op = ya + (size_t)tok * 256 + hs * 64;
#pragma unroll
    for (int e8 = 0; e8 < 8; ++e8) {
      u32x4 o;
#pragma unroll
      for (int w = 0; w < 4; ++w) o[w] = pack2(acc[e8 * 8 + 2 * w] * il, acc[e8 * 8 + 2 * w + 1] * il);
      *(u32x4*)(op + e8 * 8) = o;
    }
  }
}

DI void phase_merge(const P& p, char* smem) {
  const ushort_t* yh = (const ushort_t*)(p.ws + OFF_YH);
  const ushort_t* ya = (const ushort_t*)(p.ws + OFF_YA);
  const ushort_t* gate = (const ushort_t*)(p.ws + OFF_GATE);
  ushort_t* merged = (ushort_t*)(p.ws + OFF_MERGED);
  const int tid = tid_opaque(), lane = tid & 63, wave = tid >> 6, wm = wave >> 1, wn = wave & 1;
  constexpr int NTN = 1024 / BN, NTM = T_ / BM;
  for (int tile = blockIdx.x; tile < NTM * NTN; tile += gridDim.x) {
    const int m0 = (tile / NTN) * BM, n0 = (tile % NTN) * BN;
    f32x16 a1[2][2], a2[2][2]; acc_zero(a1); acc_zero(a2);
    ALoadBf16 l1{yh, HW_};
    gemm_mainloop(a1, l1, m0, (const ushort_t*)(p.ws + OFF_WBH_T), 512, n0, 512, smem);
    ALoadBf16 l2{ya, 256};
    gemm_mainloop(a2, l2, m0, (const ushort_t*)(p.ws + OFF_WBA_T), 256, n0, 256, smem);
#pragma unroll
    for (int mi = 0; mi < 2; ++mi)
#pragma unroll
      for (int ni = 0; ni < 2; ++ni)
#pragma unroll
        for (int r = 0; r < 16; ++r) {
          const int row = m0 + ACC_ROW(mi, r), col = n0 + ACC_COL(ni);
          float gh = bf2f(gate[(size_t)row * GATEC + col]), ga = bf2f(gate[(size_t)row * GATEC + 1024 + col]);
          merged[(size_t)row * 1024 + col] = f2bf(gh * a1[mi][ni][r] + ga * a2[mi][ni][r]);
        }
  }
}

DI void phase_outproj(const P& p, char* smem) {
  const float* ada = (const float*)(p.ws + OFF_ADA);
  const ushort_t* merged = (const ushort_t*)(p.ws + OFF_MERGED);
  const int tid = tid_opaque(), lane = tid & 63, wave = tid >> 6, wm = wave >> 1, wn = wave & 1;
  constexpr int NTN = 1024 / BN, NTM = T_ / BM;
  for (int tile = blockIdx.x; tile < NTM * NTN; tile += gridDim.x) {
    const int m0 = (tile / NTN) * BM, n0 = (tile % NTN) * BN, b = m0 / S_;
    f32x16 acc[2][2]; acc_zero(acc);
    ALoadBf16 l1{merged, 1024};
    gemm_mainloop(acc, l1, m0, (const ushort_t*)(p.ws + OFF_WOUT_T), 1024, n0, 1024, smem);
#pragma unroll
    for (int ni = 0; ni < 2; ++ni) {
      const int col = n0 + ACC_COL(ni);
      const float g1 = 1.f + ada[b * 6144 + 2 * 1024 + col];
#pragma unroll
      for (int mi = 0; mi < 2; ++mi)
#pragma unroll
        for (int r = 0; r < 16; ++r) {
          const size_t o = (size_t)(m0 + ACC_ROW(mi, r)) * 1024 + col;
          p.out[o] = DN_ALPHA * p.x[o] + g1 * acc[mi][ni][r];
        }
    }
  }
}

DI void phase_ln(float* __restrict__ xio, const float* __restrict__ g, const float* __restrict__ bta) {
  const int tq = tid_opaque(); const int lane = tq & 63, wave = tq >> 6;
  for (int row = blockIdx.x * 8 + wave; row < T_; row += gridDim.x * 8) {
    float* rp = xio + (size_t)row * 1024;
    f32x4 v[4];
    float s = 0.f;
#pragma unroll
    for (int i = 0; i < 4; ++i) { v[i] = *(const f32x4*)(rp + i * 256 + lane * 4); s += v[i][0] + v[i][1] + v[i][2] + v[i][3]; }
    const float mu = wave_sum(s) * (1.f / 1024.f);
    float q = 0.f;
#pragma unroll
    for (int i = 0; i < 4; ++i)
#pragma unroll
      for (int j = 0; j < 4; ++j) { float d = v[i][j] - mu; q += d * d; }
    const float rs = rsqrtf(wave_sum(q) * (1.f / 1024.f) + LN_EPS);
#pragma unroll
    for (int i = 0; i < 4; ++i) {
      f32x4 gg = *(const f32x4*)(g + i * 256 + lane * 4), bb = *(const f32x4*)(bta + i * 256 + lane * 4), o;
#pragma unroll
      for (int j = 0; j < 4; ++j) o[j] = (v[i][j] - mu) * rs * gg[j] + bb[j];
      *(f32x4*)(rp + i * 256 + lane * 4) = o;
    }
  }
}

DI void phase_peerq(const P& p, char* smem) {
  const float* ada = (const float*)(p.ws + OFF_ADA);
  float* mod = (float*)(smem + 2 * LDS_STAGE);
  float* q32 = (float*)(p.ws + OFF_Q32);
  const int tid = tid_opaque(), lane = tid & 63, wave = tid >> 6, wm = wave >> 1, wn = wave & 1;
  constexpr int NTN = 2048 / BN, NTM = T_ / BM;
  for (int tile = blockIdx.x; tile < NTM * NTN; tile += gridDim.x) {
    const int m0 = (tile / NTN) * BM, n0 = (tile % NTN) * BN, b = m0 / S_;
    __syncthreads();
    stage_mod(mod, ada, b, 4, 3);
    __syncthreads();
    f32x16 acc[2][2]; acc_zero(acc);
    ALoadF32Mod al{p.out, mod};
    gemm_mainloop(acc, al, m0, (const ushort_t*)(p.ws + OFF_WQ_T), 1024, n0, 1024, smem);
#pragma unroll
    for (int mi = 0; mi < 2; ++mi)
#pragma unroll
      for (int ni = 0; ni < 2; ++ni)
#pragma unroll
        for (int r = 0; r < 16; ++r) q32[(size_t)(m0 + ACC_ROW(mi, r)) * 2048 + n0 + ACC_COL(ni)] = acc[mi][ni][r];
  }
}

struct TopkLds {
  float sq[8][256]; float ssc[8][2][128]; float scand[8][256]; float ssv[8][2][16]; int ssi[8][2][16];
  int lidx[8][128]; float lgv[8][128];
};
DI void topk_token(const P& p, TopkLds& L, int tok, int slot) {
  const float* q32 = (const float*)(p.ws + OFF_Q32);
  const int tq = tid_opaque(); const int lane = tq & 63, h = tq >> 6;
  __syncthreads();
  {
    const float* qp = q32 + (size_t)tok * 2048 + h * 256;
    *(f32x4*)&L.sq[h][lane * 4] = *(const f32x4*)(qp + lane * 4);
  }
  __syncthreads();
#pragma unroll
  for (int pp = 0; pp < 2; ++pp)
#pragma unroll
    for (int half = 0; half < 2; ++half) {
      const int k = lane + 64 * half;
      const float* kp = p.keys + ((size_t)((h * 2 + pp) * 128 + k)) * 128;
      float s = 0.f;
#pragma unroll 8
      for (int e4 = 0; e4 < 32; ++e4) {
        f32x4 kv = *(const f32x4*)(kp + e4 * 4);
        f32x4 qv = *(const f32x4*)&L.sq[h][pp * 128 + e4 * 4];
        s += kv[0] * qv[0] + kv[1] * qv[1] + kv[2] * qv[2] + kv[3] * qv[3];
      }
      L.ssc[h][pp][k] = s;
    }
  __syncthreads();
#pragma unroll
  for (int pp = 0; pp < 2; ++pp) {
    const float va = L.ssc[h][pp][lane], vb = L.ssc[h][pp][lane + 64];
    int ra = 0, rb = 0;
    for (int j4 = 0; j4 < 32; ++j4) {
      f32x4 o = *(const f32x4*)&L.ssc[h][pp][j4 * 4];
#pragma unroll
      for (int u = 0; u < 4; ++u) {
        const int j = j4 * 4 + u;
        ra += (o[u] > va || (o[u] == va && j < lane)) ? 1 : 0;
        rb += (o[u] > vb || (o[u] == vb && j < lane + 64)) ? 1 : 0;
      }
    }
    if (ra < 16) { L.ssv[h][pp][ra] = va; L.ssi[h][pp][ra] = lane; }
    if (rb < 16) { L.ssv[h][pp][rb] = vb; L.ssi[h][pp][rb] = lane + 64; }
  }
  __syncthreads();
  float cv[4];
#pragma unroll
  for (int u = 0; u < 4; ++u) { const int ci = lane + 64 * u; cv[u] = L.ssv[h][0][ci >> 4] + L.ssv[h][1][ci & 15]; L.scand[h][ci] = cv[u]; }
  __syncthreads();
  int rk[4] = {0, 0, 0, 0};
  for (int j4 = 0; j4 < 64; ++j4) {
    f32x4 o = *(const f32x4*)&L.scand[h][j4 * 4];
#pragma unroll
    for (int w = 0; w < 4; ++w) {
      const int j = j4 * 4 + w;
#pragma unroll
      for (int u = 0; u < 4; ++u) rk[u] += (o[w] > cv[u] || (o[w] == cv[u] && j < lane + 64 * u)) ? 1 : 0;
    }
  }
  __syncthreads();
#pragma unroll
  for (int u = 0; u < 4; ++u)
    if (rk[u] < 16) {
      const int ci = lane + 64 * u;
      L.ssc[h][0][rk[u]] = cv[u];
      L.ssc[h][1][rk[u]] = __int_as_float(L.ssi[h][0][ci >> 4] * 128 + L.ssi[h][1][ci & 15]);
    }
  __syncthreads();
  {
    const float v = L.ssc[h][0][lane & 15];
    const float mx = L.ssc[h][0][0];
    float e = __expf(v - mx);
    float s = e;
#pragma unroll
    for (int o = 8; o > 0; o >>= 1) s += __shfl_xor(s, o);
    if (lane < 16) {
      L.lidx[slot][h * 16 + lane] = __float_as_int(L.ssc[h][1][lane]);
      L.lgv[slot][h * 16 + lane] = e / s;
    }
  }
}

DI void phase_peer(const P& p, char* smem) {
  TopkLds& L = *(TopkLds*)smem;
  const float* ada = (const float*)(p.ws + OFF_ADA);
  const int tq = tid_opaque(); const int lane = tq & 63, wave = tq >> 6;
  for (int grp = blockIdx.x; grp < T_ / 8; grp += gridDim.x) {
    for (int s = 0; s < 8; ++s) topk_token(p, L, grp * 8 + s, s);
    __syncthreads();
    const int tok = grp * 8 + wave;
    const int b = tok / S_;
    float* rp = p.out + (size_t)tok * 1024;
    f32x4 x1[4], u2[4], acc[4];
#pragma unroll
    for (int i = 0; i < 4; ++i) {
      const int col = i * 256 + lane * 4;
      x1[i] = *(const f32x4*)(rp + col);
      f32x4 sc = *(const f32x4*)(ada + b * 6144 + 4 * 1024 + col), sh = *(const f32x4*)(ada + b * 6144 + 3 * 1024 + col);
#pragma unroll
      for (int j = 0; j < 4; ++j) { u2[i][j] = x1[i][j] * (1.f + sc[j]) + sh[j]; acc[i][j] = 0.f; }
    }
    for (int s = 0; s < 128; ++s) {
      const int e = __builtin_amdgcn_readfirstlane(L.lidx[wave][s]);
      const float g = L.lgv[wave][s];
      const float* ur = p.pu + (size_t)e * 1024;
      const float* vr = p.pv + (size_t)e * 1024;
      float d = 0.f;
#pragma unroll
      for (int i = 0; i < 4; ++i) {
        f32x4 u = *(const f32x4*)(ur + i * 256 + lane * 4);
        d += u[0] * u2[i][0] + u[1] * u2[i][1] + u[2] * u2[i][2] + u[3] * u2[i][3];
      }
      const float a = wave_sum(d);
      const float coef = g * 0.5f * a * (1.f + erff(a * 0.7071067811865475f));
#pragma unroll
      for (int i = 0; i < 4; ++i) {
        f32x4 v = *(const f32x4*)(vr + i * 256 + lane * 4);
#pragma unroll
        for (int j = 0; j < 4; ++j) acc[i][j] += coef * v[j];
      }
    }
    float sm = 0.f;
#pragma unroll
    for (int i = 0; i < 4; ++i) {
      const int col = i * 256 + lane * 4;
      f32x4 g2 = *(const f32x4*)(ada + b * 6144 + 5 * 1024 + col);
#pragma unroll
      for (int j = 0; j < 4; ++j) { acc[i][j] = DN_ALPHA * x1[i][j] + (1.f + g2[j]) * acc[i][j]; sm += acc[i][j]; }
    }
    const float mu = wave_sum(sm) * (1.f / 1024.f);
    float q = 0.f;
#pragma unroll
    for (int i = 0; i < 4; ++i)
#pragma unroll
      for (int j = 0; j < 4; ++j) { float d = acc[i][j] - mu; q += d * d; }
    const float rs = rsqrtf(wave_sum(q) * (1.f / 1024.f) + LN_EPS);
#pragma unroll
    for (int i = 0; i < 4; ++i) {
      const int col = i * 256 + lane * 4;
      f32x4 gg = *(const f32x4*)(p.ln2_g + col), bb = *(const f32x4*)(p.ln2_b + col), o;
#pragma unroll
      for (int j = 0; j < 4; ++j) o[j] = (acc[i][j] - mu) * rs * gg[j] + bb[j];
      *(f32x4*)(rp + col) = o;
    }
  }
}

constexpr int SMEM_BYTES = 131072;
__global__ void __launch_bounds__(NT) fwd_megakernel(P p) {
  __shared__ __attribute__((aligned(16))) char smem[SMEM_BYTES];
  cooperative_groups::grid_group grid = cooperative_groups::this_grid();
  phase_ada(p, smem);
  phase_transposes(p, smem);
  phase_filter(p, smem);
  grid.sync();
  phase_inproj(p, smem);
  grid.sync();
  for (int item = blockIdx.x; item < 512 + 128; item += gridDim.x) {
    if (item < 512) hyena_item(p, smem, item);
    else attn_item(p, item - 512);
  }
  grid.sync();
  phase_merge(p, smem);
  grid.sync();
  phase_outproj(p, smem);
  grid.sync();
  phase_ln(p.out, p.ln1_g, p.ln1_b);
  grid.sync();
  phase_peerq(p, smem);
  grid.sync();
  phase_peer(p, smem);
}

extern "C" void kernel_launch(void* const* d_in, const int* in_sizes, int n_in, void* d_out, int out_size, void* d_ws, size_t ws_size,
                              hipStream_t stream) {
  P p{};
  p.x = (const float*)d_in[0]; p.c = (const float*)d_in[1]; p.pos = (const int*)d_in[2];
  p.w_ada = (const float*)d_in[3]; p.b_ada = (const float*)d_in[4]; p.w_in = (const float*)d_in[5];
  p.hy_conv_w = (const float*)d_in[6]; p.hy_conv_b = (const float*)d_in[7];
  p.f1_w = (const float*)d_in[8]; p.f1_b = (const float*)d_in[9]; p.f1_freq = (const float*)d_in[10];
  p.f2_w = (const float*)d_in[11]; p.f2_b = (const float*)d_in[12]; p.f2_freq = (const float*)d_in[13];
  p.f3_w = (const float*)d_in[14]; p.hy_bias = (const float*)d_in[15];
  p.w_bh = (const float*)d_in[16]; p.w_ba = (const float*)d_in[17]; p.w_out = (const float*)d_in[18];
  p.ln1_g = (const float*)d_in[19]; p.ln1_b = (const float*)d_in[20];
  p.wq = (const float*)d_in[21]; p.keys = (const float*)d_in[22]; p.pu = (const float*)d_in[23]; p.pv = (const float*)d_in[24];
  p.ln2_g = (const float*)d_in[25]; p.ln2_b = (const float*)d_in[26];
  p.out = (float*)d_out; p.ws = (char*)d_ws;

  static int grid_blocks = 0;
  if (!grid_blocks) {
    int dev = 0, cus = 0, per_cu = 0;
    hipGetDevice(&dev);
    hipDeviceGetAttribute(&cus, hipDeviceAttributeMultiprocessorCount, dev);
    hipOccupancyMaxActiveBlocksPerMultiprocessor(&per_cu, fwd_megakernel, NT, 0);
    if (per_cu > 1) per_cu = 1;
    grid_blocks = cus * per_cu;
  }
  void* args[] = {&p};
  hipError_t e = hipLaunchCooperativeKernel((void*)fwd_megakernel, dim3(grid_blocks), dim3(NT), args, 0, stream);
  if (e != hipSuccess) fprintf(stderr, "cooperative launch failed: %s (grid %d)\n", hipGetErrorString(e), grid_blocks);
}
```

```cpp
#include <hip/hip_runtime.h>
#include <hip/hip_cooperative_groups.h>
#include <cstdio>
#include <cstdint>

#define DI __device__ __forceinline__
typedef unsigned short ushort_t;
typedef __attribute__((ext_vector_type(8))) short bf16x8;
typedef __attribute__((ext_vector_type(16))) float f32x16;
typedef __attribute__((ext_vector_type(4))) float f32x4;
typedef __attribute__((ext_vector_type(4))) unsigned u32x4;

constexpr int T_ = 16384, S_ = 8192, NB = 2, D_ = 1024;
constexpr int HW_ = 512, HYC = 1536, QKVC = 2304, GATEC = 2048, INW = 5888;
constexpr int NT = 512;
constexpr float DN_ALPHA = 1.189207115002721f;
constexpr float LN_EPS = 1e-5f;

constexpr size_t OFF_ADA   = 0;
constexpr size_t OFF_WIN_T = 65536;
constexpr size_t OFF_WQ_T  = OFF_WIN_T + (size_t)INW * 1024 * 2;
constexpr size_t OFF_WOUT_T= OFF_WQ_T + (size_t)2048 * 1024 * 2;
constexpr size_t OFF_WBH_T = OFF_WOUT_T + (size_t)1024 * 1024 * 2;
constexpr size_t OFF_WBA_T = OFF_WBH_T + (size_t)1024 * 512 * 2;
constexpr size_t OFF_PH    = OFF_WBA_T + (size_t)1024 * 256 * 2;
constexpr size_t OFF_QKV   = OFF_PH + (size_t)T_ * HYC * 2;
constexpr size_t OFF_GATE  = OFF_QKV + (size_t)T_ * QKVC * 2;
constexpr size_t OFF_YH    = OFF_GATE + (size_t)T_ * GATEC * 2;
constexpr size_t OFF_YA    = OFF_YH + (size_t)T_ * HW_ * 2;
constexpr size_t OFF_END   = OFF_YA + (size_t)T_ * 256 * 2;
constexpr size_t OFF_MERGED= OFF_PH;
constexpr size_t OFF_Q32   = OFF_QKV;
constexpr size_t OFF_IDX   = OFF_YH;
constexpr size_t OFF_GV    = OFF_YH + (size_t)T_ * 128 * 4;
constexpr size_t OFF_HSCR  = OFF_END;
static_assert(OFF_HSCR + (size_t)164 * 131072 <= 268435456ull, "ws overflow");
static_assert((size_t)92 * 131072 <= (size_t)INW * 1024 * 2, "w_in^T region too small");

struct P {
  const float *x, *c; const int* pos;
  const float *w_ada, *b_ada, *w_in, *hy_conv_w, *hy_conv_b, *f1_w, *f1_b, *f1_freq, *f2_w, *f2_b, *f2_freq, *f3_w,
      *hy_bias, *w_bh, *w_ba, *w_out, *ln1_g, *ln1_b, *wq, *keys, *pu, *pv, *ln2_g, *ln2_b;
  float* out; char* ws;
};

DI ushort_t f2bf(float x) { unsigned u = __float_as_uint(x); u += 0x7fffu + ((u >> 16) & 1u); return (ushort_t)(u >> 16); }
DI float bf2f(ushort_t h) { return __uint_as_float(((unsigned)h) << 16); }
DI unsigned pack2(float a, float b) { return (unsigned)f2bf(a) | ((unsigned)f2bf(b) << 16); }
DI int tid_opaque() { int t = threadIdx.x; asm volatile("" : "+v"(t)); return t; }
DI float wave_sum(float v) {
#pragma unroll
  for (int o = 32; o > 0; o >>= 1) v += __shfl_xor(v, o);
  return v;
}

struct cf2 { float x, y; };
constexpr int FFT_N = 16384, FFT_SA = 560;

DI constexpr float wcos32(int j) {
  switch (j & 31) {
    case 0: return 1.0f; case 1: return 0.98078528040323043f; case 2: return 0.92387953251128674f; case 3: return 0.83146961230254524f;
    case 4: return 0.70710678118654752f; case 5: return 0.55557023301960218f; case 6: return 0.38268343236508978f; case 7: return 0.19509032201612825f;
    case 8: return 0.0f; case 9: return -0.19509032201612825f; case 10: return -0.38268343236508978f; case 11: return -0.55557023301960218f;
    case 12: return -0.70710678118654752f; case 13: return -0.83146961230254524f; case 14: return -0.92387953251128674f; case 15: return -0.98078528040323043f;
    case 16: return -1.0f; case 17: return -0.98078528040323043f; case 18: return -0.92387953251128674f; case 19: return -0.83146961230254524f;
    case 20: return -0.70710678118654752f; case 21: return -0.55557023301960218f; case 22: return -0.38268343236508978f; case 23: return -0.19509032201612825f;
    case 24: return 0.0f; case 25: return 0.19509032201612825f; case 26: return 0.38268343236508978f; case 27: return 0.55557023301960218f;
    case 28: return 0.70710678118654752f; case 29: return 0.83146961230254524f; case 30: return 0.92387953251128674f; default: return 0.98078528040323043f;
  }
}
DI constexpr float wsin32(int j) { return wcos32(j + 24); }
DI constexpr int brev(int v, int bits) { int r = 0; for (int i = 0; i < bits; ++i) r |= ((v >> i) & 1) << (bits - 1 - i); return r; }

template <int R, int LEN, bool INV, bool ZHI>
DI void r2_stage(float (&re)[R], float (&im)[R]) {
  constexpr int half = LEN / 2;
#pragma unroll
  for (int start = 0; start < R; start += LEN) {
#pragma unroll
    for (int j = 0; j < half; ++j) {
      const int a = start + j, b = a + half;
      const int tj = j * (32 / LEN);
      const float c = wcos32(tj), s = wsin32(tj);
      if (!INV) {
        float dr, di;
        if (ZHI) { dr = re[a]; di = im[a]; }
        else {
          const float ar = re[a], ai = im[a], br = re[b], bi = im[b];
          re[a] = ar + br; im[a] = ai + bi; dr = ar - br; di = ai - bi;
        }
        if (tj == 0) { re[b] = dr; im[b] = di; }
        else if (tj == 8) { re[b] = di; im[b] = -dr; }
        else { re[b] = dr * c + di * s; im[b] = di * c - dr * s; }
      } else {
        const float br = re[b], bi = im[b];
        float pr, pi;
        if (tj == 0) { pr = br; pi = bi; }
        else if (tj == 8) { pr = -bi; pi = br; }
        else { pr = br * c - bi * s; pi = bi * c + br * s; }
        const float ar = re[a], ai = im[a];
        re[a] = ar + pr; im[a] = ai + pi; re[b] = ar - pr; im[b] = ai - pi;
      }
    }
  }
}
template <int R, bool ZHI> DI void dft_fwd(float (&re)[R], float (&im)[R]) {
  if (R == 32) r2_stage<R, (R == 32 ? 32 : 2), false, ZHI>(re, im);
  r2_stage<R, 16, false, (R == 16) && ZHI>(re, im);
  r2_stage<R, 8, false, false>(re, im);
  r2_stage<R, 4, false, false>(re, im);
  r2_stage<R, 2, false, false>(re, im);
}
template <int R> DI void dft_inv(float (&re)[R], float (&im)[R]) {
  r2_stage<R, 2, true, false>(re, im);
  r2_stage<R, 4, true, false>(re, im);
  r2_stage<R, 8, true, false>(re, im);
  r2_stage<R, 16, true, false>(re, im);
  if (R == 32) r2_stage<R, (R == 32 ? 32 : 2), true, false>(re, im);
}

DI void sincos_turn(float frac, float& s, float& c) { sincospif(2.0f * frac, &s, &c); }

template <bool ZHI>
DI void fft_fwdA(float (&re)[32], float (&im)[32], cf2* lds, int m) {
  asm volatile("" : "+v"(m));
  float s1, c1; sincos_turn((float)m * (1.0f / 16384.0f), s1, c1);
  __builtin_amdgcn_sched_barrier(0);
  dft_fwd<32, ZHI>(re, im);
  __builtin_amdgcn_sched_barrier(0);
  float wr = 1.f, wi = 0.f;
#pragma unroll
  for (int k1 = 0; k1 < 32; ++k1) {
    if ((k1 & 3) == 0) __builtin_amdgcn_sched_barrier(0);
    const int r = brev(k1, 5);
    cf2 o; o.x = re[r] * wr - im[r] * wi; o.y = re[r] * wi + im[r] * wr;
    lds[k1 * FFT_SA + m] = o;
    const float nr = wr * c1 + wi * s1, ni = wi * c1 - wr * s1;
    wr = nr; wi = ni;
  }
}
DI void fft_B_read(float (&re)[32], float (&im)[32], const cf2* lds, int tid) {
  const int k1 = tid >> 4, mp = tid & 15;
#pragma unroll
  for (int n2 = 0; n2 < 32; ++n2) { cf2 v = lds[k1 * FFT_SA + n2 * 16 + mp]; re[n2] = v.x; im[n2] = v.y; }
}
DI void fft_fwdB_write(float (&re)[32], float (&im)[32], cf2* lds, int tid) {
  asm volatile("" : "+v"(tid));
  const int k1 = tid >> 4, mp = tid & 15;
  float s1, c1; sincos_turn((float)mp * (1.0f / 512.0f), s1, c1);
  __builtin_amdgcn_sched_barrier(0);
  dft_fwd<32, false>(re, im);
  __builtin_amdgcn_sched_barrier(0);
  float wr = 1.f, wi = 0.f;
#pragma unroll
  for (int k2 = 0; k2 < 32; ++k2) {
    if ((k2 & 3) == 0) __builtin_amdgcn_sched_barrier(0);
    const int r = brev(k2, 5);
    cf2 o; o.x = re[r] * wr - im[r] * wi; o.y = re[r] * wi + im[r] * wr;
    lds[k1 * FFT_SA + k2 * 17 + mp] = o;
    const float nr = wr * c1 + wi * s1, ni = wi * c1 - wr * s1;
    wr = nr; wi = ni;
  }
}
DI void fft_fwdC(float (&re)[32], float (&im)[32], const cf2* lds, int tid) {
  const int k1 = tid >> 5, k2 = tid & 31;
#pragma unroll
  for (int h = 0; h < 2; ++h) {
    float tr[16], ti[16];
#pragma unroll
    for (int mp = 0; mp < 16; ++mp) { cf2 v = lds[(k1 + 16 * h) * FFT_SA + k2 * 17 + mp]; tr[mp] = v.x; ti[mp] = v.y; }
    dft_fwd<16, false>(tr, ti);
#pragma unroll
    for (int i = 0; i < 16; ++i) { re[h * 16 + i] = tr[i]; im[h * 16 + i] = ti[i]; }
  }
}
DI void fft_invC(float (&re)[32], float (&im)[32], cf2* lds, int tid) {
  const int k1 = tid >> 5, k2 = tid & 31;
#pragma unroll
  for (int h = 0; h < 2; ++h) {
    float tr[16], ti[16];
#pragma unroll
    for (int i = 0; i < 16; ++i) { tr[i] = re[h * 16 + i]; ti[i] = im[h * 16 + i]; }
    dft_inv<16>(tr, ti);
#pragma unroll
    for (int mp = 0; mp < 16; ++mp) { cf2 o; o.x = tr[mp]; o.y = ti[mp]; lds[(k1 + 16 * h) * FFT_SA + k2 * 17 + mp] = o; }
  }
}
DI void fft_invB_read(float (&re)[32], float (&im)[32], const cf2* lds, int tid) {
  asm volatile("" : "+v"(tid));
  const int k1 = tid >> 4, mp = tid & 15;
  float s1, c1; sincos_turn((float)mp * (1.0f / 512.0f), s1, c1);
  float wr = 1.f, wi = 0.f;
  __builtin_amdgcn_sched_barrier(0);
#pragma unroll
  for (int k2 = 0; k2 < 32; ++k2) {
    if ((k2 & 3) == 0) __builtin_amdgcn_sched_barrier(0);
    const int r = brev(k2, 5);
    cf2 v = lds[k1 * FFT_SA + k2 * 17 + mp];
    re[r] = v.x * wr - v.y * wi; im[r] = v.x * wi + v.y * wr;
    const float nr = wr * c1 - wi * s1, ni = wi * c1 + wr * s1;
    wr = nr; wi = ni;
  }
}
DI void fft_invB_write(float (&re)[32], float (&im)[32], cf2* lds, int tid) {
  const int k1 = tid >> 4, mp = tid & 15;
  dft_inv<32>(re, im);
#pragma unroll
  for (int n2 = 0; n2 < 32; ++n2) { cf2 o; o.x = re[n2]; o.y = im[n2]; lds[k1 * FFT_SA + n2 * 16 + mp] = o; }
}
DI void fft_invA(float (&re)[32], float (&im)[32], const cf2* lds, int m) {
  asm volatile("" : "+v"(m));
  float s1, c1; sincos_turn((float)m * (1.0f / 16384.0f), s1, c1);
  float wr = 1.f, wi = 0.f;
  __builtin_amdgcn_sched_barrier(0);
#pragma unroll
  for (int k1 = 0; k1 < 32; ++k1) {
    if ((k1 & 3) == 0) __builtin_amdgcn_sched_barrier(0);
    const int r = brev(k1, 5);
    cf2 v = lds[k1 * FFT_SA + m];
    re[r] = v.x * wr - v.y * wi; im[r] = v.x * wi + v.y * wr;
    const float nr = wr * c1 - wi * s1, ni = wi * c1 + wr * s1;
    wr = nr; wi = ni;
  }
  __builtin_amdgcn_sched_barrier(0);
  dft_inv<32>(re, im);
}

DI void phase_ada(const P& p, char* smem) {
  float (*red)[8][64] = (float (*)[8][64])smem;
  const int tid = tid_opaque(), cl = tid & 63, kq = tid >> 6;
  for (int item = blockIdx.x; item < 96; item += gridDim.x) {
    const int col = item * 64 + cl;
    float a0 = 0.f, a1 = 0.f;
    for (int k = kq * 128; k < kq * 128 + 128; ++k) {
      float w = p.w_ada[(size_t)k * 6144 + col];
      float c0 = p.c[k], c1 = p.c[1024 + k];
      a0 += (c0 / (1.f + __expf(-c0))) * w;
      a1 += (c1 / (1.f + __expf(-c1))) * w;
    }
    __syncthreads();
    red[0][kq][cl] = a0; red[1][kq][cl] = a1;
    __syncthreads();
    if (tid < 128) {
      int b = tid >> 6;
      float s = p.b_ada[col];
#pragma unroll
      for (int q = 0; q < 8; ++q) s += red[b][q][cl];
      ((float*)(p.ws + OFF_ADA))[b * 6144 + col] = s;
    }
  }
}

DI void transpose_tile(const float* __restrict__ W, ushort_t* __restrict__ Wt, int K, int N, int item, char* smem) {
  float (*tile)[65] = (float (*)[65])smem;
  const int ntn = N / 64;
  const int n0 = (item % ntn) * 64, k0 = (item / ntn) * 32;
  const int tid = tid_opaque();
  __syncthreads();
  {
    const int tx = tid & 63, ty = tid >> 6;
#pragma unroll
    for (int i = 0; i < 4; ++i) tile[ty + 8 * i][tx] = W[(size_t)(k0 + ty + 8 * i) * N + n0 + tx];
  }
  __syncthreads();
  {
    const int kk = tid & 31, nn0 = tid >> 5;
#pragma unroll
    for (int i = 0; i < 4; ++i) Wt[(size_t)(n0 + nn0 + 16 * i) * K + k0 + kk] = f2bf(tile[kk][nn0 + 16 * i]);
  }
}
DI void phase_transposes(const P& p, char* smem) {
  constexpr int I0 = (INW / 64) * 32, I1 = I0 + 32 * 32, I2 = I1 + 16 * 32, I3 = I2 + 16 * 16, I4 = I3 + 16 * 8;
  for (int item = blockIdx.x; item < I4; item += gridDim.x) {
    if (item < I0) transpose_tile(p.w_in, (ushort_t*)(p.ws + OFF_WIN_T), 1024, INW, item, smem);
    else if (item < I1) transpose_tile(p.wq, (ushort_t*)(p.ws + OFF_WQ_T), 1024, 2048, item - I0, smem);
    else if (item < I2) transpose_tile(p.w_out, (ushort_t*)(p.ws + OFF_WOUT_T), 1024, 1024, item - I1, smem);
    else if (item < I3) transpose_tile(p.w_bh, (ushort_t*)(p.ws + OFF_WBH_T), 512, 1024, item - I2, smem);
    else transpose_tile(p.w_ba, (ushort_t*)(p.ws + OFF_WBA_T), 256, 1024, item - I3, smem);
  }
}

DI void phase_filter(const P& p, char* smem) {
  float (*zf)[33] = (float (*)[33])smem;
  float (*h1)[64] = (float (*)[64])(smem + 4352);
  float (*h2T)[32] = (float (*)[32])(smem + 4352 + 8192);
  const int tid = tid_opaque();
  for (int item = blockIdx.x; item < 256; item += gridDim.x) {
  const int t0 = item * 32;
  __syncthreads();
  for (int idx = tid; idx < 32 * 33; idx += NT) {
    int tt = idx / 33, e = idx % 33, t = t0 + tt;
    float tl = (float)t * (1.0f / 8191.0f);
    float w = 6.283185307179586f * (float)t / 8192.0f;
    float val;
    if (e == 0) val = tl;
    else {
      int i = (e - 1) & 15;
      float f = 1e-4f + (float)i * ((15.0f - 1e-4f) / 15.0f);
      val = (e <= 16) ? cosf(f * w) : -sinf(f * w);
    }
    zf[tt][e] = val;
  }
  __syncthreads();
  for (int idx = tid; idx < 32 * 64; idx += NT) {
    int tt = idx >> 6, j = idx & 63;
    float a = p.f1_b[j];
    for (int e = 0; e < 33; ++e) a += zf[tt][e] * p.f1_w[e * 64 + j];
    h1[tt][j] = sinf(p.f1_freq[j] * a);
  }
  __syncthreads();
  for (int idx = tid; idx < 32 * 64; idx += NT) {
    int tt = idx >> 6, j = idx & 63;
    float a = p.f2_b[j];
    for (int e = 0; e < 64; ++e) a += h1[tt][e] * p.f2_w[e * 64 + j];
    h2T[j][tt] = sinf(p.f2_freq[j] * a);
  }
  __syncthreads();
  float* filt = p.out;
  const float min_decay = -3.0701134573253945f, max_decay = -15.350567286626973f;
  for (int col = tid; col < 2048; col += NT) {
    float acc[32];
#pragma unroll
    for (int i = 0; i < 32; ++i) acc[i] = 0.f;
    for (int j = 0; j < 64; ++j) {
      float w = p.f3_w[j * 2048 + col];
#pragma unroll
      for (int q = 0; q < 8; ++q) {
        f32x4 h = *(const f32x4*)&h2T[j][q * 4];
        acc[q * 4 + 0] += h[0] * w; acc[q * 4 + 1] += h[1] * w; acc[q * 4 + 2] += h[2] * w; acc[q * 4 + 3] += h[3] * w;
      }
    }
    int c = col & 511;
    float delta = fabsf(min_decay + (float)c * ((max_decay - min_decay) / 511.0f));
    float* dst = filt + (size_t)col * 8192 + t0;
#pragma unroll
    for (int q = 0; q < 8; ++q) {
      f32x4 o;
#pragma unroll
      for (int r = 0; r < 4; ++r) {
        float tl = (float)(t0 + q * 4 + r) * (1.0f / 8191.0f);
        o[r] = acc[q * 4 + r] * __expf(-tl * delta);
      }
      *(f32x4*)(dst + q * 4) = o;
    }
  }
  }
}

constexpr int BM = 256, BN = 128, BK = 64;
constexpr int LDS_A = BM * BK * 2, LDS_B = BN * BK * 2, LDS_STAGE = LDS_A + LDS_B;
constexpr int GEMM_LDS = 2 * LDS_STAGE + 8192;

DI int swz(int row, int ch) { return row * 128 + ((ch ^ (row & 7)) << 4); }

struct ALoadBf16 {
  const ushort_t* A; int lda;
  struct Raw { u32x4 v; };
  DI Raw fetch(int row, int k) const { Raw r; r.v = *(const u32x4*)(A + (size_t)row * lda + k); return r; }
  DI u32x4 cvt(const Raw& r, int k) const { return r.v; }
};
struct ALoadF32Mod {
  const float* A; const float* mod;
  struct Raw { f32x4 a, b; };
  DI Raw fetch(int row, int k) const { Raw r; const float* s = A + (size_t)row * 1024 + k; r.a = *(const f32x4*)s; r.b = *(const f32x4*)(s + 4); return r; }
  DI u32x4 cvt(const Raw& r, int k) const {
    f32x4 s0 = *(const f32x4*)(mod + k), s1 = *(const f32x4*)(mod + k + 4);
    f32x4 h0 = *(const f32x4*)(mod + 1024 + k), h1 = *(const f32x4*)(mod + 1024 + k + 4);
    u32x4 o;
    o[0] = pack2(r.a[0] * s0[0] + h0[0], r.a[1] * s0[1] + h0[1]);
    o[1] = pack2(r.a[2] * s0[2] + h0[2], r.a[3] * s0[3] + h0[3]);
    o[2] = pack2(r.b[0] * s1[0] + h1[0], r.b[1] * s1[1] + h1[1]);
    o[3] = pack2(r.b[2] * s1[2] + h1[2], r.b[3] * s1[3] + h1[3]);
    return o;
  }
};

template <class AL, bool SWAP = false>
DI void gemm_mainloop(f32x16 (&acc)[2][2], const AL& al, int m0, const ushort_t* __restrict__ Bt, int ldb, int n0, int K, char* smem) {
  const int tid = tid_opaque(), lane = tid & 63, wave = tid >> 6;
  const int wm = wave >> 1, wn = wave & 1;
  const int lr = tid >> 3, lc = tid & 7;
  typename AL::Raw ra[4]; u32x4 rb[2];
  const int nk = K / BK;
#pragma unroll
  for (int i = 0; i < 4; ++i) ra[i] = al.fetch(m0 + lr + 64 * i, lc * 8);
#pragma unroll
  for (int i = 0; i < 2; ++i) rb[i] = *(const u32x4*)(Bt + (size_t)(n0 + lr + 64 * i) * ldb + lc * 8);
  __syncthreads();
#pragma unroll
  for (int i = 0; i < 4; ++i) *(u32x4*)(smem + swz(lr + 64 * i, lc)) = al.cvt(ra[i], lc * 8);
#pragma unroll
  for (int i = 0; i < 2; ++i) *(u32x4*)(smem + LDS_A + swz(lr + 64 * i, lc)) = rb[i];
  __syncthreads();
  for (int kt = 0; kt < nk; ++kt) {
    char* cur = smem + (kt & 1) * LDS_STAGE;
    char* nxt = smem + ((kt + 1) & 1) * LDS_STAGE;
    const bool more = (kt + 1 < nk);
    const int kn = (kt + 1) * BK + lc * 8;
    if (more) {
#pragma unroll
      for (int i = 0; i < 4; ++i) ra[i] = al.fetch(m0 + lr + 64 * i, kn);
#pragma unroll
      for (int i = 0; i < 2; ++i) rb[i] = *(const u32x4*)(Bt + (size_t)(n0 + lr + 64 * i) * ldb + kn);
    }
#pragma unroll
    for (int s = 0; s < 4; ++s) {
      const int ch = 2 * s + (lane >> 5);
      bf16x8 af[2], bfr[2];
#pragma unroll
      for (int mi = 0; mi < 2; ++mi) af[mi] = *(const bf16x8*)(cur + swz(wm * 64 + mi * 32 + (lane & 31), ch));
#pragma unroll
      for (int ni = 0; ni < 2; ++ni) bfr[ni] = *(const bf16x8*)(cur + LDS_A + swz(wn * 64 + ni * 32 + (lane & 31), ch));
#pragma unroll
      for (int mi = 0; mi < 2; ++mi)
#pragma unroll
        for (int ni = 0; ni < 2; ++ni)
          acc[mi][ni] = SWAP ? __builtin_amdgcn_mfma_f32_32x32x16_bf16(bfr[ni], af[mi], acc[mi][ni], 0, 0, 0)
                             : __builtin_amdgcn_mfma_f32_32x32x16_bf16(af[mi], bfr[ni], acc[mi][ni], 0, 0, 0);
    }
    if (more) {
#pragma unroll
      for (int i = 0; i < 4; ++i) *(u32x4*)(nxt + swz(lr + 64 * i, lc)) = al.cvt(ra[i], kn);
#pragma unroll
      for (int i = 0; i < 2; ++i) *(u32x4*)(nxt + LDS_A + swz(lr + 64 * i, lc)) = rb[i];
    }
    __syncthreads();
  }
}

constexpr int AT_ROW = 576;
constexpr int LDS_AT = 64 * AT_ROW;
constexpr int LDS_STAGE_T = LDS_AT + LDS_B;
typedef __attribute__((ext_vector_type(4))) short s16x4;
DI void gemm_mainloop_AT(f32x16 (&acc)[2][2], const ushort_t* __restrict__ At, size_t ldt, const ushort_t* __restrict__ Bt, int ldb, int n0, int K, char* smem) {
  const int tid = tid_opaque(), lane = tid & 63, wave = tid >> 6;
  const int wm = wave >> 1, wn = wave & 1;
  const int lr = tid >> 3, lc = tid & 7;
  u32x4 ra[4], rb[2];
  const int nk = K / BK;
#pragma unroll
  for (int i = 0; i < 4; ++i) { const int q = tid + 512 * i; ra[i] = *(const u32x4*)(At + (size_t)(q >> 5) * ldt + (q & 31) * 8); }
#pragma unroll
  for (int i = 0; i < 2; ++i) rb[i] = *(const u32x4*)(Bt + (size_t)(n0 + lr + 64 * i) * ldb + lc * 8);
  __syncthreads();
#pragma unroll
  for (int i = 0; i < 4; ++i) { const int q = tid + 512 * i; *(u32x4*)(smem + (q >> 5) * AT_ROW + (q & 31) * 16) = ra[i]; }
#pragma unroll
  for (int i = 0; i < 2; ++i) *(u32x4*)(smem + LDS_AT + swz(lr + 64 * i, lc)) = rb[i];
  __syncthreads();
  const int hh = lane >> 5, gg = (lane >> 4) & 1, qq = (lane & 15) >> 2, pp = lane & 3;
  for (int kt = 0; kt < nk; ++kt) {
    char* cur = smem + (kt & 1) * LDS_STAGE_T;
    char* nxt = smem + ((kt + 1) & 1) * LDS_STAGE_T;
    const bool more = (kt + 1 < nk);
    if (more) {
#pragma unroll
      for (int i = 0; i < 4; ++i) { const int q = tid + 512 * i; ra[i] = *(const u32x4*)(At + (size_t)((kt + 1) * BK + (q >> 5)) * ldt + (q & 31) * 8); }
#pragma unroll
      for (int i = 0; i < 2; ++i) rb[i] = *(const u32x4*)(Bt + (size_t)(n0 + lr + 64 * i) * ldb + (kt + 1) * BK + lc * 8);
    }
#pragma unroll
    for (int s = 0; s < 4; ++s) {
      const int ch = 2 * s + hh;
      bf16x8 af[2], bfr[2];
#pragma unroll
      for (int mi = 0; mi < 2; ++mi) {
        const char* a0 = cur + (16 * s + 8 * hh + qq) * AT_ROW + (wm * 64 + mi * 32 + 16 * gg + 4 * pp) * 2;
        s16x4 lo = __builtin_amdgcn_ds_read_tr16_b64_v4i16((__attribute__((address_space(3))) s16x4*)(a0));
        s16x4 hi = __builtin_amdgcn_ds_read_tr16_b64_v4i16((__attribute__((address_space(3))) s16x4*)(a0 + 4 * AT_ROW));
        af[mi] = __builtin_shufflevector(lo, hi, 0, 1, 2, 3, 4, 5, 6, 7);
      }
#pragma unroll
      for (int ni = 0; ni < 2; ++ni) bfr[ni] = *(const bf16x8*)(cur + LDS_AT + swz(wn * 64 + ni * 32 + (lane & 31), ch));
#pragma unroll
      for (int mi = 0; mi < 2; ++mi)
#pragma unroll
        for (int ni = 0; ni < 2; ++ni) acc[mi][ni] = __builtin_amdgcn_mfma_f32_32x32x16_bf16(af[mi], bfr[ni], acc[mi][ni], 0, 0, 0);
    }
    if (more) {
#pragma unroll
      for (int i = 0; i < 4; ++i) { const int q = tid + 512 * i; *(u32x4*)(nxt + (q >> 5) * AT_ROW + (q & 31) * 16) = ra[i]; }
#pragma unroll
      for (int i = 0; i < 2; ++i) *(u32x4*)(nxt + LDS_AT + swz(lr + 64 * i, lc)) = rb[i];
    }
    __syncthreads();
  }
}
DI void acc_zero(f32x16 (&acc)[2][2]) {
#pragma unroll
  for (int a = 0; a < 2; ++a)
#pragma unroll
    for (int b = 0; b < 2; ++b)
#pragma unroll
      for (int r = 0; r < 16; ++r) acc[a][b][r] = 0.f;
}
#define ACC_ROW(mi, r) (wm * 64 + (mi) * 32 + ((r) & 3) + 8 * ((r) >> 2) + 4 * (lane >> 5))
#define ACC_COL(ni) (wn * 64 + (ni) * 32 + (lane & 31))

DI void stage_mod(float* mod, const float* ada, int b, int sc_chunk, int sh_chunk) {
  for (int i = tid_opaque(); i < 1024; i += NT) {
    mod[i] = 1.f + ada[b * 6144 + sc_chunk * 1024 + i];
    mod[1024 + i] = ada[b * 6144 + sh_chunk * 1024 + i];
  }
}

DI void phase_inproj(const P& p, char* smem) {
  const float* ada = (const float*)(p.ws + OFF_ADA);
  float* mod = (float*)(smem + 2 * LDS_STAGE);
  const ushort_t* wt = (const ushort_t*)(p.ws + OFF_WIN_T);
  ushort_t* ph = (ushort_t*)(p.ws + OFF_PH);
  ushort_t* qkv = (ushort_t*)(p.ws + OFF_QKV);
  ushort_t* gate = (ushort_t*)(p.ws + OFF_GATE);
  const int tid = tid_opaque(), lane = tid & 63, wave = tid >> 6, wm = wave >> 1, wn = wave & 1;
  constexpr int NTN = INW / BN;
  constexpr int NTM = T_ / BM;
  for (int tile = blockIdx.x; tile < NTM * NTN; tile += gridDim.x) {
    const int tm = tile / NTN, tn = tile % NTN;
    const int m0 = tm * BM, n0 = tn * BN, b = m0 / S_;
    __syncthreads();
    stage_mod(mod, ada, b, 1, 0);
    __syncthreads();
    f32x16 acc[2][2]; acc_zero(acc);
    ALoadF32Mod al{p.x, mod};
    if (n0 < HYC) {
      gemm_mainloop<ALoadF32Mod, true>(acc, al, m0, wt, 1024, n0, 1024, smem);
#pragma unroll
      for (int mi = 0; mi < 2; ++mi) {
        const int t = (m0 & (S_ - 1)) + wm * 64 + mi * 32 + (lane & 31);
#pragma unroll
        for (int ni = 0; ni < 2; ++ni)
#pragma unroll
          for (int r = 0; r < 16; ++r) {
            const int ch = n0 + wn * 64 + ni * 32 + (r & 3) + 8 * (r >> 2) + 4 * (lane >> 5);
            ph[((size_t)(b * HYC + ch)) * S_ + t] = f2bf(acc[mi][ni][r]);
          }
      }
      continue;
    }
    gemm_mainloop(acc, al, m0, wt, 1024, n0, 1024, smem);
#pragma unroll
    for (int ni = 0; ni < 2; ++ni) {
      const int col = n0 + ACC_COL(ni);
#pragma unroll
      for (int mi = 0; mi < 2; ++mi) {
        if (col < HYC + QKVC) {
          const int cq = col - HYC;
          const bool rot = (cq < 1536) && ((cq & 63) < 16);
          const float qs = (cq < 768) ? 0.125f : 1.0f;
          const float inv = expf(-13.122363377404328f * (float)(cq & 7) * 0.125f);
#pragma unroll
          for (int r = 0; r < 16; ++r) {
            const int row = m0 + ACC_ROW(mi, r);
            float v = acc[mi][ni][r];
            float o = __shfl_xor(v, 8);
            if (rot) {
              float ang = (float)p.pos[row] * inv;
              float sn, cs; sincosf(ang, &sn, &cs);
              v = ((cq & 15) < 8) ? (v * cs - o * sn) : (v * cs + o * sn);
            }
            qkv[(size_t)row * QKVC + cq] = f2bf(v * qs);
          }
        } else {
          const int cg = col - HYC - QKVC;
#pragma unroll
          for (int r = 0; r < 16; ++r) {
            float v = acc[mi][ni][r];
            gate[(size_t)(m0 + ACC_ROW(mi, r)) * GATEC + cg] = f2bf(1.f / (1.f + __expf(-v)));
          }
        }
      }
    }
  }
}

DI float sconv_t(const ushort_t* row, int t, float w0, float w1, float w2, float cb) {
  float v = cb + w1 * bf2f(row[t]);
  if (t > 0) v += w0 * bf2f(row[t - 1]);
  if (t < S_ - 1) v += w2 * bf2f(row[t + 1]);
  return v;
}
DI void fft_C_mul_invC(cf2* lds, const cf2* __restrict__ kq, int tid) {
  asm volatile("" : "+v"(tid));
  const int k1 = tid >> 5, k2 = tid & 31;
  kq += tid;
#pragma unroll
  for (int h = 0; h < 2; ++h) {
    float tr[16], ti[16];
    cf2 kv[16];
#pragma unroll
    for (int i = 0; i < 16; ++i) kv[i] = kq[(h * 16 + i) * 512];
    cf2* blk = lds + (k1 + 16 * h) * FFT_SA + k2 * 17;
#pragma unroll
    for (int mp = 0; mp < 16; ++mp) { cf2 v = blk[mp]; tr[mp] = v.x; ti[mp] = v.y; }
    dft_fwd<16, false>(tr, ti);
#pragma unroll
    for (int i = 0; i < 16; ++i) { const float a = tr[i], b = ti[i]; tr[i] = a * kv[i].x - b * kv[i].y; ti[i] = a * kv[i].y + b * kv[i].x; }
    dft_inv<16>(tr, ti);
#pragma unroll
    for (int mp = 0; mp < 16; ++mp) { cf2 o; o.x = tr[mp]; o.y = ti[mp]; blk[mp] = o; }
  }
}
DI void hyena_item(const P& p, char* smem, int c) {
  cf2* lds = (cf2*)smem;
  const ushort_t* pht = (const ushort_t*)(p.ws + OFF_PH);
  ushort_t* yht = (ushort_t*)(p.ws + OFF_YH);
  cf2* kq = (cf2*)(p.ws + (blockIdx.x < 92 ? OFF_WIN_T + (size_t)blockIdx.x * 131072 : OFF_HSCR + (size_t)(blockIdx.x - 92) * 131072));
  const float* filt = p.out;
  const int tid0 = tid_opaque();
  float zr[32], zi[32];
  __syncthreads();
#pragma unroll 1
  for (int o = 0; o < 2; ++o) {
    int tid = tid0; asm volatile("" : "+v"(tid));
    {
      float kr[32], ki[32];
      const float* fw = filt + (size_t)(0 * 1024 + o * 512 + c) * S_;
      const float* bw = filt + (size_t)(1 * 1024 + o * 512 + c) * S_;
      const float bias = p.hy_bias[o * 512 + c];
#pragma unroll
      for (int n1 = 0; n1 < 16; ++n1) { kr[n1] = fw[n1 * 512 + tid] * (1.0f / 16384.0f); ki[n1] = 0.f; }
      if (tid == 0) kr[0] += bias * (1.0f / 16384.0f);
#pragma unroll
      for (int n1 = 16; n1 < 32; ++n1) {
        const int n = n1 * 512 + tid;
        kr[n1] = (n == S_) ? 0.f : bw[2 * S_ - n] * (1.0f / 16384.0f); ki[n1] = 0.f;
      }
      fft_fwdA<false>(kr, ki, lds, tid); __syncthreads();
      fft_B_read(kr, ki, lds, tid); __syncthreads();
      fft_fwdB_write(kr, ki, lds, tid); __syncthreads();
      fft_fwdC(kr, ki, lds, tid);
      int ts = tid; asm volatile("" : "+v"(ts));
      cf2* kqt = kq + ts;
#pragma unroll
      for (int r = 0; r < 32; ++r) { cf2 v; v.x = kr[r]; v.y = ki[r]; kqt[r * 512] = v; }
      __syncthreads();
    }
    asm volatile("" : "+v"(tid));
    if (o == 0) {
      const float w0 = p.hy_conv_w[c], w1 = p.hy_conv_w[HYC + c], w2 = p.hy_conv_w[2 * HYC + c], cb = p.hy_conv_b[c];
      const ushort_t* r0 = pht + (size_t)(0 * HYC + c) * S_;
      const ushort_t* r1 = pht + (size_t)(1 * HYC + c) * S_;
#pragma unroll
      for (int n1 = 0; n1 < 16; ++n1) {
        const int t = n1 * 512 + tid;
        zr[n1] = sconv_t(r0, t, w0, w1, w2, cb); zi[n1] = sconv_t(r1, t, w0, w1, w2, cb);
        if (n1 & 1) asm volatile("" ::: "memory");
      }
    }
#pragma unroll
    for (int n1 = 16; n1 < 32; ++n1) { zr[n1] = 0.f; zi[n1] = 0.f; }
    fft_fwdA<true>(zr, zi, lds, tid); __syncthreads();
    fft_B_read(zr, zi, lds, tid); __syncthreads();
    fft_fwdB_write(zr, zi, lds, tid); __syncthreads();
    fft_C_mul_invC(lds, kq, tid); __syncthreads();
    fft_invB_read(zr, zi, lds, tid); __syncthreads();
    fft_invB_write(zr, zi, lds, tid); __syncthreads();
    fft_invA(zr, zi, lds, tid);
    int tg = tid; asm volatile("" : "+v"(tg));
    const int gch = (o + 1) * 512 + c;
    const float w0 = p.hy_conv_w[gch], w1 = p.hy_conv_w[HYC + gch], w2 = p.hy_conv_w[2 * HYC + gch], cb = p.hy_conv_b[gch];
    const ushort_t* g0 = pht + (size_t)(0 * HYC + gch) * S_;
    const ushort_t* g1 = pht + (size_t)(1 * HYC + gch) * S_;
#pragma unroll
    for (int n1 = 0; n1 < 16; ++n1) {
      const int t = n1 * 512 + tg;
      zr[n1] *= sconv_t(g0, t, w0, w1, w2, cb);
      zi[n1] *= sconv_t(g1, t, w0, w1, w2, cb);
      if (n1 & 1) asm volatile("" ::: "memory");
    }
    if (o == 1) {
#pragma unroll
      for (int n1 = 0; n1 < 16; ++n1) {
        const int t = n1 * 512 + tg;
        yht[(size_t)(0 * HW_ + c) * S_ + t] = f2bf(zr[n1]);
        yht[(size_t)(1 * HW_ + c) * S_ + t] = f2bf(zi[n1]);
      }
    }
  }
}

DI void attn_item(const P& p, int item) {
  const ushort_t* qkv = (const ushort_t*)(p.ws + OFF_QKV);
  ushort_t* ya = (ushort_t*)(p.ws + OFF_YA);
  {
    int tx = threadIdx.x;
    asm volatile("" : "+v"(tx));
    const int hs = tx >> 7;
    const int tok = item * 128 + (tx & 127);
    const int b = tok / S_, t = tok % S_;
    float acc[64];
#pragma unroll
    for (int e = 0; e < 64; ++e) acc[e] = 0.f;
    float m = -1e30f, l = 0.f;
    for (int g = 0; g < 3; ++g) {
      const int dil = (g == 0) ? 1 : (g == 1 ? 4 : 16);
      const int head = g * 4 + hs;
      float q[64];
      {
        const ushort_t* qp = qkv + (size_t)tok * QKVC + head * 64;
#pragma unroll
        for (int e8 = 0; e8 < 8; ++e8) {
          u32x4 v = *(const u32x4*)(qp + e8 * 8);
#pragma unroll
          for (int w = 0; w < 4; ++w) { q[e8 * 8 + 2 * w] = __uint_as_float(v[w] << 16); q[e8 * 8 + 2 * w + 1] = __uint_as_float(v[w] & 0xffff0000u); }
        }
      }
      for (int j = -64; j <= 64; ++j) {
        const int tk = t + dil * j;
        if (tk < 0 || tk >= S_) continue;
        const ushort_t* kp = qkv + (size_t)(b * S_ + tk) * QKVC + 768 + head * 64;
        float s = 0.f;
#pragma unroll
        for (int e8 = 0; e8 < 8; ++e8) {
          u32x4 v = *(const u32x4*)(kp + e8 * 8);
#pragma unroll
          for (int w = 0; w < 4; ++w) { s += q[e8 * 8 + 2 * w] * __uint_as_float(v[w] << 16); s += q[e8 * 8 + 2 * w + 1] * __uint_as_float(v[w] & 0xffff0000u); }
        }
        const float mn = fmaxf(m, s);
        const float corr = __expf(m - mn), pe = __expf(s - mn);
        l = l * corr + pe; m = mn;
        const ushort_t* vp = kp + 768;
#pragma unroll
        for (int e8 = 0; e8 < 8; ++e8) {
          u32x4 v = *(const u32x4*)(vp + e8 * 8);
#pragma unroll
          for (int w = 0; w < 4; ++w) {
            acc[e8 * 8 + 2 * w] = acc[e8 * 8 + 2 * w] * corr + pe * __uint_as_float(v[w] << 16);
            acc[e8 * 8 + 2 * w + 1] = acc[e8 * 8 + 2 * w + 1] * corr + pe * __uint_as_float(v[w] & 0xffff0000u);
          }
        }
      }
    }
    const float il = 1.f / l;
    ushort_t* op = ya + (size_t)tok * 256 + hs * 64;
#pragma unroll
    for (int e8 = 0; e8 < 8; ++e8) {
      u32x4 o;
#pragma unroll
      for (int w = 0; w < 4; ++w) o[w] = pack2(acc[e8 * 8 + 2 * w] * il, acc[e8 * 8 + 2 * w + 1] * il);
      *(u32x4*)(op + e8 * 8) = o;
    }
  }
}

DI void phase_merge(const P& p, char* smem) {
  const ushort_t* yh = (const ushort_t*)(p.ws + OFF_YH);
  const ushort_t* ya = (const ushort_t*)(p.ws + OFF_YA);
  const ushort_t* gate = (const ushort_t*)(p.ws + OFF_GATE);
  ushort_t* merged = (ushort_t*)(p.ws + OFF_MERGED);
  const int tid = tid_opaque(), lane = tid & 63, wave = tid >> 6, wm = wave >> 1, wn = wave & 1;
  constexpr int NTN = 1024 / BN, NTM = T_ / BM;
  for (int tile = blockIdx.x; tile < NTM * NTN; tile += gridDim.x) {
    const int m0 = (tile / NTN) * BM, n0 = (tile % NTN) * BN;
    f32x16 a1[2][2], a2[2][2]; acc_zero(a1); acc_zero(a2);
    gemm_mainloop_AT(a1, yh + (size_t)((m0 / S_) * HW_) * S_ + (m0 & (S_ - 1)), (size_t)S_, (const ushort_t*)(p.ws + OFF_WBH_T), 512, n0, 512, smem);
    ALoadBf16 l2{ya, 256};
    gemm_mainloop(a2, l2, m0, (const ushort_t*)(p.ws + OFF_WBA_T), 256, n0, 256, smem);
#pragma unroll
    for (int mi = 0; mi < 2; ++mi)
#pragma unroll
      for (int ni = 0; ni < 2; ++ni)
#pragma unroll
        for (int r = 0; r < 16; ++r) {
          const int row = m0 + ACC_ROW(mi, r), col = n0 + ACC_COL(ni);
          float gh = bf2f(gate[(size_t)row * GATEC + col]), ga = bf2f(gate[(size_t)row * GATEC + 1024 + col]);
          merged[(size_t)row * 1024 + col] = f2bf(gh * a1[mi][ni][r] + ga * a2[mi][ni][r]);
        }
  }
}

DI void phase_outproj(const P& p, char* smem) {
  const float* ada = (const float*)(p.ws + OFF_ADA);
  const ushort_t* merged = (const ushort_t*)(p.ws + OFF_MERGED);
  const int tid = tid_opaque(), lane = tid & 63, wave = tid >> 6, wm = wave >> 1, wn = wave & 1;
  constexpr int NTN = 1024 / BN, NTM = T_ / BM;
  for (int tile = blockIdx.x; tile < NTM * NTN; tile += gridDim.x) {
    const int m0 = (tile / NTN) * BM, n0 = (tile % NTN) * BN, b = m0 / S_;
    f32x16 acc[2][2]; acc_zero(acc);
    ALoadBf16 l1{merged, 1024};
    gemm_mainloop(acc, l1, m0, (const ushort_t*)(p.ws + OFF_WOUT_T), 1024, n0, 1024, smem);
#pragma unroll
    for (int ni = 0; ni < 2; ++ni) {
      const int col = n0 + ACC_COL(ni);
      const float g1 = 1.f + ada[b * 6144 + 2 * 1024 + col];
#pragma unroll
      for (int mi = 0; mi < 2; ++mi)
#pragma unroll
        for (int r = 0; r < 16; ++r) {
          const size_t o = (size_t)(m0 + ACC_ROW(mi, r)) * 1024 + col;
          p.out[o] = DN_ALPHA * p.x[o] + g1 * acc[mi][ni][r];
        }
    }
  }
}

DI void phase_ln(float* __restrict__ xio, const float* __restrict__ g, const float* __restrict__ bta) {
  const int tq = tid_opaque(); const int lane = tq & 63, wave = tq >> 6;
  for (int row = blockIdx.x * 8 + wave; row < T_; row += gridDim.x * 8) {
    float* rp = xio + (size_t)row * 1024;
    f32x4 v[4];
    float s = 0.f;
#pragma unroll
    for (int i = 0; i < 4; ++i) { v[i] = *(const f32x4*)(rp + i * 256 + lane * 4); s += v[i][0] + v[i][1] + v[i][2] + v[i][3]; }
    const float mu = wave_sum(s) * (1.f / 1024.f);
    float q = 0.f;
#pragma unroll
    for (int i = 0; i < 4; ++i)
#pragma unroll
      for (int j = 0; j < 4; ++j) { float d = v[i][j] - mu; q += d * d; }
    const float rs = rsqrtf(wave_sum(q) * (1.f / 1024.f) + LN_EPS);
#pragma unroll
    for (int i = 0; i < 4; ++i) {
      f32x4 gg = *(const f32x4*)(g + i * 256 + lane * 4), bb = *(const f32x4*)(bta + i * 256 + lane * 4), o;
#pragma unroll
      for (int j = 0; j < 4; ++j) o[j] = (v[i][j] - mu) * rs * gg[j] + bb[j];
      *(f32x4*)(rp + i * 256 + lane * 4) = o;
    }
  }
}

DI void phase_peerq(const P& p, char* smem) {
  const float* ada = (const float*)(p.ws + OFF_ADA);
  float* mod = (float*)(smem + 2 * LDS_STAGE);
  float* q32 = (float*)(p.ws + OFF_Q32);
  const int tid = tid_opaque(), lane = tid & 63, wave = tid >> 6, wm = wave >> 1, wn = wave & 1;
  constexpr int NTN = 2048 / BN, NTM = T_ / BM;
  for (int tile = blockIdx.x; tile < NTM * NTN; tile += gridDim.x) {
    const int m0 = (tile / NTN) * BM, n0 = (tile % NTN) * BN, b = m0 / S_;
    __syncthreads();
    stage_mod(mod, ada, b, 4, 3);
    __syncthreads();
    f32x16 acc[2][2]; acc_zero(acc);
    ALoadF32Mod al{p.out, mod};
    gemm_mainloop(acc, al, m0, (const ushort_t*)(p.ws + OFF_WQ_T), 1024, n0, 1024, smem);
#pragma unroll
    for (int mi = 0; mi < 2; ++mi)
#pragma unroll
      for (int ni = 0; ni < 2; ++ni)
#pragma unroll
        for (int r = 0; r < 16; ++r) q32[(size_t)(m0 + ACC_ROW(mi, r)) * 2048 + n0 + ACC_COL(ni)] = acc[mi][ni][r];
  }
}

struct TopkLds {
  float sq[8][256]; float ssc[8][2][128]; float scand[8][256]; float ssv[8][2][16]; int ssi[8][2][16];
  int lidx[8][128]; float lgv[8][128];
};
DI void topk_token(const P& p, TopkLds& L, int tok, int slot) {
  const float* q32 = (const float*)(p.ws + OFF_Q32);
  const int tq = tid_opaque(); const int lane = tq & 63, h = tq >> 6;
  __syncthreads();
  {
    const float* qp = q32 + (size_t)tok * 2048 + h * 256;
    *(f32x4*)&L.sq[h][lane * 4] = *(const f32x4*)(qp + lane * 4);
  }
  __syncthreads();
#pragma unroll
  for (int pp = 0; pp < 2; ++pp)
#pragma unroll
    for (int half = 0; half < 2; ++half) {
      const int k = lane + 64 * half;
      const float* kp = p.keys + ((size_t)((h * 2 + pp) * 128 + k)) * 128;
      float s = 0.f;
#pragma unroll 8
      for (int e4 = 0; e4 < 32; ++e4) {
        f32x4 kv = *(const f32x4*)(kp + e4 * 4);
        f32x4 qv = *(const f32x4*)&L.sq[h][pp * 128 + e4 * 4];
        s += kv[0] * qv[0] + kv[1] * qv[1] + kv[2] * qv[2] + kv[3] * qv[3];
      }
      L.ssc[h][pp][k] = s;
    }
  __syncthreads();
#pragma unroll
  for (int pp = 0; pp < 2; ++pp) {
    const float va = L.ssc[h][pp][lane], vb = L.ssc[h][pp][lane + 64];
    int ra = 0, rb = 0;
    for (int j4 = 0; j4 < 32; ++j4) {
      f32x4 o = *(const f32x4*)&L.ssc[h][pp][j4 * 4];
#pragma unroll
      for (int u = 0; u < 4; ++u) {
        const int j = j4 * 4 + u;
        ra += (o[u] > va || (o[u] == va && j < lane)) ? 1 : 0;
        rb += (o[u] > vb || (o[u] == vb && j < lane + 64)) ? 1 : 0;
      }
    }
    if (ra < 16) { L.ssv[h][pp][ra] = va; L.ssi[h][pp][ra] = lane; }
    if (rb < 16) { L.ssv[h][pp][rb] = vb; L.ssi[h][pp][rb] = lane + 64; }
  }
  __syncthreads();
  float cv[4];
#pragma unroll
  for (int u = 0; u < 4; ++u) { const int ci = lane + 64 * u; cv[u] = L.ssv[h][0][ci >> 4] + L.ssv[h][1][ci & 15]; L.scand[h][ci] = cv[u]; }
  __syncthreads();
  int rk[4] = {0, 0, 0, 0};
  for (int j4 = 0; j4 < 64; ++j4) {
    f32x4 o = *(const f32x4*)&L.scand[h][j4 * 4];
#pragma unroll
    for (int w = 0; w < 4; ++w) {
      const int j = j4 * 4 + w;
#pragma unroll
      for (int u = 0; u < 4; ++u) rk[u] += (o[w] > cv[u] || (o[w] == cv[u] && j < lane + 64 * u)) ? 1 : 0;
    }
  }
  __syncthreads();
#pragma unroll
  for (int u = 0; u < 4; ++u)
    if (rk[u] < 16) {
      const int ci = lane + 64 * u;
      L.ssc[h][0][rk[u]] = cv[u];
      L.ssc[h][1][rk[u]] = __int_as_float(L.ssi[h][0][ci >> 4] * 128 + L.ssi[h][1][ci & 15]);
    }
  __syncthreads();
  {
    const float v = L.ssc[h][0][lane & 15];
    const float mx = L.ssc[h][0][0];
    float e = __expf(v - mx);
    float s = e;
#pragma unroll
    for (int o = 8; o > 0; o >>= 1) s += __shfl_xor(s, o);
    if (lane < 16) {
      L.lidx[slot][h * 16 + lane] = __float_as_int(L.ssc[h][1][lane]);
      L.lgv[slot][h * 16 + lane] = e / s;
    }
  }
}

DI void phase_peer(const P& p, char* smem) {
  TopkLds& L = *(TopkLds*)smem;
  const float* ada = (const float*)(p.ws + OFF_ADA);
  const int tq = tid_opaque(); const int lane = tq & 63, wave = tq >> 6;
  for (int grp = blockIdx.x; grp < T_ / 8; grp += gridDim.x) {
    for (int s = 0; s < 8; ++s) topk_token(p, L, grp * 8 + s, s);
    __syncthreads();
    const int tok = grp * 8 + wave;
    const int b = tok / S_;
    float* rp = p.out + (size_t)tok * 1024;
    f32x4 x1[4], u2[4], acc[4];
#pragma unroll
    for (int i = 0; i < 4; ++i) {
      const int col = i * 256 + lane * 4;
      x1[i] = *(const f32x4*)(rp + col);
      f32x4 sc = *(const f32x4*)(ada + b * 6144 + 4 * 1024 + col), sh = *(const f32x4*)(ada + b * 6144 + 3 * 1024 + col);
#pragma unroll
      for (int j = 0; j < 4; ++j) { u2[i][j] = x1[i][j] * (1.f + sc[j]) + sh[j]; acc[i][j] = 0.f; }
    }
    for (int s = 0; s < 128; ++s) {
      const int e = __builtin_amdgcn_readfirstlane(L.lidx[wave][s]);
      const float g = L.lgv[wave][s];
      const float* ur = p.pu + (size_t)e * 1024;
      const float* vr = p.pv + (size_t)e * 1024;
      float d = 0.f;
#pragma unroll
      for (int i = 0; i < 4; ++i) {
        f32x4 u = *(const f32x4*)(ur + i * 256 + lane * 4);
        d += u[0] * u2[i][0] + u[1] * u2[i][1] + u[2] * u2[i][2] + u[3] * u2[i][3];
      }
      const float a = wave_sum(d);
      const float coef = g * 0.5f * a * (1.f + erff(a * 0.7071067811865475f));
#pragma unroll
      for (int i = 0; i < 4; ++i) {
        f32x4 v = *(const f32x4*)(vr + i * 256 + lane * 4);
#pragma unroll
        for (int j = 0; j < 4; ++j) acc[i][j] += coef * v[j];
      }
    }
    float sm = 0.f;
#pragma unroll
    for (int i = 0; i < 4; ++i) {
      const int col = i * 256 + lane * 4;
      f32x4 g2 = *(const f32x4*)(ada + b * 6144 + 5 * 1024 + col);
#pragma unroll
      for (int j = 0; j < 4; ++j) { acc[i][j] = DN_ALPHA * x1[i][j] + (1.f + g2[j]) * acc[i][j]; sm += acc[i][j]; }
    }
    const float mu = wave_sum(sm) * (1.f / 1024.f);
    float q = 0.f;
#pragma unroll
    for (int i = 0; i < 4; ++i)
#pragma unroll
      for (int j = 0; j < 4; ++j) { float d = acc[i][j] - mu; q += d * d; }
    const float rs = rsqrtf(wave_sum(q) * (1.f / 1024.f) + LN_EPS);
#pragma unroll
    for (int i = 0; i < 4; ++i) {
      const int col = i * 256 + lane * 4;
      f32x4 gg = *(const f32x4*)(p.ln2_g + col), bb = *(const f32x4*)(p.ln2_b + col), o;
#pragma unroll
      for (int j = 0; j < 4; ++j) o[j] = (acc[i][j] - mu) * rs * gg[j] + bb[j];
      *(f32x4*)(rp + col) = o;
    }
  }
}

constexpr int SMEM_BYTES = 143360;
__global__ void __launch_bounds__(NT) fwd_megakernel(P p) {
  __shared__ __attribute__((aligned(16))) char smem[SMEM_BYTES];
  cooperative_groups::grid_group grid = cooperative_groups::this_grid();
  phase_ada(p, smem);
  phase_transposes(p, smem);
  phase_filter(p, smem);
  grid.sync();
  phase_inproj(p, smem);
  grid.sync();
  for (int item = blockIdx.x; item < 512 + 128; item += gridDim.x) {
    if (item < 512) hyena_item(p, smem, item);
    else attn_item(p, item - 512);
  }
  grid.sync();
  phase_merge(p, smem);
  grid.sync();
  phase_outproj(p, smem);
  grid.sync();
  phase_ln(p.out, p.ln1_g, p.ln1_b);
  grid.sync();
  phase_peerq(p, smem);
  grid.sync();
  phase_peer(p, smem);
}

extern "C" void kernel_launch(void* const* d_in, const int* in_sizes, int n_in, void* d_out, int out_size, void* d_ws, size_t ws_size,
                              hipStream_t stream) {
  P p{};
  p.x = (const float*)d_in[0]; p.c = (const float*)d_in[1]; p.pos = (const int*)d_in[2];
  p.w_ada = (const float*)d_in[3]; p.b_ada = (const float*)d_in[4]; p.w_in = (const float*)d_in[5];
  p.hy_conv_w = (const float*)d_in[6]; p.hy_conv_b = (const float*)d_in[7];
  p.f1_w = (const float*)d_in[8]; p.f1_b = (const float*)d_in[9]; p.f1_freq = (const float*)d_in[10];
  p.f2_w = (const float*)d_in[11]; p.f2_b = (const float*)d_in[12]; p.f2_freq = (const float*)d_in[13];
  p.f3_w = (const float*)d_in[14]; p.hy_bias = (const float*)d_in[15];
  p.w_bh = (const float*)d_in[16]; p.w_ba = (const float*)d_in[17]; p.w_out = (const float*)d_in[18];
  p.ln1_g = (const float*)d_in[19]; p.ln1_b = (const float*)d_in[20];
  p.wq = (const float*)d_in[21]; p.keys = (const float*)d_in[22]; p.pu = (const float*)d_in[23]; p.pv = (const float*)d_in[24];
  p.ln2_g = (const float*)d_in[25]; p.ln2_b = (const float*)d_in[26];
  p.out = (float*)d_out; p.ws = (char*)d_ws;

  static int grid_blocks = 0;
  if (!grid_blocks) {
    int dev = 0, cus = 0, per_cu = 0;
    hipGetDevice(&dev);
    hipDeviceGetAttribute(&cus, hipDeviceAttributeMultiprocessorCount, dev);
    hipOccupancyMaxActiveBlocksPerMultiprocessor(&per_cu, fwd_megakernel, NT, 0);
    if (per_cu > 1) per_cu = 1;
    grid_blocks = cus * per_cu;
  }
  void* args[] = {&p};
  hipError_t e = hipLaunchCooperativeKernel((void*)fwd_megakernel, dim3(grid_blocks), dim3(NT), args, 0, stream);
  if (e != hipSuccess) fprintf(stderr, "cooperative launch failed: %s (grid %d)\n", hipGetErrorString(e), grid_blocks);
}
```

```cpp
#include <hip/hip_runtime.h>
#include <hip/hip_cooperative_groups.h>
#include <cstdio>
#include <cstdint>

#define DI __device__ __forceinline__
typedef unsigned short ushort_t;
typedef __attribute__((ext_vector_type(8))) short bf16x8;
typedef __attribute__((ext_vector_type(16))) float f32x16;
typedef __attribute__((ext_vector_type(4))) float f32x4;
typedef __attribute__((ext_vector_type(4))) unsigned u32x4;

constexpr int T_ = 16384, S_ = 8192, NB = 2, D_ = 1024;
constexpr int HW_ = 512, HYC = 1536, QKVC = 2304, GATEC = 2048, INW = 5888;
constexpr int NT = 512;
constexpr float DN_ALPHA = 1.189207115002721f;
constexpr float LN_EPS = 1e-5f;

constexpr size_t OFF_ADA   = 0;
constexpr size_t OFF_KEYS_B= 65536;
constexpr size_t OFF_WIN_T = 65536 + 524288;
constexpr size_t OFF_WQ_T  = OFF_WIN_T + (size_t)INW * 1024 * 2;
constexpr size_t OFF_WOUT_T= OFF_WQ_T + (size_t)2048 * 1024 * 2;
constexpr size_t OFF_WBH_T = OFF_WOUT_T + (size_t)1024 * 1024 * 2;
constexpr size_t OFF_WBA_T = OFF_WBH_T + (size_t)1024 * 512 * 2;
constexpr size_t OFF_PH    = OFF_WBA_T + (size_t)1024 * 256 * 2;
constexpr size_t OFF_QKV   = OFF_PH + (size_t)T_ * HYC * 2;
constexpr size_t OFF_GATE  = OFF_QKV + (size_t)T_ * QKVC * 2;
constexpr size_t OFF_YH    = OFF_GATE + (size_t)T_ * GATEC * 2;
constexpr size_t OFF_YA    = OFF_YH + (size_t)T_ * HW_ * 2;
constexpr size_t OFF_END   = OFF_YA + (size_t)T_ * 256 * 2;
constexpr size_t OFF_MERGED= OFF_PH;
constexpr size_t OFF_IDX   = OFF_YH;
constexpr size_t OFF_GV    = OFF_YH + (size_t)T_ * 128 * 4;
constexpr size_t OFF_HSCR  = OFF_END;
static_assert(OFF_HSCR + (size_t)164 * 131072 <= 268435456ull, "ws overflow");
static_assert((size_t)92 * 131072 <= (size_t)INW * 1024 * 2, "w_in^T region too small");

struct P {
  const float *x, *c; const int* pos;
  const float *w_ada, *b_ada, *w_in, *hy_conv_w, *hy_conv_b, *f1_w, *f1_b, *f1_freq, *f2_w, *f2_b, *f2_freq, *f3_w,
      *hy_bias, *w_bh, *w_ba, *w_out, *ln1_g, *ln1_b, *wq, *keys, *pu, *pv, *ln2_g, *ln2_b;
  float* out; char* ws;
};

DI ushort_t f2bf(float x) { unsigned u = __float_as_uint(x); u += 0x7fffu + ((u >> 16) & 1u); return (ushort_t)(u >> 16); }
DI float bf2f(ushort_t h) { return __uint_as_float(((unsigned)h) << 16); }
DI unsigned pack2(float a, float b) { return (unsigned)f2bf(a) | ((unsigned)f2bf(b) << 16); }
DI int tid_opaque() { int t = threadIdx.x; asm volatile("" : "+v"(t)); return t; }
DI float wave_sum(float v) {
#pragma unroll
  for (int o = 32; o > 0; o >>= 1) v += __shfl_xor(v, o);
  return v;
}

struct cf2 { float x, y; };
constexpr int FFT_N = 16384, FFT_SA = 560;

DI constexpr float wcos32(int j) {
  switch (j & 31) {
    case 0: return 1.0f; case 1: return 0.98078528040323043f; case 2: return 0.92387953251128674f; case 3: return 0.83146961230254524f;
    case 4: return 0.70710678118654752f; case 5: return 0.55557023301960218f; case 6: return 0.38268343236508978f; case 7: return 0.19509032201612825f;
    case 8: return 0.0f; case 9: return -0.19509032201612825f; case 10: return -0.38268343236508978f; case 11: return -0.55557023301960218f;
    case 12: return -0.70710678118654752f; case 13: return -0.83146961230254524f; case 14: return -0.92387953251128674f; case 15: return -0.98078528040323043f;
    case 16: return -1.0f; case 17: return -0.98078528040323043f; case 18: return -0.92387953251128674f; case 19: return -0.83146961230254524f;
    case 20: return -0.70710678118654752f; case 21: return -0.55557023301960218f; case 22: return -0.38268343236508978f; case 23: return -0.19509032201612825f;
    case 24: return 0.0f; case 25: return 0.19509032201612825f; case 26: return 0.38268343236508978f; case 27: return 0.55557023301960218f;
    case 28: return 0.70710678118654752f; case 29: return 0.83146961230254524f; case 30: return 0.92387953251128674f; default: return 0.98078528040323043f;
  }
}
DI constexpr float wsin32(int j) { return wcos32(j + 24); }
DI constexpr int brev(int v, int bits) { int r = 0; for (int i = 0; i < bits; ++i) r |= ((v >> i) & 1) << (bits - 1 - i); return r; }

template <int R, int LEN, bool INV, bool ZHI>
DI void r2_stage(float (&re)[R], float (&im)[R]) {
  constexpr int half = LEN / 2;
#pragma unroll
  for (int start = 0; start < R; start += LEN) {
#pragma unroll
    for (int j = 0; j < half; ++j) {
      const int a = start + j, b = a + half;
      const int tj = j * (32 / LEN);
      const float c = wcos32(tj), s = wsin32(tj);
      if (!INV) {
        float dr, di;
        if (ZHI) { dr = re[a]; di = im[a]; }
        else {
          const float ar = re[a], ai = im[a], br = re[b], bi = im[b];
          re[a] = ar + br; im[a] = ai + bi; dr = ar - br; di = ai - bi;
        }
        if (tj == 0) { re[b] = dr; im[b] = di; }
        else if (tj == 8) { re[b] = di; im[b] = -dr; }
        else { re[b] = dr * c + di * s; im[b] = di * c - dr * s; }
      } else {
        const float br = re[b], bi = im[b];
        float pr, pi;
        if (tj == 0) { pr = br; pi = bi; }
        else if (tj == 8) { pr = -bi; pi = br; }
        else { pr = br * c - bi * s; pi = bi * c + br * s; }
        const float ar = re[a], ai = im[a];
        re[a] = ar + pr; im[a] = ai + pi; re[b] = ar - pr; im[b] = ai - pi;
      }
    }
  }
}
template <int R, bool ZHI> DI void dft_fwd(float (&re)[R], float (&im)[R]) {
  if (R == 32) r2_stage<R, (R == 32 ? 32 : 2), false, ZHI>(re, im);
  r2_stage<R, 16, false, (R == 16) && ZHI>(re, im);
  r2_stage<R, 8, false, false>(re, im);
  r2_stage<R, 4, false, false>(re, im);
  r2_stage<R, 2, false, false>(re, im);
}
template <int R> DI void dft_inv(float (&re)[R], float (&im)[R]) {
  r2_stage<R, 2, true, false>(re, im);
  r2_stage<R, 4, true, false>(re, im);
  r2_stage<R, 8, true, false>(re, im);
  r2_stage<R, 16, true, false>(re, im);
  if (R == 32) r2_stage<R, (R == 32 ? 32 : 2), true, false>(re, im);
}

DI void sincos_turn(float frac, float& s, float& c) { sincospif(2.0f * frac, &s, &c); }

template <bool ZHI>
DI void fft_fwdA(float (&re)[32], float (&im)[32], cf2* lds, int m) {
  asm volatile("" : "+v"(m));
  float s1, c1; sincos_turn((float)m * (1.0f / 16384.0f), s1, c1);
  __builtin_amdgcn_sched_barrier(0);
  dft_fwd<32, ZHI>(re, im);
  __builtin_amdgcn_sched_barrier(0);
  float wr = 1.f, wi = 0.f;
#pragma unroll
  for (int k1 = 0; k1 < 32; ++k1) {
    if ((k1 & 3) == 0) __builtin_amdgcn_sched_barrier(0);
    const int r = brev(k1, 5);
    cf2 o; o.x = re[r] * wr - im[r] * wi; o.y = re[r] * wi + im[r] * wr;
    lds[k1 * FFT_SA + m] = o;
    const float nr = wr * c1 + wi * s1, ni = wi * c1 - wr * s1;
    wr = nr; wi = ni;
  }
}
DI void fft_B_read(float (&re)[32], float (&im)[32], const cf2* lds, int tid) {
  const int k1 = tid >> 4, mp = tid & 15;
#pragma unroll
  for (int n2 = 0; n2 < 32; ++n2) { cf2 v = lds[k1 * FFT_SA + n2 * 16 + mp]; re[n2] = v.x; im[n2] = v.y; }
}
DI void fft_fwdB_write(float (&re)[32], float (&im)[32], cf2* lds, int tid) {
  asm volatile("" : "+v"(tid));
  const int k1 = tid >> 4, mp = tid & 15;
  float s1, c1; sincos_turn((float)mp * (1.0f / 512.0f), s1, c1);
  __builtin_amdgcn_sched_barrier(0);
  dft_fwd<32, false>(re, im);
  __builtin_amdgcn_sched_barrier(0);
  float wr = 1.f, wi = 0.f;
#pragma unroll
  for (int k2 = 0; k2 < 32; ++k2) {
    if ((k2 & 3) == 0) __builtin_amdgcn_sched_barrier(0);
    const int r = brev(k2, 5);
    cf2 o; o.x = re[r] * wr - im[r] * wi; o.y = re[r] * wi + im[r] * wr;
    lds[k1 * FFT_SA + k2 * 17 + mp] = o;
    const float nr = wr * c1 + wi * s1, ni = wi * c1 - wr * s1;
    wr = nr; wi = ni;
  }
}
DI void fft_fwdC(float (&re)[32], float (&im)[32], const cf2* lds, int tid) {
  const int k1 = tid >> 5, k2 = tid & 31;
#pragma unroll
  for (int h = 0; h < 2; ++h) {
    float tr[16], ti[16];
#pragma unroll
    for (int mp = 0; mp < 16; ++mp) { cf2 v = lds[(k1 + 16 * h) * FFT_SA + k2 * 17 + mp]; tr[mp] = v.x; ti[mp] = v.y; }
    dft_fwd<16, false>(tr, ti);
#pragma unroll
    for (int i = 0; i < 16; ++i) { re[h * 16 + i] = tr[i]; im[h * 16 + i] = ti[i]; }
  }
}
DI void fft_invC(float (&re)[32], float (&im)[32], cf2* lds, int tid) {
  const int k1 = tid >> 5, k2 = tid & 31;
#pragma unroll
  for (int h = 0; h < 2; ++h) {
    float tr[16], ti[16];
#pragma unroll
    for (int i = 0; i < 16; ++i) { tr[i] = re[h * 16 + i]; ti[i] = im[h * 16 + i]; }
    dft_inv<16>(tr, ti);
#pragma unroll
    for (int mp = 0; mp < 16; ++mp) { cf2 o; o.x = tr[mp]; o.y = ti[mp]; lds[(k1 + 16 * h) * FFT_SA + k2 * 17 + mp] = o; }
  }
}
DI void fft_invB_read(float (&re)[32], float (&im)[32], const cf2* lds, int tid) {
  asm volatile("" : "+v"(tid));
  const int k1 = tid >> 4, mp = tid & 15;
  float s1, c1; sincos_turn((float)mp * (1.0f / 512.0f), s1, c1);
  float wr = 1.f, wi = 0.f;
  __builtin_amdgcn_sched_barrier(0);
#pragma unroll
  for (int k2 = 0; k2 < 32; ++k2) {
    if ((k2 & 3) == 0) __builtin_amdgcn_sched_barrier(0);
    const int r = brev(k2, 5);
    cf2 v = lds[k1 * FFT_SA + k2 * 17 + mp];
    re[r] = v.x * wr - v.y * wi; im[r] = v.x * wi + v.y * wr;
    const float nr = wr * c1 - wi * s1, ni = wi * c1 + wr * s1;
    wr = nr; wi = ni;
  }
}
DI void fft_invB_write(float (&re)[32], float (&im)[32], cf2* lds, int tid) {
  const int k1 = tid >> 4, mp = tid & 15;
  dft_inv<32>(re, im);
#pragma unroll
  for (int n2 = 0; n2 < 32; ++n2) { cf2 o; o.x = re[n2]; o.y = im[n2]; lds[k1 * FFT_SA + n2 * 16 + mp] = o; }
}
DI void fft_invA(float (&re)[32], float (&im)[32], const cf2* lds, int m) {
  asm volatile("" : "+v"(m));
  float s1, c1; sincos_turn((float)m * (1.0f / 16384.0f), s1, c1);
  float wr = 1.f, wi = 0.f;
  __builtin_amdgcn_sched_barrier(0);
#pragma unroll
  for (int k1 = 0; k1 < 32; ++k1) {
    if ((k1 & 3) == 0) __builtin_amdgcn_sched_barrier(0);
    const int r = brev(k1, 5);
    cf2 v = lds[k1 * FFT_SA + m];
    re[r] = v.x * wr - v.y * wi; im[r] = v.x * wi + v.y * wr;
    const float nr = wr * c1 - wi * s1, ni = wi * c1 + wr * s1;
    wr = nr; wi = ni;
  }
  __builtin_amdgcn_sched_barrier(0);
  dft_inv<32>(re, im);
}

DI void phase_ada(const P& p, char* smem) {
  float (*red)[8][64] = (float (*)[8][64])smem;
  const int tid = tid_opaque(), cl = tid & 63, kq = tid >> 6;
  for (int item = blockIdx.x; item < 96; item += gridDim.x) {
    const int col = item * 64 + cl;
    float a0 = 0.f, a1 = 0.f;
    for (int k = kq * 128; k < kq * 128 + 128; ++k) {
      float w = p.w_ada[(size_t)k * 6144 + col];
      float c0 = p.c[k], c1 = p.c[1024 + k];
      a0 += (c0 / (1.f + __expf(-c0))) * w;
      a1 += (c1 / (1.f + __expf(-c1))) * w;
    }
    __syncthreads();
    red[0][kq][cl] = a0; red[1][kq][cl] = a1;
    __syncthreads();
    if (tid < 128) {
      int b = tid >> 6;
      float s = p.b_ada[col];
#pragma unroll
      for (int q = 0; q < 8; ++q) s += red[b][q][cl];
      ((float*)(p.ws + OFF_ADA))[b * 6144 + col] = s;
    }
  }
}

DI void transpose_tile(const float* __restrict__ W, ushort_t* __restrict__ Wt, int K, int N, int item, char* smem) {
  float (*tile)[65] = (float (*)[65])smem;
  const int ntn = N / 64;
  const int n0 = (item % ntn) * 64, k0 = (item / ntn) * 32;
  const int tid = tid_opaque();
  __syncthreads();
  {
    const int tx = tid & 63, ty = tid >> 6;
#pragma unroll
    for (int i = 0; i < 4; ++i) tile[ty + 8 * i][tx] = W[(size_t)(k0 + ty + 8 * i) * N + n0 + tx];
  }
  __syncthreads();
  {
    const int kk = tid & 31, nn0 = tid >> 5;
#pragma unroll
    for (int i = 0; i < 4; ++i) Wt[(size_t)(n0 + nn0 + 16 * i) * K + k0 + kk] = f2bf(tile[kk][nn0 + 16 * i]);
  }
}
DI void phase_transposes(const P& p, char* smem) {
  constexpr int I0 = (INW / 64) * 32, I1 = I0 + 32 * 32, I2 = I1 + 16 * 32, I3 = I2 + 16 * 16, I4 = I3 + 16 * 8;
  for (int item = blockIdx.x; item < I4; item += gridDim.x) {
    if (item < I0) transpose_tile(p.w_in, (ushort_t*)(p.ws + OFF_WIN_T), 1024, INW, item, smem);
    else if (item < I1) transpose_tile(p.wq, (ushort_t*)(p.ws + OFF_WQ_T), 1024, 2048, item - I0, smem);
    else if (item < I2) transpose_tile(p.w_out, (ushort_t*)(p.ws + OFF_WOUT_T), 1024, 1024, item - I1, smem);
    else if (item < I3) transpose_tile(p.w_bh, (ushort_t*)(p.ws + OFF_WBH_T), 512, 1024, item - I2, smem);
    else transpose_tile(p.w_ba, (ushort_t*)(p.ws + OFF_WBA_T), 256, 1024, item - I3, smem);
  }
}

DI void phase_filter(const P& p, char* smem) {
  float (*zf)[33] = (float (*)[33])smem;
  float (*h1)[64] = (float (*)[64])(smem + 4352);
  float (*h2T)[32] = (float (*)[32])(smem + 4352 + 8192);
  const int tid = tid_opaque();
  for (int item = blockIdx.x; item < 256; item += gridDim.x) {
  const int t0 = item * 32;
  __syncthreads();
  for (int idx = tid; idx < 32 * 33; idx += NT) {
    int tt = idx / 33, e = idx % 33, t = t0 + tt;
    float tl = (float)t * (1.0f / 8191.0f);
    float w = 6.283185307179586f * (float)t / 8192.0f;
    float val;
    if (e == 0) val = tl;
    else {
      int i = (e - 1) & 15;
      float f = 1e-4f + (float)i * ((15.0f - 1e-4f) / 15.0f);
      val = (e <= 16) ? cosf(f * w) : -sinf(f * w);
    }
    zf[tt][e] = val;
  }
  __syncthreads();
  for (int idx = tid; idx < 32 * 64; idx += NT) {
    int tt = idx >> 6, j = idx & 63;
    float a = p.f1_b[j];
    for (int e = 0; e < 33; ++e) a += zf[tt][e] * p.f1_w[e * 64 + j];
    h1[tt][j] = sinf(p.f1_freq[j] * a);
  }
  __syncthreads();
  for (int idx = tid; idx < 32 * 64; idx += NT) {
    int tt = idx >> 6, j = idx & 63;
    float a = p.f2_b[j];
    for (int e = 0; e < 64; ++e) a += h1[tt][e] * p.f2_w[e * 64 + j];
    h2T[j][tt] = sinf(p.f2_freq[j] * a);
  }
  __syncthreads();
  float* filt = p.out;
  const float min_decay = -3.0701134573253945f, max_decay = -15.350567286626973f;
  for (int col = tid; col < 2048; col += NT) {
    float acc[32];
#pragma unroll
    for (int i = 0; i < 32; ++i) acc[i] = 0.f;
    for (int j = 0; j < 64; ++j) {
      float w = p.f3_w[j * 2048 + col];
#pragma unroll
      for (int q = 0; q < 8; ++q) {
        f32x4 h = *(const f32x4*)&h2T[j][q * 4];
        acc[q * 4 + 0] += h[0] * w; acc[q * 4 + 1] += h[1] * w; acc[q * 4 + 2] += h[2] * w; acc[q * 4 + 3] += h[3] * w;
      }
    }
    int c = col & 511;
    float delta = fabsf(min_decay + (float)c * ((max_decay - min_decay) / 511.0f));
    float* dst = filt + (size_t)col * 8192 + t0;
#pragma unroll
    for (int q = 0; q < 8; ++q) {
      f32x4 o;
#pragma unroll
      for (int r = 0; r < 4; ++r) {
        float tl = (float)(t0 + q * 4 + r) * (1.0f / 8191.0f);
        o[r] = acc[q * 4 + r] * __expf(-tl * delta);
      }
      *(f32x4*)(dst + q * 4) = o;
    }
  }
  }
}

constexpr int BM = 256, BN = 128, BK = 64;
constexpr int LDS_A = BM * BK * 2, LDS_B = BN * BK * 2, LDS_STAGE = LDS_A + LDS_B;
constexpr int GEMM_LDS = 2 * LDS_STAGE + 8192;

DI int swz(int row, int ch) { return row * 128 + ((ch ^ (row & 7)) << 4); }

struct ALoadBf16 {
  const ushort_t* A; int lda;
  struct Raw { u32x4 v; };
  DI Raw fetch(int row, int k) const { Raw r; r.v = *(const u32x4*)(A + (size_t)row * lda + k); return r; }
  DI u32x4 cvt(const Raw& r, int k) const { return r.v; }
};
struct ALoadF32Mod {
  const float* A; const float* mod;
  struct Raw { f32x4 a, b; };
  DI Raw fetch(int row, int k) const { Raw r; const float* s = A + (size_t)row * 1024 + k; r.a = *(const f32x4*)s; r.b = *(const f32x4*)(s + 4); return r; }
  DI u32x4 cvt(const Raw& r, int k) const {
    f32x4 s0 = *(const f32x4*)(mod + k), s1 = *(const f32x4*)(mod + k + 4);
    f32x4 h0 = *(const f32x4*)(mod + 1024 + k), h1 = *(const f32x4*)(mod + 1024 + k + 4);
    u32x4 o;
    o[0] = pack2(r.a[0] * s0[0] + h0[0], r.a[1] * s0[1] + h0[1]);
    o[1] = pack2(r.a[2] * s0[2] + h0[2], r.a[3] * s0[3] + h0[3]);
    o[2] = pack2(r.b[0] * s1[0] + h1[0], r.b[1] * s1[1] + h1[1]);
    o[3] = pack2(r.b[2] * s1[2] + h1[2], r.b[3] * s1[3] + h1[3]);
    return o;
  }
};

template <class AL, bool SWAP = false>
DI void gemm_mainloop(f32x16 (&acc)[2][2], const AL& al, int m0, const ushort_t* __restrict__ Bt, int ldb, int n0, int K, char* smem) {
  const int tid = tid_opaque(), lane = tid & 63, wave = tid >> 6;
  const int wm = wave >> 1, wn = wave & 1;
  const int lr = tid >> 3, lc = tid & 7;
  typename AL::Raw ra[4]; u32x4 rb[2];
  const int nk = K / BK;
#pragma unroll
  for (int i = 0; i < 4; ++i) ra[i] = al.fetch(m0 + lr + 64 * i, lc * 8);
#pragma unroll
  for (int i = 0; i < 2; ++i) rb[i] = *(const u32x4*)(Bt + (size_t)(n0 + lr + 64 * i) * ldb + lc * 8);
  __syncthreads();
#pragma unroll
  for (int i = 0; i < 4; ++i) *(u32x4*)(smem + swz(lr + 64 * i, lc)) = al.cvt(ra[i], lc * 8);
#pragma unroll
  for (int i = 0; i < 2; ++i) *(u32x4*)(smem + LDS_A + swz(lr + 64 * i, lc)) = rb[i];
  __syncthreads();
  for (int kt = 0; kt < nk; ++kt) {
    char* cur = smem + (kt & 1) * LDS_STAGE;
    char* nxt = smem + ((kt + 1) & 1) * LDS_STAGE;
    const bool more = (kt + 1 < nk);
    const int kn = (kt + 1) * BK + lc * 8;
    if (more) {
#pragma unroll
      for (int i = 0; i < 4; ++i) ra[i] = al.fetch(m0 + lr + 64 * i, kn);
#pragma unroll
      for (int i = 0; i < 2; ++i) rb[i] = *(const u32x4*)(Bt + (size_t)(n0 + lr + 64 * i) * ldb + kn);
    }
#pragma unroll
    for (int s = 0; s < 4; ++s) {
      const int ch = 2 * s + (lane >> 5);
      bf16x8 af[2], bfr[2];
#pragma unroll
      for (int mi = 0; mi < 2; ++mi) af[mi] = *(const bf16x8*)(cur + swz(wm * 64 + mi * 32 + (lane & 31), ch));
#pragma unroll
      for (int ni = 0; ni < 2; ++ni) bfr[ni] = *(const bf16x8*)(cur + LDS_A + swz(wn * 64 + ni * 32 + (lane & 31), ch));
#pragma unroll
      for (int mi = 0; mi < 2; ++mi)
#pragma unroll
        for (int ni = 0; ni < 2; ++ni)
          acc[mi][ni] = SWAP ? __builtin_amdgcn_mfma_f32_32x32x16_bf16(bfr[ni], af[mi], acc[mi][ni], 0, 0, 0)
                             : __builtin_amdgcn_mfma_f32_32x32x16_bf16(af[mi], bfr[ni], acc[mi][ni], 0, 0, 0);
    }
    if (more) {
#pragma unroll
      for (int i = 0; i < 4; ++i) *(u32x4*)(nxt + swz(lr + 64 * i, lc)) = al.cvt(ra[i], kn);
#pragma unroll
      for (int i = 0; i < 2; ++i) *(u32x4*)(nxt + LDS_A + swz(lr + 64 * i, lc)) = rb[i];
    }
    __syncthreads();
  }
}

constexpr int AT_ROW = 576;
constexpr int LDS_AT = 64 * AT_ROW;
constexpr int LDS_STAGE_T = LDS_AT + LDS_B;
typedef __attribute__((ext_vector_type(4))) short s16x4;
DI void gemm_mainloop_AT(f32x16 (&acc)[2][2], const ushort_t* __restrict__ At, size_t ldt, const ushort_t* __restrict__ Bt, int ldb, int n0, int K, char* smem) {
  const int tid = tid_opaque(), lane = tid & 63, wave = tid >> 6;
  const int wm = wave >> 1, wn = wave & 1;
  const int lr = tid >> 3, lc = tid & 7;
  u32x4 ra[4], rb[2];
  const int nk = K / BK;
#pragma unroll
  for (int i = 0; i < 4; ++i) { const int q = tid + 512 * i; ra[i] = *(const u32x4*)(At + (size_t)(q >> 5) * ldt + (q & 31) * 8); }
#pragma unroll
  for (int i = 0; i < 2; ++i) rb[i] = *(const u32x4*)(Bt + (size_t)(n0 + lr + 64 * i) * ldb + lc * 8);
  __syncthreads();
#pragma unroll
  for (int i = 0; i < 4; ++i) { const int q = tid + 512 * i; *(u32x4*)(smem + (q >> 5) * AT_ROW + (q & 31) * 16) = ra[i]; }
#pragma unroll
  for (int i = 0; i < 2; ++i) *(u32x4*)(smem + LDS_AT + swz(lr + 64 * i, lc)) = rb[i];
  __syncthreads();
  const int hh = lane >> 5, gg = (lane >> 4) & 1, qq = (lane & 15) >> 2, pp = lane & 3;
  for (int kt = 0; kt < nk; ++kt) {
    char* cur = smem + (kt & 1) * LDS_STAGE_T;
    char* nxt = smem + ((kt + 1) & 1) * LDS_STAGE_T;
    const bool more = (kt + 1 < nk);
    if (more) {
#pragma unroll
      for (int i = 0; i < 4; ++i) { const int q = tid + 512 * i; ra[i] = *(const u32x4*)(At + (size_t)((kt + 1) * BK + (q >> 5)) * ldt + (q & 31) * 8); }
#pragma unroll
      for (int i = 0; i < 2; ++i) rb[i] = *(const u32x4*)(Bt + (size_t)(n0 + lr + 64 * i) * ldb + (kt + 1) * BK + lc * 8);
    }
#pragma unroll
    for (int s = 0; s < 4; ++s) {
      const int ch = 2 * s + hh;
      bf16x8 af[2], bfr[2];
#pragma unroll
      for (int mi = 0; mi < 2; ++mi) {
        const char* a0 = cur + (16 * s + 8 * hh + qq) * AT_ROW + (wm * 64 + mi * 32 + 16 * gg + 4 * pp) * 2;
        s16x4 lo = __builtin_amdgcn_ds_read_tr16_b64_v4i16((__attribute__((address_space(3))) s16x4*)(a0));
        s16x4 hi = __builtin_amdgcn_ds_read_tr16_b64_v4i16((__attribute__((address_space(3))) s16x4*)(a0 + 4 * AT_ROW));
        af[mi] = __builtin_shufflevector(lo, hi, 0, 1, 2, 3, 4, 5, 6, 7);
      }
#pragma unroll
      for (int ni = 0; ni < 2; ++ni) bfr[ni] = *(const bf16x8*)(cur + LDS_AT + swz(wn * 64 + ni * 32 + (lane & 31), ch));
#pragma unroll
      for (int mi = 0; mi < 2; ++mi)
#pragma unroll
        for (int ni = 0; ni < 2; ++ni) acc[mi][ni] = __builtin_amdgcn_mfma_f32_32x32x16_bf16(af[mi], bfr[ni], acc[mi][ni], 0, 0, 0);
    }
    if (more) {
#pragma unroll
      for (int i = 0; i < 4; ++i) { const int q = tid + 512 * i; *(u32x4*)(nxt + (q >> 5) * AT_ROW + (q & 31) * 16) = ra[i]; }
#pragma unroll
      for (int i = 0; i < 2; ++i) *(u32x4*)(nxt + LDS_AT + swz(lr + 64 * i, lc)) = rb[i];
    }
    __syncthreads();
  }
}
DI void acc_zero(f32x16 (&acc)[2][2]) {
#pragma unroll
  for (int a = 0; a < 2; ++a)
#pragma unroll
    for (int b = 0; b < 2; ++b)
#pragma unroll
      for (int r = 0; r < 16; ++r) acc[a][b][r] = 0.f;
}
#define ACC_ROW(mi, r) (wm * 64 + (mi) * 32 + ((r) & 3) + 8 * ((r) >> 2) + 4 * (lane >> 5))
#define ACC_COL(ni) (wn * 64 + (ni) * 32 + (lane & 31))

DI void stage_mod(float* mod, const float* ada, int b, int sc_chunk, int sh_chunk) {
  for (int i = tid_opaque(); i < 1024; i += NT) {
    mod[i] = 1.f + ada[b * 6144 + sc_chunk * 1024 + i];
    mod[1024 + i] = ada[b * 6144 + sh_chunk * 1024 + i];
  }
}

DI void phase_inproj(const P& p, char* smem) {
  const float* ada = (const float*)(p.ws + OFF_ADA);
  float* mod = (float*)(smem + 2 * LDS_STAGE);
  const ushort_t* wt = (const ushort_t*)(p.ws + OFF_WIN_T);
  ushort_t* ph = (ushort_t*)(p.ws + OFF_PH);
  ushort_t* qkv = (ushort_t*)(p.ws + OFF_QKV);
  ushort_t* gate = (ushort_t*)(p.ws + OFF_GATE);
  const int tid = tid_opaque(), lane = tid & 63, wave = tid >> 6, wm = wave >> 1, wn = wave & 1;
  constexpr int NTN = INW / BN;
  constexpr int NTM = T_ / BM;
  for (int tile = blockIdx.x; tile < NTM * NTN; tile += gridDim.x) {
    const int tm = tile / NTN, tn = tile % NTN;
    const int m0 = tm * BM, n0 = tn * BN, b = m0 / S_;
    __syncthreads();
    stage_mod(mod, ada, b, 1, 0);
    __syncthreads();
    f32x16 acc[2][2]; acc_zero(acc);
    ALoadF32Mod al{p.x, mod};
    if (n0 < HYC) {
      gemm_mainloop<ALoadF32Mod, true>(acc, al, m0, wt, 1024, n0, 1024, smem);
#pragma unroll
      for (int mi = 0; mi < 2; ++mi) {
        const int t = (m0 & (S_ - 1)) + wm * 64 + mi * 32 + (lane & 31);
#pragma unroll
        for (int ni = 0; ni < 2; ++ni)
#pragma unroll
          for (int r = 0; r < 16; ++r) {
            const int ch = n0 + wn * 64 + ni * 32 + (r & 3) + 8 * (r >> 2) + 4 * (lane >> 5);
            ph[((size_t)(b * HYC + ch)) * S_ + t] = f2bf(acc[mi][ni][r]);
          }
      }
      continue;
    }
    gemm_mainloop(acc, al, m0, wt, 1024, n0, 1024, smem);
#pragma unroll
    for (int ni = 0; ni < 2; ++ni) {
      const int col = n0 + ACC_COL(ni);
#pragma unroll
      for (int mi = 0; mi < 2; ++mi) {
        if (col < HYC + QKVC) {
          const int cq = col - HYC;
          const bool rot = (cq < 1536) && ((cq & 63) < 16);
          const float qs = (cq < 768) ? 0.125f : 1.0f;
          const float inv = expf(-13.122363377404328f * (float)(cq & 7) * 0.125f);
#pragma unroll
          for (int r = 0; r < 16; ++r) {
            const int row = m0 + ACC_ROW(mi, r);
            float v = acc[mi][ni][r];
            float o = __shfl_xor(v, 8);
            if (rot) {
              float ang = (float)p.pos[row] * inv;
              float sn, cs; sincosf(ang, &sn, &cs);
              v = ((cq & 15) < 8) ? (v * cs - o * sn) : (v * cs + o * sn);
            }
            qkv[(size_t)row * QKVC + cq] = f2bf(v * qs);
          }
        } else {
          const int cg = col - HYC - QKVC;
#pragma unroll
          for (int r = 0; r < 16; ++r) {
            float v = acc[mi][ni][r];
            gate[(size_t)(m0 + ACC_ROW(mi, r)) * GATEC + cg] = f2bf(1.f / (1.f + __expf(-v)));
          }
        }
      }
    }
  }
}

DI float sconv_t(const ushort_t* row, int t, float w0, float w1, float w2, float cb) {
  float v = cb + w1 * bf2f(row[t]);
  if (t > 0) v += w0 * bf2f(row[t - 1]);
  if (t < S_ - 1) v += w2 * bf2f(row[t + 1]);
  return v;
}
DI void fft_C_mul_invC(cf2* lds, const cf2* __restrict__ kq, int tid) {
  asm volatile("" : "+v"(tid));
  const int k1 = tid >> 5, k2 = tid & 31;
  kq += tid;
#pragma unroll
  for (int h = 0; h < 2; ++h) {
    float tr[16], ti[16];
    cf2 kv[16];
#pragma unroll
    for (int i = 0; i < 16; ++i) kv[i] = kq[(h * 16 + i) * 512];
    cf2* blk = lds + (k1 + 16 * h) * FFT_SA + k2 * 17;
#pragma unroll
    for (int mp = 0; mp < 16; ++mp) { cf2 v = blk[mp]; tr[mp] = v.x; ti[mp] = v.y; }
    dft_fwd<16, false>(tr, ti);
#pragma unroll
    for (int i = 0; i < 16; ++i) { const float a = tr[i], b = ti[i]; tr[i] = a * kv[i].x - b * kv[i].y; ti[i] = a * kv[i].y + b * kv[i].x; }
    dft_inv<16>(tr, ti);
#pragma unroll
    for (int mp = 0; mp < 16; ++mp) { cf2 o; o.x = tr[mp]; o.y = ti[mp]; blk[mp] = o; }
  }
}
DI void hyena_item(const P& p, char* smem, int c) {
  cf2* lds = (cf2*)smem;
  const ushort_t* pht = (const ushort_t*)(p.ws + OFF_PH);
  ushort_t* yht = (ushort_t*)(p.ws + OFF_YH);
  cf2* kq = (cf2*)(p.ws + (blockIdx.x < 92 ? OFF_WIN_T + (size_t)blockIdx.x * 131072 : OFF_HSCR + (size_t)(blockIdx.x - 92) * 131072));
  const float* filt = p.out;
  const int tid0 = tid_opaque();
  float zr[32], zi[32];
  __syncthreads();
#pragma unroll 1
  for (int o = 0; o < 2; ++o) {
    int tid = tid0; asm volatile("" : "+v"(tid));
    {
      float kr[32], ki[32];
      const float* fw = filt + (size_t)(0 * 1024 + o * 512 + c) * S_;
      const float* bw = filt + (size_t)(1 * 1024 + o * 512 + c) * S_;
      const float bias = p.hy_bias[o * 512 + c];
#pragma unroll
      for (int n1 = 0; n1 < 16; ++n1) { kr[n1] = fw[n1 * 512 + tid] * (1.0f / 16384.0f); ki[n1] = 0.f; }
      if (tid == 0) kr[0] += bias * (1.0f / 16384.0f);
#pragma unroll
      for (int n1 = 16; n1 < 32; ++n1) {
        const int n = n1 * 512 + tid;
        kr[n1] = (n == S_) ? 0.f : bw[2 * S_ - n] * (1.0f / 16384.0f); ki[n1] = 0.f;
      }
      fft_fwdA<false>(kr, ki, lds, tid); __syncthreads();
      fft_B_read(kr, ki, lds, tid); __syncthreads();
      fft_fwdB_write(kr, ki, lds, tid); __syncthreads();
      fft_fwdC(kr, ki, lds, tid);
      int ts = tid; asm volatile("" : "+v"(ts));
      cf2* kqt = kq + ts;
#pragma unroll
      for (int r = 0; r < 32; ++r) { cf2 v; v.x = kr[r]; v.y = ki[r]; kqt[r * 512] = v; }
      __syncthreads();
    }
    asm volatile("" : "+v"(tid));
    if (o == 0) {
      const float w0 = p.hy_conv_w[c], w1 = p.hy_conv_w[HYC + c], w2 = p.hy_conv_w[2 * HYC + c], cb = p.hy_conv_b[c];
      const ushort_t* r0 = pht + (size_t)(0 * HYC + c) * S_;
      const ushort_t* r1 = pht + (size_t)(1 * HYC + c) * S_;
#pragma unroll
      for (int n1 = 0; n1 < 16; ++n1) {
        const int t = n1 * 512 + tid;
        zr[n1] = sconv_t(r0, t, w0, w1, w2, cb); zi[n1] = sconv_t(r1, t, w0, w1, w2, cb);
        if (n1 & 1) asm volatile("" ::: "memory");
      }
    }
#pragma unroll
    for (int n1 = 16; n1 < 32; ++n1) { zr[n1] = 0.f; zi[n1] = 0.f; }
    fft_fwdA<true>(zr, zi, lds, tid); __syncthreads();
    fft_B_read(zr, zi, lds, tid); __syncthreads();
    fft_fwdB_write(zr, zi, lds, tid); __syncthreads();
    fft_C_mul_invC(lds, kq, tid); __syncthreads();
    fft_invB_read(zr, zi, lds, tid); __syncthreads();
    fft_invB_write(zr, zi, lds, tid); __syncthreads();
    fft_invA(zr, zi, lds, tid);
    int tg = tid; asm volatile("" : "+v"(tg));
    const int gch = (o + 1) * 512 + c;
    const float w0 = p.hy_conv_w[gch], w1 = p.hy_conv_w[HYC + gch], w2 = p.hy_conv_w[2 * HYC + gch], cb = p.hy_conv_b[gch];
    const ushort_t* g0 = pht + (size_t)(0 * HYC + gch) * S_;
    const ushort_t* g1 = pht + (size_t)(1 * HYC + gch) * S_;
#pragma unroll
    for (int n1 = 0; n1 < 16; ++n1) {
      const int t = n1 * 512 + tg;
      zr[n1] *= sconv_t(g0, t, w0, w1, w2, cb);
      zi[n1] *= sconv_t(g1, t, w0, w1, w2, cb);
      if (n1 & 1) asm volatile("" ::: "memory");
    }
    if (o == 1) {
#pragma unroll
      for (int n1 = 0; n1 < 16; ++n1) {
        const int t = n1 * 512 + tg;
        yht[(size_t)(0 * HW_ + c) * S_ + t] = f2bf(zr[n1]);
        yht[(size_t)(1 * HW_ + c) * S_ + t] = f2bf(zi[n1]);
      }
    }
  }
}

DI void attn_item(const P& p, int item) {
  const ushort_t* qkv = (const ushort_t*)(p.ws + OFF_QKV);
  ushort_t* ya = (ushort_t*)(p.ws + OFF_YA);
  {
    int tx = threadIdx.x;
    asm volatile("" : "+v"(tx));
    const int hs = tx >> 7;
    const int tok = item * 128 + (tx & 127);
    const int b = tok / S_, t = tok % S_;
    float acc[64];
#pragma unroll
    for (int e = 0; e < 64; ++e) acc[e] = 0.f;
    float m = -1e30f, l = 0.f;
    for (int g = 0; g < 3; ++g) {
      const int dil = (g == 0) ? 1 : (g == 1 ? 4 : 16);
      const int head = g * 4 + hs;
      float q[64];
      {
        const ushort_t* qp = qkv + (size_t)tok * QKVC + head * 64;
#pragma unroll
        for (int e8 = 0; e8 < 8; ++e8) {
          u32x4 v = *(const u32x4*)(qp + e8 * 8);
#pragma unroll
          for (int w = 0; w < 4; ++w) { q[e8 * 8 + 2 * w] = __uint_as_float(v[w] << 16); q[e8 * 8 + 2 * w + 1] = __uint_as_float(v[w] & 0xffff0000u); }
        }
      }
      for (int j = -64; j <= 64; ++j) {
        const int tk = t + dil * j;
        if (tk < 0 || tk >= S_) continue;
        const ushort_t* kp = qkv + (size_t)(b * S_ + tk) * QKVC + 768 + head * 64;
        float s = 0.f;
#pragma unroll
        for (int e8 = 0; e8 < 8; ++e8) {
          u32x4 v = *(const u32x4*)(kp + e8 * 8);
#pragma unroll
          for (int w = 0; w < 4; ++w) { s += q[e8 * 8 + 2 * w] * __uint_as_float(v[w] << 16); s += q[e8 * 8 + 2 * w + 1] * __uint_as_float(v[w] & 0xffff0000u); }
        }
        const float mn = fmaxf(m, s);
        const float corr = __expf(m - mn), pe = __expf(s - mn);
        l = l * corr + pe; m = mn;
        const ushort_t* vp = kp + 768;
#pragma unroll
        for (int e8 = 0; e8 < 8; ++e8) {
          u32x4 v = *(const u32x4*)(vp + e8 * 8);
#pragma unroll
          for (int w = 0; w < 4; ++w) {
            acc[e8 * 8 + 2 * w] = acc[e8 * 8 + 2 * w] * corr + pe * __uint_as_float(v[w] << 16);
            acc[e8 * 8 + 2 * w + 1] = acc[e8 * 8 + 2 * w + 1] * corr + pe * __uint_as_float(v[w] & 0xffff0000u);
          }
        }
      }
    }
    const float il = 1.f / l;
    ushort_t* op = ya + (size_t)tok * 256 + hs * 64;
#pragma unroll
    for (int e8 = 0; e8 < 8; ++e8) {
      u32x4 o;
#pragma unroll
      for (int w = 0; w < 4; ++w) o[w] = pack2(acc[e8 * 8 + 2 * w] * il, acc[e8 * 8 + 2 * w + 1] * il);
      *(u32x4*)(op + e8 * 8) = o;
    }
  }
}

DI void phase_merge(const P& p, char* smem) {
  const ushort_t* yh = (const ushort_t*)(p.ws + OFF_YH);
  const ushort_t* ya = (const ushort_t*)(p.ws + OFF_YA);
  const ushort_t* gate = (const ushort_t*)(p.ws + OFF_GATE);
  ushort_t* merged = (ushort_t*)(p.ws + OFF_MERGED);
  const int tid = tid_opaque(), lane = tid & 63, wave = tid >> 6, wm = wave >> 1, wn = wave & 1;
  constexpr int NTN = 1024 / BN, NTM = T_ / BM;
  for (int tile = blockIdx.x; tile < NTM * NTN; tile += gridDim.x) {
    const int m0 = (tile / NTN) * BM, n0 = (tile % NTN) * BN;
    f32x16 a1[2][2], a2[2][2]; acc_zero(a1); acc_zero(a2);
    gemm_mainloop_AT(a1, yh + (size_t)((m0 / S_) * HW_) * S_ + (m0 & (S_ - 1)), (size_t)S_, (const ushort_t*)(p.ws + OFF_WBH_T), 512, n0, 512, smem);
    ALoadBf16 l2{ya, 256};
    gemm_mainloop(a2, l2, m0, (const ushort_t*)(p.ws + OFF_WBA_T), 256, n0, 256, smem);
#pragma unroll
    for (int mi = 0; mi < 2; ++mi)
#pragma unroll
      for (int ni = 0; ni < 2; ++ni)
#pragma unroll
        for (int r = 0; r < 16; ++r) {
          const int row = m0 + ACC_ROW(mi, r), col = n0 + ACC_COL(ni);
          float gh = bf2f(gate[(size_t)row * GATEC + col]), ga = bf2f(gate[(size_t)row * GATEC + 1024 + col]);
          merged[(size_t)row * 1024 + col] = f2bf(gh * a1[mi][ni][r] + ga * a2[mi][ni][r]);
        }
  }
}

DI void phase_outproj(const P& p, char* smem) {
  const float* ada = (const float*)(p.ws + OFF_ADA);
  const ushort_t* merged = (const ushort_t*)(p.ws + OFF_MERGED);
  const int tid = tid_opaque(), lane = tid & 63, wave = tid >> 6, wm = wave >> 1, wn = wave & 1;
  constexpr int NTN = 1024 / BN, NTM = T_ / BM;
  for (int tile = blockIdx.x; tile < NTM * NTN; tile += gridDim.x) {
    const int m0 = (tile / NTN) * BM, n0 = (tile % NTN) * BN, b = m0 / S_;
    f32x16 acc[2][2]; acc_zero(acc);
    ALoadBf16 l1{merged, 1024};
    gemm_mainloop(acc, l1, m0, (const ushort_t*)(p.ws + OFF_WOUT_T), 1024, n0, 1024, smem);
#pragma unroll
    for (int ni = 0; ni < 2; ++ni) {
      const int col = n0 + ACC_COL(ni);
      const float g1 = 1.f + ada[b * 6144 + 2 * 1024 + col];
#pragma unroll
      for (int mi = 0; mi < 2; ++mi)
#pragma unroll
        for (int r = 0; r < 16; ++r) {
          const size_t o = (size_t)(m0 + ACC_ROW(mi, r)) * 1024 + col;
          p.out[o] = DN_ALPHA * p.x[o] + g1 * acc[mi][ni][r];
        }
    }
  }
}

DI void phase_ln(float* __restrict__ xio, const float* __restrict__ g, const float* __restrict__ bta) {
  const int tq = tid_opaque(); const int lane = tq & 63, wave = tq >> 6;
  for (int row = blockIdx.x * 8 + wave; row < T_; row += gridDim.x * 8) {
    float* rp = xio + (size_t)row * 1024;
    f32x4 v[4];
    float s = 0.f;
#pragma unroll
    for (int i = 0; i < 4; ++i) { v[i] = *(const f32x4*)(rp + i * 256 + lane * 4); s += v[i][0] + v[i][1] + v[i][2] + v[i][3]; }
    const float mu = wave_sum(s) * (1.f / 1024.f);
    float q = 0.f;
#pragma unroll
    for (int i = 0; i < 4; ++i)
#pragma unroll
      for (int j = 0; j < 4; ++j) { float d = v[i][j] - mu; q += d * d; }
    const float rs = rsqrtf(wave_sum(q) * (1.f / 1024.f) + LN_EPS);
#pragma unroll
    for (int i = 0; i < 4; ++i) {
      f32x4 gg = *(const f32x4*)(g + i * 256 + lane * 4), bb = *(const f32x4*)(bta + i * 256 + lane * 4), o;
#pragma unroll
      for (int j = 0; j < 4; ++j) o[j] = (v[i][j] - mu) * rs * gg[j] + bb[j];
      *(f32x4*)(rp + i * 256 + lane * 4) = o;
    }
  }
}

DI int swz256(int row, int ch) { return row * 256 + ((ch ^ (row & 15)) << 4); }
DI void ins16(float (&L)[16], float x) {
#pragma unroll
  for (int i = 0; i < 16; ++i) { const float hi = __builtin_fmaxf(L[i], x); x = __builtin_fminf(L[i], x); L[i] = hi; }
}
DI void bitonic16_desc(float (&M)[16]) {
#pragma unroll
  for (int d = 8; d >= 1; d >>= 1)
#pragma unroll
    for (int i = 0; i < 16; ++i)
      if ((i & d) == 0) { const float a = M[i], b = M[i + d]; M[i] = __builtin_fmaxf(a, b); M[i + d] = __builtin_fminf(a, b); }
}
constexpr int ROUTE_Q_OFF = 0, ROUTE_K_OFF = 65536, ROUTE_IDX_OFF = 106496;
DI void phase_route(const P& p, char* smem) {
  const float* ada = (const float*)(p.ws + OFF_ADA);
  float* mod = (float*)(smem + 2 * LDS_STAGE);
  const ushort_t* keysb = (const ushort_t*)(p.ws + OFF_KEYS_B);
  int* idx = (int*)(p.ws + OFF_IDX);
  float* gv = (float*)(p.ws + OFF_GV);
  for (int item = blockIdx.x; item < (T_ / BM) * 8; item += gridDim.x) {
    const int tid = tid_opaque(), lane = tid & 63, wave = tid >> 6, wm = wave >> 1, wn = wave & 1;
    const int m0 = (item >> 3) * BM, hh = item & 7, b = m0 / S_;
    __syncthreads();
    stage_mod(mod, ada, b, 4, 3);
    __syncthreads();
    float L0[16];
#pragma unroll 1
    for (int pp = 0; pp < 2; ++pp) {
      const int hp = hh * 2 + pp;
      f32x16 acc[2][2]; acc_zero(acc);
      ALoadF32Mod al{p.out, mod};
      gemm_mainloop<ALoadF32Mod, true>(acc, al, m0, (const ushort_t*)(p.ws + OFF_WQ_T), 1024, hp * 128, 1024, smem);
#pragma unroll
      for (int mi = 0; mi < 2; ++mi) {
        const int tok = wm * 64 + mi * 32 + (lane & 31);
#pragma unroll
        for (int ni = 0; ni < 2; ++ni)
#pragma unroll
          for (int g = 0; g < 4; ++g) {
            const int ch = wn * 8 + ni * 4 + g;
            uint2 v; v.x = pack2(acc[mi][ni][4 * g], acc[mi][ni][4 * g + 1]); v.y = pack2(acc[mi][ni][4 * g + 2], acc[mi][ni][4 * g + 3]);
            *(uint2*)(smem + ROUTE_Q_OFF + swz256(tok, ch) + 8 * (lane >> 5)) = v;
          }
      }
#pragma unroll
      for (int i = 0; i < 4; ++i) {
        const int q = tid + 512 * i, row = q >> 4, ch = q & 15;
        *(u32x4*)(smem + ROUTE_K_OFF + swz256(row, ch)) = *(const u32x4*)(keysb + (size_t)hp * 16384 + row * 128 + ch * 8);
      }
      __syncthreads();
      f32x16 sc[4];
#pragma unroll
      for (int ks = 0; ks < 4; ++ks)
#pragma unroll
        for (int r = 0; r < 16; ++r) sc[ks][r] = 0.f;
#pragma unroll
      for (int s = 0; s < 8; ++s) {
        const int ch = 2 * s + (lane >> 5);
        const bf16x8 bq = *(const bf16x8*)(smem + ROUTE_Q_OFF + swz256(wave * 32 + (lane & 31), ch));
#pragma unroll
        for (int ks = 0; ks < 4; ++ks) {
          const bf16x8 ak = *(const bf16x8*)(smem + ROUTE_K_OFF + swz256(ks * 32 + (lane & 31), ch));
          sc[ks] = __builtin_amdgcn_mfma_f32_32x32x16_bf16(ak, bq, sc[ks], 0, 0, 0);
        }
      }
      float L[16];
#pragma unroll
      for (int i = 0; i < 16; ++i) L[i] = -3.0e38f;
      const unsigned hbit = (unsigned)(lane >> 5) << 2;
#pragma unroll
      for (int ks = 0; ks < 4; ++ks)
#pragma unroll
        for (int r = 0; r < 16; ++r) {
          const unsigned key = (unsigned)(ks * 32 + (r & 3) + 8 * (r >> 2)) | hbit;
          ins16(L, __uint_as_float((__float_as_uint(sc[ks][r]) & ~127u) | key));
        }
      {
        float M[16];
#pragma unroll
        for (int i = 0; i < 16; ++i) M[i] = __builtin_fmaxf(L[i], __shfl_xor(L[15 - i], 32));
        bitonic16_desc(M);
#pragma unroll
        for (int i = 0; i < 16; ++i) L[i] = M[i];
      }
      if (pp == 0) {
#pragma unroll
        for (int i = 0; i < 16; ++i) L0[i] = L[i];
      } else {
        unsigned char* ib = (unsigned char*)(smem + ROUTE_IDX_OFF) + tid * 32;
#pragma unroll
        for (int i = 0; i < 16; ++i) { ib[i] = (unsigned char)(__float_as_uint(L0[i]) & 127u); ib[16 + i] = (unsigned char)(__float_as_uint(L[i]) & 127u); }
        float F[16];
#pragma unroll
        for (int i = 0; i < 16; ++i) F[i] = -3.0e38f;
#pragma unroll
        for (int i = 0; i < 16; ++i) {
          const float ai = __uint_as_float(__float_as_uint(L0[i]) & ~127u);
#pragma unroll
          for (int j = 0; j < 16; ++j)
            if ((i + 1) * (j + 1) <= 16) {
              const float s = ai + __uint_as_float(__float_as_uint(L[j]) & ~127u);
              ins16(F, __uint_as_float((__float_as_uint(s) & ~255u) | (unsigned)(i * 16 + j)));
            }
        }
        const float mx = __uint_as_float(__float_as_uint(F[0]) & ~255u);
        float e[16], sum = 0.f;
#pragma unroll
        for (int k = 0; k < 16; ++k) { e[k] = __expf(__uint_as_float(__float_as_uint(F[k]) & ~255u) - mx); sum += e[k]; }
        const float inv = 1.f / sum;
        if (lane < 32) {
          const int tok = m0 + wave * 32 + lane;
          int* ip = idx + (size_t)tok * 128 + hh * 16;
          float* gp = gv + (size_t)tok * 128 + hh * 16;
#pragma unroll
          for (int k4 = 0; k4 < 4; ++k4) {
            int4 iv; f32x4 g4;
            int ee[4];
#pragma unroll
            for (int u = 0; u < 4; ++u) {
              const unsigned code = __float_as_uint(F[k4 * 4 + u]) & 255u;
              ee[u] = (int)ib[code >> 4] * 128 + (int)ib[16 + (code & 15u)];
              g4[u] = e[k4 * 4 + u] * inv;
            }
            iv.x = ee[0]; iv.y = ee[1]; iv.z = ee[2]; iv.w = ee[3];
            *(int4*)(ip + k4 * 4) = iv;
            *(f32x4*)(gp + k4 * 4) = g4;
          }
        }
      }
    }
  }
}

DI void phase_keys(const P& p) {
  ushort_t* keysb = (ushort_t*)(p.ws + OFF_KEYS_B);
  for (int i = blockIdx.x * NT + tid_opaque(); i < 16 * 128 * 128 / 4; i += gridDim.x * NT) {
    f32x4 v = *(const f32x4*)(p.keys + (size_t)i * 4);
    uint2 o; o.x = pack2(v[0], v[1]); o.y = pack2(v[2], v[3]);
    *(uint2*)(keysb + (size_t)i * 4) = o;
  }
}

DI void phase_peer(const P& p, char* smem) {
  const float* ada = (const float*)(p.ws + OFF_ADA);
  const int* idx = (const int*)(p.ws + OFF_IDX);
  const float* gv = (const float*)(p.ws + OFF_GV);
  const int tq = tid_opaque(); const int lane = tq & 63, wave = tq >> 6;
  for (int tok = blockIdx.x * 8 + wave; tok < T_; tok += gridDim.x * 8) {
    const int b = tok / S_;
    float* rp = p.out + (size_t)tok * 1024;
    f32x4 x1[4], u2[4], acc[4];
#pragma unroll
    for (int i = 0; i < 4; ++i) {
      const int col = i * 256 + lane * 4;
      x1[i] = *(const f32x4*)(rp + col);
      f32x4 sc = *(const f32x4*)(ada + b * 6144 + 4 * 1024 + col), sh = *(const f32x4*)(ada + b * 6144 + 3 * 1024 + col);
#pragma unroll
      for (int j = 0; j < 4; ++j) { u2[i][j] = x1[i][j] * (1.f + sc[j]) + sh[j]; acc[i][j] = 0.f; }
    }
    for (int s = 0; s < 128; ++s) {
      const int e = __builtin_amdgcn_readfirstlane(idx[(size_t)tok * 128 + s]);
      const float g = gv[(size_t)tok * 128 + s];
      const float* ur = p.pu + (size_t)e * 1024;
      const float* vr = p.pv + (size_t)e * 1024;
      float d = 0.f;
#pragma unroll
      for (int i = 0; i < 4; ++i) {
        f32x4 u = *(const f32x4*)(ur + i * 256 + lane * 4);
        d += u[0] * u2[i][0] + u[1] * u2[i][1] + u[2] * u2[i][2] + u[3] * u2[i][3];
      }
      const float a = wave_sum(d);
      const float coef = g * 0.5f * a * (1.f + erff(a * 0.7071067811865475f));
#pragma unroll
      for (int i = 0; i < 4; ++i) {
        f32x4 v = *(const f32x4*)(vr + i * 256 + lane * 4);
#pragma unroll
        for (int j = 0; j < 4; ++j) acc[i][j] += coef * v[j];
      }
    }
    float sm = 0.f;
#pragma unroll
    for (int i = 0; i < 4; ++i) {
      const int col = i * 256 + lane * 4;
      f32x4 g2 = *(const f32x4*)(ada + b * 6144 + 5 * 1024 + col);
#pragma unroll
      for (int j = 0; j < 4; ++j) { acc[i][j] = DN_ALPHA * x1[i][j] + (1.f + g2[j]) * acc[i][j]; sm += acc[i][j]; }
    }
    const float mu = wave_sum(sm) * (1.f / 1024.f);
    float q = 0.f;
#pragma unroll
    for (int i = 0; i < 4; ++i)
#pragma unroll
      for (int j = 0; j < 4; ++j) { float d = acc[i][j] - mu; q += d * d; }
    const float rs = rsqrtf(wave_sum(q) * (1.f / 1024.f) + LN_EPS);
#pragma unroll
    for (int i = 0; i < 4; ++i) {
      const int col = i * 256 + lane * 4;
      f32x4 gg = *(const f32x4*)(p.ln2_g + col), bb = *(const f32x4*)(p.ln2_b + col), o;
#pragma unroll
      for (int j = 0; j < 4; ++j) o[j] = (acc[i][j] - mu) * rs * gg[j] + bb[j];
      *(f32x4*)(rp + col) = o;
    }
  }
}

constexpr int SMEM_BYTES = 143360;
__global__ void __launch_bounds__(NT) fwd_megakernel(P p) {
  __shared__ __attribute__((aligned(16))) char smem[SMEM_BYTES];
  cooperative_groups::grid_group grid = cooperative_groups::this_grid();
  phase_ada(p, smem);
  phase_transposes(p, smem);
  phase_keys(p);
  phase_filter(p, smem);
  grid.sync();
  phase_inproj(p, smem);
  grid.sync();
  for (int item = blockIdx.x; item < 512 + 128; item += gridDim.x) {
    if (item < 512) hyena_item(p, smem, item);
    else attn_item(p, item - 512);
  }
  grid.sync();
  phase_merge(p, smem);
  grid.sync();
  phase_outproj(p, smem);
  grid.sync();
  phase_ln(p.out, p.ln1_g, p.ln1_b);
  grid.sync();
  phase_route(p, smem);
  grid.sync();
  phase_peer(p, smem);
}

extern "C" void kernel_launch(void* const* d_in, const int* in_sizes, int n_in, void* d_out, int out_size, void* d_ws, size_t ws_size,
                              hipStream_t stream) {
  P p{};
  p.x = (const float*)d_in[0]; p.c = (const float*)d_in[1]; p.pos = (const int*)d_in[2];
  p.w_ada = (const float*)d_in[3]; p.b_ada = (const float*)d_in[4]; p.w_in = (const float*)d_in[5];
  p.hy_conv_w = (const float*)d_in[6]; p.hy_conv_b = (const float*)d_in[7];
  p.f1_w = (const float*)d_in[8]; p.f1_b = (const float*)d_in[9]; p.f1_freq = (const float*)d_in[10];
  p.f2_w = (const float*)d_in[11]; p.f2_b = (const float*)d_in[12]; p.f2_freq = (const float*)d_in[13];
  p.f3_w = (const float*)d_in[14]; p.hy_bias = (const float*)d_in[15];
  p.w_bh = (const float*)d_in[16]; p.w_ba = (const float*)d_in[17]; p.w_out = (const float*)d_in[18];
  p.ln1_g = (const float*)d_in[19]; p.ln1_b = (const float*)d_in[20];
  p.wq = (const float*)d_in[21]; p.keys = (const float*)d_in[22]; p.pu = (const float*)d_in[23]; p.pv = (const float*)d_in[24];
  p.ln2_g = (const float*)d_in[25]; p.ln2_b = (const float*)d_in[26];
  p.out = (float*)d_out; p.ws = (char*)d_ws;

  static int grid_blocks = 0;
  if (!grid_blocks) {
    int dev = 0, cus = 0, per_cu = 0;
    hipGetDevice(&dev);
    hipDeviceGetAttribute(&cus, hipDeviceAttributeMultiprocessorCount, dev);
    hipOccupancyMaxActiveBlocksPerMultiprocessor(&per_cu, fwd_megakernel, NT, 0);
    if (per_cu > 1) per_cu = 1;
    grid_blocks = cus * per_cu;
  }
  void* args[] = {&p};
  hipError_t e = hipLaunchCooperativeKernel((void*)fwd_megakernel, dim3(grid_blocks), dim3(NT), args, 0, stream);
  if (e != hipSuccess) fprintf(stderr, "cooperative launch failed: %s (grid %d)\n", hipGetErrorString(e), grid_blocks);
}
```

```cpp
#include <hip/hip_runtime.h>
#include <hip/hip_cooperative_groups.h>
#include <cstdio>
#include <cstdint>

#define DI __device__ __forceinline__
typedef unsigned short ushort_t;
typedef __attribute__((ext_vector_type(8))) short bf16x8;
typedef __attribute__((ext_vector_type(16))) float f32x16;
typedef __attribute__((ext_vector_type(4))) float f32x4;
typedef __attribute__((ext_vector_type(4))) unsigned u32x4;

constexpr int T_ = 16384, S_ = 8192, NB = 2, D_ = 1024;
constexpr int HW_ = 512, HYC = 1536, QKVC = 2304, GATEC = 2048, INW = 5888;
constexpr int NT = 512;
constexpr float DN_ALPHA = 1.189207115002721f;
constexpr float LN_EPS = 1e-5f;

constexpr size_t OFF_ADA   = 0;
constexpr size_t OFF_KEYS_B= 65536;
constexpr size_t OFF_WIN_T = 65536 + 524288;
constexpr size_t OFF_WQ_T  = OFF_WIN_T + (size_t)INW * 1024 * 2;
constexpr size_t OFF_WOUT_T= OFF_WQ_T + (size_t)2048 * 1024 * 2;
constexpr size_t OFF_WBH_T = OFF_WOUT_T + (size_t)1024 * 1024 * 2;
constexpr size_t OFF_WBA_T = OFF_WBH_T + (size_t)1024 * 512 * 2;
constexpr size_t OFF_PH    = OFF_WBA_T + (size_t)1024 * 256 * 2;
constexpr size_t OFF_QKV   = OFF_PH + (size_t)T_ * HYC * 2;
constexpr size_t OFF_GATE  = OFF_QKV + (size_t)T_ * QKVC * 2;
constexpr size_t OFF_YH    = OFF_GATE + (size_t)T_ * GATEC * 2;
constexpr size_t OFF_YA    = OFF_YH + (size_t)T_ * HW_ * 2;
constexpr size_t OFF_END   = OFF_YA + (size_t)T_ * 256 * 2;
constexpr size_t OFF_MERGED= OFF_PH;
constexpr size_t OFF_U2B   = OFF_PH;
constexpr size_t OFF_TABU  = OFF_QKV;
constexpr size_t OFF_TABV  = OFF_QKV + (size_t)32 * 1048576;
constexpr size_t OFF_COEF  = OFF_QKV + (size_t)64 * 1048576;
constexpr size_t OFF_F     = OFF_QKV + (size_t)72 * 1048576;
static_assert(OFF_F + (size_t)64 * 1048576 <= OFF_YH, "peer buffers overflow the qkv+gate region");
constexpr size_t OFF_IDX   = OFF_YH;
constexpr size_t OFF_GV    = OFF_YH + (size_t)T_ * 128 * 4;
constexpr size_t OFF_HSCR  = OFF_END;
static_assert(OFF_HSCR + (size_t)164 * 131072 <= 268435456ull, "ws overflow");
static_assert((size_t)92 * 131072 <= (size_t)INW * 1024 * 2, "w_in^T region too small");

struct P {
  const float *x, *c; const int* pos;
  const float *w_ada, *b_ada, *w_in, *hy_conv_w, *hy_conv_b, *f1_w, *f1_b, *f1_freq, *f2_w, *f2_b, *f2_freq, *f3_w,
      *hy_bias, *w_bh, *w_ba, *w_out, *ln1_g, *ln1_b, *wq, *keys, *pu, *pv, *ln2_g, *ln2_b;
  float* out; char* ws;
};

DI ushort_t f2bf(float x) { unsigned u = __float_as_uint(x); u += 0x7fffu + ((u >> 16) & 1u); return (ushort_t)(u >> 16); }
DI float bf2f(ushort_t h) { return __uint_as_float(((unsigned)h) << 16); }
DI unsigned pack2(float a, float b) { return (unsigned)f2bf(a) | ((unsigned)f2bf(b) << 16); }
DI int tid_opaque() { int t = threadIdx.x; asm volatile("" : "+v"(t)); return t; }
DI float wave_sum(float v) {
#pragma unroll
  for (int o = 32; o > 0; o >>= 1) v += __shfl_xor(v, o);
  return v;
}

struct cf2 { float x, y; };
constexpr int FFT_N = 16384, FFT_SA = 560;

DI constexpr float wcos32(int j) {
  switch (j & 31) {
    case 0: return 1.0f; case 1: return 0.98078528040323043f; case 2: return 0.92387953251128674f; case 3: return 0.83146961230254524f;
    case 4: return 0.70710678118654752f; case 5: return 0.55557023301960218f; case 6: return 0.38268343236508978f; case 7: return 0.19509032201612825f;
    case 8: return 0.0f; case 9: return -0.19509032201612825f; case 10: return -0.38268343236508978f; case 11: return -0.55557023301960218f;
    case 12: return -0.70710678118654752f; case 13: return -0.83146961230254524f; case 14: return -0.92387953251128674f; case 15: return -0.98078528040323043f;
    case 16: return -1.0f; case 17: return -0.98078528040323043f; case 18: return -0.92387953251128674f; case 19: return -0.83146961230254524f;
    case 20: return -0.70710678118654752f; case 21: return -0.55557023301960218f; case 22: return -0.38268343236508978f; case 23: return -0.19509032201612825f;
    case 24: return 0.0f; case 25: return 0.19509032201612825f; case 26: return 0.38268343236508978f; case 27: return 0.55557023301960218f;
    case 28: return 0.70710678118654752f; case 29: return 0.83146961230254524f; case 30: return 0.92387953251128674f; default: return 0.98078528040323043f;
  }
}
DI constexpr float wsin32(int j) { return wcos32(j + 24); }
DI constexpr int brev(int v, int bits) { int r = 0; for (int i = 0; i < bits; ++i) r |= ((v >> i) & 1) << (bits - 1 - i); return r; }

template <int R, int LEN, bool INV, bool ZHI>
DI void r2_stage(float (&re)[R], float (&im)[R]) {
  constexpr int half = LEN / 2;
#pragma unroll
  for (int start = 0; start < R; start += LEN) {
#pragma unroll
    for (int j = 0; j < half; ++j) {
      const int a = start + j, b = a + half;
      const int tj = j * (32 / LEN);
      const float c = wcos32(tj), s = wsin32(tj);
      if (!INV) {
        float dr, di;
        if (ZHI) { dr = re[a]; di = im[a]; }
        else {
          const float ar = re[a], ai = im[a], br = re[b], bi = im[b];
          re[a] = ar + br; im[a] = ai + bi; dr = ar - br; di = ai - bi;
        }
        if (tj == 0) { re[b] = dr; im[b] = di; }
        else if (tj == 8) { re[b] = di; im[b] = -dr; }
        else { re[b] = dr * c + di * s; im[b] = di * c - dr * s; }
      } else {
        const float br = re[b], bi = im[b];
        float pr, pi;
        if (tj == 0) { pr = br; pi = bi; }
        else if (tj == 8) { pr = -bi; pi = br; }
        else { pr = br * c - bi * s; pi = bi * c + br * s; }
        const float ar = re[a], ai = im[a];
        re[a] = ar + pr; im[a] = ai + pi; re[b] = ar - pr; im[b] = ai - pi;
      }
    }
  }
}
template <int R, bool ZHI> DI void dft_fwd(float (&re)[R], float (&im)[R]) {
  if (R == 32) r2_stage<R, (R == 32 ? 32 : 2), false, ZHI>(re, im);
  r2_stage<R, 16, false, (R == 16) && ZHI>(re, im);
  r2_stage<R, 8, false, false>(re, im);
  r2_stage<R, 4, false, false>(re, im);
  r2_stage<R, 2, false, false>(re, im);
}
template <int R> DI void dft_inv(float (&re)[R], float (&im)[R]) {
  r2_stage<R, 2, true, false>(re, im);
  r2_stage<R, 4, true, false>(re, im);
  r2_stage<R, 8, true, false>(re, im);
  r2_stage<R, 16, true, false>(re, im);
  if (R == 32) r2_stage<R, (R == 32 ? 32 : 2), true, false>(re, im);
}

DI void sincos_turn(float frac, float& s, float& c) { sincospif(2.0f * frac, &s, &c); }

template <bool ZHI>
DI void fft_fwdA(float (&re)[32], float (&im)[32], cf2* lds, int m) {
  asm volatile("" : "+v"(m));
  float s1, c1; sincos_turn((float)m * (1.0f / 16384.0f), s1, c1);
  __builtin_amdgcn_sched_barrier(0);
  dft_fwd<32, ZHI>(re, im);
  __builtin_amdgcn_sched_barrier(0);
  float wr = 1.f, wi = 0.f;
#pragma unroll
  for (int k1 = 0; k1 < 32; ++k1) {
    if ((k1 & 3) == 0) __builtin_amdgcn_sched_barrier(0);
    const int r = brev(k1, 5);
    cf2 o; o.x = re[r] * wr - im[r] * wi; o.y = re[r] * wi + im[r] * wr;
    lds[k1 * FFT_SA + m] = o;
    const float nr = wr * c1 + wi * s1, ni = wi * c1 - wr * s1;
    wr = nr; wi = ni;
  }
}
DI void fft_B_read(float (&re)[32], float (&im)[32], const cf2* lds, int tid) {
  const int k1 = tid >> 4, mp = tid & 15;
#pragma unroll
  for (int n2 = 0; n2 < 32; ++n2) { cf2 v = lds[k1 * FFT_SA + n2 * 16 + mp]; re[n2] = v.x; im[n2] = v.y; }
}
DI void fft_fwdB_write(float (&re)[32], float (&im)[32], cf2* lds, int tid) {
  asm volatile("" : "+v"(tid));
  const int k1 = tid >> 4, mp = tid & 15;
  float s1, c1; sincos_turn((float)mp * (1.0f / 512.0f), s1, c1);
  __builtin_amdgcn_sched_barrier(0);
  dft_fwd<32, false>(re, im);
  __builtin_amdgcn_sched_barrier(0);
  float wr = 1.f, wi = 0.f;
#pragma unroll
  for (int k2 = 0; k2 < 32; ++k2) {
    if ((k2 & 3) == 0) __builtin_amdgcn_sched_barrier(0);
    const int r = brev(k2, 5);
    cf2 o; o.x = re[r] * wr - im[r] * wi; o.y = re[r] * wi + im[r] * wr;
    lds[k1 * FFT_SA + k2 * 17 + mp] = o;
    const float nr = wr * c1 + wi * s1, ni = wi * c1 - wr * s1;
    wr = nr; wi = ni;
  }
}
DI void fft_fwdC(float (&re)[32], float (&im)[32], const cf2* lds, int tid) {
  const int k1 = tid >> 5, k2 = tid & 31;
#pragma unroll
  for (int h = 0; h < 2; ++h) {
    float tr[16], ti[16];
#pragma unroll
    for (int mp = 0; mp < 16; ++mp) { cf2 v = lds[(k1 + 16 * h) * FFT_SA + k2 * 17 + mp]; tr[mp] = v.x; ti[mp] = v.y; }
    dft_fwd<16, false>(tr, ti);
#pragma unroll
    for (int i = 0; i < 16; ++i) { re[h * 16 + i] = tr[i]; im[h * 16 + i] = ti[i]; }
  }
}
DI void fft_invC(float (&re)[32], float (&im)[32], cf2* lds, int tid) {
  const int k1 = tid >> 5, k2 = tid & 31;
#pragma unroll
  for (int h = 0; h < 2; ++h) {
    float tr[16], ti[16];
#pragma unroll
    for (int i = 0; i < 16; ++i) { tr[i] = re[h * 16 + i]; ti[i] = im[h * 16 + i]; }
    dft_inv<16>(tr, ti);
#pragma unroll
    for (int mp = 0; mp < 16; ++mp) { cf2 o; o.x = tr[mp]; o.y = ti[mp]; lds[(k1 + 16 * h) * FFT_SA + k2 * 17 + mp] = o; }
  }
}
DI void fft_invB_read(float (&re)[32], float (&im)[32], const cf2* lds, int tid) {
  asm volatile("" : "+v"(tid));
  const int k1 = tid >> 4, mp = tid & 15;
  float s1, c1; sincos_turn((float)mp * (1.0f / 512.0f), s1, c1);
  float wr = 1.f, wi = 0.f;
  __builtin_amdgcn_sched_barrier(0);
#pragma unroll
  for (int k2 = 0; k2 < 32; ++k2) {
    if ((k2 & 3) == 0) __builtin_amdgcn_sched_barrier(0);
    const int r = brev(k2, 5);
    cf2 v = lds[k1 * FFT_SA + k2 * 17 + mp];
    re[r] = v.x * wr - v.y * wi; im[r] = v.x * wi + v.y * wr;
    const float nr = wr * c1 - wi * s1, ni = wi * c1 + wr * s1;
    wr = nr; wi = ni;
  }
}
DI void fft_invB_write(float (&re)[32], float (&im)[32], cf2* lds, int tid) {
  const int k1 = tid >> 4, mp = tid & 15;
  dft_inv<32>(re, im);
#pragma unroll
  for (int n2 = 0; n2 < 32; ++n2) { cf2 o; o.x = re[n2]; o.y = im[n2]; lds[k1 * FFT_SA + n2 * 16 + mp] = o; }
}
DI void fft_invA(float (&re)[32], float (&im)[32], const cf2* lds, int m) {
  asm volatile("" : "+v"(m));
  float s1, c1; sincos_turn((float)m * (1.0f / 16384.0f), s1, c1);
  float wr = 1.f, wi = 0.f;
  __builtin_amdgcn_sched_barrier(0);
#pragma unroll
  for (int k1 = 0; k1 < 32; ++k1) {
    if ((k1 & 3) == 0) __builtin_amdgcn_sched_barrier(0);
    const int r = brev(k1, 5);
    cf2 v = lds[k1 * FFT_SA + m];
    re[r] = v.x * wr - v.y * wi; im[r] = v.x * wi + v.y * wr;
    const float nr = wr * c1 - wi * s1, ni = wi * c1 + wr * s1;
    wr = nr; wi = ni;
  }
  __builtin_amdgcn_sched_barrier(0);
  dft_inv<32>(re, im);
}

DI void phase_ada(const P& p, char* smem) {
  float (*red)[8][64] = (float (*)[8][64])smem;
  const int tid = tid_opaque(), cl = tid & 63, kq = tid >> 6;
  for (int item = blockIdx.x; item < 96; item += gridDim.x) {
    const int col = item * 64 + cl;
    float a0 = 0.f, a1 = 0.f;
    for (int k = kq * 128; k < kq * 128 + 128; ++k) {
      float w = p.w_ada[(size_t)k * 6144 + col];
      float c0 = p.c[k], c1 = p.c[1024 + k];
      a0 += (c0 / (1.f + __expf(-c0))) * w;
      a1 += (c1 / (1.f + __expf(-c1))) * w;
    }
    __syncthreads();
    red[0][kq][cl] = a0; red[1][kq][cl] = a1;
    __syncthreads();
    if (tid < 128) {
      int b = tid >> 6;
      float s = p.b_ada[col];
#pragma unroll
      for (int q = 0; q < 8; ++q) s += red[b][q][cl];
      ((float*)(p.ws + OFF_ADA))[b * 6144 + col] = s;
    }
  }
}

DI void transpose_tile(const float* __restrict__ W, ushort_t* __restrict__ Wt, int K, int N, int item, char* smem) {
  float (*tile)[65] = (float (*)[65])smem;
  const int ntn = N / 64;
  const int n0 = (item % ntn) * 64, k0 = (item / ntn) * 32;
  const int tid = tid_opaque();
  __syncthreads();
  {
    const int tx = tid & 63, ty = tid >> 6;
#pragma unroll
    for (int i = 0; i < 4; ++i) tile[ty + 8 * i][tx] = W[(size_t)(k0 + ty + 8 * i) * N + n0 + tx];
  }
  __syncthreads();
  {
    const int kk = tid & 31, nn0 = tid >> 5;
#pragma unroll
    for (int i = 0; i < 4; ++i) Wt[(size_t)(n0 + nn0 + 16 * i) * K + k0 + kk] = f2bf(tile[kk][nn0 + 16 * i]);
  }
}
DI void phase_transposes(const P& p, char* smem) {
  constexpr int I0 = (INW / 64) * 32, I1 = I0 + 32 * 32, I2 = I1 + 16 * 32, I3 = I2 + 16 * 16, I4 = I3 + 16 * 8;
  for (int item = blockIdx.x; item < I4; item += gridDim.x) {
    if (item < I0) transpose_tile(p.w_in, (ushort_t*)(p.ws + OFF_WIN_T), 1024, INW, item, smem);
    else if (item < I1) transpose_tile(p.wq, (ushort_t*)(p.ws + OFF_WQ_T), 1024, 2048, item - I0, smem);
    else if (item < I2) transpose_tile(p.w_out, (ushort_t*)(p.ws + OFF_WOUT_T), 1024, 1024, item - I1, smem);
    else if (item < I3) transpose_tile(p.w_bh, (ushort_t*)(p.ws + OFF_WBH_T), 512, 1024, item - I2, smem);
    else transpose_tile(p.w_ba, (ushort_t*)(p.ws + OFF_WBA_T), 256, 1024, item - I3, smem);
  }
}

DI void phase_filter(const P& p, char* smem) {
  float (*zf)[33] = (float (*)[33])smem;
  float (*h1)[64] = (float (*)[64])(smem + 4352);
  float (*h2T)[32] = (float (*)[32])(smem + 4352 + 8192);
  const int tid = tid_opaque();
  for (int item = blockIdx.x; item < 256; item += gridDim.x) {
  const int t0 = item * 32;
  __syncthreads();
  for (int idx = tid; idx < 32 * 33; idx += NT) {
    int tt = idx / 33, e = idx % 33, t = t0 + tt;
    float tl = (float)t * (1.0f / 8191.0f);
    float w = 6.283185307179586f * (float)t / 8192.0f;
    float val;
    if (e == 0) val = tl;
    else {
      int i = (e - 1) & 15;
      float f = 1e-4f + (float)i * ((15.0f - 1e-4f) / 15.0f);
      val = (e <= 16) ? cosf(f * w) : -sinf(f * w);
    }
    zf[tt][e] = val;
  }
  __syncthreads();
  for (int idx = tid; idx < 32 * 64; idx += NT) {
    int tt = idx >> 6, j = idx & 63;
    float a = p.f1_b[j];
    for (int e = 0; e < 33; ++e) a += zf[tt][e] * p.f1_w[e * 64 + j];
    h1[tt][j] = sinf(p.f1_freq[j] * a);
  }
  __syncthreads();
  for (int idx = tid; idx < 32 * 64; idx += NT) {
    int tt = idx >> 6, j = idx & 63;
    float a = p.f2_b[j];
    for (int e = 0; e < 64; ++e) a += h1[tt][e] * p.f2_w[e * 64 + j];
    h2T[j][tt] = sinf(p.f2_freq[j] * a);
  }
  __syncthreads();
  float* filt = p.out;
  const float min_decay = -3.0701134573253945f, max_decay = -15.350567286626973f;
  for (int col = tid; col < 2048; col += NT) {
    float acc[32];
#pragma unroll
    for (int i = 0; i < 32; ++i) acc[i] = 0.f;
    for (int j = 0; j < 64; ++j) {
      float w = p.f3_w[j * 2048 + col];
#pragma unroll
      for (int q = 0; q < 8; ++q) {
        f32x4 h = *(const f32x4*)&h2T[j][q * 4];
        acc[q * 4 + 0] += h[0] * w; acc[q * 4 + 1] += h[1] * w; acc[q * 4 + 2] += h[2] * w; acc[q * 4 + 3] += h[3] * w;
      }
    }
    int c = col & 511;
    float delta = fabsf(min_decay + (float)c * ((max_decay - min_decay) / 511.0f));
    float* dst = filt + (size_t)col * 8192 + t0;
#pragma unroll
    for (int q = 0; q < 8; ++q) {
      f32x4 o;
#pragma unroll
      for (int r = 0; r < 4; ++r) {
        float tl = (float)(t0 + q * 4 + r) * (1.0f / 8191.0f);
        o[r] = acc[q * 4 + r] * __expf(-tl * delta);
      }
      *(f32x4*)(dst + q * 4) = o;
    }
  }
  }
}

constexpr int BM = 256, BN = 128, BK = 64;
constexpr int LDS_A = BM * BK * 2, LDS_B = BN * BK * 2, LDS_STAGE = LDS_A + LDS_B;
constexpr int GEMM_LDS = 2 * LDS_STAGE + 8192;

DI int swz(int row, int ch) { return row * 128 + ((ch ^ (row & 7)) << 4); }

struct ALoadBf16 {
  const ushort_t* A; int lda;
  struct Raw { u32x4 v; };
  DI Raw fetch(int row, int k) const { Raw r; r.v = *(const u32x4*)(A + (size_t)row * lda + k); return r; }
  DI u32x4 cvt(const Raw& r, int k) const { return r.v; }
};
struct ALoadF32Mod {
  const float* A; const float* mod;
  struct Raw { f32x4 a, b; };
  DI Raw fetch(int row, int k) const { Raw r; const float* s = A + (size_t)row * 1024 + k; r.a = *(const f32x4*)s; r.b = *(const f32x4*)(s + 4); return r; }
  DI u32x4 cvt(const Raw& r, int k) const {
    f32x4 s0 = *(const f32x4*)(mod + k), s1 = *(const f32x4*)(mod + k + 4);
    f32x4 h0 = *(const f32x4*)(mod + 1024 + k), h1 = *(const f32x4*)(mod + 1024 + k + 4);
    u32x4 o;
    o[0] = pack2(r.a[0] * s0[0] + h0[0], r.a[1] * s0[1] + h0[1]);
    o[1] = pack2(r.a[2] * s0[2] + h0[2], r.a[3] * s0[3] + h0[3]);
    o[2] = pack2(r.b[0] * s1[0] + h1[0], r.b[1] * s1[1] + h1[1]);
    o[3] = pack2(r.b[2] * s1[2] + h1[2], r.b[3] * s1[3] + h1[3]);
    return o;
  }
};

template <class AL, bool SWAP = false>
DI void gemm_mainloop(f32x16 (&acc)[2][2], const AL& al, int m0, const ushort_t* __restrict__ Bt, int ldb, int n0, int K, char* smem) {
  const int tid = tid_opaque(), lane = tid & 63, wave = tid >> 6;
  const int wm = wave >> 1, wn = wave & 1;
  const int lr = tid >> 3, lc = tid & 7;
  typename AL::Raw ra[4]; u32x4 rb[2];
  const int nk = K / BK;
#pragma unroll
  for (int i = 0; i < 4; ++i) ra[i] = al.fetch(m0 + lr + 64 * i, lc * 8);
#pragma unroll
  for (int i = 0; i < 2; ++i) rb[i] = *(const u32x4*)(Bt + (size_t)(n0 + lr + 64 * i) * ldb + lc * 8);
  __syncthreads();
#pragma unroll
  for (int i = 0; i < 4; ++i) *(u32x4*)(smem + swz(lr + 64 * i, lc)) = al.cvt(ra[i], lc * 8);
#pragma unroll
  for (int i = 0; i < 2; ++i) *(u32x4*)(smem + LDS_A + swz(lr + 64 * i, lc)) = rb[i];
  __syncthreads();
  for (int kt = 0; kt < nk; ++kt) {
    char* cur = smem + (kt & 1) * LDS_STAGE;
    char* nxt = smem + ((kt + 1) & 1) * LDS_STAGE;
    const bool more = (kt + 1 < nk);
    const int kn = (kt + 1) * BK + lc * 8;
    if (more) {
#pragma unroll
      for (int i = 0; i < 4; ++i) ra[i] = al.fetch(m0 + lr + 64 * i, kn);
#pragma unroll
      for (int i = 0; i < 2; ++i) rb[i] = *(const u32x4*)(Bt + (size_t)(n0 + lr + 64 * i) * ldb + kn);
    }
#pragma unroll
    for (int s = 0; s < 4; ++s) {
      const int ch = 2 * s + (lane >> 5);
      bf16x8 af[2], bfr[2];
#pragma unroll
      for (int mi = 0; mi < 2; ++mi) af[mi] = *(const bf16x8*)(cur + swz(wm * 64 + mi * 32 + (lane & 31), ch));
#pragma unroll
      for (int ni = 0; ni < 2; ++ni) bfr[ni] = *(const bf16x8*)(cur + LDS_A + swz(wn * 64 + ni * 32 + (lane & 31), ch));
#pragma unroll
      for (int mi = 0; mi < 2; ++mi)
#pragma unroll
        for (int ni = 0; ni < 2; ++ni)
          acc[mi][ni] = SWAP ? __builtin_amdgcn_mfma_f32_32x32x16_bf16(bfr[ni], af[mi], acc[mi][ni], 0, 0, 0)
                             : __builtin_amdgcn_mfma_f32_32x32x16_bf16(af[mi], bfr[ni], acc[mi][ni], 0, 0, 0);
    }
    if (more) {
#pragma unroll
      for (int i = 0; i < 4; ++i) *(u32x4*)(nxt + swz(lr + 64 * i, lc)) = al.cvt(ra[i], kn);
#pragma unroll
      for (int i = 0; i < 2; ++i) *(u32x4*)(nxt + LDS_A + swz(lr + 64 * i, lc)) = rb[i];
    }
    __syncthreads();
  }
}

constexpr int AT_ROW = 576;
constexpr int LDS_AT = 64 * AT_ROW;
constexpr int LDS_STAGE_T = LDS_AT + LDS_B;
typedef __attribute__((ext_vector_type(4))) short s16x4;
DI void gemm_mainloop_AT(f32x16 (&acc)[2][2], const ushort_t* __restrict__ At, size_t ldt, const ushort_t* __restrict__ Bt, int ldb, int n0, int K, char* smem) {
  const int tid = tid_opaque(), lane = tid & 63, wave = tid >> 6;
  const int wm = wave >> 1, wn = wave & 1;
  const int lr = tid >> 3, lc = tid & 7;
  u32x4 ra[4], rb[2];
  const int nk = K / BK;
#pragma unroll
  for (int i = 0; i < 4; ++i) { const int q = tid + 512 * i; ra[i] = *(const u32x4*)(At + (size_t)(q >> 5) * ldt + (q & 31) * 8); }
#pragma unroll
  for (int i = 0; i < 2; ++i) rb[i] = *(const u32x4*)(Bt + (size_t)(n0 + lr + 64 * i) * ldb + lc * 8);
  __syncthreads();
#pragma unroll
  for (int i = 0; i < 4; ++i) { const int q = tid + 512 * i; *(u32x4*)(smem + (q >> 5) * AT_ROW + (q & 31) * 16) = ra[i]; }
#pragma unroll
  for (int i = 0; i < 2; ++i) *(u32x4*)(smem + LDS_AT + swz(lr + 64 * i, lc)) = rb[i];
  __syncthreads();
  const int hh = lane >> 5, gg = (lane >> 4) & 1, qq = (lane & 15) >> 2, pp = lane & 3;
  for (int kt = 0; kt < nk; ++kt) {
    char* cur = smem + (kt & 1) * LDS_STAGE_T;
    char* nxt = smem + ((kt + 1) & 1) * LDS_STAGE_T;
    const bool more = (kt + 1 < nk);
    if (more) {
#pragma unroll
      for (int i = 0; i < 4; ++i) { const int q = tid + 512 * i; ra[i] = *(const u32x4*)(At + (size_t)((kt + 1) * BK + (q >> 5)) * ldt + (q & 31) * 8); }
#pragma unroll
      for (int i = 0; i < 2; ++i) rb[i] = *(const u32x4*)(Bt + (size_t)(n0 + lr + 64 * i) * ldb + (kt + 1) * BK + lc * 8);
    }
#pragma unroll
    for (int s = 0; s < 4; ++s) {
      const int ch = 2 * s + hh;
      bf16x8 af[2], bfr[2];
#pragma unroll
      for (int mi = 0; mi < 2; ++mi) {
        const char* a0 = cur + (16 * s + 8 * hh + qq) * AT_ROW + (wm * 64 + mi * 32 + 16 * gg + 4 * pp) * 2;
        s16x4 lo = __builtin_amdgcn_ds_read_tr16_b64_v4i16((__attribute__((address_space(3))) s16x4*)(a0));
        s16x4 hi = __builtin_amdgcn_ds_read_tr16_b64_v4i16((__attribute__((address_space(3))) s16x4*)(a0 + 4 * AT_ROW));
        af[mi] = __builtin_shufflevector(lo, hi, 0, 1, 2, 3, 4, 5, 6, 7);
      }
#pragma unroll
      for (int ni = 0; ni < 2; ++ni) bfr[ni] = *(const bf16x8*)(cur + LDS_AT + swz(wn * 64 + ni * 32 + (lane & 31), ch));
#pragma unroll
      for (int mi = 0; mi < 2; ++mi)
#pragma unroll
        for (int ni = 0; ni < 2; ++ni) acc[mi][ni] = __builtin_amdgcn_mfma_f32_32x32x16_bf16(af[mi], bfr[ni], acc[mi][ni], 0, 0, 0);
    }
    if (more) {
#pragma unroll
      for (int i = 0; i < 4; ++i) { const int q = tid + 512 * i; *(u32x4*)(nxt + (q >> 5) * AT_ROW + (q & 31) * 16) = ra[i]; }
#pragma unroll
      for (int i = 0; i < 2; ++i) *(u32x4*)(nxt + LDS_AT + swz(lr + 64 * i, lc)) = rb[i];
    }
    __syncthreads();
  }
}
DI void acc_zero(f32x16 (&acc)[2][2]) {
#pragma unroll
  for (int a = 0; a < 2; ++a)
#pragma unroll
    for (int b = 0; b < 2; ++b)
#pragma unroll
      for (int r = 0; r < 16; ++r) acc[a][b][r] = 0.f;
}
#define ACC_ROW(mi, r) (wm * 64 + (mi) * 32 + ((r) & 3) + 8 * ((r) >> 2) + 4 * (lane >> 5))
#define ACC_COL(ni) (wn * 64 + (ni) * 32 + (lane & 31))

DI void stage_mod(float* mod, const float* ada, int b, int sc_chunk, int sh_chunk) {
  for (int i = tid_opaque(); i < 1024; i += NT) {
    mod[i] = 1.f + ada[b * 6144 + sc_chunk * 1024 + i];
    mod[1024 + i] = ada[b * 6144 + sh_chunk * 1024 + i];
  }
}

DI void phase_inproj(const P& p, char* smem) {
  const float* ada = (const float*)(p.ws + OFF_ADA);
  float* mod = (float*)(smem + 2 * LDS_STAGE);
  const ushort_t* wt = (const ushort_t*)(p.ws + OFF_WIN_T);
  ushort_t* ph = (ushort_t*)(p.ws + OFF_PH);
  ushort_t* qkv = (ushort_t*)(p.ws + OFF_QKV);
  ushort_t* gate = (ushort_t*)(p.ws + OFF_GATE);
  const int tid = tid_opaque(), lane = tid & 63, wave = tid >> 6, wm = wave >> 1, wn = wave & 1;
  constexpr int NTN = INW / BN;
  constexpr int NTM = T_ / BM;
  for (int tile = blockIdx.x; tile < NTM * NTN; tile += gridDim.x) {
    const int tm = tile / NTN, tn = tile % NTN;
    const int m0 = tm * BM, n0 = tn * BN, b = m0 / S_;
    __syncthreads();
    stage_mod(mod, ada, b, 1, 0);
    __syncthreads();
    f32x16 acc[2][2]; acc_zero(acc);
    ALoadF32Mod al{p.x, mod};
    if (n0 < HYC) {
      gemm_mainloop<ALoadF32Mod, true>(acc, al, m0, wt, 1024, n0, 1024, smem);
#pragma unroll
      for (int mi = 0; mi < 2; ++mi) {
        const int t = (m0 & (S_ - 1)) + wm * 64 + mi * 32 + (lane & 31);
#pragma unroll
        for (int ni = 0; ni < 2; ++ni)
#pragma unroll
          for (int r = 0; r < 16; ++r) {
            const int ch = n0 + wn * 64 + ni * 32 + (r & 3) + 8 * (r >> 2) + 4 * (lane >> 5);
            ph[((size_t)(b * HYC + ch)) * S_ + t] = f2bf(acc[mi][ni][r]);
          }
      }
      continue;
    }
    gemm_mainloop(acc, al, m0, wt, 1024, n0, 1024, smem);
#pragma unroll
    for (int ni = 0; ni < 2; ++ni) {
      const int col = n0 + ACC_COL(ni);
#pragma unroll
      for (int mi = 0; mi < 2; ++mi) {
        if (col < HYC + QKVC) {
          const int cq = col - HYC;
          const bool rot = (cq < 1536) && ((cq & 63) < 16);
          const float qs = (cq < 768) ? 0.125f : 1.0f;
          const float inv = expf(-13.122363377404328f * (float)(cq & 7) * 0.125f);
#pragma unroll
          for (int r = 0; r < 16; ++r) {
            const int row = m0 + ACC_ROW(mi, r);
            float v = acc[mi][ni][r];
            float o = __shfl_xor(v, 8);
            if (rot) {
              float ang = (float)p.pos[row] * inv;
              float sn, cs; sincosf(ang, &sn, &cs);
              v = ((cq & 15) < 8) ? (v * cs - o * sn) : (v * cs + o * sn);
            }
            qkv[(size_t)row * QKVC + cq] = f2bf(v * qs);
          }
        } else {
          const int cg = col - HYC - QKVC;
#pragma unroll
          for (int r = 0; r < 16; ++r) {
            float v = acc[mi][ni][r];
            gate[(size_t)(m0 + ACC_ROW(mi, r)) * GATEC + cg] = f2bf(1.f / (1.f + __expf(-v)));
          }
        }
      }
    }
  }
}

DI float sconv_t(const ushort_t* row, int t, float w0, float w1, float w2, float cb) {
  float v = cb + w1 * bf2f(row[t]);
  if (t > 0) v += w0 * bf2f(row[t - 1]);
  if (t < S_ - 1) v += w2 * bf2f(row[t + 1]);
  return v;
}
DI void fft_C_mul_invC(cf2* lds, const cf2* __restrict__ kq, int tid) {
  asm volatile("" : "+v"(tid));
  const int k1 = tid >> 5, k2 = tid & 31;
  kq += tid;
#pragma unroll
  for (int h = 0; h < 2; ++h) {
    float tr[16], ti[16];
    cf2 kv[16];
#pragma unroll
    for (int i = 0; i < 16; ++i) kv[i] = kq[(h * 16 + i) * 512];
    cf2* blk = lds + (k1 + 16 * h) * FFT_SA + k2 * 17;
#pragma unroll
    for (int mp = 0; mp < 16; ++mp) { cf2 v = blk[mp]; tr[mp] = v.x; ti[mp] = v.y; }
    dft_fwd<16, false>(tr, ti);
#pragma unroll
    for (int i = 0; i < 16; ++i) { const float a = tr[i], b = ti[i]; tr[i] = a * kv[i].x - b * kv[i].y; ti[i] = a * kv[i].y + b * kv[i].x; }
    dft_inv<16>(tr, ti);
#pragma unroll
    for (int mp = 0; mp < 16; ++mp) { cf2 o; o.x = tr[mp]; o.y = ti[mp]; blk[mp] = o; }
  }
}
DI void hyena_item(const P& p, char* smem, int c) {
  cf2* lds = (cf2*)smem;
  const ushort_t* pht = (const ushort_t*)(p.ws + OFF_PH);
  ushort_t* yht = (ushort_t*)(p.ws + OFF_YH);
  cf2* kq = (cf2*)(p.ws + (blockIdx.x < 92 ? OFF_WIN_T + (size_t)blockIdx.x * 131072 : OFF_HSCR + (size_t)(blockIdx.x - 92) * 131072));
  const float* filt = p.out;
  const int tid0 = tid_opaque();
  float zr[32], zi[32];
  __syncthreads();
#pragma unroll 1
  for (int o = 0; o < 2; ++o) {
    int tid = tid0; asm volatile("" : "+v"(tid));
    {
      float kr[32], ki[32];
      const float* fw = filt + (size_t)(0 * 1024 + o * 512 + c) * S_;
      const float* bw = filt + (size_t)(1 * 1024 + o * 512 + c) * S_;
      const float bias = p.hy_bias[o * 512 + c];
#pragma unroll
      for (int n1 = 0; n1 < 16; ++n1) { kr[n1] = fw[n1 * 512 + tid] * (1.0f / 16384.0f); ki[n1] = 0.f; }
      if (tid == 0) kr[0] += bias * (1.0f / 16384.0f);
#pragma unroll
      for (int n1 = 16; n1 < 32; ++n1) {
        const int n = n1 * 512 + tid;
        kr[n1] = (n == S_) ? 0.f : bw[2 * S_ - n] * (1.0f / 16384.0f); ki[n1] = 0.f;
      }
      fft_fwdA<false>(kr, ki, lds, tid); __syncthreads();
      fft_B_read(kr, ki, lds, tid); __syncthreads();
      fft_fwdB_write(kr, ki, lds, tid); __syncthreads();
      fft_fwdC(kr, ki, lds, tid);
      int ts = tid; asm volatile("" : "+v"(ts));
      cf2* kqt = kq + ts;
#pragma unroll
      for (int r = 0; r < 32; ++r) { cf2 v; v.x = kr[r]; v.y = ki[r]; kqt[r * 512] = v; }
      __syncthreads();
    }
    asm volatile("" : "+v"(tid));
    if (o == 0) {
      const float w0 = p.hy_conv_w[c], w1 = p.hy_conv_w[HYC + c], w2 = p.hy_conv_w[2 * HYC + c], cb = p.hy_conv_b[c];
      const ushort_t* r0 = pht + (size_t)(0 * HYC + c) * S_;
      const ushort_t* r1 = pht + (size_t)(1 * HYC + c) * S_;
#pragma unroll
      for (int n1 = 0; n1 < 16; ++n1) {
        const int t = n1 * 512 + tid;
        zr[n1] = sconv_t(r0, t, w0, w1, w2, cb); zi[n1] = sconv_t(r1, t, w0, w1, w2, cb);
        if (n1 & 1) asm volatile("" ::: "memory");
      }
    }
#pragma unroll
    for (int n1 = 16; n1 < 32; ++n1) { zr[n1] = 0.f; zi[n1] = 0.f; }
    fft_fwdA<true>(zr, zi, lds, tid); __syncthreads();
    fft_B_read(zr, zi, lds, tid); __syncthreads();
    fft_fwdB_write(zr, zi, lds, tid); __syncthreads();
    fft_C_mul_invC(lds, kq, tid); __syncthreads();
    fft_invB_read(zr, zi, lds, tid); __syncthreads();
    fft_invB_write(zr, zi, lds, tid); __syncthreads();
    fft_invA(zr, zi, lds, tid);
    int tg = tid; asm volatile("" : "+v"(tg));
    const int gch = (o + 1) * 512 + c;
    const float w0 = p.hy_conv_w[gch], w1 = p.hy_conv_w[HYC + gch], w2 = p.hy_conv_w[2 * HYC + gch], cb = p.hy_conv_b[gch];
    const ushort_t* g0 = pht + (size_t)(0 * HYC + gch) * S_;
    const ushort_t* g1 = pht + (size_t)(1 * HYC + gch) * S_;
#pragma unroll
    for (int n1 = 0; n1 < 16; ++n1) {
      const int t = n1 * 512 + tg;
      zr[n1] *= sconv_t(g0, t, w0, w1, w2, cb);
      zi[n1] *= sconv_t(g1, t, w0, w1, w2, cb);
      if (n1 & 1) asm volatile("" ::: "memory");
    }
    if (o == 1) {
#pragma unroll
      for (int n1 = 0; n1 < 16; ++n1) {
        const int t = n1 * 512 + tg;
        yht[(size_t)(0 * HW_ + c) * S_ + t] = f2bf(zr[n1]);
        yht[(size_t)(1 * HW_ + c) * S_ + t] = f2bf(zi[n1]);
      }
    }
  }
}

DI void attn_item(const P& p, int item) {
  const ushort_t* qkv = (const ushort_t*)(p.ws + OFF_QKV);
  ushort_t* ya = (ushort_t*)(p.ws + OFF_YA);
  {
    int tx = threadIdx.x;
    asm volatile("" : "+v"(tx));
    const int hs = tx >> 7;
    const int tok = item * 128 + (tx & 127);
    const int b = tok / S_, t = tok % S_;
    float acc[64];
#pragma unroll
    for (int e = 0; e < 64; ++e) acc[e] = 0.f;
    float m = -1e30f, l = 0.f;
    for (int g = 0; g < 3; ++g) {
      const int dil = (g == 0) ? 1 : (g == 1 ? 4 : 16);
      const int head = g * 4 + hs;
      float q[64];
      {
        const ushort_t* qp = qkv + (size_t)tok * QKVC + head * 64;
#pragma unroll
        for (int e8 = 0; e8 < 8; ++e8) {
          u32x4 v = *(const u32x4*)(qp + e8 * 8);
#pragma unroll
          for (int w = 0; w < 4; ++w) { q[e8 * 8 + 2 * w] = __uint_as_float(v[w] << 16); q[e8 * 8 + 2 * w + 1] = __uint_as_float(v[w] & 0xffff0000u); }
        }
      }
      for (int j = -64; j <= 64; ++j) {
        const int tk = t + dil * j;
        if (tk < 0 || tk >= S_) continue;
        const ushort_t* kp = qkv + (size_t)(b * S_ + tk) * QKVC + 768 + head * 64;
        float s = 0.f;
#pragma unroll
        for (int e8 = 0; e8 < 8; ++e8) {
          u32x4 v = *(const u32x4*)(kp + e8 * 8);
#pragma unroll
          for (int w = 0; w < 4; ++w) { s += q[e8 * 8 + 2 * w] * __uint_as_float(v[w] << 16); s += q[e8 * 8 + 2 * w + 1] * __uint_as_float(v[w] & 0xffff0000u); }
        }
        const float mn = fmaxf(m, s);
        const float corr = __expf(m - mn), pe = __expf(s - mn);
        l = l * corr + pe; m = mn;
        const ushort_t* vp = kp + 768;
#pragma unroll
        for (int e8 = 0; e8 < 8; ++e8) {
          u32x4 v = *(const u32x4*)(vp + e8 * 8);
#pragma unroll
          for (int w = 0; w < 4; ++w) {
            acc[e8 * 8 + 2 * w] = acc[e8 * 8 + 2 * w] * corr + pe * __uint_as_float(v[w] << 16);
            acc[e8 * 8 + 2 * w + 1] = acc[e8 * 8 + 2 * w + 1] * corr + pe * __uint_as_float(v[w] & 0xffff0000u);
          }
        }
      }
    }
    const float il = 1.f / l;
    ushort_t* op = ya + (size_t)tok * 256 + hs * 64;
#pragma unroll
    for (int e8 = 0; e8 < 8; ++e8) {
      u32x4 o;
#pragma unroll
      for (int w = 0; w < 4; ++w) o[w] = pack2(acc[e8 * 8 + 2 * w] * il, acc[e8 * 8 + 2 * w + 1] * il);
      *(u32x4*)(op + e8 * 8) = o;
    }
  }
}

DI void phase_merge(const P& p, char* smem) {
  const ushort_t* yh = (const ushort_t*)(p.ws + OFF_YH);
  const ushort_t* ya = (const ushort_t*)(p.ws + OFF_YA);
  const ushort_t* gate = (const ushort_t*)(p.ws + OFF_GATE);
  ushort_t* merged = (ushort_t*)(p.ws + OFF_MERGED);
  const int tid = tid_opaque(), lane = tid & 63, wave = tid >> 6, wm = wave >> 1, wn = wave & 1;
  constexpr int NTN = 1024 / BN, NTM = T_ / BM;
  for (int tile = blockIdx.x; tile < NTM * NTN; tile += gridDim.x) {
    const int m0 = (tile / NTN) * BM, n0 = (tile % NTN) * BN;
    f32x16 a1[2][2], a2[2][2]; acc_zero(a1); acc_zero(a2);
    gemm_mainloop_AT(a1, yh + (size_t)((m0 / S_) * HW_) * S_ + (m0 & (S_ - 1)), (size_t)S_, (const ushort_t*)(p.ws + OFF_WBH_T), 512, n0, 512, smem);
    ALoadBf16 l2{ya, 256};
    gemm_mainloop(a2, l2, m0, (const ushort_t*)(p.ws + OFF_WBA_T), 256, n0, 256, smem);
#pragma unroll
    for (int mi = 0; mi < 2; ++mi)
#pragma unroll
      for (int ni = 0; ni < 2; ++ni)
#pragma unroll
        for (int r = 0; r < 16; ++r) {
          const int row = m0 + ACC_ROW(mi, r), col = n0 + ACC_COL(ni);
          float gh = bf2f(gate[(size_t)row * GATEC + col]), ga = bf2f(gate[(size_t)row * GATEC + 1024 + col]);
          merged[(size_t)row * 1024 + col] = f2bf(gh * a1[mi][ni][r] + ga * a2[mi][ni][r]);
        }
  }
}

DI void phase_outproj(const P& p, char* smem) {
  const float* ada = (const float*)(p.ws + OFF_ADA);
  const ushort_t* merged = (const ushort_t*)(p.ws + OFF_MERGED);
  const int tid = tid_opaque(), lane = tid & 63, wave = tid >> 6, wm = wave >> 1, wn = wave & 1;
  constexpr int NTN = 1024 / BN, NTM = T_ / BM;
  for (int tile = blockIdx.x; tile < NTM * NTN; tile += gridDim.x) {
    const int m0 = (tile / NTN) * BM, n0 = (tile % NTN) * BN, b = m0 / S_;
    f32x16 acc[2][2]; acc_zero(acc);
    ALoadBf16 l1{merged, 1024};
    gemm_mainloop(acc, l1, m0, (const ushort_t*)(p.ws + OFF_WOUT_T), 1024, n0, 1024, smem);
#pragma unroll
    for (int ni = 0; ni < 2; ++ni) {
      const int col = n0 + ACC_COL(ni);
      const float g1 = 1.f + ada[b * 6144 + 2 * 1024 + col];
#pragma unroll
      for (int mi = 0; mi < 2; ++mi)
#pragma unroll
        for (int r = 0; r < 16; ++r) {
          const size_t o = (size_t)(m0 + ACC_ROW(mi, r)) * 1024 + col;
          p.out[o] = DN_ALPHA * p.x[o] + g1 * acc[mi][ni][r];
        }
    }
  }
}

DI void phase_ln(float* __restrict__ xio, const float* __restrict__ g, const float* __restrict__ bta) {
  const int tq = tid_opaque(); const int lane = tq & 63, wave = tq >> 6;
  for (int row = blockIdx.x * 8 + wave; row < T_; row += gridDim.x * 8) {
    float* rp = xio + (size_t)row * 1024;
    f32x4 v[4];
    float s = 0.f;
#pragma unroll
    for (int i = 0; i < 4; ++i) { v[i] = *(const f32x4*)(rp + i * 256 + lane * 4); s += v[i][0] + v[i][1] + v[i][2] + v[i][3]; }
    const float mu = wave_sum(s) * (1.f / 1024.f);
    float q = 0.f;
#pragma unroll
    for (int i = 0; i < 4; ++i)
#pragma unroll
      for (int j = 0; j < 4; ++j) { float d = v[i][j] - mu; q += d * d; }
    const float rs = rsqrtf(wave_sum(q) * (1.f / 1024.f) + LN_EPS);
#pragma unroll
    for (int i = 0; i < 4; ++i) {
      f32x4 gg = *(const f32x4*)(g + i * 256 + lane * 4), bb = *(const f32x4*)(bta + i * 256 + lane * 4), o;
#pragma unroll
      for (int j = 0; j < 4; ++j) o[j] = (v[i][j] - mu) * rs * gg[j] + bb[j];
      *(f32x4*)(rp + i * 256 + lane * 4) = o;
    }
  }
}

DI int swz256(int row, int ch) { return row * 256 + ((ch ^ (row & 15)) << 4); }
DI void ins16(float (&L)[16], float x) {
#pragma unroll
  for (int i = 0; i < 16; ++i) { const float hi = __builtin_fmaxf(L[i], x); x = __builtin_fminf(L[i], x); L[i] = hi; }
}
DI void bitonic16_desc(float (&M)[16]) {
#pragma unroll
  for (int d = 8; d >= 1; d >>= 1)
#pragma unroll
    for (int i = 0; i < 16; ++i)
      if ((i & d) == 0) { const float a = M[i], b = M[i + d]; M[i] = __builtin_fmaxf(a, b); M[i + d] = __builtin_fminf(a, b); }
}
constexpr int ROUTE_Q_OFF = 0, ROUTE_K_OFF = 65536, ROUTE_IDX_OFF = 106496;
DI void phase_route(const P& p, char* smem) {
  const float* ada = (const float*)(p.ws + OFF_ADA);
  float* mod = (float*)(smem + 2 * LDS_STAGE);
  const ushort_t* keysb = (const ushort_t*)(p.ws + OFF_KEYS_B);
  int* idx = (int*)(p.ws + OFF_IDX);
  float* gv = (float*)(p.ws + OFF_GV);
  for (int item = blockIdx.x; item < (T_ / BM) * 8; item += gridDim.x) {
    const int tid = tid_opaque(), lane = tid & 63, wave = tid >> 6, wm = wave >> 1, wn = wave & 1;
    const int m0 = (item >> 3) * BM, hh = item & 7, b = m0 / S_;
    __syncthreads();
    stage_mod(mod, ada, b, 4, 3);
    __syncthreads();
    float L0[16];
#pragma unroll 1
    for (int pp = 0; pp < 2; ++pp) {
      const int hp = hh * 2 + pp;
      f32x16 acc[2][2]; acc_zero(acc);
      ALoadF32Mod al{p.out, mod};
      gemm_mainloop<ALoadF32Mod, true>(acc, al, m0, (const ushort_t*)(p.ws + OFF_WQ_T), 1024, hp * 128, 1024, smem);
#pragma unroll
      for (int mi = 0; mi < 2; ++mi) {
        const int tok = wm * 64 + mi * 32 + (lane & 31);
#pragma unroll
        for (int ni = 0; ni < 2; ++ni)
#pragma unroll
          for (int g = 0; g < 4; ++g) {
            const int ch = wn * 8 + ni * 4 + g;
            uint2 v; v.x = pack2(acc[mi][ni][4 * g], acc[mi][ni][4 * g + 1]); v.y = pack2(acc[mi][ni][4 * g + 2], acc[mi][ni][4 * g + 3]);
            *(uint2*)(smem + ROUTE_Q_OFF + swz256(tok, ch) + 8 * (lane >> 5)) = v;
          }
      }
#pragma unroll
      for (int i = 0; i < 4; ++i) {
        const int q = tid + 512 * i, row = q >> 4, ch = q & 15;
        *(u32x4*)(smem + ROUTE_K_OFF + swz256(row, ch)) = *(const u32x4*)(keysb + (size_t)hp * 16384 + row * 128 + ch * 8);
      }
      __syncthreads();
      f32x16 sc[4];
#pragma unroll
      for (int ks = 0; ks < 4; ++ks)
#pragma unroll
        for (int r = 0; r < 16; ++r) sc[ks][r] = 0.f;
#pragma unroll
      for (int s = 0; s < 8; ++s) {
        const int ch = 2 * s + (lane >> 5);
        const bf16x8 bq = *(const bf16x8*)(smem + ROUTE_Q_OFF + swz256(wave * 32 + (lane & 31), ch));
#pragma unroll
        for (int ks = 0; ks < 4; ++ks) {
          const bf16x8 ak = *(const bf16x8*)(smem + ROUTE_K_OFF + swz256(ks * 32 + (lane & 31), ch));
          sc[ks] = __builtin_amdgcn_mfma_f32_32x32x16_bf16(ak, bq, sc[ks], 0, 0, 0);
        }
      }
      float L[16];
#pragma unroll
      for (int i = 0; i < 16; ++i) L[i] = -3.0e38f;
      const unsigned hbit = (unsigned)(lane >> 5) << 2;
#pragma unroll
      for (int ks = 0; ks < 4; ++ks)
#pragma unroll
        for (int r = 0; r < 16; ++r) {
          const unsigned key = (unsigned)(ks * 32 + (r & 3) + 8 * (r >> 2)) | hbit;
          ins16(L, __uint_as_float((__float_as_uint(sc[ks][r]) & ~127u) | key));
        }
      {
        float M[16];
#pragma unroll
        for (int i = 0; i < 16; ++i) M[i] = __builtin_fmaxf(L[i], __shfl_xor(L[15 - i], 32));
        bitonic16_desc(M);
#pragma unroll
        for (int i = 0; i < 16; ++i) L[i] = M[i];
      }
      if (pp == 0) {
#pragma unroll
        for (int i = 0; i < 16; ++i) L0[i] = L[i];
      } else {
        unsigned char* ib = (unsigned char*)(smem + ROUTE_IDX_OFF) + tid * 32;
#pragma unroll
        for (int i = 0; i < 16; ++i) { ib[i] = (unsigned char)(__float_as_uint(L0[i]) & 127u); ib[16 + i] = (unsigned char)(__float_as_uint(L[i]) & 127u); }
        float F[16];
#pragma unroll
        for (int i = 0; i < 16; ++i) F[i] = -3.0e38f;
#pragma unroll
        for (int i = 0; i < 16; ++i) {
          const float ai = __uint_as_float(__float_as_uint(L0[i]) & ~127u);
#pragma unroll
          for (int j = 0; j < 16; ++j)
            if ((i + 1) * (j + 1) <= 16) {
              const float s = ai + __uint_as_float(__float_as_uint(L[j]) & ~127u);
              ins16(F, __uint_as_float((__float_as_uint(s) & ~255u) | (unsigned)(i * 16 + j)));
            }
        }
        const float mx = __uint_as_float(__float_as_uint(F[0]) & ~255u);
        float e[16], sum = 0.f;
#pragma unroll
        for (int k = 0; k < 16; ++k) { e[k] = __expf(__uint_as_float(__float_as_uint(F[k]) & ~255u) - mx); sum += e[k]; }
        const float inv = 1.f / sum;
        if (lane < 32) {
          const int tok = m0 + wave * 32 + lane;
          int* ip = idx + (size_t)tok * 128 + hh * 16;
          float* gp = gv + (size_t)tok * 128 + hh * 16;
#pragma unroll
          for (int k4 = 0; k4 < 4; ++k4) {
            int4 iv; f32x4 g4;
            int ee[4];
#pragma unroll
            for (int u = 0; u < 4; ++u) {
              const unsigned code = __float_as_uint(F[k4 * 4 + u]) & 255u;
              ee[u] = (int)ib[code >> 4] * 128 + (int)ib[16 + (code & 15u)];
              g4[u] = e[k4 * 4 + u] * inv;
            }
            iv.x = ee[0]; iv.y = ee[1]; iv.z = ee[2]; iv.w = ee[3];
            *(int4*)(ip + k4 * 4) = iv;
            *(f32x4*)(gp + k4 * 4) = g4;
          }
        }
      }
    }
  }
}

DI void phase_keys(const P& p) {
  ushort_t* keysb = (ushort_t*)(p.ws + OFF_KEYS_B);
  for (int i = blockIdx.x * NT + tid_opaque(); i < 16 * 128 * 128 / 4; i += gridDim.x * NT) {
    f32x4 v = *(const f32x4*)(p.keys + (size_t)i * 4);
    uint2 o; o.x = pack2(v[0], v[1]); o.y = pack2(v[2], v[3]);
    *(uint2*)(keysb + (size_t)i * 4) = o;
  }
}

typedef __bf16 bf16x2_t __attribute__((ext_vector_type(2)));
DI float dot2bf(unsigned a, unsigned b, float c) { return __builtin_amdgcn_fdot2_f32_bf16(__builtin_bit_cast(bf16x2_t, a), __builtin_bit_cast(bf16x2_t, b), c, false); }
DI void phase_ln1(const P& p) {
  const float* ada = (const float*)(p.ws + OFF_ADA);
  ushort_t* u2b = (ushort_t*)(p.ws + OFF_U2B);
  const int tq = tid_opaque(); const int lane = tq & 63, wave = tq >> 6;
  for (int row = blockIdx.x * 8 + wave; row < T_; row += gridDim.x * 8) {
    const int b = row / S_;
    float* rp = p.out + (size_t)row * 1024;
    f32x4 v[4];
    float s = 0.f;
#pragma unroll
    for (int i = 0; i < 4; ++i) { v[i] = *(const f32x4*)(rp + i * 256 + lane * 4); s += v[i][0] + v[i][1] + v[i][2] + v[i][3]; }
    const float mu = wave_sum(s) * (1.f / 1024.f);
    float q = 0.f;
#pragma unroll
    for (int i = 0; i < 4; ++i)
#pragma unroll
      for (int j = 0; j < 4; ++j) { float d = v[i][j] - mu; q += d * d; }
    const float rs = rsqrtf(wave_sum(q) * (1.f / 1024.f) + LN_EPS);
#pragma unroll
    for (int i = 0; i < 4; ++i) {
      const int col = i * 256 + lane * 4;
      f32x4 gg = *(const f32x4*)(p.ln1_g + col), bb = *(const f32x4*)(p.ln1_b + col), o;
      f32x4 sc = *(const f32x4*)(ada + b * 6144 + 4 * 1024 + col), sh = *(const f32x4*)(ada + b * 6144 + 3 * 1024 + col);
#pragma unroll
      for (int j = 0; j < 4; ++j) o[j] = (v[i][j] - mu) * rs * gg[j] + bb[j];
      *(f32x4*)(rp + col) = o;
      uint2 w; w.x = pack2(o[0] * (1.f + sc[0]) + sh[0], o[1] * (1.f + sc[1]) + sh[1]); w.y = pack2(o[2] * (1.f + sc[2]) + sh[2], o[3] * (1.f + sc[3]) + sh[3]);
      *(uint2*)(u2b + (size_t)row * 1024 + col) = w;
    }
  }
}
DI void phase_tabconv(const P& p) {
  ushort_t* tu = (ushort_t*)(p.ws + OFF_TABU);
  ushort_t* tv = (ushort_t*)(p.ws + OFF_TABV);
  const int tq = tid_opaque(); const int lane = tq & 63, wave = tq >> 6;
  for (int e = blockIdx.x * 8 + wave; e < 16384; e += gridDim.x * 8) {
#pragma unroll
    for (int i = 0; i < 4; ++i) {
      const int col = i * 256 + lane * 4;
      f32x4 a = *(const f32x4*)(p.pu + (size_t)e * 1024 + col);
      f32x4 c = *(const f32x4*)(p.pv + (size_t)e * 1024 + col);
      uint2 wa; wa.x = pack2(a[0], a[1]); wa.y = pack2(a[2], a[3]);
      uint2 wc; wc.x = pack2(c[0], c[1]); wc.y = pack2(c[2], c[3]);
      *(uint2*)(tu + (size_t)e * 1024 + col) = wa;
      const int slice = i * 4 + (lane >> 4);
      *(uint2*)(tv + ((size_t)slice * 16384 + e) * 64 + (lane & 15) * 4) = wc;
    }
  }
}

DI void upass_run(unsigned long long m, int ereg, float greg, int sbase, const char* __restrict__ tabu, float* __restrict__ crow, const u32x4& xa, const u32x4& xb, int lane) {
  while (m) {
    int sl[4]; int n = 0;
#pragma unroll
    for (int k = 0; k < 4; ++k) {
      if (m) { sl[k] = __builtin_ctzll(m); m &= m - 1; n = k + 1; } else sl[k] = sl[0];
    }
    u32x4 ra[4], rb[4];
#pragma unroll
    for (int k = 0; k < 4; ++k) {
      const unsigned e = (unsigned)__builtin_amdgcn_readlane(ereg, sl[k]);
      const char* row = tabu + (size_t)e * 2048;
      ra[k] = *(const u32x4*)(row + lane * 16); rb[k] = *(const u32x4*)(row + 1024 + lane * 16);
    }
    float d[4];
#pragma unroll
    for (int k = 0; k < 4; ++k) {
      float a0 = 0.f, a1 = 0.f;
#pragma unroll
      for (int w = 0; w < 4; ++w) { a0 = dot2bf(ra[k][w], xa[w], a0); a1 = dot2bf(rb[k][w], xb[w], a1); }
      d[k] = a0 + a1;
    }
#pragma unroll
    for (int o = 32; o > 0; o >>= 1)
#pragma unroll
      for (int k = 0; k < 4; ++k) d[k] += __shfl_xor(d[k], o);
    const int kk = lane & 3;
    const float a = kk == 0 ? d[0] : (kk == 1 ? d[1] : (kk == 2 ? d[2] : d[3]));
    const int ss = kk == 0 ? sl[0] : (kk == 1 ? sl[1] : (kk == 2 ? sl[2] : sl[3]));
    const int gi = __float_as_int(greg);
    const float g = __int_as_float(kk == 0 ? __builtin_amdgcn_readlane(gi, sl[0]) : (kk == 1 ? __builtin_amdgcn_readlane(gi, sl[1]) : (kk == 2 ? __builtin_amdgcn_readlane(gi, sl[2]) : __builtin_amdgcn_readlane(gi, sl[3]))));
    const float cf = g * 0.5f * a * (1.f + erff(a * 0.7071067811865475f));
    if (lane < n) crow[sbase + ss] = cf;
  }
}
DI void phase_upass(const P& p) {
  const int* idx = (const int*)(p.ws + OFF_IDX);
  const float* gv = (const float*)(p.ws + OFF_GV);
  const ushort_t* u2b = (const ushort_t*)(p.ws + OFF_U2B);
  const char* tabu = (const char*)(p.ws + OFF_TABU);
  float* coef = (float*)(p.ws + OFF_COEF);
  const int tq = tid_opaque(); const int lane = tq & 63, wave = tq >> 6;
  const int xg = blockIdx.x & 7, bi = blockIdx.x >> 3, nb = (gridDim.x - xg + 7) >> 3;
#pragma unroll 1
  for (int pass = 0; pass < 2; ++pass) {
    const int part = xg + 8 * pass;
    for (int tok = bi * 8 + wave; tok < T_; tok += nb * 8) {
      const int e0 = idx[(size_t)tok * 128 + lane], e1 = idx[(size_t)tok * 128 + 64 + lane];
      const unsigned long long m0 = __ballot((e0 >> 10) == part), m1 = __ballot((e1 >> 10) == part);
      if ((m0 | m1) == 0ull) continue;
      const float g0 = gv[(size_t)tok * 128 + lane], g1 = gv[(size_t)tok * 128 + 64 + lane];
      const u32x4 xa = *(const u32x4*)(u2b + (size_t)tok * 1024 + lane * 8), xb = *(const u32x4*)(u2b + (size_t)tok * 1024 + 512 + lane * 8);
      float* crow = coef + (size_t)tok * 128;
      upass_run(m0, e0, g0, 0, tabu, crow, xa, xb, lane);
      upass_run(m1, e1, g1, 64, tabu, crow, xa, xb, lane);
    }
  }
}

template <int I> DI int bcast16(int v) { return __builtin_amdgcn_mov_dpp(v, 0x150 + I, 0xf, 0xf, false); }
DI void phase_vpass(const P& p) {
  const int* idx = (const int*)(p.ws + OFF_IDX);
  const float* coef = (const float*)(p.ws + OFF_COEF);
  const char* tabv = (const char*)(p.ws + OFF_TABV);
  float* f = (float*)(p.ws + OFF_F);
  const int tq = tid_opaque(); const int lane = tq & 63, wave = tq >> 6;
  const int g = lane >> 4, cq = lane & 15;
  const int xg = blockIdx.x & 7, bi = blockIdx.x >> 3, nb = (gridDim.x - xg + 7) >> 3;
#pragma unroll 1
  for (int pass = 0; pass < 2; ++pass) {
    const int slice = xg + 8 * pass;
    const char* tb = tabv + (size_t)slice * (16384 * 128) + cq * 8;
    for (int tok = bi * 8 + wave; tok < T_; tok += nb * 8) {
      const int ea = idx[(size_t)tok * 128 + g * 32 + cq], eb = idx[(size_t)tok * 128 + g * 32 + 16 + cq];
      const int ca = __float_as_int(coef[(size_t)tok * 128 + g * 32 + cq]), cb = __float_as_int(coef[(size_t)tok * 128 + g * 32 + 16 + cq]);
      uint2 va[16], vb[16];
      float fa[16], fb[16];
#define VP_STEP(I) { const unsigned e_ = (unsigned)bcast16<I>(ea); va[I] = *(const uint2*)(tb + e_ * 128u); fa[I] = __int_as_float(bcast16<I>(ca)); \
                     const unsigned e2_ = (unsigned)bcast16<I>(eb); vb[I] = *(const uint2*)(tb + e2_ * 128u); fb[I] = __int_as_float(bcast16<I>(cb)); }
      VP_STEP(0) VP_STEP(1) VP_STEP(2) VP_STEP(3) VP_STEP(4) VP_STEP(5) VP_STEP(6) VP_STEP(7)
      VP_STEP(8) VP_STEP(9) VP_STEP(10) VP_STEP(11) VP_STEP(12) VP_STEP(13) VP_STEP(14) VP_STEP(15)
#undef VP_STEP
      float a0 = 0.f, a1 = 0.f, a2 = 0.f, a3 = 0.f;
#pragma unroll
      for (int i = 0; i < 16; ++i) {
        a0 += fa[i] * __uint_as_float(va[i].x << 16); a1 += fa[i] * __uint_as_float(va[i].x & 0xffff0000u);
        a2 += fa[i] * __uint_as_float(va[i].y << 16); a3 += fa[i] * __uint_as_float(va[i].y & 0xffff0000u);
        a0 += fb[i] * __uint_as_float(vb[i].x << 16); a1 += fb[i] * __uint_as_float(vb[i].x & 0xffff0000u);
        a2 += fb[i] * __uint_as_float(vb[i].y << 16); a3 += fb[i] * __uint_as_float(vb[i].y & 0xffff0000u);
      }
      a0 += __shfl_xor(a0, 16); a1 += __shfl_xor(a1, 16); a2 += __shfl_xor(a2, 16); a3 += __shfl_xor(a3, 16);
      a0 += __shfl_xor(a0, 32); a1 += __shfl_xor(a1, 32); a2 += __shfl_xor(a2, 32); a3 += __shfl_xor(a3, 32);
      if (g == 0) { f32x4 o; o[0] = a0; o[1] = a1; o[2] = a2; o[3] = a3; *(f32x4*)(f + (size_t)tok * 1024 + slice * 64 + cq * 4) = o; }
    }
  }
}

DI void phase_ln2(const P& p) {
  const float* ada = (const float*)(p.ws + OFF_ADA);
  const float* f = (const float*)(p.ws + OFF_F);
  const int tq = tid_opaque(); const int lane = tq & 63, wave = tq >> 6;
  for (int tok = blockIdx.x * 8 + wave; tok < T_; tok += gridDim.x * 8) {
    const int b = tok / S_;
    float* rp = p.out + (size_t)tok * 1024;
    f32x4 acc[4];
    float sm = 0.f;
#pragma unroll
    for (int i = 0; i < 4; ++i) {
      const int col = i * 256 + lane * 4;
      f32x4 x1 = *(const f32x4*)(rp + col), ff = *(const f32x4*)(f + (size_t)tok * 1024 + col);
      f32x4 g2 = *(const f32x4*)(ada + b * 6144 + 5 * 1024 + col);
#pragma unroll
      for (int j = 0; j < 4; ++j) { acc[i][j] = DN_ALPHA * x1[j] + (1.f + g2[j]) * ff[j]; sm += acc[i][j]; }
    }
    const float mu = wave_sum(sm) * (1.f / 1024.f);
    float q = 0.f;
#pragma unroll
    for (int i = 0; i < 4; ++i)
#pragma unroll
      for (int j = 0; j < 4; ++j) { float d = acc[i][j] - mu; q += d * d; }
    const float rs = rsqrtf(wave_sum(q) * (1.f / 1024.f) + LN_EPS);
#pragma unroll
    for (int i = 0; i < 4; ++i) {
      const int col = i * 256 + lane * 4;
      f32x4 gg = *(const f32x4*)(p.ln2_g + col), bb = *(const f32x4*)(p.ln2_b + col), o;
#pragma unroll
      for (int j = 0; j < 4; ++j) o[j] = (acc[i][j] - mu) * rs * gg[j] + bb[j];
      *(f32x4*)(rp + col) = o;
    }
  }
}

constexpr int SMEM_BYTES = 143360;
__global__ void __launch_bounds__(NT) fwd_megakernel(P p) {
  __shared__ __attribute__((aligned(16))) char smem[SMEM_BYTES];
  cooperative_groups::grid_group grid = cooperative_groups::this_grid();
  phase_ada(p, smem);
  phase_transposes(p, smem);
  phase_keys(p);
  phase_filter(p, smem);
  grid.sync();
  phase_inproj(p, smem);
  grid.sync();
  for (int item = blockIdx.x; item < 512 + 128; item += gridDim.x) {
    if (item < 512) hyena_item(p, smem, item);
    else attn_item(p, item - 512);
  }
  grid.sync();
  phase_merge(p, smem);
  grid.sync();
  phase_outproj(p, smem);
  grid.sync();
  phase_ln1(p);
  phase_tabconv(p);
  grid.sync();
  phase_route(p, smem);
  grid.sync();
  phase_upass(p);
  grid.sync();
  phase_vpass(p);
  grid.sync();
  phase_ln2(p);
}

extern "C" void kernel_launch(void* const* d_in, const int* in_sizes, int n_in, void* d_out, int out_size, void* d_ws, size_t ws_size,
                              hipStream_t stream) {
  P p{};
  p.x = (const float*)d_in[0]; p.c = (const float*)d_in[1]; p.pos = (const int*)d_in[2];
  p.w_ada = (const float*)d_in[3]; p.b_ada = (const float*)d_in[4]; p.w_in = (const float*)d_in[5];
  p.hy_conv_w = (const float*)d_in[6]; p.hy_conv_b = (const float*)d_in[7];
  p.f1_w = (const float*)d_in[8]; p.f1_b = (const float*)d_in[9]; p.f1_freq = (const float*)d_in[10];
  p.f2_w = (const float*)d_in[11]; p.f2_b = (const float*)d_in[12]; p.f2_freq = (const float*)d_in[13];
  p.f3_w = (const float*)d_in[14]; p.hy_bias = (const float*)d_in[15];
  p.w_bh = (const float*)d_in[16]; p.w_ba = (const float*)d_in[17]; p.w_out = (const float*)d_in[18];
  p.ln1_g = (const float*)d_in[19]; p.ln1_b = (const float*)d_in[20];
  p.wq = (const float*)d_in[21]; p.keys = (const float*)d_in[22]; p.pu = (const float*)d_in[23]; p.pv = (const float*)d_in[24];
  p.ln2_g = (const float*)d_in[25]; p.ln2_b = (const float*)d_in[26];
  p.out = (float*)d_out; p.ws = (char*)d_ws;

  static int grid_blocks = 0;
  if (!grid_blocks) {
    int dev = 0, cus = 0, per_cu = 0;
    hipGetDevice(&dev);
    hipDeviceGetAttribute(&cus, hipDeviceAttributeMultiprocessorCount, dev);
    hipOccupancyMaxActiveBlocksPerMultiprocessor(&per_cu, fwd_megakernel, NT, 0);
    if (per_cu > 1) per_cu = 1;
    grid_blocks = cus * per_cu;
  }
  void* args[] = {&p};
  hipError_t e = hipLaunchCooperativeKernel((void*)fwd_megakernel, dim3(grid_blocks), dim3(NT), args, 0, stream);
  if (e != hipSuccess) fprintf(stderr, "cooperative launch failed: %s (grid %d)\n", hipGetErrorString(e), grid_blocks);
}
```

```cpp
#include <hip/hip_runtime.h>
#include <hip/hip_cooperative_groups.h>
#include <cstdio>
#include <cstdint>

#define DI __device__ __forceinline__
typedef unsigned short ushort_t;
typedef __attribute__((ext_vector_type(8))) short bf16x8;
typedef __attribute__((ext_vector_type(16))) float f32x16;
typedef __attribute__((ext_vector_type(4))) float f32x4;
typedef __attribute__((ext_vector_type(4))) unsigned u32x4;

constexpr int T_ = 16384, S_ = 8192, NB = 2, D_ = 1024;
constexpr int HW_ = 512, HYC = 1536, QKVC = 2304, GATEC = 2048, INW = 5888;
constexpr int NT = 512;
constexpr float DN_ALPHA = 1.189207115002721f;
constexpr float LN_EPS = 1e-5f;

constexpr size_t OFF_ADA   = 0;
constexpr size_t OFF_KEYS_B= 65536;
constexpr size_t OFF_WIN_T = 65536 + 524288;
constexpr size_t OFF_WQ_T  = OFF_WIN_T + (size_t)INW * 1024 * 2;
constexpr size_t OFF_WOUT_T= OFF_WQ_T + (size_t)2048 * 1024 * 2;
constexpr size_t OFF_WBH_T = OFF_WOUT_T + (size_t)1024 * 1024 * 2;
constexpr size_t OFF_WBA_T = OFF_WBH_T + (size_t)1024 * 512 * 2;
constexpr size_t OFF_PH    = OFF_WBA_T + (size_t)1024 * 256 * 2;
constexpr size_t OFF_QKV   = OFF_PH + (size_t)T_ * HYC * 2;
constexpr size_t OFF_GATE  = OFF_QKV + (size_t)T_ * QKVC * 2;
constexpr size_t OFF_YH    = OFF_GATE + (size_t)T_ * GATEC * 2;
constexpr size_t OFF_YA    = OFF_YH + (size_t)T_ * HW_ * 2;
constexpr size_t OFF_END   = OFF_YA + (size_t)T_ * 256 * 2;
constexpr size_t OFF_MERGED= OFF_PH;
constexpr size_t OFF_U2B   = OFF_PH;
constexpr size_t OFF_TABU  = OFF_QKV;
constexpr size_t OFF_TABV  = OFF_QKV + (size_t)32 * 1048576;
constexpr size_t OFF_COEF  = OFF_QKV + (size_t)64 * 1048576;
constexpr size_t OFF_F     = OFF_QKV + (size_t)72 * 1048576;
static_assert(OFF_F + (size_t)64 * 1048576 <= OFF_YH, "peer buffers overflow the qkv+gate region");
constexpr size_t OFF_IDX   = OFF_YH;
constexpr size_t OFF_GV    = OFF_YH + (size_t)T_ * 128 * 4;
constexpr size_t OFF_HSCR  = OFF_END;
static_assert(OFF_HSCR + (size_t)164 * 131072 <= 268435456ull, "ws overflow");
static_assert((size_t)92 * 131072 <= (size_t)INW * 1024 * 2, "w_in^T region too small");

struct P {
  const float *x, *c; const int* pos;
  const float *w_ada, *b_ada, *w_in, *hy_conv_w, *hy_conv_b, *f1_w, *f1_b, *f1_freq, *f2_w, *f2_b, *f2_freq, *f3_w,
      *hy_bias, *w_bh, *w_ba, *w_out, *ln1_g, *ln1_b, *wq, *keys, *pu, *pv, *ln2_g, *ln2_b;
  float* out; char* ws;
};

DI ushort_t f2bf(float x) { unsigned u = __float_as_uint(x); u += 0x7fffu + ((u >> 16) & 1u); return (ushort_t)(u >> 16); }
DI float bf2f(ushort_t h) { return __uint_as_float(((unsigned)h) << 16); }
DI unsigned pack2(float a, float b) { return (unsigned)f2bf(a) | ((unsigned)f2bf(b) << 16); }
DI int tid_opaque() { int t = threadIdx.x; asm volatile("" : "+v"(t)); return t; }
DI float wave_sum(float v) {
#pragma unroll
  for (int o = 32; o > 0; o >>= 1) v += __shfl_xor(v, o);
  return v;
}

struct cf2 { float x, y; };
constexpr int FFT_N = 16384, FFT_SA = 560;

DI constexpr float wcos32(int j) {
  switch (j & 31) {
    case 0: return 1.0f; case 1: return 0.98078528040323043f; case 2: return 0.92387953251128674f; case 3: return 0.83146961230254524f;
    case 4: return 0.70710678118654752f; case 5: return 0.55557023301960218f; case 6: return 0.38268343236508978f; case 7: return 0.19509032201612825f;
    case 8: return 0.0f; case 9: return -0.19509032201612825f; case 10: return -0.38268343236508978f; case 11: return -0.55557023301960218f;
    case 12: return -0.70710678118654752f; case 13: return -0.83146961230254524f; case 14: return -0.92387953251128674f; case 15: return -0.98078528040323043f;
    case 16: return -1.0f; case 17: return -0.98078528040323043f; case 18: return -0.92387953251128674f; case 19: return -0.83146961230254524f;
    case 20: return -0.70710678118654752f; case 21: return -0.55557023301960218f; case 22: return -0.38268343236508978f; case 23: return -0.19509032201612825f;
    case 24: return 0.0f; case 25: return 0.19509032201612825f; case 26: return 0.38268343236508978f; case 27: return 0.55557023301960218f;
    case 28: return 0.70710678118654752f; case 29: return 0.83146961230254524f; case 30: return 0.92387953251128674f; default: return 0.98078528040323043f;
  }
}
DI constexpr float wsin32(int j) { return wcos32(j + 24); }
DI constexpr int brev(int v, int bits) { int r = 0; for (int i = 0; i < bits; ++i) r |= ((v >> i) & 1) << (bits - 1 - i); return r; }

template <int R, int LEN, bool INV, bool ZHI>
DI void r2_stage(float (&re)[R], float (&im)[R]) {
  constexpr int half = LEN / 2;
#pragma unroll
  for (int start = 0; start < R; start += LEN) {
#pragma unroll
    for (int j = 0; j < half; ++j) {
      const int a = start + j, b = a + half;
      const int tj = j * (32 / LEN);
      const float c = wcos32(tj), s = wsin32(tj);
      if (!INV) {
        float dr, di;
        if (ZHI) { dr = re[a]; di = im[a]; }
        else {
          const float ar = re[a], ai = im[a], br = re[b], bi = im[b];
          re[a] = ar + br; im[a] = ai + bi; dr = ar - br; di = ai - bi;
        }
        if (tj == 0) { re[b] = dr; im[b] = di; }
        else if (tj == 8) { re[b] = di; im[b] = -dr; }
        else { re[b] = dr * c + di * s; im[b] = di * c - dr * s; }
      } else {
        const float br = re[b], bi = im[b];
        float pr, pi;
        if (tj == 0) { pr = br; pi = bi; }
        else if (tj == 8) { pr = -bi; pi = br; }
        else { pr = br * c - bi * s; pi = bi * c + br * s; }
        const float ar = re[a], ai = im[a];
        re[a] = ar + pr; im[a] = ai + pi; re[b] = ar - pr; im[b] = ai - pi;
      }
    }
  }
}
template <int R, bool ZHI> DI void dft_fwd(float (&re)[R], float (&im)[R]) {
  if (R == 32) r2_stage<R, (R == 32 ? 32 : 2), false, ZHI>(re, im);
  r2_stage<R, 16, false, (R == 16) && ZHI>(re, im);
  r2_stage<R, 8, false, false>(re, im);
  r2_stage<R, 4, false, false>(re, im);
  r2_stage<R, 2, false, false>(re, im);
}
template <int R> DI void dft_inv(float (&re)[R], float (&im)[R]) {
  r2_stage<R, 2, true, false>(re, im);
  r2_stage<R, 4, true, false>(re, im);
  r2_stage<R, 8, true, false>(re, im);
  r2_stage<R, 16, true, false>(re, im);
  if (R == 32) r2_stage<R, (R == 32 ? 32 : 2), true, false>(re, im);
}

DI void sincos_turn(float frac, float& s, float& c) { sincospif(2.0f * frac, &s, &c); }

template <bool ZHI>
DI void fft_fwdA(float (&re)[32], float (&im)[32], cf2* lds, int m) {
  asm volatile("" : "+v"(m));
  float s1, c1; sincos_turn((float)m * (1.0f / 16384.0f), s1, c1);
  __builtin_amdgcn_sched_barrier(0);
  dft_fwd<32, ZHI>(re, im);
  __builtin_amdgcn_sched_barrier(0);
  float wr = 1.f, wi = 0.f;
#pragma unroll
  for (int k1 = 0; k1 < 32; ++k1) {
    if ((k1 & 3) == 0) __builtin_amdgcn_sched_barrier(0);
    const int r = brev(k1, 5);
    cf2 o; o.x = re[r] * wr - im[r] * wi; o.y = re[r] * wi + im[r] * wr;
    lds[k1 * FFT_SA + m] = o;
    const float nr = wr * c1 + wi * s1, ni = wi * c1 - wr * s1;
    wr = nr; wi = ni;
  }
}
DI void fft_B_read(float (&re)[32], float (&im)[32], const cf2* lds, int tid) {
  const int k1 = tid >> 4, mp = tid & 15;
#pragma unroll
  for (int n2 = 0; n2 < 32; ++n2) { cf2 v = lds[k1 * FFT_SA + n2 * 16 + mp]; re[n2] = v.x; im[n2] = v.y; }
}
DI void fft_fwdB_write(float (&re)[32], float (&im)[32], cf2* lds, int tid) {
  asm volatile("" : "+v"(tid));
  const int k1 = tid >> 4, mp = tid & 15;
  float s1, c1; sincos_turn((float)mp * (1.0f / 512.0f), s1, c1);
  __builtin_amdgcn_sched_barrier(0);
  dft_fwd<32, false>(re, im);
  __builtin_amdgcn_sched_barrier(0);
  float wr = 1.f, wi = 0.f;
#pragma unroll
  for (int k2 = 0; k2 < 32; ++k2) {
    if ((k2 & 3) == 0) __builtin_amdgcn_sched_barrier(0);
    const int r = brev(k2, 5);
    cf2 o; o.x = re[r] * wr - im[r] * wi; o.y = re[r] * wi + im[r] * wr;
    lds[k1 * FFT_SA + k2 * 17 + mp] = o;
    const float nr = wr * c1 + wi * s1, ni = wi * c1 - wr * s1;
    wr = nr; wi = ni;
  }
}
DI void fft_fwdC(float (&re)[32], float (&im)[32], const cf2* lds, int tid) {
  const int k1 = tid >> 5, k2 = tid & 31;
#pragma unroll
  for (int h = 0; h < 2; ++h) {
    float tr[16], ti[16];
#pragma unroll
    for (int mp = 0; mp < 16; ++mp) { cf2 v = lds[(k1 + 16 * h) * FFT_SA + k2 * 17 + mp]; tr[mp] = v.x; ti[mp] = v.y; }
    dft_fwd<16, false>(tr, ti);
#pragma unroll
    for (int i = 0; i < 16; ++i) { re[h * 16 + i] = tr[i]; im[h * 16 + i] = ti[i]; }
  }
}
DI void fft_invC(float (&re)[32], float (&im)[32], cf2* lds, int tid) {
  const int k1 = tid >> 5, k2 = tid & 31;
#pragma unroll
  for (int h = 0; h < 2; ++h) {
    float tr[16], ti[16];
#pragma unroll
    for (int i = 0; i < 16; ++i) { tr[i] = re[h * 16 + i]; ti[i] = im[h * 16 + i]; }
    dft_inv<16>(tr, ti);
#pragma unroll
    for (int mp = 0; mp < 16; ++mp) { cf2 o; o.x = tr[mp]; o.y = ti[mp]; lds[(k1 + 16 * h) * FFT_SA + k2 * 17 + mp] = o; }
  }
}
DI void fft_invB_read(float (&re)[32], float (&im)[32], const cf2* lds, int tid) {
  asm volatile("" : "+v"(tid));
  const int k1 = tid >> 4, mp = tid & 15;
  float s1, c1; sincos_turn((float)mp * (1.0f / 512.0f), s1, c1);
  float wr = 1.f, wi = 0.f;
  __builtin_amdgcn_sched_barrier(0);
#pragma unroll
  for (int k2 = 0; k2 < 32; ++k2) {
    if ((k2 & 3) == 0) __builtin_amdgcn_sched_barrier(0);
    const int r = brev(k2, 5);
    cf2 v = lds[k1 * FFT_SA + k2 * 17 + mp];
    re[r] = v.x * wr - v.y * wi; im[r] = v.x * wi + v.y * wr;
    const float nr = wr * c1 - wi * s1, ni = wi * c1 + wr * s1;
    wr = nr; wi = ni;
  }
}
DI void fft_invB_write(float (&re)[32], float (&im)[32], cf2* lds, int tid) {
  const int k1 = tid >> 4, mp = tid & 15;
  dft_inv<32>(re, im);
#pragma unroll
  for (int n2 = 0; n2 < 32; ++n2) { cf2 o; o.x = re[n2]; o.y = im[n2]; lds[k1 * FFT_SA + n2 * 16 + mp] = o; }
}
DI void fft_invA(float (&re)[32], float (&im)[32], const cf2* lds, int m) {
  asm volatile("" : "+v"(m));
  float s1, c1; sincos_turn((float)m * (1.0f / 16384.0f), s1, c1);
  float wr = 1.f, wi = 0.f;
  __builtin_amdgcn_sched_barrier(0);
#pragma unroll
  for (int k1 = 0; k1 < 32; ++k1) {
    if ((k1 & 3) == 0) __builtin_amdgcn_sched_barrier(0);
    const int r = brev(k1, 5);
    cf2 v = lds[k1 * FFT_SA + m];
    re[r] = v.x * wr - v.y * wi; im[r] = v.x * wi + v.y * wr;
    const float nr = wr * c1 - wi * s1, ni = wi * c1 + wr * s1;
    wr = nr; wi = ni;
  }
  __builtin_amdgcn_sched_barrier(0);
  dft_inv<32>(re, im);
}

DI void phase_ada(const P& p, char* smem) {
  float (*red)[8][64] = (float (*)[8][64])smem;
  const int tid = tid_opaque(), cl = tid & 63, kq = tid >> 6;
  for (int item = blockIdx.x; item < 96; item += gridDim.x) {
    const int col = item * 64 + cl;
    float a0 = 0.f, a1 = 0.f;
    for (int k = kq * 128; k < kq * 128 + 128; ++k) {
      float w = p.w_ada[(size_t)k * 6144 + col];
      float c0 = p.c[k], c1 = p.c[1024 + k];
      a0 += (c0 / (1.f + __expf(-c0))) * w;
      a1 += (c1 / (1.f + __expf(-c1))) * w;
    }
    __syncthreads();
    red[0][kq][cl] = a0; red[1][kq][cl] = a1;
    __syncthreads();
    if (tid < 128) {
      int b = tid >> 6;
      float s = p.b_ada[col];
#pragma unroll
      for (int q = 0; q < 8; ++q) s += red[b][q][cl];
      ((float*)(p.ws + OFF_ADA))[b * 6144 + col] = s;
    }
  }
}

DI void transpose_tile(const float* __restrict__ W, ushort_t* __restrict__ Wt, int K, int N, int item, char* smem) {
  float (*tile)[65] = (float (*)[65])smem;
  const int ntn = N / 64;
  const int n0 = (item % ntn) * 64, k0 = (item / ntn) * 32;
  const int tid = tid_opaque();
  __syncthreads();
  {
    const int tx = tid & 63, ty = tid >> 6;
#pragma unroll
    for (int i = 0; i < 4; ++i) tile[ty + 8 * i][tx] = W[(size_t)(k0 + ty + 8 * i) * N + n0 + tx];
  }
  __syncthreads();
  {
    const int kk = tid & 31, nn0 = tid >> 5;
#pragma unroll
    for (int i = 0; i < 4; ++i) Wt[(size_t)(n0 + nn0 + 16 * i) * K + k0 + kk] = f2bf(tile[kk][nn0 + 16 * i]);
  }
}
DI void phase_transposes(const P& p, char* smem) {
  constexpr int I0 = (INW / 64) * 32, I1 = I0 + 32 * 32, I2 = I1 + 16 * 32, I3 = I2 + 16 * 16, I4 = I3 + 16 * 8;
  for (int item = blockIdx.x; item < I4; item += gridDim.x) {
    if (item < I0) transpose_tile(p.w_in, (ushort_t*)(p.ws + OFF_WIN_T), 1024, INW, item, smem);
    else if (item < I1) transpose_tile(p.wq, (ushort_t*)(p.ws + OFF_WQ_T), 1024, 2048, item - I0, smem);
    else if (item < I2) transpose_tile(p.w_out, (ushort_t*)(p.ws + OFF_WOUT_T), 1024, 1024, item - I1, smem);
    else if (item < I3) transpose_tile(p.w_bh, (ushort_t*)(p.ws + OFF_WBH_T), 512, 1024, item - I2, smem);
    else transpose_tile(p.w_ba, (ushort_t*)(p.ws + OFF_WBA_T), 256, 1024, item - I3, smem);
  }
}

DI void phase_filter(const P& p, char* smem) {
  float (*zf)[33] = (float (*)[33])smem;
  float (*h1)[64] = (float (*)[64])(smem + 4352);
  float (*h2T)[32] = (float (*)[32])(smem + 4352 + 8192);
  const int tid = tid_opaque();
  for (int item = blockIdx.x; item < 256; item += gridDim.x) {
  const int t0 = item * 32;
  __syncthreads();
  for (int idx = tid; idx < 32 * 33; idx += NT) {
    int tt = idx / 33, e = idx % 33, t = t0 + tt;
    float tl = (float)t * (1.0f / 8191.0f);
    float w = 6.283185307179586f * (float)t / 8192.0f;
    float val;
    if (e == 0) val = tl;
    else {
      int i = (e - 1) & 15;
      float f = 1e-4f + (float)i * ((15.0f - 1e-4f) / 15.0f);
      val = (e <= 16) ? cosf(f * w) : -sinf(f * w);
    }
    zf[tt][e] = val;
  }
  __syncthreads();
  for (int idx = tid; idx < 32 * 64; idx += NT) {
    int tt = idx >> 6, j = idx & 63;
    float a = p.f1_b[j];
    for (int e = 0; e < 33; ++e) a += zf[tt][e] * p.f1_w[e * 64 + j];
    h1[tt][j] = sinf(p.f1_freq[j] * a);
  }
  __syncthreads();
  for (int idx = tid; idx < 32 * 64; idx += NT) {
    int tt = idx >> 6, j = idx & 63;
    float a = p.f2_b[j];
    for (int e = 0; e < 64; ++e) a += h1[tt][e] * p.f2_w[e * 64 + j];
    h2T[j][tt] = sinf(p.f2_freq[j] * a);
  }
  __syncthreads();
  float* filt = p.out;
  const float min_decay = -3.0701134573253945f, max_decay = -15.350567286626973f;
  for (int col = tid; col < 2048; col += NT) {
    float acc[32];
#pragma unroll
    for (int i = 0; i < 32; ++i) acc[i] = 0.f;
    for (int j = 0; j < 64; ++j) {
      float w = p.f3_w[j * 2048 + col];
#pragma unroll
      for (int q = 0; q < 8; ++q) {
        f32x4 h = *(const f32x4*)&h2T[j][q * 4];
        acc[q * 4 + 0] += h[0] * w; acc[q * 4 + 1] += h[1] * w; acc[q * 4 + 2] += h[2] * w; acc[q * 4 + 3] += h[3] * w;
      }
    }
    int c = col & 511;
    float delta = fabsf(min_decay + (float)c * ((max_decay - min_decay) / 511.0f));
    float* dst = filt + (size_t)col * 8192 + t0;
#pragma unroll
    for (int q = 0; q < 8; ++q) {
      f32x4 o;
#pragma unroll
      for (int r = 0; r < 4; ++r) {
        float tl = (float)(t0 + q * 4 + r) * (1.0f / 8191.0f);
        o[r] = acc[q * 4 + r] * __expf(-tl * delta);
      }
      *(f32x4*)(dst + q * 4) = o;
    }
  }
  }
}

constexpr int BM = 256, BN = 128, BK = 64;
constexpr int LDS_A = BM * BK * 2, LDS_B = BN * BK * 2, LDS_STAGE = LDS_A + LDS_B;
constexpr int GEMM_LDS = 2 * LDS_STAGE + 8192;

DI int swz(int row, int ch) { return row * 128 + ((ch ^ (row & 7)) << 4); }

struct ALoadBf16 {
  const ushort_t* A; int lda;
  struct Raw { u32x4 v; };
  DI Raw fetch(int row, int k) const { Raw r; r.v = *(const u32x4*)(A + (size_t)row * lda + k); return r; }
  DI u32x4 cvt(const Raw& r, int k) const { return r.v; }
};
struct ALoadF32Mod {
  const float* A; const float* mod;
  struct Raw { f32x4 a, b; };
  DI Raw fetch(int row, int k) const { Raw r; const float* s = A + (size_t)row * 1024 + k; r.a = *(const f32x4*)s; r.b = *(const f32x4*)(s + 4); return r; }
  DI u32x4 cvt(const Raw& r, int k) const {
    f32x4 s0 = *(const f32x4*)(mod + k), s1 = *(const f32x4*)(mod + k + 4);
    f32x4 h0 = *(const f32x4*)(mod + 1024 + k), h1 = *(const f32x4*)(mod + 1024 + k + 4);
    u32x4 o;
    o[0] = pack2(r.a[0] * s0[0] + h0[0], r.a[1] * s0[1] + h0[1]);
    o[1] = pack2(r.a[2] * s0[2] + h0[2], r.a[3] * s0[3] + h0[3]);
    o[2] = pack2(r.b[0] * s1[0] + h1[0], r.b[1] * s1[1] + h1[1]);
    o[3] = pack2(r.b[2] * s1[2] + h1[2], r.b[3] * s1[3] + h1[3]);
    return o;
  }
};

template <class AL, bool SWAP = false>
DI void gemm_mainloop(f32x16 (&acc)[2][2], const AL& al, int m0, const ushort_t* __restrict__ Bt, int ldb, int n0, int K, char* smem) {
  const int tid = tid_opaque(), lane = tid & 63, wave = tid >> 6;
  const int wm = wave >> 1, wn = wave & 1;
  const int lr = tid >> 3, lc = tid & 7;
  typename AL::Raw ra[4]; u32x4 rb[2];
  const int nk = K / BK;
#pragma unroll
  for (int i = 0; i < 4; ++i) ra[i] = al.fetch(m0 + lr + 64 * i, lc * 8);
#pragma unroll
  for (int i = 0; i < 2; ++i) rb[i] = *(const u32x4*)(Bt + (size_t)(n0 + lr + 64 * i) * ldb + lc * 8);
  __syncthreads();
#pragma unroll
  for (int i = 0; i < 4; ++i) *(u32x4*)(smem + swz(lr + 64 * i, lc)) = al.cvt(ra[i], lc * 8);
#pragma unroll
  for (int i = 0; i < 2; ++i) *(u32x4*)(smem + LDS_A + swz(lr + 64 * i, lc)) = rb[i];
  __syncthreads();
  for (int kt = 0; kt < nk; ++kt) {
    char* cur = smem + (kt & 1) * LDS_STAGE;
    char* nxt = smem + ((kt + 1) & 1) * LDS_STAGE;
    const bool more = (kt + 1 < nk);
    const int kn = (kt + 1) * BK + lc * 8;
    if (more) {
#pragma unroll
      for (int i = 0; i < 4; ++i) ra[i] = al.fetch(m0 + lr + 64 * i, kn);
#pragma unroll
      for (int i = 0; i < 2; ++i) rb[i] = *(const u32x4*)(Bt + (size_t)(n0 + lr + 64 * i) * ldb + kn);
    }
#pragma unroll
    for (int s = 0; s < 4; ++s) {
      const int ch = 2 * s + (lane >> 5);
      bf16x8 af[2], bfr[2];
#pragma unroll
      for (int mi = 0; mi < 2; ++mi) af[mi] = *(const bf16x8*)(cur + swz(wm * 64 + mi * 32 + (lane & 31), ch));
#pragma unroll
      for (int ni = 0; ni < 2; ++ni) bfr[ni] = *(const bf16x8*)(cur + LDS_A + swz(wn * 64 + ni * 32 + (lane & 31), ch));
#pragma unroll
      for (int mi = 0; mi < 2; ++mi)
#pragma unroll
        for (int ni = 0; ni < 2; ++ni)
          acc[mi][ni] = SWAP ? __builtin_amdgcn_mfma_f32_32x32x16_bf16(bfr[ni], af[mi], acc[mi][ni], 0, 0, 0)
                             : __builtin_amdgcn_mfma_f32_32x32x16_bf16(af[mi], bfr[ni], acc[mi][ni], 0, 0, 0);
    }
    if (more) {
#pragma unroll
      for (int i = 0; i < 4; ++i) *(u32x4*)(nxt + swz(lr + 64 * i, lc)) = al.cvt(ra[i], kn);
#pragma unroll
      for (int i = 0; i < 2; ++i) *(u32x4*)(nxt + LDS_A + swz(lr + 64 * i, lc)) = rb[i];
    }
    __syncthreads();
  }
}

constexpr int AT_ROW = 576;
constexpr int LDS_AT = 64 * AT_ROW;
constexpr int LDS_STAGE_T = LDS_AT + LDS_B;
typedef __attribute__((ext_vector_type(4))) short s16x4;
DI void gemm_mainloop_AT(f32x16 (&acc)[2][2], const ushort_t* __restrict__ At, size_t ldt, const ushort_t* __restrict__ Bt, int ldb, int n0, int K, char* smem) {
  const int tid = tid_opaque(), lane = tid & 63, wave = tid >> 6;
  const int wm = wave >> 1, wn = wave & 1;
  const int lr = tid >> 3, lc = tid & 7;
  u32x4 ra[4], rb[2];
  const int nk = K / BK;
#pragma unroll
  for (int i = 0; i < 4; ++i) { const int q = tid + 512 * i; ra[i] = *(const u32x4*)(At + (size_t)(q >> 5) * ldt + (q & 31) * 8); }
#pragma unroll
  for (int i = 0; i < 2; ++i) rb[i] = *(const u32x4*)(Bt + (size_t)(n0 + lr + 64 * i) * ldb + lc * 8);
  __syncthreads();
#pragma unroll
  for (int i = 0; i < 4; ++i) { const int q = tid + 512 * i; *(u32x4*)(smem + (q >> 5) * AT_ROW + (q & 31) * 16) = ra[i]; }
#pragma unroll
  for (int i = 0; i < 2; ++i) *(u32x4*)(smem + LDS_AT + swz(lr + 64 * i, lc)) = rb[i];
  __syncthreads();
  const int hh = lane >> 5, gg = (lane >> 4) & 1, qq = (lane & 15) >> 2, pp = lane & 3;
  for (int kt = 0; kt < nk; ++kt) {
    char* cur = smem + (kt & 1) * LDS_STAGE_T;
    char* nxt = smem + ((kt + 1) & 1) * LDS_STAGE_T;
    const bool more = (kt + 1 < nk);
    if (more) {
#pragma unroll
      for (int i = 0; i < 4; ++i) { const int q = tid + 512 * i; ra[i] = *(const u32x4*)(At + (size_t)((kt + 1) * BK + (q >> 5)) * ldt + (q & 31) * 8); }
#pragma unroll
      for (int i = 0; i < 2; ++i) rb[i] = *(const u32x4*)(Bt + (size_t)(n0 + lr + 64 * i) * ldb + (kt + 1) * BK + lc * 8);
    }
#pragma unroll
    for (int s = 0; s < 4; ++s) {
      const int ch = 2 * s + hh;
      bf16x8 af[2], bfr[2];
#pragma unroll
      for (int mi = 0; mi < 2; ++mi) {
        const char* a0 = cur + (16 * s + 8 * hh + qq) * AT_ROW + (wm * 64 + mi * 32 + 16 * gg + 4 * pp) * 2;
        s16x4 lo = __builtin_amdgcn_ds_read_tr16_b64_v4i16((__attribute__((address_space(3))) s16x4*)(a0));
        s16x4 hi = __builtin_amdgcn_ds_read_tr16_b64_v4i16((__attribute__((address_space(3))) s16x4*)(a0 + 4 * AT_ROW));
        af[mi] = __builtin_shufflevector(lo, hi, 0, 1, 2, 3, 4, 5, 6, 7);
      }
#pragma unroll
      for (int ni = 0; ni < 2; ++ni) bfr[ni] = *(const bf16x8*)(cur + LDS_AT + swz(wn * 64 + ni * 32 + (lane & 31), ch));
#pragma unroll
      for (int mi = 0; mi < 2; ++mi)
#pragma unroll
        for (int ni = 0; ni < 2; ++ni) acc[mi][ni] = __builtin_amdgcn_mfma_f32_32x32x16_bf16(af[mi], bfr[ni], acc[mi][ni], 0, 0, 0);
    }
    if (more) {
#pragma unroll
      for (int i = 0; i < 4; ++i) { const int q = tid + 512 * i; *(u32x4*)(nxt + (q >> 5) * AT_ROW + (q & 31) * 16) = ra[i]; }
#pragma unroll
      for (int i = 0; i < 2; ++i) *(u32x4*)(nxt + LDS_AT + swz(lr + 64 * i, lc)) = rb[i];
    }
    __syncthreads();
  }
}
DI void acc_zero(f32x16 (&acc)[2][2]) {
#pragma unroll
  for (int a = 0; a < 2; ++a)
#pragma unroll
    for (int b = 0; b < 2; ++b)
#pragma unroll
      for (int r = 0; r < 16; ++r) acc[a][b][r] = 0.f;
}
#define ACC_ROW(mi, r) (wm * 64 + (mi) * 32 + ((r) & 3) + 8 * ((r) >> 2) + 4 * (lane >> 5))
#define ACC_COL(ni) (wn * 64 + (ni) * 32 + (lane & 31))

DI void stage_mod(float* mod, const float* ada, int b, int sc_chunk, int sh_chunk) {
  for (int i = tid_opaque(); i < 1024; i += NT) {
    mod[i] = 1.f + ada[b * 6144 + sc_chunk * 1024 + i];
    mod[1024 + i] = ada[b * 6144 + sh_chunk * 1024 + i];
  }
}

DI void phase_inproj(const P& p, char* smem) {
  const float* ada = (const float*)(p.ws + OFF_ADA);
  float* mod = (float*)(smem + 2 * LDS_STAGE);
  const ushort_t* wt = (const ushort_t*)(p.ws + OFF_WIN_T);
  ushort_t* ph = (ushort_t*)(p.ws + OFF_PH);
  ushort_t* qkv = (ushort_t*)(p.ws + OFF_QKV);
  ushort_t* gate = (ushort_t*)(p.ws + OFF_GATE);
  const int tid = tid_opaque(), lane = tid & 63, wave = tid >> 6, wm = wave >> 1, wn = wave & 1;
  constexpr int NTN = INW / BN;
  constexpr int NTM = T_ / BM;
  for (int tile = blockIdx.x; tile < NTM * NTN; tile += gridDim.x) {
    const int tm = tile / NTN, tn = tile % NTN;
    const int m0 = tm * BM, n0 = tn * BN, b = m0 / S_;
    __syncthreads();
    stage_mod(mod, ada, b, 1, 0);
    __syncthreads();
    f32x16 acc[2][2]; acc_zero(acc);
    ALoadF32Mod al{p.x, mod};
    if (n0 < HYC) {
      gemm_mainloop<ALoadF32Mod, true>(acc, al, m0, wt, 1024, n0, 1024, smem);
#pragma unroll
      for (int mi = 0; mi < 2; ++mi) {
        const int t = (m0 & (S_ - 1)) + wm * 64 + mi * 32 + (lane & 31);
#pragma unroll
        for (int ni = 0; ni < 2; ++ni)
#pragma unroll
          for (int r = 0; r < 16; ++r) {
            const int ch = n0 + wn * 64 + ni * 32 + (r & 3) + 8 * (r >> 2) + 4 * (lane >> 5);
            ph[((size_t)(b * HYC + ch)) * S_ + t] = f2bf(acc[mi][ni][r]);
          }
      }
      continue;
    }
    gemm_mainloop(acc, al, m0, wt, 1024, n0, 1024, smem);
#pragma unroll
    for (int ni = 0; ni < 2; ++ni) {
      const int col = n0 + ACC_COL(ni);
#pragma unroll
      for (int mi = 0; mi < 2; ++mi) {
        if (col < HYC + QKVC) {
          const int cq = col - HYC;
          const bool rot = (cq < 1536) && ((cq & 63) < 16);
          const float qs = (cq < 768) ? 0.125f : 1.0f;
          const float inv = expf(-13.122363377404328f * (float)(cq & 7) * 0.125f);
#pragma unroll
          for (int r = 0; r < 16; ++r) {
            const int row = m0 + ACC_ROW(mi, r);
            float v = acc[mi][ni][r];
            float o = __shfl_xor(v, 8);
            if (rot) {
              float ang = (float)p.pos[row] * inv;
              float sn, cs; sincosf(ang, &sn, &cs);
              v = ((cq & 15) < 8) ? (v * cs - o * sn) : (v * cs + o * sn);
            }
            qkv[(size_t)row * QKVC + cq] = f2bf(v * qs);
          }
        } else {
          const int cg = col - HYC - QKVC;
#pragma unroll
          for (int r = 0; r < 16; ++r) {
            float v = acc[mi][ni][r];
            gate[(size_t)(m0 + ACC_ROW(mi, r)) * GATEC + cg] = f2bf(1.f / (1.f + __expf(-v)));
          }
        }
      }
    }
  }
}

DI float sconv_t(const ushort_t* row, int t, float w0, float w1, float w2, float cb) {
  float v = cb + w1 * bf2f(row[t]);
  if (t > 0) v += w0 * bf2f(row[t - 1]);
  if (t < S_ - 1) v += w2 * bf2f(row[t + 1]);
  return v;
}
DI void fft_C_mul_invC(cf2* lds, const cf2* __restrict__ kq, int tid) {
  asm volatile("" : "+v"(tid));
  const int k1 = tid >> 5, k2 = tid & 31;
  kq += tid;
#pragma unroll
  for (int h = 0; h < 2; ++h) {
    float tr[16], ti[16];
    cf2 kv[16];
#pragma unroll
    for (int i = 0; i < 16; ++i) kv[i] = kq[(h * 16 + i) * 512];
    cf2* blk = lds + (k1 + 16 * h) * FFT_SA + k2 * 17;
#pragma unroll
    for (int mp = 0; mp < 16; ++mp) { cf2 v = blk[mp]; tr[mp] = v.x; ti[mp] = v.y; }
    dft_fwd<16, false>(tr, ti);
#pragma unroll
    for (int i = 0; i < 16; ++i) { const float a = tr[i], b = ti[i]; tr[i] = a * kv[i].x - b * kv[i].y; ti[i] = a * kv[i].y + b * kv[i].x; }
    dft_inv<16>(tr, ti);
#pragma unroll
    for (int mp = 0; mp < 16; ++mp) { cf2 o; o.x = tr[mp]; o.y = ti[mp]; blk[mp] = o; }
  }
}
DI void hyena_item(const P& p, char* smem, int c) {
  cf2* lds = (cf2*)smem;
  const ushort_t* pht = (const ushort_t*)(p.ws + OFF_PH);
  ushort_t* yht = (ushort_t*)(p.ws + OFF_YH);
  cf2* kq = (cf2*)(p.ws + (blockIdx.x < 92 ? OFF_WIN_T + (size_t)blockIdx.x * 131072 : OFF_HSCR + (size_t)(blockIdx.x - 92) * 131072));
  const float* filt = p.out;
  const int tid0 = tid_opaque();
  float zr[32], zi[32];
  __syncthreads();
#pragma unroll 1
  for (int o = 0; o < 2; ++o) {
    int tid = tid0; asm volatile("" : "+v"(tid));
    {
      float kr[32], ki[32];
      const float* fw = filt + (size_t)(0 * 1024 + o * 512 + c) * S_;
      const float* bw = filt + (size_t)(1 * 1024 + o * 512 + c) * S_;
      const float bias = p.hy_bias[o * 512 + c];
#pragma unroll
      for (int n1 = 0; n1 < 16; ++n1) { kr[n1] = fw[n1 * 512 + tid] * (1.0f / 16384.0f); ki[n1] = 0.f; }
      if (tid == 0) kr[0] += bias * (1.0f / 16384.0f);
#pragma unroll
      for (int n1 = 16; n1 < 32; ++n1) {
        const int n = n1 * 512 + tid;
        kr[n1] = (n == S_) ? 0.f : bw[2 * S_ - n] * (1.0f / 16384.0f); ki[n1] = 0.f;
      }
      fft_fwdA<false>(kr, ki, lds, tid); __syncthreads();
      fft_B_read(kr, ki, lds, tid); __syncthreads();
      fft_fwdB_write(kr, ki, lds, tid); __syncthreads();
      fft_fwdC(kr, ki, lds, tid);
      int ts = tid; asm volatile("" : "+v"(ts));
      cf2* kqt = kq + ts;
#pragma unroll
      for (int r = 0; r < 32; ++r) { cf2 v; v.x = kr[r]; v.y = ki[r]; kqt[r * 512] = v; }
      __syncthreads();
    }
    asm volatile("" : "+v"(tid));
    if (o == 0) {
      const float w0 = p.hy_conv_w[c], w1 = p.hy_conv_w[HYC + c], w2 = p.hy_conv_w[2 * HYC + c], cb = p.hy_conv_b[c];
      const ushort_t* r0 = pht + (size_t)(0 * HYC + c) * S_;
      const ushort_t* r1 = pht + (size_t)(1 * HYC + c) * S_;
#pragma unroll
      for (int n1 = 0; n1 < 16; ++n1) {
        const int t = n1 * 512 + tid;
        zr[n1] = sconv_t(r0, t, w0, w1, w2, cb); zi[n1] = sconv_t(r1, t, w0, w1, w2, cb);
        if (n1 & 1) asm volatile("" ::: "memory");
      }
    }
#pragma unroll
    for (int n1 = 16; n1 < 32; ++n1) { zr[n1] = 0.f; zi[n1] = 0.f; }
    fft_fwdA<true>(zr, zi, lds, tid); __syncthreads();
    fft_B_read(zr, zi, lds, tid); __syncthreads();
    fft_fwdB_write(zr, zi, lds, tid); __syncthreads();
    fft_C_mul_invC(lds, kq, tid); __syncthreads();
    fft_invB_read(zr, zi, lds, tid); __syncthreads();
    fft_invB_write(zr, zi, lds, tid); __syncthreads();
    fft_invA(zr, zi, lds, tid);
    int tg = tid; asm volatile("" : "+v"(tg));
    const int gch = (o + 1) * 512 + c;
    const float w0 = p.hy_conv_w[gch], w1 = p.hy_conv_w[HYC + gch], w2 = p.hy_conv_w[2 * HYC + gch], cb = p.hy_conv_b[gch];
    const ushort_t* g0 = pht + (size_t)(0 * HYC + gch) * S_;
    const ushort_t* g1 = pht + (size_t)(1 * HYC + gch) * S_;
#pragma unroll
    for (int n1 = 0; n1 < 16; ++n1) {
      const int t = n1 * 512 + tg;
      zr[n1] *= sconv_t(g0, t, w0, w1, w2, cb);
      zi[n1] *= sconv_t(g1, t, w0, w1, w2, cb);
      if (n1 & 1) asm volatile("" ::: "memory");
    }
    if (o == 1) {
#pragma unroll
      for (int n1 = 0; n1 < 16; ++n1) {
        const int t = n1 * 512 + tg;
        yht[(size_t)(0 * HW_ + c) * S_ + t] = f2bf(zr[n1]);
        yht[(size_t)(1 * HW_ + c) * S_ + t] = f2bf(zi[n1]);
      }
    }
  }
}

DI void attn_item(const P& p, int item) {
  const ushort_t* qkv = (const ushort_t*)(p.ws + OFF_QKV);
  ushort_t* ya = (ushort_t*)(p.ws + OFF_YA);
  {
    int tx = threadIdx.x;
    asm volatile("" : "+v"(tx));
    const int hs = tx >> 7;
    const int tok = item * 128 + (tx & 127);
    const int b = tok / S_, t = tok % S_;
    float acc[64];
#pragma unroll
    for (int e = 0; e < 64; ++e) acc[e] = 0.f;
    float m = -1e30f, l = 0.f;
    for (int g = 0; g < 3; ++g) {
      const int dil = (g == 0) ? 1 : (g == 1 ? 4 : 16);
      const int head = g * 4 + hs;
      float q[64];
      {
        const ushort_t* qp = qkv + (size_t)tok * QKVC + head * 64;
#pragma unroll
        for (int e8 = 0; e8 < 8; ++e8) {
          u32x4 v = *(const u32x4*)(qp + e8 * 8);
#pragma unroll
          for (int w = 0; w < 4; ++w) { q[e8 * 8 + 2 * w] = __uint_as_float(v[w] << 16); q[e8 * 8 + 2 * w + 1] = __uint_as_float(v[w] & 0xffff0000u); }
        }
      }
      for (int j = -64; j <= 64; ++j) {
        const int tk = t + dil * j;
        if (tk < 0 || tk >= S_) continue;
        const ushort_t* kp = qkv + (size_t)(b * S_ + tk) * QKVC + 768 + head * 64;
        float s = 0.f;
#pragma unroll
        for (int e8 = 0; e8 < 8; ++e8) {
          u32x4 v = *(const u32x4*)(kp + e8 * 8);
#pragma unroll
          for (int w = 0; w < 4; ++w) { s += q[e8 * 8 + 2 * w] * __uint_as_float(v[w] << 16); s += q[e8 * 8 + 2 * w + 1] * __uint_as_float(v[w] & 0xffff0000u); }
        }
        const float mn = fmaxf(m, s);
        const float corr = __expf(m - mn), pe = __expf(s - mn);
        l = l * corr + pe; m = mn;
        const ushort_t* vp = kp + 768;
#pragma unroll
        for (int e8 = 0; e8 < 8; ++e8) {
          u32x4 v = *(const u32x4*)(vp + e8 * 8);
#pragma unroll
          for (int w = 0; w < 4; ++w) {
            acc[e8 * 8 + 2 * w] = acc[e8 * 8 + 2 * w] * corr + pe * __uint_as_float(v[w] << 16);
            acc[e8 * 8 + 2 * w + 1] = acc[e8 * 8 + 2 * w + 1] * corr + pe * __uint_as_float(v[w] & 0xffff0000u);
          }
        }
      }
    }
    const float il = 1.f / l;
    ushort_t* op = ya + (size_t)tok * 256 + hs * 64;
#pragma unroll
    for (int e8 = 0; e8 < 8; ++e8) {
      u32x4 o;
#pragma unroll
      for (int w = 0; w < 4; ++w) o[w] = pack2(acc[e8 * 8 + 2 * w] * il, acc[e8 * 8 + 2 * w + 1] * il);
      *(u32x4*)(op + e8 * 8) = o;
    }
  }
}

DI void phase_merge(const P& p, char* smem) {
  const ushort_t* yh = (const ushort_t*)(p.ws + OFF_YH);
  const ushort_t* ya = (const ushort_t*)(p.ws + OFF_YA);
  const ushort_t* gate = (const ushort_t*)(p.ws + OFF_GATE);
  ushort_t* merged = (ushort_t*)(p.ws + OFF_MERGED);
  const int tid = tid_opaque(), lane = tid & 63, wave = tid >> 6, wm = wave >> 1, wn = wave & 1;
  constexpr int NTN = 1024 / BN, NTM = T_ / BM;
  for (int tile = blockIdx.x; tile < NTM * NTN; tile += gridDim.x) {
    const int m0 = (tile / NTN) * BM, n0 = (tile % NTN) * BN;
    f32x16 a1[2][2], a2[2][2]; acc_zero(a1); acc_zero(a2);
    gemm_mainloop_AT(a1, yh + (size_t)((m0 / S_) * HW_) * S_ + (m0 & (S_ - 1)), (size_t)S_, (const ushort_t*)(p.ws + OFF_WBH_T), 512, n0, 512, smem);
    ALoadBf16 l2{ya, 256};
    gemm_mainloop(a2, l2, m0, (const ushort_t*)(p.ws + OFF_WBA_T), 256, n0, 256, smem);
#pragma unroll
    for (int mi = 0; mi < 2; ++mi)
#pragma unroll
      for (int ni = 0; ni < 2; ++ni)
#pragma unroll
        for (int r = 0; r < 16; ++r) {
          const int row = m0 + ACC_ROW(mi, r), col = n0 + ACC_COL(ni);
          float gh = bf2f(gate[(size_t)row * GATEC + col]), ga = bf2f(gate[(size_t)row * GATEC + 1024 + col]);
          merged[(size_t)row * 1024 + col] = f2bf(gh * a1[mi][ni][r] + ga * a2[mi][ni][r]);
        }
  }
}

DI void phase_outproj(const P& p, char* smem) {
  const float* ada = (const float*)(p.ws + OFF_ADA);
  const ushort_t* merged = (const ushort_t*)(p.ws + OFF_MERGED);
  const int tid = tid_opaque(), lane = tid & 63, wave = tid >> 6, wm = wave >> 1, wn = wave & 1;
  constexpr int NTN = 1024 / BN, NTM = T_ / BM;
  for (int tile = blockIdx.x; tile < NTM * NTN; tile += gridDim.x) {
    const int m0 = (tile / NTN) * BM, n0 = (tile % NTN) * BN, b = m0 / S_;
    f32x16 acc[2][2]; acc_zero(acc);
    ALoadBf16 l1{merged, 1024};
    gemm_mainloop(acc, l1, m0, (const ushort_t*)(p.ws + OFF_WOUT_T), 1024, n0, 1024, smem);
#pragma unroll
    for (int ni = 0; ni < 2; ++ni) {
      const int col = n0 + ACC_COL(ni);
      const float g1 = 1.f + ada[b * 6144 + 2 * 1024 + col];
#pragma unroll
      for (int mi = 0; mi < 2; ++mi)
#pragma unroll
        for (int r = 0; r < 16; ++r) {
          const size_t o = (size_t)(m0 + ACC_ROW(mi, r)) * 1024 + col;
          p.out[o] = DN_ALPHA * p.x[o] + g1 * acc[mi][ni][r];
        }
    }
  }
}

DI void phase_ln(float* __restrict__ xio, const float* __restrict__ g, const float* __restrict__ bta) {
  const int tq = tid_opaque(); const int lane = tq & 63, wave = tq >> 6;
  for (int row = blockIdx.x * 8 + wave; row < T_; row += gridDim.x * 8) {
    float* rp = xio + (size_t)row * 1024;
    f32x4 v[4];
    float s = 0.f;
#pragma unroll
    for (int i = 0; i < 4; ++i) { v[i] = *(const f32x4*)(rp + i * 256 + lane * 4); s += v[i][0] + v[i][1] + v[i][2] + v[i][3]; }
    const float mu = wave_sum(s) * (1.f / 1024.f);
    float q = 0.f;
#pragma unroll
    for (int i = 0; i < 4; ++i)
#pragma unroll
      for (int j = 0; j < 4; ++j) { float d = v[i][j] - mu; q += d * d; }
    const float rs = rsqrtf(wave_sum(q) * (1.f / 1024.f) + LN_EPS);
#pragma unroll
    for (int i = 0; i < 4; ++i) {
      f32x4 gg = *(const f32x4*)(g + i * 256 + lane * 4), bb = *(const f32x4*)(bta + i * 256 + lane * 4), o;
#pragma unroll
      for (int j = 0; j < 4; ++j) o[j] = (v[i][j] - mu) * rs * gg[j] + bb[j];
      *(f32x4*)(rp + i * 256 + lane * 4) = o;
    }
  }
}

DI int swz256(int row, int ch) { return row * 256 + ((ch ^ (row & 15)) << 4); }
DI void ins16(float (&L)[16], float x) {
#pragma unroll
  for (int i = 0; i < 16; ++i) { const float hi = __builtin_fmaxf(L[i], x); x = __builtin_fminf(L[i], x); L[i] = hi; }
}
DI void bitonic16_desc(float (&M)[16]) {
#pragma unroll
  for (int d = 8; d >= 1; d >>= 1)
#pragma unroll
    for (int i = 0; i < 16; ++i)
      if ((i & d) == 0) { const float a = M[i], b = M[i + d]; M[i] = __builtin_fmaxf(a, b); M[i + d] = __builtin_fminf(a, b); }
}
constexpr int ROUTE_Q_OFF = 0, ROUTE_K_OFF = 65536, ROUTE_IDX_OFF = 106496;
DI void phase_route(const P& p, char* smem) {
  const float* ada = (const float*)(p.ws + OFF_ADA);
  float* mod = (float*)(smem + 2 * LDS_STAGE);
  const ushort_t* keysb = (const ushort_t*)(p.ws + OFF_KEYS_B);
  int* idx = (int*)(p.ws + OFF_IDX);
  float* gv = (float*)(p.ws + OFF_GV);
  for (int item = blockIdx.x; item < (T_ / BM) * 8; item += gridDim.x) {
    const int tid = tid_opaque(), lane = tid & 63, wave = tid >> 6, wm = wave >> 1, wn = wave & 1;
    const int m0 = (item >> 3) * BM, hh = item & 7, b = m0 / S_;
    __syncthreads();
    stage_mod(mod, ada, b, 4, 3);
    __syncthreads();
    float L0[16];
#pragma unroll 1
    for (int pp = 0; pp < 2; ++pp) {
      const int hp = hh * 2 + pp;
      f32x16 acc[2][2]; acc_zero(acc);
      ALoadF32Mod al{p.out, mod};
      gemm_mainloop<ALoadF32Mod, true>(acc, al, m0, (const ushort_t*)(p.ws + OFF_WQ_T), 1024, hp * 128, 1024, smem);
#pragma unroll
      for (int mi = 0; mi < 2; ++mi) {
        const int tok = wm * 64 + mi * 32 + (lane & 31);
#pragma unroll
        for (int ni = 0; ni < 2; ++ni)
#pragma unroll
          for (int g = 0; g < 4; ++g) {
            const int ch = wn * 8 + ni * 4 + g;
            uint2 v; v.x = pack2(acc[mi][ni][4 * g], acc[mi][ni][4 * g + 1]); v.y = pack2(acc[mi][ni][4 * g + 2], acc[mi][ni][4 * g + 3]);
            *(uint2*)(smem + ROUTE_Q_OFF + swz256(tok, ch) + 8 * (lane >> 5)) = v;
          }
      }
#pragma unroll
      for (int i = 0; i < 4; ++i) {
        const int q = tid + 512 * i, row = q >> 4, ch = q & 15;
        *(u32x4*)(smem + ROUTE_K_OFF + swz256(row, ch)) = *(const u32x4*)(keysb + (size_t)hp * 16384 + row * 128 + ch * 8);
      }
      __syncthreads();
      f32x16 sc[4];
#pragma unroll
      for (int ks = 0; ks < 4; ++ks)
#pragma unroll
        for (int r = 0; r < 16; ++r) sc[ks][r] = 0.f;
#pragma unroll
      for (int s = 0; s < 8; ++s) {
        const int ch = 2 * s + (lane >> 5);
        const bf16x8 bq = *(const bf16x8*)(smem + ROUTE_Q_OFF + swz256(wave * 32 + (lane & 31), ch));
#pragma unroll
        for (int ks = 0; ks < 4; ++ks) {
          const bf16x8 ak = *(const bf16x8*)(smem + ROUTE_K_OFF + swz256(ks * 32 + (lane & 31), ch));
          sc[ks] = __builtin_amdgcn_mfma_f32_32x32x16_bf16(ak, bq, sc[ks], 0, 0, 0);
        }
      }
      float L[16];
#pragma unroll
      for (int i = 0; i < 16; ++i) L[i] = -3.0e38f;
      const unsigned hbit = (unsigned)(lane >> 5) << 2;
#pragma unroll
      for (int ks = 0; ks < 4; ++ks)
#pragma unroll
        for (int r = 0; r < 16; ++r) {
          const unsigned key = (unsigned)(ks * 32 + (r & 3) + 8 * (r >> 2)) | hbit;
          ins16(L, __uint_as_float((__float_as_uint(sc[ks][r]) & ~127u) | key));
        }
      {
        float M[16];
#pragma unroll
        for (int i = 0; i < 16; ++i) M[i] = __builtin_fmaxf(L[i], __shfl_xor(L[15 - i], 32));
        bitonic16_desc(M);
#pragma unroll
        for (int i = 0; i < 16; ++i) L[i] = M[i];
      }
      if (pp == 0) {
#pragma unroll
        for (int i = 0; i < 16; ++i) L0[i] = L[i];
      } else {
        unsigned char* ib = (unsigned char*)(smem + ROUTE_IDX_OFF) + tid * 32;
#pragma unroll
        for (int i = 0; i < 16; ++i) { ib[i] = (unsigned char)(__float_as_uint(L0[i]) & 127u); ib[16 + i] = (unsigned char)(__float_as_uint(L[i]) & 127u); }
        float F[16];
#pragma unroll
        for (int i = 0; i < 16; ++i) F[i] = -3.0e38f;
#pragma unroll
        for (int i = 0; i < 16; ++i) {
          const float ai = __uint_as_float(__float_as_uint(L0[i]) & ~127u);
#pragma unroll
          for (int j = 0; j < 16; ++j)
            if ((i + 1) * (j + 1) <= 16) {
              const float s = ai + __uint_as_float(__float_as_uint(L[j]) & ~127u);
              ins16(F, __uint_as_float((__float_as_uint(s) & ~255u) | (unsigned)(i * 16 + j)));
            }
        }
        const float mx = __uint_as_float(__float_as_uint(F[0]) & ~255u);
        float e[16], sum = 0.f;
#pragma unroll
        for (int k = 0; k < 16; ++k) { e[k] = __expf(__uint_as_float(__float_as_uint(F[k]) & ~255u) - mx); sum += e[k]; }
        const float inv = 1.f / sum;
        if (lane < 32) {
          const int tok = m0 + wave * 32 + lane;
          int* ip = idx + (size_t)tok * 128 + hh * 16;
          float* gp = gv + (size_t)tok * 128 + hh * 16;
#pragma unroll
          for (int k4 = 0; k4 < 4; ++k4) {
            int4 iv; f32x4 g4;
            int ee[4];
#pragma unroll
            for (int u = 0; u < 4; ++u) {
              const unsigned code = __float_as_uint(F[k4 * 4 + u]) & 255u;
              ee[u] = (int)ib[code >> 4] * 128 + (int)ib[16 + (code & 15u)];
              g4[u] = e[k4 * 4 + u] * inv;
            }
            iv.x = ee[0]; iv.y = ee[1]; iv.z = ee[2]; iv.w = ee[3];
            *(int4*)(ip + k4 * 4) = iv;
            *(f32x4*)(gp + k4 * 4) = g4;
          }
        }
      }
    }
  }
}

DI void phase_keys(const P& p) {
  ushort_t* keysb = (ushort_t*)(p.ws + OFF_KEYS_B);
  for (int i = blockIdx.x * NT + tid_opaque(); i < 16 * 128 * 128 / 4; i += gridDim.x * NT) {
    f32x4 v = *(const f32x4*)(p.keys + (size_t)i * 4);
    uint2 o; o.x = pack2(v[0], v[1]); o.y = pack2(v[2], v[3]);
    *(uint2*)(keysb + (size_t)i * 4) = o;
  }
}

typedef __bf16 bf16x2_t __attribute__((ext_vector_type(2)));
DI float dot2bf(unsigned a, unsigned b, float c) { return __builtin_amdgcn_fdot2_f32_bf16(__builtin_bit_cast(bf16x2_t, a), __builtin_bit_cast(bf16x2_t, b), c, false); }
DI void phase_ln1(const P& p) {
  const float* ada = (const float*)(p.ws + OFF_ADA);
  ushort_t* u2b = (ushort_t*)(p.ws + OFF_U2B);
  const int tq = tid_opaque(); const int lane = tq & 63, wave = tq >> 6;
  for (int row = blockIdx.x * 8 + wave; row < T_; row += gridDim.x * 8) {
    const int b = row / S_;
    float* rp = p.out + (size_t)row * 1024;
    f32x4 v[4];
    float s = 0.f;
#pragma unroll
    for (int i = 0; i < 4; ++i) { v[i] = *(const f32x4*)(rp + i * 256 + lane * 4); s += v[i][0] + v[i][1] + v[i][2] + v[i][3]; }
    const float mu = wave_sum(s) * (1.f / 1024.f);
    float q = 0.f;
#pragma unroll
    for (int i = 0; i < 4; ++i)
#pragma unroll
      for (int j = 0; j < 4; ++j) { float d = v[i][j] - mu; q += d * d; }
    const float rs = rsqrtf(wave_sum(q) * (1.f / 1024.f) + LN_EPS);
#pragma unroll
    for (int i = 0; i < 4; ++i) {
      const int col = i * 256 + lane * 4;
      f32x4 gg = *(const f32x4*)(p.ln1_g + col), bb = *(const f32x4*)(p.ln1_b + col), o;
      f32x4 sc = *(const f32x4*)(ada + b * 6144 + 4 * 1024 + col), sh = *(const f32x4*)(ada + b * 6144 + 3 * 1024 + col);
#pragma unroll
      for (int j = 0; j < 4; ++j) o[j] = (v[i][j] - mu) * rs * gg[j] + bb[j];
      *(f32x4*)(rp + col) = o;
      uint2 w; w.x = pack2(o[0] * (1.f + sc[0]) + sh[0], o[1] * (1.f + sc[1]) + sh[1]); w.y = pack2(o[2] * (1.f + sc[2]) + sh[2], o[3] * (1.f + sc[3]) + sh[3]);
      *(uint2*)(u2b + (size_t)row * 1024 + col) = w;
    }
  }
}
DI void phase_tabconv(const P& p) {
  ushort_t* tu = (ushort_t*)(p.ws + OFF_TABU);
  ushort_t* tv = (ushort_t*)(p.ws + OFF_TABV);
  const int tq = tid_opaque(); const int lane = tq & 63, wave = tq >> 6;
  for (int e = blockIdx.x * 8 + wave; e < 16384; e += gridDim.x * 8) {
#pragma unroll
    for (int i = 0; i < 4; ++i) {
      const int col = i * 256 + lane * 4;
      f32x4 a = *(const f32x4*)(p.pu + (size_t)e * 1024 + col);
      f32x4 c = *(const f32x4*)(p.pv + (size_t)e * 1024 + col);
      uint2 wa; wa.x = pack2(a[0], a[1]); wa.y = pack2(a[2], a[3]);
      uint2 wc; wc.x = pack2(c[0], c[1]); wc.y = pack2(c[2], c[3]);
      *(uint2*)(tu + (size_t)e * 1024 + col) = wa;
      const int slice = i * 4 + (lane >> 4);
      *(uint2*)(tv + ((size_t)slice * 16384 + e) * 64 + (lane & 15) * 4) = wc;
    }
  }
}

template <int CTRL> DI float dpp_f(float v) { return __int_as_float(__builtin_amdgcn_mov_dpp(__float_as_int(v), CTRL, 0xf, 0xf, false)); }
template <int CTRL> DI int dpp_shr0(int v) { return __builtin_amdgcn_update_dpp(0, v, CTRL, 0xf, 0xf, true); }
template <int I> DI int bcast16(int v) { return __builtin_amdgcn_mov_dpp(v, 0x150 + I, 0xf, 0xf, false); }
DI float row_sum16(float d) {
  d += dpp_f<0xB1>(d);
  d += dpp_f<0x4E>(d);
  d += dpp_f<0x141>(d);
  d += dpp_f<0x140>(d);
  return d;
}
DI void phase_upass(const P& p, char* smem) {
  const int* idx = (const int*)(p.ws + OFF_IDX);
  const float* gv = (const float*)(p.ws + OFF_GV);
  const ushort_t* u2b = (const ushort_t*)(p.ws + OFF_U2B);
  const char* tabu = (const char*)(p.ws + OFF_TABU);
  float* coef = (float*)(p.ws + OFF_COEF);
  const int tq = tid_opaque(); const int lane = tq & 63, wave = tq >> 6;
  const int g = lane >> 4, j = lane & 15;
  int4* lst = (int4*)smem + wave * 512 + g * 128;
  const int xg = blockIdx.x & 7, bi = blockIdx.x >> 3, nb = (gridDim.x - xg + 7) >> 3;
  __syncthreads();
#pragma unroll 1
  for (int pass = 0; pass < 2; ++pass) {
    const int part = xg + 8 * pass;
#pragma unroll 1
    for (int tb = (bi * 8 + wave) * 4; tb < T_; tb += nb * 32) {
      const int tok = tb + g;
      const int4 i0 = *(const int4*)(idx + (size_t)tb * 128 + lane * 8), i1 = *(const int4*)(idx + (size_t)tb * 128 + lane * 8 + 4);
      const f32x4 g0 = *(const f32x4*)(gv + (size_t)tb * 128 + lane * 8), g1 = *(const f32x4*)(gv + (size_t)tb * 128 + lane * 8 + 4);
      u32x4 xr[8];
#pragma unroll
      for (int c = 0; c < 8; ++c) xr[c] = *(const u32x4*)(u2b + (size_t)tok * 1024 + (j + 16 * c) * 8);
      const int ev[8] = {i0.x, i0.y, i0.z, i0.w, i1.x, i1.y, i1.z, i1.w};
      const float gg[8] = {g0[0], g0[1], g0[2], g0[3], g1[0], g1[1], g1[2], g1[3]};
      int cnt = 0;
#pragma unroll
      for (int i = 0; i < 8; ++i) cnt += ((ev[i] >> 10) == part) ? 1 : 0;
      int incl = cnt;
      incl += dpp_shr0<0x111>(incl); incl += dpp_shr0<0x112>(incl); incl += dpp_shr0<0x114>(incl); incl += dpp_shr0<0x118>(incl);
      const int ng = bcast16<15>(incl);
      int pos = incl - cnt;
#pragma unroll
      for (int i = 0; i < 8; ++i)
        if ((ev[i] >> 10) == part) { int4 en; en.x = ev[i]; en.y = __float_as_int(gg[i]); en.z = j * 8 + i; en.w = 0; lst[pos] = en; ++pos; }
      const int nmax = max(max(__builtin_amdgcn_readlane(ng, 0), __builtin_amdgcn_readlane(ng, 16)), max(__builtin_amdgcn_readlane(ng, 32), __builtin_amdgcn_readlane(ng, 48)));
      __builtin_amdgcn_wave_barrier();
      asm volatile("s_waitcnt lgkmcnt(0)" ::: "memory");
      u32x4 ra[8];
      {
        const unsigned e = (ng > 0) ? (unsigned)lst[0].x : 0u;
        const char* row = tabu + (size_t)e * 2048 + j * 16;
#pragma unroll
        for (int c = 0; c < 8; ++c) ra[c] = *(const u32x4*)(row + c * 256);
      }
#pragma unroll 1
      for (int it = 0; it < nmax; ++it) {
        u32x4 rn[8];
        {
          const unsigned e = (it + 1 < ng) ? (unsigned)lst[it + 1].x : 0u;
          const char* row = tabu + (size_t)e * 2048 + j * 16;
#pragma unroll
          for (int c = 0; c < 8; ++c) rn[c] = *(const u32x4*)(row + c * 256);
        }
        float a0 = 0.f, a1 = 0.f, a2 = 0.f, a3 = 0.f;
#pragma unroll
        for (int c = 0; c < 8; ++c) {
          a0 = dot2bf(ra[c][0], xr[c][0], a0); a1 = dot2bf(ra[c][1], xr[c][1], a1);
          a2 = dot2bf(ra[c][2], xr[c][2], a2); a3 = dot2bf(ra[c][3], xr[c][3], a3);
        }
        const float d = row_sum16((a0 + a1) + (a2 + a3));
        if (j == 0 && it < ng) ((int*)&lst[it])[3] = __float_as_int(d);
#pragma unroll
        for (int c = 0; c < 8; ++c) ra[c] = rn[c];
      }
      __builtin_amdgcn_wave_barrier();
      asm volatile("s_waitcnt lgkmcnt(0)" ::: "memory");
#pragma unroll 1
      for (int k = 0; k < nmax; k += 16) {
        if (k + j < ng) {
          const int4 en = lst[k + j];
          const float a = __int_as_float(en.w);
          coef[(size_t)tok * 128 + en.z] = __int_as_float(en.y) * 0.5f * a * (1.f + erff(a * 0.7071067811865475f));
        }
      }
      __builtin_amdgcn_wave_barrier();
      asm volatile("s_waitcnt lgkmcnt(0)" ::: "memory");
    }
  }
}

struct VHdr { int ea, eb, ca, cb; };
DI VHdr vp_hdr(const int* idx, const float* coef, int tok, int g, int cq) {
  VHdr h;
  h.ea = idx[(size_t)tok * 128 + g * 32 + cq]; h.eb = idx[(size_t)tok * 128 + g * 32 + 16 + cq];
  h.ca = __float_as_int(coef[(size_t)tok * 128 + g * 32 + cq]); h.cb = __float_as_int(coef[(size_t)tok * 128 + g * 32 + 16 + cq]);
  return h;
}
DI void vp_rows(uint2 (&va)[16], uint2 (&vb)[16], const VHdr& h, const char* tb) {
#define VP_STEP(I) { va[I] = *(const uint2*)(tb + (unsigned)bcast16<I>(h.ea) * 128u); vb[I] = *(const uint2*)(tb + (unsigned)bcast16<I>(h.eb) * 128u); }
  VP_STEP(0) VP_STEP(1) VP_STEP(2) VP_STEP(3) VP_STEP(4) VP_STEP(5) VP_STEP(6) VP_STEP(7)
  VP_STEP(8) VP_STEP(9) VP_STEP(10) VP_STEP(11) VP_STEP(12) VP_STEP(13) VP_STEP(14) VP_STEP(15)
#undef VP_STEP
}
DI void vp_coefs(float (&fa)[16], float (&fb)[16], const VHdr& h) {
#define VP_STEP(I) { fa[I] = __int_as_float(bcast16<I>(h.ca)); fb[I] = __int_as_float(bcast16<I>(h.cb)); }
  VP_STEP(0) VP_STEP(1) VP_STEP(2) VP_STEP(3) VP_STEP(4) VP_STEP(5) VP_STEP(6) VP_STEP(7)
  VP_STEP(8) VP_STEP(9) VP_STEP(10) VP_STEP(11) VP_STEP(12) VP_STEP(13) VP_STEP(14) VP_STEP(15)
#undef VP_STEP
}
DI void phase_vpass(const P& p) {
  const int* idx = (const int*)(p.ws + OFF_IDX);
  const float* coef = (const float*)(p.ws + OFF_COEF);
  const char* tabv = (const char*)(p.ws + OFF_TABV);
  float* f = (float*)(p.ws + OFF_F);
  const int tq = tid_opaque(); const int lane = tq & 63, wave = tq >> 6;
  const int g = lane >> 4, cq = lane & 15;
  const int xg = blockIdx.x & 7, bi = blockIdx.x >> 3, nb = (gridDim.x - xg + 7) >> 3;
  const int step = nb * 8;
#pragma unroll 1
  for (int pass = 0; pass < 2; ++pass) {
    const int slice = xg + 8 * pass;
    const char* tb = tabv + (size_t)slice * (16384 * 128) + cq * 8;
    int tok = bi * 8 + wave;
    if (tok >= T_) continue;
    VHdr hc = vp_hdr(idx, coef, tok, g, cq);
    VHdr hn = vp_hdr(idx, coef, min(tok + step, T_ - 1), g, cq);
    uint2 va[16], vb[16];
    vp_rows(va, vb, hc, tb);
#pragma unroll 1
    for (; tok < T_; tok += step) {
      const VHdr hnn = vp_hdr(idx, coef, min(tok + 2 * step, T_ - 1), g, cq);
      uint2 na[16], nb2[16];
      vp_rows(na, nb2, hn, tb);
      float fa[16], fb[16];
      vp_coefs(fa, fb, hc);
      float a0 = 0.f, a1 = 0.f, a2 = 0.f, a3 = 0.f;
#pragma unroll
      for (int i = 0; i < 16; ++i) {
        a0 += fa[i] * __uint_as_float(va[i].x << 16); a1 += fa[i] * __uint_as_float(va[i].x & 0xffff0000u);
        a2 += fa[i] * __uint_as_float(va[i].y << 16); a3 += fa[i] * __uint_as_float(va[i].y & 0xffff0000u);
        a0 += fb[i] * __uint_as_float(vb[i].x << 16); a1 += fb[i] * __uint_as_float(vb[i].x & 0xffff0000u);
        a2 += fb[i] * __uint_as_float(vb[i].y << 16); a3 += fb[i] * __uint_as_float(vb[i].y & 0xffff0000u);
      }
      a0 += __shfl_xor(a0, 16); a1 += __shfl_xor(a1, 16); a2 += __shfl_xor(a2, 16); a3 += __shfl_xor(a3, 16);
      a0 += __shfl_xor(a0, 32); a1 += __shfl_xor(a1, 32); a2 += __shfl_xor(a2, 32); a3 += __shfl_xor(a3, 32);
      if (g == 0) { f32x4 o; o[0] = a0; o[1] = a1; o[2] = a2; o[3] = a3; *(f32x4*)(f + (size_t)tok * 1024 + slice * 64 + cq * 4) = o; }
#pragma unroll
      for (int i = 0; i < 16; ++i) { va[i] = na[i]; vb[i] = nb2[i]; }
      hc = hn; hn = hnn;
    }
  }
}

DI void phase_ln2(const P& p) {
  const float* ada = (const float*)(p.ws + OFF_ADA);
  const float* f = (const float*)(p.ws + OFF_F);
  const int tq = tid_opaque(); const int lane = tq & 63, wave = tq >> 6;
  for (int tok = blockIdx.x * 8 + wave; tok < T_; tok += gridDim.x * 8) {
    const int b = tok / S_;
    float* rp = p.out + (size_t)tok * 1024;
    f32x4 acc[4];
    float sm = 0.f;
#pragma unroll
    for (int i = 0; i < 4; ++i) {
      const int col = i * 256 + lane * 4;
      f32x4 x1 = *(const f32x4*)(rp + col), ff = *(const f32x4*)(f + (size_t)tok * 1024 + col);
      f32x4 g2 = *(const f32x4*)(ada + b * 6144 + 5 * 1024 + col);
#pragma unroll
      for (int j = 0; j < 4; ++j) { acc[i][j] = DN_ALPHA * x1[j] + (1.f + g2[j]) * ff[j]; sm += acc[i][j]; }
    }
    const float mu = wave_sum(sm) * (1.f / 1024.f);
    float q = 0.f;
#pragma unroll
    for (int i = 0; i < 4; ++i)
#pragma unroll
      for (int j = 0; j < 4; ++j) { float d = acc[i][j] - mu; q += d * d; }
    const float rs = rsqrtf(wave_sum(q) * (1.f / 1024.f) + LN_EPS);
#pragma unroll
    for (int i = 0; i < 4; ++i) {
      const int col = i * 256 + lane * 4;
      f32x4 gg = *(const f32x4*)(p.ln2_g + col), bb = *(const f32x4*)(p.ln2_b + col), o;
#pragma unroll
      for (int j = 0; j < 4; ++j) o[j] = (acc[i][j] - mu) * rs * gg[j] + bb[j];
      *(f32x4*)(rp + col) = o;
    }
  }
}

constexpr int SMEM_BYTES = 143360;
__global__ void __launch_bounds__(NT) fwd_megakernel(P p) {
  __shared__ __attribute__((aligned(16))) char smem[SMEM_BYTES];
  cooperative_groups::grid_group grid = cooperative_groups::this_grid();
  phase_ada(p, smem);
  phase_transposes(p, smem);
  phase_keys(p);
  phase_filter(p, smem);
  grid.sync();
  phase_inproj(p, smem);
  grid.sync();
  for (int item = blockIdx.x; item < 512 + 128; item += gridDim.x) {
    if (item < 512) hyena_item(p, smem, item);
    else attn_item(p, item - 512);
  }
  grid.sync();
  phase_merge(p, smem);
  grid.sync();
  phase_outproj(p, smem);
  grid.sync();
  phase_ln1(p);
  phase_tabconv(p);
  grid.sync();
  phase_route(p, smem);
  grid.sync();
  phase_upass(p, smem);
  grid.sync();
  phase_vpass(p);
  grid.sync();
  phase_ln2(p);
}

extern "C" void kernel_launch(void* const* d_in, const int* in_sizes, int n_in, void* d_out, int out_size, void* d_ws, size_t ws_size,
                              hipStream_t stream) {
  P p{};
  p.x = (const float*)d_in[0]; p.c = (const float*)d_in[1]; p.pos = (const int*)d_in[2];
  p.w_ada = (const float*)d_in[3]; p.b_ada = (const float*)d_in[4]; p.w_in = (const float*)d_in[5];
  p.hy_conv_w = (const float*)d_in[6]; p.hy_conv_b = (const float*)d_in[7];
  p.f1_w = (const float*)d_in[8]; p.f1_b = (const float*)d_in[9]; p.f1_freq = (const float*)d_in[10];
  p.f2_w = (const float*)d_in[11]; p.f2_b = (const float*)d_in[12]; p.f2_freq = (const float*)d_in[13];
  p.f3_w = (const float*)d_in[14]; p.hy_bias = (const float*)d_in[15];
  p.w_bh = (const float*)d_in[16]; p.w_ba = (const float*)d_in[17]; p.w_out = (const float*)d_in[18];
  p.ln1_g = (const float*)d_in[19]; p.ln1_b = (const float*)d_in[20];
  p.wq = (const float*)d_in[21]; p.keys = (const float*)d_in[22]; p.pu = (const float*)d_in[23]; p.pv = (const float*)d_in[24];
  p.ln2_g = (const float*)d_in[25]; p.ln2_b = (const float*)d_in[26];
  p.out = (float*)d_out; p.ws = (char*)d_ws;

  static int grid_blocks = 0;
  if (!grid_blocks) {
    int dev = 0, cus = 0, per_cu = 0;
    hipGetDevice(&dev);
    hipDeviceGetAttribute(&cus, hipDeviceAttributeMultiprocessorCount, dev);
    hipOccupancyMaxActiveBlocksPerMultiprocessor(&per_cu, fwd_megakernel, NT, 0);
    if (per_cu > 1) per_cu = 1;
    grid_blocks = cus * per_cu;
  }
  void* args[] = {&p};
  hipError_t e = hipLaunchCooperativeKernel((void*)fwd_megakernel, dim3(grid_blocks), dim3(NT), args, 0, stream);
  if (e != hipSuccess) fprintf(stderr, "cooperative launch failed: %s (grid %d)\n", hipGetErrorString(e), grid_blocks);
}
```

```cpp
#include <hip/hip_runtime.h>
#include <hip/hip_cooperative_groups.h>
#include <cstdio>
#include <cstdint>

#define DI __device__ __forceinline__
typedef unsigned short ushort_t;
typedef __attribute__((ext_vector_type(8))) short bf16x8;
typedef __attribute__((ext_vector_type(16))) float f32x16;
typedef __attribute__((ext_vector_type(4))) float f32x4;
typedef __attribute__((ext_vector_type(4))) unsigned u32x4;

constexpr int T_ = 16384, S_ = 8192, NB = 2, D_ = 1024;
constexpr int HW_ = 512, HYC = 1536, QKVC = 2304, GATEC = 2048, INW = 5888;
constexpr int NT = 512;
constexpr float DN_ALPHA = 1.189207115002721f;
constexpr float LN_EPS = 1e-5f;

constexpr size_t OFF_ADA   = 0;
constexpr size_t OFF_KEYS_B= 65536;
constexpr size_t OFF_WIN_T = 65536 + 524288;
constexpr size_t OFF_WQ_T  = OFF_WIN_T + (size_t)INW * 1024 * 2;
constexpr size_t OFF_WOUT_T= OFF_WQ_T + (size_t)2048 * 1024 * 2;
constexpr size_t OFF_WBH_T = OFF_WOUT_T + (size_t)1024 * 1024 * 2;
constexpr size_t OFF_WBA_T = OFF_WBH_T + (size_t)1024 * 512 * 2;
constexpr size_t OFF_PH    = OFF_WBA_T + (size_t)1024 * 256 * 2;
constexpr size_t OFF_QKV   = OFF_PH + (size_t)T_ * HYC * 2;
constexpr size_t OFF_GATE  = OFF_QKV + (size_t)T_ * QKVC * 2;
constexpr size_t OFF_YH    = OFF_GATE + (size_t)T_ * GATEC * 2;
constexpr size_t OFF_YA    = OFF_YH + (size_t)T_ * HW_ * 2;
constexpr size_t OFF_END   = OFF_YA + (size_t)T_ * 256 * 2;
constexpr size_t OFF_MERGED= OFF_PH;
constexpr size_t OFF_U2B   = OFF_PH;
constexpr size_t OFF_TABU  = OFF_QKV;
constexpr size_t OFF_TABV  = OFF_QKV + (size_t)32 * 1048576;
constexpr size_t OFF_COEF  = OFF_QKV + (size_t)64 * 1048576;
constexpr size_t OFF_F     = OFF_QKV + (size_t)72 * 1048576;
static_assert(OFF_F + (size_t)64 * 1048576 <= OFF_YH, "peer buffers overflow the qkv+gate region");
constexpr size_t OFF_IDX   = OFF_YH;
constexpr size_t OFF_GV    = OFF_YH + (size_t)T_ * 128 * 4;
constexpr size_t OFF_HSCR  = OFF_END;
static_assert(OFF_HSCR + (size_t)164 * 131072 <= 268435456ull, "ws overflow");
static_assert((size_t)92 * 131072 <= (size_t)INW * 1024 * 2, "w_in^T region too small");

struct P {
  const float *x, *c; const int* pos;
  const float *w_ada, *b_ada, *w_in, *hy_conv_w, *hy_conv_b, *f1_w, *f1_b, *f1_freq, *f2_w, *f2_b, *f2_freq, *f3_w,
      *hy_bias, *w_bh, *w_ba, *w_out, *ln1_g, *ln1_b, *wq, *keys, *pu, *pv, *ln2_g, *ln2_b;
  float* out; char* ws;
};

DI ushort_t f2bf(float x) { unsigned u = __float_as_uint(x); u += 0x7fffu + ((u >> 16) & 1u); return (ushort_t)(u >> 16); }
DI float bf2f(ushort_t h) { return __uint_as_float(((unsigned)h) << 16); }
typedef __bf16 bf16x2_hw __attribute__((ext_vector_type(2)));
typedef float f32x2_hw __attribute__((ext_vector_type(2)));
DI unsigned pack2(float a, float b) { f32x2_hw v = {a, b}; return __builtin_bit_cast(unsigned, __builtin_convertvector(v, bf16x2_hw)); }
DI int tid_opaque() { int t = threadIdx.x; asm volatile("" : "+v"(t)); return t; }
DI float wave_sum(float v) {
#pragma unroll
  for (int o = 32; o > 0; o >>= 1) v += __shfl_xor(v, o);
  return v;
}

struct cf2 { float x, y; };
constexpr int FFT_N = 16384, FFT_SA = 560;

DI constexpr float wcos32(int j) {
  switch (j & 31) {
    case 0: return 1.0f; case 1: return 0.98078528040323043f; case 2: return 0.92387953251128674f; case 3: return 0.83146961230254524f;
    case 4: return 0.70710678118654752f; case 5: return 0.55557023301960218f; case 6: return 0.38268343236508978f; case 7: return 0.19509032201612825f;
    case 8: return 0.0f; case 9: return -0.19509032201612825f; case 10: return -0.38268343236508978f; case 11: return -0.55557023301960218f;
    case 12: return -0.70710678118654752f; case 13: return -0.83146961230254524f; case 14: return -0.92387953251128674f; case 15: return -0.98078528040323043f;
    case 16: return -1.0f; case 17: return -0.98078528040323043f; case 18: return -0.92387953251128674f; case 19: return -0.83146961230254524f;
    case 20: return -0.70710678118654752f; case 21: return -0.55557023301960218f; case 22: return -0.38268343236508978f; case 23: return -0.19509032201612825f;
    case 24: return 0.0f; case 25: return 0.19509032201612825f; case 26: return 0.38268343236508978f; case 27: return 0.55557023301960218f;
    case 28: return 0.70710678118654752f; case 29: return 0.83146961230254524f; case 30: return 0.92387953251128674f; default: return 0.98078528040323043f;
  }
}
DI constexpr float wsin32(int j) { return wcos32(j + 24); }
DI constexpr int brev(int v, int bits) { int r = 0; for (int i = 0; i < bits; ++i) r |= ((v >> i) & 1) << (bits - 1 - i); return r; }

template <int R, int LEN, bool INV, bool ZHI>
DI void r2_stage(float (&re)[R], float (&im)[R]) {
  constexpr int half = LEN / 2;
#pragma unroll
  for (int start = 0; start < R; start += LEN) {
#pragma unroll
    for (int j = 0; j < half; ++j) {
      const int a = start + j, b = a + half;
      const int tj = j * (32 / LEN);
      const float c = wcos32(tj), s = wsin32(tj);
      if (!INV) {
        float dr, di;
        if (ZHI) { dr = re[a]; di = im[a]; }
        else {
          const float ar = re[a], ai = im[a], br = re[b], bi = im[b];
          re[a] = ar + br; im[a] = ai + bi; dr = ar - br; di = ai - bi;
        }
        if (tj == 0) { re[b] = dr; im[b] = di; }
        else if (tj == 8) { re[b] = di; im[b] = -dr; }
        else { re[b] = dr * c + di * s; im[b] = di * c - dr * s; }
      } else {
        const float br = re[b], bi = im[b];
        float pr, pi;
        if (tj == 0) { pr = br; pi = bi; }
        else if (tj == 8) { pr = -bi; pi = br; }
        else { pr = br * c - bi * s; pi = bi * c + br * s; }
        const float ar = re[a], ai = im[a];
        re[a] = ar + pr; im[a] = ai + pi; re[b] = ar - pr; im[b] = ai - pi;
      }
    }
  }
}
template <int R, bool ZHI> DI void dft_fwd(float (&re)[R], float (&im)[R]) {
  if (R == 32) r2_stage<R, (R == 32 ? 32 : 2), false, ZHI>(re, im);
  r2_stage<R, 16, false, (R == 16) && ZHI>(re, im);
  r2_stage<R, 8, false, false>(re, im);
  r2_stage<R, 4, false, false>(re, im);
  r2_stage<R, 2, false, false>(re, im);
}
template <int R> DI void dft_inv(float (&re)[R], float (&im)[R]) {
  r2_stage<R, 2, true, false>(re, im);
  r2_stage<R, 4, true, false>(re, im);
  r2_stage<R, 8, true, false>(re, im);
  r2_stage<R, 16, true, false>(re, im);
  if (R == 32) r2_stage<R, (R == 32 ? 32 : 2), true, false>(re, im);
}

DI void sincos_turn(float frac, float& s, float& c) { sincospif(2.0f * frac, &s, &c); }

template <bool ZHI>
DI void fft_fwdA(float (&re)[32], float (&im)[32], cf2* lds, int m) {
  asm volatile("" : "+v"(m));
  float s1, c1; sincos_turn((float)m * (1.0f / 16384.0f), s1, c1);
  __builtin_amdgcn_sched_barrier(0);
  dft_fwd<32, ZHI>(re, im);
  __builtin_amdgcn_sched_barrier(0);
  float wr = 1.f, wi = 0.f;
#pragma unroll
  for (int k1 = 0; k1 < 32; ++k1) {
    if ((k1 & 3) == 0) __builtin_amdgcn_sched_barrier(0);
    const int r = brev(k1, 5);
    cf2 o; o.x = re[r] * wr - im[r] * wi; o.y = re[r] * wi + im[r] * wr;
    lds[k1 * FFT_SA + m] = o;
    const float nr = wr * c1 + wi * s1, ni = wi * c1 - wr * s1;
    wr = nr; wi = ni;
  }
}
DI void fft_B_read(float (&re)[32], float (&im)[32], const cf2* lds, int tid) {
  const int k1 = tid >> 4, mp = tid & 15;
#pragma unroll
  for (int n2 = 0; n2 < 32; ++n2) { cf2 v = lds[k1 * FFT_SA + n2 * 16 + mp]; re[n2] = v.x; im[n2] = v.y; }
}
DI void fft_fwdB_write(float (&re)[32], float (&im)[32], cf2* lds, int tid) {
  asm volatile("" : "+v"(tid));
  const int k1 = tid >> 4, mp = tid & 15;
  float s1, c1; sincos_turn((float)mp * (1.0f / 512.0f), s1, c1);
  __builtin_amdgcn_sched_barrier(0);
  dft_fwd<32, false>(re, im);
  __builtin_amdgcn_sched_barrier(0);
  float wr = 1.f, wi = 0.f;
#pragma unroll
  for (int k2 = 0; k2 < 32; ++k2) {
    if ((k2 & 3) == 0) __builtin_amdgcn_sched_barrier(0);
    const int r = brev(k2, 5);
    cf2 o; o.x = re[r] * wr - im[r] * wi; o.y = re[r] * wi + im[r] * wr;
    lds[k1 * FFT_SA + k2 * 17 + mp] = o;
    const float nr = wr * c1 + wi * s1, ni = wi * c1 - wr * s1;
    wr = nr; wi = ni;
  }
}
DI void fft_fwdC(float (&re)[32], float (&im)[32], const cf2* lds, int tid) {
  const int k1 = tid >> 5, k2 = tid & 31;
#pragma unroll
  for (int h = 0; h < 2; ++h) {
    float tr[16], ti[16];
#pragma unroll
    for (int mp = 0; mp < 16; ++mp) { cf2 v = lds[(k1 + 16 * h) * FFT_SA + k2 * 17 + mp]; tr[mp] = v.x; ti[mp] = v.y; }
    dft_fwd<16, false>(tr, ti);
#pragma unroll
    for (int i = 0; i < 16; ++i) { re[h * 16 + i] = tr[i]; im[h * 16 + i] = ti[i]; }
  }
}
DI void fft_invC(float (&re)[32], float (&im)[32], cf2* lds, int tid) {
  const int k1 = tid >> 5, k2 = tid & 31;
#pragma unroll
  for (int h = 0; h < 2; ++h) {
    float tr[16], ti[16];
#pragma unroll
    for (int i = 0; i < 16; ++i) { tr[i] = re[h * 16 + i]; ti[i] = im[h * 16 + i]; }
    dft_inv<16>(tr, ti);
#pragma unroll
    for (int mp = 0; mp < 16; ++mp) { cf2 o; o.x = tr[mp]; o.y = ti[mp]; lds[(k1 + 16 * h) * FFT_SA + k2 * 17 + mp] = o; }
  }
}
DI void fft_invB_read(float (&re)[32], float (&im)[32], const cf2* lds, int tid) {
  asm volatile("" : "+v"(tid));
  const int k1 = tid >> 4, mp = tid & 15;
  float s1, c1; sincos_turn((float)mp * (1.0f / 512.0f), s1, c1);
  float wr = 1.f, wi = 0.f;
  __builtin_amdgcn_sched_barrier(0);
#pragma unroll
  for (int k2 = 0; k2 < 32; ++k2) {
    if ((k2 & 3) == 0) __builtin_amdgcn_sched_barrier(0);
    const int r = brev(k2, 5);
    cf2 v = lds[k1 * FFT_SA + k2 * 17 + mp];
    re[r] = v.x * wr - v.y * wi; im[r] = v.x * wi + v.y * wr;
    const float nr = wr * c1 - wi * s1, ni = wi * c1 + wr * s1;
    wr = nr; wi = ni;
  }
}
DI void fft_invB_write(float (&re)[32], float (&im)[32], cf2* lds, int tid) {
  const int k1 = tid >> 4, mp = tid & 15;
  dft_inv<32>(re, im);
#pragma unroll
  for (int n2 = 0; n2 < 32; ++n2) { cf2 o; o.x = re[n2]; o.y = im[n2]; lds[k1 * FFT_SA + n2 * 16 + mp] = o; }
}
DI void fft_invA(float (&re)[32], float (&im)[32], const cf2* lds, int m) {
  asm volatile("" : "+v"(m));
  float s1, c1; sincos_turn((float)m * (1.0f / 16384.0f), s1, c1);
  float wr = 1.f, wi = 0.f;
  __builtin_amdgcn_sched_barrier(0);
#pragma unroll
  for (int k1 = 0; k1 < 32; ++k1) {
    if ((k1 & 3) == 0) __builtin_amdgcn_sched_barrier(0);
    const int r = brev(k1, 5);
    cf2 v = lds[k1 * FFT_SA + m];
    re[r] = v.x * wr - v.y * wi; im[r] = v.x * wi + v.y * wr;
    const float nr = wr * c1 - wi * s1, ni = wi * c1 + wr * s1;
    wr = nr; wi = ni;
  }
  __builtin_amdgcn_sched_barrier(0);
  dft_inv<32>(re, im);
}

DI void phase_ada(const P& p, char* smem) {
  float (*red)[8][64] = (float (*)[8][64])smem;
  const int tid = tid_opaque(), cl = tid & 63, kq = tid >> 6;
  for (int item = blockIdx.x; item < 96; item += gridDim.x) {
    const int col = item * 64 + cl;
    float a0 = 0.f, a1 = 0.f;
    for (int k = kq * 128; k < kq * 128 + 128; ++k) {
      float w = p.w_ada[(size_t)k * 6144 + col];
      float c0 = p.c[k], c1 = p.c[1024 + k];
      a0 += (c0 / (1.f + __expf(-c0))) * w;
      a1 += (c1 / (1.f + __expf(-c1))) * w;
    }
    __syncthreads();
    red[0][kq][cl] = a0; red[1][kq][cl] = a1;
    __syncthreads();
    if (tid < 128) {
      int b = tid >> 6;
      float s = p.b_ada[col];
#pragma unroll
      for (int q = 0; q < 8; ++q) s += red[b][q][cl];
      ((float*)(p.ws + OFF_ADA))[b * 6144 + col] = s;
    }
  }
}

DI void transpose_tile(const float* __restrict__ W, ushort_t* __restrict__ Wt, int K, int N, int item, char* smem) {
  float (*tile)[65] = (float (*)[65])smem;
  const int ntn = N / 64;
  const int n0 = (item % ntn) * 64, k0 = (item / ntn) * 32;
  const int tid = tid_opaque();
  __syncthreads();
  {
    const int tx = tid & 63, ty = tid >> 6;
#pragma unroll
    for (int i = 0; i < 4; ++i) tile[ty + 8 * i][tx] = W[(size_t)(k0 + ty + 8 * i) * N + n0 + tx];
  }
  __syncthreads();
  {
    const int kk = tid & 31, nn0 = tid >> 5;
#pragma unroll
    for (int i = 0; i < 4; ++i) Wt[(size_t)(n0 + nn0 + 16 * i) * K + k0 + kk] = f2bf(tile[kk][nn0 + 16 * i]);
  }
}
DI void phase_transposes(const P& p, char* smem) {
  constexpr int I0 = (INW / 64) * 32, I1 = I0 + 32 * 32, I2 = I1 + 16 * 32, I3 = I2 + 16 * 16, I4 = I3 + 16 * 8;
  for (int item = blockIdx.x; item < I4; item += gridDim.x) {
    if (item < I0) transpose_tile(p.w_in, (ushort_t*)(p.ws + OFF_WIN_T), 1024, INW, item, smem);
    else if (item < I1) transpose_tile(p.wq, (ushort_t*)(p.ws + OFF_WQ_T), 1024, 2048, item - I0, smem);
    else if (item < I2) transpose_tile(p.w_out, (ushort_t*)(p.ws + OFF_WOUT_T), 1024, 1024, item - I1, smem);
    else if (item < I3) transpose_tile(p.w_bh, (ushort_t*)(p.ws + OFF_WBH_T), 512, 1024, item - I2, smem);
    else transpose_tile(p.w_ba, (ushort_t*)(p.ws + OFF_WBA_T), 256, 1024, item - I3, smem);
  }
}

DI void phase_filter(const P& p, char* smem) {
  float (*zf)[33] = (float (*)[33])smem;
  float (*h1)[64] = (float (*)[64])(smem + 4352);
  float (*h2T)[32] = (float (*)[32])(smem + 4352 + 8192);
  const int tid = tid_opaque();
  for (int item = blockIdx.x; item < 256; item += gridDim.x) {
  const int t0 = item * 32;
  __syncthreads();
  for (int idx = tid; idx < 32 * 33; idx += NT) {
    int tt = idx / 33, e = idx % 33, t = t0 + tt;
    float tl = (float)t * (1.0f / 8191.0f);
    float w = 6.283185307179586f * (float)t / 8192.0f;
    float val;
    if (e == 0) val = tl;
    else {
      int i = (e - 1) & 15;
      float f = 1e-4f + (float)i * ((15.0f - 1e-4f) / 15.0f);
      val = (e <= 16) ? cosf(f * w) : -sinf(f * w);
    }
    zf[tt][e] = val;
  }
  __syncthreads();
  for (int idx = tid; idx < 32 * 64; idx += NT) {
    int tt = idx >> 6, j = idx & 63;
    float a = p.f1_b[j];
    for (int e = 0; e < 33; ++e) a += zf[tt][e] * p.f1_w[e * 64 + j];
    h1[tt][j] = sinf(p.f1_freq[j] * a);
  }
  __syncthreads();
  for (int idx = tid; idx < 32 * 64; idx += NT) {
    int tt = idx >> 6, j = idx & 63;
    float a = p.f2_b[j];
    for (int e = 0; e < 64; ++e) a += h1[tt][e] * p.f2_w[e * 64 + j];
    h2T[j][tt] = sinf(p.f2_freq[j] * a);
  }
  __syncthreads();
  float* filt = p.out;
  const float min_decay = -3.0701134573253945f, max_decay = -15.350567286626973f;
  for (int col = tid; col < 2048; col += NT) {
    float acc[32];
#pragma unroll
    for (int i = 0; i < 32; ++i) acc[i] = 0.f;
    for (int j = 0; j < 64; ++j) {
      float w = p.f3_w[j * 2048 + col];
#pragma unroll
      for (int q = 0; q < 8; ++q) {
        f32x4 h = *(const f32x4*)&h2T[j][q * 4];
        acc[q * 4 + 0] += h[0] * w; acc[q * 4 + 1] += h[1] * w; acc[q * 4 + 2] += h[2] * w; acc[q * 4 + 3] += h[3] * w;
      }
    }
    int c = col & 511;
    float delta = fabsf(min_decay + (float)c * ((max_decay - min_decay) / 511.0f));
    float* dst = filt + (size_t)col * 8192 + t0;
#pragma unroll
    for (int q = 0; q < 8; ++q) {
      f32x4 o;
#pragma unroll
      for (int r = 0; r < 4; ++r) {
        float tl = (float)(t0 + q * 4 + r) * (1.0f / 8191.0f);
        o[r] = acc[q * 4 + r] * __expf(-tl * delta);
      }
      *(f32x4*)(dst + q * 4) = o;
    }
  }
  }
}

constexpr int BM = 256, BN = 128, BK = 64;
constexpr int LDS_A = BM * BK * 2, LDS_B = BN * BK * 2, LDS_STAGE = LDS_A + LDS_B;
constexpr int GEMM_LDS = 2 * LDS_STAGE + 8192;

DI int swz(int row, int ch) { return row * 128 + ((ch ^ (row & 7)) << 4); }

struct ALoadBf16 {
  const ushort_t* A; int lda;
  struct Raw { u32x4 v; };
  DI Raw fetch(int row, int k) const { Raw r; r.v = *(const u32x4*)(A + (size_t)row * lda + k); return r; }
  DI u32x4 cvt(const Raw& r, int k) const { return r.v; }
};
struct ALoadF32Mod {
  const float* A; const float* mod;
  struct Raw { f32x4 a, b; };
  DI Raw fetch(int row, int k) const { Raw r; const float* s = A + (size_t)row * 1024 + k; r.a = *(const f32x4*)s; r.b = *(const f32x4*)(s + 4); return r; }
  DI u32x4 cvt(const Raw& r, int k) const {
    f32x4 s0 = *(const f32x4*)(mod + k), s1 = *(const f32x4*)(mod + k + 4);
    f32x4 h0 = *(const f32x4*)(mod + 1024 + k), h1 = *(const f32x4*)(mod + 1024 + k + 4);
    u32x4 o;
    o[0] = pack2(r.a[0] * s0[0] + h0[0], r.a[1] * s0[1] + h0[1]);
    o[1] = pack2(r.a[2] * s0[2] + h0[2], r.a[3] * s0[3] + h0[3]);
    o[2] = pack2(r.b[0] * s1[0] + h1[0], r.b[1] * s1[1] + h1[1]);
    o[3] = pack2(r.b[2] * s1[2] + h1[2], r.b[3] * s1[3] + h1[3]);
    return o;
  }
};

template <class AL, bool SWAP = false>
DI void gemm_mainloop(f32x16 (&acc)[2][2], const AL& al, int m0, const ushort_t* __restrict__ Bt, int ldb, int n0, int K, char* smem) {
  const int tid = tid_opaque(), lane = tid & 63, wave = tid >> 6;
  const int wm = wave >> 1, wn = wave & 1;
  const int lr = tid >> 3, lc = tid & 7;
  typename AL::Raw ra[4]; u32x4 rb[2];
  const int nk = K / BK;
#pragma unroll
  for (int i = 0; i < 4; ++i) ra[i] = al.fetch(m0 + lr + 64 * i, lc * 8);
#pragma unroll
  for (int i = 0; i < 2; ++i) rb[i] = *(const u32x4*)(Bt + (size_t)(n0 + lr + 64 * i) * ldb + lc * 8);
  __syncthreads();
#pragma unroll
  for (int i = 0; i < 4; ++i) *(u32x4*)(smem + swz(lr + 64 * i, lc)) = al.cvt(ra[i], lc * 8);
#pragma unroll
  for (int i = 0; i < 2; ++i) *(u32x4*)(smem + LDS_A + swz(lr + 64 * i, lc)) = rb[i];
  __syncthreads();
  for (int kt = 0; kt < nk; ++kt) {
    char* cur = smem + (kt & 1) * LDS_STAGE;
    char* nxt = smem + ((kt + 1) & 1) * LDS_STAGE;
    const bool more = (kt + 1 < nk);
    const int kn = (kt + 1) * BK + lc * 8;
    if (more) {
#pragma unroll
      for (int i = 0; i < 4; ++i) ra[i] = al.fetch(m0 + lr + 64 * i, kn);
#pragma unroll
      for (int i = 0; i < 2; ++i) rb[i] = *(const u32x4*)(Bt + (size_t)(n0 + lr + 64 * i) * ldb + kn);
    }
#pragma unroll
    for (int s = 0; s < 4; ++s) {
      const int ch = 2 * s + (lane >> 5);
      bf16x8 af[2], bfr[2];
#pragma unroll
      for (int mi = 0; mi < 2; ++mi) af[mi] = *(const bf16x8*)(cur + swz(wm * 64 + mi * 32 + (lane & 31), ch));
#pragma unroll
      for (int ni = 0; ni < 2; ++ni) bfr[ni] = *(const bf16x8*)(cur + LDS_A + swz(wn * 64 + ni * 32 + (lane & 31), ch));
#pragma unroll
      for (int mi = 0; mi < 2; ++mi)
#pragma unroll
        for (int ni = 0; ni < 2; ++ni)
          acc[mi][ni] = SWAP ? __builtin_amdgcn_mfma_f32_32x32x16_bf16(bfr[ni], af[mi], acc[mi][ni], 0, 0, 0)
                             : __builtin_amdgcn_mfma_f32_32x32x16_bf16(af[mi], bfr[ni], acc[mi][ni], 0, 0, 0);
    }
    if (more) {
#pragma unroll
      for (int i = 0; i < 4; ++i) *(u32x4*)(nxt + swz(lr + 64 * i, lc)) = al.cvt(ra[i], kn);
#pragma unroll
      for (int i = 0; i < 2; ++i) *(u32x4*)(nxt + LDS_A + swz(lr + 64 * i, lc)) = rb[i];
    }
    __syncthreads();
  }
}

constexpr int AT_ROW = 576;
constexpr int LDS_AT = 64 * AT_ROW;
constexpr int LDS_STAGE_T = LDS_AT + LDS_B;
typedef __attribute__((ext_vector_type(4))) short s16x4;
DI void gemm_mainloop_AT(f32x16 (&acc)[2][2], const ushort_t* __restrict__ At, size_t ldt, const ushort_t* __restrict__ Bt, int ldb, int n0, int K, char* smem) {
  const int tid = tid_opaque(), lane = tid & 63, wave = tid >> 6;
  const int wm = wave >> 1, wn = wave & 1;
  const int lr = tid >> 3, lc = tid & 7;
  u32x4 ra[4], rb[2];
  const int nk = K / BK;
#pragma unroll
  for (int i = 0; i < 4; ++i) { const int q = tid + 512 * i; ra[i] = *(const u32x4*)(At + (size_t)(q >> 5) * ldt + (q & 31) * 8); }
#pragma unroll
  for (int i = 0; i < 2; ++i) rb[i] = *(const u32x4*)(Bt + (size_t)(n0 + lr + 64 * i) * ldb + lc * 8);
  __syncthreads();
#pragma unroll
  for (int i = 0; i < 4; ++i) { const int q = tid + 512 * i; *(u32x4*)(smem + (q >> 5) * AT_ROW + (q & 31) * 16) = ra[i]; }
#pragma unroll
  for (int i = 0; i < 2; ++i) *(u32x4*)(smem + LDS_AT + swz(lr + 64 * i, lc)) = rb[i];
  __syncthreads();
  const int hh = lane >> 5, gg = (lane >> 4) & 1, qq = (lane & 15) >> 2, pp = lane & 3;
  for (int kt = 0; kt < nk; ++kt) {
    char* cur = smem + (kt & 1) * LDS_STAGE_T;
    char* nxt = smem + ((kt + 1) & 1) * LDS_STAGE_T;
    const bool more = (kt + 1 < nk);
    if (more) {
#pragma unroll
      for (int i = 0; i < 4; ++i) { const int q = tid + 512 * i; ra[i] = *(const u32x4*)(At + (size_t)((kt + 1) * BK + (q >> 5)) * ldt + (q & 31) * 8); }
#pragma unroll
      for (int i = 0; i < 2; ++i) rb[i] = *(const u32x4*)(Bt + (size_t)(n0 + lr + 64 * i) * ldb + (kt + 1) * BK + lc * 8);
    }
#pragma unroll
    for (int s = 0; s < 4; ++s) {
      const int ch = 2 * s + hh;
      bf16x8 af[2], bfr[2];
#pragma unroll
      for (int mi = 0; mi < 2; ++mi) {
        const char* a0 = cur + (16 * s + 8 * hh + qq) * AT_ROW + (wm * 64 + mi * 32 + 16 * gg + 4 * pp) * 2;
        s16x4 lo = __builtin_amdgcn_ds_read_tr16_b64_v4i16((__attribute__((address_space(3))) s16x4*)(a0));
        s16x4 hi = __builtin_amdgcn_ds_read_tr16_b64_v4i16((__attribute__((address_space(3))) s16x4*)(a0 + 4 * AT_ROW));
        af[mi] = __builtin_shufflevector(lo, hi, 0, 1, 2, 3, 4, 5, 6, 7);
      }
#pragma unroll
      for (int ni = 0; ni < 2; ++ni) bfr[ni] = *(const bf16x8*)(cur + LDS_AT + swz(wn * 64 + ni * 32 + (lane & 31), ch));
#pragma unroll
      for (int mi = 0; mi < 2; ++mi)
#pragma unroll
        for (int ni = 0; ni < 2; ++ni) acc[mi][ni] = __builtin_amdgcn_mfma_f32_32x32x16_bf16(af[mi], bfr[ni], acc[mi][ni], 0, 0, 0);
    }
    if (more) {
#pragma unroll
      for (int i = 0; i < 4; ++i) { const int q = tid + 512 * i; *(u32x4*)(nxt + (q >> 5) * AT_ROW + (q & 31) * 16) = ra[i]; }
#pragma unroll
      for (int i = 0; i < 2; ++i) *(u32x4*)(nxt + LDS_AT + swz(lr + 64 * i, lc)) = rb[i];
    }
    __syncthreads();
  }
}
DI void acc_zero(f32x16 (&acc)[2][2]) {
#pragma unroll
  for (int a = 0; a < 2; ++a)
#pragma unroll
    for (int b = 0; b < 2; ++b)
#pragma unroll
      for (int r = 0; r < 16; ++r) acc[a][b][r] = 0.f;
}
#define ACC_ROW(mi, r) (wm * 64 + (mi) * 32 + ((r) & 3) + 8 * ((r) >> 2) + 4 * (lane >> 5))
#define ACC_COL(ni) (wn * 64 + (ni) * 32 + (lane & 31))

DI void stage_mod(float* mod, const float* ada, int b, int sc_chunk, int sh_chunk) {
  for (int i = tid_opaque(); i < 1024; i += NT) {
    mod[i] = 1.f + ada[b * 6144 + sc_chunk * 1024 + i];
    mod[1024 + i] = ada[b * 6144 + sh_chunk * 1024 + i];
  }
}

DI void phase_inproj(const P& p, char* smem) {
  const float* ada = (const float*)(p.ws + OFF_ADA);
  float* mod = (float*)(smem + 2 * LDS_STAGE);
  const ushort_t* wt = (const ushort_t*)(p.ws + OFF_WIN_T);
  ushort_t* ph = (ushort_t*)(p.ws + OFF_PH);
  ushort_t* qkv = (ushort_t*)(p.ws + OFF_QKV);
  ushort_t* gate = (ushort_t*)(p.ws + OFF_GATE);
  const int tid = tid_opaque(), lane = tid & 63, wave = tid >> 6, wm = wave >> 1, wn = wave & 1;
  constexpr int NTN = INW / BN;
  constexpr int NTM = T_ / BM;
  for (int tile = blockIdx.x; tile < NTM * NTN; tile += gridDim.x) {
    const int tm = tile / NTN, tn = tile % NTN;
    const int m0 = tm * BM, n0 = tn * BN, b = m0 / S_;
    __syncthreads();
    stage_mod(mod, ada, b, 1, 0);
    __syncthreads();
    f32x16 acc[2][2]; acc_zero(acc);
    ALoadF32Mod al{p.x, mod};
    if (n0 < HYC) {
      gemm_mainloop<ALoadF32Mod, true>(acc, al, m0, wt, 1024, n0, 1024, smem);
#pragma unroll
      for (int mi = 0; mi < 2; ++mi) {
        const int t = (m0 & (S_ - 1)) + wm * 64 + mi * 32 + (lane & 31);
#pragma unroll
        for (int ni = 0; ni < 2; ++ni)
#pragma unroll
          for (int r = 0; r < 16; ++r) {
            const int ch = n0 + wn * 64 + ni * 32 + (r & 3) + 8 * (r >> 2) + 4 * (lane >> 5);
            ph[((size_t)(b * HYC + ch)) * S_ + t] = f2bf(acc[mi][ni][r]);
          }
      }
      continue;
    }
    gemm_mainloop(acc, al, m0, wt, 1024, n0, 1024, smem);
#pragma unroll
    for (int ni = 0; ni < 2; ++ni) {
      const int col = n0 + ACC_COL(ni);
#pragma unroll
      for (int mi = 0; mi < 2; ++mi) {
        if (col < HYC + QKVC) {
          const int cq = col - HYC;
          const bool rot = (cq < 1536) && ((cq & 63) < 16);
          const float qs = (cq < 768) ? 0.125f : 1.0f;
          const float inv = expf(-13.122363377404328f * (float)(cq & 7) * 0.125f);
#pragma unroll
          for (int r = 0; r < 16; ++r) {
            const int row = m0 + ACC_ROW(mi, r);
            float v = acc[mi][ni][r];
            float o = __shfl_xor(v, 8);
            if (rot) {
              float ang = (float)p.pos[row] * inv;
              float sn, cs; sincosf(ang, &sn, &cs);
              v = ((cq & 15) < 8) ? (v * cs - o * sn) : (v * cs + o * sn);
            }
            qkv[(size_t)row * QKVC + cq] = f2bf(v * qs);
          }
        } else {
          const int cg = col - HYC - QKVC;
#pragma unroll
          for (int r = 0; r < 16; ++r) {
            float v = acc[mi][ni][r];
            gate[(size_t)(m0 + ACC_ROW(mi, r)) * GATEC + cg] = f2bf(1.f / (1.f + __expf(-v)));
          }
        }
      }
    }
  }
}

DI float sconv_t(const ushort_t* row, int t, float w0, float w1, float w2, float cb) {
  float v = cb + w1 * bf2f(row[t]);
  if (t > 0) v += w0 * bf2f(row[t - 1]);
  if (t < S_ - 1) v += w2 * bf2f(row[t + 1]);
  return v;
}
DI void fft_C_mul_invC(cf2* lds, const cf2* __restrict__ kq, int tid) {
  asm volatile("" : "+v"(tid));
  const int k1 = tid >> 5, k2 = tid & 31;
  kq += tid;
#pragma unroll
  for (int h = 0; h < 2; ++h) {
    float tr[16], ti[16];
    cf2 kv[16];
#pragma unroll
    for (int i = 0; i < 16; ++i) kv[i] = kq[(h * 16 + i) * 512];
    cf2* blk = lds + (k1 + 16 * h) * FFT_SA + k2 * 17;
#pragma unroll
    for (int mp = 0; mp < 16; ++mp) { cf2 v = blk[mp]; tr[mp] = v.x; ti[mp] = v.y; }
    dft_fwd<16, false>(tr, ti);
#pragma unroll
    for (int i = 0; i < 16; ++i) { const float a = tr[i], b = ti[i]; tr[i] = a * kv[i].x - b * kv[i].y; ti[i] = a * kv[i].y + b * kv[i].x; }
    dft_inv<16>(tr, ti);
#pragma unroll
    for (int mp = 0; mp < 16; ++mp) { cf2 o; o.x = tr[mp]; o.y = ti[mp]; blk[mp] = o; }
  }
}
DI void hyena_item(const P& p, char* smem, int c) {
  cf2* lds = (cf2*)smem;
  const ushort_t* pht = (const ushort_t*)(p.ws + OFF_PH);
  ushort_t* yht = (ushort_t*)(p.ws + OFF_YH);
  cf2* kq = (cf2*)(p.ws + (blockIdx.x < 92 ? OFF_WIN_T + (size_t)blockIdx.x * 131072 : OFF_HSCR + (size_t)(blockIdx.x - 92) * 131072));
  const float* filt = p.out;
  const int tid0 = tid_opaque();
  float zr[32], zi[32];
  __syncthreads();
#pragma unroll 1
  for (int o = 0; o < 2; ++o) {
    int tid = tid0; asm volatile("" : "+v"(tid));
    {
      float kr[32], ki[32];
      const float* fw = filt + (size_t)(0 * 1024 + o * 512 + c) * S_;
      const float* bw = filt + (size_t)(1 * 1024 + o * 512 + c) * S_;
      const float bias = p.hy_bias[o * 512 + c];
#pragma unroll
      for (int n1 = 0; n1 < 16; ++n1) { kr[n1] = fw[n1 * 512 + tid] * (1.0f / 16384.0f); ki[n1] = 0.f; }
      if (tid == 0) kr[0] += bias * (1.0f / 16384.0f);
#pragma unroll
      for (int n1 = 16; n1 < 32; ++n1) {
        const int n = n1 * 512 + tid;
        kr[n1] = (n == S_) ? 0.f : bw[2 * S_ - n] * (1.0f / 16384.0f); ki[n1] = 0.f;
      }
      fft_fwdA<false>(kr, ki, lds, tid); __syncthreads();
      fft_B_read(kr, ki, lds, tid); __syncthreads();
      fft_fwdB_write(kr, ki, lds, tid); __syncthreads();
      fft_fwdC(kr, ki, lds, tid);
      int ts = tid; asm volatile("" : "+v"(ts));
      cf2* kqt = kq + ts;
#pragma unroll
      for (int r = 0; r < 32; ++r) { cf2 v; v.x = kr[r]; v.y = ki[r]; kqt[r * 512] = v; }
      __syncthreads();
    }
    asm volatile("" : "+v"(tid));
    if (o == 0) {
      const float w0 = p.hy_conv_w[c], w1 = p.hy_conv_w[HYC + c], w2 = p.hy_conv_w[2 * HYC + c], cb = p.hy_conv_b[c];
      const ushort_t* r0 = pht + (size_t)(0 * HYC + c) * S_;
      const ushort_t* r1 = pht + (size_t)(1 * HYC + c) * S_;
#pragma unroll
      for (int n1 = 0; n1 < 16; ++n1) {
        const int t = n1 * 512 + tid;
        zr[n1] = sconv_t(r0, t, w0, w1, w2, cb); zi[n1] = sconv_t(r1, t, w0, w1, w2, cb);
        if (n1 & 1) asm volatile("" ::: "memory");
      }
    }
#pragma unroll
    for (int n1 = 16; n1 < 32; ++n1) { zr[n1] = 0.f; zi[n1] = 0.f; }
    fft_fwdA<true>(zr, zi, lds, tid); __syncthreads();
    fft_B_read(zr, zi, lds, tid); __syncthreads();
    fft_fwdB_write(zr, zi, lds, tid); __syncthreads();
    fft_C_mul_invC(lds, kq, tid); __syncthreads();
    fft_invB_read(zr, zi, lds, tid); __syncthreads();
    fft_invB_write(zr, zi, lds, tid); __syncthreads();
    fft_invA(zr, zi, lds, tid);
    int tg = tid; asm volatile("" : "+v"(tg));
    const int gch = (o + 1) * 512 + c;
    const float w0 = p.hy_conv_w[gch], w1 = p.hy_conv_w[HYC + gch], w2 = p.hy_conv_w[2 * HYC + gch], cb = p.hy_conv_b[gch];
    const ushort_t* g0 = pht + (size_t)(0 * HYC + gch) * S_;
    const ushort_t* g1 = pht + (size_t)(1 * HYC + gch) * S_;
#pragma unroll
    for (int n1 = 0; n1 < 16; ++n1) {
      const int t = n1 * 512 + tg;
      zr[n1] *= sconv_t(g0, t, w0, w1, w2, cb);
      zi[n1] *= sconv_t(g1, t, w0, w1, w2, cb);
      if (n1 & 1) asm volatile("" ::: "memory");
    }
    if (o == 1) {
#pragma unroll
      for (int n1 = 0; n1 < 16; ++n1) {
        const int t = n1 * 512 + tg;
        yht[(size_t)(0 * HW_ + c) * S_ + t] = f2bf(zr[n1]);
        yht[(size_t)(1 * HW_ + c) * S_ + t] = f2bf(zi[n1]);
      }
    }
  }
}

constexpr int ATT_VROW = 192;
constexpr int ATT_VBUF = 32 * ATT_VROW;
DI void attn_item(const P& p, char* smem, int item) {
  const ushort_t* qkv = (const ushort_t*)(p.ws + OFF_QKV);
  ushort_t* ya = (ushort_t*)(p.ws + OFF_YA);
  const int tid = tid_opaque(), lane = tid & 63, wave = tid >> 6;
  const int u = item * 8 + wave;
  const int hs = u & 3, r16 = (u >> 2) & 15, chunk = (u >> 6) & 15, b = u >> 10;
  const int qi = lane & 31, h = lane >> 5;
  char* vl = smem + wave * ATT_VBUF;
  const int tq = chunk * 512 + r16 + 16 * qi;
  const size_t bbase = (size_t)b * S_;
  f32x16 o0, o1;
#pragma unroll
  for (int r = 0; r < 16; ++r) { o0[r] = 0.f; o1[r] = 0.f; }
  float m = -1e30f, l = 0.f;
  const int g16 = (lane >> 4) & 1, q4 = (lane & 15) >> 2, p4 = lane & 3;
  __syncthreads();
#pragma unroll 1
  for (int g = 0; g < 3; ++g) {
    const int dsh = 2 * g;
    const int d = 1 << dsh, sd = 16 >> dsh, n = S_ >> dsh;
    const int head = g * 4 + hs;
    const int rc = r16 & (d - 1);
    const int P0 = (chunk * 512 + r16 - rc) >> dsh;
    const int pq = P0 + sd * qi;
    const int KB = P0 - 64;
    const int ntile = (g == 0) ? 20 : (g == 1 ? 8 : 5);
    bf16x8 bq[4];
    {
      const ushort_t* qrow = qkv + (bbase + tq) * QKVC + head * 64;
#pragma unroll
      for (int s = 0; s < 4; ++s) bq[s] = *(const bf16x8*)(qrow + (2 * s + h) * 8);
    }
    bf16x8 kn[4]; u32x4 vn[4];
    {
      const int kp = min(max(KB + qi, 0), n - 1);
      const ushort_t* krow = qkv + (bbase + rc + ((size_t)kp << dsh)) * QKVC + 768 + head * 64;
#pragma unroll
      for (int s = 0; s < 4; ++s) kn[s] = *(const bf16x8*)(krow + (2 * s + h) * 8);
#pragma unroll
      for (int i = 0; i < 4; ++i) {
        const int c = lane + 64 * i, row = c >> 3, ch = c & 7;
        const int vp = min(max(KB + row, 0), n - 1);
        vn[i] = *(const u32x4*)(qkv + (bbase + rc + ((size_t)vp << dsh)) * QKVC + 1536 + head * 64 + ch * 8);
      }
    }
#pragma unroll 1
    for (int kt = 0; kt < ntile; ++kt) {
      bf16x8 kc[4]; u32x4 vc[4];
#pragma unroll
      for (int s = 0; s < 4; ++s) kc[s] = kn[s];
#pragma unroll
      for (int i = 0; i < 4; ++i) vc[i] = vn[i];
      if (kt + 1 < ntile) {
        const int kb1 = KB + 32 * (kt + 1);
        const int kp = min(max(kb1 + qi, 0), n - 1);
        const ushort_t* krow = qkv + (bbase + rc + ((size_t)kp << dsh)) * QKVC + 768 + head * 64;
#pragma unroll
        for (int s = 0; s < 4; ++s) kn[s] = *(const bf16x8*)(krow + (2 * s + h) * 8);
#pragma unroll
        for (int i = 0; i < 4; ++i) {
          const int c = lane + 64 * i, row = c >> 3, ch = c & 7;
          const int vp = min(max(kb1 + row, 0), n - 1);
          vn[i] = *(const u32x4*)(qkv + (bbase + rc + ((size_t)vp << dsh)) * QKVC + 1536 + head * 64 + ch * 8);
        }
      }
      f32x16 st;
#pragma unroll
      for (int r = 0; r < 16; ++r) st[r] = 0.f;
#pragma unroll
      for (int s = 0; s < 4; ++s) st = __builtin_amdgcn_mfma_f32_32x32x16_bf16(kc[s], bq[s], st, 0, 0, 0);
#pragma unroll
      for (int i = 0; i < 4; ++i) { const int c = lane + 64 * i; *(u32x4*)(vl + (c >> 3) * ATT_VROW + (c & 7) * 16) = vc[i]; }
      const int kb = KB + 32 * kt + 4 * h;
      const int dk = kb - pq;
      float mx = -1e30f;
      bool ok[16];
#pragma unroll
      for (int r = 0; r < 16; ++r) {
        const int cr = (r & 3) + 8 * (r >> 2);
        ok[r] = ((unsigned)(dk + cr + 64) <= 128u) && ((unsigned)(kb + cr) < (unsigned)n);
        mx = fmaxf(mx, ok[r] ? st[r] : -1e30f);
      }
      mx = fmaxf(mx, __shfl_xor(mx, 32));
      const float mnew = fmaxf(m, mx);
      const float corr = __expf(m - mnew);
      float ps = 0.f;
      float pv[16];
#pragma unroll
      for (int r = 0; r < 16; ++r) { pv[r] = ok[r] ? __expf(st[r] - mnew) : 0.f; ps += pv[r]; }
      ps += __shfl_xor(ps, 32);
      l = l * corr + ps; m = mnew;
#pragma unroll
      for (int r = 0; r < 16; ++r) { o0[r] *= corr; o1[r] *= corr; }
      bf16x8 pf[2];
#pragma unroll
      for (int s = 0; s < 2; ++s) {
        u32x4 w;
        w[0] = pack2(pv[8 * s + 0], pv[8 * s + 1]); w[1] = pack2(pv[8 * s + 2], pv[8 * s + 3]);
        w[2] = pack2(pv[8 * s + 4], pv[8 * s + 5]); w[3] = pack2(pv[8 * s + 6], pv[8 * s + 7]);
        pf[s] = __builtin_bit_cast(bf16x8, w);
      }
      __builtin_amdgcn_wave_barrier();
      asm volatile("s_waitcnt lgkmcnt(0)" ::: "memory");
#pragma unroll
      for (int s = 0; s < 2; ++s) {
#pragma unroll
        for (int nt = 0; nt < 2; ++nt) {
          const char* a0 = vl + (16 * s + 4 * h + q4) * ATT_VROW + (32 * nt + 16 * g16 + 4 * p4) * 2;
          s16x4 lo = __builtin_amdgcn_ds_read_tr16_b64_v4i16((__attribute__((address_space(3))) s16x4*)(a0));
          s16x4 hi = __builtin_amdgcn_ds_read_tr16_b64_v4i16((__attribute__((address_space(3))) s16x4*)(a0 + 8 * ATT_VROW));
          const bf16x8 vf = __builtin_shufflevector(lo, hi, 0, 1, 2, 3, 4, 5, 6, 7);
          if (nt == 0) o0 = __builtin_amdgcn_mfma_f32_32x32x16_bf16(vf, pf[s], o0, 0, 0, 0);
          else o1 = __builtin_amdgcn_mfma_f32_32x32x16_bf16(vf, pf[s], o1, 0, 0, 0);
        }
      }
      __builtin_amdgcn_wave_barrier();
      asm volatile("s_waitcnt lgkmcnt(0)" ::: "memory");
    }
  }
  const float il = 1.f / l;
  ushort_t* op = ya + (bbase + tq) * 256 + hs * 64;
#pragma unroll
  for (int gq = 0; gq < 4; ++gq) {
    uint2 w0, w1;
    w0.x = pack2(o0[4 * gq] * il, o0[4 * gq + 1] * il); w0.y = pack2(o0[4 * gq + 2] * il, o0[4 * gq + 3] * il);
    w1.x = pack2(o1[4 * gq] * il, o1[4 * gq + 1] * il); w1.y = pack2(o1[4 * gq + 2] * il, o1[4 * gq + 3] * il);
    *(uint2*)(op + 8 * gq + 4 * h) = w0;
    *(uint2*)(op + 32 + 8 * gq + 4 * h) = w1;
  }
}

DI void phase_merge(const P& p, char* smem) {
  const ushort_t* yh = (const ushort_t*)(p.ws + OFF_YH);
  const ushort_t* ya = (const ushort_t*)(p.ws + OFF_YA);
  const ushort_t* gate = (const ushort_t*)(p.ws + OFF_GATE);
  ushort_t* merged = (ushort_t*)(p.ws + OFF_MERGED);
  const int tid = tid_opaque(), lane = tid & 63, wave = tid >> 6, wm = wave >> 1, wn = wave & 1;
  constexpr int NTN = 1024 / BN, NTM = T_ / BM;
  for (int tile = blockIdx.x; tile < NTM * NTN; tile += gridDim.x) {
    const int m0 = (tile / NTN) * BM, n0 = (tile % NTN) * BN;
    f32x16 a1[2][2], a2[2][2]; acc_zero(a1); acc_zero(a2);
    gemm_mainloop_AT(a1, yh + (size_t)((m0 / S_) * HW_) * S_ + (m0 & (S_ - 1)), (size_t)S_, (const ushort_t*)(p.ws + OFF_WBH_T), 512, n0, 512, smem);
    ALoadBf16 l2{ya, 256};
    gemm_mainloop(a2, l2, m0, (const ushort_t*)(p.ws + OFF_WBA_T), 256, n0, 256, smem);
#pragma unroll
    for (int mi = 0; mi < 2; ++mi)
#pragma unroll
      for (int ni = 0; ni < 2; ++ni)
#pragma unroll
        for (int r = 0; r < 16; ++r) {
          const int row = m0 + ACC_ROW(mi, r), col = n0 + ACC_COL(ni);
          float gh = bf2f(gate[(size_t)row * GATEC + col]), ga = bf2f(gate[(size_t)row * GATEC + 1024 + col]);
          merged[(size_t)row * 1024 + col] = f2bf(gh * a1[mi][ni][r] + ga * a2[mi][ni][r]);
        }
  }
}

DI void phase_outproj(const P& p, char* smem) {
  const float* ada = (const float*)(p.ws + OFF_ADA);
  const ushort_t* merged = (const ushort_t*)(p.ws + OFF_MERGED);
  const int tid = tid_opaque(), lane = tid & 63, wave = tid >> 6, wm = wave >> 1, wn = wave & 1;
  constexpr int NTN = 1024 / BN, NTM = T_ / BM;
  for (int tile = blockIdx.x; tile < NTM * NTN; tile += gridDim.x) {
    const int m0 = (tile / NTN) * BM, n0 = (tile % NTN) * BN, b = m0 / S_;
    f32x16 acc[2][2]; acc_zero(acc);
    ALoadBf16 l1{merged, 1024};
    gemm_mainloop(acc, l1, m0, (const ushort_t*)(p.ws + OFF_WOUT_T), 1024, n0, 1024, smem);
#pragma unroll
    for (int ni = 0; ni < 2; ++ni) {
      const int col = n0 + ACC_COL(ni);
      const float g1 = 1.f + ada[b * 6144 + 2 * 1024 + col];
#pragma unroll
      for (int mi = 0; mi < 2; ++mi)
#pragma unroll
        for (int r = 0; r < 16; ++r) {
          const size_t o = (size_t)(m0 + ACC_ROW(mi, r)) * 1024 + col;
          p.out[o] = DN_ALPHA * p.x[o] + g1 * acc[mi][ni][r];
        }
    }
  }
}

DI void phase_ln(float* __restrict__ xio, const float* __restrict__ g, const float* __restrict__ bta) {
  const int tq = tid_opaque(); const int lane = tq & 63, wave = tq >> 6;
  for (int row = blockIdx.x * 8 + wave; row < T_; row += gridDim.x * 8) {
    float* rp = xio + (size_t)row * 1024;
    f32x4 v[4];
    float s = 0.f;
#pragma unroll
    for (int i = 0; i < 4; ++i) { v[i] = *(const f32x4*)(rp + i * 256 + lane * 4); s += v[i][0] + v[i][1] + v[i][2] + v[i][3]; }
    const float mu = wave_sum(s) * (1.f / 1024.f);
    float q = 0.f;
#pragma unroll
    for (int i = 0; i < 4; ++i)
#pragma unroll
      for (int j = 0; j < 4; ++j) { float d = v[i][j] - mu; q += d * d; }
    const float rs = rsqrtf(wave_sum(q) * (1.f / 1024.f) + LN_EPS);
#pragma unroll
    for (int i = 0; i < 4; ++i) {
      f32x4 gg = *(const f32x4*)(g + i * 256 + lane * 4), bb = *(const f32x4*)(bta + i * 256 + lane * 4), o;
#pragma unroll
      for (int j = 0; j < 4; ++j) o[j] = (v[i][j] - mu) * rs * gg[j] + bb[j];
      *(f32x4*)(rp + i * 256 + lane * 4) = o;
    }
  }
}

DI int swz256(int row, int ch) { return row * 256 + ((ch ^ (row & 15)) << 4); }
DI void ins16(float (&L)[16], float x) {
#pragma unroll
  for (int i = 0; i < 16; ++i) { const float hi = __builtin_fmaxf(L[i], x); x = __builtin_fminf(L[i], x); L[i] = hi; }
}
DI void bitonic16_desc(float (&M)[16]) {
#pragma unroll
  for (int d = 8; d >= 1; d >>= 1)
#pragma unroll
    for (int i = 0; i < 16; ++i)
      if ((i & d) == 0) { const float a = M[i], b = M[i + d]; M[i] = __builtin_fmaxf(a, b); M[i + d] = __builtin_fminf(a, b); }
}
constexpr int ROUTE_Q_OFF = 0, ROUTE_K_OFF = 65536, ROUTE_IDX_OFF = 106496;
DI void phase_route(const P& p, char* smem) {
  const float* ada = (const float*)(p.ws + OFF_ADA);
  float* mod = (float*)(smem + 2 * LDS_STAGE);
  const ushort_t* keysb = (const ushort_t*)(p.ws + OFF_KEYS_B);
  int* idx = (int*)(p.ws + OFF_IDX);
  float* gv = (float*)(p.ws + OFF_GV);
  for (int item = blockIdx.x; item < (T_ / BM) * 8; item += gridDim.x) {
    const int tid = tid_opaque(), lane = tid & 63, wave = tid >> 6, wm = wave >> 1, wn = wave & 1;
    const int m0 = (item >> 3) * BM, hh = item & 7, b = m0 / S_;
    __syncthreads();
    stage_mod(mod, ada, b, 4, 3);
    __syncthreads();
    float L0[16];
#pragma unroll 1
    for (int pp = 0; pp < 2; ++pp) {
      const int hp = hh * 2 + pp;
      f32x16 acc[2][2]; acc_zero(acc);
      ALoadF32Mod al{p.out, mod};
      gemm_mainloop<ALoadF32Mod, true>(acc, al, m0, (const ushort_t*)(p.ws + OFF_WQ_T), 1024, hp * 128, 1024, smem);
#pragma unroll
      for (int mi = 0; mi < 2; ++mi) {
        const int tok = wm * 64 + mi * 32 + (lane & 31);
#pragma unroll
        for (int ni = 0; ni < 2; ++ni)
#pragma unroll
          for (int g = 0; g < 4; ++g) {
            const int ch = wn * 8 + ni * 4 + g;
            uint2 v; v.x = pack2(acc[mi][ni][4 * g], acc[mi][ni][4 * g + 1]); v.y = pack2(acc[mi][ni][4 * g + 2], acc[mi][ni][4 * g + 3]);
            *(uint2*)(smem + ROUTE_Q_OFF + swz256(tok, ch) + 8 * (lane >> 5)) = v;
          }
      }
#pragma unroll
      for (int i = 0; i < 4; ++i) {
        const int q = tid + 512 * i, row = q >> 4, ch = q & 15;
        *(u32x4*)(smem + ROUTE_K_OFF + swz256(row, ch)) = *(const u32x4*)(keysb + (size_t)hp * 16384 + row * 128 + ch * 8);
      }
      __syncthreads();
      f32x16 sc[4];
#pragma unroll
      for (int ks = 0; ks < 4; ++ks)
#pragma unroll
        for (int r = 0; r < 16; ++r) sc[ks][r] = 0.f;
#pragma unroll
      for (int s = 0; s < 8; ++s) {
        const int ch = 2 * s + (lane >> 5);
        const bf16x8 bq = *(const bf16x8*)(smem + ROUTE_Q_OFF + swz256(wave * 32 + (lane & 31), ch));
#pragma unroll
        for (int ks = 0; ks < 4; ++ks) {
          const bf16x8 ak = *(const bf16x8*)(smem + ROUTE_K_OFF + swz256(ks * 32 + (lane & 31), ch));
          sc[ks] = __builtin_amdgcn_mfma_f32_32x32x16_bf16(ak, bq, sc[ks], 0, 0, 0);
        }
      }
      float L[16];
#pragma unroll
      for (int i = 0; i < 16; ++i) L[i] = -3.0e38f;
      const unsigned hbit = (unsigned)(lane >> 5) << 2;
#pragma unroll
      for (int ks = 0; ks < 4; ++ks)
#pragma unroll
        for (int r = 0; r < 16; ++r) {
          const unsigned key = (unsigned)(ks * 32 + (r & 3) + 8 * (r >> 2)) | hbit;
          ins16(L, __uint_as_float((__float_as_uint(sc[ks][r]) & ~127u) | key));
        }
      {
        float M[16];
#pragma unroll
        for (int i = 0; i < 16; ++i) M[i] = __builtin_fmaxf(L[i], __shfl_xor(L[15 - i], 32));
        bitonic16_desc(M);
#pragma unroll
        for (int i = 0; i < 16; ++i) L[i] = M[i];
      }
      if (pp == 0) {
#pragma unroll
        for (int i = 0; i < 16; ++i) L0[i] = L[i];
      } else {
        unsigned char* ib = (unsigned char*)(smem + ROUTE_IDX_OFF) + tid * 32;
#pragma unroll
        for (int i = 0; i < 16; ++i) { ib[i] = (unsigned char)(__float_as_uint(L0[i]) & 127u); ib[16 + i] = (unsigned char)(__float_as_uint(L[i]) & 127u); }
        float F[16];
#pragma unroll
        for (int i = 0; i < 16; ++i) F[i] = -3.0e38f;
#pragma unroll
        for (int i = 0; i < 16; ++i) {
          const float ai = __uint_as_float(__float_as_uint(L0[i]) & ~127u);
#pragma unroll
          for (int j = 0; j < 16; ++j)
            if ((i + 1) * (j + 1) <= 16) {
              const float s = ai + __uint_as_float(__float_as_uint(L[j]) & ~127u);
              ins16(F, __uint_as_float((__float_as_uint(s) & ~255u) | (unsigned)(i * 16 + j)));
            }
        }
        const float mx = __uint_as_float(__float_as_uint(F[0]) & ~255u);
        float e[16], sum = 0.f;
#pragma unroll
        for (int k = 0; k < 16; ++k) { e[k] = __expf(__uint_as_float(__float_as_uint(F[k]) & ~255u) - mx); sum += e[k]; }
        const float inv = 1.f / sum;
        if (lane < 32) {
          const int tok = m0 + wave * 32 + lane;
          int* ip = idx + (size_t)tok * 128 + hh * 16;
          float* gp = gv + (size_t)tok * 128 + hh * 16;
#pragma unroll
          for (int k4 = 0; k4 < 4; ++k4) {
            int4 iv; f32x4 g4;
            int ee[4];
#pragma unroll
            for (int u = 0; u < 4; ++u) {
              const unsigned code = __float_as_uint(F[k4 * 4 + u]) & 255u;
              ee[u] = (int)ib[code >> 4] * 128 + (int)ib[16 + (code & 15u)];
              g4[u] = e[k4 * 4 + u] * inv;
            }
            iv.x = ee[0]; iv.y = ee[1]; iv.z = ee[2]; iv.w = ee[3];
            *(int4*)(ip + k4 * 4) = iv;
            *(f32x4*)(gp + k4 * 4) = g4;
          }
        }
      }
    }
  }
}

DI void phase_keys(const P& p) {
  ushort_t* keysb = (ushort_t*)(p.ws + OFF_KEYS_B);
  for (int i = blockIdx.x * NT + tid_opaque(); i < 16 * 128 * 128 / 4; i += gridDim.x * NT) {
    f32x4 v = *(const f32x4*)(p.keys + (size_t)i * 4);
    uint2 o; o.x = pack2(v[0], v[1]); o.y = pack2(v[2], v[3]);
    *(uint2*)(keysb + (size_t)i * 4) = o;
  }
}

typedef __bf16 bf16x2_t __attribute__((ext_vector_type(2)));
DI float dot2bf(unsigned a, unsigned b, float c) { return __builtin_amdgcn_fdot2_f32_bf16(__builtin_bit_cast(bf16x2_t, a), __builtin_bit_cast(bf16x2_t, b), c, false); }
DI void phase_ln1(const P& p) {
  const float* ada = (const float*)(p.ws + OFF_ADA);
  ushort_t* u2b = (ushort_t*)(p.ws + OFF_U2B);
  const int tq = tid_opaque(); const int lane = tq & 63, wave = tq >> 6;
  for (int row = blockIdx.x * 8 + wave; row < T_; row += gridDim.x * 8) {
    const int b = row / S_;
    float* rp = p.out + (size_t)row * 1024;
    f32x4 v[4];
    float s = 0.f;
#pragma unroll
    for (int i = 0; i < 4; ++i) { v[i] = *(const f32x4*)(rp + i * 256 + lane * 4); s += v[i][0] + v[i][1] + v[i][2] + v[i][3]; }
    const float mu = wave_sum(s) * (1.f / 1024.f);
    float q = 0.f;
#pragma unroll
    for (int i = 0; i < 4; ++i)
#pragma unroll
      for (int j = 0; j < 4; ++j) { float d = v[i][j] - mu; q += d * d; }
    const float rs = rsqrtf(wave_sum(q) * (1.f / 1024.f) + LN_EPS);
#pragma unroll
    for (int i = 0; i < 4; ++i) {
      const int col = i * 256 + lane * 4;
      f32x4 gg = *(const f32x4*)(p.ln1_g + col), bb = *(const f32x4*)(p.ln1_b + col), o;
      f32x4 sc = *(const f32x4*)(ada + b * 6144 + 4 * 1024 + col), sh = *(const f32x4*)(ada + b * 6144 + 3 * 1024 + col);
#pragma unroll
      for (int j = 0; j < 4; ++j) o[j] = (v[i][j] - mu) * rs * gg[j] + bb[j];
      *(f32x4*)(rp + col) = o;
      uint2 w; w.x = pack2(o[0] * (1.f + sc[0]) + sh[0], o[1] * (1.f + sc[1]) + sh[1]); w.y = pack2(o[2] * (1.f + sc[2]) + sh[2], o[3] * (1.f + sc[3]) + sh[3]);
      *(uint2*)(u2b + (size_t)row * 1024 + col) = w;
    }
  }
}
DI void phase_tabconv(const P& p) {
  ushort_t* tu = (ushort_t*)(p.ws + OFF_TABU);
  ushort_t* tv = (ushort_t*)(p.ws + OFF_TABV);
  const int tq = tid_opaque(); const int lane = tq & 63, wave = tq >> 6;
  for (int e = blockIdx.x * 8 + wave; e < 16384; e += gridDim.x * 8) {
#pragma unroll
    for (int i = 0; i < 4; ++i) {
      const int col = i * 256 + lane * 4;
      f32x4 a = *(const f32x4*)(p.pu + (size_t)e * 1024 + col);
      f32x4 c = *(const f32x4*)(p.pv + (size_t)e * 1024 + col);
      uint2 wa; wa.x = pack2(a[0], a[1]); wa.y = pack2(a[2], a[3]);
      uint2 wc; wc.x = pack2(c[0], c[1]); wc.y = pack2(c[2], c[3]);
      *(uint2*)(tu + (size_t)e * 1024 + col) = wa;
      const int slice = i * 4 + (lane >> 4);
      *(uint2*)(tv + ((size_t)slice * 16384 + e) * 64 + (lane & 15) * 4) = wc;
    }
  }
}

template <int CTRL> DI float dpp_f(float v) { return __int_as_float(__builtin_amdgcn_mov_dpp(__float_as_int(v), CTRL, 0xf, 0xf, false)); }
template <int CTRL> DI int dpp_shr0(int v) { return __builtin_amdgcn_update_dpp(0, v, CTRL, 0xf, 0xf, true); }
template <int I> DI int bcast16(int v) { return __builtin_amdgcn_mov_dpp(v, 0x150 + I, 0xf, 0xf, false); }
DI float row_sum16(float d) {
  d += dpp_f<0xB1>(d);
  d += dpp_f<0x4E>(d);
  d += dpp_f<0x141>(d);
  d += dpp_f<0x140>(d);
  return d;
}
DI void phase_upass(const P& p, char* smem) {
  const int* idx = (const int*)(p.ws + OFF_IDX);
  const float* gv = (const float*)(p.ws + OFF_GV);
  const ushort_t* u2b = (const ushort_t*)(p.ws + OFF_U2B);
  const char* tabu = (const char*)(p.ws + OFF_TABU);
  float* coef = (float*)(p.ws + OFF_COEF);
  const int tq = tid_opaque(); const int lane = tq & 63, wave = tq >> 6;
  const int g = lane >> 4, j = lane & 15;
  int4* lst = (int4*)smem + wave * 512 + g * 128;
  const int xg = blockIdx.x & 7, bi = blockIdx.x >> 3, nb = (gridDim.x - xg + 7) >> 3;
  __syncthreads();
#pragma unroll 1
  for (int pass = 0; pass < 2; ++pass) {
    const int part = xg + 8 * pass;
#pragma unroll 1
    for (int tb = (bi * 8 + wave) * 4; tb < T_; tb += nb * 32) {
      const int tok = tb + g;
      const int4 i0 = *(const int4*)(idx + (size_t)tb * 128 + lane * 8), i1 = *(const int4*)(idx + (size_t)tb * 128 + lane * 8 + 4);
      const f32x4 g0 = *(const f32x4*)(gv + (size_t)tb * 128 + lane * 8), g1 = *(const f32x4*)(gv + (size_t)tb * 128 + lane * 8 + 4);
      u32x4 xr[8];
#pragma unroll
      for (int c = 0; c < 8; ++c) xr[c] = *(const u32x4*)(u2b + (size_t)tok * 1024 + (j + 16 * c) * 8);
      const int ev[8] = {i0.x, i0.y, i0.z, i0.w, i1.x, i1.y, i1.z, i1.w};
      const float gg[8] = {g0[0], g0[1], g0[2], g0[3], g1[0], g1[1], g1[2], g1[3]};
      int cnt = 0;
#pragma unroll
      for (int i = 0; i < 8; ++i) cnt += ((ev[i] >> 10) == part) ? 1 : 0;
      int incl = cnt;
      incl += dpp_shr0<0x111>(incl); incl += dpp_shr0<0x112>(incl); incl += dpp_shr0<0x114>(incl); incl += dpp_shr0<0x118>(incl);
      const int ng = bcast16<15>(incl);
      int pos = incl - cnt;
#pragma unroll
      for (int i = 0; i < 8; ++i)
        if ((ev[i] >> 10) == part) { int4 en; en.x = ev[i]; en.y = __float_as_int(gg[i]); en.z = j * 8 + i; en.w = 0; lst[pos] = en; ++pos; }
      const int nmax = max(max(__builtin_amdgcn_readlane(ng, 0), __builtin_amdgcn_readlane(ng, 16)), max(__builtin_amdgcn_readlane(ng, 32), __builtin_amdgcn_readlane(ng, 48)));
      __builtin_amdgcn_wave_barrier();
      asm volatile("s_waitcnt lgkmcnt(0)" ::: "memory");
      u32x4 ra[8];
      {
        const unsigned e = (ng > 0) ? (unsigned)lst[0].x : 0u;
        const char* row = tabu + (size_t)e * 2048 + j * 16;
#pragma unroll
        for (int c = 0; c < 8; ++c) ra[c] = *(const u32x4*)(row + c * 256);
      }
#pragma unroll 1
      for (int it = 0; it < nmax; ++it) {
        u32x4 rn[8];
        {
          const unsigned e = (it + 1 < ng) ? (unsigned)lst[it + 1].x : 0u;
          const char* row = tabu + (size_t)e * 2048 + j * 16;
#pragma unroll
          for (int c = 0; c < 8; ++c) rn[c] = *(const u32x4*)(row + c * 256);
        }
        float a0 = 0.f, a1 = 0.f, a2 = 0.f, a3 = 0.f;
#pragma unroll
        for (int c = 0; c < 8; ++c) {
          a0 = dot2bf(ra[c][0], xr[c][0], a0); a1 = dot2bf(ra[c][1], xr[c][1], a1);
          a2 = dot2bf(ra[c][2], xr[c][2], a2); a3 = dot2bf(ra[c][3], xr[c][3], a3);
        }
        const float d = row_sum16((a0 + a1) + (a2 + a3));
        if (j == 0 && it < ng) ((int*)&lst[it])[3] = __float_as_int(d);
#pragma unroll
        for (int c = 0; c < 8; ++c) ra[c] = rn[c];
      }
      __builtin_amdgcn_wave_barrier();
      asm volatile("s_waitcnt lgkmcnt(0)" ::: "memory");
#pragma unroll 1
      for (int k = 0; k < nmax; k += 16) {
        if (k + j < ng) {
          const int4 en = lst[k + j];
          const float a = __int_as_float(en.w);
          coef[(size_t)tok * 128 + en.z] = __int_as_float(en.y) * 0.5f * a * (1.f + erff(a * 0.7071067811865475f));
        }
      }
      __builtin_amdgcn_wave_barrier();
      asm volatile("s_waitcnt lgkmcnt(0)" ::: "memory");
    }
  }
}

struct VHdr { int ea, eb, ca, cb; };
DI VHdr vp_hdr(const int* idx, const float* coef, int tok, int g, int cq) {
  VHdr h;
  h.ea = idx[(size_t)tok * 128 + g * 32 + cq]; h.eb = idx[(size_t)tok * 128 + g * 32 + 16 + cq];
  h.ca = __float_as_int(coef[(size_t)tok * 128 + g * 32 + cq]); h.cb = __float_as_int(coef[(size_t)tok * 128 + g * 32 + 16 + cq]);
  return h;
}
DI void vp_rows(uint2 (&va)[16], uint2 (&vb)[16], const VHdr& h, const char* tb) {
#define VP_STEP(I) { va[I] = *(const uint2*)(tb + (unsigned)bcast16<I>(h.ea) * 128u); vb[I] = *(const uint2*)(tb + (unsigned)bcast16<I>(h.eb) * 128u); }
  VP_STEP(0) VP_STEP(1) VP_STEP(2) VP_STEP(3) VP_STEP(4) VP_STEP(5) VP_STEP(6) VP_STEP(7)
  VP_STEP(8) VP_STEP(9) VP_STEP(10) VP_STEP(11) VP_STEP(12) VP_STEP(13) VP_STEP(14) VP_STEP(15)
#undef VP_STEP
}
DI void vp_coefs(float (&fa)[16], float (&fb)[16], const VHdr& h) {
#define VP_STEP(I) { fa[I] = __int_as_float(bcast16<I>(h.ca)); fb[I] = __int_as_float(bcast16<I>(h.cb)); }
  VP_STEP(0) VP_STEP(1) VP_STEP(2) VP_STEP(3) VP_STEP(4) VP_STEP(5) VP_STEP(6) VP_STEP(7)
  VP_STEP(8) VP_STEP(9) VP_STEP(10) VP_STEP(11) VP_STEP(12) VP_STEP(13) VP_STEP(14) VP_STEP(15)
#undef VP_STEP
}
DI void phase_vpass(const P& p) {
  const int* idx = (const int*)(p.ws + OFF_IDX);
  const float* coef = (const float*)(p.ws + OFF_COEF);
  const char* tabv = (const char*)(p.ws + OFF_TABV);
  float* f = (float*)(p.ws + OFF_F);
  const int tq = tid_opaque(); const int lane = tq & 63, wave = tq >> 6;
  const int g = lane >> 4, cq = lane & 15;
  const int xg = blockIdx.x & 7, bi = blockIdx.x >> 3, nb = (gridDim.x - xg + 7) >> 3;
  const int step = nb * 8;
#pragma unroll 1
  for (int pass = 0; pass < 2; ++pass) {
    const int slice = xg + 8 * pass;
    const char* tb = tabv + (size_t)slice * (16384 * 128) + cq * 8;
    int tok = bi * 8 + wave;
    if (tok >= T_) continue;
    VHdr hc = vp_hdr(idx, coef, tok, g, cq);
    VHdr hn = vp_hdr(idx, coef, min(tok + step, T_ - 1), g, cq);
    uint2 va[16], vb[16];
    vp_rows(va, vb, hc, tb);
#pragma unroll 1
    for (; tok < T_; tok += step) {
      const VHdr hnn = vp_hdr(idx, coef, min(tok + 2 * step, T_ - 1), g, cq);
      uint2 na[16], nb2[16];
      vp_rows(na, nb2, hn, tb);
      float fa[16], fb[16];
      vp_coefs(fa, fb, hc);
      float a0 = 0.f, a1 = 0.f, a2 = 0.f, a3 = 0.f;
#pragma unroll
      for (int i = 0; i < 16; ++i) {
        a0 += fa[i] * __uint_as_float(va[i].x << 16); a1 += fa[i] * __uint_as_float(va[i].x & 0xffff0000u);
        a2 += fa[i] * __uint_as_float(va[i].y << 16); a3 += fa[i] * __uint_as_float(va[i].y & 0xffff0000u);
        a0 += fb[i] * __uint_as_float(vb[i].x << 16); a1 += fb[i] * __uint_as_float(vb[i].x & 0xffff0000u);
        a2 += fb[i] * __uint_as_float(vb[i].y << 16); a3 += fb[i] * __uint_as_float(vb[i].y & 0xffff0000u);
      }
      a0 += __shfl_xor(a0, 16); a1 += __shfl_xor(a1, 16); a2 += __shfl_xor(a2, 16); a3 += __shfl_xor(a3, 16);
      a0 += __shfl_xor(a0, 32); a1 += __shfl_xor(a1, 32); a2 += __shfl_xor(a2, 32); a3 += __shfl_xor(a3, 32);
      if (g == 0) { f32x4 o; o[0] = a0; o[1] = a1; o[2] = a2; o[3] = a3; *(f32x4*)(f + (size_t)tok * 1024 + slice * 64 + cq * 4) = o; }
#pragma unroll
      for (int i = 0; i < 16; ++i) { va[i] = na[i]; vb[i] = nb2[i]; }
      hc = hn; hn = hnn;
    }
  }
}

DI void phase_ln2(const P& p) {
  const float* ada = (const float*)(p.ws + OFF_ADA);
  const float* f = (const float*)(p.ws + OFF_F);
  const int tq = tid_opaque(); const int lane = tq & 63, wave = tq >> 6;
  for (int tok = blockIdx.x * 8 + wave; tok < T_; tok += gridDim.x * 8) {
    const int b = tok / S_;
    float* rp = p.out + (size_t)tok * 1024;
    f32x4 acc[4];
    float sm = 0.f;
#pragma unroll
    for (int i = 0; i < 4; ++i) {
      const int col = i * 256 + lane * 4;
      f32x4 x1 = *(const f32x4*)(rp + col), ff = *(const f32x4*)(f + (size_t)tok * 1024 + col);
      f32x4 g2 = *(const f32x4*)(ada + b * 6144 + 5 * 1024 + col);
#pragma unroll
      for (int j = 0; j < 4; ++j) { acc[i][j] = DN_ALPHA * x1[j] + (1.f + g2[j]) * ff[j]; sm += acc[i][j]; }
    }
    const float mu = wave_sum(sm) * (1.f / 1024.f);
    float q = 0.f;
#pragma unroll
    for (int i = 0; i < 4; ++i)
#pragma unroll
      for (int j = 0; j < 4; ++j) { float d = acc[i][j] - mu; q += d * d; }
    const float rs = rsqrtf(wave_sum(q) * (1.f / 1024.f) + LN_EPS);
#pragma unroll
    for (int i = 0; i < 4; ++i) {
      const int col = i * 256 + lane * 4;
      f32x4 gg = *(const f32x4*)(p.ln2_g + col), bb = *(const f32x4*)(p.ln2_b + col), o;
#pragma unroll
      for (int j = 0; j < 4; ++j) o[j] = (acc[i][j] - mu) * rs * gg[j] + bb[j];
      *(f32x4*)(rp + col) = o;
    }
  }
}

constexpr int SMEM_BYTES = 143360;
__global__ void __launch_bounds__(NT) fwd_megakernel(P p) {
  __shared__ __attribute__((aligned(16))) char smem[SMEM_BYTES];
  cooperative_groups::grid_group grid = cooperative_groups::this_grid();
  phase_ada(p, smem);
  phase_transposes(p, smem);
  phase_keys(p);
  phase_filter(p, smem);
  grid.sync();
  phase_inproj(p, smem);
  grid.sync();
  for (int item = blockIdx.x; item < 512 + 256; item += gridDim.x) {
    if (item < 512) hyena_item(p, smem, item);
    else attn_item(p, smem, item - 512);
  }
  grid.sync();
  phase_merge(p, smem);
  grid.sync();
  phase_outproj(p, smem);
  grid.sync();
  phase_ln1(p);
  phase_tabconv(p);
  grid.sync();
  phase_route(p, smem);
  grid.sync();
  phase_upass(p, smem);
  grid.sync();
  phase_vpass(p);
  grid.sync();
  phase_ln2(p);
}

extern "C" void kernel_launch(void* const* d_in, const int* in_sizes, int n_in, void* d_out, int out_size, void* d_ws, size_t ws_size,
                              hipStream_t stream) {
  P p{};
  p.x = (const float*)d_in[0]; p.c = (const float*)d_in[1]; p.pos = (const int*)d_in[2];
  p.w_ada = (const float*)d_in[3]; p.b_ada = (const float*)d_in[4]; p.w_in = (const float*)d_in[5];
  p.hy_conv_w = (const float*)d_in[6]; p.hy_conv_b = (const float*)d_in[7];
  p.f1_w = (const float*)d_in[8]; p.f1_b = (const float*)d_in[9]; p.f1_freq = (const float*)d_in[10];
  p.f2_w = (const float*)d_in[11]; p.f2_b = (const float*)d_in[12]; p.f2_freq = (const float*)d_in[13];
  p.f3_w = (const float*)d_in[14]; p.hy_bias = (const float*)d_in[15];
  p.w_bh = (const float*)d_in[16]; p.w_ba = (const float*)d_in[17]; p.w_out = (const float*)d_in[18];
  p.ln1_g = (const float*)d_in[19]; p.ln1_b = (const float*)d_in[20];
  p.wq = (const float*)d_in[21]; p.keys = (const float*)d_in[22]; p.pu = (const float*)d_in[23]; p.pv = (const float*)d_in[24];
  p.ln2_g = (const float*)d_in[25]; p.ln2_b = (const float*)d_in[26];
  p.out = (float*)d_out; p.ws = (char*)d_ws;

  static int grid_blocks = 0;
  if (!grid_blocks) {
    int dev = 0, cus = 0, per_cu = 0;
    hipGetDevice(&dev);
    hipDeviceGetAttribute(&cus, hipDeviceAttributeMultiprocessorCount, dev);
    hipOccupancyMaxActiveBlocksPerMultiprocessor(&per_cu, fwd_megakernel, NT, 0);
    if (per_cu > 1) per_cu = 1;
    grid_blocks = cus * per_cu;
  }
  void* args[] = {&p};
  hipError_t e = hipLaunchCooperativeKernel((void*)fwd_megakernel, dim3(grid_blocks), dim3(NT), args, 0, stream);
  if (e != hipSuccess) fprintf(stderr, "cooperative launch failed: %s (grid %d)\n", hipGetErrorString(e), grid_blocks);
}
```

```cpp
#include <hip/hip_runtime.h>
#include <hip/hip_cooperative_groups.h>
#include <cstdio>
#include <cstdint>

#define DI __device__ __forceinline__
typedef unsigned short ushort_t;
typedef __attribute__((ext_vector_type(8))) short bf16x8;
typedef __attribute__((ext_vector_type(16))) float f32x16;
typedef __attribute__((ext_vector_type(4))) float f32x4;
typedef __attribute__((ext_vector_type(4))) unsigned u32x4;

constexpr int T_ = 16384, S_ = 8192, NB = 2, D_ = 1024;
constexpr int HW_ = 512, HYC = 1536, QKVC = 2304, GATEC = 2048, INW = 5888;
constexpr int NT = 512;
constexpr float DN_ALPHA = 1.189207115002721f;
constexpr float LN_EPS = 1e-5f;

constexpr size_t OFF_ADA   = 0;
constexpr size_t OFF_BAR   = 49152;
constexpr size_t OFF_KEYS_B= 65536;
constexpr size_t OFF_WIN_T = 65536 + 524288;
constexpr size_t OFF_WQ_T  = OFF_WIN_T + (size_t)INW * 1024 * 2;
constexpr size_t OFF_WOUT_T= OFF_WQ_T + (size_t)2048 * 1024 * 2;
constexpr size_t OFF_WBH_T = OFF_WOUT_T + (size_t)1024 * 1024 * 2;
constexpr size_t OFF_WBA_T = OFF_WBH_T + (size_t)1024 * 512 * 2;
constexpr size_t OFF_PH    = OFF_WBA_T + (size_t)1024 * 256 * 2;
constexpr size_t OFF_QKV   = OFF_PH + (size_t)T_ * HYC * 2;
constexpr size_t OFF_GATE  = OFF_QKV + (size_t)T_ * QKVC * 2;
constexpr size_t OFF_YH    = OFF_GATE + (size_t)T_ * GATEC * 2;
constexpr size_t OFF_YA    = OFF_YH + (size_t)T_ * HW_ * 2;
constexpr size_t OFF_END   = OFF_YA + (size_t)T_ * 256 * 2;
constexpr size_t OFF_MERGED= OFF_PH;
constexpr size_t OFF_U2B   = OFF_PH;
constexpr size_t OFF_TABU  = OFF_QKV;
constexpr size_t OFF_TABV  = OFF_QKV + (size_t)32 * 1048576;
constexpr size_t OFF_COEF  = OFF_QKV + (size_t)64 * 1048576;
constexpr size_t OFF_F     = OFF_QKV + (size_t)72 * 1048576;
static_assert(OFF_F + (size_t)64 * 1048576 <= OFF_YH, "peer buffers overflow the qkv+gate region");
constexpr size_t OFF_IDX   = OFF_YH;
constexpr size_t OFF_GV    = OFF_YH + (size_t)T_ * 128 * 4;
constexpr size_t OFF_HSCR  = OFF_END;
static_assert(OFF_HSCR + (size_t)164 * 131072 <= 268435456ull, "ws overflow");
static_assert((size_t)92 * 131072 <= (size_t)INW * 1024 * 2, "w_in^T region too small");

struct P {
  const float *x, *c; const int* pos;
  const float *w_ada, *b_ada, *w_in, *hy_conv_w, *hy_conv_b, *f1_w, *f1_b, *f1_freq, *f2_w, *f2_b, *f2_freq, *f3_w,
      *hy_bias, *w_bh, *w_ba, *w_out, *ln1_g, *ln1_b, *wq, *keys, *pu, *pv, *ln2_g, *ln2_b;
  float* out; char* ws;
};

DI ushort_t f2bf(float x) { unsigned u = __float_as_uint(x); u += 0x7fffu + ((u >> 16) & 1u); return (ushort_t)(u >> 16); }
DI float bf2f(ushort_t h) { return __uint_as_float(((unsigned)h) << 16); }
typedef __bf16 bf16x2_hw __attribute__((ext_vector_type(2)));
typedef float f32x2_hw __attribute__((ext_vector_type(2)));
DI unsigned pack2(float a, float b) { f32x2_hw v = {a, b}; return __builtin_bit_cast(unsigned, __builtin_convertvector(v, bf16x2_hw)); }
DI int tid_opaque() { int t = threadIdx.x; asm volatile("" : "+v"(t)); return t; }
DI float wave_sum(float v) {
#pragma unroll
  for (int o = 32; o > 0; o >>= 1) v += __shfl_xor(v, o);
  return v;
}

struct cf2 { float x, y; };
constexpr int FFT_N = 16384, FFT_SA = 560;

DI constexpr float wcos32(int j) {
  switch (j & 31) {
    case 0: return 1.0f; case 1: return 0.98078528040323043f; case 2: return 0.92387953251128674f; case 3: return 0.83146961230254524f;
    case 4: return 0.70710678118654752f; case 5: return 0.55557023301960218f; case 6: return 0.38268343236508978f; case 7: return 0.19509032201612825f;
    case 8: return 0.0f; case 9: return -0.19509032201612825f; case 10: return -0.38268343236508978f; case 11: return -0.55557023301960218f;
    case 12: return -0.70710678118654752f; case 13: return -0.83146961230254524f; case 14: return -0.92387953251128674f; case 15: return -0.98078528040323043f;
    case 16: return -1.0f; case 17: return -0.98078528040323043f; case 18: return -0.92387953251128674f; case 19: return -0.83146961230254524f;
    case 20: return -0.70710678118654752f; case 21: return -0.55557023301960218f; case 22: return -0.38268343236508978f; case 23: return -0.19509032201612825f;
    case 24: return 0.0f; case 25: return 0.19509032201612825f; case 26: return 0.38268343236508978f; case 27: return 0.55557023301960218f;
    case 28: return 0.70710678118654752f; case 29: return 0.83146961230254524f; case 30: return 0.92387953251128674f; default: return 0.98078528040323043f;
  }
}
DI constexpr float wsin32(int j) { return wcos32(j + 24); }
DI constexpr int brev(int v, int bits) { int r = 0; for (int i = 0; i < bits; ++i) r |= ((v >> i) & 1) << (bits - 1 - i); return r; }

template <int R, int LEN, bool INV, bool ZHI>
DI void r2_stage(float (&re)[R], float (&im)[R]) {
  constexpr int half = LEN / 2;
#pragma unroll
  for (int start = 0; start < R; start += LEN) {
#pragma unroll
    for (int j = 0; j < half; ++j) {
      const int a = start + j, b = a + half;
      const int tj = j * (32 / LEN);
      const float c = wcos32(tj), s = wsin32(tj);
      if (!INV) {
        float dr, di;
        if (ZHI) { dr = re[a]; di = im[a]; }
        else {
          const float ar = re[a], ai = im[a], br = re[b], bi = im[b];
          re[a] = ar + br; im[a] = ai + bi; dr = ar - br; di = ai - bi;
        }
        if (tj == 0) { re[b] = dr; im[b] = di; }
        else if (tj == 8) { re[b] = di; im[b] = -dr; }
        else { re[b] = dr * c + di * s; im[b] = di * c - dr * s; }
      } else {
        const float br = re[b], bi = im[b];
        float pr, pi;
        if (tj == 0) { pr = br; pi = bi; }
        else if (tj == 8) { pr = -bi; pi = br; }
        else { pr = br * c - bi * s; pi = bi * c + br * s; }
        const float ar = re[a], ai = im[a];
        re[a] = ar + pr; im[a] = ai + pi; re[b] = ar - pr; im[b] = ai - pi;
      }
    }
  }
}
template <int R, bool ZHI> DI void dft_fwd(float (&re)[R], float (&im)[R]) {
  if (R == 32) r2_stage<R, (R == 32 ? 32 : 2), false, ZHI>(re, im);
  r2_stage<R, 16, false, (R == 16) && ZHI>(re, im);
  r2_stage<R, 8, false, false>(re, im);
  r2_stage<R, 4, false, false>(re, im);
  r2_stage<R, 2, false, false>(re, im);
}
template <int R> DI void dft_inv(float (&re)[R], float (&im)[R]) {
  r2_stage<R, 2, true, false>(re, im);
  r2_stage<R, 4, true, false>(re, im);
  r2_stage<R, 8, true, false>(re, im);
  r2_stage<R, 16, true, false>(re, im);
  if (R == 32) r2_stage<R, (R == 32 ? 32 : 2), true, false>(re, im);
}

DI void sincos_turn(float frac, float& s, float& c) { sincospif(2.0f * frac, &s, &c); }

template <bool ZHI>
DI void fft_fwdA(float (&re)[32], float (&im)[32], cf2* lds, int m) {
  asm volatile("" : "+v"(m));
  float s1, c1; sincos_turn((float)m * (1.0f / 16384.0f), s1, c1);
  __builtin_amdgcn_sched_barrier(0);
  dft_fwd<32, ZHI>(re, im);
  __builtin_amdgcn_sched_barrier(0);
  float wr = 1.f, wi = 0.f;
#pragma unroll
  for (int k1 = 0; k1 < 32; ++k1) {
    if ((k1 & 3) == 0) __builtin_amdgcn_sched_barrier(0);
    const int r = brev(k1, 5);
    cf2 o; o.x = re[r] * wr - im[r] * wi; o.y = re[r] * wi + im[r] * wr;
    lds[k1 * FFT_SA + m] = o;
    const float nr = wr * c1 + wi * s1, ni = wi * c1 - wr * s1;
    wr = nr; wi = ni;
  }
}
DI void fft_B_read(float (&re)[32], float (&im)[32], const cf2* lds, int tid) {
  const int k1 = tid >> 4, mp = tid & 15;
#pragma unroll
  for (int n2 = 0; n2 < 32; ++n2) { cf2 v = lds[k1 * FFT_SA + n2 * 16 + mp]; re[n2] = v.x; im[n2] = v.y; }
}
DI void fft_fwdB_write(float (&re)[32], float (&im)[32], cf2* lds, int tid) {
  asm volatile("" : "+v"(tid));
  const int k1 = tid >> 4, mp = tid & 15;
  float s1, c1; sincos_turn((float)mp * (1.0f / 512.0f), s1, c1);
  __builtin_amdgcn_sched_barrier(0);
  dft_fwd<32, false>(re, im);
  __builtin_amdgcn_sched_barrier(0);
  float wr = 1.f, wi = 0.f;
#pragma unroll
  for (int k2 = 0; k2 < 32; ++k2) {
    if ((k2 & 3) == 0) __builtin_amdgcn_sched_barrier(0);
    const int r = brev(k2, 5);
    cf2 o; o.x = re[r] * wr - im[r] * wi; o.y = re[r] * wi + im[r] * wr;
    lds[k1 * FFT_SA + k2 * 17 + mp] = o;
    const float nr = wr * c1 + wi * s1, ni = wi * c1 - wr * s1;
    wr = nr; wi = ni;
  }
}
DI void fft_fwdC(float (&re)[32], float (&im)[32], const cf2* lds, int tid) {
  const int k1 = tid >> 5, k2 = tid & 31;
#pragma unroll
  for (int h = 0; h < 2; ++h) {
    float tr[16], ti[16];
#pragma unroll
    for (int mp = 0; mp < 16; ++mp) { cf2 v = lds[(k1 + 16 * h) * FFT_SA + k2 * 17 + mp]; tr[mp] = v.x; ti[mp] = v.y; }
    dft_fwd<16, false>(tr, ti);
#pragma unroll
    for (int i = 0; i < 16; ++i) { re[h * 16 + i] = tr[i]; im[h * 16 + i] = ti[i]; }
  }
}
DI void fft_invC(float (&re)[32], float (&im)[32], cf2* lds, int tid) {
  const int k1 = tid >> 5, k2 = tid & 31;
#pragma unroll
  for (int h = 0; h < 2; ++h) {
    float tr[16], ti[16];
#pragma unroll
    for (int i = 0; i < 16; ++i) { tr[i] = re[h * 16 + i]; ti[i] = im[h * 16 + i]; }
    dft_inv<16>(tr, ti);
#pragma unroll
    for (int mp = 0; mp < 16; ++mp) { cf2 o; o.x = tr[mp]; o.y = ti[mp]; lds[(k1 + 16 * h) * FFT_SA + k2 * 17 + mp] = o; }
  }
}
DI void fft_invB_read(float (&re)[32], float (&im)[32], const cf2* lds, int tid) {
  asm volatile("" : "+v"(tid));
  const int k1 = tid >> 4, mp = tid & 15;
  float s1, c1; sincos_turn((float)mp * (1.0f / 512.0f), s1, c1);
  float wr = 1.f, wi = 0.f;
  __builtin_amdgcn_sched_barrier(0);
#pragma unroll
  for (int k2 = 0; k2 < 32; ++k2) {
    if ((k2 & 3) == 0) __builtin_amdgcn_sched_barrier(0);
    const int r = brev(k2, 5);
    cf2 v = lds[k1 * FFT_SA + k2 * 17 + mp];
    re[r] = v.x * wr - v.y * wi; im[r] = v.x * wi + v.y * wr;
    const float nr = wr * c1 - wi * s1, ni = wi * c1 + wr * s1;
    wr = nr; wi = ni;
  }
}
DI void fft_invB_write(float (&re)[32], float (&im)[32], cf2* lds, int tid) {
  const int k1 = tid >> 4, mp = tid & 15;
  dft_inv<32>(re, im);
#pragma unroll
  for (int n2 = 0; n2 < 32; ++n2) { cf2 o; o.x = re[n2]; o.y = im[n2]; lds[k1 * FFT_SA + n2 * 16 + mp] = o; }
}
DI void fft_invA(float (&re)[32], float (&im)[32], const cf2* lds, int m) {
  asm volatile("" : "+v"(m));
  float s1, c1; sincos_turn((float)m * (1.0f / 16384.0f), s1, c1);
  float wr = 1.f, wi = 0.f;
  __builtin_amdgcn_sched_barrier(0);
#pragma unroll
  for (int k1 = 0; k1 < 32; ++k1) {
    if ((k1 & 3) == 0) __builtin_amdgcn_sched_barrier(0);
    const int r = brev(k1, 5);
    cf2 v = lds[k1 * FFT_SA + m];
    re[r] = v.x * wr - v.y * wi; im[r] = v.x * wi + v.y * wr;
    const float nr = wr * c1 - wi * s1, ni = wi * c1 + wr * s1;
    wr = nr; wi = ni;
  }
  __builtin_amdgcn_sched_barrier(0);
  dft_inv<32>(re, im);
}

DI void phase_ada(const P& p, char* smem) {
  float (*red)[8][64] = (float (*)[8][64])smem;
  const int tid = tid_opaque(), cl = tid & 63, kq = tid >> 6;
  for (int item = blockIdx.x; item < 96; item += gridDim.x) {
    const int col = item * 64 + cl;
    float a0 = 0.f, a1 = 0.f;
    for (int k = kq * 128; k < kq * 128 + 128; ++k) {
      float w = p.w_ada[(size_t)k * 6144 + col];
      float c0 = p.c[k], c1 = p.c[1024 + k];
      a0 += (c0 / (1.f + __expf(-c0))) * w;
      a1 += (c1 / (1.f + __expf(-c1))) * w;
    }
    __syncthreads();
    red[0][kq][cl] = a0; red[1][kq][cl] = a1;
    __syncthreads();
    if (tid < 128) {
      int b = tid >> 6;
      float s = p.b_ada[col];
#pragma unroll
      for (int q = 0; q < 8; ++q) s += red[b][q][cl];
      ((float*)(p.ws + OFF_ADA))[b * 6144 + col] = s;
    }
  }
}

DI void transpose_tile(const float* __restrict__ W, ushort_t* __restrict__ Wt, int K, int N, int item, char* smem) {
  float (*tile)[65] = (float (*)[65])smem;
  const int ntn = N / 64;
  const int n0 = (item % ntn) * 64, k0 = (item / ntn) * 32;
  const int tid = tid_opaque();
  __syncthreads();
  {
    const int tx = tid & 63, ty = tid >> 6;
#pragma unroll
    for (int i = 0; i < 4; ++i) tile[ty + 8 * i][tx] = W[(size_t)(k0 + ty + 8 * i) * N + n0 + tx];
  }
  __syncthreads();
  {
    const int kk = tid & 31, nn0 = tid >> 5;
#pragma unroll
    for (int i = 0; i < 4; ++i) Wt[(size_t)(n0 + nn0 + 16 * i) * K + k0 + kk] = f2bf(tile[kk][nn0 + 16 * i]);
  }
}
DI void phase_transposes(const P& p, char* smem) {
  constexpr int I0 = (INW / 64) * 32, I1 = I0 + 32 * 32, I2 = I1 + 16 * 32, I3 = I2 + 16 * 16, I4 = I3 + 16 * 8;
  for (int item = blockIdx.x; item < I4; item += gridDim.x) {
    if (item < I0) transpose_tile(p.w_in, (ushort_t*)(p.ws + OFF_WIN_T), 1024, INW, item, smem);
    else if (item < I1) transpose_tile(p.wq, (ushort_t*)(p.ws + OFF_WQ_T), 1024, 2048, item - I0, smem);
    else if (item < I2) transpose_tile(p.w_out, (ushort_t*)(p.ws + OFF_WOUT_T), 1024, 1024, item - I1, smem);
    else if (item < I3) transpose_tile(p.w_bh, (ushort_t*)(p.ws + OFF_WBH_T), 512, 1024, item - I2, smem);
    else transpose_tile(p.w_ba, (ushort_t*)(p.ws + OFF_WBA_T), 256, 1024, item - I3, smem);
  }
}

DI void phase_filter(const P& p, char* smem) {
  float (*zf)[33] = (float (*)[33])smem;
  float (*h1)[64] = (float (*)[64])(smem + 4352);
  float (*h2T)[32] = (float (*)[32])(smem + 4352 + 8192);
  const int tid = tid_opaque();
  for (int item = blockIdx.x; item < 256; item += gridDim.x) {
  const int t0 = item * 32;
  __syncthreads();
  for (int idx = tid; idx < 32 * 33; idx += NT) {
    int tt = idx / 33, e = idx % 33, t = t0 + tt;
    float tl = (float)t * (1.0f / 8191.0f);
    float w = 6.283185307179586f * (float)t / 8192.0f;
    float val;
    if (e == 0) val = tl;
    else {
      int i = (e - 1) & 15;
      float f = 1e-4f + (float)i * ((15.0f - 1e-4f) / 15.0f);
      val = (e <= 16) ? cosf(f * w) : -sinf(f * w);
    }
    zf[tt][e] = val;
  }
  __syncthreads();
  for (int idx = tid; idx < 32 * 64; idx += NT) {
    int tt = idx >> 6, j = idx & 63;
    float a = p.f1_b[j];
    for (int e = 0; e < 33; ++e) a += zf[tt][e] * p.f1_w[e * 64 + j];
    h1[tt][j] = sinf(p.f1_freq[j] * a);
  }
  __syncthreads();
  for (int idx = tid; idx < 32 * 64; idx += NT) {
    int tt = idx >> 6, j = idx & 63;
    float a = p.f2_b[j];
    for (int e = 0; e < 64; ++e) a += h1[tt][e] * p.f2_w[e * 64 + j];
    h2T[j][tt] = sinf(p.f2_freq[j] * a);
  }
  __syncthreads();
  float* filt = p.out;
  const float min_decay = -3.0701134573253945f, max_decay = -15.350567286626973f;
  for (int col = tid; col < 2048; col += NT) {
    float acc[32];
#pragma unroll
    for (int i = 0; i < 32; ++i) acc[i] = 0.f;
    for (int j = 0; j < 64; ++j) {
      float w = p.f3_w[j * 2048 + col];
#pragma unroll
      for (int q = 0; q < 8; ++q) {
        f32x4 h = *(const f32x4*)&h2T[j][q * 4];
        acc[q * 4 + 0] += h[0] * w; acc[q * 4 + 1] += h[1] * w; acc[q * 4 + 2] += h[2] * w; acc[q * 4 + 3] += h[3] * w;
      }
    }
    int c = col & 511;
    float delta = fabsf(min_decay + (float)c * ((max_decay - min_decay) / 511.0f));
    float* dst = filt + (size_t)col * 8192 + t0;
#pragma unroll
    for (int q = 0; q < 8; ++q) {
      f32x4 o;
#pragma unroll
      for (int r = 0; r < 4; ++r) {
        float tl = (float)(t0 + q * 4 + r) * (1.0f / 8191.0f);
        o[r] = acc[q * 4 + r] * __expf(-tl * delta);
      }
      *(f32x4*)(dst + q * 4) = o;
    }
  }
  }
}

constexpr int BM = 256, BN = 128, BK = 64;
constexpr int LDS_A = BM * BK * 2, LDS_B = BN * BK * 2, LDS_STAGE = LDS_A + LDS_B;
constexpr int GEMM_LDS = 2 * LDS_STAGE + 8192;

DI int swz(int row, int ch) { return row * 128 + ((ch ^ (row & 7)) << 4); }

struct ALoadBf16 {
  const ushort_t* A; int lda;
  struct Raw { u32x4 v; };
  DI Raw fetch(int row, int k) const { Raw r; r.v = *(const u32x4*)(A + (size_t)row * lda + k); return r; }
  DI u32x4 cvt(const Raw& r, int k) const { return r.v; }
};
struct ALoadF32Mod {
  const float* A; const float* mod;
  struct Raw { f32x4 a, b; };
  DI Raw fetch(int row, int k) const { Raw r; const float* s = A + (size_t)row * 1024 + k; r.a = *(const f32x4*)s; r.b = *(const f32x4*)(s + 4); return r; }
  DI u32x4 cvt(const Raw& r, int k) const {
    f32x4 s0 = *(const f32x4*)(mod + k), s1 = *(const f32x4*)(mod + k + 4);
    f32x4 h0 = *(const f32x4*)(mod + 1024 + k), h1 = *(const f32x4*)(mod + 1024 + k + 4);
    u32x4 o;
    o[0] = pack2(r.a[0] * s0[0] + h0[0], r.a[1] * s0[1] + h0[1]);
    o[1] = pack2(r.a[2] * s0[2] + h0[2], r.a[3] * s0[3] + h0[3]);
    o[2] = pack2(r.b[0] * s1[0] + h1[0], r.b[1] * s1[1] + h1[1]);
    o[3] = pack2(r.b[2] * s1[2] + h1[2], r.b[3] * s1[3] + h1[3]);
    return o;
  }
};

template <class AL, bool SWAP = false>
DI void gemm_mainloop(f32x16 (&acc)[2][2], const AL& al, int m0, const ushort_t* __restrict__ Bt, int ldb, int n0, int K, char* smem) {
  const int tid = tid_opaque(), lane = tid & 63, wave = tid >> 6;
  const int wm = wave >> 1, wn = wave & 1;
  const int lr = tid >> 3, lc = tid & 7;
  typename AL::Raw ra[4]; u32x4 rb[2];
  const int nk = K / BK;
#pragma unroll
  for (int i = 0; i < 4; ++i) ra[i] = al.fetch(m0 + lr + 64 * i, lc * 8);
#pragma unroll
  for (int i = 0; i < 2; ++i) rb[i] = *(const u32x4*)(Bt + (size_t)(n0 + lr + 64 * i) * ldb + lc * 8);
  __syncthreads();
#pragma unroll
  for (int i = 0; i < 4; ++i) *(u32x4*)(smem + swz(lr + 64 * i, lc)) = al.cvt(ra[i], lc * 8);
#pragma unroll
  for (int i = 0; i < 2; ++i) *(u32x4*)(smem + LDS_A + swz(lr + 64 * i, lc)) = rb[i];
  __syncthreads();
  for (int kt = 0; kt < nk; ++kt) {
    char* cur = smem + (kt & 1) * LDS_STAGE;
    char* nxt = smem + ((kt + 1) & 1) * LDS_STAGE;
    const bool more = (kt + 1 < nk);
    const int kn = (kt + 1) * BK + lc * 8;
    if (more) {
#pragma unroll
      for (int i = 0; i < 4; ++i) ra[i] = al.fetch(m0 + lr + 64 * i, kn);
#pragma unroll
      for (int i = 0; i < 2; ++i) rb[i] = *(const u32x4*)(Bt + (size_t)(n0 + lr + 64 * i) * ldb + kn);
    }
#pragma unroll
    for (int s = 0; s < 4; ++s) {
      const int ch = 2 * s + (lane >> 5);
      bf16x8 af[2], bfr[2];
#pragma unroll
      for (int mi = 0; mi < 2; ++mi) af[mi] = *(const bf16x8*)(cur + swz(wm * 64 + mi * 32 + (lane & 31), ch));
#pragma unroll
      for (int ni = 0; ni < 2; ++ni) bfr[ni] = *(const bf16x8*)(cur + LDS_A + swz(wn * 64 + ni * 32 + (lane & 31), ch));
#pragma unroll
      for (int mi = 0; mi < 2; ++mi)
#pragma unroll
        for (int ni = 0; ni < 2; ++ni)
          acc[mi][ni] = SWAP ? __builtin_amdgcn_mfma_f32_32x32x16_bf16(bfr[ni], af[mi], acc[mi][ni], 0, 0, 0)
                             : __builtin_amdgcn_mfma_f32_32x32x16_bf16(af[mi], bfr[ni], acc[mi][ni], 0, 0, 0);
    }
    if (more) {
#pragma unroll
      for (int i = 0; i < 4; ++i) *(u32x4*)(nxt + swz(lr + 64 * i, lc)) = al.cvt(ra[i], kn);
#pragma unroll
      for (int i = 0; i < 2; ++i) *(u32x4*)(nxt + LDS_A + swz(lr + 64 * i, lc)) = rb[i];
    }
    __syncthreads();
  }
}

constexpr int AT_ROW = 576;
constexpr int LDS_AT = 64 * AT_ROW;
constexpr int LDS_STAGE_T = LDS_AT + LDS_B;
typedef __attribute__((ext_vector_type(4))) short s16x4;
DI void gemm_mainloop_AT(f32x16 (&acc)[2][2], const ushort_t* __restrict__ At, size_t ldt, const ushort_t* __restrict__ Bt, int ldb, int n0, int K, char* smem) {
  const int tid = tid_opaque(), lane = tid & 63, wave = tid >> 6;
  const int wm = wave >> 1, wn = wave & 1;
  const int lr = tid >> 3, lc = tid & 7;
  u32x4 ra[4], rb[2];
  const int nk = K / BK;
#pragma unroll
  for (int i = 0; i < 4; ++i) { const int q = tid + 512 * i; ra[i] = *(const u32x4*)(At + (size_t)(q >> 5) * ldt + (q & 31) * 8); }
#pragma unroll
  for (int i = 0; i < 2; ++i) rb[i] = *(const u32x4*)(Bt + (size_t)(n0 + lr + 64 * i) * ldb + lc * 8);
  __syncthreads();
#pragma unroll
  for (int i = 0; i < 4; ++i) { const int q = tid + 512 * i; *(u32x4*)(smem + (q >> 5) * AT_ROW + (q & 31) * 16) = ra[i]; }
#pragma unroll
  for (int i = 0; i < 2; ++i) *(u32x4*)(smem + LDS_AT + swz(lr + 64 * i, lc)) = rb[i];
  __syncthreads();
  const int hh = lane >> 5, gg = (lane >> 4) & 1, qq = (lane & 15) >> 2, pp = lane & 3;
  for (int kt = 0; kt < nk; ++kt) {
    char* cur = smem + (kt & 1) * LDS_STAGE_T;
    char* nxt = smem + ((kt + 1) & 1) * LDS_STAGE_T;
    const bool more = (kt + 1 < nk);
    if (more) {
#pragma unroll
      for (int i = 0; i < 4; ++i) { const int q = tid + 512 * i; ra[i] = *(const u32x4*)(At + (size_t)((kt + 1) * BK + (q >> 5)) * ldt + (q & 31) * 8); }
#pragma unroll
      for (int i = 0; i < 2; ++i) rb[i] = *(const u32x4*)(Bt + (size_t)(n0 + lr + 64 * i) * ldb + (kt + 1) * BK + lc * 8);
    }
#pragma unroll
    for (int s = 0; s < 4; ++s) {
      const int ch = 2 * s + hh;
      bf16x8 af[2], bfr[2];
#pragma unroll
      for (int mi = 0; mi < 2; ++mi) {
        const char* a0 = cur + (16 * s + 8 * hh + qq) * AT_ROW + (wm * 64 + mi * 32 + 16 * gg + 4 * pp) * 2;
        s16x4 lo = __builtin_amdgcn_ds_read_tr16_b64_v4i16((__attribute__((address_space(3))) s16x4*)(a0));
        s16x4 hi = __builtin_amdgcn_ds_read_tr16_b64_v4i16((__attribute__((address_space(3))) s16x4*)(a0 + 4 * AT_ROW));
        af[mi] = __builtin_shufflevector(lo, hi, 0, 1, 2, 3, 4, 5, 6, 7);
      }
#pragma unroll
      for (int ni = 0; ni < 2; ++ni) bfr[ni] = *(const bf16x8*)(cur + LDS_AT + swz(wn * 64 + ni * 32 + (lane & 31), ch));
#pragma unroll
      for (int mi = 0; mi < 2; ++mi)
#pragma unroll
        for (int ni = 0; ni < 2; ++ni) acc[mi][ni] = __builtin_amdgcn_mfma_f32_32x32x16_bf16(af[mi], bfr[ni], acc[mi][ni], 0, 0, 0);
    }
    if (more) {
#pragma unroll
      for (int i = 0; i < 4; ++i) { const int q = tid + 512 * i; *(u32x4*)(nxt + (q >> 5) * AT_ROW + (q & 31) * 16) = ra[i]; }
#pragma unroll
      for (int i = 0; i < 2; ++i) *(u32x4*)(nxt + LDS_AT + swz(lr + 64 * i, lc)) = rb[i];
    }
    __syncthreads();
  }
}
DI void acc_zero(f32x16 (&acc)[2][2]) {
#pragma unroll
  for (int a = 0; a < 2; ++a)
#pragma unroll
    for (int b = 0; b < 2; ++b)
#pragma unroll
      for (int r = 0; r < 16; ++r) acc[a][b][r] = 0.f;
}
#define ACC_ROW(mi, r) (wm * 64 + (mi) * 32 + ((r) & 3) + 8 * ((r) >> 2) + 4 * (lane >> 5))
#define ACC_COL(ni) (wn * 64 + (ni) * 32 + (lane & 31))

DI void stage_mod(float* mod, const float* ada, int b, int sc_chunk, int sh_chunk) {
  for (int i = tid_opaque(); i < 1024; i += NT) {
    mod[i] = 1.f + ada[b * 6144 + sc_chunk * 1024 + i];
    mod[1024 + i] = ada[b * 6144 + sh_chunk * 1024 + i];
  }
}

DI void phase_inproj(const P& p, char* smem) {
  const float* ada = (const float*)(p.ws + OFF_ADA);
  float* mod = (float*)(smem + 2 * LDS_STAGE);
  const ushort_t* wt = (const ushort_t*)(p.ws + OFF_WIN_T);
  ushort_t* ph = (ushort_t*)(p.ws + OFF_PH);
  ushort_t* qkv = (ushort_t*)(p.ws + OFF_QKV);
  ushort_t* gate = (ushort_t*)(p.ws + OFF_GATE);
  constexpr int NTN = INW / BN;
  constexpr int NTM = T_ / BM;
  for (int tile = blockIdx.x; tile < NTM * NTN; tile += gridDim.x) {
    const int tid = tid_opaque(), lane = tid & 63, wave = tid >> 6, wm = wave >> 1, wn = wave & 1;
    const int tm = tile / NTN, tn = tile % NTN;
    const int m0 = tm * BM, n0 = tn * BN, b = m0 / S_;
    __syncthreads();
    stage_mod(mod, ada, b, 1, 0);
    __syncthreads();
    f32x16 acc[2][2]; acc_zero(acc);
    ALoadF32Mod al{p.x, mod};
    if (n0 < HYC) {
      gemm_mainloop<ALoadF32Mod, true>(acc, al, m0, wt, 1024, n0, 1024, smem);
#pragma unroll
      for (int mi = 0; mi < 2; ++mi) {
        const int t = (m0 & (S_ - 1)) + wm * 64 + mi * 32 + (lane & 31);
#pragma unroll
        for (int ni = 0; ni < 2; ++ni)
#pragma unroll
          for (int r = 0; r < 16; ++r) {
            const int ch = n0 + wn * 64 + ni * 32 + (r & 3) + 8 * (r >> 2) + 4 * (lane >> 5);
            ph[((size_t)(b * HYC + ch)) * S_ + t] = f2bf(acc[mi][ni][r]);
          }
      }
      continue;
    }
    gemm_mainloop(acc, al, m0, wt, 1024, n0, 1024, smem);
#pragma unroll
    for (int ni = 0; ni < 2; ++ni) {
      const int col = n0 + ACC_COL(ni);
#pragma unroll
      for (int mi = 0; mi < 2; ++mi) {
        if (col < HYC + QKVC) {
          const int cq = col - HYC;
          const bool rot = (cq < 1536) && ((cq & 63) < 16);
          const float qs = (cq < 768) ? 0.125f : 1.0f;
          const float inv = expf(-13.122363377404328f * (float)(cq & 7) * 0.125f);
#pragma unroll
          for (int r = 0; r < 16; ++r) {
            const int row = m0 + ACC_ROW(mi, r);
            float v = acc[mi][ni][r];
            float o = __shfl_xor(v, 8);
            if (rot) {
              float ang = (float)p.pos[row] * inv;
              float sn, cs; sincosf(ang, &sn, &cs);
              v = ((cq & 15) < 8) ? (v * cs - o * sn) : (v * cs + o * sn);
            }
            qkv[(size_t)row * QKVC + cq] = f2bf(v * qs);
          }
        } else {
          const int cg = col - HYC - QKVC;
#pragma unroll
          for (int r = 0; r < 16; ++r) {
            float v = acc[mi][ni][r];
            gate[(size_t)(m0 + ACC_ROW(mi, r)) * GATEC + cg] = f2bf(1.f / (1.f + __expf(-v)));
          }
        }
      }
    }
  }
}

DI float sconv_t(const ushort_t* row, int t, float w0, float w1, float w2, float cb) {
  float v = cb + w1 * bf2f(row[t]);
  if (t > 0) v += w0 * bf2f(row[t - 1]);
  if (t < S_ - 1) v += w2 * bf2f(row[t + 1]);
  return v;
}
DI void fft_C_mul_invC(cf2* lds, const cf2* __restrict__ kq, int tid) {
  asm volatile("" : "+v"(tid));
  const int k1 = tid >> 5, k2 = tid & 31;
  kq += tid;
#pragma unroll
  for (int h = 0; h < 2; ++h) {
    float tr[16], ti[16];
    cf2 kv[16];
#pragma unroll
    for (int i = 0; i < 16; ++i) kv[i] = kq[(h * 16 + i) * 512];
    cf2* blk = lds + (k1 + 16 * h) * FFT_SA + k2 * 17;
#pragma unroll
    for (int mp = 0; mp < 16; ++mp) { cf2 v = blk[mp]; tr[mp] = v.x; ti[mp] = v.y; }
    dft_fwd<16, false>(tr, ti);
#pragma unroll
    for (int i = 0; i < 16; ++i) { const float a = tr[i], b = ti[i]; tr[i] = a * kv[i].x - b * kv[i].y; ti[i] = a * kv[i].y + b * kv[i].x; }
    dft_inv<16>(tr, ti);
#pragma unroll
    for (int mp = 0; mp < 16; ++mp) { cf2 o; o.x = tr[mp]; o.y = ti[mp]; blk[mp] = o; }
  }
}
DI void hyena_item(const P& p, char* smem, int c) {
  cf2* lds = (cf2*)smem;
  const ushort_t* pht = (const ushort_t*)(p.ws + OFF_PH);
  ushort_t* yht = (ushort_t*)(p.ws + OFF_YH);
  cf2* kq = (cf2*)(p.ws + (blockIdx.x < 92 ? OFF_WIN_T + (size_t)blockIdx.x * 131072 : OFF_HSCR + (size_t)(blockIdx.x - 92) * 131072));
  const float* filt = p.out;
  const int tid0 = tid_opaque();
  float zr[32], zi[32];
  __syncthreads();
#pragma unroll 1
  for (int o = 0; o < 2; ++o) {
    int tid = tid0; asm volatile("" : "+v"(tid));
    {
      float kr[32], ki[32];
      const float* fw = filt + (size_t)(0 * 1024 + o * 512 + c) * S_;
      const float* bw = filt + (size_t)(1 * 1024 + o * 512 + c) * S_;
      const float bias = p.hy_bias[o * 512 + c];
#pragma unroll
      for (int n1 = 0; n1 < 16; ++n1) { kr[n1] = fw[n1 * 512 + tid] * (1.0f / 16384.0f); ki[n1] = 0.f; }
      if (tid == 0) kr[0] += bias * (1.0f / 16384.0f);
#pragma unroll
      for (int n1 = 16; n1 < 32; ++n1) {
        const int n = n1 * 512 + tid;
        kr[n1] = (n == S_) ? 0.f : bw[2 * S_ - n] * (1.0f / 16384.0f); ki[n1] = 0.f;
      }
      fft_fwdA<false>(kr, ki, lds, tid); __syncthreads();
      fft_B_read(kr, ki, lds, tid); __syncthreads();
      fft_fwdB_write(kr, ki, lds, tid); __syncthreads();
      fft_fwdC(kr, ki, lds, tid);
      int ts = tid; asm volatile("" : "+v"(ts));
      cf2* kqt = kq + ts;
#pragma unroll
      for (int r = 0; r < 32; ++r) { cf2 v; v.x = kr[r]; v.y = ki[r]; kqt[r * 512] = v; }
      __syncthreads();
    }
    asm volatile("" : "+v"(tid));
    if (o == 0) {
      const float w0 = p.hy_conv_w[c], w1 = p.hy_conv_w[HYC + c], w2 = p.hy_conv_w[2 * HYC + c], cb = p.hy_conv_b[c];
      const ushort_t* r0 = pht + (size_t)(0 * HYC + c) * S_;
      const ushort_t* r1 = pht + (size_t)(1 * HYC + c) * S_;
#pragma unroll
      for (int n1 = 0; n1 < 16; ++n1) {
        const int t = n1 * 512 + tid;
        zr[n1] = sconv_t(r0, t, w0, w1, w2, cb); zi[n1] = sconv_t(r1, t, w0, w1, w2, cb);
        if (n1 & 1) asm volatile("" ::: "memory");
      }
    }
#pragma unroll
    for (int n1 = 16; n1 < 32; ++n1) { zr[n1] = 0.f; zi[n1] = 0.f; }
    fft_fwdA<true>(zr, zi, lds, tid); __syncthreads();
    fft_B_read(zr, zi, lds, tid); __syncthreads();
    fft_fwdB_write(zr, zi, lds, tid); __syncthreads();
    fft_C_mul_invC(lds, kq, tid); __syncthreads();
    fft_invB_read(zr, zi, lds, tid); __syncthreads();
    fft_invB_write(zr, zi, lds, tid); __syncthreads();
    fft_invA(zr, zi, lds, tid);
    int tg = tid; asm volatile("" : "+v"(tg));
    const int gch = (o + 1) * 512 + c;
    const float w0 = p.hy_conv_w[gch], w1 = p.hy_conv_w[HYC + gch], w2 = p.hy_conv_w[2 * HYC + gch], cb = p.hy_conv_b[gch];
    const ushort_t* g0 = pht + (size_t)(0 * HYC + gch) * S_;
    const ushort_t* g1 = pht + (size_t)(1 * HYC + gch) * S_;
#pragma unroll
    for (int n1 = 0; n1 < 16; ++n1) {
      const int t = n1 * 512 + tg;
      zr[n1] *= sconv_t(g0, t, w0, w1, w2, cb);
      zi[n1] *= sconv_t(g1, t, w0, w1, w2, cb);
      if (n1 & 1) asm volatile("" ::: "memory");
    }
    if (o == 1) {
#pragma unroll
      for (int n1 = 0; n1 < 16; ++n1) {
        const int t = n1 * 512 + tg;
        yht[(size_t)(0 * HW_ + c) * S_ + t] = f2bf(zr[n1]);
        yht[(size_t)(1 * HW_ + c) * S_ + t] = f2bf(zi[n1]);
      }
    }
  }
}

constexpr int ATT_VROW = 192;
constexpr int ATT_VBUF = 32 * ATT_VROW;
DI void attn_item(const P& p, char* smem, int item) {
  const ushort_t* qkv = (const ushort_t*)(p.ws + OFF_QKV);
  ushort_t* ya = (ushort_t*)(p.ws + OFF_YA);
  const int tid = tid_opaque(), lane = tid & 63, wave = tid >> 6;
  const int u = item * 8 + wave;
  const int hs = u & 3, r16 = (u >> 2) & 15, chunk = (u >> 6) & 15, b = u >> 10;
  const int qi = lane & 31, h = lane >> 5;
  char* vl = smem + wave * ATT_VBUF;
  const int tq = chunk * 512 + r16 + 16 * qi;
  const size_t bbase = (size_t)b * S_;
  f32x16 o0, o1;
#pragma unroll
  for (int r = 0; r < 16; ++r) { o0[r] = 0.f; o1[r] = 0.f; }
  float m = -1e30f, l = 0.f;
  const int g16 = (lane >> 4) & 1, q4 = (lane & 15) >> 2, p4 = lane & 3;
  __syncthreads();
#pragma unroll 1
  for (int g = 0; g < 3; ++g) {
    const int dsh = 2 * g;
    const int d = 1 << dsh, sd = 16 >> dsh, n = S_ >> dsh;
    const int head = g * 4 + hs;
    const int rc = r16 & (d - 1);
    const int P0 = (chunk * 512 + r16 - rc) >> dsh;
    const int pq = P0 + sd * qi;
    const int KB = P0 - 64;
    const int ntile = (g == 0) ? 20 : (g == 1 ? 8 : 5);
    bf16x8 bq[4];
    {
      const ushort_t* qrow = qkv + (bbase + tq) * QKVC + head * 64;
#pragma unroll
      for (int s = 0; s < 4; ++s) bq[s] = *(const bf16x8*)(qrow + (2 * s + h) * 8);
    }
    bf16x8 kn[4]; u32x4 vn[4];
    {
      const int kp = min(max(KB + qi, 0), n - 1);
      const ushort_t* krow = qkv + (bbase + rc + ((size_t)kp << dsh)) * QKVC + 768 + head * 64;
#pragma unroll
      for (int s = 0; s < 4; ++s) kn[s] = *(const bf16x8*)(krow + (2 * s + h) * 8);
#pragma unroll
      for (int i = 0; i < 4; ++i) {
        const int c = lane + 64 * i, row = c >> 3, ch = c & 7;
        const int vp = min(max(KB + row, 0), n - 1);
        vn[i] = *(const u32x4*)(qkv + (bbase + rc + ((size_t)vp << dsh)) * QKVC + 1536 + head * 64 + ch * 8);
      }
    }
#pragma unroll 1
    for (int kt = 0; kt < ntile; ++kt) {
      bf16x8 kc[4]; u32x4 vc[4];
#pragma unroll
      for (int s = 0; s < 4; ++s) kc[s] = kn[s];
#pragma unroll
      for (int i = 0; i < 4; ++i) vc[i] = vn[i];
      if (kt + 1 < ntile) {
        const int kb1 = KB + 32 * (kt + 1);
        const int kp = min(max(kb1 + qi, 0), n - 1);
        const ushort_t* krow = qkv + (bbase + rc + ((size_t)kp << dsh)) * QKVC + 768 + head * 64;
#pragma unroll
        for (int s = 0; s < 4; ++s) kn[s] = *(const bf16x8*)(krow + (2 * s + h) * 8);
#pragma unroll
        for (int i = 0; i < 4; ++i) {
          const int c = lane + 64 * i, row = c >> 3, ch = c & 7;
          const int vp = min(max(kb1 + row, 0), n - 1);
          vn[i] = *(const u32x4*)(qkv + (bbase + rc + ((size_t)vp << dsh)) * QKVC + 1536 + head * 64 + ch * 8);
        }
      }
      f32x16 st;
#pragma unroll
      for (int r = 0; r < 16; ++r) st[r] = 0.f;
#pragma unroll
      for (int s = 0; s < 4; ++s) st = __builtin_amdgcn_mfma_f32_32x32x16_bf16(kc[s], bq[s], st, 0, 0, 0);
#pragma unroll
      for (int i = 0; i < 4; ++i) { const int c = lane + 64 * i; *(u32x4*)(vl + (c >> 3) * ATT_VROW + (c & 7) * 16) = vc[i]; }
      const int kb = KB + 32 * kt + 4 * h;
      const int dk = kb - pq;
      float mx = -1e30f;
      bool ok[16];
#pragma unroll
      for (int r = 0; r < 16; ++r) {
        const int cr = (r & 3) + 8 * (r >> 2);
        ok[r] = ((unsigned)(dk + cr + 64) <= 128u) && ((unsigned)(kb + cr) < (unsigned)n);
        mx = fmaxf(mx, ok[r] ? st[r] : -1e30f);
      }
      mx = fmaxf(mx, __shfl_xor(mx, 32));
      const float mnew = fmaxf(m, mx);
      const float corr = __expf(m - mnew);
      float ps = 0.f;
      float pv[16];
#pragma unroll
      for (int r = 0; r < 16; ++r) { pv[r] = ok[r] ? __expf(st[r] - mnew) : 0.f; ps += pv[r]; }
      ps += __shfl_xor(ps, 32);
      l = l * corr + ps; m = mnew;
#pragma unroll
      for (int r = 0; r < 16; ++r) { o0[r] *= corr; o1[r] *= corr; }
      bf16x8 pf[2];
#pragma unroll
      for (int s = 0; s < 2; ++s) {
        u32x4 w;
        w[0] = pack2(pv[8 * s + 0], pv[8 * s + 1]); w[1] = pack2(pv[8 * s + 2], pv[8 * s + 3]);
        w[2] = pack2(pv[8 * s + 4], pv[8 * s + 5]); w[3] = pack2(pv[8 * s + 6], pv[8 * s + 7]);
        pf[s] = __builtin_bit_cast(bf16x8, w);
      }
      __builtin_amdgcn_wave_barrier();
      asm volatile("s_waitcnt lgkmcnt(0)" ::: "memory");
#pragma unroll
      for (int s = 0; s < 2; ++s) {
#pragma unroll
        for (int nt = 0; nt < 2; ++nt) {
          const char* a0 = vl + (16 * s + 4 * h + q4) * ATT_VROW + (32 * nt + 16 * g16 + 4 * p4) * 2;
          s16x4 lo = __builtin_amdgcn_ds_read_tr16_b64_v4i16((__attribute__((address_space(3))) s16x4*)(a0));
          s16x4 hi = __builtin_amdgcn_ds_read_tr16_b64_v4i16((__attribute__((address_space(3))) s16x4*)(a0 + 8 * ATT_VROW));
          const bf16x8 vf = __builtin_shufflevector(lo, hi, 0, 1, 2, 3, 4, 5, 6, 7);
          if (nt == 0) o0 = __builtin_amdgcn_mfma_f32_32x32x16_bf16(vf, pf[s], o0, 0, 0, 0);
          else o1 = __builtin_amdgcn_mfma_f32_32x32x16_bf16(vf, pf[s], o1, 0, 0, 0);
        }
      }
      __builtin_amdgcn_wave_barrier();
      asm volatile("s_waitcnt lgkmcnt(0)" ::: "memory");
    }
  }
  const float il = 1.f / l;
  ushort_t* op = ya + (bbase + tq) * 256 + hs * 64;
#pragma unroll
  for (int gq = 0; gq < 4; ++gq) {
    uint2 w0, w1;
    w0.x = pack2(o0[4 * gq] * il, o0[4 * gq + 1] * il); w0.y = pack2(o0[4 * gq + 2] * il, o0[4 * gq + 3] * il);
    w1.x = pack2(o1[4 * gq] * il, o1[4 * gq + 1] * il); w1.y = pack2(o1[4 * gq + 2] * il, o1[4 * gq + 3] * il);
    *(uint2*)(op + 8 * gq + 4 * h) = w0;
    *(uint2*)(op + 32 + 8 * gq + 4 * h) = w1;
  }
}

DI void phase_merge(const P& p, char* smem) {
  const ushort_t* yh = (const ushort_t*)(p.ws + OFF_YH);
  const ushort_t* ya = (const ushort_t*)(p.ws + OFF_YA);
  const ushort_t* gate = (const ushort_t*)(p.ws + OFF_GATE);
  ushort_t* merged = (ushort_t*)(p.ws + OFF_MERGED);
  constexpr int NTN = 1024 / BN, NTM = T_ / BM;
  for (int tile = blockIdx.x; tile < NTM * NTN; tile += gridDim.x) {
    const int tid = tid_opaque(), wave = tid >> 6, wm = wave >> 1, wn = wave & 1;
    int lane = tid & 63;
    const int m0 = (tile / NTN) * BM, n0 = (tile % NTN) * BN;
    f32x16 a1[2][2]; acc_zero(a1);
    gemm_mainloop_AT(a1, yh + (size_t)((m0 / S_) * HW_) * S_ + (m0 & (S_ - 1)), (size_t)S_, (const ushort_t*)(p.ws + OFF_WBH_T), 512, n0, 512, smem);
    const ushort_t* gbh = gate + (size_t)m0 * GATEC + n0;
    ushort_t* mb = merged + (size_t)m0 * 1024 + n0;
    {
      const unsigned lg = (unsigned)((wm * 64 + 4 * (lane >> 5)) * GATEC + wn * 64 + (lane & 31));
      const unsigned lm = (unsigned)((wm * 64 + 4 * (lane >> 5)) * 1024 + wn * 64 + (lane & 31));
#pragma unroll
      for (int mi = 0; mi < 2; ++mi)
#pragma unroll
        for (int ni = 0; ni < 2; ++ni) {
#pragma unroll
          for (int r = 0; r < 16; ++r) {
            const int rr = mi * 32 + (r & 3) + 8 * (r >> 2);
            (mb + rr * 1024 + ni * 32)[lm] = f2bf(bf2f((gbh + rr * GATEC + ni * 32)[lg]) * a1[mi][ni][r]);
          }
          asm volatile("" ::: "memory");
        }
    }
    acc_zero(a1);
    ALoadBf16 l2{ya, 256};
    gemm_mainloop(a1, l2, m0, (const ushort_t*)(p.ws + OFF_WBA_T), 256, n0, 256, smem);
    asm volatile("" : "+v"(lane));
    {
      const unsigned lg = (unsigned)((wm * 64 + 4 * (lane >> 5)) * GATEC + wn * 64 + (lane & 31));
      const unsigned lm = (unsigned)((wm * 64 + 4 * (lane >> 5)) * 1024 + wn * 64 + (lane & 31));
#pragma unroll
      for (int mi = 0; mi < 2; ++mi)
#pragma unroll
        for (int ni = 0; ni < 2; ++ni) {
#pragma unroll
          for (int r = 0; r < 16; ++r) {
            const int rr = mi * 32 + (r & 3) + 8 * (r >> 2);
            ushort_t* mp = mb + rr * 1024 + ni * 32;
            mp[lm] = f2bf(bf2f(mp[lm]) + bf2f((gbh + 1024 + rr * GATEC + ni * 32)[lg]) * a1[mi][ni][r]);
          }
          asm volatile("" ::: "memory");
        }
    }
  }
}

DI void phase_outproj(const P& p, char* smem) {
  const float* ada = (const float*)(p.ws + OFF_ADA);
  const ushort_t* merged = (const ushort_t*)(p.ws + OFF_MERGED);
  constexpr int NTN = 1024 / BN, NTM = T_ / BM;
  for (int tile = blockIdx.x; tile < NTM * NTN; tile += gridDim.x) {
    const int tid = tid_opaque(), lane = tid & 63, wave = tid >> 6, wm = wave >> 1, wn = wave & 1;
    const int m0 = (tile / NTN) * BM, n0 = (tile % NTN) * BN, b = m0 / S_;
    f32x16 acc[2][2]; acc_zero(acc);
    ALoadBf16 l1{merged, 1024};
    gemm_mainloop(acc, l1, m0, (const ushort_t*)(p.ws + OFF_WOUT_T), 1024, n0, 1024, smem);
#pragma unroll
    for (int ni = 0; ni < 2; ++ni) {
      const int col = n0 + ACC_COL(ni);
      const float g1 = 1.f + ada[b * 6144 + 2 * 1024 + col];
#pragma unroll
      for (int mi = 0; mi < 2; ++mi)
#pragma unroll
        for (int r = 0; r < 16; ++r) {
          const size_t o = (size_t)(m0 + ACC_ROW(mi, r)) * 1024 + col;
          p.out[o] = DN_ALPHA * p.x[o] + g1 * acc[mi][ni][r];
        }
    }
  }
}

DI void phase_ln(float* __restrict__ xio, const float* __restrict__ g, const float* __restrict__ bta) {
  const int tq = tid_opaque(); const int lane = tq & 63, wave = tq >> 6;
  for (int row = blockIdx.x * 8 + wave; row < T_; row += gridDim.x * 8) {
    float* rp = xio + (size_t)row * 1024;
    f32x4 v[4];
    float s = 0.f;
#pragma unroll
    for (int i = 0; i < 4; ++i) { v[i] = *(const f32x4*)(rp + i * 256 + lane * 4); s += v[i][0] + v[i][1] + v[i][2] + v[i][3]; }
    const float mu = wave_sum(s) * (1.f / 1024.f);
    float q = 0.f;
#pragma unroll
    for (int i = 0; i < 4; ++i)
#pragma unroll
      for (int j = 0; j < 4; ++j) { float d = v[i][j] - mu; q += d * d; }
    const float rs = rsqrtf(wave_sum(q) * (1.f / 1024.f) + LN_EPS);
#pragma unroll
    for (int i = 0; i < 4; ++i) {
      f32x4 gg = *(const f32x4*)(g + i * 256 + lane * 4), bb = *(const f32x4*)(bta + i * 256 + lane * 4), o;
#pragma unroll
      for (int j = 0; j < 4; ++j) o[j] = (v[i][j] - mu) * rs * gg[j] + bb[j];
      *(f32x4*)(rp + i * 256 + lane * 4) = o;
    }
  }
}

DI int swz256(int row, int ch) { return row * 256 + ((ch ^ (row & 15)) << 4); }
DI void ins16(float (&L)[16], float x) {
#pragma unroll
  for (int i = 0; i < 16; ++i) { const float hi = __builtin_fmaxf(L[i], x); x = __builtin_fminf(L[i], x); L[i] = hi; }
}
DI void bitonic16_desc(float (&M)[16]) {
#pragma unroll
  for (int d = 8; d >= 1; d >>= 1)
#pragma unroll
    for (int i = 0; i < 16; ++i)
      if ((i & d) == 0) { const float a = M[i], b = M[i + d]; M[i] = __builtin_fmaxf(a, b); M[i + d] = __builtin_fminf(a, b); }
}
constexpr int ROUTE_Q_OFF = 0, ROUTE_K_OFF = 65536, ROUTE_IDX_OFF = 106496;
DI void phase_route(const P& p, char* smem) {
  const float* ada = (const float*)(p.ws + OFF_ADA);
  float* mod = (float*)(smem + 2 * LDS_STAGE);
  const ushort_t* keysb = (const ushort_t*)(p.ws + OFF_KEYS_B);
  int* idx = (int*)(p.ws + OFF_IDX);
  float* gv = (float*)(p.ws + OFF_GV);
  for (int item = blockIdx.x; item < (T_ / BM) * 8; item += gridDim.x) {
    const int tid = tid_opaque(), lane = tid & 63, wave = tid >> 6, wm = wave >> 1, wn = wave & 1;
    const int m0 = (item >> 3) * BM, hh = item & 7, b = m0 / S_;
    __syncthreads();
    stage_mod(mod, ada, b, 4, 3);
    __syncthreads();
    float L0[16];
#pragma unroll 1
    for (int pp = 0; pp < 2; ++pp) {
      const int hp = hh * 2 + pp;
      f32x16 acc[2][2]; acc_zero(acc);
      ALoadF32Mod al{p.out, mod};
      gemm_mainloop<ALoadF32Mod, true>(acc, al, m0, (const ushort_t*)(p.ws + OFF_WQ_T), 1024, hp * 128, 1024, smem);
#pragma unroll
      for (int mi = 0; mi < 2; ++mi) {
        const int tok = wm * 64 + mi * 32 + (lane & 31);
#pragma unroll
        for (int ni = 0; ni < 2; ++ni)
#pragma unroll
          for (int g = 0; g < 4; ++g) {
            const int ch = wn * 8 + ni * 4 + g;
            uint2 v; v.x = pack2(acc[mi][ni][4 * g], acc[mi][ni][4 * g + 1]); v.y = pack2(acc[mi][ni][4 * g + 2], acc[mi][ni][4 * g + 3]);
            *(uint2*)(smem + ROUTE_Q_OFF + swz256(tok, ch) + 8 * (lane >> 5)) = v;
          }
      }
#pragma unroll
      for (int i = 0; i < 4; ++i) {
        const int q = tid + 512 * i, row = q >> 4, ch = q & 15;
        *(u32x4*)(smem + ROUTE_K_OFF + swz256(row, ch)) = *(const u32x4*)(keysb + (size_t)hp * 16384 + row * 128 + ch * 8);
      }
      __syncthreads();
      f32x16 sc[4];
#pragma unroll
      for (int ks = 0; ks < 4; ++ks)
#pragma unroll
        for (int r = 0; r < 16; ++r) sc[ks][r] = 0.f;
#pragma unroll
      for (int s = 0; s < 8; ++s) {
        const int ch = 2 * s + (lane >> 5);
        const bf16x8 bq = *(const bf16x8*)(smem + ROUTE_Q_OFF + swz256(wave * 32 + (lane & 31), ch));
#pragma unroll
        for (int ks = 0; ks < 4; ++ks) {
          const bf16x8 ak = *(const bf16x8*)(smem + ROUTE_K_OFF + swz256(ks * 32 + (lane & 31), ch));
          sc[ks] = __builtin_amdgcn_mfma_f32_32x32x16_bf16(ak, bq, sc[ks], 0, 0, 0);
        }
      }
      float L[16];
#pragma unroll
      for (int i = 0; i < 16; ++i) L[i] = -3.0e38f;
      const unsigned hbit = (unsigned)(lane >> 5) << 2;
#pragma unroll
      for (int ks = 0; ks < 4; ++ks)
#pragma unroll
        for (int r = 0; r < 16; ++r) {
          const unsigned key = (unsigned)(ks * 32 + (r & 3) + 8 * (r >> 2)) | hbit;
          ins16(L, __uint_as_float((__float_as_uint(sc[ks][r]) & ~127u) | key));
        }
      {
        float M[16];
#pragma unroll
        for (int i = 0; i < 16; ++i) M[i] = __builtin_fmaxf(L[i], __shfl_xor(L[15 - i], 32));
        bitonic16_desc(M);
#pragma unroll
        for (int i = 0; i < 16; ++i) L[i] = M[i];
      }
      if (pp == 0) {
#pragma unroll
        for (int i = 0; i < 16; ++i) L0[i] = L[i];
      } else {
        unsigned char* ib = (unsigned char*)(smem + ROUTE_IDX_OFF) + tid * 32;
#pragma unroll
        for (int i = 0; i < 16; ++i) { ib[i] = (unsigned char)(__float_as_uint(L0[i]) & 127u); ib[16 + i] = (unsigned char)(__float_as_uint(L[i]) & 127u); }
        float F[16];
#pragma unroll
        for (int i = 0; i < 16; ++i) F[i] = -3.0e38f;
#pragma unroll
        for (int i = 0; i < 16; ++i) {
          const float ai = __uint_as_float(__float_as_uint(L0[i]) & ~127u);
#pragma unroll
          for (int j = 0; j < 16; ++j)
            if ((i + 1) * (j + 1) <= 16) {
              const float s = ai + __uint_as_float(__float_as_uint(L[j]) & ~127u);
              ins16(F, __uint_as_float((__float_as_uint(s) & ~255u) | (unsigned)(i * 16 + j)));
            }
        }
        const float mx = __uint_as_float(__float_as_uint(F[0]) & ~255u);
        float e[16], sum = 0.f;
#pragma unroll
        for (int k = 0; k < 16; ++k) { e[k] = __expf(__uint_as_float(__float_as_uint(F[k]) & ~255u) - mx); sum += e[k]; }
        const float inv = 1.f / sum;
        if (lane < 32) {
          const int tok = m0 + wave * 32 + lane;
          int* ip = idx + (size_t)tok * 128 + hh * 16;
          float* gp = gv + (size_t)tok * 128 + hh * 16;
#pragma unroll
          for (int k4 = 0; k4 < 4; ++k4) {
            int4 iv; f32x4 g4;
            int ee[4];
#pragma unroll
            for (int u = 0; u < 4; ++u) {
              const unsigned code = __float_as_uint(F[k4 * 4 + u]) & 255u;
              ee[u] = (int)ib[code >> 4] * 128 + (int)ib[16 + (code & 15u)];
              g4[u] = e[k4 * 4 + u] * inv;
            }
            iv.x = ee[0]; iv.y = ee[1]; iv.z = ee[2]; iv.w = ee[3];
            *(int4*)(ip + k4 * 4) = iv;
            *(f32x4*)(gp + k4 * 4) = g4;
          }
        }
      }
    }
  }
}

DI void phase_keys(const P& p) {
  ushort_t* keysb = (ushort_t*)(p.ws + OFF_KEYS_B);
  for (int i = blockIdx.x * NT + tid_opaque(); i < 16 * 128 * 128 / 4; i += gridDim.x * NT) {
    f32x4 v = *(const f32x4*)(p.keys + (size_t)i * 4);
    uint2 o; o.x = pack2(v[0], v[1]); o.y = pack2(v[2], v[3]);
    *(uint2*)(keysb + (size_t)i * 4) = o;
  }
}

typedef __bf16 bf16x2_t __attribute__((ext_vector_type(2)));
DI float dot2bf(unsigned a, unsigned b, float c) { return __builtin_amdgcn_fdot2_f32_bf16(__builtin_bit_cast(bf16x2_t, a), __builtin_bit_cast(bf16x2_t, b), c, false); }
DI void phase_ln1(const P& p) {
  const float* ada = (const float*)(p.ws + OFF_ADA);
  ushort_t* u2b = (ushort_t*)(p.ws + OFF_U2B);
  const int tq = tid_opaque(); const int lane = tq & 63, wave = tq >> 6;
  for (int row = blockIdx.x * 8 + wave; row < T_; row += gridDim.x * 8) {
    const int b = row / S_;
    float* rp = p.out + (size_t)row * 1024;
    f32x4 v[4];
    float s = 0.f;
#pragma unroll
    for (int i = 0; i < 4; ++i) { v[i] = *(const f32x4*)(rp + i * 256 + lane * 4); s += v[i][0] + v[i][1] + v[i][2] + v[i][3]; }
    const float mu = wave_sum(s) * (1.f / 1024.f);
    float q = 0.f;
#pragma unroll
    for (int i = 0; i < 4; ++i)
#pragma unroll
      for (int j = 0; j < 4; ++j) { float d = v[i][j] - mu; q += d * d; }
    const float rs = rsqrtf(wave_sum(q) * (1.f / 1024.f) + LN_EPS);
#pragma unroll
    for (int i = 0; i < 4; ++i) {
      const int col = i * 256 + lane * 4;
      f32x4 gg = *(const f32x4*)(p.ln1_g + col), bb = *(const f32x4*)(p.ln1_b + col), o;
      f32x4 sc = *(const f32x4*)(ada + b * 6144 + 4 * 1024 + col), sh = *(const f32x4*)(ada + b * 6144 + 3 * 1024 + col);
#pragma unroll
      for (int j = 0; j < 4; ++j) o[j] = (v[i][j] - mu) * rs * gg[j] + bb[j];
      *(f32x4*)(rp + col) = o;
      uint2 w; w.x = pack2(o[0] * (1.f + sc[0]) + sh[0], o[1] * (1.f + sc[1]) + sh[1]); w.y = pack2(o[2] * (1.f + sc[2]) + sh[2], o[3] * (1.f + sc[3]) + sh[3]);
      *(uint2*)(u2b + (size_t)row * 1024 + col) = w;
    }
  }
}
DI void phase_tabconv(const P& p) {
  ushort_t* tu = (ushort_t*)(p.ws + OFF_TABU);
  ushort_t* tv = (ushort_t*)(p.ws + OFF_TABV);
  const int tq = tid_opaque(); const int lane = tq & 63, wave = tq >> 6;
  for (int e = blockIdx.x * 8 + wave; e < 16384; e += gridDim.x * 8) {
#pragma unroll
    for (int i = 0; i < 4; ++i) {
      const int col = i * 256 + lane * 4;
      f32x4 a = *(const f32x4*)(p.pu + (size_t)e * 1024 + col);
      f32x4 c = *(const f32x4*)(p.pv + (size_t)e * 1024 + col);
      uint2 wa; wa.x = pack2(a[0], a[1]); wa.y = pack2(a[2], a[3]);
      uint2 wc; wc.x = pack2(c[0], c[1]); wc.y = pack2(c[2], c[3]);
      *(uint2*)(tu + (size_t)e * 1024 + col) = wa;
      const int slice = i * 4 + (lane >> 4);
      *(uint2*)(tv + ((size_t)slice * 16384 + e) * 64 + (lane & 15) * 4) = wc;
    }
  }
}

template <int CTRL> DI float dpp_f(float v) { return __int_as_float(__builtin_amdgcn_mov_dpp(__float_as_int(v), CTRL, 0xf, 0xf, false)); }
template <int CTRL> DI int dpp_shr0(int v) { return __builtin_amdgcn_update_dpp(0, v, CTRL, 0xf, 0xf, true); }
template <int I> DI int bcast16(int v) { return __builtin_amdgcn_mov_dpp(v, 0x150 + I, 0xf, 0xf, false); }
DI float row_sum16(float d) {
  d += dpp_f<0xB1>(d);
  d += dpp_f<0x4E>(d);
  d += dpp_f<0x141>(d);
  d += dpp_f<0x140>(d);
  return d;
}
DI void phase_upass(const P& p, char* smem) {
  const int* idx = (const int*)(p.ws + OFF_IDX);
  const float* gv = (const float*)(p.ws + OFF_GV);
  const ushort_t* u2b = (const ushort_t*)(p.ws + OFF_U2B);
  const char* tabu = (const char*)(p.ws + OFF_TABU);
  float* coef = (float*)(p.ws + OFF_COEF);
  const int tq = tid_opaque(); const int lane = tq & 63, wave = tq >> 6;
  const int g = lane >> 4, j = lane & 15;
  int4* lst = (int4*)smem + wave * 512 + g * 128;
  const int xg = blockIdx.x & 7, bi = blockIdx.x >> 3, nb = (gridDim.x - xg + 7) >> 3;
  __syncthreads();
#pragma unroll 1
  for (int pass = 0; pass < 2; ++pass) {
    const int part = xg + 8 * pass;
#pragma unroll 1
    for (int tb = (bi * 8 + wave) * 4; tb < T_; tb += nb * 32) {
      const int tok = tb + g;
      const int4 i0 = *(const int4*)(idx + (size_t)tb * 128 + lane * 8), i1 = *(const int4*)(idx + (size_t)tb * 128 + lane * 8 + 4);
      const f32x4 g0 = *(const f32x4*)(gv + (size_t)tb * 128 + lane * 8), g1 = *(const f32x4*)(gv + (size_t)tb * 128 + lane * 8 + 4);
      u32x4 xr[8];
#pragma unroll
      for (int c = 0; c < 8; ++c) xr[c] = *(const u32x4*)(u2b + (size_t)tok * 1024 + (j + 16 * c) * 8);
      const int ev[8] = {i0.x, i0.y, i0.z, i0.w, i1.x, i1.y, i1.z, i1.w};
      const float gg[8] = {g0[0], g0[1], g0[2], g0[3], g1[0], g1[1], g1[2], g1[3]};
      int cnt = 0;
#pragma unroll
      for (int i = 0; i < 8; ++i) cnt += ((ev[i] >> 10) == part) ? 1 : 0;
      int incl = cnt;
      incl += dpp_shr0<0x111>(incl); incl += dpp_shr0<0x112>(incl); incl += dpp_shr0<0x114>(incl); incl += dpp_shr0<0x118>(incl);
      const int ng = bcast16<15>(incl);
      int pos = incl - cnt;
#pragma unroll
      for (int i = 0; i < 8; ++i)
        if ((ev[i] >> 10) == part) { int4 en; en.x = ev[i]; en.y = __float_as_int(gg[i]); en.z = j * 8 + i; en.w = 0; lst[pos] = en; ++pos; }
      const int nmax = max(max(__builtin_amdgcn_readlane(ng, 0), __builtin_amdgcn_readlane(ng, 16)), max(__builtin_amdgcn_readlane(ng, 32), __builtin_amdgcn_readlane(ng, 48)));
      __builtin_amdgcn_wave_barrier();
      asm volatile("s_waitcnt lgkmcnt(0)" ::: "memory");
      u32x4 ra[8];
      {
        const unsigned e = (ng > 0) ? (unsigned)lst[0].x : 0u;
        const char* row = tabu + (size_t)e * 2048 + j * 16;
#pragma unroll
        for (int c = 0; c < 8; ++c) ra[c] = *(const u32x4*)(row + c * 256);
      }
#pragma unroll 1
      for (int it = 0; it < nmax; ++it) {
        u32x4 rn[8];
        {
          const unsigned e = (it + 1 < ng) ? (unsigned)lst[it + 1].x : 0u;
          const char* row = tabu + (size_t)e * 2048 + j * 16;
#pragma unroll
          for (int c = 0; c < 8; ++c) rn[c] = *(const u32x4*)(row + c * 256);
        }
        float a0 = 0.f, a1 = 0.f, a2 = 0.f, a3 = 0.f;
#pragma unroll
        for (int c = 0; c < 8; ++c) {
          a0 = dot2bf(ra[c][0], xr[c][0], a0); a1 = dot2bf(ra[c][1], xr[c][1], a1);
          a2 = dot2bf(ra[c][2], xr[c][2], a2); a3 = dot2bf(ra[c][3], xr[c][3], a3);
        }
        const float d = row_sum16((a0 + a1) + (a2 + a3));
        if (j == 0 && it < ng) ((int*)&lst[it])[3] = __float_as_int(d);
#pragma unroll
        for (int c = 0; c < 8; ++c) ra[c] = rn[c];
      }
      __builtin_amdgcn_wave_barrier();
      asm volatile("s_waitcnt lgkmcnt(0)" ::: "memory");
#pragma unroll 1
      for (int k = 0; k < nmax; k += 16) {
        if (k + j < ng) {
          const int4 en = lst[k + j];
          const float a = __int_as_float(en.w);
          coef[(size_t)tok * 128 + en.z] = __int_as_float(en.y) * 0.5f * a * (1.f + erff(a * 0.7071067811865475f));
        }
      }
      __builtin_amdgcn_wave_barrier();
      asm volatile("s_waitcnt lgkmcnt(0)" ::: "memory");
    }
  }
}

struct VHdr { int ea, eb, ca, cb; };
DI VHdr vp_hdr(const int* idx, const float* coef, int tok, int g, int cq) {
  VHdr h;
  h.ea = idx[(size_t)tok * 128 + g * 32 + cq]; h.eb = idx[(size_t)tok * 128 + g * 32 + 16 + cq];
  h.ca = __float_as_int(coef[(size_t)tok * 128 + g * 32 + cq]); h.cb = __float_as_int(coef[(size_t)tok * 128 + g * 32 + 16 + cq]);
  return h;
}
DI void vp_rows(uint2 (&va)[16], uint2 (&vb)[16], const VHdr& h, const char* tb) {
#define VP_STEP(I) { va[I] = *(const uint2*)(tb + (unsigned)bcast16<I>(h.ea) * 128u); vb[I] = *(const uint2*)(tb + (unsigned)bcast16<I>(h.eb) * 128u); }
  VP_STEP(0) VP_STEP(1) VP_STEP(2) VP_STEP(3) VP_STEP(4) VP_STEP(5) VP_STEP(6) VP_STEP(7)
  VP_STEP(8) VP_STEP(9) VP_STEP(10) VP_STEP(11) VP_STEP(12) VP_STEP(13) VP_STEP(14) VP_STEP(15)
#undef VP_STEP
}
DI void vp_coefs(float (&fa)[16], float (&fb)[16], const VHdr& h) {
#define VP_STEP(I) { fa[I] = __int_as_float(bcast16<I>(h.ca)); fb[I] = __int_as_float(bcast16<I>(h.cb)); }
  VP_STEP(0) VP_STEP(1) VP_STEP(2) VP_STEP(3) VP_STEP(4) VP_STEP(5) VP_STEP(6) VP_STEP(7)
  VP_STEP(8) VP_STEP(9) VP_STEP(10) VP_STEP(11) VP_STEP(12) VP_STEP(13) VP_STEP(14) VP_STEP(15)
#undef VP_STEP
}
DI void phase_vpass(const P& p) {
  const int* idx = (const int*)(p.ws + OFF_IDX);
  const float* coef = (const float*)(p.ws + OFF_COEF);
  const char* tabv = (const char*)(p.ws + OFF_TABV);
  float* f = (float*)(p.ws + OFF_F);
  const int tq = tid_opaque(); const int lane = tq & 63, wave = tq >> 6;
  const int g = lane >> 4, cq = lane & 15;
  const int xg = blockIdx.x & 7, bi = blockIdx.x >> 3, nb = (gridDim.x - xg + 7) >> 3;
  const int step = nb * 8;
#pragma unroll 1
  for (int pass = 0; pass < 2; ++pass) {
    const int slice = xg + 8 * pass;
    const char* tb = tabv + (size_t)slice * (16384 * 128) + cq * 8;
    int tok = bi * 8 + wave;
    if (tok >= T_) continue;
    VHdr hc = vp_hdr(idx, coef, tok, g, cq);
    VHdr hn = vp_hdr(idx, coef, min(tok + step, T_ - 1), g, cq);
    uint2 va[16], vb[16];
    vp_rows(va, vb, hc, tb);
#pragma unroll 1
    for (; tok < T_; tok += step) {
      const VHdr hnn = vp_hdr(idx, coef, min(tok + 2 * step, T_ - 1), g, cq);
      uint2 na[16], nb2[16];
      vp_rows(na, nb2, hn, tb);
      float fa[16], fb[16];
      vp_coefs(fa, fb, hc);
      float a0 = 0.f, a1 = 0.f, a2 = 0.f, a3 = 0.f;
#pragma unroll
      for (int i = 0; i < 16; ++i) {
        a0 += fa[i] * __uint_as_float(va[i].x << 16); a1 += fa[i] * __uint_as_float(va[i].x & 0xffff0000u);
        a2 += fa[i] * __uint_as_float(va[i].y << 16); a3 += fa[i] * __uint_as_float(va[i].y & 0xffff0000u);
        a0 += fb[i] * __uint_as_float(vb[i].x << 16); a1 += fb[i] * __uint_as_float(vb[i].x & 0xffff0000u);
        a2 += fb[i] * __uint_as_float(vb[i].y << 16); a3 += fb[i] * __uint_as_float(vb[i].y & 0xffff0000u);
      }
      a0 += __shfl_xor(a0, 16); a1 += __shfl_xor(a1, 16); a2 += __shfl_xor(a2, 16); a3 += __shfl_xor(a3, 16);
      a0 += __shfl_xor(a0, 32); a1 += __shfl_xor(a1, 32); a2 += __shfl_xor(a2, 32); a3 += __shfl_xor(a3, 32);
      if (g == 0) { f32x4 o; o[0] = a0; o[1] = a1; o[2] = a2; o[3] = a3; *(f32x4*)(f + (size_t)tok * 1024 + slice * 64 + cq * 4) = o; }
#pragma unroll
      for (int i = 0; i < 16; ++i) { va[i] = na[i]; vb[i] = nb2[i]; }
      hc = hn; hn = hnn;
    }
  }
}

DI void phase_ln2(const P& p) {
  const float* ada = (const float*)(p.ws + OFF_ADA);
  const float* f = (const float*)(p.ws + OFF_F);
  const int tq = tid_opaque(); const int lane = tq & 63, wave = tq >> 6;
  for (int tok = blockIdx.x * 8 + wave; tok < T_; tok += gridDim.x * 8) {
    const int b = tok / S_;
    float* rp = p.out + (size_t)tok * 1024;
    f32x4 acc[4];
    float sm = 0.f;
#pragma unroll
    for (int i = 0; i < 4; ++i) {
      const int col = i * 256 + lane * 4;
      f32x4 x1 = *(const f32x4*)(rp + col), ff = *(const f32x4*)(f + (size_t)tok * 1024 + col);
      f32x4 g2 = *(const f32x4*)(ada + b * 6144 + 5 * 1024 + col);
#pragma unroll
      for (int j = 0; j < 4; ++j) { acc[i][j] = DN_ALPHA * x1[j] + (1.f + g2[j]) * ff[j]; sm += acc[i][j]; }
    }
    const float mu = wave_sum(sm) * (1.f / 1024.f);
    float q = 0.f;
#pragma unroll
    for (int i = 0; i < 4; ++i)
#pragma unroll
      for (int j = 0; j < 4; ++j) { float d = acc[i][j] - mu; q += d * d; }
    const float rs = rsqrtf(wave_sum(q) * (1.f / 1024.f) + LN_EPS);
#pragma unroll
    for (int i = 0; i < 4; ++i) {
      const int col = i * 256 + lane * 4;
      f32x4 gg = *(const f32x4*)(p.ln2_g + col), bb = *(const f32x4*)(p.ln2_b + col), o;
#pragma unroll
      for (int j = 0; j < 4; ++j) o[j] = (acc[i][j] - mu) * rs * gg[j] + bb[j];
      *(f32x4*)(rp + col) = o;
    }
  }
}

#define XB_TMO      128
#define XB_XCNT(j)  (256  + 64 * (j))
#define XB_XSUB(j)  (1280 + 64 * (j))
#define XB_XGEN(j)  (2304 + 64 * (j))
#define XB_TOP      3328
#define XB_TOPGEN   3392
#define XCD_BAR_WORDS 3456
#define XB_SPIN_CAP (1u << 22)
#define LAS __attribute__((address_space(3)))
DI unsigned xb_ld(unsigned* p)              { return __hip_atomic_load(p, __ATOMIC_RELAXED, __HIP_MEMORY_SCOPE_AGENT); }
DI unsigned xb_add(unsigned* p, unsigned v) { return __hip_atomic_fetch_add(p, v, __ATOMIC_RELAXED, __HIP_MEMORY_SCOPE_AGENT); }
DI unsigned xb_xcc_id() { return (unsigned)__builtin_amdgcn_s_getreg((3 << 11) | 20) & 0xFu; }
#define XB_SPIN(cond, bar) do { unsigned _sp = 0; while (cond) { __builtin_amdgcn_s_sleep(1); \
    if ((++_sp & 255u) == 0u) { if (xb_ld(&(bar)[XB_TMO])) break; if (_sp > XB_SPIN_CAP) { atomicAdd(&(bar)[XB_TMO], 1u); break; } } } } while (0)
struct XcdBarrier { unsigned* bar; unsigned x; volatile LAS unsigned* st; };
DI XcdBarrier xcd_barrier_post(unsigned* bar, volatile LAS unsigned* st) {
  XcdBarrier b; b.bar = bar; b.x = xb_xcc_id(); b.st = st;
  if (threadIdx.x == 0) (void)xb_add(&bar[XB_XCNT(b.x)], 1u);
  return b;
}
DI void xcd_barrier_complete(unsigned* bar, unsigned x, unsigned& nloc, unsigned& nx) {
  const unsigned G = gridDim.x * gridDim.y * gridDim.z;
  unsigned sum, cnt, mine, sp = 0u;
  for (;;) {
    sum = 0u; cnt = 0u; mine = 0u;
#pragma unroll
    for (unsigned j = 0; j < 16; ++j) { const unsigned c = xb_ld(&bar[XB_XCNT(j)]); sum += c; cnt += (c > 0u) ? 1u : 0u; mine = (j == x) ? c : mine; }
    if (sum == G) break;
    __builtin_amdgcn_s_sleep(1);
    if ((++sp & 255u) == 0u) { if (xb_ld(&bar[XB_TMO])) break; if (sp > XB_SPIN_CAP) { atomicAdd(&bar[XB_TMO], 1u); break; } }
  }
  nloc = mine > 0u ? mine : 1u; nx = cnt > 0u ? cnt : 1u;
}
DI void xcd_barrier(unsigned* barp, char* stp) {
  asm volatile("s_waitcnt vmcnt(0)" ::: "memory");
  __syncthreads();
  if (threadIdx.x == 0) {
    XcdBarrier b; b.bar = barp; b.x = xb_xcc_id(); b.st = (volatile LAS unsigned*)stp;
    unsigned* bar = b.bar;
    __builtin_amdgcn_s_waitcnt(0);
    unsigned nloc = b.st[0], nx = b.st[1];
    if (nloc == 0u) { xcd_barrier_complete(bar, b.x, nloc, nx); b.st[0] = nloc; b.st[1] = nx; }
    const unsigned old = xb_add(&bar[XB_XSUB(b.x)], 1u);
    const unsigned gen = old / nloc;
    if (old + 1u == (gen + 1u) * nloc) {
      __builtin_amdgcn_fence(__ATOMIC_RELEASE, "agent");
      asm volatile("s_waitcnt vmcnt(0)" ::: "memory");
      const unsigned og = xb_add(&bar[XB_TOP], 1u);
      const unsigned tg = og / nx;
      if (og + 1u == (tg + 1u) * nx) xb_add(&bar[XB_TOPGEN], 1u);
      else XB_SPIN(xb_ld(&bar[XB_TOPGEN]) == tg, bar);
      __builtin_amdgcn_fence(__ATOMIC_ACQUIRE, "agent");
      xb_add(&bar[XB_XGEN(b.x)], 1u);
      asm volatile("s_waitcnt vmcnt(0)" ::: "memory");
    } else {
      XB_SPIN(xb_ld(&bar[XB_XGEN(b.x)]) == gen, bar);
      __builtin_amdgcn_fence(__ATOMIC_ACQUIRE, "agent");
      asm volatile("s_waitcnt vmcnt(0)" ::: "memory");
    }
  }
  __syncthreads();
}

constexpr int SMEM_BYTES = 143360;
__global__ void __launch_bounds__(NT) fwd_megakernel(P p) {
  __shared__ __attribute__((aligned(16))) char smem[SMEM_BYTES + 16];
  if (threadIdx.x < 4) ((volatile LAS unsigned*)(smem + SMEM_BYTES))[threadIdx.x] = 0u;
  __syncthreads();
  (void)xcd_barrier_post((unsigned*)(p.ws + OFF_BAR), (volatile LAS unsigned*)(smem + SMEM_BYTES));
  phase_ada(p, smem);
  phase_transposes(p, smem);
  phase_keys(p);
  phase_filter(p, smem);
  xcd_barrier((unsigned*)(p.ws + OFF_BAR), smem + SMEM_BYTES);
  phase_inproj(p, smem);
  xcd_barrier((unsigned*)(p.ws + OFF_BAR), smem + SMEM_BYTES);
  for (int item = blockIdx.x; item < 512 + 256; item += gridDim.x) {
    if (item < 512) hyena_item(p, smem, item);
    else attn_item(p, smem, item - 512);
  }
  xcd_barrier((unsigned*)(p.ws + OFF_BAR), smem + SMEM_BYTES);
  phase_merge(p, smem);
  xcd_barrier((unsigned*)(p.ws + OFF_BAR), smem + SMEM_BYTES);
  phase_outproj(p, smem);
  xcd_barrier((unsigned*)(p.ws + OFF_BAR), smem + SMEM_BYTES);
  phase_ln1(p);
  phase_tabconv(p);
  xcd_barrier((unsigned*)(p.ws + OFF_BAR), smem + SMEM_BYTES);
  phase_route(p, smem);
  xcd_barrier((unsigned*)(p.ws + OFF_BAR), smem + SMEM_BYTES);
  phase_upass(p, smem);
  xcd_barrier((unsigned*)(p.ws + OFF_BAR), smem + SMEM_BYTES);
  phase_vpass(p);
  xcd_barrier((unsigned*)(p.ws + OFF_BAR), smem + SMEM_BYTES);
  phase_ln2(p);
}

extern "C" void kernel_launch(void* const* d_in, const int* in_sizes, int n_in, void* d_out, int out_size, void* d_ws, size_t ws_size,
                              hipStream_t stream) {
  P p{};
  p.x = (const float*)d_in[0]; p.c = (const float*)d_in[1]; p.pos = (const int*)d_in[2];
  p.w_ada = (const float*)d_in[3]; p.b_ada = (const float*)d_in[4]; p.w_in = (const float*)d_in[5];
  p.hy_conv_w = (const float*)d_in[6]; p.hy_conv_b = (const float*)d_in[7];
  p.f1_w = (const float*)d_in[8]; p.f1_b = (const float*)d_in[9]; p.f1_freq = (const float*)d_in[10];
  p.f2_w = (const float*)d_in[11]; p.f2_b = (const float*)d_in[12]; p.f2_freq = (const float*)d_in[13];
  p.f3_w = (const float*)d_in[14]; p.hy_bias = (const float*)d_in[15];
  p.w_bh = (const float*)d_in[16]; p.w_ba = (const float*)d_in[17]; p.w_out = (const float*)d_in[18];
  p.ln1_g = (const float*)d_in[19]; p.ln1_b = (const float*)d_in[20];
  p.wq = (const float*)d_in[21]; p.keys = (const float*)d_in[22]; p.pu = (const float*)d_in[23]; p.pv = (const float*)d_in[24];
  p.ln2_g = (const float*)d_in[25]; p.ln2_b = (const float*)d_in[26];
  p.out = (float*)d_out; p.ws = (char*)d_ws;

  static int grid_blocks = 0;
  if (!grid_blocks) {
    int dev = 0, cus = 0, per_cu = 0;
    hipGetDevice(&dev);
    hipDeviceGetAttribute(&cus, hipDeviceAttributeMultiprocessorCount, dev);
    hipOccupancyMaxActiveBlocksPerMultiprocessor(&per_cu, fwd_megakernel, NT, 0);
    if (per_cu > 1) per_cu = 1;
    grid_blocks = cus * per_cu;
  }
  (void)hipMemsetAsync((char*)d_ws + OFF_BAR, 0, XCD_BAR_WORDS * 4, stream);
  void* args[] = {&p};
  hipError_t e = hipLaunchCooperativeKernel((void*)fwd_megakernel, dim3(grid_blocks), dim3(NT), args, 0, stream);
  if (e != hipSuccess) fprintf(stderr, "cooperative launch failed: %s (grid %d)\n", hipGetErrorString(e), grid_blocks);
}
```

```cpp
#include <hip/hip_runtime.h>
#include <hip/hip_cooperative_groups.h>
#include <cstdio>
#include <cstdint>

#define DI __device__ __forceinline__
typedef unsigned short ushort_t;
typedef __attribute__((ext_vector_type(8))) short bf16x8;
typedef __attribute__((ext_vector_type(16))) float f32x16;
typedef __attribute__((ext_vector_type(4))) float f32x4;
typedef __attribute__((ext_vector_type(4))) unsigned u32x4;

constexpr int T_ = 16384, S_ = 8192, NB = 2, D_ = 1024;
constexpr int HW_ = 512, HYC = 1536, QKVC = 2304, GATEC = 2048, INW = 5888;
constexpr int NT = 512;
constexpr float DN_ALPHA = 1.189207115002721f;
constexpr float LN_EPS = 1e-5f;

constexpr size_t OFF_ADA   = 0;
constexpr size_t OFF_BAR   = 49152;
constexpr size_t OFF_KEYS_B= 65536;
constexpr size_t OFF_WIN_T = 65536 + 524288;
constexpr size_t OFF_WQ_T  = OFF_WIN_T + (size_t)INW * 1024 * 2;
constexpr size_t OFF_WOUT_T= OFF_WQ_T + (size_t)2048 * 1024 * 2;
constexpr size_t OFF_WBH_T = OFF_WOUT_T + (size_t)1024 * 1024 * 2;
constexpr size_t OFF_WBA_T = OFF_WBH_T + (size_t)1024 * 512 * 2;
constexpr size_t OFF_PH    = OFF_WBA_T + (size_t)1024 * 256 * 2;
constexpr size_t OFF_QKV   = OFF_PH + (size_t)T_ * HYC * 2;
constexpr size_t OFF_GATE  = OFF_QKV + (size_t)T_ * QKVC * 2;
constexpr size_t OFF_YH    = OFF_GATE + (size_t)T_ * GATEC * 2;
constexpr size_t OFF_YA    = OFF_YH + (size_t)T_ * HW_ * 2;
constexpr size_t OFF_END   = OFF_YA + (size_t)T_ * 256 * 2;
constexpr size_t OFF_MERGED= OFF_PH;
constexpr size_t OFF_U1B   = OFF_YH;
static_assert(OFF_U1B + (size_t)T_ * 1024 * 2 <= 268435456ull, "u1b overflow");
constexpr size_t OFF_U2B   = OFF_PH;
constexpr size_t OFF_TABU  = OFF_QKV;
constexpr size_t OFF_TABV  = OFF_QKV + (size_t)32 * 1048576;
constexpr size_t OFF_COEF  = OFF_QKV + (size_t)64 * 1048576;
constexpr size_t OFF_F     = OFF_QKV + (size_t)72 * 1048576;
static_assert(OFF_F + (size_t)64 * 1048576 <= OFF_YH, "peer buffers overflow the qkv+gate region");
constexpr size_t OFF_IDX   = OFF_YH;
constexpr size_t OFF_GV    = OFF_YH + (size_t)T_ * 128 * 4;
constexpr size_t OFF_HSCR  = OFF_END;
static_assert(OFF_HSCR + (size_t)164 * 131072 <= 268435456ull, "ws overflow");
static_assert((size_t)92 * 131072 <= (size_t)INW * 1024 * 2, "w_in^T region too small");
constexpr size_t OFF_ROPE  = OFF_HSCR + (size_t)164 * 131072;
static_assert(OFF_ROPE + (size_t)T_ * 64 <= 268435456ull, "rope table overflow");

struct P {
  const float *x, *c; const int* pos;
  const float *w_ada, *b_ada, *w_in, *hy_conv_w, *hy_conv_b, *f1_w, *f1_b, *f1_freq, *f2_w, *f2_b, *f2_freq, *f3_w,
      *hy_bias, *w_bh, *w_ba, *w_out, *ln1_g, *ln1_b, *wq, *keys, *pu, *pv, *ln2_g, *ln2_b;
  float* out; char* ws;
};

DI ushort_t f2bf(float x) { unsigned u = __float_as_uint(x); u += 0x7fffu + ((u >> 16) & 1u); return (ushort_t)(u >> 16); }
DI float bf2f(ushort_t h) { return __uint_as_float(((unsigned)h) << 16); }
typedef __bf16 bf16x2_hw __attribute__((ext_vector_type(2)));
typedef float f32x2_hw __attribute__((ext_vector_type(2)));
DI unsigned pack2(float a, float b) { f32x2_hw v = {a, b}; return __builtin_bit_cast(unsigned, __builtin_convertvector(v, bf16x2_hw)); }
DI int tid_opaque() { int t = threadIdx.x; asm volatile("" : "+v"(t)); return t; }
DI float wave_sum(float v) {
#pragma unroll
  for (int o = 32; o > 0; o >>= 1) v += __shfl_xor(v, o);
  return v;
}

struct cf2 { float x, y; };
constexpr int FFT_N = 16384, FFT_SA = 560;

DI constexpr float wcos32(int j) {
  switch (j & 31) {
    case 0: return 1.0f; case 1: return 0.98078528040323043f; case 2: return 0.92387953251128674f; case 3: return 0.83146961230254524f;
    case 4: return 0.70710678118654752f; case 5: return 0.55557023301960218f; case 6: return 0.38268343236508978f; case 7: return 0.19509032201612825f;
    case 8: return 0.0f; case 9: return -0.19509032201612825f; case 10: return -0.38268343236508978f; case 11: return -0.55557023301960218f;
    case 12: return -0.70710678118654752f; case 13: return -0.83146961230254524f; case 14: return -0.92387953251128674f; case 15: return -0.98078528040323043f;
    case 16: return -1.0f; case 17: return -0.98078528040323043f; case 18: return -0.92387953251128674f; case 19: return -0.83146961230254524f;
    case 20: return -0.70710678118654752f; case 21: return -0.55557023301960218f; case 22: return -0.38268343236508978f; case 23: return -0.19509032201612825f;
    case 24: return 0.0f; case 25: return 0.19509032201612825f; case 26: return 0.38268343236508978f; case 27: return 0.55557023301960218f;
    case 28: return 0.70710678118654752f; case 29: return 0.83146961230254524f; case 30: return 0.92387953251128674f; default: return 0.98078528040323043f;
  }
}
DI constexpr float wsin32(int j) { return wcos32(j + 24); }
DI constexpr int brev(int v, int bits) { int r = 0; for (int i = 0; i < bits; ++i) r |= ((v >> i) & 1) << (bits - 1 - i); return r; }

template <int R, int LEN, bool INV, bool ZHI>
DI void r2_stage(float (&re)[R], float (&im)[R]) {
  constexpr int half = LEN / 2;
#pragma unroll
  for (int start = 0; start < R; start += LEN) {
#pragma unroll
    for (int j = 0; j < half; ++j) {
      const int a = start + j, b = a + half;
      const int tj = j * (32 / LEN);
      const float c = wcos32(tj), s = wsin32(tj);
      if (!INV) {
        float dr, di;
        if (ZHI) { dr = re[a]; di = im[a]; }
        else {
          const float ar = re[a], ai = im[a], br = re[b], bi = im[b];
          re[a] = ar + br; im[a] = ai + bi; dr = ar - br; di = ai - bi;
        }
        if (tj == 0) { re[b] = dr; im[b] = di; }
        else if (tj == 8) { re[b] = di; im[b] = -dr; }
        else { re[b] = dr * c + di * s; im[b] = di * c - dr * s; }
      } else {
        const float br = re[b], bi = im[b];
        float pr, pi;
        if (tj == 0) { pr = br; pi = bi; }
        else if (tj == 8) { pr = -bi; pi = br; }
        else { pr = br * c - bi * s; pi = bi * c + br * s; }
        const float ar = re[a], ai = im[a];
        re[a] = ar + pr; im[a] = ai + pi; re[b] = ar - pr; im[b] = ai - pi;
      }
    }
  }
}
template <int R, bool ZHI> DI void dft_fwd(float (&re)[R], float (&im)[R]) {
  if (R == 32) r2_stage<R, (R == 32 ? 32 : 2), false, ZHI>(re, im);
  r2_stage<R, 16, false, (R == 16) && ZHI>(re, im);
  r2_stage<R, 8, false, false>(re, im);
  r2_stage<R, 4, false, false>(re, im);
  r2_stage<R, 2, false, false>(re, im);
}
template <int R> DI void dft_inv(float (&re)[R], float (&im)[R]) {
  r2_stage<R, 2, true, false>(re, im);
  r2_stage<R, 4, true, false>(re, im);
  r2_stage<R, 8, true, false>(re, im);
  r2_stage<R, 16, true, false>(re, im);
  if (R == 32) r2_stage<R, (R == 32 ? 32 : 2), true, false>(re, im);
}

DI void sincos_turn(float frac, float& s, float& c) { sincospif(2.0f * frac, &s, &c); }

template <bool ZHI>
DI void fft_fwdA(float (&re)[32], float (&im)[32], cf2* lds, int m) {
  asm volatile("" : "+v"(m));
  float s1, c1; sincos_turn((float)m * (1.0f / 16384.0f), s1, c1);
  __builtin_amdgcn_sched_barrier(0);
  dft_fwd<32, ZHI>(re, im);
  __builtin_amdgcn_sched_barrier(0);
  float wr = 1.f, wi = 0.f;
#pragma unroll
  for (int k1 = 0; k1 < 32; ++k1) {
    if ((k1 & 3) == 0) __builtin_amdgcn_sched_barrier(0);
    const int r = brev(k1, 5);
    cf2 o; o.x = re[r] * wr - im[r] * wi; o.y = re[r] * wi + im[r] * wr;
    lds[k1 * FFT_SA + m] = o;
    const float nr = wr * c1 + wi * s1, ni = wi * c1 - wr * s1;
    wr = nr; wi = ni;
  }
}
DI void fft_B_read(float (&re)[32], float (&im)[32], const cf2* lds, int tid) {
  const int k1 = tid >> 4, mp = tid & 15;
#pragma unroll
  for (int n2 = 0; n2 < 32; ++n2) { cf2 v = lds[k1 * FFT_SA + n2 * 16 + mp]; re[n2] = v.x; im[n2] = v.y; }
}
DI void fft_fwdB_write(float (&re)[32], float (&im)[32], cf2* lds, int tid) {
  asm volatile("" : "+v"(tid));
  const int k1 = tid >> 4, mp = tid & 15;
  float s1, c1; sincos_turn((float)mp * (1.0f / 512.0f), s1, c1);
  __builtin_amdgcn_sched_barrier(0);
  dft_fwd<32, false>(re, im);
  __builtin_amdgcn_sched_barrier(0);
  float wr = 1.f, wi = 0.f;
#pragma unroll
  for (int k2 = 0; k2 < 32; ++k2) {
    if ((k2 & 3) == 0) __builtin_amdgcn_sched_barrier(0);
    const int r = brev(k2, 5);
    cf2 o; o.x = re[r] * wr - im[r] * wi; o.y = re[r] * wi + im[r] * wr;
    lds[k1 * FFT_SA + k2 * 17 + mp] = o;
    const float nr = wr * c1 + wi * s1, ni = wi * c1 - wr * s1;
    wr = nr; wi = ni;
  }
}
DI void fft_fwdC(float (&re)[32], float (&im)[32], const cf2* lds, int tid) {
  const int k1 = tid >> 5, k2 = tid & 31;
#pragma unroll
  for (int h = 0; h < 2; ++h) {
    float tr[16], ti[16];
#pragma unroll
    for (int mp = 0; mp < 16; ++mp) { cf2 v = lds[(k1 + 16 * h) * FFT_SA + k2 * 17 + mp]; tr[mp] = v.x; ti[mp] = v.y; }
    dft_fwd<16, false>(tr, ti);
#pragma unroll
    for (int i = 0; i < 16; ++i) { re[h * 16 + i] = tr[i]; im[h * 16 + i] = ti[i]; }
  }
}
DI void fft_invC(float (&re)[32], float (&im)[32], cf2* lds, int tid) {
  const int k1 = tid >> 5, k2 = tid & 31;
#pragma unroll
  for (int h = 0; h < 2; ++h) {
    float tr[16], ti[16];
#pragma unroll
    for (int i = 0; i < 16; ++i) { tr[i] = re[h * 16 + i]; ti[i] = im[h * 16 + i]; }
    dft_inv<16>(tr, ti);
#pragma unroll
    for (int mp = 0; mp < 16; ++mp) { cf2 o; o.x = tr[mp]; o.y = ti[mp]; lds[(k1 + 16 * h) * FFT_SA + k2 * 17 + mp] = o; }
  }
}
DI void fft_invB_read(float (&re)[32], float (&im)[32], const cf2* lds, int tid) {
  asm volatile("" : "+v"(tid));
  const int k1 = tid >> 4, mp = tid & 15;
  float s1, c1; sincos_turn((float)mp * (1.0f / 512.0f), s1, c1);
  float wr = 1.f, wi = 0.f;
  __builtin_amdgcn_sched_barrier(0);
#pragma unroll
  for (int k2 = 0; k2 < 32; ++k2) {
    if ((k2 & 3) == 0) __builtin_amdgcn_sched_barrier(0);
    const int r = brev(k2, 5);
    cf2 v = lds[k1 * FFT_SA + k2 * 17 + mp];
    re[r] = v.x * wr - v.y * wi; im[r] = v.x * wi + v.y * wr;
    const float nr = wr * c1 - wi * s1, ni = wi * c1 + wr * s1;
    wr = nr; wi = ni;
  }
}
DI void fft_invB_write(float (&re)[32], float (&im)[32], cf2* lds, int tid) {
  const int k1 = tid >> 4, mp = tid & 15;
  dft_inv<32>(re, im);
#pragma unroll
  for (int n2 = 0; n2 < 32; ++n2) { cf2 o; o.x = re[n2]; o.y = im[n2]; lds[k1 * FFT_SA + n2 * 16 + mp] = o; }
}
DI void fft_invA(float (&re)[32], float (&im)[32], const cf2* lds, int m) {
  asm volatile("" : "+v"(m));
  float s1, c1; sincos_turn((float)m * (1.0f / 16384.0f), s1, c1);
  float wr = 1.f, wi = 0.f;
  __builtin_amdgcn_sched_barrier(0);
#pragma unroll
  for (int k1 = 0; k1 < 32; ++k1) {
    if ((k1 & 3) == 0) __builtin_amdgcn_sched_barrier(0);
    const int r = brev(k1, 5);
    cf2 v = lds[k1 * FFT_SA + m];
    re[r] = v.x * wr - v.y * wi; im[r] = v.x * wi + v.y * wr;
    const float nr = wr * c1 - wi * s1, ni = wi * c1 + wr * s1;
    wr = nr; wi = ni;
  }
  __builtin_amdgcn_sched_barrier(0);
  dft_inv<32>(re, im);
}

DI void phase_ada(const P& p, char* smem) {
  float (*red)[16][32] = (float (*)[16][32])smem;
  const int tid = tid_opaque(), cl = tid & 31, kq = tid >> 5;
  for (int item = blockIdx.x; item < 192; item += gridDim.x) {
    const int col = item * 32 + cl;
    float a0 = 0.f, a1 = 0.f;
#pragma unroll 16
    for (int k = kq * 64; k < kq * 64 + 64; ++k) {
      const float w = p.w_ada[(size_t)k * 6144 + col];
      const float c0 = p.c[k], c1 = p.c[1024 + k];
      a0 += (c0 / (1.f + __expf(-c0))) * w;
      a1 += (c1 / (1.f + __expf(-c1))) * w;
    }
    __syncthreads();
    red[0][kq][cl] = a0; red[1][kq][cl] = a1;
    __syncthreads();
    if (tid < 64) {
      const int b = tid >> 5;
      float s = p.b_ada[col];
#pragma unroll
      for (int q = 0; q < 16; ++q) s += red[b][q][cl];
      ((float*)(p.ws + OFF_ADA))[b * 6144 + col] = s;
    }
  }
}
DI void phase_u1(const P& p) {
  const float* ada = (const float*)(p.ws + OFF_ADA);
  ushort_t* u1b = (ushort_t*)(p.ws + OFF_U1B);
  for (int i = blockIdx.x * NT + tid_opaque(); i < T_ * 128; i += gridDim.x * NT) {
    const int row = i >> 7, k = (i & 127) * 8, b = row / S_;
    const float* xp = p.x + (size_t)row * 1024 + k;
    const f32x4 x0 = *(const f32x4*)xp, x1 = *(const f32x4*)(xp + 4);
    const f32x4 s0 = *(const f32x4*)(ada + b * 6144 + 1024 + k), s1 = *(const f32x4*)(ada + b * 6144 + 1024 + k + 4);
    const f32x4 h0 = *(const f32x4*)(ada + b * 6144 + k), h1 = *(const f32x4*)(ada + b * 6144 + k + 4);
    u32x4 o;
    o[0] = pack2(x0[0] * (1.f + s0[0]) + h0[0], x0[1] * (1.f + s0[1]) + h0[1]);
    o[1] = pack2(x0[2] * (1.f + s0[2]) + h0[2], x0[3] * (1.f + s0[3]) + h0[3]);
    o[2] = pack2(x1[0] * (1.f + s1[0]) + h1[0], x1[1] * (1.f + s1[1]) + h1[1]);
    o[3] = pack2(x1[2] * (1.f + s1[2]) + h1[2], x1[3] * (1.f + s1[3]) + h1[3]);
    *(u32x4*)(u1b + (size_t)row * 1024 + k) = o;
  }
}

DI void transpose_tile(const float* __restrict__ W, ushort_t* __restrict__ Wt, int K, int N, int item, char* smem) {
  float (*tile)[65] = (float (*)[65])smem;
  const int ntn = N / 64;
  const int n0 = (item % ntn) * 64, k0 = (item / ntn) * 32;
  const int tid = tid_opaque();
  __syncthreads();
  {
    const int tx = tid & 63, ty = tid >> 6;
#pragma unroll
    for (int i = 0; i < 4; ++i) tile[ty + 8 * i][tx] = W[(size_t)(k0 + ty + 8 * i) * N + n0 + tx];
  }
  __syncthreads();
  {
    const int kk = tid & 31, nn0 = tid >> 5;
#pragma unroll
    for (int i = 0; i < 4; ++i) Wt[(size_t)(n0 + nn0 + 16 * i) * K + k0 + kk] = f2bf(tile[kk][nn0 + 16 * i]);
  }
}
DI void phase_transposes(const P& p, char* smem) {
  constexpr int I0 = (INW / 64) * 32, I1 = I0 + 32 * 32, I2 = I1 + 16 * 32, I3 = I2 + 16 * 16, I4 = I3 + 16 * 8;
  for (int item = blockIdx.x; item < I4; item += gridDim.x) {
    if (item < I0) transpose_tile(p.w_in, (ushort_t*)(p.ws + OFF_WIN_T), 1024, INW, item, smem);
    else if (item < I1) transpose_tile(p.wq, (ushort_t*)(p.ws + OFF_WQ_T), 1024, 2048, item - I0, smem);
    else if (item < I2) transpose_tile(p.w_out, (ushort_t*)(p.ws + OFF_WOUT_T), 1024, 1024, item - I1, smem);
    else if (item < I3) transpose_tile(p.w_bh, (ushort_t*)(p.ws + OFF_WBH_T), 512, 1024, item - I2, smem);
    else transpose_tile(p.w_ba, (ushort_t*)(p.ws + OFF_WBA_T), 256, 1024, item - I3, smem);
  }
}

DI void phase_filter(const P& p, char* smem) {
  float (*zf)[33] = (float (*)[33])smem;
  float (*h1)[64] = (float (*)[64])(smem + 4352);
  float (*h2T)[32] = (float (*)[32])(smem + 4352 + 8192);
  const int tid = tid_opaque();
  for (int item = blockIdx.x; item < 256; item += gridDim.x) {
  const int t0 = item * 32;
  __syncthreads();
  for (int idx = tid; idx < 32 * 33; idx += NT) {
    int tt = idx / 33, e = idx % 33, t = t0 + tt;
    float tl = (float)t * (1.0f / 8191.0f);
    float w = 6.283185307179586f * (float)t / 8192.0f;
    float val;
    if (e == 0) val = tl;
    else {
      int i = (e - 1) & 15;
      float f = 1e-4f + (float)i * ((15.0f - 1e-4f) / 15.0f);
      val = (e <= 16) ? cosf(f * w) : -sinf(f * w);
    }
    zf[tt][e] = val;
  }
  __syncthreads();
  for (int idx = tid; idx < 32 * 64; idx += NT) {
    int tt = idx >> 6, j = idx & 63;
    float a = p.f1_b[j];
    for (int e = 0; e < 33; ++e) a += zf[tt][e] * p.f1_w[e * 64 + j];
    h1[tt][j] = sinf(p.f1_freq[j] * a);
  }
  __syncthreads();
  for (int idx = tid; idx < 32 * 64; idx += NT) {
    int tt = idx >> 6, j = idx & 63;
    float a = p.f2_b[j];
    for (int e = 0; e < 64; ++e) a += h1[tt][e] * p.f2_w[e * 64 + j];
    h2T[j][tt] = sinf(p.f2_freq[j] * a);
  }
  __syncthreads();
  float* filt = p.out;
  const float min_decay = -3.0701134573253945f, max_decay = -15.350567286626973f;
  for (int col = tid; col < 2048; col += NT) {
    float acc[32];
#pragma unroll
    for (int i = 0; i < 32; ++i) acc[i] = 0.f;
    for (int j = 0; j < 64; ++j) {
      float w = p.f3_w[j * 2048 + col];
#pragma unroll
      for (int q = 0; q < 8; ++q) {
        f32x4 h = *(const f32x4*)&h2T[j][q * 4];
        acc[q * 4 + 0] += h[0] * w; acc[q * 4 + 1] += h[1] * w; acc[q * 4 + 2] += h[2] * w; acc[q * 4 + 3] += h[3] * w;
      }
    }
    int c = col & 511;
    float delta = fabsf(min_decay + (float)c * ((max_decay - min_decay) / 511.0f));
    float* dst = filt + (size_t)col * 8192 + t0;
#pragma unroll
    for (int q = 0; q < 8; ++q) {
      f32x4 o;
#pragma unroll
      for (int r = 0; r < 4; ++r) {
        float tl = (float)(t0 + q * 4 + r) * (1.0f / 8191.0f);
        o[r] = acc[q * 4 + r] * __expf(-tl * delta);
      }
      *(f32x4*)(dst + q * 4) = o;
    }
  }
  }
}

constexpr int BM = 256, BN = 128, BK = 64;
constexpr int LDS_A = BM * BK * 2, LDS_B = BN * BK * 2, LDS_STAGE = LDS_A + LDS_B;
constexpr int GEMM_LDS = 2 * LDS_STAGE + 8192;

DI int swz(int row, int ch) { return row * 128 + ((ch ^ (row & 7)) << 4); }

struct ALoadBf16 {
  const ushort_t* A; int lda;
  struct Raw { u32x4 v; };
  DI Raw fetch(int row, int k) const { Raw r; r.v = *(const u32x4*)(A + (size_t)row * lda + k); return r; }
  DI u32x4 cvt(const Raw& r, int k) const { return r.v; }
};
struct ALoadF32Mod {
  const float* A; const float* mod;
  struct Raw { f32x4 a, b; };
  DI Raw fetch(int row, int k) const { Raw r; const float* s = A + (size_t)row * 1024 + k; r.a = *(const f32x4*)s; r.b = *(const f32x4*)(s + 4); return r; }
  DI u32x4 cvt(const Raw& r, int k) const {
    f32x4 s0 = *(const f32x4*)(mod + k), s1 = *(const f32x4*)(mod + k + 4);
    f32x4 h0 = *(const f32x4*)(mod + 1024 + k), h1 = *(const f32x4*)(mod + 1024 + k + 4);
    u32x4 o;
    o[0] = pack2(r.a[0] * s0[0] + h0[0], r.a[1] * s0[1] + h0[1]);
    o[1] = pack2(r.a[2] * s0[2] + h0[2], r.a[3] * s0[3] + h0[3]);
    o[2] = pack2(r.b[0] * s1[0] + h1[0], r.b[1] * s1[1] + h1[1]);
    o[3] = pack2(r.b[2] * s1[2] + h1[2], r.b[3] * s1[3] + h1[3]);
    return o;
  }
};

template <class AL, bool SWAP = false>
DI void gemm_mainloop(f32x16 (&acc)[2][2], const AL& al, int m0, const ushort_t* __restrict__ Bt, int ldb, int n0, int K, char* smem) {
  const int tid = tid_opaque(), lane = tid & 63, wave = tid >> 6;
  const int wm = wave >> 1, wn = wave & 1;
  const int lr = tid >> 3, lc = tid & 7;
  typename AL::Raw ra[4]; u32x4 rb[2];
  const int nk = K / BK;
#pragma unroll
  for (int i = 0; i < 4; ++i) ra[i] = al.fetch(m0 + lr + 64 * i, lc * 8);
#pragma unroll
  for (int i = 0; i < 2; ++i) rb[i] = *(const u32x4*)(Bt + (size_t)(n0 + lr + 64 * i) * ldb + lc * 8);
  __syncthreads();
#pragma unroll
  for (int i = 0; i < 4; ++i) *(u32x4*)(smem + swz(lr + 64 * i, lc)) = al.cvt(ra[i], lc * 8);
#pragma unroll
  for (int i = 0; i < 2; ++i) *(u32x4*)(smem + LDS_A + swz(lr + 64 * i, lc)) = rb[i];
  __syncthreads();
  for (int kt = 0; kt < nk; ++kt) {
    char* cur = smem + (kt & 1) * LDS_STAGE;
    char* nxt = smem + ((kt + 1) & 1) * LDS_STAGE;
    const bool more = (kt + 1 < nk);
    const int kn = (kt + 1) * BK + lc * 8;
    if (more) {
#pragma unroll
      for (int i = 0; i < 4; ++i) ra[i] = al.fetch(m0 + lr + 64 * i, kn);
#pragma unroll
      for (int i = 0; i < 2; ++i) rb[i] = *(const u32x4*)(Bt + (size_t)(n0 + lr + 64 * i) * ldb + kn);
    }
#pragma unroll
    for (int s = 0; s < 4; ++s) {
      const int ch = 2 * s + (lane >> 5);
      bf16x8 af[2], bfr[2];
#pragma unroll
      for (int mi = 0; mi < 2; ++mi) af[mi] = *(const bf16x8*)(cur + swz(wm * 64 + mi * 32 + (lane & 31), ch));
#pragma unroll
      for (int ni = 0; ni < 2; ++ni) bfr[ni] = *(const bf16x8*)(cur + LDS_A + swz(wn * 64 + ni * 32 + (lane & 31), ch));
#pragma unroll
      for (int mi = 0; mi < 2; ++mi)
#pragma unroll
        for (int ni = 0; ni < 2; ++ni)
          acc[mi][ni] = SWAP ? __builtin_amdgcn_mfma_f32_32x32x16_bf16(bfr[ni], af[mi], acc[mi][ni], 0, 0, 0)
                             : __builtin_amdgcn_mfma_f32_32x32x16_bf16(af[mi], bfr[ni], acc[mi][ni], 0, 0, 0);
    }
    if (more) {
#pragma unroll
      for (int i = 0; i < 4; ++i) *(u32x4*)(nxt + swz(lr + 64 * i, lc)) = al.cvt(ra[i], kn);
#pragma unroll
      for (int i = 0; i < 2; ++i) *(u32x4*)(nxt + LDS_A + swz(lr + 64 * i, lc)) = rb[i];
    }
    __syncthreads();
  }
}

constexpr int AT_ROW = 576;
constexpr int LDS_AT = 64 * AT_ROW;
constexpr int LDS_STAGE_T = LDS_AT + LDS_B;
typedef __attribute__((ext_vector_type(4))) short s16x4;
DI void gemm_mainloop_AT(f32x16 (&acc)[2][2], const ushort_t* __restrict__ At, size_t ldt, const ushort_t* __restrict__ Bt, int ldb, int n0, int K, char* smem) {
  const int tid = tid_opaque(), lane = tid & 63, wave = tid >> 6;
  const int wm = wave >> 1, wn = wave & 1;
  const int lr = tid >> 3, lc = tid & 7;
  u32x4 ra[4], rb[2];
  const int nk = K / BK;
#pragma unroll
  for (int i = 0; i < 4; ++i) { const int q = tid + 512 * i; ra[i] = *(const u32x4*)(At + (size_t)(q >> 5) * ldt + (q & 31) * 8); }
#pragma unroll
  for (int i = 0; i < 2; ++i) rb[i] = *(const u32x4*)(Bt + (size_t)(n0 + lr + 64 * i) * ldb + lc * 8);
  __syncthreads();
#pragma unroll
  for (int i = 0; i < 4; ++i) { const int q = tid + 512 * i; *(u32x4*)(smem + (q >> 5) * AT_ROW + (q & 31) * 16) = ra[i]; }
#pragma unroll
  for (int i = 0; i < 2; ++i) *(u32x4*)(smem + LDS_AT + swz(lr + 64 * i, lc)) = rb[i];
  __syncthreads();
  const int hh = lane >> 5, gg = (lane >> 4) & 1, qq = (lane & 15) >> 2, pp = lane & 3;
  for (int kt = 0; kt < nk; ++kt) {
    char* cur = smem + (kt & 1) * LDS_STAGE_T;
    char* nxt = smem + ((kt + 1) & 1) * LDS_STAGE_T;
    const bool more = (kt + 1 < nk);
    if (more) {
#pragma unroll
      for (int i = 0; i < 4; ++i) { const int q = tid + 512 * i; ra[i] = *(const u32x4*)(At + (size_t)((kt + 1) * BK + (q >> 5)) * ldt + (q & 31) * 8); }
#pragma unroll
      for (int i = 0; i < 2; ++i) rb[i] = *(const u32x4*)(Bt + (size_t)(n0 + lr + 64 * i) * ldb + (kt + 1) * BK + lc * 8);
    }
#pragma unroll
    for (int s = 0; s < 4; ++s) {
      const int ch = 2 * s + hh;
      bf16x8 af[2], bfr[2];
#pragma unroll
      for (int mi = 0; mi < 2; ++mi) {
        const char* a0 = cur + (16 * s + 8 * hh + qq) * AT_ROW + (wm * 64 + mi * 32 + 16 * gg + 4 * pp) * 2;
        s16x4 lo = __builtin_amdgcn_ds_read_tr16_b64_v4i16((__attribute__((address_space(3))) s16x4*)(a0));
        s16x4 hi = __builtin_amdgcn_ds_read_tr16_b64_v4i16((__attribute__((address_space(3))) s16x4*)(a0 + 4 * AT_ROW));
        af[mi] = __builtin_shufflevector(lo, hi, 0, 1, 2, 3, 4, 5, 6, 7);
      }
#pragma unroll
      for (int ni = 0; ni < 2; ++ni) bfr[ni] = *(const bf16x8*)(cur + LDS_AT + swz(wn * 64 + ni * 32 + (lane & 31), ch));
#pragma unroll
      for (int mi = 0; mi < 2; ++mi)
#pragma unroll
        for (int ni = 0; ni < 2; ++ni) acc[mi][ni] = __builtin_amdgcn_mfma_f32_32x32x16_bf16(af[mi], bfr[ni], acc[mi][ni], 0, 0, 0);
    }
    if (more) {
#pragma unroll
      for (int i = 0; i < 4; ++i) { const int q = tid + 512 * i; *(u32x4*)(nxt + (q >> 5) * AT_ROW + (q & 31) * 16) = ra[i]; }
#pragma unroll
      for (int i = 0; i < 2; ++i) *(u32x4*)(nxt + LDS_AT + swz(lr + 64 * i, lc)) = rb[i];
    }
    __syncthreads();
  }
}

constexpr int G2_A = 32768, G2_STAGE = 65536;
template <bool SWAP>
DI void gemm256(f32x16 (&acc)[4][2], const ushort_t* __restrict__ A, int lda, int m0, const ushort_t* __restrict__ Bt, int ldb, int n0, int K, char* smem) {
  const int tid = tid_opaque(), lane = tid & 63, wave = tid >> 6;
  const int wm = wave >> 2, wn = wave & 3;
  const int lr = tid >> 3, lc = tid & 7;
  u32x4 ra[4], rb[4];
  const int nk = K / BK;
  const ushort_t* ap = A + (size_t)(m0 + lr) * lda + lc * 8;
  const ushort_t* bp = Bt + (size_t)(n0 + lr) * ldb + lc * 8;
#pragma unroll
  for (int i = 0; i < 4; ++i) { ra[i] = *(const u32x4*)(ap + (size_t)(64 * i) * lda); rb[i] = *(const u32x4*)(bp + (size_t)(64 * i) * ldb); }
  __syncthreads();
#pragma unroll
  for (int i = 0; i < 4; ++i) { *(u32x4*)(smem + swz(lr + 64 * i, lc)) = ra[i]; *(u32x4*)(smem + G2_A + swz(lr + 64 * i, lc)) = rb[i]; }
  __syncthreads();
  for (int kt = 0; kt < nk; ++kt) {
    char* cur = smem + (kt & 1) * G2_STAGE;
    char* nxt = smem + ((kt + 1) & 1) * G2_STAGE;
    const bool more = (kt + 1 < nk);
    if (more) {
#pragma unroll
      for (int i = 0; i < 4; ++i) { ra[i] = *(const u32x4*)(ap + (size_t)(64 * i) * lda + (kt + 1) * BK); rb[i] = *(const u32x4*)(bp + (size_t)(64 * i) * ldb + (kt + 1) * BK); }
    }
#pragma unroll
    for (int s = 0; s < 4; ++s) {
      const int ch = 2 * s + (lane >> 5);
      bf16x8 af[4], bfr[2];
#pragma unroll
      for (int mi = 0; mi < 4; ++mi) af[mi] = *(const bf16x8*)(cur + swz(wm * 128 + mi * 32 + (lane & 31), ch));
#pragma unroll
      for (int ni = 0; ni < 2; ++ni) bfr[ni] = *(const bf16x8*)(cur + G2_A + swz(wn * 64 + ni * 32 + (lane & 31), ch));
#pragma unroll
      for (int mi = 0; mi < 4; ++mi)
#pragma unroll
        for (int ni = 0; ni < 2; ++ni)
          acc[mi][ni] = SWAP ? __builtin_amdgcn_mfma_f32_32x32x16_bf16(bfr[ni], af[mi], acc[mi][ni], 0, 0, 0)
                             : __builtin_amdgcn_mfma_f32_32x32x16_bf16(af[mi], bfr[ni], acc[mi][ni], 0, 0, 0);
      if (s & 1) __builtin_amdgcn_sched_barrier(0);
    }
    if (more) {
#pragma unroll
      for (int i = 0; i < 4; ++i) { *(u32x4*)(nxt + swz(lr + 64 * i, lc)) = ra[i]; *(u32x4*)(nxt + G2_A + swz(lr + 64 * i, lc)) = rb[i]; }
    }
    __syncthreads();
  }
}
constexpr int G2T_A = 64 * 576, G2T_STAGE = G2T_A + 32768;
DI void gemm256_AT(f32x16 (&acc)[4][2], const ushort_t* __restrict__ At, size_t ldt, const ushort_t* __restrict__ Bt, int ldb, int n0, int K, char* smem) {
  const int tid = tid_opaque(), lane = tid & 63, wave = tid >> 6;
  const int wm = wave >> 2, wn = wave & 3;
  const int lr = tid >> 3, lc = tid & 7;
  u32x4 ra[4], rb[4];
  const int nk = K / BK;
  const ushort_t* bp = Bt + (size_t)(n0 + lr) * ldb + lc * 8;
#pragma unroll
  for (int i = 0; i < 4; ++i) { const int q = tid + 512 * i; ra[i] = *(const u32x4*)(At + (size_t)(q >> 5) * ldt + (q & 31) * 8); rb[i] = *(const u32x4*)(bp + (size_t)(64 * i) * ldb); }
  __syncthreads();
#pragma unroll
  for (int i = 0; i < 4; ++i) { const int q = tid + 512 * i; *(u32x4*)(smem + (q >> 5) * 576 + (q & 31) * 16) = ra[i]; *(u32x4*)(smem + G2T_A + swz(lr + 64 * i, lc)) = rb[i]; }
  __syncthreads();
  const int hh = lane >> 5, gg = (lane >> 4) & 1, qq = (lane & 15) >> 2, pp = lane & 3;
  for (int kt = 0; kt < nk; ++kt) {
    char* cur = smem + (kt & 1) * G2T_STAGE;
    char* nxt = smem + ((kt + 1) & 1) * G2T_STAGE;
    const bool more = (kt + 1 < nk);
    if (more) {
#pragma unroll
      for (int i = 0; i < 4; ++i) { const int q = tid + 512 * i; ra[i] = *(const u32x4*)(At + (size_t)((kt + 1) * BK + (q >> 5)) * ldt + (q & 31) * 8); rb[i] = *(const u32x4*)(bp + (size_t)(64 * i) * ldb + (kt + 1) * BK); }
    }
#pragma unroll
    for (int s = 0; s < 4; ++s) {
      const int ch = 2 * s + hh;
      bf16x8 af[4], bfr[2];
#pragma unroll
      for (int mi = 0; mi < 4; ++mi) {
        const char* a0 = cur + (16 * s + 8 * hh + qq) * 576 + (wm * 128 + mi * 32 + 16 * gg + 4 * pp) * 2;
        s16x4 lo = __builtin_amdgcn_ds_read_tr16_b64_v4i16((__attribute__((address_space(3))) s16x4*)(a0));
        s16x4 hi = __builtin_amdgcn_ds_read_tr16_b64_v4i16((__attribute__((address_space(3))) s16x4*)(a0 + 4 * 576));
        af[mi] = __builtin_shufflevector(lo, hi, 0, 1, 2, 3, 4, 5, 6, 7);
      }
#pragma unroll
      for (int ni = 0; ni < 2; ++ni) bfr[ni] = *(const bf16x8*)(cur + G2T_A + swz(wn * 64 + ni * 32 + (lane & 31), ch));
#pragma unroll
      for (int mi = 0; mi < 4; ++mi)
#pragma unroll
        for (int ni = 0; ni < 2; ++ni) acc[mi][ni] = __builtin_amdgcn_mfma_f32_32x32x16_bf16(af[mi], bfr[ni], acc[mi][ni], 0, 0, 0);
      if (s & 1) __builtin_amdgcn_sched_barrier(0);
    }
    if (more) {
#pragma unroll
      for (int i = 0; i < 4; ++i) { const int q = tid + 512 * i; *(u32x4*)(nxt + (q >> 5) * 576 + (q & 31) * 16) = ra[i]; *(u32x4*)(nxt + G2T_A + swz(lr + 64 * i, lc)) = rb[i]; }
    }
    __syncthreads();
  }
}
DI void acc_zero4(f32x16 (&acc)[4][2]) {
#pragma unroll
  for (int a = 0; a < 4; ++a)
#pragma unroll
    for (int b = 0; b < 2; ++b)
#pragma unroll
      for (int r = 0; r < 16; ++r) acc[a][b][r] = 0.f;
}
DI void acc_zero(f32x16 (&acc)[2][2]) {
#pragma unroll
  for (int a = 0; a < 2; ++a)
#pragma unroll
    for (int b = 0; b < 2; ++b)
#pragma unroll
      for (int r = 0; r < 16; ++r) acc[a][b][r] = 0.f;
}
#define ACC_ROW(mi, r) (wm * 64 + (mi) * 32 + ((r) & 3) + 8 * ((r) >> 2) + 4 * (lane >> 5))
#define ACC_COL(ni) (wn * 64 + (ni) * 32 + (lane & 31))

DI void stage_mod(float* mod, const float* ada, int b, int sc_chunk, int sh_chunk) {
  for (int i = tid_opaque(); i < 1024; i += NT) {
    mod[i] = 1.f + ada[b * 6144 + sc_chunk * 1024 + i];
    mod[1024 + i] = ada[b * 6144 + sh_chunk * 1024 + i];
  }
}

DI void phase_inproj(const P& p, char* smem) {
  const ushort_t* u1b = (const ushort_t*)(p.ws + OFF_U1B);
  const ushort_t* wt = (const ushort_t*)(p.ws + OFF_WIN_T);
  constexpr int NTN = INW / 256;
  constexpr int NTM = T_ / 256;
  for (int tile = blockIdx.x; tile < NTM * NTN; tile += gridDim.x) {
    const int tid = tid_opaque(), lane = tid & 63, wave = tid >> 6, wm = wave >> 2, wn = wave & 3;
    const int tm = tile / NTN, tn = tile % NTN;
    const int m0 = tm * 256, n0 = tn * 256, b = m0 / S_;
    f32x16 acc[4][2]; acc_zero4(acc);
    if (n0 < HYC) {
      gemm256<true>(acc, u1b, 1024, m0, wt, 1024, n0, 1024, smem);
      ushort_t* pb = (ushort_t*)(p.ws + OFF_PH) + ((size_t)(b * HYC + n0)) * S_ + (m0 & (S_ - 1));
      const unsigned lo = (unsigned)((wn * 64 + 4 * (lane >> 5)) * S_ + wm * 128 + (lane & 31));
#pragma unroll
      for (int mi = 0; mi < 4; ++mi)
#pragma unroll
        for (int ni = 0; ni < 2; ++ni) {
#pragma unroll
          for (int r = 0; r < 16; ++r) (pb + (size_t)(ni * 32 + (r & 3) + 8 * (r >> 2)) * S_ + mi * 32)[lo] = f2bf(acc[mi][ni][r]);
          asm volatile("" ::: "memory");
        }
      continue;
    }
    gemm256<false>(acc, u1b, 1024, m0, wt, 1024, n0, 1024, smem);
    if (n0 < HYC + QKVC) {
      ushort_t* qb = (ushort_t*)(p.ws + OFF_QKV) + (size_t)m0 * QKVC + (n0 - HYC);
      const unsigned lo = (unsigned)((wm * 128 + 4 * (lane >> 5)) * QKVC + wn * 64 + (lane & 31));
      const float* rtb = (const float*)(p.ws + OFF_ROPE) + (size_t)(m0 + wm * 128 + 4 * (lane >> 5)) * 16 + (lane & 7) * 2;
#pragma unroll
      for (int ni = 0; ni < 2; ++ni) {
        const int cq = n0 - HYC + wn * 64 + ni * 32 + (lane & 31);
        const bool rot = (ni == 0) && (cq < 1536) && ((cq & 63) < 16);
        const float qs = (cq < 768) ? 0.125f : 1.0f;
#pragma unroll
        for (int mi = 0; mi < 4; ++mi) {
#pragma unroll
          for (int r = 0; r < 16; ++r) {
            const int rr = mi * 32 + (r & 3) + 8 * (r >> 2);
            float v = acc[mi][ni][r];
            if (ni == 0) {
              const float o = __shfl_xor(v, 8);
              if (rot) {
                const float cs = rtb[rr * 16], sn = rtb[rr * 16 + 1];
                v = ((cq & 15) < 8) ? (v * cs - o * sn) : (v * cs + o * sn);
              }
            }
            (qb + rr * QKVC + ni * 32)[lo] = f2bf(v * qs);
          }
          asm volatile("" ::: "memory");
        }
      }
    } else {
      ushort_t* gb = (ushort_t*)(p.ws + OFF_GATE) + (size_t)m0 * GATEC + (n0 - HYC - QKVC);
      const unsigned lo = (unsigned)((wm * 128 + 4 * (lane >> 5)) * GATEC + wn * 64 + (lane & 31));
#pragma unroll
      for (int mi = 0; mi < 4; ++mi)
#pragma unroll
        for (int ni = 0; ni < 2; ++ni) {
#pragma unroll
          for (int r = 0; r < 16; ++r) (gb + (mi * 32 + (r & 3) + 8 * (r >> 2)) * GATEC + ni * 32)[lo] = f2bf(1.f / (1.f + __expf(-acc[mi][ni][r])));
          asm volatile("" ::: "memory");
        }
    }
  }
}

DI float sconv_t(const ushort_t* row, int t, float w0, float w1, float w2, float cb) {
  float v = cb + w1 * bf2f(row[t]);
  if (t > 0) v += w0 * bf2f(row[t - 1]);
  if (t < S_ - 1) v += w2 * bf2f(row[t + 1]);
  return v;
}
DI void fft_C_mul_invC(cf2* lds, const cf2* __restrict__ kq, int tid) {
  asm volatile("" : "+v"(tid));
  const int k1 = tid >> 5, k2 = tid & 31;
  kq += tid;
#pragma unroll
  for (int h = 0; h < 2; ++h) {
    float tr[16], ti[16];
    cf2 kv[16];
#pragma unroll
    for (int i = 0; i < 16; ++i) kv[i] = kq[(h * 16 + i) * 512];
    cf2* blk = lds + (k1 + 16 * h) * FFT_SA + k2 * 17;
#pragma unroll
    for (int mp = 0; mp < 16; ++mp) { cf2 v = blk[mp]; tr[mp] = v.x; ti[mp] = v.y; }
    dft_fwd<16, false>(tr, ti);
#pragma unroll
    for (int i = 0; i < 16; ++i) { const float a = tr[i], b = ti[i]; tr[i] = a * kv[i].x - b * kv[i].y; ti[i] = a * kv[i].y + b * kv[i].x; }
    dft_inv<16>(tr, ti);
#pragma unroll
    for (int mp = 0; mp < 16; ++mp) { cf2 o; o.x = tr[mp]; o.y = ti[mp]; blk[mp] = o; }
  }
}
DI void hyena_item(const P& p, char* smem, int c) {
  cf2* lds = (cf2*)smem;
  const ushort_t* pht = (const ushort_t*)(p.ws + OFF_PH);
  ushort_t* yht = (ushort_t*)(p.ws + OFF_YH);
  cf2* kq = (cf2*)(p.ws + (blockIdx.x < 92 ? OFF_WIN_T + (size_t)blockIdx.x * 131072 : OFF_HSCR + (size_t)(blockIdx.x - 92) * 131072));
  const float* filt = p.out;
  const int tid0 = tid_opaque();
  float zr[32], zi[32];
  __syncthreads();
#pragma unroll 1
  for (int o = 0; o < 2; ++o) {
    int tid = tid0; asm volatile("" : "+v"(tid));
    {
      float kr[32], ki[32];
      const float* fw = filt + (size_t)(0 * 1024 + o * 512 + c) * S_;
      const float* bw = filt + (size_t)(1 * 1024 + o * 512 + c) * S_;
      const float bias = p.hy_bias[o * 512 + c];
#pragma unroll
      for (int n1 = 0; n1 < 16; ++n1) { kr[n1] = fw[n1 * 512 + tid] * (1.0f / 16384.0f); ki[n1] = 0.f; }
      if (tid == 0) kr[0] += bias * (1.0f / 16384.0f);
#pragma unroll
      for (int n1 = 16; n1 < 32; ++n1) {
        const int n = n1 * 512 + tid;
        kr[n1] = (n == S_) ? 0.f : bw[2 * S_ - n] * (1.0f / 16384.0f); ki[n1] = 0.f;
      }
      fft_fwdA<false>(kr, ki, lds, tid); __syncthreads();
      fft_B_read(kr, ki, lds, tid); __syncthreads();
      fft_fwdB_write(kr, ki, lds, tid); __syncthreads();
      fft_fwdC(kr, ki, lds, tid);
      int ts = tid; asm volatile("" : "+v"(ts));
      cf2* kqt = kq + ts;
#pragma unroll
      for (int r = 0; r < 32; ++r) { cf2 v; v.x = kr[r]; v.y = ki[r]; kqt[r * 512] = v; }
      __syncthreads();
    }
    asm volatile("" : "+v"(tid));
    if (o == 0) {
      const float w0 = p.hy_conv_w[c], w1 = p.hy_conv_w[HYC + c], w2 = p.hy_conv_w[2 * HYC + c], cb = p.hy_conv_b[c];
      const ushort_t* r0 = pht + (size_t)(0 * HYC + c) * S_;
      const ushort_t* r1 = pht + (size_t)(1 * HYC + c) * S_;
#pragma unroll
      for (int n1 = 0; n1 < 16; ++n1) {
        const int t = n1 * 512 + tid;
        zr[n1] = sconv_t(r0, t, w0, w1, w2, cb); zi[n1] = sconv_t(r1, t, w0, w1, w2, cb);
        if (n1 & 1) asm volatile("" ::: "memory");
      }
    }
#pragma unroll
    for (int n1 = 16; n1 < 32; ++n1) { zr[n1] = 0.f; zi[n1] = 0.f; }
    fft_fwdA<true>(zr, zi, lds, tid); __syncthreads();
    fft_B_read(zr, zi, lds, tid); __syncthreads();
    fft_fwdB_write(zr, zi, lds, tid); __syncthreads();
    fft_C_mul_invC(lds, kq, tid); __syncthreads();
    fft_invB_read(zr, zi, lds, tid); __syncthreads();
    fft_invB_write(zr, zi, lds, tid); __syncthreads();
    fft_invA(zr, zi, lds, tid);
    int tg = tid; asm volatile("" : "+v"(tg));
    const int gch = (o + 1) * 512 + c;
    const float w0 = p.hy_conv_w[gch], w1 = p.hy_conv_w[HYC + gch], w2 = p.hy_conv_w[2 * HYC + gch], cb = p.hy_conv_b[gch];
    const ushort_t* g0 = pht + (size_t)(0 * HYC + gch) * S_;
    const ushort_t* g1 = pht + (size_t)(1 * HYC + gch) * S_;
#pragma unroll
    for (int n1 = 0; n1 < 16; ++n1) {
      const int t = n1 * 512 + tg;
      zr[n1] *= sconv_t(g0, t, w0, w1, w2, cb);
      zi[n1] *= sconv_t(g1, t, w0, w1, w2, cb);
      if (n1 & 1) asm volatile("" ::: "memory");
    }
    if (o == 1) {
#pragma unroll
      for (int n1 = 0; n1 < 16; ++n1) {
        const int t = n1 * 512 + tg;
        yht[(size_t)(0 * HW_ + c) * S_ + t] = f2bf(zr[n1]);
        yht[(size_t)(1 * HW_ + c) * S_ + t] = f2bf(zi[n1]);
      }
    }
  }
}

constexpr int ATT_VROW = 192;
constexpr int ATT_VBUF = 32 * ATT_VROW;
DI void attn_item(const P& p, char* smem, int item) {
  const ushort_t* qkv = (const ushort_t*)(p.ws + OFF_QKV);
  ushort_t* ya = (ushort_t*)(p.ws + OFF_YA);
  const int tid = tid_opaque(), lane = tid & 63, wave = tid >> 6;
  const int u = item * 8 + wave;
  const int hs = u & 3, r16 = (u >> 2) & 15, chunk = (u >> 6) & 15, b = u >> 10;
  const int qi = lane & 31, h = lane >> 5;
  char* vl = smem + wave * ATT_VBUF;
  const int tq = chunk * 512 + r16 + 16 * qi;
  const size_t bbase = (size_t)b * S_;
  f32x16 o0, o1;
#pragma unroll
  for (int r = 0; r < 16; ++r) { o0[r] = 0.f; o1[r] = 0.f; }
  float m = -1e30f, l = 0.f;
  const int g16 = (lane >> 4) & 1, q4 = (lane & 15) >> 2, p4 = lane & 3;
  __syncthreads();
#pragma unroll 1
  for (int g = 0; g < 3; ++g) {
    const int dsh = 2 * g;
    const int d = 1 << dsh, sd = 16 >> dsh, n = S_ >> dsh;
    const int head = g * 4 + hs;
    const int rc = r16 & (d - 1);
    const int P0 = (chunk * 512 + r16 - rc) >> dsh;
    const int pq = P0 + sd * qi;
    const int KB = P0 - 64;
    const int ntile = (g == 0) ? 20 : (g == 1 ? 8 : 5);
    bf16x8 bq[4];
    {
      const ushort_t* qrow = qkv + (bbase + tq) * QKVC + head * 64;
#pragma unroll
      for (int s = 0; s < 4; ++s) bq[s] = *(const bf16x8*)(qrow + (2 * s + h) * 8);
    }
    bf16x8 kn[4]; u32x4 vn[4];
    {
      const int kp = min(max(KB + qi, 0), n - 1);
      const ushort_t* krow = qkv + (bbase + rc + ((size_t)kp << dsh)) * QKVC + 768 + head * 64;
#pragma unroll
      for (int s = 0; s < 4; ++s) kn[s] = *(const bf16x8*)(krow + (2 * s + h) * 8);
#pragma unroll
      for (int i = 0; i < 4; ++i) {
        const int c = lane + 64 * i, row = c >> 3, ch = c & 7;
        const int vp = min(max(KB + row, 0), n - 1);
        vn[i] = *(const u32x4*)(qkv + (bbase + rc + ((size_t)vp << dsh)) * QKVC + 1536 + head * 64 + ch * 8);
      }
    }
#pragma unroll 1
    for (int kt = 0; kt < ntile; ++kt) {
      bf16x8 kc[4]; u32x4 vc[4];
#pragma unroll
      for (int s = 0; s < 4; ++s) kc[s] = kn[s];
#pragma unroll
      for (int i = 0; i < 4; ++i) vc[i] = vn[i];
      if (kt + 1 < ntile) {
        const int kb1 = KB + 32 * (kt + 1);
        const int kp = min(max(kb1 + qi, 0), n - 1);
        const ushort_t* krow = qkv + (bbase + rc + ((size_t)kp << dsh)) * QKVC + 768 + head * 64;
#pragma unroll
        for (int s = 0; s < 4; ++s) kn[s] = *(const bf16x8*)(krow + (2 * s + h) * 8);
#pragma unroll
        for (int i = 0; i < 4; ++i) {
          const int c = lane + 64 * i, row = c >> 3, ch = c & 7;
          const int vp = min(max(kb1 + row, 0), n - 1);
          vn[i] = *(const u32x4*)(qkv + (bbase + rc + ((size_t)vp << dsh)) * QKVC + 1536 + head * 64 + ch * 8);
        }
      }
      f32x16 st;
#pragma unroll
      for (int r = 0; r < 16; ++r) st[r] = 0.f;
#pragma unroll
      for (int s = 0; s < 4; ++s) st = __builtin_amdgcn_mfma_f32_32x32x16_bf16(kc[s], bq[s], st, 0, 0, 0);
#pragma unroll
      for (int i = 0; i < 4; ++i) { const int c = lane + 64 * i; *(u32x4*)(vl + (c >> 3) * ATT_VROW + (c & 7) * 16) = vc[i]; }
      const int kb = KB + 32 * kt + 4 * h;
      const int dk = kb - pq;
      float mx = -1e30f;
      bool ok[16];
#pragma unroll
      for (int r = 0; r < 16; ++r) {
        const int cr = (r & 3) + 8 * (r >> 2);
        ok[r] = ((unsigned)(dk + cr + 64) <= 128u) && ((unsigned)(kb + cr) < (unsigned)n);
        mx = fmaxf(mx, ok[r] ? st[r] : -1e30f);
      }
      mx = fmaxf(mx, __shfl_xor(mx, 32));
      const float mnew = fmaxf(m, mx);
      const float corr = __expf(m - mnew);
      float ps = 0.f;
      float pv[16];
#pragma unroll
      for (int r = 0; r < 16; ++r) { pv[r] = ok[r] ? __expf(st[r] - mnew) : 0.f; ps += pv[r]; }
      ps += __shfl_xor(ps, 32);
      l = l * corr + ps; m = mnew;
#pragma unroll
      for (int r = 0; r < 16; ++r) { o0[r] *= corr; o1[r] *= corr; }
      bf16x8 pf[2];
#pragma unroll
      for (int s = 0; s < 2; ++s) {
        u32x4 w;
        w[0] = pack2(pv[8 * s + 0], pv[8 * s + 1]); w[1] = pack2(pv[8 * s + 2], pv[8 * s + 3]);
        w[2] = pack2(pv[8 * s + 4], pv[8 * s + 5]); w[3] = pack2(pv[8 * s + 6], pv[8 * s + 7]);
        pf[s] = __builtin_bit_cast(bf16x8, w);
      }
      __builtin_amdgcn_wave_barrier();
      asm volatile("s_waitcnt lgkmcnt(0)" ::: "memory");
#pragma unroll
      for (int s = 0; s < 2; ++s) {
#pragma unroll
        for (int nt = 0; nt < 2; ++nt) {
          const char* a0 = vl + (16 * s + 4 * h + q4) * ATT_VROW + (32 * nt + 16 * g16 + 4 * p4) * 2;
          s16x4 lo = __builtin_amdgcn_ds_read_tr16_b64_v4i16((__attribute__((address_space(3))) s16x4*)(a0));
          s16x4 hi = __builtin_amdgcn_ds_read_tr16_b64_v4i16((__attribute__((address_space(3))) s16x4*)(a0 + 8 * ATT_VROW));
          const bf16x8 vf = __builtin_shufflevector(lo, hi, 0, 1, 2, 3, 4, 5, 6, 7);
          if (nt == 0) o0 = __builtin_amdgcn_mfma_f32_32x32x16_bf16(vf, pf[s], o0, 0, 0, 0);
          else o1 = __builtin_amdgcn_mfma_f32_32x32x16_bf16(vf, pf[s], o1, 0, 0, 0);
        }
      }
      __builtin_amdgcn_wave_barrier();
      asm volatile("s_waitcnt lgkmcnt(0)" ::: "memory");
    }
  }
  const float il = 1.f / l;
  ushort_t* op = ya + (bbase + tq) * 256 + hs * 64;
#pragma unroll
  for (int gq = 0; gq < 4; ++gq) {
    uint2 w0, w1;
    w0.x = pack2(o0[4 * gq] * il, o0[4 * gq + 1] * il); w0.y = pack2(o0[4 * gq + 2] * il, o0[4 * gq + 3] * il);
    w1.x = pack2(o1[4 * gq] * il, o1[4 * gq + 1] * il); w1.y = pack2(o1[4 * gq + 2] * il, o1[4 * gq + 3] * il);
    *(uint2*)(op + 8 * gq + 4 * h) = w0;
    *(uint2*)(op + 32 + 8 * gq + 4 * h) = w1;
  }
}

DI void phase_merge(const P& p, char* smem) {
  const ushort_t* yh = (const ushort_t*)(p.ws + OFF_YH);
  const ushort_t* ya = (const ushort_t*)(p.ws + OFF_YA);
  const ushort_t* gate = (const ushort_t*)(p.ws + OFF_GATE);
  ushort_t* merged = (ushort_t*)(p.ws + OFF_MERGED);
  constexpr int NTN = 1024 / 256, NTM = T_ / 256;
  for (int tile = blockIdx.x; tile < NTM * NTN; tile += gridDim.x) {
    const int tid = tid_opaque(), wave = tid >> 6, wm = wave >> 2, wn = wave & 3;
    int lane = tid & 63;
    const int m0 = (tile / NTN) * 256, n0 = (tile % NTN) * 256;
    f32x16 a1[4][2]; acc_zero4(a1);
    gemm256_AT(a1, yh + (size_t)((m0 / S_) * HW_) * S_ + (m0 & (S_ - 1)), (size_t)S_, (const ushort_t*)(p.ws + OFF_WBH_T), 512, n0, 512, smem);
    const ushort_t* gbh = gate + (size_t)m0 * GATEC + n0;
    ushort_t* mb = merged + (size_t)m0 * 1024 + n0;
    {
      const unsigned lg = (unsigned)((wm * 128 + 4 * (lane >> 5)) * GATEC + wn * 64 + (lane & 31));
      const unsigned lm = (unsigned)((wm * 128 + 4 * (lane >> 5)) * 1024 + wn * 64 + (lane & 31));
#pragma unroll
      for (int mi = 0; mi < 4; ++mi)
#pragma unroll
        for (int ni = 0; ni < 2; ++ni) {
#pragma unroll
          for (int r = 0; r < 16; ++r) {
            const int rr = mi * 32 + (r & 3) + 8 * (r >> 2);
            (mb + rr * 1024 + ni * 32)[lm] = f2bf(bf2f((gbh + rr * GATEC + ni * 32)[lg]) * a1[mi][ni][r]);
          }
          asm volatile("" ::: "memory");
        }
    }
    acc_zero4(a1);
    gemm256<false>(a1, ya, 256, m0, (const ushort_t*)(p.ws + OFF_WBA_T), 256, n0, 256, smem);
    asm volatile("" : "+v"(lane));
    {
      const unsigned lg = (unsigned)((wm * 128 + 4 * (lane >> 5)) * GATEC + wn * 64 + (lane & 31));
      const unsigned lm = (unsigned)((wm * 128 + 4 * (lane >> 5)) * 1024 + wn * 64 + (lane & 31));
#pragma unroll
      for (int mi = 0; mi < 4; ++mi)
#pragma unroll
        for (int ni = 0; ni < 2; ++ni) {
#pragma unroll
          for (int r = 0; r < 16; ++r) {
            const int rr = mi * 32 + (r & 3) + 8 * (r >> 2);
            ushort_t* mp = mb + rr * 1024 + ni * 32;
            mp[lm] = f2bf(bf2f(mp[lm]) + bf2f((gbh + 1024 + rr * GATEC + ni * 32)[lg]) * a1[mi][ni][r]);
          }
          asm volatile("" ::: "memory");
        }
    }
  }
}

DI void phase_outproj(const P& p, char* smem) {
  const float* ada = (const float*)(p.ws + OFF_ADA);
  const ushort_t* merged = (const ushort_t*)(p.ws + OFF_MERGED);
  constexpr int NTN = 1024 / 256, NTM = T_ / 256;
  for (int tile = blockIdx.x; tile < NTM * NTN; tile += gridDim.x) {
    const int tid = tid_opaque(), lane = tid & 63, wave = tid >> 6, wm = wave >> 2, wn = wave & 3;
    const int m0 = (tile / NTN) * 256, n0 = (tile % NTN) * 256, b = m0 / S_;
    f32x16 acc[4][2]; acc_zero4(acc);
    gemm256<false>(acc, merged, 1024, m0, (const ushort_t*)(p.ws + OFF_WOUT_T), 1024, n0, 1024, smem);
    const float* xb = p.x + (size_t)m0 * 1024 + n0;
    float* ob = p.out + (size_t)m0 * 1024 + n0;
    const unsigned lo = (unsigned)((wm * 128 + 4 * (lane >> 5)) * 1024 + wn * 64 + (lane & 31));
#pragma unroll
    for (int ni = 0; ni < 2; ++ni) {
      const float g1 = 1.f + ada[b * 6144 + 2 * 1024 + n0 + wn * 64 + ni * 32 + (lane & 31)];
#pragma unroll
      for (int mi = 0; mi < 4; ++mi) {
#pragma unroll
        for (int r = 0; r < 16; ++r) {
          const int rr = mi * 32 + (r & 3) + 8 * (r >> 2);
          (ob + rr * 1024 + ni * 32)[lo] = DN_ALPHA * (xb + rr * 1024 + ni * 32)[lo] + g1 * acc[mi][ni][r];
          if ((r & 3) == 3) asm volatile("" ::: "memory");
        }
      }
    }
  }
}

DI void phase_ln(float* __restrict__ xio, const float* __restrict__ g, const float* __restrict__ bta) {
  const int tq = tid_opaque(); const int lane = tq & 63, wave = tq >> 6;
  for (int row = blockIdx.x * 8 + wave; row < T_; row += gridDim.x * 8) {
    float* rp = xio + (size_t)row * 1024;
    f32x4 v[4];
    float s = 0.f;
#pragma unroll
    for (int i = 0; i < 4; ++i) { v[i] = *(const f32x4*)(rp + i * 256 + lane * 4); s += v[i][0] + v[i][1] + v[i][2] + v[i][3]; }
    const float mu = wave_sum(s) * (1.f / 1024.f);
    float q = 0.f;
#pragma unroll
    for (int i = 0; i < 4; ++i)
#pragma unroll
      for (int j = 0; j < 4; ++j) { float d = v[i][j] - mu; q += d * d; }
    const float rs = rsqrtf(wave_sum(q) * (1.f / 1024.f) + LN_EPS);
#pragma unroll
    for (int i = 0; i < 4; ++i) {
      f32x4 gg = *(const f32x4*)(g + i * 256 + lane * 4), bb = *(const f32x4*)(bta + i * 256 + lane * 4), o;
#pragma unroll
      for (int j = 0; j < 4; ++j) o[j] = (v[i][j] - mu) * rs * gg[j] + bb[j];
      *(f32x4*)(rp + i * 256 + lane * 4) = o;
    }
  }
}

DI int swz256(int row, int ch) { return row * 256 + ((ch ^ (row & 15)) << 4); }
DI void ins16(float (&L)[16], float x) {
#pragma unroll
  for (int i = 0; i < 16; ++i) { const float hi = __builtin_fmaxf(L[i], x); x = __builtin_fminf(L[i], x); L[i] = hi; }
}
DI void bitonic16_desc(float (&M)[16]) {
#pragma unroll
  for (int d = 8; d >= 1; d >>= 1)
#pragma unroll
    for (int i = 0; i < 16; ++i)
      if ((i & d) == 0) { const float a = M[i], b = M[i + d]; M[i] = __builtin_fmaxf(a, b); M[i + d] = __builtin_fminf(a, b); }
}
constexpr int ROUTE_Q_OFF = 0, ROUTE_K_OFF = 65536, ROUTE_IDX_OFF = 106496;
DI void phase_route(const P& p, char* smem) {
  const float* ada = (const float*)(p.ws + OFF_ADA);
  float* mod = (float*)(smem + 2 * LDS_STAGE);
  const ushort_t* keysb = (const ushort_t*)(p.ws + OFF_KEYS_B);
  int* idx = (int*)(p.ws + OFF_IDX);
  float* gv = (float*)(p.ws + OFF_GV);
  for (int item = blockIdx.x; item < (T_ / BM) * 8; item += gridDim.x) {
    const int tid = tid_opaque(), lane = tid & 63, wave = tid >> 6, wm = wave >> 1, wn = wave & 1;
    const int m0 = (item >> 3) * BM, hh = item & 7;
    float L0[16];
#pragma unroll 1
    for (int pp = 0; pp < 2; ++pp) {
      const int hp = hh * 2 + pp;
      f32x16 acc[2][2]; acc_zero(acc);
      ALoadBf16 al{(const ushort_t*)(p.ws + OFF_U2B), 1024};
      gemm_mainloop<ALoadBf16, true>(acc, al, m0, (const ushort_t*)(p.ws + OFF_WQ_T), 1024, hp * 128, 1024, smem);
#pragma unroll
      for (int mi = 0; mi < 2; ++mi) {
        const int tok = wm * 64 + mi * 32 + (lane & 31);
#pragma unroll
        for (int ni = 0; ni < 2; ++ni)
#pragma unroll
          for (int g = 0; g < 4; ++g) {
            const int ch = wn * 8 + ni * 4 + g;
            uint2 v; v.x = pack2(acc[mi][ni][4 * g], acc[mi][ni][4 * g + 1]); v.y = pack2(acc[mi][ni][4 * g + 2], acc[mi][ni][4 * g + 3]);
            *(uint2*)(smem + ROUTE_Q_OFF + swz256(tok, ch) + 8 * (lane >> 5)) = v;
          }
      }
#pragma unroll
      for (int i = 0; i < 4; ++i) {
        const int q = tid + 512 * i, row = q >> 4, ch = q & 15;
        *(u32x4*)(smem + ROUTE_K_OFF + swz256(row, ch)) = *(const u32x4*)(keysb + (size_t)hp * 16384 + row * 128 + ch * 8);
      }
      __syncthreads();
      f32x16 sc[4];
#pragma unroll
      for (int ks = 0; ks < 4; ++ks)
#pragma unroll
        for (int r = 0; r < 16; ++r) sc[ks][r] = 0.f;
#pragma unroll
      for (int s = 0; s < 8; ++s) {
        const int ch = 2 * s + (lane >> 5);
        const bf16x8 bq = *(const bf16x8*)(smem + ROUTE_Q_OFF + swz256(wave * 32 + (lane & 31), ch));
#pragma unroll
        for (int ks = 0; ks < 4; ++ks) {
          const bf16x8 ak = *(const bf16x8*)(smem + ROUTE_K_OFF + swz256(ks * 32 + (lane & 31), ch));
          sc[ks] = __builtin_amdgcn_mfma_f32_32x32x16_bf16(ak, bq, sc[ks], 0, 0, 0);
        }
      }
      float L[16];
#pragma unroll
      for (int i = 0; i < 16; ++i) L[i] = -3.0e38f;
      const unsigned hbit = (unsigned)(lane >> 5) << 2;
#pragma unroll
      for (int ks = 0; ks < 4; ++ks)
#pragma unroll
        for (int r = 0; r < 16; ++r) {
          const unsigned key = (unsigned)(ks * 32 + (r & 3) + 8 * (r >> 2)) | hbit;
          ins16(L, __uint_as_float((__float_as_uint(sc[ks][r]) & ~127u) | key));
        }
      {
        float M[16];
#pragma unroll
        for (int i = 0; i < 16; ++i) M[i] = __builtin_fmaxf(L[i], __shfl_xor(L[15 - i], 32));
        bitonic16_desc(M);
#pragma unroll
        for (int i = 0; i < 16; ++i) L[i] = M[i];
      }
      if (pp == 0) {
#pragma unroll
        for (int i = 0; i < 16; ++i) L0[i] = L[i];
      } else {
        unsigned char* ib = (unsigned char*)(smem + ROUTE_IDX_OFF) + tid * 32;
#pragma unroll
        for (int i = 0; i < 16; ++i) { ib[i] = (unsigned char)(__float_as_uint(L0[i]) & 127u); ib[16 + i] = (unsigned char)(__float_as_uint(L[i]) & 127u); }
        float F[16];
#pragma unroll
        for (int i = 0; i < 16; ++i) F[i] = -3.0e38f;
#pragma unroll
        for (int i = 0; i < 16; ++i) {
          const float ai = __uint_as_float(__float_as_uint(L0[i]) & ~127u);
#pragma unroll
          for (int j = 0; j < 16; ++j)
            if ((i + 1) * (j + 1) <= 16) {
              const float s = ai + __uint_as_float(__float_as_uint(L[j]) & ~127u);
              ins16(F, __uint_as_float((__float_as_uint(s) & ~255u) | (unsigned)(i * 16 + j)));
            }
        }
        const float mx = __uint_as_float(__float_as_uint(F[0]) & ~255u);
        float e[16], sum = 0.f;
#pragma unroll
        for (int k = 0; k < 16; ++k) { e[k] = __expf(__uint_as_float(__float_as_uint(F[k]) & ~255u) - mx); sum += e[k]; }
        const float inv = 1.f / sum;
        if (lane < 32) {
          const int tok = m0 + wave * 32 + lane;
          int* ip = idx + (size_t)tok * 128 + hh * 16;
          float* gp = gv + (size_t)tok * 128 + hh * 16;
#pragma unroll
          for (int k4 = 0; k4 < 4; ++k4) {
            int4 iv; f32x4 g4;
            int ee[4];
#pragma unroll
            for (int u = 0; u < 4; ++u) {
              const unsigned code = __float_as_uint(F[k4 * 4 + u]) & 255u;
              ee[u] = (int)ib[code >> 4] * 128 + (int)ib[16 + (code & 15u)];
              g4[u] = e[k4 * 4 + u] * inv;
            }
            iv.x = ee[0]; iv.y = ee[1]; iv.z = ee[2]; iv.w = ee[3];
            *(int4*)(ip + k4 * 4) = iv;
            *(f32x4*)(gp + k4 * 4) = g4;
          }
        }
      }
    }
  }
}

DI void phase_rope(const P& p) {
  float* rt = (float*)(p.ws + OFF_ROPE);
  for (int i = blockIdx.x * NT + tid_opaque(); i < T_ * 8; i += gridDim.x * NT) {
    const float inv = expf(-13.122363377404328f * (float)(i & 7) * 0.125f);
    float sn, cs; sincosf((float)p.pos[i >> 3] * inv, &sn, &cs);
    rt[2 * i] = cs; rt[2 * i + 1] = sn;
  }
}
DI void phase_keys(const P& p) {
  ushort_t* keysb = (ushort_t*)(p.ws + OFF_KEYS_B);
  for (int i = blockIdx.x * NT + tid_opaque(); i < 16 * 128 * 128 / 4; i += gridDim.x * NT) {
    f32x4 v = *(const f32x4*)(p.keys + (size_t)i * 4);
    uint2 o; o.x = pack2(v[0], v[1]); o.y = pack2(v[2], v[3]);
    *(uint2*)(keysb + (size_t)i * 4) = o;
  }
}

typedef __bf16 bf16x2_t __attribute__((ext_vector_type(2)));
DI float dot2bf(unsigned a, unsigned b, float c) { return __builtin_amdgcn_fdot2_f32_bf16(__builtin_bit_cast(bf16x2_t, a), __builtin_bit_cast(bf16x2_t, b), c, false); }
DI void phase_ln1(const P& p) {
  const float* ada = (const float*)(p.ws + OFF_ADA);
  ushort_t* u2b = (ushort_t*)(p.ws + OFF_U2B);
  const int tq = tid_opaque(); const int lane = tq & 63, wave = tq >> 6;
  for (int row = blockIdx.x * 8 + wave; row < T_; row += gridDim.x * 8) {
    const int b = row / S_;
    float* rp = p.out + (size_t)row * 1024;
    f32x4 v[4];
    float s = 0.f;
#pragma unroll
    for (int i = 0; i < 4; ++i) { v[i] = *(const f32x4*)(rp + i * 256 + lane * 4); s += v[i][0] + v[i][1] + v[i][2] + v[i][3]; }
    const float mu = wave_sum(s) * (1.f / 1024.f);
    float q = 0.f;
#pragma unroll
    for (int i = 0; i < 4; ++i)
#pragma unroll
      for (int j = 0; j < 4; ++j) { float d = v[i][j] - mu; q += d * d; }
    const float rs = rsqrtf(wave_sum(q) * (1.f / 1024.f) + LN_EPS);
#pragma unroll
    for (int i = 0; i < 4; ++i) {
      const int col = i * 256 + lane * 4;
      f32x4 gg = *(const f32x4*)(p.ln1_g + col), bb = *(const f32x4*)(p.ln1_b + col), o;
      f32x4 sc = *(const f32x4*)(ada + b * 6144 + 4 * 1024 + col), sh = *(const f32x4*)(ada + b * 6144 + 3 * 1024 + col);
#pragma unroll
      for (int j = 0; j < 4; ++j) o[j] = (v[i][j] - mu) * rs * gg[j] + bb[j];
      *(f32x4*)(rp + col) = o;
      uint2 w; w.x = pack2(o[0] * (1.f + sc[0]) + sh[0], o[1] * (1.f + sc[1]) + sh[1]); w.y = pack2(o[2] * (1.f + sc[2]) + sh[2], o[3] * (1.f + sc[3]) + sh[3]);
      *(uint2*)(u2b + (size_t)row * 1024 + col) = w;
    }
  }
}
DI void phase_tabconv(const P& p) {
  ushort_t* tu = (ushort_t*)(p.ws + OFF_TABU);
  ushort_t* tv = (ushort_t*)(p.ws + OFF_TABV);
  const int tq = tid_opaque(); const int lane = tq & 63, wave = tq >> 6;
  for (int e = blockIdx.x * 8 + wave; e < 16384; e += gridDim.x * 8) {
#pragma unroll
    for (int i = 0; i < 4; ++i) {
      const int col = i * 256 + lane * 4;
      f32x4 a = *(const f32x4*)(p.pu + (size_t)e * 1024 + col);
      f32x4 c = *(const f32x4*)(p.pv + (size_t)e * 1024 + col);
      uint2 wa; wa.x = pack2(a[0], a[1]); wa.y = pack2(a[2], a[3]);
      uint2 wc; wc.x = pack2(c[0], c[1]); wc.y = pack2(c[2], c[3]);
      *(uint2*)(tu + (size_t)e * 1024 + col) = wa;
      const int slice = i * 4 + (lane >> 4);
      *(uint2*)(tv + ((size_t)slice * 16384 + e) * 64 + (lane & 15) * 4) = wc;
    }
  }
}

template <int CTRL> DI float dpp_f(float v) { return __int_as_float(__builtin_amdgcn_mov_dpp(__float_as_int(v), CTRL, 0xf, 0xf, false)); }
template <int CTRL> DI int dpp_shr0(int v) { return __builtin_amdgcn_update_dpp(0, v, CTRL, 0xf, 0xf, true); }
template <int I> DI int bcast16(int v) { return __builtin_amdgcn_mov_dpp(v, 0x150 + I, 0xf, 0xf, false); }
DI float row_sum16(float d) {
  d += dpp_f<0xB1>(d);
  d += dpp_f<0x4E>(d);
  d += dpp_f<0x141>(d);
  d += dpp_f<0x140>(d);
  return d;
}
DI void phase_upass(const P& p, char* smem) {
  const int* idx = (const int*)(p.ws + OFF_IDX);
  const float* gv = (const float*)(p.ws + OFF_GV);
  const ushort_t* u2b = (const ushort_t*)(p.ws + OFF_U2B);
  const char* tabu = (const char*)(p.ws + OFF_TABU);
  float* coef = (float*)(p.ws + OFF_COEF);
  const int tq = tid_opaque(); const int lane = tq & 63, wave = tq >> 6;
  const int g = lane >> 4, j = lane & 15;
  int4* lst = (int4*)smem + wave * 512 + g * 128;
  const int xg = blockIdx.x & 7, bi = blockIdx.x >> 3, nb = (gridDim.x - xg + 7) >> 3;
  __syncthreads();
#pragma unroll 1
  for (int pass = 0; pass < 2; ++pass) {
    const int part = xg + 8 * pass;
#pragma unroll 1
    for (int tb = (bi * 8 + wave) * 4; tb < T_; tb += nb * 32) {
      const int tok = tb + g;
      const int4 i0 = *(const int4*)(idx + (size_t)tb * 128 + lane * 8), i1 = *(const int4*)(idx + (size_t)tb * 128 + lane * 8 + 4);
      const f32x4 g0 = *(const f32x4*)(gv + (size_t)tb * 128 + lane * 8), g1 = *(const f32x4*)(gv + (size_t)tb * 128 + lane * 8 + 4);
      u32x4 xr[8];
#pragma unroll
      for (int c = 0; c < 8; ++c) xr[c] = *(const u32x4*)(u2b + (size_t)tok * 1024 + (j + 16 * c) * 8);
      const int ev[8] = {i0.x, i0.y, i0.z, i0.w, i1.x, i1.y, i1.z, i1.w};
      const float gg[8] = {g0[0], g0[1], g0[2], g0[3], g1[0], g1[1], g1[2], g1[3]};
      int cnt = 0;
#pragma unroll
      for (int i = 0; i < 8; ++i) cnt += ((ev[i] >> 10) == part) ? 1 : 0;
      int incl = cnt;
      incl += dpp_shr0<0x111>(incl); incl += dpp_shr0<0x112>(incl); incl += dpp_shr0<0x114>(incl); incl += dpp_shr0<0x118>(incl);
      const int ng = bcast16<15>(incl);
      int pos = incl - cnt;
#pragma unroll
      for (int i = 0; i < 8; ++i)
        if ((ev[i] >> 10) == part) { int4 en; en.x = ev[i]; en.y = __float_as_int(gg[i]); en.z = j * 8 + i; en.w = 0; lst[pos] = en; ++pos; }
      const int nmax = max(max(__builtin_amdgcn_readlane(ng, 0), __builtin_amdgcn_readlane(ng, 16)), max(__builtin_amdgcn_readlane(ng, 32), __builtin_amdgcn_readlane(ng, 48)));
      __builtin_amdgcn_wave_barrier();
      asm volatile("s_waitcnt lgkmcnt(0)" ::: "memory");
      u32x4 ra[8];
      {
        const unsigned e = (ng > 0) ? (unsigned)lst[0].x : 0u;
        const char* row = tabu + (size_t)e * 2048 + j * 16;
#pragma unroll
        for (int c = 0; c < 8; ++c) ra[c] = *(const u32x4*)(row + c * 256);
      }
#pragma unroll 1
      for (int it = 0; it < nmax; ++it) {
        u32x4 rn[8];
        {
          const unsigned e = (it + 1 < ng) ? (unsigned)lst[it + 1].x : 0u;
          const char* row = tabu + (size_t)e * 2048 + j * 16;
#pragma unroll
          for (int c = 0; c < 8; ++c) rn[c] = *(const u32x4*)(row + c * 256);
        }
        float a0 = 0.f, a1 = 0.f, a2 = 0.f, a3 = 0.f;
#pragma unroll
        for (int c = 0; c < 8; ++c) {
          a0 = dot2bf(ra[c][0], xr[c][0], a0); a1 = dot2bf(ra[c][1], xr[c][1], a1);
          a2 = dot2bf(ra[c][2], xr[c][2], a2); a3 = dot2bf(ra[c][3], xr[c][3], a3);
        }
        const float d = row_sum16((a0 + a1) + (a2 + a3));
        if (j == 0 && it < ng) ((int*)&lst[it])[3] = __float_as_int(d);
#pragma unroll
        for (int c = 0; c < 8; ++c) ra[c] = rn[c];
      }
      __builtin_amdgcn_wave_barrier();
      asm volatile("s_waitcnt lgkmcnt(0)" ::: "memory");
#pragma unroll 1
      for (int k = 0; k < nmax; k += 16) {
        if (k + j < ng) {
          const int4 en = lst[k + j];
          const float a = __int_as_float(en.w);
          coef[(size_t)tok * 128 + en.z] = __int_as_float(en.y) * 0.5f * a * (1.f + erff(a * 0.7071067811865475f));
        }
      }
      __builtin_amdgcn_wave_barrier();
      asm volatile("s_waitcnt lgkmcnt(0)" ::: "memory");
    }
  }
}

struct VHdr { int ea, eb, ca, cb; };
DI VHdr vp_hdr(const int* idx, const float* coef, int tok, int g, int cq) {
  VHdr h;
  h.ea = idx[(size_t)tok * 128 + g * 32 + cq]; h.eb = idx[(size_t)tok * 128 + g * 32 + 16 + cq];
  h.ca = __float_as_int(coef[(size_t)tok * 128 + g * 32 + cq]); h.cb = __float_as_int(coef[(size_t)tok * 128 + g * 32 + 16 + cq]);
  return h;
}
DI void vp_rows(uint2 (&va)[16], uint2 (&vb)[16], const VHdr& h, const char* tb) {
#define VP_STEP(I) { va[I] = *(const uint2*)(tb + (unsigned)bcast16<I>(h.ea) * 128u); vb[I] = *(const uint2*)(tb + (unsigned)bcast16<I>(h.eb) * 128u); }
  VP_STEP(0) VP_STEP(1) VP_STEP(2) VP_STEP(3) VP_STEP(4) VP_STEP(5) VP_STEP(6) VP_STEP(7)
  VP_STEP(8) VP_STEP(9) VP_STEP(10) VP_STEP(11) VP_STEP(12) VP_STEP(13) VP_STEP(14) VP_STEP(15)
#undef VP_STEP
}
DI void vp_coefs(float (&fa)[16], float (&fb)[16], const VHdr& h) {
#define VP_STEP(I) { fa[I] = __int_as_float(bcast16<I>(h.ca)); fb[I] = __int_as_float(bcast16<I>(h.cb)); }
  VP_STEP(0) VP_STEP(1) VP_STEP(2) VP_STEP(3) VP_STEP(4) VP_STEP(5) VP_STEP(6) VP_STEP(7)
  VP_STEP(8) VP_STEP(9) VP_STEP(10) VP_STEP(11) VP_STEP(12) VP_STEP(13) VP_STEP(14) VP_STEP(15)
#undef VP_STEP
}
DI void phase_vpass(const P& p) {
  const int* idx = (const int*)(p.ws + OFF_IDX);
  const float* coef = (const float*)(p.ws + OFF_COEF);
  const char* tabv = (const char*)(p.ws + OFF_TABV);
  float* f = (float*)(p.ws + OFF_F);
  const int tq = tid_opaque(); const int lane = tq & 63, wave = tq >> 6;
  const int g = lane >> 4, cq = lane & 15;
  const int xg = blockIdx.x & 7, bi = blockIdx.x >> 3, nb = (gridDim.x - xg + 7) >> 3;
  const int step = nb * 8;
#pragma unroll 1
  for (int pass = 0; pass < 2; ++pass) {
    const int slice = xg + 8 * pass;
    const char* tb = tabv + (size_t)slice * (16384 * 128) + cq * 8;
    int tok = bi * 8 + wave;
    if (tok >= T_) continue;
    VHdr hc = vp_hdr(idx, coef, tok, g, cq);
    VHdr hn = vp_hdr(idx, coef, min(tok + step, T_ - 1), g, cq);
    uint2 va[16], vb[16];
    vp_rows(va, vb, hc, tb);
#pragma unroll 1
    for (; tok < T_; tok += step) {
      const VHdr hnn = vp_hdr(idx, coef, min(tok + 2 * step, T_ - 1), g, cq);
      uint2 na[16], nb2[16];
      vp_rows(na, nb2, hn, tb);
      float fa[16], fb[16];
      vp_coefs(fa, fb, hc);
      float a0 = 0.f, a1 = 0.f, a2 = 0.f, a3 = 0.f;
#pragma unroll
      for (int i = 0; i < 16; ++i) {
        a0 += fa[i] * __uint_as_float(va[i].x << 16); a1 += fa[i] * __uint_as_float(va[i].x & 0xffff0000u);
        a2 += fa[i] * __uint_as_float(va[i].y << 16); a3 += fa[i] * __uint_as_float(va[i].y & 0xffff0000u);
        a0 += fb[i] * __uint_as_float(vb[i].x << 16); a1 += fb[i] * __uint_as_float(vb[i].x & 0xffff0000u);
        a2 += fb[i] * __uint_as_float(vb[i].y << 16); a3 += fb[i] * __uint_as_float(vb[i].y & 0xffff0000u);
      }
      a0 += __shfl_xor(a0, 16); a1 += __shfl_xor(a1, 16); a2 += __shfl_xor(a2, 16); a3 += __shfl_xor(a3, 16);
      a0 += __shfl_xor(a0, 32); a1 += __shfl_xor(a1, 32); a2 += __shfl_xor(a2, 32); a3 += __shfl_xor(a3, 32);
      if (g == 0) { f32x4 o; o[0] = a0; o[1] = a1; o[2] = a2; o[3] = a3; *(f32x4*)(f + (size_t)tok * 1024 + slice * 64 + cq * 4) = o; }
#pragma unroll
      for (int i = 0; i < 16; ++i) { va[i] = na[i]; vb[i] = nb2[i]; }
      hc = hn; hn = hnn;
    }
  }
}

DI void phase_ln2(const P& p) {
  const float* ada = (const float*)(p.ws + OFF_ADA);
  const float* f = (const float*)(p.ws + OFF_F);
  const int tq = tid_opaque(); const int lane = tq & 63, wave = tq >> 6;
  for (int tok = blockIdx.x * 8 + wave; tok < T_; tok += gridDim.x * 8) {
    const int b = tok / S_;
    float* rp = p.out + (size_t)tok * 1024;
    f32x4 acc[4];
    float sm = 0.f;
#pragma unroll
    for (int i = 0; i < 4; ++i) {
      const int col = i * 256 + lane * 4;
      f32x4 x1 = *(const f32x4*)(rp + col), ff = *(const f32x4*)(f + (size_t)tok * 1024 + col);
      f32x4 g2 = *(const f32x4*)(ada + b * 6144 + 5 * 1024 + col);
#pragma unroll
      for (int j = 0; j < 4; ++j) { acc[i][j] = DN_ALPHA * x1[j] + (1.f + g2[j]) * ff[j]; sm += acc[i][j]; }
    }
    const float mu = wave_sum(sm) * (1.f / 1024.f);
    float q = 0.f;
#pragma unroll
    for (int i = 0; i < 4; ++i)
#pragma unroll
      for (int j = 0; j < 4; ++j) { float d = acc[i][j] - mu; q += d * d; }
    const float rs = rsqrtf(wave_sum(q) * (1.f / 1024.f) + LN_EPS);
#pragma unroll
    for (int i = 0; i < 4; ++i) {
      const int col = i * 256 + lane * 4;
      f32x4 gg = *(const f32x4*)(p.ln2_g + col), bb = *(const f32x4*)(p.ln2_b + col), o;
#pragma unroll
      for (int j = 0; j < 4; ++j) o[j] = (acc[i][j] - mu) * rs * gg[j] + bb[j];
      *(f32x4*)(rp + col) = o;
    }
  }
}

#define XB_TMO      128
#define XB_XCNT(j)  (256  + 64 * (j))
#define XB_XSUB(j)  (1280 + 64 * (j))
#define XB_XGEN(j)  (2304 + 64 * (j))
#define XB_TOP      3328
#define XB_TOPGEN   3392
#define XCD_BAR_WORDS 3456
#define XB_SPIN_CAP (1u << 22)
#define LAS __attribute__((address_space(3)))
DI unsigned xb_ld(unsigned* p)              { return __hip_atomic_load(p, __ATOMIC_RELAXED, __HIP_MEMORY_SCOPE_AGENT); }
DI unsigned xb_add(unsigned* p, unsigned v) { return __hip_atomic_fetch_add(p, v, __ATOMIC_RELAXED, __HIP_MEMORY_SCOPE_AGENT); }
DI unsigned xb_xcc_id() { return (unsigned)__builtin_amdgcn_s_getreg((3 << 11) | 20) & 0xFu; }
#define XB_SPIN(cond, bar) do { unsigned _sp = 0; while (cond) { __builtin_amdgcn_s_sleep(1); \
    if ((++_sp & 255u) == 0u) { if (xb_ld(&(bar)[XB_TMO])) break; if (_sp > XB_SPIN_CAP) { atomicAdd(&(bar)[XB_TMO], 1u); break; } } } } while (0)
struct XcdBarrier { unsigned* bar; unsigned x; volatile LAS unsigned* st; };
DI XcdBarrier xcd_barrier_post(unsigned* bar, volatile LAS unsigned* st) {
  XcdBarrier b; b.bar = bar; b.x = xb_xcc_id(); b.st = st;
  if (threadIdx.x == 0) (void)xb_add(&bar[XB_XCNT(b.x)], 1u);
  return b;
}
DI void xcd_barrier_complete(unsigned* bar, unsigned x, unsigned& nloc, unsigned& nx) {
  const unsigned G = gridDim.x * gridDim.y * gridDim.z;
  unsigned sum, cnt, mine, sp = 0u;
  for (;;) {
    sum = 0u; cnt = 0u; mine = 0u;
#pragma unroll
    for (unsigned j = 0; j < 16; ++j) { const unsigned c = xb_ld(&bar[XB_XCNT(j)]); sum += c; cnt += (c > 0u) ? 1u : 0u; mine = (j == x) ? c : mine; }
    if (sum == G) break;
    __builtin_amdgcn_s_sleep(1);
    if ((++sp & 255u) == 0u) { if (xb_ld(&bar[XB_TMO])) break; if (sp > XB_SPIN_CAP) { atomicAdd(&bar[XB_TMO], 1u); break; } }
  }
  nloc = mine > 0u ? mine : 1u; nx = cnt > 0u ? cnt : 1u;
}
DI void xcd_barrier(unsigned* barp, char* stp) {
  asm volatile("s_waitcnt vmcnt(0)" ::: "memory");
  __syncthreads();
  if (threadIdx.x == 0) {
    XcdBarrier b; b.bar = barp; b.x = xb_xcc_id(); b.st = (volatile LAS unsigned*)stp;
    unsigned* bar = b.bar;
    __builtin_amdgcn_s_waitcnt(0);
    unsigned nloc = b.st[0], nx = b.st[1];
    if (nloc == 0u) { xcd_barrier_complete(bar, b.x, nloc, nx); b.st[0] = nloc; b.st[1] = nx; }
    const unsigned old = xb_add(&bar[XB_XSUB(b.x)], 1u);
    const unsigned gen = old / nloc;
    if (old + 1u == (gen + 1u) * nloc) {
      __builtin_amdgcn_fence(__ATOMIC_RELEASE, "agent");
      asm volatile("s_waitcnt vmcnt(0)" ::: "memory");
      const unsigned og = xb_add(&bar[XB_TOP], 1u);
      const unsigned tg = og / nx;
      if (og + 1u == (tg + 1u) * nx) xb_add(&bar[XB_TOPGEN], 1u);
      else XB_SPIN(xb_ld(&bar[XB_TOPGEN]) == tg, bar);
      __builtin_amdgcn_fence(__ATOMIC_ACQUIRE, "agent");
      xb_add(&bar[XB_XGEN(b.x)], 1u);
      asm volatile("s_waitcnt vmcnt(0)" ::: "memory");
    } else {
      XB_SPIN(xb_ld(&bar[XB_XGEN(b.x)]) == gen, bar);
      __builtin_amdgcn_fence(__ATOMIC_ACQUIRE, "agent");
      asm volatile("s_waitcnt vmcnt(0)" ::: "memory");
    }
  }
  __syncthreads();
}

constexpr int SMEM_BYTES = 143360;
__global__ void __launch_bounds__(NT) fwd_megakernel(P p) {
  __shared__ __attribute__((aligned(16))) char smem[SMEM_BYTES + 16];
  if (threadIdx.x < 4) ((volatile LAS unsigned*)(smem + SMEM_BYTES))[threadIdx.x] = 0u;
  __syncthreads();
  (void)xcd_barrier_post((unsigned*)(p.ws + OFF_BAR), (volatile LAS unsigned*)(smem + SMEM_BYTES));
  phase_ada(p, smem);
  xcd_barrier((unsigned*)(p.ws + OFF_BAR), smem + SMEM_BYTES);
  phase_u1(p);
  phase_transposes(p, smem);
  phase_keys(p);
  phase_rope(p);
  phase_filter(p, smem);
  xcd_barrier((unsigned*)(p.ws + OFF_BAR), smem + SMEM_BYTES);
  phase_inproj(p, smem);
  xcd_barrier((unsigned*)(p.ws + OFF_BAR), smem + SMEM_BYTES);
  for (int item = blockIdx.x; item < 512 + 256; item += gridDim.x) {
    if (item < 512) hyena_item(p, smem, item);
    else attn_item(p, smem, item - 512);
  }
  xcd_barrier((unsigned*)(p.ws + OFF_BAR), smem + SMEM_BYTES);
  phase_merge(p, smem);
  xcd_barrier((unsigned*)(p.ws + OFF_BAR), smem + SMEM_BYTES);
  phase_outproj(p, smem);
  xcd_barrier((unsigned*)(p.ws + OFF_BAR), smem + SMEM_BYTES);
  phase_ln1(p);
  phase_tabconv(p);
  xcd_barrier((unsigned*)(p.ws + OFF_BAR), smem + SMEM_BYTES);
  phase_route(p, smem);
  xcd_barrier((unsigned*)(p.ws + OFF_BAR), smem + SMEM_BYTES);
  phase_upass(p, smem);
  xcd_barrier((unsigned*)(p.ws + OFF_BAR), smem + SMEM_BYTES);
  phase_vpass(p);
  xcd_barrier((unsigned*)(p.ws + OFF_BAR), smem + SMEM_BYTES);
  phase_ln2(p);
}

extern "C" void kernel_launch(void* const* d_in, const int* in_sizes, int n_in, void* d_out, int out_size, void* d_ws, size_t ws_size,
                              hipStream_t stream) {
  P p{};
  p.x = (const float*)d_in[0]; p.c = (const float*)d_in[1]; p.pos = (const int*)d_in[2];
  p.w_ada = (const float*)d_in[3]; p.b_ada = (const float*)d_in[4]; p.w_in = (const float*)d_in[5];
  p.hy_conv_w = (const float*)d_in[6]; p.hy_conv_b = (const float*)d_in[7];
  p.f1_w = (const float*)d_in[8]; p.f1_b = (const float*)d_in[9]; p.f1_freq = (const float*)d_in[10];
  p.f2_w = (const float*)d_in[11]; p.f2_b = (const float*)d_in[12]; p.f2_freq = (const float*)d_in[13];
  p.f3_w = (const float*)d_in[14]; p.hy_bias = (const float*)d_in[15];
  p.w_bh = (const float*)d_in[16]; p.w_ba = (const float*)d_in[17]; p.w_out = (const float*)d_in[18];
  p.ln1_g = (const float*)d_in[19]; p.ln1_b = (const float*)d_in[20];
  p.wq = (const float*)d_in[21]; p.keys = (const float*)d_in[22]; p.pu = (const float*)d_in[23]; p.pv = (const float*)d_in[24];
  p.ln2_g = (const float*)d_in[25]; p.ln2_b = (const float*)d_in[26];
  p.out = (float*)d_out; p.ws = (char*)d_ws;

  static int grid_blocks = 0;
  if (!grid_blocks) {
    int dev = 0, cus = 0, per_cu = 0;
    hipGetDevice(&dev);
    hipDeviceGetAttribute(&cus, hipDeviceAttributeMultiprocessorCount, dev);
    hipOccupancyMaxActiveBlocksPerMultiprocessor(&per_cu, fwd_megakernel, NT, 0);
    if (per_cu > 1) per_cu = 1;
    grid_blocks = cus * per_cu;
  }
  (void)hipMemsetAsync((char*)d_ws + OFF_BAR, 0, XCD_BAR_WORDS * 4, stream);
  void* args[] = {&p};
  hipError_t e = hipLaunchCooperativeKernel((void*)fwd_megakernel, dim3(grid_blocks), dim3(NT), args, 0, stream);
  if (e != hipSuccess) fprintf(stderr, "cooperative launch failed: %s (grid %d)\n", hipGetErrorString(e), grid_blocks);
}
```

```cpp
#include <hip/hip_runtime.h>
#include <hip/hip_cooperative_groups.h>
#include <cstdio>
#include <cstdint>

#define DI __device__ __forceinline__
typedef unsigned short ushort_t;
typedef __attribute__((ext_vector_type(8))) short bf16x8;
typedef __attribute__((ext_vector_type(16))) float f32x16;
typedef __attribute__((ext_vector_type(4))) float f32x4;
typedef __attribute__((ext_vector_type(4))) unsigned u32x4;

constexpr int T_ = 16384, S_ = 8192, NB = 2, D_ = 1024;
constexpr int HW_ = 512, HYC = 1536, QKVC = 2304, GATEC = 2048, INW = 5888;
constexpr int NT = 512;
constexpr float DN_ALPHA = 1.189207115002721f;
constexpr float LN_EPS = 1e-5f;

constexpr size_t OFF_ADA   = 0;
constexpr size_t OFF_BAR   = 49152;
constexpr size_t OFF_KEYS_B= 65536;
constexpr size_t OFF_WIN_T = 65536 + 524288;
constexpr size_t OFF_WQ_T  = OFF_WIN_T + (size_t)INW * 1024 * 2;
constexpr size_t OFF_WOUT_T= OFF_WQ_T + (size_t)2048 * 1024 * 2;
constexpr size_t OFF_WBH_T = OFF_WOUT_T + (size_t)1024 * 1024 * 2;
constexpr size_t OFF_WBA_T = OFF_WBH_T + (size_t)1024 * 512 * 2;
constexpr size_t OFF_PH    = OFF_WBA_T + (size_t)1024 * 256 * 2;
constexpr size_t OFF_QKV   = OFF_PH + (size_t)T_ * HYC * 2;
constexpr size_t OFF_GATE  = OFF_QKV + (size_t)T_ * QKVC * 2;
constexpr size_t OFF_YH    = OFF_GATE + (size_t)T_ * GATEC * 2;
constexpr size_t OFF_YA    = OFF_YH + (size_t)T_ * HW_ * 2;
constexpr size_t OFF_END   = OFF_YA + (size_t)T_ * 256 * 2;
constexpr size_t OFF_MERGED= OFF_PH;
constexpr size_t OFF_U1B   = OFF_YH;
static_assert(OFF_U1B + (size_t)T_ * 1024 * 2 <= 268435456ull, "u1b overflow");
constexpr size_t OFF_U2B   = OFF_PH;
constexpr size_t OFF_TABU  = OFF_QKV;
constexpr size_t OFF_TABV  = OFF_QKV + (size_t)16 * 1048576;
constexpr size_t OFF_SU    = OFF_QKV + (size_t)32 * 1048576;
constexpr size_t OFF_SV    = OFF_SU + 65536;
constexpr size_t OFF_COEF  = OFF_QKV + (size_t)64 * 1048576;
constexpr size_t OFF_F     = OFF_QKV + (size_t)72 * 1048576;
static_assert(OFF_F + (size_t)64 * 1048576 <= OFF_YH, "peer buffers overflow the qkv+gate region");
constexpr size_t OFF_IDX   = OFF_YH;
constexpr size_t OFF_GV    = OFF_YH + (size_t)T_ * 128 * 4;
constexpr size_t OFF_HSCR  = OFF_END;
static_assert(OFF_HSCR + (size_t)164 * 131072 <= 268435456ull, "ws overflow");
static_assert((size_t)92 * 131072 <= (size_t)INW * 1024 * 2, "w_in^T region too small");
constexpr size_t OFF_ROPE  = OFF_HSCR + (size_t)164 * 131072;
static_assert(OFF_ROPE + (size_t)T_ * 64 <= 268435456ull, "rope table overflow");

struct P {
  const float *x, *c; const int* pos;
  const float *w_ada, *b_ada, *w_in, *hy_conv_w, *hy_conv_b, *f1_w, *f1_b, *f1_freq, *f2_w, *f2_b, *f2_freq, *f3_w,
      *hy_bias, *w_bh, *w_ba, *w_out, *ln1_g, *ln1_b, *wq, *keys, *pu, *pv, *ln2_g, *ln2_b;
  float* out; char* ws;
};

DI ushort_t f2bf(float x) { unsigned u = __float_as_uint(x); u += 0x7fffu + ((u >> 16) & 1u); return (ushort_t)(u >> 16); }
DI float bf2f(ushort_t h) { return __uint_as_float(((unsigned)h) << 16); }
typedef __bf16 bf16x2_hw __attribute__((ext_vector_type(2)));
typedef float f32x2_hw __attribute__((ext_vector_type(2)));
DI unsigned pack2(float a, float b) { f32x2_hw v = {a, b}; return __builtin_bit_cast(unsigned, __builtin_convertvector(v, bf16x2_hw)); }
DI int tid_opaque() { int t = threadIdx.x; asm volatile("" : "+v"(t)); return t; }
DI float wave_sum(float v) {
#pragma unroll
  for (int o = 32; o > 0; o >>= 1) v += __shfl_xor(v, o);
  return v;
}

struct cf2 { float x, y; };
constexpr int FFT_N = 16384, FFT_SA = 560;

DI constexpr float wcos32(int j) {
  switch (j & 31) {
    case 0: return 1.0f; case 1: return 0.98078528040323043f; case 2: return 0.92387953251128674f; case 3: return 0.83146961230254524f;
    case 4: return 0.70710678118654752f; case 5: return 0.55557023301960218f; case 6: return 0.38268343236508978f; case 7: return 0.19509032201612825f;
    case 8: return 0.0f; case 9: return -0.19509032201612825f; case 10: return -0.38268343236508978f; case 11: return -0.55557023301960218f;
    case 12: return -0.70710678118654752f; case 13: return -0.83146961230254524f; case 14: return -0.92387953251128674f; case 15: return -0.98078528040323043f;
    case 16: return -1.0f; case 17: return -0.98078528040323043f; case 18: return -0.92387953251128674f; case 19: return -0.83146961230254524f;
    case 20: return -0.70710678118654752f; case 21: return -0.55557023301960218f; case 22: return -0.38268343236508978f; case 23: return -0.19509032201612825f;
    case 24: return 0.0f; case 25: return 0.19509032201612825f; case 26: return 0.38268343236508978f; case 27: return 0.55557023301960218f;
    case 28: return 0.70710678118654752f; case 29: return 0.83146961230254524f; case 30: return 0.92387953251128674f; default: return 0.98078528040323043f;
  }
}
DI constexpr float wsin32(int j) { return wcos32(j + 24); }
DI constexpr int brev(int v, int bits) { int r = 0; for (int i = 0; i < bits; ++i) r |= ((v >> i) & 1) << (bits - 1 - i); return r; }

template <int R, int LEN, bool INV, bool ZHI>
DI void r2_stage(float (&re)[R], float (&im)[R]) {
  constexpr int half = LEN / 2;
#pragma unroll
  for (int start = 0; start < R; start += LEN) {
#pragma unroll
    for (int j = 0; j < half; ++j) {
      const int a = start + j, b = a + half;
      const int tj = j * (32 / LEN);
      const float c = wcos32(tj), s = wsin32(tj);
      if (!INV) {
        float dr, di;
        if (ZHI) { dr = re[a]; di = im[a]; }
        else {
          const float ar = re[a], ai = im[a], br = re[b], bi = im[b];
          re[a] = ar + br; im[a] = ai + bi; dr = ar - br; di = ai - bi;
        }
        if (tj == 0) { re[b] = dr; im[b] = di; }
        else if (tj == 8) { re[b] = di; im[b] = -dr; }
        else { re[b] = dr * c + di * s; im[b] = di * c - dr * s; }
      } else {
        const float br = re[b], bi = im[b];
        float pr, pi;
        if (tj == 0) { pr = br; pi = bi; }
        else if (tj == 8) { pr = -bi; pi = br; }
        else { pr = br * c - bi * s; pi = bi * c + br * s; }
        const float ar = re[a], ai = im[a];
        re[a] = ar + pr; im[a] = ai + pi; re[b] = ar - pr; im[b] = ai - pi;
      }
    }
  }
}
template <int R, bool ZHI> DI void dft_fwd(float (&re)[R], float (&im)[R]) {
  if (R == 32) r2_stage<R, (R == 32 ? 32 : 2), false, ZHI>(re, im);
  r2_stage<R, 16, false, (R == 16) && ZHI>(re, im);
  r2_stage<R, 8, false, false>(re, im);
  r2_stage<R, 4, false, false>(re, im);
  r2_stage<R, 2, false, false>(re, im);
}
template <int R> DI void dft_inv(float (&re)[R], float (&im)[R]) {
  r2_stage<R, 2, true, false>(re, im);
  r2_stage<R, 4, true, false>(re, im);
  r2_stage<R, 8, true, false>(re, im);
  r2_stage<R, 16, true, false>(re, im);
  if (R == 32) r2_stage<R, (R == 32 ? 32 : 2), true, false>(re, im);
}

DI void sincos_turn(float frac, float& s, float& c) { sincospif(2.0f * frac, &s, &c); }

template <bool ZHI>
DI void fft_fwdA(float (&re)[32], float (&im)[32], cf2* lds, int m) {
  asm volatile("" : "+v"(m));
  float s1, c1; sincos_turn((float)m * (1.0f / 16384.0f), s1, c1);
  __builtin_amdgcn_sched_barrier(0);
  dft_fwd<32, ZHI>(re, im);
  __builtin_amdgcn_sched_barrier(0);
  float wr = 1.f, wi = 0.f;
#pragma unroll
  for (int k1 = 0; k1 < 32; ++k1) {
    if ((k1 & 3) == 0) __builtin_amdgcn_sched_barrier(0);
    const int r = brev(k1, 5);
    cf2 o; o.x = re[r] * wr - im[r] * wi; o.y = re[r] * wi + im[r] * wr;
    lds[k1 * FFT_SA + m] = o;
    const float nr = wr * c1 + wi * s1, ni = wi * c1 - wr * s1;
    wr = nr; wi = ni;
  }
}
DI void fft_B_read(float (&re)[32], float (&im)[32], const cf2* lds, int tid) {
  const int k1 = tid >> 4, mp = tid & 15;
#pragma unroll
  for (int n2 = 0; n2 < 32; ++n2) { cf2 v = lds[k1 * FFT_SA + n2 * 16 + mp]; re[n2] = v.x; im[n2] = v.y; }
}
DI void fft_fwdB_write(float (&re)[32], float (&im)[32], cf2* lds, int tid) {
  asm volatile("" : "+v"(tid));
  const int k1 = tid >> 4, mp = tid & 15;
  float s1, c1; sincos_turn((float)mp * (1.0f / 512.0f), s1, c1);
  __builtin_amdgcn_sched_barrier(0);
  dft_fwd<32, false>(re, im);
  __builtin_amdgcn_sched_barrier(0);
  float wr = 1.f, wi = 0.f;
#pragma unroll
  for (int k2 = 0; k2 < 32; ++k2) {
    if ((k2 & 3) == 0) __builtin_amdgcn_sched_barrier(0);
    const int r = brev(k2, 5);
    cf2 o; o.x = re[r] * wr - im[r] * wi; o.y = re[r] * wi + im[r] * wr;
    lds[k1 * FFT_SA + k2 * 17 + mp] = o;
    const float nr = wr * c1 + wi * s1, ni = wi * c1 - wr * s1;
    wr = nr; wi = ni;
  }
}
DI void fft_fwdC(float (&re)[32], float (&im)[32], const cf2* lds, int tid) {
  const int k1 = tid >> 5, k2 = tid & 31;
#pragma unroll
  for (int h = 0; h < 2; ++h) {
    float tr[16], ti[16];
#pragma unroll
    for (int mp = 0; mp < 16; ++mp) { cf2 v = lds[(k1 + 16 * h) * FFT_SA + k2 * 17 + mp]; tr[mp] = v.x; ti[mp] = v.y; }
    dft_fwd<16, false>(tr, ti);
#pragma unroll
    for (int i = 0; i < 16; ++i) { re[h * 16 + i] = tr[i]; im[h * 16 + i] = ti[i]; }
  }
}
DI void fft_invC(float (&re)[32], float (&im)[32], cf2* lds, int tid) {
  const int k1 = tid >> 5, k2 = tid & 31;
#pragma unroll
  for (int h = 0; h < 2; ++h) {
    float tr[16], ti[16];
#pragma unroll
    for (int i = 0; i < 16; ++i) { tr[i] = re[h * 16 + i]; ti[i] = im[h * 16 + i]; }
    dft_inv<16>(tr, ti);
#pragma unroll
    for (int mp = 0; mp < 16; ++mp) { cf2 o; o.x = tr[mp]; o.y = ti[mp]; lds[(k1 + 16 * h) * FFT_SA + k2 * 17 + mp] = o; }
  }
}
DI void fft_invB_read(float (&re)[32], float (&im)[32], const cf2* lds, int tid) {
  asm volatile("" : "+v"(tid));
  const int k1 = tid >> 4, mp = tid & 15;
  float s1, c1; sincos_turn((float)mp * (1.0f / 512.0f), s1, c1);
  float wr = 1.f, wi = 0.f;
  __builtin_amdgcn_sched_barrier(0);
#pragma unroll
  for (int k2 = 0; k2 < 32; ++k2) {
    if ((k2 & 3) == 0) __builtin_amdgcn_sched_barrier(0);
    const int r = brev(k2, 5);
    cf2 v = lds[k1 * FFT_SA + k2 * 17 + mp];
    re[r] = v.x * wr - v.y * wi; im[r] = v.x * wi + v.y * wr;
    const float nr = wr * c1 - wi * s1, ni = wi * c1 + wr * s1;
    wr = nr; wi = ni;
  }
}
DI void fft_invB_write(float (&re)[32], float (&im)[32], cf2* lds, int tid) {
  const int k1 = tid >> 4, mp = tid & 15;
  dft_inv<32>(re, im);
#pragma unroll
  for (int n2 = 0; n2 < 32; ++n2) { cf2 o; o.x = re[n2]; o.y = im[n2]; lds[k1 * FFT_SA + n2 * 16 + mp] = o; }
}
DI void fft_invA(float (&re)[32], float (&im)[32], const cf2* lds, int m) {
  asm volatile("" : "+v"(m));
  float s1, c1; sincos_turn((float)m * (1.0f / 16384.0f), s1, c1);
  float wr = 1.f, wi = 0.f;
  __builtin_amdgcn_sched_barrier(0);
#pragma unroll
  for (int k1 = 0; k1 < 32; ++k1) {
    if ((k1 & 3) == 0) __builtin_amdgcn_sched_barrier(0);
    const int r = brev(k1, 5);
    cf2 v = lds[k1 * FFT_SA + m];
    re[r] = v.x * wr - v.y * wi; im[r] = v.x * wi + v.y * wr;
    const float nr = wr * c1 - wi * s1, ni = wi * c1 + wr * s1;
    wr = nr; wi = ni;
  }
  __builtin_amdgcn_sched_barrier(0);
  dft_inv<32>(re, im);
}

DI void phase_ada(const P& p, char* smem) {
  float (*red)[16][32] = (float (*)[16][32])smem;
  const int tid = tid_opaque(), cl = tid & 31, kq = tid >> 5;
  for (int item = blockIdx.x; item < 192; item += gridDim.x) {
    const int col = item * 32 + cl;
    float a0 = 0.f, a1 = 0.f;
#pragma unroll 16
    for (int k = kq * 64; k < kq * 64 + 64; ++k) {
      const float w = p.w_ada[(size_t)k * 6144 + col];
      const float c0 = p.c[k], c1 = p.c[1024 + k];
      a0 += (c0 / (1.f + __expf(-c0))) * w;
      a1 += (c1 / (1.f + __expf(-c1))) * w;
    }
    __syncthreads();
    red[0][kq][cl] = a0; red[1][kq][cl] = a1;
    __syncthreads();
    if (tid < 64) {
      const int b = tid >> 5;
      float s = p.b_ada[col];
#pragma unroll
      for (int q = 0; q < 16; ++q) s += red[b][q][cl];
      ((float*)(p.ws + OFF_ADA))[b * 6144 + col] = s;
    }
  }
}
DI void phase_u1(const P& p) {
  const float* ada = (const float*)(p.ws + OFF_ADA);
  ushort_t* u1b = (ushort_t*)(p.ws + OFF_U1B);
  for (int i = blockIdx.x * NT + tid_opaque(); i < T_ * 128; i += gridDim.x * NT) {
    const int row = i >> 7, k = (i & 127) * 8, b = row / S_;
    const float* xp = p.x + (size_t)row * 1024 + k;
    const f32x4 x0 = *(const f32x4*)xp, x1 = *(const f32x4*)(xp + 4);
    const f32x4 s0 = *(const f32x4*)(ada + b * 6144 + 1024 + k), s1 = *(const f32x4*)(ada + b * 6144 + 1024 + k + 4);
    const f32x4 h0 = *(const f32x4*)(ada + b * 6144 + k), h1 = *(const f32x4*)(ada + b * 6144 + k + 4);
    u32x4 o;
    o[0] = pack2(x0[0] * (1.f + s0[0]) + h0[0], x0[1] * (1.f + s0[1]) + h0[1]);
    o[1] = pack2(x0[2] * (1.f + s0[2]) + h0[2], x0[3] * (1.f + s0[3]) + h0[3]);
    o[2] = pack2(x1[0] * (1.f + s1[0]) + h1[0], x1[1] * (1.f + s1[1]) + h1[1]);
    o[3] = pack2(x1[2] * (1.f + s1[2]) + h1[2], x1[3] * (1.f + s1[3]) + h1[3]);
    *(u32x4*)(u1b + (size_t)row * 1024 + k) = o;
  }
}

DI void transpose_tile(const float* __restrict__ W, ushort_t* __restrict__ Wt, int K, int N, int item, char* smem) {
  float (*tile)[65] = (float (*)[65])smem;
  const int ntn = N / 64;
  const int n0 = (item % ntn) * 64, k0 = (item / ntn) * 32;
  const int tid = tid_opaque();
  __syncthreads();
  {
    const int tx = tid & 63, ty = tid >> 6;
#pragma unroll
    for (int i = 0; i < 4; ++i) tile[ty + 8 * i][tx] = W[(size_t)(k0 + ty + 8 * i) * N + n0 + tx];
  }
  __syncthreads();
  {
    const int kk = tid & 31, nn0 = tid >> 5;
#pragma unroll
    for (int i = 0; i < 4; ++i) Wt[(size_t)(n0 + nn0 + 16 * i) * K + k0 + kk] = f2bf(tile[kk][nn0 + 16 * i]);
  }
}
DI void phase_transposes(const P& p, char* smem) {
  constexpr int I0 = (INW / 64) * 32, I1 = I0 + 32 * 32, I2 = I1 + 16 * 32, I3 = I2 + 16 * 16, I4 = I3 + 16 * 8;
  for (int item = blockIdx.x; item < I4; item += gridDim.x) {
    if (item < I0) transpose_tile(p.w_in, (ushort_t*)(p.ws + OFF_WIN_T), 1024, INW, item, smem);
    else if (item < I1) transpose_tile(p.wq, (ushort_t*)(p.ws + OFF_WQ_T), 1024, 2048, item - I0, smem);
    else if (item < I2) transpose_tile(p.w_out, (ushort_t*)(p.ws + OFF_WOUT_T), 1024, 1024, item - I1, smem);
    else if (item < I3) transpose_tile(p.w_bh, (ushort_t*)(p.ws + OFF_WBH_T), 512, 1024, item - I2, smem);
    else transpose_tile(p.w_ba, (ushort_t*)(p.ws + OFF_WBA_T), 256, 1024, item - I3, smem);
  }
}

DI void phase_filter(const P& p, char* smem) {
  float (*zf)[33] = (float (*)[33])smem;
  float (*h1)[64] = (float (*)[64])(smem + 4352);
  float (*h2T)[32] = (float (*)[32])(smem + 4352 + 8192);
  const int tid = tid_opaque();
  for (int item = blockIdx.x; item < 256; item += gridDim.x) {
  const int t0 = item * 32;
  __syncthreads();
  for (int idx = tid; idx < 32 * 33; idx += NT) {
    int tt = idx / 33, e = idx % 33, t = t0 + tt;
    float tl = (float)t * (1.0f / 8191.0f);
    float w = 6.283185307179586f * (float)t / 8192.0f;
    float val;
    if (e == 0) val = tl;
    else {
      int i = (e - 1) & 15;
      float f = 1e-4f + (float)i * ((15.0f - 1e-4f) / 15.0f);
      val = (e <= 16) ? cosf(f * w) : -sinf(f * w);
    }
    zf[tt][e] = val;
  }
  __syncthreads();
  for (int idx = tid; idx < 32 * 64; idx += NT) {
    int tt = idx >> 6, j = idx & 63;
    float a = p.f1_b[j];
    for (int e = 0; e < 33; ++e) a += zf[tt][e] * p.f1_w[e * 64 + j];
    h1[tt][j] = sinf(p.f1_freq[j] * a);
  }
  __syncthreads();
  for (int idx = tid; idx < 32 * 64; idx += NT) {
    int tt = idx >> 6, j = idx & 63;
    float a = p.f2_b[j];
    for (int e = 0; e < 64; ++e) a += h1[tt][e] * p.f2_w[e * 64 + j];
    h2T[j][tt] = sinf(p.f2_freq[j] * a);
  }
  __syncthreads();
  float* filt = p.out;
  const float min_decay = -3.0701134573253945f, max_decay = -15.350567286626973f;
  for (int col = tid; col < 2048; col += NT) {
    float acc[32];
#pragma unroll
    for (int i = 0; i < 32; ++i) acc[i] = 0.f;
    for (int j = 0; j < 64; ++j) {
      float w = p.f3_w[j * 2048 + col];
#pragma unroll
      for (int q = 0; q < 8; ++q) {
        f32x4 h = *(const f32x4*)&h2T[j][q * 4];
        acc[q * 4 + 0] += h[0] * w; acc[q * 4 + 1] += h[1] * w; acc[q * 4 + 2] += h[2] * w; acc[q * 4 + 3] += h[3] * w;
      }
    }
    int c = col & 511;
    float delta = fabsf(min_decay + (float)c * ((max_decay - min_decay) / 511.0f));
    float* dst = filt + (size_t)col * 8192 + t0;
#pragma unroll
    for (int q = 0; q < 8; ++q) {
      f32x4 o;
#pragma unroll
      for (int r = 0; r < 4; ++r) {
        float tl = (float)(t0 + q * 4 + r) * (1.0f / 8191.0f);
        o[r] = acc[q * 4 + r] * __expf(-tl * delta);
      }
      *(f32x4*)(dst + q * 4) = o;
    }
  }
  }
}

constexpr int BM = 256, BN = 128, BK = 64;
constexpr int LDS_A = BM * BK * 2, LDS_B = BN * BK * 2, LDS_STAGE = LDS_A + LDS_B;
constexpr int GEMM_LDS = 2 * LDS_STAGE + 8192;

DI int swz(int row, int ch) { return row * 128 + ((ch ^ (row & 7)) << 4); }

struct ALoadBf16 {
  const ushort_t* A; int lda;
  struct Raw { u32x4 v; };
  DI Raw fetch(int row, int k) const { Raw r; r.v = *(const u32x4*)(A + (size_t)row * lda + k); return r; }
  DI u32x4 cvt(const Raw& r, int k) const { return r.v; }
};
struct ALoadF32Mod {
  const float* A; const float* mod;
  struct Raw { f32x4 a, b; };
  DI Raw fetch(int row, int k) const { Raw r; const float* s = A + (size_t)row * 1024 + k; r.a = *(const f32x4*)s; r.b = *(const f32x4*)(s + 4); return r; }
  DI u32x4 cvt(const Raw& r, int k) const {
    f32x4 s0 = *(const f32x4*)(mod + k), s1 = *(const f32x4*)(mod + k + 4);
    f32x4 h0 = *(const f32x4*)(mod + 1024 + k), h1 = *(const f32x4*)(mod + 1024 + k + 4);
    u32x4 o;
    o[0] = pack2(r.a[0] * s0[0] + h0[0], r.a[1] * s0[1] + h0[1]);
    o[1] = pack2(r.a[2] * s0[2] + h0[2], r.a[3] * s0[3] + h0[3]);
    o[2] = pack2(r.b[0] * s1[0] + h1[0], r.b[1] * s1[1] + h1[1]);
    o[3] = pack2(r.b[2] * s1[2] + h1[2], r.b[3] * s1[3] + h1[3]);
    return o;
  }
};

template <class AL, bool SWAP = false>
DI void gemm_mainloop(f32x16 (&acc)[2][2], const AL& al, int m0, const ushort_t* __restrict__ Bt, int ldb, int n0, int K, char* smem) {
  const int tid = tid_opaque(), lane = tid & 63, wave = tid >> 6;
  const int wm = wave >> 1, wn = wave & 1;
  const int lr = tid >> 3, lc = tid & 7;
  typename AL::Raw ra[4]; u32x4 rb[2];
  const int nk = K / BK;
#pragma unroll
  for (int i = 0; i < 4; ++i) ra[i] = al.fetch(m0 + lr + 64 * i, lc * 8);
#pragma unroll
  for (int i = 0; i < 2; ++i) rb[i] = *(const u32x4*)(Bt + (size_t)(n0 + lr + 64 * i) * ldb + lc * 8);
  __syncthreads();
#pragma unroll
  for (int i = 0; i < 4; ++i) *(u32x4*)(smem + swz(lr + 64 * i, lc)) = al.cvt(ra[i], lc * 8);
#pragma unroll
  for (int i = 0; i < 2; ++i) *(u32x4*)(smem + LDS_A + swz(lr + 64 * i, lc)) = rb[i];
  __syncthreads();
  for (int kt = 0; kt < nk; ++kt) {
    char* cur = smem + (kt & 1) * LDS_STAGE;
    char* nxt = smem + ((kt + 1) & 1) * LDS_STAGE;
    const bool more = (kt + 1 < nk);
    const int kn = (kt + 1) * BK + lc * 8;
    if (more) {
#pragma unroll
      for (int i = 0; i < 4; ++i) ra[i] = al.fetch(m0 + lr + 64 * i, kn);
#pragma unroll
      for (int i = 0; i < 2; ++i) rb[i] = *(const u32x4*)(Bt + (size_t)(n0 + lr + 64 * i) * ldb + kn);
    }
#pragma unroll
    for (int s = 0; s < 4; ++s) {
      const int ch = 2 * s + (lane >> 5);
      bf16x8 af[2], bfr[2];
#pragma unroll
      for (int mi = 0; mi < 2; ++mi) af[mi] = *(const bf16x8*)(cur + swz(wm * 64 + mi * 32 + (lane & 31), ch));
#pragma unroll
      for (int ni = 0; ni < 2; ++ni) bfr[ni] = *(const bf16x8*)(cur + LDS_A + swz(wn * 64 + ni * 32 + (lane & 31), ch));
#pragma unroll
      for (int mi = 0; mi < 2; ++mi)
#pragma unroll
        for (int ni = 0; ni < 2; ++ni)
          acc[mi][ni] = SWAP ? __builtin_amdgcn_mfma_f32_32x32x16_bf16(bfr[ni], af[mi], acc[mi][ni], 0, 0, 0)
                             : __builtin_amdgcn_mfma_f32_32x32x16_bf16(af[mi], bfr[ni], acc[mi][ni], 0, 0, 0);
    }
    if (more) {
#pragma unroll
      for (int i = 0; i < 4; ++i) *(u32x4*)(nxt + swz(lr + 64 * i, lc)) = al.cvt(ra[i], kn);
#pragma unroll
      for (int i = 0; i < 2; ++i) *(u32x4*)(nxt + LDS_A + swz(lr + 64 * i, lc)) = rb[i];
    }
    __syncthreads();
  }
}

constexpr int AT_ROW = 576;
constexpr int LDS_AT = 64 * AT_ROW;
constexpr int LDS_STAGE_T = LDS_AT + LDS_B;
typedef __attribute__((ext_vector_type(4))) short s16x4;
DI void gemm_mainloop_AT(f32x16 (&acc)[2][2], const ushort_t* __restrict__ At, size_t ldt, const ushort_t* __restrict__ Bt, int ldb, int n0, int K, char* smem) {
  const int tid = tid_opaque(), lane = tid & 63, wave = tid >> 6;
  const int wm = wave >> 1, wn = wave & 1;
  const int lr = tid >> 3, lc = tid & 7;
  u32x4 ra[4], rb[2];
  const int nk = K / BK;
#pragma unroll
  for (int i = 0; i < 4; ++i) { const int q = tid + 512 * i; ra[i] = *(const u32x4*)(At + (size_t)(q >> 5) * ldt + (q & 31) * 8); }
#pragma unroll
  for (int i = 0; i < 2; ++i) rb[i] = *(const u32x4*)(Bt + (size_t)(n0 + lr + 64 * i) * ldb + lc * 8);
  __syncthreads();
#pragma unroll
  for (int i = 0; i < 4; ++i) { const int q = tid + 512 * i; *(u32x4*)(smem + (q >> 5) * AT_ROW + (q & 31) * 16) = ra[i]; }
#pragma unroll
  for (int i = 0; i < 2; ++i) *(u32x4*)(smem + LDS_AT + swz(lr + 64 * i, lc)) = rb[i];
  __syncthreads();
  const int hh = lane >> 5, gg = (lane >> 4) & 1, qq = (lane & 15) >> 2, pp = lane & 3;
  for (int kt = 0; kt < nk; ++kt) {
    char* cur = smem + (kt & 1) * LDS_STAGE_T;
    char* nxt = smem + ((kt + 1) & 1) * LDS_STAGE_T;
    const bool more = (kt + 1 < nk);
    if (more) {
#pragma unroll
      for (int i = 0; i < 4; ++i) { const int q = tid + 512 * i; ra[i] = *(const u32x4*)(At + (size_t)((kt + 1) * BK + (q >> 5)) * ldt + (q & 31) * 8); }
#pragma unroll
      for (int i = 0; i < 2; ++i) rb[i] = *(const u32x4*)(Bt + (size_t)(n0 + lr + 64 * i) * ldb + (kt + 1) * BK + lc * 8);
    }
#pragma unroll
    for (int s = 0; s < 4; ++s) {
      const int ch = 2 * s + hh;
      bf16x8 af[2], bfr[2];
#pragma unroll
      for (int mi = 0; mi < 2; ++mi) {
        const char* a0 = cur + (16 * s + 8 * hh + qq) * AT_ROW + (wm * 64 + mi * 32 + 16 * gg + 4 * pp) * 2;
        s16x4 lo = __builtin_amdgcn_ds_read_tr16_b64_v4i16((__attribute__((address_space(3))) s16x4*)(a0));
        s16x4 hi = __builtin_amdgcn_ds_read_tr16_b64_v4i16((__attribute__((address_space(3))) s16x4*)(a0 + 4 * AT_ROW));
        af[mi] = __builtin_shufflevector(lo, hi, 0, 1, 2, 3, 4, 5, 6, 7);
      }
#pragma unroll
      for (int ni = 0; ni < 2; ++ni) bfr[ni] = *(const bf16x8*)(cur + LDS_AT + swz(wn * 64 + ni * 32 + (lane & 31), ch));
#pragma unroll
      for (int mi = 0; mi < 2; ++mi)
#pragma unroll
        for (int ni = 0; ni < 2; ++ni) acc[mi][ni] = __builtin_amdgcn_mfma_f32_32x32x16_bf16(af[mi], bfr[ni], acc[mi][ni], 0, 0, 0);
    }
    if (more) {
#pragma unroll
      for (int i = 0; i < 4; ++i) { const int q = tid + 512 * i; *(u32x4*)(nxt + (q >> 5) * AT_ROW + (q & 31) * 16) = ra[i]; }
#pragma unroll
      for (int i = 0; i < 2; ++i) *(u32x4*)(nxt + LDS_AT + swz(lr + 64 * i, lc)) = rb[i];
    }
    __syncthreads();
  }
}

constexpr int G2_A = 32768, G2_STAGE = 65536;
template <bool SWAP>
DI void gemm256(f32x16 (&acc)[4][2], const ushort_t* __restrict__ A, int lda, int m0, const ushort_t* __restrict__ Bt, int ldb, int n0, int K, char* smem) {
  const int tid = tid_opaque(), lane = tid & 63, wave = tid >> 6;
  const int wm = wave >> 2, wn = wave & 3;
  const int lr = tid >> 3, lc = tid & 7;
  u32x4 ra[4], rb[4];
  const int nk = K / BK;
  const ushort_t* ap = A + (size_t)(m0 + lr) * lda + lc * 8;
  const ushort_t* bp = Bt + (size_t)(n0 + lr) * ldb + lc * 8;
#pragma unroll
  for (int i = 0; i < 4; ++i) { ra[i] = *(const u32x4*)(ap + (size_t)(64 * i) * lda); rb[i] = *(const u32x4*)(bp + (size_t)(64 * i) * ldb); }
  __syncthreads();
#pragma unroll
  for (int i = 0; i < 4; ++i) { *(u32x4*)(smem + swz(lr + 64 * i, lc)) = ra[i]; *(u32x4*)(smem + G2_A + swz(lr + 64 * i, lc)) = rb[i]; }
  __syncthreads();
  for (int kt = 0; kt < nk; ++kt) {
    char* cur = smem + (kt & 1) * G2_STAGE;
    char* nxt = smem + ((kt + 1) & 1) * G2_STAGE;
    const bool more = (kt + 1 < nk);
    if (more) {
#pragma unroll
      for (int i = 0; i < 4; ++i) { ra[i] = *(const u32x4*)(ap + (size_t)(64 * i) * lda + (kt + 1) * BK); rb[i] = *(const u32x4*)(bp + (size_t)(64 * i) * ldb + (kt + 1) * BK); }
    }
#pragma unroll
    for (int s = 0; s < 4; ++s) {
      const int ch = 2 * s + (lane >> 5);
      bf16x8 af[4], bfr[2];
#pragma unroll
      for (int mi = 0; mi < 4; ++mi) af[mi] = *(const bf16x8*)(cur + swz(wm * 128 + mi * 32 + (lane & 31), ch));
#pragma unroll
      for (int ni = 0; ni < 2; ++ni) bfr[ni] = *(const bf16x8*)(cur + G2_A + swz(wn * 64 + ni * 32 + (lane & 31), ch));
#pragma unroll
      for (int mi = 0; mi < 4; ++mi)
#pragma unroll
        for (int ni = 0; ni < 2; ++ni)
          acc[mi][ni] = SWAP ? __builtin_amdgcn_mfma_f32_32x32x16_bf16(bfr[ni], af[mi], acc[mi][ni], 0, 0, 0)
                             : __builtin_amdgcn_mfma_f32_32x32x16_bf16(af[mi], bfr[ni], acc[mi][ni], 0, 0, 0);
      if (s & 1) __builtin_amdgcn_sched_barrier(0);
    }
    if (more) {
#pragma unroll
      for (int i = 0; i < 4; ++i) { *(u32x4*)(nxt + swz(lr + 64 * i, lc)) = ra[i]; *(u32x4*)(nxt + G2_A + swz(lr + 64 * i, lc)) = rb[i]; }
    }
    __syncthreads();
  }
}
constexpr int G2T_A = 64 * 576, G2T_STAGE = G2T_A + 32768;
DI void gemm256_AT(f32x16 (&acc)[4][2], const ushort_t* __restrict__ At, size_t ldt, const ushort_t* __restrict__ Bt, int ldb, int n0, int K, char* smem) {
  const int tid = tid_opaque(), lane = tid & 63, wave = tid >> 6;
  const int wm = wave >> 2, wn = wave & 3;
  const int lr = tid >> 3, lc = tid & 7;
  u32x4 ra[4], rb[4];
  const int nk = K / BK;
  const ushort_t* bp = Bt + (size_t)(n0 + lr) * ldb + lc * 8;
#pragma unroll
  for (int i = 0; i < 4; ++i) { const int q = tid + 512 * i; ra[i] = *(const u32x4*)(At + (size_t)(q >> 5) * ldt + (q & 31) * 8); rb[i] = *(const u32x4*)(bp + (size_t)(64 * i) * ldb); }
  __syncthreads();
#pragma unroll
  for (int i = 0; i < 4; ++i) { const int q = tid + 512 * i; *(u32x4*)(smem + (q >> 5) * 576 + (q & 31) * 16) = ra[i]; *(u32x4*)(smem + G2T_A + swz(lr + 64 * i, lc)) = rb[i]; }
  __syncthreads();
  const int hh = lane >> 5, gg = (lane >> 4) & 1, qq = (lane & 15) >> 2, pp = lane & 3;
  for (int kt = 0; kt < nk; ++kt) {
    char* cur = smem + (kt & 1) * G2T_STAGE;
    char* nxt = smem + ((kt + 1) & 1) * G2T_STAGE;
    const bool more = (kt + 1 < nk);
    if (more) {
#pragma unroll
      for (int i = 0; i < 4; ++i) { const int q = tid + 512 * i; ra[i] = *(const u32x4*)(At + (size_t)((kt + 1) * BK + (q >> 5)) * ldt + (q & 31) * 8); rb[i] = *(const u32x4*)(bp + (size_t)(64 * i) * ldb + (kt + 1) * BK); }
    }
#pragma unroll
    for (int s = 0; s < 4; ++s) {
      const int ch = 2 * s + hh;
      bf16x8 af[4], bfr[2];
#pragma unroll
      for (int mi = 0; mi < 4; ++mi) {
        const char* a0 = cur + (16 * s + 8 * hh + qq) * 576 + (wm * 128 + mi * 32 + 16 * gg + 4 * pp) * 2;
        s16x4 lo = __builtin_amdgcn_ds_read_tr16_b64_v4i16((__attribute__((address_space(3))) s16x4*)(a0));
        s16x4 hi = __builtin_amdgcn_ds_read_tr16_b64_v4i16((__attribute__((address_space(3))) s16x4*)(a0 + 4 * 576));
        af[mi] = __builtin_shufflevector(lo, hi, 0, 1, 2, 3, 4, 5, 6, 7);
      }
#pragma unroll
      for (int ni = 0; ni < 2; ++ni) bfr[ni] = *(const bf16x8*)(cur + G2T_A + swz(wn * 64 + ni * 32 + (lane & 31), ch));
#pragma unroll
      for (int mi = 0; mi < 4; ++mi)
#pragma unroll
        for (int ni = 0; ni < 2; ++ni) acc[mi][ni] = __builtin_amdgcn_mfma_f32_32x32x16_bf16(af[mi], bfr[ni], acc[mi][ni], 0, 0, 0);
      if (s & 1) __builtin_amdgcn_sched_barrier(0);
    }
    if (more) {
#pragma unroll
      for (int i = 0; i < 4; ++i) { const int q = tid + 512 * i; *(u32x4*)(nxt + (q >> 5) * 576 + (q & 31) * 16) = ra[i]; *(u32x4*)(nxt + G2T_A + swz(lr + 64 * i, lc)) = rb[i]; }
    }
    __syncthreads();
  }
}
DI void acc_zero4(f32x16 (&acc)[4][2]) {
#pragma unroll
  for (int a = 0; a < 4; ++a)
#pragma unroll
    for (int b = 0; b < 2; ++b)
#pragma unroll
      for (int r = 0; r < 16; ++r) acc[a][b][r] = 0.f;
}
DI void acc_zero(f32x16 (&acc)[2][2]) {
#pragma unroll
  for (int a = 0; a < 2; ++a)
#pragma unroll
    for (int b = 0; b < 2; ++b)
#pragma unroll
      for (int r = 0; r < 16; ++r) acc[a][b][r] = 0.f;
}
#define ACC_ROW(mi, r) (wm * 64 + (mi) * 32 + ((r) & 3) + 8 * ((r) >> 2) + 4 * (lane >> 5))
#define ACC_COL(ni) (wn * 64 + (ni) * 32 + (lane & 31))

DI void stage_mod(float* mod, const float* ada, int b, int sc_chunk, int sh_chunk) {
  for (int i = tid_opaque(); i < 1024; i += NT) {
    mod[i] = 1.f + ada[b * 6144 + sc_chunk * 1024 + i];
    mod[1024 + i] = ada[b * 6144 + sh_chunk * 1024 + i];
  }
}

DI void phase_inproj(const P& p, char* smem) {
  const ushort_t* u1b = (const ushort_t*)(p.ws + OFF_U1B);
  const ushort_t* wt = (const ushort_t*)(p.ws + OFF_WIN_T);
  constexpr int NTN = INW / 256;
  constexpr int NTM = T_ / 256;
  for (int tile = blockIdx.x; tile < NTM * NTN; tile += gridDim.x) {
    const int tid = tid_opaque(), lane = tid & 63, wave = tid >> 6, wm = wave >> 2, wn = wave & 3;
    const int tm = tile / NTN, tn = tile % NTN;
    const int m0 = tm * 256, n0 = tn * 256, b = m0 / S_;
    f32x16 acc[4][2]; acc_zero4(acc);
    if (n0 < HYC) {
      gemm256<true>(acc, u1b, 1024, m0, wt, 1024, n0, 1024, smem);
      ushort_t* pb = (ushort_t*)(p.ws + OFF_PH) + ((size_t)(b * HYC + n0)) * S_ + (m0 & (S_ - 1));
      const unsigned lo = (unsigned)((wn * 64 + 4 * (lane >> 5)) * S_ + wm * 128 + (lane & 31));
#pragma unroll
      for (int mi = 0; mi < 4; ++mi)
#pragma unroll
        for (int ni = 0; ni < 2; ++ni) {
#pragma unroll
          for (int r = 0; r < 16; ++r) (pb + (size_t)(ni * 32 + (r & 3) + 8 * (r >> 2)) * S_ + mi * 32)[lo] = f2bf(acc[mi][ni][r]);
          asm volatile("" ::: "memory");
        }
      continue;
    }
    gemm256<false>(acc, u1b, 1024, m0, wt, 1024, n0, 1024, smem);
    if (n0 < HYC + QKVC) {
      ushort_t* qb = (ushort_t*)(p.ws + OFF_QKV) + (size_t)m0 * QKVC + (n0 - HYC);
      const unsigned lo = (unsigned)((wm * 128 + 4 * (lane >> 5)) * QKVC + wn * 64 + (lane & 31));
      const float* rtb = (const float*)(p.ws + OFF_ROPE) + (size_t)(m0 + wm * 128 + 4 * (lane >> 5)) * 16 + (lane & 7) * 2;
#pragma unroll
      for (int ni = 0; ni < 2; ++ni) {
        const int cq = n0 - HYC + wn * 64 + ni * 32 + (lane & 31);
        const bool rot = (ni == 0) && (cq < 1536) && ((cq & 63) < 16);
        const float qs = (cq < 768) ? 0.125f : 1.0f;
#pragma unroll
        for (int mi = 0; mi < 4; ++mi) {
#pragma unroll
          for (int r = 0; r < 16; ++r) {
            const int rr = mi * 32 + (r & 3) + 8 * (r >> 2);
            float v = acc[mi][ni][r];
            if (ni == 0) {
              const float o = __shfl_xor(v, 8);
              if (rot) {
                const float cs = rtb[rr * 16], sn = rtb[rr * 16 + 1];
                v = ((cq & 15) < 8) ? (v * cs - o * sn) : (v * cs + o * sn);
              }
            }
            (qb + rr * QKVC + ni * 32)[lo] = f2bf(v * qs);
          }
          asm volatile("" ::: "memory");
        }
      }
    } else {
      ushort_t* gb = (ushort_t*)(p.ws + OFF_GATE) + (size_t)m0 * GATEC + (n0 - HYC - QKVC);
      const unsigned lo = (unsigned)((wm * 128 + 4 * (lane >> 5)) * GATEC + wn * 64 + (lane & 31));
#pragma unroll
      for (int mi = 0; mi < 4; ++mi)
#pragma unroll
        for (int ni = 0; ni < 2; ++ni) {
#pragma unroll
          for (int r = 0; r < 16; ++r) (gb + (mi * 32 + (r & 3) + 8 * (r >> 2)) * GATEC + ni * 32)[lo] = f2bf(1.f / (1.f + __expf(-acc[mi][ni][r])));
          asm volatile("" ::: "memory");
        }
    }
  }
}

DI float sconv_t(const ushort_t* row, int t, float w0, float w1, float w2, float cb) {
  float v = cb + w1 * bf2f(row[t]);
  if (t > 0) v += w0 * bf2f(row[t - 1]);
  if (t < S_ - 1) v += w2 * bf2f(row[t + 1]);
  return v;
}
DI void fft_C_mul_invC(cf2* lds, const cf2* __restrict__ kq, int tid) {
  asm volatile("" : "+v"(tid));
  const int k1 = tid >> 5, k2 = tid & 31;
  kq += tid;
#pragma unroll
  for (int h = 0; h < 2; ++h) {
    float tr[16], ti[16];
    cf2 kv[16];
#pragma unroll
    for (int i = 0; i < 16; ++i) kv[i] = kq[(h * 16 + i) * 512];
    cf2* blk = lds + (k1 + 16 * h) * FFT_SA + k2 * 17;
#pragma unroll
    for (int mp = 0; mp < 16; ++mp) { cf2 v = blk[mp]; tr[mp] = v.x; ti[mp] = v.y; }
    dft_fwd<16, false>(tr, ti);
#pragma unroll
    for (int i = 0; i < 16; ++i) { const float a = tr[i], b = ti[i]; tr[i] = a * kv[i].x - b * kv[i].y; ti[i] = a * kv[i].y + b * kv[i].x; }
    dft_inv<16>(tr, ti);
#pragma unroll
    for (int mp = 0; mp < 16; ++mp) { cf2 o; o.x = tr[mp]; o.y = ti[mp]; blk[mp] = o; }
  }
}
DI void hyena_item(const P& p, char* smem, int c) {
  cf2* lds = (cf2*)smem;
  const ushort_t* pht = (const ushort_t*)(p.ws + OFF_PH);
  ushort_t* yht = (ushort_t*)(p.ws + OFF_YH);
  cf2* kq = (cf2*)(p.ws + (blockIdx.x < 92 ? OFF_WIN_T + (size_t)blockIdx.x * 131072 : OFF_HSCR + (size_t)(blockIdx.x - 92) * 131072));
  const float* filt = p.out;
  const int tid0 = tid_opaque();
  float zr[32], zi[32];
  __syncthreads();
#pragma unroll 1
  for (int o = 0; o < 2; ++o) {
    int tid = tid0; asm volatile("" : "+v"(tid));
    {
      float kr[32], ki[32];
      const float* fw = filt + (size_t)(0 * 1024 + o * 512 + c) * S_;
      const float* bw = filt + (size_t)(1 * 1024 + o * 512 + c) * S_;
      const float bias = p.hy_bias[o * 512 + c];
#pragma unroll
      for (int n1 = 0; n1 < 16; ++n1) { kr[n1] = fw[n1 * 512 + tid] * (1.0f / 16384.0f); ki[n1] = 0.f; }
      if (tid == 0) kr[0] += bias * (1.0f / 16384.0f);
#pragma unroll
      for (int n1 = 16; n1 < 32; ++n1) {
        const int n = n1 * 512 + tid;
        kr[n1] = (n == S_) ? 0.f : bw[2 * S_ - n] * (1.0f / 16384.0f); ki[n1] = 0.f;
      }
      fft_fwdA<false>(kr, ki, lds, tid); __syncthreads();
      fft_B_read(kr, ki, lds, tid); __syncthreads();
      fft_fwdB_write(kr, ki, lds, tid); __syncthreads();
      fft_fwdC(kr, ki, lds, tid);
      int ts = tid; asm volatile("" : "+v"(ts));
      cf2* kqt = kq + ts;
#pragma unroll
      for (int r = 0; r < 32; ++r) { cf2 v; v.x = kr[r]; v.y = ki[r]; kqt[r * 512] = v; }
      __syncthreads();
    }
    asm volatile("" : "+v"(tid));
    if (o == 0) {
      const float w0 = p.hy_conv_w[c], w1 = p.hy_conv_w[HYC + c], w2 = p.hy_conv_w[2 * HYC + c], cb = p.hy_conv_b[c];
      const ushort_t* r0 = pht + (size_t)(0 * HYC + c) * S_;
      const ushort_t* r1 = pht + (size_t)(1 * HYC + c) * S_;
#pragma unroll
      for (int n1 = 0; n1 < 16; ++n1) {
        const int t = n1 * 512 + tid;
        zr[n1] = sconv_t(r0, t, w0, w1, w2, cb); zi[n1] = sconv_t(r1, t, w0, w1, w2, cb);
        if (n1 & 1) asm volatile("" ::: "memory");
      }
    }
#pragma unroll
    for (int n1 = 16; n1 < 32; ++n1) { zr[n1] = 0.f; zi[n1] = 0.f; }
    fft_fwdA<true>(zr, zi, lds, tid); __syncthreads();
    fft_B_read(zr, zi, lds, tid); __syncthreads();
    fft_fwdB_write(zr, zi, lds, tid); __syncthreads();
    fft_C_mul_invC(lds, kq, tid); __syncthreads();
    fft_invB_read(zr, zi, lds, tid); __syncthreads();
    fft_invB_write(zr, zi, lds, tid); __syncthreads();
    fft_invA(zr, zi, lds, tid);
    int tg = tid; asm volatile("" : "+v"(tg));
    const int gch = (o + 1) * 512 + c;
    const float w0 = p.hy_conv_w[gch], w1 = p.hy_conv_w[HYC + gch], w2 = p.hy_conv_w[2 * HYC + gch], cb = p.hy_conv_b[gch];
    const ushort_t* g0 = pht + (size_t)(0 * HYC + gch) * S_;
    const ushort_t* g1 = pht + (size_t)(1 * HYC + gch) * S_;
#pragma unroll
    for (int n1 = 0; n1 < 16; ++n1) {
      const int t = n1 * 512 + tg;
      zr[n1] *= sconv_t(g0, t, w0, w1, w2, cb);
      zi[n1] *= sconv_t(g1, t, w0, w1, w2, cb);
      if (n1 & 1) asm volatile("" ::: "memory");
    }
    if (o == 1) {
#pragma unroll
      for (int n1 = 0; n1 < 16; ++n1) {
        const int t = n1 * 512 + tg;
        yht[(size_t)(0 * HW_ + c) * S_ + t] = f2bf(zr[n1]);
        yht[(size_t)(1 * HW_ + c) * S_ + t] = f2bf(zi[n1]);
      }
    }
  }
}

constexpr int ATT_VROW = 192;
constexpr int ATT_VBUF = 32 * ATT_VROW;
DI void attn_item(const P& p, char* smem, int item) {
  const ushort_t* qkv = (const ushort_t*)(p.ws + OFF_QKV);
  ushort_t* ya = (ushort_t*)(p.ws + OFF_YA);
  const int tid = tid_opaque(), lane = tid & 63, wave = tid >> 6;
  const int u = item * 8 + wave;
  const int hs = u & 3, r16 = (u >> 2) & 15, chunk = (u >> 6) & 15, b = u >> 10;
  const int qi = lane & 31, h = lane >> 5;
  char* vl = smem + wave * ATT_VBUF;
  const int tq = chunk * 512 + r16 + 16 * qi;
  const size_t bbase = (size_t)b * S_;
  f32x16 o0, o1;
#pragma unroll
  for (int r = 0; r < 16; ++r) { o0[r] = 0.f; o1[r] = 0.f; }
  float m = -1e30f, l = 0.f;
  const int g16 = (lane >> 4) & 1, q4 = (lane & 15) >> 2, p4 = lane & 3;
  __syncthreads();
#pragma unroll 1
  for (int g = 0; g < 3; ++g) {
    const int dsh = 2 * g;
    const int d = 1 << dsh, sd = 16 >> dsh, n = S_ >> dsh;
    const int head = g * 4 + hs;
    const int rc = r16 & (d - 1);
    const int P0 = (chunk * 512 + r16 - rc) >> dsh;
    const int pq = P0 + sd * qi;
    const int KB = P0 - 64;
    const int ntile = (g == 0) ? 20 : (g == 1 ? 8 : 5);
    bf16x8 bq[4];
    {
      const ushort_t* qrow = qkv + (bbase + tq) * QKVC + head * 64;
#pragma unroll
      for (int s = 0; s < 4; ++s) bq[s] = *(const bf16x8*)(qrow + (2 * s + h) * 8);
    }
    bf16x8 kn[4]; u32x4 vn[4];
    {
      const int kp = min(max(KB + qi, 0), n - 1);
      const ushort_t* krow = qkv + (bbase + rc + ((size_t)kp << dsh)) * QKVC + 768 + head * 64;
#pragma unroll
      for (int s = 0; s < 4; ++s) kn[s] = *(const bf16x8*)(krow + (2 * s + h) * 8);
#pragma unroll
      for (int i = 0; i < 4; ++i) {
        const int c = lane + 64 * i, row = c >> 3, ch = c & 7;
        const int vp = min(max(KB + row, 0), n - 1);
        vn[i] = *(const u32x4*)(qkv + (bbase + rc + ((size_t)vp << dsh)) * QKVC + 1536 + head * 64 + ch * 8);
      }
    }
#pragma unroll 1
    for (int kt = 0; kt < ntile; ++kt) {
      bf16x8 kc[4]; u32x4 vc[4];
#pragma unroll
      for (int s = 0; s < 4; ++s) kc[s] = kn[s];
#pragma unroll
      for (int i = 0; i < 4; ++i) vc[i] = vn[i];
      if (kt + 1 < ntile) {
        const int kb1 = KB + 32 * (kt + 1);
        const int kp = min(max(kb1 + qi, 0), n - 1);
        const ushort_t* krow = qkv + (bbase + rc + ((size_t)kp << dsh)) * QKVC + 768 + head * 64;
#pragma unroll
        for (int s = 0; s < 4; ++s) kn[s] = *(const bf16x8*)(krow + (2 * s + h) * 8);
#pragma unroll
        for (int i = 0; i < 4; ++i) {
          const int c = lane + 64 * i, row = c >> 3, ch = c & 7;
          const int vp = min(max(kb1 + row, 0), n - 1);
          vn[i] = *(const u32x4*)(qkv + (bbase + rc + ((size_t)vp << dsh)) * QKVC + 1536 + head * 64 + ch * 8);
        }
      }
      f32x16 st;
#pragma unroll
      for (int r = 0; r < 16; ++r) st[r] = 0.f;
#pragma unroll
      for (int s = 0; s < 4; ++s) st = __builtin_amdgcn_mfma_f32_32x32x16_bf16(kc[s], bq[s], st, 0, 0, 0);
#pragma unroll
      for (int i = 0; i < 4; ++i) { const int c = lane + 64 * i; *(u32x4*)(vl + (c >> 3) * ATT_VROW + (c & 7) * 16) = vc[i]; }
      const int kb = KB + 32 * kt + 4 * h;
      const int dk = kb - pq;
      float mx = -1e30f;
      bool ok[16];
#pragma unroll
      for (int r = 0; r < 16; ++r) {
        const int cr = (r & 3) + 8 * (r >> 2);
        ok[r] = ((unsigned)(dk + cr + 64) <= 128u) && ((unsigned)(kb + cr) < (unsigned)n);
        mx = fmaxf(mx, ok[r] ? st[r] : -1e30f);
      }
      mx = fmaxf(mx, __shfl_xor(mx, 32));
      const float mnew = fmaxf(m, mx);
      const float corr = __expf(m - mnew);
      float ps = 0.f;
      float pv[16];
#pragma unroll
      for (int r = 0; r < 16; ++r) { pv[r] = ok[r] ? __expf(st[r] - mnew) : 0.f; ps += pv[r]; }
      ps += __shfl_xor(ps, 32);
      l = l * corr + ps; m = mnew;
#pragma unroll
      for (int r = 0; r < 16; ++r) { o0[r] *= corr; o1[r] *= corr; }
      bf16x8 pf[2];
#pragma unroll
      for (int s = 0; s < 2; ++s) {
        u32x4 w;
        w[0] = pack2(pv[8 * s + 0], pv[8 * s + 1]); w[1] = pack2(pv[8 * s + 2], pv[8 * s + 3]);
        w[2] = pack2(pv[8 * s + 4], pv[8 * s + 5]); w[3] = pack2(pv[8 * s + 6], pv[8 * s + 7]);
        pf[s] = __builtin_bit_cast(bf16x8, w);
      }
      __builtin_amdgcn_wave_barrier();
      asm volatile("s_waitcnt lgkmcnt(0)" ::: "memory");
#pragma unroll
      for (int s = 0; s < 2; ++s) {
#pragma unroll
        for (int nt = 0; nt < 2; ++nt) {
          const char* a0 = vl + (16 * s + 4 * h + q4) * ATT_VROW + (32 * nt + 16 * g16 + 4 * p4) * 2;
          s16x4 lo = __builtin_amdgcn_ds_read_tr16_b64_v4i16((__attribute__((address_space(3))) s16x4*)(a0));
          s16x4 hi = __builtin_amdgcn_ds_read_tr16_b64_v4i16((__attribute__((address_space(3))) s16x4*)(a0 + 8 * ATT_VROW));
          const bf16x8 vf = __builtin_shufflevector(lo, hi, 0, 1, 2, 3, 4, 5, 6, 7);
          if (nt == 0) o0 = __builtin_amdgcn_mfma_f32_32x32x16_bf16(vf, pf[s], o0, 0, 0, 0);
          else o1 = __builtin_amdgcn_mfma_f32_32x32x16_bf16(vf, pf[s], o1, 0, 0, 0);
        }
      }
      __builtin_amdgcn_wave_barrier();
      asm volatile("s_waitcnt lgkmcnt(0)" ::: "memory");
    }
  }
  const float il = 1.f / l;
  ushort_t* op = ya + (bbase + tq) * 256 + hs * 64;
#pragma unroll
  for (int gq = 0; gq < 4; ++gq) {
    uint2 w0, w1;
    w0.x = pack2(o0[4 * gq] * il, o0[4 * gq + 1] * il); w0.y = pack2(o0[4 * gq + 2] * il, o0[4 * gq + 3] * il);
    w1.x = pack2(o1[4 * gq] * il, o1[4 * gq + 1] * il); w1.y = pack2(o1[4 * gq + 2] * il, o1[4 * gq + 3] * il);
    *(uint2*)(op + 8 * gq + 4 * h) = w0;
    *(uint2*)(op + 32 + 8 * gq + 4 * h) = w1;
  }
}

DI void phase_merge(const P& p, char* smem) {
  const ushort_t* yh = (const ushort_t*)(p.ws + OFF_YH);
  const ushort_t* ya = (const ushort_t*)(p.ws + OFF_YA);
  const ushort_t* gate = (const ushort_t*)(p.ws + OFF_GATE);
  ushort_t* merged = (ushort_t*)(p.ws + OFF_MERGED);
  constexpr int NTN = 1024 / 256, NTM = T_ / 256;
  for (int tile = blockIdx.x; tile < NTM * NTN; tile += gridDim.x) {
    const int tid = tid_opaque(), wave = tid >> 6, wm = wave >> 2, wn = wave & 3;
    int lane = tid & 63;
    const int m0 = (tile / NTN) * 256, n0 = (tile % NTN) * 256;
    f32x16 a1[4][2]; acc_zero4(a1);
    gemm256_AT(a1, yh + (size_t)((m0 / S_) * HW_) * S_ + (m0 & (S_ - 1)), (size_t)S_, (const ushort_t*)(p.ws + OFF_WBH_T), 512, n0, 512, smem);
    const ushort_t* gbh = gate + (size_t)m0 * GATEC + n0;
    ushort_t* mb = merged + (size_t)m0 * 1024 + n0;
    {
      const unsigned lg = (unsigned)((wm * 128 + 4 * (lane >> 5)) * GATEC + wn * 64 + (lane & 31));
      const unsigned lm = (unsigned)((wm * 128 + 4 * (lane >> 5)) * 1024 + wn * 64 + (lane & 31));
#pragma unroll
      for (int mi = 0; mi < 4; ++mi)
#pragma unroll
        for (int ni = 0; ni < 2; ++ni) {
#pragma unroll
          for (int r = 0; r < 16; ++r) {
            const int rr = mi * 32 + (r & 3) + 8 * (r >> 2);
            (mb + rr * 1024 + ni * 32)[lm] = f2bf(bf2f((gbh + rr * GATEC + ni * 32)[lg]) * a1[mi][ni][r]);
          }
          asm volatile("" ::: "memory");
        }
    }
    acc_zero4(a1);
    gemm256<false>(a1, ya, 256, m0, (const ushort_t*)(p.ws + OFF_WBA_T), 256, n0, 256, smem);
    asm volatile("" : "+v"(lane));
    {
      const unsigned lg = (unsigned)((wm * 128 + 4 * (lane >> 5)) * GATEC + wn * 64 + (lane & 31));
      const unsigned lm = (unsigned)((wm * 128 + 4 * (lane >> 5)) * 1024 + wn * 64 + (lane & 31));
#pragma unroll
      for (int mi = 0; mi < 4; ++mi)
#pragma unroll
        for (int ni = 0; ni < 2; ++ni) {
#pragma unroll
          for (int r = 0; r < 16; ++r) {
            const int rr = mi * 32 + (r & 3) + 8 * (r >> 2);
            ushort_t* mp = mb + rr * 1024 + ni * 32;
            mp[lm] = f2bf(bf2f(mp[lm]) + bf2f((gbh + 1024 + rr * GATEC + ni * 32)[lg]) * a1[mi][ni][r]);
          }
          asm volatile("" ::: "memory");
        }
    }
  }
}

DI void phase_outproj(const P& p, char* smem) {
  const float* ada = (const float*)(p.ws + OFF_ADA);
  const ushort_t* merged = (const ushort_t*)(p.ws + OFF_MERGED);
  constexpr int NTN = 1024 / 256, NTM = T_ / 256;
  for (int tile = blockIdx.x; tile < NTM * NTN; tile += gridDim.x) {
    const int tid = tid_opaque(), lane = tid & 63, wave = tid >> 6, wm = wave >> 2, wn = wave & 3;
    const int m0 = (tile / NTN) * 256, n0 = (tile % NTN) * 256, b = m0 / S_;
    f32x16 acc[4][2]; acc_zero4(acc);
    gemm256<false>(acc, merged, 1024, m0, (const ushort_t*)(p.ws + OFF_WOUT_T), 1024, n0, 1024, smem);
    const float* xb = p.x + (size_t)m0 * 1024 + n0;
    float* ob = p.out + (size_t)m0 * 1024 + n0;
    const unsigned lo = (unsigned)((wm * 128 + 4 * (lane >> 5)) * 1024 + wn * 64 + (lane & 31));
#pragma unroll
    for (int ni = 0; ni < 2; ++ni) {
      const float g1 = 1.f + ada[b * 6144 + 2 * 1024 + n0 + wn * 64 + ni * 32 + (lane & 31)];
#pragma unroll
      for (int mi = 0; mi < 4; ++mi) {
#pragma unroll
        for (int r = 0; r < 16; ++r) {
          const int rr = mi * 32 + (r & 3) + 8 * (r >> 2);
          (ob + rr * 1024 + ni * 32)[lo] = DN_ALPHA * (xb + rr * 1024 + ni * 32)[lo] + g1 * acc[mi][ni][r];
          if ((r & 3) == 3) asm volatile("" ::: "memory");
        }
      }
    }
  }
}

DI void phase_ln(float* __restrict__ xio, const float* __restrict__ g, const float* __restrict__ bta) {
  const int tq = tid_opaque(); const int lane = tq & 63, wave = tq >> 6;
  for (int row = blockIdx.x * 8 + wave; row < T_; row += gridDim.x * 8) {
    float* rp = xio + (size_t)row * 1024;
    f32x4 v[4];
    float s = 0.f;
#pragma unroll
    for (int i = 0; i < 4; ++i) { v[i] = *(const f32x4*)(rp + i * 256 + lane * 4); s += v[i][0] + v[i][1] + v[i][2] + v[i][3]; }
    const float mu = wave_sum(s) * (1.f / 1024.f);
    float q = 0.f;
#pragma unroll
    for (int i = 0; i < 4; ++i)
#pragma unroll
      for (int j = 0; j < 4; ++j) { float d = v[i][j] - mu; q += d * d; }
    const float rs = rsqrtf(wave_sum(q) * (1.f / 1024.f) + LN_EPS);
#pragma unroll
    for (int i = 0; i < 4; ++i) {
      f32x4 gg = *(const f32x4*)(g + i * 256 + lane * 4), bb = *(const f32x4*)(bta + i * 256 + lane * 4), o;
#pragma unroll
      for (int j = 0; j < 4; ++j) o[j] = (v[i][j] - mu) * rs * gg[j] + bb[j];
      *(f32x4*)(rp + i * 256 + lane * 4) = o;
    }
  }
}

DI int swz256(int row, int ch) { return row * 256 + ((ch ^ (row & 15)) << 4); }
DI void ins16(float (&L)[16], float x) {
#pragma unroll
  for (int i = 0; i < 16; ++i) { const float hi = __builtin_fmaxf(L[i], x); x = __builtin_fminf(L[i], x); L[i] = hi; }
}
DI void bitonic16_desc(float (&M)[16]) {
#pragma unroll
  for (int d = 8; d >= 1; d >>= 1)
#pragma unroll
    for (int i = 0; i < 16; ++i)
      if ((i & d) == 0) { const float a = M[i], b = M[i + d]; M[i] = __builtin_fmaxf(a, b); M[i + d] = __builtin_fminf(a, b); }
}
constexpr int ROUTE_Q_OFF = 0, ROUTE_K_OFF = 65536, ROUTE_IDX_OFF = 106496;
DI void phase_route(const P& p, char* smem) {
  const float* ada = (const float*)(p.ws + OFF_ADA);
  float* mod = (float*)(smem + 2 * LDS_STAGE);
  const ushort_t* keysb = (const ushort_t*)(p.ws + OFF_KEYS_B);
  int* idx = (int*)(p.ws + OFF_IDX);
  float* gv = (float*)(p.ws + OFF_GV);
  for (int item = blockIdx.x; item < (T_ / BM) * 8; item += gridDim.x) {
    const int tid = tid_opaque(), lane = tid & 63, wave = tid >> 6, wm = wave >> 1, wn = wave & 1;
    const int m0 = (item >> 3) * BM, hh = item & 7;
    float L0[16];
#pragma unroll 1
    for (int pp = 0; pp < 2; ++pp) {
      const int hp = hh * 2 + pp;
      f32x16 acc[2][2]; acc_zero(acc);
      ALoadBf16 al{(const ushort_t*)(p.ws + OFF_U2B), 1024};
      gemm_mainloop<ALoadBf16, true>(acc, al, m0, (const ushort_t*)(p.ws + OFF_WQ_T), 1024, hp * 128, 1024, smem);
#pragma unroll
      for (int mi = 0; mi < 2; ++mi) {
        const int tok = wm * 64 + mi * 32 + (lane & 31);
#pragma unroll
        for (int ni = 0; ni < 2; ++ni)
#pragma unroll
          for (int g = 0; g < 4; ++g) {
            const int ch = wn * 8 + ni * 4 + g;
            uint2 v; v.x = pack2(acc[mi][ni][4 * g], acc[mi][ni][4 * g + 1]); v.y = pack2(acc[mi][ni][4 * g + 2], acc[mi][ni][4 * g + 3]);
            *(uint2*)(smem + ROUTE_Q_OFF + swz256(tok, ch) + 8 * (lane >> 5)) = v;
          }
      }
#pragma unroll
      for (int i = 0; i < 4; ++i) {
        const int q = tid + 512 * i, row = q >> 4, ch = q & 15;
        *(u32x4*)(smem + ROUTE_K_OFF + swz256(row, ch)) = *(const u32x4*)(keysb + (size_t)hp * 16384 + row * 128 + ch * 8);
      }
      __syncthreads();
      f32x16 sc[4];
#pragma unroll
      for (int ks = 0; ks < 4; ++ks)
#pragma unroll
        for (int r = 0; r < 16; ++r) sc[ks][r] = 0.f;
#pragma unroll
      for (int s = 0; s < 8; ++s) {
        const int ch = 2 * s + (lane >> 5);
        const bf16x8 bq = *(const bf16x8*)(smem + ROUTE_Q_OFF + swz256(wave * 32 + (lane & 31), ch));
#pragma unroll
        for (int ks = 0; ks < 4; ++ks) {
          const bf16x8 ak = *(const bf16x8*)(smem + ROUTE_K_OFF + swz256(ks * 32 + (lane & 31), ch));
          sc[ks] = __builtin_amdgcn_mfma_f32_32x32x16_bf16(ak, bq, sc[ks], 0, 0, 0);
        }
      }
      float L[16];
#pragma unroll
      for (int i = 0; i < 16; ++i) L[i] = -3.0e38f;
      const unsigned hbit = (unsigned)(lane >> 5) << 2;
#pragma unroll
      for (int ks = 0; ks < 4; ++ks)
#pragma unroll
        for (int r = 0; r < 16; ++r) {
          const unsigned key = (unsigned)(ks * 32 + (r & 3) + 8 * (r >> 2)) | hbit;
          ins16(L, __uint_as_float((__float_as_uint(sc[ks][r]) & ~127u) | key));
        }
      {
        float M[16];
#pragma unroll
        for (int i = 0; i < 16; ++i) M[i] = __builtin_fmaxf(L[i], __shfl_xor(L[15 - i], 32));
        bitonic16_desc(M);
#pragma unroll
        for (int i = 0; i < 16; ++i) L[i] = M[i];
      }
      if (pp == 0) {
#pragma unroll
        for (int i = 0; i < 16; ++i) L0[i] = L[i];
      } else {
        unsigned char* ib = (unsigned char*)(smem + ROUTE_IDX_OFF) + tid * 32;
#pragma unroll
        for (int i = 0; i < 16; ++i) { ib[i] = (unsigned char)(__float_as_uint(L0[i]) & 127u); ib[16 + i] = (unsigned char)(__float_as_uint(L[i]) & 127u); }
        float F[16];
#pragma unroll
        for (int i = 0; i < 16; ++i) F[i] = -3.0e38f;
#pragma unroll
        for (int i = 0; i < 16; ++i) {
          const float ai = __uint_as_float(__float_as_uint(L0[i]) & ~127u);
#pragma unroll
          for (int j = 0; j < 16; ++j)
            if ((i + 1) * (j + 1) <= 16) {
              const float s = ai + __uint_as_float(__float_as_uint(L[j]) & ~127u);
              ins16(F, __uint_as_float((__float_as_uint(s) & ~255u) | (unsigned)(i * 16 + j)));
            }
        }
        const float mx = __uint_as_float(__float_as_uint(F[0]) & ~255u);
        float e[16], sum = 0.f;
#pragma unroll
        for (int k = 0; k < 16; ++k) { e[k] = __expf(__uint_as_float(__float_as_uint(F[k]) & ~255u) - mx); sum += e[k]; }
        const float inv = 1.f / sum;
        if (lane < 32) {
          const int tok = m0 + wave * 32 + lane;
          int* ip = idx + (size_t)tok * 128 + hh * 16;
          float* gp = gv + (size_t)tok * 128 + hh * 16;
#pragma unroll
          for (int k4 = 0; k4 < 4; ++k4) {
            int4 iv; f32x4 g4;
            int ee[4];
#pragma unroll
            for (int u = 0; u < 4; ++u) {
              const unsigned code = __float_as_uint(F[k4 * 4 + u]) & 255u;
              ee[u] = (int)ib[code >> 4] * 128 + (int)ib[16 + (code & 15u)];
              g4[u] = e[k4 * 4 + u] * inv;
            }
            iv.x = ee[0]; iv.y = ee[1]; iv.z = ee[2]; iv.w = ee[3];
            *(int4*)(ip + k4 * 4) = iv;
            *(f32x4*)(gp + k4 * 4) = g4;
          }
        }
      }
    }
  }
}

DI void phase_rope(const P& p) {
  float* rt = (float*)(p.ws + OFF_ROPE);
  for (int i = blockIdx.x * NT + tid_opaque(); i < T_ * 8; i += gridDim.x * NT) {
    const float inv = expf(-13.122363377404328f * (float)(i & 7) * 0.125f);
    float sn, cs; sincosf((float)p.pos[i >> 3] * inv, &sn, &cs);
    rt[2 * i] = cs; rt[2 * i + 1] = sn;
  }
}
DI void phase_keys(const P& p) {
  ushort_t* keysb = (ushort_t*)(p.ws + OFF_KEYS_B);
  for (int i = blockIdx.x * NT + tid_opaque(); i < 16 * 128 * 128 / 4; i += gridDim.x * NT) {
    f32x4 v = *(const f32x4*)(p.keys + (size_t)i * 4);
    uint2 o; o.x = pack2(v[0], v[1]); o.y = pack2(v[2], v[3]);
    *(uint2*)(keysb + (size_t)i * 4) = o;
  }
}

typedef __bf16 bf16x2_t __attribute__((ext_vector_type(2)));
DI float dot2bf(unsigned a, unsigned b, float c) { return __builtin_amdgcn_fdot2_f32_bf16(__builtin_bit_cast(bf16x2_t, a), __builtin_bit_cast(bf16x2_t, b), c, false); }
DI void phase_ln1(const P& p) {
  const float* ada = (const float*)(p.ws + OFF_ADA);
  ushort_t* u2b = (ushort_t*)(p.ws + OFF_U2B);
  const int tq = tid_opaque(); const int lane = tq & 63, wave = tq >> 6;
  for (int row = blockIdx.x * 8 + wave; row < T_; row += gridDim.x * 8) {
    const int b = row / S_;
    float* rp = p.out + (size_t)row * 1024;
    f32x4 v[4];
    float s = 0.f;
#pragma unroll
    for (int i = 0; i < 4; ++i) { v[i] = *(const f32x4*)(rp + i * 256 + lane * 4); s += v[i][0] + v[i][1] + v[i][2] + v[i][3]; }
    const float mu = wave_sum(s) * (1.f / 1024.f);
    float q = 0.f;
#pragma unroll
    for (int i = 0; i < 4; ++i)
#pragma unroll
      for (int j = 0; j < 4; ++j) { float d = v[i][j] - mu; q += d * d; }
    const float rs = rsqrtf(wave_sum(q) * (1.f / 1024.f) + LN_EPS);
#pragma unroll
    for (int i = 0; i < 4; ++i) {
      const int col = i * 256 + lane * 4;
      f32x4 gg = *(const f32x4*)(p.ln1_g + col), bb = *(const f32x4*)(p.ln1_b + col), o;
      f32x4 sc = *(const f32x4*)(ada + b * 6144 + 4 * 1024 + col), sh = *(const f32x4*)(ada + b * 6144 + 3 * 1024 + col);
#pragma unroll
      for (int j = 0; j < 4; ++j) o[j] = (v[i][j] - mu) * rs * gg[j] + bb[j];
      *(f32x4*)(rp + col) = o;
      uint2 w; w.x = pack2(o[0] * (1.f + sc[0]) + sh[0], o[1] * (1.f + sc[1]) + sh[1]); w.y = pack2(o[2] * (1.f + sc[2]) + sh[2], o[3] * (1.f + sc[3]) + sh[3]);
      *(uint2*)(u2b + (size_t)row * 1024 + col) = w;
    }
  }
}
DI float wave_max(float v) {
#pragma unroll
  for (int o = 32; o > 0; o >>= 1) v = fmaxf(v, __shfl_xor(v, o));
  return v;
}
DI unsigned pack4_fp8(float a, float b, float c, float d) {
  int w = 0;
  w = __builtin_amdgcn_cvt_pk_fp8_f32(a, b, w, false);
  w = __builtin_amdgcn_cvt_pk_fp8_f32(c, d, w, true);
  return (unsigned)w;
}
DI void phase_tabconv(const P& p) {
  unsigned char* tu = (unsigned char*)(p.ws + OFF_TABU);
  unsigned char* tv = (unsigned char*)(p.ws + OFF_TABV);
  float* su = (float*)(p.ws + OFF_SU);
  float* sv = (float*)(p.ws + OFF_SV);
  const int tq = tid_opaque(); const int lane = tq & 63, wave = tq >> 6;
  for (int e = blockIdx.x * 8 + wave; e < 16384; e += gridDim.x * 8) {
    f32x4 a[4], c[4];
    float ma = 0.f, mc = 0.f;
#pragma unroll
    for (int i = 0; i < 4; ++i) {
      const int col = i * 256 + lane * 4;
      a[i] = *(const f32x4*)(p.pu + (size_t)e * 1024 + col);
      c[i] = *(const f32x4*)(p.pv + (size_t)e * 1024 + col);
#pragma unroll
      for (int j = 0; j < 4; ++j) { ma = fmaxf(ma, fabsf(a[i][j])); mc = fmaxf(mc, fabsf(c[i][j])); }
    }
    ma = wave_max(ma); mc = wave_max(mc);
    const float sa = (ma > 0.f) ? ma * (1.0f / 448.0f) : 1.0f, sc = (mc > 0.f) ? mc * (1.0f / 448.0f) : 1.0f;
    const float ia = 1.0f / sa, ic = 1.0f / sc;
    if (lane == 0) { su[e] = sa; sv[e] = sc; }
#pragma unroll
    for (int i = 0; i < 4; ++i) {
      const int col = i * 256 + lane * 4;
      *(unsigned*)(tu + (size_t)e * 1024 + col) = pack4_fp8(a[i][0] * ia, a[i][1] * ia, a[i][2] * ia, a[i][3] * ia);
      const int slice = i * 2 + (lane >> 5);
      *(unsigned*)(tv + ((size_t)slice * 16384 + e) * 128 + (lane & 31) * 4) = pack4_fp8(c[i][0] * ic, c[i][1] * ic, c[i][2] * ic, c[i][3] * ic);
    }
  }
}

template <int CTRL> DI float dpp_f(float v) { return __int_as_float(__builtin_amdgcn_mov_dpp(__float_as_int(v), CTRL, 0xf, 0xf, false)); }
template <int CTRL> DI int dpp_shr0(int v) { return __builtin_amdgcn_update_dpp(0, v, CTRL, 0xf, 0xf, true); }
template <int I> DI int bcast16(int v) { return __builtin_amdgcn_mov_dpp(v, 0x150 + I, 0xf, 0xf, false); }
DI float row_sum16(float d) {
  d += dpp_f<0xB1>(d);
  d += dpp_f<0x4E>(d);
  d += dpp_f<0x141>(d);
  d += dpp_f<0x140>(d);
  return d;
}
typedef __bf16 bf16x2_c __attribute__((ext_vector_type(2)));
DI float dot4_fp8(unsigned w8, unsigned xlo, unsigned xhi, float acc) {
  const bf16x2_c lo = __builtin_amdgcn_cvt_scalef32_pk_bf16_fp8((int)w8, 1.0f, false);
  const bf16x2_c hi = __builtin_amdgcn_cvt_scalef32_pk_bf16_fp8((int)w8, 1.0f, true);
  acc = __builtin_amdgcn_fdot2_f32_bf16(lo, __builtin_bit_cast(bf16x2_c, xlo), acc, false);
  return __builtin_amdgcn_fdot2_f32_bf16(hi, __builtin_bit_cast(bf16x2_c, xhi), acc, false);
}
DI void phase_upass(const P& p, char* smem) {
  const int* idx = (const int*)(p.ws + OFF_IDX);
  const float* gv = (const float*)(p.ws + OFF_GV);
  const ushort_t* u2b = (const ushort_t*)(p.ws + OFF_U2B);
  const char* tabu = (const char*)(p.ws + OFF_TABU);
  const float* su = (const float*)(p.ws + OFF_SU);
  const float* sv = (const float*)(p.ws + OFF_SV);
  float* coef = (float*)(p.ws + OFF_COEF);
  const int tq = tid_opaque(); const int lane = tq & 63, wave = tq >> 6;
  const int g = lane >> 4, j = lane & 15;
  int4* lst = (int4*)smem + wave * 512 + g * 128;
  const int part = blockIdx.x & 7, bi = blockIdx.x >> 3, nb = (gridDim.x - part + 7) >> 3;
  __syncthreads();
#pragma unroll 1
  for (int tb = (bi * 8 + wave) * 4; tb < T_; tb += nb * 32) {
    const int tok = tb + g;
    const int4 i0 = *(const int4*)(idx + (size_t)tb * 128 + lane * 8), i1 = *(const int4*)(idx + (size_t)tb * 128 + lane * 8 + 4);
    const f32x4 g0 = *(const f32x4*)(gv + (size_t)tb * 128 + lane * 8), g1 = *(const f32x4*)(gv + (size_t)tb * 128 + lane * 8 + 4);
    u32x4 xr[8];
#pragma unroll
    for (int c = 0; c < 4; ++c) {
      xr[2 * c] = *(const u32x4*)(u2b + (size_t)tok * 1024 + (j + 16 * c) * 16);
      xr[2 * c + 1] = *(const u32x4*)(u2b + (size_t)tok * 1024 + (j + 16 * c) * 16 + 8);
    }
    const int ev[8] = {i0.x, i0.y, i0.z, i0.w, i1.x, i1.y, i1.z, i1.w};
    const float gg[8] = {g0[0], g0[1], g0[2], g0[3], g1[0], g1[1], g1[2], g1[3]};
    int cnt = 0;
#pragma unroll
    for (int i = 0; i < 8; ++i) cnt += ((ev[i] >> 11) == part) ? 1 : 0;
    int incl = cnt;
    incl += dpp_shr0<0x111>(incl); incl += dpp_shr0<0x112>(incl); incl += dpp_shr0<0x114>(incl); incl += dpp_shr0<0x118>(incl);
    const int ng = bcast16<15>(incl);
    int pos = incl - cnt;
#pragma unroll
    for (int i = 0; i < 8; ++i)
      if ((ev[i] >> 11) == part) { int4 en; en.x = ev[i]; en.y = __float_as_int(gg[i]); en.z = j * 8 + i; en.w = 0; lst[pos] = en; ++pos; }
    const int nmax = max(max(__builtin_amdgcn_readlane(ng, 0), __builtin_amdgcn_readlane(ng, 16)), max(__builtin_amdgcn_readlane(ng, 32), __builtin_amdgcn_readlane(ng, 48)));
    __builtin_amdgcn_wave_barrier();
    asm volatile("s_waitcnt lgkmcnt(0)" ::: "memory");
    u32x4 ra[4];
    {
      const unsigned e = (ng > 0) ? (unsigned)lst[0].x : 0u;
      const char* row = tabu + (size_t)e * 1024 + j * 16;
#pragma unroll
      for (int c = 0; c < 4; ++c) ra[c] = *(const u32x4*)(row + c * 256);
    }
#pragma unroll 1
    for (int it = 0; it < nmax; ++it) {
      u32x4 rn[4];
      {
        const unsigned e = (it + 1 < ng) ? (unsigned)lst[it + 1].x : 0u;
        const char* row = tabu + (size_t)e * 1024 + j * 16;
#pragma unroll
        for (int c = 0; c < 4; ++c) rn[c] = *(const u32x4*)(row + c * 256);
      }
      float a0 = 0.f, a1 = 0.f, a2 = 0.f, a3 = 0.f;
#pragma unroll
      for (int c = 0; c < 4; ++c) {
        a0 = dot4_fp8(ra[c][0], xr[2 * c][0], xr[2 * c][1], a0);
        a1 = dot4_fp8(ra[c][1], xr[2 * c][2], xr[2 * c][3], a1);
        a2 = dot4_fp8(ra[c][2], xr[2 * c + 1][0], xr[2 * c + 1][1], a2);
        a3 = dot4_fp8(ra[c][3], xr[2 * c + 1][2], xr[2 * c + 1][3], a3);
      }
      const float d = row_sum16((a0 + a1) + (a2 + a3));
      if (j == 0 && it < ng) ((int*)&lst[it])[3] = __float_as_int(d);
#pragma unroll
      for (int c = 0; c < 4; ++c) ra[c] = rn[c];
    }
    __builtin_amdgcn_wave_barrier();
    asm volatile("s_waitcnt lgkmcnt(0)" ::: "memory");
#pragma unroll 1
    for (int k = 0; k < nmax; k += 16) {
      if (k + j < ng) {
        const int4 en = lst[k + j];
        const float a = __int_as_float(en.w) * su[en.x];
        coef[(size_t)tok * 128 + en.z] = __int_as_float(en.y) * 0.5f * a * (1.f + erff(a * 0.7071067811865475f)) * sv[en.x];
      }
    }
    __builtin_amdgcn_wave_barrier();
    asm volatile("s_waitcnt lgkmcnt(0)" ::: "memory");
  }
}

struct VHdr { int ea, eb, ca, cb; };
DI VHdr vp_hdr(const int* idx, const float* coef, int tok, int g, int cq) {
  VHdr h;
  h.ea = idx[(size_t)tok * 128 + g * 32 + cq]; h.eb = idx[(size_t)tok * 128 + g * 32 + 16 + cq];
  h.ca = __float_as_int(coef[(size_t)tok * 128 + g * 32 + cq]); h.cb = __float_as_int(coef[(size_t)tok * 128 + g * 32 + 16 + cq]);
  return h;
}
DI void vp_rows(uint2 (&va)[16], uint2 (&vb)[16], const VHdr& h, const char* tb) {
#define VP_STEP(I) { va[I] = *(const uint2*)(tb + (unsigned)bcast16<I>(h.ea) * 128u); vb[I] = *(const uint2*)(tb + (unsigned)bcast16<I>(h.eb) * 128u); }
  VP_STEP(0) VP_STEP(1) VP_STEP(2) VP_STEP(3) VP_STEP(4) VP_STEP(5) VP_STEP(6) VP_STEP(7)
  VP_STEP(8) VP_STEP(9) VP_STEP(10) VP_STEP(11) VP_STEP(12) VP_STEP(13) VP_STEP(14) VP_STEP(15)
#undef VP_STEP
}
DI void vp_coefs(float (&fa)[16], float (&fb)[16], const VHdr& h) {
#define VP_STEP(I) { fa[I] = __int_as_float(bcast16<I>(h.ca)); fb[I] = __int_as_float(bcast16<I>(h.cb)); }
  VP_STEP(0) VP_STEP(1) VP_STEP(2) VP_STEP(3) VP_STEP(4) VP_STEP(5) VP_STEP(6) VP_STEP(7)
  VP_STEP(8) VP_STEP(9) VP_STEP(10) VP_STEP(11) VP_STEP(12) VP_STEP(13) VP_STEP(14) VP_STEP(15)
#undef VP_STEP
}
DI void vp_fma8(float (&a)[8], float cf, const uint2& v) {
  const f32x2_hw p0 = __builtin_amdgcn_cvt_pk_f32_fp8((int)v.x, false), p1 = __builtin_amdgcn_cvt_pk_f32_fp8((int)v.x, true);
  const f32x2_hw p2 = __builtin_amdgcn_cvt_pk_f32_fp8((int)v.y, false), p3 = __builtin_amdgcn_cvt_pk_f32_fp8((int)v.y, true);
  a[0] += cf * p0[0]; a[1] += cf * p0[1]; a[2] += cf * p1[0]; a[3] += cf * p1[1];
  a[4] += cf * p2[0]; a[5] += cf * p2[1]; a[6] += cf * p3[0]; a[7] += cf * p3[1];
}
DI void phase_vpass(const P& p) {
  const int* idx = (const int*)(p.ws + OFF_IDX);
  const float* coef = (const float*)(p.ws + OFF_COEF);
  const char* tabv = (const char*)(p.ws + OFF_TABV);
  float* f = (float*)(p.ws + OFF_F);
  const int tq = tid_opaque(); const int lane = tq & 63, wave = tq >> 6;
  const int g = lane >> 4, cq = lane & 15;
  const int slice = blockIdx.x & 7, bi = blockIdx.x >> 3, nb = (gridDim.x - slice + 7) >> 3;
  const int step = nb * 8;
  const char* tb = tabv + (size_t)slice * (16384 * 128) + cq * 8;
  int tok = bi * 8 + wave;
  if (tok >= T_) return;
  VHdr hc = vp_hdr(idx, coef, tok, g, cq);
  VHdr hn = vp_hdr(idx, coef, min(tok + step, T_ - 1), g, cq);
  uint2 va[16], vb[16];
  vp_rows(va, vb, hc, tb);
#pragma unroll 1
  for (; tok < T_; tok += step) {
    const VHdr hnn = vp_hdr(idx, coef, min(tok + 2 * step, T_ - 1), g, cq);
    uint2 na[16], nb2[16];
    vp_rows(na, nb2, hn, tb);
    float fa[16], fb[16];
    vp_coefs(fa, fb, hc);
    float a[8];
#pragma unroll
    for (int i = 0; i < 8; ++i) a[i] = 0.f;
#pragma unroll
    for (int i = 0; i < 16; ++i) { vp_fma8(a, fa[i], va[i]); vp_fma8(a, fb[i], vb[i]); }
#pragma unroll
    for (int i = 0; i < 8; ++i) { a[i] += __shfl_xor(a[i], 16); a[i] += __shfl_xor(a[i], 32); }
    if (g == 0) {
      f32x4 o0, o1; o0[0] = a[0]; o0[1] = a[1]; o0[2] = a[2]; o0[3] = a[3]; o1[0] = a[4]; o1[1] = a[5]; o1[2] = a[6]; o1[3] = a[7];
      float* fp = f + (size_t)tok * 1024 + slice * 128 + cq * 8;
      *(f32x4*)fp = o0; *(f32x4*)(fp + 4) = o1;
    }
#pragma unroll
    for (int i = 0; i < 16; ++i) { va[i] = na[i]; vb[i] = nb2[i]; }
    hc = hn; hn = hnn;
  }
}

DI void phase_ln2(const P& p) {
  const float* ada = (const float*)(p.ws + OFF_ADA);
  const float* f = (const float*)(p.ws + OFF_F);
  const int tq = tid_opaque(); const int lane = tq & 63, wave = tq >> 6;
  for (int tok = blockIdx.x * 8 + wave; tok < T_; tok += gridDim.x * 8) {
    const int b = tok / S_;
    float* rp = p.out + (size_t)tok * 1024;
    f32x4 acc[4];
    float sm = 0.f;
#pragma unroll
    for (int i = 0; i < 4; ++i) {
      const int col = i * 256 + lane * 4;
      f32x4 x1 = *(const f32x4*)(rp + col), ff = *(const f32x4*)(f + (size_t)tok * 1024 + col);
      f32x4 g2 = *(const f32x4*)(ada + b * 6144 + 5 * 1024 + col);
#pragma unroll
      for (int j = 0; j < 4; ++j) { acc[i][j] = DN_ALPHA * x1[j] + (1.f + g2[j]) * ff[j]; sm += acc[i][j]; }
    }
    const float mu = wave_sum(sm) * (1.f / 1024.f);
    float q = 0.f;
#pragma unroll
    for (int i = 0; i < 4; ++i)
#pragma unroll
      for (int j = 0; j < 4; ++j) { float d = acc[i][j] - mu; q += d * d; }
    const float rs = rsqrtf(wave_sum(q) * (1.f / 1024.f) + LN_EPS);
#pragma unroll
    for (int i = 0; i < 4; ++i) {
      const int col = i * 256 + lane * 4;
      f32x4 gg = *(const f32x4*)(p.ln2_g + col), bb = *(const f32x4*)(p.ln2_b + col), o;
#pragma unroll
      for (int j = 0; j < 4; ++j) o[j] = (acc[i][j] - mu) * rs * gg[j] + bb[j];
      *(f32x4*)(rp + col) = o;
    }
  }
}

#define XB_TMO      128
#define XB_XCNT(j)  (256  + 64 * (j))
#define XB_XSUB(j)  (1280 + 64 * (j))
#define XB_XGEN(j)  (2304 + 64 * (j))
#define XB_TOP      3328
#define XB_TOPGEN   3392
#define XCD_BAR_WORDS 3456
#define XB_SPIN_CAP (1u << 22)
#define LAS __attribute__((address_space(3)))
DI unsigned xb_ld(unsigned* p)              { return __hip_atomic_load(p, __ATOMIC_RELAXED, __HIP_MEMORY_SCOPE_AGENT); }
DI unsigned xb_add(unsigned* p, unsigned v) { return __hip_atomic_fetch_add(p, v, __ATOMIC_RELAXED, __HIP_MEMORY_SCOPE_AGENT); }
DI unsigned xb_xcc_id() { return (unsigned)__builtin_amdgcn_s_getreg((3 << 11) | 20) & 0xFu; }
#define XB_SPIN(cond, bar) do { unsigned _sp = 0; while (cond) { __builtin_amdgcn_s_sleep(1); \
    if ((++_sp & 255u) == 0u) { if (xb_ld(&(bar)[XB_TMO])) break; if (_sp > XB_SPIN_CAP) { atomicAdd(&(bar)[XB_TMO], 1u); break; } } } } while (0)
struct XcdBarrier { unsigned* bar; unsigned x; volatile LAS unsigned* st; };
DI XcdBarrier xcd_barrier_post(unsigned* bar, volatile LAS unsigned* st) {
  XcdBarrier b; b.bar = bar; b.x = xb_xcc_id(); b.st = st;
  if (threadIdx.x == 0) (void)xb_add(&bar[XB_XCNT(b.x)], 1u);
  return b;
}
DI void xcd_barrier_complete(unsigned* bar, unsigned x, unsigned& nloc, unsigned& nx) {
  const unsigned G = gridDim.x * gridDim.y * gridDim.z;
  unsigned sum, cnt, mine, sp = 0u;
  for (;;) {
    sum = 0u; cnt = 0u; mine = 0u;
#pragma unroll
    for (unsigned j = 0; j < 16; ++j) { const unsigned c = xb_ld(&bar[XB_XCNT(j)]); sum += c; cnt += (c > 0u) ? 1u : 0u; mine = (j == x) ? c : mine; }
    if (sum == G) break;
    __builtin_amdgcn_s_sleep(1);
    if ((++sp & 255u) == 0u) { if (xb_ld(&bar[XB_TMO])) break; if (sp > XB_SPIN_CAP) { atomicAdd(&bar[XB_TMO], 1u); break; } }
  }
  nloc = mine > 0u ? mine : 1u; nx = cnt > 0u ? cnt : 1u;
}
DI void xcd_barrier(unsigned* barp, char* stp) {
  asm volatile("s_waitcnt vmcnt(0)" ::: "memory");
  __syncthreads();
  if (threadIdx.x == 0) {
    XcdBarrier b; b.bar = barp; b.x = xb_xcc_id(); b.st = (volatile LAS unsigned*)stp;
    unsigned* bar = b.bar;
    __builtin_amdgcn_s_waitcnt(0);
    unsigned nloc = b.st[0], nx = b.st[1];
    if (nloc == 0u) { xcd_barrier_complete(bar, b.x, nloc, nx); b.st[0] = nloc; b.st[1] = nx; }
    const unsigned old = xb_add(&bar[XB_XSUB(b.x)], 1u);
    const unsigned gen = old / nloc;
    if (old + 1u == (gen + 1u) * nloc) {
      __builtin_amdgcn_fence(__ATOMIC_RELEASE, "agent");
      asm volatile("s_waitcnt vmcnt(0)" ::: "memory");
      const unsigned og = xb_add(&bar[XB_TOP], 1u);
      const unsigned tg = og / nx;
      if (og + 1u == (tg + 1u) * nx) xb_add(&bar[XB_TOPGEN], 1u);
      else XB_SPIN(xb_ld(&bar[XB_TOPGEN]) == tg, bar);
      __builtin_amdgcn_fence(__ATOMIC_ACQUIRE, "agent");
      xb_add(&bar[XB_XGEN(b.x)], 1u);
      asm volatile("s_waitcnt vmcnt(0)" ::: "memory");
    } else {
      XB_SPIN(xb_ld(&bar[XB_XGEN(b.x)]) == gen, bar);
      __builtin_amdgcn_fence(__ATOMIC_ACQUIRE, "agent");
      asm volatile("s_waitcnt vmcnt(0)" ::: "memory");
    }
  }
  __syncthreads();
}

constexpr int SMEM_BYTES = 143360;
__global__ void __launch_bounds__(NT) fwd_megakernel(P p) {
  __shared__ __attribute__((aligned(16))) char smem[SMEM_BYTES + 16];
  if (threadIdx.x < 4) ((volatile LAS unsigned*)(smem + SMEM_BYTES))[threadIdx.x] = 0u;
  __syncthreads();
  (void)xcd_barrier_post((unsigned*)(p.ws + OFF_BAR), (volatile LAS unsigned*)(smem + SMEM_BYTES));
  phase_ada(p, smem);
  xcd_barrier((unsigned*)(p.ws + OFF_BAR), smem + SMEM_BYTES);
  phase_u1(p);
  phase_transposes(p, smem);
  phase_keys(p);
  phase_rope(p);
  phase_filter(p, smem);
  xcd_barrier((unsigned*)(p.ws + OFF_BAR), smem + SMEM_BYTES);
  phase_inproj(p, smem);
  xcd_barrier((unsigned*)(p.ws + OFF_BAR), smem + SMEM_BYTES);
  for (int item = blockIdx.x; item < 512 + 256; item += gridDim.x) {
    if (item < 512) hyena_item(p, smem, item);
    else attn_item(p, smem, item - 512);
  }
  xcd_barrier((unsigned*)(p.ws + OFF_BAR), smem + SMEM_BYTES);
  phase_merge(p, smem);
  xcd_barrier((unsigned*)(p.ws + OFF_BAR), smem + SMEM_BYTES);
  phase_outproj(p, smem);
  xcd_barrier((unsigned*)(p.ws + OFF_BAR), smem + SMEM_BYTES);
  phase_ln1(p);
  phase_tabconv(p);
  xcd_barrier((unsigned*)(p.ws + OFF_BAR), smem + SMEM_BYTES);
  phase_route(p, smem);
  xcd_barrier((unsigned*)(p.ws + OFF_BAR), smem + SMEM_BYTES);
  phase_upass(p, smem);
  xcd_barrier((unsigned*)(p.ws + OFF_BAR), smem + SMEM_BYTES);
  phase_vpass(p);
  xcd_barrier((unsigned*)(p.ws + OFF_BAR), smem + SMEM_BYTES);
  phase_ln2(p);
}

extern "C" void kernel_launch(void* const* d_in, const int* in_sizes, int n_in, void* d_out, int out_size, void* d_ws, size_t ws_size,
                              hipStream_t stream) {
  P p{};
  p.x = (const float*)d_in[0]; p.c = (const float*)d_in[1]; p.pos = (const int*)d_in[2];
  p.w_ada = (const float*)d_in[3]; p.b_ada = (const float*)d_in[4]; p.w_in = (const float*)d_in[5];
  p.hy_conv_w = (const float*)d_in[6]; p.hy_conv_b = (const float*)d_in[7];
  p.f1_w = (const float*)d_in[8]; p.f1_b = (const float*)d_in[9]; p.f1_freq = (const float*)d_in[10];
  p.f2_w = (const float*)d_in[11]; p.f2_b = (const float*)d_in[12]; p.f2_freq = (const float*)d_in[13];
  p.f3_w = (const float*)d_in[14]; p.hy_bias = (const float*)d_in[15];
  p.w_bh = (const float*)d_in[16]; p.w_ba = (const float*)d_in[17]; p.w_out = (const float*)d_in[18];
  p.ln1_g = (const float*)d_in[19]; p.ln1_b = (const float*)d_in[20];
  p.wq = (const float*)d_in[21]; p.keys = (const float*)d_in[22]; p.pu = (const float*)d_in[23]; p.pv = (const float*)d_in[24];
  p.ln2_g = (const float*)d_in[25]; p.ln2_b = (const float*)d_in[26];
  p.out = (float*)d_out; p.ws = (char*)d_ws;

  static int grid_blocks = 0;
  if (!grid_blocks) {
    int dev = 0, cus = 0, per_cu = 0;
    hipGetDevice(&dev);
    hipDeviceGetAttribute(&cus, hipDeviceAttributeMultiprocessorCount, dev);
    hipOccupancyMaxActiveBlocksPerMultiprocessor(&per_cu, fwd_megakernel, NT, 0);
    if (per_cu > 1) per_cu = 1;
    grid_blocks = cus * per_cu;
  }
  (void)hipMemsetAsync((char*)d_ws + OFF_BAR, 0, XCD_BAR_WORDS * 4, stream);
  void* args[] = {&p};
  hipError_t e = hipLaunchCooperativeKernel((void*)fwd_megakernel, dim3(grid_blocks), dim3(NT), args, 0, stream);
  if (e != hipSuccess) fprintf(stderr, "cooperative launch failed: %s (grid %d)\n", hipGetErrorString(e), grid_blocks);
}
```

```cpp
#include <hip/hip_runtime.h>
#include <hip/hip_cooperative_groups.h>
#include <cstdio>
#include <cstdint>

#define DI __device__ __forceinline__
typedef unsigned short ushort_t;
typedef __attribute__((ext_vector_type(8))) short bf16x8;
typedef __attribute__((ext_vector_type(16))) float f32x16;
typedef __attribute__((ext_vector_type(4))) float f32x4;
typedef __attribute__((ext_vector_type(4))) unsigned u32x4;

constexpr int T_ = 16384, S_ = 8192, NB = 2, D_ = 1024;
constexpr int HW_ = 512, HYC = 1536, QKVC = 2304, GATEC = 2048, INW = 5888;
constexpr int NT = 512;
constexpr float DN_ALPHA = 1.189207115002721f;
constexpr float LN_EPS = 1e-5f;

constexpr size_t OFF_ADA   = 0;
constexpr size_t OFF_BAR   = 49152;
constexpr size_t OFF_KEYS_B= 65536;
constexpr size_t OFF_WIN_T = 65536 + 524288;
constexpr size_t OFF_WQ_T  = OFF_WIN_T + (size_t)INW * 1024 * 2;
constexpr size_t OFF_WOUT_T= OFF_WQ_T + (size_t)2048 * 1024 * 2;
constexpr size_t OFF_WBH_T = OFF_WOUT_T + (size_t)1024 * 1024 * 2;
constexpr size_t OFF_WBA_T = OFF_WBH_T + (size_t)1024 * 512 * 2;
constexpr size_t OFF_PH    = OFF_WBA_T + (size_t)1024 * 256 * 2;
constexpr size_t OFF_QKV   = OFF_PH + (size_t)T_ * HYC * 2;
constexpr size_t OFF_GATE  = OFF_QKV + (size_t)T_ * QKVC * 2;
constexpr size_t OFF_YH    = OFF_GATE + (size_t)T_ * GATEC * 2;
constexpr size_t OFF_YA    = OFF_YH + (size_t)T_ * HW_ * 2;
constexpr size_t OFF_END   = OFF_YA + (size_t)T_ * 256 * 2;
constexpr size_t OFF_MERGED= OFF_PH;
constexpr size_t OFF_U1B   = OFF_YH;
static_assert(OFF_U1B + (size_t)T_ * 1024 * 2 <= 268435456ull, "u1b overflow");
constexpr size_t OFF_U2B   = OFF_PH;
constexpr size_t OFF_TABU  = OFF_QKV;
constexpr size_t OFF_TABV  = OFF_QKV + (size_t)16 * 1048576;
constexpr size_t OFF_SU    = OFF_QKV + (size_t)32 * 1048576;
constexpr size_t OFF_SV    = OFF_SU + 65536;
constexpr size_t OFF_COEF  = OFF_QKV + (size_t)64 * 1048576;
constexpr size_t OFF_F     = OFF_QKV + (size_t)72 * 1048576;
static_assert(OFF_F + (size_t)64 * 1048576 <= OFF_YH, "peer buffers overflow the qkv+gate region");
constexpr size_t OFF_IDX   = OFF_YH;
constexpr size_t OFF_GV    = OFF_YH + (size_t)T_ * 128 * 4;
constexpr size_t OFF_HSCR  = OFF_END;
static_assert(OFF_HSCR + (size_t)164 * 131072 <= 268435456ull, "ws overflow");
static_assert((size_t)92 * 131072 <= (size_t)INW * 1024 * 2, "w_in^T region too small");
constexpr size_t OFF_ROPE  = OFF_HSCR + (size_t)164 * 131072;
static_assert(OFF_ROPE + (size_t)T_ * 64 <= 268435456ull, "rope table overflow");

struct P {
  const float *x, *c; const int* pos;
  const float *w_ada, *b_ada, *w_in, *hy_conv_w, *hy_conv_b, *f1_w, *f1_b, *f1_freq, *f2_w, *f2_b, *f2_freq, *f3_w,
      *hy_bias, *w_bh, *w_ba, *w_out, *ln1_g, *ln1_b, *wq, *keys, *pu, *pv, *ln2_g, *ln2_b;
  float* out; char* ws;
};

DI ushort_t f2bf(float x) { unsigned u = __float_as_uint(x); u += 0x7fffu + ((u >> 16) & 1u); return (ushort_t)(u >> 16); }
DI float bf2f(ushort_t h) { return __uint_as_float(((unsigned)h) << 16); }
typedef __bf16 bf16x2_hw __attribute__((ext_vector_type(2)));
typedef float f32x2_hw __attribute__((ext_vector_type(2)));
DI unsigned pack2(float a, float b) { f32x2_hw v = {a, b}; return __builtin_bit_cast(unsigned, __builtin_convertvector(v, bf16x2_hw)); }
DI int tid_opaque() { int t = threadIdx.x; asm volatile("" : "+v"(t)); return t; }
DI float wave_sum(float v) {
#pragma unroll
  for (int o = 32; o > 0; o >>= 1) v += __shfl_xor(v, o);
  return v;
}

struct cf2 { float x, y; };
constexpr int FFT_N = 16384, FFT_SA = 560;

DI constexpr float wcos32(int j) {
  switch (j & 31) {
    case 0: return 1.0f; case 1: return 0.98078528040323043f; case 2: return 0.92387953251128674f; case 3: return 0.83146961230254524f;
    case 4: return 0.70710678118654752f; case 5: return 0.55557023301960218f; case 6: return 0.38268343236508978f; case 7: return 0.19509032201612825f;
    case 8: return 0.0f; case 9: return -0.19509032201612825f; case 10: return -0.38268343236508978f; case 11: return -0.55557023301960218f;
    case 12: return -0.70710678118654752f; case 13: return -0.83146961230254524f; case 14: return -0.92387953251128674f; case 15: return -0.98078528040323043f;
    case 16: return -1.0f; case 17: return -0.98078528040323043f; case 18: return -0.92387953251128674f; case 19: return -0.83146961230254524f;
    case 20: return -0.70710678118654752f; case 21: return -0.55557023301960218f; case 22: return -0.38268343236508978f; case 23: return -0.19509032201612825f;
    case 24: return 0.0f; case 25: return 0.19509032201612825f; case 26: return 0.38268343236508978f; case 27: return 0.55557023301960218f;
    case 28: return 0.70710678118654752f; case 29: return 0.83146961230254524f; case 30: return 0.92387953251128674f; default: return 0.98078528040323043f;
  }
}
DI constexpr float wsin32(int j) { return wcos32(j + 24); }
DI constexpr int brev(int v, int bits) { int r = 0; for (int i = 0; i < bits; ++i) r |= ((v >> i) & 1) << (bits - 1 - i); return r; }

template <int R, int LEN, bool INV, bool ZHI>
DI void r2_stage(float (&re)[R], float (&im)[R]) {
  constexpr int half = LEN / 2;
#pragma unroll
  for (int start = 0; start < R; start += LEN) {
#pragma unroll
    for (int j = 0; j < half; ++j) {
      const int a = start + j, b = a + half;
      const int tj = j * (32 / LEN);
      const float c = wcos32(tj), s = wsin32(tj);
      if (!INV) {
        float dr, di;
        if (ZHI) { dr = re[a]; di = im[a]; }
        else {
          const float ar = re[a], ai = im[a], br = re[b], bi = im[b];
          re[a] = ar + br; im[a] = ai + bi; dr = ar - br; di = ai - bi;
        }
        if (tj == 0) { re[b] = dr; im[b] = di; }
        else if (tj == 8) { re[b] = di; im[b] = -dr; }
        else { re[b] = dr * c + di * s; im[b] = di * c - dr * s; }
      } else {
        const float br = re[b], bi = im[b];
        float pr, pi;
        if (tj == 0) { pr = br; pi = bi; }
        else if (tj == 8) { pr = -bi; pi = br; }
        else { pr = br * c - bi * s; pi = bi * c + br * s; }
        const float ar = re[a], ai = im[a];
        re[a] = ar + pr; im[a] = ai + pi; re[b] = ar - pr; im[b] = ai - pi;
      }
    }
  }
}
template <int R, bool ZHI> DI void dft_fwd(float (&re)[R], float (&im)[R]) {
  if (R == 32) r2_stage<R, (R == 32 ? 32 : 2), false, ZHI>(re, im);
  r2_stage<R, 16, false, (R == 16) && ZHI>(re, im);
  r2_stage<R, 8, false, false>(re, im);
  r2_stage<R, 4, false, false>(re, im);
  r2_stage<R, 2, false, false>(re, im);
}
template <int R> DI void dft_inv(float (&re)[R], float (&im)[R]) {
  r2_stage<R, 2, true, false>(re, im);
  r2_stage<R, 4, true, false>(re, im);
  r2_stage<R, 8, true, false>(re, im);
  r2_stage<R, 16, true, false>(re, im);
  if (R == 32) r2_stage<R, (R == 32 ? 32 : 2), true, false>(re, im);
}

DI void sincos_turn(float frac, float& s, float& c) { sincospif(2.0f * frac, &s, &c); }

template <bool ZHI>
DI void fft_fwdA(float (&re)[32], float (&im)[32], cf2* lds, int m) {
  asm volatile("" : "+v"(m));
  float s1, c1; sincos_turn((float)m * (1.0f / 16384.0f), s1, c1);
  __builtin_amdgcn_sched_barrier(0);
  dft_fwd<32, ZHI>(re, im);
  __builtin_amdgcn_sched_barrier(0);
  float wr = 1.f, wi = 0.f;
#pragma unroll
  for (int k1 = 0; k1 < 32; ++k1) {
    if ((k1 & 3) == 0) __builtin_amdgcn_sched_barrier(0);
    const int r = brev(k1, 5);
    cf2 o; o.x = re[r] * wr - im[r] * wi; o.y = re[r] * wi + im[r] * wr;
    lds[k1 * FFT_SA + m] = o;
    const float nr = wr * c1 + wi * s1, ni = wi * c1 - wr * s1;
    wr = nr; wi = ni;
  }
}
DI void fft_B_read(float (&re)[32], float (&im)[32], const cf2* lds, int tid) {
  const int k1 = tid >> 4, mp = tid & 15;
#pragma unroll
  for (int n2 = 0; n2 < 32; ++n2) { cf2 v = lds[k1 * FFT_SA + n2 * 16 + mp]; re[n2] = v.x; im[n2] = v.y; }
}
DI void fft_fwdB_write(float (&re)[32], float (&im)[32], cf2* lds, int tid) {
  asm volatile("" : "+v"(tid));
  const int k1 = tid >> 4, mp = tid & 15;
  float s1, c1; sincos_turn((float)mp * (1.0f / 512.0f), s1, c1);
  __builtin_amdgcn_sched_barrier(0);
  dft_fwd<32, false>(re, im);
  __builtin_amdgcn_sched_barrier(0);
  float wr = 1.f, wi = 0.f;
#pragma unroll
  for (int k2 = 0; k2 < 32; ++k2) {
    if ((k2 & 3) == 0) __builtin_amdgcn_sched_barrier(0);
    const int r = brev(k2, 5);
    cf2 o; o.x = re[r] * wr - im[r] * wi; o.y = re[r] * wi + im[r] * wr;
    lds[k1 * FFT_SA + k2 * 17 + mp] = o;
    const float nr = wr * c1 + wi * s1, ni = wi * c1 - wr * s1;
    wr = nr; wi = ni;
  }
}
DI void fft_fwdC(float (&re)[32], float (&im)[32], const cf2* lds, int tid) {
  const int k1 = tid >> 5, k2 = tid & 31;
#pragma unroll
  for (int h = 0; h < 2; ++h) {
    float tr[16], ti[16];
#pragma unroll
    for (int mp = 0; mp < 16; ++mp) { cf2 v = lds[(k1 + 16 * h) * FFT_SA + k2 * 17 + mp]; tr[mp] = v.x; ti[mp] = v.y; }
    dft_fwd<16, false>(tr, ti);
#pragma unroll
    for (int i = 0; i < 16; ++i) { re[h * 16 + i] = tr[i]; im[h * 16 + i] = ti[i]; }
  }
}
DI void fft_invC(float (&re)[32], float (&im)[32], cf2* lds, int tid) {
  const int k1 = tid >> 5, k2 = tid & 31;
#pragma unroll
  for (int h = 0; h < 2; ++h) {
    float tr[16], ti[16];
#pragma unroll
    for (int i = 0; i < 16; ++i) { tr[i] = re[h * 16 + i]; ti[i] = im[h * 16 + i]; }
    dft_inv<16>(tr, ti);
#pragma unroll
    for (int mp = 0; mp < 16; ++mp) { cf2 o; o.x = tr[mp]; o.y = ti[mp]; lds[(k1 + 16 * h) * FFT_SA + k2 * 17 + mp] = o; }
  }
}
DI void fft_invB_read(float (&re)[32], float (&im)[32], const cf2* lds, int tid) {
  asm volatile("" : "+v"(tid));
  const int k1 = tid >> 4, mp = tid & 15;
  float s1, c1; sincos_turn((float)mp * (1.0f / 512.0f), s1, c1);
  float wr = 1.f, wi = 0.f;
  __builtin_amdgcn_sched_barrier(0);
#pragma unroll
  for (int k2 = 0; k2 < 32; ++k2) {
    if ((k2 & 3) == 0) __builtin_amdgcn_sched_barrier(0);
    const int r = brev(k2, 5);
    cf2 v = lds[k1 * FFT_SA + k2 * 17 + mp];
    re[r] = v.x * wr - v.y * wi; im[r] = v.x * wi + v.y * wr;
    const float nr = wr * c1 - wi * s1, ni = wi * c1 + wr * s1;
    wr = nr; wi = ni;
  }
}
DI void fft_invB_write(float (&re)[32], float (&im)[32], cf2* lds, int tid) {
  const int k1 = tid >> 4, mp = tid & 15;
  dft_inv<32>(re, im);
#pragma unroll
  for (int n2 = 0; n2 < 32; ++n2) { cf2 o; o.x = re[n2]; o.y = im[n2]; lds[k1 * FFT_SA + n2 * 16 + mp] = o; }
}
DI void fft_invA(float (&re)[32], float (&im)[32], const cf2* lds, int m) {
  asm volatile("" : "+v"(m));
  float s1, c1; sincos_turn((float)m * (1.0f / 16384.0f), s1, c1);
  float wr = 1.f, wi = 0.f;
  __builtin_amdgcn_sched_barrier(0);
#pragma unroll
  for (int k1 = 0; k1 < 32; ++k1) {
    if ((k1 & 3) == 0) __builtin_amdgcn_sched_barrier(0);
    const int r = brev(k1, 5);
    cf2 v = lds[k1 * FFT_SA + m];
    re[r] = v.x * wr - v.y * wi; im[r] = v.x * wi + v.y * wr;
    const float nr = wr * c1 - wi * s1, ni = wi * c1 + wr * s1;
    wr = nr; wi = ni;
  }
  __builtin_amdgcn_sched_barrier(0);
  dft_inv<32>(re, im);
}

DI void phase_ada(const P& p, char* smem) {
  float (*red)[16][32] = (float (*)[16][32])smem;
  const int tid = tid_opaque(), cl = tid & 31, kq = tid >> 5;
  for (int item = blockIdx.x; item < 192; item += gridDim.x) {
    const int col = item * 32 + cl;
    float a0 = 0.f, a1 = 0.f;
#pragma unroll 16
    for (int k = kq * 64; k < kq * 64 + 64; ++k) {
      const float w = p.w_ada[(size_t)k * 6144 + col];
      const float c0 = p.c[k], c1 = p.c[1024 + k];
      a0 += (c0 / (1.f + __expf(-c0))) * w;
      a1 += (c1 / (1.f + __expf(-c1))) * w;
    }
    __syncthreads();
    red[0][kq][cl] = a0; red[1][kq][cl] = a1;
    __syncthreads();
    if (tid < 64) {
      const int b = tid >> 5;
      float s = p.b_ada[col];
#pragma unroll
      for (int q = 0; q < 16; ++q) s += red[b][q][cl];
      ((float*)(p.ws + OFF_ADA))[b * 6144 + col] = s;
    }
  }
}
DI void phase_u1(const P& p) {
  const float* ada = (const float*)(p.ws + OFF_ADA);
  ushort_t* u1b = (ushort_t*)(p.ws + OFF_U1B);
  for (int i = blockIdx.x * NT + tid_opaque(); i < T_ * 128; i += gridDim.x * NT) {
    const int row = i >> 7, k = (i & 127) * 8, b = row / S_;
    const float* xp = p.x + (size_t)row * 1024 + k;
    const f32x4 x0 = *(const f32x4*)xp, x1 = *(const f32x4*)(xp + 4);
    const f32x4 s0 = *(const f32x4*)(ada + b * 6144 + 1024 + k), s1 = *(const f32x4*)(ada + b * 6144 + 1024 + k + 4);
    const f32x4 h0 = *(const f32x4*)(ada + b * 6144 + k), h1 = *(const f32x4*)(ada + b * 6144 + k + 4);
    u32x4 o;
    o[0] = pack2(x0[0] * (1.f + s0[0]) + h0[0], x0[1] * (1.f + s0[1]) + h0[1]);
    o[1] = pack2(x0[2] * (1.f + s0[2]) + h0[2], x0[3] * (1.f + s0[3]) + h0[3]);
    o[2] = pack2(x1[0] * (1.f + s1[0]) + h1[0], x1[1] * (1.f + s1[1]) + h1[1]);
    o[3] = pack2(x1[2] * (1.f + s1[2]) + h1[2], x1[3] * (1.f + s1[3]) + h1[3]);
    *(u32x4*)(u1b + (size_t)row * 1024 + k) = o;
  }
}

DI void transpose_tile(const float* __restrict__ W, ushort_t* __restrict__ Wt, int K, int N, int item, char* smem) {
  float (*tile)[65] = (float (*)[65])smem;
  const int ntn = N / 64;
  const int n0 = (item % ntn) * 64, k0 = (item / ntn) * 32;
  const int tid = tid_opaque();
  __syncthreads();
  {
    const int tx = tid & 63, ty = tid >> 6;
#pragma unroll
    for (int i = 0; i < 4; ++i) tile[ty + 8 * i][tx] = W[(size_t)(k0 + ty + 8 * i) * N + n0 + tx];
  }
  __syncthreads();
  {
    const int kk = tid & 31, nn0 = tid >> 5;
#pragma unroll
    for (int i = 0; i < 4; ++i) Wt[(size_t)(n0 + nn0 + 16 * i) * K + k0 + kk] = f2bf(tile[kk][nn0 + 16 * i]);
  }
}
DI void phase_transposes(const P& p, char* smem) {
  constexpr int I0 = (INW / 64) * 32, I1 = I0 + 32 * 32, I2 = I1 + 16 * 32, I3 = I2 + 16 * 16, I4 = I3 + 16 * 8;
  for (int item = blockIdx.x; item < I4; item += gridDim.x) {
    if (item < I0) transpose_tile(p.w_in, (ushort_t*)(p.ws + OFF_WIN_T), 1024, INW, item, smem);
    else if (item < I1) transpose_tile(p.wq, (ushort_t*)(p.ws + OFF_WQ_T), 1024, 2048, item - I0, smem);
    else if (item < I2) transpose_tile(p.w_out, (ushort_t*)(p.ws + OFF_WOUT_T), 1024, 1024, item - I1, smem);
    else if (item < I3) transpose_tile(p.w_bh, (ushort_t*)(p.ws + OFF_WBH_T), 512, 1024, item - I2, smem);
    else transpose_tile(p.w_ba, (ushort_t*)(p.ws + OFF_WBA_T), 256, 1024, item - I3, smem);
  }
}

DI void phase_filter(const P& p, char* smem) {
  float (*zf)[33] = (float (*)[33])smem;
  float (*h1)[64] = (float (*)[64])(smem + 4352);
  float (*h2T)[32] = (float (*)[32])(smem + 4352 + 8192);
  const int tid = tid_opaque();
  for (int item = blockIdx.x; item < 256; item += gridDim.x) {
  const int t0 = item * 32;
  __syncthreads();
  for (int idx = tid; idx < 32 * 33; idx += NT) {
    int tt = idx / 33, e = idx % 33, t = t0 + tt;
    float tl = (float)t * (1.0f / 8191.0f);
    float w = 6.283185307179586f * (float)t / 8192.0f;
    float val;
    if (e == 0) val = tl;
    else {
      int i = (e - 1) & 15;
      float f = 1e-4f + (float)i * ((15.0f - 1e-4f) / 15.0f);
      val = (e <= 16) ? cosf(f * w) : -sinf(f * w);
    }
    zf[tt][e] = val;
  }
  __syncthreads();
  for (int idx = tid; idx < 32 * 64; idx += NT) {
    int tt = idx >> 6, j = idx & 63;
    float a = p.f1_b[j];
    for (int e = 0; e < 33; ++e) a += zf[tt][e] * p.f1_w[e * 64 + j];
    h1[tt][j] = sinf(p.f1_freq[j] * a);
  }
  __syncthreads();
  for (int idx = tid; idx < 32 * 64; idx += NT) {
    int tt = idx >> 6, j = idx & 63;
    float a = p.f2_b[j];
    for (int e = 0; e < 64; ++e) a += h1[tt][e] * p.f2_w[e * 64 + j];
    h2T[j][tt] = sinf(p.f2_freq[j] * a);
  }
  __syncthreads();
  float* filt = p.out;
  const float min_decay = -3.0701134573253945f, max_decay = -15.350567286626973f;
  for (int col = tid; col < 2048; col += NT) {
    float acc[32];
#pragma unroll
    for (int i = 0; i < 32; ++i) acc[i] = 0.f;
    for (int j = 0; j < 64; ++j) {
      float w = p.f3_w[j * 2048 + col];
#pragma unroll
      for (int q = 0; q < 8; ++q) {
        f32x4 h = *(const f32x4*)&h2T[j][q * 4];
        acc[q * 4 + 0] += h[0] * w; acc[q * 4 + 1] += h[1] * w; acc[q * 4 + 2] += h[2] * w; acc[q * 4 + 3] += h[3] * w;
      }
    }
    int c = col & 511;
    float delta = fabsf(min_decay + (float)c * ((max_decay - min_decay) / 511.0f));
    float* dst = filt + (size_t)col * 8192 + t0;
#pragma unroll
    for (int q = 0; q < 8; ++q) {
      f32x4 o;
#pragma unroll
      for (int r = 0; r < 4; ++r) {
        float tl = (float)(t0 + q * 4 + r) * (1.0f / 8191.0f);
        o[r] = acc[q * 4 + r] * __expf(-tl * delta);
      }
      *(f32x4*)(dst + q * 4) = o;
    }
  }
  }
}

constexpr int BM = 256, BN = 128, BK = 64;
constexpr int LDS_A = BM * BK * 2, LDS_B = BN * BK * 2, LDS_STAGE = LDS_A + LDS_B;
constexpr int GEMM_LDS = 2 * LDS_STAGE + 8192;

DI int swz(int row, int ch) { return row * 128 + ((ch ^ (row & 7)) << 4); }

struct ALoadBf16 {
  const ushort_t* A; int lda;
  struct Raw { u32x4 v; };
  DI Raw fetch(int row, int k) const { Raw r; r.v = *(const u32x4*)(A + (size_t)row * lda + k); return r; }
  DI u32x4 cvt(const Raw& r, int k) const { return r.v; }
};
struct ALoadF32Mod {
  const float* A; const float* mod;
  struct Raw { f32x4 a, b; };
  DI Raw fetch(int row, int k) const { Raw r; const float* s = A + (size_t)row * 1024 + k; r.a = *(const f32x4*)s; r.b = *(const f32x4*)(s + 4); return r; }
  DI u32x4 cvt(const Raw& r, int k) const {
    f32x4 s0 = *(const f32x4*)(mod + k), s1 = *(const f32x4*)(mod + k + 4);
    f32x4 h0 = *(const f32x4*)(mod + 1024 + k), h1 = *(const f32x4*)(mod + 1024 + k + 4);
    u32x4 o;
    o[0] = pack2(r.a[0] * s0[0] + h0[0], r.a[1] * s0[1] + h0[1]);
    o[1] = pack2(r.a[2] * s0[2] + h0[2], r.a[3] * s0[3] + h0[3]);
    o[2] = pack2(r.b[0] * s1[0] + h1[0], r.b[1] * s1[1] + h1[1]);
    o[3] = pack2(r.b[2] * s1[2] + h1[2], r.b[3] * s1[3] + h1[3]);
    return o;
  }
};

template <class AL, bool SWAP = false>
DI void gemm_mainloop(f32x16 (&acc)[2][2], const AL& al, int m0, const ushort_t* __restrict__ Bt, int ldb, int n0, int K, char* smem) {
  const int tid = tid_opaque(), lane = tid & 63, wave = tid >> 6;
  const int wm = wave >> 1, wn = wave & 1;
  const int lr = tid >> 3, lc = tid & 7;
  typename AL::Raw ra[4]; u32x4 rb[2];
  const int nk = K / BK;
#pragma unroll
  for (int i = 0; i < 4; ++i) ra[i] = al.fetch(m0 + lr + 64 * i, lc * 8);
#pragma unroll
  for (int i = 0; i < 2; ++i) rb[i] = *(const u32x4*)(Bt + (size_t)(n0 + lr + 64 * i) * ldb + lc * 8);
  __syncthreads();
#pragma unroll
  for (int i = 0; i < 4; ++i) *(u32x4*)(smem + swz(lr + 64 * i, lc)) = al.cvt(ra[i], lc * 8);
#pragma unroll
  for (int i = 0; i < 2; ++i) *(u32x4*)(smem + LDS_A + swz(lr + 64 * i, lc)) = rb[i];
  __syncthreads();
  for (int kt = 0; kt < nk; ++kt) {
    char* cur = smem + (kt & 1) * LDS_STAGE;
    char* nxt = smem + ((kt + 1) & 1) * LDS_STAGE;
    const bool more = (kt + 1 < nk);
    const int kn = (kt + 1) * BK + lc * 8;
    if (more) {
#pragma unroll
      for (int i = 0; i < 4; ++i) ra[i] = al.fetch(m0 + lr + 64 * i, kn);
#pragma unroll
      for (int i = 0; i < 2; ++i) rb[i] = *(const u32x4*)(Bt + (size_t)(n0 + lr + 64 * i) * ldb + kn);
    }
#pragma unroll
    for (int s = 0; s < 4; ++s) {
      const int ch = 2 * s + (lane >> 5);
      bf16x8 af[2], bfr[2];
#pragma unroll
      for (int mi = 0; mi < 2; ++mi) af[mi] = *(const bf16x8*)(cur + swz(wm * 64 + mi * 32 + (lane & 31), ch));
#pragma unroll
      for (int ni = 0; ni < 2; ++ni) bfr[ni] = *(const bf16x8*)(cur + LDS_A + swz(wn * 64 + ni * 32 + (lane & 31), ch));
#pragma unroll
      for (int mi = 0; mi < 2; ++mi)
#pragma unroll
        for (int ni = 0; ni < 2; ++ni)
          acc[mi][ni] = SWAP ? __builtin_amdgcn_mfma_f32_32x32x16_bf16(bfr[ni], af[mi], acc[mi][ni], 0, 0, 0)
                             : __builtin_amdgcn_mfma_f32_32x32x16_bf16(af[mi], bfr[ni], acc[mi][ni], 0, 0, 0);
    }
    if (more) {
#pragma unroll
      for (int i = 0; i < 4; ++i) *(u32x4*)(nxt + swz(lr + 64 * i, lc)) = al.cvt(ra[i], kn);
#pragma unroll
      for (int i = 0; i < 2; ++i) *(u32x4*)(nxt + LDS_A + swz(lr + 64 * i, lc)) = rb[i];
    }
    __syncthreads();
  }
}

constexpr int AT_ROW = 576;
constexpr int LDS_AT = 64 * AT_ROW;
constexpr int LDS_STAGE_T = LDS_AT + LDS_B;
typedef __attribute__((ext_vector_type(4))) short s16x4;
DI void gemm_mainloop_AT(f32x16 (&acc)[2][2], const ushort_t* __restrict__ At, size_t ldt, const ushort_t* __restrict__ Bt, int ldb, int n0, int K, char* smem) {
  const int tid = tid_opaque(), lane = tid & 63, wave = tid >> 6;
  const int wm = wave >> 1, wn = wave & 1;
  const int lr = tid >> 3, lc = tid & 7;
  u32x4 ra[4], rb[2];
  const int nk = K / BK;
#pragma unroll
  for (int i = 0; i < 4; ++i) { const int q = tid + 512 * i; ra[i] = *(const u32x4*)(At + (size_t)(q >> 5) * ldt + (q & 31) * 8); }
#pragma unroll
  for (int i = 0; i < 2; ++i) rb[i] = *(const u32x4*)(Bt + (size_t)(n0 + lr + 64 * i) * ldb + lc * 8);
  __syncthreads();
#pragma unroll
  for (int i = 0; i < 4; ++i) { const int q = tid + 512 * i; *(u32x4*)(smem + (q >> 5) * AT_ROW + (q & 31) * 16) = ra[i]; }
#pragma unroll
  for (int i = 0; i < 2; ++i) *(u32x4*)(smem + LDS_AT + swz(lr + 64 * i, lc)) = rb[i];
  __syncthreads();
  const int hh = lane >> 5, gg = (lane >> 4) & 1, qq = (lane & 15) >> 2, pp = lane & 3;
  for (int kt = 0; kt < nk; ++kt) {
    char* cur = smem + (kt & 1) * LDS_STAGE_T;
    char* nxt = smem + ((kt + 1) & 1) * LDS_STAGE_T;
    const bool more = (kt + 1 < nk);
    if (more) {
#pragma unroll
      for (int i = 0; i < 4; ++i) { const int q = tid + 512 * i; ra[i] = *(const u32x4*)(At + (size_t)((kt + 1) * BK + (q >> 5)) * ldt + (q & 31) * 8); }
#pragma unroll
      for (int i = 0; i < 2; ++i) rb[i] = *(const u32x4*)(Bt + (size_t)(n0 + lr + 64 * i) * ldb + (kt + 1) * BK + lc * 8);
    }
#pragma unroll
    for (int s = 0; s < 4; ++s) {
      const int ch = 2 * s + hh;
      bf16x8 af[2], bfr[2];
#pragma unroll
      for (int mi = 0; mi < 2; ++mi) {
        const char* a0 = cur + (16 * s + 8 * hh + qq) * AT_ROW + (wm * 64 + mi * 32 + 16 * gg + 4 * pp) * 2;
        s16x4 lo = __builtin_amdgcn_ds_read_tr16_b64_v4i16((__attribute__((address_space(3))) s16x4*)(a0));
        s16x4 hi = __builtin_amdgcn_ds_read_tr16_b64_v4i16((__attribute__((address_space(3))) s16x4*)(a0 + 4 * AT_ROW));
        af[mi] = __builtin_shufflevector(lo, hi, 0, 1, 2, 3, 4, 5, 6, 7);
      }
#pragma unroll
      for (int ni = 0; ni < 2; ++ni) bfr[ni] = *(const bf16x8*)(cur + LDS_AT + swz(wn * 64 + ni * 32 + (lane & 31), ch));
#pragma unroll
      for (int mi = 0; mi < 2; ++mi)
#pragma unroll
        for (int ni = 0; ni < 2; ++ni) acc[mi][ni] = __builtin_amdgcn_mfma_f32_32x32x16_bf16(af[mi], bfr[ni], acc[mi][ni], 0, 0, 0);
    }
    if (more) {
#pragma unroll
      for (int i = 0; i < 4; ++i) { const int q = tid + 512 * i; *(u32x4*)(nxt + (q >> 5) * AT_ROW + (q & 31) * 16) = ra[i]; }
#pragma unroll
      for (int i = 0; i < 2; ++i) *(u32x4*)(nxt + LDS_AT + swz(lr + 64 * i, lc)) = rb[i];
    }
    __syncthreads();
  }
}

constexpr int G2_A = 32768, G2_STAGE = 65536;
template <bool SWAP>
DI void gemm256(f32x16 (&acc)[4][2], const ushort_t* __restrict__ A, int lda, int m0, const ushort_t* __restrict__ Bt, int ldb, int n0, int K, char* smem) {
  const int tid = tid_opaque(), lane = tid & 63, wave = tid >> 6;
  const int wm = wave >> 2, wn = wave & 3;
  const int lr = tid >> 3, lc = tid & 7;
  u32x4 ra[4], rb[4];
  const int nk = K / BK;
  const ushort_t* ap = A + (size_t)(m0 + lr) * lda + lc * 8;
  const ushort_t* bp = Bt + (size_t)(n0 + lr) * ldb + lc * 8;
#pragma unroll
  for (int i = 0; i < 4; ++i) { ra[i] = *(const u32x4*)(ap + (size_t)(64 * i) * lda); rb[i] = *(const u32x4*)(bp + (size_t)(64 * i) * ldb); }
  __syncthreads();
#pragma unroll
  for (int i = 0; i < 4; ++i) { *(u32x4*)(smem + swz(lr + 64 * i, lc)) = ra[i]; *(u32x4*)(smem + G2_A + swz(lr + 64 * i, lc)) = rb[i]; }
  __syncthreads();
  for (int kt = 0; kt < nk; ++kt) {
    char* cur = smem + (kt & 1) * G2_STAGE;
    char* nxt = smem + ((kt + 1) & 1) * G2_STAGE;
    const bool more = (kt + 1 < nk);
    if (more) {
#pragma unroll
      for (int i = 0; i < 4; ++i) { ra[i] = *(const u32x4*)(ap + (size_t)(64 * i) * lda + (kt + 1) * BK); rb[i] = *(const u32x4*)(bp + (size_t)(64 * i) * ldb + (kt + 1) * BK); }
    }
#pragma unroll
    for (int s = 0; s < 4; ++s) {
      const int ch = 2 * s + (lane >> 5);
      bf16x8 af[4], bfr[2];
#pragma unroll
      for (int mi = 0; mi < 4; ++mi) af[mi] = *(const bf16x8*)(cur + swz(wm * 128 + mi * 32 + (lane & 31), ch));
#pragma unroll
      for (int ni = 0; ni < 2; ++ni) bfr[ni] = *(const bf16x8*)(cur + G2_A + swz(wn * 64 + ni * 32 + (lane & 31), ch));
#pragma unroll
      for (int mi = 0; mi < 4; ++mi)
#pragma unroll
        for (int ni = 0; ni < 2; ++ni)
          acc[mi][ni] = SWAP ? __builtin_amdgcn_mfma_f32_32x32x16_bf16(bfr[ni], af[mi], acc[mi][ni], 0, 0, 0)
                             : __builtin_amdgcn_mfma_f32_32x32x16_bf16(af[mi], bfr[ni], acc[mi][ni], 0, 0, 0);
      if (s & 1) __builtin_amdgcn_sched_barrier(0);
    }
    if (more) {
#pragma unroll
      for (int i = 0; i < 4; ++i) { *(u32x4*)(nxt + swz(lr + 64 * i, lc)) = ra[i]; *(u32x4*)(nxt + G2_A + swz(lr + 64 * i, lc)) = rb[i]; }
    }
    __syncthreads();
  }
}
constexpr int G2T_A = 64 * 576, G2T_STAGE = G2T_A + 32768;
DI void gemm256_AT(f32x16 (&acc)[4][2], const ushort_t* __restrict__ At, size_t ldt, const ushort_t* __restrict__ Bt, int ldb, int n0, int K, char* smem) {
  const int tid = tid_opaque(), lane = tid & 63, wave = tid >> 6;
  const int wm = wave >> 2, wn = wave & 3;
  const int lr = tid >> 3, lc = tid & 7;
  u32x4 ra[4], rb[4];
  const int nk = K / BK;
  const ushort_t* bp = Bt + (size_t)(n0 + lr) * ldb + lc * 8;
#pragma unroll
  for (int i = 0; i < 4; ++i) { const int q = tid + 512 * i; ra[i] = *(const u32x4*)(At + (size_t)(q >> 5) * ldt + (q & 31) * 8); rb[i] = *(const u32x4*)(bp + (size_t)(64 * i) * ldb); }
  __syncthreads();
#pragma unroll
  for (int i = 0; i < 4; ++i) { const int q = tid + 512 * i; *(u32x4*)(smem + (q >> 5) * 576 + (q & 31) * 16) = ra[i]; *(u32x4*)(smem + G2T_A + swz(lr + 64 * i, lc)) = rb[i]; }
  __syncthreads();
  const int hh = lane >> 5, gg = (lane >> 4) & 1, qq = (lane & 15) >> 2, pp = lane & 3;
  for (int kt = 0; kt < nk; ++kt) {
    char* cur = smem + (kt & 1) * G2T_STAGE;
    char* nxt = smem + ((kt + 1) & 1) * G2T_STAGE;
    const bool more = (kt + 1 < nk);
    if (more) {
#pragma unroll
      for (int i = 0; i < 4; ++i) { const int q = tid + 512 * i; ra[i] = *(const u32x4*)(At + (size_t)((kt + 1) * BK + (q >> 5)) * ldt + (q & 31) * 8); rb[i] = *(const u32x4*)(bp + (size_t)(64 * i) * ldb + (kt + 1) * BK); }
    }
#pragma unroll
    for (int s = 0; s < 4; ++s) {
      const int ch = 2 * s + hh;
      bf16x8 af[4], bfr[2];
#pragma unroll
      for (int mi = 0; mi < 4; ++mi) {
        const char* a0 = cur + (16 * s + 8 * hh + qq) * 576 + (wm * 128 + mi * 32 + 16 * gg + 4 * pp) * 2;
        s16x4 lo = __builtin_amdgcn_ds_read_tr16_b64_v4i16((__attribute__((address_space(3))) s16x4*)(a0));
        s16x4 hi = __builtin_amdgcn_ds_read_tr16_b64_v4i16((__attribute__((address_space(3))) s16x4*)(a0 + 4 * 576));
        af[mi] = __builtin_shufflevector(lo, hi, 0, 1, 2, 3, 4, 5, 6, 7);
      }
#pragma unroll
      for (int ni = 0; ni < 2; ++ni) bfr[ni] = *(const bf16x8*)(cur + G2T_A + swz(wn * 64 + ni * 32 + (lane & 31), ch));
#pragma unroll
      for (int mi = 0; mi < 4; ++mi)
#pragma unroll
        for (int ni = 0; ni < 2; ++ni) acc[mi][ni] = __builtin_amdgcn_mfma_f32_32x32x16_bf16(af[mi], bfr[ni], acc[mi][ni], 0, 0, 0);
      if (s & 1) __builtin_amdgcn_sched_barrier(0);
    }
    if (more) {
#pragma unroll
      for (int i = 0; i < 4; ++i) { const int q = tid + 512 * i; *(u32x4*)(nxt + (q >> 5) * 576 + (q & 31) * 16) = ra[i]; *(u32x4*)(nxt + G2T_A + swz(lr + 64 * i, lc)) = rb[i]; }
    }
    __syncthreads();
  }
}
DI void acc_zero4(f32x16 (&acc)[4][2]) {
#pragma unroll
  for (int a = 0; a < 4; ++a)
#pragma unroll
    for (int b = 0; b < 2; ++b)
#pragma unroll
      for (int r = 0; r < 16; ++r) acc[a][b][r] = 0.f;
}
DI void acc_zero(f32x16 (&acc)[2][2]) {
#pragma unroll
  for (int a = 0; a < 2; ++a)
#pragma unroll
    for (int b = 0; b < 2; ++b)
#pragma unroll
      for (int r = 0; r < 16; ++r) acc[a][b][r] = 0.f;
}
#define ACC_ROW(mi, r) (wm * 64 + (mi) * 32 + ((r) & 3) + 8 * ((r) >> 2) + 4 * (lane >> 5))
#define ACC_COL(ni) (wn * 64 + (ni) * 32 + (lane & 31))

DI void stage_mod(float* mod, const float* ada, int b, int sc_chunk, int sh_chunk) {
  for (int i = tid_opaque(); i < 1024; i += NT) {
    mod[i] = 1.f + ada[b * 6144 + sc_chunk * 1024 + i];
    mod[1024 + i] = ada[b * 6144 + sh_chunk * 1024 + i];
  }
}

DI void phase_inproj(const P& p, char* smem) {
  const ushort_t* u1b = (const ushort_t*)(p.ws + OFF_U1B);
  const ushort_t* wt = (const ushort_t*)(p.ws + OFF_WIN_T);
  constexpr int NTN = INW / 256;
  constexpr int NTM = T_ / 256;
  for (int tile = blockIdx.x; tile < NTM * NTN; tile += gridDim.x) {
    const int tid = tid_opaque(), lane = tid & 63, wave = tid >> 6, wm = wave >> 2, wn = wave & 3;
    const int tm = tile / NTN, tn = tile % NTN;
    const int m0 = tm * 256, n0 = tn * 256, b = m0 / S_;
    f32x16 acc[4][2]; acc_zero4(acc);
    if (n0 < HYC) {
      gemm256<true>(acc, u1b, 1024, m0, wt, 1024, n0, 1024, smem);
      ushort_t* pb = (ushort_t*)(p.ws + OFF_PH) + ((size_t)(b * HYC + n0)) * S_ + (m0 & (S_ - 1));
      const unsigned lo = (unsigned)((wn * 64 + 4 * (lane >> 5)) * S_ + wm * 128 + (lane & 31));
#pragma unroll
      for (int mi = 0; mi < 4; ++mi)
#pragma unroll
        for (int ni = 0; ni < 2; ++ni) {
#pragma unroll
          for (int r = 0; r < 16; ++r) (pb + (size_t)(ni * 32 + (r & 3) + 8 * (r >> 2)) * S_ + mi * 32)[lo] = f2bf(acc[mi][ni][r]);
          asm volatile("" ::: "memory");
        }
      continue;
    }
    gemm256<false>(acc, u1b, 1024, m0, wt, 1024, n0, 1024, smem);
    if (n0 < HYC + QKVC) {
      ushort_t* qb = (ushort_t*)(p.ws + OFF_QKV) + (size_t)m0 * QKVC + (n0 - HYC);
      const unsigned lo = (unsigned)((wm * 128 + 4 * (lane >> 5)) * QKVC + wn * 64 + (lane & 31));
      const float* rtb = (const float*)(p.ws + OFF_ROPE) + (size_t)(m0 + wm * 128 + 4 * (lane >> 5)) * 16 + (lane & 7) * 2;
#pragma unroll
      for (int ni = 0; ni < 2; ++ni) {
        const int cq = n0 - HYC + wn * 64 + ni * 32 + (lane & 31);
        const bool rot = (ni == 0) && (cq < 1536) && ((cq & 63) < 16);
        const float qs = (cq < 768) ? 0.125f : 1.0f;
#pragma unroll
        for (int mi = 0; mi < 4; ++mi) {
#pragma unroll
          for (int r = 0; r < 16; ++r) {
            const int rr = mi * 32 + (r & 3) + 8 * (r >> 2);
            float v = acc[mi][ni][r];
            if (ni == 0) {
              const float o = __shfl_xor(v, 8);
              if (rot) {
                const float cs = rtb[rr * 16], sn = rtb[rr * 16 + 1];
                v = ((cq & 15) < 8) ? (v * cs - o * sn) : (v * cs + o * sn);
              }
            }
            (qb + rr * QKVC + ni * 32)[lo] = f2bf(v * qs);
          }
          asm volatile("" ::: "memory");
        }
      }
    } else {
      ushort_t* gb = (ushort_t*)(p.ws + OFF_GATE) + (size_t)m0 * GATEC + (n0 - HYC - QKVC);
      const unsigned lo = (unsigned)((wm * 128 + 4 * (lane >> 5)) * GATEC + wn * 64 + (lane & 31));
#pragma unroll
      for (int mi = 0; mi < 4; ++mi)
#pragma unroll
        for (int ni = 0; ni < 2; ++ni) {
#pragma unroll
          for (int r = 0; r < 16; ++r) (gb + (mi * 32 + (r & 3) + 8 * (r >> 2)) * GATEC + ni * 32)[lo] = f2bf(1.f / (1.f + __expf(-acc[mi][ni][r])));
          asm volatile("" ::: "memory");
        }
    }
  }
}

DI float sconv_t(const ushort_t* row, int t, float w0, float w1, float w2, float cb) {
  float v = cb + w1 * bf2f(row[t]);
  if (t > 0) v += w0 * bf2f(row[t - 1]);
  if (t < S_ - 1) v += w2 * bf2f(row[t + 1]);
  return v;
}
DI void fft_C_mul_invC(cf2* lds, const cf2* __restrict__ kq, int tid) {
  asm volatile("" : "+v"(tid));
  const int k1 = tid >> 5, k2 = tid & 31;
  kq += tid;
#pragma unroll
  for (int h = 0; h < 2; ++h) {
    float tr[16], ti[16];
    cf2 kv[16];
#pragma unroll
    for (int i = 0; i < 16; ++i) kv[i] = kq[(h * 16 + i) * 512];
    cf2* blk = lds + (k1 + 16 * h) * FFT_SA + k2 * 17;
#pragma unroll
    for (int mp = 0; mp < 16; ++mp) { cf2 v = blk[mp]; tr[mp] = v.x; ti[mp] = v.y; }
    dft_fwd<16, false>(tr, ti);
#pragma unroll
    for (int i = 0; i < 16; ++i) { const float a = tr[i], b = ti[i]; tr[i] = a * kv[i].x - b * kv[i].y; ti[i] = a * kv[i].y + b * kv[i].x; }
    dft_inv<16>(tr, ti);
#pragma unroll
    for (int mp = 0; mp < 16; ++mp) { cf2 o; o.x = tr[mp]; o.y = ti[mp]; blk[mp] = o; }
  }
}
DI void hyena_item(const P& p, char* smem, int c) {
  cf2* lds = (cf2*)smem;
  const ushort_t* pht = (const ushort_t*)(p.ws + OFF_PH);
  ushort_t* yht = (ushort_t*)(p.ws + OFF_YH);
  cf2* kq = (cf2*)(p.ws + (blockIdx.x < 92 ? OFF_WIN_T + (size_t)blockIdx.x * 131072 : OFF_HSCR + (size_t)(blockIdx.x - 92) * 131072));
  const float* filt = p.out;
  const int tid0 = tid_opaque();
  float zr[32], zi[32];
  __syncthreads();
#pragma unroll 1
  for (int o = 0; o < 2; ++o) {
    int tid = tid0; asm volatile("" : "+v"(tid));
    {
      float kr[32], ki[32];
      const float* fw = filt + (size_t)(0 * 1024 + o * 512 + c) * S_;
      const float* bw = filt + (size_t)(1 * 1024 + o * 512 + c) * S_;
      const float bias = p.hy_bias[o * 512 + c];
#pragma unroll
      for (int n1 = 0; n1 < 16; ++n1) { kr[n1] = fw[n1 * 512 + tid] * (1.0f / 16384.0f); ki[n1] = 0.f; }
      if (tid == 0) kr[0] += bias * (1.0f / 16384.0f);
#pragma unroll
      for (int n1 = 16; n1 < 32; ++n1) {
        const int n = n1 * 512 + tid;
        kr[n1] = (n == S_) ? 0.f : bw[2 * S_ - n] * (1.0f / 16384.0f); ki[n1] = 0.f;
      }
      fft_fwdA<false>(kr, ki, lds, tid); __syncthreads();
      fft_B_read(kr, ki, lds, tid); __syncthreads();
      fft_fwdB_write(kr, ki, lds, tid); __syncthreads();
      fft_fwdC(kr, ki, lds, tid);
      int ts = tid; asm volatile("" : "+v"(ts));
      cf2* kqt = kq + ts;
#pragma unroll
      for (int r = 0; r < 32; ++r) { cf2 v; v.x = kr[r]; v.y = ki[r]; kqt[r * 512] = v; }
      __syncthreads();
    }
    asm volatile("" : "+v"(tid));
    if (o == 0) {
      const float w0 = p.hy_conv_w[c], w1 = p.hy_conv_w[HYC + c], w2 = p.hy_conv_w[2 * HYC + c], cb = p.hy_conv_b[c];
      const ushort_t* r0 = pht + (size_t)(0 * HYC + c) * S_;
      const ushort_t* r1 = pht + (size_t)(1 * HYC + c) * S_;
#pragma unroll
      for (int n1 = 0; n1 < 16; ++n1) {
        const int t = n1 * 512 + tid;
        zr[n1] = sconv_t(r0, t, w0, w1, w2, cb); zi[n1] = sconv_t(r1, t, w0, w1, w2, cb);
        if (n1 & 1) asm volatile("" ::: "memory");
      }
    }
#pragma unroll
    for (int n1 = 16; n1 < 32; ++n1) { zr[n1] = 0.f; zi[n1] = 0.f; }
    fft_fwdA<true>(zr, zi, lds, tid); __syncthreads();
    fft_B_read(zr, zi, lds, tid); __syncthreads();
    fft_fwdB_write(zr, zi, lds, tid); __syncthreads();
    fft_C_mul_invC(lds, kq, tid); __syncthreads();
    fft_invB_read(zr, zi, lds, tid); __syncthreads();
    fft_invB_write(zr, zi, lds, tid); __syncthreads();
    fft_invA(zr, zi, lds, tid);
    int tg = tid; asm volatile("" : "+v"(tg));
    const int gch = (o + 1) * 512 + c;
    const float w0 = p.hy_conv_w[gch], w1 = p.hy_conv_w[HYC + gch], w2 = p.hy_conv_w[2 * HYC + gch], cb = p.hy_conv_b[gch];
    const ushort_t* g0 = pht + (size_t)(0 * HYC + gch) * S_;
    const ushort_t* g1 = pht + (size_t)(1 * HYC + gch) * S_;
#pragma unroll
    for (int n1 = 0; n1 < 16; ++n1) {
      const int t = n1 * 512 + tg;
      zr[n1] *= sconv_t(g0, t, w0, w1, w2, cb);
      zi[n1] *= sconv_t(g1, t, w0, w1, w2, cb);
      if (n1 & 1) asm volatile("" ::: "memory");
    }
    if (o == 1) {
#pragma unroll
      for (int n1 = 0; n1 < 16; ++n1) {
        const int t = n1 * 512 + tg;
        yht[(size_t)(0 * HW_ + c) * S_ + t] = f2bf(zr[n1]);
        yht[(size_t)(1 * HW_ + c) * S_ + t] = f2bf(zi[n1]);
      }
    }
  }
}

constexpr int ATT_VROW = 192;
constexpr int ATT_VBUF = 32 * ATT_VROW;
DI void attn_item(const P& p, char* smem, int item) {
  const ushort_t* qkv = (const ushort_t*)(p.ws + OFF_QKV);
  ushort_t* ya = (ushort_t*)(p.ws + OFF_YA);
  const int tid = tid_opaque(), lane = tid & 63, wave = tid >> 6;
  const int u = item * 8 + wave;
  const int hs = u & 3, r16 = (u >> 2) & 15, chunk = (u >> 6) & 15, b = u >> 10;
  const int qi = lane & 31, h = lane >> 5;
  char* vl = smem + wave * ATT_VBUF;
  const int tq = chunk * 512 + r16 + 16 * qi;
  const size_t bbase = (size_t)b * S_;
  f32x16 o0, o1;
#pragma unroll
  for (int r = 0; r < 16; ++r) { o0[r] = 0.f; o1[r] = 0.f; }
  float m = -1e30f, l = 0.f;
  const int g16 = (lane >> 4) & 1, q4 = (lane & 15) >> 2, p4 = lane & 3;
  __syncthreads();
#pragma unroll 1
  for (int g = 0; g < 3; ++g) {
    const int dsh = 2 * g;
    const int d = 1 << dsh, sd = 16 >> dsh, n = S_ >> dsh;
    const int head = g * 4 + hs;
    const int rc = r16 & (d - 1);
    const int P0 = (chunk * 512 + r16 - rc) >> dsh;
    const int pq = P0 + sd * qi;
    const int KB = P0 - 64;
    const int ntile = (g == 0) ? 20 : (g == 1 ? 8 : 5);
    bf16x8 bq[4];
    {
      const ushort_t* qrow = qkv + (bbase + tq) * QKVC + head * 64;
#pragma unroll
      for (int s = 0; s < 4; ++s) bq[s] = *(const bf16x8*)(qrow + (2 * s + h) * 8);
    }
    bf16x8 kn[4]; u32x4 vn[4];
    {
      const int kp = min(max(KB + qi, 0), n - 1);
      const ushort_t* krow = qkv + (bbase + rc + ((size_t)kp << dsh)) * QKVC + 768 + head * 64;
#pragma unroll
      for (int s = 0; s < 4; ++s) kn[s] = *(const bf16x8*)(krow + (2 * s + h) * 8);
#pragma unroll
      for (int i = 0; i < 4; ++i) {
        const int c = lane + 64 * i, row = c >> 3, ch = c & 7;
        const int vp = min(max(KB + row, 0), n - 1);
        vn[i] = *(const u32x4*)(qkv + (bbase + rc + ((size_t)vp << dsh)) * QKVC + 1536 + head * 64 + ch * 8);
      }
    }
#pragma unroll 1
    for (int kt = 0; kt < ntile; ++kt) {
      bf16x8 kc[4]; u32x4 vc[4];
#pragma unroll
      for (int s = 0; s < 4; ++s) kc[s] = kn[s];
#pragma unroll
      for (int i = 0; i < 4; ++i) vc[i] = vn[i];
      if (kt + 1 < ntile) {
        const int kb1 = KB + 32 * (kt + 1);
        const int kp = min(max(kb1 + qi, 0), n - 1);
        const ushort_t* krow = qkv + (bbase + rc + ((size_t)kp << dsh)) * QKVC + 768 + head * 64;
#pragma unroll
        for (int s = 0; s < 4; ++s) kn[s] = *(const bf16x8*)(krow + (2 * s + h) * 8);
#pragma unroll
        for (int i = 0; i < 4; ++i) {
          const int c = lane + 64 * i, row = c >> 3, ch = c & 7;
          const int vp = min(max(kb1 + row, 0), n - 1);
          vn[i] = *(const u32x4*)(qkv + (bbase + rc + ((size_t)vp << dsh)) * QKVC + 1536 + head * 64 + ch * 8);
        }
      }
      f32x16 st;
#pragma unroll
      for (int r = 0; r < 16; ++r) st[r] = 0.f;
#pragma unroll
      for (int s = 0; s < 4; ++s) st = __builtin_amdgcn_mfma_f32_32x32x16_bf16(kc[s], bq[s], st, 0, 0, 0);
#pragma unroll
      for (int i = 0; i < 4; ++i) { const int c = lane + 64 * i; *(u32x4*)(vl + (c >> 3) * ATT_VROW + (c & 7) * 16) = vc[i]; }
      const int kb = KB + 32 * kt + 4 * h;
      const int dk = kb - pq;
      float mx = -1e30f;
      bool ok[16];
#pragma unroll
      for (int r = 0; r < 16; ++r) {
        const int cr = (r & 3) + 8 * (r >> 2);
        ok[r] = ((unsigned)(dk + cr + 64) <= 128u) && ((unsigned)(kb + cr) < (unsigned)n);
        mx = fmaxf(mx, ok[r] ? st[r] : -1e30f);
      }
      mx = fmaxf(mx, __shfl_xor(mx, 32));
      const float mnew = fmaxf(m, mx);
      const float corr = __expf(m - mnew);
      float ps = 0.f;
      float pv[16];
#pragma unroll
      for (int r = 0; r < 16; ++r) { pv[r] = ok[r] ? __expf(st[r] - mnew) : 0.f; ps += pv[r]; }
      ps += __shfl_xor(ps, 32);
      l = l * corr + ps; m = mnew;
#pragma unroll
      for (int r = 0; r < 16; ++r) { o0[r] *= corr; o1[r] *= corr; }
      bf16x8 pf[2];
#pragma unroll
      for (int s = 0; s < 2; ++s) {
        u32x4 w;
        w[0] = pack2(pv[8 * s + 0], pv[8 * s + 1]); w[1] = pack2(pv[8 * s + 2], pv[8 * s + 3]);
        w[2] = pack2(pv[8 * s + 4], pv[8 * s + 5]); w[3] = pack2(pv[8 * s + 6], pv[8 * s + 7]);
        pf[s] = __builtin_bit_cast(bf16x8, w);
      }
      __builtin_amdgcn_wave_barrier();
      asm volatile("s_waitcnt lgkmcnt(0)" ::: "memory");
#pragma unroll
      for (int s = 0; s < 2; ++s) {
#pragma unroll
        for (int nt = 0; nt < 2; ++nt) {
          const char* a0 = vl + (16 * s + 4 * h + q4) * ATT_VROW + (32 * nt + 16 * g16 + 4 * p4) * 2;
          s16x4 lo = __builtin_amdgcn_ds_read_tr16_b64_v4i16((__attribute__((address_space(3))) s16x4*)(a0));
          s16x4 hi = __builtin_amdgcn_ds_read_tr16_b64_v4i16((__attribute__((address_space(3))) s16x4*)(a0 + 8 * ATT_VROW));
          const bf16x8 vf = __builtin_shufflevector(lo, hi, 0, 1, 2, 3, 4, 5, 6, 7);
          if (nt == 0) o0 = __builtin_amdgcn_mfma_f32_32x32x16_bf16(vf, pf[s], o0, 0, 0, 0);
          else o1 = __builtin_amdgcn_mfma_f32_32x32x16_bf16(vf, pf[s], o1, 0, 0, 0);
        }
      }
      __builtin_amdgcn_wave_barrier();
      asm volatile("s_waitcnt lgkmcnt(0)" ::: "memory");
    }
  }
  const float il = 1.f / l;
  ushort_t* op = ya + (bbase + tq) * 256 + hs * 64;
#pragma unroll
  for (int gq = 0; gq < 4; ++gq) {
    uint2 w0, w1;
    w0.x = pack2(o0[4 * gq] * il, o0[4 * gq + 1] * il); w0.y = pack2(o0[4 * gq + 2] * il, o0[4 * gq + 3] * il);
    w1.x = pack2(o1[4 * gq] * il, o1[4 * gq + 1] * il); w1.y = pack2(o1[4 * gq + 2] * il, o1[4 * gq + 3] * il);
    *(uint2*)(op + 8 * gq + 4 * h) = w0;
    *(uint2*)(op + 32 + 8 * gq + 4 * h) = w1;
  }
}

DI void phase_merge(const P& p, char* smem) {
  const ushort_t* yh = (const ushort_t*)(p.ws + OFF_YH);
  const ushort_t* ya = (const ushort_t*)(p.ws + OFF_YA);
  const ushort_t* gate = (const ushort_t*)(p.ws + OFF_GATE);
  ushort_t* merged = (ushort_t*)(p.ws + OFF_MERGED);
  constexpr int NTN = 1024 / 256, NTM = T_ / 256;
  for (int tile = blockIdx.x; tile < NTM * NTN; tile += gridDim.x) {
    const int tid = tid_opaque(), wave = tid >> 6, wm = wave >> 2, wn = wave & 3;
    int lane = tid & 63;
    const int m0 = (tile / NTN) * 256, n0 = (tile % NTN) * 256;
    f32x16 a1[4][2]; acc_zero4(a1);
    gemm256_AT(a1, yh + (size_t)((m0 / S_) * HW_) * S_ + (m0 & (S_ - 1)), (size_t)S_, (const ushort_t*)(p.ws + OFF_WBH_T), 512, n0, 512, smem);
    const ushort_t* gbh = gate + (size_t)m0 * GATEC + n0;
    ushort_t* mb = merged + (size_t)m0 * 1024 + n0;
    {
      const unsigned lg = (unsigned)((wm * 128 + 4 * (lane >> 5)) * GATEC + wn * 64 + (lane & 31));
      const unsigned lm = (unsigned)((wm * 128 + 4 * (lane >> 5)) * 1024 + wn * 64 + (lane & 31));
#pragma unroll
      for (int mi = 0; mi < 4; ++mi)
#pragma unroll
        for (int ni = 0; ni < 2; ++ni) {
#pragma unroll
          for (int r = 0; r < 16; ++r) {
            const int rr = mi * 32 + (r & 3) + 8 * (r >> 2);
            (mb + rr * 1024 + ni * 32)[lm] = f2bf(bf2f((gbh + rr * GATEC + ni * 32)[lg]) * a1[mi][ni][r]);
          }
          asm volatile("" ::: "memory");
        }
    }
    acc_zero4(a1);
    gemm256<false>(a1, ya, 256, m0, (const ushort_t*)(p.ws + OFF_WBA_T), 256, n0, 256, smem);
    asm volatile("" : "+v"(lane));
    {
      const unsigned lg = (unsigned)((wm * 128 + 4 * (lane >> 5)) * GATEC + wn * 64 + (lane & 31));
      const unsigned lm = (unsigned)((wm * 128 + 4 * (lane >> 5)) * 1024 + wn * 64 + (lane & 31));
#pragma unroll
      for (int mi = 0; mi < 4; ++mi)
#pragma unroll
        for (int ni = 0; ni < 2; ++ni) {
#pragma unroll
          for (int r = 0; r < 16; ++r) {
            const int rr = mi * 32 + (r & 3) + 8 * (r >> 2);
            ushort_t* mp = mb + rr * 1024 + ni * 32;
            mp[lm] = f2bf(bf2f(mp[lm]) + bf2f((gbh + 1024 + rr * GATEC + ni * 32)[lg]) * a1[mi][ni][r]);
          }
          asm volatile("" ::: "memory");
        }
    }
  }
}

DI void phase_outproj(const P& p, char* smem) {
  const float* ada = (const float*)(p.ws + OFF_ADA);
  const ushort_t* merged = (const ushort_t*)(p.ws + OFF_MERGED);
  constexpr int NTN = 1024 / 256, NTM = T_ / 256;
  for (int tile = blockIdx.x; tile < NTM * NTN; tile += gridDim.x) {
    const int tid = tid_opaque(), lane = tid & 63, wave = tid >> 6, wm = wave >> 2, wn = wave & 3;
    const int m0 = (tile / NTN) * 256, n0 = (tile % NTN) * 256, b = m0 / S_;
    f32x16 acc[4][2]; acc_zero4(acc);
    gemm256<false>(acc, merged, 1024, m0, (const ushort_t*)(p.ws + OFF_WOUT_T), 1024, n0, 1024, smem);
    const float* xb = p.x + (size_t)m0 * 1024 + n0;
    float* ob = p.out + (size_t)m0 * 1024 + n0;
    const unsigned lo = (unsigned)((wm * 128 + 4 * (lane >> 5)) * 1024 + wn * 64 + (lane & 31));
#pragma unroll
    for (int ni = 0; ni < 2; ++ni) {
      const float g1 = 1.f + ada[b * 6144 + 2 * 1024 + n0 + wn * 64 + ni * 32 + (lane & 31)];
#pragma unroll
      for (int mi = 0; mi < 4; ++mi) {
#pragma unroll
        for (int r = 0; r < 16; ++r) {
          const int rr = mi * 32 + (r & 3) + 8 * (r >> 2);
          (ob + rr * 1024 + ni * 32)[lo] = DN_ALPHA * (xb + rr * 1024 + ni * 32)[lo] + g1 * acc[mi][ni][r];
          if ((r & 3) == 3) asm volatile("" ::: "memory");
        }
      }
    }
  }
}

DI void phase_ln(float* __restrict__ xio, const float* __restrict__ g, const float* __restrict__ bta) {
  const int tq = tid_opaque(); const int lane = tq & 63, wave = tq >> 6;
  for (int row = blockIdx.x * 8 + wave; row < T_; row += gridDim.x * 8) {
    float* rp = xio + (size_t)row * 1024;
    f32x4 v[4];
    float s = 0.f;
#pragma unroll
    for (int i = 0; i < 4; ++i) { v[i] = *(const f32x4*)(rp + i * 256 + lane * 4); s += v[i][0] + v[i][1] + v[i][2] + v[i][3]; }
    const float mu = wave_sum(s) * (1.f / 1024.f);
    float q = 0.f;
#pragma unroll
    for (int i = 0; i < 4; ++i)
#pragma unroll
      for (int j = 0; j < 4; ++j) { float d = v[i][j] - mu; q += d * d; }
    const float rs = rsqrtf(wave_sum(q) * (1.f / 1024.f) + LN_EPS);
#pragma unroll
    for (int i = 0; i < 4; ++i) {
      f32x4 gg = *(const f32x4*)(g + i * 256 + lane * 4), bb = *(const f32x4*)(bta + i * 256 + lane * 4), o;
#pragma unroll
      for (int j = 0; j < 4; ++j) o[j] = (v[i][j] - mu) * rs * gg[j] + bb[j];
      *(f32x4*)(rp + i * 256 + lane * 4) = o;
    }
  }
}

DI int swz256(int row, int ch) { return row * 256 + ((ch ^ (row & 15)) << 4); }
DI void ins16(float (&L)[16], float x) {
#pragma unroll
  for (int i = 0; i < 16; ++i) { const float hi = __builtin_fmaxf(L[i], x); x = __builtin_fminf(L[i], x); L[i] = hi; }
}
DI void bitonic16_desc(float (&M)[16]) {
#pragma unroll
  for (int d = 8; d >= 1; d >>= 1)
#pragma unroll
    for (int i = 0; i < 16; ++i)
      if ((i & d) == 0) { const float a = M[i], b = M[i + d]; M[i] = __builtin_fmaxf(a, b); M[i + d] = __builtin_fminf(a, b); }
}
constexpr int ROUTE_Q_OFF = 0, ROUTE_K_OFF = 65536, ROUTE_IDX_OFF = 106496;
DI void phase_route(const P& p, char* smem) {
  const float* ada = (const float*)(p.ws + OFF_ADA);
  float* mod = (float*)(smem + 2 * LDS_STAGE);
  const ushort_t* keysb = (const ushort_t*)(p.ws + OFF_KEYS_B);
  int* idx = (int*)(p.ws + OFF_IDX);
  float* gv = (float*)(p.ws + OFF_GV);
  for (int item = blockIdx.x; item < (T_ / BM) * 8; item += gridDim.x) {
    const int tid = tid_opaque(), lane = tid & 63, wave = tid >> 6, wm = wave >> 1, wn = wave & 1;
    const int m0 = (item >> 3) * BM, hh = item & 7;
    float L0[16];
#pragma unroll 1
    for (int pp = 0; pp < 2; ++pp) {
      const int hp = hh * 2 + pp;
      f32x16 acc[2][2]; acc_zero(acc);
      ALoadBf16 al{(const ushort_t*)(p.ws + OFF_U2B), 1024};
      gemm_mainloop<ALoadBf16, true>(acc, al, m0, (const ushort_t*)(p.ws + OFF_WQ_T), 1024, hp * 128, 1024, smem);
#pragma unroll
      for (int mi = 0; mi < 2; ++mi) {
        const int tok = wm * 64 + mi * 32 + (lane & 31);
#pragma unroll
        for (int ni = 0; ni < 2; ++ni)
#pragma unroll
          for (int g = 0; g < 4; ++g) {
            const int ch = wn * 8 + ni * 4 + g;
            uint2 v; v.x = pack2(acc[mi][ni][4 * g], acc[mi][ni][4 * g + 1]); v.y = pack2(acc[mi][ni][4 * g + 2], acc[mi][ni][4 * g + 3]);
            *(uint2*)(smem + ROUTE_Q_OFF + swz256(tok, ch) + 8 * (lane >> 5)) = v;
          }
      }
#pragma unroll
      for (int i = 0; i < 4; ++i) {
        const int q = tid + 512 * i, row = q >> 4, ch = q & 15;
        *(u32x4*)(smem + ROUTE_K_OFF + swz256(row, ch)) = *(const u32x4*)(keysb + (size_t)hp * 16384 + row * 128 + ch * 8);
      }
      __syncthreads();
      f32x16 sc[4];
#pragma unroll
      for (int ks = 0; ks < 4; ++ks)
#pragma unroll
        for (int r = 0; r < 16; ++r) sc[ks][r] = 0.f;
#pragma unroll
      for (int s = 0; s < 8; ++s) {
        const int ch = 2 * s + (lane >> 5);
        const bf16x8 bq = *(const bf16x8*)(smem + ROUTE_Q_OFF + swz256(wave * 32 + (lane & 31), ch));
#pragma unroll
        for (int ks = 0; ks < 4; ++ks) {
          const bf16x8 ak = *(const bf16x8*)(smem + ROUTE_K_OFF + swz256(ks * 32 + (lane & 31), ch));
          sc[ks] = __builtin_amdgcn_mfma_f32_32x32x16_bf16(ak, bq, sc[ks], 0, 0, 0);
        }
      }
      float L[16];
#pragma unroll
      for (int i = 0; i < 16; ++i) L[i] = -3.0e38f;
      const unsigned hbit = (unsigned)(lane >> 5) << 2;
#pragma unroll
      for (int ks = 0; ks < 4; ++ks)
#pragma unroll
        for (int r = 0; r < 16; ++r) {
          const unsigned key = (unsigned)(ks * 32 + (r & 3) + 8 * (r >> 2)) | hbit;
          ins16(L, __uint_as_float((__float_as_uint(sc[ks][r]) & ~127u) | key));
        }
      {
        float M[16];
#pragma unroll
        for (int i = 0; i < 16; ++i) M[i] = __builtin_fmaxf(L[i], __shfl_xor(L[15 - i], 32));
        bitonic16_desc(M);
#pragma unroll
        for (int i = 0; i < 16; ++i) L[i] = M[i];
      }
      if (pp == 0) {
#pragma unroll
        for (int i = 0; i < 16; ++i) L0[i] = L[i];
      } else {
        unsigned char* ib = (unsigned char*)(smem + ROUTE_IDX_OFF) + tid * 32;
#pragma unroll
        for (int i = 0; i < 16; ++i) { ib[i] = (unsigned char)(__float_as_uint(L0[i]) & 127u); ib[16 + i] = (unsigned char)(__float_as_uint(L[i]) & 127u); }
        float F[16];
#pragma unroll
        for (int i = 0; i < 16; ++i) F[i] = -3.0e38f;
#pragma unroll
        for (int i = 0; i < 16; ++i) {
          const float ai = __uint_as_float(__float_as_uint(L0[i]) & ~127u);
#pragma unroll
          for (int j = 0; j < 16; ++j)
            if ((i + 1) * (j + 1) <= 16) {
              const float s = ai + __uint_as_float(__float_as_uint(L[j]) & ~127u);
              ins16(F, __uint_as_float((__float_as_uint(s) & ~255u) | (unsigned)(i * 16 + j)));
            }
        }
        const float mx = __uint_as_float(__float_as_uint(F[0]) & ~255u);
        float e[16], sum = 0.f;
#pragma unroll
        for (int k = 0; k < 16; ++k) { e[k] = __expf(__uint_as_float(__float_as_uint(F[k]) & ~255u) - mx); sum += e[k]; }
        const float inv = 1.f / sum;
        if (lane < 32) {
          const int tok = m0 + wave * 32 + lane;
          int* ip = idx + (size_t)tok * 128 + hh * 16;
          float* gp = gv + (size_t)tok * 128 + hh * 16;
#pragma unroll
          for (int k4 = 0; k4 < 4; ++k4) {
            int4 iv; f32x4 g4;
            int ee[4];
#pragma unroll
            for (int u = 0; u < 4; ++u) {
              const unsigned code = __float_as_uint(F[k4 * 4 + u]) & 255u;
              ee[u] = (int)ib[code >> 4] * 128 + (int)ib[16 + (code & 15u)];
              g4[u] = e[k4 * 4 + u] * inv;
            }
            iv.x = ee[0]; iv.y = ee[1]; iv.z = ee[2]; iv.w = ee[3];
            *(int4*)(ip + k4 * 4) = iv;
            *(f32x4*)(gp + k4 * 4) = g4;
          }
        }
      }
    }
  }
}

DI void phase_rope(const P& p) {
  float* rt = (float*)(p.ws + OFF_ROPE);
  for (int i = blockIdx.x * NT + tid_opaque(); i < T_ * 8; i += gridDim.x * NT) {
    const float inv = expf(-13.122363377404328f * (float)(i & 7) * 0.125f);
    const float x = (float)p.pos[i >> 3] * inv;
    const float k = rintf(x * 0.15915494309189535f);
    float r = fmaf(-k, 6.28125f, x);
    r = fmaf(-k, 1.9353071795864769e-3f, r);
    float sn, cs; __sincosf(r, &sn, &cs);
    rt[2 * i] = cs; rt[2 * i + 1] = sn;
  }
}
DI void phase_keys(const P& p) {
  ushort_t* keysb = (ushort_t*)(p.ws + OFF_KEYS_B);
  for (int i = blockIdx.x * NT + tid_opaque(); i < 16 * 128 * 128 / 4; i += gridDim.x * NT) {
    f32x4 v = *(const f32x4*)(p.keys + (size_t)i * 4);
    uint2 o; o.x = pack2(v[0], v[1]); o.y = pack2(v[2], v[3]);
    *(uint2*)(keysb + (size_t)i * 4) = o;
  }
}

typedef __bf16 bf16x2_t __attribute__((ext_vector_type(2)));
DI float dot2bf(unsigned a, unsigned b, float c) { return __builtin_amdgcn_fdot2_f32_bf16(__builtin_bit_cast(bf16x2_t, a), __builtin_bit_cast(bf16x2_t, b), c, false); }
DI void phase_ln1(const P& p) {
  const float* ada = (const float*)(p.ws + OFF_ADA);
  ushort_t* u2b = (ushort_t*)(p.ws + OFF_U2B);
  const int tq = tid_opaque(); const int lane = tq & 63, wave = tq >> 6;
  for (int row = blockIdx.x * 8 + wave; row < T_; row += gridDim.x * 8) {
    const int b = row / S_;
    float* rp = p.out + (size_t)row * 1024;
    f32x4 v[4];
    float s = 0.f;
#pragma unroll
    for (int i = 0; i < 4; ++i) { v[i] = *(const f32x4*)(rp + i * 256 + lane * 4); s += v[i][0] + v[i][1] + v[i][2] + v[i][3]; }
    const float mu = wave_sum(s) * (1.f / 1024.f);
    float q = 0.f;
#pragma unroll
    for (int i = 0; i < 4; ++i)
#pragma unroll
      for (int j = 0; j < 4; ++j) { float d = v[i][j] - mu; q += d * d; }
    const float rs = rsqrtf(wave_sum(q) * (1.f / 1024.f) + LN_EPS);
#pragma unroll
    for (int i = 0; i < 4; ++i) {
      const int col = i * 256 + lane * 4;
      f32x4 gg = *(const f32x4*)(p.ln1_g + col), bb = *(const f32x4*)(p.ln1_b + col), o;
      f32x4 sc = *(const f32x4*)(ada + b * 6144 + 4 * 1024 + col), sh = *(const f32x4*)(ada + b * 6144 + 3 * 1024 + col);
#pragma unroll
      for (int j = 0; j < 4; ++j) o[j] = (v[i][j] - mu) * rs * gg[j] + bb[j];
      *(f32x4*)(rp + col) = o;
      uint2 w; w.x = pack2(o[0] * (1.f + sc[0]) + sh[0], o[1] * (1.f + sc[1]) + sh[1]); w.y = pack2(o[2] * (1.f + sc[2]) + sh[2], o[3] * (1.f + sc[3]) + sh[3]);
      *(uint2*)(u2b + (size_t)row * 1024 + col) = w;
    }
  }
}
DI float wave_max(float v) {
#pragma unroll
  for (int o = 32; o > 0; o >>= 1) v = fmaxf(v, __shfl_xor(v, o));
  return v;
}
DI unsigned pack4_fp8(float a, float b, float c, float d) {
  int w = 0;
  w = __builtin_amdgcn_cvt_pk_fp8_f32(a, b, w, false);
  w = __builtin_amdgcn_cvt_pk_fp8_f32(c, d, w, true);
  return (unsigned)w;
}
DI void phase_tabconv(const P& p) {
  unsigned char* tu = (unsigned char*)(p.ws + OFF_TABU);
  unsigned char* tv = (unsigned char*)(p.ws + OFF_TABV);
  float* su = (float*)(p.ws + OFF_SU);
  float* sv = (float*)(p.ws + OFF_SV);
  const int tq = tid_opaque(); const int lane = tq & 63, wave = tq >> 6;
  for (int e = blockIdx.x * 8 + wave; e < 16384; e += gridDim.x * 8) {
    f32x4 a[4], c[4];
    float ma = 0.f, mc = 0.f;
#pragma unroll
    for (int i = 0; i < 4; ++i) {
      const int col = i * 256 + lane * 4;
      a[i] = *(const f32x4*)(p.pu + (size_t)e * 1024 + col);
      c[i] = *(const f32x4*)(p.pv + (size_t)e * 1024 + col);
#pragma unroll
      for (int j = 0; j < 4; ++j) { ma = fmaxf(ma, fabsf(a[i][j])); mc = fmaxf(mc, fabsf(c[i][j])); }
    }
    ma = wave_max(ma); mc = wave_max(mc);
    const float sa = (ma > 0.f) ? ma * (1.0f / 448.0f) : 1.0f, sc = (mc > 0.f) ? mc * (1.0f / 448.0f) : 1.0f;
    const float ia = 1.0f / sa, ic = 1.0f / sc;
    if (lane == 0) { su[e] = sa; sv[e] = sc; }
#pragma unroll
    for (int i = 0; i < 4; ++i) {
      const int col = i * 256 + lane * 4;
      *(unsigned*)(tu + (size_t)e * 1024 + col) = pack4_fp8(a[i][0] * ia, a[i][1] * ia, a[i][2] * ia, a[i][3] * ia);
      const int slice = i * 2 + (lane >> 5);
      *(unsigned*)(tv + ((size_t)slice * 16384 + e) * 128 + (lane & 31) * 4) = pack4_fp8(c[i][0] * ic, c[i][1] * ic, c[i][2] * ic, c[i][3] * ic);
    }
  }
}

template <int CTRL> DI float dpp_f(float v) { return __int_as_float(__builtin_amdgcn_mov_dpp(__float_as_int(v), CTRL, 0xf, 0xf, false)); }
template <int CTRL> DI int dpp_shr0(int v) { return __builtin_amdgcn_update_dpp(0, v, CTRL, 0xf, 0xf, true); }
template <int I> DI int bcast16(int v) { return __builtin_amdgcn_mov_dpp(v, 0x150 + I, 0xf, 0xf, false); }
DI float row_sum16(float d) {
  d += dpp_f<0xB1>(d);
  d += dpp_f<0x4E>(d);
  d += dpp_f<0x141>(d);
  d += dpp_f<0x140>(d);
  return d;
}
typedef __bf16 bf16x2_c __attribute__((ext_vector_type(2)));
DI float dot4_fp8(unsigned w8, unsigned xlo, unsigned xhi, float acc) {
  const bf16x2_c lo = __builtin_amdgcn_cvt_scalef32_pk_bf16_fp8((int)w8, 1.0f, false);
  const bf16x2_c hi = __builtin_amdgcn_cvt_scalef32_pk_bf16_fp8((int)w8, 1.0f, true);
  acc = __builtin_amdgcn_fdot2_f32_bf16(lo, __builtin_bit_cast(bf16x2_c, xlo), acc, false);
  return __builtin_amdgcn_fdot2_f32_bf16(hi, __builtin_bit_cast(bf16x2_c, xhi), acc, false);
}
DI void phase_upass(const P& p, char* smem) {
  const int* idx = (const int*)(p.ws + OFF_IDX);
  const float* gv = (const float*)(p.ws + OFF_GV);
  const ushort_t* u2b = (const ushort_t*)(p.ws + OFF_U2B);
  const char* tabu = (const char*)(p.ws + OFF_TABU);
  const float* su = (const float*)(p.ws + OFF_SU);
  const float* sv = (const float*)(p.ws + OFF_SV);
  float* coef = (float*)(p.ws + OFF_COEF);
  const int tq = tid_opaque(); const int lane = tq & 63, wave = tq >> 6;
  const int g = lane >> 4, j = lane & 15;
  int4* lst = (int4*)smem + wave * 512 + g * 128;
  const int part = blockIdx.x & 7, bi = blockIdx.x >> 3, nb = (gridDim.x - part + 7) >> 3;
  __syncthreads();
#pragma unroll 1
  for (int tb = (bi * 8 + wave) * 4; tb < T_; tb += nb * 32) {
    const int tok = tb + g;
    const int4 i0 = *(const int4*)(idx + (size_t)tb * 128 + lane * 8), i1 = *(const int4*)(idx + (size_t)tb * 128 + lane * 8 + 4);
    const f32x4 g0 = *(const f32x4*)(gv + (size_t)tb * 128 + lane * 8), g1 = *(const f32x4*)(gv + (size_t)tb * 128 + lane * 8 + 4);
    u32x4 xr[8];
#pragma unroll
    for (int c = 0; c < 4; ++c) {
      xr[2 * c] = *(const u32x4*)(u2b + (size_t)tok * 1024 + (j + 16 * c) * 16);
      xr[2 * c + 1] = *(const u32x4*)(u2b + (size_t)tok * 1024 + (j + 16 * c) * 16 + 8);
    }
    const int ev[8] = {i0.x, i0.y, i0.z, i0.w, i1.x, i1.y, i1.z, i1.w};
    const float gg[8] = {g0[0], g0[1], g0[2], g0[3], g1[0], g1[1], g1[2], g1[3]};
    int cnt = 0;
#pragma unroll
    for (int i = 0; i < 8; ++i) cnt += ((ev[i] >> 11) == part) ? 1 : 0;
    int incl = cnt;
    incl += dpp_shr0<0x111>(incl); incl += dpp_shr0<0x112>(incl); incl += dpp_shr0<0x114>(incl); incl += dpp_shr0<0x118>(incl);
    const int ng = bcast16<15>(incl);
    int pos = incl - cnt;
#pragma unroll
    for (int i = 0; i < 8; ++i)
      if ((ev[i] >> 11) == part) { int4 en; en.x = ev[i]; en.y = __float_as_int(gg[i]); en.z = j * 8 + i; en.w = 0; lst[pos] = en; ++pos; }
    const int nmax = max(max(__builtin_amdgcn_readlane(ng, 0), __builtin_amdgcn_readlane(ng, 16)), max(__builtin_amdgcn_readlane(ng, 32), __builtin_amdgcn_readlane(ng, 48)));
    __builtin_amdgcn_wave_barrier();
    asm volatile("s_waitcnt lgkmcnt(0)" ::: "memory");
    u32x4 ra[4], rb[4], rc[4], rd[4];
#define UP_LOAD(R, IT) { const unsigned e_ = ((IT) < ng) ? (unsigned)lst[(IT)].x : 0u; const char* row_ = tabu + (size_t)e_ * 1024 + j * 16; \
                         _Pragma("unroll") for (int c = 0; c < 4; ++c) R[c] = *(const u32x4*)(row_ + c * 256); }
#define UP_COMP(R, IT) { float a0 = 0.f, a1 = 0.f, a2 = 0.f, a3 = 0.f; \
      _Pragma("unroll") for (int c = 0; c < 4; ++c) { \
        a0 = dot4_fp8(R[c][0], xr[2 * c][0], xr[2 * c][1], a0); a1 = dot4_fp8(R[c][1], xr[2 * c][2], xr[2 * c][3], a1); \
        a2 = dot4_fp8(R[c][2], xr[2 * c + 1][0], xr[2 * c + 1][1], a2); a3 = dot4_fp8(R[c][3], xr[2 * c + 1][2], xr[2 * c + 1][3], a3); } \
      const float d_ = row_sum16((a0 + a1) + (a2 + a3)); \
      if (j == 0 && (IT) < ng) ((int*)&lst[(IT)])[3] = __float_as_int(d_); }
    UP_LOAD(ra, 0) UP_LOAD(rb, 1) UP_LOAD(rc, 2) UP_LOAD(rd, 3)
#pragma unroll 1
    for (int it = 0; it < nmax; it += 4) {
      UP_COMP(ra, it)     UP_LOAD(ra, it + 4)
      UP_COMP(rb, it + 1) UP_LOAD(rb, it + 5)
      UP_COMP(rc, it + 2) UP_LOAD(rc, it + 6)
      UP_COMP(rd, it + 3) UP_LOAD(rd, it + 7)
    }
#undef UP_LOAD
#undef UP_COMP
    __builtin_amdgcn_wave_barrier();
    asm volatile("s_waitcnt lgkmcnt(0)" ::: "memory");
#pragma unroll 1
    for (int k = 0; k < nmax; k += 16) {
      if (k + j < ng) {
        const int4 en = lst[k + j];
        const float a = __int_as_float(en.w) * su[en.x];
        coef[(size_t)tok * 128 + en.z] = __int_as_float(en.y) * 0.5f * a * (1.f + erff(a * 0.7071067811865475f)) * sv[en.x];
      }
    }
    __builtin_amdgcn_wave_barrier();
    asm volatile("s_waitcnt lgkmcnt(0)" ::: "memory");
  }
}

struct VHdr { int ea, eb, ca, cb; };
DI VHdr vp_hdr(const int* idx, const float* coef, int tok, int g, int cq) {
  VHdr h;
  h.ea = idx[(size_t)tok * 128 + g * 32 + cq]; h.eb = idx[(size_t)tok * 128 + g * 32 + 16 + cq];
  h.ca = __float_as_int(coef[(size_t)tok * 128 + g * 32 + cq]); h.cb = __float_as_int(coef[(size_t)tok * 128 + g * 32 + 16 + cq]);
  return h;
}
DI void vp_rows(uint2 (&va)[16], uint2 (&vb)[16], const VHdr& h, const char* tb) {
#define VP_STEP(I) { va[I] = *(const uint2*)(tb + (unsigned)bcast16<I>(h.ea) * 128u); vb[I] = *(const uint2*)(tb + (unsigned)bcast16<I>(h.eb) * 128u); }
  VP_STEP(0) VP_STEP(1) VP_STEP(2) VP_STEP(3) VP_STEP(4) VP_STEP(5) VP_STEP(6) VP_STEP(7)
  VP_STEP(8) VP_STEP(9) VP_STEP(10) VP_STEP(11) VP_STEP(12) VP_STEP(13) VP_STEP(14) VP_STEP(15)
#undef VP_STEP
}
DI void vp_coefs(float (&fa)[16], float (&fb)[16], const VHdr& h) {
#define VP_STEP(I) { fa[I] = __int_as_float(bcast16<I>(h.ca)); fb[I] = __int_as_float(bcast16<I>(h.cb)); }
  VP_STEP(0) VP_STEP(1) VP_STEP(2) VP_STEP(3) VP_STEP(4) VP_STEP(5) VP_STEP(6) VP_STEP(7)
  VP_STEP(8) VP_STEP(9) VP_STEP(10) VP_STEP(11) VP_STEP(12) VP_STEP(13) VP_STEP(14) VP_STEP(15)
#undef VP_STEP
}
DI void vp_fma8(float (&a)[8], float cf, const uint2& v) {
  const f32x2_hw p0 = __builtin_amdgcn_cvt_pk_f32_fp8((int)v.x, false), p1 = __builtin_amdgcn_cvt_pk_f32_fp8((int)v.x, true);
  const f32x2_hw p2 = __builtin_amdgcn_cvt_pk_f32_fp8((int)v.y, false), p3 = __builtin_amdgcn_cvt_pk_f32_fp8((int)v.y, true);
  a[0] += cf * p0[0]; a[1] += cf * p0[1]; a[2] += cf * p1[0]; a[3] += cf * p1[1];
  a[4] += cf * p2[0]; a[5] += cf * p2[1]; a[6] += cf * p3[0]; a[7] += cf * p3[1];
}
DI void vp_consume(const uint2 (&va)[16], const uint2 (&vb)[16], const VHdr& h, float* f, int tok, int slice, int g, int cq, bool live) {
  float fa[16], fb[16];
  vp_coefs(fa, fb, h);
  float a[8];
#pragma unroll
  for (int i = 0; i < 8; ++i) a[i] = 0.f;
#pragma unroll
  for (int i = 0; i < 16; ++i) { vp_fma8(a, fa[i], va[i]); vp_fma8(a, fb[i], vb[i]); }
#pragma unroll
  for (int i = 0; i < 8; ++i) { a[i] += __shfl_xor(a[i], 16); a[i] += __shfl_xor(a[i], 32); }
  if (g == 0 && live) {
    f32x4 o0, o1; o0[0] = a[0]; o0[1] = a[1]; o0[2] = a[2]; o0[3] = a[3]; o1[0] = a[4]; o1[1] = a[5]; o1[2] = a[6]; o1[3] = a[7];
    float* fp = f + (size_t)tok * 1024 + slice * 128 + cq * 8;
    *(f32x4*)fp = o0; *(f32x4*)(fp + 4) = o1;
  }
}
DI void phase_vpass(const P& p) {
  const int* idx = (const int*)(p.ws + OFF_IDX);
  const float* coef = (const float*)(p.ws + OFF_COEF);
  const char* tabv = (const char*)(p.ws + OFF_TABV);
  float* f = (float*)(p.ws + OFF_F);
  const int tq = tid_opaque(); const int lane = tq & 63, wave = tq >> 6;
  const int g = lane >> 4, cq = lane & 15;
  const int slice = blockIdx.x & 7, bi = blockIdx.x >> 3, nb = (gridDim.x - slice + 7) >> 3;
  const int step = nb * 8;
  const char* tb = tabv + (size_t)slice * (16384 * 128) + cq * 8;
  int tok = bi * 8 + wave;
  if (tok >= T_) return;
  VHdr h0 = vp_hdr(idx, coef, tok, g, cq);
  VHdr h1 = vp_hdr(idx, coef, min(tok + step, T_ - 1), g, cq);
  uint2 va[16], vb[16], na[16], nb2[16];
  vp_rows(va, vb, h0, tb);
#pragma unroll 1
  for (; tok < T_; tok += 2 * step) {
    const VHdr h2 = vp_hdr(idx, coef, min(tok + 2 * step, T_ - 1), g, cq);
    vp_rows(na, nb2, h1, tb);
    vp_consume(va, vb, h0, f, tok, slice, g, cq, true);
    const VHdr h3 = vp_hdr(idx, coef, min(tok + 3 * step, T_ - 1), g, cq);
    vp_rows(va, vb, h2, tb);
    vp_consume(na, nb2, h1, f, tok + step, slice, g, cq, tok + step < T_);
    h0 = h2; h1 = h3;
  }
}

DI void phase_ln2(const P& p) {
  const float* ada = (const float*)(p.ws + OFF_ADA);
  const float* f = (const float*)(p.ws + OFF_F);
  const int tq = tid_opaque(); const int lane = tq & 63, wave = tq >> 6;
  for (int tok = blockIdx.x * 8 + wave; tok < T_; tok += gridDim.x * 8) {
    const int b = tok / S_;
    float* rp = p.out + (size_t)tok * 1024;
    f32x4 acc[4];
    float sm = 0.f;
#pragma unroll
    for (int i = 0; i < 4; ++i) {
      const int col = i * 256 + lane * 4;
      f32x4 x1 = *(const f32x4*)(rp + col), ff = *(const f32x4*)(f + (size_t)tok * 1024 + col);
      f32x4 g2 = *(const f32x4*)(ada + b * 6144 + 5 * 1024 + col);
#pragma unroll
      for (int j = 0; j < 4; ++j) { acc[i][j] = DN_ALPHA * x1[j] + (1.f + g2[j]) * ff[j]; sm += acc[i][j]; }
    }
    const float mu = wave_sum(sm) * (1.f / 1024.f);
    float q = 0.f;
#pragma unroll
    for (int i = 0; i < 4; ++i)
#pragma unroll
      for (int j = 0; j < 4; ++j) { float d = acc[i][j] - mu; q += d * d; }
    const float rs = rsqrtf(wave_sum(q) * (1.f / 1024.f) + LN_EPS);
#pragma unroll
    for (int i = 0; i < 4; ++i) {
      const int col = i * 256 + lane * 4;
      f32x4 gg = *(const f32x4*)(p.ln2_g + col), bb = *(const f32x4*)(p.ln2_b + col), o;
#pragma unroll
      for (int j = 0; j < 4; ++j) o[j] = (acc[i][j] - mu) * rs * gg[j] + bb[j];
      *(f32x4*)(rp + col) = o;
    }
  }
}

#define XB_TMO      128
#define XB_XCNT(j)  (256  + 64 * (j))
#define XB_XSUB(j)  (1280 + 64 * (j))
#define XB_XGEN(j)  (2304 + 64 * (j))
#define XB_TOP      3328
#define XB_TOPGEN   3392
#define XCD_BAR_WORDS 3456
#define XB_SPIN_CAP (1u << 22)
#define LAS __attribute__((address_space(3)))
DI unsigned xb_ld(unsigned* p)              { return __hip_atomic_load(p, __ATOMIC_RELAXED, __HIP_MEMORY_SCOPE_AGENT); }
DI unsigned xb_add(unsigned* p, unsigned v) { return __hip_atomic_fetch_add(p, v, __ATOMIC_RELAXED, __HIP_MEMORY_SCOPE_AGENT); }
DI unsigned xb_xcc_id() { return (unsigned)__builtin_amdgcn_s_getreg((3 << 11) | 20) & 0xFu; }
#define XB_SPIN(cond, bar) do { unsigned _sp = 0; while (cond) { __builtin_amdgcn_s_sleep(1); \
    if ((++_sp & 255u) == 0u) { if (xb_ld(&(bar)[XB_TMO])) break; if (_sp > XB_SPIN_CAP) { atomicAdd(&(bar)[XB_TMO], 1u); break; } } } } while (0)
struct XcdBarrier { unsigned* bar; unsigned x; volatile LAS unsigned* st; };
DI XcdBarrier xcd_barrier_post(unsigned* bar, volatile LAS unsigned* st) {
  XcdBarrier b; b.bar = bar; b.x = xb_xcc_id(); b.st = st;
  if (threadIdx.x == 0) (void)xb_add(&bar[XB_XCNT(b.x)], 1u);
  return b;
}
DI void xcd_barrier_complete(unsigned* bar, unsigned x, unsigned& nloc, unsigned& nx) {
  const unsigned G = gridDim.x * gridDim.y * gridDim.z;
  unsigned sum, cnt, mine, sp = 0u;
  for (;;) {
    sum = 0u; cnt = 0u; mine = 0u;
#pragma unroll
    for (unsigned j = 0; j < 16; ++j) { const unsigned c = xb_ld(&bar[XB_XCNT(j)]); sum += c; cnt += (c > 0u) ? 1u : 0u; mine = (j == x) ? c : mine; }
    if (sum == G) break;
    __builtin_amdgcn_s_sleep(1);
    if ((++sp & 255u) == 0u) { if (xb_ld(&bar[XB_TMO])) break; if (sp > XB_SPIN_CAP) { atomicAdd(&bar[XB_TMO], 1u); break; } }
  }
  nloc = mine > 0u ? mine : 1u; nx = cnt > 0u ? cnt : 1u;
}
DI void xcd_barrier(unsigned* barp, char* stp) {
  asm volatile("s_waitcnt vmcnt(0)" ::: "memory");
  __syncthreads();
  if (threadIdx.x == 0) {
    XcdBarrier b; b.bar = barp; b.x = xb_xcc_id(); b.st = (volatile LAS unsigned*)stp;
    unsigned* bar = b.bar;
    __builtin_amdgcn_s_waitcnt(0);
    unsigned nloc = b.st[0], nx = b.st[1];
    if (nloc == 0u) { xcd_barrier_complete(bar, b.x, nloc, nx); b.st[0] = nloc; b.st[1] = nx; }
    const unsigned old = xb_add(&bar[XB_XSUB(b.x)], 1u);
    const unsigned gen = old / nloc;
    if (old + 1u == (gen + 1u) * nloc) {
      __builtin_amdgcn_fence(__ATOMIC_RELEASE, "agent");
      asm volatile("s_waitcnt vmcnt(0)" ::: "memory");
      const unsigned og = xb_add(&bar[XB_TOP], 1u);
      const unsigned tg = og / nx;
      if (og + 1u == (tg + 1u) * nx) xb_add(&bar[XB_TOPGEN], 1u);
      else XB_SPIN(xb_ld(&bar[XB_TOPGEN]) == tg, bar);
      __builtin_amdgcn_fence(__ATOMIC_ACQUIRE, "agent");
      xb_add(&bar[XB_XGEN(b.x)], 1u);
      asm volatile("s_waitcnt vmcnt(0)" ::: "memory");
    } else {
      XB_SPIN(xb_ld(&bar[XB_XGEN(b.x)]) == gen, bar);
      __builtin_amdgcn_fence(__ATOMIC_ACQUIRE, "agent");
      asm volatile("s_waitcnt vmcnt(0)" ::: "memory");
    }
  }
  __syncthreads();
}

constexpr int SMEM_BYTES = 143360;
__global__ void __launch_bounds__(NT) fwd_megakernel(P p) {
  __shared__ __attribute__((aligned(16))) char smem[SMEM_BYTES + 16];
  if (threadIdx.x < 4) ((volatile LAS unsigned*)(smem + SMEM_BYTES))[threadIdx.x] = 0u;
  __syncthreads();
  (void)xcd_barrier_post((unsigned*)(p.ws + OFF_BAR), (volatile LAS unsigned*)(smem + SMEM_BYTES));
  phase_ada(p, smem);
  xcd_barrier((unsigned*)(p.ws + OFF_BAR), smem + SMEM_BYTES);
  phase_u1(p);
  phase_transposes(p, smem);
  phase_keys(p);
  phase_rope(p);
  phase_filter(p, smem);
  xcd_barrier((unsigned*)(p.ws + OFF_BAR), smem + SMEM_BYTES);
  phase_inproj(p, smem);
  xcd_barrier((unsigned*)(p.ws + OFF_BAR), smem + SMEM_BYTES);
  for (int item = blockIdx.x; item < 512 + 256; item += gridDim.x) {
    if (item < 512) hyena_item(p, smem, item);
    else attn_item(p, smem, item - 512);
  }
  xcd_barrier((unsigned*)(p.ws + OFF_BAR), smem + SMEM_BYTES);
  phase_merge(p, smem);
  xcd_barrier((unsigned*)(p.ws + OFF_BAR), smem + SMEM_BYTES);
  phase_outproj(p, smem);
  xcd_barrier((unsigned*)(p.ws + OFF_BAR), smem + SMEM_BYTES);
  phase_ln1(p);
  phase_tabconv(p);
  xcd_barrier((unsigned*)(p.ws + OFF_BAR), smem + SMEM_BYTES);
  phase_route(p, smem);
  xcd_barrier((unsigned*)(p.ws + OFF_BAR), smem + SMEM_BYTES);
  phase_upass(p, smem);
  xcd_barrier((unsigned*)(p.ws + OFF_BAR), smem + SMEM_BYTES);
  phase_vpass(p);
  xcd_barrier((unsigned*)(p.ws + OFF_BAR), smem + SMEM_BYTES);
  phase_ln2(p);
}

extern "C" void kernel_launch(void* const* d_in, const int* in_sizes, int n_in, void* d_out, int out_size, void* d_ws, size_t ws_size,
                              hipStream_t stream) {
  P p{};
  p.x = (const float*)d_in[0]; p.c = (const float*)d_in[1]; p.pos = (const int*)d_in[2];
  p.w_ada = (const float*)d_in[3]; p.b_ada = (const float*)d_in[4]; p.w_in = (const float*)d_in[5];
  p.hy_conv_w = (const float*)d_in[6]; p.hy_conv_b = (const float*)d_in[7];
  p.f1_w = (const float*)d_in[8]; p.f1_b = (const float*)d_in[9]; p.f1_freq = (const float*)d_in[10];
  p.f2_w = (const float*)d_in[11]; p.f2_b = (const float*)d_in[12]; p.f2_freq = (const float*)d_in[13];
  p.f3_w = (const float*)d_in[14]; p.hy_bias = (const float*)d_in[15];
  p.w_bh = (const float*)d_in[16]; p.w_ba = (const float*)d_in[17]; p.w_out = (const float*)d_in[18];
  p.ln1_g = (const float*)d_in[19]; p.ln1_b = (const float*)d_in[20];
  p.wq = (const float*)d_in[21]; p.keys = (const float*)d_in[22]; p.pu = (const float*)d_in[23]; p.pv = (const float*)d_in[24];
  p.ln2_g = (const float*)d_in[25]; p.ln2_b = (const float*)d_in[26];
  p.out = (float*)d_out; p.ws = (char*)d_ws;

  static int grid_blocks = 0;
  if (!grid_blocks) {
    int dev = 0, cus = 0, per_cu = 0;
    hipGetDevice(&dev);
    hipDeviceGetAttribute(&cus, hipDeviceAttributeMultiprocessorCount, dev);
    hipOccupancyMaxActiveBlocksPerMultiprocessor(&per_cu, fwd_megakernel, NT, 0);
    if (per_cu > 1) per_cu = 1;
    grid_blocks = cus * per_cu;
  }
  (void)hipMemsetAsync((char*)d_ws + OFF_BAR, 0, XCD_BAR_WORDS * 4, stream);
  void* args[] = {&p};
  hipError_t e = hipLaunchCooperativeKernel((void*)fwd_megakernel, dim3(grid_blocks), dim3(NT), args, 0, stream);
  if (e != hipSuccess) fprintf(stderr, "cooperative launch failed: %s (grid %d)\n", hipGetErrorString(e), grid_blocks);
}
```

```cpp
#include <hip/hip_runtime.h>
#include <hip/hip_cooperative_groups.h>
#include <cstdio>
#include <cstdint>

#define DI __device__ __forceinline__
typedef unsigned short ushort_t;
typedef __attribute__((ext_vector_type(8))) short bf16x8;
typedef __attribute__((ext_vector_type(16))) float f32x16;
typedef __attribute__((ext_vector_type(4))) float f32x4;
typedef __attribute__((ext_vector_type(4))) unsigned u32x4;

constexpr int T_ = 16384, S_ = 8192, NB = 2, D_ = 1024;
constexpr int HW_ = 512, HYC = 1536, QKVC = 2304, GATEC = 2048, INW = 5888;
constexpr int NT = 512;
constexpr float DN_ALPHA = 1.189207115002721f;
constexpr float LN_EPS = 1e-5f;

constexpr size_t OFF_ADA   = 0;
constexpr size_t OFF_BAR   = 49152;
constexpr size_t OFF_KEYS_B= 65536;
constexpr size_t OFF_WIN_T = 65536 + 524288;
constexpr size_t OFF_WQ_T  = OFF_WIN_T + (size_t)INW * 1024 * 2;
constexpr size_t OFF_WOUT_T= OFF_WQ_T + (size_t)2048 * 1024 * 2;
constexpr size_t OFF_WBH_T = OFF_WOUT_T + (size_t)1024 * 1024 * 2;
constexpr size_t OFF_WBA_T = OFF_WBH_T + (size_t)1024 * 512 * 2;
constexpr size_t OFF_PH    = OFF_WBA_T + (size_t)1024 * 256 * 2;
constexpr size_t OFF_QKV   = OFF_PH + (size_t)T_ * HYC * 2;
constexpr size_t OFF_GATE  = OFF_QKV + (size_t)T_ * QKVC * 2;
constexpr size_t OFF_YH    = OFF_GATE + (size_t)T_ * GATEC * 2;
constexpr size_t OFF_YA    = OFF_YH + (size_t)T_ * HW_ * 2;
constexpr size_t OFF_END   = OFF_YA + (size_t)T_ * 256 * 2;
constexpr size_t OFF_MERGED= OFF_PH;
constexpr size_t OFF_U1B   = OFF_YH;
static_assert(OFF_U1B + (size_t)T_ * 1024 * 2 <= 268435456ull, "u1b overflow");
constexpr size_t OFF_U2B   = OFF_PH;
constexpr size_t OFF_TABU  = OFF_QKV;
constexpr size_t OFF_TABV  = OFF_QKV + (size_t)16 * 1048576;
constexpr size_t OFF_SU    = OFF_QKV + (size_t)32 * 1048576;
constexpr size_t OFF_SV    = OFF_SU + 65536;
constexpr size_t OFF_COEF  = OFF_QKV + (size_t)64 * 1048576;
constexpr size_t OFF_F     = OFF_QKV + (size_t)72 * 1048576;
static_assert(OFF_F + (size_t)64 * 1048576 <= OFF_YH, "peer buffers overflow the qkv+gate region");
constexpr size_t OFF_IDX   = OFF_YH;
constexpr size_t OFF_GV    = OFF_YH + (size_t)T_ * 128 * 4;
constexpr size_t OFF_HSCR  = OFF_END;
static_assert(OFF_HSCR + (size_t)164 * 131072 <= 268435456ull, "ws overflow");
static_assert((size_t)92 * 131072 <= (size_t)INW * 1024 * 2, "w_in^T region too small");
constexpr size_t OFF_ROPE  = OFF_HSCR + (size_t)164 * 131072;
static_assert(OFF_ROPE + (size_t)T_ * 64 <= 268435456ull, "rope table overflow");

struct P {
  const float *x, *c; const int* pos;
  const float *w_ada, *b_ada, *w_in, *hy_conv_w, *hy_conv_b, *f1_w, *f1_b, *f1_freq, *f2_w, *f2_b, *f2_freq, *f3_w,
      *hy_bias, *w_bh, *w_ba, *w_out, *ln1_g, *ln1_b, *wq, *keys, *pu, *pv, *ln2_g, *ln2_b;
  float* out; char* ws;
};

DI ushort_t f2bf(float x) { unsigned u = __float_as_uint(x); u += 0x7fffu + ((u >> 16) & 1u); return (ushort_t)(u >> 16); }
DI float bf2f(ushort_t h) { return __uint_as_float(((unsigned)h) << 16); }
typedef __bf16 bf16x2_hw __attribute__((ext_vector_type(2)));
typedef float f32x2_hw __attribute__((ext_vector_type(2)));
DI unsigned pack2(float a, float b) { f32x2_hw v = {a, b}; return __builtin_bit_cast(unsigned, __builtin_convertvector(v, bf16x2_hw)); }
DI int tid_opaque() { int t = threadIdx.x; asm volatile("" : "+v"(t)); return t; }
DI float wave_sum(float v) {
#pragma unroll
  for (int o = 32; o > 0; o >>= 1) v += __shfl_xor(v, o);
  return v;
}

struct cf2 { float x, y; };
constexpr int FFT_N = 16384, FFT_SA = 560;

DI constexpr float wcos32(int j) {
  switch (j & 31) {
    case 0: return 1.0f; case 1: return 0.98078528040323043f; case 2: return 0.92387953251128674f; case 3: return 0.83146961230254524f;
    case 4: return 0.70710678118654752f; case 5: return 0.55557023301960218f; case 6: return 0.38268343236508978f; case 7: return 0.19509032201612825f;
    case 8: return 0.0f; case 9: return -0.19509032201612825f; case 10: return -0.38268343236508978f; case 11: return -0.55557023301960218f;
    case 12: return -0.70710678118654752f; case 13: return -0.83146961230254524f; case 14: return -0.92387953251128674f; case 15: return -0.98078528040323043f;
    case 16: return -1.0f; case 17: return -0.98078528040323043f; case 18: return -0.92387953251128674f; case 19: return -0.83146961230254524f;
    case 20: return -0.70710678118654752f; case 21: return -0.55557023301960218f; case 22: return -0.38268343236508978f; case 23: return -0.19509032201612825f;
    case 24: return 0.0f; case 25: return 0.19509032201612825f; case 26: return 0.38268343236508978f; case 27: return 0.55557023301960218f;
    case 28: return 0.70710678118654752f; case 29: return 0.83146961230254524f; case 30: return 0.92387953251128674f; default: return 0.98078528040323043f;
  }
}
DI constexpr float wsin32(int j) { return wcos32(j + 24); }
DI constexpr int brev(int v, int bits) { int r = 0; for (int i = 0; i < bits; ++i) r |= ((v >> i) & 1) << (bits - 1 - i); return r; }

template <int R, int LEN, bool INV, bool ZHI>
DI void r2_stage(float (&re)[R], float (&im)[R]) {
  constexpr int half = LEN / 2;
#pragma unroll
  for (int start = 0; start < R; start += LEN) {
#pragma unroll
    for (int j = 0; j < half; ++j) {
      const int a = start + j, b = a + half;
      const int tj = j * (32 / LEN);
      const float c = wcos32(tj), s = wsin32(tj);
      if (!INV) {
        float dr, di;
        if (ZHI) { dr = re[a]; di = im[a]; }
        else {
          const float ar = re[a], ai = im[a], br = re[b], bi = im[b];
          re[a] = ar + br; im[a] = ai + bi; dr = ar - br; di = ai - bi;
        }
        if (tj == 0) { re[b] = dr; im[b] = di; }
        else if (tj == 8) { re[b] = di; im[b] = -dr; }
        else { re[b] = dr * c + di * s; im[b] = di * c - dr * s; }
      } else {
        const float br = re[b], bi = im[b];
        float pr, pi;
        if (tj == 0) { pr = br; pi = bi; }
        else if (tj == 8) { pr = -bi; pi = br; }
        else { pr = br * c - bi * s; pi = bi * c + br * s; }
        const float ar = re[a], ai = im[a];
        re[a] = ar + pr; im[a] = ai + pi; re[b] = ar - pr; im[b] = ai - pi;
      }
    }
  }
}
template <int R, bool ZHI> DI void dft_fwd(float (&re)[R], float (&im)[R]) {
  if (R == 32) r2_stage<R, (R == 32 ? 32 : 2), false, ZHI>(re, im);
  r2_stage<R, 16, false, (R == 16) && ZHI>(re, im);
  r2_stage<R, 8, false, false>(re, im);
  r2_stage<R, 4, false, false>(re, im);
  r2_stage<R, 2, false, false>(re, im);
}
template <int R> DI void dft_inv(float (&re)[R], float (&im)[R]) {
  r2_stage<R, 2, true, false>(re, im);
  r2_stage<R, 4, true, false>(re, im);
  r2_stage<R, 8, true, false>(re, im);
  r2_stage<R, 16, true, false>(re, im);
  if (R == 32) r2_stage<R, (R == 32 ? 32 : 2), true, false>(re, im);
}

DI void sincos_turn(float frac, float& s, float& c) { sincospif(2.0f * frac, &s, &c); }

template <bool ZHI>
DI void fft_fwdA(float (&re)[32], float (&im)[32], cf2* lds, int m) {
  asm volatile("" : "+v"(m));
  float s1, c1; sincos_turn((float)m * (1.0f / 16384.0f), s1, c1);
  __builtin_amdgcn_sched_barrier(0);
  dft_fwd<32, ZHI>(re, im);
  __builtin_amdgcn_sched_barrier(0);
  float wr = 1.f, wi = 0.f;
#pragma unroll
  for (int k1 = 0; k1 < 32; ++k1) {
    if ((k1 & 3) == 0) __builtin_amdgcn_sched_barrier(0);
    const int r = brev(k1, 5);
    cf2 o; o.x = re[r] * wr - im[r] * wi; o.y = re[r] * wi + im[r] * wr;
    lds[k1 * FFT_SA + m] = o;
    const float nr = wr * c1 + wi * s1, ni = wi * c1 - wr * s1;
    wr = nr; wi = ni;
  }
}
DI void fft_B_read(float (&re)[32], float (&im)[32], const cf2* lds, int tid) {
  const int k1 = tid >> 4, mp = tid & 15;
#pragma unroll
  for (int n2 = 0; n2 < 32; ++n2) { cf2 v = lds[k1 * FFT_SA + n2 * 16 + mp]; re[n2] = v.x; im[n2] = v.y; }
}
DI void fft_fwdB_write(float (&re)[32], float (&im)[32], cf2* lds, int tid) {
  asm volatile("" : "+v"(tid));
  const int k1 = tid >> 4, mp = tid & 15;
  float s1, c1; sincos_turn((float)mp * (1.0f / 512.0f), s1, c1);
  __builtin_amdgcn_sched_barrier(0);
  dft_fwd<32, false>(re, im);
  __builtin_amdgcn_sched_barrier(0);
  float wr = 1.f, wi = 0.f;
#pragma unroll
  for (int k2 = 0; k2 < 32; ++k2) {
    if ((k2 & 3) == 0) __builtin_amdgcn_sched_barrier(0);
    const int r = brev(k2, 5);
    cf2 o; o.x = re[r] * wr - im[r] * wi; o.y = re[r] * wi + im[r] * wr;
    lds[k1 * FFT_SA + k2 * 17 + mp] = o;
    const float nr = wr * c1 + wi * s1, ni = wi * c1 - wr * s1;
    wr = nr; wi = ni;
  }
}
DI void fft_fwdC(float (&re)[32], float (&im)[32], const cf2* lds, int tid) {
  const int k1 = tid >> 5, k2 = tid & 31;
#pragma unroll
  for (int h = 0; h < 2; ++h) {
    float tr[16], ti[16];
#pragma unroll
    for (int mp = 0; mp < 16; ++mp) { cf2 v = lds[(k1 + 16 * h) * FFT_SA + k2 * 17 + mp]; tr[mp] = v.x; ti[mp] = v.y; }
    dft_fwd<16, false>(tr, ti);
#pragma unroll
    for (int i = 0; i < 16; ++i) { re[h * 16 + i] = tr[i]; im[h * 16 + i] = ti[i]; }
  }
}
DI void fft_invC(float (&re)[32], float (&im)[32], cf2* lds, int tid) {
  const int k1 = tid >> 5, k2 = tid & 31;
#pragma unroll
  for (int h = 0; h < 2; ++h) {
    float tr[16], ti[16];
#pragma unroll
    for (int i = 0; i < 16; ++i) { tr[i] = re[h * 16 + i]; ti[i] = im[h * 16 + i]; }
    dft_inv<16>(tr, ti);
#pragma unroll
    for (int mp = 0; mp < 16; ++mp) { cf2 o; o.x = tr[mp]; o.y = ti[mp]; lds[(k1 + 16 * h) * FFT_SA + k2 * 17 + mp] = o; }
  }
}
DI void fft_invB_read(float (&re)[32], float (&im)[32], const cf2* lds, int tid) {
  asm volatile("" : "+v"(tid));
  const int k1 = tid >> 4, mp = tid & 15;
  float s1, c1; sincos_turn((float)mp * (1.0f / 512.0f), s1, c1);
  float wr = 1.f, wi = 0.f;
  __builtin_amdgcn_sched_barrier(0);
#pragma unroll
  for (int k2 = 0; k2 < 32; ++k2) {
    if ((k2 & 3) == 0) __builtin_amdgcn_sched_barrier(0);
    const int r = brev(k2, 5);
    cf2 v = lds[k1 * FFT_SA + k2 * 17 + mp];
    re[r] = v.x * wr - v.y * wi; im[r] = v.x * wi + v.y * wr;
    const float nr = wr * c1 - wi * s1, ni = wi * c1 + wr * s1;
    wr = nr; wi = ni;
  }
}
DI void fft_invB_write(float (&re)[32], float (&im)[32], cf2* lds, int tid) {
  const int k1 = tid >> 4, mp = tid & 15;
  dft_inv<32>(re, im);
#pragma unroll
  for (int n2 = 0; n2 < 32; ++n2) { cf2 o; o.x = re[n2]; o.y = im[n2]; lds[k1 * FFT_SA + n2 * 16 + mp] = o; }
}
DI void fft_invA(float (&re)[32], float (&im)[32], const cf2* lds, int m) {
  asm volatile("" : "+v"(m));
  float s1, c1; sincos_turn((float)m * (1.0f / 16384.0f), s1, c1);
  float wr = 1.f, wi = 0.f;
  __builtin_amdgcn_sched_barrier(0);
#pragma unroll
  for (int k1 = 0; k1 < 32; ++k1) {
    if ((k1 & 3) == 0) __builtin_amdgcn_sched_barrier(0);
    const int r = brev(k1, 5);
    cf2 v = lds[k1 * FFT_SA + m];
    re[r] = v.x * wr - v.y * wi; im[r] = v.x * wi + v.y * wr;
    const float nr = wr * c1 - wi * s1, ni = wi * c1 + wr * s1;
    wr = nr; wi = ni;
  }
  __builtin_amdgcn_sched_barrier(0);
  dft_inv<32>(re, im);
}

DI void phase_ada(const P& p, char* smem) {
  float (*red)[16][32] = (float (*)[16][32])smem;
  const int tid = tid_opaque(), cl = tid & 31, kq = tid >> 5;
  for (int item = blockIdx.x; item < 192; item += gridDim.x) {
    const int col = item * 32 + cl;
    float a0 = 0.f, a1 = 0.f;
#pragma unroll 16
    for (int k = kq * 64; k < kq * 64 + 64; ++k) {
      const float w = p.w_ada[(size_t)k * 6144 + col];
      const float c0 = p.c[k], c1 = p.c[1024 + k];
      a0 += (c0 / (1.f + __expf(-c0))) * w;
      a1 += (c1 / (1.f + __expf(-c1))) * w;
    }
    __syncthreads();
    red[0][kq][cl] = a0; red[1][kq][cl] = a1;
    __syncthreads();
    if (tid < 64) {
      const int b = tid >> 5;
      float s = p.b_ada[col];
#pragma unroll
      for (int q = 0; q < 16; ++q) s += red[b][q][cl];
      ((float*)(p.ws + OFF_ADA))[b * 6144 + col] = s;
    }
  }
}
DI void phase_u1(const P& p) {
  const float* ada = (const float*)(p.ws + OFF_ADA);
  ushort_t* u1b = (ushort_t*)(p.ws + OFF_U1B);
  for (int i = blockIdx.x * NT + tid_opaque(); i < T_ * 128; i += gridDim.x * NT) {
    const int row = i >> 7, k = (i & 127) * 8, b = row / S_;
    const float* xp = p.x + (size_t)row * 1024 + k;
    const f32x4 x0 = *(const f32x4*)xp, x1 = *(const f32x4*)(xp + 4);
    const f32x4 s0 = *(const f32x4*)(ada + b * 6144 + 1024 + k), s1 = *(const f32x4*)(ada + b * 6144 + 1024 + k + 4);
    const f32x4 h0 = *(const f32x4*)(ada + b * 6144 + k), h1 = *(const f32x4*)(ada + b * 6144 + k + 4);
    u32x4 o;
    o[0] = pack2(x0[0] * (1.f + s0[0]) + h0[0], x0[1] * (1.f + s0[1]) + h0[1]);
    o[1] = pack2(x0[2] * (1.f + s0[2]) + h0[2], x0[3] * (1.f + s0[3]) + h0[3]);
    o[2] = pack2(x1[0] * (1.f + s1[0]) + h1[0], x1[1] * (1.f + s1[1]) + h1[1]);
    o[3] = pack2(x1[2] * (1.f + s1[2]) + h1[2], x1[3] * (1.f + s1[3]) + h1[3]);
    *(u32x4*)(u1b + (size_t)row * 1024 + k) = o;
  }
}

DI void transpose_tile(const float* __restrict__ W, ushort_t* __restrict__ Wt, int K, int N, int item, char* smem) {
  float (*tile)[65] = (float (*)[65])smem;
  const int ntn = N / 64;
  const int n0 = (item % ntn) * 64, k0 = (item / ntn) * 32;
  const int tid = tid_opaque();
  __syncthreads();
  {
    const int tx = tid & 63, ty = tid >> 6;
#pragma unroll
    for (int i = 0; i < 4; ++i) tile[ty + 8 * i][tx] = W[(size_t)(k0 + ty + 8 * i) * N + n0 + tx];
  }
  __syncthreads();
  {
    const int kk = tid & 31, nn0 = tid >> 5;
#pragma unroll
    for (int i = 0; i < 4; ++i) Wt[(size_t)(n0 + nn0 + 16 * i) * K + k0 + kk] = f2bf(tile[kk][nn0 + 16 * i]);
  }
}
DI void phase_transposes(const P& p, char* smem) {
  constexpr int I0 = (INW / 64) * 32, I1 = I0 + 32 * 32, I2 = I1 + 16 * 32, I3 = I2 + 16 * 16, I4 = I3 + 16 * 8;
  for (int item = blockIdx.x; item < I4; item += gridDim.x) {
    if (item < I0) transpose_tile(p.w_in, (ushort_t*)(p.ws + OFF_WIN_T), 1024, INW, item, smem);
    else if (item < I1) transpose_tile(p.wq, (ushort_t*)(p.ws + OFF_WQ_T), 1024, 2048, item - I0, smem);
    else if (item < I2) transpose_tile(p.w_out, (ushort_t*)(p.ws + OFF_WOUT_T), 1024, 1024, item - I1, smem);
    else if (item < I3) transpose_tile(p.w_bh, (ushort_t*)(p.ws + OFF_WBH_T), 512, 1024, item - I2, smem);
    else transpose_tile(p.w_ba, (ushort_t*)(p.ws + OFF_WBA_T), 256, 1024, item - I3, smem);
  }
}

DI void phase_filter(const P& p, char* smem) {
  float (*zf)[33] = (float (*)[33])smem;
  float (*h1)[64] = (float (*)[64])(smem + 4352);
  float (*h2T)[32] = (float (*)[32])(smem + 4352 + 8192);
  const int tid = tid_opaque();
  for (int item = blockIdx.x; item < 256; item += gridDim.x) {
  const int t0 = item * 32;
  __syncthreads();
  for (int idx = tid; idx < 32 * 33; idx += NT) {
    int tt = idx / 33, e = idx % 33, t = t0 + tt;
    float tl = (float)t * (1.0f / 8191.0f);
    float w = 6.283185307179586f * (float)t / 8192.0f;
    float val;
    if (e == 0) val = tl;
    else {
      int i = (e - 1) & 15;
      float f = 1e-4f + (float)i * ((15.0f - 1e-4f) / 15.0f);
      val = (e <= 16) ? cosf(f * w) : -sinf(f * w);
    }
    zf[tt][e] = val;
  }
  __syncthreads();
  for (int idx = tid; idx < 32 * 64; idx += NT) {
    int tt = idx >> 6, j = idx & 63;
    float a = p.f1_b[j];
    for (int e = 0; e < 33; ++e) a += zf[tt][e] * p.f1_w[e * 64 + j];
    h1[tt][j] = sinf(p.f1_freq[j] * a);
  }
  __syncthreads();
  for (int idx = tid; idx < 32 * 64; idx += NT) {
    int tt = idx >> 6, j = idx & 63;
    float a = p.f2_b[j];
    for (int e = 0; e < 64; ++e) a += h1[tt][e] * p.f2_w[e * 64 + j];
    h2T[j][tt] = sinf(p.f2_freq[j] * a);
  }
  __syncthreads();
  float* filt = p.out;
  const float min_decay = -3.0701134573253945f, max_decay = -15.350567286626973f;
  for (int col = tid; col < 2048; col += NT) {
    float acc[32];
#pragma unroll
    for (int i = 0; i < 32; ++i) acc[i] = 0.f;
    for (int j = 0; j < 64; ++j) {
      float w = p.f3_w[j * 2048 + col];
#pragma unroll
      for (int q = 0; q < 8; ++q) {
        f32x4 h = *(const f32x4*)&h2T[j][q * 4];
        acc[q * 4 + 0] += h[0] * w; acc[q * 4 + 1] += h[1] * w; acc[q * 4 + 2] += h[2] * w; acc[q * 4 + 3] += h[3] * w;
      }
    }
    int c = col & 511;
    float delta = fabsf(min_decay + (float)c * ((max_decay - min_decay) / 511.0f));
    float* dst = filt + (size_t)col * 8192 + t0;
#pragma unroll
    for (int q = 0; q < 8; ++q) {
      f32x4 o;
#pragma unroll
      for (int r = 0; r < 4; ++r) {
        float tl = (float)(t0 + q * 4 + r) * (1.0f / 8191.0f);
        o[r] = acc[q * 4 + r] * __expf(-tl * delta);
      }
      *(f32x4*)(dst + q * 4) = o;
    }
  }
  }
}

constexpr int BM = 256, BN = 128, BK = 64;
constexpr int LDS_A = BM * BK * 2, LDS_B = BN * BK * 2, LDS_STAGE = LDS_A + LDS_B;
constexpr int GEMM_LDS = 2 * LDS_STAGE + 8192;

DI int swz(int row, int ch) { return row * 128 + ((ch ^ (row & 7)) << 4); }

struct ALoadBf16 {
  const ushort_t* A; int lda;
  struct Raw { u32x4 v; };
  DI Raw fetch(int row, int k) const { Raw r; r.v = *(const u32x4*)(A + (size_t)row * lda + k); return r; }
  DI u32x4 cvt(const Raw& r, int k) const { return r.v; }
};
struct ALoadF32Mod {
  const float* A; const float* mod;
  struct Raw { f32x4 a, b; };
  DI Raw fetch(int row, int k) const { Raw r; const float* s = A + (size_t)row * 1024 + k; r.a = *(const f32x4*)s; r.b = *(const f32x4*)(s + 4); return r; }
  DI u32x4 cvt(const Raw& r, int k) const {
    f32x4 s0 = *(const f32x4*)(mod + k), s1 = *(const f32x4*)(mod + k + 4);
    f32x4 h0 = *(const f32x4*)(mod + 1024 + k), h1 = *(const f32x4*)(mod + 1024 + k + 4);
    u32x4 o;
    o[0] = pack2(r.a[0] * s0[0] + h0[0], r.a[1] * s0[1] + h0[1]);
    o[1] = pack2(r.a[2] * s0[2] + h0[2], r.a[3] * s0[3] + h0[3]);
    o[2] = pack2(r.b[0] * s1[0] + h1[0], r.b[1] * s1[1] + h1[1]);
    o[3] = pack2(r.b[2] * s1[2] + h1[2], r.b[3] * s1[3] + h1[3]);
    return o;
  }
};

template <class AL, bool SWAP = false>
DI void gemm_mainloop(f32x16 (&acc)[2][2], const AL& al, int m0, const ushort_t* __restrict__ Bt, int ldb, int n0, int K, char* smem) {
  const int tid = tid_opaque(), lane = tid & 63, wave = tid >> 6;
  const int wm = wave >> 1, wn = wave & 1;
  const int lr = tid >> 3, lc = tid & 7;
  typename AL::Raw ra[4]; u32x4 rb[2];
  const int nk = K / BK;
#pragma unroll
  for (int i = 0; i < 4; ++i) ra[i] = al.fetch(m0 + lr + 64 * i, lc * 8);
#pragma unroll
  for (int i = 0; i < 2; ++i) rb[i] = *(const u32x4*)(Bt + (size_t)(n0 + lr + 64 * i) * ldb + lc * 8);
  __syncthreads();
#pragma unroll
  for (int i = 0; i < 4; ++i) *(u32x4*)(smem + swz(lr + 64 * i, lc)) = al.cvt(ra[i], lc * 8);
#pragma unroll
  for (int i = 0; i < 2; ++i) *(u32x4*)(smem + LDS_A + swz(lr + 64 * i, lc)) = rb[i];
  __syncthreads();
  for (int kt = 0; kt < nk; ++kt) {
    char* cur = smem + (kt & 1) * LDS_STAGE;
    char* nxt = smem + ((kt + 1) & 1) * LDS_STAGE;
    const bool more = (kt + 1 < nk);
    const int kn = (kt + 1) * BK + lc * 8;
    if (more) {
#pragma unroll
      for (int i = 0; i < 4; ++i) ra[i] = al.fetch(m0 + lr + 64 * i, kn);
#pragma unroll
      for (int i = 0; i < 2; ++i) rb[i] = *(const u32x4*)(Bt + (size_t)(n0 + lr + 64 * i) * ldb + kn);
    }
#pragma unroll
    for (int s = 0; s < 4; ++s) {
      const int ch = 2 * s + (lane >> 5);
      bf16x8 af[2], bfr[2];
#pragma unroll
      for (int mi = 0; mi < 2; ++mi) af[mi] = *(const bf16x8*)(cur + swz(wm * 64 + mi * 32 + (lane & 31), ch));
#pragma unroll
      for (int ni = 0; ni < 2; ++ni) bfr[ni] = *(const bf16x8*)(cur + LDS_A + swz(wn * 64 + ni * 32 + (lane & 31), ch));
#pragma unroll
      for (int mi = 0; mi < 2; ++mi)
#pragma unroll
        for (int ni = 0; ni < 2; ++ni)
          acc[mi][ni] = SWAP ? __builtin_amdgcn_mfma_f32_32x32x16_bf16(bfr[ni], af[mi], acc[mi][ni], 0, 0, 0)
                             : __builtin_amdgcn_mfma_f32_32x32x16_bf16(af[mi], bfr[ni], acc[mi][ni], 0, 0, 0);
    }
    if (more) {
#pragma unroll
      for (int i = 0; i < 4; ++i) *(u32x4*)(nxt + swz(lr + 64 * i, lc)) = al.cvt(ra[i], kn);
#pragma unroll
      for (int i = 0; i < 2; ++i) *(u32x4*)(nxt + LDS_A + swz(lr + 64 * i, lc)) = rb[i];
    }
    __syncthreads();
  }
}

constexpr int AT_ROW = 576;
constexpr int LDS_AT = 64 * AT_ROW;
constexpr int LDS_STAGE_T = LDS_AT + LDS_B;
typedef __attribute__((ext_vector_type(4))) short s16x4;
DI void gemm_mainloop_AT(f32x16 (&acc)[2][2], const ushort_t* __restrict__ At, size_t ldt, const ushort_t* __restrict__ Bt, int ldb, int n0, int K, char* smem) {
  const int tid = tid_opaque(), lane = tid & 63, wave = tid >> 6;
  const int wm = wave >> 1, wn = wave & 1;
  const int lr = tid >> 3, lc = tid & 7;
  u32x4 ra[4], rb[2];
  const int nk = K / BK;
#pragma unroll
  for (int i = 0; i < 4; ++i) { const int q = tid + 512 * i; ra[i] = *(const u32x4*)(At + (size_t)(q >> 5) * ldt + (q & 31) * 8); }
#pragma unroll
  for (int i = 0; i < 2; ++i) rb[i] = *(const u32x4*)(Bt + (size_t)(n0 + lr + 64 * i) * ldb + lc * 8);
  __syncthreads();
#pragma unroll
  for (int i = 0; i < 4; ++i) { const int q = tid + 512 * i; *(u32x4*)(smem + (q >> 5) * AT_ROW + (q & 31) * 16) = ra[i]; }
#pragma unroll
  for (int i = 0; i < 2; ++i) *(u32x4*)(smem + LDS_AT + swz(lr + 64 * i, lc)) = rb[i];
  __syncthreads();
  const int hh = lane >> 5, gg = (lane >> 4) & 1, qq = (lane & 15) >> 2, pp = lane & 3;
  for (int kt = 0; kt < nk; ++kt) {
    char* cur = smem + (kt & 1) * LDS_STAGE_T;
    char* nxt = smem + ((kt + 1) & 1) * LDS_STAGE_T;
    const bool more = (kt + 1 < nk);
    if (more) {
#pragma unroll
      for (int i = 0; i < 4; ++i) { const int q = tid + 512 * i; ra[i] = *(const u32x4*)(At + (size_t)((kt + 1) * BK + (q >> 5)) * ldt + (q & 31) * 8); }
#pragma unroll
      for (int i = 0; i < 2; ++i) rb[i] = *(const u32x4*)(Bt + (size_t)(n0 + lr + 64 * i) * ldb + (kt + 1) * BK + lc * 8);
    }
#pragma unroll
    for (int s = 0; s < 4; ++s) {
      const int ch = 2 * s + hh;
      bf16x8 af[2], bfr[2];
#pragma unroll
      for (int mi = 0; mi < 2; ++mi) {
        const char* a0 = cur + (16 * s + 8 * hh + qq) * AT_ROW + (wm * 64 + mi * 32 + 16 * gg + 4 * pp) * 2;
        s16x4 lo = __builtin_amdgcn_ds_read_tr16_b64_v4i16((__attribute__((address_space(3))) s16x4*)(a0));
        s16x4 hi = __builtin_amdgcn_ds_read_tr16_b64_v4i16((__attribute__((address_space(3))) s16x4*)(a0 + 4 * AT_ROW));
        af[mi] = __builtin_shufflevector(lo, hi, 0, 1, 2, 3, 4, 5, 6, 7);
      }
#pragma unroll
      for (int ni = 0; ni < 2; ++ni) bfr[ni] = *(const bf16x8*)(cur + LDS_AT + swz(wn * 64 + ni * 32 + (lane & 31), ch));
#pragma unroll
      for (int mi = 0; mi < 2; ++mi)
#pragma unroll
        for (int ni = 0; ni < 2; ++ni) acc[mi][ni] = __builtin_amdgcn_mfma_f32_32x32x16_bf16(af[mi], bfr[ni], acc[mi][ni], 0, 0, 0);
    }
    if (more) {
#pragma unroll
      for (int i = 0; i < 4; ++i) { const int q = tid + 512 * i; *(u32x4*)(nxt + (q >> 5) * AT_ROW + (q & 31) * 16) = ra[i]; }
#pragma unroll
      for (int i = 0; i < 2; ++i) *(u32x4*)(nxt + LDS_AT + swz(lr + 64 * i, lc)) = rb[i];
    }
    __syncthreads();
  }
}

constexpr int G2_A = 32768, G2_STAGE = 65536;
template <bool SWAP>
DI void gemm256(f32x16 (&acc)[4][2], const ushort_t* __restrict__ A, int lda, int m0, const ushort_t* __restrict__ Bt, int ldb, int n0, int K, char* smem) {
  const int tid = tid_opaque(), lane = tid & 63, wave = tid >> 6;
  const int wm = wave >> 2, wn = wave & 3;
  const int lr = tid >> 3, lc = tid & 7;
  u32x4 ra[4], rb[4];
  const int nk = K / BK;
  const ushort_t* ap = A + (size_t)(m0 + lr) * lda + lc * 8;
  const ushort_t* bp = Bt + (size_t)(n0 + lr) * ldb + lc * 8;
#pragma unroll
  for (int i = 0; i < 4; ++i) { ra[i] = *(const u32x4*)(ap + (size_t)(64 * i) * lda); rb[i] = *(const u32x4*)(bp + (size_t)(64 * i) * ldb); }
  __syncthreads();
#pragma unroll
  for (int i = 0; i < 4; ++i) { *(u32x4*)(smem + swz(lr + 64 * i, lc)) = ra[i]; *(u32x4*)(smem + G2_A + swz(lr + 64 * i, lc)) = rb[i]; }
  __syncthreads();
  for (int kt = 0; kt < nk; ++kt) {
    char* cur = smem + (kt & 1) * G2_STAGE;
    char* nxt = smem + ((kt + 1) & 1) * G2_STAGE;
    const bool more = (kt + 1 < nk);
    if (more) {
#pragma unroll
      for (int i = 0; i < 4; ++i) { ra[i] = *(const u32x4*)(ap + (size_t)(64 * i) * lda + (kt + 1) * BK); rb[i] = *(const u32x4*)(bp + (size_t)(64 * i) * ldb + (kt + 1) * BK); }
    }
#pragma unroll
    for (int s = 0; s < 4; ++s) {
      const int ch = 2 * s + (lane >> 5);
      bf16x8 af[4], bfr[2];
#pragma unroll
      for (int mi = 0; mi < 4; ++mi) af[mi] = *(const bf16x8*)(cur + swz(wm * 128 + mi * 32 + (lane & 31), ch));
#pragma unroll
      for (int ni = 0; ni < 2; ++ni) bfr[ni] = *(const bf16x8*)(cur + G2_A + swz(wn * 64 + ni * 32 + (lane & 31), ch));
#pragma unroll
      for (int mi = 0; mi < 4; ++mi)
#pragma unroll
        for (int ni = 0; ni < 2; ++ni)
          acc[mi][ni] = SWAP ? __builtin_amdgcn_mfma_f32_32x32x16_bf16(bfr[ni], af[mi], acc[mi][ni], 0, 0, 0)
                             : __builtin_amdgcn_mfma_f32_32x32x16_bf16(af[mi], bfr[ni], acc[mi][ni], 0, 0, 0);
      if (s & 1) __builtin_amdgcn_sched_barrier(0);
    }
    if (more) {
#pragma unroll
      for (int i = 0; i < 4; ++i) { *(u32x4*)(nxt + swz(lr + 64 * i, lc)) = ra[i]; *(u32x4*)(nxt + G2_A + swz(lr + 64 * i, lc)) = rb[i]; }
    }
    __syncthreads();
  }
}
constexpr int G2T_A = 64 * 576, G2T_STAGE = G2T_A + 32768;
DI void gemm256_AT(f32x16 (&acc)[4][2], const ushort_t* __restrict__ At, size_t ldt, const ushort_t* __restrict__ Bt, int ldb, int n0, int K, char* smem) {
  const int tid = tid_opaque(), lane = tid & 63, wave = tid >> 6;
  const int wm = wave >> 2, wn = wave & 3;
  const int lr = tid >> 3, lc = tid & 7;
  u32x4 ra[4], rb[4];
  const int nk = K / BK;
  const ushort_t* bp = Bt + (size_t)(n0 + lr) * ldb + lc * 8;
#pragma unroll
  for (int i = 0; i < 4; ++i) { const int q = tid + 512 * i; ra[i] = *(const u32x4*)(At + (size_t)(q >> 5) * ldt + (q & 31) * 8); rb[i] = *(const u32x4*)(bp + (size_t)(64 * i) * ldb); }
  __syncthreads();
#pragma unroll
  for (int i = 0; i < 4; ++i) { const int q = tid + 512 * i; *(u32x4*)(smem + (q >> 5) * 576 + (q & 31) * 16) = ra[i]; *(u32x4*)(smem + G2T_A + swz(lr + 64 * i, lc)) = rb[i]; }
  __syncthreads();
  const int hh = lane >> 5, gg = (lane >> 4) & 1, qq = (lane & 15) >> 2, pp = lane & 3;
  for (int kt = 0; kt < nk; ++kt) {
    char* cur = smem + (kt & 1) * G2T_STAGE;
    char* nxt = smem + ((kt + 1) & 1) * G2T_STAGE;
    const bool more = (kt + 1 < nk);
    if (more) {
#pragma unroll
      for (int i = 0; i < 4; ++i) { const int q = tid + 512 * i; ra[i] = *(const u32x4*)(At + (size_t)((kt + 1) * BK + (q >> 5)) * ldt + (q & 31) * 8); rb[i] = *(const u32x4*)(bp + (size_t)(64 * i) * ldb + (kt + 1) * BK); }
    }
#pragma unroll
    for (int s = 0; s < 4; ++s) {
      const int ch = 2 * s + hh;
      bf16x8 af[4], bfr[2];
#pragma unroll
      for (int mi = 0; mi < 4; ++mi) {
        const char* a0 = cur + (16 * s + 8 * hh + qq) * 576 + (wm * 128 + mi * 32 + 16 * gg + 4 * pp) * 2;
        s16x4 lo = __builtin_amdgcn_ds_read_tr16_b64_v4i16((__attribute__((address_space(3))) s16x4*)(a0));
        s16x4 hi = __builtin_amdgcn_ds_read_tr16_b64_v4i16((__attribute__((address_space(3))) s16x4*)(a0 + 4 * 576));
        af[mi] = __builtin_shufflevector(lo, hi, 0, 1, 2, 3, 4, 5, 6, 7);
      }
#pragma unroll
      for (int ni = 0; ni < 2; ++ni) bfr[ni] = *(const bf16x8*)(cur + G2T_A + swz(wn * 64 + ni * 32 + (lane & 31), ch));
#pragma unroll
      for (int mi = 0; mi < 4; ++mi)
#pragma unroll
        for (int ni = 0; ni < 2; ++ni) acc[mi][ni] = __builtin_amdgcn_mfma_f32_32x32x16_bf16(af[mi], bfr[ni], acc[mi][ni], 0, 0, 0);
      if (s & 1) __builtin_amdgcn_sched_barrier(0);
    }
    if (more) {
#pragma unroll
      for (int i = 0; i < 4; ++i) { const int q = tid + 512 * i; *(u32x4*)(nxt + (q >> 5) * 576 + (q & 31) * 16) = ra[i]; *(u32x4*)(nxt + G2T_A + swz(lr + 64 * i, lc)) = rb[i]; }
    }
    __syncthreads();
  }
}
DI void acc_zero4(f32x16 (&acc)[4][2]) {
#pragma unroll
  for (int a = 0; a < 4; ++a)
#pragma unroll
    for (int b = 0; b < 2; ++b)
#pragma unroll
      for (int r = 0; r < 16; ++r) acc[a][b][r] = 0.f;
}
DI void acc_zero(f32x16 (&acc)[2][2]) {
#pragma unroll
  for (int a = 0; a < 2; ++a)
#pragma unroll
    for (int b = 0; b < 2; ++b)
#pragma unroll
      for (int r = 0; r < 16; ++r) acc[a][b][r] = 0.f;
}
#define ACC_ROW(mi, r) (wm * 64 + (mi) * 32 + ((r) & 3) + 8 * ((r) >> 2) + 4 * (lane >> 5))
#define ACC_COL(ni) (wn * 64 + (ni) * 32 + (lane & 31))

DI void stage_mod(float* mod, const float* ada, int b, int sc_chunk, int sh_chunk) {
  for (int i = tid_opaque(); i < 1024; i += NT) {
    mod[i] = 1.f + ada[b * 6144 + sc_chunk * 1024 + i];
    mod[1024 + i] = ada[b * 6144 + sh_chunk * 1024 + i];
  }
}


namespace pg8 {
#define PG8_LAS __attribute__((address_space(3)))
constexpr int BM8 = 256, BK8 = 64, HALF = 128, HTB = HALF * BK8 * 2, STAGE_BYTES = 8 * HTB, NXCD = 8, WGM = 8;
DI int lds_byte(int r, int c) { const int st = (r >> 4) * 2 + (c >> 5), rr = r & 15, cc = c & 31, ob = rr * 64 + cc * 2; return st * 1024 + (ob ^ (((ob >> 9) & 1) << 5)); }
DI void stage_rc(int b, int& R, int& C) { const int st = b / 1024, sb = b % 1024, sw = sb ^ (((sb >> 9) & 1) << 5); R = (st >> 1) * 16 + sw / 64; C = (st & 1) * 32 + (sw % 64) / 2; }
DI int perm32(int rho) { const int n = rho >> 4, i = rho & 15; return 8 * (i >> 2) + 4 * n + (i & 3); }
struct Unit { int pm, pn, kind; };
DI void tile_order(int L, int nM, int nN, int& pm, int& pn) {
  const int nwg = nM * nN;
  int wgid = L; { const int q = nwg / NXCD, r = nwg % NXCD, xcd = wgid % NXCD, off = wgid / NXCD; wgid = (xcd < r ? xcd * (q + 1) : r * (q + 1) + (xcd - r) * q) + off; }
  const int nig = WGM * nN, gid = wgid / nig, fm = gid * WGM, gsz = (nM - fm) < WGM ? (nM - fm) : WGM;
  pm = fm + ((wgid % nig) % gsz); pn = (wgid % nig) / gsz;
}
typedef float f32x4p __attribute__((ext_vector_type(4)));
template <class Epi, class Sched>
DI void gemm_phase(PG8_LAS unsigned char* lds, const int K, const Sched& S, const Epi& E) {
    const int tid = threadIdx.x, wid = __builtin_amdgcn_readfirstlane(tid >> 6), lane = tid & 63, wr = wid >> 2, wc = wid & 3, fr = lane & 15, fq = lane >> 4;
    const int nt = K / BK8;
    unsigned voffA[2], voffB[2];
#pragma unroll
    for (int i = 0; i < 2; ++i) { int R, C; stage_rc(tid * 16 + i * 8192, R, C); const int Rb = Epi::PERM ? ((R & ~31) + perm32(R & 31)) : R;
        voffA[i] = (unsigned)(R * K + C) * 2u; voffB[i] = (unsigned)(Rb * K + C) * 2u; }
    const size_t kstep = (size_t)(BK8 * 2);
    const size_t hstep = (size_t)HALF * K * 2;
    const unsigned ldsw = (unsigned)wid * 1024u;
    const int aoff = lds_byte(wr * 64 + fr, fq * 8), boff = lds_byte(wc * 32 + fr, fq * 8);
#define PG8_SA(b, h) (((b) * 2 + (h)) * HTB)
#define PG8_SB(b, h) ((4 + (b) * 2 + (h)) * HTB)
#define PG8_STAGE(bufoff, gbase, voff) do { _Pragma("unroll") for (int _i = 0; _i < 2; ++_i) \
        __builtin_amdgcn_global_load_lds((const unsigned*)((const char*)(gbase) + (voff)[_i]), (PG8_LAS unsigned*)(lds + (bufoff) + ldsw + _i * 8192), 16, 0, 0); } while (0)
#define PG8_LDA(dst, b, h) do { _Pragma("unroll") for (int m = 0; m < 4; ++m) _Pragma("unroll") for (int k = 0; k < 2; ++k) dst[m][k] = *(const PG8_LAS bf16x8*)(lds + PG8_SA(b, h) + aoff + m * 2048 + k * 1024); } while (0)
#define PG8_LDB(dst, b, h) do { _Pragma("unroll") for (int n = 0; n < 2; ++n) _Pragma("unroll") for (int k = 0; k < 2; ++k) dst[n][k] = *(const PG8_LAS bf16x8*)(lds + PG8_SB(b, h) + boff + n * 2048 + k * 1024); } while (0)
#define PG8_MMA(ai, bj, At, Bt) do { __builtin_amdgcn_s_setprio(1); _Pragma("unroll") for (int m = 0; m < 4; ++m) _Pragma("unroll") for (int n = 0; n < 2; ++n) _Pragma("unroll") for (int k = 0; k < 2; ++k) \
        acc[ai][bj][m][n] = __builtin_amdgcn_mfma_f32_16x16x32_bf16(Bt[n][k], At[m][k], acc[ai][bj][m][n], 0, 0, 0); __builtin_amdgcn_s_setprio(0); } while (0)
#define PG8_WAIT_V(n) asm volatile("s_waitcnt vmcnt(" #n ")" ::: "memory")
#define PG8_WAIT_L(n) asm volatile("s_waitcnt lgkmcnt(" #n ")" ::: "memory")
#define PG8_BAR __builtin_amdgcn_s_barrier()
#define PG8_SCHED __builtin_amdgcn_sched_barrier(0)
    Unit cur, nxt; int ui = 0;
    if (!S.next(0, cur)) return;
    f32x4p acc[2][2][4][2];
#pragma unroll
    for (int a = 0; a < 2; ++a)
#pragma unroll
        for (int b = 0; b < 2; ++b)
#pragma unroll
            for (int m = 0; m < 4; ++m)
#pragma unroll
                for (int n = 0; n < 2; ++n) acc[a][b][m][n] = (f32x4p){0.f, 0.f, 0.f, 0.f};
    bf16x8 At[4][2], B0[2][2], B1[2][2];
    const char* cA = S.a_ptr(cur); const char* cB = S.b_ptr(cur);
    PG8_STAGE(PG8_SB(0, 0), cB, voffB); PG8_STAGE(PG8_SA(0, 0), cA, voffA); PG8_STAGE(PG8_SB(0, 1), cB + hstep, voffB); PG8_STAGE(PG8_SA(0, 1), cA + hstep, voffA);
    if (wr == 1) PG8_BAR;
    PG8_WAIT_V(4); PG8_BAR;
    PG8_STAGE(PG8_SB(1, 0), cB + kstep, voffB); PG8_STAGE(PG8_SA(1, 0), cA + kstep, voffA); PG8_STAGE(PG8_SB(1, 1), cB + hstep + kstep, voffB);
    PG8_WAIT_V(6); PG8_BAR;
    for (;;) {
        const bool has_next = S.next(ui + 1, nxt);
        const char* nA = has_next ? S.a_ptr(nxt) : cA; const char* nB = has_next ? S.b_ptr(nxt) : cB;
        for (int t = 0; t < nt; t += 2) {
            const bool last = (t == nt - 2);
            const char* a1 = cA + (size_t)(t + 1) * kstep;
            const char* a2 = last ? nA : cA + (size_t)(t + 2) * kstep; const char* b2 = last ? nB : cB + (size_t)(t + 2) * kstep;
            const char* a3 = a2 + kstep; const char* b3 = b2 + kstep;
            PG8_LDB(B0, 0, 0); PG8_SCHED; PG8_LDA(At, 0, 0); PG8_STAGE(PG8_SA(1, 1), a1 + hstep, voffA);
            PG8_WAIT_L(8); PG8_BAR; PG8_WAIT_L(0); PG8_MMA(0, 0, At, B0); PG8_BAR; PG8_SCHED;
            PG8_LDB(B1, 0, 1); PG8_STAGE(PG8_SB(0, 0), b2, voffB);
            PG8_BAR; PG8_WAIT_L(0); PG8_MMA(0, 1, At, B1); PG8_BAR;
            PG8_LDA(At, 0, 1); PG8_STAGE(PG8_SA(0, 0), a2, voffA);
            PG8_BAR; PG8_WAIT_L(0); PG8_MMA(1, 0, At, B0); PG8_BAR; PG8_SCHED;
            PG8_STAGE(PG8_SB(0, 1), b2 + hstep, voffB);
            PG8_WAIT_V(6); PG8_BAR; PG8_MMA(1, 1, At, B1); PG8_BAR;
            PG8_LDB(B0, 1, 0); PG8_SCHED; PG8_LDA(At, 1, 0); PG8_STAGE(PG8_SA(0, 1), a2 + hstep, voffA);
            PG8_WAIT_L(8); PG8_BAR; PG8_WAIT_L(0); PG8_MMA(0, 0, At, B0); PG8_BAR; PG8_SCHED;
            PG8_LDB(B1, 1, 1); PG8_STAGE(PG8_SB(1, 0), b3, voffB);
            PG8_BAR; PG8_WAIT_L(0); PG8_MMA(0, 1, At, B1); PG8_BAR;
            PG8_LDA(At, 1, 1); PG8_STAGE(PG8_SA(1, 0), a3, voffA);
            PG8_BAR; PG8_WAIT_L(0); PG8_MMA(1, 0, At, B0); PG8_BAR; PG8_SCHED;
            PG8_STAGE(PG8_SB(1, 1), b3 + hstep, voffB);
            PG8_WAIT_V(6); PG8_BAR; PG8_MMA(1, 1, At, B1); PG8_BAR;
        }
        if constexpr (!Epi::AFTER_DRAIN) E(acc, cur, wr, wc, fr, fq);
        if (!has_next) break;
#pragma unroll
        for (int a = 0; a < 2; ++a)
#pragma unroll
            for (int b = 0; b < 2; ++b)
#pragma unroll
                for (int m = 0; m < 4; ++m)
#pragma unroll
                    for (int n = 0; n < 2; ++n) acc[a][b][m][n] = (f32x4p){0.f, 0.f, 0.f, 0.f};
        cur = nxt; cA = nA; cB = nB; ++ui;
    }
    PG8_WAIT_V(0);
    if (wr == 0) PG8_BAR;
    PG8_BAR;
    if constexpr (Epi::AFTER_DRAIN) E.fused(acc, cur, wr, wc, fr, fq, lds, wid, lane);
#undef PG8_SA
#undef PG8_SB
#undef PG8_STAGE
#undef PG8_LDA
#undef PG8_LDB
#undef PG8_MMA
#undef PG8_WAIT_V
#undef PG8_WAIT_L
#undef PG8_BAR
#undef PG8_SCHED
}
}
typedef pg8::f32x4p f32x4p;
DI u32x4 pack8(const f32x4p& a, const f32x4p& b) { u32x4 w; w[0] = pack2(a[0], a[1]); w[1] = pack2(a[2], a[3]); w[2] = pack2(b[0], b[1]); w[3] = pack2(b[2], b[3]); return w; }

struct InprojSched {
  const char* u1b; const char* wt; int G, c;
  DI bool next(int i, pg8::Unit& u) const {
    const int L = i * G + c;
    if (L >= 384 + 1088) return false;
    if (L < 384) { u.kind = 0; pg8::tile_order(L, 6, 64, u.pm, u.pn); } else { u.kind = 1; pg8::tile_order(L - 384, 64, 17, u.pm, u.pn); }
    return true;
  }
  DI const char* a_ptr(const pg8::Unit& u) const { return u.kind == 0 ? wt + (size_t)u.pm * (256 * 1024 * 2) : u1b + (size_t)u.pm * (256 * 1024 * 2); }
  DI const char* b_ptr(const pg8::Unit& u) const { return u.kind == 0 ? u1b + (size_t)u.pn * (256 * 1024 * 2) : wt + (size_t)(1536 + u.pn * 256) * (1024 * 2); }
};
struct InprojEpi {
  static constexpr bool PERM = true, AFTER_DRAIN = false;
  ushort_t* ph; ushort_t* qkv; ushort_t* gate; const float* rope;
  DI void operator()(const f32x4p (&acc)[2][2][4][2], const pg8::Unit& u, int wr, int wc, int fr, int fq) const {
    if (u.kind == 0) {
      const int b = (u.pn * 256) >> 13;
      ushort_t* base = ph + ((size_t)(b * HYC + u.pm * 256 + wr * 64 + fr)) * S_ + ((u.pn * 256) & (S_ - 1)) + wc * 32 + 8 * fq;
#pragma unroll
      for (int ai = 0; ai < 2; ++ai)
#pragma unroll
        for (int m = 0; m < 4; ++m)
#pragma unroll
          for (int bj = 0; bj < 2; ++bj) *(u32x4*)(base + (size_t)(ai * 128 + m * 16) * S_ + bj * 128) = pack8(acc[ai][bj][m][0], acc[ai][bj][m][1]);
      return;
    }
    const int row0 = u.pm * 256 + wr * 64 + fr;
    if (u.pn < 9) {
      const int cq0 = u.pn * 256 + wc * 32 + 8 * fq;
      const bool rotw = (u.pn < 6) && ((wc & 1) == 0);
      const float qs = (u.pn < 3) ? 0.125f : 1.0f;
#pragma unroll
      for (int ai = 0; ai < 2; ++ai)
#pragma unroll
        for (int m = 0; m < 4; ++m) {
          const int row = row0 + ai * 128 + m * 16;
          f32x4p cs[4];
          if (rotw) {
#pragma unroll
            for (int q = 0; q < 4; ++q) cs[q] = *(const f32x4p*)(rope + (size_t)row * 16 + q * 4);
          }
#pragma unroll
          for (int bj = 0; bj < 2; ++bj) {
            f32x4p v0 = acc[ai][bj][m][0], v1 = acc[ai][bj][m][1];
            if (rotw) {
              f32x4p o0, o1;
#pragma unroll
              for (int j = 0; j < 4; ++j) { o0[j] = __shfl_xor(v0[j], 16); o1[j] = __shfl_xor(v1[j], 16); }
              if (fq < 2) {
                const float sg = (fq == 0) ? -1.f : 1.f;
#pragma unroll
                for (int j = 0; j < 4; ++j) {
                  const float c0 = cs[j >> 1][(j & 1) * 2], s0 = cs[j >> 1][(j & 1) * 2 + 1];
                  const float c1 = cs[2 + (j >> 1)][(j & 1) * 2], s1 = cs[2 + (j >> 1)][(j & 1) * 2 + 1];
                  v0[j] = v0[j] * c0 + sg * o0[j] * s0;
                  v1[j] = v1[j] * c1 + sg * o1[j] * s1;
                }
              }
            }
            *(u32x4*)(qkv + (size_t)row * QKVC + cq0 + bj * 128) = pack8(v0 * qs, v1 * qs);
          }
        }
    } else {
      const int cg0 = (u.pn - 9) * 256 + wc * 32 + 8 * fq;
#pragma unroll
      for (int ai = 0; ai < 2; ++ai)
#pragma unroll
        for (int m = 0; m < 4; ++m)
#pragma unroll
          for (int bj = 0; bj < 2; ++bj) {
            f32x4p v0 = acc[ai][bj][m][0], v1 = acc[ai][bj][m][1];
#pragma unroll
            for (int j = 0; j < 4; ++j) { v0[j] = 1.f / (1.f + __expf(-v0[j])); v1[j] = 1.f / (1.f + __expf(-v1[j])); }
            *(u32x4*)(gate + (size_t)(row0 + ai * 128 + m * 16) * GATEC + cg0 + bj * 128) = pack8(v0, v1);
          }
    }
  }
};
DI void phase_inproj(const P& p, char* smem) {
  InprojSched S{p.ws + OFF_U1B, p.ws + OFF_WIN_T, (int)gridDim.x, (int)blockIdx.x};
  InprojEpi E{(ushort_t*)(p.ws + OFF_PH), (ushort_t*)(p.ws + OFF_QKV), (ushort_t*)(p.ws + OFF_GATE), (const float*)(p.ws + OFF_ROPE)};
  pg8::gemm_phase(( __attribute__((address_space(3))) unsigned char*)smem, 1024, S, E);
}
struct PlainSched {
  const char* A; const char* Bt; int nM, nN, K, G, c;
  DI bool next(int i, pg8::Unit& u) const { const int L = i * G + c; if (L >= nM * nN) return false; u.kind = 0; pg8::tile_order(L, nM, nN, u.pm, u.pn); return true; }
  DI const char* a_ptr(const pg8::Unit& u) const { return A + (size_t)u.pm * 256 * K * 2; }
  DI const char* b_ptr(const pg8::Unit& u) const { return Bt + (size_t)u.pn * 256 * K * 2; }
};
struct OutprojEpi {
  static constexpr bool PERM = false, AFTER_DRAIN = false;
  const float* x; float* out; const float* ada;
  DI void operator()(const f32x4p (&acc)[2][2][4][2], const pg8::Unit& u, int wr, int wc, int fr, int fq) const {
    const int row0 = u.pm * 256 + wr * 64 + fr, col0 = u.pn * 256 + wc * 32 + 4 * fq, b = (u.pm * 256) / S_;
    f32x4p g1[2][2];
#pragma unroll
    for (int bj = 0; bj < 2; ++bj)
#pragma unroll
      for (int n = 0; n < 2; ++n) g1[bj][n] = *(const f32x4p*)(ada + b * 6144 + 2 * 1024 + col0 + bj * 128 + n * 16) + 1.0f;
#pragma unroll
    for (int ai = 0; ai < 2; ++ai)
#pragma unroll
      for (int m = 0; m < 4; ++m) {
        const size_t ro = (size_t)(row0 + ai * 128 + m * 16) * 1024 + col0;
#pragma unroll
        for (int bj = 0; bj < 2; ++bj)
#pragma unroll
          for (int n = 0; n < 2; ++n) {
            const f32x4p xv = *(const f32x4p*)(x + ro + bj * 128 + n * 16);
            *(f32x4p*)(out + ro + bj * 128 + n * 16) = xv * DN_ALPHA + g1[bj][n] * acc[ai][bj][m][n];
          }
      }
  }
};
DI void phase_outproj(const P& p, char* smem) {
  PlainSched S{p.ws + OFF_MERGED, p.ws + OFF_WOUT_T, 64, 4, 1024, (int)gridDim.x, (int)blockIdx.x};
  OutprojEpi E{p.x, p.out, (const float*)(p.ws + OFF_ADA)};
  pg8::gemm_phase(( __attribute__((address_space(3))) unsigned char*)smem, 1024, S, E);
}

DI float sconv_t(const ushort_t* row, int t, float w0, float w1, float w2, float cb) {
  float v = cb + w1 * bf2f(row[t]);
  if (t > 0) v += w0 * bf2f(row[t - 1]);
  if (t < S_ - 1) v += w2 * bf2f(row[t + 1]);
  return v;
}
DI void fft_C_mul_invC(cf2* lds, const cf2* __restrict__ kq, int tid) {
  asm volatile("" : "+v"(tid));
  const int k1 = tid >> 5, k2 = tid & 31;
  kq += tid;
#pragma unroll
  for (int h = 0; h < 2; ++h) {
    float tr[16], ti[16];
    cf2 kv[16];
#pragma unroll
    for (int i = 0; i < 16; ++i) kv[i] = kq[(h * 16 + i) * 512];
    cf2* blk = lds + (k1 + 16 * h) * FFT_SA + k2 * 17;
#pragma unroll
    for (int mp = 0; mp < 16; ++mp) { cf2 v = blk[mp]; tr[mp] = v.x; ti[mp] = v.y; }
    dft_fwd<16, false>(tr, ti);
#pragma unroll
    for (int i = 0; i < 16; ++i) { const float a = tr[i], b = ti[i]; tr[i] = a * kv[i].x - b * kv[i].y; ti[i] = a * kv[i].y + b * kv[i].x; }
    dft_inv<16>(tr, ti);
#pragma unroll
    for (int mp = 0; mp < 16; ++mp) { cf2 o; o.x = tr[mp]; o.y = ti[mp]; blk[mp] = o; }
  }
}
DI void hyena_item(const P& p, char* smem, int c) {
  cf2* lds = (cf2*)smem;
  const ushort_t* pht = (const ushort_t*)(p.ws + OFF_PH);
  ushort_t* yht = (ushort_t*)(p.ws + OFF_YH);
  cf2* kq = (cf2*)(p.ws + (blockIdx.x < 92 ? OFF_WIN_T + (size_t)blockIdx.x * 131072 : OFF_HSCR + (size_t)(blockIdx.x - 92) * 131072));
  const float* filt = p.out;
  const int tid0 = tid_opaque();
  float zr[32], zi[32];
  __syncthreads();
#pragma unroll 1
  for (int o = 0; o < 2; ++o) {
    int tid = tid0; asm volatile("" : "+v"(tid));
    {
      float kr[32], ki[32];
      const float* fw = filt + (size_t)(0 * 1024 + o * 512 + c) * S_;
      const float* bw = filt + (size_t)(1 * 1024 + o * 512 + c) * S_;
      const float bias = p.hy_bias[o * 512 + c];
#pragma unroll
      for (int n1 = 0; n1 < 16; ++n1) { kr[n1] = fw[n1 * 512 + tid] * (1.0f / 16384.0f); ki[n1] = 0.f; }
      if (tid == 0) kr[0] += bias * (1.0f / 16384.0f);
#pragma unroll
      for (int n1 = 16; n1 < 32; ++n1) {
        const int n = n1 * 512 + tid;
        kr[n1] = (n == S_) ? 0.f : bw[2 * S_ - n] * (1.0f / 16384.0f); ki[n1] = 0.f;
      }
      fft_fwdA<false>(kr, ki, lds, tid); __syncthreads();
      fft_B_read(kr, ki, lds, tid); __syncthreads();
      fft_fwdB_write(kr, ki, lds, tid); __syncthreads();
      fft_fwdC(kr, ki, lds, tid);
      int ts = tid; asm volatile("" : "+v"(ts));
      cf2* kqt = kq + ts;
#pragma unroll
      for (int r = 0; r < 32; ++r) { cf2 v; v.x = kr[r]; v.y = ki[r]; kqt[r * 512] = v; }
      __syncthreads();
    }
    asm volatile("" : "+v"(tid));
    if (o == 0) {
      const float w0 = p.hy_conv_w[c], w1 = p.hy_conv_w[HYC + c], w2 = p.hy_conv_w[2 * HYC + c], cb = p.hy_conv_b[c];
      const ushort_t* r0 = pht + (size_t)(0 * HYC + c) * S_;
      const ushort_t* r1 = pht + (size_t)(1 * HYC + c) * S_;
#pragma unroll
      for (int n1 = 0; n1 < 16; ++n1) {
        const int t = n1 * 512 + tid;
        zr[n1] = sconv_t(r0, t, w0, w1, w2, cb); zi[n1] = sconv_t(r1, t, w0, w1, w2, cb);
        if (n1 & 1) asm volatile("" ::: "memory");
      }
    }
#pragma unroll
    for (int n1 = 16; n1 < 32; ++n1) { zr[n1] = 0.f; zi[n1] = 0.f; }
    fft_fwdA<true>(zr, zi, lds, tid); __syncthreads();
    fft_B_read(zr, zi, lds, tid); __syncthreads();
    fft_fwdB_write(zr, zi, lds, tid); __syncthreads();
    fft_C_mul_invC(lds, kq, tid); __syncthreads();
    fft_invB_read(zr, zi, lds, tid); __syncthreads();
    fft_invB_write(zr, zi, lds, tid); __syncthreads();
    fft_invA(zr, zi, lds, tid);
    int tg = tid; asm volatile("" : "+v"(tg));
    const int gch = (o + 1) * 512 + c;
    const float w0 = p.hy_conv_w[gch], w1 = p.hy_conv_w[HYC + gch], w2 = p.hy_conv_w[2 * HYC + gch], cb = p.hy_conv_b[gch];
    const ushort_t* g0 = pht + (size_t)(0 * HYC + gch) * S_;
    const ushort_t* g1 = pht + (size_t)(1 * HYC + gch) * S_;
#pragma unroll
    for (int n1 = 0; n1 < 16; ++n1) {
      const int t = n1 * 512 + tg;
      zr[n1] *= sconv_t(g0, t, w0, w1, w2, cb);
      zi[n1] *= sconv_t(g1, t, w0, w1, w2, cb);
      if (n1 & 1) asm volatile("" ::: "memory");
    }
    if (o == 1) {
#pragma unroll
      for (int n1 = 0; n1 < 16; ++n1) {
        const int t = n1 * 512 + tg;
        yht[(size_t)(0 * HW_ + c) * S_ + t] = f2bf(zr[n1]);
        yht[(size_t)(1 * HW_ + c) * S_ + t] = f2bf(zi[n1]);
      }
    }
  }
}

constexpr int ATT_VROW = 192;
constexpr int ATT_VBUF = 32 * ATT_VROW;
DI void attn_item(const P& p, char* smem, int item) {
  const ushort_t* qkv = (const ushort_t*)(p.ws + OFF_QKV);
  ushort_t* ya = (ushort_t*)(p.ws + OFF_YA);
  const int tid = tid_opaque(), lane = tid & 63, wave = tid >> 6;
  const int u = item * 8 + wave;
  const int hs = u & 3, r16 = (u >> 2) & 15, chunk = (u >> 6) & 15, b = u >> 10;
  const int qi = lane & 31, h = lane >> 5;
  char* vl = smem + wave * ATT_VBUF;
  const int tq = chunk * 512 + r16 + 16 * qi;
  const size_t bbase = (size_t)b * S_;
  f32x16 o0, o1;
#pragma unroll
  for (int r = 0; r < 16; ++r) { o0[r] = 0.f; o1[r] = 0.f; }
  float m = -1e30f, l = 0.f;
  const int g16 = (lane >> 4) & 1, q4 = (lane & 15) >> 2, p4 = lane & 3;
  __syncthreads();
#pragma unroll 1
  for (int g = 0; g < 3; ++g) {
    const int dsh = 2 * g;
    const int d = 1 << dsh, sd = 16 >> dsh, n = S_ >> dsh;
    const int head = g * 4 + hs;
    const int rc = r16 & (d - 1);
    const int P0 = (chunk * 512 + r16 - rc) >> dsh;
    const int pq = P0 + sd * qi;
    const int KB = P0 - 64;
    const int ntile = (g == 0) ? 20 : (g == 1 ? 8 : 5);
    bf16x8 bq[4];
    {
      const ushort_t* qrow = qkv + (bbase + tq) * QKVC + head * 64;
#pragma unroll
      for (int s = 0; s < 4; ++s) bq[s] = *(const bf16x8*)(qrow + (2 * s + h) * 8);
    }
    bf16x8 kn[4]; u32x4 vn[4];
    {
      const int kp = min(max(KB + qi, 0), n - 1);
      const ushort_t* krow = qkv + (bbase + rc + ((size_t)kp << dsh)) * QKVC + 768 + head * 64;
#pragma unroll
      for (int s = 0; s < 4; ++s) kn[s] = *(const bf16x8*)(krow + (2 * s + h) * 8);
#pragma unroll
      for (int i = 0; i < 4; ++i) {
        const int c = lane + 64 * i, row = c >> 3, ch = c & 7;
        const int vp = min(max(KB + row, 0), n - 1);
        vn[i] = *(const u32x4*)(qkv + (bbase + rc + ((size_t)vp << dsh)) * QKVC + 1536 + head * 64 + ch * 8);
      }
    }
#pragma unroll 1
    for (int kt = 0; kt < ntile; ++kt) {
      bf16x8 kc[4]; u32x4 vc[4];
#pragma unroll
      for (int s = 0; s < 4; ++s) kc[s] = kn[s];
#pragma unroll
      for (int i = 0; i < 4; ++i) vc[i] = vn[i];
      if (kt + 1 < ntile) {
        const int kb1 = KB + 32 * (kt + 1);
        const int kp = min(max(kb1 + qi, 0), n - 1);
        const ushort_t* krow = qkv + (bbase + rc + ((size_t)kp << dsh)) * QKVC + 768 + head * 64;
#pragma unroll
        for (int s = 0; s < 4; ++s) kn[s] = *(const bf16x8*)(krow + (2 * s + h) * 8);
#pragma unroll
        for (int i = 0; i < 4; ++i) {
          const int c = lane + 64 * i, row = c >> 3, ch = c & 7;
          const int vp = min(max(kb1 + row, 0), n - 1);
          vn[i] = *(const u32x4*)(qkv + (bbase + rc + ((size_t)vp << dsh)) * QKVC + 1536 + head * 64 + ch * 8);
        }
      }
      f32x16 st;
#pragma unroll
      for (int r = 0; r < 16; ++r) st[r] = 0.f;
#pragma unroll
      for (int s = 0; s < 4; ++s) st = __builtin_amdgcn_mfma_f32_32x32x16_bf16(kc[s], bq[s], st, 0, 0, 0);
#pragma unroll
      for (int i = 0; i < 4; ++i) { const int c = lane + 64 * i; *(u32x4*)(vl + (c >> 3) * ATT_VROW + (c & 7) * 16) = vc[i]; }
      const int kb = KB + 32 * kt + 4 * h;
      const int dk = kb - pq;
      float mx = -1e30f;
      bool ok[16];
#pragma unroll
      for (int r = 0; r < 16; ++r) {
        const int cr = (r & 3) + 8 * (r >> 2);
        ok[r] = ((unsigned)(dk + cr + 64) <= 128u) && ((unsigned)(kb + cr) < (unsigned)n);
        mx = fmaxf(mx, ok[r] ? st[r] : -1e30f);
      }
      mx = fmaxf(mx, __shfl_xor(mx, 32));
      const float mnew = fmaxf(m, mx);
      const float corr = __expf(m - mnew);
      float ps = 0.f;
      float pv[16];
#pragma unroll
      for (int r = 0; r < 16; ++r) { pv[r] = ok[r] ? __expf(st[r] - mnew) : 0.f; ps += pv[r]; }
      ps += __shfl_xor(ps, 32);
      l = l * corr + ps; m = mnew;
#pragma unroll
      for (int r = 0; r < 16; ++r) { o0[r] *= corr; o1[r] *= corr; }
      bf16x8 pf[2];
#pragma unroll
      for (int s = 0; s < 2; ++s) {
        u32x4 w;
        w[0] = pack2(pv[8 * s + 0], pv[8 * s + 1]); w[1] = pack2(pv[8 * s + 2], pv[8 * s + 3]);
        w[2] = pack2(pv[8 * s + 4], pv[8 * s + 5]); w[3] = pack2(pv[8 * s + 6], pv[8 * s + 7]);
        pf[s] = __builtin_bit_cast(bf16x8, w);
      }
      __builtin_amdgcn_wave_barrier();
      asm volatile("s_waitcnt lgkmcnt(0)" ::: "memory");
#pragma unroll
      for (int s = 0; s < 2; ++s) {
#pragma unroll
        for (int nt = 0; nt < 2; ++nt) {
          const char* a0 = vl + (16 * s + 4 * h + q4) * ATT_VROW + (32 * nt + 16 * g16 + 4 * p4) * 2;
          s16x4 lo = __builtin_amdgcn_ds_read_tr16_b64_v4i16((__attribute__((address_space(3))) s16x4*)(a0));
          s16x4 hi = __builtin_amdgcn_ds_read_tr16_b64_v4i16((__attribute__((address_space(3))) s16x4*)(a0 + 8 * ATT_VROW));
          const bf16x8 vf = __builtin_shufflevector(lo, hi, 0, 1, 2, 3, 4, 5, 6, 7);
          if (nt == 0) o0 = __builtin_amdgcn_mfma_f32_32x32x16_bf16(vf, pf[s], o0, 0, 0, 0);
          else o1 = __builtin_amdgcn_mfma_f32_32x32x16_bf16(vf, pf[s], o1, 0, 0, 0);
        }
      }
      __builtin_amdgcn_wave_barrier();
      asm volatile("s_waitcnt lgkmcnt(0)" ::: "memory");
    }
  }
  const float il = 1.f / l;
  ushort_t* op = ya + (bbase + tq) * 256 + hs * 64;
#pragma unroll
  for (int gq = 0; gq < 4; ++gq) {
    uint2 w0, w1;
    w0.x = pack2(o0[4 * gq] * il, o0[4 * gq + 1] * il); w0.y = pack2(o0[4 * gq + 2] * il, o0[4 * gq + 3] * il);
    w1.x = pack2(o1[4 * gq] * il, o1[4 * gq + 1] * il); w1.y = pack2(o1[4 * gq + 2] * il, o1[4 * gq + 3] * il);
    *(uint2*)(op + 8 * gq + 4 * h) = w0;
    *(uint2*)(op + 32 + 8 * gq + 4 * h) = w1;
  }
}

DI void phase_merge(const P& p, char* smem) {
  const ushort_t* yh = (const ushort_t*)(p.ws + OFF_YH);
  const ushort_t* ya = (const ushort_t*)(p.ws + OFF_YA);
  const ushort_t* gate = (const ushort_t*)(p.ws + OFF_GATE);
  ushort_t* merged = (ushort_t*)(p.ws + OFF_MERGED);
  constexpr int NTN = 1024 / 256, NTM = T_ / 256;
  for (int tile = blockIdx.x; tile < NTM * NTN; tile += gridDim.x) {
    const int tid = tid_opaque(), wave = tid >> 6, wm = wave >> 2, wn = wave & 3;
    int lane = tid & 63;
    const int m0 = (tile / NTN) * 256, n0 = (tile % NTN) * 256;
    f32x16 a1[4][2]; acc_zero4(a1);
    gemm256_AT(a1, yh + (size_t)((m0 / S_) * HW_) * S_ + (m0 & (S_ - 1)), (size_t)S_, (const ushort_t*)(p.ws + OFF_WBH_T), 512, n0, 512, smem);
    const ushort_t* gbh = gate + (size_t)m0 * GATEC + n0;
    ushort_t* mb = merged + (size_t)m0 * 1024 + n0;
    {
      const unsigned lg = (unsigned)((wm * 128 + 4 * (lane >> 5)) * GATEC + wn * 64 + (lane & 31));
      const unsigned lm = (unsigned)((wm * 128 + 4 * (lane >> 5)) * 1024 + wn * 64 + (lane & 31));
#pragma unroll
      for (int mi = 0; mi < 4; ++mi)
#pragma unroll
        for (int ni = 0; ni < 2; ++ni) {
#pragma unroll
          for (int r = 0; r < 16; ++r) {
            const int rr = mi * 32 + (r & 3) + 8 * (r >> 2);
            (mb + rr * 1024 + ni * 32)[lm] = f2bf(bf2f((gbh + rr * GATEC + ni * 32)[lg]) * a1[mi][ni][r]);
          }
          asm volatile("" ::: "memory");
        }
    }
    acc_zero4(a1);
    gemm256<false>(a1, ya, 256, m0, (const ushort_t*)(p.ws + OFF_WBA_T), 256, n0, 256, smem);
    asm volatile("" : "+v"(lane));
    {
      const unsigned lg = (unsigned)((wm * 128 + 4 * (lane >> 5)) * GATEC + wn * 64 + (lane & 31));
      const unsigned lm = (unsigned)((wm * 128 + 4 * (lane >> 5)) * 1024 + wn * 64 + (lane & 31));
#pragma unroll
      for (int mi = 0; mi < 4; ++mi)
#pragma unroll
        for (int ni = 0; ni < 2; ++ni) {
#pragma unroll
          for (int r = 0; r < 16; ++r) {
            const int rr = mi * 32 + (r & 3) + 8 * (r >> 2);
            ushort_t* mp = mb + rr * 1024 + ni * 32;
            mp[lm] = f2bf(bf2f(mp[lm]) + bf2f((gbh + 1024 + rr * GATEC + ni * 32)[lg]) * a1[mi][ni][r]);
          }
          asm volatile("" ::: "memory");
        }
    }
  }
}

DI void phase_ln(float* __restrict__ xio, const float* __restrict__ g, const float* __restrict__ bta) {
  const int tq = tid_opaque(); const int lane = tq & 63, wave = tq >> 6;
  for (int row = blockIdx.x * 8 + wave; row < T_; row += gridDim.x * 8) {
    float* rp = xio + (size_t)row * 1024;
    f32x4 v[4];
    float s = 0.f;
#pragma unroll
    for (int i = 0; i < 4; ++i) { v[i] = *(const f32x4*)(rp + i * 256 + lane * 4); s += v[i][0] + v[i][1] + v[i][2] + v[i][3]; }
    const float mu = wave_sum(s) * (1.f / 1024.f);
    float q = 0.f;
#pragma unroll
    for (int i = 0; i < 4; ++i)
#pragma unroll
      for (int j = 0; j < 4; ++j) { float d = v[i][j] - mu; q += d * d; }
    const float rs = rsqrtf(wave_sum(q) * (1.f / 1024.f) + LN_EPS);
#pragma unroll
    for (int i = 0; i < 4; ++i) {
      f32x4 gg = *(const f32x4*)(g + i * 256 + lane * 4), bb = *(const f32x4*)(bta + i * 256 + lane * 4), o;
#pragma unroll
      for (int j = 0; j < 4; ++j) o[j] = (v[i][j] - mu) * rs * gg[j] + bb[j];
      *(f32x4*)(rp + i * 256 + lane * 4) = o;
    }
  }
}

DI int swz256(int row, int ch) { return row * 256 + ((ch ^ (row & 15)) << 4); }
DI void ins16(float (&L)[16], float x) {
#pragma unroll
  for (int i = 0; i < 16; ++i) { const float hi = __builtin_fmaxf(L[i], x); x = __builtin_fminf(L[i], x); L[i] = hi; }
}
DI void bitonic16_desc(float (&M)[16]) {
#pragma unroll
  for (int d = 8; d >= 1; d >>= 1)
#pragma unroll
    for (int i = 0; i < 16; ++i)
      if ((i & d) == 0) { const float a = M[i], b = M[i + d]; M[i] = __builtin_fmaxf(a, b); M[i + d] = __builtin_fminf(a, b); }
}
constexpr int ROUTE_Q_OFF = 0, ROUTE_K_OFF = 65536, ROUTE_IDX_OFF = 106496;
DI void phase_route(const P& p, char* smem) {
  const float* ada = (const float*)(p.ws + OFF_ADA);
  float* mod = (float*)(smem + 2 * LDS_STAGE);
  const ushort_t* keysb = (const ushort_t*)(p.ws + OFF_KEYS_B);
  int* idx = (int*)(p.ws + OFF_IDX);
  float* gv = (float*)(p.ws + OFF_GV);
  for (int item = blockIdx.x; item < (T_ / BM) * 8; item += gridDim.x) {
    const int tid = tid_opaque(), lane = tid & 63, wave = tid >> 6, wm = wave >> 1, wn = wave & 1;
    const int m0 = (item >> 3) * BM, hh = item & 7;
    float L0[16];
#pragma unroll 1
    for (int pp = 0; pp < 2; ++pp) {
      const int hp = hh * 2 + pp;
      f32x16 acc[2][2]; acc_zero(acc);
      ALoadBf16 al{(const ushort_t*)(p.ws + OFF_U2B), 1024};
      gemm_mainloop<ALoadBf16, true>(acc, al, m0, (const ushort_t*)(p.ws + OFF_WQ_T), 1024, hp * 128, 1024, smem);
#pragma unroll
      for (int mi = 0; mi < 2; ++mi) {
        const int tok = wm * 64 + mi * 32 + (lane & 31);
#pragma unroll
        for (int ni = 0; ni < 2; ++ni)
#pragma unroll
          for (int g = 0; g < 4; ++g) {
            const int ch = wn * 8 + ni * 4 + g;
            uint2 v; v.x = pack2(acc[mi][ni][4 * g], acc[mi][ni][4 * g + 1]); v.y = pack2(acc[mi][ni][4 * g + 2], acc[mi][ni][4 * g + 3]);
            *(uint2*)(smem + ROUTE_Q_OFF + swz256(tok, ch) + 8 * (lane >> 5)) = v;
          }
      }
#pragma unroll
      for (int i = 0; i < 4; ++i) {
        const int q = tid + 512 * i, row = q >> 4, ch = q & 15;
        *(u32x4*)(smem + ROUTE_K_OFF + swz256(row, ch)) = *(const u32x4*)(keysb + (size_t)hp * 16384 + row * 128 + ch * 8);
      }
      __syncthreads();
      f32x16 sc[4];
#pragma unroll
      for (int ks = 0; ks < 4; ++ks)
#pragma unroll
        for (int r = 0; r < 16; ++r) sc[ks][r] = 0.f;
#pragma unroll
      for (int s = 0; s < 8; ++s) {
        const int ch = 2 * s + (lane >> 5);
        const bf16x8 bq = *(const bf16x8*)(smem + ROUTE_Q_OFF + swz256(wave * 32 + (lane & 31), ch));
#pragma unroll
        for (int ks = 0; ks < 4; ++ks) {
          const bf16x8 ak = *(const bf16x8*)(smem + ROUTE_K_OFF + swz256(ks * 32 + (lane & 31), ch));
          sc[ks] = __builtin_amdgcn_mfma_f32_32x32x16_bf16(ak, bq, sc[ks], 0, 0, 0);
        }
      }
      float L[16];
#pragma unroll
      for (int i = 0; i < 16; ++i) L[i] = -3.0e38f;
      const unsigned hbit = (unsigned)(lane >> 5) << 2;
#pragma unroll
      for (int ks = 0; ks < 4; ++ks)
#pragma unroll
        for (int r = 0; r < 16; ++r) {
          const unsigned key = (unsigned)(ks * 32 + (r & 3) + 8 * (r >> 2)) | hbit;
          ins16(L, __uint_as_float((__float_as_uint(sc[ks][r]) & ~127u) | key));
        }
      {
        float M[16];
#pragma unroll
        for (int i = 0; i < 16; ++i) M[i] = __builtin_fmaxf(L[i], __shfl_xor(L[15 - i], 32));
        bitonic16_desc(M);
#pragma unroll
        for (int i = 0; i < 16; ++i) L[i] = M[i];
      }
      if (pp == 0) {
#pragma unroll
        for (int i = 0; i < 16; ++i) L0[i] = L[i];
      } else {
        unsigned char* ib = (unsigned char*)(smem + ROUTE_IDX_OFF) + tid * 32;
#pragma unroll
        for (int i = 0; i < 16; ++i) { ib[i] = (unsigned char)(__float_as_uint(L0[i]) & 127u); ib[16 + i] = (unsigned char)(__float_as_uint(L[i]) & 127u); }
        float F[16];
#pragma unroll
        for (int i = 0; i < 16; ++i) F[i] = -3.0e38f;
#pragma unroll
        for (int i = 0; i < 16; ++i) {
          const float ai = __uint_as_float(__float_as_uint(L0[i]) & ~127u);
#pragma unroll
          for (int j = 0; j < 16; ++j)
            if ((i + 1) * (j + 1) <= 16) {
              const float s = ai + __uint_as_float(__float_as_uint(L[j]) & ~127u);
              ins16(F, __uint_as_float((__float_as_uint(s) & ~255u) | (unsigned)(i * 16 + j)));
            }
        }
        const float mx = __uint_as_float(__float_as_uint(F[0]) & ~255u);
        float e[16], sum = 0.f;
#pragma unroll
        for (int k = 0; k < 16; ++k) { e[k] = __expf(__uint_as_float(__float_as_uint(F[k]) & ~255u) - mx); sum += e[k]; }
        const float inv = 1.f / sum;
        if (lane < 32) {
          const int tok = m0 + wave * 32 + lane;
          int* ip = idx + (size_t)tok * 128 + hh * 16;
          float* gp = gv + (size_t)tok * 128 + hh * 16;
#pragma unroll
          for (int k4 = 0; k4 < 4; ++k4) {
            int4 iv; f32x4 g4;
            int ee[4];
#pragma unroll
            for (int u = 0; u < 4; ++u) {
              const unsigned code = __float_as_uint(F[k4 * 4 + u]) & 255u;
              ee[u] = (int)ib[code >> 4] * 128 + (int)ib[16 + (code & 15u)];
              g4[u] = e[k4 * 4 + u] * inv;
            }
            iv.x = ee[0]; iv.y = ee[1]; iv.z = ee[2]; iv.w = ee[3];
            *(int4*)(ip + k4 * 4) = iv;
            *(f32x4*)(gp + k4 * 4) = g4;
          }
        }
      }
    }
  }
}

DI void phase_rope(const P& p) {
  float* rt = (float*)(p.ws + OFF_ROPE);
  for (int i = blockIdx.x * NT + tid_opaque(); i < T_ * 8; i += gridDim.x * NT) {
    const float inv = expf(-13.122363377404328f * (float)(i & 7) * 0.125f);
    const float x = (float)p.pos[i >> 3] * inv;
    const float k = rintf(x * 0.15915494309189535f);
    float r = fmaf(-k, 6.28125f, x);
    r = fmaf(-k, 1.9353071795864769e-3f, r);
    float sn, cs; __sincosf(r, &sn, &cs);
    rt[2 * i] = cs; rt[2 * i + 1] = sn;
  }
}
DI void phase_keys(const P& p) {
  ushort_t* keysb = (ushort_t*)(p.ws + OFF_KEYS_B);
  for (int i = blockIdx.x * NT + tid_opaque(); i < 16 * 128 * 128 / 4; i += gridDim.x * NT) {
    f32x4 v = *(const f32x4*)(p.keys + (size_t)i * 4);
    uint2 o; o.x = pack2(v[0], v[1]); o.y = pack2(v[2], v[3]);
    *(uint2*)(keysb + (size_t)i * 4) = o;
  }
}

typedef __bf16 bf16x2_t __attribute__((ext_vector_type(2)));
DI float dot2bf(unsigned a, unsigned b, float c) { return __builtin_amdgcn_fdot2_f32_bf16(__builtin_bit_cast(bf16x2_t, a), __builtin_bit_cast(bf16x2_t, b), c, false); }
DI void phase_ln1(const P& p) {
  const float* ada = (const float*)(p.ws + OFF_ADA);
  ushort_t* u2b = (ushort_t*)(p.ws + OFF_U2B);
  const int tq = tid_opaque(); const int lane = tq & 63, wave = tq >> 6;
  for (int row = blockIdx.x * 8 + wave; row < T_; row += gridDim.x * 8) {
    const int b = row / S_;
    float* rp = p.out + (size_t)row * 1024;
    f32x4 v[4];
    float s = 0.f;
#pragma unroll
    for (int i = 0; i < 4; ++i) { v[i] = *(const f32x4*)(rp + i * 256 + lane * 4); s += v[i][0] + v[i][1] + v[i][2] + v[i][3]; }
    const float mu = wave_sum(s) * (1.f / 1024.f);
    float q = 0.f;
#pragma unroll
    for (int i = 0; i < 4; ++i)
#pragma unroll
      for (int j = 0; j < 4; ++j) { float d = v[i][j] - mu; q += d * d; }
    const float rs = rsqrtf(wave_sum(q) * (1.f / 1024.f) + LN_EPS);
#pragma unroll
    for (int i = 0; i < 4; ++i) {
      const int col = i * 256 + lane * 4;
      f32x4 gg = *(const f32x4*)(p.ln1_g + col), bb = *(const f32x4*)(p.ln1_b + col), o;
      f32x4 sc = *(const f32x4*)(ada + b * 6144 + 4 * 1024 + col), sh = *(const f32x4*)(ada + b * 6144 + 3 * 1024 + col);
#pragma unroll
      for (int j = 0; j < 4; ++j) o[j] = (v[i][j] - mu) * rs * gg[j] + bb[j];
      *(f32x4*)(rp + col) = o;
      uint2 w; w.x = pack2(o[0] * (1.f + sc[0]) + sh[0], o[1] * (1.f + sc[1]) + sh[1]); w.y = pack2(o[2] * (1.f + sc[2]) + sh[2], o[3] * (1.f + sc[3]) + sh[3]);
      *(uint2*)(u2b + (size_t)row * 1024 + col) = w;
    }
  }
}
DI float wave_max(float v) {
#pragma unroll
  for (int o = 32; o > 0; o >>= 1) v = fmaxf(v, __shfl_xor(v, o));
  return v;
}
DI unsigned pack4_fp8(float a, float b, float c, float d) {
  int w = 0;
  w = __builtin_amdgcn_cvt_pk_fp8_f32(a, b, w, false);
  w = __builtin_amdgcn_cvt_pk_fp8_f32(c, d, w, true);
  return (unsigned)w;
}
DI void phase_tabconv(const P& p) {
  unsigned char* tu = (unsigned char*)(p.ws + OFF_TABU);
  unsigned char* tv = (unsigned char*)(p.ws + OFF_TABV);
  float* su = (float*)(p.ws + OFF_SU);
  float* sv = (float*)(p.ws + OFF_SV);
  const int tq = tid_opaque(); const int lane = tq & 63, wave = tq >> 6;
  for (int e = blockIdx.x * 8 + wave; e < 16384; e += gridDim.x * 8) {
    f32x4 a[4], c[4];
    float ma = 0.f, mc = 0.f;
#pragma unroll
    for (int i = 0; i < 4; ++i) {
      const int col = i * 256 + lane * 4;
      a[i] = *(const f32x4*)(p.pu + (size_t)e * 1024 + col);
      c[i] = *(const f32x4*)(p.pv + (size_t)e * 1024 + col);
#pragma unroll
      for (int j = 0; j < 4; ++j) { ma = fmaxf(ma, fabsf(a[i][j])); mc = fmaxf(mc, fabsf(c[i][j])); }
    }
    ma = wave_max(ma); mc = wave_max(mc);
    const float sa = (ma > 0.f) ? ma * (1.0f / 448.0f) : 1.0f, sc = (mc > 0.f) ? mc * (1.0f / 448.0f) : 1.0f;
    const float ia = 1.0f / sa, ic = 1.0f / sc;
    if (lane == 0) { su[e] = sa; sv[e] = sc; }
#pragma unroll
    for (int i = 0; i < 4; ++i) {
      const int col = i * 256 + lane * 4;
      *(unsigned*)(tu + (size_t)e * 1024 + col) = pack4_fp8(a[i][0] * ia, a[i][1] * ia, a[i][2] * ia, a[i][3] * ia);
      const int slice = i * 2 + (lane >> 5);
      *(unsigned*)(tv + ((size_t)slice * 16384 + e) * 128 + (lane & 31) * 4) = pack4_fp8(c[i][0] * ic, c[i][1] * ic, c[i][2] * ic, c[i][3] * ic);
    }
  }
}

template <int CTRL> DI float dpp_f(float v) { return __int_as_float(__builtin_amdgcn_mov_dpp(__float_as_int(v), CTRL, 0xf, 0xf, false)); }
template <int CTRL> DI int dpp_shr0(int v) { return __builtin_amdgcn_update_dpp(0, v, CTRL, 0xf, 0xf, true); }
template <int I> DI int bcast16(int v) { return __builtin_amdgcn_mov_dpp(v, 0x150 + I, 0xf, 0xf, false); }
DI float row_sum16(float d) {
  d += dpp_f<0xB1>(d);
  d += dpp_f<0x4E>(d);
  d += dpp_f<0x141>(d);
  d += dpp_f<0x140>(d);
  return d;
}
typedef __bf16 bf16x2_c __attribute__((ext_vector_type(2)));
DI float dot4_fp8(unsigned w8, unsigned xlo, unsigned xhi, float acc) {
  const bf16x2_c lo = __builtin_amdgcn_cvt_scalef32_pk_bf16_fp8((int)w8, 1.0f, false);
  const bf16x2_c hi = __builtin_amdgcn_cvt_scalef32_pk_bf16_fp8((int)w8, 1.0f, true);
  acc = __builtin_amdgcn_fdot2_f32_bf16(lo, __builtin_bit_cast(bf16x2_c, xlo), acc, false);
  return __builtin_amdgcn_fdot2_f32_bf16(hi, __builtin_bit_cast(bf16x2_c, xhi), acc, false);
}
DI void phase_upass(const P& p, char* smem) {
  const int* idx = (const int*)(p.ws + OFF_IDX);
  const float* gv = (const float*)(p.ws + OFF_GV);
  const ushort_t* u2b = (const ushort_t*)(p.ws + OFF_U2B);
  const char* tabu = (const char*)(p.ws + OFF_TABU);
  const float* su = (const float*)(p.ws + OFF_SU);
  const float* sv = (const float*)(p.ws + OFF_SV);
  float* coef = (float*)(p.ws + OFF_COEF);
  const int tq = tid_opaque(); const int lane = tq & 63, wave = tq >> 6;
  const int g = lane >> 4, j = lane & 15;
  int4* lst = (int4*)smem + wave * 512 + g * 128;
  const int part = blockIdx.x & 7, bi = blockIdx.x >> 3, nb = (gridDim.x - part + 7) >> 3;
  __syncthreads();
#pragma unroll 1
  for (int tb = (bi * 8 + wave) * 4; tb < T_; tb += nb * 32) {
    const int tok = tb + g;
    const int4 i0 = *(const int4*)(idx + (size_t)tb * 128 + lane * 8), i1 = *(const int4*)(idx + (size_t)tb * 128 + lane * 8 + 4);
    const f32x4 g0 = *(const f32x4*)(gv + (size_t)tb * 128 + lane * 8), g1 = *(const f32x4*)(gv + (size_t)tb * 128 + lane * 8 + 4);
    u32x4 xr[8];
#pragma unroll
    for (int c = 0; c < 4; ++c) {
      xr[2 * c] = *(const u32x4*)(u2b + (size_t)tok * 1024 + (j + 16 * c) * 16);
      xr[2 * c + 1] = *(const u32x4*)(u2b + (size_t)tok * 1024 + (j + 16 * c) * 16 + 8);
    }
    const int ev[8] = {i0.x, i0.y, i0.z, i0.w, i1.x, i1.y, i1.z, i1.w};
    const float gg[8] = {g0[0], g0[1], g0[2], g0[3], g1[0], g1[1], g1[2], g1[3]};
    int cnt = 0;
#pragma unroll
    for (int i = 0; i < 8; ++i) cnt += ((ev[i] >> 11) == part) ? 1 : 0;
    int incl = cnt;
    incl += dpp_shr0<0x111>(incl); incl += dpp_shr0<0x112>(incl); incl += dpp_shr0<0x114>(incl); incl += dpp_shr0<0x118>(incl);
    const int ng = bcast16<15>(incl);
    int pos = incl - cnt;
#pragma unroll
    for (int i = 0; i < 8; ++i)
      if ((ev[i] >> 11) == part) { int4 en; en.x = ev[i]; en.y = __float_as_int(gg[i]); en.z = j * 8 + i; en.w = 0; lst[pos] = en; ++pos; }
    const int nmax = max(max(__builtin_amdgcn_readlane(ng, 0), __builtin_amdgcn_readlane(ng, 16)), max(__builtin_amdgcn_readlane(ng, 32), __builtin_amdgcn_readlane(ng, 48)));
    __builtin_amdgcn_wave_barrier();
    asm volatile("s_waitcnt lgkmcnt(0)" ::: "memory");
    u32x4 ra[4], rb[4], rc[4], rd[4];
#define UP_LOAD(R, IT) { const unsigned e_ = ((IT) < ng) ? (unsigned)lst[(IT)].x : 0u; const char* row_ = tabu + (size_t)e_ * 1024 + j * 16; \
                         _Pragma("unroll") for (int c = 0; c < 4; ++c) R[c] = *(const u32x4*)(row_ + c * 256); }
#define UP_COMP(R, IT) { float a0 = 0.f, a1 = 0.f, a2 = 0.f, a3 = 0.f; \
      _Pragma("unroll") for (int c = 0; c < 4; ++c) { \
        a0 = dot4_fp8(R[c][0], xr[2 * c][0], xr[2 * c][1], a0); a1 = dot4_fp8(R[c][1], xr[2 * c][2], xr[2 * c][3], a1); \
        a2 = dot4_fp8(R[c][2], xr[2 * c + 1][0], xr[2 * c + 1][1], a2); a3 = dot4_fp8(R[c][3], xr[2 * c + 1][2], xr[2 * c + 1][3], a3); } \
      const float d_ = row_sum16((a0 + a1) + (a2 + a3)); \
      if (j == 0 && (IT) < ng) ((int*)&lst[(IT)])[3] = __float_as_int(d_); }
    UP_LOAD(ra, 0) UP_LOAD(rb, 1) UP_LOAD(rc, 2) UP_LOAD(rd, 3)
#pragma unroll 1
    for (int it = 0; it < nmax; it += 4) {
      UP_COMP(ra, it)     UP_LOAD(ra, it + 4)
      UP_COMP(rb, it + 1) UP_LOAD(rb, it + 5)
      UP_COMP(rc, it + 2) UP_LOAD(rc, it + 6)
      UP_COMP(rd, it + 3) UP_LOAD(rd, it + 7)
    }
#undef UP_LOAD
#undef UP_COMP
    __builtin_amdgcn_wave_barrier();
    asm volatile("s_waitcnt lgkmcnt(0)" ::: "memory");
#pragma unroll 1
    for (int k = 0; k < nmax; k += 16) {
      if (k + j < ng) {
        const int4 en = lst[k + j];
        const float a = __int_as_float(en.w) * su[en.x];
        coef[(size_t)tok * 128 + en.z] = __int_as_float(en.y) * 0.5f * a * (1.f + erff(a * 0.7071067811865475f)) * sv[en.x];
      }
    }
    __builtin_amdgcn_wave_barrier();
    asm volatile("s_waitcnt lgkmcnt(0)" ::: "memory");
  }
}

struct VHdr { int ea, eb, ca, cb; };
DI VHdr vp_hdr(const int* idx, const float* coef, int tok, int g, int cq) {
  VHdr h;
  h.ea = idx[(size_t)tok * 128 + g * 32 + cq]; h.eb = idx[(size_t)tok * 128 + g * 32 + 16 + cq];
  h.ca = __float_as_int(coef[(size_t)tok * 128 + g * 32 + cq]); h.cb = __float_as_int(coef[(size_t)tok * 128 + g * 32 + 16 + cq]);
  return h;
}
DI void vp_rows(uint2 (&va)[16], uint2 (&vb)[16], const VHdr& h, const char* tb) {
#define VP_STEP(I) { va[I] = *(const uint2*)(tb + (unsigned)bcast16<I>(h.ea) * 128u); vb[I] = *(const uint2*)(tb + (unsigned)bcast16<I>(h.eb) * 128u); }
  VP_STEP(0) VP_STEP(1) VP_STEP(2) VP_STEP(3) VP_STEP(4) VP_STEP(5) VP_STEP(6) VP_STEP(7)
  VP_STEP(8) VP_STEP(9) VP_STEP(10) VP_STEP(11) VP_STEP(12) VP_STEP(13) VP_STEP(14) VP_STEP(15)
#undef VP_STEP
}
DI void vp_coefs(float (&fa)[16], float (&fb)[16], const VHdr& h) {
#define VP_STEP(I) { fa[I] = __int_as_float(bcast16<I>(h.ca)); fb[I] = __int_as_float(bcast16<I>(h.cb)); }
  VP_STEP(0) VP_STEP(1) VP_STEP(2) VP_STEP(3) VP_STEP(4) VP_STEP(5) VP_STEP(6) VP_STEP(7)
  VP_STEP(8) VP_STEP(9) VP_STEP(10) VP_STEP(11) VP_STEP(12) VP_STEP(13) VP_STEP(14) VP_STEP(15)
#undef VP_STEP
}
DI void vp_fma8(float (&a)[8], float cf, const uint2& v) {
  const f32x2_hw p0 = __builtin_amdgcn_cvt_pk_f32_fp8((int)v.x, false), p1 = __builtin_amdgcn_cvt_pk_f32_fp8((int)v.x, true);
  const f32x2_hw p2 = __builtin_amdgcn_cvt_pk_f32_fp8((int)v.y, false), p3 = __builtin_amdgcn_cvt_pk_f32_fp8((int)v.y, true);
  a[0] += cf * p0[0]; a[1] += cf * p0[1]; a[2] += cf * p1[0]; a[3] += cf * p1[1];
  a[4] += cf * p2[0]; a[5] += cf * p2[1]; a[6] += cf * p3[0]; a[7] += cf * p3[1];
}
DI void vp_consume(const uint2 (&va)[16], const uint2 (&vb)[16], const VHdr& h, float* f, int tok, int slice, int g, int cq, bool live) {
  float fa[16], fb[16];
  vp_coefs(fa, fb, h);
  float a[8];
#pragma unroll
  for (int i = 0; i < 8; ++i) a[i] = 0.f;
#pragma unroll
  for (int i = 0; i < 16; ++i) { vp_fma8(a, fa[i], va[i]); vp_fma8(a, fb[i], vb[i]); }
#pragma unroll
  for (int i = 0; i < 8; ++i) { a[i] += __shfl_xor(a[i], 16); a[i] += __shfl_xor(a[i], 32); }
  if (g == 0 && live) {
    f32x4 o0, o1; o0[0] = a[0]; o0[1] = a[1]; o0[2] = a[2]; o0[3] = a[3]; o1[0] = a[4]; o1[1] = a[5]; o1[2] = a[6]; o1[3] = a[7];
    float* fp = f + (size_t)tok * 1024 + slice * 128 + cq * 8;
    *(f32x4*)fp = o0; *(f32x4*)(fp + 4) = o1;
  }
}
DI void phase_vpass(const P& p) {
  const int* idx = (const int*)(p.ws + OFF_IDX);
  const float* coef = (const float*)(p.ws + OFF_COEF);
  const char* tabv = (const char*)(p.ws + OFF_TABV);
  float* f = (float*)(p.ws + OFF_F);
  const int tq = tid_opaque(); const int lane = tq & 63, wave = tq >> 6;
  const int g = lane >> 4, cq = lane & 15;
  const int slice = blockIdx.x & 7, bi = blockIdx.x >> 3, nb = (gridDim.x - slice + 7) >> 3;
  const int step = nb * 8;
  const char* tb = tabv + (size_t)slice * (16384 * 128) + cq * 8;
  int tok = bi * 8 + wave;
  if (tok >= T_) return;
  VHdr h0 = vp_hdr(idx, coef, tok, g, cq);
  VHdr h1 = vp_hdr(idx, coef, min(tok + step, T_ - 1), g, cq);
  uint2 va[16], vb[16], na[16], nb2[16];
  vp_rows(va, vb, h0, tb);
#pragma unroll 1
  for (; tok < T_; tok += 2 * step) {
    const VHdr h2 = vp_hdr(idx, coef, min(tok + 2 * step, T_ - 1), g, cq);
    vp_rows(na, nb2, h1, tb);
    vp_consume(va, vb, h0, f, tok, slice, g, cq, true);
    const VHdr h3 = vp_hdr(idx, coef, min(tok + 3 * step, T_ - 1), g, cq);
    vp_rows(va, vb, h2, tb);
    vp_consume(na, nb2, h1, f, tok + step, slice, g, cq, tok + step < T_);
    h0 = h2; h1 = h3;
  }
}

DI void phase_ln2(const P& p) {
  const float* ada = (const float*)(p.ws + OFF_ADA);
  const float* f = (const float*)(p.ws + OFF_F);
  const int tq = tid_opaque(); const int lane = tq & 63, wave = tq >> 6;
  for (int tok = blockIdx.x * 8 + wave; tok < T_; tok += gridDim.x * 8) {
    const int b = tok / S_;
    float* rp = p.out + (size_t)tok * 1024;
    f32x4 acc[4];
    float sm = 0.f;
#pragma unroll
    for (int i = 0; i < 4; ++i) {
      const int col = i * 256 + lane * 4;
      f32x4 x1 = *(const f32x4*)(rp + col), ff = *(const f32x4*)(f + (size_t)tok * 1024 + col);
      f32x4 g2 = *(const f32x4*)(ada + b * 6144 + 5 * 1024 + col);
#pragma unroll
      for (int j = 0; j < 4; ++j) { acc[i][j] = DN_ALPHA * x1[j] + (1.f + g2[j]) * ff[j]; sm += acc[i][j]; }
    }
    const float mu = wave_sum(sm) * (1.f / 1024.f);
    float q = 0.f;
#pragma unroll
    for (int i = 0; i < 4; ++i)
#pragma unroll
      for (int j = 0; j < 4; ++j) { float d = acc[i][j] - mu; q += d * d; }
    const float rs = rsqrtf(wave_sum(q) * (1.f / 1024.f) + LN_EPS);
#pragma unroll
    for (int i = 0; i < 4; ++i) {
      const int col = i * 256 + lane * 4;
      f32x4 gg = *(const f32x4*)(p.ln2_g + col), bb = *(const f32x4*)(p.ln2_b + col), o;
#pragma unroll
      for (int j = 0; j < 4; ++j) o[j] = (acc[i][j] - mu) * rs * gg[j] + bb[j];
      *(f32x4*)(rp + col) = o;
    }
  }
}

#define XB_TMO      128
#define XB_XCNT(j)  (256  + 64 * (j))
#define XB_XSUB(j)  (1280 + 64 * (j))
#define XB_XGEN(j)  (2304 + 64 * (j))
#define XB_TOP      3328
#define XB_TOPGEN   3392
#define XCD_BAR_WORDS 3456
#define XB_SPIN_CAP (1u << 22)
#define LAS __attribute__((address_space(3)))
DI unsigned xb_ld(unsigned* p)              { return __hip_atomic_load(p, __ATOMIC_RELAXED, __HIP_MEMORY_SCOPE_AGENT); }
DI unsigned xb_add(unsigned* p, unsigned v) { return __hip_atomic_fetch_add(p, v, __ATOMIC_RELAXED, __HIP_MEMORY_SCOPE_AGENT); }
DI unsigned xb_xcc_id() { return (unsigned)__builtin_amdgcn_s_getreg((3 << 11) | 20) & 0xFu; }
#define XB_SPIN(cond, bar) do { unsigned _sp = 0; while (cond) { __builtin_amdgcn_s_sleep(1); \
    if ((++_sp & 255u) == 0u) { if (xb_ld(&(bar)[XB_TMO])) break; if (_sp > XB_SPIN_CAP) { atomicAdd(&(bar)[XB_TMO], 1u); break; } } } } while (0)
struct XcdBarrier { unsigned* bar; unsigned x; volatile LAS unsigned* st; };
DI XcdBarrier xcd_barrier_post(unsigned* bar, volatile LAS unsigned* st) {
  XcdBarrier b; b.bar = bar; b.x = xb_xcc_id(); b.st = st;
  if (threadIdx.x == 0) (void)xb_add(&bar[XB_XCNT(b.x)], 1u);
  return b;
}
DI void xcd_barrier_complete(unsigned* bar, unsigned x, unsigned& nloc, unsigned& nx) {
  const unsigned G = gridDim.x * gridDim.y * gridDim.z;
  unsigned sum, cnt, mine, sp = 0u;
  for (;;) {
    sum = 0u; cnt = 0u; mine = 0u;
#pragma unroll
    for (unsigned j = 0; j < 16; ++j) { const unsigned c = xb_ld(&bar[XB_XCNT(j)]); sum += c; cnt += (c > 0u) ? 1u : 0u; mine = (j == x) ? c : mine; }
    if (sum == G) break;
    __builtin_amdgcn_s_sleep(1);
    if ((++sp & 255u) == 0u) { if (xb_ld(&bar[XB_TMO])) break; if (sp > XB_SPIN_CAP) { atomicAdd(&bar[XB_TMO], 1u); break; } }
  }
  nloc = mine > 0u ? mine : 1u; nx = cnt > 0u ? cnt : 1u;
}
DI void xcd_barrier(unsigned* barp, char* stp) {
  asm volatile("s_waitcnt vmcnt(0)" ::: "memory");
  __syncthreads();
  if (threadIdx.x == 0) {
    XcdBarrier b; b.bar = barp; b.x = xb_xcc_id(); b.st = (volatile LAS unsigned*)stp;
    unsigned* bar = b.bar;
    __builtin_amdgcn_s_waitcnt(0);
    unsigned nloc = b.st[0], nx = b.st[1];
    if (nloc == 0u) { xcd_barrier_complete(bar, b.x, nloc, nx); b.st[0] = nloc; b.st[1] = nx; }
    const unsigned old = xb_add(&bar[XB_XSUB(b.x)], 1u);
    const unsigned gen = old / nloc;
    if (old + 1u == (gen + 1u) * nloc) {
      __builtin_amdgcn_fence(__ATOMIC_RELEASE, "agent");
      asm volatile("s_waitcnt vmcnt(0)" ::: "memory");
      const unsigned og = xb_add(&bar[XB_TOP], 1u);
      const unsigned tg = og / nx;
      if (og + 1u == (tg + 1u) * nx) xb_add(&bar[XB_TOPGEN], 1u);
      else XB_SPIN(xb_ld(&bar[XB_TOPGEN]) == tg, bar);
      __builtin_amdgcn_fence(__ATOMIC_ACQUIRE, "agent");
      xb_add(&bar[XB_XGEN(b.x)], 1u);
      asm volatile("s_waitcnt vmcnt(0)" ::: "memory");
    } else {
      XB_SPIN(xb_ld(&bar[XB_XGEN(b.x)]) == gen, bar);
      __builtin_amdgcn_fence(__ATOMIC_ACQUIRE, "agent");
      asm volatile("s_waitcnt vmcnt(0)" ::: "memory");
    }
  }
  __syncthreads();
}

constexpr int SMEM_BYTES = 143360;
__global__ void __launch_bounds__(NT) fwd_megakernel(P p) {
  __shared__ __attribute__((aligned(16))) char smem[SMEM_BYTES + 16];
  if (threadIdx.x < 4) ((volatile LAS unsigned*)(smem + SMEM_BYTES))[threadIdx.x] = 0u;
  __syncthreads();
  (void)xcd_barrier_post((unsigned*)(p.ws + OFF_BAR), (volatile LAS unsigned*)(smem + SMEM_BYTES));
  phase_ada(p, smem);
  xcd_barrier((unsigned*)(p.ws + OFF_BAR), smem + SMEM_BYTES);
  phase_u1(p);
  phase_transposes(p, smem);
  phase_keys(p);
  phase_rope(p);
  phase_filter(p, smem);
  xcd_barrier((unsigned*)(p.ws + OFF_BAR), smem + SMEM_BYTES);
  phase_inproj(p, smem);
  xcd_barrier((unsigned*)(p.ws + OFF_BAR), smem + SMEM_BYTES);
  for (int item = blockIdx.x; item < 512 + 256; item += gridDim.x) {
    if (item < 512) hyena_item(p, smem, item);
    else attn_item(p, smem, item - 512);
  }
  xcd_barrier((unsigned*)(p.ws + OFF_BAR), smem + SMEM_BYTES);
  phase_merge(p, smem);
  xcd_barrier((unsigned*)(p.ws + OFF_BAR), smem + SMEM_BYTES);
  phase_outproj(p, smem);
  xcd_barrier((unsigned*)(p.ws + OFF_BAR), smem + SMEM_BYTES);
  phase_ln1(p);
  phase_tabconv(p);
  xcd_barrier((unsigned*)(p.ws + OFF_BAR), smem + SMEM_BYTES);
  phase_route(p, smem);
  xcd_barrier((unsigned*)(p.ws + OFF_BAR), smem + SMEM_BYTES);
  phase_upass(p, smem);
  xcd_barrier((unsigned*)(p.ws + OFF_BAR), smem + SMEM_BYTES);
  phase_vpass(p);
  xcd_barrier((unsigned*)(p.ws + OFF_BAR), smem + SMEM_BYTES);
  phase_ln2(p);
}

extern "C" void kernel_launch(void* const* d_in, const int* in_sizes, int n_in, void* d_out, int out_size, void* d_ws, size_t ws_size,
                              hipStream_t stream) {
  P p{};
  p.x = (const float*)d_in[0]; p.c = (const float*)d_in[1]; p.pos = (const int*)d_in[2];
  p.w_ada = (const float*)d_in[3]; p.b_ada = (const float*)d_in[4]; p.w_in = (const float*)d_in[5];
  p.hy_conv_w = (const float*)d_in[6]; p.hy_conv_b = (const float*)d_in[7];
  p.f1_w = (const float*)d_in[8]; p.f1_b = (const float*)d_in[9]; p.f1_freq = (const float*)d_in[10];
  p.f2_w = (const float*)d_in[11]; p.f2_b = (const float*)d_in[12]; p.f2_freq = (const float*)d_in[13];
  p.f3_w = (const float*)d_in[14]; p.hy_bias = (const float*)d_in[15];
  p.w_bh = (const float*)d_in[16]; p.w_ba = (const float*)d_in[17]; p.w_out = (const float*)d_in[18];
  p.ln1_g = (const float*)d_in[19]; p.ln1_b = (const float*)d_in[20];
  p.wq = (const float*)d_in[21]; p.keys = (const float*)d_in[22]; p.pu = (const float*)d_in[23]; p.pv = (const float*)d_in[24];
  p.ln2_g = (const float*)d_in[25]; p.ln2_b = (const float*)d_in[26];
  p.out = (float*)d_out; p.ws = (char*)d_ws;

  static int grid_blocks = 0;
  if (!grid_blocks) {
    int dev = 0, cus = 0, per_cu = 0;
    hipGetDevice(&dev);
    hipDeviceGetAttribute(&cus, hipDeviceAttributeMultiprocessorCount, dev);
    hipOccupancyMaxActiveBlocksPerMultiprocessor(&per_cu, fwd_megakernel, NT, 0);
    if (per_cu > 1) per_cu = 1;
    grid_blocks = cus * per_cu;
  }
  (void)hipMemsetAsync((char*)d_ws + OFF_BAR, 0, XCD_BAR_WORDS * 4, stream);
  void* args[] = {&p};
  hipError_t e = hipLaunchCooperativeKernel((void*)fwd_megakernel, dim3(grid_blocks), dim3(NT), args, 0, stream);
  if (e != hipSuccess) fprintf(stderr, "cooperative launch failed: %s (grid %d)\n", hipGetErrorString(e), grid_blocks);
}
```

```cpp
#include <hip/hip_runtime.h>
#include <hip/hip_cooperative_groups.h>
#include <cstdio>
#include <cstdint>

#define DI __device__ __forceinline__
typedef unsigned short ushort_t;
typedef __attribute__((ext_vector_type(8))) short bf16x8;
typedef __attribute__((ext_vector_type(16))) float f32x16;
typedef __attribute__((ext_vector_type(4))) float f32x4;
typedef __attribute__((ext_vector_type(4))) unsigned u32x4;

constexpr int T_ = 16384, S_ = 8192, NB = 2, D_ = 1024;
constexpr int HW_ = 512, HYC = 1536, QKVC = 2304, GATEC = 2048, INW = 5888;
constexpr int NT = 512;
constexpr float DN_ALPHA = 1.189207115002721f;
constexpr float LN_EPS = 1e-5f;

constexpr size_t OFF_ADA   = 0;
constexpr size_t OFF_BAR   = 49152;
constexpr size_t OFF_KEYS_B= 65536;
constexpr size_t OFF_WIN_T = 65536 + 524288;
constexpr size_t OFF_WQ_T  = OFF_WIN_T + (size_t)INW * 1024 * 2;
constexpr size_t OFF_WOUT_T= OFF_WQ_T + (size_t)2048 * 1024 * 2;
constexpr size_t OFF_WBH_T = OFF_WOUT_T + (size_t)1024 * 1024 * 2;
constexpr size_t OFF_WBA_T = OFF_WBH_T + (size_t)1024 * 512 * 2;
constexpr size_t OFF_PH    = OFF_WBA_T + (size_t)1024 * 256 * 2;
constexpr size_t OFF_QKV   = OFF_PH + (size_t)T_ * HYC * 2;
constexpr size_t OFF_GATE  = OFF_QKV + (size_t)T_ * QKVC * 2;
constexpr size_t OFF_YH    = OFF_GATE + (size_t)T_ * GATEC * 2;
constexpr size_t OFF_YA    = OFF_YH + (size_t)T_ * HW_ * 2;
constexpr size_t OFF_END   = OFF_YA + (size_t)T_ * 256 * 2;
constexpr size_t OFF_MERGED= OFF_PH;
constexpr size_t OFF_YHK   = OFF_PH + (size_t)32 * 1048576;
constexpr size_t OFF_U1B   = OFF_YH;
static_assert(OFF_U1B + (size_t)T_ * 1024 * 2 <= 268435456ull, "u1b overflow");
constexpr size_t OFF_U2B   = OFF_PH;
constexpr size_t OFF_TABU  = OFF_QKV;
constexpr size_t OFF_TABV  = OFF_QKV + (size_t)16 * 1048576;
constexpr size_t OFF_SU    = OFF_QKV + (size_t)32 * 1048576;
constexpr size_t OFF_SV    = OFF_SU + 65536;
constexpr size_t OFF_COEF  = OFF_QKV + (size_t)64 * 1048576;
constexpr size_t OFF_F     = OFF_QKV + (size_t)72 * 1048576;
static_assert(OFF_F + (size_t)64 * 1048576 <= OFF_YH, "peer buffers overflow the qkv+gate region");
constexpr size_t OFF_IDX   = OFF_YH;
constexpr size_t OFF_GV    = OFF_YH + (size_t)T_ * 128 * 4;
constexpr size_t OFF_HSCR  = OFF_END;
static_assert(OFF_HSCR + (size_t)164 * 131072 <= 268435456ull, "ws overflow");
static_assert((size_t)92 * 131072 <= (size_t)INW * 1024 * 2, "w_in^T region too small");
constexpr size_t OFF_ROPE  = OFF_HSCR + (size_t)164 * 131072;
static_assert(OFF_ROPE + (size_t)T_ * 64 <= 268435456ull, "rope table overflow");

struct P {
  const float *x, *c; const int* pos;
  const float *w_ada, *b_ada, *w_in, *hy_conv_w, *hy_conv_b, *f1_w, *f1_b, *f1_freq, *f2_w, *f2_b, *f2_freq, *f3_w,
      *hy_bias, *w_bh, *w_ba, *w_out, *ln1_g, *ln1_b, *wq, *keys, *pu, *pv, *ln2_g, *ln2_b;
  float* out; char* ws;
};

DI ushort_t f2bf(float x) { unsigned u = __float_as_uint(x); u += 0x7fffu + ((u >> 16) & 1u); return (ushort_t)(u >> 16); }
DI float bf2f(ushort_t h) { return __uint_as_float(((unsigned)h) << 16); }
typedef __bf16 bf16x2_hw __attribute__((ext_vector_type(2)));
typedef float f32x2_hw __attribute__((ext_vector_type(2)));
DI unsigned pack2(float a, float b) { f32x2_hw v = {a, b}; return __builtin_bit_cast(unsigned, __builtin_convertvector(v, bf16x2_hw)); }
DI int tid_opaque() { int t = threadIdx.x; asm volatile("" : "+v"(t)); return t; }
DI float wave_sum(float v) {
#pragma unroll
  for (int o = 32; o > 0; o >>= 1) v += __shfl_xor(v, o);
  return v;
}

struct cf2 { float x, y; };
constexpr int FFT_N = 16384, FFT_SA = 560;

DI constexpr float wcos32(int j) {
  switch (j & 31) {
    case 0: return 1.0f; case 1: return 0.98078528040323043f; case 2: return 0.92387953251128674f; case 3: return 0.83146961230254524f;
    case 4: return 0.70710678118654752f; case 5: return 0.55557023301960218f; case 6: return 0.38268343236508978f; case 7: return 0.19509032201612825f;
    case 8: return 0.0f; case 9: return -0.19509032201612825f; case 10: return -0.38268343236508978f; case 11: return -0.55557023301960218f;
    case 12: return -0.70710678118654752f; case 13: return -0.83146961230254524f; case 14: return -0.92387953251128674f; case 15: return -0.98078528040323043f;
    case 16: return -1.0f; case 17: return -0.98078528040323043f; case 18: return -0.92387953251128674f; case 19: return -0.83146961230254524f;
    case 20: return -0.70710678118654752f; case 21: return -0.55557023301960218f; case 22: return -0.38268343236508978f; case 23: return -0.19509032201612825f;
    case 24: return 0.0f; case 25: return 0.19509032201612825f; case 26: return 0.38268343236508978f; case 27: return 0.55557023301960218f;
    case 28: return 0.70710678118654752f; case 29: return 0.83146961230254524f; case 30: return 0.92387953251128674f; default: return 0.98078528040323043f;
  }
}
DI constexpr float wsin32(int j) { return wcos32(j + 24); }
DI constexpr int brev(int v, int bits) { int r = 0; for (int i = 0; i < bits; ++i) r |= ((v >> i) & 1) << (bits - 1 - i); return r; }

template <int R, int LEN, bool INV, bool ZHI>
DI void r2_stage(float (&re)[R], float (&im)[R]) {
  constexpr int half = LEN / 2;
#pragma unroll
  for (int start = 0; start < R; start += LEN) {
#pragma unroll
    for (int j = 0; j < half; ++j) {
      const int a = start + j, b = a + half;
      const int tj = j * (32 / LEN);
      const float c = wcos32(tj), s = wsin32(tj);
      if (!INV) {
        float dr, di;
        if (ZHI) { dr = re[a]; di = im[a]; }
        else {
          const float ar = re[a], ai = im[a], br = re[b], bi = im[b];
          re[a] = ar + br; im[a] = ai + bi; dr = ar - br; di = ai - bi;
        }
        if (tj == 0) { re[b] = dr; im[b] = di; }
        else if (tj == 8) { re[b] = di; im[b] = -dr; }
        else { re[b] = dr * c + di * s; im[b] = di * c - dr * s; }
      } else {
        const float br = re[b], bi = im[b];
        float pr, pi;
        if (tj == 0) { pr = br; pi = bi; }
        else if (tj == 8) { pr = -bi; pi = br; }
        else { pr = br * c - bi * s; pi = bi * c + br * s; }
        const float ar = re[a], ai = im[a];
        re[a] = ar + pr; im[a] = ai + pi; re[b] = ar - pr; im[b] = ai - pi;
      }
    }
  }
}
template <int R, bool ZHI> DI void dft_fwd(float (&re)[R], float (&im)[R]) {
  if (R == 32) r2_stage<R, (R == 32 ? 32 : 2), false, ZHI>(re, im);
  r2_stage<R, 16, false, (R == 16) && ZHI>(re, im);
  r2_stage<R, 8, false, false>(re, im);
  r2_stage<R, 4, false, false>(re, im);
  r2_stage<R, 2, false, false>(re, im);
}
template <int R> DI void dft_inv(float (&re)[R], float (&im)[R]) {
  r2_stage<R, 2, true, false>(re, im);
  r2_stage<R, 4, true, false>(re, im);
  r2_stage<R, 8, true, false>(re, im);
  r2_stage<R, 16, true, false>(re, im);
  if (R == 32) r2_stage<R, (R == 32 ? 32 : 2), true, false>(re, im);
}

DI void sincos_turn(float frac, float& s, float& c) { sincospif(2.0f * frac, &s, &c); }

template <bool ZHI>
DI void fft_fwdA(float (&re)[32], float (&im)[32], cf2* lds, int m) {
  asm volatile("" : "+v"(m));
  float s1, c1; sincos_turn((float)m * (1.0f / 16384.0f), s1, c1);
  __builtin_amdgcn_sched_barrier(0);
  dft_fwd<32, ZHI>(re, im);
  __builtin_amdgcn_sched_barrier(0);
  float wr = 1.f, wi = 0.f;
#pragma unroll
  for (int k1 = 0; k1 < 32; ++k1) {
    if ((k1 & 3) == 0) __builtin_amdgcn_sched_barrier(0);
    const int r = brev(k1, 5);
    cf2 o; o.x = re[r] * wr - im[r] * wi; o.y = re[r] * wi + im[r] * wr;
    lds[k1 * FFT_SA + m] = o;
    const float nr = wr * c1 + wi * s1, ni = wi * c1 - wr * s1;
    wr = nr; wi = ni;
  }
}
DI void fft_B_read(float (&re)[32], float (&im)[32], const cf2* lds, int tid) {
  const int k1 = tid >> 4, mp = tid & 15;
#pragma unroll
  for (int n2 = 0; n2 < 32; ++n2) { cf2 v = lds[k1 * FFT_SA + n2 * 16 + mp]; re[n2] = v.x; im[n2] = v.y; }
}
DI void fft_fwdB_write(float (&re)[32], float (&im)[32], cf2* lds, int tid) {
  asm volatile("" : "+v"(tid));
  const int k1 = tid >> 4, mp = tid & 15;
  float s1, c1; sincos_turn((float)mp * (1.0f / 512.0f), s1, c1);
  __builtin_amdgcn_sched_barrier(0);
  dft_fwd<32, false>(re, im);
  __builtin_amdgcn_sched_barrier(0);
  float wr = 1.f, wi = 0.f;
#pragma unroll
  for (int k2 = 0; k2 < 32; ++k2) {
    if ((k2 & 3) == 0) __builtin_amdgcn_sched_barrier(0);
    const int r = brev(k2, 5);
    cf2 o; o.x = re[r] * wr - im[r] * wi; o.y = re[r] * wi + im[r] * wr;
    lds[k1 * FFT_SA + k2 * 17 + mp] = o;
    const float nr = wr * c1 + wi * s1, ni = wi * c1 - wr * s1;
    wr = nr; wi = ni;
  }
}
DI void fft_fwdC(float (&re)[32], float (&im)[32], const cf2* lds, int tid) {
  const int k1 = tid >> 5, k2 = tid & 31;
#pragma unroll
  for (int h = 0; h < 2; ++h) {
    float tr[16], ti[16];
#pragma unroll
    for (int mp = 0; mp < 16; ++mp) { cf2 v = lds[(k1 + 16 * h) * FFT_SA + k2 * 17 + mp]; tr[mp] = v.x; ti[mp] = v.y; }
    dft_fwd<16, false>(tr, ti);
#pragma unroll
    for (int i = 0; i < 16; ++i) { re[h * 16 + i] = tr[i]; im[h * 16 + i] = ti[i]; }
  }
}
DI void fft_invC(float (&re)[32], float (&im)[32], cf2* lds, int tid) {
  const int k1 = tid >> 5, k2 = tid & 31;
#pragma unroll
  for (int h = 0; h < 2; ++h) {
    float tr[16], ti[16];
#pragma unroll
    for (int i = 0; i < 16; ++i) { tr[i] = re[h * 16 + i]; ti[i] = im[h * 16 + i]; }
    dft_inv<16>(tr, ti);
#pragma unroll
    for (int mp = 0; mp < 16; ++mp) { cf2 o; o.x = tr[mp]; o.y = ti[mp]; lds[(k1 + 16 * h) * FFT_SA + k2 * 17 + mp] = o; }
  }
}
DI void fft_invB_read(float (&re)[32], float (&im)[32], const cf2* lds, int tid) {
  asm volatile("" : "+v"(tid));
  const int k1 = tid >> 4, mp = tid & 15;
  float s1, c1; sincos_turn((float)mp * (1.0f / 512.0f), s1, c1);
  float wr = 1.f, wi = 0.f;
  __builtin_amdgcn_sched_barrier(0);
#pragma unroll
  for (int k2 = 0; k2 < 32; ++k2) {
    if ((k2 & 3) == 0) __builtin_amdgcn_sched_barrier(0);
    const int r = brev(k2, 5);
    cf2 v = lds[k1 * FFT_SA + k2 * 17 + mp];
    re[r] = v.x * wr - v.y * wi; im[r] = v.x * wi + v.y * wr;
    const float nr = wr * c1 - wi * s1, ni = wi * c1 + wr * s1;
    wr = nr; wi = ni;
  }
}
DI void fft_invB_write(float (&re)[32], float (&im)[32], cf2* lds, int tid) {
  const int k1 = tid >> 4, mp = tid & 15;
  dft_inv<32>(re, im);
#pragma unroll
  for (int n2 = 0; n2 < 32; ++n2) { cf2 o; o.x = re[n2]; o.y = im[n2]; lds[k1 * FFT_SA + n2 * 16 + mp] = o; }
}
DI void fft_invA(float (&re)[32], float (&im)[32], const cf2* lds, int m) {
  asm volatile("" : "+v"(m));
  float s1, c1; sincos_turn((float)m * (1.0f / 16384.0f), s1, c1);
  float wr = 1.f, wi = 0.f;
  __builtin_amdgcn_sched_barrier(0);
#pragma unroll
  for (int k1 = 0; k1 < 32; ++k1) {
    if ((k1 & 3) == 0) __builtin_amdgcn_sched_barrier(0);
    const int r = brev(k1, 5);
    cf2 v = lds[k1 * FFT_SA + m];
    re[r] = v.x * wr - v.y * wi; im[r] = v.x * wi + v.y * wr;
    const float nr = wr * c1 - wi * s1, ni = wi * c1 + wr * s1;
    wr = nr; wi = ni;
  }
  __builtin_amdgcn_sched_barrier(0);
  dft_inv<32>(re, im);
}

DI void phase_ada(const P& p, char* smem) {
  float (*red)[16][32] = (float (*)[16][32])smem;
  const int tid = tid_opaque(), cl = tid & 31, kq = tid >> 5;
  for (int item = blockIdx.x; item < 192; item += gridDim.x) {
    const int col = item * 32 + cl;
    float a0 = 0.f, a1 = 0.f;
#pragma unroll 16
    for (int k = kq * 64; k < kq * 64 + 64; ++k) {
      const float w = p.w_ada[(size_t)k * 6144 + col];
      const float c0 = p.c[k], c1 = p.c[1024 + k];
      a0 += (c0 / (1.f + __expf(-c0))) * w;
      a1 += (c1 / (1.f + __expf(-c1))) * w;
    }
    __syncthreads();
    red[0][kq][cl] = a0; red[1][kq][cl] = a1;
    __syncthreads();
    if (tid < 64) {
      const int b = tid >> 5;
      float s = p.b_ada[col];
#pragma unroll
      for (int q = 0; q < 16; ++q) s += red[b][q][cl];
      ((float*)(p.ws + OFF_ADA))[b * 6144 + col] = s;
    }
  }
}
DI void phase_u1(const P& p) {
  const float* ada = (const float*)(p.ws + OFF_ADA);
  ushort_t* u1b = (ushort_t*)(p.ws + OFF_U1B);
  for (int i = blockIdx.x * NT + tid_opaque(); i < T_ * 128; i += gridDim.x * NT) {
    const int row = i >> 7, k = (i & 127) * 8, b = row / S_;
    const float* xp = p.x + (size_t)row * 1024 + k;
    const f32x4 x0 = *(const f32x4*)xp, x1 = *(const f32x4*)(xp + 4);
    const f32x4 s0 = *(const f32x4*)(ada + b * 6144 + 1024 + k), s1 = *(const f32x4*)(ada + b * 6144 + 1024 + k + 4);
    const f32x4 h0 = *(const f32x4*)(ada + b * 6144 + k), h1 = *(const f32x4*)(ada + b * 6144 + k + 4);
    u32x4 o;
    o[0] = pack2(x0[0] * (1.f + s0[0]) + h0[0], x0[1] * (1.f + s0[1]) + h0[1]);
    o[1] = pack2(x0[2] * (1.f + s0[2]) + h0[2], x0[3] * (1.f + s0[3]) + h0[3]);
    o[2] = pack2(x1[0] * (1.f + s1[0]) + h1[0], x1[1] * (1.f + s1[1]) + h1[1]);
    o[3] = pack2(x1[2] * (1.f + s1[2]) + h1[2], x1[3] * (1.f + s1[3]) + h1[3]);
    *(u32x4*)(u1b + (size_t)row * 1024 + k) = o;
  }
}

DI void transpose_tile(const float* __restrict__ W, ushort_t* __restrict__ Wt, int K, int N, int item, char* smem) {
  float (*tile)[65] = (float (*)[65])smem;
  const int ntn = N / 64;
  const int n0 = (item % ntn) * 64, k0 = (item / ntn) * 32;
  const int tid = tid_opaque();
  __syncthreads();
  {
    const int tx = tid & 63, ty = tid >> 6;
#pragma unroll
    for (int i = 0; i < 4; ++i) tile[ty + 8 * i][tx] = W[(size_t)(k0 + ty + 8 * i) * N + n0 + tx];
  }
  __syncthreads();
  {
    const int kk = tid & 31, nn0 = tid >> 5;
#pragma unroll
    for (int i = 0; i < 4; ++i) Wt[(size_t)(n0 + nn0 + 16 * i) * K + k0 + kk] = f2bf(tile[kk][nn0 + 16 * i]);
  }
}
DI void phase_transposes(const P& p, char* smem) {
  constexpr int I0 = (INW / 64) * 32, I1 = I0 + 32 * 32, I2 = I1 + 16 * 32, I3 = I2 + 16 * 16, I4 = I3 + 16 * 8;
  for (int item = blockIdx.x; item < I4; item += gridDim.x) {
    if (item < I0) transpose_tile(p.w_in, (ushort_t*)(p.ws + OFF_WIN_T), 1024, INW, item, smem);
    else if (item < I1) transpose_tile(p.wq, (ushort_t*)(p.ws + OFF_WQ_T), 1024, 2048, item - I0, smem);
    else if (item < I2) transpose_tile(p.w_out, (ushort_t*)(p.ws + OFF_WOUT_T), 1024, 1024, item - I1, smem);
    else if (item < I3) transpose_tile(p.w_bh, (ushort_t*)(p.ws + OFF_WBH_T), 512, 1024, item - I2, smem);
    else transpose_tile(p.w_ba, (ushort_t*)(p.ws + OFF_WBA_T), 256, 1024, item - I3, smem);
  }
}

DI void phase_filter(const P& p, char* smem) {
  float (*zf)[33] = (float (*)[33])smem;
  float (*h1)[64] = (float (*)[64])(smem + 4352);
  float (*h2T)[32] = (float (*)[32])(smem + 4352 + 8192);
  const int tid = tid_opaque();
  for (int item = blockIdx.x; item < 256; item += gridDim.x) {
  const int t0 = item * 32;
  __syncthreads();
  for (int idx = tid; idx < 32 * 33; idx += NT) {
    int tt = idx / 33, e = idx % 33, t = t0 + tt;
    float tl = (float)t * (1.0f / 8191.0f);
    float w = 6.283185307179586f * (float)t / 8192.0f;
    float val;
    if (e == 0) val = tl;
    else {
      int i = (e - 1) & 15;
      float f = 1e-4f + (float)i * ((15.0f - 1e-4f) / 15.0f);
      val = (e <= 16) ? cosf(f * w) : -sinf(f * w);
    }
    zf[tt][e] = val;
  }
  __syncthreads();
  for (int idx = tid; idx < 32 * 64; idx += NT) {
    int tt = idx >> 6, j = idx & 63;
    float a = p.f1_b[j];
    for (int e = 0; e < 33; ++e) a += zf[tt][e] * p.f1_w[e * 64 + j];
    h1[tt][j] = sinf(p.f1_freq[j] * a);
  }
  __syncthreads();
  for (int idx = tid; idx < 32 * 64; idx += NT) {
    int tt = idx >> 6, j = idx & 63;
    float a = p.f2_b[j];
    for (int e = 0; e < 64; ++e) a += h1[tt][e] * p.f2_w[e * 64 + j];
    h2T[j][tt] = sinf(p.f2_freq[j] * a);
  }
  __syncthreads();
  float* filt = p.out;
  const float min_decay = -3.0701134573253945f, max_decay = -15.350567286626973f;
  for (int col = tid; col < 2048; col += NT) {
    float acc[32];
#pragma unroll
    for (int i = 0; i < 32; ++i) acc[i] = 0.f;
    for (int j = 0; j < 64; ++j) {
      float w = p.f3_w[j * 2048 + col];
#pragma unroll
      for (int q = 0; q < 8; ++q) {
        f32x4 h = *(const f32x4*)&h2T[j][q * 4];
        acc[q * 4 + 0] += h[0] * w; acc[q * 4 + 1] += h[1] * w; acc[q * 4 + 2] += h[2] * w; acc[q * 4 + 3] += h[3] * w;
      }
    }
    int c = col & 511;
    float delta = fabsf(min_decay + (float)c * ((max_decay - min_decay) / 511.0f));
    float* dst = filt + (size_t)col * 8192 + t0;
#pragma unroll
    for (int q = 0; q < 8; ++q) {
      f32x4 o;
#pragma unroll
      for (int r = 0; r < 4; ++r) {
        float tl = (float)(t0 + q * 4 + r) * (1.0f / 8191.0f);
        o[r] = acc[q * 4 + r] * __expf(-tl * delta);
      }
      *(f32x4*)(dst + q * 4) = o;
    }
  }
  }
}

constexpr int BM = 256, BN = 128, BK = 64;
constexpr int LDS_A = BM * BK * 2, LDS_B = BN * BK * 2, LDS_STAGE = LDS_A + LDS_B;
constexpr int GEMM_LDS = 2 * LDS_STAGE + 8192;

DI int swz(int row, int ch) { return row * 128 + ((ch ^ (row & 7)) << 4); }

struct ALoadBf16 {
  const ushort_t* A; int lda;
  struct Raw { u32x4 v; };
  DI Raw fetch(int row, int k) const { Raw r; r.v = *(const u32x4*)(A + (size_t)row * lda + k); return r; }
  DI u32x4 cvt(const Raw& r, int k) const { return r.v; }
};
struct ALoadF32Mod {
  const float* A; const float* mod;
  struct Raw { f32x4 a, b; };
  DI Raw fetch(int row, int k) const { Raw r; const float* s = A + (size_t)row * 1024 + k; r.a = *(const f32x4*)s; r.b = *(const f32x4*)(s + 4); return r; }
  DI u32x4 cvt(const Raw& r, int k) const {
    f32x4 s0 = *(const f32x4*)(mod + k), s1 = *(const f32x4*)(mod + k + 4);
    f32x4 h0 = *(const f32x4*)(mod + 1024 + k), h1 = *(const f32x4*)(mod + 1024 + k + 4);
    u32x4 o;
    o[0] = pack2(r.a[0] * s0[0] + h0[0], r.a[1] * s0[1] + h0[1]);
    o[1] = pack2(r.a[2] * s0[2] + h0[2], r.a[3] * s0[3] + h0[3]);
    o[2] = pack2(r.b[0] * s1[0] + h1[0], r.b[1] * s1[1] + h1[1]);
    o[3] = pack2(r.b[2] * s1[2] + h1[2], r.b[3] * s1[3] + h1[3]);
    return o;
  }
};

template <class AL, bool SWAP = false>
DI void gemm_mainloop(f32x16 (&acc)[2][2], const AL& al, int m0, const ushort_t* __restrict__ Bt, int ldb, int n0, int K, char* smem) {
  const int tid = tid_opaque(), lane = tid & 63, wave = tid >> 6;
  const int wm = wave >> 1, wn = wave & 1;
  const int lr = tid >> 3, lc = tid & 7;
  typename AL::Raw ra[4]; u32x4 rb[2];
  const int nk = K / BK;
#pragma unroll
  for (int i = 0; i < 4; ++i) ra[i] = al.fetch(m0 + lr + 64 * i, lc * 8);
#pragma unroll
  for (int i = 0; i < 2; ++i) rb[i] = *(const u32x4*)(Bt + (size_t)(n0 + lr + 64 * i) * ldb + lc * 8);
  __syncthreads();
#pragma unroll
  for (int i = 0; i < 4; ++i) *(u32x4*)(smem + swz(lr + 64 * i, lc)) = al.cvt(ra[i], lc * 8);
#pragma unroll
  for (int i = 0; i < 2; ++i) *(u32x4*)(smem + LDS_A + swz(lr + 64 * i, lc)) = rb[i];
  __syncthreads();
  for (int kt = 0; kt < nk; ++kt) {
    char* cur = smem + (kt & 1) * LDS_STAGE;
    char* nxt = smem + ((kt + 1) & 1) * LDS_STAGE;
    const bool more = (kt + 1 < nk);
    const int kn = (kt + 1) * BK + lc * 8;
    if (more) {
#pragma unroll
      for (int i = 0; i < 4; ++i) ra[i] = al.fetch(m0 + lr + 64 * i, kn);
#pragma unroll
      for (int i = 0; i < 2; ++i) rb[i] = *(const u32x4*)(Bt + (size_t)(n0 + lr + 64 * i) * ldb + kn);
    }
#pragma unroll
    for (int s = 0; s < 4; ++s) {
      const int ch = 2 * s + (lane >> 5);
      bf16x8 af[2], bfr[2];
#pragma unroll
      for (int mi = 0; mi < 2; ++mi) af[mi] = *(const bf16x8*)(cur + swz(wm * 64 + mi * 32 + (lane & 31), ch));
#pragma unroll
      for (int ni = 0; ni < 2; ++ni) bfr[ni] = *(const bf16x8*)(cur + LDS_A + swz(wn * 64 + ni * 32 + (lane & 31), ch));
#pragma unroll
      for (int mi = 0; mi < 2; ++mi)
#pragma unroll
        for (int ni = 0; ni < 2; ++ni)
          acc[mi][ni] = SWAP ? __builtin_amdgcn_mfma_f32_32x32x16_bf16(bfr[ni], af[mi], acc[mi][ni], 0, 0, 0)
                             : __builtin_amdgcn_mfma_f32_32x32x16_bf16(af[mi], bfr[ni], acc[mi][ni], 0, 0, 0);
    }
    if (more) {
#pragma unroll
      for (int i = 0; i < 4; ++i) *(u32x4*)(nxt + swz(lr + 64 * i, lc)) = al.cvt(ra[i], kn);
#pragma unroll
      for (int i = 0; i < 2; ++i) *(u32x4*)(nxt + LDS_A + swz(lr + 64 * i, lc)) = rb[i];
    }
    __syncthreads();
  }
}

constexpr int AT_ROW = 576;
constexpr int LDS_AT = 64 * AT_ROW;
constexpr int LDS_STAGE_T = LDS_AT + LDS_B;
typedef __attribute__((ext_vector_type(4))) short s16x4;
DI void gemm_mainloop_AT(f32x16 (&acc)[2][2], const ushort_t* __restrict__ At, size_t ldt, const ushort_t* __restrict__ Bt, int ldb, int n0, int K, char* smem) {
  const int tid = tid_opaque(), lane = tid & 63, wave = tid >> 6;
  const int wm = wave >> 1, wn = wave & 1;
  const int lr = tid >> 3, lc = tid & 7;
  u32x4 ra[4], rb[2];
  const int nk = K / BK;
#pragma unroll
  for (int i = 0; i < 4; ++i) { const int q = tid + 512 * i; ra[i] = *(const u32x4*)(At + (size_t)(q >> 5) * ldt + (q & 31) * 8); }
#pragma unroll
  for (int i = 0; i < 2; ++i) rb[i] = *(const u32x4*)(Bt + (size_t)(n0 + lr + 64 * i) * ldb + lc * 8);
  __syncthreads();
#pragma unroll
  for (int i = 0; i < 4; ++i) { const int q = tid + 512 * i; *(u32x4*)(smem + (q >> 5) * AT_ROW + (q & 31) * 16) = ra[i]; }
#pragma unroll
  for (int i = 0; i < 2; ++i) *(u32x4*)(smem + LDS_AT + swz(lr + 64 * i, lc)) = rb[i];
  __syncthreads();
  const int hh = lane >> 5, gg = (lane >> 4) & 1, qq = (lane & 15) >> 2, pp = lane & 3;
  for (int kt = 0; kt < nk; ++kt) {
    char* cur = smem + (kt & 1) * LDS_STAGE_T;
    char* nxt = smem + ((kt + 1) & 1) * LDS_STAGE_T;
    const bool more = (kt + 1 < nk);
    if (more) {
#pragma unroll
      for (int i = 0; i < 4; ++i) { const int q = tid + 512 * i; ra[i] = *(const u32x4*)(At + (size_t)((kt + 1) * BK + (q >> 5)) * ldt + (q & 31) * 8); }
#pragma unroll
      for (int i = 0; i < 2; ++i) rb[i] = *(const u32x4*)(Bt + (size_t)(n0 + lr + 64 * i) * ldb + (kt + 1) * BK + lc * 8);
    }
#pragma unroll
    for (int s = 0; s < 4; ++s) {
      const int ch = 2 * s + hh;
      bf16x8 af[2], bfr[2];
#pragma unroll
      for (int mi = 0; mi < 2; ++mi) {
        const char* a0 = cur + (16 * s + 8 * hh + qq) * AT_ROW + (wm * 64 + mi * 32 + 16 * gg + 4 * pp) * 2;
        s16x4 lo = __builtin_amdgcn_ds_read_tr16_b64_v4i16((__attribute__((address_space(3))) s16x4*)(a0));
        s16x4 hi = __builtin_amdgcn_ds_read_tr16_b64_v4i16((__attribute__((address_space(3))) s16x4*)(a0 + 4 * AT_ROW));
        af[mi] = __builtin_shufflevector(lo, hi, 0, 1, 2, 3, 4, 5, 6, 7);
      }
#pragma unroll
      for (int ni = 0; ni < 2; ++ni) bfr[ni] = *(const bf16x8*)(cur + LDS_AT + swz(wn * 64 + ni * 32 + (lane & 31), ch));
#pragma unroll
      for (int mi = 0; mi < 2; ++mi)
#pragma unroll
        for (int ni = 0; ni < 2; ++ni) acc[mi][ni] = __builtin_amdgcn_mfma_f32_32x32x16_bf16(af[mi], bfr[ni], acc[mi][ni], 0, 0, 0);
    }
    if (more) {
#pragma unroll
      for (int i = 0; i < 4; ++i) { const int q = tid + 512 * i; *(u32x4*)(nxt + (q >> 5) * AT_ROW + (q & 31) * 16) = ra[i]; }
#pragma unroll
      for (int i = 0; i < 2; ++i) *(u32x4*)(nxt + LDS_AT + swz(lr + 64 * i, lc)) = rb[i];
    }
    __syncthreads();
  }
}

constexpr int G2_A = 32768, G2_STAGE = 65536;
template <bool SWAP>
DI void gemm256(f32x16 (&acc)[4][2], const ushort_t* __restrict__ A, int lda, int m0, const ushort_t* __restrict__ Bt, int ldb, int n0, int K, char* smem) {
  const int tid = tid_opaque(), lane = tid & 63, wave = tid >> 6;
  const int wm = wave >> 2, wn = wave & 3;
  const int lr = tid >> 3, lc = tid & 7;
  u32x4 ra[4], rb[4];
  const int nk = K / BK;
  const ushort_t* ap = A + (size_t)(m0 + lr) * lda + lc * 8;
  const ushort_t* bp = Bt + (size_t)(n0 + lr) * ldb + lc * 8;
#pragma unroll
  for (int i = 0; i < 4; ++i) { ra[i] = *(const u32x4*)(ap + (size_t)(64 * i) * lda); rb[i] = *(const u32x4*)(bp + (size_t)(64 * i) * ldb); }
  __syncthreads();
#pragma unroll
  for (int i = 0; i < 4; ++i) { *(u32x4*)(smem + swz(lr + 64 * i, lc)) = ra[i]; *(u32x4*)(smem + G2_A + swz(lr + 64 * i, lc)) = rb[i]; }
  __syncthreads();
  for (int kt = 0; kt < nk; ++kt) {
    char* cur = smem + (kt & 1) * G2_STAGE;
    char* nxt = smem + ((kt + 1) & 1) * G2_STAGE;
    const bool more = (kt + 1 < nk);
    if (more) {
#pragma unroll
      for (int i = 0; i < 4; ++i) { ra[i] = *(const u32x4*)(ap + (size_t)(64 * i) * lda + (kt + 1) * BK); rb[i] = *(const u32x4*)(bp + (size_t)(64 * i) * ldb + (kt + 1) * BK); }
    }
#pragma unroll
    for (int s = 0; s < 4; ++s) {
      const int ch = 2 * s + (lane >> 5);
      bf16x8 af[4], bfr[2];
#pragma unroll
      for (int mi = 0; mi < 4; ++mi) af[mi] = *(const bf16x8*)(cur + swz(wm * 128 + mi * 32 + (lane & 31), ch));
#pragma unroll
      for (int ni = 0; ni < 2; ++ni) bfr[ni] = *(const bf16x8*)(cur + G2_A + swz(wn * 64 + ni * 32 + (lane & 31), ch));
#pragma unroll
      for (int mi = 0; mi < 4; ++mi)
#pragma unroll
        for (int ni = 0; ni < 2; ++ni)
          acc[mi][ni] = SWAP ? __builtin_amdgcn_mfma_f32_32x32x16_bf16(bfr[ni], af[mi], acc[mi][ni], 0, 0, 0)
                             : __builtin_amdgcn_mfma_f32_32x32x16_bf16(af[mi], bfr[ni], acc[mi][ni], 0, 0, 0);
      if (s & 1) __builtin_amdgcn_sched_barrier(0);
    }
    if (more) {
#pragma unroll
      for (int i = 0; i < 4; ++i) { *(u32x4*)(nxt + swz(lr + 64 * i, lc)) = ra[i]; *(u32x4*)(nxt + G2_A + swz(lr + 64 * i, lc)) = rb[i]; }
    }
    __syncthreads();
  }
}
constexpr int G2T_A = 64 * 576, G2T_STAGE = G2T_A + 32768;
DI void gemm256_AT(f32x16 (&acc)[4][2], const ushort_t* __restrict__ At, size_t ldt, const ushort_t* __restrict__ Bt, int ldb, int n0, int K, char* smem) {
  const int tid = tid_opaque(), lane = tid & 63, wave = tid >> 6;
  const int wm = wave >> 2, wn = wave & 3;
  const int lr = tid >> 3, lc = tid & 7;
  u32x4 ra[4], rb[4];
  const int nk = K / BK;
  const ushort_t* bp = Bt + (size_t)(n0 + lr) * ldb + lc * 8;
#pragma unroll
  for (int i = 0; i < 4; ++i) { const int q = tid + 512 * i; ra[i] = *(const u32x4*)(At + (size_t)(q >> 5) * ldt + (q & 31) * 8); rb[i] = *(const u32x4*)(bp + (size_t)(64 * i) * ldb); }
  __syncthreads();
#pragma unroll
  for (int i = 0; i < 4; ++i) { const int q = tid + 512 * i; *(u32x4*)(smem + (q >> 5) * 576 + (q & 31) * 16) = ra[i]; *(u32x4*)(smem + G2T_A + swz(lr + 64 * i, lc)) = rb[i]; }
  __syncthreads();
  const int hh = lane >> 5, gg = (lane >> 4) & 1, qq = (lane & 15) >> 2, pp = lane & 3;
  for (int kt = 0; kt < nk; ++kt) {
    char* cur = smem + (kt & 1) * G2T_STAGE;
    char* nxt = smem + ((kt + 1) & 1) * G2T_STAGE;
    const bool more = (kt + 1 < nk);
    if (more) {
#pragma unroll
      for (int i = 0; i < 4; ++i) { const int q = tid + 512 * i; ra[i] = *(const u32x4*)(At + (size_t)((kt + 1) * BK + (q >> 5)) * ldt + (q & 31) * 8); rb[i] = *(const u32x4*)(bp + (size_t)(64 * i) * ldb + (kt + 1) * BK); }
    }
#pragma unroll
    for (int s = 0; s < 4; ++s) {
      const int ch = 2 * s + hh;
      bf16x8 af[4], bfr[2];
#pragma unroll
      for (int mi = 0; mi < 4; ++mi) {
        const char* a0 = cur + (16 * s + 8 * hh + qq) * 576 + (wm * 128 + mi * 32 + 16 * gg + 4 * pp) * 2;
        s16x4 lo = __builtin_amdgcn_ds_read_tr16_b64_v4i16((__attribute__((address_space(3))) s16x4*)(a0));
        s16x4 hi = __builtin_amdgcn_ds_read_tr16_b64_v4i16((__attribute__((address_space(3))) s16x4*)(a0 + 4 * 576));
        af[mi] = __builtin_shufflevector(lo, hi, 0, 1, 2, 3, 4, 5, 6, 7);
      }
#pragma unroll
      for (int ni = 0; ni < 2; ++ni) bfr[ni] = *(const bf16x8*)(cur + G2T_A + swz(wn * 64 + ni * 32 + (lane & 31), ch));
#pragma unroll
      for (int mi = 0; mi < 4; ++mi)
#pragma unroll
        for (int ni = 0; ni < 2; ++ni) acc[mi][ni] = __builtin_amdgcn_mfma_f32_32x32x16_bf16(af[mi], bfr[ni], acc[mi][ni], 0, 0, 0);
      if (s & 1) __builtin_amdgcn_sched_barrier(0);
    }
    if (more) {
#pragma unroll
      for (int i = 0; i < 4; ++i) { const int q = tid + 512 * i; *(u32x4*)(nxt + (q >> 5) * 576 + (q & 31) * 16) = ra[i]; *(u32x4*)(nxt + G2T_A + swz(lr + 64 * i, lc)) = rb[i]; }
    }
    __syncthreads();
  }
}
DI void acc_zero4(f32x16 (&acc)[4][2]) {
#pragma unroll
  for (int a = 0; a < 4; ++a)
#pragma unroll
    for (int b = 0; b < 2; ++b)
#pragma unroll
      for (int r = 0; r < 16; ++r) acc[a][b][r] = 0.f;
}
DI void acc_zero(f32x16 (&acc)[2][2]) {
#pragma unroll
  for (int a = 0; a < 2; ++a)
#pragma unroll
    for (int b = 0; b < 2; ++b)
#pragma unroll
      for (int r = 0; r < 16; ++r) acc[a][b][r] = 0.f;
}
#define ACC_ROW(mi, r) (wm * 64 + (mi) * 32 + ((r) & 3) + 8 * ((r) >> 2) + 4 * (lane >> 5))
#define ACC_COL(ni) (wn * 64 + (ni) * 32 + (lane & 31))

DI void stage_mod(float* mod, const float* ada, int b, int sc_chunk, int sh_chunk) {
  for (int i = tid_opaque(); i < 1024; i += NT) {
    mod[i] = 1.f + ada[b * 6144 + sc_chunk * 1024 + i];
    mod[1024 + i] = ada[b * 6144 + sh_chunk * 1024 + i];
  }
}


namespace pg8 {
#define PG8_LAS __attribute__((address_space(3)))
constexpr int BM8 = 256, BK8 = 64, HALF = 128, HTB = HALF * BK8 * 2, STAGE_BYTES = 8 * HTB, NXCD = 8, WGM = 8;
DI int lds_byte(int r, int c) { const int st = (r >> 4) * 2 + (c >> 5), rr = r & 15, cc = c & 31, ob = rr * 64 + cc * 2; return st * 1024 + (ob ^ (((ob >> 9) & 1) << 5)); }
DI void stage_rc(int b, int& R, int& C) { const int st = b / 1024, sb = b % 1024, sw = sb ^ (((sb >> 9) & 1) << 5); R = (st >> 1) * 16 + sw / 64; C = (st & 1) * 32 + (sw % 64) / 2; }
DI int perm32(int rho) { const int n = rho >> 4, i = rho & 15; return 8 * (i >> 2) + 4 * n + (i & 3); }
struct Unit { int pm, pn, kind; };
DI void tile_order(int L, int nM, int nN, int& pm, int& pn) {
  const int nwg = nM * nN;
  int wgid = L; { const int q = nwg / NXCD, r = nwg % NXCD, xcd = wgid % NXCD, off = wgid / NXCD; wgid = (xcd < r ? xcd * (q + 1) : r * (q + 1) + (xcd - r) * q) + off; }
  const int nig = WGM * nN, gid = wgid / nig, fm = gid * WGM, gsz = (nM - fm) < WGM ? (nM - fm) : WGM;
  pm = fm + ((wgid % nig) % gsz); pn = (wgid % nig) / gsz;
}
typedef float f32x4p __attribute__((ext_vector_type(4)));
template <class Epi, class Sched>
DI void gemm_phase(PG8_LAS unsigned char* lds, const int K_, const Sched& S, const Epi& E) {
    int K = K_; asm volatile("" : "+s"(K));
    const int tid = tid_opaque();
    const int wid = __builtin_amdgcn_readfirstlane(tid >> 6), lane = tid & 63, wr = wid >> 2, wc = wid & 3, fr = lane & 15, fq = lane >> 4;
    const int nt = K / BK8;
    unsigned voffA[2], voffB[2];
#pragma unroll
    for (int i = 0; i < 2; ++i) { int R, C; stage_rc(tid * 16 + i * 8192, R, C); const int Rb = Epi::PERM ? ((R & ~31) + perm32(R & 31)) : R;
        voffA[i] = (unsigned)(R * K + C) * 2u; voffB[i] = (unsigned)(Rb * K + C) * 2u; }
    const size_t kstep = (size_t)(BK8 * 2);
    const size_t hstep = (size_t)HALF * K * 2;
    const unsigned ldsw = (unsigned)wid * 1024u;
    const int aoff = lds_byte(wr * 64 + fr, fq * 8), boff = lds_byte(wc * 32 + fr, fq * 8);
#define PG8_SA(b, h) (((b) * 2 + (h)) * HTB)
#define PG8_SB(b, h) ((4 + (b) * 2 + (h)) * HTB)
#define PG8_STAGE(bufoff, gbase, voff) do { _Pragma("unroll") for (int _i = 0; _i < 2; ++_i) \
        __builtin_amdgcn_global_load_lds((const unsigned*)((const char*)(gbase) + (voff)[_i]), (PG8_LAS unsigned*)(lds + (bufoff) + ldsw + _i * 8192), 16, 0, 0); } while (0)
#define PG8_LDA(dst, b, h) do { _Pragma("unroll") for (int m = 0; m < 4; ++m) _Pragma("unroll") for (int k = 0; k < 2; ++k) dst[m][k] = *(const PG8_LAS bf16x8*)(lds + PG8_SA(b, h) + aoff + m * 2048 + k * 1024); } while (0)
#define PG8_LDB(dst, b, h) do { _Pragma("unroll") for (int n = 0; n < 2; ++n) _Pragma("unroll") for (int k = 0; k < 2; ++k) dst[n][k] = *(const PG8_LAS bf16x8*)(lds + PG8_SB(b, h) + boff + n * 2048 + k * 1024); } while (0)
#define PG8_MMA(ai, bj, At, Bt) do { __builtin_amdgcn_s_setprio(1); _Pragma("unroll") for (int m = 0; m < 4; ++m) _Pragma("unroll") for (int n = 0; n < 2; ++n) _Pragma("unroll") for (int k = 0; k < 2; ++k) \
        acc[ai][bj][m][n] = __builtin_amdgcn_mfma_f32_16x16x32_bf16(Bt[n][k], At[m][k], acc[ai][bj][m][n], 0, 0, 0); __builtin_amdgcn_s_setprio(0); } while (0)
#define PG8_WAIT_V(n) asm volatile("s_waitcnt vmcnt(" #n ")" ::: "memory")
#define PG8_WAIT_L(n) asm volatile("s_waitcnt lgkmcnt(" #n ")" ::: "memory")
#define PG8_BAR __builtin_amdgcn_s_barrier()
#define PG8_SCHED __builtin_amdgcn_sched_barrier(0)
    Unit cur, nxt; int ui = 0;
    if (!S.next(0, cur)) return;
    f32x4p acc[2][2][4][2];
#pragma unroll
    for (int a = 0; a < 2; ++a)
#pragma unroll
        for (int b = 0; b < 2; ++b)
#pragma unroll
            for (int m = 0; m < 4; ++m)
#pragma unroll
                for (int n = 0; n < 2; ++n) acc[a][b][m][n] = (f32x4p){0.f, 0.f, 0.f, 0.f};
    bf16x8 At[4][2], B0[2][2], B1[2][2];
    const char* cA = S.a_ptr(cur); const char* cB = S.b_ptr(cur);
    PG8_STAGE(PG8_SB(0, 0), cB, voffB); PG8_STAGE(PG8_SA(0, 0), cA, voffA); PG8_STAGE(PG8_SB(0, 1), cB + hstep, voffB); PG8_STAGE(PG8_SA(0, 1), cA + hstep, voffA);
    if (wr == 1) PG8_BAR;
    PG8_WAIT_V(4); PG8_BAR;
    PG8_STAGE(PG8_SB(1, 0), cB + kstep, voffB); PG8_STAGE(PG8_SA(1, 0), cA + kstep, voffA); PG8_STAGE(PG8_SB(1, 1), cB + hstep + kstep, voffB);
    PG8_WAIT_V(6); PG8_BAR;
    for (;;) {
        const bool has_next = S.next(ui + 1, nxt);
        const char* nA = has_next ? S.a_ptr(nxt) : cA; const char* nB = has_next ? S.b_ptr(nxt) : cB;
        for (int t = 0; t < nt; t += 2) {
            const bool last = (t == nt - 2);
            const char* a1 = cA + (size_t)(t + 1) * kstep;
            const char* a2 = last ? nA : cA + (size_t)(t + 2) * kstep; const char* b2 = last ? nB : cB + (size_t)(t + 2) * kstep;
            const char* a3 = a2 + kstep; const char* b3 = b2 + kstep;
            PG8_LDB(B0, 0, 0); PG8_SCHED; PG8_LDA(At, 0, 0); PG8_STAGE(PG8_SA(1, 1), a1 + hstep, voffA);
            PG8_WAIT_L(8); PG8_BAR; PG8_WAIT_L(0); PG8_MMA(0, 0, At, B0); PG8_BAR; PG8_SCHED;
            PG8_LDB(B1, 0, 1); PG8_STAGE(PG8_SB(0, 0), b2, voffB);
            PG8_BAR; PG8_WAIT_L(0); PG8_MMA(0, 1, At, B1); PG8_BAR;
            PG8_LDA(At, 0, 1); PG8_STAGE(PG8_SA(0, 0), a2, voffA);
            PG8_BAR; PG8_WAIT_L(0); PG8_MMA(1, 0, At, B0); PG8_BAR; PG8_SCHED;
            PG8_STAGE(PG8_SB(0, 1), b2 + hstep, voffB);
            PG8_WAIT_V(6); PG8_BAR; PG8_MMA(1, 1, At, B1); PG8_BAR;
            PG8_LDB(B0, 1, 0); PG8_SCHED; PG8_LDA(At, 1, 0); PG8_STAGE(PG8_SA(0, 1), a2 + hstep, voffA);
            PG8_WAIT_L(8); PG8_BAR; PG8_WAIT_L(0); PG8_MMA(0, 0, At, B0); PG8_BAR; PG8_SCHED;
            PG8_LDB(B1, 1, 1); PG8_STAGE(PG8_SB(1, 0), b3, voffB);
            PG8_BAR; PG8_WAIT_L(0); PG8_MMA(0, 1, At, B1); PG8_BAR;
            PG8_LDA(At, 1, 1); PG8_STAGE(PG8_SA(1, 0), a3, voffA);
            PG8_BAR; PG8_WAIT_L(0); PG8_MMA(1, 0, At, B0); PG8_BAR; PG8_SCHED;
            PG8_STAGE(PG8_SB(1, 1), b3 + hstep, voffB);
            PG8_WAIT_V(6); PG8_BAR; PG8_MMA(1, 1, At, B1); PG8_BAR;
        }
        if constexpr (!Epi::AFTER_DRAIN) E(acc, cur, wr, wc, fr, fq);
        if (!has_next) break;
#pragma unroll
        for (int a = 0; a < 2; ++a)
#pragma unroll
            for (int b = 0; b < 2; ++b)
#pragma unroll
                for (int m = 0; m < 4; ++m)
#pragma unroll
                    for (int n = 0; n < 2; ++n) acc[a][b][m][n] = (f32x4p){0.f, 0.f, 0.f, 0.f};
        cur = nxt; cA = nA; cB = nB; ++ui;
    }
    PG8_WAIT_V(0);
    if (wr == 0) PG8_BAR;
    PG8_BAR;
    if constexpr (Epi::AFTER_DRAIN) E.fused(acc, cur, wr, wc, fr, fq, lds, wid, lane);
#undef PG8_SA
#undef PG8_SB
#undef PG8_STAGE
#undef PG8_LDA
#undef PG8_LDB
#undef PG8_MMA
#undef PG8_WAIT_V
#undef PG8_WAIT_L
#undef PG8_BAR
#undef PG8_SCHED
}
}
typedef pg8::f32x4p f32x4p;
DI u32x4 pack8(const f32x4p& a, const f32x4p& b) { u32x4 w; w[0] = pack2(a[0], a[1]); w[1] = pack2(a[2], a[3]); w[2] = pack2(b[0], b[1]); w[3] = pack2(b[2], b[3]); return w; }

struct InprojSched {
  const char* u1b; const char* wt; int G, c;
  DI bool next(int i, pg8::Unit& u) const {
    const int L = i * G + c;
    if (L >= 384 + 1088) return false;
    if (L < 384) { u.kind = 0; pg8::tile_order(L, 6, 64, u.pm, u.pn); } else { u.kind = 1; pg8::tile_order(L - 384, 64, 17, u.pm, u.pn); }
    return true;
  }
  DI const char* a_ptr(const pg8::Unit& u) const { return u.kind == 0 ? wt + (size_t)u.pm * (256 * 1024 * 2) : u1b + (size_t)u.pm * (256 * 1024 * 2); }
  DI const char* b_ptr(const pg8::Unit& u) const { return u.kind == 0 ? u1b + (size_t)u.pn * (256 * 1024 * 2) : wt + (size_t)(1536 + u.pn * 256) * (1024 * 2); }
};
struct InprojEpi {
  static constexpr bool PERM = true, AFTER_DRAIN = false;
  ushort_t* ph; ushort_t* qkv; ushort_t* gate; const float* rope;
  DI void operator()(const f32x4p (&acc)[2][2][4][2], const pg8::Unit& u, int wr, int wc, int fr, int fq) const {
    if (u.kind == 0) {
      const int b = (u.pn * 256) >> 13;
      ushort_t* base = ph + ((size_t)(b * HYC + u.pm * 256 + wr * 64 + fr)) * S_ + ((u.pn * 256) & (S_ - 1)) + wc * 32 + 8 * fq;
#pragma unroll
      for (int ai = 0; ai < 2; ++ai)
#pragma unroll
        for (int m = 0; m < 4; ++m)
#pragma unroll
          for (int bj = 0; bj < 2; ++bj) *(u32x4*)(base + (size_t)(ai * 128 + m * 16) * S_ + bj * 128) = pack8(acc[ai][bj][m][0], acc[ai][bj][m][1]);
      return;
    }
    const int row0 = u.pm * 256 + wr * 64 + fr;
    if (u.pn < 9) {
      const int cq0 = u.pn * 256 + wc * 32 + 8 * fq;
      const bool rotw = (u.pn < 6) && ((wc & 1) == 0);
      const float qs = (u.pn < 3) ? 0.125f : 1.0f;
#pragma unroll
      for (int ai = 0; ai < 2; ++ai)
#pragma unroll
        for (int m = 0; m < 4; ++m) {
          const int row = row0 + ai * 128 + m * 16;
          f32x4p cs[4];
          if (rotw) {
#pragma unroll
            for (int q = 0; q < 4; ++q) cs[q] = *(const f32x4p*)(rope + (size_t)row * 16 + q * 4);
          }
#pragma unroll
          for (int bj = 0; bj < 2; ++bj) {
            f32x4p v0 = acc[ai][bj][m][0], v1 = acc[ai][bj][m][1];
            if (rotw) {
              f32x4p o0, o1;
#pragma unroll
              for (int j = 0; j < 4; ++j) { o0[j] = __shfl_xor(v0[j], 16); o1[j] = __shfl_xor(v1[j], 16); }
              if (fq < 2) {
                const float sg = (fq == 0) ? -1.f : 1.f;
#pragma unroll
                for (int j = 0; j < 4; ++j) {
                  const float c0 = cs[j >> 1][(j & 1) * 2], s0 = cs[j >> 1][(j & 1) * 2 + 1];
                  const float c1 = cs[2 + (j >> 1)][(j & 1) * 2], s1 = cs[2 + (j >> 1)][(j & 1) * 2 + 1];
                  v0[j] = v0[j] * c0 + sg * o0[j] * s0;
                  v1[j] = v1[j] * c1 + sg * o1[j] * s1;
                }
              }
            }
            *(u32x4*)(qkv + (size_t)row * QKVC + cq0 + bj * 128) = pack8(v0 * qs, v1 * qs);
          }
        }
    } else {
      const int cg0 = (u.pn - 9) * 256 + wc * 32 + 8 * fq;
#pragma unroll
      for (int ai = 0; ai < 2; ++ai)
#pragma unroll
        for (int m = 0; m < 4; ++m)
#pragma unroll
          for (int bj = 0; bj < 2; ++bj) {
            f32x4p v0 = acc[ai][bj][m][0], v1 = acc[ai][bj][m][1];
#pragma unroll
            for (int j = 0; j < 4; ++j) { v0[j] = 1.f / (1.f + __expf(-v0[j])); v1[j] = 1.f / (1.f + __expf(-v1[j])); }
            *(u32x4*)(gate + (size_t)(row0 + ai * 128 + m * 16) * GATEC + cg0 + bj * 128) = pack8(v0, v1);
          }
    }
  }
};
DI void phase_inproj(const P& p, char* smem) {
  InprojSched S{p.ws + OFF_U1B, p.ws + OFF_WIN_T, (int)gridDim.x, (int)blockIdx.x};
  InprojEpi E{(ushort_t*)(p.ws + OFF_PH), (ushort_t*)(p.ws + OFF_QKV), (ushort_t*)(p.ws + OFF_GATE), (const float*)(p.ws + OFF_ROPE)};
  pg8::gemm_phase(( __attribute__((address_space(3))) unsigned char*)smem, 1024, S, E);
}
struct PlainSched {
  const char* A; const char* Bt; int nM, nN, K, G, c;
  DI bool next(int i, pg8::Unit& u) const { const int L = i * G + c; if (L >= nM * nN) return false; u.kind = 0; pg8::tile_order(L, nM, nN, u.pm, u.pn); return true; }
  DI const char* a_ptr(const pg8::Unit& u) const { return A + (size_t)u.pm * 256 * K * 2; }
  DI const char* b_ptr(const pg8::Unit& u) const { return Bt + (size_t)u.pn * 256 * K * 2; }
};
struct OutprojEpi {
  static constexpr bool PERM = false, AFTER_DRAIN = false;
  const float* x; float* out; const float* ada;
  DI void operator()(const f32x4p (&acc)[2][2][4][2], const pg8::Unit& u, int wr, int wc, int fr, int fq) const {
    const int row0 = u.pm * 256 + wr * 64 + fr, col0 = u.pn * 256 + wc * 32 + 4 * fq, b = (u.pm * 256) / S_;
    f32x4p g1[2][2];
#pragma unroll
    for (int bj = 0; bj < 2; ++bj)
#pragma unroll
      for (int n = 0; n < 2; ++n) g1[bj][n] = *(const f32x4p*)(ada + b * 6144 + 2 * 1024 + col0 + bj * 128 + n * 16) + 1.0f;
#pragma unroll
    for (int ai = 0; ai < 2; ++ai)
#pragma unroll
      for (int m = 0; m < 4; ++m) {
        const size_t ro = (size_t)(row0 + ai * 128 + m * 16) * 1024 + col0;
#pragma unroll
        for (int bj = 0; bj < 2; ++bj)
#pragma unroll
          for (int n = 0; n < 2; ++n) {
            const f32x4p xv = *(const f32x4p*)(x + ro + bj * 128 + n * 16);
            *(f32x4p*)(out + ro + bj * 128 + n * 16) = xv * DN_ALPHA + g1[bj][n] * acc[ai][bj][m][n];
          }
      }
  }
};
DI void phase_outproj(const P& p, char* smem) {
  PlainSched S{p.ws + OFF_MERGED, p.ws + OFF_WOUT_T, 64, 4, 1024, (int)gridDim.x, (int)blockIdx.x};
  OutprojEpi E{p.x, p.out, (const float*)(p.ws + OFF_ADA)};
  pg8::gemm_phase(( __attribute__((address_space(3))) unsigned char*)smem, 1024, S, E);
}

DI float sconv_t(const ushort_t* row, int t, float w0, float w1, float w2, float cb) {
  float v = cb + w1 * bf2f(row[t]);
  if (t > 0) v += w0 * bf2f(row[t - 1]);
  if (t < S_ - 1) v += w2 * bf2f(row[t + 1]);
  return v;
}
DI void fft_C_mul_invC(cf2* lds, const cf2* __restrict__ kq, int tid) {
  asm volatile("" : "+v"(tid));
  const int k1 = tid >> 5, k2 = tid & 31;
  kq += tid;
#pragma unroll
  for (int h = 0; h < 2; ++h) {
    float tr[16], ti[16];
    cf2 kv[16];
#pragma unroll
    for (int i = 0; i < 16; ++i) kv[i] = kq[(h * 16 + i) * 512];
    cf2* blk = lds + (k1 + 16 * h) * FFT_SA + k2 * 17;
#pragma unroll
    for (int mp = 0; mp < 16; ++mp) { cf2 v = blk[mp]; tr[mp] = v.x; ti[mp] = v.y; }
    dft_fwd<16, false>(tr, ti);
#pragma unroll
    for (int i = 0; i < 16; ++i) { const float a = tr[i], b = ti[i]; tr[i] = a * kv[i].x - b * kv[i].y; ti[i] = a * kv[i].y + b * kv[i].x; }
    dft_inv<16>(tr, ti);
#pragma unroll
    for (int mp = 0; mp < 16; ++mp) { cf2 o; o.x = tr[mp]; o.y = ti[mp]; blk[mp] = o; }
  }
}
DI void hyena_item(const P& p, char* smem, int c) {
  cf2* lds = (cf2*)smem;
  const ushort_t* pht = (const ushort_t*)(p.ws + OFF_PH);
  ushort_t* yht = (ushort_t*)(p.ws + OFF_YH);
  cf2* kq = (cf2*)(p.ws + (blockIdx.x < 92 ? OFF_WIN_T + (size_t)blockIdx.x * 131072 : OFF_HSCR + (size_t)(blockIdx.x - 92) * 131072));
  const float* filt = p.out;
  const int tid0 = tid_opaque();
  float zr[32], zi[32];
  __syncthreads();
#pragma unroll 1
  for (int o = 0; o < 2; ++o) {
    int tid = tid0; asm volatile("" : "+v"(tid));
    {
      float kr[32], ki[32];
      const float* fw = filt + (size_t)(0 * 1024 + o * 512 + c) * S_;
      const float* bw = filt + (size_t)(1 * 1024 + o * 512 + c) * S_;
      const float bias = p.hy_bias[o * 512 + c];
#pragma unroll
      for (int n1 = 0; n1 < 16; ++n1) { kr[n1] = fw[n1 * 512 + tid] * (1.0f / 16384.0f); ki[n1] = 0.f; }
      if (tid == 0) kr[0] += bias * (1.0f / 16384.0f);
#pragma unroll
      for (int n1 = 16; n1 < 32; ++n1) {
        const int n = n1 * 512 + tid;
        kr[n1] = (n == S_) ? 0.f : bw[2 * S_ - n] * (1.0f / 16384.0f); ki[n1] = 0.f;
      }
      fft_fwdA<false>(kr, ki, lds, tid); __syncthreads();
      fft_B_read(kr, ki, lds, tid); __syncthreads();
      fft_fwdB_write(kr, ki, lds, tid); __syncthreads();
      fft_fwdC(kr, ki, lds, tid);
      int ts = tid; asm volatile("" : "+v"(ts));
      cf2* kqt = kq + ts;
#pragma unroll
      for (int r = 0; r < 32; ++r) { cf2 v; v.x = kr[r]; v.y = ki[r]; kqt[r * 512] = v; }
      __syncthreads();
    }
    asm volatile("" : "+v"(tid));
    if (o == 0) {
      const float w0 = p.hy_conv_w[c], w1 = p.hy_conv_w[HYC + c], w2 = p.hy_conv_w[2 * HYC + c], cb = p.hy_conv_b[c];
      const ushort_t* r0 = pht + (size_t)(0 * HYC + c) * S_;
      const ushort_t* r1 = pht + (size_t)(1 * HYC + c) * S_;
#pragma unroll
      for (int n1 = 0; n1 < 16; ++n1) {
        const int t = n1 * 512 + tid;
        zr[n1] = sconv_t(r0, t, w0, w1, w2, cb); zi[n1] = sconv_t(r1, t, w0, w1, w2, cb);
        if (n1 & 1) asm volatile("" ::: "memory");
      }
    }
#pragma unroll
    for (int n1 = 16; n1 < 32; ++n1) { zr[n1] = 0.f; zi[n1] = 0.f; }
    fft_fwdA<true>(zr, zi, lds, tid); __syncthreads();
    fft_B_read(zr, zi, lds, tid); __syncthreads();
    fft_fwdB_write(zr, zi, lds, tid); __syncthreads();
    fft_C_mul_invC(lds, kq, tid); __syncthreads();
    fft_invB_read(zr, zi, lds, tid); __syncthreads();
    fft_invB_write(zr, zi, lds, tid); __syncthreads();
    fft_invA(zr, zi, lds, tid);
    int tg = tid; asm volatile("" : "+v"(tg));
    const int gch = (o + 1) * 512 + c;
    const float w0 = p.hy_conv_w[gch], w1 = p.hy_conv_w[HYC + gch], w2 = p.hy_conv_w[2 * HYC + gch], cb = p.hy_conv_b[gch];
    const ushort_t* g0 = pht + (size_t)(0 * HYC + gch) * S_;
    const ushort_t* g1 = pht + (size_t)(1 * HYC + gch) * S_;
#pragma unroll
    for (int n1 = 0; n1 < 16; ++n1) {
      const int t = n1 * 512 + tg;
      zr[n1] *= sconv_t(g0, t, w0, w1, w2, cb);
      zi[n1] *= sconv_t(g1, t, w0, w1, w2, cb);
      if (n1 & 1) asm volatile("" ::: "memory");
    }
    if (o == 1) {
#pragma unroll
      for (int n1 = 0; n1 < 16; ++n1) {
        const int t = n1 * 512 + tg;
        yht[(size_t)(0 * HW_ + c) * S_ + t] = f2bf(zr[n1]);
        yht[(size_t)(1 * HW_ + c) * S_ + t] = f2bf(zi[n1]);
      }
    }
  }
}

constexpr int ATT_VROW = 192;
constexpr int ATT_VBUF = 32 * ATT_VROW;
DI void attn_item(const P& p, char* smem, int item) {
  const ushort_t* qkv = (const ushort_t*)(p.ws + OFF_QKV);
  ushort_t* ya = (ushort_t*)(p.ws + OFF_YA);
  const int tid = tid_opaque(), lane = tid & 63, wave = tid >> 6;
  const int u = item * 8 + wave;
  const int hs = u & 3, r16 = (u >> 2) & 15, chunk = (u >> 6) & 15, b = u >> 10;
  const int qi = lane & 31, h = lane >> 5;
  char* vl = smem + wave * ATT_VBUF;
  const int tq = chunk * 512 + r16 + 16 * qi;
  const size_t bbase = (size_t)b * S_;
  f32x16 o0, o1;
#pragma unroll
  for (int r = 0; r < 16; ++r) { o0[r] = 0.f; o1[r] = 0.f; }
  float m = -1e30f, l = 0.f;
  const int g16 = (lane >> 4) & 1, q4 = (lane & 15) >> 2, p4 = lane & 3;
  __syncthreads();
#pragma unroll 1
  for (int g = 0; g < 3; ++g) {
    const int dsh = 2 * g;
    const int d = 1 << dsh, sd = 16 >> dsh, n = S_ >> dsh;
    const int head = g * 4 + hs;
    const int rc = r16 & (d - 1);
    const int P0 = (chunk * 512 + r16 - rc) >> dsh;
    const int pq = P0 + sd * qi;
    const int KB = P0 - 64;
    const int ntile = (g == 0) ? 20 : (g == 1 ? 8 : 5);
    bf16x8 bq[4];
    {
      const ushort_t* qrow = qkv + (bbase + tq) * QKVC + head * 64;
#pragma unroll
      for (int s = 0; s < 4; ++s) bq[s] = *(const bf16x8*)(qrow + (2 * s + h) * 8);
    }
    bf16x8 kn[4]; u32x4 vn[4];
    {
      const int kp = min(max(KB + qi, 0), n - 1);
      const ushort_t* krow = qkv + (bbase + rc + ((size_t)kp << dsh)) * QKVC + 768 + head * 64;
#pragma unroll
      for (int s = 0; s < 4; ++s) kn[s] = *(const bf16x8*)(krow + (2 * s + h) * 8);
#pragma unroll
      for (int i = 0; i < 4; ++i) {
        const int c = lane + 64 * i, row = c >> 3, ch = c & 7;
        const int vp = min(max(KB + row, 0), n - 1);
        vn[i] = *(const u32x4*)(qkv + (bbase + rc + ((size_t)vp << dsh)) * QKVC + 1536 + head * 64 + ch * 8);
      }
    }
#pragma unroll 1
    for (int kt = 0; kt < ntile; ++kt) {
      bf16x8 kc[4]; u32x4 vc[4];
#pragma unroll
      for (int s = 0; s < 4; ++s) kc[s] = kn[s];
#pragma unroll
      for (int i = 0; i < 4; ++i) vc[i] = vn[i];
      if (kt + 1 < ntile) {
        const int kb1 = KB + 32 * (kt + 1);
        const int kp = min(max(kb1 + qi, 0), n - 1);
        const ushort_t* krow = qkv + (bbase + rc + ((size_t)kp << dsh)) * QKVC + 768 + head * 64;
#pragma unroll
        for (int s = 0; s < 4; ++s) kn[s] = *(const bf16x8*)(krow + (2 * s + h) * 8);
#pragma unroll
        for (int i = 0; i < 4; ++i) {
          const int c = lane + 64 * i, row = c >> 3, ch = c & 7;
          const int vp = min(max(kb1 + row, 0), n - 1);
          vn[i] = *(const u32x4*)(qkv + (bbase + rc + ((size_t)vp << dsh)) * QKVC + 1536 + head * 64 + ch * 8);
        }
      }
      f32x16 st;
#pragma unroll
      for (int r = 0; r < 16; ++r) st[r] = 0.f;
#pragma unroll
      for (int s = 0; s < 4; ++s) st = __builtin_amdgcn_mfma_f32_32x32x16_bf16(kc[s], bq[s], st, 0, 0, 0);
#pragma unroll
      for (int i = 0; i < 4; ++i) { const int c = lane + 64 * i; *(u32x4*)(vl + (c >> 3) * ATT_VROW + (c & 7) * 16) = vc[i]; }
      const int kb = KB + 32 * kt + 4 * h;
      const int dk = kb - pq;
      float mx = -1e30f;
      bool ok[16];
#pragma unroll
      for (int r = 0; r < 16; ++r) {
        const int cr = (r & 3) + 8 * (r >> 2);
        ok[r] = ((unsigned)(dk + cr + 64) <= 128u) && ((unsigned)(kb + cr) < (unsigned)n);
        mx = fmaxf(mx, ok[r] ? st[r] : -1e30f);
      }
      mx = fmaxf(mx, __shfl_xor(mx, 32));
      const float mnew = fmaxf(m, mx);
      const float corr = __expf(m - mnew);
      float ps = 0.f;
      float pv[16];
#pragma unroll
      for (int r = 0; r < 16; ++r) { pv[r] = ok[r] ? __expf(st[r] - mnew) : 0.f; ps += pv[r]; }
      ps += __shfl_xor(ps, 32);
      l = l * corr + ps; m = mnew;
#pragma unroll
      for (int r = 0; r < 16; ++r) { o0[r] *= corr; o1[r] *= corr; }
      bf16x8 pf[2];
#pragma unroll
      for (int s = 0; s < 2; ++s) {
        u32x4 w;
        w[0] = pack2(pv[8 * s + 0], pv[8 * s + 1]); w[1] = pack2(pv[8 * s + 2], pv[8 * s + 3]);
        w[2] = pack2(pv[8 * s + 4], pv[8 * s + 5]); w[3] = pack2(pv[8 * s + 6], pv[8 * s + 7]);
        pf[s] = __builtin_bit_cast(bf16x8, w);
      }
      __builtin_amdgcn_wave_barrier();
      asm volatile("s_waitcnt lgkmcnt(0)" ::: "memory");
#pragma unroll
      for (int s = 0; s < 2; ++s) {
#pragma unroll
        for (int nt = 0; nt < 2; ++nt) {
          const char* a0 = vl + (16 * s + 4 * h + q4) * ATT_VROW + (32 * nt + 16 * g16 + 4 * p4) * 2;
          s16x4 lo = __builtin_amdgcn_ds_read_tr16_b64_v4i16((__attribute__((address_space(3))) s16x4*)(a0));
          s16x4 hi = __builtin_amdgcn_ds_read_tr16_b64_v4i16((__attribute__((address_space(3))) s16x4*)(a0 + 8 * ATT_VROW));
          const bf16x8 vf = __builtin_shufflevector(lo, hi, 0, 1, 2, 3, 4, 5, 6, 7);
          if (nt == 0) o0 = __builtin_amdgcn_mfma_f32_32x32x16_bf16(vf, pf[s], o0, 0, 0, 0);
          else o1 = __builtin_amdgcn_mfma_f32_32x32x16_bf16(vf, pf[s], o1, 0, 0, 0);
        }
      }
      __builtin_amdgcn_wave_barrier();
      asm volatile("s_waitcnt lgkmcnt(0)" ::: "memory");
    }
  }
  const float il = 1.f / l;
  ushort_t* op = ya + (bbase + tq) * 256 + hs * 64;
#pragma unroll
  for (int gq = 0; gq < 4; ++gq) {
    uint2 w0, w1;
    w0.x = pack2(o0[4 * gq] * il, o0[4 * gq + 1] * il); w0.y = pack2(o0[4 * gq + 2] * il, o0[4 * gq + 3] * il);
    w1.x = pack2(o1[4 * gq] * il, o1[4 * gq + 1] * il); w1.y = pack2(o1[4 * gq + 2] * il, o1[4 * gq + 3] * il);
    *(uint2*)(op + 8 * gq + 4 * h) = w0;
    *(uint2*)(op + 32 + 8 * gq + 4 * h) = w1;
  }
}

DI void phase_yh_transpose(const P& p, char* smem) {
  const ushort_t* yht = (const ushort_t*)(p.ws + OFF_YH);
  ushort_t* yhk = (ushort_t*)(p.ws + OFF_YHK);
  const int tid = tid_opaque();
  for (int item = blockIdx.x; item < 1024; item += gridDim.x) {
    const int cg = item & 15, tc = item >> 4, b = tc >> 5, t0 = (tc * 256) & (S_ - 1);
    __syncthreads();
    {
      const int ch = tid >> 4, k16 = tid & 15;
      const ushort_t* srcp = yht + (size_t)(b * HW_ + cg * 32 + ch) * S_ + t0;
#pragma unroll
      for (int i = 0; i < 2; ++i) *(u32x4*)(smem + ch * 528 + (k16 + 16 * i) * 16) = *(const u32x4*)(srcp + (k16 + 16 * i) * 8);
    }
    __syncthreads();
    {
      const int t = tid >> 1, half = tid & 1;
      unsigned w[8];
#pragma unroll
      for (int k = 0; k < 8; ++k) {
        const unsigned lo = *(const ushort_t*)(smem + (half * 16 + 2 * k) * 528 + t * 2);
        const unsigned hi = *(const ushort_t*)(smem + (half * 16 + 2 * k + 1) * 528 + t * 2);
        w[k] = lo | (hi << 16);
      }
      ushort_t* dst = yhk + (size_t)(tc * 256 + t) * HW_ + cg * 32 + half * 16;
      u32x4 o0, o1; o0[0] = w[0]; o0[1] = w[1]; o0[2] = w[2]; o0[3] = w[3]; o1[0] = w[4]; o1[1] = w[5]; o1[2] = w[6]; o1[3] = w[7];
      *(u32x4*)dst = o0; *(u32x4*)(dst + 8) = o1;
    }
  }
}
DI f32x4p bf4lo(const u32x4& w) { f32x4p r; r[0] = __uint_as_float(w[0] << 16); r[1] = __uint_as_float(w[0] & 0xffff0000u); r[2] = __uint_as_float(w[1] << 16); r[3] = __uint_as_float(w[1] & 0xffff0000u); return r; }
DI f32x4p bf4hi(const u32x4& w) { f32x4p r; r[0] = __uint_as_float(w[2] << 16); r[1] = __uint_as_float(w[2] & 0xffff0000u); r[2] = __uint_as_float(w[3] << 16); r[3] = __uint_as_float(w[3] & 0xffff0000u); return r; }
template <bool ADD>
struct MergeEpi {
  static constexpr bool PERM = true, AFTER_DRAIN = false;
  const ushort_t* gate; ushort_t* merged;
  DI void operator()(const f32x4p (&acc)[2][2][4][2], const pg8::Unit& u, int wr, int wc, int fr, int fq) const {
    const ushort_t* gb = gate + (size_t)(u.pm * 256) * GATEC + u.pn * 256;
    ushort_t* mb = merged + (size_t)(u.pm * 256) * 1024 + u.pn * 256;
    const unsigned lg = (unsigned)((wr * 64 + fr) * GATEC + wc * 32 + 8 * fq), lm = (unsigned)((wr * 64 + fr) * 1024 + wc * 32 + 8 * fq);
#pragma unroll
    for (int ai = 0; ai < 2; ++ai)
#pragma unroll
      for (int m = 0; m < 4; ++m) {
#pragma unroll
        for (int bj = 0; bj < 2; ++bj) {
          const u32x4 gw = *(const u32x4*)(gb + (ai * 128 + m * 16) * GATEC + bj * 128 + lg);
          f32x4p v0 = bf4lo(gw) * acc[ai][bj][m][0], v1 = bf4hi(gw) * acc[ai][bj][m][1];
          ushort_t* mp = mb + (ai * 128 + m * 16) * 1024 + bj * 128 + lm;
          if (ADD) { const u32x4 mw = *(const u32x4*)mp; v0 += bf4lo(mw); v1 += bf4hi(mw); }
          *(u32x4*)mp = pack8(v0, v1);
        }
        asm volatile("" ::: "memory");
      }
  }
};
DI void phase_merge(const P& p, char* smem) {
  {
    PlainSched S{p.ws + OFF_YHK, p.ws + OFF_WBH_T, 64, 4, 512, (int)gridDim.x, (int)blockIdx.x};
    MergeEpi<false> E{(const ushort_t*)(p.ws + OFF_GATE), (ushort_t*)(p.ws + OFF_MERGED)};
    pg8::gemm_phase(( __attribute__((address_space(3))) unsigned char*)smem, 512, S, E);
  }
  {
    PlainSched S{p.ws + OFF_YA, p.ws + OFF_WBA_T, 64, 4, 256, (int)gridDim.x, (int)blockIdx.x};
    MergeEpi<true> E{(const ushort_t*)(p.ws + OFF_GATE) + 1024, (ushort_t*)(p.ws + OFF_MERGED)};
    pg8::gemm_phase(( __attribute__((address_space(3))) unsigned char*)smem, 256, S, E);
  }
}

DI void phase_ln(float* __restrict__ xio, const float* __restrict__ g, const float* __restrict__ bta) {
  const int tq = tid_opaque(); const int lane = tq & 63, wave = tq >> 6;
  for (int row = blockIdx.x * 8 + wave; row < T_; row += gridDim.x * 8) {
    float* rp = xio + (size_t)row * 1024;
    f32x4 v[4];
    float s = 0.f;
#pragma unroll
    for (int i = 0; i < 4; ++i) { v[i] = *(const f32x4*)(rp + i * 256 + lane * 4); s += v[i][0] + v[i][1] + v[i][2] + v[i][3]; }
    const float mu = wave_sum(s) * (1.f / 1024.f);
    float q = 0.f;
#pragma unroll
    for (int i = 0; i < 4; ++i)
#pragma unroll
      for (int j = 0; j < 4; ++j) { float d = v[i][j] - mu; q += d * d; }
    const float rs = rsqrtf(wave_sum(q) * (1.f / 1024.f) + LN_EPS);
#pragma unroll
    for (int i = 0; i < 4; ++i) {
      f32x4 gg = *(const f32x4*)(g + i * 256 + lane * 4), bb = *(const f32x4*)(bta + i * 256 + lane * 4), o;
#pragma unroll
      for (int j = 0; j < 4; ++j) o[j] = (v[i][j] - mu) * rs * gg[j] + bb[j];
      *(f32x4*)(rp + i * 256 + lane * 4) = o;
    }
  }
}

DI int swz256(int row, int ch) { return row * 256 + ((ch ^ (row & 15)) << 4); }
DI void ins16(float (&L)[16], float x) {
#pragma unroll
  for (int i = 0; i < 16; ++i) { const float hi = __builtin_fmaxf(L[i], x); x = __builtin_fminf(L[i], x); L[i] = hi; }
}
DI void bitonic16_desc(float (&M)[16]) {
#pragma unroll
  for (int d = 8; d >= 1; d >>= 1)
#pragma unroll
    for (int i = 0; i < 16; ++i)
      if ((i & d) == 0) { const float a = M[i], b = M[i + d]; M[i] = __builtin_fmaxf(a, b); M[i + d] = __builtin_fminf(a, b); }
}
constexpr int ROUTE_Q_OFF = 0, ROUTE_K_OFF = 65536, ROUTE_IDX_OFF = 106496;
DI void phase_route(const P& p, char* smem) {
  const float* ada = (const float*)(p.ws + OFF_ADA);
  float* mod = (float*)(smem + 2 * LDS_STAGE);
  const ushort_t* keysb = (const ushort_t*)(p.ws + OFF_KEYS_B);
  int* idx = (int*)(p.ws + OFF_IDX);
  float* gv = (float*)(p.ws + OFF_GV);
  for (int item = blockIdx.x; item < (T_ / BM) * 8; item += gridDim.x) {
    const int tid = tid_opaque(), lane = tid & 63, wave = tid >> 6, wm = wave >> 1, wn = wave & 1;
    const int m0 = (item >> 3) * BM, hh = item & 7;
    float L0[16];
#pragma unroll 1
    for (int pp = 0; pp < 2; ++pp) {
      const int hp = hh * 2 + pp;
      f32x16 acc[2][2]; acc_zero(acc);
      ALoadBf16 al{(const ushort_t*)(p.ws + OFF_U2B), 1024};
      gemm_mainloop<ALoadBf16, true>(acc, al, m0, (const ushort_t*)(p.ws + OFF_WQ_T), 1024, hp * 128, 1024, smem);
#pragma unroll
      for (int mi = 0; mi < 2; ++mi) {
        const int tok = wm * 64 + mi * 32 + (lane & 31);
#pragma unroll
        for (int ni = 0; ni < 2; ++ni)
#pragma unroll
          for (int g = 0; g < 4; ++g) {
            const int ch = wn * 8 + ni * 4 + g;
            uint2 v; v.x = pack2(acc[mi][ni][4 * g], acc[mi][ni][4 * g + 1]); v.y = pack2(acc[mi][ni][4 * g + 2], acc[mi][ni][4 * g + 3]);
            *(uint2*)(smem + ROUTE_Q_OFF + swz256(tok, ch) + 8 * (lane >> 5)) = v;
          }
      }
#pragma unroll
      for (int i = 0; i < 4; ++i) {
        const int q = tid + 512 * i, row = q >> 4, ch = q & 15;
        *(u32x4*)(smem + ROUTE_K_OFF + swz256(row, ch)) = *(const u32x4*)(keysb + (size_t)hp * 16384 + row * 128 + ch * 8);
      }
      __syncthreads();
      f32x16 sc[4];
#pragma unroll
      for (int ks = 0; ks < 4; ++ks)
#pragma unroll
        for (int r = 0; r < 16; ++r) sc[ks][r] = 0.f;
#pragma unroll
      for (int s = 0; s < 8; ++s) {
        const int ch = 2 * s + (lane >> 5);
        const bf16x8 bq = *(const bf16x8*)(smem + ROUTE_Q_OFF + swz256(wave * 32 + (lane & 31), ch));
#pragma unroll
        for (int ks = 0; ks < 4; ++ks) {
          const bf16x8 ak = *(const bf16x8*)(smem + ROUTE_K_OFF + swz256(ks * 32 + (lane & 31), ch));
          sc[ks] = __builtin_amdgcn_mfma_f32_32x32x16_bf16(ak, bq, sc[ks], 0, 0, 0);
        }
      }
      float L[16];
#pragma unroll
      for (int i = 0; i < 16; ++i) L[i] = -3.0e38f;
      const unsigned hbit = (unsigned)(lane >> 5) << 2;
#pragma unroll
      for (int ks = 0; ks < 4; ++ks)
#pragma unroll
        for (int r = 0; r < 16; ++r) {
          const unsigned key = (unsigned)(ks * 32 + (r & 3) + 8 * (r >> 2)) | hbit;
          ins16(L, __uint_as_float((__float_as_uint(sc[ks][r]) & ~127u) | key));
        }
      {
        float M[16];
#pragma unroll
        for (int i = 0; i < 16; ++i) M[i] = __builtin_fmaxf(L[i], __shfl_xor(L[15 - i], 32));
        bitonic16_desc(M);
#pragma unroll
        for (int i = 0; i < 16; ++i) L[i] = M[i];
      }
      if (pp == 0) {
#pragma unroll
        for (int i = 0; i < 16; ++i) L0[i] = L[i];
      } else {
        unsigned char* ib = (unsigned char*)(smem + ROUTE_IDX_OFF) + tid * 32;
#pragma unroll
        for (int i = 0; i < 16; ++i) { ib[i] = (unsigned char)(__float_as_uint(L0[i]) & 127u); ib[16 + i] = (unsigned char)(__float_as_uint(L[i]) & 127u); }
        float F[16];
#pragma unroll
        for (int i = 0; i < 16; ++i) F[i] = -3.0e38f;
#pragma unroll
        for (int i = 0; i < 16; ++i) {
          const float ai = __uint_as_float(__float_as_uint(L0[i]) & ~127u);
#pragma unroll
          for (int j = 0; j < 16; ++j)
            if ((i + 1) * (j + 1) <= 16) {
              const float s = ai + __uint_as_float(__float_as_uint(L[j]) & ~127u);
              ins16(F, __uint_as_float((__float_as_uint(s) & ~255u) | (unsigned)(i * 16 + j)));
            }
        }
        const float mx = __uint_as_float(__float_as_uint(F[0]) & ~255u);
        float e[16], sum = 0.f;
#pragma unroll
        for (int k = 0; k < 16; ++k) { e[k] = __expf(__uint_as_float(__float_as_uint(F[k]) & ~255u) - mx); sum += e[k]; }
        const float inv = 1.f / sum;
        if (lane < 32) {
          const int tok = m0 + wave * 32 + lane;
          int* ip = idx + (size_t)tok * 128 + hh * 16;
          float* gp = gv + (size_t)tok * 128 + hh * 16;
#pragma unroll
          for (int k4 = 0; k4 < 4; ++k4) {
            int4 iv; f32x4 g4;
            int ee[4];
#pragma unroll
            for (int u = 0; u < 4; ++u) {
              const unsigned code = __float_as_uint(F[k4 * 4 + u]) & 255u;
              ee[u] = (int)ib[code >> 4] * 128 + (int)ib[16 + (code & 15u)];
              g4[u] = e[k4 * 4 + u] * inv;
            }
            iv.x = ee[0]; iv.y = ee[1]; iv.z = ee[2]; iv.w = ee[3];
            *(int4*)(ip + k4 * 4) = iv;
            *(f32x4*)(gp + k4 * 4) = g4;
          }
        }
      }
    }
  }
}

DI void phase_rope(const P& p) {
  float* rt = (float*)(p.ws + OFF_ROPE);
  for (int i = blockIdx.x * NT + tid_opaque(); i < T_ * 8; i += gridDim.x * NT) {
    const float inv = expf(-13.122363377404328f * (float)(i & 7) * 0.125f);
    const float x = (float)p.pos[i >> 3] * inv;
    const float k = rintf(x * 0.15915494309189535f);
    float r = fmaf(-k, 6.28125f, x);
    r = fmaf(-k, 1.9353071795864769e-3f, r);
    float sn, cs; __sincosf(r, &sn, &cs);
    rt[2 * i] = cs; rt[2 * i + 1] = sn;
  }
}
DI void phase_keys(const P& p) {
  ushort_t* keysb = (ushort_t*)(p.ws + OFF_KEYS_B);
  for (int i = blockIdx.x * NT + tid_opaque(); i < 16 * 128 * 128 / 4; i += gridDim.x * NT) {
    f32x4 v = *(const f32x4*)(p.keys + (size_t)i * 4);
    uint2 o; o.x = pack2(v[0], v[1]); o.y = pack2(v[2], v[3]);
    *(uint2*)(keysb + (size_t)i * 4) = o;
  }
}

typedef __bf16 bf16x2_t __attribute__((ext_vector_type(2)));
DI float dot2bf(unsigned a, unsigned b, float c) { return __builtin_amdgcn_fdot2_f32_bf16(__builtin_bit_cast(bf16x2_t, a), __builtin_bit_cast(bf16x2_t, b), c, false); }
DI void phase_ln1(const P& p) {
  const float* ada = (const float*)(p.ws + OFF_ADA);
  ushort_t* u2b = (ushort_t*)(p.ws + OFF_U2B);
  const int tq = tid_opaque(); const int lane = tq & 63, wave = tq >> 6;
  for (int row = blockIdx.x * 8 + wave; row < T_; row += gridDim.x * 8) {
    const int b = row / S_;
    float* rp = p.out + (size_t)row * 1024;
    f32x4 v[4];
    float s = 0.f;
#pragma unroll
    for (int i = 0; i < 4; ++i) { v[i] = *(const f32x4*)(rp + i * 256 + lane * 4); s += v[i][0] + v[i][1] + v[i][2] + v[i][3]; }
    const float mu = wave_sum(s) * (1.f / 1024.f);
    float q = 0.f;
#pragma unroll
    for (int i = 0; i < 4; ++i)
#pragma unroll
      for (int j = 0; j < 4; ++j) { float d = v[i][j] - mu; q += d * d; }
    const float rs = rsqrtf(wave_sum(q) * (1.f / 1024.f) + LN_EPS);
#pragma unroll
    for (int i = 0; i < 4; ++i) {
      const int col = i * 256 + lane * 4;
      f32x4 gg = *(const f32x4*)(p.ln1_g + col), bb = *(const f32x4*)(p.ln1_b + col), o;
      f32x4 sc = *(const f32x4*)(ada + b * 6144 + 4 * 1024 + col), sh = *(const f32x4*)(ada + b * 6144 + 3 * 1024 + col);
#pragma unroll
      for (int j = 0; j < 4; ++j) o[j] = (v[i][j] - mu) * rs * gg[j] + bb[j];
      *(f32x4*)(rp + col) = o;
      uint2 w; w.x = pack2(o[0] * (1.f + sc[0]) + sh[0], o[1] * (1.f + sc[1]) + sh[1]); w.y = pack2(o[2] * (1.f + sc[2]) + sh[2], o[3] * (1.f + sc[3]) + sh[3]);
      *(uint2*)(u2b + (size_t)row * 1024 + col) = w;
    }
  }
}
DI float wave_max(float v) {
#pragma unroll
  for (int o = 32; o > 0; o >>= 1) v = fmaxf(v, __shfl_xor(v, o));
  return v;
}
DI unsigned pack4_fp8(float a, float b, float c, float d) {
  int w = 0;
  w = __builtin_amdgcn_cvt_pk_fp8_f32(a, b, w, false);
  w = __builtin_amdgcn_cvt_pk_fp8_f32(c, d, w, true);
  return (unsigned)w;
}
DI void phase_tabconv(const P& p) {
  unsigned char* tu = (unsigned char*)(p.ws + OFF_TABU);
  unsigned char* tv = (unsigned char*)(p.ws + OFF_TABV);
  float* su = (float*)(p.ws + OFF_SU);
  float* sv = (float*)(p.ws + OFF_SV);
  const int tq = tid_opaque(); const int lane = tq & 63, wave = tq >> 6;
  for (int e = blockIdx.x * 8 + wave; e < 16384; e += gridDim.x * 8) {
    f32x4 a[4], c[4];
    float ma = 0.f, mc = 0.f;
#pragma unroll
    for (int i = 0; i < 4; ++i) {
      const int col = i * 256 + lane * 4;
      a[i] = *(const f32x4*)(p.pu + (size_t)e * 1024 + col);
      c[i] = *(const f32x4*)(p.pv + (size_t)e * 1024 + col);
#pragma unroll
      for (int j = 0; j < 4; ++j) { ma = fmaxf(ma, fabsf(a[i][j])); mc = fmaxf(mc, fabsf(c[i][j])); }
    }
    ma = wave_max(ma); mc = wave_max(mc);
    const float sa = (ma > 0.f) ? ma * (1.0f / 448.0f) : 1.0f, sc = (mc > 0.f) ? mc * (1.0f / 448.0f) : 1.0f;
    const float ia = 1.0f / sa, ic = 1.0f / sc;
    if (lane == 0) { su[e] = sa; sv[e] = sc; }
#pragma unroll
    for (int i = 0; i < 4; ++i) {
      const int col = i * 256 + lane * 4;
      *(unsigned*)(tu + (size_t)e * 1024 + col) = pack4_fp8(a[i][0] * ia, a[i][1] * ia, a[i][2] * ia, a[i][3] * ia);
      const int slice = i * 2 + (lane >> 5);
      *(unsigned*)(tv + ((size_t)slice * 16384 + e) * 128 + (lane & 31) * 4) = pack4_fp8(c[i][0] * ic, c[i][1] * ic, c[i][2] * ic, c[i][3] * ic);
    }
  }
}

template <int CTRL> DI float dpp_f(float v) { return __int_as_float(__builtin_amdgcn_mov_dpp(__float_as_int(v), CTRL, 0xf, 0xf, false)); }
template <int CTRL> DI int dpp_shr0(int v) { return __builtin_amdgcn_update_dpp(0, v, CTRL, 0xf, 0xf, true); }
template <int I> DI int bcast16(int v) { return __builtin_amdgcn_mov_dpp(v, 0x150 + I, 0xf, 0xf, false); }
DI float row_sum16(float d) {
  d += dpp_f<0xB1>(d);
  d += dpp_f<0x4E>(d);
  d += dpp_f<0x141>(d);
  d += dpp_f<0x140>(d);
  return d;
}
typedef __bf16 bf16x2_c __attribute__((ext_vector_type(2)));
DI float dot4_fp8(unsigned w8, unsigned xlo, unsigned xhi, float acc) {
  const bf16x2_c lo = __builtin_amdgcn_cvt_scalef32_pk_bf16_fp8((int)w8, 1.0f, false);
  const bf16x2_c hi = __builtin_amdgcn_cvt_scalef32_pk_bf16_fp8((int)w8, 1.0f, true);
  acc = __builtin_amdgcn_fdot2_f32_bf16(lo, __builtin_bit_cast(bf16x2_c, xlo), acc, false);
  return __builtin_amdgcn_fdot2_f32_bf16(hi, __builtin_bit_cast(bf16x2_c, xhi), acc, false);
}
DI void phase_upass(const P& p, char* smem) {
  const int* idx = (const int*)(p.ws + OFF_IDX);
  const float* gv = (const float*)(p.ws + OFF_GV);
  const ushort_t* u2b = (const ushort_t*)(p.ws + OFF_U2B);
  const char* tabu = (const char*)(p.ws + OFF_TABU);
  const float* su = (const float*)(p.ws + OFF_SU);
  const float* sv = (const float*)(p.ws + OFF_SV);
  float* coef = (float*)(p.ws + OFF_COEF);
  const int tq = tid_opaque(); const int lane = tq & 63, wave = tq >> 6;
  const int g = lane >> 4, j = lane & 15;
  int4* lst = (int4*)smem + wave * 512 + g * 128;
  const int part = blockIdx.x & 7, bi = blockIdx.x >> 3, nb = (gridDim.x - part + 7) >> 3;
  __syncthreads();
#pragma unroll 1
  for (int tb = (bi * 8 + wave) * 4; tb < T_; tb += nb * 32) {
    const int tok = tb + g;
    const int4 i0 = *(const int4*)(idx + (size_t)tb * 128 + lane * 8), i1 = *(const int4*)(idx + (size_t)tb * 128 + lane * 8 + 4);
    const f32x4 g0 = *(const f32x4*)(gv + (size_t)tb * 128 + lane * 8), g1 = *(const f32x4*)(gv + (size_t)tb * 128 + lane * 8 + 4);
    u32x4 xr[8];
#pragma unroll
    for (int c = 0; c < 4; ++c) {
      xr[2 * c] = *(const u32x4*)(u2b + (size_t)tok * 1024 + (j + 16 * c) * 16);
      xr[2 * c + 1] = *(const u32x4*)(u2b + (size_t)tok * 1024 + (j + 16 * c) * 16 + 8);
    }
    const int ev[8] = {i0.x, i0.y, i0.z, i0.w, i1.x, i1.y, i1.z, i1.w};
    const float gg[8] = {g0[0], g0[1], g0[2], g0[3], g1[0], g1[1], g1[2], g1[3]};
    int cnt = 0;
#pragma unroll
    for (int i = 0; i < 8; ++i) cnt += ((ev[i] >> 11) == part) ? 1 : 0;
    int incl = cnt;
    incl += dpp_shr0<0x111>(incl); incl += dpp_shr0<0x112>(incl); incl += dpp_shr0<0x114>(incl); incl += dpp_shr0<0x118>(incl);
    const int ng = bcast16<15>(incl);
    int pos = incl - cnt;
#pragma unroll
    for (int i = 0; i < 8; ++i)
      if ((ev[i] >> 11) == part) { int4 en; en.x = ev[i]; en.y = __float_as_int(gg[i]); en.z = j * 8 + i; en.w = 0; lst[pos] = en; ++pos; }
    const int nmax = max(max(__builtin_amdgcn_readlane(ng, 0), __builtin_amdgcn_readlane(ng, 16)), max(__builtin_amdgcn_readlane(ng, 32), __builtin_amdgcn_readlane(ng, 48)));
    __builtin_amdgcn_wave_barrier();
    asm volatile("s_waitcnt lgkmcnt(0)" ::: "memory");
    u32x4 ra[4], rb[4], rc[4], rd[4];
#define UP_LOAD(R, IT) { const unsigned e_ = ((IT) < ng) ? (unsigned)lst[(IT)].x : 0u; const char* row_ = tabu + (size_t)e_ * 1024 + j * 16; \
                         _Pragma("unroll") for (int c = 0; c < 4; ++c) R[c] = *(const u32x4*)(row_ + c * 256); }
#define UP_COMP(R, IT) { float a0 = 0.f, a1 = 0.f, a2 = 0.f, a3 = 0.f; \
      _Pragma("unroll") for (int c = 0; c < 4; ++c) { \
        a0 = dot4_fp8(R[c][0], xr[2 * c][0], xr[2 * c][1], a0); a1 = dot4_fp8(R[c][1], xr[2 * c][2], xr[2 * c][3], a1); \
        a2 = dot4_fp8(R[c][2], xr[2 * c + 1][0], xr[2 * c + 1][1], a2); a3 = dot4_fp8(R[c][3], xr[2 * c + 1][2], xr[2 * c + 1][3], a3); } \
      const float d_ = row_sum16((a0 + a1) + (a2 + a3)); \
      if (j == 0 && (IT) < ng) ((int*)&lst[(IT)])[3] = __float_as_int(d_); }
    UP_LOAD(ra, 0) UP_LOAD(rb, 1) UP_LOAD(rc, 2) UP_LOAD(rd, 3)
#pragma unroll 1
    for (int it = 0; it < nmax; it += 4) {
      UP_COMP(ra, it)     UP_LOAD(ra, it + 4)
      UP_COMP(rb, it + 1) UP_LOAD(rb, it + 5)
      UP_COMP(rc, it + 2) UP_LOAD(rc, it + 6)
      UP_COMP(rd, it + 3) UP_LOAD(rd, it + 7)
    }
#undef UP_LOAD
#undef UP_COMP
    __builtin_amdgcn_wave_barrier();
    asm volatile("s_waitcnt lgkmcnt(0)" ::: "memory");
#pragma unroll 1
    for (int k = 0; k < nmax; k += 16) {
      if (k + j < ng) {
        const int4 en = lst[k + j];
        const float a = __int_as_float(en.w) * su[en.x];
        coef[(size_t)tok * 128 + en.z] = __int_as_float(en.y) * 0.5f * a * (1.f + erff(a * 0.7071067811865475f)) * sv[en.x];
      }
    }
    __builtin_amdgcn_wave_barrier();
    asm volatile("s_waitcnt lgkmcnt(0)" ::: "memory");
  }
}

struct VHdr { int ea, eb, ca, cb; };
DI VHdr vp_hdr(const int* idx, const float* coef, int tok, int g, int cq) {
  VHdr h;
  h.ea = idx[(size_t)tok * 128 + g * 32 + cq]; h.eb = idx[(size_t)tok * 128 + g * 32 + 16 + cq];
  h.ca = __float_as_int(coef[(size_t)tok * 128 + g * 32 + cq]); h.cb = __float_as_int(coef[(size_t)tok * 128 + g * 32 + 16 + cq]);
  return h;
}
DI void vp_rows(uint2 (&va)[16], uint2 (&vb)[16], const VHdr& h, const char* tb) {
#define VP_STEP(I) { va[I] = *(const uint2*)(tb + (unsigned)bcast16<I>(h.ea) * 128u); vb[I] = *(const uint2*)(tb + (unsigned)bcast16<I>(h.eb) * 128u); }
  VP_STEP(0) VP_STEP(1) VP_STEP(2) VP_STEP(3) VP_STEP(4) VP_STEP(5) VP_STEP(6) VP_STEP(7)
  VP_STEP(8) VP_STEP(9) VP_STEP(10) VP_STEP(11) VP_STEP(12) VP_STEP(13) VP_STEP(14) VP_STEP(15)
#undef VP_STEP
}
DI void vp_coefs(float (&fa)[16], float (&fb)[16], const VHdr& h) {
#define VP_STEP(I) { fa[I] = __int_as_float(bcast16<I>(h.ca)); fb[I] = __int_as_float(bcast16<I>(h.cb)); }
  VP_STEP(0) VP_STEP(1) VP_STEP(2) VP_STEP(3) VP_STEP(4) VP_STEP(5) VP_STEP(6) VP_STEP(7)
  VP_STEP(8) VP_STEP(9) VP_STEP(10) VP_STEP(11) VP_STEP(12) VP_STEP(13) VP_STEP(14) VP_STEP(15)
#undef VP_STEP
}
DI void vp_fma8(float (&a)[8], float cf, const uint2& v) {
  const f32x2_hw p0 = __builtin_amdgcn_cvt_pk_f32_fp8((int)v.x, false), p1 = __builtin_amdgcn_cvt_pk_f32_fp8((int)v.x, true);
  const f32x2_hw p2 = __builtin_amdgcn_cvt_pk_f32_fp8((int)v.y, false), p3 = __builtin_amdgcn_cvt_pk_f32_fp8((int)v.y, true);
  a[0] += cf * p0[0]; a[1] += cf * p0[1]; a[2] += cf * p1[0]; a[3] += cf * p1[1];
  a[4] += cf * p2[0]; a[5] += cf * p2[1]; a[6] += cf * p3[0]; a[7] += cf * p3[1];
}
DI void vp_consume(const uint2 (&va)[16], const uint2 (&vb)[16], const VHdr& h, float* f, int tok, int slice, int g, int cq, bool live) {
  float fa[16], fb[16];
  vp_coefs(fa, fb, h);
  float a[8];
#pragma unroll
  for (int i = 0; i < 8; ++i) a[i] = 0.f;
#pragma unroll
  for (int i = 0; i < 16; ++i) { vp_fma8(a, fa[i], va[i]); vp_fma8(a, fb[i], vb[i]); }
#pragma unroll
  for (int i = 0; i < 8; ++i) { a[i] += __shfl_xor(a[i], 16); a[i] += __shfl_xor(a[i], 32); }
  if (g == 0 && live) {
    f32x4 o0, o1; o0[0] = a[0]; o0[1] = a[1]; o0[2] = a[2]; o0[3] = a[3]; o1[0] = a[4]; o1[1] = a[5]; o1[2] = a[6]; o1[3] = a[7];
    float* fp = f + (size_t)tok * 1024 + slice * 128 + cq * 8;
    *(f32x4*)fp = o0; *(f32x4*)(fp + 4) = o1;
  }
}
DI void phase_vpass(const P& p) {
  const int* idx = (const int*)(p.ws + OFF_IDX);
  const float* coef = (const float*)(p.ws + OFF_COEF);
  const char* tabv = (const char*)(p.ws + OFF_TABV);
  float* f = (float*)(p.ws + OFF_F);
  const int tq = tid_opaque(); const int lane = tq & 63, wave = tq >> 6;
  const int g = lane >> 4, cq = lane & 15;
  const int slice = blockIdx.x & 7, bi = blockIdx.x >> 3, nb = (gridDim.x - slice + 7) >> 3;
  const int step = nb * 8;
  const char* tb = tabv + (size_t)slice * (16384 * 128) + cq * 8;
  int tok = bi * 8 + wave;
  if (tok >= T_) return;
  VHdr h0 = vp_hdr(idx, coef, tok, g, cq);
  VHdr h1 = vp_hdr(idx, coef, min(tok + step, T_ - 1), g, cq);
  uint2 va[16], vb[16], na[16], nb2[16];
  vp_rows(va, vb, h0, tb);
#pragma unroll 1
  for (; tok < T_; tok += 2 * step) {
    const VHdr h2 = vp_hdr(idx, coef, min(tok + 2 * step, T_ - 1), g, cq);
    vp_rows(na, nb2, h1, tb);
    vp_consume(va, vb, h0, f, tok, slice, g, cq, true);
    const VHdr h3 = vp_hdr(idx, coef, min(tok + 3 * step, T_ - 1), g, cq);
    vp_rows(va, vb, h2, tb);
    vp_consume(na, nb2, h1, f, tok + step, slice, g, cq, tok + step < T_);
    h0 = h2; h1 = h3;
  }
}

DI void phase_ln2(const P& p) {
  const float* ada = (const float*)(p.ws + OFF_ADA);
  const float* f = (const float*)(p.ws + OFF_F);
  const int tq = tid_opaque(); const int lane = tq & 63, wave = tq >> 6;
  for (int tok = blockIdx.x * 8 + wave; tok < T_; tok += gridDim.x * 8) {
    const int b = tok / S_;
    float* rp = p.out + (size_t)tok * 1024;
    f32x4 acc[4];
    float sm = 0.f;
#pragma unroll
    for (int i = 0; i < 4; ++i) {
      const int col = i * 256 + lane * 4;
      f32x4 x1 = *(const f32x4*)(rp + col), ff = *(const f32x4*)(f + (size_t)tok * 1024 + col);
      f32x4 g2 = *(const f32x4*)(ada + b * 6144 + 5 * 1024 + col);
#pragma unroll
      for (int j = 0; j < 4; ++j) { acc[i][j] = DN_ALPHA * x1[j] + (1.f + g2[j]) * ff[j]; sm += acc[i][j]; }
    }
    const float mu = wave_sum(sm) * (1.f / 1024.f);
    float q = 0.f;
#pragma unroll
    for (int i = 0; i < 4; ++i)
#pragma unroll
      for (int j = 0; j < 4; ++j) { float d = acc[i][j] - mu; q += d * d; }
    const float rs = rsqrtf(wave_sum(q) * (1.f / 1024.f) + LN_EPS);
#pragma unroll
    for (int i = 0; i < 4; ++i) {
      const int col = i * 256 + lane * 4;
      f32x4 gg = *(const f32x4*)(p.ln2_g + col), bb = *(const f32x4*)(p.ln2_b + col), o;
#pragma unroll
      for (int j = 0; j < 4; ++j) o[j] = (acc[i][j] - mu) * rs * gg[j] + bb[j];
      *(f32x4*)(rp + col) = o;
    }
  }
}

#define XB_TMO      128
#define XB_XCNT(j)  (256  + 64 * (j))
#define XB_XSUB(j)  (1280 + 64 * (j))
#define XB_XGEN(j)  (2304 + 64 * (j))
#define XB_TOP      3328
#define XB_TOPGEN   3392
#define XCD_BAR_WORDS 3456
#define XB_SPIN_CAP (1u << 22)
#define LAS __attribute__((address_space(3)))
DI unsigned xb_ld(unsigned* p)              { return __hip_atomic_load(p, __ATOMIC_RELAXED, __HIP_MEMORY_SCOPE_AGENT); }
DI unsigned xb_add(unsigned* p, unsigned v) { return __hip_atomic_fetch_add(p, v, __ATOMIC_RELAXED, __HIP_MEMORY_SCOPE_AGENT); }
DI unsigned xb_xcc_id() { return (unsigned)__builtin_amdgcn_s_getreg((3 << 11) | 20) & 0xFu; }
#define XB_SPIN(cond, bar) do { unsigned _sp = 0; while (cond) { __builtin_amdgcn_s_sleep(1); \
    if ((++_sp & 255u) == 0u) { if (xb_ld(&(bar)[XB_TMO])) break; if (_sp > XB_SPIN_CAP) { atomicAdd(&(bar)[XB_TMO], 1u); break; } } } } while (0)
struct XcdBarrier { unsigned* bar; unsigned x; volatile LAS unsigned* st; };
DI XcdBarrier xcd_barrier_post(unsigned* bar, volatile LAS unsigned* st) {
  XcdBarrier b; b.bar = bar; b.x = xb_xcc_id(); b.st = st;
  if (threadIdx.x == 0) (void)xb_add(&bar[XB_XCNT(b.x)], 1u);
  return b;
}
DI void xcd_barrier_complete(unsigned* bar, unsigned x, unsigned& nloc, unsigned& nx) {
  const unsigned G = gridDim.x * gridDim.y * gridDim.z;
  unsigned sum, cnt, mine, sp = 0u;
  for (;;) {
    sum = 0u; cnt = 0u; mine = 0u;
#pragma unroll
    for (unsigned j = 0; j < 16; ++j) { const unsigned c = xb_ld(&bar[XB_XCNT(j)]); sum += c; cnt += (c > 0u) ? 1u : 0u; mine = (j == x) ? c : mine; }
    if (sum == G) break;
    __builtin_amdgcn_s_sleep(1);
    if ((++sp & 255u) == 0u) { if (xb_ld(&bar[XB_TMO])) break; if (sp > XB_SPIN_CAP) { atomicAdd(&bar[XB_TMO], 1u); break; } }
  }
  nloc = mine > 0u ? mine : 1u; nx = cnt > 0u ? cnt : 1u;
}
DI void xcd_barrier(unsigned* barp, char* stp) {
  asm volatile("s_waitcnt vmcnt(0)" ::: "memory");
  __syncthreads();
  if (threadIdx.x == 0) {
    XcdBarrier b; b.bar = barp; b.x = xb_xcc_id(); b.st = (volatile LAS unsigned*)stp;
    unsigned* bar = b.bar;
    __builtin_amdgcn_s_waitcnt(0);
    unsigned nloc = b.st[0], nx = b.st[1];
    if (nloc == 0u) { xcd_barrier_complete(bar, b.x, nloc, nx); b.st[0] = nloc; b.st[1] = nx; }
    const unsigned old = xb_add(&bar[XB_XSUB(b.x)], 1u);
    const unsigned gen = old / nloc;
    if (old + 1u == (gen + 1u) * nloc) {
      __builtin_amdgcn_fence(__ATOMIC_RELEASE, "agent");
      asm volatile("s_waitcnt vmcnt(0)" ::: "memory");
      const unsigned og = xb_add(&bar[XB_TOP], 1u);
      const unsigned tg = og / nx;
      if (og + 1u == (tg + 1u) * nx) xb_add(&bar[XB_TOPGEN], 1u);
      else XB_SPIN(xb_ld(&bar[XB_TOPGEN]) == tg, bar);
      __builtin_amdgcn_fence(__ATOMIC_ACQUIRE, "agent");
      xb_add(&bar[XB_XGEN(b.x)], 1u);
      asm volatile("s_waitcnt vmcnt(0)" ::: "memory");
    } else {
      XB_SPIN(xb_ld(&bar[XB_XGEN(b.x)]) == gen, bar);
      __builtin_amdgcn_fence(__ATOMIC_ACQUIRE, "agent");
      asm volatile("s_waitcnt vmcnt(0)" ::: "memory");
    }
  }
  __syncthreads();
}

constexpr int SMEM_BYTES = 143360;
__global__ void __launch_bounds__(NT) fwd_megakernel(P p) {
  __shared__ __attribute__((aligned(16))) char smem[SMEM_BYTES + 16];
  if (threadIdx.x < 4) ((volatile LAS unsigned*)(smem + SMEM_BYTES))[threadIdx.x] = 0u;
  __syncthreads();
  (void)xcd_barrier_post((unsigned*)(p.ws + OFF_BAR), (volatile LAS unsigned*)(smem + SMEM_BYTES));
  phase_ada(p, smem);
  xcd_barrier((unsigned*)(p.ws + OFF_BAR), smem + SMEM_BYTES);
  phase_u1(p);
  phase_transposes(p, smem);
  phase_keys(p);
  phase_rope(p);
  phase_filter(p, smem);
  xcd_barrier((unsigned*)(p.ws + OFF_BAR), smem + SMEM_BYTES);
  phase_inproj(p, smem);
  xcd_barrier((unsigned*)(p.ws + OFF_BAR), smem + SMEM_BYTES);
  for (int item = blockIdx.x; item < 512 + 256; item += gridDim.x) {
    if (item < 512) hyena_item(p, smem, item);
    else attn_item(p, smem, item - 512);
  }
  xcd_barrier((unsigned*)(p.ws + OFF_BAR), smem + SMEM_BYTES);
  phase_yh_transpose(p, smem);
  xcd_barrier((unsigned*)(p.ws + OFF_BAR), smem + SMEM_BYTES);
  phase_merge(p, smem);
  xcd_barrier((unsigned*)(p.ws + OFF_BAR), smem + SMEM_BYTES);
  phase_outproj(p, smem);
  xcd_barrier((unsigned*)(p.ws + OFF_BAR), smem + SMEM_BYTES);
  phase_ln1(p);
  phase_tabconv(p);
  xcd_barrier((unsigned*)(p.ws + OFF_BAR), smem + SMEM_BYTES);
  phase_route(p, smem);
  xcd_barrier((unsigned*)(p.ws + OFF_BAR), smem + SMEM_BYTES);
  phase_upass(p, smem);
  xcd_barrier((unsigned*)(p.ws + OFF_BAR), smem + SMEM_BYTES);
  phase_vpass(p);
  xcd_barrier((unsigned*)(p.ws + OFF_BAR), smem + SMEM_BYTES);
  phase_ln2(p);
}

extern "C" void kernel_launch(void* const* d_in, const int* in_sizes, int n_in, void* d_out, int out_size, void* d_ws, size_t ws_size,
                              hipStream_t stream) {
  P p{};
  p.x = (const float*)d_in[0]; p.c = (const float*)d_in[1]; p.pos = (const int*)d_in[2];
  p.w_ada = (const float*)d_in[3]; p.b_ada = (const float*)d_in[4]; p.w_in = (const float*)d_in[5];
  p.hy_conv_w = (const float*)d_in[6]; p.hy_conv_b = (const float*)d_in[7];
  p.f1_w = (const float*)d_in[8]; p.f1_b = (const float*)d_in[9]; p.f1_freq = (const float*)d_in[10];
  p.f2_w = (const float*)d_in[11]; p.f2_b = (const float*)d_in[12]; p.f2_freq = (const float*)d_in[13];
  p.f3_w = (const float*)d_in[14]; p.hy_bias = (const float*)d_in[15];
  p.w_bh = (const float*)d_in[16]; p.w_ba = (const float*)d_in[17]; p.w_out = (const float*)d_in[18];
  p.ln1_g = (const float*)d_in[19]; p.ln1_b = (const float*)d_in[20];
  p.wq = (const float*)d_in[21]; p.keys = (const float*)d_in[22]; p.pu = (const float*)d_in[23]; p.pv = (const float*)d_in[24];
  p.ln2_g = (const float*)d_in[25]; p.ln2_b = (const float*)d_in[26];
  p.out = (float*)d_out; p.ws = (char*)d_ws;

  static int grid_blocks = 0;
  if (!grid_blocks) {
    int dev = 0, cus = 0, per_cu = 0;
    hipGetDevice(&dev);
    hipDeviceGetAttribute(&cus, hipDeviceAttributeMultiprocessorCount, dev);
    hipOccupancyMaxActiveBlocksPerMultiprocessor(&per_cu, fwd_megakernel, NT, 0);
    if (per_cu > 1) per_cu = 1;
    grid_blocks = cus * per_cu;
  }
  (void)hipMemsetAsync((char*)d_ws + OFF_BAR, 0, XCD_BAR_WORDS * 4, stream);
  void* args[] = {&p};
  hipError_t e = hipLaunchCooperativeKernel((void*)fwd_megakernel, dim3(grid_blocks), dim3(NT), args, 0, stream);
  if (e != hipSuccess) fprintf(stderr, "cooperative launch failed: %s (grid %d)\n", hipGetErrorString(e), grid_blocks);
}
```

```cpp
#include <hip/hip_runtime.h>
#include <hip/hip_cooperative_groups.h>
#include <cstdio>
#include <cstdint>

#define DI __device__ __forceinline__
typedef unsigned short ushort_t;
typedef __attribute__((ext_vector_type(8))) short bf16x8;
typedef __attribute__((ext_vector_type(16))) float f32x16;
typedef __attribute__((ext_vector_type(4))) float f32x4;
typedef __attribute__((ext_vector_type(4))) unsigned u32x4;

constexpr int T_ = 16384, S_ = 8192, NB = 2, D_ = 1024;
constexpr int HW_ = 512, HYC = 1536, QKVC = 2304, GATEC = 2048, INW = 5888;
constexpr int NT = 512;
constexpr float DN_ALPHA = 1.189207115002721f;
constexpr float LN_EPS = 1e-5f;

constexpr size_t OFF_ADA   = 0;
constexpr size_t OFF_BAR   = 49152;
constexpr size_t OFF_KEYS_B= 65536;
constexpr size_t OFF_WIN_T = 65536 + 524288;
constexpr size_t OFF_WQ_T  = OFF_WIN_T + (size_t)INW * 1024 * 2;
constexpr size_t OFF_WOUT_T= OFF_WQ_T + (size_t)2048 * 1024 * 2;
constexpr size_t OFF_WBH_T = OFF_WOUT_T + (size_t)1024 * 1024 * 2;
constexpr size_t OFF_WBA_T = OFF_WBH_T + (size_t)1024 * 512 * 2;
constexpr size_t OFF_PH    = OFF_WBA_T + (size_t)1024 * 256 * 2;
constexpr size_t OFF_QKV   = OFF_PH + (size_t)T_ * HYC * 2;
constexpr size_t OFF_GATE  = OFF_QKV + (size_t)T_ * QKVC * 2;
constexpr size_t OFF_YH    = OFF_GATE + (size_t)T_ * GATEC * 2;
constexpr size_t OFF_YA    = OFF_YH + (size_t)T_ * HW_ * 2;
constexpr size_t OFF_END   = OFF_YA + (size_t)T_ * 256 * 2;
constexpr size_t OFF_MERGED= OFF_PH;
constexpr size_t OFF_YHK   = OFF_PH + (size_t)32 * 1048576;
constexpr size_t OFF_U1B   = OFF_YH;
static_assert(OFF_U1B + (size_t)T_ * 1024 * 2 <= 268435456ull, "u1b overflow");
constexpr size_t OFF_U2B   = OFF_PH;
constexpr size_t OFF_TABU  = OFF_QKV;
constexpr size_t OFF_TABV  = OFF_QKV + (size_t)16 * 1048576;
constexpr size_t OFF_SU    = OFF_QKV + (size_t)32 * 1048576;
constexpr size_t OFF_SV    = OFF_SU + 65536;
constexpr size_t OFF_COEF  = OFF_QKV + (size_t)64 * 1048576;
constexpr size_t OFF_F     = OFF_QKV + (size_t)72 * 1048576;
static_assert(OFF_F + (size_t)64 * 1048576 <= OFF_YH, "peer buffers overflow the qkv+gate region");
constexpr size_t OFF_IDX   = OFF_YH;
constexpr size_t OFF_GV    = OFF_YH + (size_t)T_ * 128 * 4;
constexpr size_t OFF_HSCR  = OFF_END;
static_assert(OFF_HSCR + (size_t)164 * 131072 <= 268435456ull, "ws overflow");
static_assert((size_t)92 * 131072 <= (size_t)INW * 1024 * 2, "w_in^T region too small");
constexpr size_t OFF_ROPE  = OFF_HSCR + (size_t)164 * 131072;
static_assert(OFF_ROPE + (size_t)T_ * 64 <= 268435456ull, "rope table overflow");

struct P {
  const float *x, *c; const int* pos;
  const float *w_ada, *b_ada, *w_in, *hy_conv_w, *hy_conv_b, *f1_w, *f1_b, *f1_freq, *f2_w, *f2_b, *f2_freq, *f3_w,
      *hy_bias, *w_bh, *w_ba, *w_out, *ln1_g, *ln1_b, *wq, *keys, *pu, *pv, *ln2_g, *ln2_b;
  float* out; char* ws;
};

DI ushort_t f2bf(float x) { unsigned u = __float_as_uint(x); u += 0x7fffu + ((u >> 16) & 1u); return (ushort_t)(u >> 16); }
DI float bf2f(ushort_t h) { return __uint_as_float(((unsigned)h) << 16); }
typedef __bf16 bf16x2_hw __attribute__((ext_vector_type(2)));
typedef float f32x2_hw __attribute__((ext_vector_type(2)));
DI unsigned pack2(float a, float b) { f32x2_hw v = {a, b}; return __builtin_bit_cast(unsigned, __builtin_convertvector(v, bf16x2_hw)); }
DI int tid_opaque() { int t = threadIdx.x; asm volatile("" : "+v"(t)); return t; }
DI float wave_sum(float v) {
#pragma unroll
  for (int o = 32; o > 0; o >>= 1) v += __shfl_xor(v, o);
  return v;
}

struct cf2 { float x, y; };
constexpr int FFT_N = 16384, FFT_SA = 560;

DI constexpr float wcos32(int j) {
  switch (j & 31) {
    case 0: return 1.0f; case 1: return 0.98078528040323043f; case 2: return 0.92387953251128674f; case 3: return 0.83146961230254524f;
    case 4: return 0.70710678118654752f; case 5: return 0.55557023301960218f; case 6: return 0.38268343236508978f; case 7: return 0.19509032201612825f;
    case 8: return 0.0f; case 9: return -0.19509032201612825f; case 10: return -0.38268343236508978f; case 11: return -0.55557023301960218f;
    case 12: return -0.70710678118654752f; case 13: return -0.83146961230254524f; case 14: return -0.92387953251128674f; case 15: return -0.98078528040323043f;
    case 16: return -1.0f; case 17: return -0.98078528040323043f; case 18: return -0.92387953251128674f; case 19: return -0.83146961230254524f;
    case 20: return -0.70710678118654752f; case 21: return -0.55557023301960218f; case 22: return -0.38268343236508978f; case 23: return -0.19509032201612825f;
    case 24: return 0.0f; case 25: return 0.19509032201612825f; case 26: return 0.38268343236508978f; case 27: return 0.55557023301960218f;
    case 28: return 0.70710678118654752f; case 29: return 0.83146961230254524f; case 30: return 0.92387953251128674f; default: return 0.98078528040323043f;
  }
}
DI constexpr float wsin32(int j) { return wcos32(j + 24); }
DI constexpr int brev(int v, int bits) { int r = 0; for (int i = 0; i < bits; ++i) r |= ((v >> i) & 1) << (bits - 1 - i); return r; }

template <int R, int LEN, bool INV, bool ZHI>
DI void r2_stage(float (&re)[R], float (&im)[R]) {
  constexpr int half = LEN / 2;
#pragma unroll
  for (int start = 0; start < R; start += LEN) {
#pragma unroll
    for (int j = 0; j < half; ++j) {
      const int a = start + j, b = a + half;
      const int tj = j * (32 / LEN);
      const float c = wcos32(tj), s = wsin32(tj);
      if (!INV) {
        float dr, di;
        if (ZHI) { dr = re[a]; di = im[a]; }
        else {
          const float ar = re[a], ai = im[a], br = re[b], bi = im[b];
          re[a] = ar + br; im[a] = ai + bi; dr = ar - br; di = ai - bi;
        }
        if (tj == 0) { re[b] = dr; im[b] = di; }
        else if (tj == 8) { re[b] = di; im[b] = -dr; }
        else { re[b] = dr * c + di * s; im[b] = di * c - dr * s; }
      } else {
        const float br = re[b], bi = im[b];
        float pr, pi;
        if (tj == 0) { pr = br; pi = bi; }
        else if (tj == 8) { pr = -bi; pi = br; }
        else { pr = br * c - bi * s; pi = bi * c + br * s; }
        const float ar = re[a], ai = im[a];
        re[a] = ar + pr; im[a] = ai + pi; re[b] = ar - pr; im[b] = ai - pi;
      }
    }
  }
}
template <int R, bool ZHI> DI void dft_fwd(float (&re)[R], float (&im)[R]) {
  if (R == 32) r2_stage<R, (R == 32 ? 32 : 2), false, ZHI>(re, im);
  r2_stage<R, 16, false, (R == 16) && ZHI>(re, im);
  r2_stage<R, 8, false, false>(re, im);
  r2_stage<R, 4, false, false>(re, im);
  r2_stage<R, 2, false, false>(re, im);
}
template <int R> DI void dft_inv(float (&re)[R], float (&im)[R]) {
  r2_stage<R, 2, true, false>(re, im);
  r2_stage<R, 4, true, false>(re, im);
  r2_stage<R, 8, true, false>(re, im);
  r2_stage<R, 16, true, false>(re, im);
  if (R == 32) r2_stage<R, (R == 32 ? 32 : 2), true, false>(re, im);
}

DI void sincos_turn(float frac, float& s, float& c) { sincospif(2.0f * frac, &s, &c); }

template <bool ZHI>
DI void fft_fwdA(float (&re)[32], float (&im)[32], cf2* lds, int m) {
  asm volatile("" : "+v"(m));
  float s1, c1; sincos_turn((float)m * (1.0f / 16384.0f), s1, c1);
  __builtin_amdgcn_sched_barrier(0);
  dft_fwd<32, ZHI>(re, im);
  __builtin_amdgcn_sched_barrier(0);
  float wr = 1.f, wi = 0.f;
#pragma unroll
  for (int k1 = 0; k1 < 32; ++k1) {
    if ((k1 & 3) == 0) __builtin_amdgcn_sched_barrier(0);
    const int r = brev(k1, 5);
    cf2 o; o.x = re[r] * wr - im[r] * wi; o.y = re[r] * wi + im[r] * wr;
    lds[k1 * FFT_SA + m] = o;
    const float nr = wr * c1 + wi * s1, ni = wi * c1 - wr * s1;
    wr = nr; wi = ni;
  }
}
DI void fft_B_read(float (&re)[32], float (&im)[32], const cf2* lds, int tid) {
  const int k1 = tid >> 4, mp = tid & 15;
#pragma unroll
  for (int n2 = 0; n2 < 32; ++n2) { cf2 v = lds[k1 * FFT_SA + n2 * 16 + mp]; re[n2] = v.x; im[n2] = v.y; }
}
DI void fft_fwdB_write(float (&re)[32], float (&im)[32], cf2* lds, int tid) {
  asm volatile("" : "+v"(tid));
  const int k1 = tid >> 4, mp = tid & 15;
  float s1, c1; sincos_turn((float)mp * (1.0f / 512.0f), s1, c1);
  __builtin_amdgcn_sched_barrier(0);
  dft_fwd<32, false>(re, im);
  __builtin_amdgcn_sched_barrier(0);
  float wr = 1.f, wi = 0.f;
#pragma unroll
  for (int k2 = 0; k2 < 32; ++k2) {
    if ((k2 & 3) == 0) __builtin_amdgcn_sched_barrier(0);
    const int r = brev(k2, 5);
    cf2 o; o.x = re[r] * wr - im[r] * wi; o.y = re[r] * wi + im[r] * wr;
    lds[k1 * FFT_SA + k2 * 17 + mp] = o;
    const float nr = wr * c1 + wi * s1, ni = wi * c1 - wr * s1;
    wr = nr; wi = ni;
  }
}
DI void fft_fwdC(float (&re)[32], float (&im)[32], const cf2* lds, int tid) {
  const int k1 = tid >> 5, k2 = tid & 31;
#pragma unroll
  for (int h = 0; h < 2; ++h) {
    float tr[16], ti[16];
#pragma unroll
    for (int mp = 0; mp < 16; ++mp) { cf2 v = lds[(k1 + 16 * h) * FFT_SA + k2 * 17 + mp]; tr[mp] = v.x; ti[mp] = v.y; }
    dft_fwd<16, false>(tr, ti);
#pragma unroll
    for (int i = 0; i < 16; ++i) { re[h * 16 + i] = tr[i]; im[h * 16 + i] = ti[i]; }
  }
}
DI void fft_invC(float (&re)[32], float (&im)[32], cf2* lds, int tid) {
  const int k1 = tid >> 5, k2 = tid & 31;
#pragma unroll
  for (int h = 0; h < 2; ++h) {
    float tr[16], ti[16];
#pragma unroll
    for (int i = 0; i < 16; ++i) { tr[i] = re[h * 16 + i]; ti[i] = im[h * 16 + i]; }
    dft_inv<16>(tr, ti);
#pragma unroll
    for (int mp = 0; mp < 16; ++mp) { cf2 o; o.x = tr[mp]; o.y = ti[mp]; lds[(k1 + 16 * h) * FFT_SA + k2 * 17 + mp] = o; }
  }
}
DI void fft_invB_read(float (&re)[32], float (&im)[32], const cf2* lds, int tid) {
  asm volatile("" : "+v"(tid));
  const int k1 = tid >> 4, mp = tid & 15;
  float s1, c1; sincos_turn((float)mp * (1.0f / 512.0f), s1, c1);
  float wr = 1.f, wi = 0.f;
  __builtin_amdgcn_sched_barrier(0);
#pragma unroll
  for (int k2 = 0; k2 < 32; ++k2) {
    if ((k2 & 3) == 0) __builtin_amdgcn_sched_barrier(0);
    const int r = brev(k2, 5);
    cf2 v = lds[k1 * FFT_SA + k2 * 17 + mp];
    re[r] = v.x * wr - v.y * wi; im[r] = v.x * wi + v.y * wr;
    const float nr = wr * c1 - wi * s1, ni = wi * c1 + wr * s1;
    wr = nr; wi = ni;
  }
}
DI void fft_invB_write(float (&re)[32], float (&im)[32], cf2* lds, int tid) {
  const int k1 = tid >> 4, mp = tid & 15;
  dft_inv<32>(re, im);
#pragma unroll
  for (int n2 = 0; n2 < 32; ++n2) { cf2 o; o.x = re[n2]; o.y = im[n2]; lds[k1 * FFT_SA + n2 * 16 + mp] = o; }
}
DI void fft_invA(float (&re)[32], float (&im)[32], const cf2* lds, int m) {
  asm volatile("" : "+v"(m));
  float s1, c1; sincos_turn((float)m * (1.0f / 16384.0f), s1, c1);
  float wr = 1.f, wi = 0.f;
  __builtin_amdgcn_sched_barrier(0);
#pragma unroll
  for (int k1 = 0; k1 < 32; ++k1) {
    if ((k1 & 3) == 0) __builtin_amdgcn_sched_barrier(0);
    const int r = brev(k1, 5);
    cf2 v = lds[k1 * FFT_SA + m];
    re[r] = v.x * wr - v.y * wi; im[r] = v.x * wi + v.y * wr;
    const float nr = wr * c1 - wi * s1, ni = wi * c1 + wr * s1;
    wr = nr; wi = ni;
  }
  __builtin_amdgcn_sched_barrier(0);
  dft_inv<32>(re, im);
}

DI void phase_ada(const P& p, char* smem) {
  float (*red)[16][32] = (float (*)[16][32])smem;
  const int tid = tid_opaque(), cl = tid & 31, kq = tid >> 5;
  for (int item = blockIdx.x; item < 192; item += gridDim.x) {
    const int col = item * 32 + cl;
    float a0 = 0.f, a1 = 0.f;
#pragma unroll 16
    for (int k = kq * 64; k < kq * 64 + 64; ++k) {
      const float w = p.w_ada[(size_t)k * 6144 + col];
      const float c0 = p.c[k], c1 = p.c[1024 + k];
      a0 += (c0 / (1.f + __expf(-c0))) * w;
      a1 += (c1 / (1.f + __expf(-c1))) * w;
    }
    __syncthreads();
    red[0][kq][cl] = a0; red[1][kq][cl] = a1;
    __syncthreads();
    if (tid < 64) {
      const int b = tid >> 5;
      float s = p.b_ada[col];
#pragma unroll
      for (int q = 0; q < 16; ++q) s += red[b][q][cl];
      ((float*)(p.ws + OFF_ADA))[b * 6144 + col] = s;
    }
  }
}
DI void phase_u1(const P& p) {
  const float* ada = (const float*)(p.ws + OFF_ADA);
  ushort_t* u1b = (ushort_t*)(p.ws + OFF_U1B);
  for (int i = blockIdx.x * NT + tid_opaque(); i < T_ * 128; i += gridDim.x * NT) {
    const int row = i >> 7, k = (i & 127) * 8, b = row / S_;
    const float* xp = p.x + (size_t)row * 1024 + k;
    const f32x4 x0 = *(const f32x4*)xp, x1 = *(const f32x4*)(xp + 4);
    const f32x4 s0 = *(const f32x4*)(ada + b * 6144 + 1024 + k), s1 = *(const f32x4*)(ada + b * 6144 + 1024 + k + 4);
    const f32x4 h0 = *(const f32x4*)(ada + b * 6144 + k), h1 = *(const f32x4*)(ada + b * 6144 + k + 4);
    u32x4 o;
    o[0] = pack2(x0[0] * (1.f + s0[0]) + h0[0], x0[1] * (1.f + s0[1]) + h0[1]);
    o[1] = pack2(x0[2] * (1.f + s0[2]) + h0[2], x0[3] * (1.f + s0[3]) + h0[3]);
    o[2] = pack2(x1[0] * (1.f + s1[0]) + h1[0], x1[1] * (1.f + s1[1]) + h1[1]);
    o[3] = pack2(x1[2] * (1.f + s1[2]) + h1[2], x1[3] * (1.f + s1[3]) + h1[3]);
    *(u32x4*)(u1b + (size_t)row * 1024 + k) = o;
  }
}

DI void transpose_tile(const float* __restrict__ W, ushort_t* __restrict__ Wt, int K, int N, int item, char* smem) {
  float (*tile)[65] = (float (*)[65])smem;
  const int ntn = N / 64;
  const int n0 = (item % ntn) * 64, k0 = (item / ntn) * 32;
  const int tid = tid_opaque();
  __syncthreads();
  {
    const int tx = tid & 63, ty = tid >> 6;
#pragma unroll
    for (int i = 0; i < 4; ++i) tile[ty + 8 * i][tx] = W[(size_t)(k0 + ty + 8 * i) * N + n0 + tx];
  }
  __syncthreads();
  {
    const int kk = tid & 31, nn0 = tid >> 5;
#pragma unroll
    for (int i = 0; i < 4; ++i) Wt[(size_t)(n0 + nn0 + 16 * i) * K + k0 + kk] = f2bf(tile[kk][nn0 + 16 * i]);
  }
}
DI void phase_transposes(const P& p, char* smem) {
  constexpr int I0 = (INW / 64) * 32, I1 = I0 + 32 * 32, I2 = I1 + 16 * 32, I3 = I2 + 16 * 16, I4 = I3 + 16 * 8;
  for (int item = blockIdx.x; item < I4; item += gridDim.x) {
    if (item < I0) transpose_tile(p.w_in, (ushort_t*)(p.ws + OFF_WIN_T), 1024, INW, item, smem);
    else if (item < I1) transpose_tile(p.wq, (ushort_t*)(p.ws + OFF_WQ_T), 1024, 2048, item - I0, smem);
    else if (item < I2) transpose_tile(p.w_out, (ushort_t*)(p.ws + OFF_WOUT_T), 1024, 1024, item - I1, smem);
    else if (item < I3) transpose_tile(p.w_bh, (ushort_t*)(p.ws + OFF_WBH_T), 512, 1024, item - I2, smem);
    else transpose_tile(p.w_ba, (ushort_t*)(p.ws + OFF_WBA_T), 256, 1024, item - I3, smem);
  }
}

DI void phase_filter(const P& p, char* smem) {
  float (*zf)[33] = (float (*)[33])smem;
  float (*h1)[64] = (float (*)[64])(smem + 4352);
  float (*h2)[65] = (float (*)[65])(smem + 4352 + 8192);
  float* w1s = (float*)(smem + 32768);
  float* w2s = (float*)(smem + 32768 + 8448);
  const int tid = tid_opaque(), lane = tid & 63, wave = tid >> 6;
  __syncthreads();
  for (int i = tid; i < 33 * 64; i += NT) w1s[i] = p.f1_w[i];
  for (int i = tid; i < 64 * 64; i += NT) w2s[i] = p.f2_w[i];
  for (int item = blockIdx.x; item < 256; item += gridDim.x) {
  const int t0 = item * 32;
  __syncthreads();
  for (int idx = tid; idx < 32 * 33; idx += NT) {
    int tt = idx / 33, e = idx % 33, t = t0 + tt;
    float tl = (float)t * (1.0f / 8191.0f);
    float w = 6.283185307179586f * (float)t / 8192.0f;
    float val;
    if (e == 0) val = tl;
    else {
      int i = (e - 1) & 15;
      float f = 1e-4f + (float)i * ((15.0f - 1e-4f) / 15.0f);
      val = (e <= 16) ? cosf(f * w) : -sinf(f * w);
    }
    zf[tt][e] = val;
  }
  __syncthreads();
  for (int idx = tid; idx < 32 * 64; idx += NT) {
    int tt = idx >> 6, j = idx & 63;
    float a = p.f1_b[j];
#pragma unroll
    for (int e = 0; e < 33; ++e) a += zf[tt][e] * w1s[e * 64 + j];
    h1[tt][j] = sinf(p.f1_freq[j] * a);
  }
  __syncthreads();
  for (int idx = tid; idx < 32 * 64; idx += NT) {
    int tt = idx >> 6, j = idx & 63;
    float a = p.f2_b[j];
#pragma unroll
    for (int e = 0; e < 64; ++e) a += h1[tt][e] * w2s[e * 64 + j];
    h2[tt][j] = sinf(p.f2_freq[j] * a);
  }
  __syncthreads();
  float* filt = p.out;
  const float min_decay = -3.0701134573253945f, max_decay = -15.350567286626973f;
  float af[32];
#pragma unroll
  for (int s = 0; s < 32; ++s) af[s] = h2[lane & 31][2 * s + (lane >> 5)];
#pragma unroll 1
  for (int ci = 0; ci < 8; ++ci) {
    const int col = (wave + 8 * ci) * 32 + (lane & 31);
    const float* wp = p.f3_w + (size_t)(lane >> 5) * 2048 + col;
    float bfv[32];
#pragma unroll
    for (int s = 0; s < 32; ++s) bfv[s] = wp[(size_t)s * 4096];
    f32x16 acc;
#pragma unroll
    for (int r = 0; r < 16; ++r) acc[r] = 0.f;
#pragma unroll
    for (int s = 0; s < 32; ++s) acc = __builtin_amdgcn_mfma_f32_32x32x2f32(af[s], bfv[s], acc, 0, 0, 0);
    const float delta = fabsf(min_decay + (float)(col & 511) * ((max_decay - min_decay) / 511.0f));
    float* dst = filt + (size_t)col * 8192 + t0 + 4 * (lane >> 5);
#pragma unroll
    for (int q = 0; q < 4; ++q) {
      f32x4 o;
#pragma unroll
      for (int r = 0; r < 4; ++r) {
        const float tl = (float)(t0 + 8 * q + 4 * (lane >> 5) + r) * (1.0f / 8191.0f);
        o[r] = acc[4 * q + r] * __expf(-tl * delta);
      }
      *(f32x4*)(dst + 8 * q) = o;
    }
  }
  }
}

constexpr int BM = 256, BN = 128, BK = 64;
constexpr int LDS_A = BM * BK * 2, LDS_B = BN * BK * 2, LDS_STAGE = LDS_A + LDS_B;
constexpr int GEMM_LDS = 2 * LDS_STAGE + 8192;

DI int swz(int row, int ch) { return row * 128 + ((ch ^ (row & 7)) << 4); }

struct ALoadBf16 {
  const ushort_t* A; int lda;
  struct Raw { u32x4 v; };
  DI Raw fetch(int row, int k) const { Raw r; r.v = *(const u32x4*)(A + (size_t)row * lda + k); return r; }
  DI u32x4 cvt(const Raw& r, int k) const { return r.v; }
};
struct ALoadF32Mod {
  const float* A; const float* mod;
  struct Raw { f32x4 a, b; };
  DI Raw fetch(int row, int k) const { Raw r; const float* s = A + (size_t)row * 1024 + k; r.a = *(const f32x4*)s; r.b = *(const f32x4*)(s + 4); return r; }
  DI u32x4 cvt(const Raw& r, int k) const {
    f32x4 s0 = *(const f32x4*)(mod + k), s1 = *(const f32x4*)(mod + k + 4);
    f32x4 h0 = *(const f32x4*)(mod + 1024 + k), h1 = *(const f32x4*)(mod + 1024 + k + 4);
    u32x4 o;
    o[0] = pack2(r.a[0] * s0[0] + h0[0], r.a[1] * s0[1] + h0[1]);
    o[1] = pack2(r.a[2] * s0[2] + h0[2], r.a[3] * s0[3] + h0[3]);
    o[2] = pack2(r.b[0] * s1[0] + h1[0], r.b[1] * s1[1] + h1[1]);
    o[3] = pack2(r.b[2] * s1[2] + h1[2], r.b[3] * s1[3] + h1[3]);
    return o;
  }
};

template <class AL, bool SWAP = false>
DI void gemm_mainloop(f32x16 (&acc)[2][2], const AL& al, int m0, const ushort_t* __restrict__ Bt, int ldb, int n0, int K, char* smem) {
  const int tid = tid_opaque(), lane = tid & 63, wave = tid >> 6;
  const int wm = wave >> 1, wn = wave & 1;
  const int lr = tid >> 3, lc = tid & 7;
  typename AL::Raw ra[4]; u32x4 rb[2];
  const int nk = K / BK;
#pragma unroll
  for (int i = 0; i < 4; ++i) ra[i] = al.fetch(m0 + lr + 64 * i, lc * 8);
#pragma unroll
  for (int i = 0; i < 2; ++i) rb[i] = *(const u32x4*)(Bt + (size_t)(n0 + lr + 64 * i) * ldb + lc * 8);
  __syncthreads();
#pragma unroll
  for (int i = 0; i < 4; ++i) *(u32x4*)(smem + swz(lr + 64 * i, lc)) = al.cvt(ra[i], lc * 8);
#pragma unroll
  for (int i = 0; i < 2; ++i) *(u32x4*)(smem + LDS_A + swz(lr + 64 * i, lc)) = rb[i];
  __syncthreads();
  for (int kt = 0; kt < nk; ++kt) {
    char* cur = smem + (kt & 1) * LDS_STAGE;
    char* nxt = smem + ((kt + 1) & 1) * LDS_STAGE;
    const bool more = (kt + 1 < nk);
    const int kn = (kt + 1) * BK + lc * 8;
    if (more) {
#pragma unroll
      for (int i = 0; i < 4; ++i) ra[i] = al.fetch(m0 + lr + 64 * i, kn);
#pragma unroll
      for (int i = 0; i < 2; ++i) rb[i] = *(const u32x4*)(Bt + (size_t)(n0 + lr + 64 * i) * ldb + kn);
    }
#pragma unroll
    for (int s = 0; s < 4; ++s) {
      const int ch = 2 * s + (lane >> 5);
      bf16x8 af[2], bfr[2];
#pragma unroll
      for (int mi = 0; mi < 2; ++mi) af[mi] = *(const bf16x8*)(cur + swz(wm * 64 + mi * 32 + (lane & 31), ch));
#pragma unroll
      for (int ni = 0; ni < 2; ++ni) bfr[ni] = *(const bf16x8*)(cur + LDS_A + swz(wn * 64 + ni * 32 + (lane & 31), ch));
#pragma unroll
      for (int mi = 0; mi < 2; ++mi)
#pragma unroll
        for (int ni = 0; ni < 2; ++ni)
          acc[mi][ni] = SWAP ? __builtin_amdgcn_mfma_f32_32x32x16_bf16(bfr[ni], af[mi], acc[mi][ni], 0, 0, 0)
                             : __builtin_amdgcn_mfma_f32_32x32x16_bf16(af[mi], bfr[ni], acc[mi][ni], 0, 0, 0);
    }
    if (more) {
#pragma unroll
      for (int i = 0; i < 4; ++i) *(u32x4*)(nxt + swz(lr + 64 * i, lc)) = al.cvt(ra[i], kn);
#pragma unroll
      for (int i = 0; i < 2; ++i) *(u32x4*)(nxt + LDS_A + swz(lr + 64 * i, lc)) = rb[i];
    }
    __syncthreads();
  }
}

constexpr int AT_ROW = 576;
constexpr int LDS_AT = 64 * AT_ROW;
constexpr int LDS_STAGE_T = LDS_AT + LDS_B;
typedef __attribute__((ext_vector_type(4))) short s16x4;
DI void gemm_mainloop_AT(f32x16 (&acc)[2][2], const ushort_t* __restrict__ At, size_t ldt, const ushort_t* __restrict__ Bt, int ldb, int n0, int K, char* smem) {
  const int tid = tid_opaque(), lane = tid & 63, wave = tid >> 6;
  const int wm = wave >> 1, wn = wave & 1;
  const int lr = tid >> 3, lc = tid & 7;
  u32x4 ra[4], rb[2];
  const int nk = K / BK;
#pragma unroll
  for (int i = 0; i < 4; ++i) { const int q = tid + 512 * i; ra[i] = *(const u32x4*)(At + (size_t)(q >> 5) * ldt + (q & 31) * 8); }
#pragma unroll
  for (int i = 0; i < 2; ++i) rb[i] = *(const u32x4*)(Bt + (size_t)(n0 + lr + 64 * i) * ldb + lc * 8);
  __syncthreads();
#pragma unroll
  for (int i = 0; i < 4; ++i) { const int q = tid + 512 * i; *(u32x4*)(smem + (q >> 5) * AT_ROW + (q & 31) * 16) = ra[i]; }
#pragma unroll
  for (int i = 0; i < 2; ++i) *(u32x4*)(smem + LDS_AT + swz(lr + 64 * i, lc)) = rb[i];
  __syncthreads();
  const int hh = lane >> 5, gg = (lane >> 4) & 1, qq = (lane & 15) >> 2, pp = lane & 3;
  for (int kt = 0; kt < nk; ++kt) {
    char* cur = smem + (kt & 1) * LDS_STAGE_T;
    char* nxt = smem + ((kt + 1) & 1) * LDS_STAGE_T;
    const bool more = (kt + 1 < nk);
    if (more) {
#pragma unroll
      for (int i = 0; i < 4; ++i) { const int q = tid + 512 * i; ra[i] = *(const u32x4*)(At + (size_t)((kt + 1) * BK + (q >> 5)) * ldt + (q & 31) * 8); }
#pragma unroll
      for (int i = 0; i < 2; ++i) rb[i] = *(const u32x4*)(Bt + (size_t)(n0 + lr + 64 * i) * ldb + (kt + 1) * BK + lc * 8);
    }
#pragma unroll
    for (int s = 0; s < 4; ++s) {
      const int ch = 2 * s + hh;
      bf16x8 af[2], bfr[2];
#pragma unroll
      for (int mi = 0; mi < 2; ++mi) {
        const char* a0 = cur + (16 * s + 8 * hh + qq) * AT_ROW + (wm * 64 + mi * 32 + 16 * gg + 4 * pp) * 2;
        s16x4 lo = __builtin_amdgcn_ds_read_tr16_b64_v4i16((__attribute__((address_space(3))) s16x4*)(a0));
        s16x4 hi = __builtin_amdgcn_ds_read_tr16_b64_v4i16((__attribute__((address_space(3))) s16x4*)(a0 + 4 * AT_ROW));
        af[mi] = __builtin_shufflevector(lo, hi, 0, 1, 2, 3, 4, 5, 6, 7);
      }
#pragma unroll
      for (int ni = 0; ni < 2; ++ni) bfr[ni] = *(const bf16x8*)(cur + LDS_AT + swz(wn * 64 + ni * 32 + (lane & 31), ch));
#pragma unroll
      for (int mi = 0; mi < 2; ++mi)
#pragma unroll
        for (int ni = 0; ni < 2; ++ni) acc[mi][ni] = __builtin_amdgcn_mfma_f32_32x32x16_bf16(af[mi], bfr[ni], acc[mi][ni], 0, 0, 0);
    }
    if (more) {
#pragma unroll
      for (int i = 0; i < 4; ++i) { const int q = tid + 512 * i; *(u32x4*)(nxt + (q >> 5) * AT_ROW + (q & 31) * 16) = ra[i]; }
#pragma unroll
      for (int i = 0; i < 2; ++i) *(u32x4*)(nxt + LDS_AT + swz(lr + 64 * i, lc)) = rb[i];
    }
    __syncthreads();
  }
}

constexpr int G2_A = 32768, G2_STAGE = 65536;
template <bool SWAP>
DI void gemm256(f32x16 (&acc)[4][2], const ushort_t* __restrict__ A, int lda, int m0, const ushort_t* __restrict__ Bt, int ldb, int n0, int K, char* smem) {
  const int tid = tid_opaque(), lane = tid & 63, wave = tid >> 6;
  const int wm = wave >> 2, wn = wave & 3;
  const int lr = tid >> 3, lc = tid & 7;
  u32x4 ra[4], rb[4];
  const int nk = K / BK;
  const ushort_t* ap = A + (size_t)(m0 + lr) * lda + lc * 8;
  const ushort_t* bp = Bt + (size_t)(n0 + lr) * ldb + lc * 8;
#pragma unroll
  for (int i = 0; i < 4; ++i) { ra[i] = *(const u32x4*)(ap + (size_t)(64 * i) * lda); rb[i] = *(const u32x4*)(bp + (size_t)(64 * i) * ldb); }
  __syncthreads();
#pragma unroll
  for (int i = 0; i < 4; ++i) { *(u32x4*)(smem + swz(lr + 64 * i, lc)) = ra[i]; *(u32x4*)(smem + G2_A + swz(lr + 64 * i, lc)) = rb[i]; }
  __syncthreads();
  for (int kt = 0; kt < nk; ++kt) {
    char* cur = smem + (kt & 1) * G2_STAGE;
    char* nxt = smem + ((kt + 1) & 1) * G2_STAGE;
    const bool more = (kt + 1 < nk);
    if (more) {
#pragma unroll
      for (int i = 0; i < 4; ++i) { ra[i] = *(const u32x4*)(ap + (size_t)(64 * i) * lda + (kt + 1) * BK); rb[i] = *(const u32x4*)(bp + (size_t)(64 * i) * ldb + (kt + 1) * BK); }
    }
#pragma unroll
    for (int s = 0; s < 4; ++s) {
      const int ch = 2 * s + (lane >> 5);
      bf16x8 af[4], bfr[2];
#pragma unroll
      for (int mi = 0; mi < 4; ++mi) af[mi] = *(const bf16x8*)(cur + swz(wm * 128 + mi * 32 + (lane & 31), ch));
#pragma unroll
      for (int ni = 0; ni < 2; ++ni) bfr[ni] = *(const bf16x8*)(cur + G2_A + swz(wn * 64 + ni * 32 + (lane & 31), ch));
#pragma unroll
      for (int mi = 0; mi < 4; ++mi)
#pragma unroll
        for (int ni = 0; ni < 2; ++ni)
          acc[mi][ni] = SWAP ? __builtin_amdgcn_mfma_f32_32x32x16_bf16(bfr[ni], af[mi], acc[mi][ni], 0, 0, 0)
                             : __builtin_amdgcn_mfma_f32_32x32x16_bf16(af[mi], bfr[ni], acc[mi][ni], 0, 0, 0);
      if (s & 1) __builtin_amdgcn_sched_barrier(0);
    }
    if (more) {
#pragma unroll
      for (int i = 0; i < 4; ++i) { *(u32x4*)(nxt + swz(lr + 64 * i, lc)) = ra[i]; *(u32x4*)(nxt + G2_A + swz(lr + 64 * i, lc)) = rb[i]; }
    }
    __syncthreads();
  }
}
constexpr int G2T_A = 64 * 576, G2T_STAGE = G2T_A + 32768;
DI void gemm256_AT(f32x16 (&acc)[4][2], const ushort_t* __restrict__ At, size_t ldt, const ushort_t* __restrict__ Bt, int ldb, int n0, int K, char* smem) {
  const int tid = tid_opaque(), lane = tid & 63, wave = tid >> 6;
  const int wm = wave >> 2, wn = wave & 3;
  const int lr = tid >> 3, lc = tid & 7;
  u32x4 ra[4], rb[4];
  const int nk = K / BK;
  const ushort_t* bp = Bt + (size_t)(n0 + lr) * ldb + lc * 8;
#pragma unroll
  for (int i = 0; i < 4; ++i) { const int q = tid + 512 * i; ra[i] = *(const u32x4*)(At + (size_t)(q >> 5) * ldt + (q & 31) * 8); rb[i] = *(const u32x4*)(bp + (size_t)(64 * i) * ldb); }
  __syncthreads();
#pragma unroll
  for (int i = 0; i < 4; ++i) { const int q = tid + 512 * i; *(u32x4*)(smem + (q >> 5) * 576 + (q & 31) * 16) = ra[i]; *(u32x4*)(smem + G2T_A + swz(lr + 64 * i, lc)) = rb[i]; }
  __syncthreads();
  const int hh = lane >> 5, gg = (lane >> 4) & 1, qq = (lane & 15) >> 2, pp = lane & 3;
  for (int kt = 0; kt < nk; ++kt) {
    char* cur = smem + (kt & 1) * G2T_STAGE;
    char* nxt = smem + ((kt + 1) & 1) * G2T_STAGE;
    const bool more = (kt + 1 < nk);
    if (more) {
#pragma unroll
      for (int i = 0; i < 4; ++i) { const int q = tid + 512 * i; ra[i] = *(const u32x4*)(At + (size_t)((kt + 1) * BK + (q >> 5)) * ldt + (q & 31) * 8); rb[i] = *(const u32x4*)(bp + (size_t)(64 * i) * ldb + (kt + 1) * BK); }
    }
#pragma unroll
    for (int s = 0; s < 4; ++s) {
      const int ch = 2 * s + hh;
      bf16x8 af[4], bfr[2];
#pragma unroll
      for (int mi = 0; mi < 4; ++mi) {
        const char* a0 = cur + (16 * s + 8 * hh + qq) * 576 + (wm * 128 + mi * 32 + 16 * gg + 4 * pp) * 2;
        s16x4 lo = __builtin_amdgcn_ds_read_tr16_b64_v4i16((__attribute__((address_space(3))) s16x4*)(a0));
        s16x4 hi = __builtin_amdgcn_ds_read_tr16_b64_v4i16((__attribute__((address_space(3))) s16x4*)(a0 + 4 * 576));
        af[mi] = __builtin_shufflevector(lo, hi, 0, 1, 2, 3, 4, 5, 6, 7);
      }
#pragma unroll
      for (int ni = 0; ni < 2; ++ni) bfr[ni] = *(const bf16x8*)(cur + G2T_A + swz(wn * 64 + ni * 32 + (lane & 31), ch));
#pragma unroll
      for (int mi = 0; mi < 4; ++mi)
#pragma unroll
        for (int ni = 0; ni < 2; ++ni) acc[mi][ni] = __builtin_amdgcn_mfma_f32_32x32x16_bf16(af[mi], bfr[ni], acc[mi][ni], 0, 0, 0);
      if (s & 1) __builtin_amdgcn_sched_barrier(0);
    }
    if (more) {
#pragma unroll
      for (int i = 0; i < 4; ++i) { const int q = tid + 512 * i; *(u32x4*)(nxt + (q >> 5) * 576 + (q & 31) * 16) = ra[i]; *(u32x4*)(nxt + G2T_A + swz(lr + 64 * i, lc)) = rb[i]; }
    }
    __syncthreads();
  }
}
DI void acc_zero4(f32x16 (&acc)[4][2]) {
#pragma unroll
  for (int a = 0; a < 4; ++a)
#pragma unroll
    for (int b = 0; b < 2; ++b)
#pragma unroll
      for (int r = 0; r < 16; ++r) acc[a][b][r] = 0.f;
}
DI void acc_zero(f32x16 (&acc)[2][2]) {
#pragma unroll
  for (int a = 0; a < 2; ++a)
#pragma unroll
    for (int b = 0; b < 2; ++b)
#pragma unroll
      for (int r = 0; r < 16; ++r) acc[a][b][r] = 0.f;
}
#define ACC_ROW(mi, r) (wm * 64 + (mi) * 32 + ((r) & 3) + 8 * ((r) >> 2) + 4 * (lane >> 5))
#define ACC_COL(ni) (wn * 64 + (ni) * 32 + (lane & 31))

DI void stage_mod(float* mod, const float* ada, int b, int sc_chunk, int sh_chunk) {
  for (int i = tid_opaque(); i < 1024; i += NT) {
    mod[i] = 1.f + ada[b * 6144 + sc_chunk * 1024 + i];
    mod[1024 + i] = ada[b * 6144 + sh_chunk * 1024 + i];
  }
}


namespace pg8 {
#define PG8_LAS __attribute__((address_space(3)))
constexpr int BM8 = 256, BK8 = 64, HALF = 128, HTB = HALF * BK8 * 2, STAGE_BYTES = 8 * HTB, NXCD = 8, WGM = 8;
DI int lds_byte(int r, int c) { const int st = (r >> 4) * 2 + (c >> 5), rr = r & 15, cc = c & 31, ob = rr * 64 + cc * 2; return st * 1024 + (ob ^ (((ob >> 9) & 1) << 5)); }
DI void stage_rc(int b, int& R, int& C) { const int st = b / 1024, sb = b % 1024, sw = sb ^ (((sb >> 9) & 1) << 5); R = (st >> 1) * 16 + sw / 64; C = (st & 1) * 32 + (sw % 64) / 2; }
DI int perm32(int rho) { const int n = rho >> 4, i = rho & 15; return 8 * (i >> 2) + 4 * n + (i & 3); }
struct Unit { int pm, pn, kind; };
DI void tile_order(int L, int nM, int nN, int& pm, int& pn) {
  const int nwg = nM * nN;
  int wgid = L; { const int q = nwg / NXCD, r = nwg % NXCD, xcd = wgid % NXCD, off = wgid / NXCD; wgid = (xcd < r ? xcd * (q + 1) : r * (q + 1) + (xcd - r) * q) + off; }
  const int nig = WGM * nN, gid = wgid / nig, fm = gid * WGM, gsz = (nM - fm) < WGM ? (nM - fm) : WGM;
  pm = fm + ((wgid % nig) % gsz); pn = (wgid % nig) / gsz;
}
typedef float f32x4p __attribute__((ext_vector_type(4)));
template <class Epi, class Sched>
DI void gemm_phase(PG8_LAS unsigned char* lds, const int K_, const Sched& S, const Epi& E) {
    int K = K_; asm volatile("" : "+s"(K));
    const int tid = tid_opaque();
    const int wid = __builtin_amdgcn_readfirstlane(tid >> 6), lane = tid & 63, wr = wid >> 2, wc = wid & 3, fr = lane & 15, fq = lane >> 4;
    const int nt = K / BK8;
    unsigned voffA[2], voffB[2];
#pragma unroll
    for (int i = 0; i < 2; ++i) { int R, C; stage_rc(tid * 16 + i * 8192, R, C); const int Rb = Epi::PERM ? ((R & ~31) + perm32(R & 31)) : R;
        voffA[i] = (unsigned)(R * K + C) * 2u; voffB[i] = (unsigned)(Rb * K + C) * 2u; }
    const size_t kstep = (size_t)(BK8 * 2);
    const size_t hstep = (size_t)HALF * K * 2;
    const unsigned ldsw = (unsigned)wid * 1024u;
    const int aoff = lds_byte(wr * 64 + fr, fq * 8), boff = lds_byte(wc * 32 + fr, fq * 8);
#define PG8_SA(b, h) (((b) * 2 + (h)) * HTB)
#define PG8_SB(b, h) ((4 + (b) * 2 + (h)) * HTB)
#define PG8_STAGE(bufoff, gbase, voff) do { _Pragma("unroll") for (int _i = 0; _i < 2; ++_i) \
        __builtin_amdgcn_global_load_lds((const unsigned*)((const char*)(gbase) + (voff)[_i]), (PG8_LAS unsigned*)(lds + (bufoff) + ldsw + _i * 8192), 16, 0, 0); } while (0)
#define PG8_LDA(dst, b, h) do { _Pragma("unroll") for (int m = 0; m < 4; ++m) _Pragma("unroll") for (int k = 0; k < 2; ++k) dst[m][k] = *(const PG8_LAS bf16x8*)(lds + PG8_SA(b, h) + aoff + m * 2048 + k * 1024); } while (0)
#define PG8_LDB(dst, b, h) do { _Pragma("unroll") for (int n = 0; n < 2; ++n) _Pragma("unroll") for (int k = 0; k < 2; ++k) dst[n][k] = *(const PG8_LAS bf16x8*)(lds + PG8_SB(b, h) + boff + n * 2048 + k * 1024); } while (0)
#define PG8_MMA(ai, bj, At, Bt) do { __builtin_amdgcn_s_setprio(1); _Pragma("unroll") for (int m = 0; m < 4; ++m) _Pragma("unroll") for (int n = 0; n < 2; ++n) _Pragma("unroll") for (int k = 0; k < 2; ++k) \
        acc[ai][bj][m][n] = __builtin_amdgcn_mfma_f32_16x16x32_bf16(Bt[n][k], At[m][k], acc[ai][bj][m][n], 0, 0, 0); __builtin_amdgcn_s_setprio(0); } while (0)
#define PG8_WAIT_V(n) asm volatile("s_waitcnt vmcnt(" #n ")" ::: "memory")
#define PG8_WAIT_L(n) asm volatile("s_waitcnt lgkmcnt(" #n ")" ::: "memory")
#define PG8_BAR __builtin_amdgcn_s_barrier()
#define PG8_SCHED __builtin_amdgcn_sched_barrier(0)
    Unit cur, nxt; int ui = 0;
    if (!S.next(0, cur)) return;
    f32x4p acc[2][2][4][2];
#pragma unroll
    for (int a = 0; a < 2; ++a)
#pragma unroll
        for (int b = 0; b < 2; ++b)
#pragma unroll
            for (int m = 0; m < 4; ++m)
#pragma unroll
                for (int n = 0; n < 2; ++n) acc[a][b][m][n] = (f32x4p){0.f, 0.f, 0.f, 0.f};
    bf16x8 At[4][2], B0[2][2], B1[2][2];
    const char* cA = S.a_ptr(cur); const char* cB = S.b_ptr(cur);
    PG8_STAGE(PG8_SB(0, 0), cB, voffB); PG8_STAGE(PG8_SA(0, 0), cA, voffA); PG8_STAGE(PG8_SB(0, 1), cB + hstep, voffB); PG8_STAGE(PG8_SA(0, 1), cA + hstep, voffA);
    if (wr == 1) PG8_BAR;
    PG8_WAIT_V(4); PG8_BAR;
    PG8_STAGE(PG8_SB(1, 0), cB + kstep, voffB); PG8_STAGE(PG8_SA(1, 0), cA + kstep, voffA); PG8_STAGE(PG8_SB(1, 1), cB + hstep + kstep, voffB);
    PG8_WAIT_V(6); PG8_BAR;
    for (;;) {
        const bool has_next = S.next(ui + 1, nxt);
        const char* nA = has_next ? S.a_ptr(nxt) : cA; const char* nB = has_next ? S.b_ptr(nxt) : cB;
        for (int t = 0; t < nt; t += 2) {
            const bool last = (t == nt - 2);
            const char* a1 = cA + (size_t)(t + 1) * kstep;
            const char* a2 = last ? nA : cA + (size_t)(t + 2) * kstep; const char* b2 = last ? nB : cB + (size_t)(t + 2) * kstep;
            const char* a3 = a2 + kstep; const char* b3 = b2 + kstep;
            PG8_LDB(B0, 0, 0); PG8_SCHED; PG8_LDA(At, 0, 0); PG8_STAGE(PG8_SA(1, 1), a1 + hstep, voffA);
            PG8_WAIT_L(8); PG8_BAR; PG8_WAIT_L(0); PG8_MMA(0, 0, At, B0); PG8_BAR; PG8_SCHED;
            PG8_LDB(B1, 0, 1); PG8_STAGE(PG8_SB(0, 0), b2, voffB);
            PG8_BAR; PG8_WAIT_L(0); PG8_MMA(0, 1, At, B1); PG8_BAR;
            PG8_LDA(At, 0, 1); PG8_STAGE(PG8_SA(0, 0), a2, voffA);
            PG8_BAR; PG8_WAIT_L(0); PG8_MMA(1, 0, At, B0); PG8_BAR; PG8_SCHED;
            PG8_STAGE(PG8_SB(0, 1), b2 + hstep, voffB);
            PG8_WAIT_V(6); PG8_BAR; PG8_MMA(1, 1, At, B1); PG8_BAR;
            PG8_LDB(B0, 1, 0); PG8_SCHED; PG8_LDA(At, 1, 0); PG8_STAGE(PG8_SA(0, 1), a2 + hstep, voffA);
            PG8_WAIT_L(8); PG8_BAR; PG8_WAIT_L(0); PG8_MMA(0, 0, At, B0); PG8_BAR; PG8_SCHED;
            PG8_LDB(B1, 1, 1); PG8_STAGE(PG8_SB(1, 0), b3, voffB);
            PG8_BAR; PG8_WAIT_L(0); PG8_MMA(0, 1, At, B1); PG8_BAR;
            PG8_LDA(At, 1, 1); PG8_STAGE(PG8_SA(1, 0), a3, voffA);
            PG8_BAR; PG8_WAIT_L(0); PG8_MMA(1, 0, At, B0); PG8_BAR; PG8_SCHED;
            PG8_STAGE(PG8_SB(1, 1), b3 + hstep, voffB);
            PG8_WAIT_V(6); PG8_BAR; PG8_MMA(1, 1, At, B1); PG8_BAR;
        }
        if constexpr (!Epi::AFTER_DRAIN) E(acc, cur, wr, wc, fr, fq);
        if (!has_next) break;
#pragma unroll
        for (int a = 0; a < 2; ++a)
#pragma unroll
            for (int b = 0; b < 2; ++b)
#pragma unroll
                for (int m = 0; m < 4; ++m)
#pragma unroll
                    for (int n = 0; n < 2; ++n) acc[a][b][m][n] = (f32x4p){0.f, 0.f, 0.f, 0.f};
        cur = nxt; cA = nA; cB = nB; ++ui;
    }
    PG8_WAIT_V(0);
    if (wr == 0) PG8_BAR;
    PG8_BAR;
    if constexpr (Epi::AFTER_DRAIN) E.fused(acc, cur, wr, wc, fr, fq, lds, wid, lane);
#undef PG8_SA
#undef PG8_SB
#undef PG8_STAGE
#undef PG8_LDA
#undef PG8_LDB
#undef PG8_MMA
#undef PG8_WAIT_V
#undef PG8_WAIT_L
#undef PG8_BAR
#undef PG8_SCHED
}
}
typedef pg8::f32x4p f32x4p;
DI u32x4 pack8(const f32x4p& a, const f32x4p& b) { u32x4 w; w[0] = pack2(a[0], a[1]); w[1] = pack2(a[2], a[3]); w[2] = pack2(b[0], b[1]); w[3] = pack2(b[2], b[3]); return w; }

struct InprojSched {
  const char* u1b; const char* wt; int G, c;
  DI bool next(int i, pg8::Unit& u) const {
    const int L = i * G + c;
    if (L >= 384 + 1088) return false;
    if (L < 384) { u.kind = 0; pg8::tile_order(L, 6, 64, u.pm, u.pn); } else { u.kind = 1; pg8::tile_order(L - 384, 64, 17, u.pm, u.pn); }
    return true;
  }
  DI const char* a_ptr(const pg8::Unit& u) const { return u.kind == 0 ? wt + (size_t)u.pm * (256 * 1024 * 2) : u1b + (size_t)u.pm * (256 * 1024 * 2); }
  DI const char* b_ptr(const pg8::Unit& u) const { return u.kind == 0 ? u1b + (size_t)u.pn * (256 * 1024 * 2) : wt + (size_t)(1536 + u.pn * 256) * (1024 * 2); }
};
struct InprojEpi {
  static constexpr bool PERM = true, AFTER_DRAIN = false;
  ushort_t* ph; ushort_t* qkv; ushort_t* gate; const float* rope;
  DI void operator()(const f32x4p (&acc)[2][2][4][2], const pg8::Unit& u, int wr, int wc, int fr, int fq) const {
    if (u.kind == 0) {
      const int b = (u.pn * 256) >> 13;
      ushort_t* base = ph + ((size_t)(b * HYC + u.pm * 256 + wr * 64 + fr)) * S_ + ((u.pn * 256) & (S_ - 1)) + wc * 32 + 8 * fq;
#pragma unroll
      for (int ai = 0; ai < 2; ++ai)
#pragma unroll
        for (int m = 0; m < 4; ++m)
#pragma unroll
          for (int bj = 0; bj < 2; ++bj) *(u32x4*)(base + (size_t)(ai * 128 + m * 16) * S_ + bj * 128) = pack8(acc[ai][bj][m][0], acc[ai][bj][m][1]);
      return;
    }
    const int row0 = u.pm * 256 + wr * 64 + fr;
    if (u.pn < 9) {
      const int cq0 = u.pn * 256 + wc * 32 + 8 * fq;
      const bool rotw = (u.pn < 6) && ((wc & 1) == 0);
      const float qs = (u.pn < 3) ? 0.125f : 1.0f;
#pragma unroll
      for (int ai = 0; ai < 2; ++ai)
#pragma unroll
        for (int m = 0; m < 4; ++m) {
          const int row = row0 + ai * 128 + m * 16;
          f32x4p cs[4];
          if (rotw) {
#pragma unroll
            for (int q = 0; q < 4; ++q) cs[q] = *(const f32x4p*)(rope + (size_t)row * 16 + q * 4);
          }
#pragma unroll
          for (int bj = 0; bj < 2; ++bj) {
            f32x4p v0 = acc[ai][bj][m][0], v1 = acc[ai][bj][m][1];
            if (rotw) {
              f32x4p o0, o1;
#pragma unroll
              for (int j = 0; j < 4; ++j) { o0[j] = __shfl_xor(v0[j], 16); o1[j] = __shfl_xor(v1[j], 16); }
              if (fq < 2) {
                const float sg = (fq == 0) ? -1.f : 1.f;
#pragma unroll
                for (int j = 0; j < 4; ++j) {
                  const float c0 = cs[j >> 1][(j & 1) * 2], s0 = cs[j >> 1][(j & 1) * 2 + 1];
                  const float c1 = cs[2 + (j >> 1)][(j & 1) * 2], s1 = cs[2 + (j >> 1)][(j & 1) * 2 + 1];
                  v0[j] = v0[j] * c0 + sg * o0[j] * s0;
                  v1[j] = v1[j] * c1 + sg * o1[j] * s1;
                }
              }
            }
            *(u32x4*)(qkv + (size_t)row * QKVC + cq0 + bj * 128) = pack8(v0 * qs, v1 * qs);
          }
        }
    } else {
      const int cg0 = (u.pn - 9) * 256 + wc * 32 + 8 * fq;
#pragma unroll
      for (int ai = 0; ai < 2; ++ai)
#pragma unroll
        for (int m = 0; m < 4; ++m)
#pragma unroll
          for (int bj = 0; bj < 2; ++bj) {
            f32x4p v0 = acc[ai][bj][m][0], v1 = acc[ai][bj][m][1];
#pragma unroll
            for (int j = 0; j < 4; ++j) { v0[j] = 1.f / (1.f + __expf(-v0[j])); v1[j] = 1.f / (1.f + __expf(-v1[j])); }
            *(u32x4*)(gate + (size_t)(row0 + ai * 128 + m * 16) * GATEC + cg0 + bj * 128) = pack8(v0, v1);
          }
    }
  }
};
DI void phase_inproj(const P& p, char* smem) {
  InprojSched S{p.ws + OFF_U1B, p.ws + OFF_WIN_T, (int)gridDim.x, (int)blockIdx.x};
  InprojEpi E{(ushort_t*)(p.ws + OFF_PH), (ushort_t*)(p.ws + OFF_QKV), (ushort_t*)(p.ws + OFF_GATE), (const float*)(p.ws + OFF_ROPE)};
  pg8::gemm_phase(( __attribute__((address_space(3))) unsigned char*)smem, 1024, S, E);
}
struct PlainSched {
  const char* A; const char* Bt; int nM, nN, K, G, c;
  DI bool next(int i, pg8::Unit& u) const { const int L = i * G + c; if (L >= nM * nN) return false; u.kind = 0; pg8::tile_order(L, nM, nN, u.pm, u.pn); return true; }
  DI const char* a_ptr(const pg8::Unit& u) const { return A + (size_t)u.pm * 256 * K * 2; }
  DI const char* b_ptr(const pg8::Unit& u) const { return Bt + (size_t)u.pn * 256 * K * 2; }
};
struct OutprojEpi {
  static constexpr bool PERM = false, AFTER_DRAIN = false;
  const float* x; float* out; const float* ada;
  DI void operator()(const f32x4p (&acc)[2][2][4][2], const pg8::Unit& u, int wr, int wc, int fr, int fq) const {
    const int row0 = u.pm * 256 + wr * 64 + fr, col0 = u.pn * 256 + wc * 32 + 4 * fq, b = (u.pm * 256) / S_;
    f32x4p g1[2][2];
#pragma unroll
    for (int bj = 0; bj < 2; ++bj)
#pragma unroll
      for (int n = 0; n < 2; ++n) g1[bj][n] = *(const f32x4p*)(ada + b * 6144 + 2 * 1024 + col0 + bj * 128 + n * 16) + 1.0f;
#pragma unroll
    for (int ai = 0; ai < 2; ++ai)
#pragma unroll
      for (int m = 0; m < 4; ++m) {
        const size_t ro = (size_t)(row0 + ai * 128 + m * 16) * 1024 + col0;
#pragma unroll
        for (int bj = 0; bj < 2; ++bj)
#pragma unroll
          for (int n = 0; n < 2; ++n) {
            const f32x4p xv = *(const f32x4p*)(x + ro + bj * 128 + n * 16);
            *(f32x4p*)(out + ro + bj * 128 + n * 16) = xv * DN_ALPHA + g1[bj][n] * acc[ai][bj][m][n];
          }
      }
  }
};
DI void phase_outproj(const P& p, char* smem) {
  PlainSched S{p.ws + OFF_MERGED, p.ws + OFF_WOUT_T, 64, 4, 1024, (int)gridDim.x, (int)blockIdx.x};
  OutprojEpi E{p.x, p.out, (const float*)(p.ws + OFF_ADA)};
  pg8::gemm_phase(( __attribute__((address_space(3))) unsigned char*)smem, 1024, S, E);
}

DI float sconv_t(const ushort_t* row, int t, float w0, float w1, float w2, float cb) {
  float v = cb + w1 * bf2f(row[t]);
  if (t > 0) v += w0 * bf2f(row[t - 1]);
  if (t < S_ - 1) v += w2 * bf2f(row[t + 1]);
  return v;
}
DI void fft_C_mul_invC(cf2* lds, const cf2* __restrict__ kq, int tid) {
  asm volatile("" : "+v"(tid));
  const int k1 = tid >> 5, k2 = tid & 31;
  kq += tid;
#pragma unroll
  for (int h = 0; h < 2; ++h) {
    float tr[16], ti[16];
    cf2 kv[16];
#pragma unroll
    for (int i = 0; i < 16; ++i) kv[i] = kq[(h * 16 + i) * 512];
    cf2* blk = lds + (k1 + 16 * h) * FFT_SA + k2 * 17;
#pragma unroll
    for (int mp = 0; mp < 16; ++mp) { cf2 v = blk[mp]; tr[mp] = v.x; ti[mp] = v.y; }
    dft_fwd<16, false>(tr, ti);
#pragma unroll
    for (int i = 0; i < 16; ++i) { const float a = tr[i], b = ti[i]; tr[i] = a * kv[i].x - b * kv[i].y; ti[i] = a * kv[i].y + b * kv[i].x; }
    dft_inv<16>(tr, ti);
#pragma unroll
    for (int mp = 0; mp < 16; ++mp) { cf2 o; o.x = tr[mp]; o.y = ti[mp]; blk[mp] = o; }
  }
}
DI void hyena_item(const P& p, char* smem, int c) {
  cf2* lds = (cf2*)smem;
  const ushort_t* pht = (const ushort_t*)(p.ws + OFF_PH);
  ushort_t* yht = (ushort_t*)(p.ws + OFF_YH);
  cf2* kq = (cf2*)(p.ws + (blockIdx.x < 92 ? OFF_WIN_T + (size_t)blockIdx.x * 131072 : OFF_HSCR + (size_t)(blockIdx.x - 92) * 131072));
  const float* filt = p.out;
  const int tid0 = tid_opaque();
  float zr[32], zi[32];
  __syncthreads();
#pragma unroll 1
  for (int o = 0; o < 2; ++o) {
    int tid = tid0; asm volatile("" : "+v"(tid));
    {
      float kr[32], ki[32];
      const float* fw = filt + (size_t)(0 * 1024 + o * 512 + c) * S_;
      const float* bw = filt + (size_t)(1 * 1024 + o * 512 + c) * S_;
      const float bias = p.hy_bias[o * 512 + c];
#pragma unroll
      for (int n1 = 0; n1 < 16; ++n1) { kr[n1] = fw[n1 * 512 + tid] * (1.0f / 16384.0f); ki[n1] = 0.f; }
      if (tid == 0) kr[0] += bias * (1.0f / 16384.0f);
#pragma unroll
      for (int n1 = 16; n1 < 32; ++n1) {
        const int n = n1 * 512 + tid;
        kr[n1] = (n == S_) ? 0.f : bw[2 * S_ - n] * (1.0f / 16384.0f); ki[n1] = 0.f;
      }
      fft_fwdA<false>(kr, ki, lds, tid); __syncthreads();
      fft_B_read(kr, ki, lds, tid); __syncthreads();
      fft_fwdB_write(kr, ki, lds, tid); __syncthreads();
      fft_fwdC(kr, ki, lds, tid);
      int ts = tid; asm volatile("" : "+v"(ts));
      cf2* kqt = kq + ts;
#pragma unroll
      for (int r = 0; r < 32; ++r) { cf2 v; v.x = kr[r]; v.y = ki[r]; kqt[r * 512] = v; }
      __syncthreads();
    }
    asm volatile("" : "+v"(tid));
    if (o == 0) {
      const float w0 = p.hy_conv_w[c], w1 = p.hy_conv_w[HYC + c], w2 = p.hy_conv_w[2 * HYC + c], cb = p.hy_conv_b[c];
      const ushort_t* r0 = pht + (size_t)(0 * HYC + c) * S_;
      const ushort_t* r1 = pht + (size_t)(1 * HYC + c) * S_;
#pragma unroll
      for (int n1 = 0; n1 < 16; ++n1) {
        const int t = n1 * 512 + tid;
        zr[n1] = sconv_t(r0, t, w0, w1, w2, cb); zi[n1] = sconv_t(r1, t, w0, w1, w2, cb);
        if (n1 & 1) asm volatile("" ::: "memory");
      }
    }
#pragma unroll
    for (int n1 = 16; n1 < 32; ++n1) { zr[n1] = 0.f; zi[n1] = 0.f; }
    fft_fwdA<true>(zr, zi, lds, tid); __syncthreads();
    fft_B_read(zr, zi, lds, tid); __syncthreads();
    fft_fwdB_write(zr, zi, lds, tid); __syncthreads();
    fft_C_mul_invC(lds, kq, tid); __syncthreads();
    fft_invB_read(zr, zi, lds, tid); __syncthreads();
    fft_invB_write(zr, zi, lds, tid); __syncthreads();
    fft_invA(zr, zi, lds, tid);
    int tg = tid; asm volatile("" : "+v"(tg));
    const int gch = (o + 1) * 512 + c;
    const float w0 = p.hy_conv_w[gch], w1 = p.hy_conv_w[HYC + gch], w2 = p.hy_conv_w[2 * HYC + gch], cb = p.hy_conv_b[gch];
    const ushort_t* g0 = pht + (size_t)(0 * HYC + gch) * S_;
    const ushort_t* g1 = pht + (size_t)(1 * HYC + gch) * S_;
#pragma unroll
    for (int n1 = 0; n1 < 16; ++n1) {
      const int t = n1 * 512 + tg;
      zr[n1] *= sconv_t(g0, t, w0, w1, w2, cb);
      zi[n1] *= sconv_t(g1, t, w0, w1, w2, cb);
      if (n1 & 1) asm volatile("" ::: "memory");
    }
    if (o == 1) {
#pragma unroll
      for (int n1 = 0; n1 < 16; ++n1) {
        const int t = n1 * 512 + tg;
        yht[(size_t)(0 * HW_ + c) * S_ + t] = f2bf(zr[n1]);
        yht[(size_t)(1 * HW_ + c) * S_ + t] = f2bf(zi[n1]);
      }
    }
  }
}

constexpr int ATT_VROW = 192;
constexpr int ATT_VBUF = 32 * ATT_VROW;
DI void attn_item(const P& p, char* smem, int item) {
  const ushort_t* qkv = (const ushort_t*)(p.ws + OFF_QKV);
  ushort_t* ya = (ushort_t*)(p.ws + OFF_YA);
  const int tid = tid_opaque(), lane = tid & 63, wave = tid >> 6;
  const int u = item * 8 + wave;
  const int hs = u & 3, r16 = (u >> 2) & 15, chunk = (u >> 6) & 15, b = u >> 10;
  const int qi = lane & 31, h = lane >> 5;
  char* vl = smem + wave * ATT_VBUF;
  const int tq = chunk * 512 + r16 + 16 * qi;
  const size_t bbase = (size_t)b * S_;
  f32x16 o0, o1;
#pragma unroll
  for (int r = 0; r < 16; ++r) { o0[r] = 0.f; o1[r] = 0.f; }
  float m = -1e30f, l = 0.f;
  const int g16 = (lane >> 4) & 1, q4 = (lane & 15) >> 2, p4 = lane & 3;
  __syncthreads();
#pragma unroll 1
  for (int g = 0; g < 3; ++g) {
    const int dsh = 2 * g;
    const int d = 1 << dsh, sd = 16 >> dsh, n = S_ >> dsh;
    const int head = g * 4 + hs;
    const int rc = r16 & (d - 1);
    const int P0 = (chunk * 512 + r16 - rc) >> dsh;
    const int pq = P0 + sd * qi;
    const int KB = P0 - 64;
    const int ntile = (g == 0) ? 20 : (g == 1 ? 8 : 5);
    bf16x8 bq[4];
    {
      const ushort_t* qrow = qkv + (bbase + tq) * QKVC + head * 64;
#pragma unroll
      for (int s = 0; s < 4; ++s) bq[s] = *(const bf16x8*)(qrow + (2 * s + h) * 8);
    }
    bf16x8 kn[4]; u32x4 vn[4];
    {
      const int kp = min(max(KB + qi, 0), n - 1);
      const ushort_t* krow = qkv + (bbase + rc + ((size_t)kp << dsh)) * QKVC + 768 + head * 64;
#pragma unroll
      for (int s = 0; s < 4; ++s) kn[s] = *(const bf16x8*)(krow + (2 * s + h) * 8);
#pragma unroll
      for (int i = 0; i < 4; ++i) {
        const int c = lane + 64 * i, row = c >> 3, ch = c & 7;
        const int vp = min(max(KB + row, 0), n - 1);
        vn[i] = *(const u32x4*)(qkv + (bbase + rc + ((size_t)vp << dsh)) * QKVC + 1536 + head * 64 + ch * 8);
      }
    }
#pragma unroll 1
    for (int kt = 0; kt < ntile; ++kt) {
      bf16x8 kc[4]; u32x4 vc[4];
#pragma unroll
      for (int s = 0; s < 4; ++s) kc[s] = kn[s];
#pragma unroll
      for (int i = 0; i < 4; ++i) vc[i] = vn[i];
      if (kt + 1 < ntile) {
        const int kb1 = KB + 32 * (kt + 1);
        const int kp = min(max(kb1 + qi, 0), n - 1);
        const ushort_t* krow = qkv + (bbase + rc + ((size_t)kp << dsh)) * QKVC + 768 + head * 64;
#pragma unroll
        for (int s = 0; s < 4; ++s) kn[s] = *(const bf16x8*)(krow + (2 * s + h) * 8);
#pragma unroll
        for (int i = 0; i < 4; ++i) {
          const int c = lane + 64 * i, row = c >> 3, ch = c & 7;
          const int vp = min(max(kb1 + row, 0), n - 1);
          vn[i] = *(const u32x4*)(qkv + (bbase + rc + ((size_t)vp << dsh)) * QKVC + 1536 + head * 64 + ch * 8);
        }
      }
      f32x16 st;
#pragma unroll
      for (int r = 0; r < 16; ++r) st[r] = 0.f;
#pragma unroll
      for (int s = 0; s < 4; ++s) st = __builtin_amdgcn_mfma_f32_32x32x16_bf16(kc[s], bq[s], st, 0, 0, 0);
#pragma unroll
      for (int i = 0; i < 4; ++i) { const int c = lane + 64 * i; *(u32x4*)(vl + (c >> 3) * ATT_VROW + (c & 7) * 16) = vc[i]; }
      const int kb = KB + 32 * kt + 4 * h;
      const int dk = kb - pq;
      float mx = -1e30f;
      bool ok[16];
#pragma unroll
      for (int r = 0; r < 16; ++r) {
        const int cr = (r & 3) + 8 * (r >> 2);
        ok[r] = ((unsigned)(dk + cr + 64) <= 128u) && ((unsigned)(kb + cr) < (unsigned)n);
        mx = fmaxf(mx, ok[r] ? st[r] : -1e30f);
      }
      mx = fmaxf(mx, __shfl_xor(mx, 32));
      const float mnew = fmaxf(m, mx);
      const float corr = __expf(m - mnew);
      float ps = 0.f;
      float pv[16];
#pragma unroll
      for (int r = 0; r < 16; ++r) { pv[r] = ok[r] ? __expf(st[r] - mnew) : 0.f; ps += pv[r]; }
      ps += __shfl_xor(ps, 32);
      l = l * corr + ps; m = mnew;
#pragma unroll
      for (int r = 0; r < 16; ++r) { o0[r] *= corr; o1[r] *= corr; }
      bf16x8 pf[2];
#pragma unroll
      for (int s = 0; s < 2; ++s) {
        u32x4 w;
        w[0] = pack2(pv[8 * s + 0], pv[8 * s + 1]); w[1] = pack2(pv[8 * s + 2], pv[8 * s + 3]);
        w[2] = pack2(pv[8 * s + 4], pv[8 * s + 5]); w[3] = pack2(pv[8 * s + 6], pv[8 * s + 7]);
        pf[s] = __builtin_bit_cast(bf16x8, w);
      }
      __builtin_amdgcn_wave_barrier();
      asm volatile("s_waitcnt lgkmcnt(0)" ::: "memory");
#pragma unroll
      for (int s = 0; s < 2; ++s) {
#pragma unroll
        for (int nt = 0; nt < 2; ++nt) {
          const char* a0 = vl + (16 * s + 4 * h + q4) * ATT_VROW + (32 * nt + 16 * g16 + 4 * p4) * 2;
          s16x4 lo = __builtin_amdgcn_ds_read_tr16_b64_v4i16((__attribute__((address_space(3))) s16x4*)(a0));
          s16x4 hi = __builtin_amdgcn_ds_read_tr16_b64_v4i16((__attribute__((address_space(3))) s16x4*)(a0 + 8 * ATT_VROW));
          const bf16x8 vf = __builtin_shufflevector(lo, hi, 0, 1, 2, 3, 4, 5, 6, 7);
          if (nt == 0) o0 = __builtin_amdgcn_mfma_f32_32x32x16_bf16(vf, pf[s], o0, 0, 0, 0);
          else o1 = __builtin_amdgcn_mfma_f32_32x32x16_bf16(vf, pf[s], o1, 0, 0, 0);
        }
      }
      __builtin_amdgcn_wave_barrier();
      asm volatile("s_waitcnt lgkmcnt(0)" ::: "memory");
    }
  }
  const float il = 1.f / l;
  ushort_t* op = ya + (bbase + tq) * 256 + hs * 64;
#pragma unroll
  for (int gq = 0; gq < 4; ++gq) {
    uint2 w0, w1;
    w0.x = pack2(o0[4 * gq] * il, o0[4 * gq + 1] * il); w0.y = pack2(o0[4 * gq + 2] * il, o0[4 * gq + 3] * il);
    w1.x = pack2(o1[4 * gq] * il, o1[4 * gq + 1] * il); w1.y = pack2(o1[4 * gq + 2] * il, o1[4 * gq + 3] * il);
    *(uint2*)(op + 8 * gq + 4 * h) = w0;
    *(uint2*)(op + 32 + 8 * gq + 4 * h) = w1;
  }
}

DI void phase_yh_transpose(const P& p, char* smem) {
  const ushort_t* yht = (const ushort_t*)(p.ws + OFF_YH);
  ushort_t* yhk = (ushort_t*)(p.ws + OFF_YHK);
  const int tid = tid_opaque();
  for (int item = blockIdx.x; item < 1024; item += gridDim.x) {
    const int cg = item & 15, tc = item >> 4, b = tc >> 5, t0 = (tc * 256) & (S_ - 1);
    __syncthreads();
    {
      const int ch = tid >> 4, k16 = tid & 15;
      const ushort_t* srcp = yht + (size_t)(b * HW_ + cg * 32 + ch) * S_ + t0;
#pragma unroll
      for (int i = 0; i < 2; ++i) *(u32x4*)(smem + ch * 528 + (k16 + 16 * i) * 16) = *(const u32x4*)(srcp + (k16 + 16 * i) * 8);
    }
    __syncthreads();
    {
      const int t = tid >> 1, half = tid & 1;
      unsigned w[8];
#pragma unroll
      for (int k = 0; k < 8; ++k) {
        const unsigned lo = *(const ushort_t*)(smem + (half * 16 + 2 * k) * 528 + t * 2);
        const unsigned hi = *(const ushort_t*)(smem + (half * 16 + 2 * k + 1) * 528 + t * 2);
        w[k] = lo | (hi << 16);
      }
      ushort_t* dst = yhk + (size_t)(tc * 256 + t) * HW_ + cg * 32 + half * 16;
      u32x4 o0, o1; o0[0] = w[0]; o0[1] = w[1]; o0[2] = w[2]; o0[3] = w[3]; o1[0] = w[4]; o1[1] = w[5]; o1[2] = w[6]; o1[3] = w[7];
      *(u32x4*)dst = o0; *(u32x4*)(dst + 8) = o1;
    }
  }
}
DI f32x4p bf4lo(const u32x4& w) { f32x4p r; r[0] = __uint_as_float(w[0] << 16); r[1] = __uint_as_float(w[0] & 0xffff0000u); r[2] = __uint_as_float(w[1] << 16); r[3] = __uint_as_float(w[1] & 0xffff0000u); return r; }
DI f32x4p bf4hi(const u32x4& w) { f32x4p r; r[0] = __uint_as_float(w[2] << 16); r[1] = __uint_as_float(w[2] & 0xffff0000u); r[2] = __uint_as_float(w[3] << 16); r[3] = __uint_as_float(w[3] & 0xffff0000u); return r; }
template <bool ADD>
struct MergeEpi {
  static constexpr bool PERM = true, AFTER_DRAIN = false;
  const ushort_t* gate; ushort_t* merged;
  DI void operator()(const f32x4p (&acc)[2][2][4][2], const pg8::Unit& u, int wr, int wc, int fr, int fq) const {
    const ushort_t* gb = gate + (size_t)(u.pm * 256) * GATEC + u.pn * 256;
    ushort_t* mb = merged + (size_t)(u.pm * 256) * 1024 + u.pn * 256;
    const unsigned lg = (unsigned)((wr * 64 + fr) * GATEC + wc * 32 + 8 * fq), lm = (unsigned)((wr * 64 + fr) * 1024 + wc * 32 + 8 * fq);
#pragma unroll
    for (int ai = 0; ai < 2; ++ai)
#pragma unroll
      for (int m = 0; m < 4; ++m) {
#pragma unroll
        for (int bj = 0; bj < 2; ++bj) {
          const u32x4 gw = *(const u32x4*)(gb + (ai * 128 + m * 16) * GATEC + bj * 128 + lg);
          f32x4p v0 = bf4lo(gw) * acc[ai][bj][m][0], v1 = bf4hi(gw) * acc[ai][bj][m][1];
          ushort_t* mp = mb + (ai * 128 + m * 16) * 1024 + bj * 128 + lm;
          if (ADD) { const u32x4 mw = *(const u32x4*)mp; v0 += bf4lo(mw); v1 += bf4hi(mw); }
          *(u32x4*)mp = pack8(v0, v1);
        }
        asm volatile("" ::: "memory");
      }
  }
};
DI void phase_merge(const P& p, char* smem) {
  {
    PlainSched S{p.ws + OFF_YHK, p.ws + OFF_WBH_T, 64, 4, 512, (int)gridDim.x, (int)blockIdx.x};
    MergeEpi<false> E{(const ushort_t*)(p.ws + OFF_GATE), (ushort_t*)(p.ws + OFF_MERGED)};
    pg8::gemm_phase(( __attribute__((address_space(3))) unsigned char*)smem, 512, S, E);
  }
  {
    PlainSched S{p.ws + OFF_YA, p.ws + OFF_WBA_T, 64, 4, 256, (int)gridDim.x, (int)blockIdx.x};
    MergeEpi<true> E{(const ushort_t*)(p.ws + OFF_GATE) + 1024, (ushort_t*)(p.ws + OFF_MERGED)};
    pg8::gemm_phase(( __attribute__((address_space(3))) unsigned char*)smem, 256, S, E);
  }
}

DI void phase_ln(float* __restrict__ xio, const float* __restrict__ g, const float* __restrict__ bta) {
  const int tq = tid_opaque(); const int lane = tq & 63, wave = tq >> 6;
  for (int row = blockIdx.x * 8 + wave; row < T_; row += gridDim.x * 8) {
    float* rp = xio + (size_t)row * 1024;
    f32x4 v[4];
    float s = 0.f;
#pragma unroll
    for (int i = 0; i < 4; ++i) { v[i] = *(const f32x4*)(rp + i * 256 + lane * 4); s += v[i][0] + v[i][1] + v[i][2] + v[i][3]; }
    const float mu = wave_sum(s) * (1.f / 1024.f);
    float q = 0.f;
#pragma unroll
    for (int i = 0; i < 4; ++i)
#pragma unroll
      for (int j = 0; j < 4; ++j) { float d = v[i][j] - mu; q += d * d; }
    const float rs = rsqrtf(wave_sum(q) * (1.f / 1024.f) + LN_EPS);
#pragma unroll
    for (int i = 0; i < 4; ++i) {
      f32x4 gg = *(const f32x4*)(g + i * 256 + lane * 4), bb = *(const f32x4*)(bta + i * 256 + lane * 4), o;
#pragma unroll
      for (int j = 0; j < 4; ++j) o[j] = (v[i][j] - mu) * rs * gg[j] + bb[j];
      *(f32x4*)(rp + i * 256 + lane * 4) = o;
    }
  }
}

DI int swz256(int row, int ch) { return row * 256 + ((ch ^ (row & 15)) << 4); }
DI void ins16(float (&L)[16], float x) {
#pragma unroll
  for (int i = 0; i < 16; ++i) { const float hi = __builtin_fmaxf(L[i], x); x = __builtin_fminf(L[i], x); L[i] = hi; }
}
DI void bitonic16_desc(float (&M)[16]) {
#pragma unroll
  for (int d = 8; d >= 1; d >>= 1)
#pragma unroll
    for (int i = 0; i < 16; ++i)
      if ((i & d) == 0) { const float a = M[i], b = M[i + d]; M[i] = __builtin_fmaxf(a, b); M[i + d] = __builtin_fminf(a, b); }
}
constexpr int ROUTE_Q_OFF = 0, ROUTE_K_OFF = 65536, ROUTE_IDX_OFF = 106496;
DI void phase_route(const P& p, char* smem) {
  const float* ada = (const float*)(p.ws + OFF_ADA);
  float* mod = (float*)(smem + 2 * LDS_STAGE);
  const ushort_t* keysb = (const ushort_t*)(p.ws + OFF_KEYS_B);
  int* idx = (int*)(p.ws + OFF_IDX);
  float* gv = (float*)(p.ws + OFF_GV);
  for (int item = blockIdx.x; item < (T_ / BM) * 8; item += gridDim.x) {
    const int tid = tid_opaque(), lane = tid & 63, wave = tid >> 6, wm = wave >> 1, wn = wave & 1;
    const int m0 = (item >> 3) * BM, hh = item & 7;
    float L0[16];
#pragma unroll 1
    for (int pp = 0; pp < 2; ++pp) {
      const int hp = hh * 2 + pp;
      f32x16 acc[2][2]; acc_zero(acc);
      ALoadBf16 al{(const ushort_t*)(p.ws + OFF_U2B), 1024};
      gemm_mainloop<ALoadBf16, true>(acc, al, m0, (const ushort_t*)(p.ws + OFF_WQ_T), 1024, hp * 128, 1024, smem);
#pragma unroll
      for (int mi = 0; mi < 2; ++mi) {
        const int tok = wm * 64 + mi * 32 + (lane & 31);
#pragma unroll
        for (int ni = 0; ni < 2; ++ni)
#pragma unroll
          for (int g = 0; g < 4; ++g) {
            const int ch = wn * 8 + ni * 4 + g;
            uint2 v; v.x = pack2(acc[mi][ni][4 * g], acc[mi][ni][4 * g + 1]); v.y = pack2(acc[mi][ni][4 * g + 2], acc[mi][ni][4 * g + 3]);
            *(uint2*)(smem + ROUTE_Q_OFF + swz256(tok, ch) + 8 * (lane >> 5)) = v;
          }
      }
#pragma unroll
      for (int i = 0; i < 4; ++i) {
        const int q = tid + 512 * i, row = q >> 4, ch = q & 15;
        *(u32x4*)(smem + ROUTE_K_OFF + swz256(row, ch)) = *(const u32x4*)(keysb + (size_t)hp * 16384 + row * 128 + ch * 8);
      }
      __syncthreads();
      f32x16 sc[4];
#pragma unroll
      for (int ks = 0; ks < 4; ++ks)
#pragma unroll
        for (int r = 0; r < 16; ++r) sc[ks][r] = 0.f;
#pragma unroll
      for (int s = 0; s < 8; ++s) {
        const int ch = 2 * s + (lane >> 5);
        const bf16x8 bq = *(const bf16x8*)(smem + ROUTE_Q_OFF + swz256(wave * 32 + (lane & 31), ch));
#pragma unroll
        for (int ks = 0; ks < 4; ++ks) {
          const bf16x8 ak = *(const bf16x8*)(smem + ROUTE_K_OFF + swz256(ks * 32 + (lane & 31), ch));
          sc[ks] = __builtin_amdgcn_mfma_f32_32x32x16_bf16(ak, bq, sc[ks], 0, 0, 0);
        }
      }
      float L[16];
#pragma unroll
      for (int i = 0; i < 16; ++i) L[i] = -3.0e38f;
      const unsigned hbit = (unsigned)(lane >> 5) << 2;
#pragma unroll
      for (int ks = 0; ks < 4; ++ks)
#pragma unroll
        for (int r = 0; r < 16; ++r) {
          const unsigned key = (unsigned)(ks * 32 + (r & 3) + 8 * (r >> 2)) | hbit;
          ins16(L, __uint_as_float((__float_as_uint(sc[ks][r]) & ~127u) | key));
        }
      {
        float M[16];
#pragma unroll
        for (int i = 0; i < 16; ++i) M[i] = __builtin_fmaxf(L[i], __shfl_xor(L[15 - i], 32));
        bitonic16_desc(M);
#pragma unroll
        for (int i = 0; i < 16; ++i) L[i] = M[i];
      }
      if (pp == 0) {
#pragma unroll
        for (int i = 0; i < 16; ++i) L0[i] = L[i];
      } else {
        unsigned char* ib = (unsigned char*)(smem + ROUTE_IDX_OFF) + tid * 32;
#pragma unroll
        for (int i = 0; i < 16; ++i) { ib[i] = (unsigned char)(__float_as_uint(L0[i]) & 127u); ib[16 + i] = (unsigned char)(__float_as_uint(L[i]) & 127u); }
        float F[16];
#pragma unroll
        for (int i = 0; i < 16; ++i) F[i] = -3.0e38f;
#pragma unroll
        for (int i = 0; i < 16; ++i) {
          const float ai = __uint_as_float(__float_as_uint(L0[i]) & ~127u);
#pragma unroll
          for (int j = 0; j < 16; ++j)
            if ((i + 1) * (j + 1) <= 16) {
              const float s = ai + __uint_as_float(__float_as_uint(L[j]) & ~127u);
              ins16(F, __uint_as_float((__float_as_uint(s) & ~255u) | (unsigned)(i * 16 + j)));
            }
        }
        const float mx = __uint_as_float(__float_as_uint(F[0]) & ~255u);
        float e[16], sum = 0.f;
#pragma unroll
        for (int k = 0; k < 16; ++k) { e[k] = __expf(__uint_as_float(__float_as_uint(F[k]) & ~255u) - mx); sum += e[k]; }
        const float inv = 1.f / sum;
        if (lane < 32) {
          const int tok = m0 + wave * 32 + lane;
          int* ip = idx + (size_t)tok * 128 + hh * 16;
          float* gp = gv + (size_t)tok * 128 + hh * 16;
#pragma unroll
          for (int k4 = 0; k4 < 4; ++k4) {
            int4 iv; f32x4 g4;
            int ee[4];
#pragma unroll
            for (int u = 0; u < 4; ++u) {
              const unsigned code = __float_as_uint(F[k4 * 4 + u]) & 255u;
              ee[u] = (int)ib[code >> 4] * 128 + (int)ib[16 + (code & 15u)];
              g4[u] = e[k4 * 4 + u] * inv;
            }
            iv.x = ee[0]; iv.y = ee[1]; iv.z = ee[2]; iv.w = ee[3];
            *(int4*)(ip + k4 * 4) = iv;
            *(f32x4*)(gp + k4 * 4) = g4;
          }
        }
      }
    }
  }
}

DI void phase_rope(const P& p) {
  float* rt = (float*)(p.ws + OFF_ROPE);
  for (int i = blockIdx.x * NT + tid_opaque(); i < T_ * 8; i += gridDim.x * NT) {
    const float inv = expf(-13.122363377404328f * (float)(i & 7) * 0.125f);
    const float x = (float)p.pos[i >> 3] * inv;
    const float k = rintf(x * 0.15915494309189535f);
    float r = fmaf(-k, 6.28125f, x);
    r = fmaf(-k, 1.9353071795864769e-3f, r);
    float sn, cs; __sincosf(r, &sn, &cs);
    rt[2 * i] = cs; rt[2 * i + 1] = sn;
  }
}
DI void phase_keys(const P& p) {
  ushort_t* keysb = (ushort_t*)(p.ws + OFF_KEYS_B);
  for (int i = blockIdx.x * NT + tid_opaque(); i < 16 * 128 * 128 / 4; i += gridDim.x * NT) {
    f32x4 v = *(const f32x4*)(p.keys + (size_t)i * 4);
    uint2 o; o.x = pack2(v[0], v[1]); o.y = pack2(v[2], v[3]);
    *(uint2*)(keysb + (size_t)i * 4) = o;
  }
}

typedef __bf16 bf16x2_t __attribute__((ext_vector_type(2)));
DI float dot2bf(unsigned a, unsigned b, float c) { return __builtin_amdgcn_fdot2_f32_bf16(__builtin_bit_cast(bf16x2_t, a), __builtin_bit_cast(bf16x2_t, b), c, false); }
DI void phase_ln1(const P& p) {
  const float* ada = (const float*)(p.ws + OFF_ADA);
  ushort_t* u2b = (ushort_t*)(p.ws + OFF_U2B);
  const int tq = tid_opaque(); const int lane = tq & 63, wave = tq >> 6;
  for (int row = blockIdx.x * 8 + wave; row < T_; row += gridDim.x * 8) {
    const int b = row / S_;
    float* rp = p.out + (size_t)row * 1024;
    f32x4 v[4];
    float s = 0.f;
#pragma unroll
    for (int i = 0; i < 4; ++i) { v[i] = *(const f32x4*)(rp + i * 256 + lane * 4); s += v[i][0] + v[i][1] + v[i][2] + v[i][3]; }
    const float mu = wave_sum(s) * (1.f / 1024.f);
    float q = 0.f;
#pragma unroll
    for (int i = 0; i < 4; ++i)
#pragma unroll
      for (int j = 0; j < 4; ++j) { float d = v[i][j] - mu; q += d * d; }
    const float rs = rsqrtf(wave_sum(q) * (1.f / 1024.f) + LN_EPS);
#pragma unroll
    for (int i = 0; i < 4; ++i) {
      const int col = i * 256 + lane * 4;
      f32x4 gg = *(const f32x4*)(p.ln1_g + col), bb = *(const f32x4*)(p.ln1_b + col), o;
      f32x4 sc = *(const f32x4*)(ada + b * 6144 + 4 * 1024 + col), sh = *(const f32x4*)(ada + b * 6144 + 3 * 1024 + col);
#pragma unroll
      for (int j = 0; j < 4; ++j) o[j] = (v[i][j] - mu) * rs * gg[j] + bb[j];
      *(f32x4*)(rp + col) = o;
      uint2 w; w.x = pack2(o[0] * (1.f + sc[0]) + sh[0], o[1] * (1.f + sc[1]) + sh[1]); w.y = pack2(o[2] * (1.f + sc[2]) + sh[2], o[3] * (1.f + sc[3]) + sh[3]);
      *(uint2*)(u2b + (size_t)row * 1024 + col) = w;
    }
  }
}
DI float wave_max(float v) {
#pragma unroll
  for (int o = 32; o > 0; o >>= 1) v = fmaxf(v, __shfl_xor(v, o));
  return v;
}
DI unsigned pack4_fp8(float a, float b, float c, float d) {
  int w = 0;
  w = __builtin_amdgcn_cvt_pk_fp8_f32(a, b, w, false);
  w = __builtin_amdgcn_cvt_pk_fp8_f32(c, d, w, true);
  return (unsigned)w;
}
DI void phase_tabconv(const P& p) {
  unsigned char* tu = (unsigned char*)(p.ws + OFF_TABU);
  unsigned char* tv = (unsigned char*)(p.ws + OFF_TABV);
  float* su = (float*)(p.ws + OFF_SU);
  float* sv = (float*)(p.ws + OFF_SV);
  const int tq = tid_opaque(); const int lane = tq & 63, wave = tq >> 6;
  for (int e = blockIdx.x * 8 + wave; e < 16384; e += gridDim.x * 8) {
    f32x4 a[4], c[4];
    float ma = 0.f, mc = 0.f;
#pragma unroll
    for (int i = 0; i < 4; ++i) {
      const int col = i * 256 + lane * 4;
      a[i] = *(const f32x4*)(p.pu + (size_t)e * 1024 + col);
      c[i] = *(const f32x4*)(p.pv + (size_t)e * 1024 + col);
#pragma unroll
      for (int j = 0; j < 4; ++j) { ma = fmaxf(ma, fabsf(a[i][j])); mc = fmaxf(mc, fabsf(c[i][j])); }
    }
    ma = wave_max(ma); mc = wave_max(mc);
    const float sa = (ma > 0.f) ? ma * (1.0f / 448.0f) : 1.0f, sc = (mc > 0.f) ? mc * (1.0f / 448.0f) : 1.0f;
    const float ia = 1.0f / sa, ic = 1.0f / sc;
    if (lane == 0) { su[e] = sa; sv[e] = sc; }
#pragma unroll
    for (int i = 0; i < 4; ++i) {
      const int col = i * 256 + lane * 4;
      *(unsigned*)(tu + (size_t)e * 1024 + col) = pack4_fp8(a[i][0] * ia, a[i][1] * ia, a[i][2] * ia, a[i][3] * ia);
      const int slice = i * 2 + (lane >> 5);
      *(unsigned*)(tv + ((size_t)slice * 16384 + e) * 128 + (lane & 31) * 4) = pack4_fp8(c[i][0] * ic, c[i][1] * ic, c[i][2] * ic, c[i][3] * ic);
    }
  }
}

template <int CTRL> DI float dpp_f(float v) { return __int_as_float(__builtin_amdgcn_mov_dpp(__float_as_int(v), CTRL, 0xf, 0xf, false)); }
template <int CTRL> DI int dpp_shr0(int v) { return __builtin_amdgcn_update_dpp(0, v, CTRL, 0xf, 0xf, true); }
template <int I> DI int bcast16(int v) { return __builtin_amdgcn_mov_dpp(v, 0x150 + I, 0xf, 0xf, false); }
DI float row_sum16(float d) {
  d += dpp_f<0xB1>(d);
  d += dpp_f<0x4E>(d);
  d += dpp_f<0x141>(d);
  d += dpp_f<0x140>(d);
  return d;
}
typedef __bf16 bf16x2_c __attribute__((ext_vector_type(2)));
DI float dot4_fp8(unsigned w8, unsigned xlo, unsigned xhi, float acc) {
  const bf16x2_c lo = __builtin_amdgcn_cvt_scalef32_pk_bf16_fp8((int)w8, 1.0f, false);
  const bf16x2_c hi = __builtin_amdgcn_cvt_scalef32_pk_bf16_fp8((int)w8, 1.0f, true);
  acc = __builtin_amdgcn_fdot2_f32_bf16(lo, __builtin_bit_cast(bf16x2_c, xlo), acc, false);
  return __builtin_amdgcn_fdot2_f32_bf16(hi, __builtin_bit_cast(bf16x2_c, xhi), acc, false);
}
DI void phase_upass(const P& p, char* smem) {
  const int* idx = (const int*)(p.ws + OFF_IDX);
  const float* gv = (const float*)(p.ws + OFF_GV);
  const ushort_t* u2b = (const ushort_t*)(p.ws + OFF_U2B);
  const char* tabu = (const char*)(p.ws + OFF_TABU);
  const float* su = (const float*)(p.ws + OFF_SU);
  const float* sv = (const float*)(p.ws + OFF_SV);
  float* coef = (float*)(p.ws + OFF_COEF);
  const int tq = tid_opaque(); const int lane = tq & 63, wave = tq >> 6;
  const int g = lane >> 4, j = lane & 15;
  int4* lst = (int4*)smem + wave * 512 + g * 128;
  const int part = blockIdx.x & 7, bi = blockIdx.x >> 3, nb = (gridDim.x - part + 7) >> 3;
  __syncthreads();
#pragma unroll 1
  for (int tb = (bi * 8 + wave) * 4; tb < T_; tb += nb * 32) {
    const int tok = tb + g;
    const int4 i0 = *(const int4*)(idx + (size_t)tb * 128 + lane * 8), i1 = *(const int4*)(idx + (size_t)tb * 128 + lane * 8 + 4);
    const f32x4 g0 = *(const f32x4*)(gv + (size_t)tb * 128 + lane * 8), g1 = *(const f32x4*)(gv + (size_t)tb * 128 + lane * 8 + 4);
    u32x4 xr[8];
#pragma unroll
    for (int c = 0; c < 4; ++c) {
      xr[2 * c] = *(const u32x4*)(u2b + (size_t)tok * 1024 + (j + 16 * c) * 16);
      xr[2 * c + 1] = *(const u32x4*)(u2b + (size_t)tok * 1024 + (j + 16 * c) * 16 + 8);
    }
    const int ev[8] = {i0.x, i0.y, i0.z, i0.w, i1.x, i1.y, i1.z, i1.w};
    const float gg[8] = {g0[0], g0[1], g0[2], g0[3], g1[0], g1[1], g1[2], g1[3]};
    int cnt = 0;
#pragma unroll
    for (int i = 0; i < 8; ++i) cnt += ((ev[i] >> 11) == part) ? 1 : 0;
    int incl = cnt;
    incl += dpp_shr0<0x111>(incl); incl += dpp_shr0<0x112>(incl); incl += dpp_shr0<0x114>(incl); incl += dpp_shr0<0x118>(incl);
    const int ng = bcast16<15>(incl);
    int pos = incl - cnt;
#pragma unroll
    for (int i = 0; i < 8; ++i)
      if ((ev[i] >> 11) == part) { int4 en; en.x = ev[i]; en.y = __float_as_int(gg[i]); en.z = j * 8 + i; en.w = 0; lst[pos] = en; ++pos; }
    const int nmax = max(max(__builtin_amdgcn_readlane(ng, 0), __builtin_amdgcn_readlane(ng, 16)), max(__builtin_amdgcn_readlane(ng, 32), __builtin_amdgcn_readlane(ng, 48)));
    __builtin_amdgcn_wave_barrier();
    asm volatile("s_waitcnt lgkmcnt(0)" ::: "memory");
    u32x4 ra[4], rb[4], rc[4], rd[4];
#define UP_LOAD(R, IT) { const unsigned e_ = ((IT) < ng) ? (unsigned)lst[(IT)].x : 0u; const char* row_ = tabu + (size_t)e_ * 1024 + j * 16; \
                         _Pragma("unroll") for (int c = 0; c < 4; ++c) R[c] = *(const u32x4*)(row_ + c * 256); }
#define UP_COMP(R, IT) { float a0 = 0.f, a1 = 0.f, a2 = 0.f, a3 = 0.f; \
      _Pragma("unroll") for (int c = 0; c < 4; ++c) { \
        a0 = dot4_fp8(R[c][0], xr[2 * c][0], xr[2 * c][1], a0); a1 = dot4_fp8(R[c][1], xr[2 * c][2], xr[2 * c][3], a1); \
        a2 = dot4_fp8(R[c][2], xr[2 * c + 1][0], xr[2 * c + 1][1], a2); a3 = dot4_fp8(R[c][3], xr[2 * c + 1][2], xr[2 * c + 1][3], a3); } \
      const float d_ = row_sum16((a0 + a1) + (a2 + a3)); \
      if (j == 0 && (IT) < ng) ((int*)&lst[(IT)])[3] = __float_as_int(d_); }
    UP_LOAD(ra, 0) UP_LOAD(rb, 1) UP_LOAD(rc, 2) UP_LOAD(rd, 3)
#pragma unroll 1
    for (int it = 0; it < nmax; it += 4) {
      UP_COMP(ra, it)     UP_LOAD(ra, it + 4)
      UP_COMP(rb, it + 1) UP_LOAD(rb, it + 5)
      UP_COMP(rc, it + 2) UP_LOAD(rc, it + 6)
      UP_COMP(rd, it + 3) UP_LOAD(rd, it + 7)
    }
#undef UP_LOAD
#undef UP_COMP
    __builtin_amdgcn_wave_barrier();
    asm volatile("s_waitcnt lgkmcnt(0)" ::: "memory");
#pragma unroll 1
    for (int k = 0; k < nmax; k += 16) {
      if (k + j < ng) {
        const int4 en = lst[k + j];
        const float a = __int_as_float(en.w) * su[en.x];
        coef[(size_t)tok * 128 + en.z] = __int_as_float(en.y) * 0.5f * a * (1.f + erff(a * 0.7071067811865475f)) * sv[en.x];
      }
    }
    __builtin_amdgcn_wave_barrier();
    asm volatile("s_waitcnt lgkmcnt(0)" ::: "memory");
  }
}

struct VHdr { int ea, eb, ca, cb; };
DI VHdr vp_hdr(const int* idx, const float* coef, int tok, int g, int cq) {
  VHdr h;
  h.ea = idx[(size_t)tok * 128 + g * 32 + cq]; h.eb = idx[(size_t)tok * 128 + g * 32 + 16 + cq];
  h.ca = __float_as_int(coef[(size_t)tok * 128 + g * 32 + cq]); h.cb = __float_as_int(coef[(size_t)tok * 128 + g * 32 + 16 + cq]);
  return h;
}
DI void vp_rows(uint2 (&va)[16], uint2 (&vb)[16], const VHdr& h, const char* tb) {
#define VP_STEP(I) { va[I] = *(const uint2*)(tb + (unsigned)bcast16<I>(h.ea) * 128u); vb[I] = *(const uint2*)(tb + (unsigned)bcast16<I>(h.eb) * 128u); }
  VP_STEP(0) VP_STEP(1) VP_STEP(2) VP_STEP(3) VP_STEP(4) VP_STEP(5) VP_STEP(6) VP_STEP(7)
  VP_STEP(8) VP_STEP(9) VP_STEP(10) VP_STEP(11) VP_STEP(12) VP_STEP(13) VP_STEP(14) VP_STEP(15)
#undef VP_STEP
}
DI void vp_coefs(float (&fa)[16], float (&fb)[16], const VHdr& h) {
#define VP_STEP(I) { fa[I] = __int_as_float(bcast16<I>(h.ca)); fb[I] = __int_as_float(bcast16<I>(h.cb)); }
  VP_STEP(0) VP_STEP(1) VP_STEP(2) VP_STEP(3) VP_STEP(4) VP_STEP(5) VP_STEP(6) VP_STEP(7)
  VP_STEP(8) VP_STEP(9) VP_STEP(10) VP_STEP(11) VP_STEP(12) VP_STEP(13) VP_STEP(14) VP_STEP(15)
#undef VP_STEP
}
DI void vp_fma8(float (&a)[8], float cf, const uint2& v) {
  const f32x2_hw p0 = __builtin_amdgcn_cvt_pk_f32_fp8((int)v.x, false), p1 = __builtin_amdgcn_cvt_pk_f32_fp8((int)v.x, true);
  const f32x2_hw p2 = __builtin_amdgcn_cvt_pk_f32_fp8((int)v.y, false), p3 = __builtin_amdgcn_cvt_pk_f32_fp8((int)v.y, true);
  a[0] += cf * p0[0]; a[1] += cf * p0[1]; a[2] += cf * p1[0]; a[3] += cf * p1[1];
  a[4] += cf * p2[0]; a[5] += cf * p2[1]; a[6] += cf * p3[0]; a[7] += cf * p3[1];
}
DI void vp_consume(const uint2 (&va)[16], const uint2 (&vb)[16], const VHdr& h, float* f, int tok, int slice, int g, int cq, bool live) {
  float fa[16], fb[16];
  vp_coefs(fa, fb, h);
  float a[8];
#pragma unroll
  for (int i = 0; i < 8; ++i) a[i] = 0.f;
#pragma unroll
  for (int i = 0; i < 16; ++i) { vp_fma8(a, fa[i], va[i]); vp_fma8(a, fb[i], vb[i]); }
#pragma unroll
  for (int i = 0; i < 8; ++i) { a[i] += __shfl_xor(a[i], 16); a[i] += __shfl_xor(a[i], 32); }
  if (g == 0 && live) {
    f32x4 o0, o1; o0[0] = a[0]; o0[1] = a[1]; o0[2] = a[2]; o0[3] = a[3]; o1[0] = a[4]; o1[1] = a[5]; o1[2] = a[6]; o1[3] = a[7];
    float* fp = f + (size_t)tok * 1024 + slice * 128 + cq * 8;
    *(f32x4*)fp = o0; *(f32x4*)(fp + 4) = o1;
  }
}
DI void phase_vpass(const P& p) {
  const int* idx = (const int*)(p.ws + OFF_IDX);
  const float* coef = (const float*)(p.ws + OFF_COEF);
  const char* tabv = (const char*)(p.ws + OFF_TABV);
  float* f = (float*)(p.ws + OFF_F);
  const int tq = tid_opaque(); const int lane = tq & 63, wave = tq >> 6;
  const int g = lane >> 4, cq = lane & 15;
  const int slice = blockIdx.x & 7, bi = blockIdx.x >> 3, nb = (gridDim.x - slice + 7) >> 3;
  const int step = nb * 8;
  const char* tb = tabv + (size_t)slice * (16384 * 128) + cq * 8;
  int tok = bi * 8 + wave;
  if (tok >= T_) return;
  VHdr h0 = vp_hdr(idx, coef, tok, g, cq);
  VHdr h1 = vp_hdr(idx, coef, min(tok + step, T_ - 1), g, cq);
  uint2 va[16], vb[16], na[16], nb2[16];
  vp_rows(va, vb, h0, tb);
#pragma unroll 1
  for (; tok < T_; tok += 2 * step) {
    const VHdr h2 = vp_hdr(idx, coef, min(tok + 2 * step, T_ - 1), g, cq);
    vp_rows(na, nb2, h1, tb);
    vp_consume(va, vb, h0, f, tok, slice, g, cq, true);
    const VHdr h3 = vp_hdr(idx, coef, min(tok + 3 * step, T_ - 1), g, cq);
    vp_rows(va, vb, h2, tb);
    vp_consume(na, nb2, h1, f, tok + step, slice, g, cq, tok + step < T_);
    h0 = h2; h1 = h3;
  }
}

DI void phase_ln2(const P& p) {
  const float* ada = (const float*)(p.ws + OFF_ADA);
  const float* f = (const float*)(p.ws + OFF_F);
  const int tq = tid_opaque(); const int lane = tq & 63, wave = tq >> 6;
  for (int tok = blockIdx.x * 8 + wave; tok < T_; tok += gridDim.x * 8) {
    const int b = tok / S_;
    float* rp = p.out + (size_t)tok * 1024;
    f32x4 acc[4];
    float sm = 0.f;
#pragma unroll
    for (int i = 0; i < 4; ++i) {
      const int col = i * 256 + lane * 4;
      f32x4 x1 = *(const f32x4*)(rp + col), ff = *(const f32x4*)(f + (size_t)tok * 1024 + col);
      f32x4 g2 = *(const f32x4*)(ada + b * 6144 + 5 * 1024 + col);
#pragma unroll
      for (int j = 0; j < 4; ++j) { acc[i][j] = DN_ALPHA * x1[j] + (1.f + g2[j]) * ff[j]; sm += acc[i][j]; }
    }
    const float mu = wave_sum(sm) * (1.f / 1024.f);
    float q = 0.f;
#pragma unroll
    for (int i = 0; i < 4; ++i)
#pragma unroll
      for (int j = 0; j < 4; ++j) { float d = acc[i][j] - mu; q += d * d; }
    const float rs = rsqrtf(wave_sum(q) * (1.f / 1024.f) + LN_EPS);
#pragma unroll
    for (int i = 0; i < 4; ++i) {
      const int col = i * 256 + lane * 4;
      f32x4 gg = *(const f32x4*)(p.ln2_g + col), bb = *(const f32x4*)(p.ln2_b + col), o;
#pragma unroll
      for (int j = 0; j < 4; ++j) o[j] = (acc[i][j] - mu) * rs * gg[j] + bb[j];
      *(f32x4*)(rp + col) = o;
    }
  }
}

#define XB_TMO      128
#define XB_XCNT(j)  (256  + 64 * (j))
#define XB_XSUB(j)  (1280 + 64 * (j))
#define XB_XGEN(j)  (2304 + 64 * (j))
#define XB_TOP      3328
#define XB_TOPGEN   3392
#define XCD_BAR_WORDS 3456
#define XB_SPIN_CAP (1u << 22)
#define LAS __attribute__((address_space(3)))
DI unsigned xb_ld(unsigned* p)              { return __hip_atomic_load(p, __ATOMIC_RELAXED, __HIP_MEMORY_SCOPE_AGENT); }
DI unsigned xb_add(unsigned* p, unsigned v) { return __hip_atomic_fetch_add(p, v, __ATOMIC_RELAXED, __HIP_MEMORY_SCOPE_AGENT); }
DI unsigned xb_xcc_id() { return (unsigned)__builtin_amdgcn_s_getreg((3 << 11) | 20) & 0xFu; }
#define XB_SPIN(cond, bar) do { unsigned _sp = 0; while (cond) { __builtin_amdgcn_s_sleep(1); \
    if ((++_sp & 255u) == 0u) { if (xb_ld(&(bar)[XB_TMO])) break; if (_sp > XB_SPIN_CAP) { atomicAdd(&(bar)[XB_TMO], 1u); break; } } } } while (0)
struct XcdBarrier { unsigned* bar; unsigned x; volatile LAS unsigned* st; };
DI XcdBarrier xcd_barrier_post(unsigned* bar, volatile LAS unsigned* st) {
  XcdBarrier b; b.bar = bar; b.x = xb_xcc_id(); b.st = st;
  if (threadIdx.x == 0) (void)xb_add(&bar[XB_XCNT(b.x)], 1u);
  return b;
}
DI void xcd_barrier_complete(unsigned* bar, unsigned x, unsigned& nloc, unsigned& nx) {
  const unsigned G = gridDim.x * gridDim.y * gridDim.z;
  unsigned sum, cnt, mine, sp = 0u;
  for (;;) {
    sum = 0u; cnt = 0u; mine = 0u;
#pragma unroll
    for (unsigned j = 0; j < 16; ++j) { const unsigned c = xb_ld(&bar[XB_XCNT(j)]); sum += c; cnt += (c > 0u) ? 1u : 0u; mine = (j == x) ? c : mine; }
    if (sum == G) break;
    __builtin_amdgcn_s_sleep(1);
    if ((++sp & 255u) == 0u) { if (xb_ld(&bar[XB_TMO])) break; if (sp > XB_SPIN_CAP) { atomicAdd(&bar[XB_TMO], 1u); break; } }
  }
  nloc = mine > 0u ? mine : 1u; nx = cnt > 0u ? cnt : 1u;
}
DI void xcd_barrier(unsigned* barp, char* stp) {
  asm volatile("s_waitcnt vmcnt(0)" ::: "memory");
  __syncthreads();
  if (threadIdx.x == 0) {
    XcdBarrier b; b.bar = barp; b.x = xb_xcc_id(); b.st = (volatile LAS unsigned*)stp;
    unsigned* bar = b.bar;
    __builtin_amdgcn_s_waitcnt(0);
    unsigned nloc = b.st[0], nx = b.st[1];
    if (nloc == 0u) { xcd_barrier_complete(bar, b.x, nloc, nx); b.st[0] = nloc; b.st[1] = nx; }
    const unsigned old = xb_add(&bar[XB_XSUB(b.x)], 1u);
    const unsigned gen = old / nloc;
    if (old + 1u == (gen + 1u) * nloc) {
      __builtin_amdgcn_fence(__ATOMIC_RELEASE, "agent");
      asm volatile("s_waitcnt vmcnt(0)" ::: "memory");
      const unsigned og = xb_add(&bar[XB_TOP], 1u);
      const unsigned tg = og / nx;
      if (og + 1u == (tg + 1u) * nx) xb_add(&bar[XB_TOPGEN], 1u);
      else XB_SPIN(xb_ld(&bar[XB_TOPGEN]) == tg, bar);
      __builtin_amdgcn_fence(__ATOMIC_ACQUIRE, "agent");
      xb_add(&bar[XB_XGEN(b.x)], 1u);
      asm volatile("s_waitcnt vmcnt(0)" ::: "memory");
    } else {
      XB_SPIN(xb_ld(&bar[XB_XGEN(b.x)]) == gen, bar);
      __builtin_amdgcn_fence(__ATOMIC_ACQUIRE, "agent");
      asm volatile("s_waitcnt vmcnt(0)" ::: "memory");
    }
  }
  __syncthreads();
}

constexpr int SMEM_BYTES = 143360;
__global__ void __launch_bounds__(NT) fwd_megakernel(P p) {
  __shared__ __attribute__((aligned(16))) char smem[SMEM_BYTES + 16];
  if (threadIdx.x < 4) ((volatile LAS unsigned*)(smem + SMEM_BYTES))[threadIdx.x] = 0u;
  __syncthreads();
  (void)xcd_barrier_post((unsigned*)(p.ws + OFF_BAR), (volatile LAS unsigned*)(smem + SMEM_BYTES));
  phase_ada(p, smem);
  xcd_barrier((unsigned*)(p.ws + OFF_BAR), smem + SMEM_BYTES);
  phase_u1(p);
  phase_transposes(p, smem);
  xcd_barrier((unsigned*)(p.ws + OFF_BAR), smem + SMEM_BYTES);
  phase_transposes(p, smem);
  phase_keys(p);
  phase_rope(p);
  phase_filter(p, smem);
  xcd_barrier((unsigned*)(p.ws + OFF_BAR), smem + SMEM_BYTES);
  phase_inproj(p, smem);
  xcd_barrier((unsigned*)(p.ws + OFF_BAR), smem + SMEM_BYTES);
  for (int item = blockIdx.x; item < 512 + 256; item += gridDim.x) {
    if (item < 512) hyena_item(p, smem, item);
    else attn_item(p, smem, item - 512);
  }
  xcd_barrier((unsigned*)(p.ws + OFF_BAR), smem + SMEM_BYTES);
  phase_yh_transpose(p, smem);
  xcd_barrier((unsigned*)(p.ws + OFF_BAR), smem + SMEM_BYTES);
  phase_merge(p, smem);
  xcd_barrier((unsigned*)(p.ws + OFF_BAR), smem + SMEM_BYTES);
  phase_outproj(p, smem);
  xcd_barrier((unsigned*)(p.ws + OFF_BAR), smem + SMEM_BYTES);
  phase_ln1(p);
  phase_tabconv(p);
  xcd_barrier((unsigned*)(p.ws + OFF_BAR), smem + SMEM_BYTES);
  phase_route(p, smem);
  xcd_barrier((unsigned*)(p.ws + OFF_BAR), smem + SMEM_BYTES);
  phase_upass(p, smem);
  xcd_barrier((unsigned*)(p.ws + OFF_BAR), smem + SMEM_BYTES);
  phase_vpass(p);
  xcd_barrier((unsigned*)(p.ws + OFF_BAR), smem + SMEM_BYTES);
  phase_ln2(p);
}

extern "C" void kernel_launch(void* const* d_in, const int* in_sizes, int n_in, void* d_out, int out_size, void* d_ws, size_t ws_size,
                              hipStream_t stream) {
  P p{};
  p.x = (const float*)d_in[0]; p.c = (const float*)d_in[1]; p.pos = (const int*)d_in[2];
  p.w_ada = (const float*)d_in[3]; p.b_ada = (const float*)d_in[4]; p.w_in = (const float*)d_in[5];
  p.hy_conv_w = (const float*)d_in[6]; p.hy_conv_b = (const float*)d_in[7];
  p.f1_w = (const float*)d_in[8]; p.f1_b = (const float*)d_in[9]; p.f1_freq = (const float*)d_in[10];
  p.f2_w = (const float*)d_in[11]; p.f2_b = (const float*)d_in[12]; p.f2_freq = (const float*)d_in[13];
  p.f3_w = (const float*)d_in[14]; p.hy_bias = (const float*)d_in[15];
  p.w_bh = (const float*)d_in[16]; p.w_ba = (const float*)d_in[17]; p.w_out = (const float*)d_in[18];
  p.ln1_g = (const float*)d_in[19]; p.ln1_b = (const float*)d_in[20];
  p.wq = (const float*)d_in[21]; p.keys = (const float*)d_in[22]; p.pu = (const float*)d_in[23]; p.pv = (const float*)d_in[24];
  p.ln2_g = (const float*)d_in[25]; p.ln2_b = (const float*)d_in[26];
  p.out = (float*)d_out; p.ws = (char*)d_ws;

  static int grid_blocks = 0;
  if (!grid_blocks) {
    int dev = 0, cus = 0, per_cu = 0;
    hipGetDevice(&dev);
    hipDeviceGetAttribute(&cus, hipDeviceAttributeMultiprocessorCount, dev);
    hipOccupancyMaxActiveBlocksPerMultiprocessor(&per_cu, fwd_megakernel, NT, 0);
    if (per_cu > 1) per_cu = 1;
    grid_blocks = cus * per_cu;
  }
  (void)hipMemsetAsync((char*)d_ws + OFF_BAR, 0, XCD_BAR_WORDS * 4, stream);
  void* args[] = {&p};
  hipError_t e = hipLaunchCooperativeKernel((void*)fwd_megakernel, dim3(grid_blocks), dim3(NT), args, 0, stream);
  if (e != hipSuccess) fprintf(stderr, "cooperative launch failed: %s (grid %d)\n", hipGetErrorString(e), grid_blocks);
}
```

```cpp
#include <hip/hip_runtime.h>
#include <hip/hip_cooperative_groups.h>
#include <cstdio>
#include <cstdint>

#define DI __device__ __forceinline__
typedef unsigned short ushort_t;
typedef __attribute__((ext_vector_type(8))) short bf16x8;
typedef __attribute__((ext_vector_type(16))) float f32x16;
typedef __attribute__((ext_vector_type(4))) float f32x4;
typedef __attribute__((ext_vector_type(4))) unsigned u32x4;

constexpr int T_ = 16384, S_ = 8192, NB = 2, D_ = 1024;
constexpr int HW_ = 512, HYC = 1536, QKVC = 2304, GATEC = 2048, INW = 5888;
constexpr int NT = 512;
constexpr float DN_ALPHA = 1.189207115002721f;
constexpr float LN_EPS = 1e-5f;

constexpr size_t OFF_ADA   = 0;
constexpr size_t OFF_BAR   = 49152;
constexpr size_t OFF_KEYS_B= 65536;
constexpr size_t OFF_WIN_T = 65536 + 524288;
constexpr size_t OFF_WQ_T  = OFF_WIN_T + (size_t)INW * 1024 * 2;
constexpr size_t OFF_WOUT_T= OFF_WQ_T + (size_t)2048 * 1024 * 2;
constexpr size_t OFF_WBH_T = OFF_WOUT_T + (size_t)1024 * 1024 * 2;
constexpr size_t OFF_WBA_T = OFF_WBH_T + (size_t)1024 * 512 * 2;
constexpr size_t OFF_PH    = OFF_WBA_T + (size_t)1024 * 256 * 2;
constexpr size_t OFF_QKV   = OFF_PH + (size_t)T_ * HYC * 2;
constexpr size_t OFF_GATE  = OFF_QKV + (size_t)T_ * QKVC * 2;
constexpr size_t OFF_YH    = OFF_GATE + (size_t)T_ * GATEC * 2;
constexpr size_t OFF_YA    = OFF_YH + (size_t)T_ * HW_ * 2;
constexpr size_t OFF_END   = OFF_YA + (size_t)T_ * 256 * 2;
constexpr size_t OFF_MERGED= OFF_PH;
constexpr size_t OFF_YHK   = OFF_PH + (size_t)32 * 1048576;
constexpr size_t OFF_U1B   = OFF_YH;
static_assert(OFF_U1B + (size_t)T_ * 1024 * 2 <= 268435456ull, "u1b overflow");
constexpr size_t OFF_U2B   = OFF_PH;
constexpr size_t OFF_TABU  = OFF_QKV;
constexpr size_t OFF_TABV  = OFF_QKV + (size_t)16 * 1048576;
constexpr size_t OFF_SU    = OFF_QKV + (size_t)32 * 1048576;
constexpr size_t OFF_SV    = OFF_SU + 65536;
constexpr size_t OFF_COEF  = OFF_QKV + (size_t)64 * 1048576;
constexpr size_t OFF_F     = OFF_QKV + (size_t)72 * 1048576;
static_assert(OFF_F + (size_t)64 * 1048576 <= OFF_YH, "peer buffers overflow the qkv+gate region");
constexpr size_t OFF_IDX   = OFF_YH;
constexpr size_t OFF_GV    = OFF_YH + (size_t)T_ * 128 * 4;
constexpr size_t OFF_HSCR  = OFF_END;
static_assert(OFF_HSCR + (size_t)164 * 131072 <= 268435456ull, "ws overflow");
static_assert((size_t)92 * 131072 <= (size_t)INW * 1024 * 2, "w_in^T region too small");
constexpr size_t OFF_ROPE  = OFF_HSCR + (size_t)164 * 131072;
static_assert(OFF_ROPE + (size_t)T_ * 64 <= 268435456ull, "rope table overflow");

struct P {
  const float *x, *c; const int* pos;
  const float *w_ada, *b_ada, *w_in, *hy_conv_w, *hy_conv_b, *f1_w, *f1_b, *f1_freq, *f2_w, *f2_b, *f2_freq, *f3_w,
      *hy_bias, *w_bh, *w_ba, *w_out, *ln1_g, *ln1_b, *wq, *keys, *pu, *pv, *ln2_g, *ln2_b;
  float* out; char* ws;
};

DI ushort_t f2bf(float x) { unsigned u = __float_as_uint(x); u += 0x7fffu + ((u >> 16) & 1u); return (ushort_t)(u >> 16); }
DI float bf2f(ushort_t h) { return __uint_as_float(((unsigned)h) << 16); }
typedef __bf16 bf16x2_hw __attribute__((ext_vector_type(2)));
typedef float f32x2_hw __attribute__((ext_vector_type(2)));
DI unsigned pack2(float a, float b) { f32x2_hw v = {a, b}; return __builtin_bit_cast(unsigned, __builtin_convertvector(v, bf16x2_hw)); }
DI int tid_opaque() { int t = threadIdx.x; asm volatile("" : "+v"(t)); return t; }
DI float wave_sum(float v) {
#pragma unroll
  for (int o = 32; o > 0; o >>= 1) v += __shfl_xor(v, o);
  return v;
}

struct cf2 { float x, y; };
constexpr int FFT_N = 16384, FFT_SA = 560;

DI constexpr float wcos32(int j) {
  switch (j & 31) {
    case 0: return 1.0f; case 1: return 0.98078528040323043f; case 2: return 0.92387953251128674f; case 3: return 0.83146961230254524f;
    case 4: return 0.70710678118654752f; case 5: return 0.55557023301960218f; case 6: return 0.38268343236508978f; case 7: return 0.19509032201612825f;
    case 8: return 0.0f; case 9: return -0.19509032201612825f; case 10: return -0.38268343236508978f; case 11: return -0.55557023301960218f;
    case 12: return -0.70710678118654752f; case 13: return -0.83146961230254524f; case 14: return -0.92387953251128674f; case 15: return -0.98078528040323043f;
    case 16: return -1.0f; case 17: return -0.98078528040323043f; case 18: return -0.92387953251128674f; case 19: return -0.83146961230254524f;
    case 20: return -0.70710678118654752f; case 21: return -0.55557023301960218f; case 22: return -0.38268343236508978f; case 23: return -0.19509032201612825f;
    case 24: return 0.0f; case 25: return 0.19509032201612825f; case 26: return 0.38268343236508978f; case 27: return 0.55557023301960218f;
    case 28: return 0.70710678118654752f; case 29: return 0.83146961230254524f; case 30: return 0.92387953251128674f; default: return 0.98078528040323043f;
  }
}
DI constexpr float wsin32(int j) { return wcos32(j + 24); }
DI constexpr int brev(int v, int bits) { int r = 0; for (int i = 0; i < bits; ++i) r |= ((v >> i) & 1) << (bits - 1 - i); return r; }

template <int R, int LEN, bool INV, bool ZHI>
DI void r2_stage(float (&re)[R], float (&im)[R]) {
  constexpr int half = LEN / 2;
#pragma unroll
  for (int start = 0; start < R; start += LEN) {
#pragma unroll
    for (int j = 0; j < half; ++j) {
      const int a = start + j, b = a + half;
      const int tj = j * (32 / LEN);
      const float c = wcos32(tj), s = wsin32(tj);
      if (!INV) {
        float dr, di;
        if (ZHI) { dr = re[a]; di = im[a]; }
        else {
          const float ar = re[a], ai = im[a], br = re[b], bi = im[b];
          re[a] = ar + br; im[a] = ai + bi; dr = ar - br; di = ai - bi;
        }
        if (tj == 0) { re[b] = dr; im[b] = di; }
        else if (tj == 8) { re[b] = di; im[b] = -dr; }
        else { re[b] = dr * c + di * s; im[b] = di * c - dr * s; }
      } else {
        const float br = re[b], bi = im[b];
        float pr, pi;
        if (tj == 0) { pr = br; pi = bi; }
        else if (tj == 8) { pr = -bi; pi = br; }
        else { pr = br * c - bi * s; pi = bi * c + br * s; }
        const float ar = re[a], ai = im[a];
        re[a] = ar + pr; im[a] = ai + pi; re[b] = ar - pr; im[b] = ai - pi;
      }
    }
  }
}
template <int R, bool ZHI> DI void dft_fwd(float (&re)[R], float (&im)[R]) {
  if (R == 32) r2_stage<R, (R == 32 ? 32 : 2), false, ZHI>(re, im);
  r2_stage<R, 16, false, (R == 16) && ZHI>(re, im);
  r2_stage<R, 8, false, false>(re, im);
  r2_stage<R, 4, false, false>(re, im);
  r2_stage<R, 2, false, false>(re, im);
}
template <int R> DI void dft_inv(float (&re)[R], float (&im)[R]) {
  r2_stage<R, 2, true, false>(re, im);
  r2_stage<R, 4, true, false>(re, im);
  r2_stage<R, 8, true, false>(re, im);
  r2_stage<R, 16, true, false>(re, im);
  if (R == 32) r2_stage<R, (R == 32 ? 32 : 2), true, false>(re, im);
}

DI void sincos_turn(float frac, float& s, float& c) { sincospif(2.0f * frac, &s, &c); }

template <bool ZHI>
DI void fft_fwdA(float (&re)[32], float (&im)[32], cf2* lds, int m) {
  asm volatile("" : "+v"(m));
  float s1, c1; sincos_turn((float)m * (1.0f / 16384.0f), s1, c1);
  __builtin_amdgcn_sched_barrier(0);
  dft_fwd<32, ZHI>(re, im);
  __builtin_amdgcn_sched_barrier(0);
  float wr = 1.f, wi = 0.f;
#pragma unroll
  for (int k1 = 0; k1 < 32; ++k1) {
    if ((k1 & 3) == 0) __builtin_amdgcn_sched_barrier(0);
    const int r = brev(k1, 5);
    cf2 o; o.x = re[r] * wr - im[r] * wi; o.y = re[r] * wi + im[r] * wr;
    lds[k1 * FFT_SA + m] = o;
    const float nr = wr * c1 + wi * s1, ni = wi * c1 - wr * s1;
    wr = nr; wi = ni;
  }
}
DI void fft_B_read(float (&re)[32], float (&im)[32], const cf2* lds, int tid) {
  const int k1 = tid >> 4, mp = tid & 15;
#pragma unroll
  for (int n2 = 0; n2 < 32; ++n2) { cf2 v = lds[k1 * FFT_SA + n2 * 16 + mp]; re[n2] = v.x; im[n2] = v.y; }
}
DI void fft_fwdB_write(float (&re)[32], float (&im)[32], cf2* lds, int tid) {
  asm volatile("" : "+v"(tid));
  const int k1 = tid >> 4, mp = tid & 15;
  float s1, c1; sincos_turn((float)mp * (1.0f / 512.0f), s1, c1);
  __builtin_amdgcn_sched_barrier(0);
  dft_fwd<32, false>(re, im);
  __builtin_amdgcn_sched_barrier(0);
  float wr = 1.f, wi = 0.f;
#pragma unroll
  for (int k2 = 0; k2 < 32; ++k2) {
    if ((k2 & 3) == 0) __builtin_amdgcn_sched_barrier(0);
    const int r = brev(k2, 5);
    cf2 o; o.x = re[r] * wr - im[r] * wi; o.y = re[r] * wi + im[r] * wr;
    lds[k1 * FFT_SA + k2 * 17 + mp] = o;
    const float nr = wr * c1 + wi * s1, ni = wi * c1 - wr * s1;
    wr = nr; wi = ni;
  }
}
DI void fft_fwdC(float (&re)[32], float (&im)[32], const cf2* lds, int tid) {
  const int k1 = tid >> 5, k2 = tid & 31;
#pragma unroll
  for (int h = 0; h < 2; ++h) {
    float tr[16], ti[16];
#pragma unroll
    for (int mp = 0; mp < 16; ++mp) { cf2 v = lds[(k1 + 16 * h) * FFT_SA + k2 * 17 + mp]; tr[mp] = v.x; ti[mp] = v.y; }
    dft_fwd<16, false>(tr, ti);
#pragma unroll
    for (int i = 0; i < 16; ++i) { re[h * 16 + i] = tr[i]; im[h * 16 + i] = ti[i]; }
  }
}
DI void fft_invC(float (&re)[32], float (&im)[32], cf2* lds, int tid) {
  const int k1 = tid >> 5, k2 = tid & 31;
#pragma unroll
  for (int h = 0; h < 2; ++h) {
    float tr[16], ti[16];
#pragma unroll
    for (int i = 0; i < 16; ++i) { tr[i] = re[h * 16 + i]; ti[i] = im[h * 16 + i]; }
    dft_inv<16>(tr, ti);
#pragma unroll
    for (int mp = 0; mp < 16; ++mp) { cf2 o; o.x = tr[mp]; o.y = ti[mp]; lds[(k1 + 16 * h) * FFT_SA + k2 * 17 + mp] = o; }
  }
}
DI void fft_invB_read(float (&re)[32], float (&im)[32], const cf2* lds, int tid) {
  asm volatile("" : "+v"(tid));
  const int k1 = tid >> 4, mp = tid & 15;
  float s1, c1; sincos_turn((float)mp * (1.0f / 512.0f), s1, c1);
  float wr = 1.f, wi = 0.f;
  __builtin_amdgcn_sched_barrier(0);
#pragma unroll
  for (int k2 = 0; k2 < 32; ++k2) {
    if ((k2 & 3) == 0) __builtin_amdgcn_sched_barrier(0);
    const int r = brev(k2, 5);
    cf2 v = lds[k1 * FFT_SA + k2 * 17 + mp];
    re[r] = v.x * wr - v.y * wi; im[r] = v.x * wi + v.y * wr;
    const float nr = wr * c1 - wi * s1, ni = wi * c1 + wr * s1;
    wr = nr; wi = ni;
  }
}
DI void fft_invB_write(float (&re)[32], float (&im)[32], cf2* lds, int tid) {
  const int k1 = tid >> 4, mp = tid & 15;
  dft_inv<32>(re, im);
#pragma unroll
  for (int n2 = 0; n2 < 32; ++n2) { cf2 o; o.x = re[n2]; o.y = im[n2]; lds[k1 * FFT_SA + n2 * 16 + mp] = o; }
}
DI void fft_invA(float (&re)[32], float (&im)[32], const cf2* lds, int m) {
  asm volatile("" : "+v"(m));
  float s1, c1; sincos_turn((float)m * (1.0f / 16384.0f), s1, c1);
  float wr = 1.f, wi = 0.f;
  __builtin_amdgcn_sched_barrier(0);
#pragma unroll
  for (int k1 = 0; k1 < 32; ++k1) {
    if ((k1 & 3) == 0) __builtin_amdgcn_sched_barrier(0);
    const int r = brev(k1, 5);
    cf2 v = lds[k1 * FFT_SA + m];
    re[r] = v.x * wr - v.y * wi; im[r] = v.x * wi + v.y * wr;
    const float nr = wr * c1 - wi * s1, ni = wi * c1 + wr * s1;
    wr = nr; wi = ni;
  }
  __builtin_amdgcn_sched_barrier(0);
  dft_inv<32>(re, im);
}

DI void phase_ada(const P& p, char* smem) {
  float (*red)[16][32] = (float (*)[16][32])smem;
  const int tid = tid_opaque(), cl = tid & 31, kq = tid >> 5;
  for (int item = blockIdx.x; item < 192; item += gridDim.x) {
    const int col = item * 32 + cl;
    float a0 = 0.f, a1 = 0.f;
#pragma unroll 16
    for (int k = kq * 64; k < kq * 64 + 64; ++k) {
      const float w = p.w_ada[(size_t)k * 6144 + col];
      const float c0 = p.c[k], c1 = p.c[1024 + k];
      a0 += (c0 / (1.f + __expf(-c0))) * w;
      a1 += (c1 / (1.f + __expf(-c1))) * w;
    }
    __syncthreads();
    red[0][kq][cl] = a0; red[1][kq][cl] = a1;
    __syncthreads();
    if (tid < 64) {
      const int b = tid >> 5;
      float s = p.b_ada[col];
#pragma unroll
      for (int q = 0; q < 16; ++q) s += red[b][q][cl];
      ((float*)(p.ws + OFF_ADA))[b * 6144 + col] = s;
    }
  }
}
DI void phase_u1(const P& p) {
  const float* ada = (const float*)(p.ws + OFF_ADA);
  ushort_t* u1b = (ushort_t*)(p.ws + OFF_U1B);
  for (int i = blockIdx.x * NT + tid_opaque(); i < T_ * 128; i += gridDim.x * NT) {
    const int row = i >> 7, k = (i & 127) * 8, b = row / S_;
    const float* xp = p.x + (size_t)row * 1024 + k;
    const f32x4 x0 = *(const f32x4*)xp, x1 = *(const f32x4*)(xp + 4);
    const f32x4 s0 = *(const f32x4*)(ada + b * 6144 + 1024 + k), s1 = *(const f32x4*)(ada + b * 6144 + 1024 + k + 4);
    const f32x4 h0 = *(const f32x4*)(ada + b * 6144 + k), h1 = *(const f32x4*)(ada + b * 6144 + k + 4);
    u32x4 o;
    o[0] = pack2(x0[0] * (1.f + s0[0]) + h0[0], x0[1] * (1.f + s0[1]) + h0[1]);
    o[1] = pack2(x0[2] * (1.f + s0[2]) + h0[2], x0[3] * (1.f + s0[3]) + h0[3]);
    o[2] = pack2(x1[0] * (1.f + s1[0]) + h1[0], x1[1] * (1.f + s1[1]) + h1[1]);
    o[3] = pack2(x1[2] * (1.f + s1[2]) + h1[2], x1[3] * (1.f + s1[3]) + h1[3]);
    *(u32x4*)(u1b + (size_t)row * 1024 + k) = o;
  }
}

DI void transpose_tile(const float* __restrict__ W, ushort_t* __restrict__ Wt, int K, int N, int item, char* smem) {
  float (*tile)[65] = (float (*)[65])smem;
  const int ntn = N / 64;
  const int n0 = (item % ntn) * 64, k0 = (item / ntn) * 32;
  const int tid = tid_opaque();
  __syncthreads();
  {
    const int tx = tid & 63, ty = tid >> 6;
#pragma unroll
    for (int i = 0; i < 4; ++i) tile[ty + 8 * i][tx] = W[(size_t)(k0 + ty + 8 * i) * N + n0 + tx];
  }
  __syncthreads();
  {
    const int kk = tid & 31, nn0 = tid >> 5;
#pragma unroll
    for (int i = 0; i < 4; ++i) Wt[(size_t)(n0 + nn0 + 16 * i) * K + k0 + kk] = f2bf(tile[kk][nn0 + 16 * i]);
  }
}
DI void phase_transposes(const P& p, char* smem) {
  constexpr int I0 = (INW / 64) * 32, I1 = I0 + 32 * 32, I2 = I1 + 16 * 32, I3 = I2 + 16 * 16, I4 = I3 + 16 * 8;
  for (int item = blockIdx.x; item < I4; item += gridDim.x) {
    if (item < I0) transpose_tile(p.w_in, (ushort_t*)(p.ws + OFF_WIN_T), 1024, INW, item, smem);
    else if (item < I1) transpose_tile(p.wq, (ushort_t*)(p.ws + OFF_WQ_T), 1024, 2048, item - I0, smem);
    else if (item < I2) transpose_tile(p.w_out, (ushort_t*)(p.ws + OFF_WOUT_T), 1024, 1024, item - I1, smem);
    else if (item < I3) transpose_tile(p.w_bh, (ushort_t*)(p.ws + OFF_WBH_T), 512, 1024, item - I2, smem);
    else transpose_tile(p.w_ba, (ushort_t*)(p.ws + OFF_WBA_T), 256, 1024, item - I3, smem);
  }
}

DI void phase_filter(const P& p, char* smem) {
  float (*zf)[33] = (float (*)[33])smem;
  float (*h1)[64] = (float (*)[64])(smem + 4352);
  float (*h2)[65] = (float (*)[65])(smem + 4352 + 8192);
  float* w1s = (float*)(smem + 32768);
  float* w2s = (float*)(smem + 32768 + 8448);
  const int tid = tid_opaque(), lane = tid & 63, wave = tid >> 6;
  __syncthreads();
  for (int i = tid; i < 33 * 64; i += NT) w1s[i] = p.f1_w[i];
  for (int i = tid; i < 64 * 64; i += NT) w2s[i] = p.f2_w[i];
  for (int item = blockIdx.x; item < 256; item += gridDim.x) {
  const int t0 = item * 32;
  __syncthreads();
  for (int idx = tid; idx < 32 * 33; idx += NT) {
    int tt = idx / 33, e = idx % 33, t = t0 + tt;
    float tl = (float)t * (1.0f / 8191.0f);
    float w = 6.283185307179586f * (float)t / 8192.0f;
    float val;
    if (e == 0) val = tl;
    else {
      int i = (e - 1) & 15;
      float f = 1e-4f + (float)i * ((15.0f - 1e-4f) / 15.0f);
      val = (e <= 16) ? cosf(f * w) : -sinf(f * w);
    }
    zf[tt][e] = val;
  }
  __syncthreads();
  for (int idx = tid; idx < 32 * 64; idx += NT) {
    int tt = idx >> 6, j = idx & 63;
    float a = p.f1_b[j];
#pragma unroll
    for (int e = 0; e < 33; ++e) a += zf[tt][e] * w1s[e * 64 + j];
    h1[tt][j] = sinf(p.f1_freq[j] * a);
  }
  __syncthreads();
  for (int idx = tid; idx < 32 * 64; idx += NT) {
    int tt = idx >> 6, j = idx & 63;
    float a = p.f2_b[j];
#pragma unroll
    for (int e = 0; e < 64; ++e) a += h1[tt][e] * w2s[e * 64 + j];
    h2[tt][j] = sinf(p.f2_freq[j] * a);
  }
  __syncthreads();
  float* filt = p.out;
  const float min_decay = -3.0701134573253945f, max_decay = -15.350567286626973f;
  float af[32];
#pragma unroll
  for (int s = 0; s < 32; ++s) af[s] = h2[lane & 31][2 * s + (lane >> 5)];
#pragma unroll 1
  for (int ci = 0; ci < 8; ++ci) {
    const int col = (wave + 8 * ci) * 32 + (lane & 31);
    const float* wp = p.f3_w + (size_t)(lane >> 5) * 2048 + col;
    float bfv[32];
#pragma unroll
    for (int s = 0; s < 32; ++s) bfv[s] = wp[(size_t)s * 4096];
    f32x16 acc;
#pragma unroll
    for (int r = 0; r < 16; ++r) acc[r] = 0.f;
#pragma unroll
    for (int s = 0; s < 32; ++s) acc = __builtin_amdgcn_mfma_f32_32x32x2f32(af[s], bfv[s], acc, 0, 0, 0);
    const float delta = fabsf(min_decay + (float)(col & 511) * ((max_decay - min_decay) / 511.0f));
    float* dst = filt + (size_t)col * 8192 + t0 + 4 * (lane >> 5);
#pragma unroll
    for (int q = 0; q < 4; ++q) {
      f32x4 o;
#pragma unroll
      for (int r = 0; r < 4; ++r) {
        const float tl = (float)(t0 + 8 * q + 4 * (lane >> 5) + r) * (1.0f / 8191.0f);
        o[r] = acc[4 * q + r] * __expf(-tl * delta);
      }
      *(f32x4*)(dst + 8 * q) = o;
    }
  }
  }
}

constexpr int BM = 256, BN = 128, BK = 64;
constexpr int LDS_A = BM * BK * 2, LDS_B = BN * BK * 2, LDS_STAGE = LDS_A + LDS_B;
constexpr int GEMM_LDS = 2 * LDS_STAGE + 8192;

DI int swz(int row, int ch) { return row * 128 + ((ch ^ (row & 7)) << 4); }

struct ALoadBf16 {
  const ushort_t* A; int lda;
  struct Raw { u32x4 v; };
  DI Raw fetch(int row, int k) const { Raw r; r.v = *(const u32x4*)(A + (size_t)row * lda + k); return r; }
  DI u32x4 cvt(const Raw& r, int k) const { return r.v; }
};
struct ALoadF32Mod {
  const float* A; const float* mod;
  struct Raw { f32x4 a, b; };
  DI Raw fetch(int row, int k) const { Raw r; const float* s = A + (size_t)row * 1024 + k; r.a = *(const f32x4*)s; r.b = *(const f32x4*)(s + 4); return r; }
  DI u32x4 cvt(const Raw& r, int k) const {
    f32x4 s0 = *(const f32x4*)(mod + k), s1 = *(const f32x4*)(mod + k + 4);
    f32x4 h0 = *(const f32x4*)(mod + 1024 + k), h1 = *(const f32x4*)(mod + 1024 + k + 4);
    u32x4 o;
    o[0] = pack2(r.a[0] * s0[0] + h0[0], r.a[1] * s0[1] + h0[1]);
    o[1] = pack2(r.a[2] * s0[2] + h0[2], r.a[3] * s0[3] + h0[3]);
    o[2] = pack2(r.b[0] * s1[0] + h1[0], r.b[1] * s1[1] + h1[1]);
    o[3] = pack2(r.b[2] * s1[2] + h1[2], r.b[3] * s1[3] + h1[3]);
    return o;
  }
};

template <class AL, bool SWAP = false>
DI void gemm_mainloop(f32x16 (&acc)[2][2], const AL& al, int m0, const ushort_t* __restrict__ Bt, int ldb, int n0, int K, char* smem) {
  const int tid = tid_opaque(), lane = tid & 63, wave = tid >> 6;
  const int wm = wave >> 1, wn = wave & 1;
  const int lr = tid >> 3, lc = tid & 7;
  typename AL::Raw ra[4]; u32x4 rb[2];
  const int nk = K / BK;
#pragma unroll
  for (int i = 0; i < 4; ++i) ra[i] = al.fetch(m0 + lr + 64 * i, lc * 8);
#pragma unroll
  for (int i = 0; i < 2; ++i) rb[i] = *(const u32x4*)(Bt + (size_t)(n0 + lr + 64 * i) * ldb + lc * 8);
  __syncthreads();
#pragma unroll
  for (int i = 0; i < 4; ++i) *(u32x4*)(smem + swz(lr + 64 * i, lc)) = al.cvt(ra[i], lc * 8);
#pragma unroll
  for (int i = 0; i < 2; ++i) *(u32x4*)(smem + LDS_A + swz(lr + 64 * i, lc)) = rb[i];
  __syncthreads();
  for (int kt = 0; kt < nk; ++kt) {
    char* cur = smem + (kt & 1) * LDS_STAGE;
    char* nxt = smem + ((kt + 1) & 1) * LDS_STAGE;
    const bool more = (kt + 1 < nk);
    const int kn = (kt + 1) * BK + lc * 8;
    if (more) {
#pragma unroll
      for (int i = 0; i < 4; ++i) ra[i] = al.fetch(m0 + lr + 64 * i, kn);
#pragma unroll
      for (int i = 0; i < 2; ++i) rb[i] = *(const u32x4*)(Bt + (size_t)(n0 + lr + 64 * i) * ldb + kn);
    }
#pragma unroll
    for (int s = 0; s < 4; ++s) {
      const int ch = 2 * s + (lane >> 5);
      bf16x8 af[2], bfr[2];
#pragma unroll
      for (int mi = 0; mi < 2; ++mi) af[mi] = *(const bf16x8*)(cur + swz(wm * 64 + mi * 32 + (lane & 31), ch));
#pragma unroll
      for (int ni = 0; ni < 2; ++ni) bfr[ni] = *(const bf16x8*)(cur + LDS_A + swz(wn * 64 + ni * 32 + (lane & 31), ch));
#pragma unroll
      for (int mi = 0; mi < 2; ++mi)
#pragma unroll
        for (int ni = 0; ni < 2; ++ni)
          acc[mi][ni] = SWAP ? __builtin_amdgcn_mfma_f32_32x32x16_bf16(bfr[ni], af[mi], acc[mi][ni], 0, 0, 0)
                             : __builtin_amdgcn_mfma_f32_32x32x16_bf16(af[mi], bfr[ni], acc[mi][ni], 0, 0, 0);
    }
    if (more) {
#pragma unroll
      for (int i = 0; i < 4; ++i) *(u32x4*)(nxt + swz(lr + 64 * i, lc)) = al.cvt(ra[i], kn);
#pragma unroll
      for (int i = 0; i < 2; ++i) *(u32x4*)(nxt + LDS_A + swz(lr + 64 * i, lc)) = rb[i];
    }
    __syncthreads();
  }
}

constexpr int AT_ROW = 576;
constexpr int LDS_AT = 64 * AT_ROW;
constexpr int LDS_STAGE_T = LDS_AT + LDS_B;
typedef __attribute__((ext_vector_type(4))) short s16x4;
DI void gemm_mainloop_AT(f32x16 (&acc)[2][2], const ushort_t* __restrict__ At, size_t ldt, const ushort_t* __restrict__ Bt, int ldb, int n0, int K, char* smem) {
  const int tid = tid_opaque(), lane = tid & 63, wave = tid >> 6;
  const int wm = wave >> 1, wn = wave & 1;
  const int lr = tid >> 3, lc = tid & 7;
  u32x4 ra[4], rb[2];
  const int nk = K / BK;
#pragma unroll
  for (int i = 0; i < 4; ++i) { const int q = tid + 512 * i; ra[i] = *(const u32x4*)(At + (size_t)(q >> 5) * ldt + (q & 31) * 8); }
#pragma unroll
  for (int i = 0; i < 2; ++i) rb[i] = *(const u32x4*)(Bt + (size_t)(n0 + lr + 64 * i) * ldb + lc * 8);
  __syncthreads();
#pragma unroll
  for (int i = 0; i < 4; ++i) { const int q = tid + 512 * i; *(u32x4*)(smem + (q >> 5) * AT_ROW + (q & 31) * 16) = ra[i]; }
#pragma unroll
  for (int i = 0; i < 2; ++i) *(u32x4*)(smem + LDS_AT + swz(lr + 64 * i, lc)) = rb[i];
  __syncthreads();
  const int hh = lane >> 5, gg = (lane >> 4) & 1, qq = (lane & 15) >> 2, pp = lane & 3;
  for (int kt = 0; kt < nk; ++kt) {
    char* cur = smem + (kt & 1) * LDS_STAGE_T;
    char* nxt = smem + ((kt + 1) & 1) * LDS_STAGE_T;
    const bool more = (kt + 1 < nk);
    if (more) {
#pragma unroll
      for (int i = 0; i < 4; ++i) { const int q = tid + 512 * i; ra[i] = *(const u32x4*)(At + (size_t)((kt + 1) * BK + (q >> 5)) * ldt + (q & 31) * 8); }
#pragma unroll
      for (int i = 0; i < 2; ++i) rb[i] = *(const u32x4*)(Bt + (size_t)(n0 + lr + 64 * i) * ldb + (kt + 1) * BK + lc * 8);
    }
#pragma unroll
    for (int s = 0; s < 4; ++s) {
      const int ch = 2 * s + hh;
      bf16x8 af[2], bfr[2];
#pragma unroll
      for (int mi = 0; mi < 2; ++mi) {
        const char* a0 = cur + (16 * s + 8 * hh + qq) * AT_ROW + (wm * 64 + mi * 32 + 16 * gg + 4 * pp) * 2;
        s16x4 lo = __builtin_amdgcn_ds_read_tr16_b64_v4i16((__attribute__((address_space(3))) s16x4*)(a0));
        s16x4 hi = __builtin_amdgcn_ds_read_tr16_b64_v4i16((__attribute__((address_space(3))) s16x4*)(a0 + 4 * AT_ROW));
        af[mi] = __builtin_shufflevector(lo, hi, 0, 1, 2, 3, 4, 5, 6, 7);
      }
#pragma unroll
      for (int ni = 0; ni < 2; ++ni) bfr[ni] = *(const bf16x8*)(cur + LDS_AT + swz(wn * 64 + ni * 32 + (lane & 31), ch));
#pragma unroll
      for (int mi = 0; mi < 2; ++mi)
#pragma unroll
        for (int ni = 0; ni < 2; ++ni) acc[mi][ni] = __builtin_amdgcn_mfma_f32_32x32x16_bf16(af[mi], bfr[ni], acc[mi][ni], 0, 0, 0);
    }
    if (more) {
#pragma unroll
      for (int i = 0; i < 4; ++i) { const int q = tid + 512 * i; *(u32x4*)(nxt + (q >> 5) * AT_ROW + (q & 31) * 16) = ra[i]; }
#pragma unroll
      for (int i = 0; i < 2; ++i) *(u32x4*)(nxt + LDS_AT + swz(lr + 64 * i, lc)) = rb[i];
    }
    __syncthreads();
  }
}

constexpr int G2_A = 32768, G2_STAGE = 65536;
template <bool SWAP>
DI void gemm256(f32x16 (&acc)[4][2], const ushort_t* __restrict__ A, int lda, int m0, const ushort_t* __restrict__ Bt, int ldb, int n0, int K, char* smem) {
  const int tid = tid_opaque(), lane = tid & 63, wave = tid >> 6;
  const int wm = wave >> 2, wn = wave & 3;
  const int lr = tid >> 3, lc = tid & 7;
  u32x4 ra[4], rb[4];
  const int nk = K / BK;
  const ushort_t* ap = A + (size_t)(m0 + lr) * lda + lc * 8;
  const ushort_t* bp = Bt + (size_t)(n0 + lr) * ldb + lc * 8;
#pragma unroll
  for (int i = 0; i < 4; ++i) { ra[i] = *(const u32x4*)(ap + (size_t)(64 * i) * lda); rb[i] = *(const u32x4*)(bp + (size_t)(64 * i) * ldb); }
  __syncthreads();
#pragma unroll
  for (int i = 0; i < 4; ++i) { *(u32x4*)(smem + swz(lr + 64 * i, lc)) = ra[i]; *(u32x4*)(smem + G2_A + swz(lr + 64 * i, lc)) = rb[i]; }
  __syncthreads();
  for (int kt = 0; kt < nk; ++kt) {
    char* cur = smem + (kt & 1) * G2_STAGE;
    char* nxt = smem + ((kt + 1) & 1) * G2_STAGE;
    const bool more = (kt + 1 < nk);
    if (more) {
#pragma unroll
      for (int i = 0; i < 4; ++i) { ra[i] = *(const u32x4*)(ap + (size_t)(64 * i) * lda + (kt + 1) * BK); rb[i] = *(const u32x4*)(bp + (size_t)(64 * i) * ldb + (kt + 1) * BK); }
    }
#pragma unroll
    for (int s = 0; s < 4; ++s) {
      const int ch = 2 * s + (lane >> 5);
      bf16x8 af[4], bfr[2];
#pragma unroll
      for (int mi = 0; mi < 4; ++mi) af[mi] = *(const bf16x8*)(cur + swz(wm * 128 + mi * 32 + (lane & 31), ch));
#pragma unroll
      for (int ni = 0; ni < 2; ++ni) bfr[ni] = *(const bf16x8*)(cur + G2_A + swz(wn * 64 + ni * 32 + (lane & 31), ch));
#pragma unroll
      for (int mi = 0; mi < 4; ++mi)
#pragma unroll
        for (int ni = 0; ni < 2; ++ni)
          acc[mi][ni] = SWAP ? __builtin_amdgcn_mfma_f32_32x32x16_bf16(bfr[ni], af[mi], acc[mi][ni], 0, 0, 0)
                             : __builtin_amdgcn_mfma_f32_32x32x16_bf16(af[mi], bfr[ni], acc[mi][ni], 0, 0, 0);
      if (s & 1) __builtin_amdgcn_sched_barrier(0);
    }
    if (more) {
#pragma unroll
      for (int i = 0; i < 4; ++i) { *(u32x4*)(nxt + swz(lr + 64 * i, lc)) = ra[i]; *(u32x4*)(nxt + G2_A + swz(lr + 64 * i, lc)) = rb[i]; }
    }
    __syncthreads();
  }
}
constexpr int G2T_A = 64 * 576, G2T_STAGE = G2T_A + 32768;
DI void gemm256_AT(f32x16 (&acc)[4][2], const ushort_t* __restrict__ At, size_t ldt, const ushort_t* __restrict__ Bt, int ldb, int n0, int K, char* smem) {
  const int tid = tid_opaque(), lane = tid & 63, wave = tid >> 6;
  const int wm = wave >> 2, wn = wave & 3;
  const int lr = tid >> 3, lc = tid & 7;
  u32x4 ra[4], rb[4];
  const int nk = K / BK;
  const ushort_t* bp = Bt + (size_t)(n0 + lr) * ldb + lc * 8;
#pragma unroll
  for (int i = 0; i < 4; ++i) { const int q = tid + 512 * i; ra[i] = *(const u32x4*)(At + (size_t)(q >> 5) * ldt + (q & 31) * 8); rb[i] = *(const u32x4*)(bp + (size_t)(64 * i) * ldb); }
  __syncthreads();
#pragma unroll
  for (int i = 0; i < 4; ++i) { const int q = tid + 512 * i; *(u32x4*)(smem + (q >> 5) * 576 + (q & 31) * 16) = ra[i]; *(u32x4*)(smem + G2T_A + swz(lr + 64 * i, lc)) = rb[i]; }
  __syncthreads();
  const int hh = lane >> 5, gg = (lane >> 4) & 1, qq = (lane & 15) >> 2, pp = lane & 3;
  for (int kt = 0; kt < nk; ++kt) {
    char* cur = smem + (kt & 1) * G2T_STAGE;
    char* nxt = smem + ((kt + 1) & 1) * G2T_STAGE;
    const bool more = (kt + 1 < nk);
    if (more) {
#pragma unroll
      for (int i = 0; i < 4; ++i) { const int q = tid + 512 * i; ra[i] = *(const u32x4*)(At + (size_t)((kt + 1) * BK + (q >> 5)) * ldt + (q & 31) * 8); rb[i] = *(const u32x4*)(bp + (size_t)(64 * i) * ldb + (kt + 1) * BK); }
    }
#pragma unroll
    for (int s = 0; s < 4; ++s) {
      const int ch = 2 * s + hh;
      bf16x8 af[4], bfr[2];
#pragma unroll
      for (int mi = 0; mi < 4; ++mi) {
        const char* a0 = cur + (16 * s + 8 * hh + qq) * 576 + (wm * 128 + mi * 32 + 16 * gg + 4 * pp) * 2;
        s16x4 lo = __builtin_amdgcn_ds_read_tr16_b64_v4i16((__attribute__((address_space(3))) s16x4*)(a0));
        s16x4 hi = __builtin_amdgcn_ds_read_tr16_b64_v4i16((__attribute__((address_space(3))) s16x4*)(a0 + 4 * 576));
        af[mi] = __builtin_shufflevector(lo, hi, 0, 1, 2, 3, 4, 5, 6, 7);
      }
#pragma unroll
      for (int ni = 0; ni < 2; ++ni) bfr[ni] = *(const bf16x8*)(cur + G2T_A + swz(wn * 64 + ni * 32 + (lane & 31), ch));
#pragma unroll
      for (int mi = 0; mi < 4; ++mi)
#pragma unroll
        for (int ni = 0; ni < 2; ++ni) acc[mi][ni] = __builtin_amdgcn_mfma_f32_32x32x16_bf16(af[mi], bfr[ni], acc[mi][ni], 0, 0, 0);
      if (s & 1) __builtin_amdgcn_sched_barrier(0);
    }
    if (more) {
#pragma unroll
      for (int i = 0; i < 4; ++i) { const int q = tid + 512 * i; *(u32x4*)(nxt + (q >> 5) * 576 + (q & 31) * 16) = ra[i]; *(u32x4*)(nxt + G2T_A + swz(lr + 64 * i, lc)) = rb[i]; }
    }
    __syncthreads();
  }
}
DI void acc_zero4(f32x16 (&acc)[4][2]) {
#pragma unroll
  for (int a = 0; a < 4; ++a)
#pragma unroll
    for (int b = 0; b < 2; ++b)
#pragma unroll
      for (int r = 0; r < 16; ++r) acc[a][b][r] = 0.f;
}
DI void acc_zero(f32x16 (&acc)[2][2]) {
#pragma unroll
  for (int a = 0; a < 2; ++a)
#pragma unroll
    for (int b = 0; b < 2; ++b)
#pragma unroll
      for (int r = 0; r < 16; ++r) acc[a][b][r] = 0.f;
}
#define ACC_ROW(mi, r) (wm * 64 + (mi) * 32 + ((r) & 3) + 8 * ((r) >> 2) + 4 * (lane >> 5))
#define ACC_COL(ni) (wn * 64 + (ni) * 32 + (lane & 31))

DI void stage_mod(float* mod, const float* ada, int b, int sc_chunk, int sh_chunk) {
  for (int i = tid_opaque(); i < 1024; i += NT) {
    mod[i] = 1.f + ada[b * 6144 + sc_chunk * 1024 + i];
    mod[1024 + i] = ada[b * 6144 + sh_chunk * 1024 + i];
  }
}


namespace pg8 {
#define PG8_LAS __attribute__((address_space(3)))
constexpr int BM8 = 256, BK8 = 64, HALF = 128, HTB = HALF * BK8 * 2, STAGE_BYTES = 8 * HTB, NXCD = 8, WGM = 8;
DI int lds_byte(int r, int c) { const int st = (r >> 4) * 2 + (c >> 5), rr = r & 15, cc = c & 31, ob = rr * 64 + cc * 2; return st * 1024 + (ob ^ (((ob >> 9) & 1) << 5)); }
DI void stage_rc(int b, int& R, int& C) { const int st = b / 1024, sb = b % 1024, sw = sb ^ (((sb >> 9) & 1) << 5); R = (st >> 1) * 16 + sw / 64; C = (st & 1) * 32 + (sw % 64) / 2; }
DI int perm32(int rho) { const int n = rho >> 4, i = rho & 15; return 8 * (i >> 2) + 4 * n + (i & 3); }
struct Unit { int pm, pn, kind; };
DI void tile_order(int L, int nM, int nN, int& pm, int& pn) {
  const int nwg = nM * nN;
  int wgid = L; { const int q = nwg / NXCD, r = nwg % NXCD, xcd = wgid % NXCD, off = wgid / NXCD; wgid = (xcd < r ? xcd * (q + 1) : r * (q + 1) + (xcd - r) * q) + off; }
  const int nig = WGM * nN, gid = wgid / nig, fm = gid * WGM, gsz = (nM - fm) < WGM ? (nM - fm) : WGM;
  pm = fm + ((wgid % nig) % gsz); pn = (wgid % nig) / gsz;
}
typedef float f32x4p __attribute__((ext_vector_type(4)));
template <class Epi, class Sched>
DI void gemm_phase(PG8_LAS unsigned char* lds, const int K_, const Sched& S, const Epi& E) {
    int K = K_; asm volatile("" : "+s"(K));
    const int tid = tid_opaque();
    const int wid = __builtin_amdgcn_readfirstlane(tid >> 6), lane = tid & 63, wr = wid >> 2, wc = wid & 3, fr = lane & 15, fq = lane >> 4;
    const int nt = K / BK8;
    unsigned voffA[2], voffB[2];
#pragma unroll
    for (int i = 0; i < 2; ++i) { int R, C; stage_rc(tid * 16 + i * 8192, R, C); const int Rb = Epi::PERM ? ((R & ~31) + perm32(R & 31)) : R;
        voffA[i] = (unsigned)(R * K + C) * 2u; voffB[i] = (unsigned)(Rb * K + C) * 2u; }
    const size_t kstep = (size_t)(BK8 * 2);
    const size_t hstep = (size_t)HALF * K * 2;
    const unsigned ldsw = (unsigned)wid * 1024u;
    const int aoff = lds_byte(wr * 64 + fr, fq * 8), boff = lds_byte(wc * 32 + fr, fq * 8);
#define PG8_SA(b, h) (((b) * 2 + (h)) * HTB)
#define PG8_SB(b, h) ((4 + (b) * 2 + (h)) * HTB)
#define PG8_STAGE(bufoff, gbase, voff) do { _Pragma("unroll") for (int _i = 0; _i < 2; ++_i) \
        __builtin_amdgcn_global_load_lds((const unsigned*)((const char*)(gbase) + (voff)[_i]), (PG8_LAS unsigned*)(lds + (bufoff) + ldsw + _i * 8192), 16, 0, 0); } while (0)
#define PG8_LDA(dst, b, h) do { _Pragma("unroll") for (int m = 0; m < 4; ++m) _Pragma("unroll") for (int k = 0; k < 2; ++k) dst[m][k] = *(const PG8_LAS bf16x8*)(lds + PG8_SA(b, h) + aoff + m * 2048 + k * 1024); } while (0)
#define PG8_LDB(dst, b, h) do { _Pragma("unroll") for (int n = 0; n < 2; ++n) _Pragma("unroll") for (int k = 0; k < 2; ++k) dst[n][k] = *(const PG8_LAS bf16x8*)(lds + PG8_SB(b, h) + boff + n * 2048 + k * 1024); } while (0)
#define PG8_MMA(ai, bj, At, Bt) do { __builtin_amdgcn_s_setprio(1); _Pragma("unroll") for (int m = 0; m < 4; ++m) _Pragma("unroll") for (int n = 0; n < 2; ++n) _Pragma("unroll") for (int k = 0; k < 2; ++k) \
        acc[ai][bj][m][n] = __builtin_amdgcn_mfma_f32_16x16x32_bf16(Bt[n][k], At[m][k], acc[ai][bj][m][n], 0, 0, 0); __builtin_amdgcn_s_setprio(0); } while (0)
#define PG8_WAIT_V(n) asm volatile("s_waitcnt vmcnt(" #n ")" ::: "memory")
#define PG8_WAIT_L(n) asm volatile("s_waitcnt lgkmcnt(" #n ")" ::: "memory")
#define PG8_BAR __builtin_amdgcn_s_barrier()
#define PG8_SCHED __builtin_amdgcn_sched_barrier(0)
    Unit cur, nxt; int ui = 0;
    if (!S.next(0, cur)) return;
    f32x4p acc[2][2][4][2];
#pragma unroll
    for (int a = 0; a < 2; ++a)
#pragma unroll
        for (int b = 0; b < 2; ++b)
#pragma unroll
            for (int m = 0; m < 4; ++m)
#pragma unroll
                for (int n = 0; n < 2; ++n) acc[a][b][m][n] = (f32x4p){0.f, 0.f, 0.f, 0.f};
    bf16x8 At[4][2], B0[2][2], B1[2][2];
    const char* cA = S.a_ptr(cur); const char* cB = S.b_ptr(cur);
    PG8_STAGE(PG8_SB(0, 0), cB, voffB); PG8_STAGE(PG8_SA(0, 0), cA, voffA); PG8_STAGE(PG8_SB(0, 1), cB + hstep, voffB); PG8_STAGE(PG8_SA(0, 1), cA + hstep, voffA);
    if (wr == 1) PG8_BAR;
    PG8_WAIT_V(4); PG8_BAR;
    PG8_STAGE(PG8_SB(1, 0), cB + kstep, voffB); PG8_STAGE(PG8_SA(1, 0), cA + kstep, voffA); PG8_STAGE(PG8_SB(1, 1), cB + hstep + kstep, voffB);
    PG8_WAIT_V(6); PG8_BAR;
    for (;;) {
        const bool has_next = S.next(ui + 1, nxt);
        const char* nA = has_next ? S.a_ptr(nxt) : cA; const char* nB = has_next ? S.b_ptr(nxt) : cB;
        for (int t = 0; t < nt; t += 2) {
            const bool last = (t == nt - 2);
            const char* a1 = cA + (size_t)(t + 1) * kstep;
            const char* a2 = last ? nA : cA + (size_t)(t + 2) * kstep; const char* b2 = last ? nB : cB + (size_t)(t + 2) * kstep;
            const char* a3 = a2 + kstep; const char* b3 = b2 + kstep;
            PG8_LDB(B0, 0, 0); PG8_SCHED; PG8_LDA(At, 0, 0); PG8_STAGE(PG8_SA(1, 1), a1 + hstep, voffA);
            PG8_WAIT_L(8); PG8_BAR; PG8_WAIT_L(0); PG8_MMA(0, 0, At, B0); PG8_BAR; PG8_SCHED;
            PG8_LDB(B1, 0, 1); PG8_STAGE(PG8_SB(0, 0), b2, voffB);
            PG8_BAR; PG8_WAIT_L(0); PG8_MMA(0, 1, At, B1); PG8_BAR;
            PG8_LDA(At, 0, 1); PG8_STAGE(PG8_SA(0, 0), a2, voffA);
            PG8_BAR; PG8_WAIT_L(0); PG8_MMA(1, 0, At, B0); PG8_BAR; PG8_SCHED;
            PG8_STAGE(PG8_SB(0, 1), b2 + hstep, voffB);
            PG8_WAIT_V(6); PG8_BAR; PG8_MMA(1, 1, At, B1); PG8_BAR;
            PG8_LDB(B0, 1, 0); PG8_SCHED; PG8_LDA(At, 1, 0); PG8_STAGE(PG8_SA(0, 1), a2 + hstep, voffA);
            PG8_WAIT_L(8); PG8_BAR; PG8_WAIT_L(0); PG8_MMA(0, 0, At, B0); PG8_BAR; PG8_SCHED;
            PG8_LDB(B1, 1, 1); PG8_STAGE(PG8_SB(1, 0), b3, voffB);
            PG8_BAR; PG8_WAIT_L(0); PG8_MMA(0, 1, At, B1); PG8_BAR;
            PG8_LDA(At, 1, 1); PG8_STAGE(PG8_SA(1, 0), a3, voffA);
            PG8_BAR; PG8_WAIT_L(0); PG8_MMA(1, 0, At, B0); PG8_BAR; PG8_SCHED;
            PG8_STAGE(PG8_SB(1, 1), b3 + hstep, voffB);
            PG8_WAIT_V(6); PG8_BAR; PG8_MMA(1, 1, At, B1); PG8_BAR;
        }
        if constexpr (!Epi::AFTER_DRAIN) E(acc, cur, wr, wc, fr, fq);
        if (!has_next) break;
#pragma unroll
        for (int a = 0; a < 2; ++a)
#pragma unroll
            for (int b = 0; b < 2; ++b)
#pragma unroll
                for (int m = 0; m < 4; ++m)
#pragma unroll
                    for (int n = 0; n < 2; ++n) acc[a][b][m][n] = (f32x4p){0.f, 0.f, 0.f, 0.f};
        cur = nxt; cA = nA; cB = nB; ++ui;
    }
    PG8_WAIT_V(0);
    if (wr == 0) PG8_BAR;
    PG8_BAR;
    if constexpr (Epi::AFTER_DRAIN) E.fused(acc, cur, wr, wc, fr, fq, lds, wid, lane);
#undef PG8_SA
#undef PG8_SB
#undef PG8_STAGE
#undef PG8_LDA
#undef PG8_LDB
#undef PG8_MMA
#undef PG8_WAIT_V
#undef PG8_WAIT_L
#undef PG8_BAR
#undef PG8_SCHED
}
}
typedef pg8::f32x4p f32x4p;
DI u32x4 pack8(const f32x4p& a, const f32x4p& b) { u32x4 w; w[0] = pack2(a[0], a[1]); w[1] = pack2(a[2], a[3]); w[2] = pack2(b[0], b[1]); w[3] = pack2(b[2], b[3]); return w; }

struct InprojSched {
  const char* u1b; const char* wt; int G, c;
  DI bool next(int i, pg8::Unit& u) const {
    const int L = i * G + c;
    if (L >= 384 + 1088) return false;
    if (L < 384) { u.kind = 0; pg8::tile_order(L, 6, 64, u.pm, u.pn); } else { u.kind = 1; pg8::tile_order(L - 384, 64, 17, u.pm, u.pn); }
    return true;
  }
  DI const char* a_ptr(const pg8::Unit& u) const { return u.kind == 0 ? wt + (size_t)u.pm * (256 * 1024 * 2) : u1b + (size_t)u.pm * (256 * 1024 * 2); }
  DI const char* b_ptr(const pg8::Unit& u) const { return u.kind == 0 ? u1b + (size_t)u.pn * (256 * 1024 * 2) : wt + (size_t)(1536 + u.pn * 256) * (1024 * 2); }
};
struct InprojEpi {
  static constexpr bool PERM = true, AFTER_DRAIN = false;
  ushort_t* ph; ushort_t* qkv; ushort_t* gate; const float* rope;
  DI void operator()(const f32x4p (&acc)[2][2][4][2], const pg8::Unit& u, int wr, int wc, int fr, int fq) const {
    if (u.kind == 0) {
      const int b = (u.pn * 256) >> 13;
      ushort_t* base = ph + ((size_t)(b * HYC + u.pm * 256 + wr * 64 + fr)) * S_ + ((u.pn * 256) & (S_ - 1)) + wc * 32 + 8 * fq;
#pragma unroll
      for (int ai = 0; ai < 2; ++ai)
#pragma unroll
        for (int m = 0; m < 4; ++m)
#pragma unroll
          for (int bj = 0; bj < 2; ++bj) *(u32x4*)(base + (size_t)(ai * 128 + m * 16) * S_ + bj * 128) = pack8(acc[ai][bj][m][0], acc[ai][bj][m][1]);
      return;
    }
    const int row0 = u.pm * 256 + wr * 64 + fr;
    if (u.pn < 9) {
      const int cq0 = u.pn * 256 + wc * 32 + 8 * fq;
      const bool rotw = (u.pn < 6) && ((wc & 1) == 0);
      const float qs = (u.pn < 3) ? 0.125f : 1.0f;
#pragma unroll
      for (int ai = 0; ai < 2; ++ai)
#pragma unroll
        for (int m = 0; m < 4; ++m) {
          const int row = row0 + ai * 128 + m * 16;
          f32x4p cs[4];
          if (rotw) {
#pragma unroll
            for (int q = 0; q < 4; ++q) cs[q] = *(const f32x4p*)(rope + (size_t)row * 16 + q * 4);
          }
#pragma unroll
          for (int bj = 0; bj < 2; ++bj) {
            f32x4p v0 = acc[ai][bj][m][0], v1 = acc[ai][bj][m][1];
            if (rotw) {
              f32x4p o0, o1;
#pragma unroll
              for (int j = 0; j < 4; ++j) { o0[j] = __shfl_xor(v0[j], 16); o1[j] = __shfl_xor(v1[j], 16); }
              if (fq < 2) {
                const float sg = (fq == 0) ? -1.f : 1.f;
#pragma unroll
                for (int j = 0; j < 4; ++j) {
                  const float c0 = cs[j >> 1][(j & 1) * 2], s0 = cs[j >> 1][(j & 1) * 2 + 1];
                  const float c1 = cs[2 + (j >> 1)][(j & 1) * 2], s1 = cs[2 + (j >> 1)][(j & 1) * 2 + 1];
                  v0[j] = v0[j] * c0 + sg * o0[j] * s0;
                  v1[j] = v1[j] * c1 + sg * o1[j] * s1;
                }
              }
            }
            *(u32x4*)(qkv + (size_t)row * QKVC + cq0 + bj * 128) = pack8(v0 * qs, v1 * qs);
          }
        }
    } else {
      const int cg0 = (u.pn - 9) * 256 + wc * 32 + 8 * fq;
#pragma unroll
      for (int ai = 0; ai < 2; ++ai)
#pragma unroll
        for (int m = 0; m < 4; ++m)
#pragma unroll
          for (int bj = 0; bj < 2; ++bj) {
            f32x4p v0 = acc[ai][bj][m][0], v1 = acc[ai][bj][m][1];
#pragma unroll
            for (int j = 0; j < 4; ++j) { v0[j] = 1.f / (1.f + __expf(-v0[j])); v1[j] = 1.f / (1.f + __expf(-v1[j])); }
            *(u32x4*)(gate + (size_t)(row0 + ai * 128 + m * 16) * GATEC + cg0 + bj * 128) = pack8(v0, v1);
          }
    }
  }
};
DI void phase_inproj(const P& p, char* smem) {
  InprojSched S{p.ws + OFF_U1B, p.ws + OFF_WIN_T, (int)gridDim.x, (int)blockIdx.x};
  InprojEpi E{(ushort_t*)(p.ws + OFF_PH), (ushort_t*)(p.ws + OFF_QKV), (ushort_t*)(p.ws + OFF_GATE), (const float*)(p.ws + OFF_ROPE)};
  pg8::gemm_phase(( __attribute__((address_space(3))) unsigned char*)smem, 1024, S, E);
}
struct PlainSched {
  const char* A; const char* Bt; int nM, nN, K, G, c;
  DI bool next(int i, pg8::Unit& u) const { const int L = i * G + c; if (L >= nM * nN) return false; u.kind = 0; pg8::tile_order(L, nM, nN, u.pm, u.pn); return true; }
  DI const char* a_ptr(const pg8::Unit& u) const { return A + (size_t)u.pm * 256 * K * 2; }
  DI const char* b_ptr(const pg8::Unit& u) const { return Bt + (size_t)u.pn * 256 * K * 2; }
};
struct OutprojEpi {
  static constexpr bool PERM = false, AFTER_DRAIN = false;
  const float* x; float* out; const float* ada;
  DI void operator()(const f32x4p (&acc)[2][2][4][2], const pg8::Unit& u, int wr, int wc, int fr, int fq) const {
    const int row0 = u.pm * 256 + wr * 64 + fr, col0 = u.pn * 256 + wc * 32 + 4 * fq, b = (u.pm * 256) / S_;
    f32x4p g1[2][2];
#pragma unroll
    for (int bj = 0; bj < 2; ++bj)
#pragma unroll
      for (int n = 0; n < 2; ++n) g1[bj][n] = *(const f32x4p*)(ada + b * 6144 + 2 * 1024 + col0 + bj * 128 + n * 16) + 1.0f;
#pragma unroll
    for (int ai = 0; ai < 2; ++ai)
#pragma unroll
      for (int m = 0; m < 4; ++m) {
        const size_t ro = (size_t)(row0 + ai * 128 + m * 16) * 1024 + col0;
#pragma unroll
        for (int bj = 0; bj < 2; ++bj)
#pragma unroll
          for (int n = 0; n < 2; ++n) {
            const f32x4p xv = *(const f32x4p*)(x + ro + bj * 128 + n * 16);
            *(f32x4p*)(out + ro + bj * 128 + n * 16) = xv * DN_ALPHA + g1[bj][n] * acc[ai][bj][m][n];
          }
      }
  }
};
DI void phase_outproj(const P& p, char* smem) {
  PlainSched S{p.ws + OFF_MERGED, p.ws + OFF_WOUT_T, 64, 4, 1024, (int)gridDim.x, (int)blockIdx.x};
  OutprojEpi E{p.x, p.out, (const float*)(p.ws + OFF_ADA)};
  pg8::gemm_phase(( __attribute__((address_space(3))) unsigned char*)smem, 1024, S, E);
}

DI float sconv_t(const ushort_t* row, int t, float w0, float w1, float w2, float cb) {
  float v = cb + w1 * bf2f(row[t]);
  if (t > 0) v += w0 * bf2f(row[t - 1]);
  if (t < S_ - 1) v += w2 * bf2f(row[t + 1]);
  return v;
}
DI void fft_C_mul_invC(cf2* lds, const cf2* __restrict__ kq, int tid) {
  asm volatile("" : "+v"(tid));
  const int k1 = tid >> 5, k2 = tid & 31;
  kq += tid;
#pragma unroll
  for (int h = 0; h < 2; ++h) {
    float tr[16], ti[16];
    cf2 kv[16];
#pragma unroll
    for (int i = 0; i < 16; ++i) kv[i] = kq[(h * 16 + i) * 512];
    cf2* blk = lds + (k1 + 16 * h) * FFT_SA + k2 * 17;
#pragma unroll
    for (int mp = 0; mp < 16; ++mp) { cf2 v = blk[mp]; tr[mp] = v.x; ti[mp] = v.y; }
    dft_fwd<16, false>(tr, ti);
#pragma unroll
    for (int i = 0; i < 16; ++i) { const float a = tr[i], b = ti[i]; tr[i] = a * kv[i].x - b * kv[i].y; ti[i] = a * kv[i].y + b * kv[i].x; }
    dft_inv<16>(tr, ti);
#pragma unroll
    for (int mp = 0; mp < 16; ++mp) { cf2 o; o.x = tr[mp]; o.y = ti[mp]; blk[mp] = o; }
  }
}
DI void hyena_item(const P& p, char* smem, int c) {
  cf2* lds = (cf2*)smem;
  const ushort_t* pht = (const ushort_t*)(p.ws + OFF_PH);
  ushort_t* yht = (ushort_t*)(p.ws + OFF_YH);
  cf2* kq = (cf2*)(p.ws + (blockIdx.x < 92 ? OFF_WIN_T + (size_t)blockIdx.x * 131072 : OFF_HSCR + (size_t)(blockIdx.x - 92) * 131072));
  const float* filt = p.out;
  const int tid0 = tid_opaque();
  float zr[32], zi[32];
  __syncthreads();
#pragma unroll 1
  for (int o = 0; o < 2; ++o) {
    int tid = tid0; asm volatile("" : "+v"(tid));
    {
      float kr[32], ki[32];
      const float* fw = filt + (size_t)(0 * 1024 + o * 512 + c) * S_;
      const float* bw = filt + (size_t)(1 * 1024 + o * 512 + c) * S_;
      const float bias = p.hy_bias[o * 512 + c];
#pragma unroll
      for (int n1 = 0; n1 < 16; ++n1) { kr[n1] = fw[n1 * 512 + tid] * (1.0f / 16384.0f); ki[n1] = 0.f; }
      if (tid == 0) kr[0] += bias * (1.0f / 16384.0f);
#pragma unroll
      for (int n1 = 16; n1 < 32; ++n1) {
        const int n = n1 * 512 + tid;
        kr[n1] = (n == S_) ? 0.f : bw[2 * S_ - n] * (1.0f / 16384.0f); ki[n1] = 0.f;
      }
      fft_fwdA<false>(kr, ki, lds, tid); __syncthreads();
      fft_B_read(kr, ki, lds, tid); __syncthreads();
      fft_fwdB_write(kr, ki, lds, tid); __syncthreads();
      fft_fwdC(kr, ki, lds, tid);
      int ts = tid; asm volatile("" : "+v"(ts));
      cf2* kqt = kq + ts;
#pragma unroll
      for (int r = 0; r < 32; ++r) { cf2 v; v.x = kr[r]; v.y = ki[r]; kqt[r * 512] = v; }
      __syncthreads();
    }
    asm volatile("" : "+v"(tid));
    if (o == 0) {
      const float w0 = p.hy_conv_w[c], w1 = p.hy_conv_w[HYC + c], w2 = p.hy_conv_w[2 * HYC + c], cb = p.hy_conv_b[c];
      const ushort_t* r0 = pht + (size_t)(0 * HYC + c) * S_;
      const ushort_t* r1 = pht + (size_t)(1 * HYC + c) * S_;
#pragma unroll
      for (int n1 = 0; n1 < 16; ++n1) {
        const int t = n1 * 512 + tid;
        zr[n1] = sconv_t(r0, t, w0, w1, w2, cb); zi[n1] = sconv_t(r1, t, w0, w1, w2, cb);
        if (n1 & 1) asm volatile("" ::: "memory");
      }
    }
#pragma unroll
    for (int n1 = 16; n1 < 32; ++n1) { zr[n1] = 0.f; zi[n1] = 0.f; }
    fft_fwdA<true>(zr, zi, lds, tid); __syncthreads();
    fft_B_read(zr, zi, lds, tid); __syncthreads();
    fft_fwdB_write(zr, zi, lds, tid); __syncthreads();
    fft_C_mul_invC(lds, kq, tid); __syncthreads();
    fft_invB_read(zr, zi, lds, tid); __syncthreads();
    fft_invB_write(zr, zi, lds, tid); __syncthreads();
    fft_invA(zr, zi, lds, tid);
    int tg = tid; asm volatile("" : "+v"(tg));
    const int gch = (o + 1) * 512 + c;
    const float w0 = p.hy_conv_w[gch], w1 = p.hy_conv_w[HYC + gch], w2 = p.hy_conv_w[2 * HYC + gch], cb = p.hy_conv_b[gch];
    const ushort_t* g0 = pht + (size_t)(0 * HYC + gch) * S_;
    const ushort_t* g1 = pht + (size_t)(1 * HYC + gch) * S_;
#pragma unroll
    for (int n1 = 0; n1 < 16; ++n1) {
      const int t = n1 * 512 + tg;
      zr[n1] *= sconv_t(g0, t, w0, w1, w2, cb);
      zi[n1] *= sconv_t(g1, t, w0, w1, w2, cb);
      if (n1 & 1) asm volatile("" ::: "memory");
    }
    if (o == 1) {
#pragma unroll
      for (int n1 = 0; n1 < 16; ++n1) {
        const int t = n1 * 512 + tg;
        yht[(size_t)(0 * HW_ + c) * S_ + t] = f2bf(zr[n1]);
        yht[(size_t)(1 * HW_ + c) * S_ + t] = f2bf(zi[n1]);
      }
    }
  }
}

constexpr int ATT_VROW = 192;
constexpr int ATT_VBUF = 32 * ATT_VROW;
DI void attn_item(const P& p, char* smem, int item) {
  const ushort_t* qkv = (const ushort_t*)(p.ws + OFF_QKV);
  ushort_t* ya = (ushort_t*)(p.ws + OFF_YA);
  const int tid = tid_opaque(), lane = tid & 63, wave = tid >> 6;
  const int u = item * 8 + wave;
  const int hs = u & 3, r16 = (u >> 2) & 15, chunk = (u >> 6) & 15, b = u >> 10;
  const int qi = lane & 31, h = lane >> 5;
  char* vl = smem + wave * ATT_VBUF;
  const int tq = chunk * 512 + r16 + 16 * qi;
  const size_t bbase = (size_t)b * S_;
  f32x16 o0, o1;
#pragma unroll
  for (int r = 0; r < 16; ++r) { o0[r] = 0.f; o1[r] = 0.f; }
  float m = -1e30f, l = 0.f;
  const int g16 = (lane >> 4) & 1, q4 = (lane & 15) >> 2, p4 = lane & 3;
  __syncthreads();
#pragma unroll 1
  for (int g = 0; g < 3; ++g) {
    const int dsh = 2 * g;
    const int d = 1 << dsh, sd = 16 >> dsh, n = S_ >> dsh;
    const int head = g * 4 + hs;
    const int rc = r16 & (d - 1);
    const int P0 = (chunk * 512 + r16 - rc) >> dsh;
    const int pq = P0 + sd * qi;
    const int KB = P0 - 64;
    const int ntile = (g == 0) ? 20 : (g == 1 ? 8 : 5);
    bf16x8 bq[4];
    {
      const ushort_t* qrow = qkv + (bbase + tq) * QKVC + head * 64;
#pragma unroll
      for (int s = 0; s < 4; ++s) bq[s] = *(const bf16x8*)(qrow + (2 * s + h) * 8);
    }
    bf16x8 kn[4]; u32x4 vn[4];
    {
      const int kp = min(max(KB + qi, 0), n - 1);
      const ushort_t* krow = qkv + (bbase + rc + ((size_t)kp << dsh)) * QKVC + 768 + head * 64;
#pragma unroll
      for (int s = 0; s < 4; ++s) kn[s] = *(const bf16x8*)(krow + (2 * s + h) * 8);
#pragma unroll
      for (int i = 0; i < 4; ++i) {
        const int c = lane + 64 * i, row = c >> 3, ch = c & 7;
        const int vp = min(max(KB + row, 0), n - 1);
        vn[i] = *(const u32x4*)(qkv + (bbase + rc + ((size_t)vp << dsh)) * QKVC + 1536 + head * 64 + ch * 8);
      }
    }
#pragma unroll 1
    for (int kt = 0; kt < ntile; ++kt) {
      bf16x8 kc[4]; u32x4 vc[4];
#pragma unroll
      for (int s = 0; s < 4; ++s) kc[s] = kn[s];
#pragma unroll
      for (int i = 0; i < 4; ++i) vc[i] = vn[i];
      if (kt + 1 < ntile) {
        const int kb1 = KB + 32 * (kt + 1);
        const int kp = min(max(kb1 + qi, 0), n - 1);
        const ushort_t* krow = qkv + (bbase + rc + ((size_t)kp << dsh)) * QKVC + 768 + head * 64;
#pragma unroll
        for (int s = 0; s < 4; ++s) kn[s] = *(const bf16x8*)(krow + (2 * s + h) * 8);
#pragma unroll
        for (int i = 0; i < 4; ++i) {
          const int c = lane + 64 * i, row = c >> 3, ch = c & 7;
          const int vp = min(max(kb1 + row, 0), n - 1);
          vn[i] = *(const u32x4*)(qkv + (bbase + rc + ((size_t)vp << dsh)) * QKVC + 1536 + head * 64 + ch * 8);
        }
      }
      f32x16 st;
#pragma unroll
      for (int r = 0; r < 16; ++r) st[r] = 0.f;
#pragma unroll
      for (int s = 0; s < 4; ++s) st = __builtin_amdgcn_mfma_f32_32x32x16_bf16(kc[s], bq[s], st, 0, 0, 0);
#pragma unroll
      for (int i = 0; i < 4; ++i) { const int c = lane + 64 * i; *(u32x4*)(vl + (c >> 3) * ATT_VROW + (c & 7) * 16) = vc[i]; }
      const int kb = KB + 32 * kt + 4 * h;
      const int dk = kb - pq;
      float mx = -1e30f;
      bool ok[16];
#pragma unroll
      for (int r = 0; r < 16; ++r) {
        const int cr = (r & 3) + 8 * (r >> 2);
        ok[r] = ((unsigned)(dk + cr + 64) <= 128u) && ((unsigned)(kb + cr) < (unsigned)n);
        mx = fmaxf(mx, ok[r] ? st[r] : -1e30f);
      }
      mx = fmaxf(mx, __shfl_xor(mx, 32));
      const float mnew = fmaxf(m, mx);
      const float corr = __expf(m - mnew);
      float ps = 0.f;
      float pv[16];
#pragma unroll
      for (int r = 0; r < 16; ++r) { pv[r] = ok[r] ? __expf(st[r] - mnew) : 0.f; ps += pv[r]; }
      ps += __shfl_xor(ps, 32);
      l = l * corr + ps; m = mnew;
#pragma unroll
      for (int r = 0; r < 16; ++r) { o0[r] *= corr; o1[r] *= corr; }
      bf16x8 pf[2];
#pragma unroll
      for (int s = 0; s < 2; ++s) {
        u32x4 w;
        w[0] = pack2(pv[8 * s + 0], pv[8 * s + 1]); w[1] = pack2(pv[8 * s + 2], pv[8 * s + 3]);
        w[2] = pack2(pv[8 * s + 4], pv[8 * s + 5]); w[3] = pack2(pv[8 * s + 6], pv[8 * s + 7]);
        pf[s] = __builtin_bit_cast(bf16x8, w);
      }
      __builtin_amdgcn_wave_barrier();
      asm volatile("s_waitcnt lgkmcnt(0)" ::: "memory");
#pragma unroll
      for (int s = 0; s < 2; ++s) {
#pragma unroll
        for (int nt = 0; nt < 2; ++nt) {
          const char* a0 = vl + (16 * s + 4 * h + q4) * ATT_VROW + (32 * nt + 16 * g16 + 4 * p4) * 2;
          s16x4 lo = __builtin_amdgcn_ds_read_tr16_b64_v4i16((__attribute__((address_space(3))) s16x4*)(a0));
          s16x4 hi = __builtin_amdgcn_ds_read_tr16_b64_v4i16((__attribute__((address_space(3))) s16x4*)(a0 + 8 * ATT_VROW));
          const bf16x8 vf = __builtin_shufflevector(lo, hi, 0, 1, 2, 3, 4, 5, 6, 7);
          if (nt == 0) o0 = __builtin_amdgcn_mfma_f32_32x32x16_bf16(vf, pf[s], o0, 0, 0, 0);
          else o1 = __builtin_amdgcn_mfma_f32_32x32x16_bf16(vf, pf[s], o1, 0, 0, 0);
        }
      }
      __builtin_amdgcn_wave_barrier();
      asm volatile("s_waitcnt lgkmcnt(0)" ::: "memory");
    }
  }
  const float il = 1.f / l;
  ushort_t* op = ya + (bbase + tq) * 256 + hs * 64;
#pragma unroll
  for (int gq = 0; gq < 4; ++gq) {
    uint2 w0, w1;
    w0.x = pack2(o0[4 * gq] * il, o0[4 * gq + 1] * il); w0.y = pack2(o0[4 * gq + 2] * il, o0[4 * gq + 3] * il);
    w1.x = pack2(o1[4 * gq] * il, o1[4 * gq + 1] * il); w1.y = pack2(o1[4 * gq + 2] * il, o1[4 * gq + 3] * il);
    *(uint2*)(op + 8 * gq + 4 * h) = w0;
    *(uint2*)(op + 32 + 8 * gq + 4 * h) = w1;
  }
}

DI void phase_yh_transpose(const P& p, char* smem) {
  const ushort_t* yht = (const ushort_t*)(p.ws + OFF_YH);
  ushort_t* yhk = (ushort_t*)(p.ws + OFF_YHK);
  const int tid = tid_opaque();
  for (int item = blockIdx.x; item < 1024; item += gridDim.x) {
    const int cg = item & 15, tc = item >> 4, b = tc >> 5, t0 = (tc * 256) & (S_ - 1);
    __syncthreads();
    {
      const int ch = tid >> 4, k16 = tid & 15;
      const ushort_t* srcp = yht + (size_t)(b * HW_ + cg * 32 + ch) * S_ + t0;
#pragma unroll
      for (int i = 0; i < 2; ++i) *(u32x4*)(smem + ch * 528 + (k16 + 16 * i) * 16) = *(const u32x4*)(srcp + (k16 + 16 * i) * 8);
    }
    __syncthreads();
    {
      const int t = tid >> 1, half = tid & 1;
      unsigned w[8];
#pragma unroll
      for (int k = 0; k < 8; ++k) {
        const unsigned lo = *(const ushort_t*)(smem + (half * 16 + 2 * k) * 528 + t * 2);
        const unsigned hi = *(const ushort_t*)(smem + (half * 16 + 2 * k + 1) * 528 + t * 2);
        w[k] = lo | (hi << 16);
      }
      ushort_t* dst = yhk + (size_t)(tc * 256 + t) * HW_ + cg * 32 + half * 16;
      u32x4 o0, o1; o0[0] = w[0]; o0[1] = w[1]; o0[2] = w[2]; o0[3] = w[3]; o1[0] = w[4]; o1[1] = w[5]; o1[2] = w[6]; o1[3] = w[7];
      *(u32x4*)dst = o0; *(u32x4*)(dst + 8) = o1;
    }
  }
}
DI f32x4p bf4lo(const u32x4& w) { f32x4p r; r[0] = __uint_as_float(w[0] << 16); r[1] = __uint_as_float(w[0] & 0xffff0000u); r[2] = __uint_as_float(w[1] << 16); r[3] = __uint_as_float(w[1] & 0xffff0000u); return r; }
DI f32x4p bf4hi(const u32x4& w) { f32x4p r; r[0] = __uint_as_float(w[2] << 16); r[1] = __uint_as_float(w[2] & 0xffff0000u); r[2] = __uint_as_float(w[3] << 16); r[3] = __uint_as_float(w[3] & 0xffff0000u); return r; }
template <bool ADD>
struct MergeEpi {
  static constexpr bool PERM = true, AFTER_DRAIN = false;
  const ushort_t* gate; ushort_t* merged;
  DI void operator()(const f32x4p (&acc)[2][2][4][2], const pg8::Unit& u, int wr, int wc, int fr, int fq) const {
    const ushort_t* gb = gate + (size_t)(u.pm * 256) * GATEC + u.pn * 256;
    ushort_t* mb = merged + (size_t)(u.pm * 256) * 1024 + u.pn * 256;
    const unsigned lg = (unsigned)((wr * 64 + fr) * GATEC + wc * 32 + 8 * fq), lm = (unsigned)((wr * 64 + fr) * 1024 + wc * 32 + 8 * fq);
#pragma unroll
    for (int ai = 0; ai < 2; ++ai)
#pragma unroll
      for (int m = 0; m < 4; ++m) {
#pragma unroll
        for (int bj = 0; bj < 2; ++bj) {
          const u32x4 gw = *(const u32x4*)(gb + (ai * 128 + m * 16) * GATEC + bj * 128 + lg);
          f32x4p v0 = bf4lo(gw) * acc[ai][bj][m][0], v1 = bf4hi(gw) * acc[ai][bj][m][1];
          ushort_t* mp = mb + (ai * 128 + m * 16) * 1024 + bj * 128 + lm;
          if (ADD) { const u32x4 mw = *(const u32x4*)mp; v0 += bf4lo(mw); v1 += bf4hi(mw); }
          *(u32x4*)mp = pack8(v0, v1);
        }
        asm volatile("" ::: "memory");
      }
  }
};
DI void phase_merge(const P& p, char* smem) {
  {
    PlainSched S{p.ws + OFF_YHK, p.ws + OFF_WBH_T, 64, 4, 512, (int)gridDim.x, (int)blockIdx.x};
    MergeEpi<false> E{(const ushort_t*)(p.ws + OFF_GATE), (ushort_t*)(p.ws + OFF_MERGED)};
    pg8::gemm_phase(( __attribute__((address_space(3))) unsigned char*)smem, 512, S, E);
  }
  {
    PlainSched S{p.ws + OFF_YA, p.ws + OFF_WBA_T, 64, 4, 256, (int)gridDim.x, (int)blockIdx.x};
    MergeEpi<true> E{(const ushort_t*)(p.ws + OFF_GATE) + 1024, (ushort_t*)(p.ws + OFF_MERGED)};
    pg8::gemm_phase(( __attribute__((address_space(3))) unsigned char*)smem, 256, S, E);
  }
}

DI void phase_ln(float* __restrict__ xio, const float* __restrict__ g, const float* __restrict__ bta) {
  const int tq = tid_opaque(); const int lane = tq & 63, wave = tq >> 6;
  for (int row = blockIdx.x * 8 + wave; row < T_; row += gridDim.x * 8) {
    float* rp = xio + (size_t)row * 1024;
    f32x4 v[4];
    float s = 0.f;
#pragma unroll
    for (int i = 0; i < 4; ++i) { v[i] = *(const f32x4*)(rp + i * 256 + lane * 4); s += v[i][0] + v[i][1] + v[i][2] + v[i][3]; }
    const float mu = wave_sum(s) * (1.f / 1024.f);
    float q = 0.f;
#pragma unroll
    for (int i = 0; i < 4; ++i)
#pragma unroll
      for (int j = 0; j < 4; ++j) { float d = v[i][j] - mu; q += d * d; }
    const float rs = rsqrtf(wave_sum(q) * (1.f / 1024.f) + LN_EPS);
#pragma unroll
    for (int i = 0; i < 4; ++i) {
      f32x4 gg = *(const f32x4*)(g + i * 256 + lane * 4), bb = *(const f32x4*)(bta + i * 256 + lane * 4), o;
#pragma unroll
      for (int j = 0; j < 4; ++j) o[j] = (v[i][j] - mu) * rs * gg[j] + bb[j];
      *(f32x4*)(rp + i * 256 + lane * 4) = o;
    }
  }
}

DI int swz256(int row, int ch) { return row * 256 + ((ch ^ (row & 15)) << 4); }
DI void ins16(float (&L)[16], float x) {
#pragma unroll
  for (int i = 0; i < 16; ++i) { const float hi = __builtin_fmaxf(L[i], x); x = __builtin_fminf(L[i], x); L[i] = hi; }
}
DI void bitonic16_desc(float (&M)[16]) {
#pragma unroll
  for (int d = 8; d >= 1; d >>= 1)
#pragma unroll
    for (int i = 0; i < 16; ++i)
      if ((i & d) == 0) { const float a = M[i], b = M[i + d]; M[i] = __builtin_fmaxf(a, b); M[i + d] = __builtin_fminf(a, b); }
}
constexpr int ROUTE_Q_OFF = 0, ROUTE_K_OFF = 65536, ROUTE_IDX_OFF = 106496;
DI void phase_route(const P& p, char* smem) {
  const float* ada = (const float*)(p.ws + OFF_ADA);
  float* mod = (float*)(smem + 2 * LDS_STAGE);
  const ushort_t* keysb = (const ushort_t*)(p.ws + OFF_KEYS_B);
  int* idx = (int*)(p.ws + OFF_IDX);
  float* gv = (float*)(p.ws + OFF_GV);
  for (int item = blockIdx.x; item < (T_ / BM) * 8; item += gridDim.x) {
    const int tid = tid_opaque(), lane = tid & 63, wave = tid >> 6, wm = wave >> 1, wn = wave & 1;
    const int m0 = (item >> 3) * BM, hh = item & 7;
    float L0[16];
#pragma unroll 1
    for (int pp = 0; pp < 2; ++pp) {
      const int hp = hh * 2 + pp;
      f32x16 acc[2][2]; acc_zero(acc);
      ALoadBf16 al{(const ushort_t*)(p.ws + OFF_U2B), 1024};
      gemm_mainloop<ALoadBf16, true>(acc, al, m0, (const ushort_t*)(p.ws + OFF_WQ_T), 1024, hp * 128, 1024, smem);
#pragma unroll
      for (int mi = 0; mi < 2; ++mi) {
        const int tok = wm * 64 + mi * 32 + (lane & 31);
#pragma unroll
        for (int ni = 0; ni < 2; ++ni)
#pragma unroll
          for (int g = 0; g < 4; ++g) {
            const int ch = wn * 8 + ni * 4 + g;
            uint2 v; v.x = pack2(acc[mi][ni][4 * g], acc[mi][ni][4 * g + 1]); v.y = pack2(acc[mi][ni][4 * g + 2], acc[mi][ni][4 * g + 3]);
            *(uint2*)(smem + ROUTE_Q_OFF + swz256(tok, ch) + 8 * (lane >> 5)) = v;
          }
      }
#pragma unroll
      for (int i = 0; i < 4; ++i) {
        const int q = tid + 512 * i, row = q >> 4, ch = q & 15;
        *(u32x4*)(smem + ROUTE_K_OFF + swz256(row, ch)) = *(const u32x4*)(keysb + (size_t)hp * 16384 + row * 128 + ch * 8);
      }
      __syncthreads();
      f32x16 sc[4];
#pragma unroll
      for (int ks = 0; ks < 4; ++ks)
#pragma unroll
        for (int r = 0; r < 16; ++r) sc[ks][r] = 0.f;
#pragma unroll
      for (int s = 0; s < 8; ++s) {
        const int ch = 2 * s + (lane >> 5);
        const bf16x8 bq = *(const bf16x8*)(smem + ROUTE_Q_OFF + swz256(wave * 32 + (lane & 31), ch));
#pragma unroll
        for (int ks = 0; ks < 4; ++ks) {
          const bf16x8 ak = *(const bf16x8*)(smem + ROUTE_K_OFF + swz256(ks * 32 + (lane & 31), ch));
          sc[ks] = __builtin_amdgcn_mfma_f32_32x32x16_bf16(ak, bq, sc[ks], 0, 0, 0);
        }
      }
      float L[16];
#pragma unroll
      for (int i = 0; i < 16; ++i) L[i] = -3.0e38f;
      const unsigned hbit = (unsigned)(lane >> 5) << 2;
#pragma unroll
      for (int ks = 0; ks < 4; ++ks)
#pragma unroll
        for (int r = 0; r < 16; ++r) {
          const unsigned key = (unsigned)(ks * 32 + (r & 3) + 8 * (r >> 2)) | hbit;
          ins16(L, __uint_as_float((__float_as_uint(sc[ks][r]) & ~127u) | key));
        }
      {
        float M[16];
#pragma unroll
        for (int i = 0; i < 16; ++i) M[i] = __builtin_fmaxf(L[i], __shfl_xor(L[15 - i], 32));
        bitonic16_desc(M);
#pragma unroll
        for (int i = 0; i < 16; ++i) L[i] = M[i];
      }
      if (pp == 0) {
#pragma unroll
        for (int i = 0; i < 16; ++i) L0[i] = L[i];
      } else {
        unsigned char* ib = (unsigned char*)(smem + ROUTE_IDX_OFF) + tid * 32;
#pragma unroll
        for (int i = 0; i < 16; ++i) { ib[i] = (unsigned char)(__float_as_uint(L0[i]) & 127u); ib[16 + i] = (unsigned char)(__float_as_uint(L[i]) & 127u); }
        float F[16];
#pragma unroll
        for (int i = 0; i < 16; ++i) F[i] = -3.0e38f;
#pragma unroll
        for (int i = 0; i < 16; ++i) {
          const float ai = __uint_as_float(__float_as_uint(L0[i]) & ~127u);
#pragma unroll
          for (int j = 0; j < 16; ++j)
            if ((i + 1) * (j + 1) <= 16) {
              const float s = ai + __uint_as_float(__float_as_uint(L[j]) & ~127u);
              ins16(F, __uint_as_float((__float_as_uint(s) & ~255u) | (unsigned)(i * 16 + j)));
            }
        }
        const float mx = __uint_as_float(__float_as_uint(F[0]) & ~255u);
        float e[16], sum = 0.f;
#pragma unroll
        for (int k = 0; k < 16; ++k) { e[k] = __expf(__uint_as_float(__float_as_uint(F[k]) & ~255u) - mx); sum += e[k]; }
        const float inv = 1.f / sum;
        if (lane < 32) {
          const int tok = m0 + wave * 32 + lane;
          int* ip = idx + (size_t)tok * 128 + hh * 16;
          float* gp = gv + (size_t)tok * 128 + hh * 16;
#pragma unroll
          for (int k4 = 0; k4 < 4; ++k4) {
            int4 iv; f32x4 g4;
            int ee[4];
#pragma unroll
            for (int u = 0; u < 4; ++u) {
              const unsigned code = __float_as_uint(F[k4 * 4 + u]) & 255u;
              ee[u] = (int)ib[code >> 4] * 128 + (int)ib[16 + (code & 15u)];
              g4[u] = e[k4 * 4 + u] * inv;
            }
            iv.x = ee[0]; iv.y = ee[1]; iv.z = ee[2]; iv.w = ee[3];
            *(int4*)(ip + k4 * 4) = iv;
            *(f32x4*)(gp + k4 * 4) = g4;
          }
        }
      }
    }
  }
}

DI void phase_rope(const P& p) {
  float* rt = (float*)(p.ws + OFF_ROPE);
  for (int i = blockIdx.x * NT + tid_opaque(); i < T_ * 8; i += gridDim.x * NT) {
    const float inv = expf(-13.122363377404328f * (float)(i & 7) * 0.125f);
    const float x = (float)p.pos[i >> 3] * inv;
    const float k = rintf(x * 0.15915494309189535f);
    float r = fmaf(-k, 6.28125f, x);
    r = fmaf(-k, 1.9353071795864769e-3f, r);
    float sn, cs; __sincosf(r, &sn, &cs);
    rt[2 * i] = cs; rt[2 * i + 1] = sn;
  }
}
DI void phase_keys(const P& p) {
  ushort_t* keysb = (ushort_t*)(p.ws + OFF_KEYS_B);
  for (int i = blockIdx.x * NT + tid_opaque(); i < 16 * 128 * 128 / 4; i += gridDim.x * NT) {
    f32x4 v = *(const f32x4*)(p.keys + (size_t)i * 4);
    uint2 o; o.x = pack2(v[0], v[1]); o.y = pack2(v[2], v[3]);
    *(uint2*)(keysb + (size_t)i * 4) = o;
  }
}

typedef __bf16 bf16x2_t __attribute__((ext_vector_type(2)));
DI float dot2bf(unsigned a, unsigned b, float c) { return __builtin_amdgcn_fdot2_f32_bf16(__builtin_bit_cast(bf16x2_t, a), __builtin_bit_cast(bf16x2_t, b), c, false); }
DI void phase_ln1(const P& p) {
  const float* ada = (const float*)(p.ws + OFF_ADA);
  ushort_t* u2b = (ushort_t*)(p.ws + OFF_U2B);
  const int tq = tid_opaque(); const int lane = tq & 63, wave = tq >> 6;
  for (int row = blockIdx.x * 8 + wave; row < T_; row += gridDim.x * 8) {
    const int b = row / S_;
    float* rp = p.out + (size_t)row * 1024;
    f32x4 v[4];
    float s = 0.f;
#pragma unroll
    for (int i = 0; i < 4; ++i) { v[i] = *(const f32x4*)(rp + i * 256 + lane * 4); s += v[i][0] + v[i][1] + v[i][2] + v[i][3]; }
    const float mu = wave_sum(s) * (1.f / 1024.f);
    float q = 0.f;
#pragma unroll
    for (int i = 0; i < 4; ++i)
#pragma unroll
      for (int j = 0; j < 4; ++j) { float d = v[i][j] - mu; q += d * d; }
    const float rs = rsqrtf(wave_sum(q) * (1.f / 1024.f) + LN_EPS);
#pragma unroll
    for (int i = 0; i < 4; ++i) {
      const int col = i * 256 + lane * 4;
      f32x4 gg = *(const f32x4*)(p.ln1_g + col), bb = *(const f32x4*)(p.ln1_b + col), o;
      f32x4 sc = *(const f32x4*)(ada + b * 6144 + 4 * 1024 + col), sh = *(const f32x4*)(ada + b * 6144 + 3 * 1024 + col);
#pragma unroll
      for (int j = 0; j < 4; ++j) o[j] = (v[i][j] - mu) * rs * gg[j] + bb[j];
      *(f32x4*)(rp + col) = o;
      uint2 w; w.x = pack2(o[0] * (1.f + sc[0]) + sh[0], o[1] * (1.f + sc[1]) + sh[1]); w.y = pack2(o[2] * (1.f + sc[2]) + sh[2], o[3] * (1.f + sc[3]) + sh[3]);
      *(uint2*)(u2b + (size_t)row * 1024 + col) = w;
    }
  }
}
DI float wave_max(float v) {
#pragma unroll
  for (int o = 32; o > 0; o >>= 1) v = fmaxf(v, __shfl_xor(v, o));
  return v;
}
DI unsigned pack4_fp8(float a, float b, float c, float d) {
  int w = 0;
  w = __builtin_amdgcn_cvt_pk_fp8_f32(a, b, w, false);
  w = __builtin_amdgcn_cvt_pk_fp8_f32(c, d, w, true);
  return (unsigned)w;
}
DI void phase_tabconv(const P& p) {
  unsigned char* tu = (unsigned char*)(p.ws + OFF_TABU);
  unsigned char* tv = (unsigned char*)(p.ws + OFF_TABV);
  float* su = (float*)(p.ws + OFF_SU);
  float* sv = (float*)(p.ws + OFF_SV);
  const int tq = tid_opaque(); const int lane = tq & 63, wave = tq >> 6;
  for (int e = blockIdx.x * 8 + wave; e < 16384; e += gridDim.x * 8) {
    f32x4 a[4], c[4];
    float ma = 0.f, mc = 0.f;
#pragma unroll
    for (int i = 0; i < 4; ++i) {
      const int col = i * 256 + lane * 4;
      a[i] = *(const f32x4*)(p.pu + (size_t)e * 1024 + col);
      c[i] = *(const f32x4*)(p.pv + (size_t)e * 1024 + col);
#pragma unroll
      for (int j = 0; j < 4; ++j) { ma = fmaxf(ma, fabsf(a[i][j])); mc = fmaxf(mc, fabsf(c[i][j])); }
    }
    ma = wave_max(ma); mc = wave_max(mc);
    const float sa = (ma > 0.f) ? ma * (1.0f / 448.0f) : 1.0f, sc = (mc > 0.f) ? mc * (1.0f / 448.0f) : 1.0f;
    const float ia = 1.0f / sa, ic = 1.0f / sc;
    if (lane == 0) { su[e] = sa; sv[e] = sc; }
#pragma unroll
    for (int i = 0; i < 4; ++i) {
      const int col = i * 256 + lane * 4;
      *(unsigned*)(tu + (size_t)e * 1024 + col) = pack4_fp8(a[i][0] * ia, a[i][1] * ia, a[i][2] * ia, a[i][3] * ia);
      const int slice = i * 2 + (lane >> 5);
      *(unsigned*)(tv + ((size_t)slice * 16384 + e) * 128 + (lane & 31) * 4) = pack4_fp8(c[i][0] * ic, c[i][1] * ic, c[i][2] * ic, c[i][3] * ic);
    }
  }
}

template <int CTRL> DI float dpp_f(float v) { return __int_as_float(__builtin_amdgcn_mov_dpp(__float_as_int(v), CTRL, 0xf, 0xf, false)); }
template <int CTRL> DI int dpp_shr0(int v) { return __builtin_amdgcn_update_dpp(0, v, CTRL, 0xf, 0xf, true); }
template <int I> DI int bcast16(int v) { return __builtin_amdgcn_mov_dpp(v, 0x150 + I, 0xf, 0xf, false); }
DI float row_sum16(float d) {
  d += dpp_f<0xB1>(d);
  d += dpp_f<0x4E>(d);
  d += dpp_f<0x141>(d);
  d += dpp_f<0x140>(d);
  return d;
}
typedef __bf16 bf16x2_c __attribute__((ext_vector_type(2)));
DI float dot4_fp8(unsigned w8, unsigned xlo, unsigned xhi, float acc) {
  const bf16x2_c lo = __builtin_amdgcn_cvt_scalef32_pk_bf16_fp8((int)w8, 1.0f, false);
  const bf16x2_c hi = __builtin_amdgcn_cvt_scalef32_pk_bf16_fp8((int)w8, 1.0f, true);
  acc = __builtin_amdgcn_fdot2_f32_bf16(lo, __builtin_bit_cast(bf16x2_c, xlo), acc, false);
  return __builtin_amdgcn_fdot2_f32_bf16(hi, __builtin_bit_cast(bf16x2_c, xhi), acc, false);
}
DI void phase_upass(const P& p, char* smem) {
  const int* idx = (const int*)(p.ws + OFF_IDX);
  const float* gv = (const float*)(p.ws + OFF_GV);
  const ushort_t* u2b = (const ushort_t*)(p.ws + OFF_U2B);
  const char* tabu = (const char*)(p.ws + OFF_TABU);
  const float* su = (const float*)(p.ws + OFF_SU);
  const float* sv = (const float*)(p.ws + OFF_SV);
  float* coef = (float*)(p.ws + OFF_COEF);
  const int tq = tid_opaque(); const int lane = tq & 63, wave = tq >> 6;
  const int g = lane >> 4, j = lane & 15;
  int4* lst = (int4*)smem + wave * 512 + g * 128;
  const int part = blockIdx.x & 7, bi = blockIdx.x >> 3, nb = (gridDim.x - part + 7) >> 3;
  __syncthreads();
#pragma unroll 1
  for (int tb = (bi * 8 + wave) * 4; tb < T_; tb += nb * 32) {
    const int tok = tb + g;
    const int4 i0 = *(const int4*)(idx + (size_t)tb * 128 + lane * 8), i1 = *(const int4*)(idx + (size_t)tb * 128 + lane * 8 + 4);
    const f32x4 g0 = *(const f32x4*)(gv + (size_t)tb * 128 + lane * 8), g1 = *(const f32x4*)(gv + (size_t)tb * 128 + lane * 8 + 4);
    u32x4 xr[8];
#pragma unroll
    for (int c = 0; c < 4; ++c) {
      xr[2 * c] = *(const u32x4*)(u2b + (size_t)tok * 1024 + (j + 16 * c) * 16);
      xr[2 * c + 1] = *(const u32x4*)(u2b + (size_t)tok * 1024 + (j + 16 * c) * 16 + 8);
    }
    const int ev[8] = {i0.x, i0.y, i0.z, i0.w, i1.x, i1.y, i1.z, i1.w};
    const float gg[8] = {g0[0], g0[1], g0[2], g0[3], g1[0], g1[1], g1[2], g1[3]};
    int cnt = 0;
#pragma unroll
    for (int i = 0; i < 8; ++i) cnt += ((ev[i] >> 11) == part) ? 1 : 0;
    int incl = cnt;
    incl += dpp_shr0<0x111>(incl); incl += dpp_shr0<0x112>(incl); incl += dpp_shr0<0x114>(incl); incl += dpp_shr0<0x118>(incl);
    const int ng = bcast16<15>(incl);
    int pos = incl - cnt;
#pragma unroll
    for (int i = 0; i < 8; ++i)
      if ((ev[i] >> 11) == part) { int4 en; en.x = ev[i]; en.y = __float_as_int(gg[i]); en.z = j * 8 + i; en.w = 0; lst[pos] = en; ++pos; }
    const int nmax = max(max(__builtin_amdgcn_readlane(ng, 0), __builtin_amdgcn_readlane(ng, 16)), max(__builtin_amdgcn_readlane(ng, 32), __builtin_amdgcn_readlane(ng, 48)));
    __builtin_amdgcn_wave_barrier();
    asm volatile("s_waitcnt lgkmcnt(0)" ::: "memory");
    u32x4 ra[4], rb[4], rc[4], rd[4];
#define UP_LOAD(R, IT) { const unsigned e_ = ((IT) < ng) ? (unsigned)lst[(IT)].x : 0u; const char* row_ = tabu + (size_t)e_ * 1024 + j * 16; \
                         _Pragma("unroll") for (int c = 0; c < 4; ++c) R[c] = *(const u32x4*)(row_ + c * 256); }
#define UP_COMP(R, IT) { float a0 = 0.f, a1 = 0.f, a2 = 0.f, a3 = 0.f; \
      _Pragma("unroll") for (int c = 0; c < 4; ++c) { \
        a0 = dot4_fp8(R[c][0], xr[2 * c][0], xr[2 * c][1], a0); a1 = dot4_fp8(R[c][1], xr[2 * c][2], xr[2 * c][3], a1); \
        a2 = dot4_fp8(R[c][2], xr[2 * c + 1][0], xr[2 * c + 1][1], a2); a3 = dot4_fp8(R[c][3], xr[2 * c + 1][2], xr[2 * c + 1][3], a3); } \
      const float d_ = row_sum16((a0 + a1) + (a2 + a3)); \
      if (j == 0 && (IT) < ng) ((int*)&lst[(IT)])[3] = __float_as_int(d_); }
    UP_LOAD(ra, 0) UP_LOAD(rb, 1) UP_LOAD(rc, 2) UP_LOAD(rd, 3)
#pragma unroll 1
    for (int it = 0; it < nmax; it += 4) {
      UP_COMP(ra, it)     UP_LOAD(ra, it + 4)
      UP_COMP(rb, it + 1) UP_LOAD(rb, it + 5)
      UP_COMP(rc, it + 2) UP_LOAD(rc, it + 6)
      UP_COMP(rd, it + 3) UP_LOAD(rd, it + 7)
    }
#undef UP_LOAD
#undef UP_COMP
    __builtin_amdgcn_wave_barrier();
    asm volatile("s_waitcnt lgkmcnt(0)" ::: "memory");
#pragma unroll 1
    for (int k = 0; k < nmax; k += 16) {
      if (k + j < ng) {
        const int4 en = lst[k + j];
        const float a = __int_as_float(en.w) * su[en.x];
        coef[(size_t)tok * 128 + en.z] = __int_as_float(en.y) * 0.5f * a * (1.f + erff(a * 0.7071067811865475f)) * sv[en.x];
      }
    }
    __builtin_amdgcn_wave_barrier();
    asm volatile("s_waitcnt lgkmcnt(0)" ::: "memory");
  }
}

struct VHdr { int ea, eb, ca, cb; };
DI VHdr vp_hdr(const int* idx, const float* coef, int tok, int g, int cq) {
  VHdr h;
  h.ea = idx[(size_t)tok * 128 + g * 32 + cq]; h.eb = idx[(size_t)tok * 128 + g * 32 + 16 + cq];
  h.ca = __float_as_int(coef[(size_t)tok * 128 + g * 32 + cq]); h.cb = __float_as_int(coef[(size_t)tok * 128 + g * 32 + 16 + cq]);
  return h;
}
DI void vp_rows(uint2 (&va)[16], uint2 (&vb)[16], const VHdr& h, const char* tb) {
#define VP_STEP(I) { va[I] = *(const uint2*)(tb + (unsigned)bcast16<I>(h.ea) * 128u); vb[I] = *(const uint2*)(tb + (unsigned)bcast16<I>(h.eb) * 128u); }
  VP_STEP(0) VP_STEP(1) VP_STEP(2) VP_STEP(3) VP_STEP(4) VP_STEP(5) VP_STEP(6) VP_STEP(7)
  VP_STEP(8) VP_STEP(9) VP_STEP(10) VP_STEP(11) VP_STEP(12) VP_STEP(13) VP_STEP(14) VP_STEP(15)
#undef VP_STEP
}
DI void vp_coefs(float (&fa)[16], float (&fb)[16], const VHdr& h) {
#define VP_STEP(I) { fa[I] = __int_as_float(bcast16<I>(h.ca)); fb[I] = __int_as_float(bcast16<I>(h.cb)); }
  VP_STEP(0) VP_STEP(1) VP_STEP(2) VP_STEP(3) VP_STEP(4) VP_STEP(5) VP_STEP(6) VP_STEP(7)
  VP_STEP(8) VP_STEP(9) VP_STEP(10) VP_STEP(11) VP_STEP(12) VP_STEP(13) VP_STEP(14) VP_STEP(15)
#undef VP_STEP
}
DI void vp_fma8(float (&a)[8], float cf, const uint2& v) {
  const f32x2_hw p0 = __builtin_amdgcn_cvt_pk_f32_fp8((int)v.x, false), p1 = __builtin_amdgcn_cvt_pk_f32_fp8((int)v.x, true);
  const f32x2_hw p2 = __builtin_amdgcn_cvt_pk_f32_fp8((int)v.y, false), p3 = __builtin_amdgcn_cvt_pk_f32_fp8((int)v.y, true);
  a[0] += cf * p0[0]; a[1] += cf * p0[1]; a[2] += cf * p1[0]; a[3] += cf * p1[1];
  a[4] += cf * p2[0]; a[5] += cf * p2[1]; a[6] += cf * p3[0]; a[7] += cf * p3[1];
}
DI void vp_consume(const uint2 (&va)[16], const uint2 (&vb)[16], const VHdr& h, float* f, int tok, int slice, int g, int cq, bool live) {
  float fa[16], fb[16];
  vp_coefs(fa, fb, h);
  float a[8];
#pragma unroll
  for (int i = 0; i < 8; ++i) a[i] = 0.f;
#pragma unroll
  for (int i = 0; i < 16; ++i) { vp_fma8(a, fa[i], va[i]); vp_fma8(a, fb[i], vb[i]); }
#pragma unroll
  for (int i = 0; i < 8; ++i) { a[i] += __shfl_xor(a[i], 16); a[i] += __shfl_xor(a[i], 32); }
  if (g == 0 && live) {
    f32x4 o0, o1; o0[0] = a[0]; o0[1] = a[1]; o0[2] = a[2]; o0[3] = a[3]; o1[0] = a[4]; o1[1] = a[5]; o1[2] = a[6]; o1[3] = a[7];
    float* fp = f + (size_t)tok * 1024 + slice * 128 + cq * 8;
    *(f32x4*)fp = o0; *(f32x4*)(fp + 4) = o1;
  }
}
DI void phase_vpass(const P& p) {
  const int* idx = (const int*)(p.ws + OFF_IDX);
  const float* coef = (const float*)(p.ws + OFF_COEF);
  const char* tabv = (const char*)(p.ws + OFF_TABV);
  float* f = (float*)(p.ws + OFF_F);
  const int tq = tid_opaque(); const int lane = tq & 63, wave = tq >> 6;
  const int g = lane >> 4, cq = lane & 15;
  const int slice = blockIdx.x & 7, bi = blockIdx.x >> 3, nb = (gridDim.x - slice + 7) >> 3;
  const int step = nb * 8;
  const char* tb = tabv + (size_t)slice * (16384 * 128) + cq * 8;
  int tok = bi * 8 + wave;
  if (tok >= T_) return;
  VHdr h0 = vp_hdr(idx, coef, tok, g, cq);
  VHdr h1 = vp_hdr(idx, coef, min(tok + step, T_ - 1), g, cq);
  uint2 va[16], vb[16], na[16], nb2[16];
  vp_rows(va, vb, h0, tb);
#pragma unroll 1
  for (; tok < T_; tok += 2 * step) {
    const VHdr h2 = vp_hdr(idx, coef, min(tok + 2 * step, T_ - 1), g, cq);
    vp_rows(na, nb2, h1, tb);
    vp_consume(va, vb, h0, f, tok, slice, g, cq, true);
    const VHdr h3 = vp_hdr(idx, coef, min(tok + 3 * step, T_ - 1), g, cq);
    vp_rows(va, vb, h2, tb);
    vp_consume(na, nb2, h1, f, tok + step, slice, g, cq, tok + step < T_);
    h0 = h2; h1 = h3;
  }
}

DI void phase_ln2(const P& p) {
  const float* ada = (const float*)(p.ws + OFF_ADA);
  const float* f = (const float*)(p.ws + OFF_F);
  const int tq = tid_opaque(); const int lane = tq & 63, wave = tq >> 6;
  for (int tok = blockIdx.x * 8 + wave; tok < T_; tok += gridDim.x * 8) {
    const int b = tok / S_;
    float* rp = p.out + (size_t)tok * 1024;
    f32x4 acc[4];
    float sm = 0.f;
#pragma unroll
    for (int i = 0; i < 4; ++i) {
      const int col = i * 256 + lane * 4;
      f32x4 x1 = *(const f32x4*)(rp + col), ff = *(const f32x4*)(f + (size_t)tok * 1024 + col);
      f32x4 g2 = *(const f32x4*)(ada + b * 6144 + 5 * 1024 + col);
#pragma unroll
      for (int j = 0; j < 4; ++j) { acc[i][j] = DN_ALPHA * x1[j] + (1.f + g2[j]) * ff[j]; sm += acc[i][j]; }
    }
    const float mu = wave_sum(sm) * (1.f / 1024.f);
    float q = 0.f;
#pragma unroll
    for (int i = 0; i < 4; ++i)
#pragma unroll
      for (int j = 0; j < 4; ++j) { float d = acc[i][j] - mu; q += d * d; }
    const float rs = rsqrtf(wave_sum(q) * (1.f / 1024.f) + LN_EPS);
#pragma unroll
    for (int i = 0; i < 4; ++i) {
      const int col = i * 256 + lane * 4;
      f32x4 gg = *(const f32x4*)(p.ln2_g + col), bb = *(const f32x4*)(p.ln2_b + col), o;
#pragma unroll
      for (int j = 0; j < 4; ++j) o[j] = (acc[i][j] - mu) * rs * gg[j] + bb[j];
      *(f32x4*)(rp + col) = o;
    }
  }
}

#define XB_TMO      128
#define XB_XCNT(j)  (256  + 64 * (j))
#define XB_XSUB(j)  (1280 + 64 * (j))
#define XB_XGEN(j)  (2304 + 64 * (j))
#define XB_TOP      3328
#define XB_TOPGEN   3392
#define XCD_BAR_WORDS 3456
#define XB_SPIN_CAP (1u << 22)
#define LAS __attribute__((address_space(3)))
DI unsigned xb_ld(unsigned* p)              { return __hip_atomic_load(p, __ATOMIC_RELAXED, __HIP_MEMORY_SCOPE_AGENT); }
DI unsigned xb_add(unsigned* p, unsigned v) { return __hip_atomic_fetch_add(p, v, __ATOMIC_RELAXED, __HIP_MEMORY_SCOPE_AGENT); }
DI unsigned xb_xcc_id() { return (unsigned)__builtin_amdgcn_s_getreg((3 << 11) | 20) & 0xFu; }
#define XB_SPIN(cond, bar) do { unsigned _sp = 0; while (cond) { __builtin_amdgcn_s_sleep(1); \
    if ((++_sp & 255u) == 0u) { if (xb_ld(&(bar)[XB_TMO])) break; if (_sp > XB_SPIN_CAP) { atomicAdd(&(bar)[XB_TMO], 1u); break; } } } } while (0)
struct XcdBarrier { unsigned* bar; unsigned x; volatile LAS unsigned* st; };
DI XcdBarrier xcd_barrier_post(unsigned* bar, volatile LAS unsigned* st) {
  XcdBarrier b; b.bar = bar; b.x = xb_xcc_id(); b.st = st;
  if (threadIdx.x == 0) (void)xb_add(&bar[XB_XCNT(b.x)], 1u);
  return b;
}
DI void xcd_barrier_complete(unsigned* bar, unsigned x, unsigned& nloc, unsigned& nx) {
  const unsigned G = gridDim.x * gridDim.y * gridDim.z;
  unsigned sum, cnt, mine, sp = 0u;
  for (;;) {
    sum = 0u; cnt = 0u; mine = 0u;
#pragma unroll
    for (unsigned j = 0; j < 16; ++j) { const unsigned c = xb_ld(&bar[XB_XCNT(j)]); sum += c; cnt += (c > 0u) ? 1u : 0u; mine = (j == x) ? c : mine; }
    if (sum == G) break;
    __builtin_amdgcn_s_sleep(1);
    if ((++sp & 255u) == 0u) { if (xb_ld(&bar[XB_TMO])) break; if (sp > XB_SPIN_CAP) { atomicAdd(&bar[XB_TMO], 1u); break; } }
  }
  nloc = mine > 0u ? mine : 1u; nx = cnt > 0u ? cnt : 1u;
}
DI void xcd_barrier(unsigned* barp, char* stp) {
  asm volatile("s_waitcnt vmcnt(0)" ::: "memory");
  __syncthreads();
  if (threadIdx.x == 0) {
    XcdBarrier b; b.bar = barp; b.x = xb_xcc_id(); b.st = (volatile LAS unsigned*)stp;
    unsigned* bar = b.bar;
    __builtin_amdgcn_s_waitcnt(0);
    unsigned nloc = b.st[0], nx = b.st[1];
    if (nloc == 0u) { xcd_barrier_complete(bar, b.x, nloc, nx); b.st[0] = nloc; b.st[1] = nx; }
    const unsigned old = xb_add(&bar[XB_XSUB(b.x)], 1u);
    const unsigned gen = old / nloc;
    if (old + 1u == (gen + 1u) * nloc) {
      __builtin_amdgcn_fence(__ATOMIC_RELEASE, "agent");
      asm volatile("s_waitcnt vmcnt(0)" ::: "memory");
      const unsigned og = xb_add(&bar[XB_TOP], 1u);
      const unsigned tg = og / nx;
      if (og + 1u == (tg + 1u) * nx) xb_add(&bar[XB_TOPGEN], 1u);
      else XB_SPIN(xb_ld(&bar[XB_TOPGEN]) == tg, bar);
      __builtin_amdgcn_fence(__ATOMIC_ACQUIRE, "agent");
      xb_add(&bar[XB_XGEN(b.x)], 1u);
      asm volatile("s_waitcnt vmcnt(0)" ::: "memory");
    } else {
      XB_SPIN(xb_ld(&bar[XB_XGEN(b.x)]) == gen, bar);
      __builtin_amdgcn_fence(__ATOMIC_ACQUIRE, "agent");
      asm volatile("s_waitcnt vmcnt(0)" ::: "memory");
    }
  }
  __syncthreads();
}

constexpr int SMEM_BYTES = 143360;
__global__ void __launch_bounds__(NT) fwd_megakernel(P p) {
  __shared__ __attribute__((aligned(16))) char smem[SMEM_BYTES + 16];
  if (threadIdx.x < 4) ((volatile LAS unsigned*)(smem + SMEM_BYTES))[threadIdx.x] = 0u;
  __syncthreads();
  (void)xcd_barrier_post((unsigned*)(p.ws + OFF_BAR), (volatile LAS unsigned*)(smem + SMEM_BYTES));
  phase_ada(p, smem);
  xcd_barrier((unsigned*)(p.ws + OFF_BAR), smem + SMEM_BYTES);
  phase_u1(p);
  phase_transposes(p, smem);
  phase_keys(p);
  phase_rope(p);
  phase_filter(p, smem);
  xcd_barrier((unsigned*)(p.ws + OFF_BAR), smem + SMEM_BYTES);
  phase_inproj(p, smem);
  xcd_barrier((unsigned*)(p.ws + OFF_BAR), smem + SMEM_BYTES);
  for (int item = blockIdx.x; item < 512 + 256; item += gridDim.x) {
    if (item < 512) hyena_item(p, smem, item);
    else attn_item(p, smem, item - 512);
  }
  xcd_barrier((unsigned*)(p.ws + OFF_BAR), smem + SMEM_BYTES);
  phase_yh_transpose(p, smem);
  xcd_barrier((unsigned*)(p.ws + OFF_BAR), smem + SMEM_BYTES);
  phase_merge(p, smem);
  xcd_barrier((unsigned*)(p.ws + OFF_BAR), smem + SMEM_BYTES);
  phase_outproj(p, smem);
  xcd_barrier((unsigned*)(p.ws + OFF_BAR), smem + SMEM_BYTES);
  phase_ln1(p);
  phase_tabconv(p);
  xcd_barrier((unsigned*)(p.ws + OFF_BAR), smem + SMEM_BYTES);
  phase_route(p, smem);
  xcd_barrier((unsigned*)(p.ws + OFF_BAR), smem + SMEM_BYTES);
  phase_upass(p, smem);
  xcd_barrier((unsigned*)(p.ws + OFF_BAR), smem + SMEM_BYTES);
  phase_vpass(p);
  xcd_barrier((unsigned*)(p.ws + OFF_BAR), smem + SMEM_BYTES);
  phase_ln2(p);
}

extern "C" void kernel_launch(void* const* d_in, const int* in_sizes, int n_in, void* d_out, int out_size, void* d_ws, size_t ws_size,
                              hipStream_t stream) {
  P p{};
  p.x = (const float*)d_in[0]; p.c = (const float*)d_in[1]; p.pos = (const int*)d_in[2];
  p.w_ada = (const float*)d_in[3]; p.b_ada = (const float*)d_in[4]; p.w_in = (const float*)d_in[5];
  p.hy_conv_w = (const float*)d_in[6]; p.hy_conv_b = (const float*)d_in[7];
  p.f1_w = (const float*)d_in[8]; p.f1_b = (const float*)d_in[9]; p.f1_freq = (const float*)d_in[10];
  p.f2_w = (const float*)d_in[11]; p.f2_b = (const float*)d_in[12]; p.f2_freq = (const float*)d_in[13];
  p.f3_w = (const float*)d_in[14]; p.hy_bias = (const float*)d_in[15];
  p.w_bh = (const float*)d_in[16]; p.w_ba = (const float*)d_in[17]; p.w_out = (const float*)d_in[18];
  p.ln1_g = (const float*)d_in[19]; p.ln1_b = (const float*)d_in[20];
  p.wq = (const float*)d_in[21]; p.keys = (const float*)d_in[22]; p.pu = (const float*)d_in[23]; p.pv = (const float*)d_in[24];
  p.ln2_g = (const float*)d_in[25]; p.ln2_b = (const float*)d_in[26];
  p.out = (float*)d_out; p.ws = (char*)d_ws;

  static int grid_blocks = 0;
  if (!grid_blocks) {
    int dev = 0, cus = 0, per_cu = 0;
    hipGetDevice(&dev);
    hipDeviceGetAttribute(&cus, hipDeviceAttributeMultiprocessorCount, dev);
    hipOccupancyMaxActiveBlocksPerMultiprocessor(&per_cu, fwd_megakernel, NT, 0);
    if (per_cu > 1) per_cu = 1;
    grid_blocks = cus * per_cu;
  }
  (void)hipMemsetAsync((char*)d_ws + OFF_BAR, 0, XCD_BAR_WORDS * 4, stream);
  void* args[] = {&p};
  hipError_t e = hipLaunchCooperativeKernel((void*)fwd_megakernel, dim3(grid_blocks), dim3(NT), args, 0, stream);
  if (e != hipSuccess) fprintf(stderr, "cooperative launch failed: %s (grid %d)\n", hipGetErrorString(e), grid_blocks);
}
```

```cpp
#include <hip/hip_runtime.h>
#include <hip/hip_cooperative_groups.h>
#include <cstdio>
#include <cstdint>

#define DI __device__ __forceinline__
typedef unsigned short ushort_t;
typedef __attribute__((ext_vector_type(8))) short bf16x8;
typedef __attribute__((ext_vector_type(16))) float f32x16;
typedef __attribute__((ext_vector_type(4))) float f32x4;
typedef __attribute__((ext_vector_type(4))) unsigned u32x4;

constexpr int T_ = 16384, S_ = 8192, NB = 2, D_ = 1024;
constexpr int HW_ = 512, HYC = 1536, QKVC = 2304, GATEC = 2048, INW = 5888;
constexpr int NT = 512;
constexpr float DN_ALPHA = 1.189207115002721f;
constexpr float LN_EPS = 1e-5f;

constexpr size_t OFF_ADA   = 0;
constexpr size_t OFF_BAR   = 49152;
constexpr size_t OFF_KEYS_B= 65536;
constexpr size_t OFF_WIN_T = 65536 + 524288;
constexpr size_t OFF_WQ_T  = OFF_WIN_T + (size_t)INW * 1024 * 2;
constexpr size_t OFF_WOUT_T= OFF_WQ_T + (size_t)2048 * 1024 * 2;
constexpr size_t OFF_WBH_T = OFF_WOUT_T + (size_t)1024 * 1024 * 2;
constexpr size_t OFF_WBA_T = OFF_WBH_T + (size_t)1024 * 512 * 2;
constexpr size_t OFF_PH    = OFF_WBA_T + (size_t)1024 * 256 * 2;
constexpr size_t OFF_QKV   = OFF_PH + (size_t)T_ * HYC * 2;
constexpr size_t OFF_GATE  = OFF_QKV + (size_t)T_ * QKVC * 2;
constexpr size_t OFF_YH    = OFF_GATE + (size_t)T_ * GATEC * 2;
constexpr size_t OFF_YA    = OFF_YH + (size_t)T_ * HW_ * 2;
constexpr size_t OFF_END   = OFF_YA + (size_t)T_ * 256 * 2;
constexpr size_t OFF_MERGED= OFF_PH;
constexpr size_t OFF_YHK   = OFF_PH + (size_t)32 * 1048576;
constexpr size_t OFF_U1B   = OFF_YH;
static_assert(OFF_U1B + (size_t)T_ * 1024 * 2 <= 268435456ull, "u1b overflow");
constexpr size_t OFF_U2B   = OFF_PH;
constexpr size_t OFF_TABU  = OFF_QKV;
constexpr size_t OFF_TABV  = OFF_QKV + (size_t)16 * 1048576;
constexpr size_t OFF_SU    = OFF_QKV + (size_t)32 * 1048576;
constexpr size_t OFF_SV    = OFF_SU + 65536;
constexpr size_t OFF_COEF  = OFF_QKV + (size_t)64 * 1048576;
constexpr size_t OFF_F     = OFF_QKV + (size_t)72 * 1048576;
static_assert(OFF_F + (size_t)64 * 1048576 <= OFF_YH, "peer buffers overflow the qkv+gate region");
constexpr size_t OFF_IDX   = OFF_YH;
constexpr size_t OFF_GV    = OFF_YH + (size_t)T_ * 128 * 4;
constexpr size_t OFF_HSCR  = OFF_END;
static_assert(OFF_HSCR + (size_t)164 * 131072 <= 268435456ull, "ws overflow");
static_assert((size_t)92 * 131072 <= (size_t)INW * 1024 * 2, "w_in^T region too small");
constexpr size_t OFF_ROPE  = OFF_HSCR + (size_t)164 * 131072;
static_assert(OFF_ROPE + (size_t)T_ * 64 <= 268435456ull, "rope table overflow");

struct P {
  const float *x, *c; const int* pos;
  const float *w_ada, *b_ada, *w_in, *hy_conv_w, *hy_conv_b, *f1_w, *f1_b, *f1_freq, *f2_w, *f2_b, *f2_freq, *f3_w,
      *hy_bias, *w_bh, *w_ba, *w_out, *ln1_g, *ln1_b, *wq, *keys, *pu, *pv, *ln2_g, *ln2_b;
  float* out; char* ws;
};

DI ushort_t f2bf(float x) { unsigned u = __float_as_uint(x); u += 0x7fffu + ((u >> 16) & 1u); return (ushort_t)(u >> 16); }
DI float bf2f(ushort_t h) { return __uint_as_float(((unsigned)h) << 16); }
typedef __bf16 bf16x2_hw __attribute__((ext_vector_type(2)));
typedef float f32x2_hw __attribute__((ext_vector_type(2)));
DI unsigned pack2(float a, float b) { f32x2_hw v = {a, b}; return __builtin_bit_cast(unsigned, __builtin_convertvector(v, bf16x2_hw)); }
DI int tid_opaque() { int t = threadIdx.x; asm volatile("" : "+v"(t)); return t; }
DI float wave_sum(float v) {
#pragma unroll
  for (int o = 32; o > 0; o >>= 1) v += __shfl_xor(v, o);
  return v;
}

struct cf2 { float x, y; };
constexpr int FFT_N = 16384, FFT_SA = 560;

DI constexpr float wcos32(int j) {
  switch (j & 31) {
    case 0: return 1.0f; case 1: return 0.98078528040323043f; case 2: return 0.92387953251128674f; case 3: return 0.83146961230254524f;
    case 4: return 0.70710678118654752f; case 5: return 0.55557023301960218f; case 6: return 0.38268343236508978f; case 7: return 0.19509032201612825f;
    case 8: return 0.0f; case 9: return -0.19509032201612825f; case 10: return -0.38268343236508978f; case 11: return -0.55557023301960218f;
    case 12: return -0.70710678118654752f; case 13: return -0.83146961230254524f; case 14: return -0.92387953251128674f; case 15: return -0.98078528040323043f;
    case 16: return -1.0f; case 17: return -0.98078528040323043f; case 18: return -0.92387953251128674f; case 19: return -0.83146961230254524f;
    case 20: return -0.70710678118654752f; case 21: return -0.55557023301960218f; case 22: return -0.38268343236508978f; case 23: return -0.19509032201612825f;
    case 24: return 0.0f; case 25: return 0.19509032201612825f; case 26: return 0.38268343236508978f; case 27: return 0.55557023301960218f;
    case 28: return 0.70710678118654752f; case 29: return 0.83146961230254524f; case 30: return 0.92387953251128674f; default: return 0.98078528040323043f;
  }
}
DI constexpr float wsin32(int j) { return wcos32(j + 24); }
DI constexpr int brev(int v, int bits) { int r = 0; for (int i = 0; i < bits; ++i) r |= ((v >> i) & 1) << (bits - 1 - i); return r; }

template <int R, int LEN, bool INV, bool ZHI>
DI void r2_stage(float (&re)[R], float (&im)[R]) {
  constexpr int half = LEN / 2;
#pragma unroll
  for (int start = 0; start < R; start += LEN) {
#pragma unroll
    for (int j = 0; j < half; ++j) {
      const int a = start + j, b = a + half;
      const int tj = j * (32 / LEN);
      const float c = wcos32(tj), s = wsin32(tj);
      if (!INV) {
        float dr, di;
        if (ZHI) { dr = re[a]; di = im[a]; }
        else {
          const float ar = re[a], ai = im[a], br = re[b], bi = im[b];
          re[a] = ar + br; im[a] = ai + bi; dr = ar - br; di = ai - bi;
        }
        if (tj == 0) { re[b] = dr; im[b] = di; }
        else if (tj == 8) { re[b] = di; im[b] = -dr; }
        else { re[b] = dr * c + di * s; im[b] = di * c - dr * s; }
      } else {
        const float br = re[b], bi = im[b];
        float pr, pi;
        if (tj == 0) { pr = br; pi = bi; }
        else if (tj == 8) { pr = -bi; pi = br; }
        else { pr = br * c - bi * s; pi = bi * c + br * s; }
        const float ar = re[a], ai = im[a];
        re[a] = ar + pr; im[a] = ai + pi; re[b] = ar - pr; im[b] = ai - pi;
      }
    }
  }
}
template <int R, bool ZHI> DI void dft_fwd(float (&re)[R], float (&im)[R]) {
  if (R == 32) r2_stage<R, (R == 32 ? 32 : 2), false, ZHI>(re, im);
  r2_stage<R, 16, false, (R == 16) && ZHI>(re, im);
  r2_stage<R, 8, false, false>(re, im);
  r2_stage<R, 4, false, false>(re, im);
  r2_stage<R, 2, false, false>(re, im);
}
template <int R> DI void dft_inv(float (&re)[R], float (&im)[R]) {
  r2_stage<R, 2, true, false>(re, im);
  r2_stage<R, 4, true, false>(re, im);
  r2_stage<R, 8, true, false>(re, im);
  r2_stage<R, 16, true, false>(re, im);
  if (R == 32) r2_stage<R, (R == 32 ? 32 : 2), true, false>(re, im);
}

DI void sincos_turn(float frac, float& s, float& c) { sincospif(2.0f * frac, &s, &c); }

template <bool ZHI>
DI void fft_fwdA(float (&re)[32], float (&im)[32], cf2* lds, int m) {
  asm volatile("" : "+v"(m));
  float s1, c1; sincos_turn((float)m * (1.0f / 16384.0f), s1, c1);
  __builtin_amdgcn_sched_barrier(0);
  dft_fwd<32, ZHI>(re, im);
  __builtin_amdgcn_sched_barrier(0);
  float wr = 1.f, wi = 0.f;
#pragma unroll
  for (int k1 = 0; k1 < 32; ++k1) {
    if ((k1 & 3) == 0) __builtin_amdgcn_sched_barrier(0);
    const int r = brev(k1, 5);
    cf2 o; o.x = re[r] * wr - im[r] * wi; o.y = re[r] * wi + im[r] * wr;
    lds[k1 * FFT_SA + m] = o;
    const float nr = wr * c1 + wi * s1, ni = wi * c1 - wr * s1;
    wr = nr; wi = ni;
  }
}
DI void fft_B_read(float (&re)[32], float (&im)[32], const cf2* lds, int tid) {
  const int k1 = tid >> 4, mp = tid & 15;
#pragma unroll
  for (int n2 = 0; n2 < 32; ++n2) { cf2 v = lds[k1 * FFT_SA + n2 * 16 + mp]; re[n2] = v.x; im[n2] = v.y; }
}
DI void fft_fwdB_write(float (&re)[32], float (&im)[32], cf2* lds, int tid) {
  asm volatile("" : "+v"(tid));
  const int k1 = tid >> 4, mp = tid & 15;
  float s1, c1; sincos_turn((float)mp * (1.0f / 512.0f), s1, c1);
  __builtin_amdgcn_sched_barrier(0);
  dft_fwd<32, false>(re, im);
  __builtin_amdgcn_sched_barrier(0);
  float wr = 1.f, wi = 0.f;
#pragma unroll
  for (int k2 = 0; k2 < 32; ++k2) {
    if ((k2 & 3) == 0) __builtin_amdgcn_sched_barrier(0);
    const int r = brev(k2, 5);
    cf2 o; o.x = re[r] * wr - im[r] * wi; o.y = re[r] * wi + im[r] * wr;
    lds[k1 * FFT_SA + k2 * 17 + mp] = o;
    const float nr = wr * c1 + wi * s1, ni = wi * c1 - wr * s1;
    wr = nr; wi = ni;
  }
}
DI void fft_fwdC(float (&re)[32], float (&im)[32], const cf2* lds, int tid) {
  const int k1 = tid >> 5, k2 = tid & 31;
#pragma unroll
  for (int h = 0; h < 2; ++h) {
    float tr[16], ti[16];
#pragma unroll
    for (int mp = 0; mp < 16; ++mp) { cf2 v = lds[(k1 + 16 * h) * FFT_SA + k2 * 17 + mp]; tr[mp] = v.x; ti[mp] = v.y; }
    dft_fwd<16, false>(tr, ti);
#pragma unroll
    for (int i = 0; i < 16; ++i) { re[h * 16 + i] = tr[i]; im[h * 16 + i] = ti[i]; }
  }
}
DI void fft_invC(float (&re)[32], float (&im)[32], cf2* lds, int tid) {
  const int k1 = tid >> 5, k2 = tid & 31;
#pragma unroll
  for (int h = 0; h < 2; ++h) {
    float tr[16], ti[16];
#pragma unroll
    for (int i = 0; i < 16; ++i) { tr[i] = re[h * 16 + i]; ti[i] = im[h * 16 + i]; }
    dft_inv<16>(tr, ti);
#pragma unroll
    for (int mp = 0; mp < 16; ++mp) { cf2 o; o.x = tr[mp]; o.y = ti[mp]; lds[(k1 + 16 * h) * FFT_SA + k2 * 17 + mp] = o; }
  }
}
DI void fft_invB_read(float (&re)[32], float (&im)[32], const cf2* lds, int tid) {
  asm volatile("" : "+v"(tid));
  const int k1 = tid >> 4, mp = tid & 15;
  float s1, c1; sincos_turn((float)mp * (1.0f / 512.0f), s1, c1);
  float wr = 1.f, wi = 0.f;
  __builtin_amdgcn_sched_barrier(0);
#pragma unroll
  for (int k2 = 0; k2 < 32; ++k2) {
    if ((k2 & 3) == 0) __builtin_amdgcn_sched_barrier(0);
    const int r = brev(k2, 5);
    cf2 v = lds[k1 * FFT_SA + k2 * 17 + mp];
    re[r] = v.x * wr - v.y * wi; im[r] = v.x * wi + v.y * wr;
    const float nr = wr * c1 - wi * s1, ni = wi * c1 + wr * s1;
    wr = nr; wi = ni;
  }
}
DI void fft_invB_write(float (&re)[32], float (&im)[32], cf2* lds, int tid) {
  const int k1 = tid >> 4, mp = tid & 15;
  dft_inv<32>(re, im);
#pragma unroll
  for (int n2 = 0; n2 < 32; ++n2) { cf2 o; o.x = re[n2]; o.y = im[n2]; lds[k1 * FFT_SA + n2 * 16 + mp] = o; }
}
DI void fft_invA(float (&re)[32], float (&im)[32], const cf2* lds, int m) {
  asm volatile("" : "+v"(m));
  float s1, c1; sincos_turn((float)m * (1.0f / 16384.0f), s1, c1);
  float wr = 1.f, wi = 0.f;
  __builtin_amdgcn_sched_barrier(0);
#pragma unroll
  for (int k1 = 0; k1 < 32; ++k1) {
    if ((k1 & 3) == 0) __builtin_amdgcn_sched_barrier(0);
    const int r = brev(k1, 5);
    cf2 v = lds[k1 * FFT_SA + m];
    re[r] = v.x * wr - v.y * wi; im[r] = v.x * wi + v.y * wr;
    const float nr = wr * c1 - wi * s1, ni = wi * c1 + wr * s1;
    wr = nr; wi = ni;
  }
  __builtin_amdgcn_sched_barrier(0);
  dft_inv<32>(re, im);
}

DI void phase_ada(const P& p, char* smem) {
  float (*red)[16][32] = (float (*)[16][32])smem;
  const int tid = tid_opaque(), cl = tid & 31, kq = tid >> 5;
  for (int item = blockIdx.x; item < 192; item += gridDim.x) {
    const int col = item * 32 + cl;
    float a0 = 0.f, a1 = 0.f;
#pragma unroll 16
    for (int k = kq * 64; k < kq * 64 + 64; ++k) {
      const float w = p.w_ada[(size_t)k * 6144 + col];
      const float c0 = p.c[k], c1 = p.c[1024 + k];
      a0 += (c0 / (1.f + __expf(-c0))) * w;
      a1 += (c1 / (1.f + __expf(-c1))) * w;
    }
    __syncthreads();
    red[0][kq][cl] = a0; red[1][kq][cl] = a1;
    __syncthreads();
    if (tid < 64) {
      const int b = tid >> 5;
      float s = p.b_ada[col];
#pragma unroll
      for (int q = 0; q < 16; ++q) s += red[b][q][cl];
      ((float*)(p.ws + OFF_ADA))[b * 6144 + col] = s;
    }
  }
}
DI void phase_u1(const P& p) {
  const float* ada = (const float*)(p.ws + OFF_ADA);
  ushort_t* u1b = (ushort_t*)(p.ws + OFF_U1B);
  for (int i = blockIdx.x * NT + tid_opaque(); i < T_ * 128; i += gridDim.x * NT) {
    const int row = i >> 7, k = (i & 127) * 8, b = row / S_;
    const float* xp = p.x + (size_t)row * 1024 + k;
    const f32x4 x0 = *(const f32x4*)xp, x1 = *(const f32x4*)(xp + 4);
    const f32x4 s0 = *(const f32x4*)(ada + b * 6144 + 1024 + k), s1 = *(const f32x4*)(ada + b * 6144 + 1024 + k + 4);
    const f32x4 h0 = *(const f32x4*)(ada + b * 6144 + k), h1 = *(const f32x4*)(ada + b * 6144 + k + 4);
    u32x4 o;
    o[0] = pack2(x0[0] * (1.f + s0[0]) + h0[0], x0[1] * (1.f + s0[1]) + h0[1]);
    o[1] = pack2(x0[2] * (1.f + s0[2]) + h0[2], x0[3] * (1.f + s0[3]) + h0[3]);
    o[2] = pack2(x1[0] * (1.f + s1[0]) + h1[0], x1[1] * (1.f + s1[1]) + h1[1]);
    o[3] = pack2(x1[2] * (1.f + s1[2]) + h1[2], x1[3] * (1.f + s1[3]) + h1[3]);
    *(u32x4*)(u1b + (size_t)row * 1024 + k) = o;
  }
}

DI void transpose_tile(const float* __restrict__ W, ushort_t* __restrict__ Wt, int K, int N, int item, char* smem) {
  float (*tile)[65] = (float (*)[65])smem;
  const int ntn = N / 64;
  const int n0 = (item % ntn) * 64, k0 = (item / ntn) * 32;
  const int tid = tid_opaque();
  __syncthreads();
  {
    const int tx = tid & 63, ty = tid >> 6;
#pragma unroll
    for (int i = 0; i < 4; ++i) tile[ty + 8 * i][tx] = W[(size_t)(k0 + ty + 8 * i) * N + n0 + tx];
  }
  __syncthreads();
  {
    const int kk = tid & 31, nn0 = tid >> 5;
#pragma unroll
    for (int i = 0; i < 4; ++i) Wt[(size_t)(n0 + nn0 + 16 * i) * K + k0 + kk] = f2bf(tile[kk][nn0 + 16 * i]);
  }
}
DI void phase_transposes(const P& p, char* smem) {
  constexpr int I0 = (INW / 64) * 32, I1 = I0 + 32 * 32, I2 = I1 + 16 * 32, I3 = I2 + 16 * 16, I4 = I3 + 16 * 8;
  for (int item = blockIdx.x; item < I4; item += gridDim.x) {
    if (item < I0) transpose_tile(p.w_in, (ushort_t*)(p.ws + OFF_WIN_T), 1024, INW, item, smem);
    else if (item < I1) transpose_tile(p.wq, (ushort_t*)(p.ws + OFF_WQ_T), 1024, 2048, item - I0, smem);
    else if (item < I2) transpose_tile(p.w_out, (ushort_t*)(p.ws + OFF_WOUT_T), 1024, 1024, item - I1, smem);
    else if (item < I3) transpose_tile(p.w_bh, (ushort_t*)(p.ws + OFF_WBH_T), 512, 1024, item - I2, smem);
    else transpose_tile(p.w_ba, (ushort_t*)(p.ws + OFF_WBA_T), 256, 1024, item - I3, smem);
  }
}

DI void phase_filter(const P& p, char* smem) {
  float (*zf)[33] = (float (*)[33])smem;
  float (*h1)[64] = (float (*)[64])(smem + 4352);
  float (*h2)[65] = (float (*)[65])(smem + 4352 + 8192);
  float* w1s = (float*)(smem + 32768);
  float* w2s = (float*)(smem + 32768 + 8448);
  const int tid = tid_opaque(), lane = tid & 63, wave = tid >> 6;
  __syncthreads();
  for (int i = tid; i < 33 * 64; i += NT) w1s[i] = p.f1_w[i];
  for (int i = tid; i < 64 * 64; i += NT) w2s[i] = p.f2_w[i];
  for (int item = blockIdx.x; item < 256; item += gridDim.x) {
  const int t0 = item * 32;
  __syncthreads();
  for (int idx = tid; idx < 32 * 33; idx += NT) {
    int tt = idx / 33, e = idx % 33, t = t0 + tt;
    float tl = (float)t * (1.0f / 8191.0f);
    float w = 6.283185307179586f * (float)t / 8192.0f;
    float val;
    if (e == 0) val = tl;
    else {
      int i = (e - 1) & 15;
      float f = 1e-4f + (float)i * ((15.0f - 1e-4f) / 15.0f);
      val = (e <= 16) ? cosf(f * w) : -sinf(f * w);
    }
    zf[tt][e] = val;
  }
  __syncthreads();
  for (int idx = tid; idx < 32 * 64; idx += NT) {
    int tt = idx >> 6, j = idx & 63;
    float a = p.f1_b[j];
#pragma unroll
    for (int e = 0; e < 33; ++e) a += zf[tt][e] * w1s[e * 64 + j];
    h1[tt][j] = sinf(p.f1_freq[j] * a);
  }
  __syncthreads();
  for (int idx = tid; idx < 32 * 64; idx += NT) {
    int tt = idx >> 6, j = idx & 63;
    float a = p.f2_b[j];
#pragma unroll
    for (int e = 0; e < 64; ++e) a += h1[tt][e] * w2s[e * 64 + j];
    h2[tt][j] = sinf(p.f2_freq[j] * a);
  }
  __syncthreads();
  float* filt = p.out;
  const float min_decay = -3.0701134573253945f, max_decay = -15.350567286626973f;
  float af[32];
#pragma unroll
  for (int s = 0; s < 32; ++s) af[s] = h2[lane & 31][2 * s + (lane >> 5)];
#pragma unroll 1
  for (int ci = 0; ci < 8; ++ci) {
    const int col = (wave + 8 * ci) * 32 + (lane & 31);
    const float* wp = p.f3_w + (size_t)(lane >> 5) * 2048 + col;
    float bfv[32];
#pragma unroll
    for (int s = 0; s < 32; ++s) bfv[s] = wp[(size_t)s * 4096];
    f32x16 acc;
#pragma unroll
    for (int r = 0; r < 16; ++r) acc[r] = 0.f;
#pragma unroll
    for (int s = 0; s < 32; ++s) acc = __builtin_amdgcn_mfma_f32_32x32x2f32(af[s], bfv[s], acc, 0, 0, 0);
    const float delta = fabsf(min_decay + (float)(col & 511) * ((max_decay - min_decay) / 511.0f));
    float* dst = filt + (size_t)col * 8192 + t0 + 4 * (lane >> 5);
#pragma unroll
    for (int q = 0; q < 4; ++q) {
      f32x4 o;
#pragma unroll
      for (int r = 0; r < 4; ++r) {
        const float tl = (float)(t0 + 8 * q + 4 * (lane >> 5) + r) * (1.0f / 8191.0f);
        o[r] = acc[4 * q + r] * __expf(-tl * delta);
      }
      *(f32x4*)(dst + 8 * q) = o;
    }
  }
  }
}

constexpr int BM = 256, BN = 128, BK = 64;
constexpr int LDS_A = BM * BK * 2, LDS_B = BN * BK * 2, LDS_STAGE = LDS_A + LDS_B;
constexpr int GEMM_LDS = 2 * LDS_STAGE + 8192;

DI int swz(int row, int ch) { return row * 128 + ((ch ^ (row & 7)) << 4); }

struct ALoadBf16 {
  const ushort_t* A; int lda;
  struct Raw { u32x4 v; };
  DI Raw fetch(int row, int k) const { Raw r; r.v = *(const u32x4*)(A + (size_t)row * lda + k); return r; }
  DI u32x4 cvt(const Raw& r, int k) const { return r.v; }
};
struct ALoadF32Mod {
  const float* A; const float* mod;
  struct Raw { f32x4 a, b; };
  DI Raw fetch(int row, int k) const { Raw r; const float* s = A + (size_t)row * 1024 + k; r.a = *(const f32x4*)s; r.b = *(const f32x4*)(s + 4); return r; }
  DI u32x4 cvt(const Raw& r, int k) const {
    f32x4 s0 = *(const f32x4*)(mod + k), s1 = *(const f32x4*)(mod + k + 4);
    f32x4 h0 = *(const f32x4*)(mod + 1024 + k), h1 = *(const f32x4*)(mod + 1024 + k + 4);
    u32x4 o;
    o[0] = pack2(r.a[0] * s0[0] + h0[0], r.a[1] * s0[1] + h0[1]);
    o[1] = pack2(r.a[2] * s0[2] + h0[2], r.a[3] * s0[3] + h0[3]);
    o[2] = pack2(r.b[0] * s1[0] + h1[0], r.b[1] * s1[1] + h1[1]);
    o[3] = pack2(r.b[2] * s1[2] + h1[2], r.b[3] * s1[3] + h1[3]);
    return o;
  }
};

template <class AL, bool SWAP = false>
DI void gemm_mainloop(f32x16 (&acc)[2][2], const AL& al, int m0, const ushort_t* __restrict__ Bt, int ldb, int n0, int K, char* smem) {
  const int tid = tid_opaque(), lane = tid & 63, wave = tid >> 6;
  const int wm = wave >> 1, wn = wave & 1;
  const int lr = tid >> 3, lc = tid & 7;
  typename AL::Raw ra[4]; u32x4 rb[2];
  const int nk = K / BK;
#pragma unroll
  for (int i = 0; i < 4; ++i) ra[i] = al.fetch(m0 + lr + 64 * i, lc * 8);
#pragma unroll
  for (int i = 0; i < 2; ++i) rb[i] = *(const u32x4*)(Bt + (size_t)(n0 + lr + 64 * i) * ldb + lc * 8);
  __syncthreads();
#pragma unroll
  for (int i = 0; i < 4; ++i) *(u32x4*)(smem + swz(lr + 64 * i, lc)) = al.cvt(ra[i], lc * 8);
#pragma unroll
  for (int i = 0; i < 2; ++i) *(u32x4*)(smem + LDS_A + swz(lr + 64 * i, lc)) = rb[i];
  __syncthreads();
  for (int kt = 0; kt < nk; ++kt) {
    char* cur = smem + (kt & 1) * LDS_STAGE;
    char* nxt = smem + ((kt + 1) & 1) * LDS_STAGE;
    const bool more = (kt + 1 < nk);
    const int kn = (kt + 1) * BK + lc * 8;
    if (more) {
#pragma unroll
      for (int i = 0; i < 4; ++i) ra[i] = al.fetch(m0 + lr + 64 * i, kn);
#pragma unroll
      for (int i = 0; i < 2; ++i) rb[i] = *(const u32x4*)(Bt + (size_t)(n0 + lr + 64 * i) * ldb + kn);
    }
#pragma unroll
    for (int s = 0; s < 4; ++s) {
      const int ch = 2 * s + (lane >> 5);
      bf16x8 af[2], bfr[2];
#pragma unroll
      for (int mi = 0; mi < 2; ++mi) af[mi] = *(const bf16x8*)(cur + swz(wm * 64 + mi * 32 + (lane & 31), ch));
#pragma unroll
      for (int ni = 0; ni < 2; ++ni) bfr[ni] = *(const bf16x8*)(cur + LDS_A + swz(wn * 64 + ni * 32 + (lane & 31), ch));
#pragma unroll
      for (int mi = 0; mi < 2; ++mi)
#pragma unroll
        for (int ni = 0; ni < 2; ++ni)
          acc[mi][ni] = SWAP ? __builtin_amdgcn_mfma_f32_32x32x16_bf16(bfr[ni], af[mi], acc[mi][ni], 0, 0, 0)
                             : __builtin_amdgcn_mfma_f32_32x32x16_bf16(af[mi], bfr[ni], acc[mi][ni], 0, 0, 0);
    }
    if (more) {
#pragma unroll
      for (int i = 0; i < 4; ++i) *(u32x4*)(nxt + swz(lr + 64 * i, lc)) = al.cvt(ra[i], kn);
#pragma unroll
      for (int i = 0; i < 2; ++i) *(u32x4*)(nxt + LDS_A + swz(lr + 64 * i, lc)) = rb[i];
    }
    __syncthreads();
  }
}

constexpr int AT_ROW = 576;
constexpr int LDS_AT = 64 * AT_ROW;
constexpr int LDS_STAGE_T = LDS_AT + LDS_B;
typedef __attribute__((ext_vector_type(4))) short s16x4;
DI void gemm_mainloop_AT(f32x16 (&acc)[2][2], const ushort_t* __restrict__ At, size_t ldt, const ushort_t* __restrict__ Bt, int ldb, int n0, int K, char* smem) {
  const int tid = tid_opaque(), lane = tid & 63, wave = tid >> 6;
  const int wm = wave >> 1, wn = wave & 1;
  const int lr = tid >> 3, lc = tid & 7;
  u32x4 ra[4], rb[2];
  const int nk = K / BK;
#pragma unroll
  for (int i = 0; i < 4; ++i) { const int q = tid + 512 * i; ra[i] = *(const u32x4*)(At + (size_t)(q >> 5) * ldt + (q & 31) * 8); }
#pragma unroll
  for (int i = 0; i < 2; ++i) rb[i] = *(const u32x4*)(Bt + (size_t)(n0 + lr + 64 * i) * ldb + lc * 8);
  __syncthreads();
#pragma unroll
  for (int i = 0; i < 4; ++i) { const int q = tid + 512 * i; *(u32x4*)(smem + (q >> 5) * AT_ROW + (q & 31) * 16) = ra[i]; }
#pragma unroll
  for (int i = 0; i < 2; ++i) *(u32x4*)(smem + LDS_AT + swz(lr + 64 * i, lc)) = rb[i];
  __syncthreads();
  const int hh = lane >> 5, gg = (lane >> 4) & 1, qq = (lane & 15) >> 2, pp = lane & 3;
  for (int kt = 0; kt < nk; ++kt) {
    char* cur = smem + (kt & 1) * LDS_STAGE_T;
    char* nxt = smem + ((kt + 1) & 1) * LDS_STAGE_T;
    const bool more = (kt + 1 < nk);
    if (more) {
#pragma unroll
      for (int i = 0; i < 4; ++i) { const int q = tid + 512 * i; ra[i] = *(const u32x4*)(At + (size_t)((kt + 1) * BK + (q >> 5)) * ldt + (q & 31) * 8); }
#pragma unroll
      for (int i = 0; i < 2; ++i) rb[i] = *(const u32x4*)(Bt + (size_t)(n0 + lr + 64 * i) * ldb + (kt + 1) * BK + lc * 8);
    }
#pragma unroll
    for (int s = 0; s < 4; ++s) {
      const int ch = 2 * s + hh;
      bf16x8 af[2], bfr[2];
#pragma unroll
      for (int mi = 0; mi < 2; ++mi) {
        const char* a0 = cur + (16 * s + 8 * hh + qq) * AT_ROW + (wm * 64 + mi * 32 + 16 * gg + 4 * pp) * 2;
        s16x4 lo = __builtin_amdgcn_ds_read_tr16_b64_v4i16((__attribute__((address_space(3))) s16x4*)(a0));
        s16x4 hi = __builtin_amdgcn_ds_read_tr16_b64_v4i16((__attribute__((address_space(3))) s16x4*)(a0 + 4 * AT_ROW));
        af[mi] = __builtin_shufflevector(lo, hi, 0, 1, 2, 3, 4, 5, 6, 7);
      }
#pragma unroll
      for (int ni = 0; ni < 2; ++ni) bfr[ni] = *(const bf16x8*)(cur + LDS_AT + swz(wn * 64 + ni * 32 + (lane & 31), ch));
#pragma unroll
      for (int mi = 0; mi < 2; ++mi)
#pragma unroll
        for (int ni = 0; ni < 2; ++ni) acc[mi][ni] = __builtin_amdgcn_mfma_f32_32x32x16_bf16(af[mi], bfr[ni], acc[mi][ni], 0, 0, 0);
    }
    if (more) {
#pragma unroll
      for (int i = 0; i < 4; ++i) { const int q = tid + 512 * i; *(u32x4*)(nxt + (q >> 5) * AT_ROW + (q & 31) * 16) = ra[i]; }
#pragma unroll
      for (int i = 0; i < 2; ++i) *(u32x4*)(nxt + LDS_AT + swz(lr + 64 * i, lc)) = rb[i];
    }
    __syncthreads();
  }
}

constexpr int G2_A = 32768, G2_STAGE = 65536;
template <bool SWAP>
DI void gemm256(f32x16 (&acc)[4][2], const ushort_t* __restrict__ A, int lda, int m0, const ushort_t* __restrict__ Bt, int ldb, int n0, int K, char* smem) {
  const int tid = tid_opaque(), lane = tid & 63, wave = tid >> 6;
  const int wm = wave >> 2, wn = wave & 3;
  const int lr = tid >> 3, lc = tid & 7;
  u32x4 ra[4], rb[4];
  const int nk = K / BK;
  const ushort_t* ap = A + (size_t)(m0 + lr) * lda + lc * 8;
  const ushort_t* bp = Bt + (size_t)(n0 + lr) * ldb + lc * 8;
#pragma unroll
  for (int i = 0; i < 4; ++i) { ra[i] = *(const u32x4*)(ap + (size_t)(64 * i) * lda); rb[i] = *(const u32x4*)(bp + (size_t)(64 * i) * ldb); }
  __syncthreads();
#pragma unroll
  for (int i = 0; i < 4; ++i) { *(u32x4*)(smem + swz(lr + 64 * i, lc)) = ra[i]; *(u32x4*)(smem + G2_A + swz(lr + 64 * i, lc)) = rb[i]; }
  __syncthreads();
  for (int kt = 0; kt < nk; ++kt) {
    char* cur = smem + (kt & 1) * G2_STAGE;
    char* nxt = smem + ((kt + 1) & 1) * G2_STAGE;
    const bool more = (kt + 1 < nk);
    if (more) {
#pragma unroll
      for (int i = 0; i < 4; ++i) { ra[i] = *(const u32x4*)(ap + (size_t)(64 * i) * lda + (kt + 1) * BK); rb[i] = *(const u32x4*)(bp + (size_t)(64 * i) * ldb + (kt + 1) * BK); }
    }
#pragma unroll
    for (int s = 0; s < 4; ++s) {
      const int ch = 2 * s + (lane >> 5);
      bf16x8 af[4], bfr[2];
#pragma unroll
      for (int mi = 0; mi < 4; ++mi) af[mi] = *(const bf16x8*)(cur + swz(wm * 128 + mi * 32 + (lane & 31), ch));
#pragma unroll
      for (int ni = 0; ni < 2; ++ni) bfr[ni] = *(const bf16x8*)(cur + G2_A + swz(wn * 64 + ni * 32 + (lane & 31), ch));
#pragma unroll
      for (int mi = 0; mi < 4; ++mi)
#pragma unroll
        for (int ni = 0; ni < 2; ++ni)
          acc[mi][ni] = SWAP ? __builtin_amdgcn_mfma_f32_32x32x16_bf16(bfr[ni], af[mi], acc[mi][ni], 0, 0, 0)
                             : __builtin_amdgcn_mfma_f32_32x32x16_bf16(af[mi], bfr[ni], acc[mi][ni], 0, 0, 0);
      if (s & 1) __builtin_amdgcn_sched_barrier(0);
    }
    if (more) {
#pragma unroll
      for (int i = 0; i < 4; ++i) { *(u32x4*)(nxt + swz(lr + 64 * i, lc)) = ra[i]; *(u32x4*)(nxt + G2_A + swz(lr + 64 * i, lc)) = rb[i]; }
    }
    __syncthreads();
  }
}
constexpr int G2T_A = 64 * 576, G2T_STAGE = G2T_A + 32768;
DI void gemm256_AT(f32x16 (&acc)[4][2], const ushort_t* __restrict__ At, size_t ldt, const ushort_t* __restrict__ Bt, int ldb, int n0, int K, char* smem) {
  const int tid = tid_opaque(), lane = tid & 63, wave = tid >> 6;
  const int wm = wave >> 2, wn = wave & 3;
  const int lr = tid >> 3, lc = tid & 7;
  u32x4 ra[4], rb[4];
  const int nk = K / BK;
  const ushort_t* bp = Bt + (size_t)(n0 + lr) * ldb + lc * 8;
#pragma unroll
  for (int i = 0; i < 4; ++i) { const int q = tid + 512 * i; ra[i] = *(const u32x4*)(At + (size_t)(q >> 5) * ldt + (q & 31) * 8); rb[i] = *(const u32x4*)(bp + (size_t)(64 * i) * ldb); }
  __syncthreads();
#pragma unroll
  for (int i = 0; i < 4; ++i) { const int q = tid + 512 * i; *(u32x4*)(smem + (q >> 5) * 576 + (q & 31) * 16) = ra[i]; *(u32x4*)(smem + G2T_A + swz(lr + 64 * i, lc)) = rb[i]; }
  __syncthreads();
  const int hh = lane >> 5, gg = (lane >> 4) & 1, qq = (lane & 15) >> 2, pp = lane & 3;
  for (int kt = 0; kt < nk; ++kt) {
    char* cur = smem + (kt & 1) * G2T_STAGE;
    char* nxt = smem + ((kt + 1) & 1) * G2T_STAGE;
    const bool more = (kt + 1 < nk);
    if (more) {
#pragma unroll
      for (int i = 0; i < 4; ++i) { const int q = tid + 512 * i; ra[i] = *(const u32x4*)(At + (size_t)((kt + 1) * BK + (q >> 5)) * ldt + (q & 31) * 8); rb[i] = *(const u32x4*)(bp + (size_t)(64 * i) * ldb + (kt + 1) * BK); }
    }
#pragma unroll
    for (int s = 0; s < 4; ++s) {
      const int ch = 2 * s + hh;
      bf16x8 af[4], bfr[2];
#pragma unroll
      for (int mi = 0; mi < 4; ++mi) {
        const char* a0 = cur + (16 * s + 8 * hh + qq) * 576 + (wm * 128 + mi * 32 + 16 * gg + 4 * pp) * 2;
        s16x4 lo = __builtin_amdgcn_ds_read_tr16_b64_v4i16((__attribute__((address_space(3))) s16x4*)(a0));
        s16x4 hi = __builtin_amdgcn_ds_read_tr16_b64_v4i16((__attribute__((address_space(3))) s16x4*)(a0 + 4 * 576));
        af[mi] = __builtin_shufflevector(lo, hi, 0, 1, 2, 3, 4, 5, 6, 7);
      }
#pragma unroll
      for (int ni = 0; ni < 2; ++ni) bfr[ni] = *(const bf16x8*)(cur + G2T_A + swz(wn * 64 + ni * 32 + (lane & 31), ch));
#pragma unroll
      for (int mi = 0; mi < 4; ++mi)
#pragma unroll
        for (int ni = 0; ni < 2; ++ni) acc[mi][ni] = __builtin_amdgcn_mfma_f32_32x32x16_bf16(af[mi], bfr[ni], acc[mi][ni], 0, 0, 0);
      if (s & 1) __builtin_amdgcn_sched_barrier(0);
    }
    if (more) {
#pragma unroll
      for (int i = 0; i < 4; ++i) { const int q = tid + 512 * i; *(u32x4*)(nxt + (q >> 5) * 576 + (q & 31) * 16) = ra[i]; *(u32x4*)(nxt + G2T_A + swz(lr + 64 * i, lc)) = rb[i]; }
    }
    __syncthreads();
  }
}
DI void acc_zero4(f32x16 (&acc)[4][2]) {
#pragma unroll
  for (int a = 0; a < 4; ++a)
#pragma unroll
    for (int b = 0; b < 2; ++b)
#pragma unroll
      for (int r = 0; r < 16; ++r) acc[a][b][r] = 0.f;
}
DI void acc_zero(f32x16 (&acc)[2][2]) {
#pragma unroll
  for (int a = 0; a < 2; ++a)
#pragma unroll
    for (int b = 0; b < 2; ++b)
#pragma unroll
      for (int r = 0; r < 16; ++r) acc[a][b][r] = 0.f;
}
#define ACC_ROW(mi, r) (wm * 64 + (mi) * 32 + ((r) & 3) + 8 * ((r) >> 2) + 4 * (lane >> 5))
#define ACC_COL(ni) (wn * 64 + (ni) * 32 + (lane & 31))

DI void stage_mod(float* mod, const float* ada, int b, int sc_chunk, int sh_chunk) {
  for (int i = tid_opaque(); i < 1024; i += NT) {
    mod[i] = 1.f + ada[b * 6144 + sc_chunk * 1024 + i];
    mod[1024 + i] = ada[b * 6144 + sh_chunk * 1024 + i];
  }
}


namespace pg8 {
#define PG8_LAS __attribute__((address_space(3)))
constexpr int BM8 = 256, BK8 = 64, HALF = 128, HTB = HALF * BK8 * 2, STAGE_BYTES = 8 * HTB, NXCD = 8, WGM = 8;
DI int lds_byte(int r, int c) { const int st = (r >> 4) * 2 + (c >> 5), rr = r & 15, cc = c & 31, ob = rr * 64 + cc * 2; return st * 1024 + (ob ^ (((ob >> 9) & 1) << 5)); }
DI void stage_rc(int b, int& R, int& C) { const int st = b / 1024, sb = b % 1024, sw = sb ^ (((sb >> 9) & 1) << 5); R = (st >> 1) * 16 + sw / 64; C = (st & 1) * 32 + (sw % 64) / 2; }
DI int perm32(int rho) { const int n = rho >> 4, i = rho & 15; return 8 * (i >> 2) + 4 * n + (i & 3); }
struct Unit { int pm, pn, kind; };
DI void tile_order(int L, int nM, int nN, int& pm, int& pn) {
  const int nwg = nM * nN;
  int wgid = L; { const int q = nwg / NXCD, r = nwg % NXCD, xcd = wgid % NXCD, off = wgid / NXCD; wgid = (xcd < r ? xcd * (q + 1) : r * (q + 1) + (xcd - r) * q) + off; }
  const int nig = WGM * nN, gid = wgid / nig, fm = gid * WGM, gsz = (nM - fm) < WGM ? (nM - fm) : WGM;
  pm = fm + ((wgid % nig) % gsz); pn = (wgid % nig) / gsz;
}
typedef float f32x4p __attribute__((ext_vector_type(4)));
template <class Epi, class Sched>
DI void gemm_phase(PG8_LAS unsigned char* lds, const int K_, const Sched& S, const Epi& E) {
    int K = K_; asm volatile("" : "+s"(K));
    const int tid = tid_opaque();
    const int wid = __builtin_amdgcn_readfirstlane(tid >> 6), lane = tid & 63, wr = wid >> 2, wc = wid & 3, fr = lane & 15, fq = lane >> 4;
    const int nt = K / BK8;
    unsigned voffA[2], voffB[2];
#pragma unroll
    for (int i = 0; i < 2; ++i) { int R, C; stage_rc(tid * 16 + i * 8192, R, C); const int Rb = Epi::PERM ? ((R & ~31) + perm32(R & 31)) : R;
        voffA[i] = (unsigned)(R * K + C) * 2u; voffB[i] = (unsigned)(Rb * K + C) * 2u; }
    const size_t kstep = (size_t)(BK8 * 2);
    const size_t hstep = (size_t)HALF * K * 2;
    const unsigned ldsw = (unsigned)wid * 1024u;
    const int aoff = lds_byte(wr * 64 + fr, fq * 8), boff = lds_byte(wc * 32 + fr, fq * 8);
#define PG8_SA(b, h) (((b) * 2 + (h)) * HTB)
#define PG8_SB(b, h) ((4 + (b) * 2 + (h)) * HTB)
#define PG8_STAGE(bufoff, gbase, voff) do { _Pragma("unroll") for (int _i = 0; _i < 2; ++_i) \
        __builtin_amdgcn_global_load_lds((const unsigned*)((const char*)(gbase) + (voff)[_i]), (PG8_LAS unsigned*)(lds + (bufoff) + ldsw + _i * 8192), 16, 0, 0); } while (0)
#define PG8_LDA(dst, b, h) do { _Pragma("unroll") for (int m = 0; m < 4; ++m) _Pragma("unroll") for (int k = 0; k < 2; ++k) dst[m][k] = *(const PG8_LAS bf16x8*)(lds + PG8_SA(b, h) + aoff + m * 2048 + k * 1024); } while (0)
#define PG8_LDB(dst, b, h) do { _Pragma("unroll") for (int n = 0; n < 2; ++n) _Pragma("unroll") for (int k = 0; k < 2; ++k) dst[n][k] = *(const PG8_LAS bf16x8*)(lds + PG8_SB(b, h) + boff + n * 2048 + k * 1024); } while (0)
#define PG8_MMA(ai, bj, At, Bt) do { __builtin_amdgcn_s_setprio(1); _Pragma("unroll") for (int m = 0; m < 4; ++m) _Pragma("unroll") for (int n = 0; n < 2; ++n) _Pragma("unroll") for (int k = 0; k < 2; ++k) \
        acc[ai][bj][m][n] = __builtin_amdgcn_mfma_f32_16x16x32_bf16(Bt[n][k], At[m][k], acc[ai][bj][m][n], 0, 0, 0); __builtin_amdgcn_s_setprio(0); } while (0)
#define PG8_WAIT_V(n) asm volatile("s_waitcnt vmcnt(" #n ")" ::: "memory")
#define PG8_WAIT_L(n) asm volatile("s_waitcnt lgkmcnt(" #n ")" ::: "memory")
#define PG8_BAR __builtin_amdgcn_s_barrier()
#define PG8_SCHED __builtin_amdgcn_sched_barrier(0)
    Unit cur, nxt; int ui = 0;
    if (!S.next(0, cur)) return;
    f32x4p acc[2][2][4][2];
#pragma unroll
    for (int a = 0; a < 2; ++a)
#pragma unroll
        for (int b = 0; b < 2; ++b)
#pragma unroll
            for (int m = 0; m < 4; ++m)
#pragma unroll
                for (int n = 0; n < 2; ++n) acc[a][b][m][n] = (f32x4p){0.f, 0.f, 0.f, 0.f};
    bf16x8 At[4][2], B0[2][2], B1[2][2];
    const char* cA = S.a_ptr(cur); const char* cB = S.b_ptr(cur);
    PG8_STAGE(PG8_SB(0, 0), cB, voffB); PG8_STAGE(PG8_SA(0, 0), cA, voffA); PG8_STAGE(PG8_SB(0, 1), cB + hstep, voffB); PG8_STAGE(PG8_SA(0, 1), cA + hstep, voffA);
    if (wr == 1) PG8_BAR;
    PG8_WAIT_V(4); PG8_BAR;
    PG8_STAGE(PG8_SB(1, 0), cB + kstep, voffB); PG8_STAGE(PG8_SA(1, 0), cA + kstep, voffA); PG8_STAGE(PG8_SB(1, 1), cB + hstep + kstep, voffB);
    PG8_WAIT_V(6); PG8_BAR;
    for (;;) {
        const bool has_next = S.next(ui + 1, nxt);
        const char* nA = has_next ? S.a_ptr(nxt) : cA; const char* nB = has_next ? S.b_ptr(nxt) : cB;
        for (int t = 0; t < nt; t += 2) {
            const bool last = (t == nt - 2);
            const char* a1 = cA + (size_t)(t + 1) * kstep;
            const char* a2 = last ? nA : cA + (size_t)(t + 2) * kstep; const char* b2 = last ? nB : cB + (size_t)(t + 2) * kstep;
            const char* a3 = a2 + kstep; const char* b3 = b2 + kstep;
            PG8_LDB(B0, 0, 0); PG8_SCHED; PG8_LDA(At, 0, 0); PG8_STAGE(PG8_SA(1, 1), a1 + hstep, voffA);
            PG8_WAIT_L(8); PG8_BAR; PG8_WAIT_L(0); PG8_MMA(0, 0, At, B0); PG8_BAR; PG8_SCHED;
            PG8_LDB(B1, 0, 1); PG8_STAGE(PG8_SB(0, 0), b2, voffB);
            PG8_BAR; PG8_WAIT_L(0); PG8_MMA(0, 1, At, B1); PG8_BAR;
            PG8_LDA(At, 0, 1); PG8_STAGE(PG8_SA(0, 0), a2, voffA);
            PG8_BAR; PG8_WAIT_L(0); PG8_MMA(1, 0, At, B0); PG8_BAR; PG8_SCHED;
            PG8_STAGE(PG8_SB(0, 1), b2 + hstep, voffB);
            PG8_WAIT_V(6); PG8_BAR; PG8_MMA(1, 1, At, B1); PG8_BAR;
            PG8_LDB(B0, 1, 0); PG8_SCHED; PG8_LDA(At, 1, 0); PG8_STAGE(PG8_SA(0, 1), a2 + hstep, voffA);
            PG8_WAIT_L(8); PG8_BAR; PG8_WAIT_L(0); PG8_MMA(0, 0, At, B0); PG8_BAR; PG8_SCHED;
            PG8_LDB(B1, 1, 1); PG8_STAGE(PG8_SB(1, 0), b3, voffB);
            PG8_BAR; PG8_WAIT_L(0); PG8_MMA(0, 1, At, B1); PG8_BAR;
            PG8_LDA(At, 1, 1); PG8_STAGE(PG8_SA(1, 0), a3, voffA);
            PG8_BAR; PG8_WAIT_L(0); PG8_MMA(1, 0, At, B0); PG8_BAR; PG8_SCHED;
            PG8_STAGE(PG8_SB(1, 1), b3 + hstep, voffB);
            PG8_WAIT_V(6); PG8_BAR; PG8_MMA(1, 1, At, B1); PG8_BAR;
        }
        if constexpr (!Epi::AFTER_DRAIN) E(acc, cur, wr, wc, fr, fq);
        if (!has_next) break;
#pragma unroll
        for (int a = 0; a < 2; ++a)
#pragma unroll
            for (int b = 0; b < 2; ++b)
#pragma unroll
                for (int m = 0; m < 4; ++m)
#pragma unroll
                    for (int n = 0; n < 2; ++n) acc[a][b][m][n] = (f32x4p){0.f, 0.f, 0.f, 0.f};
        cur = nxt; cA = nA; cB = nB; ++ui;
    }
    PG8_WAIT_V(0);
    if (wr == 0) PG8_BAR;
    PG8_BAR;
    if constexpr (Epi::AFTER_DRAIN) E.fused(acc, cur, wr, wc, fr, fq, lds, wid, lane);
#undef PG8_SA
#undef PG8_SB
#undef PG8_STAGE
#undef PG8_LDA
#undef PG8_LDB
#undef PG8_MMA
#undef PG8_WAIT_V
#undef PG8_WAIT_L
#undef PG8_BAR
#undef PG8_SCHED
}
}
typedef pg8::f32x4p f32x4p;
DI u32x4 pack8(const f32x4p& a, const f32x4p& b) { u32x4 w; w[0] = pack2(a[0], a[1]); w[1] = pack2(a[2], a[3]); w[2] = pack2(b[0], b[1]); w[3] = pack2(b[2], b[3]); return w; }

struct InprojSched {
  const char* u1b; const char* wt; int G, c;
  DI bool next(int i, pg8::Unit& u) const {
    const int L = i * G + c;
    if (L >= 384 + 1088) return false;
    if (L < 384) { u.kind = 0; pg8::tile_order(L, 6, 64, u.pm, u.pn); } else { u.kind = 1; pg8::tile_order(L - 384, 64, 17, u.pm, u.pn); }
    return true;
  }
  DI const char* a_ptr(const pg8::Unit& u) const { return u.kind == 0 ? wt + (size_t)u.pm * (256 * 1024 * 2) : u1b + (size_t)u.pm * (256 * 1024 * 2); }
  DI const char* b_ptr(const pg8::Unit& u) const { return u.kind == 0 ? u1b + (size_t)u.pn * (256 * 1024 * 2) : wt + (size_t)(1536 + u.pn * 256) * (1024 * 2); }
};
struct InprojEpi {
  static constexpr bool PERM = true, AFTER_DRAIN = false;
  ushort_t* ph; ushort_t* qkv; ushort_t* gate; const float* rope;
  DI void operator()(const f32x4p (&acc)[2][2][4][2], const pg8::Unit& u, int wr, int wc, int fr, int fq) const {
    if (u.kind == 0) {
      const int b = (u.pn * 256) >> 13;
      ushort_t* base = ph + ((size_t)(b * HYC + u.pm * 256 + wr * 64 + fr)) * S_ + ((u.pn * 256) & (S_ - 1)) + wc * 32 + 8 * fq;
#pragma unroll
      for (int ai = 0; ai < 2; ++ai)
#pragma unroll
        for (int m = 0; m < 4; ++m)
#pragma unroll
          for (int bj = 0; bj < 2; ++bj) *(u32x4*)(base + (size_t)(ai * 128 + m * 16) * S_ + bj * 128) = pack8(acc[ai][bj][m][0], acc[ai][bj][m][1]);
      return;
    }
    const int row0 = u.pm * 256 + wr * 64 + fr;
    if (u.pn < 9) {
      const int cq0 = u.pn * 256 + wc * 32 + 8 * fq;
      const bool rotw = (u.pn < 6) && ((wc & 1) == 0);
      const float qs = (u.pn < 3) ? 0.125f : 1.0f;
#pragma unroll
      for (int ai = 0; ai < 2; ++ai)
#pragma unroll
        for (int m = 0; m < 4; ++m) {
          const int row = row0 + ai * 128 + m * 16;
          f32x4p cs[4];
          if (rotw) {
#pragma unroll
            for (int q = 0; q < 4; ++q) cs[q] = *(const f32x4p*)(rope + (size_t)row * 16 + q * 4);
          }
#pragma unroll
          for (int bj = 0; bj < 2; ++bj) {
            f32x4p v0 = acc[ai][bj][m][0], v1 = acc[ai][bj][m][1];
            if (rotw) {
              f32x4p o0, o1;
#pragma unroll
              for (int j = 0; j < 4; ++j) { o0[j] = __shfl_xor(v0[j], 16); o1[j] = __shfl_xor(v1[j], 16); }
              if (fq < 2) {
                const float sg = (fq == 0) ? -1.f : 1.f;
#pragma unroll
                for (int j = 0; j < 4; ++j) {
                  const float c0 = cs[j >> 1][(j & 1) * 2], s0 = cs[j >> 1][(j & 1) * 2 + 1];
                  const float c1 = cs[2 + (j >> 1)][(j & 1) * 2], s1 = cs[2 + (j >> 1)][(j & 1) * 2 + 1];
                  v0[j] = v0[j] * c0 + sg * o0[j] * s0;
                  v1[j] = v1[j] * c1 + sg * o1[j] * s1;
                }
              }
            }
            *(u32x4*)(qkv + (size_t)row * QKVC + cq0 + bj * 128) = pack8(v0 * qs, v1 * qs);
          }
        }
    } else {
      const int cg0 = (u.pn - 9) * 256 + wc * 32 + 8 * fq;
#pragma unroll
      for (int ai = 0; ai < 2; ++ai)
#pragma unroll
        for (int m = 0; m < 4; ++m)
#pragma unroll
          for (int bj = 0; bj < 2; ++bj) {
            f32x4p v0 = acc[ai][bj][m][0], v1 = acc[ai][bj][m][1];
#pragma unroll
            for (int j = 0; j < 4; ++j) { v0[j] = 1.f / (1.f + __expf(-v0[j])); v1[j] = 1.f / (1.f + __expf(-v1[j])); }
            *(u32x4*)(gate + (size_t)(row0 + ai * 128 + m * 16) * GATEC + cg0 + bj * 128) = pack8(v0, v1);
          }
    }
  }
};
DI void phase_inproj(const P& p, char* smem) {
  InprojSched S{p.ws + OFF_U1B, p.ws + OFF_WIN_T, (int)gridDim.x, (int)blockIdx.x};
  InprojEpi E{(ushort_t*)(p.ws + OFF_PH), (ushort_t*)(p.ws + OFF_QKV), (ushort_t*)(p.ws + OFF_GATE), (const float*)(p.ws + OFF_ROPE)};
  pg8::gemm_phase(( __attribute__((address_space(3))) unsigned char*)smem, 1024, S, E);
}
struct PlainSched {
  const char* A; const char* Bt; int nM, nN, K, G, c;
  DI bool next(int i, pg8::Unit& u) const { const int L = i * G + c; if (L >= nM * nN) return false; u.kind = 0; pg8::tile_order(L, nM, nN, u.pm, u.pn); return true; }
  DI const char* a_ptr(const pg8::Unit& u) const { return A + (size_t)u.pm * 256 * K * 2; }
  DI const char* b_ptr(const pg8::Unit& u) const { return Bt + (size_t)u.pn * 256 * K * 2; }
};
struct OutprojEpi {
  static constexpr bool PERM = false, AFTER_DRAIN = false;
  const float* x; float* out; const float* ada;
  DI void operator()(const f32x4p (&acc)[2][2][4][2], const pg8::Unit& u, int wr, int wc, int fr, int fq) const {
    const int row0 = u.pm * 256 + wr * 64 + fr, col0 = u.pn * 256 + wc * 32 + 4 * fq, b = (u.pm * 256) / S_;
    f32x4p g1[2][2];
#pragma unroll
    for (int bj = 0; bj < 2; ++bj)
#pragma unroll
      for (int n = 0; n < 2; ++n) g1[bj][n] = *(const f32x4p*)(ada + b * 6144 + 2 * 1024 + col0 + bj * 128 + n * 16) + 1.0f;
#pragma unroll
    for (int ai = 0; ai < 2; ++ai)
#pragma unroll
      for (int m = 0; m < 4; ++m) {
        const size_t ro = (size_t)(row0 + ai * 128 + m * 16) * 1024 + col0;
#pragma unroll
        for (int bj = 0; bj < 2; ++bj)
#pragma unroll
          for (int n = 0; n < 2; ++n) {
            const f32x4p xv = *(const f32x4p*)(x + ro + bj * 128 + n * 16);
            *(f32x4p*)(out + ro + bj * 128 + n * 16) = xv * DN_ALPHA + g1[bj][n] * acc[ai][bj][m][n];
          }
      }
  }
};
DI void phase_outproj(const P& p, char* smem) {
  PlainSched S{p.ws + OFF_MERGED, p.ws + OFF_WOUT_T, 64, 4, 1024, (int)gridDim.x, (int)blockIdx.x};
  OutprojEpi E{p.x, p.out, (const float*)(p.ws + OFF_ADA)};
  pg8::gemm_phase(( __attribute__((address_space(3))) unsigned char*)smem, 1024, S, E);
}

DI float sconv_t(const ushort_t* row, int t, float w0, float w1, float w2, float cb) {
  float v = cb + w1 * bf2f(row[t]);
  if (t > 0) v += w0 * bf2f(row[t - 1]);
  if (t < S_ - 1) v += w2 * bf2f(row[t + 1]);
  return v;
}
DI void fft_C_mul_invC(cf2* lds, const cf2* __restrict__ kq, int tid) {
  asm volatile("" : "+v"(tid));
  const int k1 = tid >> 5, k2 = tid & 31;
  kq += tid;
#pragma unroll
  for (int h = 0; h < 2; ++h) {
    float tr[16], ti[16];
    cf2 kv[16];
#pragma unroll
    for (int i = 0; i < 16; ++i) kv[i] = kq[(h * 16 + i) * 512];
    cf2* blk = lds + (k1 + 16 * h) * FFT_SA + k2 * 17;
#pragma unroll
    for (int mp = 0; mp < 16; ++mp) { cf2 v = blk[mp]; tr[mp] = v.x; ti[mp] = v.y; }
    dft_fwd<16, false>(tr, ti);
#pragma unroll
    for (int i = 0; i < 16; ++i) { const float a = tr[i], b = ti[i]; tr[i] = a * kv[i].x - b * kv[i].y; ti[i] = a * kv[i].y + b * kv[i].x; }
    dft_inv<16>(tr, ti);
#pragma unroll
    for (int mp = 0; mp < 16; ++mp) { cf2 o; o.x = tr[mp]; o.y = ti[mp]; blk[mp] = o; }
  }
}
DI void hyena_item(const P& p, char* smem, int c) {
  cf2* lds = (cf2*)smem;
  const ushort_t* pht = (const ushort_t*)(p.ws + OFF_PH);
  ushort_t* yht = (ushort_t*)(p.ws + OFF_YH);
  cf2* kq = (cf2*)(p.ws + (blockIdx.x < 92 ? OFF_WIN_T + (size_t)blockIdx.x * 131072 : OFF_HSCR + (size_t)(blockIdx.x - 92) * 131072));
  const float* filt = p.out;
  const int tid0 = tid_opaque();
  float zr[32], zi[32];
  __syncthreads();
#pragma unroll 1
  for (int o = 0; o < 2; ++o) {
    int tid = tid0; asm volatile("" : "+v"(tid));
    {
      float kr[32], ki[32];
      const float* fw = filt + (size_t)(0 * 1024 + o * 512 + c) * S_;
      const float* bw = filt + (size_t)(1 * 1024 + o * 512 + c) * S_;
      const float bias = p.hy_bias[o * 512 + c];
#pragma unroll
      for (int n1 = 0; n1 < 16; ++n1) { kr[n1] = fw[n1 * 512 + tid] * (1.0f / 16384.0f); ki[n1] = 0.f; }
      if (tid == 0) kr[0] += bias * (1.0f / 16384.0f);
#pragma unroll
      for (int n1 = 16; n1 < 32; ++n1) {
        const int n = n1 * 512 + tid;
        kr[n1] = (n == S_) ? 0.f : bw[2 * S_ - n] * (1.0f / 16384.0f); ki[n1] = 0.f;
      }
      fft_fwdA<false>(kr, ki, lds, tid); __syncthreads();
      fft_B_read(kr, ki, lds, tid); __syncthreads();
      fft_fwdB_write(kr, ki, lds, tid); __syncthreads();
      fft_fwdC(kr, ki, lds, tid);
      int ts = tid; asm volatile("" : "+v"(ts));
      cf2* kqt = kq + ts;
#pragma unroll
      for (int r = 0; r < 32; ++r) { cf2 v; v.x = kr[r]; v.y = ki[r]; kqt[r * 512] = v; }
      __syncthreads();
    }
    asm volatile("" : "+v"(tid));
    if (o == 0) {
      const float w0 = p.hy_conv_w[c], w1 = p.hy_conv_w[HYC + c], w2 = p.hy_conv_w[2 * HYC + c], cb = p.hy_conv_b[c];
      const ushort_t* r0 = pht + (size_t)(0 * HYC + c) * S_;
      const ushort_t* r1 = pht + (size_t)(1 * HYC + c) * S_;
#pragma unroll
      for (int n1 = 0; n1 < 16; ++n1) {
        const int t = n1 * 512 + tid;
        zr[n1] = sconv_t(r0, t, w0, w1, w2, cb); zi[n1] = sconv_t(r1, t, w0, w1, w2, cb);
        if (n1 & 1) asm volatile("" ::: "memory");
      }
    }
#pragma unroll
    for (int n1 = 16; n1 < 32; ++n1) { zr[n1] = 0.f; zi[n1] = 0.f; }
    fft_fwdA<true>(zr, zi, lds, tid); __syncthreads();
    fft_B_read(zr, zi, lds, tid); __syncthreads();
    fft_fwdB_write(zr, zi, lds, tid); __syncthreads();
    fft_C_mul_invC(lds, kq, tid); __syncthreads();
    fft_invB_read(zr, zi, lds, tid); __syncthreads();
    fft_invB_write(zr, zi, lds, tid); __syncthreads();
    fft_invA(zr, zi, lds, tid);
    int tg = tid; asm volatile("" : "+v"(tg));
    const int gch = (o + 1) * 512 + c;
    const float w0 = p.hy_conv_w[gch], w1 = p.hy_conv_w[HYC + gch], w2 = p.hy_conv_w[2 * HYC + gch], cb = p.hy_conv_b[gch];
    const ushort_t* g0 = pht + (size_t)(0 * HYC + gch) * S_;
    const ushort_t* g1 = pht + (size_t)(1 * HYC + gch) * S_;
#pragma unroll
    for (int n1 = 0; n1 < 16; ++n1) {
      const int t = n1 * 512 + tg;
      zr[n1] *= sconv_t(g0, t, w0, w1, w2, cb);
      zi[n1] *= sconv_t(g1, t, w0, w1, w2, cb);
      if (n1 & 1) asm volatile("" ::: "memory");
    }
    if (o == 1) {
#pragma unroll
      for (int n1 = 0; n1 < 16; ++n1) {
        const int t = n1 * 512 + tg;
        yht[(size_t)(0 * HW_ + c) * S_ + t] = f2bf(zr[n1]);
        yht[(size_t)(1 * HW_ + c) * S_ + t] = f2bf(zi[n1]);
      }
    }
  }
}

constexpr int ATT_VROW = 192;
constexpr int ATT_VBUF = 32 * ATT_VROW;
DI void attn_item(const P& p, char* smem, int item) {
  const ushort_t* qkv = (const ushort_t*)(p.ws + OFF_QKV);
  ushort_t* ya = (ushort_t*)(p.ws + OFF_YA);
  const int tid = tid_opaque(), lane = tid & 63, wave = tid >> 6;
  const int u = item * 8 + wave;
  const int hs = u & 3, r16 = (u >> 2) & 15, chunk = (u >> 6) & 15, b = u >> 10;
  const int qi = lane & 31, h = lane >> 5;
  char* vl = smem + wave * ATT_VBUF;
  const int tq = chunk * 512 + r16 + 16 * qi;
  const size_t bbase = (size_t)b * S_;
  f32x16 o0, o1;
#pragma unroll
  for (int r = 0; r < 16; ++r) { o0[r] = 0.f; o1[r] = 0.f; }
  float m = -1e30f, l = 0.f;
  const int g16 = (lane >> 4) & 1, q4 = (lane & 15) >> 2, p4 = lane & 3;
  __syncthreads();
#pragma unroll 1
  for (int g = 0; g < 3; ++g) {
    const int dsh = 2 * g;
    const int d = 1 << dsh, sd = 16 >> dsh, n = S_ >> dsh;
    const int head = g * 4 + hs;
    const int rc = r16 & (d - 1);
    const int P0 = (chunk * 512 + r16 - rc) >> dsh;
    const int pq = P0 + sd * qi;
    const int KB = P0 - 64;
    const int ntile = (g == 0) ? 20 : (g == 1 ? 8 : 5);
    bf16x8 bq[4];
    {
      const ushort_t* qrow = qkv + (bbase + tq) * QKVC + head * 64;
#pragma unroll
      for (int s = 0; s < 4; ++s) bq[s] = *(const bf16x8*)(qrow + (2 * s + h) * 8);
    }
    bf16x8 kn[4]; u32x4 vn[4];
    {
      const int kp = min(max(KB + qi, 0), n - 1);
      const ushort_t* krow = qkv + (bbase + rc + ((size_t)kp << dsh)) * QKVC + 768 + head * 64;
#pragma unroll
      for (int s = 0; s < 4; ++s) kn[s] = *(const bf16x8*)(krow + (2 * s + h) * 8);
#pragma unroll
      for (int i = 0; i < 4; ++i) {
        const int c = lane + 64 * i, row = c >> 3, ch = c & 7;
        const int vp = min(max(KB + row, 0), n - 1);
        vn[i] = *(const u32x4*)(qkv + (bbase + rc + ((size_t)vp << dsh)) * QKVC + 1536 + head * 64 + ch * 8);
      }
    }
#pragma unroll 1
    for (int kt = 0; kt < ntile; ++kt) {
      bf16x8 kc[4]; u32x4 vc[4];
#pragma unroll
      for (int s = 0; s < 4; ++s) kc[s] = kn[s];
#pragma unroll
      for (int i = 0; i < 4; ++i) vc[i] = vn[i];
      if (kt + 1 < ntile) {
        const int kb1 = KB + 32 * (kt + 1);
        const int kp = min(max(kb1 + qi, 0), n - 1);
        const ushort_t* krow = qkv + (bbase + rc + ((size_t)kp << dsh)) * QKVC + 768 + head * 64;
#pragma unroll
        for (int s = 0; s < 4; ++s) kn[s] = *(const bf16x8*)(krow + (2 * s + h) * 8);
#pragma unroll
        for (int i = 0; i < 4; ++i) {
          const int c = lane + 64 * i, row = c >> 3, ch = c & 7;
          const int vp = min(max(kb1 + row, 0), n - 1);
          vn[i] = *(const u32x4*)(qkv + (bbase + rc + ((size_t)vp << dsh)) * QKVC + 1536 + head * 64 + ch * 8);
        }
      }
      f32x16 st;
#pragma unroll
      for (int r = 0; r < 16; ++r) st[r] = 0.f;
#pragma unroll
      for (int s = 0; s < 4; ++s) st = __builtin_amdgcn_mfma_f32_32x32x16_bf16(kc[s], bq[s], st, 0, 0, 0);
#pragma unroll
      for (int i = 0; i < 4; ++i) { const int c = lane + 64 * i; *(u32x4*)(vl + (c >> 3) * ATT_VROW + (c & 7) * 16) = vc[i]; }
      const int kb = KB + 32 * kt + 4 * h;
      const int dk = kb - pq;
      float mx = -1e30f;
      bool ok[16];
#pragma unroll
      for (int r = 0; r < 16; ++r) {
        const int cr = (r & 3) + 8 * (r >> 2);
        ok[r] = ((unsigned)(dk + cr + 64) <= 128u) && ((unsigned)(kb + cr) < (unsigned)n);
        mx = fmaxf(mx, ok[r] ? st[r] : -1e30f);
      }
      mx = fmaxf(mx, __shfl_xor(mx, 32));
      const float mnew = fmaxf(m, mx);
      const float corr = __expf(m - mnew);
      float ps = 0.f;
      float pv[16];
#pragma unroll
      for (int r = 0; r < 16; ++r) { pv[r] = ok[r] ? __expf(st[r] - mnew) : 0.f; ps += pv[r]; }
      ps += __shfl_xor(ps, 32);
      l = l * corr + ps; m = mnew;
#pragma unroll
      for (int r = 0; r < 16; ++r) { o0[r] *= corr; o1[r] *= corr; }
      bf16x8 pf[2];
#pragma unroll
      for (int s = 0; s < 2; ++s) {
        u32x4 w;
        w[0] = pack2(pv[8 * s + 0], pv[8 * s + 1]); w[1] = pack2(pv[8 * s + 2], pv[8 * s + 3]);
        w[2] = pack2(pv[8 * s + 4], pv[8 * s + 5]); w[3] = pack2(pv[8 * s + 6], pv[8 * s + 7]);
        pf[s] = __builtin_bit_cast(bf16x8, w);
      }
      __builtin_amdgcn_wave_barrier();
      asm volatile("s_waitcnt lgkmcnt(0)" ::: "memory");
#pragma unroll
      for (int s = 0; s < 2; ++s) {
#pragma unroll
        for (int nt = 0; nt < 2; ++nt) {
          const char* a0 = vl + (16 * s + 4 * h + q4) * ATT_VROW + (32 * nt + 16 * g16 + 4 * p4) * 2;
          s16x4 lo = __builtin_amdgcn_ds_read_tr16_b64_v4i16((__attribute__((address_space(3))) s16x4*)(a0));
          s16x4 hi = __builtin_amdgcn_ds_read_tr16_b64_v4i16((__attribute__((address_space(3))) s16x4*)(a0 + 8 * ATT_VROW));
          const bf16x8 vf = __builtin_shufflevector(lo, hi, 0, 1, 2, 3, 4, 5, 6, 7);
          if (nt == 0) o0 = __builtin_amdgcn_mfma_f32_32x32x16_bf16(vf, pf[s], o0, 0, 0, 0);
          else o1 = __builtin_amdgcn_mfma_f32_32x32x16_bf16(vf, pf[s], o1, 0, 0, 0);
        }
      }
      __builtin_amdgcn_wave_barrier();
      asm volatile("s_waitcnt lgkmcnt(0)" ::: "memory");
    }
  }
  const float il = 1.f / l;
  ushort_t* op = ya + (bbase + tq) * 256 + hs * 64;
#pragma unroll
  for (int gq = 0; gq < 4; ++gq) {
    uint2 w0, w1;
    w0.x = pack2(o0[4 * gq] * il, o0[4 * gq + 1] * il); w0.y = pack2(o0[4 * gq + 2] * il, o0[4 * gq + 3] * il);
    w1.x = pack2(o1[4 * gq] * il, o1[4 * gq + 1] * il); w1.y = pack2(o1[4 * gq + 2] * il, o1[4 * gq + 3] * il);
    *(uint2*)(op + 8 * gq + 4 * h) = w0;
    *(uint2*)(op + 32 + 8 * gq + 4 * h) = w1;
  }
}

DI void phase_yh_transpose(const P& p, char* smem) {
  const ushort_t* yht = (const ushort_t*)(p.ws + OFF_YH);
  ushort_t* yhk = (ushort_t*)(p.ws + OFF_YHK);
  const int tid = tid_opaque();
  for (int item = blockIdx.x; item < 1024; item += gridDim.x) {
    const int cg = item & 15, tc = item >> 4, b = tc >> 5, t0 = (tc * 256) & (S_ - 1);
    __syncthreads();
    {
      const int ch = tid >> 4, k16 = tid & 15;
      const ushort_t* srcp = yht + (size_t)(b * HW_ + cg * 32 + ch) * S_ + t0;
#pragma unroll
      for (int i = 0; i < 2; ++i) *(u32x4*)(smem + ch * 528 + (k16 + 16 * i) * 16) = *(const u32x4*)(srcp + (k16 + 16 * i) * 8);
    }
    __syncthreads();
    {
      const int t = tid >> 1, half = tid & 1;
      unsigned w[8];
#pragma unroll
      for (int k = 0; k < 8; ++k) {
        const unsigned lo = *(const ushort_t*)(smem + (half * 16 + 2 * k) * 528 + t * 2);
        const unsigned hi = *(const ushort_t*)(smem + (half * 16 + 2 * k + 1) * 528 + t * 2);
        w[k] = lo | (hi << 16);
      }
      ushort_t* dst = yhk + (size_t)(tc * 256 + t) * HW_ + cg * 32 + half * 16;
      u32x4 o0, o1; o0[0] = w[0]; o0[1] = w[1]; o0[2] = w[2]; o0[3] = w[3]; o1[0] = w[4]; o1[1] = w[5]; o1[2] = w[6]; o1[3] = w[7];
      *(u32x4*)dst = o0; *(u32x4*)(dst + 8) = o1;
    }
  }
}
DI f32x4p bf4lo(const u32x4& w) { f32x4p r; r[0] = __uint_as_float(w[0] << 16); r[1] = __uint_as_float(w[0] & 0xffff0000u); r[2] = __uint_as_float(w[1] << 16); r[3] = __uint_as_float(w[1] & 0xffff0000u); return r; }
DI f32x4p bf4hi(const u32x4& w) { f32x4p r; r[0] = __uint_as_float(w[2] << 16); r[1] = __uint_as_float(w[2] & 0xffff0000u); r[2] = __uint_as_float(w[3] << 16); r[3] = __uint_as_float(w[3] & 0xffff0000u); return r; }
template <bool ADD>
struct MergeEpi {
  static constexpr bool PERM = true, AFTER_DRAIN = false;
  const ushort_t* gate; ushort_t* merged;
  DI void operator()(const f32x4p (&acc)[2][2][4][2], const pg8::Unit& u, int wr, int wc, int fr, int fq) const {
    const ushort_t* gb = gate + (size_t)(u.pm * 256) * GATEC + u.pn * 256;
    ushort_t* mb = merged + (size_t)(u.pm * 256) * 1024 + u.pn * 256;
    const unsigned lg = (unsigned)((wr * 64 + fr) * GATEC + wc * 32 + 8 * fq), lm = (unsigned)((wr * 64 + fr) * 1024 + wc * 32 + 8 * fq);
#pragma unroll
    for (int ai = 0; ai < 2; ++ai)
#pragma unroll
      for (int m = 0; m < 4; ++m) {
#pragma unroll
        for (int bj = 0; bj < 2; ++bj) {
          const u32x4 gw = *(const u32x4*)(gb + (ai * 128 + m * 16) * GATEC + bj * 128 + lg);
          f32x4p v0 = bf4lo(gw) * acc[ai][bj][m][0], v1 = bf4hi(gw) * acc[ai][bj][m][1];
          ushort_t* mp = mb + (ai * 128 + m * 16) * 1024 + bj * 128 + lm;
          if (ADD) { const u32x4 mw = *(const u32x4*)mp; v0 += bf4lo(mw); v1 += bf4hi(mw); }
          *(u32x4*)mp = pack8(v0, v1);
        }
        asm volatile("" ::: "memory");
      }
  }
};
DI void phase_merge(const P& p, char* smem) {
  {
    PlainSched S{p.ws + OFF_YHK, p.ws + OFF_WBH_T, 64, 4, 512, (int)gridDim.x, (int)blockIdx.x};
    MergeEpi<false> E{(const ushort_t*)(p.ws + OFF_GATE), (ushort_t*)(p.ws + OFF_MERGED)};
    pg8::gemm_phase(( __attribute__((address_space(3))) unsigned char*)smem, 512, S, E);
  }
  {
    PlainSched S{p.ws + OFF_YA, p.ws + OFF_WBA_T, 64, 4, 256, (int)gridDim.x, (int)blockIdx.x};
    MergeEpi<true> E{(const ushort_t*)(p.ws + OFF_GATE) + 1024, (ushort_t*)(p.ws + OFF_MERGED)};
    pg8::gemm_phase(( __attribute__((address_space(3))) unsigned char*)smem, 256, S, E);
  }
}

DI void phase_ln(float* __restrict__ xio, const float* __restrict__ g, const float* __restrict__ bta) {
  const int tq = tid_opaque(); const int lane = tq & 63, wave = tq >> 6;
  for (int row = blockIdx.x * 8 + wave; row < T_; row += gridDim.x * 8) {
    float* rp = xio + (size_t)row * 1024;
    f32x4 v[4];
    float s = 0.f;
#pragma unroll
    for (int i = 0; i < 4; ++i) { v[i] = *(const f32x4*)(rp + i * 256 + lane * 4); s += v[i][0] + v[i][1] + v[i][2] + v[i][3]; }
    const float mu = wave_sum(s) * (1.f / 1024.f);
    float q = 0.f;
#pragma unroll
    for (int i = 0; i < 4; ++i)
#pragma unroll
      for (int j = 0; j < 4; ++j) { float d = v[i][j] - mu; q += d * d; }
    const float rs = rsqrtf(wave_sum(q) * (1.f / 1024.f) + LN_EPS);
#pragma unroll
    for (int i = 0; i < 4; ++i) {
      f32x4 gg = *(const f32x4*)(g + i * 256 + lane * 4), bb = *(const f32x4*)(bta + i * 256 + lane * 4), o;
#pragma unroll
      for (int j = 0; j < 4; ++j) o[j] = (v[i][j] - mu) * rs * gg[j] + bb[j];
      *(f32x4*)(rp + i * 256 + lane * 4) = o;
    }
  }
}

DI int swz256(int row, int ch) { return row * 256 + ((ch ^ (row & 15)) << 4); }
DI void ins16(float (&L)[16], float x) {
#pragma unroll
  for (int i = 0; i < 16; ++i) { const float hi = __builtin_fmaxf(L[i], x); x = __builtin_fminf(L[i], x); L[i] = hi; }
}
DI void bitonic16_desc(float (&M)[16]) {
#pragma unroll
  for (int d = 8; d >= 1; d >>= 1)
#pragma unroll
    for (int i = 0; i < 16; ++i)
      if ((i & d) == 0) { const float a = M[i], b = M[i + d]; M[i] = __builtin_fmaxf(a, b); M[i + d] = __builtin_fminf(a, b); }
}
constexpr int ROUTE_Q_OFF = 0, ROUTE_K_OFF = 65536, ROUTE_IDX_OFF = 98304;
struct OneUnitSched {
  const char* A; const char* Bt; int pm, pn;
  DI bool next(int i, pg8::Unit& u) const { if (i != 0) return false; u.pm = pm; u.pn = pn; u.kind = 0; return true; }
  DI const char* a_ptr(const pg8::Unit& u) const { return A + (size_t)u.pm * 256 * 1024 * 2; }
  DI const char* b_ptr(const pg8::Unit& u) const { return Bt + (size_t)u.pn * 256 * 1024 * 2; }
};
struct RouteEpi {
  static constexpr bool PERM = false, AFTER_DRAIN = true;
  const ushort_t* keysb; int* idx; float* gv;
  DI void operator()(const f32x4p (&)[2][2][4][2], const pg8::Unit&, int, int, int, int) const {}
  DI void fused(const f32x4p (&acc)[2][2][4][2], const pg8::Unit& u, int wr, int wc, int fr, int fq, PG8_LAS unsigned char* ldsp, int wave, int lane) const {
    char* smem = (char*)ldsp;
    const int tid = wave * 64 + lane;
    const int m0 = u.pm * 256, hh = u.pn;
    float L0[16];
#pragma unroll
    for (int pp = 0; pp < 2; ++pp) {
      const int hp = hh * 2 + pp;
      if (pp == 1) __syncthreads();
#pragma unroll
      for (int ai = 0; ai < 2; ++ai)
#pragma unroll
        for (int m = 0; m < 4; ++m) {
          const int tok = 128 * ai + 64 * wr + 16 * m + fr;
#pragma unroll
          for (int n = 0; n < 2; ++n) {
            const int ch = 4 * wc + 2 * n + (fq >> 1);
            uint2 v; v.x = pack2(acc[ai][pp][m][n][0], acc[ai][pp][m][n][1]); v.y = pack2(acc[ai][pp][m][n][2], acc[ai][pp][m][n][3]);
            *(uint2*)(smem + ROUTE_Q_OFF + swz256(tok, ch) + 8 * (fq & 1)) = v;
          }
        }
#pragma unroll
      for (int i = 0; i < 4; ++i) {
        const int q = tid + 512 * i, row = q >> 4, ch = q & 15;
        *(u32x4*)(smem + ROUTE_K_OFF + swz256(row, ch)) = *(const u32x4*)(keysb + (size_t)hp * 16384 + row * 128 + ch * 8);
      }
      __syncthreads();
      f32x16 sc[4];
#pragma unroll
      for (int ks = 0; ks < 4; ++ks)
#pragma unroll
        for (int r = 0; r < 16; ++r) sc[ks][r] = 0.f;
#pragma unroll
      for (int s = 0; s < 8; ++s) {
        const int ch = 2 * s + (lane >> 5);
        const bf16x8 bq = *(const bf16x8*)(smem + ROUTE_Q_OFF + swz256(wave * 32 + (lane & 31), ch));
#pragma unroll
        for (int ks = 0; ks < 4; ++ks) {
          const bf16x8 ak = *(const bf16x8*)(smem + ROUTE_K_OFF + swz256(ks * 32 + (lane & 31), ch));
          sc[ks] = __builtin_amdgcn_mfma_f32_32x32x16_bf16(ak, bq, sc[ks], 0, 0, 0);
        }
      }
      float L[16];
#pragma unroll
      for (int i = 0; i < 16; ++i) L[i] = -3.0e38f;
      const unsigned hbit = (unsigned)(lane >> 5) << 2;
#pragma unroll
      for (int ks = 0; ks < 4; ++ks)
#pragma unroll
        for (int r = 0; r < 16; ++r) {
          const unsigned key = (unsigned)(ks * 32 + (r & 3) + 8 * (r >> 2)) | hbit;
          ins16(L, __uint_as_float((__float_as_uint(sc[ks][r]) & ~127u) | key));
        }
      {
        float M[16];
#pragma unroll
        for (int i = 0; i < 16; ++i) M[i] = __builtin_fmaxf(L[i], __shfl_xor(L[15 - i], 32));
        bitonic16_desc(M);
#pragma unroll
        for (int i = 0; i < 16; ++i) L[i] = M[i];
      }
      if (pp == 0) {
#pragma unroll
        for (int i = 0; i < 16; ++i) L0[i] = L[i];
      } else {
        unsigned char* ib = (unsigned char*)(smem + ROUTE_IDX_OFF) + tid * 32;
#pragma unroll
        for (int i = 0; i < 16; ++i) { ib[i] = (unsigned char)(__float_as_uint(L0[i]) & 127u); ib[16 + i] = (unsigned char)(__float_as_uint(L[i]) & 127u); }
        float F[16];
#pragma unroll
        for (int i = 0; i < 16; ++i) F[i] = -3.0e38f;
#pragma unroll
        for (int i = 0; i < 16; ++i) {
          const float ai_ = __uint_as_float(__float_as_uint(L0[i]) & ~127u);
#pragma unroll
          for (int jj = 0; jj < 16; ++jj)
            if ((i + 1) * (jj + 1) <= 16) {
              const float s = ai_ + __uint_as_float(__float_as_uint(L[jj]) & ~127u);
              ins16(F, __uint_as_float((__float_as_uint(s) & ~255u) | (unsigned)(i * 16 + jj)));
            }
        }
        const float mx = __uint_as_float(__float_as_uint(F[0]) & ~255u);
        float e[16], sum = 0.f;
#pragma unroll
        for (int k = 0; k < 16; ++k) { e[k] = __expf(__uint_as_float(__float_as_uint(F[k]) & ~255u) - mx); sum += e[k]; }
        const float inv = 1.f / sum;
        if (lane < 32) {
          const int tok = m0 + wave * 32 + lane;
          int* ip = idx + (size_t)tok * 128 + hh * 16;
          float* gp = gv + (size_t)tok * 128 + hh * 16;
#pragma unroll
          for (int k4 = 0; k4 < 4; ++k4) {
            int4 iv; f32x4 g4;
            int ee[4];
#pragma unroll
            for (int uu = 0; uu < 4; ++uu) {
              const unsigned code = __float_as_uint(F[k4 * 4 + uu]) & 255u;
              ee[uu] = (int)ib[code >> 4] * 128 + (int)ib[16 + (code & 15u)];
              g4[uu] = e[k4 * 4 + uu] * inv;
            }
            iv.x = ee[0]; iv.y = ee[1]; iv.z = ee[2]; iv.w = ee[3];
            *(int4*)(ip + k4 * 4) = iv;
            *(f32x4*)(gp + k4 * 4) = g4;
          }
        }
      }
    }
    __syncthreads();
  }
};
DI void phase_route(const P& p, char* smem) {
  for (int item = blockIdx.x; item < (T_ / 256) * 8; item += gridDim.x) {
    OneUnitSched S{p.ws + OFF_U2B, p.ws + OFF_WQ_T, item >> 3, item & 7};
    RouteEpi E{(const ushort_t*)(p.ws + OFF_KEYS_B), (int*)(p.ws + OFF_IDX), (float*)(p.ws + OFF_GV)};
    pg8::gemm_phase((__attribute__((address_space(3))) unsigned char*)smem, 1024, S, E);
  }
}

DI void phase_rope(const P& p) {
  float* rt = (float*)(p.ws + OFF_ROPE);
  for (int i = blockIdx.x * NT + tid_opaque(); i < T_ * 8; i += gridDim.x * NT) {
    const float inv = expf(-13.122363377404328f * (float)(i & 7) * 0.125f);
    const float x = (float)p.pos[i >> 3] * inv;
    const float k = rintf(x * 0.15915494309189535f);
    float r = fmaf(-k, 6.28125f, x);
    r = fmaf(-k, 1.9353071795864769e-3f, r);
    float sn, cs; __sincosf(r, &sn, &cs);
    rt[2 * i] = cs; rt[2 * i + 1] = sn;
  }
}
DI void phase_keys(const P& p) {
  ushort_t* keysb = (ushort_t*)(p.ws + OFF_KEYS_B);
  for (int i = blockIdx.x * NT + tid_opaque(); i < 16 * 128 * 128 / 4; i += gridDim.x * NT) {
    f32x4 v = *(const f32x4*)(p.keys + (size_t)i * 4);
    uint2 o; o.x = pack2(v[0], v[1]); o.y = pack2(v[2], v[3]);
    *(uint2*)(keysb + (size_t)i * 4) = o;
  }
}

typedef __bf16 bf16x2_t __attribute__((ext_vector_type(2)));
DI float dot2bf(unsigned a, unsigned b, float c) { return __builtin_amdgcn_fdot2_f32_bf16(__builtin_bit_cast(bf16x2_t, a), __builtin_bit_cast(bf16x2_t, b), c, false); }
DI void phase_ln1(const P& p) {
  const float* ada = (const float*)(p.ws + OFF_ADA);
  ushort_t* u2b = (ushort_t*)(p.ws + OFF_U2B);
  const int tq = tid_opaque(); const int lane = tq & 63, wave = tq >> 6;
  for (int row = blockIdx.x * 8 + wave; row < T_; row += gridDim.x * 8) {
    const int b = row / S_;
    float* rp = p.out + (size_t)row * 1024;
    f32x4 v[4];
    float s = 0.f;
#pragma unroll
    for (int i = 0; i < 4; ++i) { v[i] = *(const f32x4*)(rp + i * 256 + lane * 4); s += v[i][0] + v[i][1] + v[i][2] + v[i][3]; }
    const float mu = wave_sum(s) * (1.f / 1024.f);
    float q = 0.f;
#pragma unroll
    for (int i = 0; i < 4; ++i)
#pragma unroll
      for (int j = 0; j < 4; ++j) { float d = v[i][j] - mu; q += d * d; }
    const float rs = rsqrtf(wave_sum(q) * (1.f / 1024.f) + LN_EPS);
#pragma unroll
    for (int i = 0; i < 4; ++i) {
      const int col = i * 256 + lane * 4;
      f32x4 gg = *(const f32x4*)(p.ln1_g + col), bb = *(const f32x4*)(p.ln1_b + col), o;
      f32x4 sc = *(const f32x4*)(ada + b * 6144 + 4 * 1024 + col), sh = *(const f32x4*)(ada + b * 6144 + 3 * 1024 + col);
#pragma unroll
      for (int j = 0; j < 4; ++j) o[j] = (v[i][j] - mu) * rs * gg[j] + bb[j];
      *(f32x4*)(rp + col) = o;
      uint2 w; w.x = pack2(o[0] * (1.f + sc[0]) + sh[0], o[1] * (1.f + sc[1]) + sh[1]); w.y = pack2(o[2] * (1.f + sc[2]) + sh[2], o[3] * (1.f + sc[3]) + sh[3]);
      *(uint2*)(u2b + (size_t)row * 1024 + col) = w;
    }
  }
}
DI float wave_max(float v) {
#pragma unroll
  for (int o = 32; o > 0; o >>= 1) v = fmaxf(v, __shfl_xor(v, o));
  return v;
}
DI unsigned pack4_fp8(float a, float b, float c, float d) {
  int w = 0;
  w = __builtin_amdgcn_cvt_pk_fp8_f32(a, b, w, false);
  w = __builtin_amdgcn_cvt_pk_fp8_f32(c, d, w, true);
  return (unsigned)w;
}
DI void phase_tabconv(const P& p) {
  unsigned char* tu = (unsigned char*)(p.ws + OFF_TABU);
  unsigned char* tv = (unsigned char*)(p.ws + OFF_TABV);
  float* su = (float*)(p.ws + OFF_SU);
  float* sv = (float*)(p.ws + OFF_SV);
  const int tq = tid_opaque(); const int lane = tq & 63, wave = tq >> 6;
  for (int e = blockIdx.x * 8 + wave; e < 16384; e += gridDim.x * 8) {
    f32x4 a[4], c[4];
    float ma = 0.f, mc = 0.f;
#pragma unroll
    for (int i = 0; i < 4; ++i) {
      const int col = i * 256 + lane * 4;
      a[i] = *(const f32x4*)(p.pu + (size_t)e * 1024 + col);
      c[i] = *(const f32x4*)(p.pv + (size_t)e * 1024 + col);
#pragma unroll
      for (int j = 0; j < 4; ++j) { ma = fmaxf(ma, fabsf(a[i][j])); mc = fmaxf(mc, fabsf(c[i][j])); }
    }
    ma = wave_max(ma); mc = wave_max(mc);
    const float sa = (ma > 0.f) ? ma * (1.0f / 448.0f) : 1.0f, sc = (mc > 0.f) ? mc * (1.0f / 448.0f) : 1.0f;
    const float ia = 1.0f / sa, ic = 1.0f / sc;
    if (lane == 0) { su[e] = sa; sv[e] = sc; }
#pragma unroll
    for (int i = 0; i < 4; ++i) {
      const int col = i * 256 + lane * 4;
      *(unsigned*)(tu + (size_t)e * 1024 + col) = pack4_fp8(a[i][0] * ia, a[i][1] * ia, a[i][2] * ia, a[i][3] * ia);
      const int slice = i * 2 + (lane >> 5);
      *(unsigned*)(tv + ((size_t)slice * 16384 + e) * 128 + (lane & 31) * 4) = pack4_fp8(c[i][0] * ic, c[i][1] * ic, c[i][2] * ic, c[i][3] * ic);
    }
  }
}

template <int CTRL> DI float dpp_f(float v) { return __int_as_float(__builtin_amdgcn_mov_dpp(__float_as_int(v), CTRL, 0xf, 0xf, false)); }
template <int CTRL> DI int dpp_shr0(int v) { return __builtin_amdgcn_update_dpp(0, v, CTRL, 0xf, 0xf, true); }
template <int I> DI int bcast16(int v) { return __builtin_amdgcn_mov_dpp(v, 0x150 + I, 0xf, 0xf, false); }
DI float row_sum16(float d) {
  d += dpp_f<0xB1>(d);
  d += dpp_f<0x4E>(d);
  d += dpp_f<0x141>(d);
  d += dpp_f<0x140>(d);
  return d;
}
typedef __bf16 bf16x2_c __attribute__((ext_vector_type(2)));
DI float dot4_fp8(unsigned w8, unsigned xlo, unsigned xhi, float acc) {
  const bf16x2_c lo = __builtin_amdgcn_cvt_scalef32_pk_bf16_fp8((int)w8, 1.0f, false);
  const bf16x2_c hi = __builtin_amdgcn_cvt_scalef32_pk_bf16_fp8((int)w8, 1.0f, true);
  acc = __builtin_amdgcn_fdot2_f32_bf16(lo, __builtin_bit_cast(bf16x2_c, xlo), acc, false);
  return __builtin_amdgcn_fdot2_f32_bf16(hi, __builtin_bit_cast(bf16x2_c, xhi), acc, false);
}
DI void phase_upass(const P& p, char* smem) {
  const int* idx = (const int*)(p.ws + OFF_IDX);
  const float* gv = (const float*)(p.ws + OFF_GV);
  const ushort_t* u2b = (const ushort_t*)(p.ws + OFF_U2B);
  const char* tabu = (const char*)(p.ws + OFF_TABU);
  const float* su = (const float*)(p.ws + OFF_SU);
  const float* sv = (const float*)(p.ws + OFF_SV);
  float* coef = (float*)(p.ws + OFF_COEF);
  const int tq = tid_opaque(); const int lane = tq & 63, wave = tq >> 6;
  const int g = lane >> 4, j = lane & 15;
  int4* lst = (int4*)smem + wave * 512 + g * 128;
  const int part = blockIdx.x & 7, bi = blockIdx.x >> 3, nb = (gridDim.x - part + 7) >> 3;
  __syncthreads();
#pragma unroll 1
  for (int tb = (bi * 8 + wave) * 4; tb < T_; tb += nb * 32) {
    const int tok = tb + g;
    const int4 i0 = *(const int4*)(idx + (size_t)tb * 128 + lane * 8), i1 = *(const int4*)(idx + (size_t)tb * 128 + lane * 8 + 4);
    const f32x4 g0 = *(const f32x4*)(gv + (size_t)tb * 128 + lane * 8), g1 = *(const f32x4*)(gv + (size_t)tb * 128 + lane * 8 + 4);
    u32x4 xr[8];
#pragma unroll
    for (int c = 0; c < 4; ++c) {
      xr[2 * c] = *(const u32x4*)(u2b + (size_t)tok * 1024 + (j + 16 * c) * 16);
      xr[2 * c + 1] = *(const u32x4*)(u2b + (size_t)tok * 1024 + (j + 16 * c) * 16 + 8);
    }
    const int ev[8] = {i0.x, i0.y, i0.z, i0.w, i1.x, i1.y, i1.z, i1.w};
    const float gg[8] = {g0[0], g0[1], g0[2], g0[3], g1[0], g1[1], g1[2], g1[3]};
    int cnt = 0;
#pragma unroll
    for (int i = 0; i < 8; ++i) cnt += ((ev[i] >> 11) == part) ? 1 : 0;
    int incl = cnt;
    incl += dpp_shr0<0x111>(incl); incl += dpp_shr0<0x112>(incl); incl += dpp_shr0<0x114>(incl); incl += dpp_shr0<0x118>(incl);
    const int ng = bcast16<15>(incl);
    int pos = incl - cnt;
#pragma unroll
    for (int i = 0; i < 8; ++i)
      if ((ev[i] >> 11) == part) { int4 en; en.x = ev[i]; en.y = __float_as_int(gg[i]); en.z = j * 8 + i; en.w = 0; lst[pos] = en; ++pos; }
    const int nmax = max(max(__builtin_amdgcn_readlane(ng, 0), __builtin_amdgcn_readlane(ng, 16)), max(__builtin_amdgcn_readlane(ng, 32), __builtin_amdgcn_readlane(ng, 48)));
    __builtin_amdgcn_wave_barrier();
    asm volatile("s_waitcnt lgkmcnt(0)" ::: "memory");
    u32x4 ra[4], rb[4], rc[4], rd[4];
#define UP_LOAD(R, IT) { const unsigned e_ = ((IT) < ng) ? (unsigned)lst[(IT)].x : 0u; const char* row_ = tabu + (size_t)e_ * 1024 + j * 16; \
                         _Pragma("unroll") for (int c = 0; c < 4; ++c) R[c] = *(const u32x4*)(row_ + c * 256); }
#define UP_COMP(R, IT) { float a0 = 0.f, a1 = 0.f, a2 = 0.f, a3 = 0.f; \
      _Pragma("unroll") for (int c = 0; c < 4; ++c) { \
        a0 = dot4_fp8(R[c][0], xr[2 * c][0], xr[2 * c][1], a0); a1 = dot4_fp8(R[c][1], xr[2 * c][2], xr[2 * c][3], a1); \
        a2 = dot4_fp8(R[c][2], xr[2 * c + 1][0], xr[2 * c + 1][1], a2); a3 = dot4_fp8(R[c][3], xr[2 * c + 1][2], xr[2 * c + 1][3], a3); } \
      const float d_ = row_sum16((a0 + a1) + (a2 + a3)); \
      if (j == 0 && (IT) < ng) ((int*)&lst[(IT)])[3] = __float_as_int(d_); }
    UP_LOAD(ra, 0) UP_LOAD(rb, 1) UP_LOAD(rc, 2) UP_LOAD(rd, 3)
#pragma unroll 1
    for (int it = 0; it < nmax; it += 4) {
      UP_COMP(ra, it)     UP_LOAD(ra, it + 4)
      UP_COMP(rb, it + 1) UP_LOAD(rb, it + 5)
      UP_COMP(rc, it + 2) UP_LOAD(rc, it + 6)
      UP_COMP(rd, it + 3) UP_LOAD(rd, it + 7)
    }
#undef UP_LOAD
#undef UP_COMP
    __builtin_amdgcn_wave_barrier();
    asm volatile("s_waitcnt lgkmcnt(0)" ::: "memory");
#pragma unroll 1
    for (int k = 0; k < nmax; k += 16) {
      if (k + j < ng) {
        const int4 en = lst[k + j];
        const float a = __int_as_float(en.w) * su[en.x];
        coef[(size_t)tok * 128 + en.z] = __int_as_float(en.y) * 0.5f * a * (1.f + erff(a * 0.7071067811865475f)) * sv[en.x];
      }
    }
    __builtin_amdgcn_wave_barrier();
    asm volatile("s_waitcnt lgkmcnt(0)" ::: "memory");
  }
}

struct VHdr { int ea, eb, ca, cb; };
DI VHdr vp_hdr(const int* idx, const float* coef, int tok, int g, int cq) {
  VHdr h;
  h.ea = idx[(size_t)tok * 128 + g * 32 + cq]; h.eb = idx[(size_t)tok * 128 + g * 32 + 16 + cq];
  h.ca = __float_as_int(coef[(size_t)tok * 128 + g * 32 + cq]); h.cb = __float_as_int(coef[(size_t)tok * 128 + g * 32 + 16 + cq]);
  return h;
}
DI void vp_rows(uint2 (&va)[16], uint2 (&vb)[16], const VHdr& h, const char* tb) {
#define VP_STEP(I) { va[I] = *(const uint2*)(tb + (unsigned)bcast16<I>(h.ea) * 128u); vb[I] = *(const uint2*)(tb + (unsigned)bcast16<I>(h.eb) * 128u); }
  VP_STEP(0) VP_STEP(1) VP_STEP(2) VP_STEP(3) VP_STEP(4) VP_STEP(5) VP_STEP(6) VP_STEP(7)
  VP_STEP(8) VP_STEP(9) VP_STEP(10) VP_STEP(11) VP_STEP(12) VP_STEP(13) VP_STEP(14) VP_STEP(15)
#undef VP_STEP
}
DI void vp_coefs(float (&fa)[16], float (&fb)[16], const VHdr& h) {
#define VP_STEP(I) { fa[I] = __int_as_float(bcast16<I>(h.ca)); fb[I] = __int_as_float(bcast16<I>(h.cb)); }
  VP_STEP(0) VP_STEP(1) VP_STEP(2) VP_STEP(3) VP_STEP(4) VP_STEP(5) VP_STEP(6) VP_STEP(7)
  VP_STEP(8) VP_STEP(9) VP_STEP(10) VP_STEP(11) VP_STEP(12) VP_STEP(13) VP_STEP(14) VP_STEP(15)
#undef VP_STEP
}
DI void vp_fma8(float (&a)[8], float cf, const uint2& v) {
  const f32x2_hw p0 = __builtin_amdgcn_cvt_pk_f32_fp8((int)v.x, false), p1 = __builtin_amdgcn_cvt_pk_f32_fp8((int)v.x, true);
  const f32x2_hw p2 = __builtin_amdgcn_cvt_pk_f32_fp8((int)v.y, false), p3 = __builtin_amdgcn_cvt_pk_f32_fp8((int)v.y, true);
  a[0] += cf * p0[0]; a[1] += cf * p0[1]; a[2] += cf * p1[0]; a[3] += cf * p1[1];
  a[4] += cf * p2[0]; a[5] += cf * p2[1]; a[6] += cf * p3[0]; a[7] += cf * p3[1];
}
DI void vp_consume(const uint2 (&va)[16], const uint2 (&vb)[16], const VHdr& h, float* f, int tok, int slice, int g, int cq, bool live) {
  float fa[16], fb[16];
  vp_coefs(fa, fb, h);
  float a[8];
#pragma unroll
  for (int i = 0; i < 8; ++i) a[i] = 0.f;
#pragma unroll
  for (int i = 0; i < 16; ++i) { vp_fma8(a, fa[i], va[i]); vp_fma8(a, fb[i], vb[i]); }
#pragma unroll
  for (int i = 0; i < 8; ++i) { a[i] += __shfl_xor(a[i], 16); a[i] += __shfl_xor(a[i], 32); }
  if (g == 0 && live) {
    f32x4 o0, o1; o0[0] = a[0]; o0[1] = a[1]; o0[2] = a[2]; o0[3] = a[3]; o1[0] = a[4]; o1[1] = a[5]; o1[2] = a[6]; o1[3] = a[7];
    float* fp = f + (size_t)tok * 1024 + slice * 128 + cq * 8;
    *(f32x4*)fp = o0; *(f32x4*)(fp + 4) = o1;
  }
}
DI void phase_vpass(const P& p) {
  const int* idx = (const int*)(p.ws + OFF_IDX);
  const float* coef = (const float*)(p.ws + OFF_COEF);
  const char* tabv = (const char*)(p.ws + OFF_TABV);
  float* f = (float*)(p.ws + OFF_F);
  const int tq = tid_opaque(); const int lane = tq & 63, wave = tq >> 6;
  const int g = lane >> 4, cq = lane & 15;
  const int slice = blockIdx.x & 7, bi = blockIdx.x >> 3, nb = (gridDim.x - slice + 7) >> 3;
  const int step = nb * 8;
  const char* tb = tabv + (size_t)slice * (16384 * 128) + cq * 8;
  int tok = bi * 8 + wave;
  if (tok >= T_) return;
  VHdr h0 = vp_hdr(idx, coef, tok, g, cq);
  VHdr h1 = vp_hdr(idx, coef, min(tok + step, T_ - 1), g, cq);
  uint2 va[16], vb[16], na[16], nb2[16];
  vp_rows(va, vb, h0, tb);
#pragma unroll 1
  for (; tok < T_; tok += 2 * step) {
    const VHdr h2 = vp_hdr(idx, coef, min(tok + 2 * step, T_ - 1), g, cq);
    vp_rows(na, nb2, h1, tb);
    vp_consume(va, vb, h0, f, tok, slice, g, cq, true);
    const VHdr h3 = vp_hdr(idx, coef, min(tok + 3 * step, T_ - 1), g, cq);
    vp_rows(va, vb, h2, tb);
    vp_consume(na, nb2, h1, f, tok + step, slice, g, cq, tok + step < T_);
    h0 = h2; h1 = h3;
  }
}

DI void phase_ln2(const P& p) {
  const float* ada = (const float*)(p.ws + OFF_ADA);
  const float* f = (const float*)(p.ws + OFF_F);
  const int tq = tid_opaque(); const int lane = tq & 63, wave = tq >> 6;
  for (int tok = blockIdx.x * 8 + wave; tok < T_; tok += gridDim.x * 8) {
    const int b = tok / S_;
    float* rp = p.out + (size_t)tok * 1024;
    f32x4 acc[4];
    float sm = 0.f;
#pragma unroll
    for (int i = 0; i < 4; ++i) {
      const int col = i * 256 + lane * 4;
      f32x4 x1 = *(const f32x4*)(rp + col), ff = *(const f32x4*)(f + (size_t)tok * 1024 + col);
      f32x4 g2 = *(const f32x4*)(ada + b * 6144 + 5 * 1024 + col);
#pragma unroll
      for (int j = 0; j < 4; ++j) { acc[i][j] = DN_ALPHA * x1[j] + (1.f + g2[j]) * ff[j]; sm += acc[i][j]; }
    }
    const float mu = wave_sum(sm) * (1.f / 1024.f);
    float q = 0.f;
#pragma unroll
    for (int i = 0; i < 4; ++i)
#pragma unroll
      for (int j = 0; j < 4; ++j) { float d = acc[i][j] - mu; q += d * d; }
    const float rs = rsqrtf(wave_sum(q) * (1.f / 1024.f) + LN_EPS);
#pragma unroll
    for (int i = 0; i < 4; ++i) {
      const int col = i * 256 + lane * 4;
      f32x4 gg = *(const f32x4*)(p.ln2_g + col), bb = *(const f32x4*)(p.ln2_b + col), o;
#pragma unroll
      for (int j = 0; j < 4; ++j) o[j] = (acc[i][j] - mu) * rs * gg[j] + bb[j];
      *(f32x4*)(rp + col) = o;
    }
  }
}

#define XB_TMO      128
#define XB_XCNT(j)  (256  + 64 * (j))
#define XB_XSUB(j)  (1280 + 64 * (j))
#define XB_XGEN(j)  (2304 + 64 * (j))
#define XB_TOP      3328
#define XB_TOPGEN   3392
#define XCD_BAR_WORDS 3456
#define XB_SPIN_CAP (1u << 22)
#define LAS __attribute__((address_space(3)))
DI unsigned xb_ld(unsigned* p)              { return __hip_atomic_load(p, __ATOMIC_RELAXED, __HIP_MEMORY_SCOPE_AGENT); }
DI unsigned xb_add(unsigned* p, unsigned v) { return __hip_atomic_fetch_add(p, v, __ATOMIC_RELAXED, __HIP_MEMORY_SCOPE_AGENT); }
DI unsigned xb_xcc_id() { return (unsigned)__builtin_amdgcn_s_getreg((3 << 11) | 20) & 0xFu; }
#define XB_SPIN(cond, bar) do { unsigned _sp = 0; while (cond) { __builtin_amdgcn_s_sleep(1); \
    if ((++_sp & 255u) == 0u) { if (xb_ld(&(bar)[XB_TMO])) break; if (_sp > XB_SPIN_CAP) { atomicAdd(&(bar)[XB_TMO], 1u); break; } } } } while (0)
struct XcdBarrier { unsigned* bar; unsigned x; volatile LAS unsigned* st; };
DI XcdBarrier xcd_barrier_post(unsigned* bar, volatile LAS unsigned* st) {
  XcdBarrier b; b.bar = bar; b.x = xb_xcc_id(); b.st = st;
  if (threadIdx.x == 0) (void)xb_add(&bar[XB_XCNT(b.x)], 1u);
  return b;
}
DI void xcd_barrier_complete(unsigned* bar, unsigned x, unsigned& nloc, unsigned& nx) {
  const unsigned G = gridDim.x * gridDim.y * gridDim.z;
  unsigned sum, cnt, mine, sp = 0u;
  for (;;) {
    sum = 0u; cnt = 0u; mine = 0u;
#pragma unroll
    for (unsigned j = 0; j < 16; ++j) { const unsigned c = xb_ld(&bar[XB_XCNT(j)]); sum += c; cnt += (c > 0u) ? 1u : 0u; mine = (j == x) ? c : mine; }
    if (sum == G) break;
    __builtin_amdgcn_s_sleep(1);
    if ((++sp & 255u) == 0u) { if (xb_ld(&bar[XB_TMO])) break; if (sp > XB_SPIN_CAP) { atomicAdd(&bar[XB_TMO], 1u); break; } }
  }
  nloc = mine > 0u ? mine : 1u; nx = cnt > 0u ? cnt : 1u;
}
DI void xcd_barrier(unsigned* barp, char* stp) {
  asm volatile("s_waitcnt vmcnt(0)" ::: "memory");
  __syncthreads();
  if (threadIdx.x == 0) {
    XcdBarrier b; b.bar = barp; b.x = xb_xcc_id(); b.st = (volatile LAS unsigned*)stp;
    unsigned* bar = b.bar;
    __builtin_amdgcn_s_waitcnt(0);
    unsigned nloc = b.st[0], nx = b.st[1];
    if (nloc == 0u) { xcd_barrier_complete(bar, b.x, nloc, nx); b.st[0] = nloc; b.st[1] = nx; }
    const unsigned old = xb_add(&bar[XB_XSUB(b.x)], 1u);
    const unsigned gen = old / nloc;
    if (old + 1u == (gen + 1u) * nloc) {
      __builtin_amdgcn_fence(__ATOMIC_RELEASE, "agent");
      asm volatile("s_waitcnt vmcnt(0)" ::: "memory");
      const unsigned og = xb_add(&bar[XB_TOP], 1u);
      const unsigned tg = og / nx;
      if (og + 1u == (tg + 1u) * nx) xb_add(&bar[XB_TOPGEN], 1u);
      else XB_SPIN(xb_ld(&bar[XB_TOPGEN]) == tg, bar);
      __builtin_amdgcn_fence(__ATOMIC_ACQUIRE, "agent");
      xb_add(&bar[XB_XGEN(b.x)], 1u);
      asm volatile("s_waitcnt vmcnt(0)" ::: "memory");
    } else {
      XB_SPIN(xb_ld(&bar[XB_XGEN(b.x)]) == gen, bar);
      __builtin_amdgcn_fence(__ATOMIC_ACQUIRE, "agent");
      asm volatile("s_waitcnt vmcnt(0)" ::: "memory");
    }
  }
  __syncthreads();
}

constexpr int SMEM_BYTES = 143360;
__global__ void __launch_bounds__(NT) fwd_megakernel(P p) {
  __shared__ __attribute__((aligned(16))) char smem[SMEM_BYTES + 16];
  if (threadIdx.x < 4) ((volatile LAS unsigned*)(smem + SMEM_BYTES))[threadIdx.x] = 0u;
  __syncthreads();
  (void)xcd_barrier_post((unsigned*)(p.ws + OFF_BAR), (volatile LAS unsigned*)(smem + SMEM_BYTES));
  phase_ada(p, smem);
  xcd_barrier((unsigned*)(p.ws + OFF_BAR), smem + SMEM_BYTES);
  phase_u1(p);
  phase_transposes(p, smem);
  phase_keys(p);
  phase_rope(p);
  phase_filter(p, smem);
  xcd_barrier((unsigned*)(p.ws + OFF_BAR), smem + SMEM_BYTES);
  phase_inproj(p, smem);
  xcd_barrier((unsigned*)(p.ws + OFF_BAR), smem + SMEM_BYTES);
  for (int item = blockIdx.x; item < 512 + 256; item += gridDim.x) {
    if (item < 512) hyena_item(p, smem, item);
    else attn_item(p, smem, item - 512);
  }
  xcd_barrier((unsigned*)(p.ws + OFF_BAR), smem + SMEM_BYTES);
  phase_yh_transpose(p, smem);
  xcd_barrier((unsigned*)(p.ws + OFF_BAR), smem + SMEM_BYTES);
  phase_merge(p, smem);
  xcd_barrier((unsigned*)(p.ws + OFF_BAR), smem + SMEM_BYTES);
  phase_outproj(p, smem);
  xcd_barrier((unsigned*)(p.ws + OFF_BAR), smem + SMEM_BYTES);
  phase_ln1(p);
  phase_tabconv(p);
  xcd_barrier((unsigned*)(p.ws + OFF_BAR), smem + SMEM_BYTES);
  phase_route(p, smem);
  xcd_barrier((unsigned*)(p.ws + OFF_BAR), smem + SMEM_BYTES);
  phase_upass(p, smem);
  xcd_barrier((unsigned*)(p.ws + OFF_BAR), smem + SMEM_BYTES);
  phase_vpass(p);
  xcd_barrier((unsigned*)(p.ws + OFF_BAR), smem + SMEM_BYTES);
  phase_ln2(p);
}

extern "C" void kernel_launch(void* const* d_in, const int* in_sizes, int n_in, void* d_out, int out_size, void* d_ws, size_t ws_size,
                              hipStream_t stream) {
  P p{};
  p.x = (const float*)d_in[0]; p.c = (const float*)d_in[1]; p.pos = (const int*)d_in[2];
  p.w_ada = (const float*)d_in[3]; p.b_ada = (const float*)d_in[4]; p.w_in = (const float*)d_in[5];
  p.hy_conv_w = (const float*)d_in[6]; p.hy_conv_b = (const float*)d_in[7];
  p.f1_w = (const float*)d_in[8]; p.f1_b = (const float*)d_in[9]; p.f1_freq = (const float*)d_in[10];
  p.f2_w = (const float*)d_in[11]; p.f2_b = (const float*)d_in[12]; p.f2_freq = (const float*)d_in[13];
  p.f3_w = (const float*)d_in[14]; p.hy_bias = (const float*)d_in[15];
  p.w_bh = (const float*)d_in[16]; p.w_ba = (const float*)d_in[17]; p.w_out = (const float*)d_in[18];
  p.ln1_g = (const float*)d_in[19]; p.ln1_b = (const float*)d_in[20];
  p.wq = (const float*)d_in[21]; p.keys = (const float*)d_in[22]; p.pu = (const float*)d_in[23]; p.pv = (const float*)d_in[24];
  p.ln2_g = (const float*)d_in[25]; p.ln2_b = (const float*)d_in[26];
  p.out = (float*)d_out; p.ws = (char*)d_ws;

  static int grid_blocks = 0;
  if (!grid_blocks) {
    int dev = 0, cus = 0, per_cu = 0;
    hipGetDevice(&dev);
    hipDeviceGetAttribute(&cus, hipDeviceAttributeMultiprocessorCount, dev);
    hipOccupancyMaxActiveBlocksPerMultiprocessor(&per_cu, fwd_megakernel, NT, 0);
    if (per_cu > 1) per_cu = 1;
    grid_blocks = cus * per_cu;
  }
  (void)hipMemsetAsync((char*)d_ws + OFF_BAR, 0, XCD_BAR_WORDS * 4, stream);
  void* args[] = {&p};
  hipError_t e = hipLaunchCooperativeKernel((void*)fwd_megakernel, dim3(grid_blocks), dim3(NT), args, 0, stream);
  if (e != hipSuccess) fprintf(stderr, "cooperative launch failed: %s (grid %d)\n", hipGetErrorString(e), grid_blocks);
}
```

```cpp
#include <hip/hip_runtime.h>
#include <hip/hip_cooperative_groups.h>
#include <cstdio>
#include <cstdint>

#define DI __device__ __forceinline__
typedef unsigned short ushort_t;
typedef __attribute__((ext_vector_type(8))) short bf16x8;
typedef __attribute__((ext_vector_type(16))) float f32x16;
typedef __attribute__((ext_vector_type(4))) float f32x4;
typedef __attribute__((ext_vector_type(4))) unsigned u32x4;

constexpr int T_ = 16384, S_ = 8192, NB = 2, D_ = 1024;
constexpr int HW_ = 512, HYC = 1536, QKVC = 2304, GATEC = 2048, INW = 5888;
constexpr int NT = 512;
constexpr float DN_ALPHA = 1.189207115002721f;
constexpr float LN_EPS = 1e-5f;

constexpr size_t OFF_ADA   = 0;
constexpr size_t OFF_BAR   = 49152;
constexpr size_t OFF_KEYS_B= 65536;
constexpr size_t OFF_WIN_T = 65536 + 524288;
constexpr size_t OFF_WQ_T  = OFF_WIN_T + (size_t)INW * 1024 * 2;
constexpr size_t OFF_WOUT_T= OFF_WQ_T + (size_t)2048 * 1024 * 2;
constexpr size_t OFF_WBH_T = OFF_WOUT_T + (size_t)1024 * 1024 * 2;
constexpr size_t OFF_WBA_T = OFF_WBH_T + (size_t)1024 * 512 * 2;
constexpr size_t OFF_PH    = OFF_WBA_T + (size_t)1024 * 256 * 2;
constexpr size_t OFF_QKV   = OFF_PH + (size_t)T_ * HYC * 2;
constexpr size_t OFF_GATE  = OFF_QKV + (size_t)T_ * QKVC * 2;
constexpr size_t OFF_YH    = OFF_GATE + (size_t)T_ * GATEC * 2;
constexpr size_t OFF_YA    = OFF_YH + (size_t)T_ * HW_ * 2;
constexpr size_t OFF_END   = OFF_YA + (size_t)T_ * 256 * 2;
constexpr size_t OFF_MERGED= OFF_PH;
constexpr size_t OFF_YHK   = OFF_PH + (size_t)32 * 1048576;
constexpr size_t OFF_U1B   = OFF_YH;
static_assert(OFF_U1B + (size_t)T_ * 1024 * 2 <= 268435456ull, "u1b overflow");
constexpr size_t OFF_U2B   = OFF_PH;
constexpr size_t OFF_TABU  = OFF_QKV;
constexpr size_t OFF_TABV  = OFF_QKV + (size_t)16 * 1048576;
constexpr size_t OFF_SU    = OFF_QKV + (size_t)32 * 1048576;
constexpr size_t OFF_SV    = OFF_SU + 65536;
constexpr size_t OFF_COEF  = OFF_QKV + (size_t)64 * 1048576;
constexpr size_t OFF_F     = OFF_QKV + (size_t)72 * 1048576;
static_assert(OFF_F + (size_t)64 * 1048576 <= OFF_YH, "peer buffers overflow the qkv+gate region");
constexpr size_t OFF_IDX   = OFF_YH;
constexpr size_t OFF_GV    = OFF_YH + (size_t)T_ * 128 * 4;
constexpr size_t OFF_HSCR  = OFF_END;
static_assert(OFF_HSCR + (size_t)164 * 131072 <= 268435456ull, "ws overflow");
static_assert((size_t)92 * 131072 <= (size_t)INW * 1024 * 2, "w_in^T region too small");
constexpr size_t OFF_ROPE  = OFF_HSCR + (size_t)164 * 131072;
static_assert(OFF_ROPE + (size_t)T_ * 64 <= 268435456ull, "rope table overflow");

struct P {
  const float *x, *c; const int* pos;
  const float *w_ada, *b_ada, *w_in, *hy_conv_w, *hy_conv_b, *f1_w, *f1_b, *f1_freq, *f2_w, *f2_b, *f2_freq, *f3_w,
      *hy_bias, *w_bh, *w_ba, *w_out, *ln1_g, *ln1_b, *wq, *keys, *pu, *pv, *ln2_g, *ln2_b;
  float* out; char* ws;
};

DI ushort_t f2bf(float x) { unsigned u = __float_as_uint(x); u += 0x7fffu + ((u >> 16) & 1u); return (ushort_t)(u >> 16); }
DI float bf2f(ushort_t h) { return __uint_as_float(((unsigned)h) << 16); }
typedef __bf16 bf16x2_hw __attribute__((ext_vector_type(2)));
typedef float f32x2_hw __attribute__((ext_vector_type(2)));
DI unsigned pack2(float a, float b) { f32x2_hw v = {a, b}; return __builtin_bit_cast(unsigned, __builtin_convertvector(v, bf16x2_hw)); }
DI int tid_opaque() { int t = threadIdx.x; asm volatile("" : "+v"(t)); return t; }
DI float wave_sum(float v) {
#pragma unroll
  for (int o = 32; o > 0; o >>= 1) v += __shfl_xor(v, o);
  return v;
}

struct cf2 { float x, y; };
constexpr int FFT_N = 16384, FFT_SA = 560;

DI constexpr float wcos32(int j) {
  switch (j & 31) {
    case 0: return 1.0f; case 1: return 0.98078528040323043f; case 2: return 0.92387953251128674f; case 3: return 0.83146961230254524f;
    case 4: return 0.70710678118654752f; case 5: return 0.55557023301960218f; case 6: return 0.38268343236508978f; case 7: return 0.19509032201612825f;
    case 8: return 0.0f; case 9: return -0.19509032201612825f; case 10: return -0.38268343236508978f; case 11: return -0.55557023301960218f;
    case 12: return -0.70710678118654752f; case 13: return -0.83146961230254524f; case 14: return -0.92387953251128674f; case 15: return -0.98078528040323043f;
    case 16: return -1.0f; case 17: return -0.98078528040323043f; case 18: return -0.92387953251128674f; case 19: return -0.83146961230254524f;
    case 20: return -0.70710678118654752f; case 21: return -0.55557023301960218f; case 22: return -0.38268343236508978f; case 23: return -0.19509032201612825f;
    case 24: return 0.0f; case 25: return 0.19509032201612825f; case 26: return 0.38268343236508978f; case 27: return 0.55557023301960218f;
    case 28: return 0.70710678118654752f; case 29: return 0.83146961230254524f; case 30: return 0.92387953251128674f; default: return 0.98078528040323043f;
  }
}
DI constexpr float wsin32(int j) { return wcos32(j + 24); }
DI constexpr int brev(int v, int bits) { int r = 0; for (int i = 0; i < bits; ++i) r |= ((v >> i) & 1) << (bits - 1 - i); return r; }

template <int R, int LEN, bool INV, bool ZHI>
DI void r2_stage(float (&re)[R], float (&im)[R]) {
  constexpr int half = LEN / 2;
#pragma unroll
  for (int start = 0; start < R; start += LEN) {
#pragma unroll
    for (int j = 0; j < half; ++j) {
      const int a = start + j, b = a + half;
      const int tj = j * (32 / LEN);
      const float c = wcos32(tj), s = wsin32(tj);
      if (!INV) {
        float dr, di;
        if (ZHI) { dr = re[a]; di = im[a]; }
        else {
          const float ar = re[a], ai = im[a], br = re[b], bi = im[b];
          re[a] = ar + br; im[a] = ai + bi; dr = ar - br; di = ai - bi;
        }
        if (tj == 0) { re[b] = dr; im[b] = di; }
        else if (tj == 8) { re[b] = di; im[b] = -dr; }
        else { re[b] = dr * c + di * s; im[b] = di * c - dr * s; }
      } else {
        const float br = re[b], bi = im[b];
        float pr, pi;
        if (tj == 0) { pr = br; pi = bi; }
        else if (tj == 8) { pr = -bi; pi = br; }
        else { pr = br * c - bi * s; pi = bi * c + br * s; }
        const float ar = re[a], ai = im[a];
        re[a] = ar + pr; im[a] = ai + pi; re[b] = ar - pr; im[b] = ai - pi;
      }
    }
  }
}
template <int R, bool ZHI> DI void dft_fwd(float (&re)[R], float (&im)[R]) {
  if (R == 32) r2_stage<R, (R == 32 ? 32 : 2), false, ZHI>(re, im);
  r2_stage<R, 16, false, (R == 16) && ZHI>(re, im);
  r2_stage<R, 8, false, false>(re, im);
  r2_stage<R, 4, false, false>(re, im);
  r2_stage<R, 2, false, false>(re, im);
}
template <int R> DI void dft_inv(float (&re)[R], float (&im)[R]) {
  r2_stage<R, 2, true, false>(re, im);
  r2_stage<R, 4, true, false>(re, im);
  r2_stage<R, 8, true, false>(re, im);
  r2_stage<R, 16, true, false>(re, im);
  if (R == 32) r2_stage<R, (R == 32 ? 32 : 2), true, false>(re, im);
}

DI void sincos_turn(float frac, float& s, float& c) { sincospif(2.0f * frac, &s, &c); }

template <bool ZHI>
DI void fft_fwdA(float (&re)[32], float (&im)[32], cf2* lds, int m) {
  asm volatile("" : "+v"(m));
  float s1, c1; sincos_turn((float)m * (1.0f / 16384.0f), s1, c1);
  __builtin_amdgcn_sched_barrier(0);
  dft_fwd<32, ZHI>(re, im);
  __builtin_amdgcn_sched_barrier(0);
  float wr = 1.f, wi = 0.f;
#pragma unroll
  for (int k1 = 0; k1 < 32; ++k1) {
    if ((k1 & 3) == 0) __builtin_amdgcn_sched_barrier(0);
    const int r = brev(k1, 5);
    cf2 o; o.x = re[r] * wr - im[r] * wi; o.y = re[r] * wi + im[r] * wr;
    lds[k1 * FFT_SA + m] = o;
    const float nr = wr * c1 + wi * s1, ni = wi * c1 - wr * s1;
    wr = nr; wi = ni;
  }
}
DI void fft_B_read(float (&re)[32], float (&im)[32], const cf2* lds, int tid) {
  const int k1 = tid >> 4, mp = tid & 15;
#pragma unroll
  for (int n2 = 0; n2 < 32; ++n2) { cf2 v = lds[k1 * FFT_SA + n2 * 16 + mp]; re[n2] = v.x; im[n2] = v.y; }
}
DI void fft_fwdB_write(float (&re)[32], float (&im)[32], cf2* lds, int tid) {
  asm volatile("" : "+v"(tid));
  const int k1 = tid >> 4, mp = tid & 15;
  float s1, c1; sincos_turn((float)mp * (1.0f / 512.0f), s1, c1);
  __builtin_amdgcn_sched_barrier(0);
  dft_fwd<32, false>(re, im);
  __builtin_amdgcn_sched_barrier(0);
  float wr = 1.f, wi = 0.f;
#pragma unroll
  for (int k2 = 0; k2 < 32; ++k2) {
    if ((k2 & 3) == 0) __builtin_amdgcn_sched_barrier(0);
    const int r = brev(k2, 5);
    cf2 o; o.x = re[r] * wr - im[r] * wi; o.y = re[r] * wi + im[r] * wr;
    lds[k1 * FFT_SA + k2 * 17 + mp] = o;
    const float nr = wr * c1 + wi * s1, ni = wi * c1 - wr * s1;
    wr = nr; wi = ni;
  }
}
DI void fft_fwdC(float (&re)[32], float (&im)[32], const cf2* lds, int tid) {
  const int k1 = tid >> 5, k2 = tid & 31;
#pragma unroll
  for (int h = 0; h < 2; ++h) {
    float tr[16], ti[16];
#pragma unroll
    for (int mp = 0; mp < 16; ++mp) { cf2 v = lds[(k1 + 16 * h) * FFT_SA + k2 * 17 + mp]; tr[mp] = v.x; ti[mp] = v.y; }
    dft_fwd<16, false>(tr, ti);
#pragma unroll
    for (int i = 0; i < 16; ++i) { re[h * 16 + i] = tr[i]; im[h * 16 + i] = ti[i]; }
  }
}
DI void fft_invC(float (&re)[32], float (&im)[32], cf2* lds, int tid) {
  const int k1 = tid >> 5, k2 = tid & 31;
#pragma unroll
  for (int h = 0; h < 2; ++h) {
    float tr[16], ti[16];
#pragma unroll
    for (int i = 0; i < 16; ++i) { tr[i] = re[h * 16 + i]; ti[i] = im[h * 16 + i]; }
    dft_inv<16>(tr, ti);
#pragma unroll
    for (int mp = 0; mp < 16; ++mp) { cf2 o; o.x = tr[mp]; o.y = ti[mp]; lds[(k1 + 16 * h) * FFT_SA + k2 * 17 + mp] = o; }
  }
}
DI void fft_invB_read(float (&re)[32], float (&im)[32], const cf2* lds, int tid) {
  asm volatile("" : "+v"(tid));
  const int k1 = tid >> 4, mp = tid & 15;
  float s1, c1; sincos_turn((float)mp * (1.0f / 512.0f), s1, c1);
  float wr = 1.f, wi = 0.f;
  __builtin_amdgcn_sched_barrier(0);
#pragma unroll
  for (int k2 = 0; k2 < 32; ++k2) {
    if ((k2 & 3) == 0) __builtin_amdgcn_sched_barrier(0);
    const int r = brev(k2, 5);
    cf2 v = lds[k1 * FFT_SA + k2 * 17 + mp];
    re[r] = v.x * wr - v.y * wi; im[r] = v.x * wi + v.y * wr;
    const float nr = wr * c1 - wi * s1, ni = wi * c1 + wr * s1;
    wr = nr; wi = ni;
  }
}
DI void fft_invB_write(float (&re)[32], float (&im)[32], cf2* lds, int tid) {
  const int k1 = tid >> 4, mp = tid & 15;
  dft_inv<32>(re, im);
#pragma unroll
  for (int n2 = 0; n2 < 32; ++n2) { cf2 o; o.x = re[n2]; o.y = im[n2]; lds[k1 * FFT_SA + n2 * 16 + mp] = o; }
}
DI void fft_invA(float (&re)[32], float (&im)[32], const cf2* lds, int m) {
  asm volatile("" : "+v"(m));
  float s1, c1; sincos_turn((float)m * (1.0f / 16384.0f), s1, c1);
  float wr = 1.f, wi = 0.f;
  __builtin_amdgcn_sched_barrier(0);
#pragma unroll
  for (int k1 = 0; k1 < 32; ++k1) {
    if ((k1 & 3) == 0) __builtin_amdgcn_sched_barrier(0);
    const int r = brev(k1, 5);
    cf2 v = lds[k1 * FFT_SA + m];
    re[r] = v.x * wr - v.y * wi; im[r] = v.x * wi + v.y * wr;
    const float nr = wr * c1 - wi * s1, ni = wi * c1 + wr * s1;
    wr = nr; wi = ni;
  }
  __builtin_amdgcn_sched_barrier(0);
  dft_inv<32>(re, im);
}

DI void phase_ada(const P& p, char* smem) {
  float (*red)[16][32] = (float (*)[16][32])smem;
  const int tid = tid_opaque(), cl = tid & 31, kq = tid >> 5;
  for (int item = blockIdx.x; item < 192; item += gridDim.x) {
    const int col = item * 32 + cl;
    float a0 = 0.f, a1 = 0.f;
#pragma unroll 16
    for (int k = kq * 64; k < kq * 64 + 64; ++k) {
      const float w = p.w_ada[(size_t)k * 6144 + col];
      const float c0 = p.c[k], c1 = p.c[1024 + k];
      a0 += (c0 / (1.f + __expf(-c0))) * w;
      a1 += (c1 / (1.f + __expf(-c1))) * w;
    }
    __syncthreads();
    red[0][kq][cl] = a0; red[1][kq][cl] = a1;
    __syncthreads();
    if (tid < 64) {
      const int b = tid >> 5;
      float s = p.b_ada[col];
#pragma unroll
      for (int q = 0; q < 16; ++q) s += red[b][q][cl];
      ((float*)(p.ws + OFF_ADA))[b * 6144 + col] = s;
    }
  }
}
DI void phase_u1(const P& p) {
  const float* ada = (const float*)(p.ws + OFF_ADA);
  ushort_t* u1b = (ushort_t*)(p.ws + OFF_U1B);
  for (int i = blockIdx.x * NT + tid_opaque(); i < T_ * 128; i += gridDim.x * NT) {
    const int row = i >> 7, k = (i & 127) * 8, b = row / S_;
    const float* xp = p.x + (size_t)row * 1024 + k;
    const f32x4 x0 = *(const f32x4*)xp, x1 = *(const f32x4*)(xp + 4);
    const f32x4 s0 = *(const f32x4*)(ada + b * 6144 + 1024 + k), s1 = *(const f32x4*)(ada + b * 6144 + 1024 + k + 4);
    const f32x4 h0 = *(const f32x4*)(ada + b * 6144 + k), h1 = *(const f32x4*)(ada + b * 6144 + k + 4);
    u32x4 o;
    o[0] = pack2(x0[0] * (1.f + s0[0]) + h0[0], x0[1] * (1.f + s0[1]) + h0[1]);
    o[1] = pack2(x0[2] * (1.f + s0[2]) + h0[2], x0[3] * (1.f + s0[3]) + h0[3]);
    o[2] = pack2(x1[0] * (1.f + s1[0]) + h1[0], x1[1] * (1.f + s1[1]) + h1[1]);
    o[3] = pack2(x1[2] * (1.f + s1[2]) + h1[2], x1[3] * (1.f + s1[3]) + h1[3]);
    *(u32x4*)(u1b + (size_t)row * 1024 + k) = o;
  }
}

DI void transpose_tile(const float* __restrict__ W, ushort_t* __restrict__ Wt, int K, int N, int item, char* smem) {
  float (*tile)[65] = (float (*)[65])smem;
  const int ntn = N / 64;
  const int n0 = (item % ntn) * 64, k0 = (item / ntn) * 32;
  const int tid = tid_opaque();
  __syncthreads();
  {
    const int tx = tid & 63, ty = tid >> 6;
#pragma unroll
    for (int i = 0; i < 4; ++i) tile[ty + 8 * i][tx] = W[(size_t)(k0 + ty + 8 * i) * N + n0 + tx];
  }
  __syncthreads();
  {
    const int kk = tid & 31, nn0 = tid >> 5;
#pragma unroll
    for (int i = 0; i < 4; ++i) Wt[(size_t)(n0 + nn0 + 16 * i) * K + k0 + kk] = f2bf(tile[kk][nn0 + 16 * i]);
  }
}
DI void phase_transposes(const P& p, char* smem) {
  constexpr int I0 = (INW / 64) * 32, I1 = I0 + 32 * 32, I2 = I1 + 16 * 32, I3 = I2 + 16 * 16, I4 = I3 + 16 * 8;
  for (int item = blockIdx.x; item < I4; item += gridDim.x) {
    if (item < I0) transpose_tile(p.w_in, (ushort_t*)(p.ws + OFF_WIN_T), 1024, INW, item, smem);
    else if (item < I1) transpose_tile(p.wq, (ushort_t*)(p.ws + OFF_WQ_T), 1024, 2048, item - I0, smem);
    else if (item < I2) transpose_tile(p.w_out, (ushort_t*)(p.ws + OFF_WOUT_T), 1024, 1024, item - I1, smem);
    else if (item < I3) transpose_tile(p.w_bh, (ushort_t*)(p.ws + OFF_WBH_T), 512, 1024, item - I2, smem);
    else transpose_tile(p.w_ba, (ushort_t*)(p.ws + OFF_WBA_T), 256, 1024, item - I3, smem);
  }
}

DI void phase_filter(const P& p, char* smem) {
  float (*zf)[33] = (float (*)[33])smem;
  float (*h1)[64] = (float (*)[64])(smem + 4352);
  float (*h2)[65] = (float (*)[65])(smem + 4352 + 8192);
  float* w1s = (float*)(smem + 32768);
  float* w2s = (float*)(smem + 32768 + 8448);
  const int tid = tid_opaque(), lane = tid & 63, wave = tid >> 6;
  __syncthreads();
  for (int i = tid; i < 33 * 64; i += NT) w1s[i] = p.f1_w[i];
  for (int i = tid; i < 64 * 64; i += NT) w2s[i] = p.f2_w[i];
  for (int item = blockIdx.x; item < 256; item += gridDim.x) {
  const int t0 = item * 32;
  __syncthreads();
  for (int idx = tid; idx < 32 * 33; idx += NT) {
    int tt = idx / 33, e = idx % 33, t = t0 + tt;
    float tl = (float)t * (1.0f / 8191.0f);
    float w = 6.283185307179586f * (float)t / 8192.0f;
    float val;
    if (e == 0) val = tl;
    else {
      int i = (e - 1) & 15;
      float f = 1e-4f + (float)i * ((15.0f - 1e-4f) / 15.0f);
      val = (e <= 16) ? cosf(f * w) : -sinf(f * w);
    }
    zf[tt][e] = val;
  }
  __syncthreads();
  for (int idx = tid; idx < 32 * 64; idx += NT) {
    int tt = idx >> 6, j = idx & 63;
    float a = p.f1_b[j];
#pragma unroll
    for (int e = 0; e < 33; ++e) a += zf[tt][e] * w1s[e * 64 + j];
    h1[tt][j] = sinf(p.f1_freq[j] * a);
  }
  __syncthreads();
  for (int idx = tid; idx < 32 * 64; idx += NT) {
    int tt = idx >> 6, j = idx & 63;
    float a = p.f2_b[j];
#pragma unroll
    for (int e = 0; e < 64; ++e) a += h1[tt][e] * w2s[e * 64 + j];
    h2[tt][j] = sinf(p.f2_freq[j] * a);
  }
  __syncthreads();
  float* filt = p.out;
  const float min_decay = -3.0701134573253945f, max_decay = -15.350567286626973f;
  float af[32];
#pragma unroll
  for (int s = 0; s < 32; ++s) af[s] = h2[lane & 31][2 * s + (lane >> 5)];
#pragma unroll 1
  for (int ci = 0; ci < 8; ++ci) {
    const int col = (wave + 8 * ci) * 32 + (lane & 31);
    const float* wp = p.f3_w + (size_t)(lane >> 5) * 2048 + col;
    float bfv[32];
#pragma unroll
    for (int s = 0; s < 32; ++s) bfv[s] = wp[(size_t)s * 4096];
    f32x16 acc;
#pragma unroll
    for (int r = 0; r < 16; ++r) acc[r] = 0.f;
#pragma unroll
    for (int s = 0; s < 32; ++s) acc = __builtin_amdgcn_mfma_f32_32x32x2f32(af[s], bfv[s], acc, 0, 0, 0);
    const float delta = fabsf(min_decay + (float)(col & 511) * ((max_decay - min_decay) / 511.0f));
    float* dst = filt + (size_t)col * 8192 + t0 + 4 * (lane >> 5);
#pragma unroll
    for (int q = 0; q < 4; ++q) {
      f32x4 o;
#pragma unroll
      for (int r = 0; r < 4; ++r) {
        const float tl = (float)(t0 + 8 * q + 4 * (lane >> 5) + r) * (1.0f / 8191.0f);
        o[r] = acc[4 * q + r] * __expf(-tl * delta);
      }
      *(f32x4*)(dst + 8 * q) = o;
    }
  }
  }
}

constexpr int BM = 256, BN = 128, BK = 64;
constexpr int LDS_A = BM * BK * 2, LDS_B = BN * BK * 2, LDS_STAGE = LDS_A + LDS_B;
constexpr int GEMM_LDS = 2 * LDS_STAGE + 8192;

DI int swz(int row, int ch) { return row * 128 + ((ch ^ (row & 7)) << 4); }

struct ALoadBf16 {
  const ushort_t* A; int lda;
  struct Raw { u32x4 v; };
  DI Raw fetch(int row, int k) const { Raw r; r.v = *(const u32x4*)(A + (size_t)row * lda + k); return r; }
  DI u32x4 cvt(const Raw& r, int k) const { return r.v; }
};
struct ALoadF32Mod {
  const float* A; const float* mod;
  struct Raw { f32x4 a, b; };
  DI Raw fetch(int row, int k) const { Raw r; const float* s = A + (size_t)row * 1024 + k; r.a = *(const f32x4*)s; r.b = *(const f32x4*)(s + 4); return r; }
  DI u32x4 cvt(const Raw& r, int k) const {
    f32x4 s0 = *(const f32x4*)(mod + k), s1 = *(const f32x4*)(mod + k + 4);
    f32x4 h0 = *(const f32x4*)(mod + 1024 + k), h1 = *(const f32x4*)(mod + 1024 + k + 4);
    u32x4 o;
    o[0] = pack2(r.a[0] * s0[0] + h0[0], r.a[1] * s0[1] + h0[1]);
    o[1] = pack2(r.a[2] * s0[2] + h0[2], r.a[3] * s0[3] + h0[3]);
    o[2] = pack2(r.b[0] * s1[0] + h1[0], r.b[1] * s1[1] + h1[1]);
    o[3] = pack2(r.b[2] * s1[2] + h1[2], r.b[3] * s1[3] + h1[3]);
    return o;
  }
};

template <class AL, bool SWAP = false>
DI void gemm_mainloop(f32x16 (&acc)[2][2], const AL& al, int m0, const ushort_t* __restrict__ Bt, int ldb, int n0, int K, char* smem) {
  const int tid = tid_opaque(), lane = tid & 63, wave = tid >> 6;
  const int wm = wave >> 1, wn = wave & 1;
  const int lr = tid >> 3, lc = tid & 7;
  typename AL::Raw ra[4]; u32x4 rb[2];
  const int nk = K / BK;
#pragma unroll
  for (int i = 0; i < 4; ++i) ra[i] = al.fetch(m0 + lr + 64 * i, lc * 8);
#pragma unroll
  for (int i = 0; i < 2; ++i) rb[i] = *(const u32x4*)(Bt + (size_t)(n0 + lr + 64 * i) * ldb + lc * 8);
  __syncthreads();
#pragma unroll
  for (int i = 0; i < 4; ++i) *(u32x4*)(smem + swz(lr + 64 * i, lc)) = al.cvt(ra[i], lc * 8);
#pragma unroll
  for (int i = 0; i < 2; ++i) *(u32x4*)(smem + LDS_A + swz(lr + 64 * i, lc)) = rb[i];
  __syncthreads();
  for (int kt = 0; kt < nk; ++kt) {
    char* cur = smem + (kt & 1) * LDS_STAGE;
    char* nxt = smem + ((kt + 1) & 1) * LDS_STAGE;
    const bool more = (kt + 1 < nk);
    const int kn = (kt + 1) * BK + lc * 8;
    if (more) {
#pragma unroll
      for (int i = 0; i < 4; ++i) ra[i] = al.fetch(m0 + lr + 64 * i, kn);
#pragma unroll
      for (int i = 0; i < 2; ++i) rb[i] = *(const u32x4*)(Bt + (size_t)(n0 + lr + 64 * i) * ldb + kn);
    }
#pragma unroll
    for (int s = 0; s < 4; ++s) {
      const int ch = 2 * s + (lane >> 5);
      bf16x8 af[2], bfr[2];
#pragma unroll
      for (int mi = 0; mi < 2; ++mi) af[mi] = *(const bf16x8*)(cur + swz(wm * 64 + mi * 32 + (lane & 31), ch));
#pragma unroll
      for (int ni = 0; ni < 2; ++ni) bfr[ni] = *(const bf16x8*)(cur + LDS_A + swz(wn * 64 + ni * 32 + (lane & 31), ch));
#pragma unroll
      for (int mi = 0; mi < 2; ++mi)
#pragma unroll
        for (int ni = 0; ni < 2; ++ni)
          acc[mi][ni] = SWAP ? __builtin_amdgcn_mfma_f32_32x32x16_bf16(bfr[ni], af[mi], acc[mi][ni], 0, 0, 0)
                             : __builtin_amdgcn_mfma_f32_32x32x16_bf16(af[mi], bfr[ni], acc[mi][ni], 0, 0, 0);
    }
    if (more) {
#pragma unroll
      for (int i = 0; i < 4; ++i) *(u32x4*)(nxt + swz(lr + 64 * i, lc)) = al.cvt(ra[i], kn);
#pragma unroll
      for (int i = 0; i < 2; ++i) *(u32x4*)(nxt + LDS_A + swz(lr + 64 * i, lc)) = rb[i];
    }
    __syncthreads();
  }
}

constexpr int AT_ROW = 576;
constexpr int LDS_AT = 64 * AT_ROW;
constexpr int LDS_STAGE_T = LDS_AT + LDS_B;
typedef __attribute__((ext_vector_type(4))) short s16x4;
DI void gemm_mainloop_AT(f32x16 (&acc)[2][2], const ushort_t* __restrict__ At, size_t ldt, const ushort_t* __restrict__ Bt, int ldb, int n0, int K, char* smem) {
  const int tid = tid_opaque(), lane = tid & 63, wave = tid >> 6;
  const int wm = wave >> 1, wn = wave & 1;
  const int lr = tid >> 3, lc = tid & 7;
  u32x4 ra[4], rb[2];
  const int nk = K / BK;
#pragma unroll
  for (int i = 0; i < 4; ++i) { const int q = tid + 512 * i; ra[i] = *(const u32x4*)(At + (size_t)(q >> 5) * ldt + (q & 31) * 8); }
#pragma unroll
  for (int i = 0; i < 2; ++i) rb[i] = *(const u32x4*)(Bt + (size_t)(n0 + lr + 64 * i) * ldb + lc * 8);
  __syncthreads();
#pragma unroll
  for (int i = 0; i < 4; ++i) { const int q = tid + 512 * i; *(u32x4*)(smem + (q >> 5) * AT_ROW + (q & 31) * 16) = ra[i]; }
#pragma unroll
  for (int i = 0; i < 2; ++i) *(u32x4*)(smem + LDS_AT + swz(lr + 64 * i, lc)) = rb[i];
  __syncthreads();
  const int hh = lane >> 5, gg = (lane >> 4) & 1, qq = (lane & 15) >> 2, pp = lane & 3;
  for (int kt = 0; kt < nk; ++kt) {
    char* cur = smem + (kt & 1) * LDS_STAGE_T;
    char* nxt = smem + ((kt + 1) & 1) * LDS_STAGE_T;
    const bool more = (kt + 1 < nk);
    if (more) {
#pragma unroll
      for (int i = 0; i < 4; ++i) { const int q = tid + 512 * i; ra[i] = *(const u32x4*)(At + (size_t)((kt + 1) * BK + (q >> 5)) * ldt + (q & 31) * 8); }
#pragma unroll
      for (int i = 0; i < 2; ++i) rb[i] = *(const u32x4*)(Bt + (size_t)(n0 + lr + 64 * i) * ldb + (kt + 1) * BK + lc * 8);
    }
#pragma unroll
    for (int s = 0; s < 4; ++s) {
      const int ch = 2 * s + hh;
      bf16x8 af[2], bfr[2];
#pragma unroll
      for (int mi = 0; mi < 2; ++mi) {
        const char* a0 = cur + (16 * s + 8 * hh + qq) * AT_ROW + (wm * 64 + mi * 32 + 16 * gg + 4 * pp) * 2;
        s16x4 lo = __builtin_amdgcn_ds_read_tr16_b64_v4i16((__attribute__((address_space(3))) s16x4*)(a0));
        s16x4 hi = __builtin_amdgcn_ds_read_tr16_b64_v4i16((__attribute__((address_space(3))) s16x4*)(a0 + 4 * AT_ROW));
        af[mi] = __builtin_shufflevector(lo, hi, 0, 1, 2, 3, 4, 5, 6, 7);
      }
#pragma unroll
      for (int ni = 0; ni < 2; ++ni) bfr[ni] = *(const bf16x8*)(cur + LDS_AT + swz(wn * 64 + ni * 32 + (lane & 31), ch));
#pragma unroll
      for (int mi = 0; mi < 2; ++mi)
#pragma unroll
        for (int ni = 0; ni < 2; ++ni) acc[mi][ni] = __builtin_amdgcn_mfma_f32_32x32x16_bf16(af[mi], bfr[ni], acc[mi][ni], 0, 0, 0);
    }
    if (more) {
#pragma unroll
      for (int i = 0; i < 4; ++i) { const int q = tid + 512 * i; *(u32x4*)(nxt + (q >> 5) * AT_ROW + (q & 31) * 16) = ra[i]; }
#pragma unroll
      for (int i = 0; i < 2; ++i) *(u32x4*)(nxt + LDS_AT + swz(lr + 64 * i, lc)) = rb[i];
    }
    __syncthreads();
  }
}

constexpr int G2_A = 32768, G2_STAGE = 65536;
template <bool SWAP>
DI void gemm256(f32x16 (&acc)[4][2], const ushort_t* __restrict__ A, int lda, int m0, const ushort_t* __restrict__ Bt, int ldb, int n0, int K, char* smem) {
  const int tid = tid_opaque(), lane = tid & 63, wave = tid >> 6;
  const int wm = wave >> 2, wn = wave & 3;
  const int lr = tid >> 3, lc = tid & 7;
  u32x4 ra[4], rb[4];
  const int nk = K / BK;
  const ushort_t* ap = A + (size_t)(m0 + lr) * lda + lc * 8;
  const ushort_t* bp = Bt + (size_t)(n0 + lr) * ldb + lc * 8;
#pragma unroll
  for (int i = 0; i < 4; ++i) { ra[i] = *(const u32x4*)(ap + (size_t)(64 * i) * lda); rb[i] = *(const u32x4*)(bp + (size_t)(64 * i) * ldb); }
  __syncthreads();
#pragma unroll
  for (int i = 0; i < 4; ++i) { *(u32x4*)(smem + swz(lr + 64 * i, lc)) = ra[i]; *(u32x4*)(smem + G2_A + swz(lr + 64 * i, lc)) = rb[i]; }
  __syncthreads();
  for (int kt = 0; kt < nk; ++kt) {
    char* cur = smem + (kt & 1) * G2_STAGE;
    char* nxt = smem + ((kt + 1) & 1) * G2_STAGE;
    const bool more = (kt + 1 < nk);
    if (more) {
#pragma unroll
      for (int i = 0; i < 4; ++i) { ra[i] = *(const u32x4*)(ap + (size_t)(64 * i) * lda + (kt + 1) * BK); rb[i] = *(const u32x4*)(bp + (size_t)(64 * i) * ldb + (kt + 1) * BK); }
    }
#pragma unroll
    for (int s = 0; s < 4; ++s) {
      const int ch = 2 * s + (lane >> 5);
      bf16x8 af[4], bfr[2];
#pragma unroll
      for (int mi = 0; mi < 4; ++mi) af[mi] = *(const bf16x8*)(cur + swz(wm * 128 + mi * 32 + (lane & 31), ch));
#pragma unroll
      for (int ni = 0; ni < 2; ++ni) bfr[ni] = *(const bf16x8*)(cur + G2_A + swz(wn * 64 + ni * 32 + (lane & 31), ch));
#pragma unroll
      for (int mi = 0; mi < 4; ++mi)
#pragma unroll
        for (int ni = 0; ni < 2; ++ni)
          acc[mi][ni] = SWAP ? __builtin_amdgcn_mfma_f32_32x32x16_bf16(bfr[ni], af[mi], acc[mi][ni], 0, 0, 0)
                             : __builtin_amdgcn_mfma_f32_32x32x16_bf16(af[mi], bfr[ni], acc[mi][ni], 0, 0, 0);
      if (s & 1) __builtin_amdgcn_sched_barrier(0);
    }
    if (more) {
#pragma unroll
      for (int i = 0; i < 4; ++i) { *(u32x4*)(nxt + swz(lr + 64 * i, lc)) = ra[i]; *(u32x4*)(nxt + G2_A + swz(lr + 64 * i, lc)) = rb[i]; }
    }
    __syncthreads();
  }
}
constexpr int G2T_A = 64 * 576, G2T_STAGE = G2T_A + 32768;
DI void gemm256_AT(f32x16 (&acc)[4][2], const ushort_t* __restrict__ At, size_t ldt, const ushort_t* __restrict__ Bt, int ldb, int n0, int K, char* smem) {
  const int tid = tid_opaque(), lane = tid & 63, wave = tid >> 6;
  const int wm = wave >> 2, wn = wave & 3;
  const int lr = tid >> 3, lc = tid & 7;
  u32x4 ra[4], rb[4];
  const int nk = K / BK;
  const ushort_t* bp = Bt + (size_t)(n0 + lr) * ldb + lc * 8;
#pragma unroll
  for (int i = 0; i < 4; ++i) { const int q = tid + 512 * i; ra[i] = *(const u32x4*)(At + (size_t)(q >> 5) * ldt + (q & 31) * 8); rb[i] = *(const u32x4*)(bp + (size_t)(64 * i) * ldb); }
  __syncthreads();
#pragma unroll
  for (int i = 0; i < 4; ++i) { const int q = tid + 512 * i; *(u32x4*)(smem + (q >> 5) * 576 + (q & 31) * 16) = ra[i]; *(u32x4*)(smem + G2T_A + swz(lr + 64 * i, lc)) = rb[i]; }
  __syncthreads();
  const int hh = lane >> 5, gg = (lane >> 4) & 1, qq = (lane & 15) >> 2, pp = lane & 3;
  for (int kt = 0; kt < nk; ++kt) {
    char* cur = smem + (kt & 1) * G2T_STAGE;
    char* nxt = smem + ((kt + 1) & 1) * G2T_STAGE;
    const bool more = (kt + 1 < nk);
    if (more) {
#pragma unroll
      for (int i = 0; i < 4; ++i) { const int q = tid + 512 * i; ra[i] = *(const u32x4*)(At + (size_t)((kt + 1) * BK + (q >> 5)) * ldt + (q & 31) * 8); rb[i] = *(const u32x4*)(bp + (size_t)(64 * i) * ldb + (kt + 1) * BK); }
    }
#pragma unroll
    for (int s = 0; s < 4; ++s) {
      const int ch = 2 * s + hh;
      bf16x8 af[4], bfr[2];
#pragma unroll
      for (int mi = 0; mi < 4; ++mi) {
        const char* a0 = cur + (16 * s + 8 * hh + qq) * 576 + (wm * 128 + mi * 32 + 16 * gg + 4 * pp) * 2;
        s16x4 lo = __builtin_amdgcn_ds_read_tr16_b64_v4i16((__attribute__((address_space(3))) s16x4*)(a0));
        s16x4 hi = __builtin_amdgcn_ds_read_tr16_b64_v4i16((__attribute__((address_space(3))) s16x4*)(a0 + 4 * 576));
        af[mi] = __builtin_shufflevector(lo, hi, 0, 1, 2, 3, 4, 5, 6, 7);
      }
#pragma unroll
      for (int ni = 0; ni < 2; ++ni) bfr[ni] = *(const bf16x8*)(cur + G2T_A + swz(wn * 64 + ni * 32 + (lane & 31), ch));
#pragma unroll
      for (int mi = 0; mi < 4; ++mi)
#pragma unroll
        for (int ni = 0; ni < 2; ++ni) acc[mi][ni] = __builtin_amdgcn_mfma_f32_32x32x16_bf16(af[mi], bfr[ni], acc[mi][ni], 0, 0, 0);
      if (s & 1) __builtin_amdgcn_sched_barrier(0);
    }
    if (more) {
#pragma unroll
      for (int i = 0; i < 4; ++i) { const int q = tid + 512 * i; *(u32x4*)(nxt + (q >> 5) * 576 + (q & 31) * 16) = ra[i]; *(u32x4*)(nxt + G2T_A + swz(lr + 64 * i, lc)) = rb[i]; }
    }
    __syncthreads();
  }
}
DI void acc_zero4(f32x16 (&acc)[4][2]) {
#pragma unroll
  for (int a = 0; a < 4; ++a)
#pragma unroll
    for (int b = 0; b < 2; ++b)
#pragma unroll
      for (int r = 0; r < 16; ++r) acc[a][b][r] = 0.f;
}
DI void acc_zero(f32x16 (&acc)[2][2]) {
#pragma unroll
  for (int a = 0; a < 2; ++a)
#pragma unroll
    for (int b = 0; b < 2; ++b)
#pragma unroll
      for (int r = 0; r < 16; ++r) acc[a][b][r] = 0.f;
}
#define ACC_ROW(mi, r) (wm * 64 + (mi) * 32 + ((r) & 3) + 8 * ((r) >> 2) + 4 * (lane >> 5))
#define ACC_COL(ni) (wn * 64 + (ni) * 32 + (lane & 31))

DI void stage_mod(float* mod, const float* ada, int b, int sc_chunk, int sh_chunk) {
  for (int i = tid_opaque(); i < 1024; i += NT) {
    mod[i] = 1.f + ada[b * 6144 + sc_chunk * 1024 + i];
    mod[1024 + i] = ada[b * 6144 + sh_chunk * 1024 + i];
  }
}


namespace pg8 {
#define PG8_LAS __attribute__((address_space(3)))
constexpr int BM8 = 256, BK8 = 64, HALF = 128, HTB = HALF * BK8 * 2, STAGE_BYTES = 8 * HTB, NXCD = 8, WGM = 8;
DI int lds_byte(int r, int c) { const int st = (r >> 4) * 2 + (c >> 5), rr = r & 15, cc = c & 31, ob = rr * 64 + cc * 2; return st * 1024 + (ob ^ (((ob >> 9) & 1) << 5)); }
DI void stage_rc(int b, int& R, int& C) { const int st = b / 1024, sb = b % 1024, sw = sb ^ (((sb >> 9) & 1) << 5); R = (st >> 1) * 16 + sw / 64; C = (st & 1) * 32 + (sw % 64) / 2; }
DI int perm32(int rho) { const int n = rho >> 4, i = rho & 15; return 8 * (i >> 2) + 4 * n + (i & 3); }
struct Unit { int pm, pn, kind; };
DI void tile_order(int L, int nM, int nN, int& pm, int& pn) {
  const int nwg = nM * nN;
  int wgid = L; { const int q = nwg / NXCD, r = nwg % NXCD, xcd = wgid % NXCD, off = wgid / NXCD; wgid = (xcd < r ? xcd * (q + 1) : r * (q + 1) + (xcd - r) * q) + off; }
  const int nig = WGM * nN, gid = wgid / nig, fm = gid * WGM, gsz = (nM - fm) < WGM ? (nM - fm) : WGM;
  pm = fm + ((wgid % nig) % gsz); pn = (wgid % nig) / gsz;
}
typedef float f32x4p __attribute__((ext_vector_type(4)));
template <class Epi, class Sched>
DI void gemm_phase(PG8_LAS unsigned char* lds, const int K_, const Sched& S, const Epi& E) {
    int K = K_; asm volatile("" : "+s"(K));
    const int tid = tid_opaque();
    const int wid = __builtin_amdgcn_readfirstlane(tid >> 6), lane = tid & 63, wr = wid >> 2, wc = wid & 3, fr = lane & 15, fq = lane >> 4;
    const int nt = K / BK8;
    unsigned voffA[2], voffB[2];
#pragma unroll
    for (int i = 0; i < 2; ++i) { int R, C; stage_rc(tid * 16 + i * 8192, R, C); const int Rb = Epi::PERM ? ((R & ~31) + perm32(R & 31)) : R;
        voffA[i] = (unsigned)(R * K + C) * 2u; voffB[i] = (unsigned)(Rb * K + C) * 2u; }
    const size_t kstep = (size_t)(BK8 * 2);
    const size_t hstep = (size_t)HALF * K * 2;
    const unsigned ldsw = (unsigned)wid * 1024u;
    const int aoff = lds_byte(wr * 64 + fr, fq * 8), boff = lds_byte(wc * 32 + fr, fq * 8);
#define PG8_SA(b, h) (((b) * 2 + (h)) * HTB)
#define PG8_SB(b, h) ((4 + (b) * 2 + (h)) * HTB)
#define PG8_STAGE(bufoff, gbase, voff) do { _Pragma("unroll") for (int _i = 0; _i < 2; ++_i) \
        __builtin_amdgcn_global_load_lds((const unsigned*)((const char*)(gbase) + (voff)[_i]), (PG8_LAS unsigned*)(lds + (bufoff) + ldsw + _i * 8192), 16, 0, 0); } while (0)
#define PG8_LDA(dst, b, h) do { _Pragma("unroll") for (int m = 0; m < 4; ++m) _Pragma("unroll") for (int k = 0; k < 2; ++k) dst[m][k] = *(const PG8_LAS bf16x8*)(lds + PG8_SA(b, h) + aoff + m * 2048 + k * 1024); } while (0)
#define PG8_LDB(dst, b, h) do { _Pragma("unroll") for (int n = 0; n < 2; ++n) _Pragma("unroll") for (int k = 0; k < 2; ++k) dst[n][k] = *(const PG8_LAS bf16x8*)(lds + PG8_SB(b, h) + boff + n * 2048 + k * 1024); } while (0)
#define PG8_MMA(ai, bj, At, Bt) do { __builtin_amdgcn_s_setprio(1); _Pragma("unroll") for (int m = 0; m < 4; ++m) _Pragma("unroll") for (int n = 0; n < 2; ++n) _Pragma("unroll") for (int k = 0; k < 2; ++k) \
        acc[ai][bj][m][n] = __builtin_amdgcn_mfma_f32_16x16x32_bf16(Bt[n][k], At[m][k], acc[ai][bj][m][n], 0, 0, 0); __builtin_amdgcn_s_setprio(0); } while (0)
#define PG8_WAIT_V(n) asm volatile("s_waitcnt vmcnt(" #n ")" ::: "memory")
#define PG8_WAIT_L(n) asm volatile("s_waitcnt lgkmcnt(" #n ")" ::: "memory")
#define PG8_BAR __builtin_amdgcn_s_barrier()
#define PG8_SCHED __builtin_amdgcn_sched_barrier(0)
    Unit cur, nxt; int ui = 0;
    if (!S.next(0, cur)) return;
    f32x4p acc[2][2][4][2];
#pragma unroll
    for (int a = 0; a < 2; ++a)
#pragma unroll
        for (int b = 0; b < 2; ++b)
#pragma unroll
            for (int m = 0; m < 4; ++m)
#pragma unroll
                for (int n = 0; n < 2; ++n) acc[a][b][m][n] = (f32x4p){0.f, 0.f, 0.f, 0.f};
    bf16x8 At[4][2], B0[2][2], B1[2][2];
    const char* cA = S.a_ptr(cur); const char* cB = S.b_ptr(cur);
    PG8_STAGE(PG8_SB(0, 0), cB, voffB); PG8_STAGE(PG8_SA(0, 0), cA, voffA); PG8_STAGE(PG8_SB(0, 1), cB + hstep, voffB); PG8_STAGE(PG8_SA(0, 1), cA + hstep, voffA);
    if (wr == 1) PG8_BAR;
    PG8_WAIT_V(4); PG8_BAR;
    PG8_STAGE(PG8_SB(1, 0), cB + kstep, voffB); PG8_STAGE(PG8_SA(1, 0), cA + kstep, voffA); PG8_STAGE(PG8_SB(1, 1), cB + hstep + kstep, voffB);
    PG8_WAIT_V(6); PG8_BAR;
    for (;;) {
        const bool has_next = S.next(ui + 1, nxt);
        const char* nA = has_next ? S.a_ptr(nxt) : cA; const char* nB = has_next ? S.b_ptr(nxt) : cB;
        for (int t = 0; t < nt; t += 2) {
            const bool last = (t == nt - 2);
            const char* a1 = cA + (size_t)(t + 1) * kstep;
            const char* a2 = last ? nA : cA + (size_t)(t + 2) * kstep; const char* b2 = last ? nB : cB + (size_t)(t + 2) * kstep;
            const char* a3 = a2 + kstep; const char* b3 = b2 + kstep;
            PG8_LDB(B0, 0, 0); PG8_SCHED; PG8_LDA(At, 0, 0); PG8_STAGE(PG8_SA(1, 1), a1 + hstep, voffA);
            PG8_WAIT_L(8); PG8_BAR; PG8_WAIT_L(0); PG8_MMA(0, 0, At, B0); PG8_BAR; PG8_SCHED;
            PG8_LDB(B1, 0, 1); PG8_STAGE(PG8_SB(0, 0), b2, voffB);
            PG8_BAR; PG8_WAIT_L(0); PG8_MMA(0, 1, At, B1); PG8_BAR;
            PG8_LDA(At, 0, 1); PG8_STAGE(PG8_SA(0, 0), a2, voffA);
            PG8_BAR; PG8_WAIT_L(0); PG8_MMA(1, 0, At, B0); PG8_BAR; PG8_SCHED;
            PG8_STAGE(PG8_SB(0, 1), b2 + hstep, voffB);
            PG8_WAIT_V(6); PG8_BAR; PG8_MMA(1, 1, At, B1); PG8_BAR;
            PG8_LDB(B0, 1, 0); PG8_SCHED; PG8_LDA(At, 1, 0); PG8_STAGE(PG8_SA(0, 1), a2 + hstep, voffA);
            PG8_WAIT_L(8); PG8_BAR; PG8_WAIT_L(0); PG8_MMA(0, 0, At, B0); PG8_BAR; PG8_SCHED;
            PG8_LDB(B1, 1, 1); PG8_STAGE(PG8_SB(1, 0), b3, voffB);
            PG8_BAR; PG8_WAIT_L(0); PG8_MMA(0, 1, At, B1); PG8_BAR;
            PG8_LDA(At, 1, 1); PG8_STAGE(PG8_SA(1, 0), a3, voffA);
            PG8_BAR; PG8_WAIT_L(0); PG8_MMA(1, 0, At, B0); PG8_BAR; PG8_SCHED;
            PG8_STAGE(PG8_SB(1, 1), b3 + hstep, voffB);
            PG8_WAIT_V(6); PG8_BAR; PG8_MMA(1, 1, At, B1); PG8_BAR;
        }
        if constexpr (!Epi::AFTER_DRAIN) E(acc, cur, wr, wc, fr, fq);
        if (!has_next) break;
#pragma unroll
        for (int a = 0; a < 2; ++a)
#pragma unroll
            for (int b = 0; b < 2; ++b)
#pragma unroll
                for (int m = 0; m < 4; ++m)
#pragma unroll
                    for (int n = 0; n < 2; ++n) acc[a][b][m][n] = (f32x4p){0.f, 0.f, 0.f, 0.f};
        cur = nxt; cA = nA; cB = nB; ++ui;
    }
    PG8_WAIT_V(0);
    if (wr == 0) PG8_BAR;
    PG8_BAR;
    if constexpr (Epi::AFTER_DRAIN) E.fused(acc, cur, wr, wc, fr, fq, lds, wid, lane);
#undef PG8_SA
#undef PG8_SB
#undef PG8_STAGE
#undef PG8_LDA
#undef PG8_LDB
#undef PG8_MMA
#undef PG8_WAIT_V
#undef PG8_WAIT_L
#undef PG8_BAR
#undef PG8_SCHED
}
}
typedef pg8::f32x4p f32x4p;
DI u32x4 pack8(const f32x4p& a, const f32x4p& b) { u32x4 w; w[0] = pack2(a[0], a[1]); w[1] = pack2(a[2], a[3]); w[2] = pack2(b[0], b[1]); w[3] = pack2(b[2], b[3]); return w; }

struct InprojSched {
  const char* u1b; const char* wt; int G, c;
  DI bool next(int i, pg8::Unit& u) const {
    const int L = i * G + c;
    if (L >= 384 + 1088) return false;
    if (L < 384) { u.kind = 0; pg8::tile_order(L, 6, 64, u.pm, u.pn); } else { u.kind = 1; pg8::tile_order(L - 384, 64, 17, u.pm, u.pn); }
    return true;
  }
  DI const char* a_ptr(const pg8::Unit& u) const { return u.kind == 0 ? wt + (size_t)u.pm * (256 * 1024 * 2) : u1b + (size_t)u.pm * (256 * 1024 * 2); }
  DI const char* b_ptr(const pg8::Unit& u) const { return u.kind == 0 ? u1b + (size_t)u.pn * (256 * 1024 * 2) : wt + (size_t)(1536 + u.pn * 256) * (1024 * 2); }
};
struct InprojEpi {
  static constexpr bool PERM = true, AFTER_DRAIN = false;
  ushort_t* ph; ushort_t* qkv; ushort_t* gate; const float* rope;
  DI void operator()(const f32x4p (&acc)[2][2][4][2], const pg8::Unit& u, int wr, int wc, int fr, int fq) const {
    if (u.kind == 0) {
      const int b = (u.pn * 256) >> 13;
      ushort_t* base = ph + ((size_t)(b * HYC + u.pm * 256 + wr * 64 + fr)) * S_ + ((u.pn * 256) & (S_ - 1)) + wc * 32 + 8 * fq;
#pragma unroll
      for (int ai = 0; ai < 2; ++ai)
#pragma unroll
        for (int m = 0; m < 4; ++m)
#pragma unroll
          for (int bj = 0; bj < 2; ++bj) *(u32x4*)(base + (size_t)(ai * 128 + m * 16) * S_ + bj * 128) = pack8(acc[ai][bj][m][0], acc[ai][bj][m][1]);
      return;
    }
    const int row0 = u.pm * 256 + wr * 64 + fr;
    if (u.pn < 9) {
      const int cq0 = u.pn * 256 + wc * 32 + 8 * fq;
      const bool rotw = (u.pn < 6) && ((wc & 1) == 0);
      const float qs = (u.pn < 3) ? 0.125f : 1.0f;
#pragma unroll
      for (int ai = 0; ai < 2; ++ai)
#pragma unroll
        for (int m = 0; m < 4; ++m) {
          const int row = row0 + ai * 128 + m * 16;
          f32x4p cs[4];
          if (rotw) {
#pragma unroll
            for (int q = 0; q < 4; ++q) cs[q] = *(const f32x4p*)(rope + (size_t)row * 16 + q * 4);
          }
#pragma unroll
          for (int bj = 0; bj < 2; ++bj) {
            f32x4p v0 = acc[ai][bj][m][0], v1 = acc[ai][bj][m][1];
            if (rotw) {
              f32x4p o0, o1;
#pragma unroll
              for (int j = 0; j < 4; ++j) { o0[j] = __shfl_xor(v0[j], 16); o1[j] = __shfl_xor(v1[j], 16); }
              if (fq < 2) {
                const float sg = (fq == 0) ? -1.f : 1.f;
#pragma unroll
                for (int j = 0; j < 4; ++j) {
                  const float c0 = cs[j >> 1][(j & 1) * 2], s0 = cs[j >> 1][(j & 1) * 2 + 1];
                  const float c1 = cs[2 + (j >> 1)][(j & 1) * 2], s1 = cs[2 + (j >> 1)][(j & 1) * 2 + 1];
                  v0[j] = v0[j] * c0 + sg * o0[j] * s0;
                  v1[j] = v1[j] * c1 + sg * o1[j] * s1;
                }
              }
            }
            *(u32x4*)(qkv + (size_t)row * QKVC + cq0 + bj * 128) = pack8(v0 * qs, v1 * qs);
          }
        }
    } else {
      const int cg0 = (u.pn - 9) * 256 + wc * 32 + 8 * fq;
#pragma unroll
      for (int ai = 0; ai < 2; ++ai)
#pragma unroll
        for (int m = 0; m < 4; ++m)
#pragma unroll
          for (int bj = 0; bj < 2; ++bj) {
            f32x4p v0 = acc[ai][bj][m][0], v1 = acc[ai][bj][m][1];
#pragma unroll
            for (int j = 0; j < 4; ++j) { v0[j] = 1.f / (1.f + __expf(-v0[j])); v1[j] = 1.f / (1.f + __expf(-v1[j])); }
            *(u32x4*)(gate + (size_t)(row0 + ai * 128 + m * 16) * GATEC + cg0 + bj * 128) = pack8(v0, v1);
          }
    }
  }
};
DI void phase_inproj(const P& p, char* smem) {
  InprojSched S{p.ws + OFF_U1B, p.ws + OFF_WIN_T, (int)gridDim.x, (int)blockIdx.x};
  InprojEpi E{(ushort_t*)(p.ws + OFF_PH), (ushort_t*)(p.ws + OFF_QKV), (ushort_t*)(p.ws + OFF_GATE), (const float*)(p.ws + OFF_ROPE)};
  pg8::gemm_phase(( __attribute__((address_space(3))) unsigned char*)smem, 1024, S, E);
}
struct PlainSched {
  const char* A; const char* Bt; int nM, nN, K, G, c;
  DI bool next(int i, pg8::Unit& u) const { const int L = i * G + c; if (L >= nM * nN) return false; u.kind = 0; pg8::tile_order(L, nM, nN, u.pm, u.pn); return true; }
  DI const char* a_ptr(const pg8::Unit& u) const { return A + (size_t)u.pm * 256 * K * 2; }
  DI const char* b_ptr(const pg8::Unit& u) const { return Bt + (size_t)u.pn * 256 * K * 2; }
};
struct OutprojEpi {
  static constexpr bool PERM = false, AFTER_DRAIN = false;
  const float* x; float* out; const float* ada;
  DI void operator()(const f32x4p (&acc)[2][2][4][2], const pg8::Unit& u, int wr, int wc, int fr, int fq) const {
    const int row0 = u.pm * 256 + wr * 64 + fr, col0 = u.pn * 256 + wc * 32 + 4 * fq, b = (u.pm * 256) / S_;
    f32x4p g1[2][2];
#pragma unroll
    for (int bj = 0; bj < 2; ++bj)
#pragma unroll
      for (int n = 0; n < 2; ++n) g1[bj][n] = *(const f32x4p*)(ada + b * 6144 + 2 * 1024 + col0 + bj * 128 + n * 16) + 1.0f;
#pragma unroll
    for (int ai = 0; ai < 2; ++ai)
#pragma unroll
      for (int m = 0; m < 4; ++m) {
        const size_t ro = (size_t)(row0 + ai * 128 + m * 16) * 1024 + col0;
#pragma unroll
        for (int bj = 0; bj < 2; ++bj)
#pragma unroll
          for (int n = 0; n < 2; ++n) {
            const f32x4p xv = *(const f32x4p*)(x + ro + bj * 128 + n * 16);
            *(f32x4p*)(out + ro + bj * 128 + n * 16) = xv * DN_ALPHA + g1[bj][n] * acc[ai][bj][m][n];
          }
      }
  }
};
DI void phase_outproj(const P& p, char* smem) {
  PlainSched S{p.ws + OFF_MERGED, p.ws + OFF_WOUT_T, 64, 4, 1024, (int)gridDim.x, (int)blockIdx.x};
  OutprojEpi E{p.x, p.out, (const float*)(p.ws + OFF_ADA)};
  pg8::gemm_phase(( __attribute__((address_space(3))) unsigned char*)smem, 1024, S, E);
}

DI float sconv_t(const ushort_t* row, int t, float w0, float w1, float w2, float cb) {
  float v = cb + w1 * bf2f(row[t]);
  if (t > 0) v += w0 * bf2f(row[t - 1]);
  if (t < S_ - 1) v += w2 * bf2f(row[t + 1]);
  return v;
}
DI void fft_C_mul_invC(cf2* lds, const cf2* __restrict__ kq, int tid, int o) {
  asm volatile("" : "+v"(tid));
  const int k1 = tid >> 5, k2 = tid & 31;
  const float sgn = o ? 1.f : -1.f;
#pragma unroll
  for (int h = 0; h < 2; ++h) {
    float tr[16], ti[16];
    cf2 kv[16], km[16];
#pragma unroll
    for (int i = 0; i < 16; ++i) {
      kv[i] = kq[(h * 16 + i) * 512 + tid];
      const int f = (k1 + 16 * h) + 32 * k2 + 1024 * brev(i, 4);
      const int fm = (16384 - f) & 16383;
      const int q1 = fm & 31, q2 = (fm >> 5) & 31, q3 = fm >> 10;
      const int rr = (q1 >> 4) * 16 + (int)(__builtin_bitreverse32((unsigned)q3) >> 28);
      km[i] = kq[rr * 512 + (q1 & 15) * 32 + q2];
    }
    cf2* blk = lds + (k1 + 16 * h) * FFT_SA + k2 * 17;
#pragma unroll
    for (int mp = 0; mp < 16; ++mp) { cf2 v = blk[mp]; tr[mp] = v.x; ti[mp] = v.y; }
    dft_fwd<16, false>(tr, ti);
#pragma unroll
    for (int i = 0; i < 16; ++i) {
      const float a = kv[i].x, b = kv[i].y, c = km[i].x, d = km[i].y;
      const float kx = o ? 0.5f * (b + d) : 0.5f * (a + c);
      const float ky = o ? 0.5f * (c - a) : 0.5f * (b - d);
      const float x = tr[i], y = ti[i];
      tr[i] = x * kx - y * ky; ti[i] = x * ky + y * kx;
    }
    dft_inv<16>(tr, ti);
#pragma unroll
    for (int mp = 0; mp < 16; ++mp) { cf2 ov; ov.x = tr[mp]; ov.y = ti[mp]; blk[mp] = ov; }
  }
  (void)sgn;
}
DI void hyena_item(const P& p, char* smem, int c) {
  cf2* lds = (cf2*)smem;
  const ushort_t* pht = (const ushort_t*)(p.ws + OFF_PH);
  ushort_t* yht = (ushort_t*)(p.ws + OFF_YH);
  cf2* kq = (cf2*)(p.ws + (blockIdx.x < 92 ? OFF_WIN_T + (size_t)blockIdx.x * 131072 : OFF_HSCR + (size_t)(blockIdx.x - 92) * 131072));
  const float* filt = p.out;
  const int tid0 = tid_opaque();
  float zr[32], zi[32];
  __syncthreads();
  {
    int tid = tid0; asm volatile("" : "+v"(tid));
    float kr[32], ki[32];
    const float* fw0 = filt + (size_t)(0 * 1024 + 0 * 512 + c) * S_;
    const float* bw0 = filt + (size_t)(1 * 1024 + 0 * 512 + c) * S_;
    const float* fw1 = filt + (size_t)(0 * 1024 + 1 * 512 + c) * S_;
    const float* bw1 = filt + (size_t)(1 * 1024 + 1 * 512 + c) * S_;
#pragma unroll
    for (int n1 = 0; n1 < 16; ++n1) { kr[n1] = fw0[n1 * 512 + tid] * (1.0f / 16384.0f); ki[n1] = fw1[n1 * 512 + tid] * (1.0f / 16384.0f); }
    if (tid == 0) { kr[0] += p.hy_bias[c] * (1.0f / 16384.0f); ki[0] += p.hy_bias[512 + c] * (1.0f / 16384.0f); }
#pragma unroll
    for (int n1 = 16; n1 < 32; ++n1) {
      const int n = n1 * 512 + tid;
      kr[n1] = (n == S_) ? 0.f : bw0[2 * S_ - n] * (1.0f / 16384.0f);
      ki[n1] = (n == S_) ? 0.f : bw1[2 * S_ - n] * (1.0f / 16384.0f);
    }
    fft_fwdA<false>(kr, ki, lds, tid); __syncthreads();
    fft_B_read(kr, ki, lds, tid); __syncthreads();
    fft_fwdB_write(kr, ki, lds, tid); __syncthreads();
    fft_fwdC(kr, ki, lds, tid);
    int ts = tid; asm volatile("" : "+v"(ts));
    cf2* kqt = kq + ts;
#pragma unroll
    for (int r = 0; r < 32; ++r) { cf2 v; v.x = kr[r]; v.y = ki[r]; kqt[r * 512] = v; }
    __syncthreads();
  }
#pragma unroll 1
  for (int o = 0; o < 2; ++o) {
    int tid = tid0; asm volatile("" : "+v"(tid));
    asm volatile("" : "+v"(tid));
    if (o == 0) {
      const float w0 = p.hy_conv_w[c], w1 = p.hy_conv_w[HYC + c], w2 = p.hy_conv_w[2 * HYC + c], cb = p.hy_conv_b[c];
      const ushort_t* r0 = pht + (size_t)(0 * HYC + c) * S_;
      const ushort_t* r1 = pht + (size_t)(1 * HYC + c) * S_;
#pragma unroll
      for (int n1 = 0; n1 < 16; ++n1) {
        const int t = n1 * 512 + tid;
        zr[n1] = sconv_t(r0, t, w0, w1, w2, cb); zi[n1] = sconv_t(r1, t, w0, w1, w2, cb);
        if (n1 & 1) asm volatile("" ::: "memory");
      }
    }
#pragma unroll
    for (int n1 = 16; n1 < 32; ++n1) { zr[n1] = 0.f; zi[n1] = 0.f; }
    fft_fwdA<true>(zr, zi, lds, tid); __syncthreads();
    fft_B_read(zr, zi, lds, tid); __syncthreads();
    fft_fwdB_write(zr, zi, lds, tid); __syncthreads();
    fft_C_mul_invC(lds, kq, tid, o); __syncthreads();
    fft_invB_read(zr, zi, lds, tid); __syncthreads();
    fft_invB_write(zr, zi, lds, tid); __syncthreads();
    fft_invA(zr, zi, lds, tid);
    int tg = tid; asm volatile("" : "+v"(tg));
    const int gch = (o + 1) * 512 + c;
    const float w0 = p.hy_conv_w[gch], w1 = p.hy_conv_w[HYC + gch], w2 = p.hy_conv_w[2 * HYC + gch], cb = p.hy_conv_b[gch];
    const ushort_t* g0 = pht + (size_t)(0 * HYC + gch) * S_;
    const ushort_t* g1 = pht + (size_t)(1 * HYC + gch) * S_;
#pragma unroll
    for (int n1 = 0; n1 < 16; ++n1) {
      const int t = n1 * 512 + tg;
      zr[n1] *= sconv_t(g0, t, w0, w1, w2, cb);
      zi[n1] *= sconv_t(g1, t, w0, w1, w2, cb);
      if (n1 & 1) asm volatile("" ::: "memory");
    }
    if (o == 1) {
#pragma unroll
      for (int n1 = 0; n1 < 16; ++n1) {
        const int t = n1 * 512 + tg;
        yht[(size_t)(0 * HW_ + c) * S_ + t] = f2bf(zr[n1]);
        yht[(size_t)(1 * HW_ + c) * S_ + t] = f2bf(zi[n1]);
      }
    }
  }
}

constexpr int ATT_VROW = 192;
constexpr int ATT_VBUF = 32 * ATT_VROW;
DI void attn_item(const P& p, char* smem, int item) {
  const ushort_t* qkv = (const ushort_t*)(p.ws + OFF_QKV);
  ushort_t* ya = (ushort_t*)(p.ws + OFF_YA);
  const int tid = tid_opaque(), lane = tid & 63, wave = tid >> 6;
  const int u = item * 8 + wave;
  const int hs = u & 3, r16 = (u >> 2) & 15, chunk = (u >> 6) & 15, b = u >> 10;
  const int qi = lane & 31, h = lane >> 5;
  char* vl = smem + wave * ATT_VBUF;
  const int tq = chunk * 512 + r16 + 16 * qi;
  const size_t bbase = (size_t)b * S_;
  f32x16 o0, o1;
#pragma unroll
  for (int r = 0; r < 16; ++r) { o0[r] = 0.f; o1[r] = 0.f; }
  float m = -1e30f, l = 0.f;
  const int g16 = (lane >> 4) & 1, q4 = (lane & 15) >> 2, p4 = lane & 3;
  __syncthreads();
#pragma unroll 1
  for (int g = 0; g < 3; ++g) {
    const int dsh = 2 * g;
    const int d = 1 << dsh, sd = 16 >> dsh, n = S_ >> dsh;
    const int head = g * 4 + hs;
    const int rc = r16 & (d - 1);
    const int P0 = (chunk * 512 + r16 - rc) >> dsh;
    const int pq = P0 + sd * qi;
    const int KB = P0 - 64;
    const int ntile = (g == 0) ? 20 : (g == 1 ? 8 : 5);
    bf16x8 bq[4];
    {
      const ushort_t* qrow = qkv + (bbase + tq) * QKVC + head * 64;
#pragma unroll
      for (int s = 0; s < 4; ++s) bq[s] = *(const bf16x8*)(qrow + (2 * s + h) * 8);
    }
    bf16x8 kn[4]; u32x4 vn[4];
    {
      const int kp = min(max(KB + qi, 0), n - 1);
      const ushort_t* krow = qkv + (bbase + rc + ((size_t)kp << dsh)) * QKVC + 768 + head * 64;
#pragma unroll
      for (int s = 0; s < 4; ++s) kn[s] = *(const bf16x8*)(krow + (2 * s + h) * 8);
#pragma unroll
      for (int i = 0; i < 4; ++i) {
        const int c = lane + 64 * i, row = c >> 3, ch = c & 7;
        const int vp = min(max(KB + row, 0), n - 1);
        vn[i] = *(const u32x4*)(qkv + (bbase + rc + ((size_t)vp << dsh)) * QKVC + 1536 + head * 64 + ch * 8);
      }
    }
#pragma unroll 1
    for (int kt = 0; kt < ntile; ++kt) {
      bf16x8 kc[4]; u32x4 vc[4];
#pragma unroll
      for (int s = 0; s < 4; ++s) kc[s] = kn[s];
#pragma unroll
      for (int i = 0; i < 4; ++i) vc[i] = vn[i];
      if (kt + 1 < ntile) {
        const int kb1 = KB + 32 * (kt + 1);
        const int kp = min(max(kb1 + qi, 0), n - 1);
        const ushort_t* krow = qkv + (bbase + rc + ((size_t)kp << dsh)) * QKVC + 768 + head * 64;
#pragma unroll
        for (int s = 0; s < 4; ++s) kn[s] = *(const bf16x8*)(krow + (2 * s + h) * 8);
#pragma unroll
        for (int i = 0; i < 4; ++i) {
          const int c = lane + 64 * i, row = c >> 3, ch = c & 7;
          const int vp = min(max(kb1 + row, 0), n - 1);
          vn[i] = *(const u32x4*)(qkv + (bbase + rc + ((size_t)vp << dsh)) * QKVC + 1536 + head * 64 + ch * 8);
        }
      }
      f32x16 st;
#pragma unroll
      for (int r = 0; r < 16; ++r) st[r] = 0.f;
#pragma unroll
      for (int s = 0; s < 4; ++s) st = __builtin_amdgcn_mfma_f32_32x32x16_bf16(kc[s], bq[s], st, 0, 0, 0);
#pragma unroll
      for (int i = 0; i < 4; ++i) { const int c = lane + 64 * i; *(u32x4*)(vl + (c >> 3) * ATT_VROW + (c & 7) * 16) = vc[i]; }
      const int kb = KB + 32 * kt + 4 * h;
      const int dk = kb - pq;
      float mx = -1e30f;
      bool ok[16];
#pragma unroll
      for (int r = 0; r < 16; ++r) {
        const int cr = (r & 3) + 8 * (r >> 2);
        ok[r] = ((unsigned)(dk + cr + 64) <= 128u) && ((unsigned)(kb + cr) < (unsigned)n);
        mx = fmaxf(mx, ok[r] ? st[r] : -1e30f);
      }
      mx = fmaxf(mx, __shfl_xor(mx, 32));
      const float mnew = fmaxf(m, mx);
      const float corr = __expf(m - mnew);
      float ps = 0.f;
      float pv[16];
#pragma unroll
      for (int r = 0; r < 16; ++r) { pv[r] = ok[r] ? __expf(st[r] - mnew) : 0.f; ps += pv[r]; }
      ps += __shfl_xor(ps, 32);
      l = l * corr + ps; m = mnew;
#pragma unroll
      for (int r = 0; r < 16; ++r) { o0[r] *= corr; o1[r] *= corr; }
      bf16x8 pf[2];
#pragma unroll
      for (int s = 0; s < 2; ++s) {
        u32x4 w;
        w[0] = pack2(pv[8 * s + 0], pv[8 * s + 1]); w[1] = pack2(pv[8 * s + 2], pv[8 * s + 3]);
        w[2] = pack2(pv[8 * s + 4], pv[8 * s + 5]); w[3] = pack2(pv[8 * s + 6], pv[8 * s + 7]);
        pf[s] = __builtin_bit_cast(bf16x8, w);
      }
      __builtin_amdgcn_wave_barrier();
      asm volatile("s_waitcnt lgkmcnt(0)" ::: "memory");
#pragma unroll
      for (int s = 0; s < 2; ++s) {
#pragma unroll
        for (int nt = 0; nt < 2; ++nt) {
          const char* a0 = vl + (16 * s + 4 * h + q4) * ATT_VROW + (32 * nt + 16 * g16 + 4 * p4) * 2;
          s16x4 lo = __builtin_amdgcn_ds_read_tr16_b64_v4i16((__attribute__((address_space(3))) s16x4*)(a0));
          s16x4 hi = __builtin_amdgcn_ds_read_tr16_b64_v4i16((__attribute__((address_space(3))) s16x4*)(a0 + 8 * ATT_VROW));
          const bf16x8 vf = __builtin_shufflevector(lo, hi, 0, 1, 2, 3, 4, 5, 6, 7);
          if (nt == 0) o0 = __builtin_amdgcn_mfma_f32_32x32x16_bf16(vf, pf[s], o0, 0, 0, 0);
          else o1 = __builtin_amdgcn_mfma_f32_32x32x16_bf16(vf, pf[s], o1, 0, 0, 0);
        }
      }
      __builtin_amdgcn_wave_barrier();
      asm volatile("s_waitcnt lgkmcnt(0)" ::: "memory");
    }
  }
  const float il = 1.f / l;
  ushort_t* op = ya + (bbase + tq) * 256 + hs * 64;
#pragma unroll
  for (int gq = 0; gq < 4; ++gq) {
    uint2 w0, w1;
    w0.x = pack2(o0[4 * gq] * il, o0[4 * gq + 1] * il); w0.y = pack2(o0[4 * gq + 2] * il, o0[4 * gq + 3] * il);
    w1.x = pack2(o1[4 * gq] * il, o1[4 * gq + 1] * il); w1.y = pack2(o1[4 * gq + 2] * il, o1[4 * gq + 3] * il);
    *(uint2*)(op + 8 * gq + 4 * h) = w0;
    *(uint2*)(op + 32 + 8 * gq + 4 * h) = w1;
  }
}

DI void phase_yh_transpose(const P& p, char* smem) {
  const ushort_t* yht = (const ushort_t*)(p.ws + OFF_YH);
  ushort_t* yhk = (ushort_t*)(p.ws + OFF_YHK);
  const int tid = tid_opaque();
  for (int item = blockIdx.x; item < 1024; item += gridDim.x) {
    const int cg = item & 15, tc = item >> 4, b = tc >> 5, t0 = (tc * 256) & (S_ - 1);
    __syncthreads();
    {
      const int ch = tid >> 4, k16 = tid & 15;
      const ushort_t* srcp = yht + (size_t)(b * HW_ + cg * 32 + ch) * S_ + t0;
#pragma unroll
      for (int i = 0; i < 2; ++i) *(u32x4*)(smem + ch * 528 + (k16 + 16 * i) * 16) = *(const u32x4*)(srcp + (k16 + 16 * i) * 8);
    }
    __syncthreads();
    {
      const int t = tid >> 1, half = tid & 1;
      unsigned w[8];
#pragma unroll
      for (int k = 0; k < 8; ++k) {
        const unsigned lo = *(const ushort_t*)(smem + (half * 16 + 2 * k) * 528 + t * 2);
        const unsigned hi = *(const ushort_t*)(smem + (half * 16 + 2 * k + 1) * 528 + t * 2);
        w[k] = lo | (hi << 16);
      }
      ushort_t* dst = yhk + (size_t)(tc * 256 + t) * HW_ + cg * 32 + half * 16;
      u32x4 o0, o1; o0[0] = w[0]; o0[1] = w[1]; o0[2] = w[2]; o0[3] = w[3]; o1[0] = w[4]; o1[1] = w[5]; o1[2] = w[6]; o1[3] = w[7];
      *(u32x4*)dst = o0; *(u32x4*)(dst + 8) = o1;
    }
  }
}
DI f32x4p bf4lo(const u32x4& w) { f32x4p r; r[0] = __uint_as_float(w[0] << 16); r[1] = __uint_as_float(w[0] & 0xffff0000u); r[2] = __uint_as_float(w[1] << 16); r[3] = __uint_as_float(w[1] & 0xffff0000u); return r; }
DI f32x4p bf4hi(const u32x4& w) { f32x4p r; r[0] = __uint_as_float(w[2] << 16); r[1] = __uint_as_float(w[2] & 0xffff0000u); r[2] = __uint_as_float(w[3] << 16); r[3] = __uint_as_float(w[3] & 0xffff0000u); return r; }
template <bool ADD>
struct MergeEpi {
  static constexpr bool PERM = true, AFTER_DRAIN = false;
  const ushort_t* gate; ushort_t* merged;
  DI void operator()(const f32x4p (&acc)[2][2][4][2], const pg8::Unit& u, int wr, int wc, int fr, int fq) const {
    const ushort_t* gb = gate + (size_t)(u.pm * 256) * GATEC + u.pn * 256;
    ushort_t* mb = merged + (size_t)(u.pm * 256) * 1024 + u.pn * 256;
    const unsigned lg = (unsigned)((wr * 64 + fr) * GATEC + wc * 32 + 8 * fq), lm = (unsigned)((wr * 64 + fr) * 1024 + wc * 32 + 8 * fq);
#pragma unroll
    for (int ai = 0; ai < 2; ++ai)
#pragma unroll
      for (int m = 0; m < 4; ++m) {
#pragma unroll
        for (int bj = 0; bj < 2; ++bj) {
          const u32x4 gw = *(const u32x4*)(gb + (ai * 128 + m * 16) * GATEC + bj * 128 + lg);
          f32x4p v0 = bf4lo(gw) * acc[ai][bj][m][0], v1 = bf4hi(gw) * acc[ai][bj][m][1];
          ushort_t* mp = mb + (ai * 128 + m * 16) * 1024 + bj * 128 + lm;
          if (ADD) { const u32x4 mw = *(const u32x4*)mp; v0 += bf4lo(mw); v1 += bf4hi(mw); }
          *(u32x4*)mp = pack8(v0, v1);
        }
        asm volatile("" ::: "memory");
      }
  }
};
DI void phase_merge(const P& p, char* smem) {
  {
    PlainSched S{p.ws + OFF_YHK, p.ws + OFF_WBH_T, 64, 4, 512, (int)gridDim.x, (int)blockIdx.x};
    MergeEpi<false> E{(const ushort_t*)(p.ws + OFF_GATE), (ushort_t*)(p.ws + OFF_MERGED)};
    pg8::gemm_phase(( __attribute__((address_space(3))) unsigned char*)smem, 512, S, E);
  }
  {
    PlainSched S{p.ws + OFF_YA, p.ws + OFF_WBA_T, 64, 4, 256, (int)gridDim.x, (int)blockIdx.x};
    MergeEpi<true> E{(const ushort_t*)(p.ws + OFF_GATE) + 1024, (ushort_t*)(p.ws + OFF_MERGED)};
    pg8::gemm_phase(( __attribute__((address_space(3))) unsigned char*)smem, 256, S, E);
  }
}

DI void phase_ln(float* __restrict__ xio, const float* __restrict__ g, const float* __restrict__ bta) {
  const int tq = tid_opaque(); const int lane = tq & 63, wave = tq >> 6;
  for (int row = blockIdx.x * 8 + wave; row < T_; row += gridDim.x * 8) {
    float* rp = xio + (size_t)row * 1024;
    f32x4 v[4];
    float s = 0.f;
#pragma unroll
    for (int i = 0; i < 4; ++i) { v[i] = *(const f32x4*)(rp + i * 256 + lane * 4); s += v[i][0] + v[i][1] + v[i][2] + v[i][3]; }
    const float mu = wave_sum(s) * (1.f / 1024.f);
    float q = 0.f;
#pragma unroll
    for (int i = 0; i < 4; ++i)
#pragma unroll
      for (int j = 0; j < 4; ++j) { float d = v[i][j] - mu; q += d * d; }
    const float rs = rsqrtf(wave_sum(q) * (1.f / 1024.f) + LN_EPS);
#pragma unroll
    for (int i = 0; i < 4; ++i) {
      f32x4 gg = *(const f32x4*)(g + i * 256 + lane * 4), bb = *(const f32x4*)(bta + i * 256 + lane * 4), o;
#pragma unroll
      for (int j = 0; j < 4; ++j) o[j] = (v[i][j] - mu) * rs * gg[j] + bb[j];
      *(f32x4*)(rp + i * 256 + lane * 4) = o;
    }
  }
}

DI int swz256(int row, int ch) { return row * 256 + ((ch ^ (row & 15)) << 4); }
DI void ins16(float (&L)[16], float x) {
#pragma unroll
  for (int i = 0; i < 16; ++i) { const float hi = __builtin_fmaxf(L[i], x); x = __builtin_fminf(L[i], x); L[i] = hi; }
}
DI void bitonic16_desc(float (&M)[16]) {
#pragma unroll
  for (int d = 8; d >= 1; d >>= 1)
#pragma unroll
    for (int i = 0; i < 16; ++i)
      if ((i & d) == 0) { const float a = M[i], b = M[i + d]; M[i] = __builtin_fmaxf(a, b); M[i + d] = __builtin_fminf(a, b); }
}
constexpr int ROUTE_Q_OFF = 0, ROUTE_K_OFF = 65536, ROUTE_IDX_OFF = 98304;
struct OneUnitSched {
  const char* A; const char* Bt; int pm, pn;
  DI bool next(int i, pg8::Unit& u) const { if (i != 0) return false; u.pm = pm; u.pn = pn; u.kind = 0; return true; }
  DI const char* a_ptr(const pg8::Unit& u) const { return A + (size_t)u.pm * 256 * 1024 * 2; }
  DI const char* b_ptr(const pg8::Unit& u) const { return Bt + (size_t)u.pn * 256 * 1024 * 2; }
};
struct RouteEpi {
  static constexpr bool PERM = false, AFTER_DRAIN = true;
  const ushort_t* keysb; int* idx; float* gv;
  DI void operator()(const f32x4p (&)[2][2][4][2], const pg8::Unit&, int, int, int, int) const {}
  DI void fused(const f32x4p (&acc)[2][2][4][2], const pg8::Unit& u, int wr, int wc, int fr, int fq, PG8_LAS unsigned char* ldsp, int wave, int lane) const {
    char* smem = (char*)ldsp;
    const int tid = wave * 64 + lane;
    const int m0 = u.pm * 256, hh = u.pn;
    float L0[16];
#pragma unroll
    for (int pp = 0; pp < 2; ++pp) {
      const int hp = hh * 2 + pp;
      if (pp == 1) __syncthreads();
#pragma unroll
      for (int ai = 0; ai < 2; ++ai)
#pragma unroll
        for (int m = 0; m < 4; ++m) {
          const int tok = 128 * ai + 64 * wr + 16 * m + fr;
#pragma unroll
          for (int n = 0; n < 2; ++n) {
            const int ch = 4 * wc + 2 * n + (fq >> 1);
            uint2 v; v.x = pack2(acc[ai][pp][m][n][0], acc[ai][pp][m][n][1]); v.y = pack2(acc[ai][pp][m][n][2], acc[ai][pp][m][n][3]);
            *(uint2*)(smem + ROUTE_Q_OFF + swz256(tok, ch) + 8 * (fq & 1)) = v;
          }
        }
#pragma unroll
      for (int i = 0; i < 4; ++i) {
        const int q = tid + 512 * i, row = q >> 4, ch = q & 15;
        *(u32x4*)(smem + ROUTE_K_OFF + swz256(row, ch)) = *(const u32x4*)(keysb + (size_t)hp * 16384 + row * 128 + ch * 8);
      }
      __syncthreads();
      f32x16 sc[4];
#pragma unroll
      for (int ks = 0; ks < 4; ++ks)
#pragma unroll
        for (int r = 0; r < 16; ++r) sc[ks][r] = 0.f;
#pragma unroll
      for (int s = 0; s < 8; ++s) {
        const int ch = 2 * s + (lane >> 5);
        const bf16x8 bq = *(const bf16x8*)(smem + ROUTE_Q_OFF + swz256(wave * 32 + (lane & 31), ch));
#pragma unroll
        for (int ks = 0; ks < 4; ++ks) {
          const bf16x8 ak = *(const bf16x8*)(smem + ROUTE_K_OFF + swz256(ks * 32 + (lane & 31), ch));
          sc[ks] = __builtin_amdgcn_mfma_f32_32x32x16_bf16(ak, bq, sc[ks], 0, 0, 0);
        }
      }
      float L[16];
#pragma unroll
      for (int i = 0; i < 16; ++i) L[i] = -3.0e38f;
      const unsigned hbit = (unsigned)(lane >> 5) << 2;
#pragma unroll
      for (int ks = 0; ks < 4; ++ks)
#pragma unroll
        for (int r = 0; r < 16; ++r) {
          const unsigned key = (unsigned)(ks * 32 + (r & 3) + 8 * (r >> 2)) | hbit;
          ins16(L, __uint_as_float((__float_as_uint(sc[ks][r]) & ~127u) | key));
        }
      {
        float M[16];
#pragma unroll
        for (int i = 0; i < 16; ++i) M[i] = __builtin_fmaxf(L[i], __shfl_xor(L[15 - i], 32));
        bitonic16_desc(M);
#pragma unroll
        for (int i = 0; i < 16; ++i) L[i] = M[i];
      }
      if (pp == 0) {
#pragma unroll
        for (int i = 0; i < 16; ++i) L0[i] = L[i];
      } else {
        unsigned char* ib = (unsigned char*)(smem + ROUTE_IDX_OFF) + tid * 32;
#pragma unroll
        for (int i = 0; i < 16; ++i) { ib[i] = (unsigned char)(__float_as_uint(L0[i]) & 127u); ib[16 + i] = (unsigned char)(__float_as_uint(L[i]) & 127u); }
        float F[16];
#pragma unroll
        for (int i = 0; i < 16; ++i) F[i] = -3.0e38f;
#pragma unroll
        for (int i = 0; i < 16; ++i) {
          const float ai_ = __uint_as_float(__float_as_uint(L0[i]) & ~127u);
#pragma unroll
          for (int jj = 0; jj < 16; ++jj)
            if ((i + 1) * (jj + 1) <= 16) {
              const float s = ai_ + __uint_as_float(__float_as_uint(L[jj]) & ~127u);
              ins16(F, __uint_as_float((__float_as_uint(s) & ~255u) | (unsigned)(i * 16 + jj)));
            }
        }
        const float mx = __uint_as_float(__float_as_uint(F[0]) & ~255u);
        float e[16], sum = 0.f;
#pragma unroll
        for (int k = 0; k < 16; ++k) { e[k] = __expf(__uint_as_float(__float_as_uint(F[k]) & ~255u) - mx); sum += e[k]; }
        const float inv = 1.f / sum;
        if (lane < 32) {
          const int tok = m0 + wave * 32 + lane;
          int* ip = idx + (size_t)tok * 128 + hh * 16;
          float* gp = gv + (size_t)tok * 128 + hh * 16;
#pragma unroll
          for (int k4 = 0; k4 < 4; ++k4) {
            int4 iv; f32x4 g4;
            int ee[4];
#pragma unroll
            for (int uu = 0; uu < 4; ++uu) {
              const unsigned code = __float_as_uint(F[k4 * 4 + uu]) & 255u;
              ee[uu] = (int)ib[code >> 4] * 128 + (int)ib[16 + (code & 15u)];
              g4[uu] = e[k4 * 4 + uu] * inv;
            }
            iv.x = ee[0]; iv.y = ee[1]; iv.z = ee[2]; iv.w = ee[3];
            *(int4*)(ip + k4 * 4) = iv;
            *(f32x4*)(gp + k4 * 4) = g4;
          }
        }
      }
    }
    __syncthreads();
  }
};
DI void phase_route(const P& p, char* smem) {
  for (int item = blockIdx.x; item < (T_ / 256) * 8; item += gridDim.x) {
    OneUnitSched S{p.ws + OFF_U2B, p.ws + OFF_WQ_T, item >> 3, item & 7};
    RouteEpi E{(const ushort_t*)(p.ws + OFF_KEYS_B), (int*)(p.ws + OFF_IDX), (float*)(p.ws + OFF_GV)};
    pg8::gemm_phase((__attribute__((address_space(3))) unsigned char*)smem, 1024, S, E);
  }
}

DI void phase_rope(const P& p) {
  float* rt = (float*)(p.ws + OFF_ROPE);
  for (int i = blockIdx.x * NT + tid_opaque(); i < T_ * 8; i += gridDim.x * NT) {
    const float inv = expf(-13.122363377404328f * (float)(i & 7) * 0.125f);
    const float x = (float)p.pos[i >> 3] * inv;
    const float k = rintf(x * 0.15915494309189535f);
    float r = fmaf(-k, 6.28125f, x);
    r = fmaf(-k, 1.9353071795864769e-3f, r);
    float sn, cs; __sincosf(r, &sn, &cs);
    rt[2 * i] = cs; rt[2 * i + 1] = sn;
  }
}
DI void phase_keys(const P& p) {
  ushort_t* keysb = (ushort_t*)(p.ws + OFF_KEYS_B);
  for (int i = blockIdx.x * NT + tid_opaque(); i < 16 * 128 * 128 / 4; i += gridDim.x * NT) {
    f32x4 v = *(const f32x4*)(p.keys + (size_t)i * 4);
    uint2 o; o.x = pack2(v[0], v[1]); o.y = pack2(v[2], v[3]);
    *(uint2*)(keysb + (size_t)i * 4) = o;
  }
}

typedef __bf16 bf16x2_t __attribute__((ext_vector_type(2)));
DI float dot2bf(unsigned a, unsigned b, float c) { return __builtin_amdgcn_fdot2_f32_bf16(__builtin_bit_cast(bf16x2_t, a), __builtin_bit_cast(bf16x2_t, b), c, false); }
DI void phase_ln1(const P& p) {
  const float* ada = (const float*)(p.ws + OFF_ADA);
  ushort_t* u2b = (ushort_t*)(p.ws + OFF_U2B);
  const int tq = tid_opaque(); const int lane = tq & 63, wave = tq >> 6;
  for (int row = blockIdx.x * 8 + wave; row < T_; row += gridDim.x * 8) {
    const int b = row / S_;
    float* rp = p.out + (size_t)row * 1024;
    f32x4 v[4];
    float s = 0.f;
#pragma unroll
    for (int i = 0; i < 4; ++i) { v[i] = *(const f32x4*)(rp + i * 256 + lane * 4); s += v[i][0] + v[i][1] + v[i][2] + v[i][3]; }
    const float mu = wave_sum(s) * (1.f / 1024.f);
    float q = 0.f;
#pragma unroll
    for (int i = 0; i < 4; ++i)
#pragma unroll
      for (int j = 0; j < 4; ++j) { float d = v[i][j] - mu; q += d * d; }
    const float rs = rsqrtf(wave_sum(q) * (1.f / 1024.f) + LN_EPS);
#pragma unroll
    for (int i = 0; i < 4; ++i) {
      const int col = i * 256 + lane * 4;
      f32x4 gg = *(const f32x4*)(p.ln1_g + col), bb = *(const f32x4*)(p.ln1_b + col), o;
      f32x4 sc = *(const f32x4*)(ada + b * 6144 + 4 * 1024 + col), sh = *(const f32x4*)(ada + b * 6144 + 3 * 1024 + col);
#pragma unroll
      for (int j = 0; j < 4; ++j) o[j] = (v[i][j] - mu) * rs * gg[j] + bb[j];
      *(f32x4*)(rp + col) = o;
      uint2 w; w.x = pack2(o[0] * (1.f + sc[0]) + sh[0], o[1] * (1.f + sc[1]) + sh[1]); w.y = pack2(o[2] * (1.f + sc[2]) + sh[2], o[3] * (1.f + sc[3]) + sh[3]);
      *(uint2*)(u2b + (size_t)row * 1024 + col) = w;
    }
  }
}
DI float wave_max(float v) {
#pragma unroll
  for (int o = 32; o > 0; o >>= 1) v = fmaxf(v, __shfl_xor(v, o));
  return v;
}
DI unsigned pack4_fp8(float a, float b, float c, float d) {
  int w = 0;
  w = __builtin_amdgcn_cvt_pk_fp8_f32(a, b, w, false);
  w = __builtin_amdgcn_cvt_pk_fp8_f32(c, d, w, true);
  return (unsigned)w;
}
DI void phase_tabconv(const P& p) {
  unsigned char* tu = (unsigned char*)(p.ws + OFF_TABU);
  unsigned char* tv = (unsigned char*)(p.ws + OFF_TABV);
  float* su = (float*)(p.ws + OFF_SU);
  float* sv = (float*)(p.ws + OFF_SV);
  const int tq = tid_opaque(); const int lane = tq & 63, wave = tq >> 6;
  for (int e = blockIdx.x * 8 + wave; e < 16384; e += gridDim.x * 8) {
    f32x4 a[4], c[4];
    float ma = 0.f, mc = 0.f;
#pragma unroll
    for (int i = 0; i < 4; ++i) {
      const int col = i * 256 + lane * 4;
      a[i] = *(const f32x4*)(p.pu + (size_t)e * 1024 + col);
      c[i] = *(const f32x4*)(p.pv + (size_t)e * 1024 + col);
#pragma unroll
      for (int j = 0; j < 4; ++j) { ma = fmaxf(ma, fabsf(a[i][j])); mc = fmaxf(mc, fabsf(c[i][j])); }
    }
    ma = wave_max(ma); mc = wave_max(mc);
    const float sa = (ma > 0.f) ? ma * (1.0f / 448.0f) : 1.0f, sc = (mc > 0.f) ? mc * (1.0f / 448.0f) : 1.0f;
    const float ia = 1.0f / sa, ic = 1.0f / sc;
    if (lane == 0) { su[e] = sa; sv[e] = sc; }
#pragma unroll
    for (int i = 0; i < 4; ++i) {
      const int col = i * 256 + lane * 4;
      *(unsigned*)(tu + (size_t)e * 1024 + col) = pack4_fp8(a[i][0] * ia, a[i][1] * ia, a[i][2] * ia, a[i][3] * ia);
      const int slice = i * 2 + (lane >> 5);
      *(unsigned*)(tv + ((size_t)slice * 16384 + e) * 128 + (lane & 31) * 4) = pack4_fp8(c[i][0] * ic, c[i][1] * ic, c[i][2] * ic, c[i][3] * ic);
    }
  }
}

template <int CTRL> DI float dpp_f(float v) { return __int_as_float(__builtin_amdgcn_mov_dpp(__float_as_int(v), CTRL, 0xf, 0xf, false)); }
template <int CTRL> DI int dpp_shr0(int v) { return __builtin_amdgcn_update_dpp(0, v, CTRL, 0xf, 0xf, true); }
template <int I> DI int bcast16(int v) { return __builtin_amdgcn_mov_dpp(v, 0x150 + I, 0xf, 0xf, false); }
DI float row_sum16(float d) {
  d += dpp_f<0xB1>(d);
  d += dpp_f<0x4E>(d);
  d += dpp_f<0x141>(d);
  d += dpp_f<0x140>(d);
  return d;
}
typedef __bf16 bf16x2_c __attribute__((ext_vector_type(2)));
DI float dot4_fp8(unsigned w8, unsigned xlo, unsigned xhi, float acc) {
  const bf16x2_c lo = __builtin_amdgcn_cvt_scalef32_pk_bf16_fp8((int)w8, 1.0f, false);
  const bf16x2_c hi = __builtin_amdgcn_cvt_scalef32_pk_bf16_fp8((int)w8, 1.0f, true);
  acc = __builtin_amdgcn_fdot2_f32_bf16(lo, __builtin_bit_cast(bf16x2_c, xlo), acc, false);
  return __builtin_amdgcn_fdot2_f32_bf16(hi, __builtin_bit_cast(bf16x2_c, xhi), acc, false);
}
DI void phase_upass(const P& p, char* smem) {
  const int* idx = (const int*)(p.ws + OFF_IDX);
  const float* gv = (const float*)(p.ws + OFF_GV);
  const ushort_t* u2b = (const ushort_t*)(p.ws + OFF_U2B);
  const char* tabu = (const char*)(p.ws + OFF_TABU);
  const float* su = (const float*)(p.ws + OFF_SU);
  const float* sv = (const float*)(p.ws + OFF_SV);
  float* coef = (float*)(p.ws + OFF_COEF);
  const int tq = tid_opaque(); const int lane = tq & 63, wave = tq >> 6;
  const int g = lane >> 4, j = lane & 15;
  int4* lst = (int4*)smem + wave * 512 + g * 128;
  const int part = blockIdx.x & 7, bi = blockIdx.x >> 3, nb = (gridDim.x - part + 7) >> 3;
  __syncthreads();
#pragma unroll 1
  for (int tb = (bi * 8 + wave) * 4; tb < T_; tb += nb * 32) {
    const int tok = tb + g;
    const int4 i0 = *(const int4*)(idx + (size_t)tb * 128 + lane * 8), i1 = *(const int4*)(idx + (size_t)tb * 128 + lane * 8 + 4);
    const f32x4 g0 = *(const f32x4*)(gv + (size_t)tb * 128 + lane * 8), g1 = *(const f32x4*)(gv + (size_t)tb * 128 + lane * 8 + 4);
    u32x4 xr[8];
#pragma unroll
    for (int c = 0; c < 4; ++c) {
      xr[2 * c] = *(const u32x4*)(u2b + (size_t)tok * 1024 + (j + 16 * c) * 16);
      xr[2 * c + 1] = *(const u32x4*)(u2b + (size_t)tok * 1024 + (j + 16 * c) * 16 + 8);
    }
    const int ev[8] = {i0.x, i0.y, i0.z, i0.w, i1.x, i1.y, i1.z, i1.w};
    const float gg[8] = {g0[0], g0[1], g0[2], g0[3], g1[0], g1[1], g1[2], g1[3]};
    int cnt = 0;
#pragma unroll
    for (int i = 0; i < 8; ++i) cnt += ((ev[i] >> 11) == part) ? 1 : 0;
    int incl = cnt;
    incl += dpp_shr0<0x111>(incl); incl += dpp_shr0<0x112>(incl); incl += dpp_shr0<0x114>(incl); incl += dpp_shr0<0x118>(incl);
    const int ng = bcast16<15>(incl);
    int pos = incl - cnt;
#pragma unroll
    for (int i = 0; i < 8; ++i)
      if ((ev[i] >> 11) == part) { int4 en; en.x = ev[i]; en.y = __float_as_int(gg[i]); en.z = j * 8 + i; en.w = 0; lst[pos] = en; ++pos; }
    const int nmax = max(max(__builtin_amdgcn_readlane(ng, 0), __builtin_amdgcn_readlane(ng, 16)), max(__builtin_amdgcn_readlane(ng, 32), __builtin_amdgcn_readlane(ng, 48)));
    __builtin_amdgcn_wave_barrier();
    asm volatile("s_waitcnt lgkmcnt(0)" ::: "memory");
    u32x4 ra[4], rb[4], rc[4], rd[4];
#define UP_LOAD(R, IT) { const unsigned e_ = ((IT) < ng) ? (unsigned)lst[(IT)].x : 0u; const char* row_ = tabu + (size_t)e_ * 1024 + j * 16; \
                         _Pragma("unroll") for (int c = 0; c < 4; ++c) R[c] = *(const u32x4*)(row_ + c * 256); }
#define UP_COMP(R, IT) { float a0 = 0.f, a1 = 0.f, a2 = 0.f, a3 = 0.f; \
      _Pragma("unroll") for (int c = 0; c < 4; ++c) { \
        a0 = dot4_fp8(R[c][0], xr[2 * c][0], xr[2 * c][1], a0); a1 = dot4_fp8(R[c][1], xr[2 * c][2], xr[2 * c][3], a1); \
        a2 = dot4_fp8(R[c][2], xr[2 * c + 1][0], xr[2 * c + 1][1], a2); a3 = dot4_fp8(R[c][3], xr[2 * c + 1][2], xr[2 * c + 1][3], a3); } \
      const float d_ = row_sum16((a0 + a1) + (a2 + a3)); \
      if (j == 0 && (IT) < ng) ((int*)&lst[(IT)])[3] = __float_as_int(d_); }
    UP_LOAD(ra, 0) UP_LOAD(rb, 1) UP_LOAD(rc, 2) UP_LOAD(rd, 3)
#pragma unroll 1
    for (int it = 0; it < nmax; it += 4) {
      UP_COMP(ra, it)     UP_LOAD(ra, it + 4)
      UP_COMP(rb, it + 1) UP_LOAD(rb, it + 5)
      UP_COMP(rc, it + 2) UP_LOAD(rc, it + 6)
      UP_COMP(rd, it + 3) UP_LOAD(rd, it + 7)
    }
#undef UP_LOAD
#undef UP_COMP
    __builtin_amdgcn_wave_barrier();
    asm volatile("s_waitcnt lgkmcnt(0)" ::: "memory");
#pragma unroll 1
    for (int k = 0; k < nmax; k += 16) {
      if (k + j < ng) {
        const int4 en = lst[k + j];
        const float a = __int_as_float(en.w) * su[en.x];
        coef[(size_t)tok * 128 + en.z] = __int_as_float(en.y) * 0.5f * a * (1.f + erff(a * 0.7071067811865475f)) * sv[en.x];
      }
    }
    __builtin_amdgcn_wave_barrier();
    asm volatile("s_waitcnt lgkmcnt(0)" ::: "memory");
  }
}

struct VHdr { int ea, eb, ca, cb; };
DI VHdr vp_hdr(const int* idx, const float* coef, int tok, int g, int cq) {
  VHdr h;
  h.ea = idx[(size_t)tok * 128 + g * 32 + cq]; h.eb = idx[(size_t)tok * 128 + g * 32 + 16 + cq];
  h.ca = __float_as_int(coef[(size_t)tok * 128 + g * 32 + cq]); h.cb = __float_as_int(coef[(size_t)tok * 128 + g * 32 + 16 + cq]);
  return h;
}
DI void vp_rows(uint2 (&va)[16], uint2 (&vb)[16], const VHdr& h, const char* tb) {
#define VP_STEP(I) { va[I] = *(const uint2*)(tb + (unsigned)bcast16<I>(h.ea) * 128u); vb[I] = *(const uint2*)(tb + (unsigned)bcast16<I>(h.eb) * 128u); }
  VP_STEP(0) VP_STEP(1) VP_STEP(2) VP_STEP(3) VP_STEP(4) VP_STEP(5) VP_STEP(6) VP_STEP(7)
  VP_STEP(8) VP_STEP(9) VP_STEP(10) VP_STEP(11) VP_STEP(12) VP_STEP(13) VP_STEP(14) VP_STEP(15)
#undef VP_STEP
}
DI void vp_coefs(float (&fa)[16], float (&fb)[16], const VHdr& h) {
#define VP_STEP(I) { fa[I] = __int_as_float(bcast16<I>(h.ca)); fb[I] = __int_as_float(bcast16<I>(h.cb)); }
  VP_STEP(0) VP_STEP(1) VP_STEP(2) VP_STEP(3) VP_STEP(4) VP_STEP(5) VP_STEP(6) VP_STEP(7)
  VP_STEP(8) VP_STEP(9) VP_STEP(10) VP_STEP(11) VP_STEP(12) VP_STEP(13) VP_STEP(14) VP_STEP(15)
#undef VP_STEP
}
DI void vp_fma8(float (&a)[8], float cf, const uint2& v) {
  const f32x2_hw p0 = __builtin_amdgcn_cvt_pk_f32_fp8((int)v.x, false), p1 = __builtin_amdgcn_cvt_pk_f32_fp8((int)v.x, true);
  const f32x2_hw p2 = __builtin_amdgcn_cvt_pk_f32_fp8((int)v.y, false), p3 = __builtin_amdgcn_cvt_pk_f32_fp8((int)v.y, true);
  a[0] += cf * p0[0]; a[1] += cf * p0[1]; a[2] += cf * p1[0]; a[3] += cf * p1[1];
  a[4] += cf * p2[0]; a[5] += cf * p2[1]; a[6] += cf * p3[0]; a[7] += cf * p3[1];
}
DI void vp_consume(const uint2 (&va)[16], const uint2 (&vb)[16], const VHdr& h, float* f, int tok, int slice, int g, int cq, bool live) {
  float fa[16], fb[16];
  vp_coefs(fa, fb, h);
  float a[8];
#pragma unroll
  for (int i = 0; i < 8; ++i) a[i] = 0.f;
#pragma unroll
  for (int i = 0; i < 16; ++i) { vp_fma8(a, fa[i], va[i]); vp_fma8(a, fb[i], vb[i]); }
#pragma unroll
  for (int i = 0; i < 8; ++i) { a[i] += __shfl_xor(a[i], 16); a[i] += __shfl_xor(a[i], 32); }
  if (g == 0 && live) {
    f32x4 o0, o1; o0[0] = a[0]; o0[1] = a[1]; o0[2] = a[2]; o0[3] = a[3]; o1[0] = a[4]; o1[1] = a[5]; o1[2] = a[6]; o1[3] = a[7];
    float* fp = f + (size_t)tok * 1024 + slice * 128 + cq * 8;
    *(f32x4*)fp = o0; *(f32x4*)(fp + 4) = o1;
  }
}
DI void phase_vpass(const P& p) {
  const int* idx = (const int*)(p.ws + OFF_IDX);
  const float* coef = (const float*)(p.ws + OFF_COEF);
  const char* tabv = (const char*)(p.ws + OFF_TABV);
  float* f = (float*)(p.ws + OFF_F);
  const int tq = tid_opaque(); const int lane = tq & 63, wave = tq >> 6;
  const int g = lane >> 4, cq = lane & 15;
  const int slice = blockIdx.x & 7, bi = blockIdx.x >> 3, nb = (gridDim.x - slice + 7) >> 3;
  const int step = nb * 8;
  const char* tb = tabv + (size_t)slice * (16384 * 128) + cq * 8;
  int tok = bi * 8 + wave;
  if (tok >= T_) return;
  VHdr h0 = vp_hdr(idx, coef, tok, g, cq);
  VHdr h1 = vp_hdr(idx, coef, min(tok + step, T_ - 1), g, cq);
  uint2 va[16], vb[16], na[16], nb2[16];
  vp_rows(va, vb, h0, tb);
#pragma unroll 1
  for (; tok < T_; tok += 2 * step) {
    const VHdr h2 = vp_hdr(idx, coef, min(tok + 2 * step, T_ - 1), g, cq);
    vp_rows(na, nb2, h1, tb);
    vp_consume(va, vb, h0, f, tok, slice, g, cq, true);
    const VHdr h3 = vp_hdr(idx, coef, min(tok + 3 * step, T_ - 1), g, cq);
    vp_rows(va, vb, h2, tb);
    vp_consume(na, nb2, h1, f, tok + step, slice, g, cq, tok + step < T_);
    h0 = h2; h1 = h3;
  }
}

DI void phase_ln2(const P& p) {
  const float* ada = (const float*)(p.ws + OFF_ADA);
  const float* f = (const float*)(p.ws + OFF_F);
  const int tq = tid_opaque(); const int lane = tq & 63, wave = tq >> 6;
  for (int tok = blockIdx.x * 8 + wave; tok < T_; tok += gridDim.x * 8) {
    const int b = tok / S_;
    float* rp = p.out + (size_t)tok * 1024;
    f32x4 acc[4];
    float sm = 0.f;
#pragma unroll
    for (int i = 0; i < 4; ++i) {
      const int col = i * 256 + lane * 4;
      f32x4 x1 = *(const f32x4*)(rp + col), ff = *(const f32x4*)(f + (size_t)tok * 1024 + col);
      f32x4 g2 = *(const f32x4*)(ada + b * 6144 + 5 * 1024 + col);
#pragma unroll
      for (int j = 0; j < 4; ++j) { acc[i][j] = DN_ALPHA * x1[j] + (1.f + g2[j]) * ff[j]; sm += acc[i][j]; }
    }
    const float mu = wave_sum(sm) * (1.f / 1024.f);
    float q = 0.f;
#pragma unroll
    for (int i = 0; i < 4; ++i)
#pragma unroll
      for (int j = 0; j < 4; ++j) { float d = acc[i][j] - mu; q += d * d; }
    const float rs = rsqrtf(wave_sum(q) * (1.f / 1024.f) + LN_EPS);
#pragma unroll
    for (int i = 0; i < 4; ++i) {
      const int col = i * 256 + lane * 4;
      f32x4 gg = *(const f32x4*)(p.ln2_g + col), bb = *(const f32x4*)(p.ln2_b + col), o;
#pragma unroll
      for (int j = 0; j < 4; ++j) o[j] = (acc[i][j] - mu) * rs * gg[j] + bb[j];
      *(f32x4*)(rp + col) = o;
    }
  }
}

#define XB_TMO      128
#define XB_XCNT(j)  (256  + 64 * (j))
#define XB_XSUB(j)  (1280 + 64 * (j))
#define XB_XGEN(j)  (2304 + 64 * (j))
#define XB_TOP      3328
#define XB_TOPGEN   3392
#define XCD_BAR_WORDS 3456
#define XB_SPIN_CAP (1u << 22)
#define LAS __attribute__((address_space(3)))
DI unsigned xb_ld(unsigned* p)              { return __hip_atomic_load(p, __ATOMIC_RELAXED, __HIP_MEMORY_SCOPE_AGENT); }
DI unsigned xb_add(unsigned* p, unsigned v) { return __hip_atomic_fetch_add(p, v, __ATOMIC_RELAXED, __HIP_MEMORY_SCOPE_AGENT); }
DI unsigned xb_xcc_id() { return (unsigned)__builtin_amdgcn_s_getreg((3 << 11) | 20) & 0xFu; }
#define XB_SPIN(cond, bar) do { unsigned _sp = 0; while (cond) { __builtin_amdgcn_s_sleep(1); \
    if ((++_sp & 255u) == 0u) { if (xb_ld(&(bar)[XB_TMO])) break; if (_sp > XB_SPIN_CAP) { atomicAdd(&(bar)[XB_TMO], 1u); break; } } } } while (0)
struct XcdBarrier { unsigned* bar; unsigned x; volatile LAS unsigned* st; };
DI XcdBarrier xcd_barrier_post(unsigned* bar, volatile LAS unsigned* st) {
  XcdBarrier b; b.bar = bar; b.x = xb_xcc_id(); b.st = st;
  if (threadIdx.x == 0) (void)xb_add(&bar[XB_XCNT(b.x)], 1u);
  return b;
}
DI void xcd_barrier_complete(unsigned* bar, unsigned x, unsigned& nloc, unsigned& nx) {
  const unsigned G = gridDim.x * gridDim.y * gridDim.z;
  unsigned sum, cnt, mine, sp = 0u;
  for (;;) {
    sum = 0u; cnt = 0u; mine = 0u;
#pragma unroll
    for (unsigned j = 0; j < 16; ++j) { const unsigned c = xb_ld(&bar[XB_XCNT(j)]); sum += c; cnt += (c > 0u) ? 1u : 0u; mine = (j == x) ? c : mine; }
    if (sum == G) break;
    __builtin_amdgcn_s_sleep(1);
    if ((++sp & 255u) == 0u) { if (xb_ld(&bar[XB_TMO])) break; if (sp > XB_SPIN_CAP) { atomicAdd(&bar[XB_TMO], 1u); break; } }
  }
  nloc = mine > 0u ? mine : 1u; nx = cnt > 0u ? cnt : 1u;
}
DI void xcd_barrier(unsigned* barp, char* stp) {
  asm volatile("s_waitcnt vmcnt(0)" ::: "memory");
  __syncthreads();
  if (threadIdx.x == 0) {
    XcdBarrier b; b.bar = barp; b.x = xb_xcc_id(); b.st = (volatile LAS unsigned*)stp;
    unsigned* bar = b.bar;
    __builtin_amdgcn_s_waitcnt(0);
    unsigned nloc = b.st[0], nx = b.st[1];
    if (nloc == 0u) { xcd_barrier_complete(bar, b.x, nloc, nx); b.st[0] = nloc; b.st[1] = nx; }
    const unsigned old = xb_add(&bar[XB_XSUB(b.x)], 1u);
    const unsigned gen = old / nloc;
    if (old + 1u == (gen + 1u) * nloc) {
      __builtin_amdgcn_fence(__ATOMIC_RELEASE, "agent");
      asm volatile("s_waitcnt vmcnt(0)" ::: "memory");
      const unsigned og = xb_add(&bar[XB_TOP], 1u);
      const unsigned tg = og / nx;
      if (og + 1u == (tg + 1u) * nx) xb_add(&bar[XB_TOPGEN], 1u);
      else XB_SPIN(xb_ld(&bar[XB_TOPGEN]) == tg, bar);
      __builtin_amdgcn_fence(__ATOMIC_ACQUIRE, "agent");
      xb_add(&bar[XB_XGEN(b.x)], 1u);
      asm volatile("s_waitcnt vmcnt(0)" ::: "memory");
    } else {
      XB_SPIN(xb_ld(&bar[XB_XGEN(b.x)]) == gen, bar);
      __builtin_amdgcn_fence(__ATOMIC_ACQUIRE, "agent");
      asm volatile("s_waitcnt vmcnt(0)" ::: "memory");
    }
  }
  __syncthreads();
}

constexpr int SMEM_BYTES = 143360;
__global__ void __launch_bounds__(NT) fwd_megakernel(P p) {
  __shared__ __attribute__((aligned(16))) char smem[SMEM_BYTES + 16];
  if (threadIdx.x < 4) ((volatile LAS unsigned*)(smem + SMEM_BYTES))[threadIdx.x] = 0u;
  __syncthreads();
  (void)xcd_barrier_post((unsigned*)(p.ws + OFF_BAR), (volatile LAS unsigned*)(smem + SMEM_BYTES));
  phase_ada(p, smem);
  xcd_barrier((unsigned*)(p.ws + OFF_BAR), smem + SMEM_BYTES);
  phase_u1(p);
  phase_transposes(p, smem);
  phase_keys(p);
  phase_rope(p);
  phase_filter(p, smem);
  xcd_barrier((unsigned*)(p.ws + OFF_BAR), smem + SMEM_BYTES);
  phase_inproj(p, smem);
  xcd_barrier((unsigned*)(p.ws + OFF_BAR), smem + SMEM_BYTES);
  for (int item = blockIdx.x; item < 512 + 256; item += gridDim.x) {
    if (item < 512) hyena_item(p, smem, item);
    else attn_item(p, smem, item - 512);
  }
  xcd_barrier((unsigned*)(p.ws + OFF_BAR), smem + SMEM_BYTES);
  phase_yh_transpose(p, smem);
  xcd_barrier((unsigned*)(p.ws + OFF_BAR), smem + SMEM_BYTES);
  phase_merge(p, smem);
  xcd_barrier((unsigned*)(p.ws + OFF_BAR), smem + SMEM_BYTES);
  phase_outproj(p, smem);
  xcd_barrier((unsigned*)(p.ws + OFF_BAR), smem + SMEM_BYTES);
  phase_ln1(p);
  phase_tabconv(p);
  xcd_barrier((unsigned*)(p.ws + OFF_BAR), smem + SMEM_BYTES);
  phase_route(p, smem);
  xcd_barrier((unsigned*)(p.ws + OFF_BAR), smem + SMEM_BYTES);
  phase_upass(p, smem);
  xcd_barrier((unsigned*)(p.ws + OFF_BAR), smem + SMEM_BYTES);
  phase_vpass(p);
  xcd_barrier((unsigned*)(p.ws + OFF_BAR), smem + SMEM_BYTES);
  phase_ln2(p);
}

extern "C" void kernel_launch(void* const* d_in, const int* in_sizes, int n_in, void* d_out, int out_size, void* d_ws, size_t ws_size,
                              hipStream_t stream) {
  P p{};
  p.x = (const float*)d_in[0]; p.c = (const float*)d_in[1]; p.pos = (const int*)d_in[2];
  p.w_ada = (const float*)d_in[3]; p.b_ada = (const float*)d_in[4]; p.w_in = (const float*)d_in[5];
  p.hy_conv_w = (const float*)d_in[6]; p.hy_conv_b = (const float*)d_in[7];
  p.f1_w = (const float*)d_in[8]; p.f1_b = (const float*)d_in[9]; p.f1_freq = (const float*)d_in[10];
  p.f2_w = (const float*)d_in[11]; p.f2_b = (const float*)d_in[12]; p.f2_freq = (const float*)d_in[13];
  p.f3_w = (const float*)d_in[14]; p.hy_bias = (const float*)d_in[15];
  p.w_bh = (const float*)d_in[16]; p.w_ba = (const float*)d_in[17]; p.w_out = (const float*)d_in[18];
  p.ln1_g = (const float*)d_in[19]; p.ln1_b = (const float*)d_in[20];
  p.wq = (const float*)d_in[21]; p.keys = (const float*)d_in[22]; p.pu = (const float*)d_in[23]; p.pv = (const float*)d_in[24];
  p.ln2_g = (const float*)d_in[25]; p.ln2_b = (const float*)d_in[26];
  p.out = (float*)d_out; p.ws = (char*)d_ws;

  static int grid_blocks = 0;
  if (!grid_blocks) {
    int dev = 0, cus = 0, per_cu = 0;
    hipGetDevice(&dev);
    hipDeviceGetAttribute(&cus, hipDeviceAttributeMultiprocessorCount, dev);
    hipOccupancyMaxActiveBlocksPerMultiprocessor(&per_cu, fwd_megakernel, NT, 0);
    if (per_cu > 1) per_cu = 1;
    grid_blocks = cus * per_cu;
  }
  (void)hipMemsetAsync((char*)d_ws + OFF_BAR, 0, XCD_BAR_WORDS * 4, stream);
  void* args[] = {&p};
  hipError_t e = hipLaunchCooperativeKernel((void*)fwd_megakernel, dim3(grid_blocks), dim3(NT), args, 0, stream);
  if (e != hipSuccess) fprintf(stderr, "cooperative launch failed: %s (grid %d)\n", hipGetErrorString(e), grid_blocks);
}
```

```cpp
#include <hip/hip_runtime.h>
#include <hip/hip_cooperative_groups.h>
#include <cstdio>
#include <cstdint>

#define DI __device__ __forceinline__
typedef unsigned short ushort_t;
typedef __attribute__((ext_vector_type(8))) short bf16x8;
typedef __attribute__((ext_vector_type(16))) float f32x16;
typedef __attribute__((ext_vector_type(4))) float f32x4;
typedef __attribute__((ext_vector_type(4))) unsigned u32x4;

constexpr int T_ = 16384, S_ = 8192, NB = 2, D_ = 1024;
constexpr int HW_ = 512, HYC = 1536, QKVC = 2304, GATEC = 2048, INW = 5888;
constexpr int NT = 512;
constexpr float DN_ALPHA = 1.189207115002721f;
constexpr float LN_EPS = 1e-5f;

constexpr size_t OFF_ADA   = 0;
constexpr size_t OFF_BAR   = 49152;
constexpr size_t OFF_KEYS_B= 65536;
constexpr size_t OFF_WIN_T = 65536 + 524288;
constexpr size_t OFF_WQ_T  = OFF_WIN_T + (size_t)INW * 1024 * 2;
constexpr size_t OFF_WOUT_T= OFF_WQ_T + (size_t)2048 * 1024 * 2;
constexpr size_t OFF_WBH_T = OFF_WOUT_T + (size_t)1024 * 1024 * 2;
constexpr size_t OFF_WBA_T = OFF_WBH_T + (size_t)1024 * 512 * 2;
constexpr size_t OFF_PH    = OFF_WBA_T + (size_t)1024 * 256 * 2;
constexpr size_t OFF_QKV   = OFF_PH + (size_t)T_ * HYC * 2;
constexpr size_t OFF_GATE  = OFF_QKV + (size_t)T_ * QKVC * 2;
constexpr size_t OFF_YH    = OFF_GATE + (size_t)T_ * GATEC * 2;
constexpr size_t OFF_YA    = OFF_YH + (size_t)T_ * HW_ * 2;
constexpr size_t OFF_END   = OFF_YA + (size_t)T_ * 256 * 2;
constexpr size_t OFF_MERGED= OFF_PH;
constexpr size_t OFF_YHK   = OFF_PH + (size_t)32 * 1048576;
constexpr size_t OFF_U1B   = OFF_YH;
static_assert(OFF_U1B + (size_t)T_ * 1024 * 2 <= 268435456ull, "u1b overflow");
constexpr size_t OFF_U2B   = OFF_PH;
constexpr size_t OFF_TABU  = OFF_QKV;
constexpr size_t OFF_TABV  = OFF_QKV + (size_t)16 * 1048576;
constexpr size_t OFF_SU    = OFF_QKV + (size_t)32 * 1048576;
constexpr size_t OFF_SV    = OFF_SU + 65536;
constexpr size_t OFF_COEF  = OFF_QKV + (size_t)64 * 1048576;
constexpr size_t OFF_F     = OFF_QKV + (size_t)72 * 1048576;
static_assert(OFF_F + (size_t)64 * 1048576 <= OFF_YH, "peer buffers overflow the qkv+gate region");
constexpr size_t OFF_IDX   = OFF_YH;
constexpr size_t OFF_GV    = OFF_YH + (size_t)T_ * 128 * 4;
constexpr size_t OFF_HSCR  = OFF_END;
static_assert(OFF_HSCR + (size_t)164 * 131072 <= 268435456ull, "ws overflow");
static_assert((size_t)92 * 131072 <= (size_t)INW * 1024 * 2, "w_in^T region too small");
constexpr size_t OFF_ROPE  = OFF_HSCR + (size_t)164 * 131072;
static_assert(OFF_ROPE + (size_t)T_ * 64 <= 268435456ull, "rope table overflow");

struct P {
  const float *x, *c; const int* pos;
  const float *w_ada, *b_ada, *w_in, *hy_conv_w, *hy_conv_b, *f1_w, *f1_b, *f1_freq, *f2_w, *f2_b, *f2_freq, *f3_w,
      *hy_bias, *w_bh, *w_ba, *w_out, *ln1_g, *ln1_b, *wq, *keys, *pu, *pv, *ln2_g, *ln2_b;
  float* out; char* ws;
};

DI ushort_t f2bf(float x) { unsigned u = __float_as_uint(x); u += 0x7fffu + ((u >> 16) & 1u); return (ushort_t)(u >> 16); }
DI float bf2f(ushort_t h) { return __uint_as_float(((unsigned)h) << 16); }
typedef __bf16 bf16x2_hw __attribute__((ext_vector_type(2)));
typedef float f32x2_hw __attribute__((ext_vector_type(2)));
DI unsigned pack2(float a, float b) { f32x2_hw v = {a, b}; return __builtin_bit_cast(unsigned, __builtin_convertvector(v, bf16x2_hw)); }
DI int tid_opaque() { int t = threadIdx.x; asm volatile("" : "+v"(t)); return t; }
DI float wave_sum(float v) {
#pragma unroll
  for (int o = 32; o > 0; o >>= 1) v += __shfl_xor(v, o);
  return v;
}

struct cf2 { float x, y; };
constexpr int FFT_N = 16384, FFT_SA = 560;

DI constexpr float wcos32(int j) {
  switch (j & 31) {
    case 0: return 1.0f; case 1: return 0.98078528040323043f; case 2: return 0.92387953251128674f; case 3: return 0.83146961230254524f;
    case 4: return 0.70710678118654752f; case 5: return 0.55557023301960218f; case 6: return 0.38268343236508978f; case 7: return 0.19509032201612825f;
    case 8: return 0.0f; case 9: return -0.19509032201612825f; case 10: return -0.38268343236508978f; case 11: return -0.55557023301960218f;
    case 12: return -0.70710678118654752f; case 13: return -0.83146961230254524f; case 14: return -0.92387953251128674f; case 15: return -0.98078528040323043f;
    case 16: return -1.0f; case 17: return -0.98078528040323043f; case 18: return -0.92387953251128674f; case 19: return -0.83146961230254524f;
    case 20: return -0.70710678118654752f; case 21: return -0.55557023301960218f; case 22: return -0.38268343236508978f; case 23: return -0.19509032201612825f;
    case 24: return 0.0f; case 25: return 0.19509032201612825f; case 26: return 0.38268343236508978f; case 27: return 0.55557023301960218f;
    case 28: return 0.70710678118654752f; case 29: return 0.83146961230254524f; case 30: return 0.92387953251128674f; default: return 0.98078528040323043f;
  }
}
DI constexpr float wsin32(int j) { return wcos32(j + 24); }
DI constexpr int brev(int v, int bits) { int r = 0; for (int i = 0; i < bits; ++i) r |= ((v >> i) & 1) << (bits - 1 - i); return r; }

template <int R, int LEN, bool INV, bool ZHI>
DI void r2_stage(float (&re)[R], float (&im)[R]) {
  constexpr int half = LEN / 2;
#pragma unroll
  for (int start = 0; start < R; start += LEN) {
#pragma unroll
    for (int j = 0; j < half; ++j) {
      const int a = start + j, b = a + half;
      const int tj = j * (32 / LEN);
      const float c = wcos32(tj), s = wsin32(tj);
      if (!INV) {
        float dr, di;
        if (ZHI) { dr = re[a]; di = im[a]; }
        else {
          const float ar = re[a], ai = im[a], br = re[b], bi = im[b];
          re[a] = ar + br; im[a] = ai + bi; dr = ar - br; di = ai - bi;
        }
        if (tj == 0) { re[b] = dr; im[b] = di; }
        else if (tj == 8) { re[b] = di; im[b] = -dr; }
        else { re[b] = dr * c + di * s; im[b] = di * c - dr * s; }
      } else {
        const float br = re[b], bi = im[b];
        float pr, pi;
        if (tj == 0) { pr = br; pi = bi; }
        else if (tj == 8) { pr = -bi; pi = br; }
        else { pr = br * c - bi * s; pi = bi * c + br * s; }
        const float ar = re[a], ai = im[a];
        re[a] = ar + pr; im[a] = ai + pi; re[b] = ar - pr; im[b] = ai - pi;
      }
    }
  }
}
template <int R, bool ZHI> DI void dft_fwd(float (&re)[R], float (&im)[R]) {
  if (R == 32) r2_stage<R, (R == 32 ? 32 : 2), false, ZHI>(re, im);
  r2_stage<R, 16, false, (R == 16) && ZHI>(re, im);
  r2_stage<R, 8, false, false>(re, im);
  r2_stage<R, 4, false, false>(re, im);
  r2_stage<R, 2, false, false>(re, im);
}
template <int R> DI void dft_inv(float (&re)[R], float (&im)[R]) {
  r2_stage<R, 2, true, false>(re, im);
  r2_stage<R, 4, true, false>(re, im);
  r2_stage<R, 8, true, false>(re, im);
  r2_stage<R, 16, true, false>(re, im);
  if (R == 32) r2_stage<R, (R == 32 ? 32 : 2), true, false>(re, im);
}

DI void sincos_turn(float frac, float& s, float& c) { sincospif(2.0f * frac, &s, &c); }

template <bool ZHI>
DI void fft_fwdA(float (&re)[32], float (&im)[32], cf2* lds, int m) {
  asm volatile("" : "+v"(m));
  float s1, c1; sincos_turn((float)m * (1.0f / 16384.0f), s1, c1);
  __builtin_amdgcn_sched_barrier(0);
  dft_fwd<32, ZHI>(re, im);
  __builtin_amdgcn_sched_barrier(0);
  float wr = 1.f, wi = 0.f;
#pragma unroll
  for (int k1 = 0; k1 < 32; ++k1) {
    if ((k1 & 3) == 0) __builtin_amdgcn_sched_barrier(0);
    const int r = brev(k1, 5);
    cf2 o; o.x = re[r] * wr - im[r] * wi; o.y = re[r] * wi + im[r] * wr;
    lds[k1 * FFT_SA + m] = o;
    const float nr = wr * c1 + wi * s1, ni = wi * c1 - wr * s1;
    wr = nr; wi = ni;
  }
}
DI void fft_B_read(float (&re)[32], float (&im)[32], const cf2* lds, int tid) {
  const int k1 = tid >> 4, mp = tid & 15;
#pragma unroll
  for (int n2 = 0; n2 < 32; ++n2) { cf2 v = lds[k1 * FFT_SA + n2 * 16 + mp]; re[n2] = v.x; im[n2] = v.y; }
}
DI void fft_fwdB_write(float (&re)[32], float (&im)[32], cf2* lds, int tid) {
  asm volatile("" : "+v"(tid));
  const int k1 = tid >> 4, mp = tid & 15;
  float s1, c1; sincos_turn((float)mp * (1.0f / 512.0f), s1, c1);
  __builtin_amdgcn_sched_barrier(0);
  dft_fwd<32, false>(re, im);
  __builtin_amdgcn_sched_barrier(0);
  float wr = 1.f, wi = 0.f;
#pragma unroll
  for (int k2 = 0; k2 < 32; ++k2) {
    if ((k2 & 3) == 0) __builtin_amdgcn_sched_barrier(0);
    const int r = brev(k2, 5);
    cf2 o; o.x = re[r] * wr - im[r] * wi; o.y = re[r] * wi + im[r] * wr;
    lds[k1 * FFT_SA + k2 * 17 + mp] = o;
    const float nr = wr * c1 + wi * s1, ni = wi * c1 - wr * s1;
    wr = nr; wi = ni;
  }
}
DI void fft_fwdC(float (&re)[32], float (&im)[32], const cf2* lds, int tid) {
  const int k1 = tid >> 5, k2 = tid & 31;
#pragma unroll
  for (int h = 0; h < 2; ++h) {
    float tr[16], ti[16];
#pragma unroll
    for (int mp = 0; mp < 16; ++mp) { cf2 v = lds[(k1 + 16 * h) * FFT_SA + k2 * 17 + mp]; tr[mp] = v.x; ti[mp] = v.y; }
    dft_fwd<16, false>(tr, ti);
#pragma unroll
    for (int i = 0; i < 16; ++i) { re[h * 16 + i] = tr[i]; im[h * 16 + i] = ti[i]; }
  }
}
DI void fft_invC(float (&re)[32], float (&im)[32], cf2* lds, int tid) {
  const int k1 = tid >> 5, k2 = tid & 31;
#pragma unroll
  for (int h = 0; h < 2; ++h) {
    float tr[16], ti[16];
#pragma unroll
    for (int i = 0; i < 16; ++i) { tr[i] = re[h * 16 + i]; ti[i] = im[h * 16 + i]; }
    dft_inv<16>(tr, ti);
#pragma unroll
    for (int mp = 0; mp < 16; ++mp) { cf2 o; o.x = tr[mp]; o.y = ti[mp]; lds[(k1 + 16 * h) * FFT_SA + k2 * 17 + mp] = o; }
  }
}
DI void fft_invB_read(float (&re)[32], float (&im)[32], const cf2* lds, int tid) {
  asm volatile("" : "+v"(tid));
  const int k1 = tid >> 4, mp = tid & 15;
  float s1, c1; sincos_turn((float)mp * (1.0f / 512.0f), s1, c1);
  float wr = 1.f, wi = 0.f;
  __builtin_amdgcn_sched_barrier(0);
#pragma unroll
  for (int k2 = 0; k2 < 32; ++k2) {
    if ((k2 & 3) == 0) __builtin_amdgcn_sched_barrier(0);
    const int r = brev(k2, 5);
    cf2 v = lds[k1 * FFT_SA + k2 * 17 + mp];
    re[r] = v.x * wr - v.y * wi; im[r] = v.x * wi + v.y * wr;
    const float nr = wr * c1 - wi * s1, ni = wi * c1 + wr * s1;
    wr = nr; wi = ni;
  }
}
DI void fft_invB_write(float (&re)[32], float (&im)[32], cf2* lds, int tid) {
  const int k1 = tid >> 4, mp = tid & 15;
  dft_inv<32>(re, im);
#pragma unroll
  for (int n2 = 0; n2 < 32; ++n2) { cf2 o; o.x = re[n2]; o.y = im[n2]; lds[k1 * FFT_SA + n2 * 16 + mp] = o; }
}
DI void fft_invA(float (&re)[32], float (&im)[32], const cf2* lds, int m) {
  asm volatile("" : "+v"(m));
  float s1, c1; sincos_turn((float)m * (1.0f / 16384.0f), s1, c1);
  float wr = 1.f, wi = 0.f;
  __builtin_amdgcn_sched_barrier(0);
#pragma unroll
  for (int k1 = 0; k1 < 32; ++k1) {
    if ((k1 & 3) == 0) __builtin_amdgcn_sched_barrier(0);
    const int r = brev(k1, 5);
    cf2 v = lds[k1 * FFT_SA + m];
    re[r] = v.x * wr - v.y * wi; im[r] = v.x * wi + v.y * wr;
    const float nr = wr * c1 - wi * s1, ni = wi * c1 + wr * s1;
    wr = nr; wi = ni;
  }
  __builtin_amdgcn_sched_barrier(0);
  dft_inv<32>(re, im);
}

DI void phase_ada(const P& p, char* smem) {
  float (*red)[16][32] = (float (*)[16][32])smem;
  const int tid = tid_opaque(), cl = tid & 31, kq = tid >> 5;
  for (int item = blockIdx.x; item < 192; item += gridDim.x) {
    const int col = item * 32 + cl;
    float a0 = 0.f, a1 = 0.f;
#pragma unroll 16
    for (int k = kq * 64; k < kq * 64 + 64; ++k) {
      const float w = p.w_ada[(size_t)k * 6144 + col];
      const float c0 = p.c[k], c1 = p.c[1024 + k];
      a0 += (c0 / (1.f + __expf(-c0))) * w;
      a1 += (c1 / (1.f + __expf(-c1))) * w;
    }
    __syncthreads();
    red[0][kq][cl] = a0; red[1][kq][cl] = a1;
    __syncthreads();
    if (tid < 64) {
      const int b = tid >> 5;
      float s = p.b_ada[col];
#pragma unroll
      for (int q = 0; q < 16; ++q) s += red[b][q][cl];
      ((float*)(p.ws + OFF_ADA))[b * 6144 + col] = s;
    }
  }
}
DI void phase_u1(const P& p) {
  const float* ada = (const float*)(p.ws + OFF_ADA);
  ushort_t* u1b = (ushort_t*)(p.ws + OFF_U1B);
  for (int i = blockIdx.x * NT + tid_opaque(); i < T_ * 128; i += gridDim.x * NT) {
    const int row = i >> 7, k = (i & 127) * 8, b = row / S_;
    const float* xp = p.x + (size_t)row * 1024 + k;
    const f32x4 x0 = *(const f32x4*)xp, x1 = *(const f32x4*)(xp + 4);
    const f32x4 s0 = *(const f32x4*)(ada + b * 6144 + 1024 + k), s1 = *(const f32x4*)(ada + b * 6144 + 1024 + k + 4);
    const f32x4 h0 = *(const f32x4*)(ada + b * 6144 + k), h1 = *(const f32x4*)(ada + b * 6144 + k + 4);
    u32x4 o;
    o[0] = pack2(x0[0] * (1.f + s0[0]) + h0[0], x0[1] * (1.f + s0[1]) + h0[1]);
    o[1] = pack2(x0[2] * (1.f + s0[2]) + h0[2], x0[3] * (1.f + s0[3]) + h0[3]);
    o[2] = pack2(x1[0] * (1.f + s1[0]) + h1[0], x1[1] * (1.f + s1[1]) + h1[1]);
    o[3] = pack2(x1[2] * (1.f + s1[2]) + h1[2], x1[3] * (1.f + s1[3]) + h1[3]);
    *(u32x4*)(u1b + (size_t)row * 1024 + k) = o;
  }
}

DI void transpose_tile(const float* __restrict__ W, ushort_t* __restrict__ Wt, int K, int N, int item, char* smem) {
  float (*tile)[65] = (float (*)[65])smem;
  const int ntn = N / 64;
  const int n0 = (item % ntn) * 64, k0 = (item / ntn) * 32;
  const int tid = tid_opaque();
  __syncthreads();
  {
    const int tx = tid & 63, ty = tid >> 6;
#pragma unroll
    for (int i = 0; i < 4; ++i) tile[ty + 8 * i][tx] = W[(size_t)(k0 + ty + 8 * i) * N + n0 + tx];
  }
  __syncthreads();
  {
    const int kk = tid & 31, nn0 = tid >> 5;
#pragma unroll
    for (int i = 0; i < 4; ++i) Wt[(size_t)(n0 + nn0 + 16 * i) * K + k0 + kk] = f2bf(tile[kk][nn0 + 16 * i]);
  }
}
DI void phase_transposes(const P& p, char* smem) {
  constexpr int I0 = (INW / 64) * 32, I1 = I0 + 32 * 32, I2 = I1 + 16 * 32, I3 = I2 + 16 * 16, I4 = I3 + 16 * 8;
  for (int item = blockIdx.x; item < I4; item += gridDim.x) {
    if (item < I0) transpose_tile(p.w_in, (ushort_t*)(p.ws + OFF_WIN_T), 1024, INW, item, smem);
    else if (item < I1) transpose_tile(p.wq, (ushort_t*)(p.ws + OFF_WQ_T), 1024, 2048, item - I0, smem);
    else if (item < I2) transpose_tile(p.w_out, (ushort_t*)(p.ws + OFF_WOUT_T), 1024, 1024, item - I1, smem);
    else if (item < I3) transpose_tile(p.w_bh, (ushort_t*)(p.ws + OFF_WBH_T), 512, 1024, item - I2, smem);
    else transpose_tile(p.w_ba, (ushort_t*)(p.ws + OFF_WBA_T), 256, 1024, item - I3, smem);
  }
}

DI void phase_filter(const P& p, char* smem) {
  float (*zf)[33] = (float (*)[33])smem;
  float (*h1)[64] = (float (*)[64])(smem + 4352);
  float (*h2)[65] = (float (*)[65])(smem + 4352 + 8192);
  float* w1s = (float*)(smem + 32768);
  float* w2s = (float*)(smem + 32768 + 8448);
  const int tid = tid_opaque(), lane = tid & 63, wave = tid >> 6;
  __syncthreads();
  for (int i = tid; i < 33 * 64; i += NT) w1s[i] = p.f1_w[i];
  for (int i = tid; i < 64 * 64; i += NT) w2s[i] = p.f2_w[i];
  for (int item = blockIdx.x; item < 256; item += gridDim.x) {
  const int t0 = item * 32;
  __syncthreads();
  for (int idx = tid; idx < 32 * 33; idx += NT) {
    int tt = idx / 33, e = idx % 33, t = t0 + tt;
    float tl = (float)t * (1.0f / 8191.0f);
    float w = 6.283185307179586f * (float)t / 8192.0f;
    float val;
    if (e == 0) val = tl;
    else {
      int i = (e - 1) & 15;
      float f = 1e-4f + (float)i * ((15.0f - 1e-4f) / 15.0f);
      val = (e <= 16) ? cosf(f * w) : -sinf(f * w);
    }
    zf[tt][e] = val;
  }
  __syncthreads();
  for (int idx = tid; idx < 32 * 64; idx += NT) {
    int tt = idx >> 6, j = idx & 63;
    float a = p.f1_b[j];
#pragma unroll
    for (int e = 0; e < 33; ++e) a += zf[tt][e] * w1s[e * 64 + j];
    h1[tt][j] = sinf(p.f1_freq[j] * a);
  }
  __syncthreads();
  for (int idx = tid; idx < 32 * 64; idx += NT) {
    int tt = idx >> 6, j = idx & 63;
    float a = p.f2_b[j];
#pragma unroll
    for (int e = 0; e < 64; ++e) a += h1[tt][e] * w2s[e * 64 + j];
    h2[tt][j] = sinf(p.f2_freq[j] * a);
  }
  __syncthreads();
  float* filt = p.out;
  const float min_decay = -3.0701134573253945f, max_decay = -15.350567286626973f;
  float af[32];
#pragma unroll
  for (int s = 0; s < 32; ++s) af[s] = h2[lane & 31][2 * s + (lane >> 5)];
#pragma unroll 1
  for (int ci = 0; ci < 8; ++ci) {
    const int col = (wave + 8 * ci) * 32 + (lane & 31);
    const float* wp = p.f3_w + (size_t)(lane >> 5) * 2048 + col;
    float bfv[32];
#pragma unroll
    for (int s = 0; s < 32; ++s) bfv[s] = wp[(size_t)s * 4096];
    f32x16 acc;
#pragma unroll
    for (int r = 0; r < 16; ++r) acc[r] = 0.f;
#pragma unroll
    for (int s = 0; s < 32; ++s) acc = __builtin_amdgcn_mfma_f32_32x32x2f32(af[s], bfv[s], acc, 0, 0, 0);
    const float delta = fabsf(min_decay + (float)(col & 511) * ((max_decay - min_decay) / 511.0f));
    float* dst = filt + (size_t)col * 8192 + t0 + 4 * (lane >> 5);
#pragma unroll
    for (int q = 0; q < 4; ++q) {
      f32x4 o;
#pragma unroll
      for (int r = 0; r < 4; ++r) {
        const float tl = (float)(t0 + 8 * q + 4 * (lane >> 5) + r) * (1.0f / 8191.0f);
        o[r] = acc[4 * q + r] * __expf(-tl * delta);
      }
      *(f32x4*)(dst + 8 * q) = o;
    }
  }
  }
}

constexpr int BM = 256, BN = 128, BK = 64;
constexpr int LDS_A = BM * BK * 2, LDS_B = BN * BK * 2, LDS_STAGE = LDS_A + LDS_B;
constexpr int GEMM_LDS = 2 * LDS_STAGE + 8192;

DI int swz(int row, int ch) { return row * 128 + ((ch ^ (row & 7)) << 4); }

struct ALoadBf16 {
  const ushort_t* A; int lda;
  struct Raw { u32x4 v; };
  DI Raw fetch(int row, int k) const { Raw r; r.v = *(const u32x4*)(A + (size_t)row * lda + k); return r; }
  DI u32x4 cvt(const Raw& r, int k) const { return r.v; }
};
struct ALoadF32Mod {
  const float* A; const float* mod;
  struct Raw { f32x4 a, b; };
  DI Raw fetch(int row, int k) const { Raw r; const float* s = A + (size_t)row * 1024 + k; r.a = *(const f32x4*)s; r.b = *(const f32x4*)(s + 4); return r; }
  DI u32x4 cvt(const Raw& r, int k) const {
    f32x4 s0 = *(const f32x4*)(mod + k), s1 = *(const f32x4*)(mod + k + 4);
    f32x4 h0 = *(const f32x4*)(mod + 1024 + k), h1 = *(const f32x4*)(mod + 1024 + k + 4);
    u32x4 o;
    o[0] = pack2(r.a[0] * s0[0] + h0[0], r.a[1] * s0[1] + h0[1]);
    o[1] = pack2(r.a[2] * s0[2] + h0[2], r.a[3] * s0[3] + h0[3]);
    o[2] = pack2(r.b[0] * s1[0] + h1[0], r.b[1] * s1[1] + h1[1]);
    o[3] = pack2(r.b[2] * s1[2] + h1[2], r.b[3] * s1[3] + h1[3]);
    return o;
  }
};

template <class AL, bool SWAP = false>
DI void gemm_mainloop(f32x16 (&acc)[2][2], const AL& al, int m0, const ushort_t* __restrict__ Bt, int ldb, int n0, int K, char* smem) {
  const int tid = tid_opaque(), lane = tid & 63, wave = tid >> 6;
  const int wm = wave >> 1, wn = wave & 1;
  const int lr = tid >> 3, lc = tid & 7;
  typename AL::Raw ra[4]; u32x4 rb[2];
  const int nk = K / BK;
#pragma unroll
  for (int i = 0; i < 4; ++i) ra[i] = al.fetch(m0 + lr + 64 * i, lc * 8);
#pragma unroll
  for (int i = 0; i < 2; ++i) rb[i] = *(const u32x4*)(Bt + (size_t)(n0 + lr + 64 * i) * ldb + lc * 8);
  __syncthreads();
#pragma unroll
  for (int i = 0; i < 4; ++i) *(u32x4*)(smem + swz(lr + 64 * i, lc)) = al.cvt(ra[i], lc * 8);
#pragma unroll
  for (int i = 0; i < 2; ++i) *(u32x4*)(smem + LDS_A + swz(lr + 64 * i, lc)) = rb[i];
  __syncthreads();
  for (int kt = 0; kt < nk; ++kt) {
    char* cur = smem + (kt & 1) * LDS_STAGE;
    char* nxt = smem + ((kt + 1) & 1) * LDS_STAGE;
    const bool more = (kt + 1 < nk);
    const int kn = (kt + 1) * BK + lc * 8;
    if (more) {
#pragma unroll
      for (int i = 0; i < 4; ++i) ra[i] = al.fetch(m0 + lr + 64 * i, kn);
#pragma unroll
      for (int i = 0; i < 2; ++i) rb[i] = *(const u32x4*)(Bt + (size_t)(n0 + lr + 64 * i) * ldb + kn);
    }
#pragma unroll
    for (int s = 0; s < 4; ++s) {
      const int ch = 2 * s + (lane >> 5);
      bf16x8 af[2], bfr[2];
#pragma unroll
      for (int mi = 0; mi < 2; ++mi) af[mi] = *(const bf16x8*)(cur + swz(wm * 64 + mi * 32 + (lane & 31), ch));
#pragma unroll
      for (int ni = 0; ni < 2; ++ni) bfr[ni] = *(const bf16x8*)(cur + LDS_A + swz(wn * 64 + ni * 32 + (lane & 31), ch));
#pragma unroll
      for (int mi = 0; mi < 2; ++mi)
#pragma unroll
        for (int ni = 0; ni < 2; ++ni)
          acc[mi][ni] = SWAP ? __builtin_amdgcn_mfma_f32_32x32x16_bf16(bfr[ni], af[mi], acc[mi][ni], 0, 0, 0)
                             : __builtin_amdgcn_mfma_f32_32x32x16_bf16(af[mi], bfr[ni], acc[mi][ni], 0, 0, 0);
    }
    if (more) {
#pragma unroll
      for (int i = 0; i < 4; ++i) *(u32x4*)(nxt + swz(lr + 64 * i, lc)) = al.cvt(ra[i], kn);
#pragma unroll
      for (int i = 0; i < 2; ++i) *(u32x4*)(nxt + LDS_A + swz(lr + 64 * i, lc)) = rb[i];
    }
    __syncthreads();
  }
}

constexpr int AT_ROW = 576;
constexpr int LDS_AT = 64 * AT_ROW;
constexpr int LDS_STAGE_T = LDS_AT + LDS_B;
typedef __attribute__((ext_vector_type(4))) short s16x4;
DI void gemm_mainloop_AT(f32x16 (&acc)[2][2], const ushort_t* __restrict__ At, size_t ldt, const ushort_t* __restrict__ Bt, int ldb, int n0, int K, char* smem) {
  const int tid = tid_opaque(), lane = tid & 63, wave = tid >> 6;
  const int wm = wave >> 1, wn = wave & 1;
  const int lr = tid >> 3, lc = tid & 7;
  u32x4 ra[4], rb[2];
  const int nk = K / BK;
#pragma unroll
  for (int i = 0; i < 4; ++i) { const int q = tid + 512 * i; ra[i] = *(const u32x4*)(At + (size_t)(q >> 5) * ldt + (q & 31) * 8); }
#pragma unroll
  for (int i = 0; i < 2; ++i) rb[i] = *(const u32x4*)(Bt + (size_t)(n0 + lr + 64 * i) * ldb + lc * 8);
  __syncthreads();
#pragma unroll
  for (int i = 0; i < 4; ++i) { const int q = tid + 512 * i; *(u32x4*)(smem + (q >> 5) * AT_ROW + (q & 31) * 16) = ra[i]; }
#pragma unroll
  for (int i = 0; i < 2; ++i) *(u32x4*)(smem + LDS_AT + swz(lr + 64 * i, lc)) = rb[i];
  __syncthreads();
  const int hh = lane >> 5, gg = (lane >> 4) & 1, qq = (lane & 15) >> 2, pp = lane & 3;
  for (int kt = 0; kt < nk; ++kt) {
    char* cur = smem + (kt & 1) * LDS_STAGE_T;
    char* nxt = smem + ((kt + 1) & 1) * LDS_STAGE_T;
    const bool more = (kt + 1 < nk);
    if (more) {
#pragma unroll
      for (int i = 0; i < 4; ++i) { const int q = tid + 512 * i; ra[i] = *(const u32x4*)(At + (size_t)((kt + 1) * BK + (q >> 5)) * ldt + (q & 31) * 8); }
#pragma unroll
      for (int i = 0; i < 2; ++i) rb[i] = *(const u32x4*)(Bt + (size_t)(n0 + lr + 64 * i) * ldb + (kt + 1) * BK + lc * 8);
    }
#pragma unroll
    for (int s = 0; s < 4; ++s) {
      const int ch = 2 * s + hh;
      bf16x8 af[2], bfr[2];
#pragma unroll
      for (int mi = 0; mi < 2; ++mi) {
        const char* a0 = cur + (16 * s + 8 * hh + qq) * AT_ROW + (wm * 64 + mi * 32 + 16 * gg + 4 * pp) * 2;
        s16x4 lo = __builtin_amdgcn_ds_read_tr16_b64_v4i16((__attribute__((address_space(3))) s16x4*)(a0));
        s16x4 hi = __builtin_amdgcn_ds_read_tr16_b64_v4i16((__attribute__((address_space(3))) s16x4*)(a0 + 4 * AT_ROW));
        af[mi] = __builtin_shufflevector(lo, hi, 0, 1, 2, 3, 4, 5, 6, 7);
      }
#pragma unroll
      for (int ni = 0; ni < 2; ++ni) bfr[ni] = *(const bf16x8*)(cur + LDS_AT + swz(wn * 64 + ni * 32 + (lane & 31), ch));
#pragma unroll
      for (int mi = 0; mi < 2; ++mi)
#pragma unroll
        for (int ni = 0; ni < 2; ++ni) acc[mi][ni] = __builtin_amdgcn_mfma_f32_32x32x16_bf16(af[mi], bfr[ni], acc[mi][ni], 0, 0, 0);
    }
    if (more) {
#pragma unroll
      for (int i = 0; i < 4; ++i) { const int q = tid + 512 * i; *(u32x4*)(nxt + (q >> 5) * AT_ROW + (q & 31) * 16) = ra[i]; }
#pragma unroll
      for (int i = 0; i < 2; ++i) *(u32x4*)(nxt + LDS_AT + swz(lr + 64 * i, lc)) = rb[i];
    }
    __syncthreads();
  }
}

constexpr int G2_A = 32768, G2_STAGE = 65536;
template <bool SWAP>
DI void gemm256(f32x16 (&acc)[4][2], const ushort_t* __restrict__ A, int lda, int m0, const ushort_t* __restrict__ Bt, int ldb, int n0, int K, char* smem) {
  const int tid = tid_opaque(), lane = tid & 63, wave = tid >> 6;
  const int wm = wave >> 2, wn = wave & 3;
  const int lr = tid >> 3, lc = tid & 7;
  u32x4 ra[4], rb[4];
  const int nk = K / BK;
  const ushort_t* ap = A + (size_t)(m0 + lr) * lda + lc * 8;
  const ushort_t* bp = Bt + (size_t)(n0 + lr) * ldb + lc * 8;
#pragma unroll
  for (int i = 0; i < 4; ++i) { ra[i] = *(const u32x4*)(ap + (size_t)(64 * i) * lda); rb[i] = *(const u32x4*)(bp + (size_t)(64 * i) * ldb); }
  __syncthreads();
#pragma unroll
  for (int i = 0; i < 4; ++i) { *(u32x4*)(smem + swz(lr + 64 * i, lc)) = ra[i]; *(u32x4*)(smem + G2_A + swz(lr + 64 * i, lc)) = rb[i]; }
  __syncthreads();
  for (int kt = 0; kt < nk; ++kt) {
    char* cur = smem + (kt & 1) * G2_STAGE;
    char* nxt = smem + ((kt + 1) & 1) * G2_STAGE;
    const bool more = (kt + 1 < nk);
    if (more) {
#pragma unroll
      for (int i = 0; i < 4; ++i) { ra[i] = *(const u32x4*)(ap + (size_t)(64 * i) * lda + (kt + 1) * BK); rb[i] = *(const u32x4*)(bp + (size_t)(64 * i) * ldb + (kt + 1) * BK); }
    }
#pragma unroll
    for (int s = 0; s < 4; ++s) {
      const int ch = 2 * s + (lane >> 5);
      bf16x8 af[4], bfr[2];
#pragma unroll
      for (int mi = 0; mi < 4; ++mi) af[mi] = *(const bf16x8*)(cur + swz(wm * 128 + mi * 32 + (lane & 31), ch));
#pragma unroll
      for (int ni = 0; ni < 2; ++ni) bfr[ni] = *(const bf16x8*)(cur + G2_A + swz(wn * 64 + ni * 32 + (lane & 31), ch));
#pragma unroll
      for (int mi = 0; mi < 4; ++mi)
#pragma unroll
        for (int ni = 0; ni < 2; ++ni)
          acc[mi][ni] = SWAP ? __builtin_amdgcn_mfma_f32_32x32x16_bf16(bfr[ni], af[mi], acc[mi][ni], 0, 0, 0)
                             : __builtin_amdgcn_mfma_f32_32x32x16_bf16(af[mi], bfr[ni], acc[mi][ni], 0, 0, 0);
      if (s & 1) __builtin_amdgcn_sched_barrier(0);
    }
    if (more) {
#pragma unroll
      for (int i = 0; i < 4; ++i) { *(u32x4*)(nxt + swz(lr + 64 * i, lc)) = ra[i]; *(u32x4*)(nxt + G2_A + swz(lr + 64 * i, lc)) = rb[i]; }
    }
    __syncthreads();
  }
}
constexpr int G2T_A = 64 * 576, G2T_STAGE = G2T_A + 32768;
DI void gemm256_AT(f32x16 (&acc)[4][2], const ushort_t* __restrict__ At, size_t ldt, const ushort_t* __restrict__ Bt, int ldb, int n0, int K, char* smem) {
  const int tid = tid_opaque(), lane = tid & 63, wave = tid >> 6;
  const int wm = wave >> 2, wn = wave & 3;
  const int lr = tid >> 3, lc = tid & 7;
  u32x4 ra[4], rb[4];
  const int nk = K / BK;
  const ushort_t* bp = Bt + (size_t)(n0 + lr) * ldb + lc * 8;
#pragma unroll
  for (int i = 0; i < 4; ++i) { const int q = tid + 512 * i; ra[i] = *(const u32x4*)(At + (size_t)(q >> 5) * ldt + (q & 31) * 8); rb[i] = *(const u32x4*)(bp + (size_t)(64 * i) * ldb); }
  __syncthreads();
#pragma unroll
  for (int i = 0; i < 4; ++i) { const int q = tid + 512 * i; *(u32x4*)(smem + (q >> 5) * 576 + (q & 31) * 16) = ra[i]; *(u32x4*)(smem + G2T_A + swz(lr + 64 * i, lc)) = rb[i]; }
  __syncthreads();
  const int hh = lane >> 5, gg = (lane >> 4) & 1, qq = (lane & 15) >> 2, pp = lane & 3;
  for (int kt = 0; kt < nk; ++kt) {
    char* cur = smem + (kt & 1) * G2T_STAGE;
    char* nxt = smem + ((kt + 1) & 1) * G2T_STAGE;
    const bool more = (kt + 1 < nk);
    if (more) {
#pragma unroll
      for (int i = 0; i < 4; ++i) { const int q = tid + 512 * i; ra[i] = *(const u32x4*)(At + (size_t)((kt + 1) * BK + (q >> 5)) * ldt + (q & 31) * 8); rb[i] = *(const u32x4*)(bp + (size_t)(64 * i) * ldb + (kt + 1) * BK); }
    }
#pragma unroll
    for (int s = 0; s < 4; ++s) {
      const int ch = 2 * s + hh;
      bf16x8 af[4], bfr[2];
#pragma unroll
      for (int mi = 0; mi < 4; ++mi) {
        const char* a0 = cur + (16 * s + 8 * hh + qq) * 576 + (wm * 128 + mi * 32 + 16 * gg + 4 * pp) * 2;
        s16x4 lo = __builtin_amdgcn_ds_read_tr16_b64_v4i16((__attribute__((address_space(3))) s16x4*)(a0));
        s16x4 hi = __builtin_amdgcn_ds_read_tr16_b64_v4i16((__attribute__((address_space(3))) s16x4*)(a0 + 4 * 576));
        af[mi] = __builtin_shufflevector(lo, hi, 0, 1, 2, 3, 4, 5, 6, 7);
      }
#pragma unroll
      for (int ni = 0; ni < 2; ++ni) bfr[ni] = *(const bf16x8*)(cur + G2T_A + swz(wn * 64 + ni * 32 + (lane & 31), ch));
#pragma unroll
      for (int mi = 0; mi < 4; ++mi)
#pragma unroll
        for (int ni = 0; ni < 2; ++ni) acc[mi][ni] = __builtin_amdgcn_mfma_f32_32x32x16_bf16(af[mi], bfr[ni], acc[mi][ni], 0, 0, 0);
      if (s & 1) __builtin_amdgcn_sched_barrier(0);
    }
    if (more) {
#pragma unroll
      for (int i = 0; i < 4; ++i) { const int q = tid + 512 * i; *(u32x4*)(nxt + (q >> 5) * 576 + (q & 31) * 16) = ra[i]; *(u32x4*)(nxt + G2T_A + swz(lr + 64 * i, lc)) = rb[i]; }
    }
    __syncthreads();
  }
}
DI void acc_zero4(f32x16 (&acc)[4][2]) {
#pragma unroll
  for (int a = 0; a < 4; ++a)
#pragma unroll
    for (int b = 0; b < 2; ++b)
#pragma unroll
      for (int r = 0; r < 16; ++r) acc[a][b][r] = 0.f;
}
DI void acc_zero(f32x16 (&acc)[2][2]) {
#pragma unroll
  for (int a = 0; a < 2; ++a)
#pragma unroll
    for (int b = 0; b < 2; ++b)
#pragma unroll
      for (int r = 0; r < 16; ++r) acc[a][b][r] = 0.f;
}
#define ACC_ROW(mi, r) (wm * 64 + (mi) * 32 + ((r) & 3) + 8 * ((r) >> 2) + 4 * (lane >> 5))
#define ACC_COL(ni) (wn * 64 + (ni) * 32 + (lane & 31))

DI void stage_mod(float* mod, const float* ada, int b, int sc_chunk, int sh_chunk) {
  for (int i = tid_opaque(); i < 1024; i += NT) {
    mod[i] = 1.f + ada[b * 6144 + sc_chunk * 1024 + i];
    mod[1024 + i] = ada[b * 6144 + sh_chunk * 1024 + i];
  }
}


namespace pg8 {
#define PG8_LAS __attribute__((address_space(3)))
constexpr int BM8 = 256, BK8 = 64, HALF = 128, HTB = HALF * BK8 * 2, STAGE_BYTES = 8 * HTB, NXCD = 8, WGM = 8;
DI int lds_byte(int r, int c) { const int st = (r >> 4) * 2 + (c >> 5), rr = r & 15, cc = c & 31, ob = rr * 64 + cc * 2; return st * 1024 + (ob ^ (((ob >> 9) & 1) << 5)); }
DI void stage_rc(int b, int& R, int& C) { const int st = b / 1024, sb = b % 1024, sw = sb ^ (((sb >> 9) & 1) << 5); R = (st >> 1) * 16 + sw / 64; C = (st & 1) * 32 + (sw % 64) / 2; }
DI int perm32(int rho) { const int n = rho >> 4, i = rho & 15; return 8 * (i >> 2) + 4 * n + (i & 3); }
struct Unit { int pm, pn, kind; };
DI void tile_order(int L, int nM, int nN, int& pm, int& pn) {
  const int nwg = nM * nN;
  int wgid = L; { const int q = nwg / NXCD, r = nwg % NXCD, xcd = wgid % NXCD, off = wgid / NXCD; wgid = (xcd < r ? xcd * (q + 1) : r * (q + 1) + (xcd - r) * q) + off; }
  const int nig = WGM * nN, gid = wgid / nig, fm = gid * WGM, gsz = (nM - fm) < WGM ? (nM - fm) : WGM;
  pm = fm + ((wgid % nig) % gsz); pn = (wgid % nig) / gsz;
}
typedef float f32x4p __attribute__((ext_vector_type(4)));
template <class Epi, class Sched>
DI void gemm_phase(PG8_LAS unsigned char* lds, const int K_, const Sched& S, const Epi& E) {
    int K = K_; asm volatile("" : "+s"(K));
    const int tid = tid_opaque();
    const int wid = __builtin_amdgcn_readfirstlane(tid >> 6), lane = tid & 63, wr = wid >> 2, wc = wid & 3, fr = lane & 15, fq = lane >> 4;
    const int nt = K / BK8;
    unsigned voffA[2], voffB[2];
#pragma unroll
    for (int i = 0; i < 2; ++i) { int R, C; stage_rc(tid * 16 + i * 8192, R, C); const int Rb = Epi::PERM ? ((R & ~31) + perm32(R & 31)) : R;
        voffA[i] = (unsigned)(R * K + C) * 2u; voffB[i] = (unsigned)(Rb * K + C) * 2u; }
    const size_t kstep = (size_t)(BK8 * 2);
    const size_t hstep = (size_t)HALF * K * 2;
    const unsigned ldsw = (unsigned)wid * 1024u;
    const int aoff = lds_byte(wr * 64 + fr, fq * 8), boff = lds_byte(wc * 32 + fr, fq * 8);
#define PG8_SA(b, h) (((b) * 2 + (h)) * HTB)
#define PG8_SB(b, h) ((4 + (b) * 2 + (h)) * HTB)
#define PG8_STAGE(bufoff, gbase, voff) do { _Pragma("unroll") for (int _i = 0; _i < 2; ++_i) \
        __builtin_amdgcn_global_load_lds((const unsigned*)((const char*)(gbase) + (voff)[_i]), (PG8_LAS unsigned*)(lds + (bufoff) + ldsw + _i * 8192), 16, 0, 0); } while (0)
#define PG8_LDA(dst, b, h) do { _Pragma("unroll") for (int m = 0; m < 4; ++m) _Pragma("unroll") for (int k = 0; k < 2; ++k) dst[m][k] = *(const PG8_LAS bf16x8*)(lds + PG8_SA(b, h) + aoff + m * 2048 + k * 1024); } while (0)
#define PG8_LDB(dst, b, h) do { _Pragma("unroll") for (int n = 0; n < 2; ++n) _Pragma("unroll") for (int k = 0; k < 2; ++k) dst[n][k] = *(const PG8_LAS bf16x8*)(lds + PG8_SB(b, h) + boff + n * 2048 + k * 1024); } while (0)
#define PG8_MMA(ai, bj, At, Bt) do { __builtin_amdgcn_s_setprio(1); _Pragma("unroll") for (int m = 0; m < 4; ++m) _Pragma("unroll") for (int n = 0; n < 2; ++n) _Pragma("unroll") for (int k = 0; k < 2; ++k) \
        acc[ai][bj][m][n] = __builtin_amdgcn_mfma_f32_16x16x32_bf16(Bt[n][k], At[m][k], acc[ai][bj][m][n], 0, 0, 0); __builtin_amdgcn_s_setprio(0); } while (0)
#define PG8_WAIT_V(n) asm volatile("s_waitcnt vmcnt(" #n ")" ::: "memory")
#define PG8_WAIT_L(n) asm volatile("s_waitcnt lgkmcnt(" #n ")" ::: "memory")
#define PG8_BAR __builtin_amdgcn_s_barrier()
#define PG8_SCHED __builtin_amdgcn_sched_barrier(0)
    Unit cur, nxt; int ui = 0;
    if (!S.next(0, cur)) return;
    f32x4p acc[2][2][4][2];
#pragma unroll
    for (int a = 0; a < 2; ++a)
#pragma unroll
        for (int b = 0; b < 2; ++b)
#pragma unroll
            for (int m = 0; m < 4; ++m)
#pragma unroll
                for (int n = 0; n < 2; ++n) acc[a][b][m][n] = (f32x4p){0.f, 0.f, 0.f, 0.f};
    bf16x8 At[4][2], B0[2][2], B1[2][2];
    const char* cA = S.a_ptr(cur); const char* cB = S.b_ptr(cur);
    PG8_STAGE(PG8_SB(0, 0), cB, voffB); PG8_STAGE(PG8_SA(0, 0), cA, voffA); PG8_STAGE(PG8_SB(0, 1), cB + hstep, voffB); PG8_STAGE(PG8_SA(0, 1), cA + hstep, voffA);
    if (wr == 1) PG8_BAR;
    PG8_WAIT_V(4); PG8_BAR;
    PG8_STAGE(PG8_SB(1, 0), cB + kstep, voffB); PG8_STAGE(PG8_SA(1, 0), cA + kstep, voffA); PG8_STAGE(PG8_SB(1, 1), cB + hstep + kstep, voffB);
    PG8_WAIT_V(6); PG8_BAR;
    for (;;) {
        const bool has_next = S.next(ui + 1, nxt);
        const char* nA = has_next ? S.a_ptr(nxt) : cA; const char* nB = has_next ? S.b_ptr(nxt) : cB;
        for (int t = 0; t < nt; t += 2) {
            const bool last = (t == nt - 2);
            const char* a1 = cA + (size_t)(t + 1) * kstep;
            const char* a2 = last ? nA : cA + (size_t)(t + 2) * kstep; const char* b2 = last ? nB : cB + (size_t)(t + 2) * kstep;
            const char* a3 = a2 + kstep; const char* b3 = b2 + kstep;
            PG8_LDB(B0, 0, 0); PG8_SCHED; PG8_LDA(At, 0, 0); PG8_STAGE(PG8_SA(1, 1), a1 + hstep, voffA);
            PG8_WAIT_L(8); PG8_BAR; PG8_WAIT_L(0); PG8_MMA(0, 0, At, B0); PG8_BAR; PG8_SCHED;
            PG8_LDB(B1, 0, 1); PG8_STAGE(PG8_SB(0, 0), b2, voffB);
            PG8_BAR; PG8_WAIT_L(0); PG8_MMA(0, 1, At, B1); PG8_BAR;
            PG8_LDA(At, 0, 1); PG8_STAGE(PG8_SA(0, 0), a2, voffA);
            PG8_BAR; PG8_WAIT_L(0); PG8_MMA(1, 0, At, B0); PG8_BAR; PG8_SCHED;
            PG8_STAGE(PG8_SB(0, 1), b2 + hstep, voffB);
            PG8_WAIT_V(6); PG8_BAR; PG8_MMA(1, 1, At, B1); PG8_BAR;
            PG8_LDB(B0, 1, 0); PG8_SCHED; PG8_LDA(At, 1, 0); PG8_STAGE(PG8_SA(0, 1), a2 + hstep, voffA);
            PG8_WAIT_L(8); PG8_BAR; PG8_WAIT_L(0); PG8_MMA(0, 0, At, B0); PG8_BAR; PG8_SCHED;
            PG8_LDB(B1, 1, 1); PG8_STAGE(PG8_SB(1, 0), b3, voffB);
            PG8_BAR; PG8_WAIT_L(0); PG8_MMA(0, 1, At, B1); PG8_BAR;
            PG8_LDA(At, 1, 1); PG8_STAGE(PG8_SA(1, 0), a3, voffA);
            PG8_BAR; PG8_WAIT_L(0); PG8_MMA(1, 0, At, B0); PG8_BAR; PG8_SCHED;
            PG8_STAGE(PG8_SB(1, 1), b3 + hstep, voffB);
            PG8_WAIT_V(6); PG8_BAR; PG8_MMA(1, 1, At, B1); PG8_BAR;
        }
        if constexpr (!Epi::AFTER_DRAIN) E(acc, cur, wr, wc, fr, fq);
        if (!has_next) break;
#pragma unroll
        for (int a = 0; a < 2; ++a)
#pragma unroll
            for (int b = 0; b < 2; ++b)
#pragma unroll
                for (int m = 0; m < 4; ++m)
#pragma unroll
                    for (int n = 0; n < 2; ++n) acc[a][b][m][n] = (f32x4p){0.f, 0.f, 0.f, 0.f};
        cur = nxt; cA = nA; cB = nB; ++ui;
    }
    PG8_WAIT_V(0);
    if (wr == 0) PG8_BAR;
    PG8_BAR;
    if constexpr (Epi::AFTER_DRAIN) E.fused(acc, cur, wr, wc, fr, fq, lds, wid, lane);
#undef PG8_SA
#undef PG8_SB
#undef PG8_STAGE
#undef PG8_LDA
#undef PG8_LDB
#undef PG8_MMA
#undef PG8_WAIT_V
#undef PG8_WAIT_L
#undef PG8_BAR
#undef PG8_SCHED
}
}
typedef pg8::f32x4p f32x4p;
DI u32x4 pack8(const f32x4p& a, const f32x4p& b) { u32x4 w; w[0] = pack2(a[0], a[1]); w[1] = pack2(a[2], a[3]); w[2] = pack2(b[0], b[1]); w[3] = pack2(b[2], b[3]); return w; }

struct InprojSched {
  const char* u1b; const char* wt; int G, c;
  DI bool next(int i, pg8::Unit& u) const {
    const int L = i * G + c;
    if (L >= 384 + 1088) return false;
    if (L < 384) { u.kind = 0; pg8::tile_order(L, 6, 64, u.pm, u.pn); } else { u.kind = 1; pg8::tile_order(L - 384, 64, 17, u.pm, u.pn); }
    return true;
  }
  DI const char* a_ptr(const pg8::Unit& u) const { return u.kind == 0 ? wt + (size_t)u.pm * (256 * 1024 * 2) : u1b + (size_t)u.pm * (256 * 1024 * 2); }
  DI const char* b_ptr(const pg8::Unit& u) const { return u.kind == 0 ? u1b + (size_t)u.pn * (256 * 1024 * 2) : wt + (size_t)(1536 + u.pn * 256) * (1024 * 2); }
};
struct InprojEpi {
  static constexpr bool PERM = true, AFTER_DRAIN = false;
  ushort_t* ph; ushort_t* qkv; ushort_t* gate; const float* rope;
  DI void operator()(const f32x4p (&acc)[2][2][4][2], const pg8::Unit& u, int wr, int wc, int fr, int fq) const {
    if (u.kind == 0) {
      const int b = (u.pn * 256) >> 13;
      ushort_t* base = ph + ((size_t)(b * HYC + u.pm * 256 + wr * 64 + fr)) * S_ + ((u.pn * 256) & (S_ - 1)) + wc * 32 + 8 * fq;
#pragma unroll
      for (int ai = 0; ai < 2; ++ai)
#pragma unroll
        for (int m = 0; m < 4; ++m)
#pragma unroll
          for (int bj = 0; bj < 2; ++bj) *(u32x4*)(base + (size_t)(ai * 128 + m * 16) * S_ + bj * 128) = pack8(acc[ai][bj][m][0], acc[ai][bj][m][1]);
      return;
    }
    const int row0 = u.pm * 256 + wr * 64 + fr;
    if (u.pn < 9) {
      const int cq0 = u.pn * 256 + wc * 32 + 8 * fq;
      const bool rotw = (u.pn < 6) && ((wc & 1) == 0);
      const float qs = (u.pn < 3) ? 0.125f : 1.0f;
#pragma unroll
      for (int ai = 0; ai < 2; ++ai)
#pragma unroll
        for (int m = 0; m < 4; ++m) {
          const int row = row0 + ai * 128 + m * 16;
          f32x4p cs[4];
          if (rotw) {
#pragma unroll
            for (int q = 0; q < 4; ++q) cs[q] = *(const f32x4p*)(rope + (size_t)row * 16 + q * 4);
          }
#pragma unroll
          for (int bj = 0; bj < 2; ++bj) {
            f32x4p v0 = acc[ai][bj][m][0], v1 = acc[ai][bj][m][1];
            if (rotw) {
              f32x4p o0, o1;
#pragma unroll
              for (int j = 0; j < 4; ++j) { o0[j] = __shfl_xor(v0[j], 16); o1[j] = __shfl_xor(v1[j], 16); }
              if (fq < 2) {
                const float sg = (fq == 0) ? -1.f : 1.f;
#pragma unroll
                for (int j = 0; j < 4; ++j) {
                  const float c0 = cs[j >> 1][(j & 1) * 2], s0 = cs[j >> 1][(j & 1) * 2 + 1];
                  const float c1 = cs[2 + (j >> 1)][(j & 1) * 2], s1 = cs[2 + (j >> 1)][(j & 1) * 2 + 1];
                  v0[j] = v0[j] * c0 + sg * o0[j] * s0;
                  v1[j] = v1[j] * c1 + sg * o1[j] * s1;
                }
              }
            }
            *(u32x4*)(qkv + (size_t)row * QKVC + cq0 + bj * 128) = pack8(v0 * qs, v1 * qs);
          }
        }
    } else {
      const int cg0 = (u.pn - 9) * 256 + wc * 32 + 8 * fq;
#pragma unroll
      for (int ai = 0; ai < 2; ++ai)
#pragma unroll
        for (int m = 0; m < 4; ++m)
#pragma unroll
          for (int bj = 0; bj < 2; ++bj) {
            f32x4p v0 = acc[ai][bj][m][0], v1 = acc[ai][bj][m][1];
#pragma unroll
            for (int j = 0; j < 4; ++j) { v0[j] = 1.f / (1.f + __expf(-v0[j])); v1[j] = 1.f / (1.f + __expf(-v1[j])); }
            *(u32x4*)(gate + (size_t)(row0 + ai * 128 + m * 16) * GATEC + cg0 + bj * 128) = pack8(v0, v1);
          }
    }
  }
};
DI void phase_inproj(const P& p, char* smem) {
  InprojSched S{p.ws + OFF_U1B, p.ws + OFF_WIN_T, (int)gridDim.x, (int)blockIdx.x};
  InprojEpi E{(ushort_t*)(p.ws + OFF_PH), (ushort_t*)(p.ws + OFF_QKV), (ushort_t*)(p.ws + OFF_GATE), (const float*)(p.ws + OFF_ROPE)};
  pg8::gemm_phase(( __attribute__((address_space(3))) unsigned char*)smem, 1024, S, E);
}
struct PlainSched {
  const char* A; const char* Bt; int nM, nN, K, G, c;
  DI bool next(int i, pg8::Unit& u) const { const int L = i * G + c; if (L >= nM * nN) return false; u.kind = 0; pg8::tile_order(L, nM, nN, u.pm, u.pn); return true; }
  DI const char* a_ptr(const pg8::Unit& u) const { return A + (size_t)u.pm * 256 * K * 2; }
  DI const char* b_ptr(const pg8::Unit& u) const { return Bt + (size_t)u.pn * 256 * K * 2; }
};
struct OutprojEpi {
  static constexpr bool PERM = false, AFTER_DRAIN = false;
  const float* x; float* out; const float* ada;
  DI void operator()(const f32x4p (&acc)[2][2][4][2], const pg8::Unit& u, int wr, int wc, int fr, int fq) const {
    const int row0 = u.pm * 256 + wr * 64 + fr, col0 = u.pn * 256 + wc * 32 + 4 * fq, b = (u.pm * 256) / S_;
    f32x4p g1[2][2];
#pragma unroll
    for (int bj = 0; bj < 2; ++bj)
#pragma unroll
      for (int n = 0; n < 2; ++n) g1[bj][n] = *(const f32x4p*)(ada + b * 6144 + 2 * 1024 + col0 + bj * 128 + n * 16) + 1.0f;
#pragma unroll
    for (int ai = 0; ai < 2; ++ai)
#pragma unroll
      for (int m = 0; m < 4; ++m) {
        const size_t ro = (size_t)(row0 + ai * 128 + m * 16) * 1024 + col0;
#pragma unroll
        for (int bj = 0; bj < 2; ++bj)
#pragma unroll
          for (int n = 0; n < 2; ++n) {
            const f32x4p xv = *(const f32x4p*)(x + ro + bj * 128 + n * 16);
            *(f32x4p*)(out + ro + bj * 128 + n * 16) = xv * DN_ALPHA + g1[bj][n] * acc[ai][bj][m][n];
          }
      }
  }
};
DI void phase_outproj(const P& p, char* smem) {
  PlainSched S{p.ws + OFF_MERGED, p.ws + OFF_WOUT_T, 64, 4, 1024, (int)gridDim.x, (int)blockIdx.x};
  OutprojEpi E{p.x, p.out, (const float*)(p.ws + OFF_ADA)};
  pg8::gemm_phase(( __attribute__((address_space(3))) unsigned char*)smem, 1024, S, E);
}

DI float sconv_t(const ushort_t* row, int t, float w0, float w1, float w2, float cb) {
  const float xm = bf2f(row[max(t - 1, 0)]), x0 = bf2f(row[t]), xp = bf2f(row[min(t + 1, S_ - 1)]);
  return cb + w1 * x0 + ((t > 0) ? w0 : 0.f) * xm + ((t < S_ - 1) ? w2 : 0.f) * xp;
}
DI void fft_C_mul_invC(cf2* lds, const cf2* __restrict__ kq, int tid, int o) {
  asm volatile("" : "+v"(tid));
  const int k1 = tid >> 5, k2 = tid & 31;
  const float sgn = o ? 1.f : -1.f;
#pragma unroll
  for (int h = 0; h < 2; ++h) {
    float tr[16], ti[16];
    cf2 kv[16], km[16];
#pragma unroll
    for (int i = 0; i < 16; ++i) {
      kv[i] = kq[(h * 16 + i) * 512 + tid];
      const int f = (k1 + 16 * h) + 32 * k2 + 1024 * brev(i, 4);
      const int fm = (16384 - f) & 16383;
      const int q1 = fm & 31, q2 = (fm >> 5) & 31, q3 = fm >> 10;
      const int rr = (q1 >> 4) * 16 + (int)(__builtin_bitreverse32((unsigned)q3) >> 28);
      km[i] = kq[rr * 512 + (q1 & 15) * 32 + q2];
    }
    cf2* blk = lds + (k1 + 16 * h) * FFT_SA + k2 * 17;
#pragma unroll
    for (int mp = 0; mp < 16; ++mp) { cf2 v = blk[mp]; tr[mp] = v.x; ti[mp] = v.y; }
    dft_fwd<16, false>(tr, ti);
#pragma unroll
    for (int i = 0; i < 16; ++i) {
      const float a = kv[i].x, b = kv[i].y, c = km[i].x, d = km[i].y;
      const float kx = o ? 0.5f * (b + d) : 0.5f * (a + c);
      const float ky = o ? 0.5f * (c - a) : 0.5f * (b - d);
      const float x = tr[i], y = ti[i];
      tr[i] = x * kx - y * ky; ti[i] = x * ky + y * kx;
    }
    dft_inv<16>(tr, ti);
#pragma unroll
    for (int mp = 0; mp < 16; ++mp) { cf2 ov; ov.x = tr[mp]; ov.y = ti[mp]; blk[mp] = ov; }
  }
  (void)sgn;
}
DI void hyena_item(const P& p, char* smem, int c) {
  cf2* lds = (cf2*)smem;
  const ushort_t* pht = (const ushort_t*)(p.ws + OFF_PH);
  ushort_t* yht = (ushort_t*)(p.ws + OFF_YH);
  cf2* kq = (cf2*)(p.ws + (blockIdx.x < 92 ? OFF_WIN_T + (size_t)blockIdx.x * 131072 : OFF_HSCR + (size_t)(blockIdx.x - 92) * 131072));
  const float* filt = p.out;
  const int tid0 = tid_opaque();
  float zr[32], zi[32];
  __syncthreads();
  {
    int tid = tid0; asm volatile("" : "+v"(tid));
    float kr[32], ki[32];
    const float* fw0 = filt + (size_t)(0 * 1024 + 0 * 512 + c) * S_;
    const float* bw0 = filt + (size_t)(1 * 1024 + 0 * 512 + c) * S_;
    const float* fw1 = filt + (size_t)(0 * 1024 + 1 * 512 + c) * S_;
    const float* bw1 = filt + (size_t)(1 * 1024 + 1 * 512 + c) * S_;
#pragma unroll
    for (int n1 = 0; n1 < 16; ++n1) { kr[n1] = fw0[n1 * 512 + tid] * (1.0f / 16384.0f); ki[n1] = fw1[n1 * 512 + tid] * (1.0f / 16384.0f); }
    if (tid == 0) { kr[0] += p.hy_bias[c] * (1.0f / 16384.0f); ki[0] += p.hy_bias[512 + c] * (1.0f / 16384.0f); }
#pragma unroll
    for (int n1 = 16; n1 < 32; ++n1) {
      const int n = n1 * 512 + tid;
      kr[n1] = (n == S_) ? 0.f : bw0[2 * S_ - n] * (1.0f / 16384.0f);
      ki[n1] = (n == S_) ? 0.f : bw1[2 * S_ - n] * (1.0f / 16384.0f);
    }
    fft_fwdA<false>(kr, ki, lds, tid); __syncthreads();
    fft_B_read(kr, ki, lds, tid); __syncthreads();
    fft_fwdB_write(kr, ki, lds, tid); __syncthreads();
    fft_fwdC(kr, ki, lds, tid);
    int ts = tid; asm volatile("" : "+v"(ts));
    cf2* kqt = kq + ts;
#pragma unroll
    for (int r = 0; r < 32; ++r) { cf2 v; v.x = kr[r]; v.y = ki[r]; kqt[r * 512] = v; }
    __syncthreads();
  }
#pragma unroll 1
  for (int o = 0; o < 2; ++o) {
    int tid = tid0; asm volatile("" : "+v"(tid));
    asm volatile("" : "+v"(tid));
    if (o == 0) {
      const float w0 = p.hy_conv_w[c], w1 = p.hy_conv_w[HYC + c], w2 = p.hy_conv_w[2 * HYC + c], cb = p.hy_conv_b[c];
      const ushort_t* r0 = pht + (size_t)(0 * HYC + c) * S_;
      const ushort_t* r1 = pht + (size_t)(1 * HYC + c) * S_;
#pragma unroll
      for (int n1 = 0; n1 < 16; ++n1) {
        const int t = n1 * 512 + tid;
        zr[n1] = sconv_t(r0, t, w0, w1, w2, cb); zi[n1] = sconv_t(r1, t, w0, w1, w2, cb);
        if (n1 & 1) asm volatile("" ::: "memory");
      }
    }
#pragma unroll
    for (int n1 = 16; n1 < 32; ++n1) { zr[n1] = 0.f; zi[n1] = 0.f; }
    fft_fwdA<true>(zr, zi, lds, tid); __syncthreads();
    fft_B_read(zr, zi, lds, tid); __syncthreads();
    fft_fwdB_write(zr, zi, lds, tid); __syncthreads();
    fft_C_mul_invC(lds, kq, tid, o); __syncthreads();
    fft_invB_read(zr, zi, lds, tid); __syncthreads();
    fft_invB_write(zr, zi, lds, tid); __syncthreads();
    fft_invA(zr, zi, lds, tid);
    int tg = tid; asm volatile("" : "+v"(tg));
    const int gch = (o + 1) * 512 + c;
    const float w0 = p.hy_conv_w[gch], w1 = p.hy_conv_w[HYC + gch], w2 = p.hy_conv_w[2 * HYC + gch], cb = p.hy_conv_b[gch];
    const ushort_t* g0 = pht + (size_t)(0 * HYC + gch) * S_;
    const ushort_t* g1 = pht + (size_t)(1 * HYC + gch) * S_;
#pragma unroll
    for (int n1 = 0; n1 < 16; ++n1) {
      const int t = n1 * 512 + tg;
      zr[n1] *= sconv_t(g0, t, w0, w1, w2, cb);
      zi[n1] *= sconv_t(g1, t, w0, w1, w2, cb);
      if (n1 & 1) asm volatile("" ::: "memory");
    }
    if (o == 1) {
#pragma unroll
      for (int n1 = 0; n1 < 16; ++n1) {
        const int t = n1 * 512 + tg;
        yht[(size_t)(0 * HW_ + c) * S_ + t] = f2bf(zr[n1]);
        yht[(size_t)(1 * HW_ + c) * S_ + t] = f2bf(zi[n1]);
      }
    }
  }
}

constexpr int ATT_VROW = 192;
constexpr int ATT_VBUF = 32 * ATT_VROW;
DI void attn_item(const P& p, char* smem, int item) {
  const ushort_t* qkv = (const ushort_t*)(p.ws + OFF_QKV);
  ushort_t* ya = (ushort_t*)(p.ws + OFF_YA);
  const int tid = tid_opaque(), lane = tid & 63, wave = tid >> 6;
  const int u = item * 8 + wave;
  const int hs = u & 3, r16 = (u >> 2) & 15, chunk = (u >> 6) & 15, b = u >> 10;
  const int qi = lane & 31, h = lane >> 5;
  char* vl = smem + wave * ATT_VBUF;
  const int tq = chunk * 512 + r16 + 16 * qi;
  const size_t bbase = (size_t)b * S_;
  f32x16 o0, o1;
#pragma unroll
  for (int r = 0; r < 16; ++r) { o0[r] = 0.f; o1[r] = 0.f; }
  float m = -1e30f, l = 0.f;
  const int g16 = (lane >> 4) & 1, q4 = (lane & 15) >> 2, p4 = lane & 3;
  __syncthreads();
#pragma unroll 1
  for (int g = 0; g < 3; ++g) {
    const int dsh = 2 * g;
    const int d = 1 << dsh, sd = 16 >> dsh, n = S_ >> dsh;
    const int head = g * 4 + hs;
    const int rc = r16 & (d - 1);
    const int P0 = (chunk * 512 + r16 - rc) >> dsh;
    const int pq = P0 + sd * qi;
    const int KB = P0 - 64;
    const int ntile = (g == 0) ? 20 : (g == 1 ? 8 : 5);
    bf16x8 bq[4];
    {
      const ushort_t* qrow = qkv + (bbase + tq) * QKVC + head * 64;
#pragma unroll
      for (int s = 0; s < 4; ++s) bq[s] = *(const bf16x8*)(qrow + (2 * s + h) * 8);
    }
    bf16x8 kn[4]; u32x4 vn[4];
    {
      const int kp = min(max(KB + qi, 0), n - 1);
      const ushort_t* krow = qkv + (bbase + rc + ((size_t)kp << dsh)) * QKVC + 768 + head * 64;
#pragma unroll
      for (int s = 0; s < 4; ++s) kn[s] = *(const bf16x8*)(krow + (2 * s + h) * 8);
#pragma unroll
      for (int i = 0; i < 4; ++i) {
        const int c = lane + 64 * i, row = c >> 3, ch = c & 7;
        const int vp = min(max(KB + row, 0), n - 1);
        vn[i] = *(const u32x4*)(qkv + (bbase + rc + ((size_t)vp << dsh)) * QKVC + 1536 + head * 64 + ch * 8);
      }
    }
#pragma unroll 1
    for (int kt = 0; kt < ntile; ++kt) {
      bf16x8 kc[4]; u32x4 vc[4];
#pragma unroll
      for (int s = 0; s < 4; ++s) kc[s] = kn[s];
#pragma unroll
      for (int i = 0; i < 4; ++i) vc[i] = vn[i];
      if (kt + 1 < ntile) {
        const int kb1 = KB + 32 * (kt + 1);
        const int kp = min(max(kb1 + qi, 0), n - 1);
        const ushort_t* krow = qkv + (bbase + rc + ((size_t)kp << dsh)) * QKVC + 768 + head * 64;
#pragma unroll
        for (int s = 0; s < 4; ++s) kn[s] = *(const bf16x8*)(krow + (2 * s + h) * 8);
#pragma unroll
        for (int i = 0; i < 4; ++i) {
          const int c = lane + 64 * i, row = c >> 3, ch = c & 7;
          const int vp = min(max(kb1 + row, 0), n - 1);
          vn[i] = *(const u32x4*)(qkv + (bbase + rc + ((size_t)vp << dsh)) * QKVC + 1536 + head * 64 + ch * 8);
        }
      }
      f32x16 st;
#pragma unroll
      for (int r = 0; r < 16; ++r) st[r] = 0.f;
#pragma unroll
      for (int s = 0; s < 4; ++s) st = __builtin_amdgcn_mfma_f32_32x32x16_bf16(kc[s], bq[s], st, 0, 0, 0);
#pragma unroll
      for (int i = 0; i < 4; ++i) { const int c = lane + 64 * i; *(u32x4*)(vl + (c >> 3) * ATT_VROW + (c & 7) * 16) = vc[i]; }
      const int kb = KB + 32 * kt + 4 * h;
      const int dk = kb - pq;
      float mx = -1e30f;
      bool ok[16];
#pragma unroll
      for (int r = 0; r < 16; ++r) {
        const int cr = (r & 3) + 8 * (r >> 2);
        ok[r] = ((unsigned)(dk + cr + 64) <= 128u) && ((unsigned)(kb + cr) < (unsigned)n);
        mx = fmaxf(mx, ok[r] ? st[r] : -1e30f);
      }
      mx = fmaxf(mx, __shfl_xor(mx, 32));
      const float mnew = fmaxf(m, mx);
      const float corr = __expf(m - mnew);
      float ps = 0.f;
      float pv[16];
#pragma unroll
      for (int r = 0; r < 16; ++r) { pv[r] = ok[r] ? __expf(st[r] - mnew) : 0.f; ps += pv[r]; }
      ps += __shfl_xor(ps, 32);
      l = l * corr + ps; m = mnew;
#pragma unroll
      for (int r = 0; r < 16; ++r) { o0[r] *= corr; o1[r] *= corr; }
      bf16x8 pf[2];
#pragma unroll
      for (int s = 0; s < 2; ++s) {
        u32x4 w;
        w[0] = pack2(pv[8 * s + 0], pv[8 * s + 1]); w[1] = pack2(pv[8 * s + 2], pv[8 * s + 3]);
        w[2] = pack2(pv[8 * s + 4], pv[8 * s + 5]); w[3] = pack2(pv[8 * s + 6], pv[8 * s + 7]);
        pf[s] = __builtin_bit_cast(bf16x8, w);
      }
      __builtin_amdgcn_wave_barrier();
      asm volatile("s_waitcnt lgkmcnt(0)" ::: "memory");
#pragma unroll
      for (int s = 0; s < 2; ++s) {
#pragma unroll
        for (int nt = 0; nt < 2; ++nt) {
          const char* a0 = vl + (16 * s + 4 * h + q4) * ATT_VROW + (32 * nt + 16 * g16 + 4 * p4) * 2;
          s16x4 lo = __builtin_amdgcn_ds_read_tr16_b64_v4i16((__attribute__((address_space(3))) s16x4*)(a0));
          s16x4 hi = __builtin_amdgcn_ds_read_tr16_b64_v4i16((__attribute__((address_space(3))) s16x4*)(a0 + 8 * ATT_VROW));
          const bf16x8 vf = __builtin_shufflevector(lo, hi, 0, 1, 2, 3, 4, 5, 6, 7);
          if (nt == 0) o0 = __builtin_amdgcn_mfma_f32_32x32x16_bf16(vf, pf[s], o0, 0, 0, 0);
          else o1 = __builtin_amdgcn_mfma_f32_32x32x16_bf16(vf, pf[s], o1, 0, 0, 0);
        }
      }
      __builtin_amdgcn_wave_barrier();
      asm volatile("s_waitcnt lgkmcnt(0)" ::: "memory");
    }
  }
  const float il = 1.f / l;
  ushort_t* op = ya + (bbase + tq) * 256 + hs * 64;
#pragma unroll
  for (int gq = 0; gq < 4; ++gq) {
    uint2 w0, w1;
    w0.x = pack2(o0[4 * gq] * il, o0[4 * gq + 1] * il); w0.y = pack2(o0[4 * gq + 2] * il, o0[4 * gq + 3] * il);
    w1.x = pack2(o1[4 * gq] * il, o1[4 * gq + 1] * il); w1.y = pack2(o1[4 * gq + 2] * il, o1[4 * gq + 3] * il);
    *(uint2*)(op + 8 * gq + 4 * h) = w0;
    *(uint2*)(op + 32 + 8 * gq + 4 * h) = w1;
  }
}

DI void phase_yh_transpose(const P& p, char* smem) {
  const ushort_t* yht = (const ushort_t*)(p.ws + OFF_YH);
  ushort_t* yhk = (ushort_t*)(p.ws + OFF_YHK);
  const int tid = tid_opaque();
  for (int item = blockIdx.x; item < 1024; item += gridDim.x) {
    const int cg = item & 15, tc = item >> 4, b = tc >> 5, t0 = (tc * 256) & (S_ - 1);
    __syncthreads();
    {
      const int ch = tid >> 4, k16 = tid & 15;
      const ushort_t* srcp = yht + (size_t)(b * HW_ + cg * 32 + ch) * S_ + t0;
#pragma unroll
      for (int i = 0; i < 2; ++i) *(u32x4*)(smem + ch * 528 + (k16 + 16 * i) * 16) = *(const u32x4*)(srcp + (k16 + 16 * i) * 8);
    }
    __syncthreads();
    {
      const int t = tid >> 1, half = tid & 1;
      unsigned w[8];
#pragma unroll
      for (int k = 0; k < 8; ++k) {
        const unsigned lo = *(const ushort_t*)(smem + (half * 16 + 2 * k) * 528 + t * 2);
        const unsigned hi = *(const ushort_t*)(smem + (half * 16 + 2 * k + 1) * 528 + t * 2);
        w[k] = lo | (hi << 16);
      }
      ushort_t* dst = yhk + (size_t)(tc * 256 + t) * HW_ + cg * 32 + half * 16;
      u32x4 o0, o1; o0[0] = w[0]; o0[1] = w[1]; o0[2] = w[2]; o0[3] = w[3]; o1[0] = w[4]; o1[1] = w[5]; o1[2] = w[6]; o1[3] = w[7];
      *(u32x4*)dst = o0; *(u32x4*)(dst + 8) = o1;
    }
  }
}
DI f32x4p bf4lo(const u32x4& w) { f32x4p r; r[0] = __uint_as_float(w[0] << 16); r[1] = __uint_as_float(w[0] & 0xffff0000u); r[2] = __uint_as_float(w[1] << 16); r[3] = __uint_as_float(w[1] & 0xffff0000u); return r; }
DI f32x4p bf4hi(const u32x4& w) { f32x4p r; r[0] = __uint_as_float(w[2] << 16); r[1] = __uint_as_float(w[2] & 0xffff0000u); r[2] = __uint_as_float(w[3] << 16); r[3] = __uint_as_float(w[3] & 0xffff0000u); return r; }
template <bool ADD>
struct MergeEpi {
  static constexpr bool PERM = true, AFTER_DRAIN = false;
  const ushort_t* gate; ushort_t* merged;
  DI void operator()(const f32x4p (&acc)[2][2][4][2], const pg8::Unit& u, int wr, int wc, int fr, int fq) const {
    const ushort_t* gb = gate + (size_t)(u.pm * 256) * GATEC + u.pn * 256;
    ushort_t* mb = merged + (size_t)(u.pm * 256) * 1024 + u.pn * 256;
    const unsigned lg = (unsigned)((wr * 64 + fr) * GATEC + wc * 32 + 8 * fq), lm = (unsigned)((wr * 64 + fr) * 1024 + wc * 32 + 8 * fq);
#pragma unroll
    for (int ai = 0; ai < 2; ++ai)
#pragma unroll
      for (int m = 0; m < 4; ++m) {
#pragma unroll
        for (int bj = 0; bj < 2; ++bj) {
          const u32x4 gw = *(const u32x4*)(gb + (ai * 128 + m * 16) * GATEC + bj * 128 + lg);
          f32x4p v0 = bf4lo(gw) * acc[ai][bj][m][0], v1 = bf4hi(gw) * acc[ai][bj][m][1];
          ushort_t* mp = mb + (ai * 128 + m * 16) * 1024 + bj * 128 + lm;
          if (ADD) { const u32x4 mw = *(const u32x4*)mp; v0 += bf4lo(mw); v1 += bf4hi(mw); }
          *(u32x4*)mp = pack8(v0, v1);
        }
        asm volatile("" ::: "memory");
      }
  }
};
DI void phase_merge(const P& p, char* smem) {
  {
    PlainSched S{p.ws + OFF_YHK, p.ws + OFF_WBH_T, 64, 4, 512, (int)gridDim.x, (int)blockIdx.x};
    MergeEpi<false> E{(const ushort_t*)(p.ws + OFF_GATE), (ushort_t*)(p.ws + OFF_MERGED)};
    pg8::gemm_phase(( __attribute__((address_space(3))) unsigned char*)smem, 512, S, E);
  }
  {
    PlainSched S{p.ws + OFF_YA, p.ws + OFF_WBA_T, 64, 4, 256, (int)gridDim.x, (int)blockIdx.x};
    MergeEpi<true> E{(const ushort_t*)(p.ws + OFF_GATE) + 1024, (ushort_t*)(p.ws + OFF_MERGED)};
    pg8::gemm_phase(( __attribute__((address_space(3))) unsigned char*)smem, 256, S, E);
  }
}

DI void phase_ln(float* __restrict__ xio, const float* __restrict__ g, const float* __restrict__ bta) {
  const int tq = tid_opaque(); const int lane = tq & 63, wave = tq >> 6;
  for (int row = blockIdx.x * 8 + wave; row < T_; row += gridDim.x * 8) {
    float* rp = xio + (size_t)row * 1024;
    f32x4 v[4];
    float s = 0.f;
#pragma unroll
    for (int i = 0; i < 4; ++i) { v[i] = *(const f32x4*)(rp + i * 256 + lane * 4); s += v[i][0] + v[i][1] + v[i][2] + v[i][3]; }
    const float mu = wave_sum(s) * (1.f / 1024.f);
    float q = 0.f;
#pragma unroll
    for (int i = 0; i < 4; ++i)
#pragma unroll
      for (int j = 0; j < 4; ++j) { float d = v[i][j] - mu; q += d * d; }
    const float rs = rsqrtf(wave_sum(q) * (1.f / 1024.f) + LN_EPS);
#pragma unroll
    for (int i = 0; i < 4; ++i) {
      f32x4 gg = *(const f32x4*)(g + i * 256 + lane * 4), bb = *(const f32x4*)(bta + i * 256 + lane * 4), o;
#pragma unroll
      for (int j = 0; j < 4; ++j) o[j] = (v[i][j] - mu) * rs * gg[j] + bb[j];
      *(f32x4*)(rp + i * 256 + lane * 4) = o;
    }
  }
}

DI int swz256(int row, int ch) { return row * 256 + ((ch ^ (row & 15)) << 4); }
DI void ins16(float (&L)[16], float x) {
#pragma unroll
  for (int i = 0; i < 16; ++i) { const float hi = __builtin_fmaxf(L[i], x); x = __builtin_fminf(L[i], x); L[i] = hi; }
}
DI void bitonic16_desc(float (&M)[16]) {
#pragma unroll
  for (int d = 8; d >= 1; d >>= 1)
#pragma unroll
    for (int i = 0; i < 16; ++i)
      if ((i & d) == 0) { const float a = M[i], b = M[i + d]; M[i] = __builtin_fmaxf(a, b); M[i + d] = __builtin_fminf(a, b); }
}
constexpr int ROUTE_Q_OFF = 0, ROUTE_K_OFF = 65536, ROUTE_IDX_OFF = 98304;
struct OneUnitSched {
  const char* A; const char* Bt; int pm, pn;
  DI bool next(int i, pg8::Unit& u) const { if (i != 0) return false; u.pm = pm; u.pn = pn; u.kind = 0; return true; }
  DI const char* a_ptr(const pg8::Unit& u) const { return A + (size_t)u.pm * 256 * 1024 * 2; }
  DI const char* b_ptr(const pg8::Unit& u) const { return Bt + (size_t)u.pn * 256 * 1024 * 2; }
};
struct RouteEpi {
  static constexpr bool PERM = false, AFTER_DRAIN = true;
  const ushort_t* keysb; int* idx; float* gv;
  DI void operator()(const f32x4p (&)[2][2][4][2], const pg8::Unit&, int, int, int, int) const {}
  DI void fused(const f32x4p (&acc)[2][2][4][2], const pg8::Unit& u, int wr, int wc, int fr, int fq, PG8_LAS unsigned char* ldsp, int wave, int lane) const {
    char* smem = (char*)ldsp;
    const int tid = wave * 64 + lane;
    const int m0 = u.pm * 256, hh = u.pn;
    float L0[16];
#pragma unroll
    for (int pp = 0; pp < 2; ++pp) {
      const int hp = hh * 2 + pp;
      if (pp == 1) __syncthreads();
#pragma unroll
      for (int ai = 0; ai < 2; ++ai)
#pragma unroll
        for (int m = 0; m < 4; ++m) {
          const int tok = 128 * ai + 64 * wr + 16 * m + fr;
#pragma unroll
          for (int n = 0; n < 2; ++n) {
            const int ch = 4 * wc + 2 * n + (fq >> 1);
            uint2 v; v.x = pack2(acc[ai][pp][m][n][0], acc[ai][pp][m][n][1]); v.y = pack2(acc[ai][pp][m][n][2], acc[ai][pp][m][n][3]);
            *(uint2*)(smem + ROUTE_Q_OFF + swz256(tok, ch) + 8 * (fq & 1)) = v;
          }
        }
#pragma unroll
      for (int i = 0; i < 4; ++i) {
        const int q = tid + 512 * i, row = q >> 4, ch = q & 15;
        *(u32x4*)(smem + ROUTE_K_OFF + swz256(row, ch)) = *(const u32x4*)(keysb + (size_t)hp * 16384 + row * 128 + ch * 8);
      }
      __syncthreads();
      f32x16 sc[4];
#pragma unroll
      for (int ks = 0; ks < 4; ++ks)
#pragma unroll
        for (int r = 0; r < 16; ++r) sc[ks][r] = 0.f;
#pragma unroll
      for (int s = 0; s < 8; ++s) {
        const int ch = 2 * s + (lane >> 5);
        const bf16x8 bq = *(const bf16x8*)(smem + ROUTE_Q_OFF + swz256(wave * 32 + (lane & 31), ch));
#pragma unroll
        for (int ks = 0; ks < 4; ++ks) {
          const bf16x8 ak = *(const bf16x8*)(smem + ROUTE_K_OFF + swz256(ks * 32 + (lane & 31), ch));
          sc[ks] = __builtin_amdgcn_mfma_f32_32x32x16_bf16(ak, bq, sc[ks], 0, 0, 0);
        }
      }
      float L[16];
#pragma unroll
      for (int i = 0; i < 16; ++i) L[i] = -3.0e38f;
      const unsigned hbit = (unsigned)(lane >> 5) << 2;
#pragma unroll
      for (int ks = 0; ks < 4; ++ks)
#pragma unroll
        for (int r = 0; r < 16; ++r) {
          const unsigned key = (unsigned)(ks * 32 + (r & 3) + 8 * (r >> 2)) | hbit;
          ins16(L, __uint_as_float((__float_as_uint(sc[ks][r]) & ~127u) | key));
        }
      {
        float M[16];
#pragma unroll
        for (int i = 0; i < 16; ++i) M[i] = __builtin_fmaxf(L[i], __shfl_xor(L[15 - i], 32));
        bitonic16_desc(M);
#pragma unroll
        for (int i = 0; i < 16; ++i) L[i] = M[i];
      }
      if (pp == 0) {
#pragma unroll
        for (int i = 0; i < 16; ++i) L0[i] = L[i];
      } else {
        unsigned char* ib = (unsigned char*)(smem + ROUTE_IDX_OFF) + tid * 32;
#pragma unroll
        for (int i = 0; i < 16; ++i) { ib[i] = (unsigned char)(__float_as_uint(L0[i]) & 127u); ib[16 + i] = (unsigned char)(__float_as_uint(L[i]) & 127u); }
        float F[16];
#pragma unroll
        for (int i = 0; i < 16; ++i) F[i] = -3.0e38f;
#pragma unroll
        for (int i = 0; i < 16; ++i) {
          const float ai_ = __uint_as_float(__float_as_uint(L0[i]) & ~127u);
#pragma unroll
          for (int jj = 0; jj < 16; ++jj)
            if ((i + 1) * (jj + 1) <= 16) {
              const float s = ai_ + __uint_as_float(__float_as_uint(L[jj]) & ~127u);
              ins16(F, __uint_as_float((__float_as_uint(s) & ~255u) | (unsigned)(i * 16 + jj)));
            }
        }
        const float mx = __uint_as_float(__float_as_uint(F[0]) & ~255u);
        float e[16], sum = 0.f;
#pragma unroll
        for (int k = 0; k < 16; ++k) { e[k] = __expf(__uint_as_float(__float_as_uint(F[k]) & ~255u) - mx); sum += e[k]; }
        const float inv = 1.f / sum;
        if (lane < 32) {
          const int tok = m0 + wave * 32 + lane;
          int* ip = idx + (size_t)tok * 128 + hh * 16;
          float* gp = gv + (size_t)tok * 128 + hh * 16;
#pragma unroll
          for (int k4 = 0; k4 < 4; ++k4) {
            int4 iv; f32x4 g4;
            int ee[4];
#pragma unroll
            for (int uu = 0; uu < 4; ++uu) {
              const unsigned code = __float_as_uint(F[k4 * 4 + uu]) & 255u;
              ee[uu] = (int)ib[code >> 4] * 128 + (int)ib[16 + (code & 15u)];
              g4[uu] = e[k4 * 4 + uu] * inv;
            }
            iv.x = ee[0]; iv.y = ee[1]; iv.z = ee[2]; iv.w = ee[3];
            *(int4*)(ip + k4 * 4) = iv;
            *(f32x4*)(gp + k4 * 4) = g4;
          }
        }
      }
    }
    __syncthreads();
  }
};
DI void phase_route(const P& p, char* smem) {
  for (int item = blockIdx.x; item < (T_ / 256) * 8; item += gridDim.x) {
    OneUnitSched S{p.ws + OFF_U2B, p.ws + OFF_WQ_T, item >> 3, item & 7};
    RouteEpi E{(const ushort_t*)(p.ws + OFF_KEYS_B), (int*)(p.ws + OFF_IDX), (float*)(p.ws + OFF_GV)};
    pg8::gemm_phase((__attribute__((address_space(3))) unsigned char*)smem, 1024, S, E);
  }
}

DI void phase_rope(const P& p) {
  float* rt = (float*)(p.ws + OFF_ROPE);
  for (int i = blockIdx.x * NT + tid_opaque(); i < T_ * 8; i += gridDim.x * NT) {
    const float inv = expf(-13.122363377404328f * (float)(i & 7) * 0.125f);
    const float x = (float)p.pos[i >> 3] * inv;
    const float k = rintf(x * 0.15915494309189535f);
    float r = fmaf(-k, 6.28125f, x);
    r = fmaf(-k, 1.9353071795864769e-3f, r);
    float sn, cs; __sincosf(r, &sn, &cs);
    rt[2 * i] = cs; rt[2 * i + 1] = sn;
  }
}
DI void phase_keys(const P& p) {
  ushort_t* keysb = (ushort_t*)(p.ws + OFF_KEYS_B);
  for (int i = blockIdx.x * NT + tid_opaque(); i < 16 * 128 * 128 / 4; i += gridDim.x * NT) {
    f32x4 v = *(const f32x4*)(p.keys + (size_t)i * 4);
    uint2 o; o.x = pack2(v[0], v[1]); o.y = pack2(v[2], v[3]);
    *(uint2*)(keysb + (size_t)i * 4) = o;
  }
}

typedef __bf16 bf16x2_t __attribute__((ext_vector_type(2)));
DI float dot2bf(unsigned a, unsigned b, float c) { return __builtin_amdgcn_fdot2_f32_bf16(__builtin_bit_cast(bf16x2_t, a), __builtin_bit_cast(bf16x2_t, b), c, false); }
DI void phase_ln1(const P& p) {
  const float* ada = (const float*)(p.ws + OFF_ADA);
  ushort_t* u2b = (ushort_t*)(p.ws + OFF_U2B);
  const int tq = tid_opaque(); const int lane = tq & 63, wave = tq >> 6;
  for (int row = blockIdx.x * 8 + wave; row < T_; row += gridDim.x * 8) {
    const int b = row / S_;
    float* rp = p.out + (size_t)row * 1024;
    f32x4 v[4];
    float s = 0.f;
#pragma unroll
    for (int i = 0; i < 4; ++i) { v[i] = *(const f32x4*)(rp + i * 256 + lane * 4); s += v[i][0] + v[i][1] + v[i][2] + v[i][3]; }
    const float mu = wave_sum(s) * (1.f / 1024.f);
    float q = 0.f;
#pragma unroll
    for (int i = 0; i < 4; ++i)
#pragma unroll
      for (int j = 0; j < 4; ++j) { float d = v[i][j] - mu; q += d * d; }
    const float rs = rsqrtf(wave_sum(q) * (1.f / 1024.f) + LN_EPS);
#pragma unroll
    for (int i = 0; i < 4; ++i) {
      const int col = i * 256 + lane * 4;
      f32x4 gg = *(const f32x4*)(p.ln1_g + col), bb = *(const f32x4*)(p.ln1_b + col), o;
      f32x4 sc = *(const f32x4*)(ada + b * 6144 + 4 * 1024 + col), sh = *(const f32x4*)(ada + b * 6144 + 3 * 1024 + col);
#pragma unroll
      for (int j = 0; j < 4; ++j) o[j] = (v[i][j] - mu) * rs * gg[j] + bb[j];
      *(f32x4*)(rp + col) = o;
      uint2 w; w.x = pack2(o[0] * (1.f + sc[0]) + sh[0], o[1] * (1.f + sc[1]) + sh[1]); w.y = pack2(o[2] * (1.f + sc[2]) + sh[2], o[3] * (1.f + sc[3]) + sh[3]);
      *(uint2*)(u2b + (size_t)row * 1024 + col) = w;
    }
  }
}
DI float wave_max(float v) {
#pragma unroll
  for (int o = 32; o > 0; o >>= 1) v = fmaxf(v, __shfl_xor(v, o));
  return v;
}
DI unsigned pack4_fp8(float a, float b, float c, float d) {
  int w = 0;
  w = __builtin_amdgcn_cvt_pk_fp8_f32(a, b, w, false);
  w = __builtin_amdgcn_cvt_pk_fp8_f32(c, d, w, true);
  return (unsigned)w;
}
DI void phase_tabconv(const P& p) {
  unsigned char* tu = (unsigned char*)(p.ws + OFF_TABU);
  unsigned char* tv = (unsigned char*)(p.ws + OFF_TABV);
  float* su = (float*)(p.ws + OFF_SU);
  float* sv = (float*)(p.ws + OFF_SV);
  const int tq = tid_opaque(); const int lane = tq & 63, wave = tq >> 6;
  for (int e = blockIdx.x * 8 + wave; e < 16384; e += gridDim.x * 8) {
    f32x4 a[4], c[4];
    float ma = 0.f, mc = 0.f;
#pragma unroll
    for (int i = 0; i < 4; ++i) {
      const int col = i * 256 + lane * 4;
      a[i] = *(const f32x4*)(p.pu + (size_t)e * 1024 + col);
      c[i] = *(const f32x4*)(p.pv + (size_t)e * 1024 + col);
#pragma unroll
      for (int j = 0; j < 4; ++j) { ma = fmaxf(ma, fabsf(a[i][j])); mc = fmaxf(mc, fabsf(c[i][j])); }
    }
    ma = wave_max(ma); mc = wave_max(mc);
    const float sa = (ma > 0.f) ? ma * (1.0f / 448.0f) : 1.0f, sc = (mc > 0.f) ? mc * (1.0f / 448.0f) : 1.0f;
    const float ia = 1.0f / sa, ic = 1.0f / sc;
    if (lane == 0) { su[e] = sa; sv[e] = sc; }
#pragma unroll
    for (int i = 0; i < 4; ++i) {
      const int col = i * 256 + lane * 4;
      *(unsigned*)(tu + (size_t)e * 1024 + col) = pack4_fp8(a[i][0] * ia, a[i][1] * ia, a[i][2] * ia, a[i][3] * ia);
      const int slice = i * 2 + (lane >> 5);
      *(unsigned*)(tv + ((size_t)slice * 16384 + e) * 128 + (lane & 31) * 4) = pack4_fp8(c[i][0] * ic, c[i][1] * ic, c[i][2] * ic, c[i][3] * ic);
    }
  }
}

template <int CTRL> DI float dpp_f(float v) { return __int_as_float(__builtin_amdgcn_mov_dpp(__float_as_int(v), CTRL, 0xf, 0xf, false)); }
template <int CTRL> DI int dpp_shr0(int v) { return __builtin_amdgcn_update_dpp(0, v, CTRL, 0xf, 0xf, true); }
template <int I> DI int bcast16(int v) { return __builtin_amdgcn_mov_dpp(v, 0x150 + I, 0xf, 0xf, false); }
DI float row_sum16(float d) {
  d += dpp_f<0xB1>(d);
  d += dpp_f<0x4E>(d);
  d += dpp_f<0x141>(d);
  d += dpp_f<0x140>(d);
  return d;
}
typedef __bf16 bf16x2_c __attribute__((ext_vector_type(2)));
DI float dot4_fp8(unsigned w8, unsigned xlo, unsigned xhi, float acc) {
  const bf16x2_c lo = __builtin_amdgcn_cvt_scalef32_pk_bf16_fp8((int)w8, 1.0f, false);
  const bf16x2_c hi = __builtin_amdgcn_cvt_scalef32_pk_bf16_fp8((int)w8, 1.0f, true);
  acc = __builtin_amdgcn_fdot2_f32_bf16(lo, __builtin_bit_cast(bf16x2_c, xlo), acc, false);
  return __builtin_amdgcn_fdot2_f32_bf16(hi, __builtin_bit_cast(bf16x2_c, xhi), acc, false);
}
DI void phase_upass(const P& p, char* smem) {
  const int* idx = (const int*)(p.ws + OFF_IDX);
  const float* gv = (const float*)(p.ws + OFF_GV);
  const ushort_t* u2b = (const ushort_t*)(p.ws + OFF_U2B);
  const char* tabu = (const char*)(p.ws + OFF_TABU);
  const float* su = (const float*)(p.ws + OFF_SU);
  const float* sv = (const float*)(p.ws + OFF_SV);
  float* coef = (float*)(p.ws + OFF_COEF);
  const int tq = tid_opaque(); const int lane = tq & 63, wave = tq >> 6;
  const int g = lane >> 4, j = lane & 15;
  int4* lst = (int4*)smem + wave * 512 + g * 128;
  const int part = blockIdx.x & 7, bi = blockIdx.x >> 3, nb = (gridDim.x - part + 7) >> 3;
  __syncthreads();
#pragma unroll 1
  for (int tb = (bi * 8 + wave) * 4; tb < T_; tb += nb * 32) {
    const int tok = tb + g;
    const int4 i0 = *(const int4*)(idx + (size_t)tb * 128 + lane * 8), i1 = *(const int4*)(idx + (size_t)tb * 128 + lane * 8 + 4);
    const f32x4 g0 = *(const f32x4*)(gv + (size_t)tb * 128 + lane * 8), g1 = *(const f32x4*)(gv + (size_t)tb * 128 + lane * 8 + 4);
    u32x4 xr[8];
#pragma unroll
    for (int c = 0; c < 4; ++c) {
      xr[2 * c] = *(const u32x4*)(u2b + (size_t)tok * 1024 + (j + 16 * c) * 16);
      xr[2 * c + 1] = *(const u32x4*)(u2b + (size_t)tok * 1024 + (j + 16 * c) * 16 + 8);
    }
    const int ev[8] = {i0.x, i0.y, i0.z, i0.w, i1.x, i1.y, i1.z, i1.w};
    const float gg[8] = {g0[0], g0[1], g0[2], g0[3], g1[0], g1[1], g1[2], g1[3]};
    int cnt = 0;
#pragma unroll
    for (int i = 0; i < 8; ++i) cnt += ((ev[i] >> 11) == part) ? 1 : 0;
    int incl = cnt;
    incl += dpp_shr0<0x111>(incl); incl += dpp_shr0<0x112>(incl); incl += dpp_shr0<0x114>(incl); incl += dpp_shr0<0x118>(incl);
    const int ng = bcast16<15>(incl);
    int pos = incl - cnt;
#pragma unroll
    for (int i = 0; i < 8; ++i)
      if ((ev[i] >> 11) == part) { int4 en; en.x = ev[i]; en.y = __float_as_int(gg[i]); en.z = j * 8 + i; en.w = 0; lst[pos] = en; ++pos; }
    const int nmax = max(max(__builtin_amdgcn_readlane(ng, 0), __builtin_amdgcn_readlane(ng, 16)), max(__builtin_amdgcn_readlane(ng, 32), __builtin_amdgcn_readlane(ng, 48)));
    __builtin_amdgcn_wave_barrier();
    asm volatile("s_waitcnt lgkmcnt(0)" ::: "memory");
    u32x4 ra[4], rb[4], rc[4], rd[4];
#define UP_LOAD(R, IT) { const unsigned e_ = ((IT) < ng) ? (unsigned)lst[(IT)].x : 0u; const char* row_ = tabu + (size_t)e_ * 1024 + j * 16; \
                         _Pragma("unroll") for (int c = 0; c < 4; ++c) R[c] = *(const u32x4*)(row_ + c * 256); }
#define UP_COMP(R, IT) { float a0 = 0.f, a1 = 0.f, a2 = 0.f, a3 = 0.f; \
      _Pragma("unroll") for (int c = 0; c < 4; ++c) { \
        a0 = dot4_fp8(R[c][0], xr[2 * c][0], xr[2 * c][1], a0); a1 = dot4_fp8(R[c][1], xr[2 * c][2], xr[2 * c][3], a1); \
        a2 = dot4_fp8(R[c][2], xr[2 * c + 1][0], xr[2 * c + 1][1], a2); a3 = dot4_fp8(R[c][3], xr[2 * c + 1][2], xr[2 * c + 1][3], a3); } \
      const float d_ = row_sum16((a0 + a1) + (a2 + a3)); \
      if (j == 0 && (IT) < ng) ((int*)&lst[(IT)])[3] = __float_as_int(d_); }
    UP_LOAD(ra, 0) UP_LOAD(rb, 1) UP_LOAD(rc, 2) UP_LOAD(rd, 3)
#pragma unroll 1
    for (int it = 0; it < nmax; it += 4) {
      UP_COMP(ra, it)     UP_LOAD(ra, it + 4)
      UP_COMP(rb, it + 1) UP_LOAD(rb, it + 5)
      UP_COMP(rc, it + 2) UP_LOAD(rc, it + 6)
      UP_COMP(rd, it + 3) UP_LOAD(rd, it + 7)
    }
#undef UP_LOAD
#undef UP_COMP
    __builtin_amdgcn_wave_barrier();
    asm volatile("s_waitcnt lgkmcnt(0)" ::: "memory");
#pragma unroll 1
    for (int k = 0; k < nmax; k += 16) {
      if (k + j < ng) {
        const int4 en = lst[k + j];
        const float a = __int_as_float(en.w) * su[en.x];
        coef[(size_t)tok * 128 + en.z] = __int_as_float(en.y) * 0.5f * a * (1.f + erff(a * 0.7071067811865475f)) * sv[en.x];
      }
    }
    __builtin_amdgcn_wave_barrier();
    asm volatile("s_waitcnt lgkmcnt(0)" ::: "memory");
  }
}

struct VHdr { int ea, eb, ca, cb; };
DI VHdr vp_hdr(const int* idx, const float* coef, int tok, int g, int cq) {
  VHdr h;
  h.ea = idx[(size_t)tok * 128 + g * 32 + cq]; h.eb = idx[(size_t)tok * 128 + g * 32 + 16 + cq];
  h.ca = __float_as_int(coef[(size_t)tok * 128 + g * 32 + cq]); h.cb = __float_as_int(coef[(size_t)tok * 128 + g * 32 + 16 + cq]);
  return h;
}
DI void vp_rows(uint2 (&va)[16], uint2 (&vb)[16], const VHdr& h, const char* tb) {
#define VP_STEP(I) { va[I] = *(const uint2*)(tb + (unsigned)bcast16<I>(h.ea) * 128u); vb[I] = *(const uint2*)(tb + (unsigned)bcast16<I>(h.eb) * 128u); }
  VP_STEP(0) VP_STEP(1) VP_STEP(2) VP_STEP(3) VP_STEP(4) VP_STEP(5) VP_STEP(6) VP_STEP(7)
  VP_STEP(8) VP_STEP(9) VP_STEP(10) VP_STEP(11) VP_STEP(12) VP_STEP(13) VP_STEP(14) VP_STEP(15)
#undef VP_STEP
}
DI void vp_coefs(float (&fa)[16], float (&fb)[16], const VHdr& h) {
#define VP_STEP(I) { fa[I] = __int_as_float(bcast16<I>(h.ca)); fb[I] = __int_as_float(bcast16<I>(h.cb)); }
  VP_STEP(0) VP_STEP(1) VP_STEP(2) VP_STEP(3) VP_STEP(4) VP_STEP(5) VP_STEP(6) VP_STEP(7)
  VP_STEP(8) VP_STEP(9) VP_STEP(10) VP_STEP(11) VP_STEP(12) VP_STEP(13) VP_STEP(14) VP_STEP(15)
#undef VP_STEP
}
DI void vp_fma8(float (&a)[8], float cf, const uint2& v) {
  const f32x2_hw p0 = __builtin_amdgcn_cvt_pk_f32_fp8((int)v.x, false), p1 = __builtin_amdgcn_cvt_pk_f32_fp8((int)v.x, true);
  const f32x2_hw p2 = __builtin_amdgcn_cvt_pk_f32_fp8((int)v.y, false), p3 = __builtin_amdgcn_cvt_pk_f32_fp8((int)v.y, true);
  a[0] += cf * p0[0]; a[1] += cf * p0[1]; a[2] += cf * p1[0]; a[3] += cf * p1[1];
  a[4] += cf * p2[0]; a[5] += cf * p2[1]; a[6] += cf * p3[0]; a[7] += cf * p3[1];
}
DI void vp_consume(const uint2 (&va)[16], const uint2 (&vb)[16], const VHdr& h, float* f, int tok, int slice, int g, int cq, bool live) {
  float fa[16], fb[16];
  vp_coefs(fa, fb, h);
  float a[8];
#pragma unroll
  for (int i = 0; i < 8; ++i) a[i] = 0.f;
#pragma unroll
  for (int i = 0; i < 16; ++i) { vp_fma8(a, fa[i], va[i]); vp_fma8(a, fb[i], vb[i]); }
#pragma unroll
  for (int i = 0; i < 8; ++i) { a[i] += __shfl_xor(a[i], 16); a[i] += __shfl_xor(a[i], 32); }
  if (g == 0 && live) {
    f32x4 o0, o1; o0[0] = a[0]; o0[1] = a[1]; o0[2] = a[2]; o0[3] = a[3]; o1[0] = a[4]; o1[1] = a[5]; o1[2] = a[6]; o1[3] = a[7];
    float* fp = f + (size_t)tok * 1024 + slice * 128 + cq * 8;
    *(f32x4*)fp = o0; *(f32x4*)(fp + 4) = o1;
  }
}
DI void phase_vpass(const P& p) {
  const int* idx = (const int*)(p.ws + OFF_IDX);
  const float* coef = (const float*)(p.ws + OFF_COEF);
  const char* tabv = (const char*)(p.ws + OFF_TABV);
  float* f = (float*)(p.ws + OFF_F);
  const int tq = tid_opaque(); const int lane = tq & 63, wave = tq >> 6;
  const int g = lane >> 4, cq = lane & 15;
  const int slice = blockIdx.x & 7, bi = blockIdx.x >> 3, nb = (gridDim.x - slice + 7) >> 3;
  const int step = nb * 8;
  const char* tb = tabv + (size_t)slice * (16384 * 128) + cq * 8;
  int tok = bi * 8 + wave;
  if (tok >= T_) return;
  VHdr h0 = vp_hdr(idx, coef, tok, g, cq);
  VHdr h1 = vp_hdr(idx, coef, min(tok + step, T_ - 1), g, cq);
  uint2 va[16], vb[16], na[16], nb2[16];
  vp_rows(va, vb, h0, tb);
#pragma unroll 1
  for (; tok < T_; tok += 2 * step) {
    const VHdr h2 = vp_hdr(idx, coef, min(tok + 2 * step, T_ - 1), g, cq);
    vp_rows(na, nb2, h1, tb);
    vp_consume(va, vb, h0, f, tok, slice, g, cq, true);
    const VHdr h3 = vp_hdr(idx, coef, min(tok + 3 * step, T_ - 1), g, cq);
    vp_rows(va, vb, h2, tb);
    vp_consume(na, nb2, h1, f, tok + step, slice, g, cq, tok + step < T_);
    h0 = h2; h1 = h3;
  }
}

DI void phase_ln2(const P& p) {
  const float* ada = (const float*)(p.ws + OFF_ADA);
  const float* f = (const float*)(p.ws + OFF_F);
  const int tq = tid_opaque(); const int lane = tq & 63, wave = tq >> 6;
  for (int tok = blockIdx.x * 8 + wave; tok < T_; tok += gridDim.x * 8) {
    const int b = tok / S_;
    float* rp = p.out + (size_t)tok * 1024;
    f32x4 acc[4];
    float sm = 0.f;
#pragma unroll
    for (int i = 0; i < 4; ++i) {
      const int col = i * 256 + lane * 4;
      f32x4 x1 = *(const f32x4*)(rp + col), ff = *(const f32x4*)(f + (size_t)tok * 1024 + col);
      f32x4 g2 = *(const f32x4*)(ada + b * 6144 + 5 * 1024 + col);
#pragma unroll
      for (int j = 0; j < 4; ++j) { acc[i][j] = DN_ALPHA * x1[j] + (1.f + g2[j]) * ff[j]; sm += acc[i][j]; }
    }
    const float mu = wave_sum(sm) * (1.f / 1024.f);
    float q = 0.f;
#pragma unroll
    for (int i = 0; i < 4; ++i)
#pragma unroll
      for (int j = 0; j < 4; ++j) { float d = acc[i][j] - mu; q += d * d; }
    const float rs = rsqrtf(wave_sum(q) * (1.f / 1024.f) + LN_EPS);
#pragma unroll
    for (int i = 0; i < 4; ++i) {
      const int col = i * 256 + lane * 4;
      f32x4 gg = *(const f32x4*)(p.ln2_g + col), bb = *(const f32x4*)(p.ln2_b + col), o;
#pragma unroll
      for (int j = 0; j < 4; ++j) o[j] = (acc[i][j] - mu) * rs * gg[j] + bb[j];
      *(f32x4*)(rp + col) = o;
    }
  }
}

#define XB_TMO      128
#define XB_XCNT(j)  (256  + 64 * (j))
#define XB_XSUB(j)  (1280 + 64 * (j))
#define XB_XGEN(j)  (2304 + 64 * (j))
#define XB_TOP      3328
#define XB_TOPGEN   3392
#define XCD_BAR_WORDS 3456
#define XB_SPIN_CAP (1u << 22)
#define LAS __attribute__((address_space(3)))
DI unsigned xb_ld(unsigned* p)              { return __hip_atomic_load(p, __ATOMIC_RELAXED, __HIP_MEMORY_SCOPE_AGENT); }
DI unsigned xb_add(unsigned* p, unsigned v) { return __hip_atomic_fetch_add(p, v, __ATOMIC_RELAXED, __HIP_MEMORY_SCOPE_AGENT); }
DI unsigned xb_xcc_id() { return (unsigned)__builtin_amdgcn_s_getreg((3 << 11) | 20) & 0xFu; }
#define XB_SPIN(cond, bar) do { unsigned _sp = 0; while (cond) { __builtin_amdgcn_s_sleep(1); \
    if ((++_sp & 255u) == 0u) { if (xb_ld(&(bar)[XB_TMO])) break; if (_sp > XB_SPIN_CAP) { atomicAdd(&(bar)[XB_TMO], 1u); break; } } } } while (0)
struct XcdBarrier { unsigned* bar; unsigned x; volatile LAS unsigned* st; };
DI XcdBarrier xcd_barrier_post(unsigned* bar, volatile LAS unsigned* st) {
  XcdBarrier b; b.bar = bar; b.x = xb_xcc_id(); b.st = st;
  if (threadIdx.x == 0) (void)xb_add(&bar[XB_XCNT(b.x)], 1u);
  return b;
}
DI void xcd_barrier_complete(unsigned* bar, unsigned x, unsigned& nloc, unsigned& nx) {
  const unsigned G = gridDim.x * gridDim.y * gridDim.z;
  unsigned sum, cnt, mine, sp = 0u;
  for (;;) {
    sum = 0u; cnt = 0u; mine = 0u;
#pragma unroll
    for (unsigned j = 0; j < 16; ++j) { const unsigned c = xb_ld(&bar[XB_XCNT(j)]); sum += c; cnt += (c > 0u) ? 1u : 0u; mine = (j == x) ? c : mine; }
    if (sum == G) break;
    __builtin_amdgcn_s_sleep(1);
    if ((++sp & 255u) == 0u) { if (xb_ld(&bar[XB_TMO])) break; if (sp > XB_SPIN_CAP) { atomicAdd(&bar[XB_TMO], 1u); break; } }
  }
  nloc = mine > 0u ? mine : 1u; nx = cnt > 0u ? cnt : 1u;
}
DI void xcd_barrier(unsigned* barp, char* stp) {
  asm volatile("s_waitcnt vmcnt(0)" ::: "memory");
  __syncthreads();
  if (threadIdx.x == 0) {
    XcdBarrier b; b.bar = barp; b.x = xb_xcc_id(); b.st = (volatile LAS unsigned*)stp;
    unsigned* bar = b.bar;
    __builtin_amdgcn_s_waitcnt(0);
    unsigned nloc = b.st[0], nx = b.st[1];
    if (nloc == 0u) { xcd_barrier_complete(bar, b.x, nloc, nx); b.st[0] = nloc; b.st[1] = nx; }
    const unsigned old = xb_add(&bar[XB_XSUB(b.x)], 1u);
    const unsigned gen = old / nloc;
    if (old + 1u == (gen + 1u) * nloc) {
      __builtin_amdgcn_fence(__ATOMIC_RELEASE, "agent");
      asm volatile("s_waitcnt vmcnt(0)" ::: "memory");
      const unsigned og = xb_add(&bar[XB_TOP], 1u);
      const unsigned tg = og / nx;
      if (og + 1u == (tg + 1u) * nx) xb_add(&bar[XB_TOPGEN], 1u);
      else XB_SPIN(xb_ld(&bar[XB_TOPGEN]) == tg, bar);
      __builtin_amdgcn_fence(__ATOMIC_ACQUIRE, "agent");
      xb_add(&bar[XB_XGEN(b.x)], 1u);
      asm volatile("s_waitcnt vmcnt(0)" ::: "memory");
    } else {
      XB_SPIN(xb_ld(&bar[XB_XGEN(b.x)]) == gen, bar);
      __builtin_amdgcn_fence(__ATOMIC_ACQUIRE, "agent");
      asm volatile("s_waitcnt vmcnt(0)" ::: "memory");
    }
  }
  __syncthreads();
}

constexpr int SMEM_BYTES = 143360;
__global__ void __launch_bounds__(NT) fwd_megakernel(P p) {
  __shared__ __attribute__((aligned(16))) char smem[SMEM_BYTES + 16];
  if (threadIdx.x < 4) ((volatile LAS unsigned*)(smem + SMEM_BYTES))[threadIdx.x] = 0u;
  __syncthreads();
  (void)xcd_barrier_post((unsigned*)(p.ws + OFF_BAR), (volatile LAS unsigned*)(smem + SMEM_BYTES));
  phase_ada(p, smem);
  xcd_barrier((unsigned*)(p.ws + OFF_BAR), smem + SMEM_BYTES);
  phase_u1(p);
  phase_transposes(p, smem);
  phase_keys(p);
  phase_rope(p);
  phase_filter(p, smem);
  xcd_barrier((unsigned*)(p.ws + OFF_BAR), smem + SMEM_BYTES);
  phase_inproj(p, smem);
  xcd_barrier((unsigned*)(p.ws + OFF_BAR), smem + SMEM_BYTES);
  for (int item = blockIdx.x; item < 512 + 256; item += gridDim.x) {
    if (item < 512) hyena_item(p, smem, item);
    else attn_item(p, smem, item - 512);
  }
  xcd_barrier((unsigned*)(p.ws + OFF_BAR), smem + SMEM_BYTES);
  phase_yh_transpose(p, smem);
  xcd_barrier((unsigned*)(p.ws + OFF_BAR), smem + SMEM_BYTES);
  phase_merge(p, smem);
  xcd_barrier((unsigned*)(p.ws + OFF_BAR), smem + SMEM_BYTES);
  phase_outproj(p, smem);
  xcd_barrier((unsigned*)(p.ws + OFF_BAR), smem + SMEM_BYTES);
  phase_ln1(p);
  phase_tabconv(p);
  xcd_barrier((unsigned*)(p.ws + OFF_BAR), smem + SMEM_BYTES);
  phase_route(p, smem);
  xcd_barrier((unsigned*)(p.ws + OFF_BAR), smem + SMEM_BYTES);
  phase_upass(p, smem);
  xcd_barrier((unsigned*)(p.ws + OFF_BAR), smem + SMEM_BYTES);
  phase_vpass(p);
  xcd_barrier((unsigned*)(p.ws + OFF_BAR), smem + SMEM_BYTES);
  phase_ln2(p);
}

extern "C" void kernel_launch(void* const* d_in, const int* in_sizes, int n_in, void* d_out, int out_size, void* d_ws, size_t ws_size,
                              hipStream_t stream) {
  P p{};
  p.x = (const float*)d_in[0]; p.c = (const float*)d_in[1]; p.pos = (const int*)d_in[2];
  p.w_ada = (const float*)d_in[3]; p.b_ada = (const float*)d_in[4]; p.w_in = (const float*)d_in[5];
  p.hy_conv_w = (const float*)d_in[6]; p.hy_conv_b = (const float*)d_in[7];
  p.f1_w = (const float*)d_in[8]; p.f1_b = (const float*)d_in[9]; p.f1_freq = (const float*)d_in[10];
  p.f2_w = (const float*)d_in[11]; p.f2_b = (const float*)d_in[12]; p.f2_freq = (const float*)d_in[13];
  p.f3_w = (const float*)d_in[14]; p.hy_bias = (const float*)d_in[15];
  p.w_bh = (const float*)d_in[16]; p.w_ba = (const float*)d_in[17]; p.w_out = (const float*)d_in[18];
  p.ln1_g = (const float*)d_in[19]; p.ln1_b = (const float*)d_in[20];
  p.wq = (const float*)d_in[21]; p.keys = (const float*)d_in[22]; p.pu = (const float*)d_in[23]; p.pv = (const float*)d_in[24];
  p.ln2_g = (const float*)d_in[25]; p.ln2_b = (const float*)d_in[26];
  p.out = (float*)d_out; p.ws = (char*)d_ws;

  static int grid_blocks = 0;
  if (!grid_blocks) {
    int dev = 0, cus = 0, per_cu = 0;
    hipGetDevice(&dev);
    hipDeviceGetAttribute(&cus, hipDeviceAttributeMultiprocessorCount, dev);
    hipOccupancyMaxActiveBlocksPerMultiprocessor(&per_cu, fwd_megakernel, NT, 0);
    if (per_cu > 1) per_cu = 1;
    grid_blocks = cus * per_cu;
  }
  (void)hipMemsetAsync((char*)d_ws + OFF_BAR, 0, XCD_BAR_WORDS * 4, stream);
  void* args[] = {&p};
  hipError_t e = hipLaunchCooperativeKernel((void*)fwd_megakernel, dim3(grid_blocks), dim3(NT), args, 0, stream);
  if (e != hipSuccess) fprintf(stderr, "cooperative launch failed: %s (grid %d)\n", hipGetErrorString(e), grid_blocks);
}
```

```cpp
#include <hip/hip_runtime.h>
#include <hip/hip_cooperative_groups.h>
#include <cstdio>
#include <cstdint>

#define DI __device__ __forceinline__
typedef unsigned short ushort_t;
typedef __attribute__((ext_vector_type(8))) short bf16x8;
typedef __attribute__((ext_vector_type(16))) float f32x16;
typedef __attribute__((ext_vector_type(4))) float f32x4;
typedef __attribute__((ext_vector_type(4))) unsigned u32x4;

constexpr int T_ = 16384, S_ = 8192, NB = 2, D_ = 1024;
constexpr int HW_ = 512, HYC = 1536, QKVC = 2304, GATEC = 2048, INW = 5888;
constexpr int NT = 512;
constexpr float DN_ALPHA = 1.189207115002721f;
constexpr float LN_EPS = 1e-5f;

constexpr size_t OFF_ADA   = 0;
constexpr size_t OFF_BAR   = 49152;
constexpr size_t OFF_KEYS_B= 65536;
constexpr size_t OFF_WIN_T = 65536 + 524288;
constexpr size_t OFF_WQ_T  = OFF_WIN_T + (size_t)INW * 1024 * 2;
constexpr size_t OFF_WOUT_T= OFF_WQ_T + (size_t)2048 * 1024 * 2;
constexpr size_t OFF_WBH_T = OFF_WOUT_T + (size_t)1024 * 1024 * 2;
constexpr size_t OFF_WBA_T = OFF_WBH_T + (size_t)1024 * 512 * 2;
constexpr size_t OFF_PH    = OFF_WBA_T + (size_t)1024 * 256 * 2;
constexpr size_t OFF_QKV   = OFF_PH + (size_t)T_ * HYC * 2;
constexpr size_t OFF_GATE  = OFF_QKV + (size_t)T_ * QKVC * 2;
constexpr size_t OFF_YH    = OFF_GATE + (size_t)T_ * GATEC * 2;
constexpr size_t OFF_YA    = OFF_YH + (size_t)T_ * HW_ * 2;
constexpr size_t OFF_END   = OFF_YA + (size_t)T_ * 256 * 2;
constexpr size_t OFF_MERGED= OFF_PH;
constexpr size_t OFF_YHK   = OFF_PH + (size_t)32 * 1048576;
constexpr size_t OFF_U1B   = OFF_YH;
static_assert(OFF_U1B + (size_t)T_ * 1024 * 2 <= 268435456ull, "u1b overflow");
constexpr size_t OFF_U2B   = OFF_PH;
constexpr size_t OFF_TABU  = OFF_QKV;
constexpr size_t OFF_TABV  = OFF_QKV + (size_t)16 * 1048576;
constexpr size_t OFF_SU    = OFF_QKV + (size_t)32 * 1048576;
constexpr size_t OFF_SV    = OFF_SU + 65536;
constexpr size_t OFF_COEF  = OFF_QKV + (size_t)64 * 1048576;
constexpr size_t OFF_F     = OFF_QKV + (size_t)72 * 1048576;
static_assert(OFF_F + (size_t)64 * 1048576 <= OFF_YH, "peer buffers overflow the qkv+gate region");
constexpr size_t OFF_IDX   = OFF_YH;
constexpr size_t OFF_GV    = OFF_YH + (size_t)T_ * 128 * 4;
constexpr size_t OFF_HSCR  = OFF_END;
static_assert(OFF_HSCR + (size_t)164 * 131072 <= 268435456ull, "ws overflow");
static_assert((size_t)92 * 131072 <= (size_t)INW * 1024 * 2, "w_in^T region too small");
constexpr size_t OFF_ROPE  = OFF_HSCR + (size_t)164 * 131072;
static_assert(OFF_ROPE + (size_t)T_ * 64 <= 268435456ull, "rope table overflow");

struct P {
  const float *x, *c; const int* pos;
  const float *w_ada, *b_ada, *w_in, *hy_conv_w, *hy_conv_b, *f1_w, *f1_b, *f1_freq, *f2_w, *f2_b, *f2_freq, *f3_w,
      *hy_bias, *w_bh, *w_ba, *w_out, *ln1_g, *ln1_b, *wq, *keys, *pu, *pv, *ln2_g, *ln2_b;
  float* out; char* ws;
};

DI ushort_t f2bf(float x) { unsigned u = __float_as_uint(x); u += 0x7fffu + ((u >> 16) & 1u); return (ushort_t)(u >> 16); }
DI float bf2f(ushort_t h) { return __uint_as_float(((unsigned)h) << 16); }
typedef __bf16 bf16x2_hw __attribute__((ext_vector_type(2)));
typedef float f32x2_hw __attribute__((ext_vector_type(2)));
DI unsigned pack2(float a, float b) { f32x2_hw v = {a, b}; return __builtin_bit_cast(unsigned, __builtin_convertvector(v, bf16x2_hw)); }
DI int tid_opaque() { int t = threadIdx.x; asm volatile("" : "+v"(t)); return t; }
DI float wave_sum(float v) {
#pragma unroll
  for (int o = 32; o > 0; o >>= 1) v += __shfl_xor(v, o);
  return v;
}

struct cf2 { float x, y; };
constexpr int FFT_N = 16384, FFT_SA = 560;

DI constexpr float wcos32(int j) {
  switch (j & 31) {
    case 0: return 1.0f; case 1: return 0.98078528040323043f; case 2: return 0.92387953251128674f; case 3: return 0.83146961230254524f;
    case 4: return 0.70710678118654752f; case 5: return 0.55557023301960218f; case 6: return 0.38268343236508978f; case 7: return 0.19509032201612825f;
    case 8: return 0.0f; case 9: return -0.19509032201612825f; case 10: return -0.38268343236508978f; case 11: return -0.55557023301960218f;
    case 12: return -0.70710678118654752f; case 13: return -0.83146961230254524f; case 14: return -0.92387953251128674f; case 15: return -0.98078528040323043f;
    case 16: return -1.0f; case 17: return -0.98078528040323043f; case 18: return -0.92387953251128674f; case 19: return -0.83146961230254524f;
    case 20: return -0.70710678118654752f; case 21: return -0.55557023301960218f; case 22: return -0.38268343236508978f; case 23: return -0.19509032201612825f;
    case 24: return 0.0f; case 25: return 0.19509032201612825f; case 26: return 0.38268343236508978f; case 27: return 0.55557023301960218f;
    case 28: return 0.70710678118654752f; case 29: return 0.83146961230254524f; case 30: return 0.92387953251128674f; default: return 0.98078528040323043f;
  }
}
DI constexpr float wsin32(int j) { return wcos32(j + 24); }
DI constexpr int brev(int v, int bits) { int r = 0; for (int i = 0; i < bits; ++i) r |= ((v >> i) & 1) << (bits - 1 - i); return r; }

template <int R, int LEN, bool INV, bool ZHI>
DI void r2_stage(float (&re)[R], float (&im)[R]) {
  constexpr int half = LEN / 2;
#pragma unroll
  for (int start = 0; start < R; start += LEN) {
#pragma unroll
    for (int j = 0; j < half; ++j) {
      const int a = start + j, b = a + half;
      const int tj = j * (32 / LEN);
      const float c = wcos32(tj), s = wsin32(tj);
      if (!INV) {
        float dr, di;
        if (ZHI) { dr = re[a]; di = im[a]; }
        else {
          const float ar = re[a], ai = im[a], br = re[b], bi = im[b];
          re[a] = ar + br; im[a] = ai + bi; dr = ar - br; di = ai - bi;
        }
        if (tj == 0) { re[b] = dr; im[b] = di; }
        else if (tj == 8) { re[b] = di; im[b] = -dr; }
        else { re[b] = dr * c + di * s; im[b] = di * c - dr * s; }
      } else {
        const float br = re[b], bi = im[b];
        float pr, pi;
        if (tj == 0) { pr = br; pi = bi; }
        else if (tj == 8) { pr = -bi; pi = br; }
        else { pr = br * c - bi * s; pi = bi * c + br * s; }
        const float ar = re[a], ai = im[a];
        re[a] = ar + pr; im[a] = ai + pi; re[b] = ar - pr; im[b] = ai - pi;
      }
    }
  }
}
template <int R, bool ZHI> DI void dft_fwd(float (&re)[R], float (&im)[R]) {
  if (R == 32) r2_stage<R, (R == 32 ? 32 : 2), false, ZHI>(re, im);
  r2_stage<R, 16, false, (R == 16) && ZHI>(re, im);
  r2_stage<R, 8, false, false>(re, im);
  r2_stage<R, 4, false, false>(re, im);
  r2_stage<R, 2, false, false>(re, im);
}
template <int R> DI void dft_inv(float (&re)[R], float (&im)[R]) {
  r2_stage<R, 2, true, false>(re, im);
  r2_stage<R, 4, true, false>(re, im);
  r2_stage<R, 8, true, false>(re, im);
  r2_stage<R, 16, true, false>(re, im);
  if (R == 32) r2_stage<R, (R == 32 ? 32 : 2), true, false>(re, im);
}

DI void sincos_turn(float frac, float& s, float& c) { sincospif(2.0f * frac, &s, &c); }

template <bool ZHI>
DI void fft_fwdA(float (&re)[32], float (&im)[32], cf2* lds, int m) {
  asm volatile("" : "+v"(m));
  float s1, c1; sincos_turn((float)m * (1.0f / 16384.0f), s1, c1);
  __builtin_amdgcn_sched_barrier(0);
  dft_fwd<32, ZHI>(re, im);
  __builtin_amdgcn_sched_barrier(0);
  float wr = 1.f, wi = 0.f;
#pragma unroll
  for (int k1 = 0; k1 < 32; ++k1) {
    if ((k1 & 3) == 0) __builtin_amdgcn_sched_barrier(0);
    const int r = brev(k1, 5);
    cf2 o; o.x = re[r] * wr - im[r] * wi; o.y = re[r] * wi + im[r] * wr;
    lds[k1 * FFT_SA + m] = o;
    const float nr = wr * c1 + wi * s1, ni = wi * c1 - wr * s1;
    wr = nr; wi = ni;
  }
}
DI void fft_B_read(float (&re)[32], float (&im)[32], const cf2* lds, int tid) {
  const int k1 = tid >> 4, mp = tid & 15;
#pragma unroll
  for (int n2 = 0; n2 < 32; ++n2) { cf2 v = lds[k1 * FFT_SA + n2 * 16 + mp]; re[n2] = v.x; im[n2] = v.y; }
}
DI void fft_fwdB_write(float (&re)[32], float (&im)[32], cf2* lds, int tid) {
  asm volatile("" : "+v"(tid));
  const int k1 = tid >> 4, mp = tid & 15;
  float s1, c1; sincos_turn((float)mp * (1.0f / 512.0f), s1, c1);
  __builtin_amdgcn_sched_barrier(0);
  dft_fwd<32, false>(re, im);
  __builtin_amdgcn_sched_barrier(0);
  float wr = 1.f, wi = 0.f;
#pragma unroll
  for (int k2 = 0; k2 < 32; ++k2) {
    if ((k2 & 3) == 0) __builtin_amdgcn_sched_barrier(0);
    const int r = brev(k2, 5);
    cf2 o; o.x = re[r] * wr - im[r] * wi; o.y = re[r] * wi + im[r] * wr;
    lds[k1 * FFT_SA + k2 * 17 + mp] = o;
    const float nr = wr * c1 + wi * s1, ni = wi * c1 - wr * s1;
    wr = nr; wi = ni;
  }
}
DI void fft_fwdC(float (&re)[32], float (&im)[32], const cf2* lds, int tid) {
  const int k1 = tid >> 5, k2 = tid & 31;
#pragma unroll
  for (int h = 0; h < 2; ++h) {
    float tr[16], ti[16];
#pragma unroll
    for (int mp = 0; mp < 16; ++mp) { cf2 v = lds[(k1 + 16 * h) * FFT_SA + k2 * 17 + mp]; tr[mp] = v.x; ti[mp] = v.y; }
    dft_fwd<16, false>(tr, ti);
#pragma unroll
    for (int i = 0; i < 16; ++i) { re[h * 16 + i] = tr[i]; im[h * 16 + i] = ti[i]; }
  }
}
DI void fft_invC(float (&re)[32], float (&im)[32], cf2* lds, int tid) {
  const int k1 = tid >> 5, k2 = tid & 31;
#pragma unroll
  for (int h = 0; h < 2; ++h) {
    float tr[16], ti[16];
#pragma unroll
    for (int i = 0; i < 16; ++i) { tr[i] = re[h * 16 + i]; ti[i] = im[h * 16 + i]; }
    dft_inv<16>(tr, ti);
#pragma unroll
    for (int mp = 0; mp < 16; ++mp) { cf2 o; o.x = tr[mp]; o.y = ti[mp]; lds[(k1 + 16 * h) * FFT_SA + k2 * 17 + mp] = o; }
  }
}
DI void fft_invB_read(float (&re)[32], float (&im)[32], const cf2* lds, int tid) {
  asm volatile("" : "+v"(tid));
  const int k1 = tid >> 4, mp = tid & 15;
  float s1, c1; sincos_turn((float)mp * (1.0f / 512.0f), s1, c1);
  float wr = 1.f, wi = 0.f;
  __builtin_amdgcn_sched_barrier(0);
#pragma unroll
  for (int k2 = 0; k2 < 32; ++k2) {
    if ((k2 & 3) == 0) __builtin_amdgcn_sched_barrier(0);
    const int r = brev(k2, 5);
    cf2 v = lds[k1 * FFT_SA + k2 * 17 + mp];
    re[r] = v.x * wr - v.y * wi; im[r] = v.x * wi + v.y * wr;
    const float nr = wr * c1 - wi * s1, ni = wi * c1 + wr * s1;
    wr = nr; wi = ni;
  }
}
DI void fft_invB_write(float (&re)[32], float (&im)[32], cf2* lds, int tid) {
  const int k1 = tid >> 4, mp = tid & 15;
  dft_inv<32>(re, im);
#pragma unroll
  for (int n2 = 0; n2 < 32; ++n2) { cf2 o; o.x = re[n2]; o.y = im[n2]; lds[k1 * FFT_SA + n2 * 16 + mp] = o; }
}
DI void fft_invA(float (&re)[32], float (&im)[32], const cf2* lds, int m) {
  asm volatile("" : "+v"(m));
  float s1, c1; sincos_turn((float)m * (1.0f / 16384.0f), s1, c1);
  float wr = 1.f, wi = 0.f;
  __builtin_amdgcn_sched_barrier(0);
#pragma unroll
  for (int k1 = 0; k1 < 32; ++k1) {
    if ((k1 & 3) == 0) __builtin_amdgcn_sched_barrier(0);
    const int r = brev(k1, 5);
    cf2 v = lds[k1 * FFT_SA + m];
    re[r] = v.x * wr - v.y * wi; im[r] = v.x * wi + v.y * wr;
    const float nr = wr * c1 - wi * s1, ni = wi * c1 + wr * s1;
    wr = nr; wi = ni;
  }
  __builtin_amdgcn_sched_barrier(0);
  dft_inv<32>(re, im);
}

DI void phase_ada(const P& p, char* smem) {
  float (*red)[16][32] = (float (*)[16][32])smem;
  const int tid = tid_opaque(), cl = tid & 31, kq = tid >> 5;
  for (int item = blockIdx.x; item < 192; item += gridDim.x) {
    const int col = item * 32 + cl;
    float a0 = 0.f, a1 = 0.f;
#pragma unroll 16
    for (int k = kq * 64; k < kq * 64 + 64; ++k) {
      const float w = p.w_ada[(size_t)k * 6144 + col];
      const float c0 = p.c[k], c1 = p.c[1024 + k];
      a0 += (c0 / (1.f + __expf(-c0))) * w;
      a1 += (c1 / (1.f + __expf(-c1))) * w;
    }
    __syncthreads();
    red[0][kq][cl] = a0; red[1][kq][cl] = a1;
    __syncthreads();
    if (tid < 64) {
      const int b = tid >> 5;
      float s = p.b_ada[col];
#pragma unroll
      for (int q = 0; q < 16; ++q) s += red[b][q][cl];
      ((float*)(p.ws + OFF_ADA))[b * 6144 + col] = s;
    }
  }
}
DI void phase_u1(const P& p) {
  const float* ada = (const float*)(p.ws + OFF_ADA);
  ushort_t* u1b = (ushort_t*)(p.ws + OFF_U1B);
  for (int i = blockIdx.x * NT + tid_opaque(); i < T_ * 128; i += gridDim.x * NT) {
    const int row = i >> 7, k = (i & 127) * 8, b = row / S_;
    const float* xp = p.x + (size_t)row * 1024 + k;
    const f32x4 x0 = *(const f32x4*)xp, x1 = *(const f32x4*)(xp + 4);
    const f32x4 s0 = *(const f32x4*)(ada + b * 6144 + 1024 + k), s1 = *(const f32x4*)(ada + b * 6144 + 1024 + k + 4);
    const f32x4 h0 = *(const f32x4*)(ada + b * 6144 + k), h1 = *(const f32x4*)(ada + b * 6144 + k + 4);
    u32x4 o;
    o[0] = pack2(x0[0] * (1.f + s0[0]) + h0[0], x0[1] * (1.f + s0[1]) + h0[1]);
    o[1] = pack2(x0[2] * (1.f + s0[2]) + h0[2], x0[3] * (1.f + s0[3]) + h0[3]);
    o[2] = pack2(x1[0] * (1.f + s1[0]) + h1[0], x1[1] * (1.f + s1[1]) + h1[1]);
    o[3] = pack2(x1[2] * (1.f + s1[2]) + h1[2], x1[3] * (1.f + s1[3]) + h1[3]);
    *(u32x4*)(u1b + (size_t)row * 1024 + k) = o;
  }
}

DI void transpose_tile(const float* __restrict__ W, ushort_t* __restrict__ Wt, int K, int N, int item, char* smem) {
  float (*tile)[65] = (float (*)[65])smem;
  const int ntn = N / 64;
  const int n0 = (item % ntn) * 64, k0 = (item / ntn) * 32;
  const int tid = tid_opaque();
  __syncthreads();
  {
    const int tx = tid & 63, ty = tid >> 6;
#pragma unroll
    for (int i = 0; i < 4; ++i) tile[ty + 8 * i][tx] = W[(size_t)(k0 + ty + 8 * i) * N + n0 + tx];
  }
  __syncthreads();
  {
    const int kk = tid & 31, nn0 = tid >> 5;
#pragma unroll
    for (int i = 0; i < 4; ++i) Wt[(size_t)(n0 + nn0 + 16 * i) * K + k0 + kk] = f2bf(tile[kk][nn0 + 16 * i]);
  }
}
DI void phase_transposes(const P& p, char* smem) {
  constexpr int I0 = (INW / 64) * 32, I1 = I0 + 32 * 32, I2 = I1 + 16 * 32, I3 = I2 + 16 * 16, I4 = I3 + 16 * 8;
  for (int item = blockIdx.x; item < I4; item += gridDim.x) {
    if (item < I0) transpose_tile(p.w_in, (ushort_t*)(p.ws + OFF_WIN_T), 1024, INW, item, smem);
    else if (item < I1) transpose_tile(p.wq, (ushort_t*)(p.ws + OFF_WQ_T), 1024, 2048, item - I0, smem);
    else if (item < I2) transpose_tile(p.w_out, (ushort_t*)(p.ws + OFF_WOUT_T), 1024, 1024, item - I1, smem);
    else if (item < I3) transpose_tile(p.w_bh, (ushort_t*)(p.ws + OFF_WBH_T), 512, 1024, item - I2, smem);
    else transpose_tile(p.w_ba, (ushort_t*)(p.ws + OFF_WBA_T), 256, 1024, item - I3, smem);
  }
}

DI void phase_filter(const P& p, char* smem) {
  float (*zf)[33] = (float (*)[33])smem;
  float (*h1)[64] = (float (*)[64])(smem + 4352);
  float (*h2)[65] = (float (*)[65])(smem + 4352 + 8192);
  float* w1s = (float*)(smem + 32768);
  float* w2s = (float*)(smem + 32768 + 8448);
  const int tid = tid_opaque(), lane = tid & 63, wave = tid >> 6;
  __syncthreads();
  for (int i = tid; i < 33 * 64; i += NT) w1s[i] = p.f1_w[i];
  for (int i = tid; i < 64 * 64; i += NT) w2s[i] = p.f2_w[i];
  for (int item = blockIdx.x; item < 256; item += gridDim.x) {
  const int t0 = item * 32;
  __syncthreads();
  for (int idx = tid; idx < 32 * 33; idx += NT) {
    int tt = idx / 33, e = idx % 33, t = t0 + tt;
    float tl = (float)t * (1.0f / 8191.0f);
    float w = 6.283185307179586f * (float)t / 8192.0f;
    float val;
    if (e == 0) val = tl;
    else {
      int i = (e - 1) & 15;
      float f = 1e-4f + (float)i * ((15.0f - 1e-4f) / 15.0f);
      val = (e <= 16) ? cosf(f * w) : -sinf(f * w);
    }
    zf[tt][e] = val;
  }
  __syncthreads();
  for (int idx = tid; idx < 32 * 64; idx += NT) {
    int tt = idx >> 6, j = idx & 63;
    float a = p.f1_b[j];
#pragma unroll
    for (int e = 0; e < 33; ++e) a += zf[tt][e] * w1s[e * 64 + j];
    h1[tt][j] = sinf(p.f1_freq[j] * a);
  }
  __syncthreads();
  for (int idx = tid; idx < 32 * 64; idx += NT) {
    int tt = idx >> 6, j = idx & 63;
    float a = p.f2_b[j];
#pragma unroll
    for (int e = 0; e < 64; ++e) a += h1[tt][e] * w2s[e * 64 + j];
    h2[tt][j] = sinf(p.f2_freq[j] * a);
  }
  __syncthreads();
  float* filt = p.out;
  const float min_decay = -3.0701134573253945f, max_decay = -15.350567286626973f;
  float af[32];
#pragma unroll
  for (int s = 0; s < 32; ++s) af[s] = h2[lane & 31][2 * s + (lane >> 5)];
#pragma unroll 1
  for (int ci = 0; ci < 8; ++ci) {
    const int col = (wave + 8 * ci) * 32 + (lane & 31);
    const float* wp = p.f3_w + (size_t)(lane >> 5) * 2048 + col;
    float bfv[32];
#pragma unroll
    for (int s = 0; s < 32; ++s) bfv[s] = wp[(size_t)s * 4096];
    f32x16 acc;
#pragma unroll
    for (int r = 0; r < 16; ++r) acc[r] = 0.f;
#pragma unroll
    for (int s = 0; s < 32; ++s) acc = __builtin_amdgcn_mfma_f32_32x32x2f32(af[s], bfv[s], acc, 0, 0, 0);
    const float delta = fabsf(min_decay + (float)(col & 511) * ((max_decay - min_decay) / 511.0f));
    float* dst = filt + (size_t)col * 8192 + t0 + 4 * (lane >> 5);
#pragma unroll
    for (int q = 0; q < 4; ++q) {
      f32x4 o;
#pragma unroll
      for (int r = 0; r < 4; ++r) {
        const float tl = (float)(t0 + 8 * q + 4 * (lane >> 5) + r) * (1.0f / 8191.0f);
        o[r] = acc[4 * q + r] * __expf(-tl * delta);
      }
      *(f32x4*)(dst + 8 * q) = o;
    }
  }
  }
}

constexpr int BM = 256, BN = 128, BK = 64;
constexpr int LDS_A = BM * BK * 2, LDS_B = BN * BK * 2, LDS_STAGE = LDS_A + LDS_B;
constexpr int GEMM_LDS = 2 * LDS_STAGE + 8192;

DI int swz(int row, int ch) { return row * 128 + ((ch ^ (row & 7)) << 4); }

struct ALoadBf16 {
  const ushort_t* A; int lda;
  struct Raw { u32x4 v; };
  DI Raw fetch(int row, int k) const { Raw r; r.v = *(const u32x4*)(A + (size_t)row * lda + k); return r; }
  DI u32x4 cvt(const Raw& r, int k) const { return r.v; }
};
struct ALoadF32Mod {
  const float* A; const float* mod;
  struct Raw { f32x4 a, b; };
  DI Raw fetch(int row, int k) const { Raw r; const float* s = A + (size_t)row * 1024 + k; r.a = *(const f32x4*)s; r.b = *(const f32x4*)(s + 4); return r; }
  DI u32x4 cvt(const Raw& r, int k) const {
    f32x4 s0 = *(const f32x4*)(mod + k), s1 = *(const f32x4*)(mod + k + 4);
    f32x4 h0 = *(const f32x4*)(mod + 1024 + k), h1 = *(const f32x4*)(mod + 1024 + k + 4);
    u32x4 o;
    o[0] = pack2(r.a[0] * s0[0] + h0[0], r.a[1] * s0[1] + h0[1]);
    o[1] = pack2(r.a[2] * s0[2] + h0[2], r.a[3] * s0[3] + h0[3]);
    o[2] = pack2(r.b[0] * s1[0] + h1[0], r.b[1] * s1[1] + h1[1]);
    o[3] = pack2(r.b[2] * s1[2] + h1[2], r.b[3] * s1[3] + h1[3]);
    return o;
  }
};

template <class AL, bool SWAP = false>
DI void gemm_mainloop(f32x16 (&acc)[2][2], const AL& al, int m0, const ushort_t* __restrict__ Bt, int ldb, int n0, int K, char* smem) {
  const int tid = tid_opaque(), lane = tid & 63, wave = tid >> 6;
  const int wm = wave >> 1, wn = wave & 1;
  const int lr = tid >> 3, lc = tid & 7;
  typename AL::Raw ra[4]; u32x4 rb[2];
  const int nk = K / BK;
#pragma unroll
  for (int i = 0; i < 4; ++i) ra[i] = al.fetch(m0 + lr + 64 * i, lc * 8);
#pragma unroll
  for (int i = 0; i < 2; ++i) rb[i] = *(const u32x4*)(Bt + (size_t)(n0 + lr + 64 * i) * ldb + lc * 8);
  __syncthreads();
#pragma unroll
  for (int i = 0; i < 4; ++i) *(u32x4*)(smem + swz(lr + 64 * i, lc)) = al.cvt(ra[i], lc * 8);
#pragma unroll
  for (int i = 0; i < 2; ++i) *(u32x4*)(smem + LDS_A + swz(lr + 64 * i, lc)) = rb[i];
  __syncthreads();
  for (int kt = 0; kt < nk; ++kt) {
    char* cur = smem + (kt & 1) * LDS_STAGE;
    char* nxt = smem + ((kt + 1) & 1) * LDS_STAGE;
    const bool more = (kt + 1 < nk);
    const int kn = (kt + 1) * BK + lc * 8;
    if (more) {
#pragma unroll
      for (int i = 0; i < 4; ++i) ra[i] = al.fetch(m0 + lr + 64 * i, kn);
#pragma unroll
      for (int i = 0; i < 2; ++i) rb[i] = *(const u32x4*)(Bt + (size_t)(n0 + lr + 64 * i) * ldb + kn);
    }
#pragma unroll
    for (int s = 0; s < 4; ++s) {
      const int ch = 2 * s + (lane >> 5);
      bf16x8 af[2], bfr[2];
#pragma unroll
      for (int mi = 0; mi < 2; ++mi) af[mi] = *(const bf16x8*)(cur + swz(wm * 64 + mi * 32 + (lane & 31), ch));
#pragma unroll
      for (int ni = 0; ni < 2; ++ni) bfr[ni] = *(const bf16x8*)(cur + LDS_A + swz(wn * 64 + ni * 32 + (lane & 31), ch));
#pragma unroll
      for (int mi = 0; mi < 2; ++mi)
#pragma unroll
        for (int ni = 0; ni < 2; ++ni)
          acc[mi][ni] = SWAP ? __builtin_amdgcn_mfma_f32_32x32x16_bf16(bfr[ni], af[mi], acc[mi][ni], 0, 0, 0)
                             : __builtin_amdgcn_mfma_f32_32x32x16_bf16(af[mi], bfr[ni], acc[mi][ni], 0, 0, 0);
    }
    if (more) {
#pragma unroll
      for (int i = 0; i < 4; ++i) *(u32x4*)(nxt + swz(lr + 64 * i, lc)) = al.cvt(ra[i], kn);
#pragma unroll
      for (int i = 0; i < 2; ++i) *(u32x4*)(nxt + LDS_A + swz(lr + 64 * i, lc)) = rb[i];
    }
    __syncthreads();
  }
}

constexpr int AT_ROW = 576;
constexpr int LDS_AT = 64 * AT_ROW;
constexpr int LDS_STAGE_T = LDS_AT + LDS_B;
typedef __attribute__((ext_vector_type(4))) short s16x4;
DI void gemm_mainloop_AT(f32x16 (&acc)[2][2], const ushort_t* __restrict__ At, size_t ldt, const ushort_t* __restrict__ Bt, int ldb, int n0, int K, char* smem) {
  const int tid = tid_opaque(), lane = tid & 63, wave = tid >> 6;
  const int wm = wave >> 1, wn = wave & 1;
  const int lr = tid >> 3, lc = tid & 7;
  u32x4 ra[4], rb[2];
  const int nk = K / BK;
#pragma unroll
  for (int i = 0; i < 4; ++i) { const int q = tid + 512 * i; ra[i] = *(const u32x4*)(At + (size_t)(q >> 5) * ldt + (q & 31) * 8); }
#pragma unroll
  for (int i = 0; i < 2; ++i) rb[i] = *(const u32x4*)(Bt + (size_t)(n0 + lr + 64 * i) * ldb + lc * 8);
  __syncthreads();
#pragma unroll
  for (int i = 0; i < 4; ++i) { const int q = tid + 512 * i; *(u32x4*)(smem + (q >> 5) * AT_ROW + (q & 31) * 16) = ra[i]; }
#pragma unroll
  for (int i = 0; i < 2; ++i) *(u32x4*)(smem + LDS_AT + swz(lr + 64 * i, lc)) = rb[i];
  __syncthreads();
  const int hh = lane >> 5, gg = (lane >> 4) & 1, qq = (lane & 15) >> 2, pp = lane & 3;
  for (int kt = 0; kt < nk; ++kt) {
    char* cur = smem + (kt & 1) * LDS_STAGE_T;
    char* nxt = smem + ((kt + 1) & 1) * LDS_STAGE_T;
    const bool more = (kt + 1 < nk);
    if (more) {
#pragma unroll
      for (int i = 0; i < 4; ++i) { const int q = tid + 512 * i; ra[i] = *(const u32x4*)(At + (size_t)((kt + 1) * BK + (q >> 5)) * ldt + (q & 31) * 8); }
#pragma unroll
      for (int i = 0; i < 2; ++i) rb[i] = *(const u32x4*)(Bt + (size_t)(n0 + lr + 64 * i) * ldb + (kt + 1) * BK + lc * 8);
    }
#pragma unroll
    for (int s = 0; s < 4; ++s) {
      const int ch = 2 * s + hh;
      bf16x8 af[2], bfr[2];
#pragma unroll
      for (int mi = 0; mi < 2; ++mi) {
        const char* a0 = cur + (16 * s + 8 * hh + qq) * AT_ROW + (wm * 64 + mi * 32 + 16 * gg + 4 * pp) * 2;
        s16x4 lo = __builtin_amdgcn_ds_read_tr16_b64_v4i16((__attribute__((address_space(3))) s16x4*)(a0));
        s16x4 hi = __builtin_amdgcn_ds_read_tr16_b64_v4i16((__attribute__((address_space(3))) s16x4*)(a0 + 4 * AT_ROW));
        af[mi] = __builtin_shufflevector(lo, hi, 0, 1, 2, 3, 4, 5, 6, 7);
      }
#pragma unroll
      for (int ni = 0; ni < 2; ++ni) bfr[ni] = *(const bf16x8*)(cur + LDS_AT + swz(wn * 64 + ni * 32 + (lane & 31), ch));
#pragma unroll
      for (int mi = 0; mi < 2; ++mi)
#pragma unroll
        for (int ni = 0; ni < 2; ++ni) acc[mi][ni] = __builtin_amdgcn_mfma_f32_32x32x16_bf16(af[mi], bfr[ni], acc[mi][ni], 0, 0, 0);
    }
    if (more) {
#pragma unroll
      for (int i = 0; i < 4; ++i) { const int q = tid + 512 * i; *(u32x4*)(nxt + (q >> 5) * AT_ROW + (q & 31) * 16) = ra[i]; }
#pragma unroll
      for (int i = 0; i < 2; ++i) *(u32x4*)(nxt + LDS_AT + swz(lr + 64 * i, lc)) = rb[i];
    }
    __syncthreads();
  }
}

constexpr int G2_A = 32768, G2_STAGE = 65536;
template <bool SWAP>
DI void gemm256(f32x16 (&acc)[4][2], const ushort_t* __restrict__ A, int lda, int m0, const ushort_t* __restrict__ Bt, int ldb, int n0, int K, char* smem) {
  const int tid = tid_opaque(), lane = tid & 63, wave = tid >> 6;
  const int wm = wave >> 2, wn = wave & 3;
  const int lr = tid >> 3, lc = tid & 7;
  u32x4 ra[4], rb[4];
  const int nk = K / BK;
  const ushort_t* ap = A + (size_t)(m0 + lr) * lda + lc * 8;
  const ushort_t* bp = Bt + (size_t)(n0 + lr) * ldb + lc * 8;
#pragma unroll
  for (int i = 0; i < 4; ++i) { ra[i] = *(const u32x4*)(ap + (size_t)(64 * i) * lda); rb[i] = *(const u32x4*)(bp + (size_t)(64 * i) * ldb); }
  __syncthreads();
#pragma unroll
  for (int i = 0; i < 4; ++i) { *(u32x4*)(smem + swz(lr + 64 * i, lc)) = ra[i]; *(u32x4*)(smem + G2_A + swz(lr + 64 * i, lc)) = rb[i]; }
  __syncthreads();
  for (int kt = 0; kt < nk; ++kt) {
    char* cur = smem + (kt & 1) * G2_STAGE;
    char* nxt = smem + ((kt + 1) & 1) * G2_STAGE;
    const bool more = (kt + 1 < nk);
    if (more) {
#pragma unroll
      for (int i = 0; i < 4; ++i) { ra[i] = *(const u32x4*)(ap + (size_t)(64 * i) * lda + (kt + 1) * BK); rb[i] = *(const u32x4*)(bp + (size_t)(64 * i) * ldb + (kt + 1) * BK); }
    }
#pragma unroll
    for (int s = 0; s < 4; ++s) {
      const int ch = 2 * s + (lane >> 5);
      bf16x8 af[4], bfr[2];
#pragma unroll
      for (int mi = 0; mi < 4; ++mi) af[mi] = *(const bf16x8*)(cur + swz(wm * 128 + mi * 32 + (lane & 31), ch));
#pragma unroll
      for (int ni = 0; ni < 2; ++ni) bfr[ni] = *(const bf16x8*)(cur + G2_A + swz(wn * 64 + ni * 32 + (lane & 31), ch));
#pragma unroll
      for (int mi = 0; mi < 4; ++mi)
#pragma unroll
        for (int ni = 0; ni < 2; ++ni)
          acc[mi][ni] = SWAP ? __builtin_amdgcn_mfma_f32_32x32x16_bf16(bfr[ni], af[mi], acc[mi][ni], 0, 0, 0)
                             : __builtin_amdgcn_mfma_f32_32x32x16_bf16(af[mi], bfr[ni], acc[mi][ni], 0, 0, 0);
      if (s & 1) __builtin_amdgcn_sched_barrier(0);
    }
    if (more) {
#pragma unroll
      for (int i = 0; i < 4; ++i) { *(u32x4*)(nxt + swz(lr + 64 * i, lc)) = ra[i]; *(u32x4*)(nxt + G2_A + swz(lr + 64 * i, lc)) = rb[i]; }
    }
    __syncthreads();
  }
}
constexpr int G2T_A = 64 * 576, G2T_STAGE = G2T_A + 32768;
DI void gemm256_AT(f32x16 (&acc)[4][2], const ushort_t* __restrict__ At, size_t ldt, const ushort_t* __restrict__ Bt, int ldb, int n0, int K, char* smem) {
  const int tid = tid_opaque(), lane = tid & 63, wave = tid >> 6;
  const int wm = wave >> 2, wn = wave & 3;
  const int lr = tid >> 3, lc = tid & 7;
  u32x4 ra[4], rb[4];
  const int nk = K / BK;
  const ushort_t* bp = Bt + (size_t)(n0 + lr) * ldb + lc * 8;
#pragma unroll
  for (int i = 0; i < 4; ++i) { const int q = tid + 512 * i; ra[i] = *(const u32x4*)(At + (size_t)(q >> 5) * ldt + (q & 31) * 8); rb[i] = *(const u32x4*)(bp + (size_t)(64 * i) * ldb); }
  __syncthreads();
#pragma unroll
  for (int i = 0; i < 4; ++i) { const int q = tid + 512 * i; *(u32x4*)(smem + (q >> 5) * 576 + (q & 31) * 16) = ra[i]; *(u32x4*)(smem + G2T_A + swz(lr + 64 * i, lc)) = rb[i]; }
  __syncthreads();
  const int hh = lane >> 5, gg = (lane >> 4) & 1, qq = (lane & 15) >> 2, pp = lane & 3;
  for (int kt = 0; kt < nk; ++kt) {
    char* cur = smem + (kt & 1) * G2T_STAGE;
    char* nxt = smem + ((kt + 1) & 1) * G2T_STAGE;
    const bool more = (kt + 1 < nk);
    if (more) {
#pragma unroll
      for (int i = 0; i < 4; ++i) { const int q = tid + 512 * i; ra[i] = *(const u32x4*)(At + (size_t)((kt + 1) * BK + (q >> 5)) * ldt + (q & 31) * 8); rb[i] = *(const u32x4*)(bp + (size_t)(64 * i) * ldb + (kt + 1) * BK); }
    }
#pragma unroll
    for (int s = 0; s < 4; ++s) {
      const int ch = 2 * s + hh;
      bf16x8 af[4], bfr[2];
#pragma unroll
      for (int mi = 0; mi < 4; ++mi) {
        const char* a0 = cur + (16 * s + 8 * hh + qq) * 576 + (wm * 128 + mi * 32 + 16 * gg + 4 * pp) * 2;
        s16x4 lo = __builtin_amdgcn_ds_read_tr16_b64_v4i16((__attribute__((address_space(3))) s16x4*)(a0));
        s16x4 hi = __builtin_amdgcn_ds_read_tr16_b64_v4i16((__attribute__((address_space(3))) s16x4*)(a0 + 4 * 576));
        af[mi] = __builtin_shufflevector(lo, hi, 0, 1, 2, 3, 4, 5, 6, 7);
      }
#pragma unroll
      for (int ni = 0; ni < 2; ++ni) bfr[ni] = *(const bf16x8*)(cur + G2T_A + swz(wn * 64 + ni * 32 + (lane & 31), ch));
#pragma unroll
      for (int mi = 0; mi < 4; ++mi)
#pragma unroll
        for (int ni = 0; ni < 2; ++ni) acc[mi][ni] = __builtin_amdgcn_mfma_f32_32x32x16_bf16(af[mi], bfr[ni], acc[mi][ni], 0, 0, 0);
      if (s & 1) __builtin_amdgcn_sched_barrier(0);
    }
    if (more) {
#pragma unroll
      for (int i = 0; i < 4; ++i) { const int q = tid + 512 * i; *(u32x4*)(nxt + (q >> 5) * 576 + (q & 31) * 16) = ra[i]; *(u32x4*)(nxt + G2T_A + swz(lr + 64 * i, lc)) = rb[i]; }
    }
    __syncthreads();
  }
}
DI void acc_zero4(f32x16 (&acc)[4][2]) {
#pragma unroll
  for (int a = 0; a < 4; ++a)
#pragma unroll
    for (int b = 0; b < 2; ++b)
#pragma unroll
      for (int r = 0; r < 16; ++r) acc[a][b][r] = 0.f;
}
DI void acc_zero(f32x16 (&acc)[2][2]) {
#pragma unroll
  for (int a = 0; a < 2; ++a)
#pragma unroll
    for (int b = 0; b < 2; ++b)
#pragma unroll
      for (int r = 0; r < 16; ++r) acc[a][b][r] = 0.f;
}
#define ACC_ROW(mi, r) (wm * 64 + (mi) * 32 + ((r) & 3) + 8 * ((r) >> 2) + 4 * (lane >> 5))
#define ACC_COL(ni) (wn * 64 + (ni) * 32 + (lane & 31))

DI void stage_mod(float* mod, const float* ada, int b, int sc_chunk, int sh_chunk) {
  for (int i = tid_opaque(); i < 1024; i += NT) {
    mod[i] = 1.f + ada[b * 6144 + sc_chunk * 1024 + i];
    mod[1024 + i] = ada[b * 6144 + sh_chunk * 1024 + i];
  }
}


namespace pg8 {
#define PG8_LAS __attribute__((address_space(3)))
constexpr int BM8 = 256, BK8 = 64, HALF = 128, HTB = HALF * BK8 * 2, STAGE_BYTES = 8 * HTB, NXCD = 8, WGM = 8;
DI int lds_byte(int r, int c) { const int st = (r >> 4) * 2 + (c >> 5), rr = r & 15, cc = c & 31, ob = rr * 64 + cc * 2; return st * 1024 + (ob ^ (((ob >> 9) & 1) << 5)); }
DI void stage_rc(int b, int& R, int& C) { const int st = b / 1024, sb = b % 1024, sw = sb ^ (((sb >> 9) & 1) << 5); R = (st >> 1) * 16 + sw / 64; C = (st & 1) * 32 + (sw % 64) / 2; }
DI int perm32(int rho) { const int n = rho >> 4, i = rho & 15; return 8 * (i >> 2) + 4 * n + (i & 3); }
struct Unit { int pm, pn, kind; };
DI void tile_order(int L, int nM, int nN, int& pm, int& pn) {
  const int nwg = nM * nN;
  int wgid = L; { const int q = nwg / NXCD, r = nwg % NXCD, xcd = wgid % NXCD, off = wgid / NXCD; wgid = (xcd < r ? xcd * (q + 1) : r * (q + 1) + (xcd - r) * q) + off; }
  const int nig = WGM * nN, gid = wgid / nig, fm = gid * WGM, gsz = (nM - fm) < WGM ? (nM - fm) : WGM;
  pm = fm + ((wgid % nig) % gsz); pn = (wgid % nig) / gsz;
}
typedef float f32x4p __attribute__((ext_vector_type(4)));
template <class Epi, class Sched>
DI void gemm_phase(PG8_LAS unsigned char* lds, const int K_, const Sched& S, const Epi& E) {
    int K = K_; asm volatile("" : "+s"(K));
    const int tid = tid_opaque();
    const int wid = __builtin_amdgcn_readfirstlane(tid >> 6), lane = tid & 63, wr = wid >> 2, wc = wid & 3, fr = lane & 15, fq = lane >> 4;
    const int nt = K / BK8;
    unsigned voffA[2], voffB[2];
#pragma unroll
    for (int i = 0; i < 2; ++i) { int R, C; stage_rc(tid * 16 + i * 8192, R, C); const int Rb = Epi::PERM ? ((R & ~31) + perm32(R & 31)) : R;
        voffA[i] = (unsigned)(R * K + C) * 2u; voffB[i] = (unsigned)(Rb * K + C) * 2u; }
    const size_t kstep = (size_t)(BK8 * 2);
    const size_t hstep = (size_t)HALF * K * 2;
    const unsigned ldsw = (unsigned)wid * 1024u;
    const int aoff = lds_byte(wr * 64 + fr, fq * 8), boff = lds_byte(wc * 32 + fr, fq * 8);
#define PG8_SA(b, h) (((b) * 2 + (h)) * HTB)
#define PG8_SB(b, h) ((4 + (b) * 2 + (h)) * HTB)
#define PG8_STAGE(bufoff, gbase, voff) do { _Pragma("unroll") for (int _i = 0; _i < 2; ++_i) \
        __builtin_amdgcn_global_load_lds((const unsigned*)((const char*)(gbase) + (voff)[_i]), (PG8_LAS unsigned*)(lds + (bufoff) + ldsw + _i * 8192), 16, 0, 0); } while (0)
#define PG8_LDA(dst, b, h) do { _Pragma("unroll") for (int m = 0; m < 4; ++m) _Pragma("unroll") for (int k = 0; k < 2; ++k) dst[m][k] = *(const PG8_LAS bf16x8*)(lds + PG8_SA(b, h) + aoff + m * 2048 + k * 1024); } while (0)
#define PG8_LDB(dst, b, h) do { _Pragma("unroll") for (int n = 0; n < 2; ++n) _Pragma("unroll") for (int k = 0; k < 2; ++k) dst[n][k] = *(const PG8_LAS bf16x8*)(lds + PG8_SB(b, h) + boff + n * 2048 + k * 1024); } while (0)
#define PG8_MMA(ai, bj, At, Bt) do { __builtin_amdgcn_s_setprio(1); _Pragma("unroll") for (int m = 0; m < 4; ++m) _Pragma("unroll") for (int n = 0; n < 2; ++n) _Pragma("unroll") for (int k = 0; k < 2; ++k) \
        acc[ai][bj][m][n] = __builtin_amdgcn_mfma_f32_16x16x32_bf16(Bt[n][k], At[m][k], acc[ai][bj][m][n], 0, 0, 0); __builtin_amdgcn_s_setprio(0); } while (0)
#define PG8_WAIT_V(n) asm volatile("s_waitcnt vmcnt(" #n ")" ::: "memory")
#define PG8_WAIT_L(n) asm volatile("s_waitcnt lgkmcnt(" #n ")" ::: "memory")
#define PG8_BAR __builtin_amdgcn_s_barrier()
#define PG8_SCHED __builtin_amdgcn_sched_barrier(0)
    Unit cur, nxt; int ui = 0;
    if (!S.next(0, cur)) return;
    f32x4p acc[2][2][4][2];
#pragma unroll
    for (int a = 0; a < 2; ++a)
#pragma unroll
        for (int b = 0; b < 2; ++b)
#pragma unroll
            for (int m = 0; m < 4; ++m)
#pragma unroll
                for (int n = 0; n < 2; ++n) acc[a][b][m][n] = (f32x4p){0.f, 0.f, 0.f, 0.f};
    bf16x8 At[4][2], B0[2][2], B1[2][2];
    const char* cA = S.a_ptr(cur); const char* cB = S.b_ptr(cur);
    PG8_STAGE(PG8_SB(0, 0), cB, voffB); PG8_STAGE(PG8_SA(0, 0), cA, voffA); PG8_STAGE(PG8_SB(0, 1), cB + hstep, voffB); PG8_STAGE(PG8_SA(0, 1), cA + hstep, voffA);
    if (wr == 1) PG8_BAR;
    PG8_WAIT_V(4); PG8_BAR;
    PG8_STAGE(PG8_SB(1, 0), cB + kstep, voffB); PG8_STAGE(PG8_SA(1, 0), cA + kstep, voffA); PG8_STAGE(PG8_SB(1, 1), cB + hstep + kstep, voffB);
    PG8_WAIT_V(6); PG8_BAR;
    for (;;) {
        const bool has_next = S.next(ui + 1, nxt);
        const char* nA = has_next ? S.a_ptr(nxt) : cA; const char* nB = has_next ? S.b_ptr(nxt) : cB;
        for (int t = 0; t < nt; t += 2) {
            const bool last = (t == nt - 2);
            const char* a1 = cA + (size_t)(t + 1) * kstep;
            const char* a2 = last ? nA : cA + (size_t)(t + 2) * kstep; const char* b2 = last ? nB : cB + (size_t)(t + 2) * kstep;
            const char* a3 = a2 + kstep; const char* b3 = b2 + kstep;
            PG8_LDB(B0, 0, 0); PG8_SCHED; PG8_LDA(At, 0, 0); PG8_STAGE(PG8_SA(1, 1), a1 + hstep, voffA);
            PG8_WAIT_L(8); PG8_BAR; PG8_WAIT_L(0); PG8_MMA(0, 0, At, B0); PG8_BAR; PG8_SCHED;
            PG8_LDB(B1, 0, 1); PG8_STAGE(PG8_SB(0, 0), b2, voffB);
            PG8_BAR; PG8_WAIT_L(0); PG8_MMA(0, 1, At, B1); PG8_BAR;
            PG8_LDA(At, 0, 1); PG8_STAGE(PG8_SA(0, 0), a2, voffA);
            PG8_BAR; PG8_WAIT_L(0); PG8_MMA(1, 0, At, B0); PG8_BAR; PG8_SCHED;
            PG8_STAGE(PG8_SB(0, 1), b2 + hstep, voffB);
            PG8_WAIT_V(6); PG8_BAR; PG8_MMA(1, 1, At, B1); PG8_BAR;
            PG8_LDB(B0, 1, 0); PG8_SCHED; PG8_LDA(At, 1, 0); PG8_STAGE(PG8_SA(0, 1), a2 + hstep, voffA);
            PG8_WAIT_L(8); PG8_BAR; PG8_WAIT_L(0); PG8_MMA(0, 0, At, B0); PG8_BAR; PG8_SCHED;
            PG8_LDB(B1, 1, 1); PG8_STAGE(PG8_SB(1, 0), b3, voffB);
            PG8_BAR; PG8_WAIT_L(0); PG8_MMA(0, 1, At, B1); PG8_BAR;
            PG8_LDA(At, 1, 1); PG8_STAGE(PG8_SA(1, 0), a3, voffA);
            PG8_BAR; PG8_WAIT_L(0); PG8_MMA(1, 0, At, B0); PG8_BAR; PG8_SCHED;
            PG8_STAGE(PG8_SB(1, 1), b3 + hstep, voffB);
            PG8_WAIT_V(6); PG8_BAR; PG8_MMA(1, 1, At, B1); PG8_BAR;
        }
        if constexpr (!Epi::AFTER_DRAIN) E(acc, cur, wr, wc, fr, fq);
        if (!has_next) break;
#pragma unroll
        for (int a = 0; a < 2; ++a)
#pragma unroll
            for (int b = 0; b < 2; ++b)
#pragma unroll
                for (int m = 0; m < 4; ++m)
#pragma unroll
                    for (int n = 0; n < 2; ++n) acc[a][b][m][n] = (f32x4p){0.f, 0.f, 0.f, 0.f};
        cur = nxt; cA = nA; cB = nB; ++ui;
    }
    PG8_WAIT_V(0);
    if (wr == 0) PG8_BAR;
    PG8_BAR;
    if constexpr (Epi::AFTER_DRAIN) E.fused(acc, cur, wr, wc, fr, fq, lds, wid, lane);
#undef PG8_SA
#undef PG8_SB
#undef PG8_STAGE
#undef PG8_LDA
#undef PG8_LDB
#undef PG8_MMA
#undef PG8_WAIT_V
#undef PG8_WAIT_L
#undef PG8_BAR
#undef PG8_SCHED
}
}
typedef pg8::f32x4p f32x4p;
DI u32x4 pack8(const f32x4p& a, const f32x4p& b) { u32x4 w; w[0] = pack2(a[0], a[1]); w[1] = pack2(a[2], a[3]); w[2] = pack2(b[0], b[1]); w[3] = pack2(b[2], b[3]); return w; }

struct InprojSched {
  const char* u1b; const char* wt; int G, c;
  DI bool next(int i, pg8::Unit& u) const {
    const int L = i * G + c;
    if (L >= 384 + 1088) return false;
    if (L < 384) { u.kind = 0; pg8::tile_order(L, 6, 64, u.pm, u.pn); } else { u.kind = 1; pg8::tile_order(L - 384, 64, 17, u.pm, u.pn); }
    return true;
  }
  DI const char* a_ptr(const pg8::Unit& u) const { return u.kind == 0 ? wt + (size_t)u.pm * (256 * 1024 * 2) : u1b + (size_t)u.pm * (256 * 1024 * 2); }
  DI const char* b_ptr(const pg8::Unit& u) const { return u.kind == 0 ? u1b + (size_t)u.pn * (256 * 1024 * 2) : wt + (size_t)(1536 + u.pn * 256) * (1024 * 2); }
};
struct InprojEpi {
  static constexpr bool PERM = true, AFTER_DRAIN = false;
  ushort_t* ph; ushort_t* qkv; ushort_t* gate; const float* rope;
  DI void operator()(const f32x4p (&acc)[2][2][4][2], const pg8::Unit& u, int wr, int wc, int fr, int fq) const {
    if (u.kind == 0) {
      const int b = (u.pn * 256) >> 13;
      ushort_t* base = ph + ((size_t)(b * HYC + u.pm * 256 + wr * 64 + fr)) * S_ + ((u.pn * 256) & (S_ - 1)) + wc * 32 + 8 * fq;
#pragma unroll
      for (int ai = 0; ai < 2; ++ai)
#pragma unroll
        for (int m = 0; m < 4; ++m)
#pragma unroll
          for (int bj = 0; bj < 2; ++bj) *(u32x4*)(base + (size_t)(ai * 128 + m * 16) * S_ + bj * 128) = pack8(acc[ai][bj][m][0], acc[ai][bj][m][1]);
      return;
    }
    const int row0 = u.pm * 256 + wr * 64 + fr;
    if (u.pn < 9) {
      const int cq0 = u.pn * 256 + wc * 32 + 8 * fq;
      const bool rotw = (u.pn < 6) && ((wc & 1) == 0);
      const float qs = (u.pn < 3) ? 0.125f : 1.0f;
#pragma unroll
      for (int ai = 0; ai < 2; ++ai)
#pragma unroll
        for (int m = 0; m < 4; ++m) {
          const int row = row0 + ai * 128 + m * 16;
          f32x4p cs[4];
          if (rotw) {
#pragma unroll
            for (int q = 0; q < 4; ++q) cs[q] = *(const f32x4p*)(rope + (size_t)row * 16 + q * 4);
          }
#pragma unroll
          for (int bj = 0; bj < 2; ++bj) {
            f32x4p v0 = acc[ai][bj][m][0], v1 = acc[ai][bj][m][1];
            if (rotw) {
              f32x4p o0, o1;
#pragma unroll
              for (int j = 0; j < 4; ++j) { o0[j] = __shfl_xor(v0[j], 16); o1[j] = __shfl_xor(v1[j], 16); }
              if (fq < 2) {
                const float sg = (fq == 0) ? -1.f : 1.f;
#pragma unroll
                for (int j = 0; j < 4; ++j) {
                  const float c0 = cs[j >> 1][(j & 1) * 2], s0 = cs[j >> 1][(j & 1) * 2 + 1];
                  const float c1 = cs[2 + (j >> 1)][(j & 1) * 2], s1 = cs[2 + (j >> 1)][(j & 1) * 2 + 1];
                  v0[j] = v0[j] * c0 + sg * o0[j] * s0;
                  v1[j] = v1[j] * c1 + sg * o1[j] * s1;
                }
              }
            }
            *(u32x4*)(qkv + (size_t)row * QKVC + cq0 + bj * 128) = pack8(v0 * qs, v1 * qs);
          }
        }
    } else {
      const int cg0 = (u.pn - 9) * 256 + wc * 32 + 8 * fq;
#pragma unroll
      for (int ai = 0; ai < 2; ++ai)
#pragma unroll
        for (int m = 0; m < 4; ++m)
#pragma unroll
          for (int bj = 0; bj < 2; ++bj) {
            f32x4p v0 = acc[ai][bj][m][0], v1 = acc[ai][bj][m][1];
#pragma unroll
            for (int j = 0; j < 4; ++j) { v0[j] = 1.f / (1.f + __expf(-v0[j])); v1[j] = 1.f / (1.f + __expf(-v1[j])); }
            *(u32x4*)(gate + (size_t)(row0 + ai * 128 + m * 16) * GATEC + cg0 + bj * 128) = pack8(v0, v1);
          }
    }
  }
};
DI void phase_inproj(const P& p, char* smem) {
  InprojSched S{p.ws + OFF_U1B, p.ws + OFF_WIN_T, (int)gridDim.x, (int)blockIdx.x};
  InprojEpi E{(ushort_t*)(p.ws + OFF_PH), (ushort_t*)(p.ws + OFF_QKV), (ushort_t*)(p.ws + OFF_GATE), (const float*)(p.ws + OFF_ROPE)};
  pg8::gemm_phase(( __attribute__((address_space(3))) unsigned char*)smem, 1024, S, E);
}
struct PlainSched {
  const char* A; const char* Bt; int nM, nN, K, G, c;
  DI bool next(int i, pg8::Unit& u) const { const int L = i * G + c; if (L >= nM * nN) return false; u.kind = 0; pg8::tile_order(L, nM, nN, u.pm, u.pn); return true; }
  DI const char* a_ptr(const pg8::Unit& u) const { return A + (size_t)u.pm * 256 * K * 2; }
  DI const char* b_ptr(const pg8::Unit& u) const { return Bt + (size_t)u.pn * 256 * K * 2; }
};
struct OutprojEpi {
  static constexpr bool PERM = false, AFTER_DRAIN = false;
  const float* x; float* out; const float* ada;
  DI void operator()(const f32x4p (&acc)[2][2][4][2], const pg8::Unit& u, int wr, int wc, int fr, int fq) const {
    const int row0 = u.pm * 256 + wr * 64 + fr, col0 = u.pn * 256 + wc * 32 + 4 * fq, b = (u.pm * 256) / S_;
    f32x4p g1[2][2];
#pragma unroll
    for (int bj = 0; bj < 2; ++bj)
#pragma unroll
      for (int n = 0; n < 2; ++n) g1[bj][n] = *(const f32x4p*)(ada + b * 6144 + 2 * 1024 + col0 + bj * 128 + n * 16) + 1.0f;
#pragma unroll
    for (int ai = 0; ai < 2; ++ai)
#pragma unroll
      for (int m = 0; m < 4; ++m) {
        const size_t ro = (size_t)(row0 + ai * 128 + m * 16) * 1024 + col0;
#pragma unroll
        for (int bj = 0; bj < 2; ++bj)
#pragma unroll
          for (int n = 0; n < 2; ++n) {
            const f32x4p xv = *(const f32x4p*)(x + ro + bj * 128 + n * 16);
            *(f32x4p*)(out + ro + bj * 128 + n * 16) = xv * DN_ALPHA + g1[bj][n] * acc[ai][bj][m][n];
          }
      }
  }
};
DI void phase_outproj(const P& p, char* smem) {
  PlainSched S{p.ws + OFF_MERGED, p.ws + OFF_WOUT_T, 64, 4, 1024, (int)gridDim.x, (int)blockIdx.x};
  OutprojEpi E{p.x, p.out, (const float*)(p.ws + OFF_ADA)};
  pg8::gemm_phase(( __attribute__((address_space(3))) unsigned char*)smem, 1024, S, E);
}

DI float sconv_t(const ushort_t* row, int t, float w0, float w1, float w2, float cb) {
  const float xm = bf2f(row[max(t - 1, 0)]), x0 = bf2f(row[t]), xp = bf2f(row[min(t + 1, S_ - 1)]);
  return cb + w1 * x0 + ((t > 0) ? w0 : 0.f) * xm + ((t < S_ - 1) ? w2 : 0.f) * xp;
}
DI void fft_C_mul_invC(cf2* lds, const cf2* __restrict__ kq, int tid, int o) {
  asm volatile("" : "+v"(tid));
  const int k1 = tid >> 5, k2 = tid & 31;
  const float sgn = o ? 1.f : -1.f;
#pragma unroll
  for (int h = 0; h < 2; ++h) {
    float tr[16], ti[16];
    cf2 kv[16], km[16];
#pragma unroll
    for (int i = 0; i < 16; ++i) {
      kv[i] = kq[(h * 16 + i) * 512 + tid];
      const int f = (k1 + 16 * h) + 32 * k2 + 1024 * brev(i, 4);
      const int fm = (16384 - f) & 16383;
      const int q1 = fm & 31, q2 = (fm >> 5) & 31, q3 = fm >> 10;
      const int rr = (q1 >> 4) * 16 + (int)(__builtin_bitreverse32((unsigned)q3) >> 28);
      km[i] = kq[rr * 512 + (q1 & 15) * 32 + q2];
    }
    cf2* blk = lds + (k1 + 16 * h) * FFT_SA + k2 * 17;
#pragma unroll
    for (int mp = 0; mp < 16; ++mp) { cf2 v = blk[mp]; tr[mp] = v.x; ti[mp] = v.y; }
    dft_fwd<16, false>(tr, ti);
#pragma unroll
    for (int i = 0; i < 16; ++i) {
      const float a = kv[i].x, b = kv[i].y, c = km[i].x, d = km[i].y;
      const float kx = o ? 0.5f * (b + d) : 0.5f * (a + c);
      const float ky = o ? 0.5f * (c - a) : 0.5f * (b - d);
      const float x = tr[i], y = ti[i];
      tr[i] = x * kx - y * ky; ti[i] = x * ky + y * kx;
    }
    dft_inv<16>(tr, ti);
#pragma unroll
    for (int mp = 0; mp < 16; ++mp) { cf2 ov; ov.x = tr[mp]; ov.y = ti[mp]; blk[mp] = ov; }
  }
  (void)sgn;
}
DI void hyena_item(const P& p, char* smem, int c) {
  cf2* lds = (cf2*)smem;
  const ushort_t* pht = (const ushort_t*)(p.ws + OFF_PH);
  ushort_t* yht = (ushort_t*)(p.ws + OFF_YH);
  cf2* kq = (cf2*)(p.ws + (blockIdx.x < 92 ? OFF_WIN_T + (size_t)blockIdx.x * 131072 : OFF_HSCR + (size_t)(blockIdx.x - 92) * 131072));
  const float* filt = p.out;
  const int tid0 = tid_opaque();
  float zr[32], zi[32];
  __syncthreads();
  {
    int tid = tid0; asm volatile("" : "+v"(tid));
    float kr[32], ki[32];
    const float* fw0 = filt + (size_t)(0 * 1024 + 0 * 512 + c) * S_;
    const float* bw0 = filt + (size_t)(1 * 1024 + 0 * 512 + c) * S_;
    const float* fw1 = filt + (size_t)(0 * 1024 + 1 * 512 + c) * S_;
    const float* bw1 = filt + (size_t)(1 * 1024 + 1 * 512 + c) * S_;
#pragma unroll
    for (int n1 = 0; n1 < 16; ++n1) { kr[n1] = fw0[n1 * 512 + tid] * (1.0f / 16384.0f); ki[n1] = fw1[n1 * 512 + tid] * (1.0f / 16384.0f); }
    if (tid == 0) { kr[0] += p.hy_bias[c] * (1.0f / 16384.0f); ki[0] += p.hy_bias[512 + c] * (1.0f / 16384.0f); }
#pragma unroll
    for (int n1 = 16; n1 < 32; ++n1) {
      const int n = n1 * 512 + tid;
      const float zs = (n == S_) ? 0.f : (1.0f / 16384.0f);
      const int nb_ = min(2 * S_ - n, S_ - 1);
      kr[n1] = bw0[nb_] * zs;
      ki[n1] = bw1[nb_] * zs;
    }
    fft_fwdA<false>(kr, ki, lds, tid); __syncthreads();
    fft_B_read(kr, ki, lds, tid); __syncthreads();
    fft_fwdB_write(kr, ki, lds, tid); __syncthreads();
    fft_fwdC(kr, ki, lds, tid);
    int ts = tid; asm volatile("" : "+v"(ts));
    cf2* kqt = kq + ts;
#pragma unroll
    for (int r = 0; r < 32; ++r) { cf2 v; v.x = kr[r]; v.y = ki[r]; kqt[r * 512] = v; }
    __syncthreads();
  }
#pragma unroll 1
  for (int o = 0; o < 2; ++o) {
    int tid = tid0; asm volatile("" : "+v"(tid));
    asm volatile("" : "+v"(tid));
    if (o == 0) {
      const float w0 = p.hy_conv_w[c], w1 = p.hy_conv_w[HYC + c], w2 = p.hy_conv_w[2 * HYC + c], cb = p.hy_conv_b[c];
      const ushort_t* r0 = pht + (size_t)(0 * HYC + c) * S_;
      const ushort_t* r1 = pht + (size_t)(1 * HYC + c) * S_;
#pragma unroll
      for (int n1 = 0; n1 < 16; ++n1) {
        const int t = n1 * 512 + tid;
        zr[n1] = sconv_t(r0, t, w0, w1, w2, cb); zi[n1] = sconv_t(r1, t, w0, w1, w2, cb);
        if (n1 & 1) asm volatile("" ::: "memory");
      }
    }
#pragma unroll
    for (int n1 = 16; n1 < 32; ++n1) { zr[n1] = 0.f; zi[n1] = 0.f; }
    fft_fwdA<true>(zr, zi, lds, tid); __syncthreads();
    fft_B_read(zr, zi, lds, tid); __syncthreads();
    fft_fwdB_write(zr, zi, lds, tid); __syncthreads();
    fft_C_mul_invC(lds, kq, tid, o); __syncthreads();
    fft_invB_read(zr, zi, lds, tid); __syncthreads();
    fft_invB_write(zr, zi, lds, tid); __syncthreads();
    fft_invA(zr, zi, lds, tid);
    int tg = tid; asm volatile("" : "+v"(tg));
    const int gch = (o + 1) * 512 + c;
    const float w0 = p.hy_conv_w[gch], w1 = p.hy_conv_w[HYC + gch], w2 = p.hy_conv_w[2 * HYC + gch], cb = p.hy_conv_b[gch];
    const ushort_t* g0 = pht + (size_t)(0 * HYC + gch) * S_;
    const ushort_t* g1 = pht + (size_t)(1 * HYC + gch) * S_;
#pragma unroll
    for (int n1 = 0; n1 < 16; ++n1) {
      const int t = n1 * 512 + tg;
      zr[n1] *= sconv_t(g0, t, w0, w1, w2, cb);
      zi[n1] *= sconv_t(g1, t, w0, w1, w2, cb);
      if (n1 & 1) asm volatile("" ::: "memory");
    }
    if (o == 1) {
#pragma unroll
      for (int n1 = 0; n1 < 16; ++n1) {
        const int t = n1 * 512 + tg;
        yht[(size_t)(0 * HW_ + c) * S_ + t] = f2bf(zr[n1]);
        yht[(size_t)(1 * HW_ + c) * S_ + t] = f2bf(zi[n1]);
      }
    }
  }
}

constexpr int ATT_VROW = 192;
constexpr int ATT_VBUF = 32 * ATT_VROW;
DI void attn_item(const P& p, char* smem, int item) {
  const ushort_t* qkv = (const ushort_t*)(p.ws + OFF_QKV);
  ushort_t* ya = (ushort_t*)(p.ws + OFF_YA);
  const int tid = tid_opaque(), lane = tid & 63, wave = tid >> 6;
  const int u = item * 8 + wave;
  const int hs = u & 3, r16 = (u >> 2) & 15, chunk = (u >> 6) & 15, b = u >> 10;
  const int qi = lane & 31, h = lane >> 5;
  char* vl = smem + wave * ATT_VBUF;
  const int tq = chunk * 512 + r16 + 16 * qi;
  const size_t bbase = (size_t)b * S_;
  f32x16 o0, o1;
#pragma unroll
  for (int r = 0; r < 16; ++r) { o0[r] = 0.f; o1[r] = 0.f; }
  float m = -1e30f, l = 0.f;
  const int g16 = (lane >> 4) & 1, q4 = (lane & 15) >> 2, p4 = lane & 3;
  __syncthreads();
#pragma unroll 1
  for (int g = 0; g < 3; ++g) {
    const int dsh = 2 * g;
    const int d = 1 << dsh, sd = 16 >> dsh, n = S_ >> dsh;
    const int head = g * 4 + hs;
    const int rc = r16 & (d - 1);
    const int P0 = (chunk * 512 + r16 - rc) >> dsh;
    const int pq = P0 + sd * qi;
    const int KB = P0 - 64;
    const int ntile = (g == 0) ? 20 : (g == 1 ? 8 : 5);
    bf16x8 bq[4];
    {
      const ushort_t* qrow = qkv + (bbase + tq) * QKVC + head * 64;
#pragma unroll
      for (int s = 0; s < 4; ++s) bq[s] = *(const bf16x8*)(qrow + (2 * s + h) * 8);
    }
    bf16x8 kA[4], kB[4]; u32x4 vA[4], vB[4];
#define ATT_LOAD(KR, VR, KT) { const int kb1_ = KB + 32 * (KT); const int kp_ = min(max(kb1_ + qi, 0), n - 1); \
      const ushort_t* krow_ = qkv + (bbase + rc + ((size_t)kp_ << dsh)) * QKVC + 768 + head * 64; \
      _Pragma("unroll") for (int s = 0; s < 4; ++s) KR[s] = *(const bf16x8*)(krow_ + (2 * s + h) * 8); \
      _Pragma("unroll") for (int i = 0; i < 4; ++i) { const int c_ = lane + 64 * i, row_ = c_ >> 3, ch_ = c_ & 7; const int vp_ = min(max(kb1_ + row_, 0), n - 1); \
        VR[i] = *(const u32x4*)(qkv + (bbase + rc + ((size_t)vp_ << dsh)) * QKVC + 1536 + head * 64 + ch_ * 8); } }
    auto tile = [&](const bf16x8 (&kc)[4], const u32x4 (&vc)[4], const int kt) {
      f32x16 st;
#pragma unroll
      for (int r = 0; r < 16; ++r) st[r] = 0.f;
#pragma unroll
      for (int s = 0; s < 4; ++s) st = __builtin_amdgcn_mfma_f32_32x32x16_bf16(kc[s], bq[s], st, 0, 0, 0);
#pragma unroll
      for (int i = 0; i < 4; ++i) { const int c = lane + 64 * i; *(u32x4*)(vl + (c >> 3) * ATT_VROW + (c & 7) * 16) = vc[i]; }
      const int kb = KB + 32 * kt + 4 * h;
      const int dk = kb - pq;
      float mx = -1e30f;
      bool ok[16];
#pragma unroll
      for (int r = 0; r < 16; ++r) {
        const int cr = (r & 3) + 8 * (r >> 2);
        ok[r] = ((unsigned)(dk + cr + 64) <= 128u) && ((unsigned)(kb + cr) < (unsigned)n);
        mx = fmaxf(mx, ok[r] ? st[r] : -1e30f);
      }
      mx = fmaxf(mx, __shfl_xor(mx, 32));
      const float mnew = fmaxf(m, mx);
      const float corr = __expf(m - mnew);
      float ps = 0.f;
      float pv[16];
#pragma unroll
      for (int r = 0; r < 16; ++r) { pv[r] = ok[r] ? __expf(st[r] - mnew) : 0.f; ps += pv[r]; }
      ps += __shfl_xor(ps, 32);
      l = l * corr + ps; m = mnew;
#pragma unroll
      for (int r = 0; r < 16; ++r) { o0[r] *= corr; o1[r] *= corr; }
      bf16x8 pf[2];
#pragma unroll
      for (int s = 0; s < 2; ++s) {
        u32x4 w;
        w[0] = pack2(pv[8 * s + 0], pv[8 * s + 1]); w[1] = pack2(pv[8 * s + 2], pv[8 * s + 3]);
        w[2] = pack2(pv[8 * s + 4], pv[8 * s + 5]); w[3] = pack2(pv[8 * s + 6], pv[8 * s + 7]);
        pf[s] = __builtin_bit_cast(bf16x8, w);
      }
      __builtin_amdgcn_wave_barrier();
      asm volatile("s_waitcnt lgkmcnt(0)" ::: "memory");
#pragma unroll
      for (int s = 0; s < 2; ++s) {
#pragma unroll
        for (int nt = 0; nt < 2; ++nt) {
          const char* a0 = vl + (16 * s + 4 * h + q4) * ATT_VROW + (32 * nt + 16 * g16 + 4 * p4) * 2;
          s16x4 lo = __builtin_amdgcn_ds_read_tr16_b64_v4i16((__attribute__((address_space(3))) s16x4*)(a0));
          s16x4 hi = __builtin_amdgcn_ds_read_tr16_b64_v4i16((__attribute__((address_space(3))) s16x4*)(a0 + 8 * ATT_VROW));
          const bf16x8 vf = __builtin_shufflevector(lo, hi, 0, 1, 2, 3, 4, 5, 6, 7);
          if (nt == 0) o0 = __builtin_amdgcn_mfma_f32_32x32x16_bf16(vf, pf[s], o0, 0, 0, 0);
          else o1 = __builtin_amdgcn_mfma_f32_32x32x16_bf16(vf, pf[s], o1, 0, 0, 0);
        }
      }
      __builtin_amdgcn_wave_barrier();
      asm volatile("s_waitcnt lgkmcnt(0)" ::: "memory");
    };
    ATT_LOAD(kA, vA, 0)
#pragma unroll 1
    for (int kt = 0; kt < ntile; kt += 2) {
      ATT_LOAD(kB, vB, min(kt + 1, ntile - 1))
      tile(kA, vA, kt);
      ATT_LOAD(kA, vA, min(kt + 2, ntile - 1))
      if (kt + 1 < ntile) tile(kB, vB, kt + 1);
    }
#undef ATT_LOAD
  }
  const float il = 1.f / l;
  ushort_t* op = ya + (bbase + tq) * 256 + hs * 64;
#pragma unroll
  for (int gq = 0; gq < 4; ++gq) {
    uint2 w0, w1;
    w0.x = pack2(o0[4 * gq] * il, o0[4 * gq + 1] * il); w0.y = pack2(o0[4 * gq + 2] * il, o0[4 * gq + 3] * il);
    w1.x = pack2(o1[4 * gq] * il, o1[4 * gq + 1] * il); w1.y = pack2(o1[4 * gq + 2] * il, o1[4 * gq + 3] * il);
    *(uint2*)(op + 8 * gq + 4 * h) = w0;
    *(uint2*)(op + 32 + 8 * gq + 4 * h) = w1;
  }
}

DI void phase_yh_transpose(const P& p, char* smem) {
  const ushort_t* yht = (const ushort_t*)(p.ws + OFF_YH);
  ushort_t* yhk = (ushort_t*)(p.ws + OFF_YHK);
  const int tid = tid_opaque();
  for (int item = blockIdx.x; item < 1024; item += gridDim.x) {
    const int cg = item & 15, tc = item >> 4, b = tc >> 5, t0 = (tc * 256) & (S_ - 1);
    __syncthreads();
    {
      const int ch = tid >> 4, k16 = tid & 15;
      const ushort_t* srcp = yht + (size_t)(b * HW_ + cg * 32 + ch) * S_ + t0;
#pragma unroll
      for (int i = 0; i < 2; ++i) *(u32x4*)(smem + ch * 528 + (k16 + 16 * i) * 16) = *(const u32x4*)(srcp + (k16 + 16 * i) * 8);
    }
    __syncthreads();
    {
      const int t = tid >> 1, half = tid & 1;
      unsigned w[8];
#pragma unroll
      for (int k = 0; k < 8; ++k) {
        const unsigned lo = *(const ushort_t*)(smem + (half * 16 + 2 * k) * 528 + t * 2);
        const unsigned hi = *(const ushort_t*)(smem + (half * 16 + 2 * k + 1) * 528 + t * 2);
        w[k] = lo | (hi << 16);
      }
      ushort_t* dst = yhk + (size_t)(tc * 256 + t) * HW_ + cg * 32 + half * 16;
      u32x4 o0, o1; o0[0] = w[0]; o0[1] = w[1]; o0[2] = w[2]; o0[3] = w[3]; o1[0] = w[4]; o1[1] = w[5]; o1[2] = w[6]; o1[3] = w[7];
      *(u32x4*)dst = o0; *(u32x4*)(dst + 8) = o1;
    }
  }
}
DI f32x4p bf4lo(const u32x4& w) { f32x4p r; r[0] = __uint_as_float(w[0] << 16); r[1] = __uint_as_float(w[0] & 0xffff0000u); r[2] = __uint_as_float(w[1] << 16); r[3] = __uint_as_float(w[1] & 0xffff0000u); return r; }
DI f32x4p bf4hi(const u32x4& w) { f32x4p r; r[0] = __uint_as_float(w[2] << 16); r[1] = __uint_as_float(w[2] & 0xffff0000u); r[2] = __uint_as_float(w[3] << 16); r[3] = __uint_as_float(w[3] & 0xffff0000u); return r; }
template <bool ADD>
struct MergeEpi {
  static constexpr bool PERM = true, AFTER_DRAIN = false;
  const ushort_t* gate; ushort_t* merged;
  DI void operator()(const f32x4p (&acc)[2][2][4][2], const pg8::Unit& u, int wr, int wc, int fr, int fq) const {
    const ushort_t* gb = gate + (size_t)(u.pm * 256) * GATEC + u.pn * 256;
    ushort_t* mb = merged + (size_t)(u.pm * 256) * 1024 + u.pn * 256;
    const unsigned lg = (unsigned)((wr * 64 + fr) * GATEC + wc * 32 + 8 * fq), lm = (unsigned)((wr * 64 + fr) * 1024 + wc * 32 + 8 * fq);
#pragma unroll
    for (int ai = 0; ai < 2; ++ai)
#pragma unroll
      for (int m = 0; m < 4; ++m) {
#pragma unroll
        for (int bj = 0; bj < 2; ++bj) {
          const u32x4 gw = *(const u32x4*)(gb + (ai * 128 + m * 16) * GATEC + bj * 128 + lg);
          f32x4p v0 = bf4lo(gw) * acc[ai][bj][m][0], v1 = bf4hi(gw) * acc[ai][bj][m][1];
          ushort_t* mp = mb + (ai * 128 + m * 16) * 1024 + bj * 128 + lm;
          if (ADD) { const u32x4 mw = *(const u32x4*)mp; v0 += bf4lo(mw); v1 += bf4hi(mw); }
          *(u32x4*)mp = pack8(v0, v1);
        }
        asm volatile("" ::: "memory");
      }
  }
};
DI void phase_merge(const P& p, char* smem) {
  {
    PlainSched S{p.ws + OFF_YHK, p.ws + OFF_WBH_T, 64, 4, 512, (int)gridDim.x, (int)blockIdx.x};
    MergeEpi<false> E{(const ushort_t*)(p.ws + OFF_GATE), (ushort_t*)(p.ws + OFF_MERGED)};
    pg8::gemm_phase(( __attribute__((address_space(3))) unsigned char*)smem, 512, S, E);
  }
  {
    PlainSched S{p.ws + OFF_YA, p.ws + OFF_WBA_T, 64, 4, 256, (int)gridDim.x, (int)blockIdx.x};
    MergeEpi<true> E{(const ushort_t*)(p.ws + OFF_GATE) + 1024, (ushort_t*)(p.ws + OFF_MERGED)};
    pg8::gemm_phase(( __attribute__((address_space(3))) unsigned char*)smem, 256, S, E);
  }
}

DI void phase_ln(float* __restrict__ xio, const float* __restrict__ g, const float* __restrict__ bta) {
  const int tq = tid_opaque(); const int lane = tq & 63, wave = tq >> 6;
  for (int row = blockIdx.x * 8 + wave; row < T_; row += gridDim.x * 8) {
    float* rp = xio + (size_t)row * 1024;
    f32x4 v[4];
    float s = 0.f;
#pragma unroll
    for (int i = 0; i < 4; ++i) { v[i] = *(const f32x4*)(rp + i * 256 + lane * 4); s += v[i][0] + v[i][1] + v[i][2] + v[i][3]; }
    const float mu = wave_sum(s) * (1.f / 1024.f);
    float q = 0.f;
#pragma unroll
    for (int i = 0; i < 4; ++i)
#pragma unroll
      for (int j = 0; j < 4; ++j) { float d = v[i][j] - mu; q += d * d; }
    const float rs = rsqrtf(wave_sum(q) * (1.f / 1024.f) + LN_EPS);
#pragma unroll
    for (int i = 0; i < 4; ++i) {
      f32x4 gg = *(const f32x4*)(g + i * 256 + lane * 4), bb = *(const f32x4*)(bta + i * 256 + lane * 4), o;
#pragma unroll
      for (int j = 0; j < 4; ++j) o[j] = (v[i][j] - mu) * rs * gg[j] + bb[j];
      *(f32x4*)(rp + i * 256 + lane * 4) = o;
    }
  }
}

DI int swz256(int row, int ch) { return row * 256 + ((ch ^ (row & 15)) << 4); }
DI void ins16(float (&L)[16], float x) {
#pragma unroll
  for (int i = 0; i < 16; ++i) { const float hi = __builtin_fmaxf(L[i], x); x = __builtin_fminf(L[i], x); L[i] = hi; }
}
DI void bitonic16_desc(float (&M)[16]) {
#pragma unroll
  for (int d = 8; d >= 1; d >>= 1)
#pragma unroll
    for (int i = 0; i < 16; ++i)
      if ((i & d) == 0) { const float a = M[i], b = M[i + d]; M[i] = __builtin_fmaxf(a, b); M[i + d] = __builtin_fminf(a, b); }
}
constexpr int ROUTE_Q_OFF = 0, ROUTE_K_OFF = 65536, ROUTE_IDX_OFF = 98304;
struct OneUnitSched {
  const char* A; const char* Bt; int pm, pn;
  DI bool next(int i, pg8::Unit& u) const { if (i != 0) return false; u.pm = pm; u.pn = pn; u.kind = 0; return true; }
  DI const char* a_ptr(const pg8::Unit& u) const { return A + (size_t)u.pm * 256 * 1024 * 2; }
  DI const char* b_ptr(const pg8::Unit& u) const { return Bt + (size_t)u.pn * 256 * 1024 * 2; }
};
struct RouteEpi {
  static constexpr bool PERM = false, AFTER_DRAIN = true;
  const ushort_t* keysb; int* idx; float* gv;
  DI void operator()(const f32x4p (&)[2][2][4][2], const pg8::Unit&, int, int, int, int) const {}
  DI void fused(const f32x4p (&acc)[2][2][4][2], const pg8::Unit& u, int wr, int wc, int fr, int fq, PG8_LAS unsigned char* ldsp, int wave, int lane) const {
    char* smem = (char*)ldsp;
    const int tid = wave * 64 + lane;
    const int m0 = u.pm * 256, hh = u.pn;
    float L0[16];
#pragma unroll
    for (int pp = 0; pp < 2; ++pp) {
      const int hp = hh * 2 + pp;
      if (pp == 1) __syncthreads();
#pragma unroll
      for (int ai = 0; ai < 2; ++ai)
#pragma unroll
        for (int m = 0; m < 4; ++m) {
          const int tok = 128 * ai + 64 * wr + 16 * m + fr;
#pragma unroll
          for (int n = 0; n < 2; ++n) {
            const int ch = 4 * wc + 2 * n + (fq >> 1);
            uint2 v; v.x = pack2(acc[ai][pp][m][n][0], acc[ai][pp][m][n][1]); v.y = pack2(acc[ai][pp][m][n][2], acc[ai][pp][m][n][3]);
            *(uint2*)(smem + ROUTE_Q_OFF + swz256(tok, ch) + 8 * (fq & 1)) = v;
          }
        }
#pragma unroll
      for (int i = 0; i < 4; ++i) {
        const int q = tid + 512 * i, row = q >> 4, ch = q & 15;
        *(u32x4*)(smem + ROUTE_K_OFF + swz256(row, ch)) = *(const u32x4*)(keysb + (size_t)hp * 16384 + row * 128 + ch * 8);
      }
      __syncthreads();
      f32x16 sc[4];
#pragma unroll
      for (int ks = 0; ks < 4; ++ks)
#pragma unroll
        for (int r = 0; r < 16; ++r) sc[ks][r] = 0.f;
#pragma unroll
      for (int s = 0; s < 8; ++s) {
        const int ch = 2 * s + (lane >> 5);
        const bf16x8 bq = *(const bf16x8*)(smem + ROUTE_Q_OFF + swz256(wave * 32 + (lane & 31), ch));
#pragma unroll
        for (int ks = 0; ks < 4; ++ks) {
          const bf16x8 ak = *(const bf16x8*)(smem + ROUTE_K_OFF + swz256(ks * 32 + (lane & 31), ch));
          sc[ks] = __builtin_amdgcn_mfma_f32_32x32x16_bf16(ak, bq, sc[ks], 0, 0, 0);
        }
      }
      float L[16];
#pragma unroll
      for (int i = 0; i < 16; ++i) L[i] = -3.0e38f;
      const unsigned hbit = (unsigned)(lane >> 5) << 2;
#pragma unroll
      for (int ks = 0; ks < 4; ++ks)
#pragma unroll
        for (int r = 0; r < 16; ++r) {
          const unsigned key = (unsigned)(ks * 32 + (r & 3) + 8 * (r >> 2)) | hbit;
          ins16(L, __uint_as_float((__float_as_uint(sc[ks][r]) & ~127u) | key));
        }
      {
        float M[16];
#pragma unroll
        for (int i = 0; i < 16; ++i) M[i] = __builtin_fmaxf(L[i], __shfl_xor(L[15 - i], 32));
        bitonic16_desc(M);
#pragma unroll
        for (int i = 0; i < 16; ++i) L[i] = M[i];
      }
      if (pp == 0) {
#pragma unroll
        for (int i = 0; i < 16; ++i) L0[i] = L[i];
      } else {
        unsigned char* ib = (unsigned char*)(smem + ROUTE_IDX_OFF) + tid * 32;
#pragma unroll
        for (int i = 0; i < 16; ++i) { ib[i] = (unsigned char)(__float_as_uint(L0[i]) & 127u); ib[16 + i] = (unsigned char)(__float_as_uint(L[i]) & 127u); }
        float F[16];
#pragma unroll
        for (int i = 0; i < 16; ++i) F[i] = -3.0e38f;
#pragma unroll
        for (int i = 0; i < 16; ++i) {
          const float ai_ = __uint_as_float(__float_as_uint(L0[i]) & ~127u);
#pragma unroll
          for (int jj = 0; jj < 16; ++jj)
            if ((i + 1) * (jj + 1) <= 16) {
              const float s = ai_ + __uint_as_float(__float_as_uint(L[jj]) & ~127u);
              ins16(F, __uint_as_float((__float_as_uint(s) & ~255u) | (unsigned)(i * 16 + jj)));
            }
        }
        const float mx = __uint_as_float(__float_as_uint(F[0]) & ~255u);
        float e[16], sum = 0.f;
#pragma unroll
        for (int k = 0; k < 16; ++k) { e[k] = __expf(__uint_as_float(__float_as_uint(F[k]) & ~255u) - mx); sum += e[k]; }
        const float inv = 1.f / sum;
        if (lane < 32) {
          const int tok = m0 + wave * 32 + lane;
          int* ip = idx + (size_t)tok * 128 + hh * 16;
          float* gp = gv + (size_t)tok * 128 + hh * 16;
#pragma unroll
          for (int k4 = 0; k4 < 4; ++k4) {
            int4 iv; f32x4 g4;
            int ee[4];
#pragma unroll
            for (int uu = 0; uu < 4; ++uu) {
              const unsigned code = __float_as_uint(F[k4 * 4 + uu]) & 255u;
              ee[uu] = (int)ib[code >> 4] * 128 + (int)ib[16 + (code & 15u)];
              g4[uu] = e[k4 * 4 + uu] * inv;
            }
            iv.x = ee[0]; iv.y = ee[1]; iv.z = ee[2]; iv.w = ee[3];
            *(int4*)(ip + k4 * 4) = iv;
            *(f32x4*)(gp + k4 * 4) = g4;
          }
        }
      }
    }
    __syncthreads();
  }
};
DI void phase_route(const P& p, char* smem) {
  for (int item = blockIdx.x; item < (T_ / 256) * 8; item += gridDim.x) {
    OneUnitSched S{p.ws + OFF_U2B, p.ws + OFF_WQ_T, item >> 3, item & 7};
    RouteEpi E{(const ushort_t*)(p.ws + OFF_KEYS_B), (int*)(p.ws + OFF_IDX), (float*)(p.ws + OFF_GV)};
    pg8::gemm_phase((__attribute__((address_space(3))) unsigned char*)smem, 1024, S, E);
  }
}

DI void phase_rope(const P& p) {
  float* rt = (float*)(p.ws + OFF_ROPE);
  for (int i = blockIdx.x * NT + tid_opaque(); i < T_ * 8; i += gridDim.x * NT) {
    const float inv = expf(-13.122363377404328f * (float)(i & 7) * 0.125f);
    const float x = (float)p.pos[i >> 3] * inv;
    const float k = rintf(x * 0.15915494309189535f);
    float r = fmaf(-k, 6.28125f, x);
    r = fmaf(-k, 1.9353071795864769e-3f, r);
    float sn, cs; __sincosf(r, &sn, &cs);
    rt[2 * i] = cs; rt[2 * i + 1] = sn;
  }
}
DI void phase_keys(const P& p) {
  ushort_t* keysb = (ushort_t*)(p.ws + OFF_KEYS_B);
  for (int i = blockIdx.x * NT + tid_opaque(); i < 16 * 128 * 128 / 4; i += gridDim.x * NT) {
    f32x4 v = *(const f32x4*)(p.keys + (size_t)i * 4);
    uint2 o; o.x = pack2(v[0], v[1]); o.y = pack2(v[2], v[3]);
    *(uint2*)(keysb + (size_t)i * 4) = o;
  }
}

typedef __bf16 bf16x2_t __attribute__((ext_vector_type(2)));
DI float dot2bf(unsigned a, unsigned b, float c) { return __builtin_amdgcn_fdot2_f32_bf16(__builtin_bit_cast(bf16x2_t, a), __builtin_bit_cast(bf16x2_t, b), c, false); }
DI void phase_ln1(const P& p) {
  const float* ada = (const float*)(p.ws + OFF_ADA);
  ushort_t* u2b = (ushort_t*)(p.ws + OFF_U2B);
  const int tq = tid_opaque(); const int lane = tq & 63, wave = tq >> 6;
  for (int row = blockIdx.x * 8 + wave; row < T_; row += gridDim.x * 8) {
    const int b = row / S_;
    float* rp = p.out + (size_t)row * 1024;
    f32x4 v[4];
    float s = 0.f;
#pragma unroll
    for (int i = 0; i < 4; ++i) { v[i] = *(const f32x4*)(rp + i * 256 + lane * 4); s += v[i][0] + v[i][1] + v[i][2] + v[i][3]; }
    const float mu = wave_sum(s) * (1.f / 1024.f);
    float q = 0.f;
#pragma unroll
    for (int i = 0; i < 4; ++i)
#pragma unroll
      for (int j = 0; j < 4; ++j) { float d = v[i][j] - mu; q += d * d; }
    const float rs = rsqrtf(wave_sum(q) * (1.f / 1024.f) + LN_EPS);
#pragma unroll
    for (int i = 0; i < 4; ++i) {
      const int col = i * 256 + lane * 4;
      f32x4 gg = *(const f32x4*)(p.ln1_g + col), bb = *(const f32x4*)(p.ln1_b + col), o;
      f32x4 sc = *(const f32x4*)(ada + b * 6144 + 4 * 1024 + col), sh = *(const f32x4*)(ada + b * 6144 + 3 * 1024 + col);
#pragma unroll
      for (int j = 0; j < 4; ++j) o[j] = (v[i][j] - mu) * rs * gg[j] + bb[j];
      *(f32x4*)(rp + col) = o;
      uint2 w; w.x = pack2(o[0] * (1.f + sc[0]) + sh[0], o[1] * (1.f + sc[1]) + sh[1]); w.y = pack2(o[2] * (1.f + sc[2]) + sh[2], o[3] * (1.f + sc[3]) + sh[3]);
      *(uint2*)(u2b + (size_t)row * 1024 + col) = w;
    }
  }
}
DI float wave_max(float v) {
#pragma unroll
  for (int o = 32; o > 0; o >>= 1) v = fmaxf(v, __shfl_xor(v, o));
  return v;
}
DI unsigned pack4_fp8(float a, float b, float c, float d) {
  int w = 0;
  w = __builtin_amdgcn_cvt_pk_fp8_f32(a, b, w, false);
  w = __builtin_amdgcn_cvt_pk_fp8_f32(c, d, w, true);
  return (unsigned)w;
}
DI void phase_tabconv(const P& p) {
  unsigned char* tu = (unsigned char*)(p.ws + OFF_TABU);
  unsigned char* tv = (unsigned char*)(p.ws + OFF_TABV);
  float* su = (float*)(p.ws + OFF_SU);
  float* sv = (float*)(p.ws + OFF_SV);
  const int tq = tid_opaque(); const int lane = tq & 63, wave = tq >> 6;
  for (int e = blockIdx.x * 8 + wave; e < 16384; e += gridDim.x * 8) {
    f32x4 a[4], c[4];
    float ma = 0.f, mc = 0.f;
#pragma unroll
    for (int i = 0; i < 4; ++i) {
      const int col = i * 256 + lane * 4;
      a[i] = *(const f32x4*)(p.pu + (size_t)e * 1024 + col);
      c[i] = *(const f32x4*)(p.pv + (size_t)e * 1024 + col);
#pragma unroll
      for (int j = 0; j < 4; ++j) { ma = fmaxf(ma, fabsf(a[i][j])); mc = fmaxf(mc, fabsf(c[i][j])); }
    }
    ma = wave_max(ma); mc = wave_max(mc);
    const float sa = (ma > 0.f) ? ma * (1.0f / 448.0f) : 1.0f, sc = (mc > 0.f) ? mc * (1.0f / 448.0f) : 1.0f;
    const float ia = 1.0f / sa, ic = 1.0f / sc;
    if (lane == 0) { su[e] = sa; sv[e] = sc; }
#pragma unroll
    for (int i = 0; i < 4; ++i) {
      const int col = i * 256 + lane * 4;
      *(unsigned*)(tu + (size_t)e * 1024 + col) = pack4_fp8(a[i][0] * ia, a[i][1] * ia, a[i][2] * ia, a[i][3] * ia);
      const int slice = i * 2 + (lane >> 5);
      *(unsigned*)(tv + ((size_t)slice * 16384 + e) * 128 + (lane & 31) * 4) = pack4_fp8(c[i][0] * ic, c[i][1] * ic, c[i][2] * ic, c[i][3] * ic);
    }
  }
}

template <int CTRL> DI float dpp_f(float v) { return __int_as_float(__builtin_amdgcn_mov_dpp(__float_as_int(v), CTRL, 0xf, 0xf, false)); }
template <int CTRL> DI int dpp_shr0(int v) { return __builtin_amdgcn_update_dpp(0, v, CTRL, 0xf, 0xf, true); }
template <int I> DI int bcast16(int v) { return __builtin_amdgcn_mov_dpp(v, 0x150 + I, 0xf, 0xf, false); }
DI float row_sum16(float d) {
  d += dpp_f<0xB1>(d);
  d += dpp_f<0x4E>(d);
  d += dpp_f<0x141>(d);
  d += dpp_f<0x140>(d);
  return d;
}
typedef __bf16 bf16x2_c __attribute__((ext_vector_type(2)));
DI float dot4_fp8(unsigned w8, unsigned xlo, unsigned xhi, float acc) {
  const bf16x2_c lo = __builtin_amdgcn_cvt_scalef32_pk_bf16_fp8((int)w8, 1.0f, false);
  const bf16x2_c hi = __builtin_amdgcn_cvt_scalef32_pk_bf16_fp8((int)w8, 1.0f, true);
  acc = __builtin_amdgcn_fdot2_f32_bf16(lo, __builtin_bit_cast(bf16x2_c, xlo), acc, false);
  return __builtin_amdgcn_fdot2_f32_bf16(hi, __builtin_bit_cast(bf16x2_c, xhi), acc, false);
}
DI void phase_upass(const P& p, char* smem) {
  const int* idx = (const int*)(p.ws + OFF_IDX);
  const float* gv = (const float*)(p.ws + OFF_GV);
  const ushort_t* u2b = (const ushort_t*)(p.ws + OFF_U2B);
  const char* tabu = (const char*)(p.ws + OFF_TABU);
  const float* su = (const float*)(p.ws + OFF_SU);
  const float* sv = (const float*)(p.ws + OFF_SV);
  float* coef = (float*)(p.ws + OFF_COEF);
  const int tq = tid_opaque(); const int lane = tq & 63, wave = tq >> 6;
  const int g = lane >> 4, j = lane & 15;
  int4* lst = (int4*)smem + wave * 512 + g * 128;
  const int part = blockIdx.x & 7, bi = blockIdx.x >> 3, nb = (gridDim.x - part + 7) >> 3;
  __syncthreads();
#pragma unroll 1
  for (int tb = (bi * 8 + wave) * 4; tb < T_; tb += nb * 32) {
    const int tok = tb + g;
    const int4 i0 = *(const int4*)(idx + (size_t)tb * 128 + lane * 8), i1 = *(const int4*)(idx + (size_t)tb * 128 + lane * 8 + 4);
    const f32x4 g0 = *(const f32x4*)(gv + (size_t)tb * 128 + lane * 8), g1 = *(const f32x4*)(gv + (size_t)tb * 128 + lane * 8 + 4);
    u32x4 xr[8];
#pragma unroll
    for (int c = 0; c < 4; ++c) {
      xr[2 * c] = *(const u32x4*)(u2b + (size_t)tok * 1024 + (j + 16 * c) * 16);
      xr[2 * c + 1] = *(const u32x4*)(u2b + (size_t)tok * 1024 + (j + 16 * c) * 16 + 8);
    }
    const int ev[8] = {i0.x, i0.y, i0.z, i0.w, i1.x, i1.y, i1.z, i1.w};
    const float gg[8] = {g0[0], g0[1], g0[2], g0[3], g1[0], g1[1], g1[2], g1[3]};
    int cnt = 0;
#pragma unroll
    for (int i = 0; i < 8; ++i) cnt += ((ev[i] >> 11) == part) ? 1 : 0;
    int incl = cnt;
    incl += dpp_shr0<0x111>(incl); incl += dpp_shr0<0x112>(incl); incl += dpp_shr0<0x114>(incl); incl += dpp_shr0<0x118>(incl);
    const int ng = bcast16<15>(incl);
    int pos = incl - cnt;
#pragma unroll
    for (int i = 0; i < 8; ++i)
      if ((ev[i] >> 11) == part) { int4 en; en.x = ev[i]; en.y = __float_as_int(gg[i]); en.z = j * 8 + i; en.w = 0; lst[pos] = en; ++pos; }
    const int nmax = max(max(__builtin_amdgcn_readlane(ng, 0), __builtin_amdgcn_readlane(ng, 16)), max(__builtin_amdgcn_readlane(ng, 32), __builtin_amdgcn_readlane(ng, 48)));
    __builtin_amdgcn_wave_barrier();
    asm volatile("s_waitcnt lgkmcnt(0)" ::: "memory");
    u32x4 ra[4], rb[4], rc[4], rd[4];
#define UP_LOAD(R, IT) { const unsigned e_ = ((IT) < ng) ? (unsigned)lst[(IT)].x : 0u; const char* row_ = tabu + (size_t)e_ * 1024 + j * 16; \
                         _Pragma("unroll") for (int c = 0; c < 4; ++c) R[c] = *(const u32x4*)(row_ + c * 256); }
#define UP_COMP(R, IT) { float a0 = 0.f, a1 = 0.f, a2 = 0.f, a3 = 0.f; \
      _Pragma("unroll") for (int c = 0; c < 4; ++c) { \
        a0 = dot4_fp8(R[c][0], xr[2 * c][0], xr[2 * c][1], a0); a1 = dot4_fp8(R[c][1], xr[2 * c][2], xr[2 * c][3], a1); \
        a2 = dot4_fp8(R[c][2], xr[2 * c + 1][0], xr[2 * c + 1][1], a2); a3 = dot4_fp8(R[c][3], xr[2 * c + 1][2], xr[2 * c + 1][3], a3); } \
      const float d_ = row_sum16((a0 + a1) + (a2 + a3)); \
      if (j == 0 && (IT) < ng) ((int*)&lst[(IT)])[3] = __float_as_int(d_); }
    UP_LOAD(ra, 0) UP_LOAD(rb, 1) UP_LOAD(rc, 2) UP_LOAD(rd, 3)
#pragma unroll 1
    for (int it = 0; it < nmax; it += 4) {
      UP_COMP(ra, it)     UP_LOAD(ra, it + 4)
      UP_COMP(rb, it + 1) UP_LOAD(rb, it + 5)
      UP_COMP(rc, it + 2) UP_LOAD(rc, it + 6)
      UP_COMP(rd, it + 3) UP_LOAD(rd, it + 7)
    }
#undef UP_LOAD
#undef UP_COMP
    __builtin_amdgcn_wave_barrier();
    asm volatile("s_waitcnt lgkmcnt(0)" ::: "memory");
#pragma unroll 1
    for (int k = 0; k < nmax; k += 16) {
      if (k + j < ng) {
        const int4 en = lst[k + j];
        const float a = __int_as_float(en.w) * su[en.x];
        coef[(size_t)tok * 128 + en.z] = __int_as_float(en.y) * 0.5f * a * (1.f + erff(a * 0.7071067811865475f)) * sv[en.x];
      }
    }
    __builtin_amdgcn_wave_barrier();
    asm volatile("s_waitcnt lgkmcnt(0)" ::: "memory");
  }
}

struct VHdr { int ea, eb, ca, cb; };
DI VHdr vp_hdr(const int* idx, const float* coef, int tok, int g, int cq) {
  VHdr h;
  h.ea = idx[(size_t)tok * 128 + g * 32 + cq]; h.eb = idx[(size_t)tok * 128 + g * 32 + 16 + cq];
  h.ca = __float_as_int(coef[(size_t)tok * 128 + g * 32 + cq]); h.cb = __float_as_int(coef[(size_t)tok * 128 + g * 32 + 16 + cq]);
  return h;
}
DI void vp_rows(uint2 (&va)[16], uint2 (&vb)[16], const VHdr& h, const char* tb) {
#define VP_STEP(I) { va[I] = *(const uint2*)(tb + (unsigned)bcast16<I>(h.ea) * 128u); vb[I] = *(const uint2*)(tb + (unsigned)bcast16<I>(h.eb) * 128u); }
  VP_STEP(0) VP_STEP(1) VP_STEP(2) VP_STEP(3) VP_STEP(4) VP_STEP(5) VP_STEP(6) VP_STEP(7)
  VP_STEP(8) VP_STEP(9) VP_STEP(10) VP_STEP(11) VP_STEP(12) VP_STEP(13) VP_STEP(14) VP_STEP(15)
#undef VP_STEP
}
DI void vp_coefs(float (&fa)[16], float (&fb)[16], const VHdr& h) {
#define VP_STEP(I) { fa[I] = __int_as_float(bcast16<I>(h.ca)); fb[I] = __int_as_float(bcast16<I>(h.cb)); }
  VP_STEP(0) VP_STEP(1) VP_STEP(2) VP_STEP(3) VP_STEP(4) VP_STEP(5) VP_STEP(6) VP_STEP(7)
  VP_STEP(8) VP_STEP(9) VP_STEP(10) VP_STEP(11) VP_STEP(12) VP_STEP(13) VP_STEP(14) VP_STEP(15)
#undef VP_STEP
}
DI void vp_fma8(float (&a)[8], float cf, const uint2& v) {
  const f32x2_hw p0 = __builtin_amdgcn_cvt_pk_f32_fp8((int)v.x, false), p1 = __builtin_amdgcn_cvt_pk_f32_fp8((int)v.x, true);
  const f32x2_hw p2 = __builtin_amdgcn_cvt_pk_f32_fp8((int)v.y, false), p3 = __builtin_amdgcn_cvt_pk_f32_fp8((int)v.y, true);
  a[0] += cf * p0[0]; a[1] += cf * p0[1]; a[2] += cf * p1[0]; a[3] += cf * p1[1];
  a[4] += cf * p2[0]; a[5] += cf * p2[1]; a[6] += cf * p3[0]; a[7] += cf * p3[1];
}
DI void vp_consume(const uint2 (&va)[16], const uint2 (&vb)[16], const VHdr& h, float* f, int tok, int slice, int g, int cq, bool live) {
  float fa[16], fb[16];
  vp_coefs(fa, fb, h);
  float a[8];
#pragma unroll
  for (int i = 0; i < 8; ++i) a[i] = 0.f;
#pragma unroll
  for (int i = 0; i < 16; ++i) { vp_fma8(a, fa[i], va[i]); vp_fma8(a, fb[i], vb[i]); }
#pragma unroll
  for (int i = 0; i < 8; ++i) { a[i] += __shfl_xor(a[i], 16); a[i] += __shfl_xor(a[i], 32); }
  if (g == 0 && live) {
    f32x4 o0, o1; o0[0] = a[0]; o0[1] = a[1]; o0[2] = a[2]; o0[3] = a[3]; o1[0] = a[4]; o1[1] = a[5]; o1[2] = a[6]; o1[3] = a[7];
    float* fp = f + (size_t)tok * 1024 + slice * 128 + cq * 8;
    *(f32x4*)fp = o0; *(f32x4*)(fp + 4) = o1;
  }
}
DI void phase_vpass(const P& p) {
  const int* idx = (const int*)(p.ws + OFF_IDX);
  const float* coef = (const float*)(p.ws + OFF_COEF);
  const char* tabv = (const char*)(p.ws + OFF_TABV);
  float* f = (float*)(p.ws + OFF_F);
  const int tq = tid_opaque(); const int lane = tq & 63, wave = tq >> 6;
  const int g = lane >> 4, cq = lane & 15;
  const int slice = blockIdx.x & 7, bi = blockIdx.x >> 3, nb = (gridDim.x - slice + 7) >> 3;
  const int step = nb * 8;
  const char* tb = tabv + (size_t)slice * (16384 * 128) + cq * 8;
  int tok = bi * 8 + wave;
  if (tok >= T_) return;
  VHdr h0 = vp_hdr(idx, coef, tok, g, cq);
  VHdr h1 = vp_hdr(idx, coef, min(tok + step, T_ - 1), g, cq);
  uint2 va[16], vb[16], na[16], nb2[16];
  vp_rows(va, vb, h0, tb);
#pragma unroll 1
  for (; tok < T_; tok += 2 * step) {
    const VHdr h2 = vp_hdr(idx, coef, min(tok + 2 * step, T_ - 1), g, cq);
    vp_rows(na, nb2, h1, tb);
    vp_consume(va, vb, h0, f, tok, slice, g, cq, true);
    const VHdr h3 = vp_hdr(idx, coef, min(tok + 3 * step, T_ - 1), g, cq);
    vp_rows(va, vb, h2, tb);
    vp_consume(na, nb2, h1, f, tok + step, slice, g, cq, tok + step < T_);
    h0 = h2; h1 = h3;
  }
}

DI void phase_ln2(const P& p) {
  const float* ada = (const float*)(p.ws + OFF_ADA);
  const float* f = (const float*)(p.ws + OFF_F);
  const int tq = tid_opaque(); const int lane = tq & 63, wave = tq >> 6;
  for (int tok = blockIdx.x * 8 + wave; tok < T_; tok += gridDim.x * 8) {
    const int b = tok / S_;
    float* rp = p.out + (size_t)tok * 1024;
    f32x4 acc[4];
    float sm = 0.f;
#pragma unroll
    for (int i = 0; i < 4; ++i) {
      const int col = i * 256 + lane * 4;
      f32x4 x1 = *(const f32x4*)(rp + col), ff = *(const f32x4*)(f + (size_t)tok * 1024 + col);
      f32x4 g2 = *(const f32x4*)(ada + b * 6144 + 5 * 1024 + col);
#pragma unroll
      for (int j = 0; j < 4; ++j) { acc[i][j] = DN_ALPHA * x1[j] + (1.f + g2[j]) * ff[j]; sm += acc[i][j]; }
    }
    const float mu = wave_sum(sm) * (1.f / 1024.f);
    float q = 0.f;
#pragma unroll
    for (int i = 0; i < 4; ++i)
#pragma unroll
      for (int j = 0; j < 4; ++j) { float d = acc[i][j] - mu; q += d * d; }
    const float rs = rsqrtf(wave_sum(q) * (1.f / 1024.f) + LN_EPS);
#pragma unroll
    for (int i = 0; i < 4; ++i) {
      const int col = i * 256 + lane * 4;
      f32x4 gg = *(const f32x4*)(p.ln2_g + col), bb = *(const f32x4*)(p.ln2_b + col), o;
#pragma unroll
      for (int j = 0; j < 4; ++j) o[j] = (acc[i][j] - mu) * rs * gg[j] + bb[j];
      *(f32x4*)(rp + col) = o;
    }
  }
}

#define XB_TMO      128
#define XB_XCNT(j)  (256  + 64 * (j))
#define XB_XSUB(j)  (1280 + 64 * (j))
#define XB_XGEN(j)  (2304 + 64 * (j))
#define XB_TOP      3328
#define XB_TOPGEN   3392
#define XCD_BAR_WORDS 3456
#define XB_SPIN_CAP (1u << 22)
#define LAS __attribute__((address_space(3)))
DI unsigned xb_ld(unsigned* p)              { return __hip_atomic_load(p, __ATOMIC_RELAXED, __HIP_MEMORY_SCOPE_AGENT); }
DI unsigned xb_add(unsigned* p, unsigned v) { return __hip_atomic_fetch_add(p, v, __ATOMIC_RELAXED, __HIP_MEMORY_SCOPE_AGENT); }
DI unsigned xb_xcc_id() { return (unsigned)__builtin_amdgcn_s_getreg((3 << 11) | 20) & 0xFu; }
#define XB_SPIN(cond, bar) do { unsigned _sp = 0; while (cond) { __builtin_amdgcn_s_sleep(1); \
    if ((++_sp & 255u) == 0u) { if (xb_ld(&(bar)[XB_TMO])) break; if (_sp > XB_SPIN_CAP) { atomicAdd(&(bar)[XB_TMO], 1u); break; } } } } while (0)
struct XcdBarrier { unsigned* bar; unsigned x; volatile LAS unsigned* st; };
DI XcdBarrier xcd_barrier_post(unsigned* bar, volatile LAS unsigned* st) {
  XcdBarrier b; b.bar = bar; b.x = xb_xcc_id(); b.st = st;
  if (threadIdx.x == 0) (void)xb_add(&bar[XB_XCNT(b.x)], 1u);
  return b;
}
DI void xcd_barrier_complete(unsigned* bar, unsigned x, unsigned& nloc, unsigned& nx) {
  const unsigned G = gridDim.x * gridDim.y * gridDim.z;
  unsigned sum, cnt, mine, sp = 0u;
  for (;;) {
    sum = 0u; cnt = 0u; mine = 0u;
#pragma unroll
    for (unsigned j = 0; j < 16; ++j) { const unsigned c = xb_ld(&bar[XB_XCNT(j)]); sum += c; cnt += (c > 0u) ? 1u : 0u; mine = (j == x) ? c : mine; }
    if (sum == G) break;
    __builtin_amdgcn_s_sleep(1);
    if ((++sp & 255u) == 0u) { if (xb_ld(&bar[XB_TMO])) break; if (sp > XB_SPIN_CAP) { atomicAdd(&bar[XB_TMO], 1u); break; } }
  }
  nloc = mine > 0u ? mine : 1u; nx = cnt > 0u ? cnt : 1u;
}
DI void xcd_barrier(unsigned* barp, char* stp) {
  asm volatile("s_waitcnt vmcnt(0)" ::: "memory");
  __syncthreads();
  if (threadIdx.x == 0) {
    XcdBarrier b; b.bar = barp; b.x = xb_xcc_id(); b.st = (volatile LAS unsigned*)stp;
    unsigned* bar = b.bar;
    __builtin_amdgcn_s_waitcnt(0);
    unsigned nloc = b.st[0], nx = b.st[1];
    if (nloc == 0u) { xcd_barrier_complete(bar, b.x, nloc, nx); b.st[0] = nloc; b.st[1] = nx; }
    const unsigned old = xb_add(&bar[XB_XSUB(b.x)], 1u);
    const unsigned gen = old / nloc;
    if (old + 1u == (gen + 1u) * nloc) {
      __builtin_amdgcn_fence(__ATOMIC_RELEASE, "agent");
      asm volatile("s_waitcnt vmcnt(0)" ::: "memory");
      const unsigned og = xb_add(&bar[XB_TOP], 1u);
      const unsigned tg = og / nx;
      if (og + 1u == (tg + 1u) * nx) xb_add(&bar[XB_TOPGEN], 1u);
      else XB_SPIN(xb_ld(&bar[XB_TOPGEN]) == tg, bar);
      __builtin_amdgcn_fence(__ATOMIC_ACQUIRE, "agent");
      xb_add(&bar[XB_XGEN(b.x)], 1u);
      asm volatile("s_waitcnt vmcnt(0)" ::: "memory");
    } else {
      XB_SPIN(xb_ld(&bar[XB_XGEN(b.x)]) == gen, bar);
      __builtin_amdgcn_fence(__ATOMIC_ACQUIRE, "agent");
      asm volatile("s_waitcnt vmcnt(0)" ::: "memory");
    }
  }
  __syncthreads();
}

constexpr int SMEM_BYTES = 143360;
__global__ void __launch_bounds__(NT) fwd_megakernel(P p) {
  __shared__ __attribute__((aligned(16))) char smem[SMEM_BYTES + 16];
  if (threadIdx.x < 4) ((volatile LAS unsigned*)(smem + SMEM_BYTES))[threadIdx.x] = 0u;
  __syncthreads();
  (void)xcd_barrier_post((unsigned*)(p.ws + OFF_BAR), (volatile LAS unsigned*)(smem + SMEM_BYTES));
  phase_ada(p, smem);
  xcd_barrier((unsigned*)(p.ws + OFF_BAR), smem + SMEM_BYTES);
  phase_u1(p);
  phase_transposes(p, smem);
  phase_keys(p);
  phase_rope(p);
  phase_filter(p, smem);
  xcd_barrier((unsigned*)(p.ws + OFF_BAR), smem + SMEM_BYTES);
  phase_inproj(p, smem);
  xcd_barrier((unsigned*)(p.ws + OFF_BAR), smem + SMEM_BYTES);
  for (int item = blockIdx.x; item < 512 + 256; item += gridDim.x) {
    if (item < 512) hyena_item(p, smem, item);
    else attn_item(p, smem, item - 512);
  }
  xcd_barrier((unsigned*)(p.ws + OFF_BAR), smem + SMEM_BYTES);
  phase_yh_transpose(p, smem);
  xcd_barrier((unsigned*)(p.ws + OFF_BAR), smem + SMEM_BYTES);
  phase_merge(p, smem);
  xcd_barrier((unsigned*)(p.ws + OFF_BAR), smem + SMEM_BYTES);
  phase_outproj(p, smem);
  xcd_barrier((unsigned*)(p.ws + OFF_BAR), smem + SMEM_BYTES);
  phase_ln1(p);
  phase_tabconv(p);
  xcd_barrier((unsigned*)(p.ws + OFF_BAR), smem + SMEM_BYTES);
  phase_route(p, smem);
  xcd_barrier((unsigned*)(p.ws + OFF_BAR), smem + SMEM_BYTES);
  phase_upass(p, smem);
  xcd_barrier((unsigned*)(p.ws + OFF_BAR), smem + SMEM_BYTES);
  phase_vpass(p);
  xcd_barrier((unsigned*)(p.ws + OFF_BAR), smem + SMEM_BYTES);
  phase_ln2(p);
}

extern "C" void kernel_launch(void* const* d_in, const int* in_sizes, int n_in, void* d_out, int out_size, void* d_ws, size_t ws_size,
                              hipStream_t stream) {
  P p{};
  p.x = (const float*)d_in[0]; p.c = (const float*)d_in[1]; p.pos = (const int*)d_in[2];
  p.w_ada = (const float*)d_in[3]; p.b_ada = (const float*)d_in[4]; p.w_in = (const float*)d_in[5];
  p.hy_conv_w = (const float*)d_in[6]; p.hy_conv_b = (const float*)d_in[7];
  p.f1_w = (const float*)d_in[8]; p.f1_b = (const float*)d_in[9]; p.f1_freq = (const float*)d_in[10];
  p.f2_w = (const float*)d_in[11]; p.f2_b = (const float*)d_in[12]; p.f2_freq = (const float*)d_in[13];
  p.f3_w = (const float*)d_in[14]; p.hy_bias = (const float*)d_in[15];
  p.w_bh = (const float*)d_in[16]; p.w_ba = (const float*)d_in[17]; p.w_out = (const float*)d_in[18];
  p.ln1_g = (const float*)d_in[19]; p.ln1_b = (const float*)d_in[20];
  p.wq = (const float*)d_in[21]; p.keys = (const float*)d_in[22]; p.pu = (const float*)d_in[23]; p.pv = (const float*)d_in[24];
  p.ln2_g = (const float*)d_in[25]; p.ln2_b = (const float*)d_in[26];
  p.out = (float*)d_out; p.ws = (char*)d_ws;

  static int grid_blocks = 0;
  if (!grid_blocks) {
    int dev = 0, cus = 0, per_cu = 0;
    hipGetDevice(&dev);
    hipDeviceGetAttribute(&cus, hipDeviceAttributeMultiprocessorCount, dev);
    hipOccupancyMaxActiveBlocksPerMultiprocessor(&per_cu, fwd_megakernel, NT, 0);
    if (per_cu > 1) per_cu = 1;
    grid_blocks = cus * per_cu;
  }
  (void)hipMemsetAsync((char*)d_ws + OFF_BAR, 0, XCD_BAR_WORDS * 4, stream);
  void* args[] = {&p};
  hipError_t e = hipLaunchCooperativeKernel((void*)fwd_megakernel, dim3(grid_blocks), dim3(NT), args, 0, stream);
  if (e != hipSuccess) fprintf(stderr, "cooperative launch failed: %s (grid %d)\n", hipGetErrorString(e), grid_blocks);
}
```
